# Optimizing an MI355X kernel written in HIP

```python
import jax, jax.numpy as jnp
from jax import lax
import numpy as np

D_MODEL = 1024
BATCH = 4
SEQ = 8192
DEPTH = 1

PLE_DIM = 256
HEAD_DIM = 64
FOX_HEADS = 8
RWKV_HEADS = 8
FOX_WIDTH = FOX_HEADS * HEAD_DIM
RWKV_WIDTH = RWKV_HEADS * HEAD_DIM
MIX_WIDTH = FOX_WIDTH + RWKV_WIDTH
Q_BLOCK = 128
DECAY_LORA = 64
ICLR_LORA = 64
GATE_LORA = 128
FOX_IN = 4 * FOX_WIDTH + FOX_HEADS
RWKV_IN = 3 * RWKV_WIDTH + DECAY_LORA + ICLR_LORA + GATE_LORA
IN_WIDTH = FOX_IN + RWKV_IN
FOX_SPLIT_IDX = (FOX_WIDTH, 2 * FOX_WIDTH, 3 * FOX_WIDTH, 4 * FOX_WIDTH)
RWKV_SPLIT_IDX = (RWKV_WIDTH, 2 * RWKV_WIDTH, 3 * RWKV_WIDTH,
                  3 * RWKV_WIDTH + DECAY_LORA, 3 * RWKV_WIDTH + DECAY_LORA + ICLR_LORA)
N_EXPERTS = 32
TOP_K = 4
EXPERT_FF = 1024
SWIGLU_LIMIT = 7.0
SWIGLU_ALPHA = 1.702
MOE_BLOCK = 256
NORM_EPS = 1e-6
GN_EPS = 64e-5

kernel_name = "fox_rwkv7_hybrid_moe_ple_block"


def rmsnorm(x, g):
    xf = x.astype(jnp.float32)
    y = xf * lax.rsqrt(jnp.mean(xf * xf, axis=-1, keepdims=True) + NORM_EPS)
    return (y * g.astype(jnp.float32)).astype(x.dtype)


def token_shift(z):
    return jnp.pad(z[:, :-1], ((0, 0), (1, 0), (0, 0)))


def fox_attention(q, k, v, log_f):
    B, S, H, Dh = q.shape
    nblk = S // Q_BLOCK
    c = jnp.cumsum(log_f, axis=1)
    c_keys = c.transpose(0, 2, 1)
    qb = q.reshape(B, nblk, Q_BLOCK, H, Dh).transpose(1, 0, 2, 3, 4)
    cb = c.reshape(B, nblk, Q_BLOCK, H).transpose(1, 0, 3, 2)
    kpos = jnp.arange(S)
    scale = HEAD_DIM ** -0.5

    def block(args):
        i, q_i, c_i = args
        s = jnp.einsum('bqhd,bkhd->bhqk', q_i, k, preferred_element_type=jnp.float32) * scale
        s = s + (c_i[..., :, None] - c_keys[..., None, :])
        qpos = i * Q_BLOCK + jnp.arange(Q_BLOCK)
        s = jnp.where(kpos[None, :] <= qpos[:, None], s, -jnp.inf)
        pr = jax.nn.softmax(s, axis=-1)
        return jnp.einsum('bhqk,bkhd->bqhd', pr.astype(v.dtype), v)

    out = lax.map(block, (jnp.arange(nblk), qb, cb))
    return out.transpose(1, 0, 2, 3, 4).reshape(B, S, H, Dh)


def rwkv7_recurrence(r, w, k, v, a, b):
    B, S, H, N = r.shape

    def step(state, inp):
        r_t, w_t, k_t, v_t, a_t, b_t = inp
        sa = jnp.einsum('bhvk,bhk->bhv', state, a_t)
        state = (state * w_t[:, :, None, :] + sa[..., None] * b_t[:, :, None, :]
                 + v_t[..., None] * k_t[:, :, None, :])
        return state, jnp.einsum('bhvk,bhk->bhv', state, r_t)

    xs = tuple(t.transpose(1, 0, 2, 3) for t in (r, w, k, v, a, b))
    _, y = lax.scan(step, jnp.zeros((B, H, N, N), jnp.float32), xs)
    return y.transpose(1, 0, 2, 3)


def rwkv7_time_mix(z_all, mu, w0, w2, a0, a2, g2, k_k, k_a, r_k, ln_w, ln_b):
    B, S, _ = z_all.shape
    f32 = jnp.float32
    z = (z_all + (token_shift(z_all) - z_all) * mu).astype(f32)
    r, k, v, zw, za, zg = jnp.split(z, RWKV_SPLIT_IDX, axis=-1)
    w_log = -jax.nn.softplus(-(w0.astype(f32) + jnp.tanh(zw) @ w2.astype(f32))) - 0.5
    decay = jnp.exp(-jnp.exp(w_log))
    a = jax.nn.sigmoid(a0.astype(f32) + za @ a2.astype(f32))
    g = jax.nn.sigmoid(zg) @ g2.astype(f32)
    heads = lambda t: t.reshape(B, S, RWKV_HEADS, HEAD_DIM)
    kk = heads(k * k_k.astype(f32))
    kk = kk / jnp.maximum(jnp.sqrt(jnp.sum(kk * kk, axis=-1, keepdims=True)), 1e-12)
    k = k * (1.0 + (a - 1.0) * k_a.astype(f32))
    rh, kh, vh, ah = heads(r), heads(k), heads(v), heads(a)
    y = rwkv7_recurrence(rh, heads(decay), kh, vh, -kk, kk * ah)
    mean = jnp.mean(y, axis=-1, keepdims=True)
    var = jnp.mean(jnp.square(y - mean), axis=-1, keepdims=True)
    y = ((y - mean) * lax.rsqrt(var + GN_EPS)).reshape(B, S, RWKV_WIDTH)
    y = y * ln_w.astype(f32) + ln_b.astype(f32)
    bonus = jnp.sum(rh * kh * r_k.astype(f32), axis=-1, keepdims=True) * vh
    y = (y + bonus.reshape(B, S, RWKV_WIDTH)) * g
    return y.astype(z_all.dtype)


def moe_ffn(h, w_router, b_router, w_gu, b_gu, w_down, b_down):
    B, S, D = h.shape
    xt = h.reshape(-1, D)
    N = xt.shape[0]
    NK = N * TOP_K
    logits = (xt @ w_router).astype(jnp.float32) + b_router.astype(jnp.float32)
    top_val, top_idx = lax.top_k(logits, TOP_K)
    gates = jax.nn.softmax(top_val, axis=-1)
    flat_e = top_idx.reshape(-1)
    flat_tok = jnp.arange(NK) // TOP_K
    order = jnp.argsort(flat_e)
    e_sorted, tok_sorted, g_sorted = flat_e[order], flat_tok[order], gates.reshape(-1)[order]
    counts = jnp.bincount(flat_e, length=N_EXPERTS)
    group_start = jnp.cumsum(counts) - counts
    padded = ((counts + MOE_BLOCK - 1) // MOE_BLOCK) * MOE_BLOCK
    pad_end = jnp.cumsum(padded)
    pad_start = pad_end - padded
    dest = pad_start[e_sorted] + (jnp.arange(NK) - group_start[e_sorted])
    n_blocks = -(-NK // MOE_BLOCK) + N_EXPERTS
    P = n_blocks * MOE_BLOCK
    pad_tok = jnp.full((P,), N, jnp.int32).at[dest].set(tok_sorted.astype(jnp.int32))
    pad_gate = jnp.zeros((P,), jnp.float32).at[dest].set(g_sorted)
    block_e = jnp.clip(jnp.searchsorted(pad_end, jnp.arange(n_blocks) * MOE_BLOCK, side='right'),
                       0, N_EXPERTS - 1)

    def expert_block(args):
        idx, gt, e = args
        xb = jnp.take(xt, idx, axis=0, mode='fill', fill_value=0)
        hh = (xb @ w_gu[e] + b_gu[e]).astype(jnp.float32)
        glu = jnp.minimum(hh[:, :EXPERT_FF], SWIGLU_LIMIT)
        lin = jnp.clip(hh[:, EXPERT_FF:], -SWIGLU_LIMIT, SWIGLU_LIMIT)
        act = (glu * jax.nn.sigmoid(SWIGLU_ALPHA * glu) * (lin + 1.0)).astype(xt.dtype)
        return (act @ w_down[e] + b_down[e]).astype(jnp.float32) * gt[:, None]

    y_pad = lax.map(expert_block, (pad_tok.reshape(n_blocks, MOE_BLOCK),
                                   pad_gate.reshape(n_blocks, MOE_BLOCK), block_e))
    out = jnp.zeros((N, D), jnp.float32).at[pad_tok].add(y_pad.reshape(P, D), mode='drop')
    return out.astype(h.dtype).reshape(B, S, D)


def setup_inputs(seed: int = 0) -> dict:
    key = jax.random.key(seed)
    ks = iter(jax.random.split(key, 40))
    L = DEPTH
    f32 = jnp.float32

    def nrm(shape, scale):
        return jax.random.normal(next(ks), shape, f32) * scale

    def gain(shape):
        return 1.0 + nrm(shape, 0.05)

    def unif(shape, lo, hi):
        return jax.random.uniform(next(ks), shape, f32, minval=lo, maxval=hi)

    return {
        "x": nrm((BATCH, SEQ, D_MODEL), 1.0),
        "p": nrm((DEPTH, BATCH, SEQ, PLE_DIM), 1.0),
        "mix_norm": gain((L, D_MODEL)),
        "w_in": nrm((L, D_MODEL, IN_WIDTH), D_MODEL ** -0.5),
        "fox_f_bias": unif((L, FOX_HEADS), 1.0, 5.0),
        "fox_q_norm": gain((L, HEAD_DIM)),
        "fox_k_norm": gain((L, HEAD_DIM)),
        "rwkv_mu": unif((L, RWKV_IN), 0.0, 1.0),
        "rwkv_w0": unif((L, RWKV_WIDTH), -6.5, -1.5),
        "rwkv_w2": nrm((L, DECAY_LORA, RWKV_WIDTH), 0.1),
        "rwkv_a0": nrm((L, RWKV_WIDTH), 0.1),
        "rwkv_a2": nrm((L, ICLR_LORA, RWKV_WIDTH), 0.1),
        "rwkv_g2": nrm((L, GATE_LORA, RWKV_WIDTH), GATE_LORA ** -0.5),
        "rwkv_k_k": 0.85 + nrm((L, RWKV_WIDTH), 0.02),
        "rwkv_k_a": 1.0 + nrm((L, RWKV_WIDTH), 0.02),
        "rwkv_r_k": nrm((L, RWKV_HEADS, HEAD_DIM), 0.1),
        "rwkv_ln_w": gain((L, RWKV_WIDTH)),
        "rwkv_ln_b": nrm((L, RWKV_WIDTH), 0.01),
        "w_out": nrm((L, MIX_WIDTH, D_MODEL), MIX_WIDTH ** -0.5),
        "moe_norm": gain((L, D_MODEL)),
        "w_router": nrm((L, D_MODEL, N_EXPERTS), D_MODEL ** -0.5),
        "b_router": nrm((L, N_EXPERTS), 0.01),
        "w_gu": nrm((L, N_EXPERTS, D_MODEL, 2 * EXPERT_FF), D_MODEL ** -0.5),
        "b_gu": nrm((L, N_EXPERTS, 2 * EXPERT_FF), 0.01),
        "w_down": nrm((L, N_EXPERTS, EXPERT_FF, D_MODEL), EXPERT_FF ** -0.5),
        "b_down": nrm((L, N_EXPERTS, D_MODEL), 0.01),
        "ple_norm": gain((L, D_MODEL)),
        "w_ple_gate": nrm((L, D_MODEL, D_MODEL), D_MODEL ** -0.5),
        "w_ple_proj": nrm((L, PLE_DIM, D_MODEL), PLE_DIM ** -0.5),
        "final_norm": gain((D_MODEL,)),
    }


def reference(x, p, mix_norm, w_in, fox_f_bias, fox_q_norm, fox_k_norm, rwkv_mu, rwkv_w0, rwkv_w2,
              rwkv_a0, rwkv_a2, rwkv_g2, rwkv_k_k, rwkv_k_a, rwkv_r_k, rwkv_ln_w, rwkv_ln_b, w_out,
              moe_norm, w_router, b_router, w_gu, b_gu, w_down, b_down, ple_norm, w_ple_gate,
              w_ple_proj, final_norm):
    B, S, _ = x.shape
    for i in range(DEPTH):
        h = rmsnorm(x, mix_norm[i])
        z = h @ w_in[i]
        z_fox, z_rwkv = z[..., :FOX_IN], z[..., FOX_IN:]
        fq, fk, fv, fog, ff = jnp.split(z_fox, FOX_SPLIT_IDX, axis=-1)
        hd = lambda t: t.reshape(B, S, FOX_HEADS, HEAD_DIM)
        q = rmsnorm(hd(fq), fox_q_norm[i])
        k = rmsnorm(hd(fk), fox_k_norm[i])
        log_f = jax.nn.log_sigmoid(ff.astype(jnp.float32) + fox_f_bias[i].astype(jnp.float32))
        fox_out = fox_attention(q, k, hd(fv), log_f).reshape(B, S, FOX_WIDTH) * jax.nn.sigmoid(fog)
        rwkv_out = rwkv7_time_mix(z_rwkv, rwkv_mu[i], rwkv_w0[i], rwkv_w2[i], rwkv_a0[i], rwkv_a2[i],
                                  rwkv_g2[i], rwkv_k_k[i], rwkv_k_a[i], rwkv_r_k[i],
                                  rwkv_ln_w[i], rwkv_ln_b[i])
        x = x + jnp.concatenate([fox_out, rwkv_out], axis=-1) @ w_out[i]
        x = x + moe_ffn(rmsnorm(x, moe_norm[i]), w_router[i], b_router[i], w_gu[i], b_gu[i],
                        w_down[i], b_down[i])
        gate = jax.nn.sigmoid(rmsnorm(x, ple_norm[i]) @ w_ple_gate[i])
        x = x + gate * (p[i] @ w_ple_proj[i])
    return rmsnorm(x, final_norm)
```

```cpp
#include <hip/hip_runtime.h>
#include <cstdio>
#include <cstdint>

#define LAS __attribute__((address_space(3)))
#define GAS __attribute__((address_space(1)))
typedef unsigned short bf16_t;
typedef short bf16x8 __attribute__((ext_vector_type(8)));
typedef float f32x2 __attribute__((ext_vector_type(2)));
typedef float f32x4 __attribute__((ext_vector_type(4)));
typedef float f32x16 __attribute__((ext_vector_type(16)));
typedef unsigned u32x2 __attribute__((ext_vector_type(2)));
typedef unsigned u32x4 __attribute__((ext_vector_type(4)));

constexpr int NB = 4, SEQ = 8192, NTOK = NB * SEQ, DM = 1024;
constexpr int NH = 8, HD = 64;
constexpr int INW = 3848;
constexpr int ZW = 3840;
constexpr int ZQ = 0, ZK = 512, ZV = 1024, ZOG = 1536, ZR = 2048;
constexpr int RW_R = 0, RW_K = 512, RW_V = 1024, RW_W = 1536, RW_A = 1600, RW_G = 1664, RWIN = 1792;
constexpr int NE = 32, TOPK = 4, EFF = 1024;
constexpr int MAXBLK = (NTOK * TOPK) / 256 + NE;
constexpr int PLE = 256;
constexpr float LOG2E = 1.4426950408889634f;
constexpr float QSCALE = 0.125f * LOG2E;

constexpr size_t MiB = 1u << 20;
constexpr size_t WS_CTL = 0, CTL_BYTES = 1 * MiB;
constexpr size_t WS_C2 = 1 * MiB;
constexpr size_t WS_LOGF = 2 * MiB;
constexpr size_t WS_ROUTE = 3 * MiB;
constexpr size_t WS_TOKSLOT = 5 * MiB;
constexpr size_t WS_GATESLOT = 9 * MiB;
constexpr size_t WS_CTOT = 13 * MiB;
constexpr size_t WS_WIN = 16 * MiB;
constexpr size_t WS_WOUT = 24 * MiB;
constexpr size_t WS_WPG = 26 * MiB;
constexpr size_t WS_WPP = 28 * MiB;
constexpr size_t WS_WGU = 32 * MiB;
constexpr size_t WS_WDN = 160 * MiB;
constexpr size_t WS_XN = 224 * MiB;
constexpr size_t WS_X1 = 290 * MiB;
constexpr size_t WS_Z = 418 * MiB;
constexpr size_t WS_AO = 658 * MiB;
constexpr size_t WS_ACT = 418 * MiB;
constexpr size_t WS_RW = 722 * MiB;
constexpr size_t WS_RR = WS_RW, WS_RK = WS_RW + 32 * MiB, WS_RV = WS_RW + 64 * MiB, WS_RG = WS_RW + 96 * MiB;
constexpr size_t WS_RLW = WS_RW + 128 * MiB;
constexpr size_t WS_RKK = WS_RW + 192 * MiB, WS_RKA = WS_RW + 224 * MiB;
constexpr size_t WS_YP = 722 * MiB;
constexpr size_t WS_END = 994 * MiB;
static_assert(WS_ACT + (size_t)MAXBLK * 256 * 1024 * 2 <= WS_RW && WS_YP + (size_t)MAXBLK * 256 * 1024 * 2 <= WS_END, "ws map");
constexpr size_t DO_PJ = 0, DO_PB = 64 * MiB;
constexpr int CW_TMO = 0, CW_CNT = 64  , CW_BAR = 4096;

struct Params {
    const float *x, *p, *mix_norm, *w_in, *f_bias, *q_norm, *k_norm, *mu, *w0, *w2, *a0, *a2, *g2, *k_k, *k_a, *r_k, *ln_w, *ln_b, *w_out, *moe_norm, *w_router, *b_router, *w_gu, *b_gu, *w_down,
        *b_down, *ple_norm, *w_pg, *w_pp, *final_norm;
    float* out; unsigned char* ws;
};

__device__ __forceinline__ unsigned f2bf(float f) { unsigned u = __builtin_bit_cast(unsigned, f); return (u + 0x7fffu + ((u >> 16) & 1u)) >> 16; }
__device__ __forceinline__ unsigned pk2(float lo, float hi) { return f2bf(lo) | (f2bf(hi) << 16); }
__device__ __forceinline__ float bf2f(unsigned h) { return __builtin_bit_cast(float, h << 16); }
__device__ __forceinline__ float bflo(unsigned w) { return __builtin_bit_cast(float, w << 16); }
__device__ __forceinline__ float bfhi(unsigned w) { return __builtin_bit_cast(float, w & 0xffff0000u); }
__device__ __forceinline__ unsigned cvt_pk_bf16(float lo, float hi) { unsigned r; asm volatile("v_cvt_pk_bf16_f32 %0, %1, %2" : "=v"(r) : "v"(lo), "v"(hi)); return r; }
__device__ __forceinline__ float wave_sum(float v) {
#pragma unroll
    for (int o = 1; o < 64; o <<= 1) v += __shfl_xor(v, o);
    return v;
}
__device__ __forceinline__ float sigmoidf_(float x) { return 1.0f / (1.0f + __expf(-x)); }
__device__ __forceinline__ float logsigmoidf_(float x) { return fminf(x, 0.f) - log1pf(expf(-fabsf(x))); }
namespace pg8 {
constexpr int BM = 256, BK = 64, HALF = 128, HTB = HALF * BK * 2, STAGE_BYTES = 8 * HTB, NXCD = 8, WGM = 8;
__host__ __device__ __forceinline__ int lds_byte(int r, int c) { const int st = (r >> 4) * 2 + (c >> 5), rr = r & 15, cc = c & 31, ob = rr * 64 + cc * 2; return st * 1024 + (ob ^ (((ob >> 9) & 1) << 5)); }
__host__ __device__ __forceinline__ void stage_rc(int b, int& R, int& C) { const int st = b / 1024, sb = b % 1024, swz = sb ^ (((sb >> 9) & 1) << 5); R = (st >> 1) * 16 + swz / 64; C = (st & 1) * 32 + (swz % 64) / 2; }
__host__ __device__ __forceinline__ int perm32(int rho) { const int n = rho >> 4, i = rho & 15; return 8 * (i >> 2) + 4 * n + (i & 3); }

struct Unit { int pm, pn, e, lb; };

__device__ __forceinline__ bool tile_order(int i, int G, int c, int nM, int nN, int& pm, int& pn) {
    const int nwg = nM * nN; const long L = (long)i * G + c; if (L >= nwg) return false;
    int wgid = (int)L; { const int q = nwg / NXCD, r = nwg % NXCD, xcd = wgid % NXCD, off = wgid / NXCD; wgid = (xcd < r ? xcd * (q + 1) : r * (q + 1) + (xcd - r) * q) + off; }
    const int nig = WGM * nN, gid = wgid / nig, fm = gid * WGM, gsz = (nM - fm) < WGM ? (nM - fm) : WGM;
    pm = fm + ((wgid % nig) % gsz); pn = (wgid % nig) / gsz; return true;
}
struct DenseOrder {
    const bf16_t* A; const bf16_t* Bt; int K, nM, nN, G, c;
    __device__ __forceinline__ bool next(int i, Unit& u) const { u.e = 0; u.lb = 0; return tile_order(i, G, c, nM, nN, u.pm, u.pn); }
    __device__ __forceinline__ const char* a_base(const Unit& u) const { return (const char*)A + (size_t)u.pm * BM * K * 2; }
    __device__ __forceinline__ const char* b_base(const Unit& u) const { return (const char*)Bt + (size_t)u.pn * BM * K * 2; }
    __device__ __forceinline__ void a_off(const Unit&, const int (&R)[2], const int (&C)[2], unsigned (&off)[2][2]) const {
#pragma unroll
        for (int h = 0; h < 2; ++h)
#pragma unroll
            for (int i = 0; i < 2; ++i) off[h][i] = (unsigned)((R[i] + HALF * h) * K + C[i]) * 2u;
    }
};

template <class Epi, class Sched, bool ALIGN_EPI>
__device__ __forceinline__ void gemm_phase(LAS unsigned char* lds, const int K, const Sched& S, const Epi& E) {
    const int tid = threadIdx.x, wid = __builtin_amdgcn_readfirstlane(tid >> 6), lane = tid & 63, wr = wid >> 2, wc = wid & 3, fr = lane & 15, fq = lane >> 4;
    const int nt = K / BK;
    int sR[2], sC[2]; unsigned voffB[2];
#pragma unroll
    for (int i = 0; i < 2; ++i) { int R, C; stage_rc(tid * 16 + i * 8192, R, C); const int Rb = Epi::PERM ? ((R & ~31) + perm32(R & 31)) : R; sR[i] = R; sC[i] = C; voffB[i] = (unsigned)(Rb * K + C) * 2u; }
    const size_t kstep = (size_t)(BK * 2);
    const size_t hstep = (size_t)HALF * K * 2;
    const unsigned ldsw = (unsigned)wid * 1024u;
    const int aoff = lds_byte(wr * 64 + fr, fq * 8), boff = lds_byte(wc * 32 + fr, fq * 8);
#define PG8_SA(b, h) (((b) * 2 + (h)) * HTB)
#define PG8_SB(b, h) ((4 + (b) * 2 + (h)) * HTB)
#define PG8_STAGE(bufoff, gbase, voff) do { _Pragma("unroll") for (int _i = 0; _i < 2; ++_i) \
        __builtin_amdgcn_global_load_lds((const unsigned*)((const char*)(gbase) + (voff)[_i]), (LAS unsigned*)(lds + (bufoff) + ldsw + _i * 8192), 16, 0, 0); } while (0)
#define PG8_LDA(dst, b, h) do { _Pragma("unroll") for (int m = 0; m < 4; ++m) _Pragma("unroll") for (int k = 0; k < 2; ++k) dst[m][k] = *(const LAS bf16x8*)(lds + PG8_SA(b, h) + aoff + m * 2048 + k * 1024); } while (0)
#define PG8_LDB(dst, b, h) do { _Pragma("unroll") for (int n = 0; n < 2; ++n) _Pragma("unroll") for (int k = 0; k < 2; ++k) dst[n][k] = *(const LAS bf16x8*)(lds + PG8_SB(b, h) + boff + n * 2048 + k * 1024); } while (0)
#define PG8_MMA(ai, bj, At, Bt) do { __builtin_amdgcn_s_setprio(1); _Pragma("unroll") for (int m = 0; m < 4; ++m) _Pragma("unroll") for (int n = 0; n < 2; ++n) _Pragma("unroll") for (int k = 0; k < 2; ++k) \
        acc[ai][bj][m][n] = __builtin_amdgcn_mfma_f32_16x16x32_bf16(Bt[n][k], At[m][k], acc[ai][bj][m][n], 0, 0, 0); __builtin_amdgcn_s_setprio(0); } while (0)
#define PG8_WAIT_V(n) asm volatile("s_waitcnt vmcnt(" #n ")" ::: "memory")
#define PG8_WAIT_L(n) asm volatile("s_waitcnt lgkmcnt(" #n ")" ::: "memory")
#define PG8_BAR __builtin_amdgcn_s_barrier()
#define PG8_SCHED __builtin_amdgcn_sched_barrier(0)
    Unit cur, nxt; int ui = 0;
    if (!S.next(0, cur)) return;
    f32x4 acc[2][2][4][2];
#pragma unroll
    for (int a = 0; a < 2; ++a)
#pragma unroll
        for (int b = 0; b < 2; ++b)
#pragma unroll
            for (int m = 0; m < 4; ++m)
#pragma unroll
                for (int n = 0; n < 2; ++n) acc[a][b][m][n] = (f32x4){0.f, 0.f, 0.f, 0.f};
    bf16x8 At[4][2], B0[2][2], B1[2][2];
    unsigned offC[2][2], offN[2][2];
    S.a_off(cur, sR, sC, offC);
    const char* cA = S.a_base(cur); const char* cB = S.b_base(cur);
    PG8_STAGE(PG8_SB(0, 0), cB, voffB); PG8_STAGE(PG8_SB(0, 1), cB + hstep, voffB); PG8_STAGE(PG8_SA(0, 0), cA, offC[0]); PG8_STAGE(PG8_SA(0, 1), cA, offC[1]);
    if (wr == 1) PG8_BAR;
    PG8_WAIT_V(2); PG8_BAR;
    PG8_STAGE(PG8_SB(1, 0), cB + kstep, voffB); PG8_STAGE(PG8_SA(1, 0), cA + kstep, offC[0]); PG8_STAGE(PG8_SB(1, 1), cB + hstep + kstep, voffB);
    PG8_WAIT_V(6); PG8_BAR;
    for (;;) {
        const bool has_next = S.next(ui + 1, nxt);
        const char* nA = cA; const char* nB = cB;
        if (has_next) { nA = S.a_base(nxt); nB = S.b_base(nxt); S.a_off(nxt, sR, sC, offN); }
        else {
#pragma unroll
            for (int h = 0; h < 2; ++h)
#pragma unroll
                for (int i = 0; i < 2; ++i) offN[h][i] = offC[h][i];
        }
#pragma nounroll
        for (int t = 0; t < nt; t += 2) {
            const bool last = (t == nt - 2);
            const char* a1 = cA + (size_t)(t + 1) * kstep;
            const char* a2 = last ? nA : cA + (size_t)(t + 2) * kstep; const char* b2 = last ? nB : cB + (size_t)(t + 2) * kstep;
            const char* a3 = a2 + kstep; const char* b3 = b2 + kstep;
            unsigned o2[2][2];
#pragma unroll
            for (int h = 0; h < 2; ++h)
#pragma unroll
                for (int i = 0; i < 2; ++i) o2[h][i] = last ? offN[h][i] : offC[h][i];
            PG8_LDB(B0, 0, 0); PG8_LDB(B1, 0, 1); PG8_SCHED; PG8_LDA(At, 0, 0); PG8_STAGE(PG8_SA(1, 1), a1, offC[1]);
            PG8_WAIT_V(8); PG8_WAIT_L(0); PG8_BAR; PG8_MMA(0, 0, At, B0); PG8_MMA(0, 1, At, B1); PG8_BAR; PG8_SCHED;
            PG8_LDA(At, 0, 1); PG8_STAGE(PG8_SB(0, 0), b2, voffB); PG8_STAGE(PG8_SB(0, 1), b2 + hstep, voffB); PG8_STAGE(PG8_SA(0, 0), a2, o2[0]);
            PG8_WAIT_V(8); PG8_WAIT_L(0); PG8_BAR; PG8_MMA(1, 0, At, B0); PG8_MMA(1, 1, At, B1); PG8_BAR; PG8_SCHED;
            PG8_LDB(B0, 1, 0); PG8_LDB(B1, 1, 1); PG8_SCHED; PG8_LDA(At, 1, 0); PG8_STAGE(PG8_SA(0, 1), a2, o2[1]);
            PG8_WAIT_V(8); PG8_WAIT_L(0); PG8_BAR; PG8_MMA(0, 0, At, B0); PG8_MMA(0, 1, At, B1); PG8_BAR; PG8_SCHED;
            PG8_LDA(At, 1, 1); PG8_STAGE(PG8_SB(1, 0), b3, voffB); PG8_STAGE(PG8_SB(1, 1), b3 + hstep, voffB); PG8_STAGE(PG8_SA(1, 0), a3, o2[0]);
            PG8_WAIT_V(8); PG8_WAIT_L(0); PG8_BAR; PG8_MMA(1, 0, At, B0); PG8_MMA(1, 1, At, B1); PG8_BAR; PG8_SCHED;
        }
        if constexpr (ALIGN_EPI) { if (wr == 0) PG8_BAR; }
        E(acc, cur, wr, wc, fr, fq);
        if (!has_next) break;
#pragma unroll
        for (int a = 0; a < 2; ++a)
#pragma unroll
            for (int b = 0; b < 2; ++b)
#pragma unroll
                for (int m = 0; m < 4; ++m)
#pragma unroll
                    for (int n = 0; n < 2; ++n) acc[a][b][m][n] = (f32x4){0.f, 0.f, 0.f, 0.f};
        cur = nxt; cA = nA; cB = nB; ++ui;
#pragma unroll
        for (int h = 0; h < 2; ++h)
#pragma unroll
            for (int i = 0; i < 2; ++i) offC[h][i] = offN[h][i];
        if constexpr (ALIGN_EPI) { if (wr == 1) PG8_BAR; }
    }
    PG8_WAIT_V(0);
    if constexpr (!ALIGN_EPI) { if (wr == 0) PG8_BAR; }
    PG8_BAR;
#undef PG8_SA
#undef PG8_SB
#undef PG8_STAGE
#undef PG8_LDA
#undef PG8_LDB
#undef PG8_MMA
#undef PG8_WAIT_V
#undef PG8_WAIT_L
#undef PG8_BAR
#undef PG8_SCHED
}
}
namespace pg8 {
constexpr int T_BLKSTART = 0  , T_CNT = 40  , T_BLKE = 80  , T_WORDS = 80 + 560;

struct EpiIn {
    static constexpr bool PERM = true;
    bf16_t* Z; const float* qn; const float* kn;
    __device__ __forceinline__ void operator()(const f32x4 (&acc)[2][2][4][2], const Unit& u, int wr, int wc, int fr, int fq) const {
        const int row0 = u.pm * BM + wr * 64 + fr;
        if (u.pn < 4) {
            const float* g = (u.pn < 2) ? qn : kn; const float sc = (u.pn < 2) ? QSCALE : 1.0f;
            f32x4 gv[2][2];
#pragma unroll
            for (int bj = 0; bj < 2; ++bj)
#pragma unroll
                for (int n = 0; n < 2; ++n) gv[bj][n] = *(const f32x4*)(g + 32 * bj + 8 * fq + 4 * n) * sc;
#pragma unroll
            for (int ai = 0; ai < 2; ++ai)
#pragma unroll
                for (int m = 0; m < 4; ++m) {
                    float ss = 0.f;
#pragma unroll
                    for (int bj = 0; bj < 2; ++bj)
#pragma unroll
                        for (int n = 0; n < 2; ++n) { const f32x4 x = acc[ai][bj][m][n]; ss += (x[0] * x[0] + x[1] * x[1]) + (x[2] * x[2] + x[3] * x[3]); }
                    ss += __shfl_xor(ss, 16); ss += __shfl_xor(ss, 32);
                    const float rstd = rsqrtf(ss * (1.0f / 64.0f) + 1e-6f);
                    bf16_t* rowp = Z + (size_t)(row0 + ai * HALF + m * 16) * ZW + u.pn * BM + 64 * wc + 8 * fq;
#pragma unroll
                    for (int bj = 0; bj < 2; ++bj) { const f32x4 v0 = acc[ai][bj][m][0] * rstd * gv[bj][0], v1 = acc[ai][bj][m][1] * rstd * gv[bj][1];
                        u32x4 w; w.x = cvt_pk_bf16(v0[0], v0[1]); w.y = cvt_pk_bf16(v0[2], v0[3]); w.z = cvt_pk_bf16(v1[0], v1[1]); w.w = cvt_pk_bf16(v1[2], v1[3]);
                        *(u32x4*)(rowp + 32 * bj) = w; }
                }
        } else {
            const int col0 = u.pn * BM + wc * 32 + 8 * fq;
#pragma unroll
            for (int ai = 0; ai < 2; ++ai)
#pragma unroll
                for (int m = 0; m < 4; ++m) { bf16_t* rowp = Z + (size_t)(row0 + ai * HALF + m * 16) * ZW + col0;
#pragma unroll
                    for (int bj = 0; bj < 2; ++bj) { const f32x4 v0 = acc[ai][bj][m][0], v1 = acc[ai][bj][m][1];
                        u32x4 w; w.x = cvt_pk_bf16(v0[0], v0[1]); w.y = cvt_pk_bf16(v0[2], v0[3]); w.z = cvt_pk_bf16(v1[0], v1[1]); w.w = cvt_pk_bf16(v1[2], v1[3]);
                        *(u32x4*)(rowp + bj * HALF) = w; } }
        }
    }
};
struct EpiBf16 {
    static constexpr bool PERM = true;
    bf16_t* O; int ldc;
    __device__ __forceinline__ void operator()(const f32x4 (&acc)[2][2][4][2], const Unit& u, int wr, int wc, int fr, int fq) const {
        const int row0 = u.pm * BM + wr * 64 + fr, col0 = u.pn * BM + wc * 32 + 8 * fq;
#pragma unroll
        for (int ai = 0; ai < 2; ++ai)
#pragma unroll
            for (int m = 0; m < 4; ++m) { bf16_t* rowp = O + (size_t)(row0 + ai * HALF + m * 16) * ldc + col0;
#pragma unroll
                for (int bj = 0; bj < 2; ++bj) { const f32x4 v0 = acc[ai][bj][m][0], v1 = acc[ai][bj][m][1];
                    u32x4 w; w.x = cvt_pk_bf16(v0[0], v0[1]); w.y = cvt_pk_bf16(v0[2], v0[3]); w.z = cvt_pk_bf16(v1[0], v1[1]); w.w = cvt_pk_bf16(v1[2], v1[3]);
                    *(u32x4*)(rowp + bj * HALF) = w; } }
    }
};
struct EpiOut {
    static constexpr bool PERM = false;
    const float* X; float* O;
    __device__ __forceinline__ void operator()(const f32x4 (&acc)[2][2][4][2], const Unit& u, int wr, int wc, int fr, int fq) const {
        const int row0 = u.pm * BM + wr * 64 + fr, col0 = u.pn * BM + wc * 32 + 4 * fq;
#pragma unroll
        for (int ai = 0; ai < 2; ++ai)
#pragma unroll
            for (int m = 0; m < 4; ++m) { const size_t off = (size_t)(row0 + ai * HALF + m * 16) * DM + col0;
#pragma unroll
                for (int bj = 0; bj < 2; ++bj)
#pragma unroll
                    for (int n = 0; n < 2; ++n) *(f32x4*)(O + off + bj * HALF + n * 16) = *(const f32x4*)(X + off + bj * HALF + n * 16) + acc[ai][bj][m][n];
                if (m & 1) asm volatile("" ::: "memory"); }
    }
};
struct EpiPg {
    static constexpr bool PERM = false;
    float* X; const bf16_t* PJ;
    __device__ __forceinline__ void operator()(const f32x4 (&acc)[2][2][4][2], const Unit& u, int wr, int wc, int fr, int fq) const {
        const int row0 = u.pm * BM + wr * 64 + fr, col0 = u.pn * BM + wc * 32 + 4 * fq;
#pragma unroll
        for (int ai = 0; ai < 2; ++ai)
#pragma unroll
            for (int m = 0; m < 4; ++m) { const size_t off = (size_t)(row0 + ai * HALF + m * 16) * DM + col0;
#pragma unroll
                for (int bj = 0; bj < 2; ++bj)
#pragma unroll
                    for (int n = 0; n < 2; ++n) { const size_t o = off + bj * HALF + n * 16; const u32x2 pj = *(const u32x2*)(PJ + o); const f32x4 a = acc[ai][bj][m][n]; const f32x4 xv = *(const f32x4*)(X + o);
                        f32x4 r; r[0] = xv[0] + sigmoidf_(a[0]) * bflo(pj.x); r[1] = xv[1] + sigmoidf_(a[1]) * bfhi(pj.x); r[2] = xv[2] + sigmoidf_(a[2]) * bflo(pj.y); r[3] = xv[3] + sigmoidf_(a[3]) * bfhi(pj.y);
                        *(f32x4*)(X + o) = r; }
                if (m & 1) asm volatile("" ::: "memory"); }
    }
};
struct EpiGu {
    static constexpr bool PERM = true;
    bf16_t* ACT; const float* b_gu;
    __device__ __forceinline__ void operator()(const f32x4 (&acc)[2][2][4][2], const Unit& u, int wr, int wc, int fr, int fq) const {
        const int row0 = u.pm * BM + wr * 64 + fr, cl = u.pn * HALF + wc * 32 + 8 * fq;
        const float* bg = b_gu + (size_t)u.e * 2048 + cl;
        f32x4 bgl[2], bli[2];
#pragma unroll
        for (int n = 0; n < 2; ++n) { bgl[n] = *(const f32x4*)(bg + 4 * n); bli[n] = *(const f32x4*)(bg + 1024 + 4 * n); }
#pragma unroll
        for (int ai = 0; ai < 2; ++ai)
#pragma unroll
            for (int m = 0; m < 4; ++m) { bf16_t* rowp = ACT + (size_t)(row0 + ai * HALF + m * 16) * EFF + cl; float r[8];
#pragma unroll
                for (int n = 0; n < 2; ++n)
#pragma unroll
                    for (int i = 0; i < 4; ++i) { const float gl = fminf(acc[ai][0][m][n][i] + bgl[n][i], 7.0f); const float li = fminf(fmaxf(acc[ai][1][m][n][i] + bli[n][i], -7.0f), 7.0f);
                        r[4 * n + i] = gl * sigmoidf_(1.702f * gl) * (li + 1.0f); }
                u32x4 w; w.x = cvt_pk_bf16(r[0], r[1]); w.y = cvt_pk_bf16(r[2], r[3]); w.z = cvt_pk_bf16(r[4], r[5]); w.w = cvt_pk_bf16(r[6], r[7]);
                *(u32x4*)rowp = w; }
    }
};
struct EpiDn {
    static constexpr bool PERM = true;
    bf16_t* YP; const float* b_dn; const float* gateslot; const LAS int* tab;
    __device__ __forceinline__ void operator()(const f32x4 (&acc)[2][2][4][2], const Unit& u, int wr, int wc, int fr, int fq) const {
        const int row0 = u.pm * BM + wr * 64 + fr, col0 = u.pn * BM + wc * 32 + 8 * fq;
        const float* bd = b_dn + (size_t)u.e * 1024 + col0; const int cnt = tab[T_CNT + u.e];
        f32x4 bv[2][2];
#pragma unroll
        for (int bj = 0; bj < 2; ++bj)
#pragma unroll
            for (int n = 0; n < 2; ++n) bv[bj][n] = *(const f32x4*)(bd + bj * HALF + 4 * n);
#pragma unroll
        for (int ai = 0; ai < 2; ++ai)
#pragma unroll
            for (int m = 0; m < 4; ++m) { const int rr = wr * 64 + fr + ai * HALF + m * 16, slot = u.lb * 256 + rr;
                const float gt = slot < cnt ? gateslot[(size_t)u.e * NTOK + slot] : 0.f;
                bf16_t* rowp = YP + (size_t)(row0 + ai * HALF + m * 16) * DM + col0;
#pragma unroll
                for (int bj = 0; bj < 2; ++bj) { const f32x4 v0 = (acc[ai][bj][m][0] + bv[bj][0]) * gt, v1 = (acc[ai][bj][m][1] + bv[bj][1]) * gt;
                    u32x4 w; w.x = cvt_pk_bf16(v0[0], v0[1]); w.y = cvt_pk_bf16(v0[2], v0[3]); w.z = cvt_pk_bf16(v1[0], v1[1]); w.w = cvt_pk_bf16(v1[2], v1[3]);
                    *(u32x4*)(rowp + bj * HALF) = w; } }
    }
};
struct MoeOrder {
    const bf16_t* A; const bf16_t* Bt; const int* tokslot; const LAS int* tab; int nblk, nN, G, c; bool gather;
    __device__ __forceinline__ bool next(int i, Unit& u) const { if (!tile_order(i, G, c, nblk, nN, u.pm, u.pn)) return false; u.e = tab[T_BLKE + u.pm]; u.lb = u.pm - tab[T_BLKSTART + u.e]; return true; }
    __device__ __forceinline__ const char* a_base(const Unit& u) const { return gather ? (const char*)A : (const char*)A + (size_t)u.pm * BM * 1024 * 2; }
    __device__ __forceinline__ const char* b_base(const Unit& u) const { return (const char*)Bt + ((size_t)u.e * nN + u.pn) * BM * 1024 * 2; }
    __device__ __forceinline__ void a_off(const Unit& u, const int (&R)[2], const int (&C)[2], unsigned (&off)[2][2]) const {
        const int cnt = tab[T_CNT + u.e];
#pragma unroll
        for (int h = 0; h < 2; ++h)
#pragma unroll
            for (int i = 0; i < 2; ++i) {
                if (gather) { const int slot = u.lb * 256 + R[i] + HALF * h; const int tok = slot < cnt ? tokslot[(size_t)u.e * NTOK + slot] : NTOK; off[h][i] = (unsigned)tok * 2048u + (unsigned)C[i] * 2u; }
                else off[h][i] = (unsigned)((R[i] + HALF * h) * 1024 + C[i]) * 2u;
            }
    }
};
__device__ __forceinline__ int moe_tables(LAS int* tab, const unsigned* cntw) {
    if (threadIdx.x == 0) { int s = 0; for (int e = 0; e < NE; ++e) { const int c = (int)cntw[e]; tab[T_CNT + e] = c; tab[T_BLKSTART + e] = s; const int nb = (c + 255) >> 8; for (int j = 0; j < nb; ++j) tab[T_BLKE + s + j] = e; s += nb; } tab[T_BLKSTART + NE] = s; }
    __syncthreads();
    return tab[T_BLKSTART + NE];
}
}
constexpr int NWAVES = 8, NTHREADS = 512;
constexpr int RING_BYTES = 131072, MISC_OFF = RING_BYTES, LDS_BYTES = 147456;

__device__ __forceinline__ void tr_item(const float* W, int ldw, int srccol0, int k0, bf16_t* WT, int Kd, int dstrow0, LAS float* scr, int lane) {
#pragma unroll 8
    for (int i = 0; i < 32; ++i) { const int kk = 2 * i + (lane >> 5); scr[kk * 33 + (lane & 31)] = W[(size_t)(k0 + kk) * ldw + srccol0 + (lane & 31)]; }
    asm volatile("s_waitcnt lgkmcnt(0)" ::: "memory");
    const int c = lane & 7;
#pragma unroll
    for (int j = 0; j < 4; ++j) { const int n = (lane >> 3) + 8 * j; const LAS float* s = scr + (8 * c) * 33 + n;
        u32x4 o; o.x = pk2(s[0 * 33], s[1 * 33]); o.y = pk2(s[2 * 33], s[3 * 33]); o.z = pk2(s[4 * 33], s[5 * 33]); o.w = pk2(s[6 * 33], s[7 * 33]);
        *(u32x4*)(WT + (size_t)(dstrow0 + n) * Kd + k0 + 8 * c) = o; }
    asm volatile("s_waitcnt lgkmcnt(0)" ::: "memory");
}
constexpr int I_IN = 16 * 120, I_OUT = 16 * 32, I_PG = 16 * 32, I_PP = 4 * 32, I_GU1 = 16 * 64, I_DN1 = 16 * 32;
constexpr int I_SMALL = I_IN + I_OUT + I_PG + I_PP, I_GU = NE * I_GU1, I_DN = NE * I_DN1, I_ALL = I_SMALL + I_GU + I_DN;
__device__ __forceinline__ void prep_item(const Params& P, int it, LAS float* scr, int lane) {
    unsigned char* ws = P.ws;
    if (it < I_IN) { const int kb = it / 120, nb = it % 120, n0 = nb * 32, pn = n0 >> 8, j0 = n0 & 255;
        const int src = pn < 4 ? (pn * 256 + 64 * ((j0 & 127) >> 5) + 32 * (j0 >> 7)) : (n0 < 2048 ? n0 : n0 + 8);
        tr_item(P.w_in, INW, src, kb * 64, (bf16_t*)(ws + WS_WIN), 1024, n0, scr, lane); return; }
    it -= I_IN;
    if (it < I_OUT) { tr_item(P.w_out, 1024, (it % 32) * 32, (it / 32) * 64, (bf16_t*)(ws + WS_WOUT), 1024, (it % 32) * 32, scr, lane); return; }
    it -= I_OUT;
    if (it < I_PG) { tr_item(P.w_pg, 1024, (it % 32) * 32, (it / 32) * 64, (bf16_t*)(ws + WS_WPG), 1024, (it % 32) * 32, scr, lane); return; }
    it -= I_PG;
    if (it < I_PP) { tr_item(P.w_pp, 1024, (it % 32) * 32, (it / 32) * 64, (bf16_t*)(ws + WS_WPP), 256, (it % 32) * 32, scr, lane); return; }
    it -= I_PP;
    if (it < I_GU) { const int e = it / I_GU1, r = it % I_GU1, kb = r / 64, nb = r % 64, n0 = nb * 32, pn = n0 >> 8, j0 = n0 & 255;
        const int src = (j0 >> 7) * 1024 + pn * 128 + (j0 & 127);
        tr_item(P.w_gu + (size_t)e * 1024 * 2048, 2048, src, kb * 64, (bf16_t*)(ws + WS_WGU) + (size_t)e * 2048 * 1024, 1024, n0, scr, lane); return; }
    it -= I_GU;
    { const int e = it / I_DN1, r = it % I_DN1, kb = r / 32, nb = r % 32;
        tr_item(P.w_down + (size_t)e * 1024 * 1024, 1024, nb * 32, kb * 64, (bf16_t*)(ws + WS_WDN) + (size_t)e * 1024 * 1024, 1024, nb * 32, scr, lane); }
}
__device__ __forceinline__ void phase_prep_weights(const Params& P, LAS unsigned char* lds, int gw, int ngw, int wave, int lane) {
    LAS float* scr = (LAS float*)(lds + wave * 16384);
    for (int it = gw; it < I_ALL; it += ngw) prep_item(P, it, scr, lane);
}
__device__ __forceinline__ void phase_cvt_p(const Params& P, int gt, int ngt) {
    bf16_t* PB = (bf16_t*)((unsigned char*)P.out + DO_PB);
    for (int i = gt; i < NTOK * PLE / 8; i += ngt) { const f32x4 a = ((const f32x4*)P.p)[2 * i], b = ((const f32x4*)P.p)[2 * i + 1];
        u32x4 w; w.x = pk2(a[0], a[1]); w.y = pk2(a[2], a[3]); w.z = pk2(b[0], b[1]); w.w = pk2(b[2], b[3]); ((u32x4*)PB)[i] = w; }
}
__device__ __forceinline__ void rms_row(const float* xrow, const float* gain, int lane, f32x4 (&v)[4]) {
    const f32x4* xr = (const f32x4*)xrow + lane; float s = 0.f;
#pragma unroll
    for (int j = 0; j < 4; ++j) { v[j] = xr[64 * j]; s += (v[j][0] * v[j][0] + v[j][1] * v[j][1]) + (v[j][2] * v[j][2] + v[j][3] * v[j][3]); }
    const float rstd = rsqrtf(wave_sum(s) * (1.f / DM) + 1e-6f);
#pragma unroll
    for (int j = 0; j < 4; ++j) v[j] = v[j] * rstd * ((const f32x4*)gain)[64 * j + lane];
}
__device__ __forceinline__ void store_row_bf16(bf16_t* orow, int lane, const f32x4 (&v)[4]) {
    u32x2* o8 = (u32x2*)orow + lane;
#pragma unroll
    for (int j = 0; j < 4; ++j) { u32x2 w; w.x = pk2(v[j][0], v[j][1]); w.y = pk2(v[j][2], v[j][3]); o8[64 * j] = w; }
}
__device__ __forceinline__ void norm1_row(const Params& P, int row, int lane, const LAS float* wff) {
    f32x4 v[4]; rms_row(P.x + (size_t)row * DM, P.mix_norm, lane, v);
    store_row_bf16((bf16_t*)(P.ws + WS_XN) + (size_t)row * DM, lane, v);
    float ff[8];
#pragma unroll
    for (int q = 0; q < 8; ++q) ff[q] = 0.f;
#pragma unroll
    for (int j = 0; j < 4; ++j)
#pragma unroll
        for (int i = 0; i < 4; ++i) { const LAS f32x4* w = (const LAS f32x4*)(wff + (size_t)(4 * (64 * j + lane) + i) * 8); const f32x4 w0 = w[0], w1 = w[1]; const float h = v[j][i];
            ff[0] += h * w0[0]; ff[1] += h * w0[1]; ff[2] += h * w0[2]; ff[3] += h * w0[3]; ff[4] += h * w1[0]; ff[5] += h * w1[1]; ff[6] += h * w1[2]; ff[7] += h * w1[3]; }
#pragma unroll
    for (int q = 0; q < 8; ++q) ff[q] = wave_sum(ff[q]);
    if (lane < 8) { float f = ff[0];
#pragma unroll
        for (int q = 1; q < 8; ++q) f = (lane == q) ? ff[q] : f;
        ((float*)(P.ws + WS_LOGF))[(size_t)row * 8 + lane] = logsigmoidf_(f + P.f_bias[lane]); }
}
__device__ __forceinline__ void load_wff(const Params& P, LAS float* wff, int tid, int nthr) {
    for (int i = tid; i < 1024 * 8; i += nthr) wff[i] = P.w_in[(size_t)(i >> 3) * INW + 2048 + (i & 7)];
}
__device__ __forceinline__ void final_row(const Params& P, int row, int lane) {
    f32x4 v[4]; rms_row((const float*)(P.ws + WS_X1) + (size_t)row * DM, P.final_norm, lane, v);
    f32x4* o = (f32x4*)(P.out + (size_t)row * DM) + lane;
#pragma unroll
    for (int j = 0; j < 4; ++j) o[64 * j] = v[j];
}
__device__ __forceinline__ int crow(int r, int hi) { return (r & 3) + 8 * (r >> 2) + 4 * hi; }

__global__ void __launch_bounds__(64) k_cumsum(Params P) {
    const int bh = blockIdx.x, b = bh >> 3, h = bh & 7, lane = threadIdx.x;
    const float* lf = (const float*)(P.ws + WS_LOGF) + ((size_t)b * SEQ) * 8 + h; float* c2 = (float*)(P.ws + WS_C2) + (size_t)bh * SEQ;
    float s = 0.f;
    for (int i = 0; i < 128; ++i) s += lf[(size_t)(lane * 128 + i) * 8];
    float incl = s;
#pragma unroll
    for (int o = 1; o < 64; o <<= 1) { const float t = __shfl_up(incl, o); if (lane >= o) incl += t; }
    float run = incl - s;
    for (int i = 0; i < 128; ++i) { run += lf[(size_t)(lane * 128 + i) * 8]; c2[lane * 128 + i] = run * LOG2E; }
}

__global__ void __launch_bounds__(256) k_attn_v1(Params P) {
    __shared__ __attribute__((aligned(16))) bf16_t Ks[64][72];
    __shared__ __attribute__((aligned(16))) bf16_t Vt[64][72];
    __shared__ __attribute__((aligned(16))) float wsf[4][64];
    const bf16_t* Z = (const bf16_t*)(P.ws + WS_Z); bf16_t* AO = (bf16_t*)(P.ws + WS_AO);
    const int tid = threadIdx.x, lane = tid & 63, w = tid >> 6, r32 = lane & 31, hi = lane >> 5;
    const int unit = blockIdx.x, bh = unit & 31, qb = 63 - (unit >> 5), b = bh >> 3, h = bh & 7, q0 = qb * 128;
    const size_t rowbase = (size_t)b * SEQ;
    const float* c2 = (const float*)(P.ws + WS_C2) + (size_t)bh * SEQ;
    const int qloc = q0 + 32 * w + r32;
    const bf16_t* Qp = Z + (rowbase + qloc) * ZW + ZQ + h * 64;
    bf16x8 qr[4];
#pragma unroll
    for (int ks = 0; ks < 4; ++ks) qr[ks] = *(const bf16x8*)(Qp + ks * 16 + hi * 8);
    const float cq = c2[qloc];
    float m = -1e30f, l = 0.f; f32x16 o[2]; o[0] = f32x16{}; o[1] = f32x16{};
    const int ntiles = (q0 + 128) / 64;
    for (int t = 0; t < ntiles; ++t) {
        __syncthreads();
#pragma unroll
        for (int i = 0; i < 2; ++i) { const int row = (tid >> 3) + 32 * i, ch = tid & 7; const bf16_t* src = Z + (rowbase + t * 64 + row) * ZW + h * 64 + ch * 8;
            *(u32x4*)&Ks[row][ch * 8] = *(const u32x4*)(src + ZK);
            const u32x4 v = *(const u32x4*)(src + ZV); const unsigned vv[4] = {v.x, v.y, v.z, v.w};
#pragma unroll
            for (int e = 0; e < 4; ++e) { Vt[ch * 8 + 2 * e][row] = (bf16_t)(vv[e] & 0xffffu); Vt[ch * 8 + 2 * e + 1][row] = (bf16_t)(vv[e] >> 16); } }
        __syncthreads();
        f32x16 p[2];
#pragma unroll
        for (int g = 0; g < 2; ++g) { p[g] = f32x16{};
#pragma unroll
            for (int ks = 0; ks < 4; ++ks) { const bf16x8 kf = *(const bf16x8*)&Ks[32 * g + r32][ks * 16 + hi * 8]; p[g] = __builtin_amdgcn_mfma_f32_32x32x16_bf16(kf, qr[ks], p[g], 0, 0, 0); } }
        float mx = -1e30f;
#pragma unroll
        for (int g = 0; g < 2; ++g)
#pragma unroll
            for (int r4 = 0; r4 < 4; ++r4) { const int kv0 = t * 64 + 32 * g + 8 * r4 + 4 * hi; const f32x4 ck = *(const f32x4*)(c2 + kv0);
#pragma unroll
                for (int i = 0; i < 4; ++i) { float s = p[g][4 * r4 + i] + (cq - ck[i]); if (kv0 + i > qloc) s = -INFINITY; p[g][4 * r4 + i] = s; mx = fmaxf(mx, s); } }
        mx = fmaxf(mx, __shfl_xor(mx, 32));
        const float mnew = fmaxf(m, mx), alpha = exp2f(m - mnew); m = mnew;
        float ps = 0.f;
#pragma unroll
        for (int g = 0; g < 2; ++g)
#pragma unroll
            for (int r = 0; r < 16; ++r) { const float e = exp2f(p[g][r] - mnew); p[g][r] = e; ps += e; }
        l = l * alpha + ps;
        if (hi == 0) wsf[w][r32] = alpha;
        __builtin_amdgcn_wave_barrier(); asm volatile("s_waitcnt lgkmcnt(0)" ::: "memory");
#pragma unroll
        for (int r4 = 0; r4 < 4; ++r4) { const f32x4 al = *(const f32x4*)&wsf[w][8 * r4 + 4 * hi];
#pragma unroll
            for (int i = 0; i < 4; ++i) { o[0][4 * r4 + i] *= al[i]; o[1][4 * r4 + i] *= al[i]; } }
#pragma unroll
        for (int g = 0; g < 2; ++g)
#pragma unroll
            for (int s = 0; s < 2; ++s) { u32x4 pw; pw.x = pk2(p[g][8 * s + 0], p[g][8 * s + 1]); pw.y = pk2(p[g][8 * s + 2], p[g][8 * s + 3]); pw.z = pk2(p[g][8 * s + 4], p[g][8 * s + 5]); pw.w = pk2(p[g][8 * s + 6], p[g][8 * s + 7]);
                const bf16x8 pa = __builtin_bit_cast(bf16x8, pw);
#pragma unroll
                for (int d0 = 0; d0 < 2; ++d0) { const u32x2 lo = *(const u32x2*)&Vt[32 * d0 + r32][32 * g + 16 * s + 4 * hi], hh = *(const u32x2*)&Vt[32 * d0 + r32][32 * g + 16 * s + 8 + 4 * hi];
                    u32x4 vw; vw.x = lo.x; vw.y = lo.y; vw.z = hh.x; vw.w = hh.y;
                    o[d0] = __builtin_amdgcn_mfma_f32_32x32x16_bf16(pa, __builtin_bit_cast(bf16x8, vw), o[d0], 0, 0, 0); } }
        __builtin_amdgcn_wave_barrier();
    }
    l += __shfl_xor(l, 32);
    __builtin_amdgcn_wave_barrier();
    if (hi == 0) wsf[w][32 + r32] = l;
    __builtin_amdgcn_wave_barrier(); asm volatile("s_waitcnt lgkmcnt(0)" ::: "memory");
#pragma unroll
    for (int r = 0; r < 16; ++r) { const int q = crow(r, hi); const float li = 1.0f / wsf[w][32 + q]; const size_t row = rowbase + q0 + 32 * w + q;
#pragma unroll
        for (int d0 = 0; d0 < 2; ++d0) { const int d = 32 * d0 + r32; const float og = bf2f(Z[row * ZW + ZOG + h * 64 + d]);
            AO[row * DM + h * 64 + d] = (bf16_t)f2bf(o[d0][r] * li * sigmoidf_(og)); } }
}

__device__ __forceinline__ float zlerp(const bf16_t* Z, size_t row, bool first, int col, const float* mu) {
    const float z1 = bf2f(Z[row * ZW + ZR + col]); const float z0 = first ? 0.f : bf2f(Z[(row - 1) * ZW + ZR + col]);
    return z1 + (z0 - z1) * mu[col];
}
__global__ void __launch_bounds__(256) k_rwkv_prep(Params P) {
    __shared__ float xs[8][256];
    const bf16_t* Z = (const bf16_t*)(P.ws + WS_Z);
    const int tid = threadIdx.x; const size_t row0 = (size_t)blockIdx.x * 8;
    for (int tok = 0; tok < 8; ++tok) { const size_t row = row0 + tok; const bool first = (row % SEQ) == 0;
        const float z = zlerp(Z, row, first, RW_W + tid, P.mu);
        xs[tok][tid] = tid < 64 ? tanhf(z) : (tid < 128 ? z : sigmoidf_(z)); }
    __syncthreads();
    float lw[8][2], la[8][2], lg[8][2];
#pragma unroll
    for (int t = 0; t < 8; ++t)
#pragma unroll
        for (int c = 0; c < 2; ++c) { lw[t][c] = 0.f; la[t][c] = 0.f; lg[t][c] = 0.f; }
    for (int j = 0; j < 64; ++j) { const float w0 = P.w2[j * 512 + tid], w1 = P.w2[j * 512 + tid + 256], a0 = P.a2[j * 512 + tid], a1 = P.a2[j * 512 + tid + 256];
#pragma unroll
        for (int t = 0; t < 8; ++t) { const float xw = xs[t][j], xa = xs[t][64 + j]; lw[t][0] += xw * w0; lw[t][1] += xw * w1; la[t][0] += xa * a0; la[t][1] += xa * a1; } }
    for (int j = 0; j < 128; ++j) { const float g0 = P.g2[j * 512 + tid], g1 = P.g2[j * 512 + tid + 256];
#pragma unroll
        for (int t = 0; t < 8; ++t) { const float xg = xs[t][128 + j]; lg[t][0] += xg * g0; lg[t][1] += xg * g1; } }
    bf16_t* RR = (bf16_t*)(P.ws + WS_RR); bf16_t* RK = (bf16_t*)(P.ws + WS_RK); bf16_t* RV = (bf16_t*)(P.ws + WS_RV); bf16_t* RG = (bf16_t*)(P.ws + WS_RG);
    float* RLW = (float*)(P.ws + WS_RLW); bf16_t* RKK = (bf16_t*)(P.ws + WS_RKK); bf16_t* RKA = (bf16_t*)(P.ws + WS_RKA);
#pragma unroll
    for (int t = 0; t < 8; ++t) { const size_t row = row0 + t; const bool first = (row % SEQ) == 0;
#pragma unroll
        for (int c = 0; c < 2; ++c) { const int cc = tid + 256 * c;
            const float zr = zlerp(Z, row, first, RW_R + cc, P.mu), zk = zlerp(Z, row, first, RW_K + cc, P.mu), zv = zlerp(Z, row, first, RW_V + cc, P.mu);
            const float wl = P.w0[cc] + lw[t][c]; const float sp = fmaxf(-wl, 0.f) + log1pf(expf(-fabsf(wl)));
            const float logdecay = -expf(-sp - 0.5f);
            const float a = sigmoidf_(P.a0[cc] + la[t][c]);
            const float kkr = zk * P.k_k[cc]; const float ss = wave_sum(kkr * kkr); const float kk = kkr / fmaxf(sqrtf(ss), 1e-12f);
            const float kp = zk * (1.0f + (a - 1.0f) * P.k_a[cc]);
            const size_t o = row * 512 + cc;
            RR[o] = (bf16_t)f2bf(zr); RK[o] = (bf16_t)f2bf(kp); RV[o] = (bf16_t)f2bf(zv); RG[o] = (bf16_t)f2bf(lg[t][c]); RLW[o] = logdecay; RKK[o] = (bf16_t)f2bf(kk); RKA[o] = (bf16_t)f2bf(kk * a); } }
}
__global__ void __launch_bounds__(256) k_rwkv_scan(Params P) {
    const bf16_t* RR = (const bf16_t*)(P.ws + WS_RR); const bf16_t* RK = (const bf16_t*)(P.ws + WS_RK); const bf16_t* RV = (const bf16_t*)(P.ws + WS_RV);
    const float* RLW = (const float*)(P.ws + WS_RLW); const bf16_t* RKK = (const bf16_t*)(P.ws + WS_RKK); const bf16_t* RKA = (const bf16_t*)(P.ws + WS_RKA);
    float* Y = (float*)(P.ws + WS_X1);
    const int tid = threadIdx.x, bh = blockIdx.x >> 2, rg = blockIdx.x & 3, b = bh >> 3, h = bh & 7, vrow = rg * 16 + (tid >> 4), cg = tid & 15;
    float S[4] = {0.f, 0.f, 0.f, 0.f};
    size_t o = ((size_t)b * SEQ) * 512 + h * 64;
    u32x2 r4 = *(const u32x2*)(RR + o + 4 * cg), k4 = *(const u32x2*)(RK + o + 4 * cg), kk4 = *(const u32x2*)(RKK + o + 4 * cg), ka4 = *(const u32x2*)(RKA + o + 4 * cg); f32x4 lw4 = *(const f32x4*)(RLW + o + 4 * cg); float v = bf2f(RV[o + vrow]);
    for (int t = 0; t < SEQ; ++t) {
        const size_t on = o + 512; const bool more = t + 1 < SEQ;
        u32x2 nr4 = r4, nk4 = k4, nkk4 = kk4, nka4 = ka4; f32x4 nlw4 = lw4; float nv = v;
        if (more) { nr4 = *(const u32x2*)(RR + on + 4 * cg); nk4 = *(const u32x2*)(RK + on + 4 * cg); nkk4 = *(const u32x2*)(RKK + on + 4 * cg); nka4 = *(const u32x2*)(RKA + on + 4 * cg); nlw4 = *(const f32x4*)(RLW + on + 4 * cg); nv = bf2f(RV[on + vrow]); }
        const float r[4] = {bflo(r4.x), bfhi(r4.x), bflo(r4.y), bfhi(r4.y)}, k[4] = {bflo(k4.x), bfhi(k4.x), bflo(k4.y), bfhi(k4.y)};
        const float kk[4] = {bflo(kk4.x), bfhi(kk4.x), bflo(kk4.y), bfhi(kk4.y)}, ka[4] = {bflo(ka4.x), bfhi(ka4.x), bflo(ka4.y), bfhi(ka4.y)};
        float sa = -(S[0] * kk[0] + S[1] * kk[1] + S[2] * kk[2] + S[3] * kk[3]);
        sa += __shfl_xor(sa, 1); sa += __shfl_xor(sa, 2); sa += __shfl_xor(sa, 4); sa += __shfl_xor(sa, 8);
        float y = 0.f;
#pragma unroll
        for (int c = 0; c < 4; ++c) { S[c] = S[c] * __expf(lw4[c]) + sa * ka[c] + v * k[c]; y += S[c] * r[c]; }
        y += __shfl_xor(y, 1); y += __shfl_xor(y, 2); y += __shfl_xor(y, 4); y += __shfl_xor(y, 8);
        if (cg == 0) Y[o + vrow] = y;
        o = on; r4 = nr4; k4 = nk4; kk4 = nkk4; ka4 = nka4; lw4 = nlw4; v = nv;
    }
}
__global__ void __launch_bounds__(256) k_rwkv_post(Params P) {
    const bf16_t* RR = (const bf16_t*)(P.ws + WS_RR); const bf16_t* RK = (const bf16_t*)(P.ws + WS_RK); const bf16_t* RV = (const bf16_t*)(P.ws + WS_RV); const bf16_t* RG = (const bf16_t*)(P.ws + WS_RG);
    const float* Y = (const float*)(P.ws + WS_X1); bf16_t* AO = (bf16_t*)(P.ws + WS_AO);
    const int lane = threadIdx.x & 63; const size_t gw = (size_t)blockIdx.x * 4 + (threadIdx.x >> 6);
    const size_t tok = gw >> 3; const int h = (int)(gw & 7), cc = h * 64 + lane; const size_t o = tok * 512 + cc;
    const float y = Y[o], mean = wave_sum(y) * (1.f / 64.f), d = y - mean, var = wave_sum(d * d) * (1.f / 64.f);
    const float yn = d * rsqrtf(var + 64e-5f) * P.ln_w[cc] + P.ln_b[cc];
    const float r = bf2f(RR[o]), k = bf2f(RK[o]), v = bf2f(RV[o]), g = bf2f(RG[o]);
    const float bonus = wave_sum(r * k * P.r_k[cc]) * v;
    AO[tok * DM + 512 + cc] = (bf16_t)f2bf((yn + bonus) * g);
}

__global__ void __launch_bounds__(256) k_norm2_route(Params P) {
    extern __shared__ __attribute__((aligned(16))) unsigned char smem[];
    LAS float* wr = (LAS float*)(LAS unsigned char*)smem;
    const int tid = threadIdx.x, lane = tid & 63, w = tid >> 6;
    LAS float* xr = (LAS float*)((LAS unsigned char*)smem + 131072 + w * 4096);
    for (int i = tid; i < 1024 * 32; i += 256) wr[i] = P.w_router[i];
    if (blockIdx.x == 0) { bf16_t* zr = (bf16_t*)(P.ws + WS_XN) + (size_t)NTOK * DM; for (int i = tid; i < DM; i += 256) zr[i] = 0; }
    __syncthreads();
    unsigned* cnt = (unsigned*)(P.ws + WS_CTL) + CW_CNT; int* route = (int*)(P.ws + WS_ROUTE); int* tokslot = (int*)(P.ws + WS_TOKSLOT); float* gateslot = (float*)(P.ws + WS_GATESLOT);
    const int e = lane & 31, kh = lane >> 5;
    for (int row = blockIdx.x * 4 + w; row < NTOK; row += gridDim.x * 4) {
        f32x4 v[4]; rms_row((const float*)(P.ws + WS_X1) + (size_t)row * DM, P.moe_norm, lane, v);
        store_row_bf16((bf16_t*)(P.ws + WS_XN) + (size_t)row * DM, lane, v);
#pragma unroll
        for (int j = 0; j < 4; ++j) *(LAS f32x4*)(xr + 4 * (64 * j + lane)) = v[j];
        __builtin_amdgcn_wave_barrier(); asm volatile("s_waitcnt lgkmcnt(0)" ::: "memory");
        float acc = 0.f;
        for (int k4 = 0; k4 < 128; ++k4) { const int k = kh * 512 + 4 * k4; const f32x4 xv = *(const LAS f32x4*)(xr + k);
            acc += xv[0] * wr[(k + 0) * 32 + e]; acc += xv[1] * wr[(k + 1) * 32 + e]; acc += xv[2] * wr[(k + 2) * 32 + e]; acc += xv[3] * wr[(k + 3) * 32 + e]; }
        acc += __shfl_xor(acc, 32);
        float logit = acc + P.b_router[e];
        float tv[4]; int ti[4];
#pragma unroll
        for (int k = 0; k < 4; ++k) { float bv = logit; int bi = e;
#pragma unroll
            for (int o = 1; o < 32; o <<= 1) { const float ov = __shfl_xor(bv, o); const int oi = __shfl_xor(bi, o); if (ov > bv || (ov == bv && oi < bi)) { bv = ov; bi = oi; } }
            tv[k] = bv; ti[k] = bi; if (e == bi) logit = -INFINITY; }
        const float e0 = 1.f, e1 = expf(tv[1] - tv[0]), e2 = expf(tv[2] - tv[0]), e3 = expf(tv[3] - tv[0]), inv = 1.f / (e0 + e1 + e2 + e3);
        const float gt[4] = {e0 * inv, e1 * inv, e2 * inv, e3 * inv};
        if (lane < 4) { float g = gt[0]; int ex = ti[0];
#pragma unroll
            for (int k = 1; k < 4; ++k) { g = (lane == k) ? gt[k] : g; ex = (lane == k) ? ti[k] : ex; }
            const int rank = (int)atomicAdd(cnt + ex, 1u);
            tokslot[(size_t)ex * NTOK + rank] = row; gateslot[(size_t)ex * NTOK + rank] = g;
            route[(size_t)row * 12 + lane] = ex; route[(size_t)row * 12 + 4 + lane] = rank; }
        __builtin_amdgcn_wave_barrier();
    }
}
__global__ void __launch_bounds__(256) k_combine_norm3(Params P) {
    __shared__ int bs[33];
    const unsigned* cnt = (const unsigned*)(P.ws + WS_CTL) + CW_CNT;
    if (threadIdx.x == 0) { int s = 0; for (int e = 0; e < NE; ++e) { bs[e] = s; s += ((int)cnt[e] + 255) >> 8; } bs[NE] = s; }
    __syncthreads();
    const int lane = threadIdx.x & 63, w = threadIdx.x >> 6; const int* route = (const int*)(P.ws + WS_ROUTE); const bf16_t* YP = (const bf16_t*)(P.ws + WS_YP);
    float* X = (float*)(P.ws + WS_X1);
    for (int row = blockIdx.x * 4 + w; row < NTOK; row += gridDim.x * 4) {
        f32x4 v[4]; const f32x4* xr = (const f32x4*)(X + (size_t)row * DM) + lane;
#pragma unroll
        for (int j = 0; j < 4; ++j) v[j] = xr[64 * j];
#pragma unroll
        for (int k = 0; k < 4; ++k) { const int ex = route[(size_t)row * 12 + k], rank = route[(size_t)row * 12 + 4 + k]; const size_t pos = (size_t)bs[ex] * 256 + rank;
            const u32x2* yr = (const u32x2*)(YP + pos * DM) + lane;
#pragma unroll
            for (int j = 0; j < 4; ++j) { const u32x2 y = yr[64 * j]; v[j][0] += bflo(y.x); v[j][1] += bfhi(y.x); v[j][2] += bflo(y.y); v[j][3] += bfhi(y.y); } }
        f32x4* xo = (f32x4*)(X + (size_t)row * DM) + lane; float s = 0.f;
#pragma unroll
        for (int j = 0; j < 4; ++j) { xo[64 * j] = v[j]; s += (v[j][0] * v[j][0] + v[j][1] * v[j][1]) + (v[j][2] * v[j][2] + v[j][3] * v[j][3]); }
        const float rstd = rsqrtf(wave_sum(s) * (1.f / DM) + 1e-6f);
#pragma unroll
        for (int j = 0; j < 4; ++j) v[j] = v[j] * rstd * ((const f32x4*)P.ple_norm)[64 * j + lane];
        store_row_bf16((bf16_t*)(P.ws + WS_XN) + (size_t)row * DM, lane, v);
    }
}
__global__ void __launch_bounds__(NTHREADS, 2) k_prep(Params P) {
    extern __shared__ __attribute__((aligned(16))) unsigned char smem[];
    const int tid = threadIdx.x, lane = tid & 63, wave = tid >> 6;
    phase_prep_weights(P, (LAS unsigned char*)smem, blockIdx.x * NWAVES + wave, gridDim.x * NWAVES, wave, lane);
    phase_cvt_p(P, blockIdx.x * NTHREADS + tid, gridDim.x * NTHREADS);
}
__global__ void __launch_bounds__(NTHREADS, 2) k_norm1(Params P) {
    extern __shared__ __attribute__((aligned(16))) unsigned char smem[];
    LAS float* wff = (LAS float*)(LAS unsigned char*)smem;
    const int tid = threadIdx.x, lane = tid & 63, wave = tid >> 6;
    load_wff(P, wff, tid, NTHREADS); __syncthreads();
    for (int row = blockIdx.x * NWAVES + wave; row < NTOK; row += gridDim.x * NWAVES) norm1_row(P, row, lane, wff);
}
__global__ void __launch_bounds__(NTHREADS, 2) k_final(Params P) {
    const int tid = threadIdx.x, lane = tid & 63, wave = tid >> 6;
    for (int row = blockIdx.x * NWAVES + wave; row < NTOK; row += gridDim.x * NWAVES) final_row(P, row, lane);
}
__global__ void __launch_bounds__(NTHREADS, 2) k_gemm_in(Params P) {
    extern __shared__ __attribute__((aligned(16))) unsigned char smem[];
    pg8::DenseOrder S{(const bf16_t*)(P.ws + WS_XN), (const bf16_t*)(P.ws + WS_WIN), 1024, NTOK / 256, ZW / 256, (int)gridDim.x, (int)blockIdx.x};
    pg8::EpiIn E{(bf16_t*)(P.ws + WS_Z), P.q_norm, P.k_norm};
    pg8::gemm_phase<pg8::EpiIn, pg8::DenseOrder, true>((LAS unsigned char*)smem, 1024, S, E);
}
__global__ void __launch_bounds__(NTHREADS, 2) k_gemm_pj(Params P) {
    extern __shared__ __attribute__((aligned(16))) unsigned char smem[];
    pg8::DenseOrder S{(const bf16_t*)((unsigned char*)P.out + DO_PB), (const bf16_t*)(P.ws + WS_WPP), PLE, NTOK / 256, DM / 256, (int)gridDim.x, (int)blockIdx.x};
    pg8::EpiBf16 E{(bf16_t*)((unsigned char*)P.out + DO_PJ), DM};
    pg8::gemm_phase<pg8::EpiBf16, pg8::DenseOrder, true>((LAS unsigned char*)smem, PLE, S, E);
}
__global__ void __launch_bounds__(NTHREADS, 2) k_gemm_out(Params P) {
    extern __shared__ __attribute__((aligned(16))) unsigned char smem[];
    pg8::DenseOrder S{(const bf16_t*)(P.ws + WS_AO), (const bf16_t*)(P.ws + WS_WOUT), 1024, NTOK / 256, DM / 256, (int)gridDim.x, (int)blockIdx.x};
    pg8::EpiOut E{P.x, (float*)(P.ws + WS_X1)};
    pg8::gemm_phase<pg8::EpiOut, pg8::DenseOrder, true>((LAS unsigned char*)smem, 1024, S, E);
}
__global__ void __launch_bounds__(NTHREADS, 2) k_gemm_gu(Params P) {
    extern __shared__ __attribute__((aligned(16))) unsigned char smem[];
    LAS int* tab = (LAS int*)((LAS unsigned char*)smem + MISC_OFF);
    const int nblk = pg8::moe_tables(tab, (const unsigned*)(P.ws + WS_CTL) + CW_CNT);
    pg8::MoeOrder S{(const bf16_t*)(P.ws + WS_XN), (const bf16_t*)(P.ws + WS_WGU), (const int*)(P.ws + WS_TOKSLOT), tab, nblk, 8, (int)gridDim.x, (int)blockIdx.x, true};
    pg8::EpiGu E{(bf16_t*)(P.ws + WS_ACT), P.b_gu};
    pg8::gemm_phase<pg8::EpiGu, pg8::MoeOrder, true>((LAS unsigned char*)smem, 1024, S, E);
}
__global__ void __launch_bounds__(NTHREADS, 2) k_gemm_dn(Params P) {
    extern __shared__ __attribute__((aligned(16))) unsigned char smem[];
    LAS int* tab = (LAS int*)((LAS unsigned char*)smem + MISC_OFF);
    const int nblk = pg8::moe_tables(tab, (const unsigned*)(P.ws + WS_CTL) + CW_CNT);
    pg8::MoeOrder S{(const bf16_t*)(P.ws + WS_ACT), (const bf16_t*)(P.ws + WS_WDN), (const int*)(P.ws + WS_TOKSLOT), tab, nblk, 4, (int)gridDim.x, (int)blockIdx.x, false};
    pg8::EpiDn E{(bf16_t*)(P.ws + WS_YP), P.b_down, (const float*)(P.ws + WS_GATESLOT), tab};
    pg8::gemm_phase<pg8::EpiDn, pg8::MoeOrder, true>((LAS unsigned char*)smem, 1024, S, E);
}
__global__ void __launch_bounds__(NTHREADS, 2) k_gemm_pg(Params P) {
    extern __shared__ __attribute__((aligned(16))) unsigned char smem[];
    pg8::DenseOrder S{(const bf16_t*)(P.ws + WS_XN), (const bf16_t*)(P.ws + WS_WPG), 1024, NTOK / 256, DM / 256, (int)gridDim.x, (int)blockIdx.x};
    pg8::EpiPg E{(float*)(P.ws + WS_X1), (const bf16_t*)((unsigned char*)P.out + DO_PJ)};
    pg8::gemm_phase<pg8::EpiPg, pg8::DenseOrder, true>((LAS unsigned char*)smem, 1024, S, E);
}

extern "C" void kernel_launch(void* const* d_in, const int* in_sizes, int n_in, void* d_out, int out_size, void* d_ws, size_t ws_size, hipStream_t stream) {
    static int ok = 0;
    if (ok == 0) {
        if (n_in != 30 || in_sizes[0] != NTOK * DM || out_size != NTOK * DM || ws_size < WS_END) { fprintf(stderr, "kernel_launch: unexpected shapes (n_in %d, ws %zu)\n", n_in, ws_size); ok = -1; return; }
        const void* big[] = {(const void*)k_prep, (const void*)k_norm1, (const void*)k_gemm_in, (const void*)k_gemm_pj, (const void*)k_gemm_out, (const void*)k_gemm_gu, (const void*)k_gemm_dn, (const void*)k_gemm_pg, (const void*)k_norm2_route};
        for (const void* f : big) if (hipFuncSetAttribute(f, hipFuncAttributeMaxDynamicSharedMemorySize, LDS_BYTES) != hipSuccess) { fprintf(stderr, "kernel_launch: hipFuncSetAttribute failed\n"); ok = -1; return; }
        ok = 1;
    }
    if (ok < 0) return;
    Params P{};
    const float** pp = (const float**)&P;
    for (int i = 0; i < 30; ++i) pp[i] = (const float*)d_in[i];
    P.out = (float*)d_out; P.ws = (unsigned char*)d_ws;
    hipMemsetAsync((char*)d_ws + WS_CTL, 0, CTL_BYTES, stream);
    const int G = 256;
    hipLaunchKernelGGL(k_prep, dim3(G), dim3(NTHREADS), LDS_BYTES, stream, P);
    hipLaunchKernelGGL(k_norm1, dim3(G), dim3(NTHREADS), LDS_BYTES, stream, P);
    hipLaunchKernelGGL(k_cumsum, dim3(32), dim3(64), 0, stream, P);
    hipLaunchKernelGGL(k_gemm_in, dim3(G), dim3(NTHREADS), LDS_BYTES, stream, P);
    hipLaunchKernelGGL(k_gemm_pj, dim3(G), dim3(NTHREADS), LDS_BYTES, stream, P);
    hipLaunchKernelGGL(k_attn_v1, dim3(2048), dim3(256), 0, stream, P);
    hipLaunchKernelGGL(k_rwkv_prep, dim3(NTOK / 8), dim3(256), 0, stream, P);
    hipLaunchKernelGGL(k_rwkv_scan, dim3(128), dim3(256), 0, stream, P);
    hipLaunchKernelGGL(k_rwkv_post, dim3(NTOK * 8 / 4), dim3(256), 0, stream, P);
    hipLaunchKernelGGL(k_gemm_out, dim3(G), dim3(NTHREADS), LDS_BYTES, stream, P);
    hipLaunchKernelGGL(k_norm2_route, dim3(G), dim3(256), LDS_BYTES, stream, P);
    hipLaunchKernelGGL(k_gemm_gu, dim3(G), dim3(NTHREADS), LDS_BYTES, stream, P);
    hipLaunchKernelGGL(k_gemm_dn, dim3(G), dim3(NTHREADS), LDS_BYTES, stream, P);
    hipLaunchKernelGGL(k_combine_norm3, dim3(1024), dim3(256), 0, stream, P);
    hipLaunchKernelGGL(k_gemm_pg, dim3(G), dim3(NTHREADS), LDS_BYTES, stream, P);
    hipLaunchKernelGGL(k_final, dim3(G), dim3(NTHREADS), 0, stream, P);
}
```

```cpp
#include <hip/hip_runtime.h>
#include <cstdio>
#include <cstdint>

#define LAS __attribute__((address_space(3)))
#define GAS __attribute__((address_space(1)))
typedef unsigned short bf16_t;
typedef short bf16x8 __attribute__((ext_vector_type(8)));
typedef float f32x2 __attribute__((ext_vector_type(2)));
typedef float f32x4 __attribute__((ext_vector_type(4)));
typedef float f32x16 __attribute__((ext_vector_type(16)));
typedef unsigned u32x2 __attribute__((ext_vector_type(2)));
typedef unsigned u32x4 __attribute__((ext_vector_type(4)));

constexpr int NB = 4, SEQ = 8192, NTOK = NB * SEQ, DM = 1024;
constexpr int NH = 8, HD = 64;
constexpr int INW = 3848;
constexpr int ZW = 3840;
constexpr int ZQ = 0, ZK = 512, ZV = 1024, ZOG = 1536, ZR = 2048;
constexpr int RW_R = 0, RW_K = 512, RW_V = 1024, RW_W = 1536, RW_A = 1600, RW_G = 1664, RWIN = 1792;
constexpr int NE = 32, TOPK = 4, EFF = 1024;
constexpr int MAXBLK = (NTOK * TOPK) / 256 + NE;
constexpr int PLE = 256;
constexpr float LOG2E = 1.4426950408889634f;
constexpr float QSCALE = 0.125f * LOG2E;

constexpr size_t MiB = 1u << 20;
constexpr size_t WS_CTL = 0, CTL_BYTES = 1 * MiB;
constexpr size_t WS_C2 = 1 * MiB;
constexpr size_t WS_LOGF = 2 * MiB;
constexpr size_t WS_ROUTE = 3 * MiB;
constexpr size_t WS_TOKSLOT = 5 * MiB;
constexpr size_t WS_GATESLOT = 9 * MiB;
constexpr size_t WS_CTOT = 13 * MiB;
constexpr size_t WS_WIN = 16 * MiB;
constexpr size_t WS_WOUT = 24 * MiB;
constexpr size_t WS_WPG = 26 * MiB;
constexpr size_t WS_WPP = 28 * MiB;
constexpr size_t WS_WGU = 32 * MiB;
constexpr size_t WS_WDN = 160 * MiB;
constexpr size_t WS_XN = 224 * MiB;
constexpr size_t WS_X1 = 290 * MiB;
constexpr size_t WS_Z = 418 * MiB;
constexpr size_t WS_AO = 658 * MiB;
constexpr size_t WS_ACT = 418 * MiB;
constexpr size_t WS_RW = 722 * MiB;
constexpr size_t WS_RR = WS_RW, WS_RK = WS_RW + 32 * MiB, WS_RV = WS_RW + 64 * MiB, WS_RG = WS_RW + 96 * MiB;
constexpr size_t WS_RLW = WS_RW + 128 * MiB;
constexpr size_t WS_RKK = WS_RW + 192 * MiB, WS_RKA = WS_RW + 224 * MiB;
constexpr size_t WS_YP = 722 * MiB;
constexpr size_t WS_END = 994 * MiB;
static_assert(WS_ACT + (size_t)MAXBLK * 256 * 1024 * 2 <= WS_RW && WS_YP + (size_t)MAXBLK * 256 * 1024 * 2 <= WS_END, "ws map");
constexpr size_t DO_PJ = 0, DO_PB = 64 * MiB;
constexpr int CW_TMO = 0, CW_CNT = 64  , CW_BAR = 4096;

struct Params {
    const float *x, *p, *mix_norm, *w_in, *f_bias, *q_norm, *k_norm, *mu, *w0, *w2, *a0, *a2, *g2, *k_k, *k_a, *r_k, *ln_w, *ln_b, *w_out, *moe_norm, *w_router, *b_router, *w_gu, *b_gu, *w_down,
        *b_down, *ple_norm, *w_pg, *w_pp, *final_norm;
    float* out; unsigned char* ws; int ph_lo, ph_hi;
};

typedef const __attribute__((address_space(4))) Params& KPR;
__device__ __forceinline__ const __attribute__((address_space(4))) Params* kp_fresh() {
    unsigned long long p = (unsigned long long)__builtin_amdgcn_kernarg_segment_ptr(); asm volatile("" : "+s"(p)); return (const __attribute__((address_space(4))) Params*)p; }

__device__ __forceinline__ unsigned f2bf(float f) { unsigned u = __builtin_bit_cast(unsigned, f); return (u + 0x7fffu + ((u >> 16) & 1u)) >> 16; }
__device__ __forceinline__ unsigned pk2(float lo, float hi) { return f2bf(lo) | (f2bf(hi) << 16); }
__device__ __forceinline__ float bf2f(unsigned h) { return __builtin_bit_cast(float, h << 16); }
__device__ __forceinline__ float bflo(unsigned w) { return __builtin_bit_cast(float, w << 16); }
__device__ __forceinline__ float bfhi(unsigned w) { return __builtin_bit_cast(float, w & 0xffff0000u); }
__device__ __forceinline__ unsigned cvt_pk_bf16(float lo, float hi) { unsigned r; asm volatile("v_cvt_pk_bf16_f32 %0, %1, %2" : "=v"(r) : "v"(lo), "v"(hi)); return r; }
__device__ __forceinline__ float wave_sum(float v) {
#pragma unroll
    for (int o = 1; o < 64; o <<= 1) v += __shfl_xor(v, o);
    return v;
}
__device__ __forceinline__ float sigmoidf_(float x) { return 1.0f / (1.0f + __expf(-x)); }
__device__ __forceinline__ float logsigmoidf_(float x) { return fminf(x, 0.f) - log1pf(expf(-fabsf(x))); }
namespace pg8 {
constexpr int BM = 256, BK = 64, HALF = 128, HTB = HALF * BK * 2, STAGE_BYTES = 8 * HTB, NXCD = 8, WGM = 8;
__host__ __device__ __forceinline__ int lds_byte(int r, int c) { const int st = (r >> 4) * 2 + (c >> 5), rr = r & 15, cc = c & 31, ob = rr * 64 + cc * 2; return st * 1024 + (ob ^ (((ob >> 9) & 1) << 5)); }
__host__ __device__ __forceinline__ void stage_rc(int b, int& R, int& C) { const int st = b / 1024, sb = b % 1024, swz = sb ^ (((sb >> 9) & 1) << 5); R = (st >> 1) * 16 + swz / 64; C = (st & 1) * 32 + (swz % 64) / 2; }
__host__ __device__ __forceinline__ int perm32(int rho) { const int n = rho >> 4, i = rho & 15; return 8 * (i >> 2) + 4 * n + (i & 3); }

struct Unit { int pm, pn, e, lb; };

__device__ __forceinline__ bool tile_order(int i, int G, int c, int nM, int nN, int& pm, int& pn) {
    const int nwg = nM * nN; const long L = (long)i * G + c; if (L >= nwg) return false;
    int wgid = (int)L; { const int q = nwg / NXCD, r = nwg % NXCD, xcd = wgid % NXCD, off = wgid / NXCD; wgid = (xcd < r ? xcd * (q + 1) : r * (q + 1) + (xcd - r) * q) + off; }
    const int nig = WGM * nN, gid = wgid / nig, fm = gid * WGM, gsz = (nM - fm) < WGM ? (nM - fm) : WGM;
    pm = fm + ((wgid % nig) % gsz); pn = (wgid % nig) / gsz; return true;
}
struct DenseOrder {
    const bf16_t* A; const bf16_t* Bt; int K, nM, nN, G, c;
    __device__ __forceinline__ bool next(int i, Unit& u) const { u.e = 0; u.lb = 0; return tile_order(i, G, c, nM, nN, u.pm, u.pn); }
    __device__ __forceinline__ const char* a_base(const Unit& u) const { return (const char*)A + (size_t)u.pm * BM * K * 2; }
    __device__ __forceinline__ const char* b_base(const Unit& u) const { return (const char*)Bt + (size_t)u.pn * BM * K * 2; }
    __device__ __forceinline__ void a_off(const Unit&, const int (&R)[2], const int (&C)[2], unsigned (&off)[2][2]) const {
#pragma unroll
        for (int h = 0; h < 2; ++h)
#pragma unroll
            for (int i = 0; i < 2; ++i) off[h][i] = (unsigned)((R[i] + HALF * h) * K + C[i]) * 2u;
    }
};

template <class Epi, class Sched, bool ALIGN_EPI>
__device__ __forceinline__ void gemm_phase(LAS unsigned char* lds, const int K, const Sched& S, const Epi& E) {
    int tid_ = threadIdx.x; asm volatile("" : "+v"(tid_));
    const int tid = tid_, wid = __builtin_amdgcn_readfirstlane(tid >> 6), lane = tid & 63, wr = wid >> 2, wc = wid & 3, fr = lane & 15, fq = lane >> 4;
    const int nt = K / BK;
    int sR[2], sC[2]; unsigned voffB[2];
#pragma unroll
    for (int i = 0; i < 2; ++i) { int R, C; stage_rc(tid * 16 + i * 8192, R, C); const int Rb = Epi::PERM ? ((R & ~31) + perm32(R & 31)) : R; sR[i] = R; sC[i] = C; voffB[i] = (unsigned)(Rb * K + C) * 2u; }
    const size_t kstep = (size_t)(BK * 2);
    const size_t hstep = (size_t)HALF * K * 2;
    const unsigned ldsw = (unsigned)wid * 1024u;
    const int aoff = lds_byte(wr * 64 + fr, fq * 8), boff = lds_byte(wc * 32 + fr, fq * 8);
#define PG8_SA(b, h) (((b) * 2 + (h)) * HTB)
#define PG8_SB(b, h) ((4 + (b) * 2 + (h)) * HTB)
#define PG8_STAGE(bufoff, gbase, voff) do { _Pragma("unroll") for (int _i = 0; _i < 2; ++_i) \
        __builtin_amdgcn_global_load_lds((const unsigned*)((const char*)(gbase) + (voff)[_i]), (LAS unsigned*)(lds + (bufoff) + ldsw + _i * 8192), 16, 0, 0); } while (0)
#define PG8_LDA(dst, b, h) do { _Pragma("unroll") for (int m = 0; m < 4; ++m) _Pragma("unroll") for (int k = 0; k < 2; ++k) dst[m][k] = *(const LAS bf16x8*)(lds + PG8_SA(b, h) + aoff + m * 2048 + k * 1024); } while (0)
#define PG8_LDB(dst, b, h) do { _Pragma("unroll") for (int n = 0; n < 2; ++n) _Pragma("unroll") for (int k = 0; k < 2; ++k) dst[n][k] = *(const LAS bf16x8*)(lds + PG8_SB(b, h) + boff + n * 2048 + k * 1024); } while (0)
#define PG8_MMA(ai, bj, At, Bt) do { __builtin_amdgcn_s_setprio(1); _Pragma("unroll") for (int m = 0; m < 4; ++m) _Pragma("unroll") for (int n = 0; n < 2; ++n) _Pragma("unroll") for (int k = 0; k < 2; ++k) \
        acc[ai][bj][m][n] = __builtin_amdgcn_mfma_f32_16x16x32_bf16(Bt[n][k], At[m][k], acc[ai][bj][m][n], 0, 0, 0); __builtin_amdgcn_s_setprio(0); } while (0)
#define PG8_WAIT_V(n) asm volatile("s_waitcnt vmcnt(" #n ")" ::: "memory")
#define PG8_WAIT_L(n) asm volatile("s_waitcnt lgkmcnt(" #n ")" ::: "memory")
#define PG8_BAR __builtin_amdgcn_s_barrier()
#define PG8_SCHED __builtin_amdgcn_sched_barrier(0)
    Unit cur, nxt; int ui = 0;
    if (!S.next(0, cur)) return;
    f32x4 acc[2][2][4][2];
#pragma unroll
    for (int a = 0; a < 2; ++a)
#pragma unroll
        for (int b = 0; b < 2; ++b)
#pragma unroll
            for (int m = 0; m < 4; ++m)
#pragma unroll
                for (int n = 0; n < 2; ++n) acc[a][b][m][n] = (f32x4){0.f, 0.f, 0.f, 0.f};
    bf16x8 At[4][2], B0[2][2], B1[2][2];
    unsigned offC[2][2], offN[2][2];
    S.a_off(cur, sR, sC, offC);
    const char* cA = S.a_base(cur); const char* cB = S.b_base(cur);
    PG8_STAGE(PG8_SB(0, 0), cB, voffB); PG8_STAGE(PG8_SB(0, 1), cB + hstep, voffB); PG8_STAGE(PG8_SA(0, 0), cA, offC[0]); PG8_STAGE(PG8_SA(0, 1), cA, offC[1]);
    if (wr == 1) PG8_BAR;
    PG8_WAIT_V(2); PG8_BAR;
    PG8_STAGE(PG8_SB(1, 0), cB + kstep, voffB); PG8_STAGE(PG8_SA(1, 0), cA + kstep, offC[0]); PG8_STAGE(PG8_SB(1, 1), cB + hstep + kstep, voffB);
    PG8_WAIT_V(6); PG8_BAR;
    for (;;) {
        const bool has_next = S.next(ui + 1, nxt);
        const char* nA = cA; const char* nB = cB;
        if (has_next) { nA = S.a_base(nxt); nB = S.b_base(nxt); S.a_off(nxt, sR, sC, offN); }
        else {
#pragma unroll
            for (int h = 0; h < 2; ++h)
#pragma unroll
                for (int i = 0; i < 2; ++i) offN[h][i] = offC[h][i];
        }
#pragma nounroll
        for (int t = 0; t < nt; t += 2) {
            const bool last = (t == nt - 2);
            const char* a1 = cA + (size_t)(t + 1) * kstep;
            const char* a2 = last ? nA : cA + (size_t)(t + 2) * kstep; const char* b2 = last ? nB : cB + (size_t)(t + 2) * kstep;
            const char* a3 = a2 + kstep; const char* b3 = b2 + kstep;
            unsigned o2[2][2];
#pragma unroll
            for (int h = 0; h < 2; ++h)
#pragma unroll
                for (int i = 0; i < 2; ++i) o2[h][i] = last ? offN[h][i] : offC[h][i];
            PG8_LDB(B0, 0, 0); PG8_LDB(B1, 0, 1); PG8_SCHED; PG8_LDA(At, 0, 0); PG8_STAGE(PG8_SA(1, 1), a1, offC[1]);
            PG8_WAIT_V(8); PG8_WAIT_L(0); PG8_BAR; PG8_MMA(0, 0, At, B0); PG8_MMA(0, 1, At, B1); PG8_BAR; PG8_SCHED;
            PG8_LDA(At, 0, 1); PG8_STAGE(PG8_SB(0, 0), b2, voffB); PG8_STAGE(PG8_SB(0, 1), b2 + hstep, voffB); PG8_STAGE(PG8_SA(0, 0), a2, o2[0]);
            PG8_WAIT_V(8); PG8_WAIT_L(0); PG8_BAR; PG8_MMA(1, 0, At, B0); PG8_MMA(1, 1, At, B1); PG8_BAR; PG8_SCHED;
            PG8_LDB(B0, 1, 0); PG8_LDB(B1, 1, 1); PG8_SCHED; PG8_LDA(At, 1, 0); PG8_STAGE(PG8_SA(0, 1), a2, o2[1]);
            PG8_WAIT_V(8); PG8_WAIT_L(0); PG8_BAR; PG8_MMA(0, 0, At, B0); PG8_MMA(0, 1, At, B1); PG8_BAR; PG8_SCHED;
            PG8_LDA(At, 1, 1); PG8_STAGE(PG8_SB(1, 0), b3, voffB); PG8_STAGE(PG8_SB(1, 1), b3 + hstep, voffB); PG8_STAGE(PG8_SA(1, 0), a3, o2[0]);
            PG8_WAIT_V(8); PG8_WAIT_L(0); PG8_BAR; PG8_MMA(1, 0, At, B0); PG8_MMA(1, 1, At, B1); PG8_BAR; PG8_SCHED;
        }
        if constexpr (ALIGN_EPI) { if (wr == 0) PG8_BAR; }
        E(acc, cur, wr, wc, fr, fq);
        if (!has_next) break;
#pragma unroll
        for (int a = 0; a < 2; ++a)
#pragma unroll
            for (int b = 0; b < 2; ++b)
#pragma unroll
                for (int m = 0; m < 4; ++m)
#pragma unroll
                    for (int n = 0; n < 2; ++n) acc[a][b][m][n] = (f32x4){0.f, 0.f, 0.f, 0.f};
        cur = nxt; cA = nA; cB = nB; ++ui;
#pragma unroll
        for (int h = 0; h < 2; ++h)
#pragma unroll
            for (int i = 0; i < 2; ++i) offC[h][i] = offN[h][i];
        if constexpr (ALIGN_EPI) { if (wr == 1) PG8_BAR; }
    }
    PG8_WAIT_V(0);
    if constexpr (!ALIGN_EPI) { if (wr == 0) PG8_BAR; }
    PG8_BAR;
#undef PG8_SA
#undef PG8_SB
#undef PG8_STAGE
#undef PG8_LDA
#undef PG8_LDB
#undef PG8_MMA
#undef PG8_WAIT_V
#undef PG8_WAIT_L
#undef PG8_BAR
#undef PG8_SCHED
}
}
namespace pg8 {
constexpr int T_BLKSTART = 0  , T_CNT = 40  , T_BLKE = 80  , T_WORDS = 80 + 560;

struct EpiIn {
    static constexpr bool PERM = true;
    bf16_t* Z; const float* qn; const float* kn;
    __device__ __forceinline__ void operator()(const f32x4 (&acc)[2][2][4][2], const Unit& u, int wr, int wc, int fr, int fq) const {
        const int row0 = u.pm * BM + wr * 64 + fr;
        if (u.pn < 4) {
            const float* g = (u.pn < 2) ? qn : kn; const float sc = (u.pn < 2) ? QSCALE : 1.0f;
            f32x4 gv[2][2];
#pragma unroll
            for (int bj = 0; bj < 2; ++bj)
#pragma unroll
                for (int n = 0; n < 2; ++n) gv[bj][n] = *(const f32x4*)(g + 32 * bj + 8 * fq + 4 * n) * sc;
#pragma unroll
            for (int ai = 0; ai < 2; ++ai)
#pragma unroll
                for (int m = 0; m < 4; ++m) {
                    float ss = 0.f;
#pragma unroll
                    for (int bj = 0; bj < 2; ++bj)
#pragma unroll
                        for (int n = 0; n < 2; ++n) { const f32x4 x = acc[ai][bj][m][n]; ss += (x[0] * x[0] + x[1] * x[1]) + (x[2] * x[2] + x[3] * x[3]); }
                    ss += __shfl_xor(ss, 16); ss += __shfl_xor(ss, 32);
                    const float rstd = rsqrtf(ss * (1.0f / 64.0f) + 1e-6f);
                    bf16_t* rowp = Z + (size_t)(row0 + ai * HALF + m * 16) * ZW + u.pn * BM + 64 * wc + 8 * fq;
#pragma unroll
                    for (int bj = 0; bj < 2; ++bj) { const f32x4 v0 = acc[ai][bj][m][0] * rstd * gv[bj][0], v1 = acc[ai][bj][m][1] * rstd * gv[bj][1];
                        u32x4 w; w.x = cvt_pk_bf16(v0[0], v0[1]); w.y = cvt_pk_bf16(v0[2], v0[3]); w.z = cvt_pk_bf16(v1[0], v1[1]); w.w = cvt_pk_bf16(v1[2], v1[3]);
                        *(u32x4*)(rowp + 32 * bj) = w; }
                }
        } else {
            const int col0 = u.pn * BM + wc * 32 + 8 * fq;
#pragma unroll
            for (int ai = 0; ai < 2; ++ai)
#pragma unroll
                for (int m = 0; m < 4; ++m) { bf16_t* rowp = Z + (size_t)(row0 + ai * HALF + m * 16) * ZW + col0;
#pragma unroll
                    for (int bj = 0; bj < 2; ++bj) { const f32x4 v0 = acc[ai][bj][m][0], v1 = acc[ai][bj][m][1];
                        u32x4 w; w.x = cvt_pk_bf16(v0[0], v0[1]); w.y = cvt_pk_bf16(v0[2], v0[3]); w.z = cvt_pk_bf16(v1[0], v1[1]); w.w = cvt_pk_bf16(v1[2], v1[3]);
                        *(u32x4*)(rowp + bj * HALF) = w; } }
        }
    }
};
struct EpiBf16 {
    static constexpr bool PERM = true;
    bf16_t* O; int ldc;
    __device__ __forceinline__ void operator()(const f32x4 (&acc)[2][2][4][2], const Unit& u, int wr, int wc, int fr, int fq) const {
        const int row0 = u.pm * BM + wr * 64 + fr, col0 = u.pn * BM + wc * 32 + 8 * fq;
#pragma unroll
        for (int ai = 0; ai < 2; ++ai)
#pragma unroll
            for (int m = 0; m < 4; ++m) { bf16_t* rowp = O + (size_t)(row0 + ai * HALF + m * 16) * ldc + col0;
#pragma unroll
                for (int bj = 0; bj < 2; ++bj) { const f32x4 v0 = acc[ai][bj][m][0], v1 = acc[ai][bj][m][1];
                    u32x4 w; w.x = cvt_pk_bf16(v0[0], v0[1]); w.y = cvt_pk_bf16(v0[2], v0[3]); w.z = cvt_pk_bf16(v1[0], v1[1]); w.w = cvt_pk_bf16(v1[2], v1[3]);
                    *(u32x4*)(rowp + bj * HALF) = w; } }
    }
};
struct EpiOut {
    static constexpr bool PERM = false;
    const float* X; float* O;
    __device__ __forceinline__ void operator()(const f32x4 (&acc)[2][2][4][2], const Unit& u, int wr, int wc, int fr, int fq) const {
        const int row0 = u.pm * BM + wr * 64 + fr, col0 = u.pn * BM + wc * 32 + 4 * fq;
#pragma unroll
        for (int ai = 0; ai < 2; ++ai)
#pragma unroll
            for (int m = 0; m < 4; ++m) { const size_t off = (size_t)(row0 + ai * HALF + m * 16) * DM + col0;
#pragma unroll
                for (int bj = 0; bj < 2; ++bj)
#pragma unroll
                    for (int n = 0; n < 2; ++n) *(f32x4*)(O + off + bj * HALF + n * 16) = *(const f32x4*)(X + off + bj * HALF + n * 16) + acc[ai][bj][m][n];
                if (m & 1) asm volatile("" ::: "memory"); }
    }
};
struct EpiPg {
    static constexpr bool PERM = false;
    float* X; const bf16_t* PJ;
    __device__ __forceinline__ void operator()(const f32x4 (&acc)[2][2][4][2], const Unit& u, int wr, int wc, int fr, int fq) const {
        const int row0 = u.pm * BM + wr * 64 + fr, col0 = u.pn * BM + wc * 32 + 4 * fq;
#pragma unroll
        for (int ai = 0; ai < 2; ++ai)
#pragma unroll
            for (int m = 0; m < 4; ++m) { const size_t off = (size_t)(row0 + ai * HALF + m * 16) * DM + col0;
#pragma unroll
                for (int bj = 0; bj < 2; ++bj)
#pragma unroll
                    for (int n = 0; n < 2; ++n) { const size_t o = off + bj * HALF + n * 16; const u32x2 pj = *(const u32x2*)(PJ + o); const f32x4 a = acc[ai][bj][m][n]; const f32x4 xv = *(const f32x4*)(X + o);
                        f32x4 r; r[0] = xv[0] + sigmoidf_(a[0]) * bflo(pj.x); r[1] = xv[1] + sigmoidf_(a[1]) * bfhi(pj.x); r[2] = xv[2] + sigmoidf_(a[2]) * bflo(pj.y); r[3] = xv[3] + sigmoidf_(a[3]) * bfhi(pj.y);
                        *(f32x4*)(X + o) = r; }
                if (m & 1) asm volatile("" ::: "memory"); }
    }
};
struct EpiGu {
    static constexpr bool PERM = true;
    bf16_t* ACT; const float* b_gu;
    __device__ __forceinline__ void operator()(const f32x4 (&acc)[2][2][4][2], const Unit& u, int wr, int wc, int fr, int fq) const {
        const int row0 = u.pm * BM + wr * 64 + fr, cl = u.pn * HALF + wc * 32 + 8 * fq;
        const float* bg = b_gu + (size_t)u.e * 2048 + cl;
        f32x4 bgl[2], bli[2];
#pragma unroll
        for (int n = 0; n < 2; ++n) { bgl[n] = *(const f32x4*)(bg + 4 * n); bli[n] = *(const f32x4*)(bg + 1024 + 4 * n); }
#pragma unroll
        for (int ai = 0; ai < 2; ++ai)
#pragma unroll
            for (int m = 0; m < 4; ++m) { bf16_t* rowp = ACT + (size_t)(row0 + ai * HALF + m * 16) * EFF + cl; float r[8];
#pragma unroll
                for (int n = 0; n < 2; ++n)
#pragma unroll
                    for (int i = 0; i < 4; ++i) { const float gl = fminf(acc[ai][0][m][n][i] + bgl[n][i], 7.0f); const float li = fminf(fmaxf(acc[ai][1][m][n][i] + bli[n][i], -7.0f), 7.0f);
                        r[4 * n + i] = gl * sigmoidf_(1.702f * gl) * (li + 1.0f); }
                u32x4 w; w.x = cvt_pk_bf16(r[0], r[1]); w.y = cvt_pk_bf16(r[2], r[3]); w.z = cvt_pk_bf16(r[4], r[5]); w.w = cvt_pk_bf16(r[6], r[7]);
                *(u32x4*)rowp = w; }
    }
};
struct EpiDn {
    static constexpr bool PERM = true;
    bf16_t* YP; const float* b_dn; const float* gateslot; const LAS int* tab;
    __device__ __forceinline__ void operator()(const f32x4 (&acc)[2][2][4][2], const Unit& u, int wr, int wc, int fr, int fq) const {
        const int row0 = u.pm * BM + wr * 64 + fr, col0 = u.pn * BM + wc * 32 + 8 * fq;
        const float* bd = b_dn + (size_t)u.e * 1024 + col0; const int cnt = tab[T_CNT + u.e];
        f32x4 bv[2][2];
#pragma unroll
        for (int bj = 0; bj < 2; ++bj)
#pragma unroll
            for (int n = 0; n < 2; ++n) bv[bj][n] = *(const f32x4*)(bd + bj * HALF + 4 * n);
#pragma unroll
        for (int ai = 0; ai < 2; ++ai)
#pragma unroll
            for (int m = 0; m < 4; ++m) { const int rr = wr * 64 + fr + ai * HALF + m * 16, slot = u.lb * 256 + rr;
                const float gt = slot < cnt ? gateslot[(size_t)u.e * NTOK + slot] : 0.f;
                bf16_t* rowp = YP + (size_t)(row0 + ai * HALF + m * 16) * DM + col0;
#pragma unroll
                for (int bj = 0; bj < 2; ++bj) { const f32x4 v0 = (acc[ai][bj][m][0] + bv[bj][0]) * gt, v1 = (acc[ai][bj][m][1] + bv[bj][1]) * gt;
                    u32x4 w; w.x = cvt_pk_bf16(v0[0], v0[1]); w.y = cvt_pk_bf16(v0[2], v0[3]); w.z = cvt_pk_bf16(v1[0], v1[1]); w.w = cvt_pk_bf16(v1[2], v1[3]);
                    *(u32x4*)(rowp + bj * HALF) = w; } }
    }
};
struct MoeOrder {
    const bf16_t* A; const bf16_t* Bt; const int* tokslot; const LAS int* tab; int nblk, nN, G, c; bool gather;
    __device__ __forceinline__ bool next(int i, Unit& u) const { if (!tile_order(i, G, c, nblk, nN, u.pm, u.pn)) return false; u.e = tab[T_BLKE + u.pm]; u.lb = u.pm - tab[T_BLKSTART + u.e]; return true; }
    __device__ __forceinline__ const char* a_base(const Unit& u) const { return gather ? (const char*)A : (const char*)A + (size_t)u.pm * BM * 1024 * 2; }
    __device__ __forceinline__ const char* b_base(const Unit& u) const { return (const char*)Bt + ((size_t)u.e * nN + u.pn) * BM * 1024 * 2; }
    __device__ __forceinline__ void a_off(const Unit& u, const int (&R)[2], const int (&C)[2], unsigned (&off)[2][2]) const {
        const int cnt = tab[T_CNT + u.e];
#pragma unroll
        for (int h = 0; h < 2; ++h)
#pragma unroll
            for (int i = 0; i < 2; ++i) {
                if (gather) { const int slot = u.lb * 256 + R[i] + HALF * h; const int tok = slot < cnt ? tokslot[(size_t)u.e * NTOK + slot] : NTOK; off[h][i] = (unsigned)tok * 2048u + (unsigned)C[i] * 2u; }
                else off[h][i] = (unsigned)((R[i] + HALF * h) * 1024 + C[i]) * 2u;
            }
    }
};
__device__ __forceinline__ int moe_tables(LAS int* tab, const unsigned* cntw) {
    if (threadIdx.x == 0) { int s = 0; for (int e = 0; e < NE; ++e) { const int c = (int)cntw[e]; tab[T_CNT + e] = c; tab[T_BLKSTART + e] = s; const int nb = (c + 255) >> 8; for (int j = 0; j < nb; ++j) tab[T_BLKE + s + j] = e; s += nb; } tab[T_BLKSTART + NE] = s; }
    __syncthreads();
    return tab[T_BLKSTART + NE];
}
}
constexpr int NWAVES = 8, NTHREADS = 512;
constexpr int RING_BYTES = 131072, MISC_OFF = RING_BYTES, LDS_BYTES = 147456;

__device__ __forceinline__ void tr_item(const float* W, int ldw, int srccol0, int k0, bf16_t* WT, int Kd, int dstrow0, LAS float* scr, int lane) {
#pragma unroll 8
    for (int i = 0; i < 32; ++i) { const int kk = 2 * i + (lane >> 5); scr[kk * 33 + (lane & 31)] = W[(size_t)(k0 + kk) * ldw + srccol0 + (lane & 31)]; }
    asm volatile("s_waitcnt lgkmcnt(0)" ::: "memory");
    const int c = lane & 7;
#pragma unroll
    for (int j = 0; j < 4; ++j) { const int n = (lane >> 3) + 8 * j; const LAS float* s = scr + (8 * c) * 33 + n;
        u32x4 o; o.x = pk2(s[0 * 33], s[1 * 33]); o.y = pk2(s[2 * 33], s[3 * 33]); o.z = pk2(s[4 * 33], s[5 * 33]); o.w = pk2(s[6 * 33], s[7 * 33]);
        *(u32x4*)(WT + (size_t)(dstrow0 + n) * Kd + k0 + 8 * c) = o; }
    asm volatile("s_waitcnt lgkmcnt(0)" ::: "memory");
}
constexpr int I_IN = 16 * 120, I_OUT = 16 * 32, I_PG = 16 * 32, I_PP = 4 * 32, I_GU1 = 16 * 64, I_DN1 = 16 * 32;
constexpr int I_SMALL = I_IN + I_OUT + I_PG + I_PP, I_GU = NE * I_GU1, I_DN = NE * I_DN1, I_ALL = I_SMALL + I_GU + I_DN;
__device__ __forceinline__ void prep_item(KPR P, int it, LAS float* scr, int lane) {
    unsigned char* ws = P.ws;
    if (it < I_IN) { const int kb = it / 120, nb = it % 120, n0 = nb * 32, pn = n0 >> 8, j0 = n0 & 255;
        const int src = pn < 4 ? (pn * 256 + 64 * ((j0 & 127) >> 5) + 32 * (j0 >> 7)) : (n0 < 2048 ? n0 : n0 + 8);
        tr_item(P.w_in, INW, src, kb * 64, (bf16_t*)(ws + WS_WIN), 1024, n0, scr, lane); return; }
    it -= I_IN;
    if (it < I_OUT) { tr_item(P.w_out, 1024, (it % 32) * 32, (it / 32) * 64, (bf16_t*)(ws + WS_WOUT), 1024, (it % 32) * 32, scr, lane); return; }
    it -= I_OUT;
    if (it < I_PG) { tr_item(P.w_pg, 1024, (it % 32) * 32, (it / 32) * 64, (bf16_t*)(ws + WS_WPG), 1024, (it % 32) * 32, scr, lane); return; }
    it -= I_PG;
    if (it < I_PP) { tr_item(P.w_pp, 1024, (it % 32) * 32, (it / 32) * 64, (bf16_t*)(ws + WS_WPP), 256, (it % 32) * 32, scr, lane); return; }
    it -= I_PP;
    if (it < I_GU) { const int e = it / I_GU1, r = it % I_GU1, kb = r / 64, nb = r % 64, n0 = nb * 32, pn = n0 >> 8, j0 = n0 & 255;
        const int src = (j0 >> 7) * 1024 + pn * 128 + (j0 & 127);
        tr_item(P.w_gu + (size_t)e * 1024 * 2048, 2048, src, kb * 64, (bf16_t*)(ws + WS_WGU) + (size_t)e * 2048 * 1024, 1024, n0, scr, lane); return; }
    it -= I_GU;
    { const int e = it / I_DN1, r = it % I_DN1, kb = r / 32, nb = r % 32;
        tr_item(P.w_down + (size_t)e * 1024 * 1024, 1024, nb * 32, kb * 64, (bf16_t*)(ws + WS_WDN) + (size_t)e * 1024 * 1024, 1024, nb * 32, scr, lane); }
}
__device__ __forceinline__ void phase_prep_weights(KPR P, LAS unsigned char* lds, int gw, int ngw, int wave, int lane) {
    LAS float* scr = (LAS float*)(lds + wave * 16384);
    for (int it = gw; it < I_ALL; it += ngw) prep_item(P, it, scr, lane);
}
__device__ __forceinline__ void phase_cvt_p(KPR P, int gt, int ngt) {
    bf16_t* PB = (bf16_t*)((unsigned char*)P.out + DO_PB);
    for (int i = gt; i < NTOK * PLE / 8; i += ngt) { const f32x4 a = ((const f32x4*)P.p)[2 * i], b = ((const f32x4*)P.p)[2 * i + 1];
        u32x4 w; w.x = pk2(a[0], a[1]); w.y = pk2(a[2], a[3]); w.z = pk2(b[0], b[1]); w.w = pk2(b[2], b[3]); ((u32x4*)PB)[i] = w; }
}
__device__ __forceinline__ void rms_row(const float* xrow, const float* gain, int lane, f32x4 (&v)[4]) {
    const f32x4* xr = (const f32x4*)xrow + lane; float s = 0.f;
#pragma unroll
    for (int j = 0; j < 4; ++j) { v[j] = xr[64 * j]; s += (v[j][0] * v[j][0] + v[j][1] * v[j][1]) + (v[j][2] * v[j][2] + v[j][3] * v[j][3]); }
    const float rstd = rsqrtf(wave_sum(s) * (1.f / DM) + 1e-6f);
#pragma unroll
    for (int j = 0; j < 4; ++j) v[j] = v[j] * rstd * ((const f32x4*)gain)[64 * j + lane];
}
__device__ __forceinline__ void store_row_bf16(bf16_t* orow, int lane, const f32x4 (&v)[4]) {
    u32x2* o8 = (u32x2*)orow + lane;
#pragma unroll
    for (int j = 0; j < 4; ++j) { u32x2 w; w.x = pk2(v[j][0], v[j][1]); w.y = pk2(v[j][2], v[j][3]); o8[64 * j] = w; }
}
__device__ __forceinline__ void norm1_row(KPR P, int row, int lane, const LAS float* wff, LAS float* lf_out  ) {
    f32x4 v[4]; rms_row(P.x + (size_t)row * DM, P.mix_norm, lane, v);
    store_row_bf16((bf16_t*)(P.ws + WS_XN) + (size_t)row * DM, lane, v);
    float ff[8];
#pragma unroll
    for (int q = 0; q < 8; ++q) ff[q] = 0.f;
#pragma unroll
    for (int j = 0; j < 4; ++j)
#pragma unroll
        for (int i = 0; i < 4; ++i) { const LAS f32x4* w = (const LAS f32x4*)(wff + (size_t)(4 * (64 * j + lane) + i) * 8); const f32x4 w0 = w[0], w1 = w[1]; const float h = v[j][i];
            ff[0] += h * w0[0]; ff[1] += h * w0[1]; ff[2] += h * w0[2]; ff[3] += h * w0[3]; ff[4] += h * w1[0]; ff[5] += h * w1[1]; ff[6] += h * w1[2]; ff[7] += h * w1[3]; }
#pragma unroll
    for (int q = 0; q < 8; ++q) ff[q] = wave_sum(ff[q]);
    if (lane < 8) { float f = ff[0];
#pragma unroll
        for (int q = 1; q < 8; ++q) f = (lane == q) ? ff[q] : f;
        lf_out[lane] = logsigmoidf_(f + P.f_bias[lane]); }
}
__device__ __forceinline__ void load_wff(KPR P, LAS float* wff, int tid, int nthr) {
    for (int i = tid; i < 1024 * 8; i += nthr) wff[i] = P.w_in[(size_t)(i >> 3) * INW + 2048 + (i & 7)];
}
__device__ __forceinline__ void final_row(KPR P, int row, int lane, bool dead) {
    f32x4 v[4]; rms_row((const float*)(P.ws + WS_X1) + (size_t)row * DM, P.final_norm, lane, v);
    f32x4* o = (f32x4*)(P.out + (size_t)row * DM) + lane;
#pragma unroll
    for (int j = 0; j < 4; ++j) { if (dead) { const float q = __builtin_nanf(""); v[j] = (f32x4){q, q, q, q}; } o[64 * j] = v[j]; }
}
typedef GAS unsigned gu32;
#define RLX_AGENT __ATOMIC_RELAXED, __HIP_MEMORY_SCOPE_AGENT
#define XB_TMO      128
#define XB_XCNT(j)  (256  + 64 * (j))
#define XB_XSUB(j)  (1280 + 64 * (j))
#define XB_XGEN(j)  (2304 + 64 * (j))
#define XB_TOP      3328
#define XB_TOPGEN   3392
#define XCD_BAR_WORDS 3456
#define XB_SPIN_CAP (1u << 22)

__device__ __forceinline__ unsigned xb_ld(unsigned* p)              { return __hip_atomic_load(p, __ATOMIC_RELAXED, __HIP_MEMORY_SCOPE_AGENT); }
__device__ __forceinline__ unsigned xb_add(unsigned* p, unsigned v) { return __hip_atomic_fetch_add(p, v, __ATOMIC_RELAXED, __HIP_MEMORY_SCOPE_AGENT); }
__device__ __forceinline__ unsigned xb_xcc_id() { return (unsigned)__builtin_amdgcn_s_getreg((3 << 11) | 20) & 0xFu; }
#define XB_SPIN(cond, bar) do { unsigned _sp = 0; while (cond) { __builtin_amdgcn_s_sleep(1); \
    if ((++_sp & 255u) == 0u) { if (xb_ld(&(bar)[XB_TMO])) break; if (_sp > XB_SPIN_CAP) { atomicAdd(&(bar)[XB_TMO], 1u); break; } } } } while (0)

struct XcdBarrier { unsigned* bar; unsigned x; volatile LAS unsigned* st; };

__device__ __forceinline__ XcdBarrier xcd_barrier_post(unsigned* bar, volatile LAS unsigned* st) {
    XcdBarrier b; b.bar = bar; b.x = xb_xcc_id(); b.st = st;
    if (threadIdx.x == 0) (void)xb_add(&bar[XB_XCNT(b.x)], 1u);
    return b;
}
__device__ __forceinline__ void xcd_barrier_complete(unsigned* bar, unsigned x, unsigned& nloc, unsigned& nx) {
    const unsigned G = gridDim.x * gridDim.y * gridDim.z;
    unsigned sum, cnt, mine, sp = 0u;
    for (;;) {
        sum = 0u; cnt = 0u; mine = 0u;
#pragma unroll
        for (unsigned j = 0; j < 16; ++j) { const unsigned c = xb_ld(&bar[XB_XCNT(j)]); sum += c; cnt += (c > 0u) ? 1u : 0u; mine = (j == x) ? c : mine; }
        if (sum == G) break;
        __builtin_amdgcn_s_sleep(1);
        if ((++sp & 255u) == 0u) { if (xb_ld(&bar[XB_TMO])) break; if (sp > XB_SPIN_CAP) { atomicAdd(&bar[XB_TMO], 1u); break; } }
    }
    nloc = mine > 0u ? mine : 1u; nx = cnt > 0u ? cnt : 1u;
}
__device__ __forceinline__ void xcd_barrier(const XcdBarrier& b) {
    asm volatile("s_waitcnt vmcnt(0)" ::: "memory");
    __syncthreads();
    if (threadIdx.x == 0) {
        unsigned* bar = b.bar;
        __builtin_amdgcn_s_waitcnt(0);
        unsigned nloc = b.st[0], nx = b.st[1];
        if (nloc == 0u) { xcd_barrier_complete(bar, b.x, nloc, nx); b.st[0] = nloc; b.st[1] = nx; }
        const unsigned old = xb_add(&bar[XB_XSUB(b.x)], 1u);
        const unsigned gen = old / nloc;
        if (old + 1u == (gen + 1u) * nloc) {
            __builtin_amdgcn_fence(__ATOMIC_RELEASE, "agent");
            asm volatile("s_waitcnt vmcnt(0)" ::: "memory");
            const unsigned og = xb_add(&bar[XB_TOP], 1u);
            const unsigned tg = og / nx;
            if (og + 1u == (tg + 1u) * nx) xb_add(&bar[XB_TOPGEN], 1u);
            else XB_SPIN(xb_ld(&bar[XB_TOPGEN]) == tg, bar);
            __builtin_amdgcn_fence(__ATOMIC_ACQUIRE, "agent");
            xb_add(&bar[XB_XGEN(b.x)], 1u);
            asm volatile("s_waitcnt vmcnt(0)" ::: "memory");
        } else {
            XB_SPIN(xb_ld(&bar[XB_XGEN(b.x)]) == gen, bar);
            __builtin_amdgcn_fence(__ATOMIC_ACQUIRE, "agent");
            asm volatile("s_waitcnt vmcnt(0)" ::: "memory");
        }
    }
    __syncthreads();
}
__device__ __forceinline__ int crow(int r, int hi) { return (r & 3) + 8 * (r >> 2) + 4 * hi; }
constexpr int CW_QATT = 128;
constexpr int MISC_TAB = 64, MISC_Q = 4096, MISC_PFX = 4160;

__device__ __forceinline__ void attn_unit_v2(KPR P, LAS unsigned char* lds, int bh, int qb) {
    LAS bf16_t* Ks = (LAS bf16_t*)lds;
    LAS bf16_t* Vt = (LAS bf16_t*)(lds + 9216);
    LAS float* wsf = (LAS float*)(lds + 18432);
    const bf16_t* Z = (const bf16_t*)(P.ws + WS_Z); bf16_t* AO = (bf16_t*)(P.ws + WS_AO);
    const int tid = threadIdx.x, lane = tid & 63, w = tid >> 6, r32 = lane & 31, hi = lane >> 5;
    const int b = bh >> 3, h = bh & 7, q0 = qb * 256;
    const size_t rowbase = (size_t)b * SEQ;
    const float* c2 = (const float*)(P.ws + WS_C2) + (size_t)bh * SEQ;
    const int qloc = q0 + 32 * w + r32;
    const bf16_t* Qp = Z + (rowbase + qloc) * ZW + ZQ + h * 64;
    bf16x8 qr[4];
#pragma unroll
    for (int ks = 0; ks < 4; ++ks) qr[ks] = *(const bf16x8*)(Qp + ks * 16 + hi * 8);
    const float cq = c2[qloc];
    float m = -1e30f, l = 0.f; f32x16 o[2]; o[0] = f32x16{}; o[1] = f32x16{};
    const int ntiles = (q0 + 256) / 64;
    LAS float* wsw = wsf + w * 64;
    for (int t = 0; t < ntiles; ++t) {
        __syncthreads();
        { const int row = tid >> 3, ch = tid & 7; const bf16_t* src = Z + (rowbase + t * 64 + row) * ZW + h * 64 + ch * 8;
            *(LAS u32x4*)&Ks[row * 72 + ch * 8] = *(const u32x4*)(src + ZK);
            const u32x4 v = *(const u32x4*)(src + ZV); const unsigned vv[4] = {v.x, v.y, v.z, v.w};
#pragma unroll
            for (int e = 0; e < 4; ++e) { Vt[(ch * 8 + 2 * e) * 72 + row] = (bf16_t)(vv[e] & 0xffffu); Vt[(ch * 8 + 2 * e + 1) * 72 + row] = (bf16_t)(vv[e] >> 16); } }
        __syncthreads();
        if (t * 64 > q0 + 32 * w + 31) continue;
        f32x16 p[2];
#pragma unroll
        for (int g = 0; g < 2; ++g) { p[g] = f32x16{};
#pragma unroll
            for (int ks = 0; ks < 4; ++ks) { const bf16x8 kf = *(const LAS bf16x8*)&Ks[(32 * g + r32) * 72 + ks * 16 + hi * 8]; p[g] = __builtin_amdgcn_mfma_f32_32x32x16_bf16(kf, qr[ks], p[g], 0, 0, 0); } }
        float mx = -1e30f;
#pragma unroll
        for (int g = 0; g < 2; ++g)
#pragma unroll
            for (int r4 = 0; r4 < 4; ++r4) { const int kv0 = t * 64 + 32 * g + 8 * r4 + 4 * hi; const f32x4 ck = *(const f32x4*)(c2 + kv0);
#pragma unroll
                for (int i = 0; i < 4; ++i) { float s = p[g][4 * r4 + i] + (cq - ck[i]); if (kv0 + i > qloc) s = -INFINITY; p[g][4 * r4 + i] = s; mx = fmaxf(mx, s); } }
        mx = fmaxf(mx, __shfl_xor(mx, 32));
        const float mnew = fmaxf(m, mx), alpha = exp2f(m - mnew); m = mnew;
        float ps = 0.f;
#pragma unroll
        for (int g = 0; g < 2; ++g)
#pragma unroll
            for (int r = 0; r < 16; ++r) { const float e = exp2f(p[g][r] - mnew); p[g][r] = e; ps += e; }
        l = l * alpha + ps;
        if (hi == 0) wsw[r32] = alpha;
        __builtin_amdgcn_wave_barrier(); asm volatile("s_waitcnt lgkmcnt(0)" ::: "memory");
#pragma unroll
        for (int r4 = 0; r4 < 4; ++r4) { const f32x4 al = *(const LAS f32x4*)&wsw[8 * r4 + 4 * hi];
#pragma unroll
            for (int i = 0; i < 4; ++i) { o[0][4 * r4 + i] *= al[i]; o[1][4 * r4 + i] *= al[i]; } }
#pragma unroll
        for (int g = 0; g < 2; ++g)
#pragma unroll
            for (int s = 0; s < 2; ++s) { u32x4 pw; pw.x = pk2(p[g][8 * s + 0], p[g][8 * s + 1]); pw.y = pk2(p[g][8 * s + 2], p[g][8 * s + 3]); pw.z = pk2(p[g][8 * s + 4], p[g][8 * s + 5]); pw.w = pk2(p[g][8 * s + 6], p[g][8 * s + 7]);
                const bf16x8 pa = __builtin_bit_cast(bf16x8, pw);
#pragma unroll
                for (int d0 = 0; d0 < 2; ++d0) { const u32x2 lo = *(const LAS u32x2*)&Vt[(32 * d0 + r32) * 72 + 32 * g + 16 * s + 4 * hi], hh = *(const LAS u32x2*)&Vt[(32 * d0 + r32) * 72 + 32 * g + 16 * s + 8 + 4 * hi];
                    u32x4 vw; vw.x = lo.x; vw.y = lo.y; vw.z = hh.x; vw.w = hh.y;
                    o[d0] = __builtin_amdgcn_mfma_f32_32x32x16_bf16(pa, __builtin_bit_cast(bf16x8, vw), o[d0], 0, 0, 0); } }
        __builtin_amdgcn_wave_barrier();
    }
    l += __shfl_xor(l, 32);
    __builtin_amdgcn_wave_barrier();
    if (hi == 0) wsw[32 + r32] = l;
    __builtin_amdgcn_wave_barrier(); asm volatile("s_waitcnt lgkmcnt(0)" ::: "memory");
#pragma unroll
    for (int r = 0; r < 16; ++r) { const int q = crow(r, hi); const float li = 1.0f / wsw[32 + q]; const size_t row = rowbase + q0 + 32 * w + q;
#pragma unroll
        for (int d0 = 0; d0 < 2; ++d0) { const int d = 32 * d0 + r32; const float og = bf2f(Z[row * ZW + ZOG + h * 64 + d]);
            AO[row * DM + h * 64 + d] = (bf16_t)f2bf(o[d0][r] * li * sigmoidf_(og)); } }
    __builtin_amdgcn_wave_barrier();
}

__device__ __forceinline__ float zlerp(const bf16_t* Z, size_t row, bool first, int col, const float* mu) {
    const float z1 = bf2f(Z[row * ZW + ZR + col]); const float z0 = first ? 0.f : bf2f(Z[(row - 1) * ZW + ZR + col]);
    return z1 + (z0 - z1) * mu[col];
}
__device__ __forceinline__ void rwkv_prep_group(KPR P, LAS float* xs  , int grp, int tid  ) {
    const bf16_t* Z = (const bf16_t*)(P.ws + WS_Z);
    const size_t row0 = (size_t)grp * 8;
    for (int tok = 0; tok < 8; ++tok) { const size_t row = row0 + tok; const bool first = (row % SEQ) == 0;
        const float z = zlerp(Z, row, first, RW_W + tid, P.mu);
        xs[tok * 256 + tid] = tid < 64 ? tanhf(z) : (tid < 128 ? z : sigmoidf_(z)); }
    __syncthreads();
    float lw[8][2], la[8][2], lg[8][2];
#pragma unroll
    for (int t = 0; t < 8; ++t)
#pragma unroll
        for (int c = 0; c < 2; ++c) { lw[t][c] = 0.f; la[t][c] = 0.f; lg[t][c] = 0.f; }
    for (int j = 0; j < 64; ++j) { const float w0 = P.w2[j * 512 + tid], w1 = P.w2[j * 512 + tid + 256], a0 = P.a2[j * 512 + tid], a1 = P.a2[j * 512 + tid + 256];
#pragma unroll
        for (int t = 0; t < 8; ++t) { const float xw = xs[t * 256 + j], xa = xs[t * 256 + 64 + j]; lw[t][0] += xw * w0; lw[t][1] += xw * w1; la[t][0] += xa * a0; la[t][1] += xa * a1; } }
    for (int j = 0; j < 128; ++j) { const float g0 = P.g2[j * 512 + tid], g1 = P.g2[j * 512 + tid + 256];
#pragma unroll
        for (int t = 0; t < 8; ++t) { const float xg = xs[t * 256 + 128 + j]; lg[t][0] += xg * g0; lg[t][1] += xg * g1; } }
    bf16_t* RR = (bf16_t*)(P.ws + WS_RR); bf16_t* RK = (bf16_t*)(P.ws + WS_RK); bf16_t* RV = (bf16_t*)(P.ws + WS_RV); bf16_t* RG = (bf16_t*)(P.ws + WS_RG);
    float* RLW = (float*)(P.ws + WS_RLW); bf16_t* RKK = (bf16_t*)(P.ws + WS_RKK); bf16_t* RKA = (bf16_t*)(P.ws + WS_RKA);
#pragma unroll
    for (int t = 0; t < 8; ++t) { const size_t row = row0 + t; const bool first = (row % SEQ) == 0;
#pragma unroll
        for (int c = 0; c < 2; ++c) { const int cc = tid + 256 * c;
            const float zr = zlerp(Z, row, first, RW_R + cc, P.mu), zk = zlerp(Z, row, first, RW_K + cc, P.mu), zv = zlerp(Z, row, first, RW_V + cc, P.mu);
            const float wl = P.w0[cc] + lw[t][c]; const float sp = fmaxf(-wl, 0.f) + log1pf(expf(-fabsf(wl)));
            const float logdecay = -expf(-sp - 0.5f);
            const float a = sigmoidf_(P.a0[cc] + la[t][c]);
            const float kkr = zk * P.k_k[cc]; const float ss = wave_sum(kkr * kkr); const float kk = kkr / fmaxf(sqrtf(ss), 1e-12f);
            const float kp = zk * (1.0f + (a - 1.0f) * P.k_a[cc]);
            const size_t o = row * 512 + cc;
            RR[o] = (bf16_t)f2bf(zr); RK[o] = (bf16_t)f2bf(kp); RV[o] = (bf16_t)f2bf(zv); RG[o] = (bf16_t)f2bf(lg[t][c]); RLW[o] = logdecay; RKK[o] = (bf16_t)f2bf(kk); RKA[o] = (bf16_t)f2bf(kk * a); } }
    __syncthreads();
}
struct ScanOps { u32x2 r4, k4, kk4, ka4; f32x4 lw4; unsigned short v; };
__device__ __forceinline__ void rwkv_scan_unit(KPR P, int unit, int tid  ) {
    const bf16_t* RR = (const bf16_t*)(P.ws + WS_RR); const bf16_t* RK = (const bf16_t*)(P.ws + WS_RK); const bf16_t* RV = (const bf16_t*)(P.ws + WS_RV);
    const float* RLW = (const float*)(P.ws + WS_RLW); const bf16_t* RKK = (const bf16_t*)(P.ws + WS_RKK); const bf16_t* RKA = (const bf16_t*)(P.ws + WS_RKA);
    float* Y = (float*)(P.ws + WS_X1);
    const int bh = unit >> 2, rg = unit & 3, b = bh >> 3, h = bh & 7, vrow = rg * 16 + (tid >> 4), cg = tid & 15;
    float S[4] = {0.f, 0.f, 0.f, 0.f};
    const size_t o0 = ((size_t)b * SEQ) * 512 + h * 64;
#define SCAN_LOAD(dst, t_) do { const size_t o_ = o0 + (size_t)(t_) * 512; dst.r4 = *(const u32x2*)(RR + o_ + 4 * cg); dst.k4 = *(const u32x2*)(RK + o_ + 4 * cg); dst.kk4 = *(const u32x2*)(RKK + o_ + 4 * cg); \
        dst.ka4 = *(const u32x2*)(RKA + o_ + 4 * cg); dst.lw4 = *(const f32x4*)(RLW + o_ + 4 * cg); dst.v = RV[o_ + vrow]; } while (0)
#define SCAN_STEP(src, t_) do { const float r[4] = {bflo(src.r4.x), bfhi(src.r4.x), bflo(src.r4.y), bfhi(src.r4.y)}, k[4] = {bflo(src.k4.x), bfhi(src.k4.x), bflo(src.k4.y), bfhi(src.k4.y)}; \
        const float kk[4] = {bflo(src.kk4.x), bfhi(src.kk4.x), bflo(src.kk4.y), bfhi(src.kk4.y)}, ka[4] = {bflo(src.ka4.x), bfhi(src.ka4.x), bflo(src.ka4.y), bfhi(src.ka4.y)}; const float v = bf2f(src.v); \
        float sa = -(S[0] * kk[0] + S[1] * kk[1] + S[2] * kk[2] + S[3] * kk[3]); \
        sa += __shfl_xor(sa, 1); sa += __shfl_xor(sa, 2); sa += __shfl_xor(sa, 4); sa += __shfl_xor(sa, 8); \
        float y = 0.f; \
        _Pragma("unroll") for (int c = 0; c < 4; ++c) { S[c] = S[c] * __expf(src.lw4[c]) + sa * ka[c] + v * k[c]; y += S[c] * r[c]; } \
        y += __shfl_xor(y, 1); y += __shfl_xor(y, 2); y += __shfl_xor(y, 4); y += __shfl_xor(y, 8); \
        if (cg == 0) Y[o0 + (size_t)(t_) * 512 + vrow] = y; } while (0)
    ScanOps q0, q1, q2, q3;
    SCAN_LOAD(q0, 0); SCAN_LOAD(q1, 1); SCAN_LOAD(q2, 2); SCAN_LOAD(q3, 3);
    for (int t = 0; t < SEQ; t += 4) {
        const int tn = (t + 4 < SEQ) ? t + 4 : t;
        SCAN_STEP(q0, t);     SCAN_LOAD(q0, tn);
        SCAN_STEP(q1, t + 1); SCAN_LOAD(q1, tn + 1);
        SCAN_STEP(q2, t + 2); SCAN_LOAD(q2, tn + 2);
        SCAN_STEP(q3, t + 3); SCAN_LOAD(q3, tn + 3);
    }
#undef SCAN_LOAD
#undef SCAN_STEP
}
__device__ __forceinline__ void rwkv_post_item(KPR P, size_t gw, int lane) {
    const bf16_t* RR = (const bf16_t*)(P.ws + WS_RR); const bf16_t* RK = (const bf16_t*)(P.ws + WS_RK); const bf16_t* RV = (const bf16_t*)(P.ws + WS_RV); const bf16_t* RG = (const bf16_t*)(P.ws + WS_RG);
    const float* Y = (const float*)(P.ws + WS_X1); bf16_t* AO = (bf16_t*)(P.ws + WS_AO);
    const size_t tok = gw >> 3; const int h = (int)(gw & 7), cc = h * 64 + lane; const size_t o = tok * 512 + cc;
    const float y = Y[o], mean = wave_sum(y) * (1.f / 64.f), d = y - mean, var = wave_sum(d * d) * (1.f / 64.f);
    const float yn = d * rsqrtf(var + 64e-5f) * P.ln_w[cc] + P.ln_b[cc];
    const float r = bf2f(RR[o]), k = bf2f(RK[o]), v = bf2f(RV[o]), g = bf2f(RG[o]);
    const float bonus = wave_sum(r * k * P.r_k[cc]) * v;
    AO[tok * DM + 512 + cc] = (bf16_t)f2bf((yn + bonus) * g);
}
__device__ __forceinline__ float rdlane(float v, int l) { unsigned r; asm volatile("s_nop 3\n\tv_readlane_b32 %0, %1, %2\n\ts_nop 3" : "=s"(r) : "v"(v), "s"(l)); return __builtin_bit_cast(float, r); }
__device__ __forceinline__ void route_row(KPR P, const LAS float* wr, int row, int lane) {
    unsigned* cnt = (unsigned*)(P.ws + WS_CTL) + CW_CNT; int* route = (int*)(P.ws + WS_ROUTE); int* tokslot = (int*)(P.ws + WS_TOKSLOT); float* gateslot = (float*)(P.ws + WS_GATESLOT);
    f32x4 v[4]; rms_row((const float*)(P.ws + WS_X1) + (size_t)row * DM, P.moe_norm, lane, v);
    store_row_bf16((bf16_t*)(P.ws + WS_XN) + (size_t)row * DM, lane, v);
    const int e = lane & 31;
    float acc = 0.f;
#pragma unroll
    for (int j = 0; j < 4; ++j)
_Pragma("nounroll")
        for (int l = 0; l < 64; ++l) {
            const float x0 = rdlane(v[j][0], l), x1 = rdlane(v[j][1], l), x2 = rdlane(v[j][2], l), x3 = rdlane(v[j][3], l);
            const int k = 256 * j + 4 * l;
            acc += x0 * wr[k * 32 + e]; acc += x1 * wr[(k + 1) * 32 + e]; acc += x2 * wr[(k + 2) * 32 + e]; acc += x3 * wr[(k + 3) * 32 + e];
        }
    float logit = acc + P.b_router[e];
    float tv[4]; int ti[4];
#pragma unroll
    for (int k = 0; k < 4; ++k) { float bv = logit; int bi = e;
#pragma unroll
        for (int o = 1; o < 32; o <<= 1) { const float ov = __shfl_xor(bv, o); const int oi = __shfl_xor(bi, o); if (ov > bv || (ov == bv && oi < bi)) { bv = ov; bi = oi; } }
        tv[k] = bv; ti[k] = bi; if (e == bi) logit = -INFINITY; }
    const float e0 = 1.f, e1 = expf(tv[1] - tv[0]), e2 = expf(tv[2] - tv[0]), e3 = expf(tv[3] - tv[0]), inv = 1.f / (e0 + e1 + e2 + e3);
    const float gt[4] = {e0 * inv, e1 * inv, e2 * inv, e3 * inv};
    if (lane < 4) { float g = gt[0]; int ex = ti[0];
#pragma unroll
        for (int k = 1; k < 4; ++k) { g = (lane == k) ? gt[k] : g; ex = (lane == k) ? ti[k] : ex; }
        const int rank = (int)atomicAdd(cnt + ex, 1u);
        tokslot[(size_t)ex * NTOK + rank] = row; gateslot[(size_t)ex * NTOK + rank] = g;
        route[(size_t)row * 12 + lane] = ex; route[(size_t)row * 12 + 4 + lane] = rank; }
}
__device__ __forceinline__ void combine_row(KPR P, const LAS int* tab, int row, int lane) {
    const int* route = (const int*)(P.ws + WS_ROUTE); const bf16_t* YP = (const bf16_t*)(P.ws + WS_YP); float* X = (float*)(P.ws + WS_X1);
    f32x4 v[4]; const f32x4* xr = (const f32x4*)(X + (size_t)row * DM) + lane;
#pragma unroll
    for (int j = 0; j < 4; ++j) v[j] = xr[64 * j];
#pragma unroll
    for (int k = 0; k < 4; ++k) { const int ex = route[(size_t)row * 12 + k], rank = route[(size_t)row * 12 + 4 + k]; const size_t pos = (size_t)tab[pg8::T_BLKSTART + ex] * 256 + rank;
        const u32x2* yr = (const u32x2*)(YP + pos * DM) + lane;
#pragma unroll
        for (int j = 0; j < 4; ++j) { const u32x2 y = yr[64 * j]; v[j][0] += bflo(y.x); v[j][1] += bfhi(y.x); v[j][2] += bflo(y.y); v[j][3] += bfhi(y.y); } }
    f32x4* xo = (f32x4*)(X + (size_t)row * DM) + lane; float s = 0.f;
#pragma unroll
    for (int j = 0; j < 4; ++j) { xo[64 * j] = v[j]; s += (v[j][0] * v[j][0] + v[j][1] * v[j][1]) + (v[j][2] * v[j][2] + v[j][3] * v[j][3]); }
    const float rstd = rsqrtf(wave_sum(s) * (1.f / DM) + 1e-6f);
#pragma unroll
    for (int j = 0; j < 4; ++j) v[j] = v[j] * rstd * ((const f32x4*)P.ple_norm)[64 * j + lane];
    store_row_bf16((bf16_t*)(P.ws + WS_XN) + (size_t)row * DM, lane, v);
}

__global__ void __launch_bounds__(NTHREADS, 2) mega_fwd(Params Pkarg_unused) {
    extern __shared__ __attribute__((aligned(16))) unsigned char smem[];
    LAS unsigned char* lds = (LAS unsigned char*)smem;
    const int tid = threadIdx.x, lane = tid & 63, wave = __builtin_amdgcn_readfirstlane(tid >> 6);
    const int G = gridDim.x, blk = blockIdx.x;
#define P (*kpe)
    const __attribute__((address_space(4))) Params* kpe = kp_fresh();
    unsigned* ctl = (unsigned*)(P.ws + WS_CTL);
    volatile LAS unsigned* MISC = (volatile LAS unsigned*)(lds + MISC_OFF);
    LAS int* tab = (LAS int*)(lds + MISC_OFF + MISC_TAB);
    if (tid < 16) MISC[tid] = 0u;
    __syncthreads();
    XcdBarrier bar = xcd_barrier_post(ctl + CW_BAR, MISC);
    unsigned char* const wsb = P.ws;
    const int ph_lo = P.ph_lo, ph_hi = P.ph_hi;
#define IN(k) (ph_lo <= (k) && (k) < ph_hi)
#define BOTH(k) (IN(k) && IN((k) + 1))

    if (IN(0)) {
#undef P
#define P (*kp0)
    const __attribute__((address_space(4))) Params* kp0 = kp_fresh();
    phase_prep_weights(P, lds, blk * NWAVES + wave, G * NWAVES, wave, lane);
    phase_cvt_p(P, blk * NTHREADS + tid, G * NTHREADS);
    __syncthreads();
    {
        LAS float* wff = (LAS float*)lds; LAS float* lf = (LAS float*)(lds + 32768);
        load_wff(P, wff, tid, NTHREADS); __syncthreads();
        for (int i = 0; i < 16; ++i) { const int rl = wave * 16 + i; norm1_row(P, blk * 128 + rl, lane, wff, lf + rl * 8); }
        __syncthreads();
        if (tid < 8) { float run = 0.f; float* cloc = (float*)(P.ws + WS_LOGF) + (size_t)blk * 128 * 8 + tid;
            for (int r = 0; r < 128; ++r) { run += lf[r * 8 + tid]; cloc[r * 8] = run; }
            ((float*)(P.ws + WS_CTOT))[blk * 8 + tid] = run; }
        if (blk == 0) { bf16_t* zr = (bf16_t*)(P.ws + WS_XN) + (size_t)NTOK * DM; for (int i = tid; i < DM; i += NTHREADS) zr[i] = 0; }
    }
    }
    if (BOTH(0)) xcd_barrier(bar);

    if (IN(1)) {
#undef P
#define P (*kp1)
    const __attribute__((address_space(4))) Params* kp1 = kp_fresh();
    {
        LAS float* pfx = (LAS float*)(lds + MISC_OFF + MISC_PFX);
        if (tid < 8) { float s = 0.f; const float* ct = (const float*)(wsb + WS_CTOT); for (int j = (blk & ~63); j < blk; ++j) s += ct[j * 8 + tid]; pfx[tid] = s; }
        __syncthreads();
        const float* cloc = (const float*)(wsb + WS_LOGF) + (size_t)blk * 128 * 8; float* c2 = (float*)(P.ws + WS_C2);
        for (int i = tid; i < 1024; i += NTHREADS) { const int r = i >> 3, h = i & 7; const int row = blk * 128 + r, b = row >> 13, t = row & (SEQ - 1);
            c2[((size_t)(b * 8 + h)) * SEQ + t] = (cloc[i] + pfx[h]) * LOG2E; }
        __syncthreads();
    }
    {
        pg8::DenseOrder S{(const bf16_t*)(wsb + WS_XN), (const bf16_t*)(wsb + WS_WIN), 1024, NTOK / 256, ZW / 256, G, blk};
        pg8::EpiIn E{(bf16_t*)(P.ws + WS_Z), P.q_norm, P.k_norm};
        pg8::gemm_phase<pg8::EpiIn, pg8::DenseOrder, true>(lds, 1024, S, E);
    }
    {
        pg8::DenseOrder S{(const bf16_t*)((unsigned char*)P.out + DO_PB), (const bf16_t*)(wsb + WS_WPP), PLE, NTOK / 256, DM / 256, G, blk};
        pg8::EpiBf16 E{(bf16_t*)((unsigned char*)P.out + DO_PJ), DM};
        pg8::gemm_phase<pg8::EpiBf16, pg8::DenseOrder, true>(lds, PLE, S, E);
    }
    }
    if (BOTH(1)) xcd_barrier(bar);

    if (IN(2)) {
#undef P
#define P (*kp2)
    const __attribute__((address_space(4))) Params* kp2 = kp_fresh();
    {
        const int sub = tid >> 8, st = tid & 255; LAS float* xs = (LAS float*)(lds + sub * 8192);
        for (int it = 0; it < NTOK / 8 / (2 * 256); ++it) rwkv_prep_group(P, xs, (it * G + blk) * 2 + sub, st);
    }
    }
    if (BOTH(2)) xcd_barrier(bar);

    if (IN(3)) {
#undef P
#define P (*kp3)
    const __attribute__((address_space(4))) Params* kp3 = kp_fresh();
    if (blk < 64) rwkv_scan_unit(P, blk * 2 + (tid >> 8), tid & 255);
    for (;;) {
        __syncthreads();
        if (tid == 0) MISC[MISC_Q / 4] = __hip_atomic_fetch_add(ctl + CW_QATT, 1u, RLX_AGENT);
        __syncthreads();
        const int q = (int)MISC[MISC_Q / 4];
        if (q >= 1024) break;
        attn_unit_v2(P, lds, q & 31, 31 - (q >> 5));
    }
    }
    if (BOTH(3)) xcd_barrier(bar);

    if (IN(4)) {
#undef P
#define P (*kp4)
    const __attribute__((address_space(4))) Params* kp4 = kp_fresh();
    for (size_t gw = (size_t)blk * NWAVES + wave; gw < (size_t)NTOK * 8; gw += (size_t)G * NWAVES) rwkv_post_item(P, gw, lane);
    }
    if (BOTH(4)) xcd_barrier(bar);

    if (IN(5)) {
#undef P
#define P (*kp5)
    const __attribute__((address_space(4))) Params* kp5 = kp_fresh();
    {
        pg8::DenseOrder S{(const bf16_t*)(wsb + WS_AO), (const bf16_t*)(wsb + WS_WOUT), 1024, NTOK / 256, DM / 256, G, blk};
        pg8::EpiOut E{P.x, (float*)(P.ws + WS_X1)};
        pg8::gemm_phase<pg8::EpiOut, pg8::DenseOrder, true>(lds, 1024, S, E);
    }
    }
    if (BOTH(5)) xcd_barrier(bar);

    if (IN(6)) {
#undef P
#define P (*kp6)
    const __attribute__((address_space(4))) Params* kp6 = kp_fresh();
    {
        LAS float* wr = (LAS float*)lds;
        for (int i = tid; i < 1024 * 32; i += NTHREADS) wr[i] = P.w_router[i];
        __syncthreads();
        for (int row = blk * NWAVES + wave; row < NTOK; row += G * NWAVES) route_row(P, wr, row, lane);
    }
    }
    if (BOTH(6)) xcd_barrier(bar);

    if (IN(7)) {
#undef P
#define P (*kp7)
    const __attribute__((address_space(4))) Params* kp7 = kp_fresh();
    const int nblk = pg8::moe_tables(tab, (const unsigned*)(wsb + WS_CTL) + CW_CNT);
    {
        pg8::MoeOrder S{(const bf16_t*)(wsb + WS_XN), (const bf16_t*)(wsb + WS_WGU), (const int*)(wsb + WS_TOKSLOT), tab, nblk, 8, G, blk, true};
        pg8::EpiGu E{(bf16_t*)(P.ws + WS_ACT), P.b_gu};
        pg8::gemm_phase<pg8::EpiGu, pg8::MoeOrder, true>(lds, 1024, S, E);
    }
    }
    if (BOTH(7)) xcd_barrier(bar);
    if (IN(8)) {
#undef P
#define P (*kp8)
    const __attribute__((address_space(4))) Params* kp8 = kp_fresh();
    const int nblk = pg8::moe_tables(tab, (const unsigned*)(wsb + WS_CTL) + CW_CNT);
    {
        pg8::MoeOrder S{(const bf16_t*)(wsb + WS_ACT), (const bf16_t*)(wsb + WS_WDN), (const int*)(wsb + WS_TOKSLOT), tab, nblk, 4, G, blk, false};
        pg8::EpiDn E{(bf16_t*)(P.ws + WS_YP), P.b_down, (const float*)(wsb + WS_GATESLOT), tab};
        pg8::gemm_phase<pg8::EpiDn, pg8::MoeOrder, true>(lds, 1024, S, E);
    }
    }
    if (BOTH(8)) xcd_barrier(bar);
    if (IN(9)) {
#undef P
#define P (*kp9)
    const __attribute__((address_space(4))) Params* kp9 = kp_fresh();
    (void)pg8::moe_tables(tab, (const unsigned*)(wsb + WS_CTL) + CW_CNT);
    for (int row = blk * NWAVES + wave; row < NTOK; row += G * NWAVES) combine_row(P, tab, row, lane);
    }
    if (BOTH(9)) xcd_barrier(bar);
    if (IN(10)) {
#undef P
#define P (*kp10)
    const __attribute__((address_space(4))) Params* kp10 = kp_fresh();
    {
        pg8::DenseOrder S{(const bf16_t*)(wsb + WS_XN), (const bf16_t*)(wsb + WS_WPG), 1024, NTOK / 256, DM / 256, G, blk};
        pg8::EpiPg E{(float*)(P.ws + WS_X1), (const bf16_t*)((unsigned char*)P.out + DO_PJ)};
        pg8::gemm_phase<pg8::EpiPg, pg8::DenseOrder, true>(lds, 1024, S, E);
    }
    }
    if (BOTH(10)) xcd_barrier(bar);
    if (IN(11)) {
#undef P
#define P (*kp11)
    const __attribute__((address_space(4))) Params* kp11 = kp_fresh();
    const bool dead = __hip_atomic_load(ctl + CW_BAR + XB_TMO, RLX_AGENT) != 0u;
    for (int row = blk * NWAVES + wave; row < NTOK; row += G * NWAVES) final_row(P, row, lane, dead);

    }
}
#undef P
extern "C" void kernel_launch(void* const* d_in, const int* in_sizes, int n_in, void* d_out, int out_size, void* d_ws, size_t ws_size, hipStream_t stream) {
    static int ok = 0;
    if (ok == 0) {
        if (n_in != 30 || in_sizes[0] != NTOK * DM || out_size != NTOK * DM || ws_size < WS_END) { fprintf(stderr, "kernel_launch: unexpected shapes (n_in %d, ws %zu)\n", n_in, ws_size); ok = -1; return; }
        if (hipFuncSetAttribute((const void*)mega_fwd, hipFuncAttributeMaxDynamicSharedMemorySize, LDS_BYTES) != hipSuccess) { fprintf(stderr, "kernel_launch: hipFuncSetAttribute failed\n"); ok = -1; return; }
        int dev = 0, cus = 0, per_cu = 0;
        if (hipGetDevice(&dev) != hipSuccess || hipDeviceGetAttribute(&cus, hipDeviceAttributeMultiprocessorCount, dev) != hipSuccess) { ok = -1; return; }
        if (hipOccupancyMaxActiveBlocksPerMultiprocessor(&per_cu, (const void*)mega_fwd, NTHREADS, LDS_BYTES) != hipSuccess || per_cu < 1) { fprintf(stderr, "kernel_launch: occupancy query says %d\n", per_cu); }
        (void)hipGetLastError();
        if (cus != 256) { fprintf(stderr, "kernel_launch: built for 256 CUs, device has %d\n", cus); ok = -1; return; }
        ok = 1;
    }
    if (ok < 0) return;
    Params P{};
    const float** pp = (const float**)&P;
    for (int i = 0; i < 30; ++i) pp[i] = (const float*)d_in[i];
    P.out = (float*)d_out; P.ws = (unsigned char*)d_ws;
    if (hipMemsetAsync((char*)d_ws + WS_CTL, 0, CTL_BYTES, stream) != hipSuccess) return;
#ifndef MK_CUTS
#define MK_CUTS 0
#endif
    if (MK_CUTS == 0) { P.ph_lo = 0; P.ph_hi = 12; hipLaunchKernelGGL(mega_fwd, dim3(256), dim3(NTHREADS), LDS_BYTES, stream, P); }
    else for (int k = 0; k < 12; ++k) { P.ph_lo = k; P.ph_hi = k + 1;
#if MK_CUTS == 2
        if (k == 2) { hipLaunchKernelGGL(v1k::k_attn_v1, dim3(2048), dim3(256), 0, stream, P); hipLaunchKernelGGL(v1k::k_rwkv_prep, dim3(NTOK / 8), dim3(256), 0, stream, P); hipLaunchKernelGGL(v1k::k_rwkv_scan, dim3(128), dim3(256), 0, stream, P); hipLaunchKernelGGL(v1k::k_rwkv_post, dim3(NTOK * 8 / 4), dim3(256), 0, stream, P); }
        if (k >= 2 && k <= 4) continue;
#endif
#if MK_CUTS == 3
        if (k == 2) { hipLaunchKernelGGL(v1k::k_attn_v1, dim3(2048), dim3(256), 0, stream, P); hipLaunchKernelGGL(v1k::k_rwkv_prep, dim3(NTOK / 8), dim3(256), 0, stream, P); hipLaunchKernelGGL(v1k::k_rwkv_scan, dim3(128), dim3(256), 0, stream, P); hipLaunchKernelGGL(v1k::k_rwkv_post, dim3(NTOK * 8 / 4), dim3(256), 0, stream, P); }
        if (k >= 2 && k <= 4) continue;
        if (k == 6) { hipFuncSetAttribute((const void*)v1k::k_norm2_route, hipFuncAttributeMaxDynamicSharedMemorySize, LDS_BYTES); hipLaunchKernelGGL(v1k::k_norm2_route, dim3(256), dim3(256), LDS_BYTES, stream, P); continue; }
        if (k == 9) { hipLaunchKernelGGL(v1k::k_combine_norm3, dim3(1024), dim3(256), 0, stream, P); continue; }
#endif
        hipLaunchKernelGGL(mega_fwd, dim3(256), dim3(NTHREADS), LDS_BYTES, stream, P); }
}
```

```cpp
#include <hip/hip_runtime.h>
#include <cstdio>
#include <cstdint>

#define LAS __attribute__((address_space(3)))
#define GAS __attribute__((address_space(1)))
typedef unsigned short bf16_t;
typedef short bf16x8 __attribute__((ext_vector_type(8)));
typedef float f32x2 __attribute__((ext_vector_type(2)));
typedef float f32x4 __attribute__((ext_vector_type(4)));
typedef float f32x16 __attribute__((ext_vector_type(16)));
typedef unsigned u32x2 __attribute__((ext_vector_type(2)));
typedef unsigned u32x4 __attribute__((ext_vector_type(4)));

constexpr int NB = 4, SEQ = 8192, NTOK = NB * SEQ, DM = 1024;
constexpr int NH = 8, HD = 64;
constexpr int INW = 3848;
constexpr int ZW = 3840;
constexpr int ZQ = 0, ZK = 512, ZV = 1024, ZOG = 1536, ZR = 2048;
constexpr int RW_R = 0, RW_K = 512, RW_V = 1024, RW_W = 1536, RW_A = 1600, RW_G = 1664, RWIN = 1792;
constexpr int NE = 32, TOPK = 4, EFF = 1024;
constexpr int MAXBLK = (NTOK * TOPK) / 256 + NE;
constexpr int PLE = 256;
constexpr float LOG2E = 1.4426950408889634f;
constexpr float QSCALE = 0.125f * LOG2E;

constexpr size_t MiB = 1u << 20;
constexpr size_t WS_CTL = 0, CTL_BYTES = 1 * MiB;
constexpr size_t WS_C2 = 1 * MiB;
constexpr size_t WS_LOGF = 2 * MiB;
constexpr size_t WS_ROUTE = 3 * MiB;
constexpr size_t WS_TOKSLOT = 5 * MiB;
constexpr size_t WS_GATESLOT = 9 * MiB;
constexpr size_t WS_CTOT = 13 * MiB;
constexpr size_t WS_WIN = 16 * MiB;
constexpr size_t WS_WOUT = 24 * MiB;
constexpr size_t WS_WPG = 26 * MiB;
constexpr size_t WS_WPP = 28 * MiB;
constexpr size_t WS_WGU = 32 * MiB;
constexpr size_t WS_WDN = 160 * MiB;
constexpr size_t WS_XN = 224 * MiB;
constexpr size_t WS_X1 = 290 * MiB;
constexpr size_t WS_Z = 418 * MiB;
constexpr size_t WS_AO = 658 * MiB;
constexpr size_t WS_ACT = 418 * MiB;
constexpr size_t WS_RW = 722 * MiB;
constexpr size_t WS_RR = WS_RW, WS_RK = WS_RW + 32 * MiB, WS_RV = WS_RW + 64 * MiB, WS_RG = WS_RW + 96 * MiB;
constexpr size_t WS_RLW = WS_RW + 128 * MiB;
constexpr size_t WS_RKK = WS_RW + 160 * MiB, WS_RKA = WS_RW + 192 * MiB;
constexpr size_t WS_YP = 722 * MiB;
constexpr size_t WS_END = 994 * MiB;
static_assert(WS_ACT + (size_t)MAXBLK * 256 * 1024 * 2 <= WS_RW && WS_YP + (size_t)MAXBLK * 256 * 1024 * 2 <= WS_END, "ws map");
constexpr size_t DO_PJ = 0, DO_PB = 64 * MiB;
constexpr int CW_TMO = 0, CW_CNT = 64  , CW_BAR = 4096;

struct Params {
    const float *x, *p, *mix_norm, *w_in, *f_bias, *q_norm, *k_norm, *mu, *w0, *w2, *a0, *a2, *g2, *k_k, *k_a, *r_k, *ln_w, *ln_b, *w_out, *moe_norm, *w_router, *b_router, *w_gu, *b_gu, *w_down,
        *b_down, *ple_norm, *w_pg, *w_pp, *final_norm;
    float* out; unsigned char* ws; int ph_lo, ph_hi;
};

typedef const __attribute__((address_space(4))) Params& KPR;
__device__ __forceinline__ const __attribute__((address_space(4))) Params* kp_fresh() {
    unsigned long long p = (unsigned long long)__builtin_amdgcn_kernarg_segment_ptr(); asm volatile("" : "+s"(p)); return (const __attribute__((address_space(4))) Params*)p; }

__device__ __forceinline__ unsigned f2bf(float f) { unsigned u = __builtin_bit_cast(unsigned, f); return (u + 0x7fffu + ((u >> 16) & 1u)) >> 16; }
__device__ __forceinline__ unsigned pk2(float lo, float hi) { return f2bf(lo) | (f2bf(hi) << 16); }
__device__ __forceinline__ float bf2f(unsigned h) { return __builtin_bit_cast(float, h << 16); }
__device__ __forceinline__ float bflo(unsigned w) { return __builtin_bit_cast(float, w << 16); }
__device__ __forceinline__ float bfhi(unsigned w) { return __builtin_bit_cast(float, w & 0xffff0000u); }
__device__ __forceinline__ unsigned cvt_pk_bf16(float lo, float hi) { unsigned r; asm volatile("v_cvt_pk_bf16_f32 %0, %1, %2" : "=v"(r) : "v"(lo), "v"(hi)); return r; }
__device__ __forceinline__ float wave_sum(float v) {
#pragma unroll
    for (int o = 1; o < 64; o <<= 1) v += __shfl_xor(v, o);
    return v;
}
__device__ __forceinline__ float sigmoidf_(float x) { return 1.0f / (1.0f + __expf(-x)); }
__device__ __forceinline__ float logsigmoidf_(float x) { return fminf(x, 0.f) - log1pf(expf(-fabsf(x))); }
namespace pg8 {
constexpr int BM = 256, BK = 64, HALF = 128, HTB = HALF * BK * 2, STAGE_BYTES = 8 * HTB, NXCD = 8, WGM = 8;
__host__ __device__ __forceinline__ int lds_byte(int r, int c) { const int st = (r >> 4) * 2 + (c >> 5), rr = r & 15, cc = c & 31, ob = rr * 64 + cc * 2; return st * 1024 + (ob ^ (((ob >> 9) & 1) << 5)); }
__host__ __device__ __forceinline__ void stage_rc(int b, int& R, int& C) { const int st = b / 1024, sb = b % 1024, swz = sb ^ (((sb >> 9) & 1) << 5); R = (st >> 1) * 16 + swz / 64; C = (st & 1) * 32 + (swz % 64) / 2; }
__host__ __device__ __forceinline__ int perm32(int rho) { const int n = rho >> 4, i = rho & 15; return 8 * (i >> 2) + 4 * n + (i & 3); }

struct Unit { int pm, pn, e, lb; };

__device__ __forceinline__ bool tile_order(int i, int G, int c, int nM, int nN, int& pm, int& pn) {
    const int nwg = nM * nN; const long L = (long)i * G + c; if (L >= nwg) return false;
    int wgid = (int)L; { const int q = nwg / NXCD, r = nwg % NXCD, xcd = wgid % NXCD, off = wgid / NXCD; wgid = (xcd < r ? xcd * (q + 1) : r * (q + 1) + (xcd - r) * q) + off; }
    const int nig = WGM * nN, gid = wgid / nig, fm = gid * WGM, gsz = (nM - fm) < WGM ? (nM - fm) : WGM;
    pm = fm + ((wgid % nig) % gsz); pn = (wgid % nig) / gsz; return true;
}
struct DenseOrder {
    const bf16_t* A; const bf16_t* Bt; int K, nM, nN, G, c;
    __device__ __forceinline__ bool next(int i, Unit& u) const { u.e = 0; u.lb = 0; return tile_order(i, G, c, nM, nN, u.pm, u.pn); }
    __device__ __forceinline__ const char* a_base(const Unit& u) const { return (const char*)A + (size_t)u.pm * BM * K * 2; }
    __device__ __forceinline__ const char* b_base(const Unit& u) const { return (const char*)Bt + (size_t)u.pn * BM * K * 2; }
    __device__ __forceinline__ void a_off(const Unit&, const int (&R)[2], const int (&C)[2], unsigned (&off)[2][2]) const {
#pragma unroll
        for (int h = 0; h < 2; ++h)
#pragma unroll
            for (int i = 0; i < 2; ++i) off[h][i] = (unsigned)((R[i] + HALF * h) * K + C[i]) * 2u;
    }
};

template <class Epi, class Sched, bool ALIGN_EPI>
__device__ __forceinline__ void gemm_phase(LAS unsigned char* lds, const int K, const Sched& S, const Epi& E) {
    int tid_ = threadIdx.x; asm volatile("" : "+v"(tid_));
    const int tid = tid_, wid = __builtin_amdgcn_readfirstlane(tid >> 6), lane = tid & 63, wr = wid >> 2, wc = wid & 3, fr = lane & 15, fq = lane >> 4;
    const int nt = K / BK;
    int sR[2], sC[2]; unsigned voffB[2];
#pragma unroll
    for (int i = 0; i < 2; ++i) { int R, C; stage_rc(tid * 16 + i * 8192, R, C); const int Rb = Epi::PERM ? ((R & ~31) + perm32(R & 31)) : R; sR[i] = R; sC[i] = C; voffB[i] = (unsigned)(Rb * K + C) * 2u; }
    const size_t kstep = (size_t)(BK * 2);
    const size_t hstep = (size_t)HALF * K * 2;
    const unsigned ldsw = (unsigned)wid * 1024u;
    const int aoff = lds_byte(wr * 64 + fr, fq * 8), boff = lds_byte(wc * 32 + fr, fq * 8);
#define PG8_SA(b, h) (((b) * 2 + (h)) * HTB)
#define PG8_SB(b, h) ((4 + (b) * 2 + (h)) * HTB)
#define PG8_STAGE(bufoff, gbase, voff) do { _Pragma("unroll") for (int _i = 0; _i < 2; ++_i) \
        __builtin_amdgcn_global_load_lds((const unsigned*)((const char*)(gbase) + (voff)[_i]), (LAS unsigned*)(lds + (bufoff) + ldsw + _i * 8192), 16, 0, 0); } while (0)
#define PG8_LDA(dst, b, h) do { _Pragma("unroll") for (int m = 0; m < 4; ++m) _Pragma("unroll") for (int k = 0; k < 2; ++k) dst[m][k] = *(const LAS bf16x8*)(lds + PG8_SA(b, h) + aoff + m * 2048 + k * 1024); } while (0)
#define PG8_LDB(dst, b, h) do { _Pragma("unroll") for (int n = 0; n < 2; ++n) _Pragma("unroll") for (int k = 0; k < 2; ++k) dst[n][k] = *(const LAS bf16x8*)(lds + PG8_SB(b, h) + boff + n * 2048 + k * 1024); } while (0)
#define PG8_MMA(ai, bj, At, Bt) do { __builtin_amdgcn_s_setprio(1); _Pragma("unroll") for (int m = 0; m < 4; ++m) _Pragma("unroll") for (int n = 0; n < 2; ++n) _Pragma("unroll") for (int k = 0; k < 2; ++k) \
        acc[ai][bj][m][n] = __builtin_amdgcn_mfma_f32_16x16x32_bf16(Bt[n][k], At[m][k], acc[ai][bj][m][n], 0, 0, 0); __builtin_amdgcn_s_setprio(0); } while (0)
#define PG8_WAIT_V(n) asm volatile("s_waitcnt vmcnt(" #n ")" ::: "memory")
#define PG8_WAIT_L(n) asm volatile("s_waitcnt lgkmcnt(" #n ")" ::: "memory")
#define PG8_BAR __builtin_amdgcn_s_barrier()
#define PG8_SCHED __builtin_amdgcn_sched_barrier(0)
    Unit cur, nxt; int ui = 0;
    if (!S.next(0, cur)) return;
    f32x4 acc[2][2][4][2];
#pragma unroll
    for (int a = 0; a < 2; ++a)
#pragma unroll
        for (int b = 0; b < 2; ++b)
#pragma unroll
            for (int m = 0; m < 4; ++m)
#pragma unroll
                for (int n = 0; n < 2; ++n) acc[a][b][m][n] = (f32x4){0.f, 0.f, 0.f, 0.f};
    bf16x8 At[4][2], B0[2][2], B1[2][2];
    unsigned offC[2][2], offN[2][2];
    S.a_off(cur, sR, sC, offC);
    const char* cA = S.a_base(cur); const char* cB = S.b_base(cur);
    PG8_STAGE(PG8_SB(0, 0), cB, voffB); PG8_STAGE(PG8_SB(0, 1), cB + hstep, voffB); PG8_STAGE(PG8_SA(0, 0), cA, offC[0]); PG8_STAGE(PG8_SA(0, 1), cA, offC[1]);
    if (wr == 1) PG8_BAR;
    PG8_WAIT_V(2); PG8_BAR;
    PG8_STAGE(PG8_SB(1, 0), cB + kstep, voffB); PG8_STAGE(PG8_SA(1, 0), cA + kstep, offC[0]); PG8_STAGE(PG8_SB(1, 1), cB + hstep + kstep, voffB);
    PG8_WAIT_V(6); PG8_BAR;
    for (;;) {
        const bool has_next = S.next(ui + 1, nxt);
        const char* nA = cA; const char* nB = cB;
        if (has_next) { nA = S.a_base(nxt); nB = S.b_base(nxt); S.a_off(nxt, sR, sC, offN); }
        else {
#pragma unroll
            for (int h = 0; h < 2; ++h)
#pragma unroll
                for (int i = 0; i < 2; ++i) offN[h][i] = offC[h][i];
        }
#pragma nounroll
        for (int t = 0; t < nt; t += 2) {
            const bool last = (t == nt - 2);
            const char* a1 = cA + (size_t)(t + 1) * kstep;
            const char* a2 = last ? nA : cA + (size_t)(t + 2) * kstep; const char* b2 = last ? nB : cB + (size_t)(t + 2) * kstep;
            const char* a3 = a2 + kstep; const char* b3 = b2 + kstep;
            unsigned o2[2][2];
#pragma unroll
            for (int h = 0; h < 2; ++h)
#pragma unroll
                for (int i = 0; i < 2; ++i) o2[h][i] = last ? offN[h][i] : offC[h][i];
            PG8_LDB(B0, 0, 0); PG8_LDB(B1, 0, 1); PG8_SCHED; PG8_LDA(At, 0, 0); PG8_STAGE(PG8_SA(1, 1), a1, offC[1]);
            PG8_WAIT_V(8); PG8_WAIT_L(0); PG8_BAR; PG8_MMA(0, 0, At, B0); PG8_MMA(0, 1, At, B1); PG8_BAR; PG8_SCHED;
            PG8_LDA(At, 0, 1); PG8_STAGE(PG8_SB(0, 0), b2, voffB); PG8_STAGE(PG8_SB(0, 1), b2 + hstep, voffB); PG8_STAGE(PG8_SA(0, 0), a2, o2[0]);
            PG8_WAIT_V(8); PG8_WAIT_L(0); PG8_BAR; PG8_MMA(1, 0, At, B0); PG8_MMA(1, 1, At, B1); PG8_BAR; PG8_SCHED;
            PG8_LDB(B0, 1, 0); PG8_LDB(B1, 1, 1); PG8_SCHED; PG8_LDA(At, 1, 0); PG8_STAGE(PG8_SA(0, 1), a2, o2[1]);
            PG8_WAIT_V(8); PG8_WAIT_L(0); PG8_BAR; PG8_MMA(0, 0, At, B0); PG8_MMA(0, 1, At, B1); PG8_BAR; PG8_SCHED;
            PG8_LDA(At, 1, 1); PG8_STAGE(PG8_SB(1, 0), b3, voffB); PG8_STAGE(PG8_SB(1, 1), b3 + hstep, voffB); PG8_STAGE(PG8_SA(1, 0), a3, o2[0]);
            PG8_WAIT_V(8); PG8_WAIT_L(0); PG8_BAR; PG8_MMA(1, 0, At, B0); PG8_MMA(1, 1, At, B1); PG8_BAR; PG8_SCHED;
        }
        if constexpr (ALIGN_EPI) { if (wr == 0) PG8_BAR; }
        E(acc, cur, wr, wc, fr, fq);
        if (!has_next) break;
#pragma unroll
        for (int a = 0; a < 2; ++a)
#pragma unroll
            for (int b = 0; b < 2; ++b)
#pragma unroll
                for (int m = 0; m < 4; ++m)
#pragma unroll
                    for (int n = 0; n < 2; ++n) acc[a][b][m][n] = (f32x4){0.f, 0.f, 0.f, 0.f};
        cur = nxt; cA = nA; cB = nB; ++ui;
#pragma unroll
        for (int h = 0; h < 2; ++h)
#pragma unroll
            for (int i = 0; i < 2; ++i) offC[h][i] = offN[h][i];
        if constexpr (ALIGN_EPI) { if (wr == 1) PG8_BAR; }
    }
    PG8_WAIT_V(0);
    if constexpr (!ALIGN_EPI) { if (wr == 0) PG8_BAR; }
    PG8_BAR;
#undef PG8_SA
#undef PG8_SB
#undef PG8_STAGE
#undef PG8_LDA
#undef PG8_LDB
#undef PG8_MMA
#undef PG8_WAIT_V
#undef PG8_WAIT_L
#undef PG8_BAR
#undef PG8_SCHED
}
}
namespace pg8 {
constexpr int T_BLKSTART = 0  , T_CNT = 40  , T_BLKE = 80  , T_WORDS = 80 + 560;

struct EpiIn {
    static constexpr bool PERM = true;
    bf16_t* Z; const float* qn; const float* kn;
    __device__ __forceinline__ void operator()(const f32x4 (&acc)[2][2][4][2], const Unit& u, int wr, int wc, int fr, int fq) const {
        const int row0 = u.pm * BM + wr * 64 + fr;
        if (u.pn < 4) {
            const float* g = (u.pn < 2) ? qn : kn; const float sc = (u.pn < 2) ? QSCALE : 1.0f;
            f32x4 gv[2][2];
#pragma unroll
            for (int bj = 0; bj < 2; ++bj)
#pragma unroll
                for (int n = 0; n < 2; ++n) gv[bj][n] = *(const f32x4*)(g + 32 * bj + 8 * fq + 4 * n) * sc;
#pragma unroll
            for (int ai = 0; ai < 2; ++ai)
#pragma unroll
                for (int m = 0; m < 4; ++m) {
                    float ss = 0.f;
#pragma unroll
                    for (int bj = 0; bj < 2; ++bj)
#pragma unroll
                        for (int n = 0; n < 2; ++n) { const f32x4 x = acc[ai][bj][m][n]; ss += (x[0] * x[0] + x[1] * x[1]) + (x[2] * x[2] + x[3] * x[3]); }
                    ss += __shfl_xor(ss, 16); ss += __shfl_xor(ss, 32);
                    const float rstd = rsqrtf(ss * (1.0f / 64.0f) + 1e-6f);
                    bf16_t* rowp = Z + (size_t)(row0 + ai * HALF + m * 16) * ZW + u.pn * BM + 64 * wc + 8 * fq;
#pragma unroll
                    for (int bj = 0; bj < 2; ++bj) { const f32x4 v0 = acc[ai][bj][m][0] * rstd * gv[bj][0], v1 = acc[ai][bj][m][1] * rstd * gv[bj][1];
                        u32x4 w; w.x = cvt_pk_bf16(v0[0], v0[1]); w.y = cvt_pk_bf16(v0[2], v0[3]); w.z = cvt_pk_bf16(v1[0], v1[1]); w.w = cvt_pk_bf16(v1[2], v1[3]);
                        *(u32x4*)(rowp + 32 * bj) = w; }
                }
        } else {
            const int col0 = u.pn * BM + wc * 32 + 8 * fq;
#pragma unroll
            for (int ai = 0; ai < 2; ++ai)
#pragma unroll
                for (int m = 0; m < 4; ++m) { bf16_t* rowp = Z + (size_t)(row0 + ai * HALF + m * 16) * ZW + col0;
#pragma unroll
                    for (int bj = 0; bj < 2; ++bj) { const f32x4 v0 = acc[ai][bj][m][0], v1 = acc[ai][bj][m][1];
                        u32x4 w; w.x = cvt_pk_bf16(v0[0], v0[1]); w.y = cvt_pk_bf16(v0[2], v0[3]); w.z = cvt_pk_bf16(v1[0], v1[1]); w.w = cvt_pk_bf16(v1[2], v1[3]);
                        *(u32x4*)(rowp + bj * HALF) = w; } }
        }
    }
};
struct EpiBf16 {
    static constexpr bool PERM = true;
    bf16_t* O; int ldc;
    __device__ __forceinline__ void operator()(const f32x4 (&acc)[2][2][4][2], const Unit& u, int wr, int wc, int fr, int fq) const {
        const int row0 = u.pm * BM + wr * 64 + fr, col0 = u.pn * BM + wc * 32 + 8 * fq;
#pragma unroll
        for (int ai = 0; ai < 2; ++ai)
#pragma unroll
            for (int m = 0; m < 4; ++m) { bf16_t* rowp = O + (size_t)(row0 + ai * HALF + m * 16) * ldc + col0;
#pragma unroll
                for (int bj = 0; bj < 2; ++bj) { const f32x4 v0 = acc[ai][bj][m][0], v1 = acc[ai][bj][m][1];
                    u32x4 w; w.x = cvt_pk_bf16(v0[0], v0[1]); w.y = cvt_pk_bf16(v0[2], v0[3]); w.z = cvt_pk_bf16(v1[0], v1[1]); w.w = cvt_pk_bf16(v1[2], v1[3]);
                    *(u32x4*)(rowp + bj * HALF) = w; } }
    }
};
struct EpiOut {
    static constexpr bool PERM = false;
    const float* X; float* O;
    __device__ __forceinline__ void operator()(const f32x4 (&acc)[2][2][4][2], const Unit& u, int wr, int wc, int fr, int fq) const {
        const int row0 = u.pm * BM + wr * 64 + fr, col0 = u.pn * BM + wc * 32 + 4 * fq;
#pragma unroll
        for (int ai = 0; ai < 2; ++ai)
#pragma unroll
            for (int m = 0; m < 4; ++m) { const size_t off = (size_t)(row0 + ai * HALF + m * 16) * DM + col0;
#pragma unroll
                for (int bj = 0; bj < 2; ++bj)
#pragma unroll
                    for (int n = 0; n < 2; ++n) *(f32x4*)(O + off + bj * HALF + n * 16) = *(const f32x4*)(X + off + bj * HALF + n * 16) + acc[ai][bj][m][n];
                if (m & 1) asm volatile("" ::: "memory"); }
    }
};
struct EpiPg {
    static constexpr bool PERM = false;
    float* X; const bf16_t* PJ;
    __device__ __forceinline__ void operator()(const f32x4 (&acc)[2][2][4][2], const Unit& u, int wr, int wc, int fr, int fq) const {
        const int row0 = u.pm * BM + wr * 64 + fr, col0 = u.pn * BM + wc * 32 + 4 * fq;
#pragma unroll
        for (int ai = 0; ai < 2; ++ai)
#pragma unroll
            for (int m = 0; m < 4; ++m) { const size_t off = (size_t)(row0 + ai * HALF + m * 16) * DM + col0;
#pragma unroll
                for (int bj = 0; bj < 2; ++bj)
#pragma unroll
                    for (int n = 0; n < 2; ++n) { const size_t o = off + bj * HALF + n * 16; const u32x2 pj = *(const u32x2*)(PJ + o); const f32x4 a = acc[ai][bj][m][n]; const f32x4 xv = *(const f32x4*)(X + o);
                        f32x4 r; r[0] = xv[0] + sigmoidf_(a[0]) * bflo(pj.x); r[1] = xv[1] + sigmoidf_(a[1]) * bfhi(pj.x); r[2] = xv[2] + sigmoidf_(a[2]) * bflo(pj.y); r[3] = xv[3] + sigmoidf_(a[3]) * bfhi(pj.y);
                        *(f32x4*)(X + o) = r; }
                if (m & 1) asm volatile("" ::: "memory"); }
    }
};
struct EpiGu {
    static constexpr bool PERM = true;
    bf16_t* ACT; const float* b_gu;
    __device__ __forceinline__ void operator()(const f32x4 (&acc)[2][2][4][2], const Unit& u, int wr, int wc, int fr, int fq) const {
        const int row0 = u.pm * BM + wr * 64 + fr, cl = u.pn * HALF + wc * 32 + 8 * fq;
        const float* bg = b_gu + (size_t)u.e * 2048 + cl;
        f32x4 bgl[2], bli[2];
#pragma unroll
        for (int n = 0; n < 2; ++n) { bgl[n] = *(const f32x4*)(bg + 4 * n); bli[n] = *(const f32x4*)(bg + 1024 + 4 * n); }
#pragma unroll
        for (int ai = 0; ai < 2; ++ai)
#pragma unroll
            for (int m = 0; m < 4; ++m) { bf16_t* rowp = ACT + (size_t)(row0 + ai * HALF + m * 16) * EFF + cl; float r[8];
#pragma unroll
                for (int n = 0; n < 2; ++n)
#pragma unroll
                    for (int i = 0; i < 4; ++i) { const float gl = fminf(acc[ai][0][m][n][i] + bgl[n][i], 7.0f); const float li = fminf(fmaxf(acc[ai][1][m][n][i] + bli[n][i], -7.0f), 7.0f);
                        r[4 * n + i] = gl * sigmoidf_(1.702f * gl) * (li + 1.0f); }
                u32x4 w; w.x = cvt_pk_bf16(r[0], r[1]); w.y = cvt_pk_bf16(r[2], r[3]); w.z = cvt_pk_bf16(r[4], r[5]); w.w = cvt_pk_bf16(r[6], r[7]);
                *(u32x4*)rowp = w; }
    }
};
struct EpiDn {
    static constexpr bool PERM = true;
    bf16_t* YP; const float* b_dn; const float* gateslot; const LAS int* tab;
    __device__ __forceinline__ void operator()(const f32x4 (&acc)[2][2][4][2], const Unit& u, int wr, int wc, int fr, int fq) const {
        const int row0 = u.pm * BM + wr * 64 + fr, col0 = u.pn * BM + wc * 32 + 8 * fq;
        const float* bd = b_dn + (size_t)u.e * 1024 + col0; const int cnt = tab[T_CNT + u.e];
        f32x4 bv[2][2];
#pragma unroll
        for (int bj = 0; bj < 2; ++bj)
#pragma unroll
            for (int n = 0; n < 2; ++n) bv[bj][n] = *(const f32x4*)(bd + bj * HALF + 4 * n);
#pragma unroll
        for (int ai = 0; ai < 2; ++ai)
#pragma unroll
            for (int m = 0; m < 4; ++m) { const int rr = wr * 64 + fr + ai * HALF + m * 16, slot = u.lb * 256 + rr;
                const float gt = slot < cnt ? gateslot[(size_t)u.e * NTOK + slot] : 0.f;
                bf16_t* rowp = YP + (size_t)(row0 + ai * HALF + m * 16) * DM + col0;
#pragma unroll
                for (int bj = 0; bj < 2; ++bj) { const f32x4 v0 = (acc[ai][bj][m][0] + bv[bj][0]) * gt, v1 = (acc[ai][bj][m][1] + bv[bj][1]) * gt;
                    u32x4 w; w.x = cvt_pk_bf16(v0[0], v0[1]); w.y = cvt_pk_bf16(v0[2], v0[3]); w.z = cvt_pk_bf16(v1[0], v1[1]); w.w = cvt_pk_bf16(v1[2], v1[3]);
                    *(u32x4*)(rowp + bj * HALF) = w; } }
    }
};
struct MoeOrder {
    const bf16_t* A; const bf16_t* Bt; const int* tokslot; const LAS int* tab; int nblk, nN, G, c; bool gather;
    __device__ __forceinline__ bool next(int i, Unit& u) const { if (!tile_order(i, G, c, nblk, nN, u.pm, u.pn)) return false; u.e = tab[T_BLKE + u.pm]; u.lb = u.pm - tab[T_BLKSTART + u.e]; return true; }
    __device__ __forceinline__ const char* a_base(const Unit& u) const { return gather ? (const char*)A : (const char*)A + (size_t)u.pm * BM * 1024 * 2; }
    __device__ __forceinline__ const char* b_base(const Unit& u) const { return (const char*)Bt + ((size_t)u.e * nN + u.pn) * BM * 1024 * 2; }
    __device__ __forceinline__ void a_off(const Unit& u, const int (&R)[2], const int (&C)[2], unsigned (&off)[2][2]) const {
        const int cnt = tab[T_CNT + u.e];
#pragma unroll
        for (int h = 0; h < 2; ++h)
#pragma unroll
            for (int i = 0; i < 2; ++i) {
                if (gather) { const int slot = u.lb * 256 + R[i] + HALF * h; const int tok = slot < cnt ? tokslot[(size_t)u.e * NTOK + slot] : NTOK; off[h][i] = (unsigned)tok * 2048u + (unsigned)C[i] * 2u; }
                else off[h][i] = (unsigned)((R[i] + HALF * h) * 1024 + C[i]) * 2u;
            }
    }
};
__device__ __forceinline__ int moe_tables(LAS int* tab, const unsigned* cntw) {
    if (threadIdx.x == 0) { int s = 0; for (int e = 0; e < NE; ++e) { const int c = (int)cntw[e]; tab[T_CNT + e] = c; tab[T_BLKSTART + e] = s; const int nb = (c + 255) >> 8; for (int j = 0; j < nb; ++j) tab[T_BLKE + s + j] = e; s += nb; } tab[T_BLKSTART + NE] = s; }
    __syncthreads();
    return tab[T_BLKSTART + NE];
}
}
constexpr int NWAVES = 8, NTHREADS = 512;
constexpr int RING_BYTES = 131072, MISC_OFF = RING_BYTES, LDS_BYTES = 147456;

__device__ __forceinline__ void tr_item(const float* W, int ldw, int srccol0, int k0, bf16_t* WT, int Kd, int dstrow0, LAS float* scr, int lane) {
#pragma unroll 8
    for (int i = 0; i < 32; ++i) { const int kk = 2 * i + (lane >> 5); scr[kk * 33 + (lane & 31)] = W[(size_t)(k0 + kk) * ldw + srccol0 + (lane & 31)]; }
    asm volatile("s_waitcnt lgkmcnt(0)" ::: "memory");
    const int c = lane & 7;
#pragma unroll
    for (int j = 0; j < 4; ++j) { const int n = (lane >> 3) + 8 * j; const LAS float* s = scr + (8 * c) * 33 + n;
        u32x4 o; o.x = pk2(s[0 * 33], s[1 * 33]); o.y = pk2(s[2 * 33], s[3 * 33]); o.z = pk2(s[4 * 33], s[5 * 33]); o.w = pk2(s[6 * 33], s[7 * 33]);
        *(u32x4*)(WT + (size_t)(dstrow0 + n) * Kd + k0 + 8 * c) = o; }
    asm volatile("s_waitcnt lgkmcnt(0)" ::: "memory");
}
constexpr int I_IN = 16 * 120, I_OUT = 16 * 32, I_PG = 16 * 32, I_PP = 4 * 32, I_GU1 = 16 * 64, I_DN1 = 16 * 32;
constexpr int I_SMALL = I_IN + I_OUT + I_PG + I_PP, I_GU = NE * I_GU1, I_DN = NE * I_DN1, I_ALL = I_SMALL + I_GU + I_DN;
__device__ __forceinline__ void prep_item(KPR P, int it, LAS float* scr, int lane) {
    unsigned char* ws = P.ws;
    if (it < I_IN) { const int kb = it / 120, nb = it % 120, n0 = nb * 32, pn = n0 >> 8, j0 = n0 & 255;
        const int src = pn < 4 ? (pn * 256 + 64 * ((j0 & 127) >> 5) + 32 * (j0 >> 7)) : (n0 < 2048 ? n0 : n0 + 8);
        tr_item(P.w_in, INW, src, kb * 64, (bf16_t*)(ws + WS_WIN), 1024, n0, scr, lane); return; }
    it -= I_IN;
    if (it < I_OUT) { tr_item(P.w_out, 1024, (it % 32) * 32, (it / 32) * 64, (bf16_t*)(ws + WS_WOUT), 1024, (it % 32) * 32, scr, lane); return; }
    it -= I_OUT;
    if (it < I_PG) { tr_item(P.w_pg, 1024, (it % 32) * 32, (it / 32) * 64, (bf16_t*)(ws + WS_WPG), 1024, (it % 32) * 32, scr, lane); return; }
    it -= I_PG;
    if (it < I_PP) { tr_item(P.w_pp, 1024, (it % 32) * 32, (it / 32) * 64, (bf16_t*)(ws + WS_WPP), 256, (it % 32) * 32, scr, lane); return; }
    it -= I_PP;
    if (it < I_GU) { const int e = it / I_GU1, r = it % I_GU1, kb = r / 64, nb = r % 64, n0 = nb * 32, pn = n0 >> 8, j0 = n0 & 255;
        const int src = (j0 >> 7) * 1024 + pn * 128 + (j0 & 127);
        tr_item(P.w_gu + (size_t)e * 1024 * 2048, 2048, src, kb * 64, (bf16_t*)(ws + WS_WGU) + (size_t)e * 2048 * 1024, 1024, n0, scr, lane); return; }
    it -= I_GU;
    { const int e = it / I_DN1, r = it % I_DN1, kb = r / 32, nb = r % 32;
        tr_item(P.w_down + (size_t)e * 1024 * 1024, 1024, nb * 32, kb * 64, (bf16_t*)(ws + WS_WDN) + (size_t)e * 1024 * 1024, 1024, nb * 32, scr, lane); }
}
__device__ __forceinline__ void phase_prep_weights(KPR P, LAS unsigned char* lds, int gw, int ngw, int wave, int lane) {
    LAS float* scr = (LAS float*)(lds + wave * 16384);
    for (int it = gw; it < I_ALL; it += ngw) prep_item(P, it, scr, lane);
}
__device__ __forceinline__ void phase_cvt_p(KPR P, int gt, int ngt) {
    bf16_t* PB = (bf16_t*)((unsigned char*)P.out + DO_PB);
    for (int i = gt; i < NTOK * PLE / 8; i += ngt) { const f32x4 a = ((const f32x4*)P.p)[2 * i], b = ((const f32x4*)P.p)[2 * i + 1];
        u32x4 w; w.x = pk2(a[0], a[1]); w.y = pk2(a[2], a[3]); w.z = pk2(b[0], b[1]); w.w = pk2(b[2], b[3]); ((u32x4*)PB)[i] = w; }
}
__device__ __forceinline__ void rms_row(const float* xrow, const float* gain, int lane, f32x4 (&v)[4]) {
    const f32x4* xr = (const f32x4*)xrow + lane; float s = 0.f;
#pragma unroll
    for (int j = 0; j < 4; ++j) { v[j] = xr[64 * j]; s += (v[j][0] * v[j][0] + v[j][1] * v[j][1]) + (v[j][2] * v[j][2] + v[j][3] * v[j][3]); }
    const float rstd = rsqrtf(wave_sum(s) * (1.f / DM) + 1e-6f);
#pragma unroll
    for (int j = 0; j < 4; ++j) v[j] = v[j] * rstd * ((const f32x4*)gain)[64 * j + lane];
}
__device__ __forceinline__ void store_row_bf16(bf16_t* orow, int lane, const f32x4 (&v)[4]) {
    u32x2* o8 = (u32x2*)orow + lane;
#pragma unroll
    for (int j = 0; j < 4; ++j) { u32x2 w; w.x = pk2(v[j][0], v[j][1]); w.y = pk2(v[j][2], v[j][3]); o8[64 * j] = w; }
}
__device__ __forceinline__ void norm1_row(KPR P, int row, int lane, const LAS float* wff, LAS float* lf_out  ) {
    f32x4 v[4]; rms_row(P.x + (size_t)row * DM, P.mix_norm, lane, v);
    store_row_bf16((bf16_t*)(P.ws + WS_XN) + (size_t)row * DM, lane, v);
    float ff[8];
#pragma unroll
    for (int q = 0; q < 8; ++q) ff[q] = 0.f;
#pragma unroll
    for (int j = 0; j < 4; ++j)
#pragma unroll
        for (int i = 0; i < 4; ++i) { const LAS f32x4* w = (const LAS f32x4*)(wff + (size_t)(4 * (64 * j + lane) + i) * 8); const f32x4 w0 = w[0], w1 = w[1]; const float h = v[j][i];
            ff[0] += h * w0[0]; ff[1] += h * w0[1]; ff[2] += h * w0[2]; ff[3] += h * w0[3]; ff[4] += h * w1[0]; ff[5] += h * w1[1]; ff[6] += h * w1[2]; ff[7] += h * w1[3]; }
#pragma unroll
    for (int q = 0; q < 8; ++q) ff[q] = wave_sum(ff[q]);
    if (lane < 8) { float f = ff[0];
#pragma unroll
        for (int q = 1; q < 8; ++q) f = (lane == q) ? ff[q] : f;
        lf_out[lane] = logsigmoidf_(f + P.f_bias[lane]); }
}
__device__ __forceinline__ void load_wff(KPR P, LAS float* wff, int tid, int nthr) {
    for (int i = tid; i < 1024 * 8; i += nthr) wff[i] = P.w_in[(size_t)(i >> 3) * INW + 2048 + (i & 7)];
}
__device__ __forceinline__ void final_row(KPR P, int row, int lane, bool dead) {
    f32x4 v[4]; rms_row((const float*)(P.ws + WS_X1) + (size_t)row * DM, P.final_norm, lane, v);
    f32x4* o = (f32x4*)(P.out + (size_t)row * DM) + lane;
#pragma unroll
    for (int j = 0; j < 4; ++j) { if (dead) { const float q = __builtin_nanf(""); v[j] = (f32x4){q, q, q, q}; } o[64 * j] = v[j]; }
}
typedef GAS unsigned gu32;
#define RLX_AGENT __ATOMIC_RELAXED, __HIP_MEMORY_SCOPE_AGENT
#define XB_TMO      128
#define XB_XCNT(j)  (256  + 64 * (j))
#define XB_XSUB(j)  (1280 + 64 * (j))
#define XB_XGEN(j)  (2304 + 64 * (j))
#define XB_TOP      3328
#define XB_TOPGEN   3392
#define XCD_BAR_WORDS 3456
#define XB_SPIN_CAP (1u << 22)

__device__ __forceinline__ unsigned xb_ld(unsigned* p)              { return __hip_atomic_load(p, __ATOMIC_RELAXED, __HIP_MEMORY_SCOPE_AGENT); }
__device__ __forceinline__ unsigned xb_add(unsigned* p, unsigned v) { return __hip_atomic_fetch_add(p, v, __ATOMIC_RELAXED, __HIP_MEMORY_SCOPE_AGENT); }
__device__ __forceinline__ unsigned xb_xcc_id() { return (unsigned)__builtin_amdgcn_s_getreg((3 << 11) | 20) & 0xFu; }
#define XB_SPIN(cond, bar) do { unsigned _sp = 0; while (cond) { __builtin_amdgcn_s_sleep(1); \
    if ((++_sp & 255u) == 0u) { if (xb_ld(&(bar)[XB_TMO])) break; if (_sp > XB_SPIN_CAP) { atomicAdd(&(bar)[XB_TMO], 1u); break; } } } } while (0)

struct XcdBarrier { unsigned* bar; unsigned x; volatile LAS unsigned* st; };

__device__ __forceinline__ XcdBarrier xcd_barrier_post(unsigned* bar, volatile LAS unsigned* st) {
    XcdBarrier b; b.bar = bar; b.x = xb_xcc_id(); b.st = st;
    if (threadIdx.x == 0) (void)xb_add(&bar[XB_XCNT(b.x)], 1u);
    return b;
}
__device__ __forceinline__ void xcd_barrier_complete(unsigned* bar, unsigned x, unsigned& nloc, unsigned& nx) {
    const unsigned G = gridDim.x * gridDim.y * gridDim.z;
    unsigned sum, cnt, mine, sp = 0u;
    for (;;) {
        sum = 0u; cnt = 0u; mine = 0u;
#pragma unroll
        for (unsigned j = 0; j < 16; ++j) { const unsigned c = xb_ld(&bar[XB_XCNT(j)]); sum += c; cnt += (c > 0u) ? 1u : 0u; mine = (j == x) ? c : mine; }
        if (sum == G) break;
        __builtin_amdgcn_s_sleep(1);
        if ((++sp & 255u) == 0u) { if (xb_ld(&bar[XB_TMO])) break; if (sp > XB_SPIN_CAP) { atomicAdd(&bar[XB_TMO], 1u); break; } }
    }
    nloc = mine > 0u ? mine : 1u; nx = cnt > 0u ? cnt : 1u;
}
__device__ __forceinline__ void xcd_barrier(const XcdBarrier& b) {
    asm volatile("s_waitcnt vmcnt(0)" ::: "memory");
    __syncthreads();
    if (threadIdx.x == 0) {
        unsigned* bar = b.bar;
        __builtin_amdgcn_s_waitcnt(0);
        unsigned nloc = b.st[0], nx = b.st[1];
        if (nloc == 0u) { xcd_barrier_complete(bar, b.x, nloc, nx); b.st[0] = nloc; b.st[1] = nx; }
        const unsigned old = xb_add(&bar[XB_XSUB(b.x)], 1u);
        const unsigned gen = old / nloc;
        if (old + 1u == (gen + 1u) * nloc) {
            __builtin_amdgcn_fence(__ATOMIC_RELEASE, "agent");
            asm volatile("s_waitcnt vmcnt(0)" ::: "memory");
            const unsigned og = xb_add(&bar[XB_TOP], 1u);
            const unsigned tg = og / nx;
            if (og + 1u == (tg + 1u) * nx) xb_add(&bar[XB_TOPGEN], 1u);
            else XB_SPIN(xb_ld(&bar[XB_TOPGEN]) == tg, bar);
            __builtin_amdgcn_fence(__ATOMIC_ACQUIRE, "agent");
            xb_add(&bar[XB_XGEN(b.x)], 1u);
            asm volatile("s_waitcnt vmcnt(0)" ::: "memory");
        } else {
            XB_SPIN(xb_ld(&bar[XB_XGEN(b.x)]) == gen, bar);
            __builtin_amdgcn_fence(__ATOMIC_ACQUIRE, "agent");
            asm volatile("s_waitcnt vmcnt(0)" ::: "memory");
        }
    }
    __syncthreads();
}
namespace rk {
constexpr int MB = 8192;
constexpr int S_AT = 0, S_RT = 1, S_KT = 2, S_BT = 3, S_ATT = 4, S_KTT = 5, S_BTT = 6, S_VT = 7, S_N = 8, S_NT = 9, S_MAK = 10, S_MRB = 11, S_MRK = 12, S_TA = 13, S_TB = 14;
constexpr int SCR = 15 * MB;
constexpr int NCHUNK = SEQ / 64;
constexpr size_t WS_HT = WS_X1;
constexpr size_t WS_Y0 = WS_X1 + 64 * MiB;
constexpr size_t WS_QI = WS_X1 + 96 * MiB;
constexpr size_t WS_SC = WS_RW + 224 * MiB;
constexpr size_t DO_GT = 80 * MiB;
static_assert(WS_SC + 32 * MiB <= WS_END, "rwkv blobs");

__device__ __forceinline__ int moff(int row, int col) { return row * 128 + ((((col >> 3) ^ (row >> 1)) & 7) << 4) + (col & 7) * 2; }
__device__ __forceinline__ int crow(int r, int hi) { return (r & 3) + 8 * (r >> 2) + 4 * hi; }
__device__ __forceinline__ f32x16 mm_nt(const LAS unsigned char* A, int ar0, const LAS unsigned char* Bt, int br0, f32x16 acc, int r32, int hi) {
#pragma unroll
    for (int ks = 0; ks < 4; ++ks) { const bf16x8 a = *(const LAS bf16x8*)(A + moff(ar0 + r32, 16 * ks + 8 * hi)), b = *(const LAS bf16x8*)(Bt + moff(br0 + r32, 16 * ks + 8 * hi));
        acc = __builtin_amdgcn_mfma_f32_32x32x16_bf16(a, b, acc, 0, 0, 0); }
    return acc;
}
__device__ __forceinline__ void store_t(LAS unsigned char* dst, const f32x16& acc, int i0, int j0, int r32, int hi) {
#pragma unroll
    for (int g = 0; g < 4; ++g) { u32x2 w; w.x = pk2(acc[4 * g], acc[4 * g + 1]); w.y = pk2(acc[4 * g + 2], acc[4 * g + 3]); *(LAS u32x2*)(dst + moff(j0 + r32, i0 + 8 * g + 4 * hi)) = w; }
}
template <int MODE> __device__ __forceinline__ void mask_tri(f32x16& acc, int i0, int j0, int r32, int hi) {
#pragma unroll
    for (int r = 0; r < 16; ++r) { const int i = i0 + crow(r, hi), j = j0 + r32; const bool keep = MODE == 0 ? (j < i) : (MODE == 1 ? (i < j) : (i <= j)); if (!keep) acc[r] = 0.f; }
}

__device__ __forceinline__ void pass1_chunk(KPR P, LAS unsigned char* lds, int bh, int c, int tid) {
    const int lane = tid & 63, wave = tid >> 6, r32 = lane & 31, hi = lane >> 5, grp = wave >> 2, wq = wave & 3, i0 = 32 * (wq >> 1), j0 = 32 * (wq & 1);
    const int b = bh >> 3, h = bh & 7; const size_t tok0 = (size_t)b * SEQ + (size_t)c * 64; const size_t ci = (size_t)bh * NCHUNK + c;
    LAS float* part = (LAS float*)(lds + SCR); LAS float* WL = (LAS float*)(lds + SCR + 2048);
#define MAT(s) (lds + (s) * MB)
    {
        const bf16_t* RR = (const bf16_t*)(P.ws + WS_RR); const bf16_t* RK = (const bf16_t*)(P.ws + WS_RK); const bf16_t* RV = (const bf16_t*)(P.ws + WS_RV);
        const bf16_t* RLW = (const bf16_t*)(P.ws + WS_RLW); const bf16_t* RKK = (const bf16_t*)(P.ws + WS_RKK); const bf16_t* RKA = (const bf16_t*)(P.ws + WS_RKA);
        const int ch = tid & 63, tq = tid >> 6; const size_t base = (tok0 + 8 * tq) * 512 + h * 64 + ch;
        float cum[8]; float run = 0.f;
#pragma unroll
        for (int i = 0; i < 8; ++i) { run += bf2f(RLW[base + (size_t)i * 512]); cum[i] = run; }
        part[tq * 64 + ch] = run;
        __syncthreads();
        float pre = 0.f;
#pragma unroll
        for (int g = 0; g < 8; ++g) { const float pv = part[g * 64 + ch]; pre += (g < tq) ? pv : 0.f; }
        float eprev = __expf(pre);
        unsigned atT[4], ktT[4], btT[4], vT[4]; unsigned short hold[4] = {0, 0, 0, 0};
#pragma unroll
        for (int i = 0; i < 8; ++i) { const int t = 8 * tq + i; const size_t o = base + (size_t)i * 512;
            const float cm = pre + cum[i], e1 = __expf(cm), einv = __expf(-cm);
            const float r = bf2f(RR[o]), k = bf2f(RK[o]), kk = bf2f(RKK[o]), ka = bf2f(RKA[o]);
            const unsigned short at = (unsigned short)f2bf(-kk * eprev), rt = (unsigned short)f2bf(r * e1), kt = (unsigned short)f2bf(k * einv), bt = (unsigned short)f2bf(ka * einv), vv = RV[o];
            eprev = e1;
            *(LAS unsigned short*)(MAT(S_AT) + moff(t, ch)) = at; *(LAS unsigned short*)(MAT(S_RT) + moff(t, ch)) = rt; *(LAS unsigned short*)(MAT(S_KT) + moff(t, ch)) = kt; *(LAS unsigned short*)(MAT(S_BT) + moff(t, ch)) = bt;
            if (i & 1) { atT[i >> 1] = hold[0] | ((unsigned)at << 16); ktT[i >> 1] = hold[1] | ((unsigned)kt << 16); btT[i >> 1] = hold[2] | ((unsigned)bt << 16); vT[i >> 1] = hold[3] | ((unsigned)vv << 16); }
            else { hold[0] = at; hold[1] = kt; hold[2] = bt; hold[3] = vv; }
            if (i == 7 && tq == 7) WL[ch] = e1; }
        *(LAS u32x4*)(MAT(S_ATT) + moff(ch, 8 * tq)) = (u32x4){atT[0], atT[1], atT[2], atT[3]}; *(LAS u32x4*)(MAT(S_KTT) + moff(ch, 8 * tq)) = (u32x4){ktT[0], ktT[1], ktT[2], ktT[3]};
        *(LAS u32x4*)(MAT(S_BTT) + moff(ch, 8 * tq)) = (u32x4){btT[0], btT[1], btT[2], btT[3]}; *(LAS u32x4*)(MAT(S_VT) + moff(ch, 8 * tq)) = (u32x4){vT[0], vT[1], vT[2], vT[3]};
    }
    __syncthreads();
    const f32x16 zero = f32x16{};
    if (grp == 0) { f32x16 d = mm_nt(MAT(S_AT), i0, MAT(S_BT), j0, zero, r32, hi); mask_tri<0>(d, i0, j0, r32, hi); store_t(MAT(S_NT), d, i0, j0, r32, hi);
        d = mm_nt(MAT(S_KT), i0, MAT(S_AT), j0, zero, r32, hi); mask_tri<1>(d, i0, j0, r32, hi); store_t(MAT(S_MAK), d, i0, j0, r32, hi);
        d = mm_nt(MAT(S_KT), i0, MAT(S_RT), j0, zero, r32, hi); mask_tri<2>(d, i0, j0, r32, hi); store_t(MAT(S_MRK), d, i0, j0, r32, hi); }
    else { f32x16 d = mm_nt(MAT(S_BT), i0, MAT(S_AT), j0, zero, r32, hi); mask_tri<1>(d, i0, j0, r32, hi); store_t(MAT(S_N), d, i0, j0, r32, hi);
#pragma unroll
        for (int r = 0; r < 16; ++r) if (i0 + crow(r, hi) == j0 + r32) d[r] = 1.0f;
        store_t(MAT(S_TA), d, i0, j0, r32, hi);
        d = mm_nt(MAT(S_BT), i0, MAT(S_RT), j0, zero, r32, hi); mask_tri<2>(d, i0, j0, r32, hi); store_t(MAT(S_MRB), d, i0, j0, r32, hi); }
    __syncthreads();
#pragma unroll
    for (int s = 1; s <= 6; ++s) {
        const int mc = (s & 1) ? S_N : S_AT, mcT = (s & 1) ? S_NT : S_KT, mn = (s & 1) ? S_AT : S_N, mnT = (s & 1) ? S_KT : S_NT;
        const int tc = (s & 1) ? S_TB : S_TA, tn = (s & 1) ? S_TA : S_TB;
        if (s <= 5) {
            if (grp == 0) { const f32x16 d = mm_nt(MAT(mc), i0, MAT(mcT), j0, zero, r32, hi); store_t(MAT(mnT), d, i0, j0, r32, hi); }
            else { const f32x16 d = mm_nt(MAT(mcT), i0, MAT(mc), j0, zero, r32, hi); store_t(MAT(mn), d, i0, j0, r32, hi); }
        }
        if (s >= 2 && grp == (s <= 5 ? 0 : 1) ) {
            f32x16 d = mm_nt(MAT(mcT), i0, MAT(tc), j0, zero, r32, hi);
#pragma unroll
            for (int g = 0; g < 4; ++g) { const u32x2 tv = *(const LAS u32x2*)(MAT(tc) + moff(j0 + r32, i0 + 8 * g + 4 * hi)); d[4 * g] += bflo(tv.x); d[4 * g + 1] += bfhi(tv.x); d[4 * g + 2] += bflo(tv.y); d[4 * g + 3] += bfhi(tv.y); }
            store_t(MAT(tn), d, i0, j0, r32, hi);
        }
        __syncthreads();
    }
    if (grp == 0) { const f32x16 d = mm_nt(MAT(S_TB), i0, MAT(S_ATT), j0, zero, r32, hi); store_t(MAT(S_BT), d, i0, j0, r32, hi); }
    else { const f32x16 d = mm_nt(MAT(S_MAK), i0, MAT(S_VT), j0, zero, r32, hi); store_t(MAT(S_N), d, i0, j0, r32, hi); }
    __syncthreads();
    if (grp == 0) { const f32x16 d = mm_nt(MAT(S_TB), i0, MAT(S_N), j0, zero, r32, hi); store_t(MAT(S_NT), d, i0, j0, r32, hi);
        f32x16 q = mm_nt(MAT(S_BT), i0, MAT(S_MRB), j0, zero, r32, hi);
#pragma unroll
        for (int g = 0; g < 4; ++g) { const u32x2 rv = *(const LAS u32x2*)(MAT(S_RT) + moff(j0 + r32, i0 + 8 * g + 4 * hi)); q[4 * g] += bflo(rv.x); q[4 * g + 1] += bfhi(rv.x); q[4 * g + 2] += bflo(rv.y); q[4 * g + 3] += bfhi(rv.y); }
        store_t(MAT(S_KT), q, i0, j0, r32, hi); }
    else { f32x16 g_ = mm_nt(MAT(S_BT), i0, MAT(S_BTT), j0, zero, r32, hi);
        const float wl = WL[j0 + r32];
#pragma unroll
        for (int r = 0; r < 16; ++r) { if (i0 + crow(r, hi) == j0 + r32) g_[r] += 1.0f; g_[r] *= wl; }
        store_t(MAT(S_AT), g_, i0, j0, r32, hi); }
    __syncthreads();
    if (grp == 0) { f32x16 d = mm_nt(MAT(S_BTT), i0, MAT(S_NT), j0, zero, r32, hi); d = mm_nt(MAT(S_KTT), i0, MAT(S_VT), j0, d, r32, hi);
        float* HT = (float*)(P.ws + WS_HT) + ci * 4096 + (size_t)wq * 1024 + lane;
#pragma unroll
        for (int g = 0; g < 4; ++g) { const f32x4 wl4 = *(const LAS f32x4*)(WL + i0 + 8 * g + 4 * hi);
#pragma unroll
            for (int i = 0; i < 4; ++i) HT[(4 * g + i) * 64] = d[4 * g + i] * wl4[i]; } }
    else { f32x16 d = mm_nt(MAT(S_MRB), i0, MAT(S_NT), j0, zero, r32, hi); d = mm_nt(MAT(S_MRK), i0, MAT(S_VT), j0, d, r32, hi);
        unsigned* Y0 = (unsigned*)(P.ws + WS_Y0) + ci * 2048 + (size_t)wq * 512 + lane;
#pragma unroll
        for (int r2 = 0; r2 < 8; ++r2) Y0[r2 * 64] = pk2(d[2 * r2], d[2 * r2 + 1]); }
    { u32x4* GTg = (u32x4*)((unsigned char*)P.out + DO_GT + ci * MB); u32x4* QIg = (u32x4*)(P.ws + WS_QI + ci * MB);
        GTg[tid] = *(const LAS u32x4*)(MAT(S_AT) + tid * 16); QIg[tid] = *(const LAS u32x4*)(MAT(S_KT) + tid * 16); }
    __syncthreads();
#undef MAT
}

__device__ __forceinline__ void pass2_seq(KPR P, LAS unsigned char* lds, int bh, int tid) {
    const int lane = tid & 63, wave = tid >> 6, r32 = lane & 31, hi = lane >> 5, wq = wave & 3, i0 = 32 * (wq >> 1), j0 = 32 * (wq & 1);
    LAS unsigned char* Sm = lds; LAS unsigned char* G0 = lds + MB; LAS unsigned char* G1 = lds + 2 * MB;
    const size_t ci0 = (size_t)bh * NCHUNK;
    const u32x4* GTg = (const u32x4*)((const unsigned char*)P.out + DO_GT + ci0 * MB); u32x4* SCg = (u32x4*)(P.ws + WS_SC + ci0 * MB);
    const float* HT = (const float*)(P.ws + WS_HT) + ci0 * 4096 + (size_t)wq * 1024 + lane;
    *(LAS u32x4*)(Sm + tid * 16) = (u32x4){0u, 0u, 0u, 0u};
    *(LAS u32x4*)(G0 + tid * 16) = GTg[tid];
    u32x4 gnext = GTg[512 + tid];
    f32x16 hcur, hnext;
    if (wave < 4) {
#pragma unroll
        for (int r = 0; r < 16; ++r) { hcur[r] = HT[r * 64]; hnext[r] = HT[4096 + r * 64]; } }
    __syncthreads();
    for (int c = 0; c < NCHUNK; ++c) {
        LAS unsigned char* Gc = (c & 1) ? G1 : G0; LAS unsigned char* Gn = (c & 1) ? G0 : G1;
        SCg[(size_t)c * 512 + tid] = *(const LAS u32x4*)(Sm + tid * 16);
        f32x16 d = hcur;
        if (wave < 4) d = mm_nt(Gc, i0, Sm, j0, d, r32, hi);
        __syncthreads();
        if (wave < 4) store_t(Sm, d, i0, j0, r32, hi);
        *(LAS u32x4*)(Gn + tid * 16) = gnext;
        const int c2 = (c + 2 < NCHUNK) ? c + 2 : NCHUNK - 1;
        gnext = GTg[(size_t)c2 * 512 + tid];
        if (wave < 4) { hcur = hnext;
#pragma unroll
            for (int r = 0; r < 16; ++r) hnext[r] = HT[(size_t)c2 * 4096 + r * 64]; }
        __syncthreads();
    }
}

__device__ __forceinline__ void pass3_chunk(KPR P, LAS unsigned char* lds, int bh, int c, int tid) {
    const int lane = tid & 63, wave = tid >> 6, r32 = lane & 31, hi = lane >> 5, wq = wave & 3, i0 = 32 * (wq >> 1), j0 = 32 * (wq & 1);
    const int b = bh >> 3, h = bh & 7; const size_t tok0 = (size_t)b * SEQ + (size_t)c * 64; const size_t ci = (size_t)bh * NCHUNK + c;
    LAS unsigned char* Qm = lds; LAS unsigned char* Sm = lds + MB; LAS float* Yl = (LAS float*)(lds + 2 * MB);
    *(LAS u32x4*)(Qm + tid * 16) = ((const u32x4*)(P.ws + WS_QI + ci * MB))[tid];
    *(LAS u32x4*)(Sm + tid * 16) = ((const u32x4*)(P.ws + WS_SC + ci * MB))[tid];
    f32x16 d = f32x16{};
    if (wave < 4) { const unsigned* Y0 = (const unsigned*)(P.ws + WS_Y0) + ci * 2048 + (size_t)wq * 512 + lane;
#pragma unroll
        for (int r2 = 0; r2 < 8; ++r2) { const unsigned w = Y0[r2 * 64]; d[2 * r2] = bflo(w); d[2 * r2 + 1] = bfhi(w); } }
    __syncthreads();
    if (wave < 4) { d = mm_nt(Qm, i0, Sm, j0, d, r32, hi);
#pragma unroll
        for (int r = 0; r < 16; ++r) Yl[(i0 + crow(r, hi)) * 65 + j0 + r32] = d[r]; }
    __syncthreads();
    const bf16_t* RR = (const bf16_t*)(P.ws + WS_RR); const bf16_t* RK = (const bf16_t*)(P.ws + WS_RK); const bf16_t* RV = (const bf16_t*)(P.ws + WS_RV); const bf16_t* RG = (const bf16_t*)(P.ws + WS_RG);
    bf16_t* AO = (bf16_t*)(P.ws + WS_AO); const int cc = h * 64 + lane;
    const float lnw = P.ln_w[cc], lnb = P.ln_b[cc], rkc = P.r_k[cc];
#pragma unroll
    for (int i = 0; i < 8; ++i) { const int t = wave * 8 + i; const size_t tok = tok0 + t, o = tok * 512 + cc;
        const float y = Yl[t * 65 + lane], mean = wave_sum(y) * (1.f / 64.f), dv = y - mean, var = wave_sum(dv * dv) * (1.f / 64.f);
        const float yn = dv * rsqrtf(var + 64e-5f) * lnw + lnb;
        const float r = bf2f(RR[o]), k = bf2f(RK[o]), v = bf2f(RV[o]), g = bf2f(RG[o]);
        const float bonus = wave_sum(r * k * rkc) * v;
        AO[tok * DM + 512 + cc] = (bf16_t)f2bf((yn + bonus) * g); }
}
}
__device__ __forceinline__ int crow(int r, int hi) { return (r & 3) + 8 * (r >> 2) + 4 * hi; }
constexpr int CW_QATT = 128;
constexpr int MISC_TAB = 64, MISC_Q = 4096, MISC_PFX = 4160;

__device__ __forceinline__ void attn_unit_v2(KPR P, LAS unsigned char* lds, int bh, int qb) {
    LAS bf16_t* Ks = (LAS bf16_t*)lds;
    LAS bf16_t* Vt = (LAS bf16_t*)(lds + 9216);
    LAS float* wsf = (LAS float*)(lds + 18432);
    const bf16_t* Z = (const bf16_t*)(P.ws + WS_Z); bf16_t* AO = (bf16_t*)(P.ws + WS_AO);
    const int tid = threadIdx.x, lane = tid & 63, w = tid >> 6, r32 = lane & 31, hi = lane >> 5;
    const int b = bh >> 3, h = bh & 7, q0 = qb * 256;
    const size_t rowbase = (size_t)b * SEQ;
    const float* c2 = (const float*)(P.ws + WS_C2) + (size_t)bh * SEQ;
    const int qloc = q0 + 32 * w + r32;
    const bf16_t* Qp = Z + (rowbase + qloc) * ZW + ZQ + h * 64;
    bf16x8 qr[4];
#pragma unroll
    for (int ks = 0; ks < 4; ++ks) qr[ks] = *(const bf16x8*)(Qp + ks * 16 + hi * 8);
    const float cq = c2[qloc];
    float m = -1e30f, l = 0.f; f32x16 o[2]; o[0] = f32x16{}; o[1] = f32x16{};
    const int ntiles = (q0 + 256) / 64;
    LAS float* wsw = wsf + w * 64;
    for (int t = 0; t < ntiles; ++t) {
        __syncthreads();
        { const int row = tid >> 3, ch = tid & 7; const bf16_t* src = Z + (rowbase + t * 64 + row) * ZW + h * 64 + ch * 8;
            *(LAS u32x4*)&Ks[row * 72 + ch * 8] = *(const u32x4*)(src + ZK);
            const u32x4 v = *(const u32x4*)(src + ZV); const unsigned vv[4] = {v.x, v.y, v.z, v.w};
#pragma unroll
            for (int e = 0; e < 4; ++e) { Vt[(ch * 8 + 2 * e) * 72 + row] = (bf16_t)(vv[e] & 0xffffu); Vt[(ch * 8 + 2 * e + 1) * 72 + row] = (bf16_t)(vv[e] >> 16); } }
        __syncthreads();
        if (t * 64 > q0 + 32 * w + 31) continue;
        f32x16 p[2];
#pragma unroll
        for (int g = 0; g < 2; ++g) { p[g] = f32x16{};
#pragma unroll
            for (int ks = 0; ks < 4; ++ks) { const bf16x8 kf = *(const LAS bf16x8*)&Ks[(32 * g + r32) * 72 + ks * 16 + hi * 8]; p[g] = __builtin_amdgcn_mfma_f32_32x32x16_bf16(kf, qr[ks], p[g], 0, 0, 0); } }
        float mx = -1e30f;
#pragma unroll
        for (int g = 0; g < 2; ++g)
#pragma unroll
            for (int r4 = 0; r4 < 4; ++r4) { const int kv0 = t * 64 + 32 * g + 8 * r4 + 4 * hi; const f32x4 ck = *(const f32x4*)(c2 + kv0);
#pragma unroll
                for (int i = 0; i < 4; ++i) { float s = p[g][4 * r4 + i] + (cq - ck[i]); if (kv0 + i > qloc) s = -INFINITY; p[g][4 * r4 + i] = s; mx = fmaxf(mx, s); } }
        mx = fmaxf(mx, __shfl_xor(mx, 32));
        const float mnew = fmaxf(m, mx), alpha = exp2f(m - mnew); m = mnew;
        float ps = 0.f;
#pragma unroll
        for (int g = 0; g < 2; ++g)
#pragma unroll
            for (int r = 0; r < 16; ++r) { const float e = exp2f(p[g][r] - mnew); p[g][r] = e; ps += e; }
        l = l * alpha + ps;
        if (hi == 0) wsw[r32] = alpha;
        __builtin_amdgcn_wave_barrier(); asm volatile("s_waitcnt lgkmcnt(0)" ::: "memory");
#pragma unroll
        for (int r4 = 0; r4 < 4; ++r4) { const f32x4 al = *(const LAS f32x4*)&wsw[8 * r4 + 4 * hi];
#pragma unroll
            for (int i = 0; i < 4; ++i) { o[0][4 * r4 + i] *= al[i]; o[1][4 * r4 + i] *= al[i]; } }
#pragma unroll
        for (int g = 0; g < 2; ++g)
#pragma unroll
            for (int s = 0; s < 2; ++s) { u32x4 pw; pw.x = pk2(p[g][8 * s + 0], p[g][8 * s + 1]); pw.y = pk2(p[g][8 * s + 2], p[g][8 * s + 3]); pw.z = pk2(p[g][8 * s + 4], p[g][8 * s + 5]); pw.w = pk2(p[g][8 * s + 6], p[g][8 * s + 7]);
                const bf16x8 pa = __builtin_bit_cast(bf16x8, pw);
#pragma unroll
                for (int d0 = 0; d0 < 2; ++d0) { const u32x2 lo = *(const LAS u32x2*)&Vt[(32 * d0 + r32) * 72 + 32 * g + 16 * s + 4 * hi], hh = *(const LAS u32x2*)&Vt[(32 * d0 + r32) * 72 + 32 * g + 16 * s + 8 + 4 * hi];
                    u32x4 vw; vw.x = lo.x; vw.y = lo.y; vw.z = hh.x; vw.w = hh.y;
                    o[d0] = __builtin_amdgcn_mfma_f32_32x32x16_bf16(pa, __builtin_bit_cast(bf16x8, vw), o[d0], 0, 0, 0); } }
        __builtin_amdgcn_wave_barrier();
    }
    l += __shfl_xor(l, 32);
    __builtin_amdgcn_wave_barrier();
    if (hi == 0) wsw[32 + r32] = l;
    __builtin_amdgcn_wave_barrier(); asm volatile("s_waitcnt lgkmcnt(0)" ::: "memory");
#pragma unroll
    for (int r = 0; r < 16; ++r) { const int q = crow(r, hi); const float li = 1.0f / wsw[32 + q]; const size_t row = rowbase + q0 + 32 * w + q;
#pragma unroll
        for (int d0 = 0; d0 < 2; ++d0) { const int d = 32 * d0 + r32; const float og = bf2f(Z[row * ZW + ZOG + h * 64 + d]);
            AO[row * DM + h * 64 + d] = (bf16_t)f2bf(o[d0][r] * li * sigmoidf_(og)); } }
    __builtin_amdgcn_wave_barrier();
}

__device__ __forceinline__ float zlerp(const bf16_t* Z, size_t row, bool first, int col, const float* mu) {
    const float z1 = bf2f(Z[row * ZW + ZR + col]); const float z0 = first ? 0.f : bf2f(Z[(row - 1) * ZW + ZR + col]);
    return z1 + (z0 - z1) * mu[col];
}
__device__ __forceinline__ void rwkv_prep_group(KPR P, LAS float* xs  , int grp, int tid  ) {
    const bf16_t* Z = (const bf16_t*)(P.ws + WS_Z);
    const size_t row0 = (size_t)grp * 8;
    for (int tok = 0; tok < 8; ++tok) { const size_t row = row0 + tok; const bool first = (row % SEQ) == 0;
        const float z = zlerp(Z, row, first, RW_W + tid, P.mu);
        xs[tok * 256 + tid] = tid < 64 ? tanhf(z) : (tid < 128 ? z : sigmoidf_(z)); }
    __syncthreads();
    float lw[8][2], la[8][2], lg[8][2];
#pragma unroll
    for (int t = 0; t < 8; ++t)
#pragma unroll
        for (int c = 0; c < 2; ++c) { lw[t][c] = 0.f; la[t][c] = 0.f; lg[t][c] = 0.f; }
    for (int j = 0; j < 64; ++j) { const float w0 = P.w2[j * 512 + tid], w1 = P.w2[j * 512 + tid + 256], a0 = P.a2[j * 512 + tid], a1 = P.a2[j * 512 + tid + 256];
#pragma unroll
        for (int t = 0; t < 8; ++t) { const float xw = xs[t * 256 + j], xa = xs[t * 256 + 64 + j]; lw[t][0] += xw * w0; lw[t][1] += xw * w1; la[t][0] += xa * a0; la[t][1] += xa * a1; } }
    for (int j = 0; j < 128; ++j) { const float g0 = P.g2[j * 512 + tid], g1 = P.g2[j * 512 + tid + 256];
#pragma unroll
        for (int t = 0; t < 8; ++t) { const float xg = xs[t * 256 + 128 + j]; lg[t][0] += xg * g0; lg[t][1] += xg * g1; } }
    bf16_t* RR = (bf16_t*)(P.ws + WS_RR); bf16_t* RK = (bf16_t*)(P.ws + WS_RK); bf16_t* RV = (bf16_t*)(P.ws + WS_RV); bf16_t* RG = (bf16_t*)(P.ws + WS_RG);
    bf16_t* RLW = (bf16_t*)(P.ws + WS_RLW); bf16_t* RKK = (bf16_t*)(P.ws + WS_RKK); bf16_t* RKA = (bf16_t*)(P.ws + WS_RKA);
#pragma unroll
    for (int t = 0; t < 8; ++t) { const size_t row = row0 + t; const bool first = (row % SEQ) == 0;
#pragma unroll
        for (int c = 0; c < 2; ++c) { const int cc = tid + 256 * c;
            const float zr = zlerp(Z, row, first, RW_R + cc, P.mu), zk = zlerp(Z, row, first, RW_K + cc, P.mu), zv = zlerp(Z, row, first, RW_V + cc, P.mu);
            const float wl = P.w0[cc] + lw[t][c]; const float sp = fmaxf(-wl, 0.f) + log1pf(expf(-fabsf(wl)));
            const float logdecay = -expf(-sp - 0.5f);
            const float a = sigmoidf_(P.a0[cc] + la[t][c]);
            const float kkr = zk * P.k_k[cc]; const float ss = wave_sum(kkr * kkr); const float kk = kkr / fmaxf(sqrtf(ss), 1e-12f);
            const float kp = zk * (1.0f + (a - 1.0f) * P.k_a[cc]);
            const size_t o = row * 512 + cc;
            RR[o] = (bf16_t)f2bf(zr); RK[o] = (bf16_t)f2bf(kp); RV[o] = (bf16_t)f2bf(zv); RG[o] = (bf16_t)f2bf(lg[t][c]); RLW[o] = (bf16_t)f2bf(logdecay); RKK[o] = (bf16_t)f2bf(kk); RKA[o] = (bf16_t)f2bf(kk * a); } }
    __syncthreads();
}
__device__ __forceinline__ float rdlane(float v, int l) { unsigned r; asm volatile("s_nop 3\n\tv_readlane_b32 %0, %1, %2\n\ts_nop 3" : "=s"(r) : "v"(v), "s"(l)); return __builtin_bit_cast(float, r); }
__device__ __forceinline__ void route_row(KPR P, const LAS float* wr, int row, int lane) {
    unsigned* cnt = (unsigned*)(P.ws + WS_CTL) + CW_CNT; int* route = (int*)(P.ws + WS_ROUTE); int* tokslot = (int*)(P.ws + WS_TOKSLOT); float* gateslot = (float*)(P.ws + WS_GATESLOT);
    f32x4 v[4]; rms_row((const float*)(P.ws + WS_X1) + (size_t)row * DM, P.moe_norm, lane, v);
    store_row_bf16((bf16_t*)(P.ws + WS_XN) + (size_t)row * DM, lane, v);
    const int e = lane & 31;
    float acc = 0.f;
#pragma unroll
    for (int j = 0; j < 4; ++j)
_Pragma("nounroll")
        for (int l = 0; l < 64; ++l) {
            const float x0 = rdlane(v[j][0], l), x1 = rdlane(v[j][1], l), x2 = rdlane(v[j][2], l), x3 = rdlane(v[j][3], l);
            const int k = 256 * j + 4 * l;
            acc += x0 * wr[k * 32 + e]; acc += x1 * wr[(k + 1) * 32 + e]; acc += x2 * wr[(k + 2) * 32 + e]; acc += x3 * wr[(k + 3) * 32 + e];
        }
    float logit = acc + P.b_router[e];
    float tv[4]; int ti[4];
#pragma unroll
    for (int k = 0; k < 4; ++k) { float bv = logit; int bi = e;
#pragma unroll
        for (int o = 1; o < 32; o <<= 1) { const float ov = __shfl_xor(bv, o); const int oi = __shfl_xor(bi, o); if (ov > bv || (ov == bv && oi < bi)) { bv = ov; bi = oi; } }
        tv[k] = bv; ti[k] = bi; if (e == bi) logit = -INFINITY; }
    const float e0 = 1.f, e1 = expf(tv[1] - tv[0]), e2 = expf(tv[2] - tv[0]), e3 = expf(tv[3] - tv[0]), inv = 1.f / (e0 + e1 + e2 + e3);
    const float gt[4] = {e0 * inv, e1 * inv, e2 * inv, e3 * inv};
    if (lane < 4) { float g = gt[0]; int ex = ti[0];
#pragma unroll
        for (int k = 1; k < 4; ++k) { g = (lane == k) ? gt[k] : g; ex = (lane == k) ? ti[k] : ex; }
        const int rank = (int)atomicAdd(cnt + ex, 1u);
        tokslot[(size_t)ex * NTOK + rank] = row; gateslot[(size_t)ex * NTOK + rank] = g;
        route[(size_t)row * 12 + lane] = ex; route[(size_t)row * 12 + 4 + lane] = rank; }
}
__device__ __forceinline__ void combine_row(KPR P, const LAS int* tab, int row, int lane) {
    const int* route = (const int*)(P.ws + WS_ROUTE); const bf16_t* YP = (const bf16_t*)(P.ws + WS_YP); float* X = (float*)(P.ws + WS_X1);
    f32x4 v[4]; const f32x4* xr = (const f32x4*)(X + (size_t)row * DM) + lane;
#pragma unroll
    for (int j = 0; j < 4; ++j) v[j] = xr[64 * j];
#pragma unroll
    for (int k = 0; k < 4; ++k) { const int ex = route[(size_t)row * 12 + k], rank = route[(size_t)row * 12 + 4 + k]; const size_t pos = (size_t)tab[pg8::T_BLKSTART + ex] * 256 + rank;
        const u32x2* yr = (const u32x2*)(YP + pos * DM) + lane;
#pragma unroll
        for (int j = 0; j < 4; ++j) { const u32x2 y = yr[64 * j]; v[j][0] += bflo(y.x); v[j][1] += bfhi(y.x); v[j][2] += bflo(y.y); v[j][3] += bfhi(y.y); } }
    f32x4* xo = (f32x4*)(X + (size_t)row * DM) + lane; float s = 0.f;
#pragma unroll
    for (int j = 0; j < 4; ++j) { xo[64 * j] = v[j]; s += (v[j][0] * v[j][0] + v[j][1] * v[j][1]) + (v[j][2] * v[j][2] + v[j][3] * v[j][3]); }
    const float rstd = rsqrtf(wave_sum(s) * (1.f / DM) + 1e-6f);
#pragma unroll
    for (int j = 0; j < 4; ++j) v[j] = v[j] * rstd * ((const f32x4*)P.ple_norm)[64 * j + lane];
    store_row_bf16((bf16_t*)(P.ws + WS_XN) + (size_t)row * DM, lane, v);
}

constexpr int NPHASE = 13;
__global__ void __launch_bounds__(NTHREADS, 2) mega_fwd(Params Pkarg_unused) {
    extern __shared__ __attribute__((aligned(16))) unsigned char smem[];
    LAS unsigned char* lds = (LAS unsigned char*)smem;
    const int tid = threadIdx.x, lane = tid & 63, wave = __builtin_amdgcn_readfirstlane(tid >> 6);
    const int G = gridDim.x, blk = blockIdx.x;
#define P (*kpp)
#define PHASE_BEGIN(k) if (IN(k)) { const __attribute__((address_space(4))) Params* kpp = kp_fresh();
#define PHASE_END(k) } if (BOTH(k)) xcd_barrier(bar);
#define IN(k) (ph_lo <= (k) && (k) < ph_hi)
#define BOTH(k) (IN(k) && IN((k) + 1))
    const __attribute__((address_space(4))) Params* kpp = kp_fresh();
    unsigned* ctl = (unsigned*)(P.ws + WS_CTL);
    volatile LAS unsigned* MISC = (volatile LAS unsigned*)(lds + MISC_OFF);
    LAS int* tab = (LAS int*)(lds + MISC_OFF + MISC_TAB);
    if (tid < 16) MISC[tid] = 0u;
    __syncthreads();
    XcdBarrier bar = xcd_barrier_post(ctl + CW_BAR, MISC);
    unsigned char* const wsb = P.ws;
    const int ph_lo = P.ph_lo, ph_hi = P.ph_hi;

    PHASE_BEGIN(0)
        phase_prep_weights(P, lds, blk * NWAVES + wave, G * NWAVES, wave, lane);
        phase_cvt_p(P, blk * NTHREADS + tid, G * NTHREADS);
        __syncthreads();
        LAS float* wff = (LAS float*)lds; LAS float* lf = (LAS float*)(lds + 32768);
        load_wff(P, wff, tid, NTHREADS); __syncthreads();
        for (int i = 0; i < 16; ++i) { const int rl = wave * 16 + i; norm1_row(P, blk * 128 + rl, lane, wff, lf + rl * 8); }
        __syncthreads();
        if (tid < 8) { float run = 0.f; float* cloc = (float*)(P.ws + WS_LOGF) + (size_t)blk * 128 * 8 + tid;
            for (int r = 0; r < 128; ++r) { run += lf[r * 8 + tid]; cloc[r * 8] = run; }
            ((float*)(P.ws + WS_CTOT))[blk * 8 + tid] = run; }
        if (blk == 0) { bf16_t* zr = (bf16_t*)(P.ws + WS_XN) + (size_t)NTOK * DM; for (int i = tid; i < DM; i += NTHREADS) zr[i] = 0; }
    PHASE_END(0)

    PHASE_BEGIN(1)
        {
            LAS float* pfx = (LAS float*)(lds + MISC_OFF + MISC_PFX);
            if (tid < 8) { float s = 0.f; const float* ct = (const float*)(wsb + WS_CTOT); for (int j = (blk & ~63); j < blk; ++j) s += ct[j * 8 + tid]; pfx[tid] = s; }
            __syncthreads();
            const float* cloc = (const float*)(wsb + WS_LOGF) + (size_t)blk * 128 * 8; float* c2 = (float*)(P.ws + WS_C2);
            for (int i = tid; i < 1024; i += NTHREADS) { const int r = i >> 3, h = i & 7; const int row = blk * 128 + r, b = row >> 13, t = row & (SEQ - 1);
                c2[((size_t)(b * 8 + h)) * SEQ + t] = (cloc[i] + pfx[h]) * LOG2E; }
            __syncthreads();
        }
        {
            pg8::DenseOrder S{(const bf16_t*)(wsb + WS_XN), (const bf16_t*)(wsb + WS_WIN), 1024, NTOK / 256, ZW / 256, G, blk};
            pg8::EpiIn E{(bf16_t*)(P.ws + WS_Z), P.q_norm, P.k_norm};
            pg8::gemm_phase<pg8::EpiIn, pg8::DenseOrder, true>(lds, 1024, S, E);
        }
        {
            pg8::DenseOrder S{(const bf16_t*)((unsigned char*)P.out + DO_PB), (const bf16_t*)(wsb + WS_WPP), PLE, NTOK / 256, DM / 256, G, blk};
            pg8::EpiBf16 E{(bf16_t*)((unsigned char*)P.out + DO_PJ), DM};
            pg8::gemm_phase<pg8::EpiBf16, pg8::DenseOrder, true>(lds, PLE, S, E);
        }
    PHASE_END(1)

    PHASE_BEGIN(2)
        const int sub = tid >> 8, st = tid & 255; LAS float* xs = (LAS float*)(lds + sub * 8192);
        for (int it = 0; it < NTOK / 8 / (2 * 256); ++it) rwkv_prep_group(P, xs, (it * G + blk) * 2 + sub, st);
    PHASE_END(2)

    PHASE_BEGIN(3)
        for (int task = blk; task < NB * NH * rk::NCHUNK; task += G) rk::pass1_chunk(P, lds, task >> 7, task & 127, tid);
    PHASE_END(3)

    PHASE_BEGIN(4)
        if (blk < NB * NH) rk::pass2_seq(P, lds, blk, tid);
        for (;;) {
            __syncthreads();
            if (tid == 0) MISC[MISC_Q / 4] = __hip_atomic_fetch_add(ctl + CW_QATT, 1u, RLX_AGENT);
            __syncthreads();
            const int q = (int)MISC[MISC_Q / 4];
            if (q >= 1024) break;
            attn_unit_v2(P, lds, q & 31, 31 - (q >> 5));
        }
    PHASE_END(4)

    PHASE_BEGIN(5)
        for (int task = blk; task < NB * NH * rk::NCHUNK; task += G) rk::pass3_chunk(P, lds, task >> 7, task & 127, tid);
    PHASE_END(5)

    PHASE_BEGIN(6)
        pg8::DenseOrder S{(const bf16_t*)(wsb + WS_AO), (const bf16_t*)(wsb + WS_WOUT), 1024, NTOK / 256, DM / 256, G, blk};
        pg8::EpiOut E{P.x, (float*)(P.ws + WS_X1)};
        pg8::gemm_phase<pg8::EpiOut, pg8::DenseOrder, true>(lds, 1024, S, E);
    PHASE_END(6)

    PHASE_BEGIN(7)
        LAS float* wr = (LAS float*)lds;
        for (int i = tid; i < 1024 * 32; i += NTHREADS) wr[i] = P.w_router[i];
        __syncthreads();
        for (int row = blk * NWAVES + wave; row < NTOK; row += G * NWAVES) route_row(P, wr, row, lane);
    PHASE_END(7)

    PHASE_BEGIN(8)
        const int nblk = pg8::moe_tables(tab, (const unsigned*)(wsb + WS_CTL) + CW_CNT);
        pg8::MoeOrder S{(const bf16_t*)(wsb + WS_XN), (const bf16_t*)(wsb + WS_WGU), (const int*)(wsb + WS_TOKSLOT), tab, nblk, 8, G, blk, true};
        pg8::EpiGu E{(bf16_t*)(P.ws + WS_ACT), P.b_gu};
        pg8::gemm_phase<pg8::EpiGu, pg8::MoeOrder, true>(lds, 1024, S, E);
    PHASE_END(8)
    PHASE_BEGIN(9)
        const int nblk = pg8::moe_tables(tab, (const unsigned*)(wsb + WS_CTL) + CW_CNT);
        pg8::MoeOrder S{(const bf16_t*)(wsb + WS_ACT), (const bf16_t*)(wsb + WS_WDN), (const int*)(wsb + WS_TOKSLOT), tab, nblk, 4, G, blk, false};
        pg8::EpiDn E{(bf16_t*)(P.ws + WS_YP), P.b_down, (const float*)(wsb + WS_GATESLOT), tab};
        pg8::gemm_phase<pg8::EpiDn, pg8::MoeOrder, true>(lds, 1024, S, E);
    PHASE_END(9)
    PHASE_BEGIN(10)
        (void)pg8::moe_tables(tab, (const unsigned*)(wsb + WS_CTL) + CW_CNT);
        for (int row = blk * NWAVES + wave; row < NTOK; row += G * NWAVES) combine_row(P, tab, row, lane);
    PHASE_END(10)
    PHASE_BEGIN(11)
        pg8::DenseOrder S{(const bf16_t*)(wsb + WS_XN), (const bf16_t*)(wsb + WS_WPG), 1024, NTOK / 256, DM / 256, G, blk};
        pg8::EpiPg E{(float*)(P.ws + WS_X1), (const bf16_t*)((unsigned char*)P.out + DO_PJ)};
        pg8::gemm_phase<pg8::EpiPg, pg8::DenseOrder, true>(lds, 1024, S, E);
    PHASE_END(11)
    PHASE_BEGIN(12)
        const bool dead = __hip_atomic_load(ctl + CW_BAR + XB_TMO, RLX_AGENT) != 0u;
        for (int row = blk * NWAVES + wave; row < NTOK; row += G * NWAVES) final_row(P, row, lane, dead);
    PHASE_END(12)
}
#undef P
extern "C" void kernel_launch(void* const* d_in, const int* in_sizes, int n_in, void* d_out, int out_size, void* d_ws, size_t ws_size, hipStream_t stream) {
    static int ok = 0;
    if (ok == 0) {
        if (n_in != 30 || in_sizes[0] != NTOK * DM || out_size != NTOK * DM || ws_size < WS_END) { fprintf(stderr, "kernel_launch: unexpected shapes (n_in %d, ws %zu)\n", n_in, ws_size); ok = -1; return; }
        if (hipFuncSetAttribute((const void*)mega_fwd, hipFuncAttributeMaxDynamicSharedMemorySize, LDS_BYTES) != hipSuccess) { fprintf(stderr, "kernel_launch: hipFuncSetAttribute failed\n"); ok = -1; return; }
        int dev = 0, cus = 0, per_cu = 0;
        if (hipGetDevice(&dev) != hipSuccess || hipDeviceGetAttribute(&cus, hipDeviceAttributeMultiprocessorCount, dev) != hipSuccess) { ok = -1; return; }
        if (hipOccupancyMaxActiveBlocksPerMultiprocessor(&per_cu, (const void*)mega_fwd, NTHREADS, LDS_BYTES) != hipSuccess || per_cu < 1) { fprintf(stderr, "kernel_launch: occupancy query says %d\n", per_cu); }
        (void)hipGetLastError();
        if (cus != 256) { fprintf(stderr, "kernel_launch: built for 256 CUs, device has %d\n", cus); ok = -1; return; }
        ok = 1;
    }
    if (ok < 0) return;
    Params P{};
    const float** pp = (const float**)&P;
    for (int i = 0; i < 30; ++i) pp[i] = (const float*)d_in[i];
    P.out = (float*)d_out; P.ws = (unsigned char*)d_ws;
    if (hipMemsetAsync((char*)d_ws + WS_CTL, 0, CTL_BYTES, stream) != hipSuccess) return;
#ifndef MK_CUTS
#define MK_CUTS 0
#endif
    if (MK_CUTS == 0) { P.ph_lo = 0; P.ph_hi = NPHASE; hipLaunchKernelGGL(mega_fwd, dim3(256), dim3(NTHREADS), LDS_BYTES, stream, P); }
    else for (int k = 0; k < NPHASE; ++k) { P.ph_lo = k; P.ph_hi = k + 1;
        hipLaunchKernelGGL(mega_fwd, dim3(256), dim3(NTHREADS), LDS_BYTES, stream, P); }
}
```

```cpp
#include <hip/hip_runtime.h>
#include <cstdio>
#include <cstdint>

#define LAS __attribute__((address_space(3)))
#define GAS __attribute__((address_space(1)))
typedef unsigned short bf16_t;
typedef short bf16x8 __attribute__((ext_vector_type(8)));
typedef float f32x2 __attribute__((ext_vector_type(2)));
typedef float f32x4 __attribute__((ext_vector_type(4)));
typedef float f32x16 __attribute__((ext_vector_type(16)));
typedef unsigned u32x2 __attribute__((ext_vector_type(2)));
typedef unsigned u32x4 __attribute__((ext_vector_type(4)));

constexpr int NB = 4, SEQ = 8192, NTOK = NB * SEQ, DM = 1024;
constexpr int NH = 8, HD = 64;
constexpr int INW = 3848;
constexpr int ZW = 3840;
constexpr int ZQ = 0, ZK = 512, ZV = 1024, ZOG = 1536, ZR = 2048;
constexpr int RW_R = 0, RW_K = 512, RW_V = 1024, RW_W = 1536, RW_A = 1600, RW_G = 1664, RWIN = 1792;
constexpr int NE = 32, TOPK = 4, EFF = 1024;
constexpr int MAXBLK = (NTOK * TOPK) / 256 + NE;
constexpr int PLE = 256;
constexpr float LOG2E = 1.4426950408889634f;
constexpr float QSCALE = 0.125f * LOG2E;

constexpr size_t MiB = 1u << 20;
constexpr size_t WS_CTL = 0, CTL_BYTES = 1 * MiB;
constexpr size_t WS_C2 = 1 * MiB;
constexpr size_t WS_LOGF = 2 * MiB;
constexpr size_t WS_ROUTE = 3 * MiB;
constexpr size_t WS_TOKSLOT = 5 * MiB;
constexpr size_t WS_GATESLOT = 9 * MiB;
constexpr size_t WS_CTOT = 13 * MiB;
constexpr size_t WS_WIN = 16 * MiB;
constexpr size_t WS_WOUT = 24 * MiB;
constexpr size_t WS_WPG = 26 * MiB;
constexpr size_t WS_WPP = 28 * MiB;
constexpr size_t WS_WGU = 32 * MiB;
constexpr size_t WS_WDN = 160 * MiB;
constexpr size_t WS_XN = 224 * MiB;
constexpr size_t WS_X1 = 290 * MiB;
constexpr size_t WS_Z = 418 * MiB;
constexpr size_t WS_AO = 658 * MiB;
constexpr size_t WS_ACT = 418 * MiB;
constexpr size_t WS_RW = 722 * MiB;
constexpr size_t WS_RR = WS_RW, WS_RK = WS_RW + 32 * MiB, WS_RV = WS_RW + 64 * MiB, WS_RG = WS_RW + 96 * MiB;
constexpr size_t WS_RLW = WS_RW + 128 * MiB;
constexpr size_t WS_RKK = WS_RW + 160 * MiB, WS_RKA = WS_RW + 192 * MiB;
constexpr size_t WS_YP = 722 * MiB;
constexpr size_t WS_END = 994 * MiB;
static_assert(WS_ACT + (size_t)MAXBLK * 256 * 1024 * 2 <= WS_RW && WS_YP + (size_t)MAXBLK * 256 * 1024 * 2 <= WS_END, "ws map");
constexpr size_t DO_PJ = 0, DO_PB = 64 * MiB;
constexpr int CW_TMO = 0, CW_CNT = 64  , CW_BAR = 4096;

struct Params {
    const float *x, *p, *mix_norm, *w_in, *f_bias, *q_norm, *k_norm, *mu, *w0, *w2, *a0, *a2, *g2, *k_k, *k_a, *r_k, *ln_w, *ln_b, *w_out, *moe_norm, *w_router, *b_router, *w_gu, *b_gu, *w_down,
        *b_down, *ple_norm, *w_pg, *w_pp, *final_norm;
    float* out; unsigned char* ws; int ph_lo, ph_hi;
};

typedef const __attribute__((address_space(4))) Params& KPR;
__device__ __forceinline__ const __attribute__((address_space(4))) Params* kp_fresh() {
    unsigned long long p = (unsigned long long)__builtin_amdgcn_kernarg_segment_ptr(); asm volatile("" : "+s"(p)); return (const __attribute__((address_space(4))) Params*)p; }

__device__ __forceinline__ unsigned f2bf(float f) { unsigned u = __builtin_bit_cast(unsigned, f); return (u + 0x7fffu + ((u >> 16) & 1u)) >> 16; }
__device__ __forceinline__ unsigned pk2(float lo, float hi) { return f2bf(lo) | (f2bf(hi) << 16); }
__device__ __forceinline__ float bf2f(unsigned h) { return __builtin_bit_cast(float, h << 16); }
__device__ __forceinline__ float bflo(unsigned w) { return __builtin_bit_cast(float, w << 16); }
__device__ __forceinline__ float bfhi(unsigned w) { return __builtin_bit_cast(float, w & 0xffff0000u); }
__device__ __forceinline__ unsigned cvt_pk_bf16(float lo, float hi) { unsigned r; asm volatile("v_cvt_pk_bf16_f32 %0, %1, %2" : "=v"(r) : "v"(lo), "v"(hi)); return r; }
__device__ __forceinline__ float wave_sum(float v) {
#pragma unroll
    for (int o = 1; o < 64; o <<= 1) v += __shfl_xor(v, o);
    return v;
}
__device__ __forceinline__ float sigmoidf_(float x) { return 1.0f / (1.0f + __expf(-x)); }
__device__ __forceinline__ float logsigmoidf_(float x) { return fminf(x, 0.f) - log1pf(expf(-fabsf(x))); }
namespace pg8 {
constexpr int BM = 256, BK = 64, HALF = 128, HTB = HALF * BK * 2, STAGE_BYTES = 8 * HTB, NXCD = 8, WGM = 8;
__host__ __device__ __forceinline__ int lds_byte(int r, int c) { const int st = (r >> 4) * 2 + (c >> 5), rr = r & 15, cc = c & 31, ob = rr * 64 + cc * 2; return st * 1024 + (ob ^ (((ob >> 9) & 1) << 5)); }
__host__ __device__ __forceinline__ void stage_rc(int b, int& R, int& C) { const int st = b / 1024, sb = b % 1024, swz = sb ^ (((sb >> 9) & 1) << 5); R = (st >> 1) * 16 + swz / 64; C = (st & 1) * 32 + (swz % 64) / 2; }
__host__ __device__ __forceinline__ int perm32(int rho) { const int n = rho >> 4, i = rho & 15; return 8 * (i >> 2) + 4 * n + (i & 3); }

struct Unit { int pm, pn, e, lb; };

__device__ __forceinline__ bool tile_order(int i, int G, int c, int nM, int nN, int& pm, int& pn) {
    const int nwg = nM * nN; const long L = (long)i * G + c; if (L >= nwg) return false;
    int wgid = (int)L; { const int q = nwg / NXCD, r = nwg % NXCD, xcd = wgid % NXCD, off = wgid / NXCD; wgid = (xcd < r ? xcd * (q + 1) : r * (q + 1) + (xcd - r) * q) + off; }
    const int nig = WGM * nN, gid = wgid / nig, fm = gid * WGM, gsz = (nM - fm) < WGM ? (nM - fm) : WGM;
    pm = fm + ((wgid % nig) % gsz); pn = (wgid % nig) / gsz; return true;
}
struct DenseOrder {
    const bf16_t* A; const bf16_t* Bt; int K, nM, nN, G, c;
    __device__ __forceinline__ bool next(int i, Unit& u) const { u.e = 0; u.lb = 0; return tile_order(i, G, c, nM, nN, u.pm, u.pn); }
    __device__ __forceinline__ const char* a_base(const Unit& u) const { return (const char*)A + (size_t)u.pm * BM * K * 2; }
    __device__ __forceinline__ const char* b_base(const Unit& u) const { return (const char*)Bt + (size_t)u.pn * BM * K * 2; }
    __device__ __forceinline__ void a_off(const Unit&, const int (&R)[2], const int (&C)[2], unsigned (&off)[2][2]) const {
#pragma unroll
        for (int h = 0; h < 2; ++h)
#pragma unroll
            for (int i = 0; i < 2; ++i) off[h][i] = (unsigned)((R[i] + HALF * h) * K + C[i]) * 2u;
    }
};

template <class Epi, class Sched, bool ALIGN_EPI>
__device__ __forceinline__ void gemm_phase(LAS unsigned char* lds, const int K, const Sched& S, const Epi& E) {
    int tid_ = threadIdx.x; asm volatile("" : "+v"(tid_));
    const int tid = tid_, wid = __builtin_amdgcn_readfirstlane(tid >> 6), lane = tid & 63, wr = wid >> 2, wc = wid & 3, fr = lane & 15, fq = lane >> 4;
    const int nt = K / BK;
    int sR[2], sC[2]; unsigned voffB[2];
#pragma unroll
    for (int i = 0; i < 2; ++i) { int R, C; stage_rc(tid * 16 + i * 8192, R, C); const int Rb = Epi::PERM ? ((R & ~31) + perm32(R & 31)) : R; sR[i] = R; sC[i] = C; voffB[i] = (unsigned)(Rb * K + C) * 2u; }
    const size_t kstep = (size_t)(BK * 2);
    const size_t hstep = (size_t)HALF * K * 2;
    const unsigned ldsw = (unsigned)wid * 1024u;
    const int aoff = lds_byte(wr * 64 + fr, fq * 8), boff = lds_byte(wc * 32 + fr, fq * 8);
#define PG8_SA(b, h) (((b) * 2 + (h)) * HTB)
#define PG8_SB(b, h) ((4 + (b) * 2 + (h)) * HTB)
#define PG8_STAGE(bufoff, gbase, voff) do { _Pragma("unroll") for (int _i = 0; _i < 2; ++_i) \
        __builtin_amdgcn_global_load_lds((const unsigned*)((const char*)(gbase) + (voff)[_i]), (LAS unsigned*)(lds + (bufoff) + ldsw + _i * 8192), 16, 0, 0); } while (0)
#define PG8_LDA(dst, b, h) do { _Pragma("unroll") for (int m = 0; m < 4; ++m) _Pragma("unroll") for (int k = 0; k < 2; ++k) dst[m][k] = *(const LAS bf16x8*)(lds + PG8_SA(b, h) + aoff + m * 2048 + k * 1024); } while (0)
#define PG8_LDB(dst, b, h) do { _Pragma("unroll") for (int n = 0; n < 2; ++n) _Pragma("unroll") for (int k = 0; k < 2; ++k) dst[n][k] = *(const LAS bf16x8*)(lds + PG8_SB(b, h) + boff + n * 2048 + k * 1024); } while (0)
#define PG8_MMA(ai, bj, At, Bt) do { __builtin_amdgcn_s_setprio(1); _Pragma("unroll") for (int m = 0; m < 4; ++m) _Pragma("unroll") for (int n = 0; n < 2; ++n) _Pragma("unroll") for (int k = 0; k < 2; ++k) \
        acc[ai][bj][m][n] = __builtin_amdgcn_mfma_f32_16x16x32_bf16(Bt[n][k], At[m][k], acc[ai][bj][m][n], 0, 0, 0); __builtin_amdgcn_s_setprio(0); } while (0)
#define PG8_WAIT_V(n) asm volatile("s_waitcnt vmcnt(" #n ")" ::: "memory")
#define PG8_WAIT_L(n) asm volatile("s_waitcnt lgkmcnt(" #n ")" ::: "memory")
#define PG8_BAR __builtin_amdgcn_s_barrier()
#define PG8_SCHED __builtin_amdgcn_sched_barrier(0)
    Unit cur, nxt; int ui = 0;
    if (!S.next(0, cur)) return;
    f32x4 acc[2][2][4][2];
#pragma unroll
    for (int a = 0; a < 2; ++a)
#pragma unroll
        for (int b = 0; b < 2; ++b)
#pragma unroll
            for (int m = 0; m < 4; ++m)
#pragma unroll
                for (int n = 0; n < 2; ++n) acc[a][b][m][n] = (f32x4){0.f, 0.f, 0.f, 0.f};
    bf16x8 At[4][2], B0[2][2], B1[2][2];
    unsigned offC[2][2], offN[2][2];
    S.a_off(cur, sR, sC, offC);
    const char* cA = S.a_base(cur); const char* cB = S.b_base(cur);
    PG8_STAGE(PG8_SB(0, 0), cB, voffB); PG8_STAGE(PG8_SB(0, 1), cB + hstep, voffB); PG8_STAGE(PG8_SA(0, 0), cA, offC[0]); PG8_STAGE(PG8_SA(0, 1), cA, offC[1]);
    if (wr == 1) PG8_BAR;
    PG8_WAIT_V(2); PG8_BAR;
    PG8_STAGE(PG8_SB(1, 0), cB + kstep, voffB); PG8_STAGE(PG8_SA(1, 0), cA + kstep, offC[0]); PG8_STAGE(PG8_SB(1, 1), cB + hstep + kstep, voffB);
    PG8_WAIT_V(6); PG8_BAR;
    for (;;) {
        const bool has_next = S.next(ui + 1, nxt);
        const char* nA = cA; const char* nB = cB;
        if (has_next) { nA = S.a_base(nxt); nB = S.b_base(nxt); S.a_off(nxt, sR, sC, offN); }
        else {
#pragma unroll
            for (int h = 0; h < 2; ++h)
#pragma unroll
                for (int i = 0; i < 2; ++i) offN[h][i] = offC[h][i];
        }
#pragma nounroll
        for (int t = 0; t < nt; t += 2) {
            const bool last = (t == nt - 2);
            const char* a1 = cA + (size_t)(t + 1) * kstep;
            const char* a2 = last ? nA : cA + (size_t)(t + 2) * kstep; const char* b2 = last ? nB : cB + (size_t)(t + 2) * kstep;
            const char* a3 = a2 + kstep; const char* b3 = b2 + kstep;
            unsigned o2[2][2];
#pragma unroll
            for (int h = 0; h < 2; ++h)
#pragma unroll
                for (int i = 0; i < 2; ++i) o2[h][i] = last ? offN[h][i] : offC[h][i];
            PG8_LDB(B0, 0, 0); PG8_LDB(B1, 0, 1); PG8_SCHED; PG8_LDA(At, 0, 0); PG8_STAGE(PG8_SA(1, 1), a1, offC[1]);
            PG8_WAIT_V(8); PG8_WAIT_L(0); PG8_BAR; PG8_MMA(0, 0, At, B0); PG8_MMA(0, 1, At, B1); PG8_BAR; PG8_SCHED;
            PG8_LDA(At, 0, 1); PG8_STAGE(PG8_SB(0, 0), b2, voffB); PG8_STAGE(PG8_SB(0, 1), b2 + hstep, voffB); PG8_STAGE(PG8_SA(0, 0), a2, o2[0]);
            PG8_WAIT_V(8); PG8_WAIT_L(0); PG8_BAR; PG8_MMA(1, 0, At, B0); PG8_MMA(1, 1, At, B1); PG8_BAR; PG8_SCHED;
            PG8_LDB(B0, 1, 0); PG8_LDB(B1, 1, 1); PG8_SCHED; PG8_LDA(At, 1, 0); PG8_STAGE(PG8_SA(0, 1), a2, o2[1]);
            PG8_WAIT_V(8); PG8_WAIT_L(0); PG8_BAR; PG8_MMA(0, 0, At, B0); PG8_MMA(0, 1, At, B1); PG8_BAR; PG8_SCHED;
            PG8_LDA(At, 1, 1); PG8_STAGE(PG8_SB(1, 0), b3, voffB); PG8_STAGE(PG8_SB(1, 1), b3 + hstep, voffB); PG8_STAGE(PG8_SA(1, 0), a3, o2[0]);
            PG8_WAIT_V(8); PG8_WAIT_L(0); PG8_BAR; PG8_MMA(1, 0, At, B0); PG8_MMA(1, 1, At, B1); PG8_BAR; PG8_SCHED;
        }
        if constexpr (ALIGN_EPI) { if (wr == 0) PG8_BAR; }
        E(acc, cur, wr, wc, fr, fq);
        if (!has_next) break;
#pragma unroll
        for (int a = 0; a < 2; ++a)
#pragma unroll
            for (int b = 0; b < 2; ++b)
#pragma unroll
                for (int m = 0; m < 4; ++m)
#pragma unroll
                    for (int n = 0; n < 2; ++n) acc[a][b][m][n] = (f32x4){0.f, 0.f, 0.f, 0.f};
        cur = nxt; cA = nA; cB = nB; ++ui;
#pragma unroll
        for (int h = 0; h < 2; ++h)
#pragma unroll
            for (int i = 0; i < 2; ++i) offC[h][i] = offN[h][i];
        if constexpr (ALIGN_EPI) { if (wr == 1) PG8_BAR; }
    }
    PG8_WAIT_V(0);
    if constexpr (!ALIGN_EPI) { if (wr == 0) PG8_BAR; }
    PG8_BAR;
#undef PG8_SA
#undef PG8_SB
#undef PG8_STAGE
#undef PG8_LDA
#undef PG8_LDB
#undef PG8_MMA
#undef PG8_WAIT_V
#undef PG8_WAIT_L
#undef PG8_BAR
#undef PG8_SCHED
}
}
namespace pg8 {
constexpr int T_BLKSTART = 0  , T_CNT = 40  , T_BLKE = 80  , T_WORDS = 80 + 560;

struct EpiIn {
    static constexpr bool PERM = true;
    bf16_t* Z; const float* qn; const float* kn;
    __device__ __forceinline__ void operator()(const f32x4 (&acc)[2][2][4][2], const Unit& u, int wr, int wc, int fr, int fq) const {
        const int row0 = u.pm * BM + wr * 64 + fr;
        if (u.pn < 4) {
            const float* g = (u.pn < 2) ? qn : kn; const float sc = (u.pn < 2) ? QSCALE : 1.0f;
            f32x4 gv[2][2];
#pragma unroll
            for (int bj = 0; bj < 2; ++bj)
#pragma unroll
                for (int n = 0; n < 2; ++n) gv[bj][n] = *(const f32x4*)(g + 32 * bj + 8 * fq + 4 * n) * sc;
#pragma unroll
            for (int ai = 0; ai < 2; ++ai)
#pragma unroll
                for (int m = 0; m < 4; ++m) {
                    float ss = 0.f;
#pragma unroll
                    for (int bj = 0; bj < 2; ++bj)
#pragma unroll
                        for (int n = 0; n < 2; ++n) { const f32x4 x = acc[ai][bj][m][n]; ss += (x[0] * x[0] + x[1] * x[1]) + (x[2] * x[2] + x[3] * x[3]); }
                    ss += __shfl_xor(ss, 16); ss += __shfl_xor(ss, 32);
                    const float rstd = rsqrtf(ss * (1.0f / 64.0f) + 1e-6f);
                    bf16_t* rowp = Z + (size_t)(row0 + ai * HALF + m * 16) * ZW + u.pn * BM + 64 * wc + 8 * fq;
#pragma unroll
                    for (int bj = 0; bj < 2; ++bj) { const f32x4 v0 = acc[ai][bj][m][0] * rstd * gv[bj][0], v1 = acc[ai][bj][m][1] * rstd * gv[bj][1];
                        u32x4 w; w.x = cvt_pk_bf16(v0[0], v0[1]); w.y = cvt_pk_bf16(v0[2], v0[3]); w.z = cvt_pk_bf16(v1[0], v1[1]); w.w = cvt_pk_bf16(v1[2], v1[3]);
                        *(u32x4*)(rowp + 32 * bj) = w; }
                }
        } else {
            const int col0 = u.pn * BM + wc * 32 + 8 * fq;
#pragma unroll
            for (int ai = 0; ai < 2; ++ai)
#pragma unroll
                for (int m = 0; m < 4; ++m) { bf16_t* rowp = Z + (size_t)(row0 + ai * HALF + m * 16) * ZW + col0;
#pragma unroll
                    for (int bj = 0; bj < 2; ++bj) { const f32x4 v0 = acc[ai][bj][m][0], v1 = acc[ai][bj][m][1];
                        u32x4 w; w.x = cvt_pk_bf16(v0[0], v0[1]); w.y = cvt_pk_bf16(v0[2], v0[3]); w.z = cvt_pk_bf16(v1[0], v1[1]); w.w = cvt_pk_bf16(v1[2], v1[3]);
                        *(u32x4*)(rowp + bj * HALF) = w; } }
        }
    }
};
struct EpiBf16 {
    static constexpr bool PERM = true;
    bf16_t* O; int ldc;
    __device__ __forceinline__ void operator()(const f32x4 (&acc)[2][2][4][2], const Unit& u, int wr, int wc, int fr, int fq) const {
        const int row0 = u.pm * BM + wr * 64 + fr, col0 = u.pn * BM + wc * 32 + 8 * fq;
#pragma unroll
        for (int ai = 0; ai < 2; ++ai)
#pragma unroll
            for (int m = 0; m < 4; ++m) { bf16_t* rowp = O + (size_t)(row0 + ai * HALF + m * 16) * ldc + col0;
#pragma unroll
                for (int bj = 0; bj < 2; ++bj) { const f32x4 v0 = acc[ai][bj][m][0], v1 = acc[ai][bj][m][1];
                    u32x4 w; w.x = cvt_pk_bf16(v0[0], v0[1]); w.y = cvt_pk_bf16(v0[2], v0[3]); w.z = cvt_pk_bf16(v1[0], v1[1]); w.w = cvt_pk_bf16(v1[2], v1[3]);
                    *(u32x4*)(rowp + bj * HALF) = w; } }
    }
};
struct EpiOut {
    static constexpr bool PERM = false;
    const float* X; float* O;
    __device__ __forceinline__ void operator()(const f32x4 (&acc)[2][2][4][2], const Unit& u, int wr, int wc, int fr, int fq) const {
        const int row0 = u.pm * BM + wr * 64 + fr, col0 = u.pn * BM + wc * 32 + 4 * fq;
#pragma unroll
        for (int ai = 0; ai < 2; ++ai)
#pragma unroll
            for (int m = 0; m < 4; ++m) { const size_t off = (size_t)(row0 + ai * HALF + m * 16) * DM + col0;
#pragma unroll
                for (int bj = 0; bj < 2; ++bj)
#pragma unroll
                    for (int n = 0; n < 2; ++n) *(f32x4*)(O + off + bj * HALF + n * 16) = *(const f32x4*)(X + off + bj * HALF + n * 16) + acc[ai][bj][m][n];
                if (m & 1) asm volatile("" ::: "memory"); }
    }
};
struct EpiPg {
    static constexpr bool PERM = false;
    float* X; const bf16_t* PJ;
    __device__ __forceinline__ void operator()(const f32x4 (&acc)[2][2][4][2], const Unit& u, int wr, int wc, int fr, int fq) const {
        const int row0 = u.pm * BM + wr * 64 + fr, col0 = u.pn * BM + wc * 32 + 4 * fq;
#pragma unroll
        for (int ai = 0; ai < 2; ++ai)
#pragma unroll
            for (int m = 0; m < 4; ++m) { const size_t off = (size_t)(row0 + ai * HALF + m * 16) * DM + col0;
#pragma unroll
                for (int bj = 0; bj < 2; ++bj)
#pragma unroll
                    for (int n = 0; n < 2; ++n) { const size_t o = off + bj * HALF + n * 16; const u32x2 pj = *(const u32x2*)(PJ + o); const f32x4 a = acc[ai][bj][m][n]; const f32x4 xv = *(const f32x4*)(X + o);
                        f32x4 r; r[0] = xv[0] + sigmoidf_(a[0]) * bflo(pj.x); r[1] = xv[1] + sigmoidf_(a[1]) * bfhi(pj.x); r[2] = xv[2] + sigmoidf_(a[2]) * bflo(pj.y); r[3] = xv[3] + sigmoidf_(a[3]) * bfhi(pj.y);
                        *(f32x4*)(X + o) = r; }
                if (m & 1) asm volatile("" ::: "memory"); }
    }
};
struct EpiGu {
    static constexpr bool PERM = true;
    bf16_t* ACT; const float* b_gu;
    __device__ __forceinline__ void operator()(const f32x4 (&acc)[2][2][4][2], const Unit& u, int wr, int wc, int fr, int fq) const {
        const int row0 = u.pm * BM + wr * 64 + fr, cl = u.pn * HALF + wc * 32 + 8 * fq;
        const float* bg = b_gu + (size_t)u.e * 2048 + cl;
        f32x4 bgl[2], bli[2];
#pragma unroll
        for (int n = 0; n < 2; ++n) { bgl[n] = *(const f32x4*)(bg + 4 * n); bli[n] = *(const f32x4*)(bg + 1024 + 4 * n); }
#pragma unroll
        for (int ai = 0; ai < 2; ++ai)
#pragma unroll
            for (int m = 0; m < 4; ++m) { bf16_t* rowp = ACT + (size_t)(row0 + ai * HALF + m * 16) * EFF + cl; float r[8];
#pragma unroll
                for (int n = 0; n < 2; ++n)
#pragma unroll
                    for (int i = 0; i < 4; ++i) { const float gl = fminf(acc[ai][0][m][n][i] + bgl[n][i], 7.0f); const float li = fminf(fmaxf(acc[ai][1][m][n][i] + bli[n][i], -7.0f), 7.0f);
                        r[4 * n + i] = gl * sigmoidf_(1.702f * gl) * (li + 1.0f); }
                u32x4 w; w.x = cvt_pk_bf16(r[0], r[1]); w.y = cvt_pk_bf16(r[2], r[3]); w.z = cvt_pk_bf16(r[4], r[5]); w.w = cvt_pk_bf16(r[6], r[7]);
                *(u32x4*)rowp = w; }
    }
};
struct EpiDn {
    static constexpr bool PERM = true;
    bf16_t* YP; const float* b_dn; const float* gateslot; const LAS int* tab;
    __device__ __forceinline__ void operator()(const f32x4 (&acc)[2][2][4][2], const Unit& u, int wr, int wc, int fr, int fq) const {
        const int row0 = u.pm * BM + wr * 64 + fr, col0 = u.pn * BM + wc * 32 + 8 * fq;
        const float* bd = b_dn + (size_t)u.e * 1024 + col0; const int cnt = tab[T_CNT + u.e];
        f32x4 bv[2][2];
#pragma unroll
        for (int bj = 0; bj < 2; ++bj)
#pragma unroll
            for (int n = 0; n < 2; ++n) bv[bj][n] = *(const f32x4*)(bd + bj * HALF + 4 * n);
#pragma unroll
        for (int ai = 0; ai < 2; ++ai)
#pragma unroll
            for (int m = 0; m < 4; ++m) { const int rr = wr * 64 + fr + ai * HALF + m * 16, slot = u.lb * 256 + rr;
                const float gt = slot < cnt ? gateslot[(size_t)u.e * NTOK + slot] : 0.f;
                bf16_t* rowp = YP + (size_t)(row0 + ai * HALF + m * 16) * DM + col0;
#pragma unroll
                for (int bj = 0; bj < 2; ++bj) { const f32x4 v0 = (acc[ai][bj][m][0] + bv[bj][0]) * gt, v1 = (acc[ai][bj][m][1] + bv[bj][1]) * gt;
                    u32x4 w; w.x = cvt_pk_bf16(v0[0], v0[1]); w.y = cvt_pk_bf16(v0[2], v0[3]); w.z = cvt_pk_bf16(v1[0], v1[1]); w.w = cvt_pk_bf16(v1[2], v1[3]);
                    *(u32x4*)(rowp + bj * HALF) = w; } }
    }
};
struct MoeOrder {
    const bf16_t* A; const bf16_t* Bt; const int* tokslot; const LAS int* tab; int nblk, nN, G, c; bool gather;
    __device__ __forceinline__ bool next(int i, Unit& u) const { if (!tile_order(i, G, c, nblk, nN, u.pm, u.pn)) return false; u.e = tab[T_BLKE + u.pm]; u.lb = u.pm - tab[T_BLKSTART + u.e]; return true; }
    __device__ __forceinline__ const char* a_base(const Unit& u) const { return gather ? (const char*)A : (const char*)A + (size_t)u.pm * BM * 1024 * 2; }
    __device__ __forceinline__ const char* b_base(const Unit& u) const { return (const char*)Bt + ((size_t)u.e * nN + u.pn) * BM * 1024 * 2; }
    __device__ __forceinline__ void a_off(const Unit& u, const int (&R)[2], const int (&C)[2], unsigned (&off)[2][2]) const {
        const int cnt = tab[T_CNT + u.e];
#pragma unroll
        for (int h = 0; h < 2; ++h)
#pragma unroll
            for (int i = 0; i < 2; ++i) {
                if (gather) { const int slot = u.lb * 256 + R[i] + HALF * h; const int tok = slot < cnt ? tokslot[(size_t)u.e * NTOK + slot] : NTOK; off[h][i] = (unsigned)tok * 2048u + (unsigned)C[i] * 2u; }
                else off[h][i] = (unsigned)((R[i] + HALF * h) * 1024 + C[i]) * 2u;
            }
    }
};
__device__ __forceinline__ int moe_tables(LAS int* tab, const unsigned* cntw) {
    if (threadIdx.x == 0) { int s = 0; for (int e = 0; e < NE; ++e) { const int c = (int)cntw[e]; tab[T_CNT + e] = c; tab[T_BLKSTART + e] = s; const int nb = (c + 255) >> 8; for (int j = 0; j < nb; ++j) tab[T_BLKE + s + j] = e; s += nb; } tab[T_BLKSTART + NE] = s; }
    __syncthreads();
    return tab[T_BLKSTART + NE];
}
}
constexpr int NWAVES = 8, NTHREADS = 512;
constexpr int RING_BYTES = 131072, MISC_OFF = RING_BYTES, LDS_BYTES = 147456;

__device__ __forceinline__ void tr_item(const float* W, int ldw, int srccol0, int k0, bf16_t* WT, int Kd, int dstrow0, LAS float* scr, int lane) {
#pragma unroll 8
    for (int i = 0; i < 32; ++i) { const int kk = 2 * i + (lane >> 5); scr[kk * 33 + (lane & 31)] = W[(size_t)(k0 + kk) * ldw + srccol0 + (lane & 31)]; }
    asm volatile("s_waitcnt lgkmcnt(0)" ::: "memory");
    const int c = lane & 7;
#pragma unroll
    for (int j = 0; j < 4; ++j) { const int n = (lane >> 3) + 8 * j; const LAS float* s = scr + (8 * c) * 33 + n;
        u32x4 o; o.x = pk2(s[0 * 33], s[1 * 33]); o.y = pk2(s[2 * 33], s[3 * 33]); o.z = pk2(s[4 * 33], s[5 * 33]); o.w = pk2(s[6 * 33], s[7 * 33]);
        *(u32x4*)(WT + (size_t)(dstrow0 + n) * Kd + k0 + 8 * c) = o; }
    asm volatile("s_waitcnt lgkmcnt(0)" ::: "memory");
}
constexpr int I_IN = 16 * 120, I_OUT = 16 * 32, I_PG = 16 * 32, I_PP = 4 * 32, I_GU1 = 16 * 64, I_DN1 = 16 * 32;
constexpr int I_SMALL = I_IN + I_OUT + I_PG + I_PP, I_GU = NE * I_GU1, I_DN = NE * I_DN1, I_ALL = I_SMALL + I_GU + I_DN;
__device__ __forceinline__ void prep_item(KPR P, int it, LAS float* scr, int lane) {
    unsigned char* ws = P.ws;
    if (it < I_IN) { const int kb = it / 120, nb = it % 120, n0 = nb * 32, pn = n0 >> 8, j0 = n0 & 255;
        const int src = pn < 4 ? (pn * 256 + 64 * ((j0 & 127) >> 5) + 32 * (j0 >> 7)) : (n0 < 2048 ? n0 : n0 + 8);
        tr_item(P.w_in, INW, src, kb * 64, (bf16_t*)(ws + WS_WIN), 1024, n0, scr, lane); return; }
    it -= I_IN;
    if (it < I_OUT) { tr_item(P.w_out, 1024, (it % 32) * 32, (it / 32) * 64, (bf16_t*)(ws + WS_WOUT), 1024, (it % 32) * 32, scr, lane); return; }
    it -= I_OUT;
    if (it < I_PG) { tr_item(P.w_pg, 1024, (it % 32) * 32, (it / 32) * 64, (bf16_t*)(ws + WS_WPG), 1024, (it % 32) * 32, scr, lane); return; }
    it -= I_PG;
    if (it < I_PP) { tr_item(P.w_pp, 1024, (it % 32) * 32, (it / 32) * 64, (bf16_t*)(ws + WS_WPP), 256, (it % 32) * 32, scr, lane); return; }
    it -= I_PP;
    if (it < I_GU) { const int e = it / I_GU1, r = it % I_GU1, kb = r / 64, nb = r % 64, n0 = nb * 32, pn = n0 >> 8, j0 = n0 & 255;
        const int src = (j0 >> 7) * 1024 + pn * 128 + (j0 & 127);
        tr_item(P.w_gu + (size_t)e * 1024 * 2048, 2048, src, kb * 64, (bf16_t*)(ws + WS_WGU) + (size_t)e * 2048 * 1024, 1024, n0, scr, lane); return; }
    it -= I_GU;
    { const int e = it / I_DN1, r = it % I_DN1, kb = r / 32, nb = r % 32;
        tr_item(P.w_down + (size_t)e * 1024 * 1024, 1024, nb * 32, kb * 64, (bf16_t*)(ws + WS_WDN) + (size_t)e * 1024 * 1024, 1024, nb * 32, scr, lane); }
}
__device__ __forceinline__ void phase_prep_weights(KPR P, LAS unsigned char* lds, int gw, int ngw, int wave, int lane) {
    LAS float* scr = (LAS float*)(lds + wave * 16384);
    for (int it = gw; it < I_ALL; it += ngw) prep_item(P, it, scr, lane);
}
__device__ __forceinline__ void phase_cvt_p(KPR P, int gt, int ngt) {
    bf16_t* PB = (bf16_t*)((unsigned char*)P.out + DO_PB);
    for (int i = gt; i < NTOK * PLE / 8; i += ngt) { const f32x4 a = ((const f32x4*)P.p)[2 * i], b = ((const f32x4*)P.p)[2 * i + 1];
        u32x4 w; w.x = pk2(a[0], a[1]); w.y = pk2(a[2], a[3]); w.z = pk2(b[0], b[1]); w.w = pk2(b[2], b[3]); ((u32x4*)PB)[i] = w; }
}
__device__ __forceinline__ void rms_row(const float* xrow, const float* gain, int lane, f32x4 (&v)[4]) {
    const f32x4* xr = (const f32x4*)xrow + lane; float s = 0.f;
#pragma unroll
    for (int j = 0; j < 4; ++j) { v[j] = xr[64 * j]; s += (v[j][0] * v[j][0] + v[j][1] * v[j][1]) + (v[j][2] * v[j][2] + v[j][3] * v[j][3]); }
    const float rstd = rsqrtf(wave_sum(s) * (1.f / DM) + 1e-6f);
#pragma unroll
    for (int j = 0; j < 4; ++j) v[j] = v[j] * rstd * ((const f32x4*)gain)[64 * j + lane];
}
__device__ __forceinline__ void store_row_bf16(bf16_t* orow, int lane, const f32x4 (&v)[4]) {
    u32x2* o8 = (u32x2*)orow + lane;
#pragma unroll
    for (int j = 0; j < 4; ++j) { u32x2 w; w.x = pk2(v[j][0], v[j][1]); w.y = pk2(v[j][2], v[j][3]); o8[64 * j] = w; }
}
__device__ __forceinline__ void norm1_row(KPR P, int row, int lane, const LAS float* wff, LAS float* lf_out  ) {
    f32x4 v[4]; rms_row(P.x + (size_t)row * DM, P.mix_norm, lane, v);
    store_row_bf16((bf16_t*)(P.ws + WS_XN) + (size_t)row * DM, lane, v);
    float ff[8];
#pragma unroll
    for (int q = 0; q < 8; ++q) ff[q] = 0.f;
#pragma unroll
    for (int j = 0; j < 4; ++j)
#pragma unroll
        for (int i = 0; i < 4; ++i) { const LAS f32x4* w = (const LAS f32x4*)(wff + (size_t)(4 * (64 * j + lane) + i) * 8); const f32x4 w0 = w[0], w1 = w[1]; const float h = v[j][i];
            ff[0] += h * w0[0]; ff[1] += h * w0[1]; ff[2] += h * w0[2]; ff[3] += h * w0[3]; ff[4] += h * w1[0]; ff[5] += h * w1[1]; ff[6] += h * w1[2]; ff[7] += h * w1[3]; }
#pragma unroll
    for (int q = 0; q < 8; ++q) ff[q] = wave_sum(ff[q]);
    if (lane < 8) { float f = ff[0];
#pragma unroll
        for (int q = 1; q < 8; ++q) f = (lane == q) ? ff[q] : f;
        lf_out[lane] = logsigmoidf_(f + P.f_bias[lane]); }
}
__device__ __forceinline__ void load_wff(KPR P, LAS float* wff, int tid, int nthr) {
    for (int i = tid; i < 1024 * 8; i += nthr) wff[i] = P.w_in[(size_t)(i >> 3) * INW + 2048 + (i & 7)];
}
__device__ __forceinline__ void final_row(KPR P, int row, int lane, bool dead) {
    f32x4 v[4]; rms_row((const float*)(P.ws + WS_X1) + (size_t)row * DM, P.final_norm, lane, v);
    f32x4* o = (f32x4*)(P.out + (size_t)row * DM) + lane;
#pragma unroll
    for (int j = 0; j < 4; ++j) { if (dead) { const float q = __builtin_nanf(""); v[j] = (f32x4){q, q, q, q}; } o[64 * j] = v[j]; }
}
typedef GAS unsigned gu32;
#define RLX_AGENT __ATOMIC_RELAXED, __HIP_MEMORY_SCOPE_AGENT
#define XB_TMO      128
#define XB_XCNT(j)  (256  + 64 * (j))
#define XB_XSUB(j)  (1280 + 64 * (j))
#define XB_XGEN(j)  (2304 + 64 * (j))
#define XB_TOP      3328
#define XB_TOPGEN   3392
#define XCD_BAR_WORDS 3456
#define XB_SPIN_CAP (1u << 22)

__device__ __forceinline__ unsigned xb_ld(unsigned* p)              { return __hip_atomic_load(p, __ATOMIC_RELAXED, __HIP_MEMORY_SCOPE_AGENT); }
__device__ __forceinline__ unsigned xb_add(unsigned* p, unsigned v) { return __hip_atomic_fetch_add(p, v, __ATOMIC_RELAXED, __HIP_MEMORY_SCOPE_AGENT); }
__device__ __forceinline__ unsigned xb_xcc_id() { return (unsigned)__builtin_amdgcn_s_getreg((3 << 11) | 20) & 0xFu; }
#define XB_SPIN(cond, bar) do { unsigned _sp = 0; while (cond) { __builtin_amdgcn_s_sleep(1); \
    if ((++_sp & 255u) == 0u) { if (xb_ld(&(bar)[XB_TMO])) break; if (_sp > XB_SPIN_CAP) { atomicAdd(&(bar)[XB_TMO], 1u); break; } } } } while (0)

struct XcdBarrier { unsigned* bar; unsigned x; volatile LAS unsigned* st; };

__device__ __forceinline__ XcdBarrier xcd_barrier_post(unsigned* bar, volatile LAS unsigned* st) {
    XcdBarrier b; b.bar = bar; b.x = xb_xcc_id(); b.st = st;
    if (threadIdx.x == 0) (void)xb_add(&bar[XB_XCNT(b.x)], 1u);
    return b;
}
__device__ __forceinline__ void xcd_barrier_complete(unsigned* bar, unsigned x, unsigned& nloc, unsigned& nx) {
    const unsigned G = gridDim.x * gridDim.y * gridDim.z;
    unsigned sum, cnt, mine, sp = 0u;
    for (;;) {
        sum = 0u; cnt = 0u; mine = 0u;
#pragma unroll
        for (unsigned j = 0; j < 16; ++j) { const unsigned c = xb_ld(&bar[XB_XCNT(j)]); sum += c; cnt += (c > 0u) ? 1u : 0u; mine = (j == x) ? c : mine; }
        if (sum == G) break;
        __builtin_amdgcn_s_sleep(1);
        if ((++sp & 255u) == 0u) { if (xb_ld(&bar[XB_TMO])) break; if (sp > XB_SPIN_CAP) { atomicAdd(&bar[XB_TMO], 1u); break; } }
    }
    nloc = mine > 0u ? mine : 1u; nx = cnt > 0u ? cnt : 1u;
}
__device__ __forceinline__ void xcd_barrier(const XcdBarrier& b) {
    asm volatile("s_waitcnt vmcnt(0)" ::: "memory");
    __syncthreads();
    if (threadIdx.x == 0) {
        unsigned* bar = b.bar;
        __builtin_amdgcn_s_waitcnt(0);
        unsigned nloc = b.st[0], nx = b.st[1];
        if (nloc == 0u) { xcd_barrier_complete(bar, b.x, nloc, nx); b.st[0] = nloc; b.st[1] = nx; }
        const unsigned old = xb_add(&bar[XB_XSUB(b.x)], 1u);
        const unsigned gen = old / nloc;
        if (old + 1u == (gen + 1u) * nloc) {
            __builtin_amdgcn_fence(__ATOMIC_RELEASE, "agent");
            asm volatile("s_waitcnt vmcnt(0)" ::: "memory");
            const unsigned og = xb_add(&bar[XB_TOP], 1u);
            const unsigned tg = og / nx;
            if (og + 1u == (tg + 1u) * nx) xb_add(&bar[XB_TOPGEN], 1u);
            else XB_SPIN(xb_ld(&bar[XB_TOPGEN]) == tg, bar);
            __builtin_amdgcn_fence(__ATOMIC_ACQUIRE, "agent");
            xb_add(&bar[XB_XGEN(b.x)], 1u);
            asm volatile("s_waitcnt vmcnt(0)" ::: "memory");
        } else {
            XB_SPIN(xb_ld(&bar[XB_XGEN(b.x)]) == gen, bar);
            __builtin_amdgcn_fence(__ATOMIC_ACQUIRE, "agent");
            asm volatile("s_waitcnt vmcnt(0)" ::: "memory");
        }
    }
    __syncthreads();
}
namespace rk {
constexpr int MB = 8192;
constexpr int S_AT = 0, S_RT = 1, S_KT = 2, S_BT = 3, S_ATT = 4, S_KTT = 5, S_BTT = 6, S_VT = 7, S_N = 8, S_NT = 9, S_MAK = 10, S_MRB = 11, S_MRK = 12, S_TA = 13, S_TB = 14;
constexpr int SCR = 15 * MB;
constexpr int NCHUNK = SEQ / 64;
constexpr size_t WS_HT = WS_X1;
constexpr size_t WS_Y0 = WS_X1 + 64 * MiB;
constexpr size_t WS_QI = WS_X1 + 96 * MiB;
constexpr size_t WS_SC = WS_RW + 224 * MiB;
constexpr size_t DO_GT = 80 * MiB;
static_assert(WS_SC + 32 * MiB <= WS_END, "rwkv blobs");

__device__ __forceinline__ int moff(int row, int col) { return row * 128 + ((((col >> 3) ^ (row >> 1)) & 7) << 4) + (col & 7) * 2; }
__device__ __forceinline__ int crow(int r, int hi) { return (r & 3) + 8 * (r >> 2) + 4 * hi; }
__device__ __forceinline__ f32x16 mm_nt(const LAS unsigned char* A, int ar0, const LAS unsigned char* Bt, int br0, f32x16 acc, int r32, int hi) {
#pragma unroll
    for (int ks = 0; ks < 4; ++ks) { const bf16x8 a = *(const LAS bf16x8*)(A + moff(ar0 + r32, 16 * ks + 8 * hi)), b = *(const LAS bf16x8*)(Bt + moff(br0 + r32, 16 * ks + 8 * hi));
        acc = __builtin_amdgcn_mfma_f32_32x32x16_bf16(a, b, acc, 0, 0, 0); }
    return acc;
}
__device__ __forceinline__ void store_t(LAS unsigned char* dst, const f32x16& acc, int i0, int j0, int r32, int hi) {
#pragma unroll
    for (int g = 0; g < 4; ++g) { u32x2 w; w.x = pk2(acc[4 * g], acc[4 * g + 1]); w.y = pk2(acc[4 * g + 2], acc[4 * g + 3]); *(LAS u32x2*)(dst + moff(j0 + r32, i0 + 8 * g + 4 * hi)) = w; }
}
template <int MODE> __device__ __forceinline__ void mask_tri(f32x16& acc, int i0, int j0, int r32, int hi) {
#pragma unroll
    for (int r = 0; r < 16; ++r) { const int i = i0 + crow(r, hi), j = j0 + r32; const bool keep = MODE == 0 ? (j < i) : (MODE == 1 ? (i < j) : (i <= j)); if (!keep) acc[r] = 0.f; }
}

__device__ __forceinline__ void pass1_chunk(KPR P, LAS unsigned char* lds, int bh, int c, int tid) {
    const int lane = tid & 63, wave = tid >> 6, r32 = lane & 31, hi = lane >> 5, grp = wave >> 2, wq = wave & 3, i0 = 32 * (wq >> 1), j0 = 32 * (wq & 1);
    const int b = bh >> 3, h = bh & 7; const size_t tok0 = (size_t)b * SEQ + (size_t)c * 64; const size_t ci = (size_t)bh * NCHUNK + c;
    LAS float* part = (LAS float*)(lds + SCR); LAS float* WL = (LAS float*)(lds + SCR + 2048);
#define MAT(s) (lds + (s) * MB)
    {
        const bf16_t* RR = (const bf16_t*)(P.ws + WS_RR); const bf16_t* RK = (const bf16_t*)(P.ws + WS_RK); const bf16_t* RV = (const bf16_t*)(P.ws + WS_RV);
        const bf16_t* RLW = (const bf16_t*)(P.ws + WS_RLW); const bf16_t* RKK = (const bf16_t*)(P.ws + WS_RKK); const bf16_t* RKA = (const bf16_t*)(P.ws + WS_RKA);
        const int ch = tid & 63, tq = tid >> 6; const size_t base = (tok0 + 8 * tq) * 512 + h * 64 + ch;
        float cum[8]; float run = 0.f;
#pragma unroll
        for (int i = 0; i < 8; ++i) { run += bf2f(RLW[base + (size_t)i * 512]); cum[i] = run; }
        part[tq * 64 + ch] = run;
        __syncthreads();
        float pre = 0.f;
#pragma unroll
        for (int g = 0; g < 8; ++g) { const float pv = part[g * 64 + ch]; pre += (g < tq) ? pv : 0.f; }
        float eprev = __expf(pre);
        unsigned atT[4], ktT[4], btT[4], vT[4]; unsigned short hold[4] = {0, 0, 0, 0};
#pragma unroll
        for (int i = 0; i < 8; ++i) { const int t = 8 * tq + i; const size_t o = base + (size_t)i * 512;
            const float cm = pre + cum[i], e1 = __expf(cm), einv = __expf(-cm);
            const float r = bf2f(RR[o]), k = bf2f(RK[o]), kk = bf2f(RKK[o]), ka = bf2f(RKA[o]);
            const unsigned short at = (unsigned short)f2bf(-kk * eprev), rt = (unsigned short)f2bf(r * e1), kt = (unsigned short)f2bf(k * einv), bt = (unsigned short)f2bf(ka * einv), vv = RV[o];
            eprev = e1;
            *(LAS unsigned short*)(MAT(S_AT) + moff(t, ch)) = at; *(LAS unsigned short*)(MAT(S_RT) + moff(t, ch)) = rt; *(LAS unsigned short*)(MAT(S_KT) + moff(t, ch)) = kt; *(LAS unsigned short*)(MAT(S_BT) + moff(t, ch)) = bt;
            if (i & 1) { atT[i >> 1] = hold[0] | ((unsigned)at << 16); ktT[i >> 1] = hold[1] | ((unsigned)kt << 16); btT[i >> 1] = hold[2] | ((unsigned)bt << 16); vT[i >> 1] = hold[3] | ((unsigned)vv << 16); }
            else { hold[0] = at; hold[1] = kt; hold[2] = bt; hold[3] = vv; }
            if (i == 7 && tq == 7) WL[ch] = e1; }
        *(LAS u32x4*)(MAT(S_ATT) + moff(ch, 8 * tq)) = (u32x4){atT[0], atT[1], atT[2], atT[3]}; *(LAS u32x4*)(MAT(S_KTT) + moff(ch, 8 * tq)) = (u32x4){ktT[0], ktT[1], ktT[2], ktT[3]};
        *(LAS u32x4*)(MAT(S_BTT) + moff(ch, 8 * tq)) = (u32x4){btT[0], btT[1], btT[2], btT[3]}; *(LAS u32x4*)(MAT(S_VT) + moff(ch, 8 * tq)) = (u32x4){vT[0], vT[1], vT[2], vT[3]};
    }
    __syncthreads();
    const f32x16 zero = f32x16{};
    if (grp == 0) { f32x16 d = mm_nt(MAT(S_AT), i0, MAT(S_BT), j0, zero, r32, hi); mask_tri<0>(d, i0, j0, r32, hi); store_t(MAT(S_NT), d, i0, j0, r32, hi);
        d = mm_nt(MAT(S_KT), i0, MAT(S_AT), j0, zero, r32, hi); mask_tri<1>(d, i0, j0, r32, hi); store_t(MAT(S_MAK), d, i0, j0, r32, hi);
        d = mm_nt(MAT(S_KT), i0, MAT(S_RT), j0, zero, r32, hi); mask_tri<2>(d, i0, j0, r32, hi); store_t(MAT(S_MRK), d, i0, j0, r32, hi); }
    else { f32x16 d = mm_nt(MAT(S_BT), i0, MAT(S_AT), j0, zero, r32, hi); mask_tri<1>(d, i0, j0, r32, hi); store_t(MAT(S_N), d, i0, j0, r32, hi);
#pragma unroll
        for (int r = 0; r < 16; ++r) if (i0 + crow(r, hi) == j0 + r32) d[r] = 1.0f;
        store_t(MAT(S_TA), d, i0, j0, r32, hi);
        d = mm_nt(MAT(S_BT), i0, MAT(S_RT), j0, zero, r32, hi); mask_tri<2>(d, i0, j0, r32, hi); store_t(MAT(S_MRB), d, i0, j0, r32, hi); }
    __syncthreads();
#pragma unroll
    for (int s = 1; s <= 6; ++s) {
        const int mc = (s & 1) ? S_N : S_AT, mcT = (s & 1) ? S_NT : S_KT, mn = (s & 1) ? S_AT : S_N, mnT = (s & 1) ? S_KT : S_NT;
        const int tc = (s & 1) ? S_TB : S_TA, tn = (s & 1) ? S_TA : S_TB;
        if (s <= 5) {
            if (grp == 0) { const f32x16 d = mm_nt(MAT(mc), i0, MAT(mcT), j0, zero, r32, hi); store_t(MAT(mnT), d, i0, j0, r32, hi); }
            else { const f32x16 d = mm_nt(MAT(mcT), i0, MAT(mc), j0, zero, r32, hi); store_t(MAT(mn), d, i0, j0, r32, hi); }
        }
        if (s >= 2 && grp == (s <= 5 ? 0 : 1) ) {
            f32x16 d = mm_nt(MAT(mcT), i0, MAT(tc), j0, zero, r32, hi);
#pragma unroll
            for (int g = 0; g < 4; ++g) { const u32x2 tv = *(const LAS u32x2*)(MAT(tc) + moff(j0 + r32, i0 + 8 * g + 4 * hi)); d[4 * g] += bflo(tv.x); d[4 * g + 1] += bfhi(tv.x); d[4 * g + 2] += bflo(tv.y); d[4 * g + 3] += bfhi(tv.y); }
            store_t(MAT(tn), d, i0, j0, r32, hi);
        }
        __syncthreads();
    }
    if (grp == 0) { const f32x16 d = mm_nt(MAT(S_TB), i0, MAT(S_ATT), j0, zero, r32, hi); store_t(MAT(S_BT), d, i0, j0, r32, hi); }
    else { const f32x16 d = mm_nt(MAT(S_MAK), i0, MAT(S_VT), j0, zero, r32, hi); store_t(MAT(S_N), d, i0, j0, r32, hi); }
    __syncthreads();
    if (grp == 0) { const f32x16 d = mm_nt(MAT(S_TB), i0, MAT(S_N), j0, zero, r32, hi); store_t(MAT(S_NT), d, i0, j0, r32, hi);
        f32x16 q = mm_nt(MAT(S_BT), i0, MAT(S_MRB), j0, zero, r32, hi);
#pragma unroll
        for (int g = 0; g < 4; ++g) { const u32x2 rv = *(const LAS u32x2*)(MAT(S_RT) + moff(j0 + r32, i0 + 8 * g + 4 * hi)); q[4 * g] += bflo(rv.x); q[4 * g + 1] += bfhi(rv.x); q[4 * g + 2] += bflo(rv.y); q[4 * g + 3] += bfhi(rv.y); }
        store_t(MAT(S_KT), q, i0, j0, r32, hi); }
    else { f32x16 g_ = mm_nt(MAT(S_BT), i0, MAT(S_BTT), j0, zero, r32, hi);
        const float wl = WL[j0 + r32];
#pragma unroll
        for (int r = 0; r < 16; ++r) { if (i0 + crow(r, hi) == j0 + r32) g_[r] += 1.0f; g_[r] *= wl; }
        store_t(MAT(S_AT), g_, i0, j0, r32, hi); }
    __syncthreads();
    if (grp == 0) { f32x16 d = mm_nt(MAT(S_BTT), i0, MAT(S_NT), j0, zero, r32, hi); d = mm_nt(MAT(S_KTT), i0, MAT(S_VT), j0, d, r32, hi);
        float* HT = (float*)(P.ws + WS_HT) + ci * 4096 + (size_t)wq * 1024 + lane;
#pragma unroll
        for (int g = 0; g < 4; ++g) { const f32x4 wl4 = *(const LAS f32x4*)(WL + i0 + 8 * g + 4 * hi);
#pragma unroll
            for (int i = 0; i < 4; ++i) HT[(4 * g + i) * 64] = d[4 * g + i] * wl4[i]; } }
    else { f32x16 d = mm_nt(MAT(S_MRB), i0, MAT(S_NT), j0, zero, r32, hi); d = mm_nt(MAT(S_MRK), i0, MAT(S_VT), j0, d, r32, hi);
        unsigned* Y0 = (unsigned*)(P.ws + WS_Y0) + ci * 2048 + (size_t)wq * 512 + lane;
#pragma unroll
        for (int r2 = 0; r2 < 8; ++r2) Y0[r2 * 64] = pk2(d[2 * r2], d[2 * r2 + 1]); }
    { u32x4* GTg = (u32x4*)((unsigned char*)P.out + DO_GT + ci * MB); u32x4* QIg = (u32x4*)(P.ws + WS_QI + ci * MB);
        GTg[tid] = *(const LAS u32x4*)(MAT(S_AT) + tid * 16); QIg[tid] = *(const LAS u32x4*)(MAT(S_KT) + tid * 16); }
    __syncthreads();
#undef MAT
}

__device__ __forceinline__ void pass2_seq(KPR P, LAS unsigned char* lds, int bh, int tid) {
    const int lane = tid & 63, wave = tid >> 6, r32 = lane & 31, hi = lane >> 5, wq = wave & 3, i0 = 32 * (wq >> 1), j0 = 32 * (wq & 1);
    LAS unsigned char* Sm = lds; LAS unsigned char* G0 = lds + MB; LAS unsigned char* G1 = lds + 2 * MB;
    const size_t ci0 = (size_t)bh * NCHUNK;
    const u32x4* GTg = (const u32x4*)((const unsigned char*)P.out + DO_GT + ci0 * MB); u32x4* SCg = (u32x4*)(P.ws + WS_SC + ci0 * MB);
    const float* HT = (const float*)(P.ws + WS_HT) + ci0 * 4096 + (size_t)wq * 1024 + lane;
    *(LAS u32x4*)(Sm + tid * 16) = (u32x4){0u, 0u, 0u, 0u};
    *(LAS u32x4*)(G0 + tid * 16) = GTg[tid];
    u32x4 gnext = GTg[512 + tid];
    f32x16 hcur, hnext;
    if (wave < 4) {
#pragma unroll
        for (int r = 0; r < 16; ++r) { hcur[r] = HT[r * 64]; hnext[r] = HT[4096 + r * 64]; } }
    __syncthreads();
    for (int c = 0; c < NCHUNK; ++c) {
        LAS unsigned char* Gc = (c & 1) ? G1 : G0; LAS unsigned char* Gn = (c & 1) ? G0 : G1;
        SCg[(size_t)c * 512 + tid] = *(const LAS u32x4*)(Sm + tid * 16);
        f32x16 d = hcur;
        if (wave < 4) d = mm_nt(Gc, i0, Sm, j0, d, r32, hi);
        __syncthreads();
        if (wave < 4) store_t(Sm, d, i0, j0, r32, hi);
        *(LAS u32x4*)(Gn + tid * 16) = gnext;
        const int c2 = (c + 2 < NCHUNK) ? c + 2 : NCHUNK - 1;
        gnext = GTg[(size_t)c2 * 512 + tid];
        if (wave < 4) { hcur = hnext;
#pragma unroll
            for (int r = 0; r < 16; ++r) hnext[r] = HT[(size_t)c2 * 4096 + r * 64]; }
        __syncthreads();
    }
}

__device__ __forceinline__ void pass3_chunk(KPR P, LAS unsigned char* lds, int bh, int c, int tid) {
    const int lane = tid & 63, wave = tid >> 6, r32 = lane & 31, hi = lane >> 5, wq = wave & 3, i0 = 32 * (wq >> 1), j0 = 32 * (wq & 1);
    const int b = bh >> 3, h = bh & 7; const size_t tok0 = (size_t)b * SEQ + (size_t)c * 64; const size_t ci = (size_t)bh * NCHUNK + c;
    LAS unsigned char* Qm = lds; LAS unsigned char* Sm = lds + MB; LAS float* Yl = (LAS float*)(lds + 2 * MB);
    *(LAS u32x4*)(Qm + tid * 16) = ((const u32x4*)(P.ws + WS_QI + ci * MB))[tid];
    *(LAS u32x4*)(Sm + tid * 16) = ((const u32x4*)(P.ws + WS_SC + ci * MB))[tid];
    f32x16 d = f32x16{};
    if (wave < 4) { const unsigned* Y0 = (const unsigned*)(P.ws + WS_Y0) + ci * 2048 + (size_t)wq * 512 + lane;
#pragma unroll
        for (int r2 = 0; r2 < 8; ++r2) { const unsigned w = Y0[r2 * 64]; d[2 * r2] = bflo(w); d[2 * r2 + 1] = bfhi(w); } }
    __syncthreads();
    if (wave < 4) { d = mm_nt(Qm, i0, Sm, j0, d, r32, hi);
#pragma unroll
        for (int r = 0; r < 16; ++r) Yl[(i0 + crow(r, hi)) * 65 + j0 + r32] = d[r]; }
    __syncthreads();
    const bf16_t* RR = (const bf16_t*)(P.ws + WS_RR); const bf16_t* RK = (const bf16_t*)(P.ws + WS_RK); const bf16_t* RV = (const bf16_t*)(P.ws + WS_RV); const bf16_t* RG = (const bf16_t*)(P.ws + WS_RG);
    bf16_t* AO = (bf16_t*)(P.ws + WS_AO); const int cc = h * 64 + lane;
    const float lnw = P.ln_w[cc], lnb = P.ln_b[cc], rkc = P.r_k[cc];
#pragma unroll
    for (int i = 0; i < 8; ++i) { const int t = wave * 8 + i; const size_t tok = tok0 + t, o = tok * 512 + cc;
        const float y = Yl[t * 65 + lane], mean = wave_sum(y) * (1.f / 64.f), dv = y - mean, var = wave_sum(dv * dv) * (1.f / 64.f);
        const float yn = dv * rsqrtf(var + 64e-5f) * lnw + lnb;
        const float r = bf2f(RR[o]), k = bf2f(RK[o]), v = bf2f(RV[o]), g = bf2f(RG[o]);
        const float bonus = wave_sum(r * k * rkc) * v;
        AO[tok * DM + 512 + cc] = (bf16_t)f2bf((yn + bonus) * g); }
}
}
__device__ __forceinline__ int crow(int r, int hi) { return (r & 3) + 8 * (r >> 2) + 4 * hi; }
constexpr int CW_QATT = 128;
constexpr int MISC_TAB = 64, MISC_Q = 4096, MISC_PFX = 4160;

__device__ __forceinline__ void attn_unit_v2(KPR P, LAS unsigned char* lds, int bh, int qb) {
    LAS bf16_t* Ks = (LAS bf16_t*)lds;
    LAS bf16_t* Vt = (LAS bf16_t*)(lds + 9216);
    LAS float* wsf = (LAS float*)(lds + 18432);
    const bf16_t* Z = (const bf16_t*)(P.ws + WS_Z); bf16_t* AO = (bf16_t*)(P.ws + WS_AO);
    const int tid = threadIdx.x, lane = tid & 63, w = tid >> 6, r32 = lane & 31, hi = lane >> 5;
    const int b = bh >> 3, h = bh & 7, q0 = qb * 256;
    const size_t rowbase = (size_t)b * SEQ;
    const float* c2 = (const float*)(P.ws + WS_C2) + (size_t)bh * SEQ;
    const int qloc = q0 + 32 * w + r32;
    const bf16_t* Qp = Z + (rowbase + qloc) * ZW + ZQ + h * 64;
    bf16x8 qr[4];
#pragma unroll
    for (int ks = 0; ks < 4; ++ks) qr[ks] = *(const bf16x8*)(Qp + ks * 16 + hi * 8);
    const float cq = c2[qloc];
    float m = -1e30f, l = 0.f; f32x16 o[2]; o[0] = f32x16{}; o[1] = f32x16{};
    const int ntiles = (q0 + 256) / 64;
    LAS float* wsw = wsf + w * 64;
    int t0 = 0;
    { float gq = fabsf(P.q_norm[lane]), gk = fabsf(P.k_norm[lane]);
#pragma unroll
        for (int o = 1; o < 64; o <<= 1) { gq = fmaxf(gq, __shfl_xor(gq, o)); gk = fmaxf(gk, __shfl_xor(gk, o)); }
        const float thr = c2[q0] + (2.0f * 8.0f * LOG2E * gq * gk + 40.0f);
        const int nfull = q0 / 64;
        for (int tb = 0; tb < nfull; tb += 64) { const int tt = tb + lane; const bool sk = (tt < nfull) && (c2[tt * 64 + 63] > thr); const unsigned long long bm = __ballot(sk); t0 += __popcll(bm); if (bm != ~0ull) break; } }
    for (int t = t0; t < ntiles; ++t) {
        __syncthreads();
        { const int row = tid >> 3, ch = tid & 7; const bf16_t* src = Z + (rowbase + t * 64 + row) * ZW + h * 64 + ch * 8;
            *(LAS u32x4*)&Ks[row * 72 + ch * 8] = *(const u32x4*)(src + ZK);
            const u32x4 v = *(const u32x4*)(src + ZV); const unsigned vv[4] = {v.x, v.y, v.z, v.w};
#pragma unroll
            for (int e = 0; e < 4; ++e) { Vt[(ch * 8 + 2 * e) * 72 + row] = (bf16_t)(vv[e] & 0xffffu); Vt[(ch * 8 + 2 * e + 1) * 72 + row] = (bf16_t)(vv[e] >> 16); } }
        __syncthreads();
        if (t * 64 > q0 + 32 * w + 31) continue;
        f32x16 p[2];
#pragma unroll
        for (int g = 0; g < 2; ++g) { p[g] = f32x16{};
#pragma unroll
            for (int ks = 0; ks < 4; ++ks) { const bf16x8 kf = *(const LAS bf16x8*)&Ks[(32 * g + r32) * 72 + ks * 16 + hi * 8]; p[g] = __builtin_amdgcn_mfma_f32_32x32x16_bf16(kf, qr[ks], p[g], 0, 0, 0); } }
        float mx = -1e30f;
#pragma unroll
        for (int g = 0; g < 2; ++g)
#pragma unroll
            for (int r4 = 0; r4 < 4; ++r4) { const int kv0 = t * 64 + 32 * g + 8 * r4 + 4 * hi; const f32x4 ck = *(const f32x4*)(c2 + kv0);
#pragma unroll
                for (int i = 0; i < 4; ++i) { float s = p[g][4 * r4 + i] + (cq - ck[i]); if (kv0 + i > qloc) s = -INFINITY; p[g][4 * r4 + i] = s; mx = fmaxf(mx, s); } }
        mx = fmaxf(mx, __shfl_xor(mx, 32));
        const float mnew = fmaxf(m, mx), alpha = exp2f(m - mnew); m = mnew;
        float ps = 0.f;
#pragma unroll
        for (int g = 0; g < 2; ++g)
#pragma unroll
            for (int r = 0; r < 16; ++r) { const float e = exp2f(p[g][r] - mnew); p[g][r] = e; ps += e; }
        l = l * alpha + ps;
        if (hi == 0) wsw[r32] = alpha;
        __builtin_amdgcn_wave_barrier(); asm volatile("s_waitcnt lgkmcnt(0)" ::: "memory");
#pragma unroll
        for (int r4 = 0; r4 < 4; ++r4) { const f32x4 al = *(const LAS f32x4*)&wsw[8 * r4 + 4 * hi];
#pragma unroll
            for (int i = 0; i < 4; ++i) { o[0][4 * r4 + i] *= al[i]; o[1][4 * r4 + i] *= al[i]; } }
#pragma unroll
        for (int g = 0; g < 2; ++g)
#pragma unroll
            for (int s = 0; s < 2; ++s) { u32x4 pw; pw.x = pk2(p[g][8 * s + 0], p[g][8 * s + 1]); pw.y = pk2(p[g][8 * s + 2], p[g][8 * s + 3]); pw.z = pk2(p[g][8 * s + 4], p[g][8 * s + 5]); pw.w = pk2(p[g][8 * s + 6], p[g][8 * s + 7]);
                const bf16x8 pa = __builtin_bit_cast(bf16x8, pw);
#pragma unroll
                for (int d0 = 0; d0 < 2; ++d0) { const u32x2 lo = *(const LAS u32x2*)&Vt[(32 * d0 + r32) * 72 + 32 * g + 16 * s + 4 * hi], hh = *(const LAS u32x2*)&Vt[(32 * d0 + r32) * 72 + 32 * g + 16 * s + 8 + 4 * hi];
                    u32x4 vw; vw.x = lo.x; vw.y = lo.y; vw.z = hh.x; vw.w = hh.y;
                    o[d0] = __builtin_amdgcn_mfma_f32_32x32x16_bf16(pa, __builtin_bit_cast(bf16x8, vw), o[d0], 0, 0, 0); } }
        __builtin_amdgcn_wave_barrier();
    }
    l += __shfl_xor(l, 32);
    __builtin_amdgcn_wave_barrier();
    if (hi == 0) wsw[32 + r32] = l;
    __builtin_amdgcn_wave_barrier(); asm volatile("s_waitcnt lgkmcnt(0)" ::: "memory");
#pragma unroll
    for (int r = 0; r < 16; ++r) { const int q = crow(r, hi); const float li = 1.0f / wsw[32 + q]; const size_t row = rowbase + q0 + 32 * w + q;
#pragma unroll
        for (int d0 = 0; d0 < 2; ++d0) { const int d = 32 * d0 + r32; const float og = bf2f(Z[row * ZW + ZOG + h * 64 + d]);
            AO[row * DM + h * 64 + d] = (bf16_t)f2bf(o[d0][r] * li * sigmoidf_(og)); } }
    __builtin_amdgcn_wave_barrier();
}

__device__ __forceinline__ float zlerp(const bf16_t* Z, size_t row, bool first, int col, const float* mu) {
    const float z1 = bf2f(Z[row * ZW + ZR + col]); const float z0 = first ? 0.f : bf2f(Z[(row - 1) * ZW + ZR + col]);
    return z1 + (z0 - z1) * mu[col];
}
__device__ __forceinline__ void rwkv_prep_group(KPR P, LAS float* xs  , int grp, int tid  ) {
    const bf16_t* Z = (const bf16_t*)(P.ws + WS_Z);
    const size_t row0 = (size_t)grp * 8;
    for (int tok = 0; tok < 8; ++tok) { const size_t row = row0 + tok; const bool first = (row % SEQ) == 0;
        const float z = zlerp(Z, row, first, RW_W + tid, P.mu);
        xs[tok * 256 + tid] = tid < 64 ? tanhf(z) : (tid < 128 ? z : sigmoidf_(z)); }
    __syncthreads();
    float lw[8][2], la[8][2], lg[8][2];
#pragma unroll
    for (int t = 0; t < 8; ++t)
#pragma unroll
        for (int c = 0; c < 2; ++c) { lw[t][c] = 0.f; la[t][c] = 0.f; lg[t][c] = 0.f; }
    for (int j = 0; j < 64; ++j) { const float w0 = P.w2[j * 512 + tid], w1 = P.w2[j * 512 + tid + 256], a0 = P.a2[j * 512 + tid], a1 = P.a2[j * 512 + tid + 256];
#pragma unroll
        for (int t = 0; t < 8; ++t) { const float xw = xs[t * 256 + j], xa = xs[t * 256 + 64 + j]; lw[t][0] += xw * w0; lw[t][1] += xw * w1; la[t][0] += xa * a0; la[t][1] += xa * a1; } }
    for (int j = 0; j < 128; ++j) { const float g0 = P.g2[j * 512 + tid], g1 = P.g2[j * 512 + tid + 256];
#pragma unroll
        for (int t = 0; t < 8; ++t) { const float xg = xs[t * 256 + 128 + j]; lg[t][0] += xg * g0; lg[t][1] += xg * g1; } }
    bf16_t* RR = (bf16_t*)(P.ws + WS_RR); bf16_t* RK = (bf16_t*)(P.ws + WS_RK); bf16_t* RV = (bf16_t*)(P.ws + WS_RV); bf16_t* RG = (bf16_t*)(P.ws + WS_RG);
    bf16_t* RLW = (bf16_t*)(P.ws + WS_RLW); bf16_t* RKK = (bf16_t*)(P.ws + WS_RKK); bf16_t* RKA = (bf16_t*)(P.ws + WS_RKA);
#pragma unroll
    for (int t = 0; t < 8; ++t) { const size_t row = row0 + t; const bool first = (row % SEQ) == 0;
#pragma unroll
        for (int c = 0; c < 2; ++c) { const int cc = tid + 256 * c;
            const float zr = zlerp(Z, row, first, RW_R + cc, P.mu), zk = zlerp(Z, row, first, RW_K + cc, P.mu), zv = zlerp(Z, row, first, RW_V + cc, P.mu);
            const float wl = P.w0[cc] + lw[t][c]; const float sp = fmaxf(-wl, 0.f) + log1pf(expf(-fabsf(wl)));
            const float logdecay = -expf(-sp - 0.5f);
            const float a = sigmoidf_(P.a0[cc] + la[t][c]);
            const float kkr = zk * P.k_k[cc]; const float ss = wave_sum(kkr * kkr); const float kk = kkr / fmaxf(sqrtf(ss), 1e-12f);
            const float kp = zk * (1.0f + (a - 1.0f) * P.k_a[cc]);
            const size_t o = row * 512 + cc;
            RR[o] = (bf16_t)f2bf(zr); RK[o] = (bf16_t)f2bf(kp); RV[o] = (bf16_t)f2bf(zv); RG[o] = (bf16_t)f2bf(lg[t][c]); RLW[o] = (bf16_t)f2bf(logdecay); RKK[o] = (bf16_t)f2bf(kk); RKA[o] = (bf16_t)f2bf(kk * a); } }
    __syncthreads();
}
__device__ __forceinline__ float rdlane(float v, int l) { unsigned r; asm volatile("s_nop 3\n\tv_readlane_b32 %0, %1, %2\n\ts_nop 3" : "=s"(r) : "v"(v), "s"(l)); return __builtin_bit_cast(float, r); }
__device__ __forceinline__ void route_row(KPR P, const LAS float* wr, int row, int lane) {
    unsigned* cnt = (unsigned*)(P.ws + WS_CTL) + CW_CNT; int* route = (int*)(P.ws + WS_ROUTE); int* tokslot = (int*)(P.ws + WS_TOKSLOT); float* gateslot = (float*)(P.ws + WS_GATESLOT);
    f32x4 v[4]; rms_row((const float*)(P.ws + WS_X1) + (size_t)row * DM, P.moe_norm, lane, v);
    store_row_bf16((bf16_t*)(P.ws + WS_XN) + (size_t)row * DM, lane, v);
    const int e = lane & 31;
    float acc = 0.f;
#pragma unroll
    for (int j = 0; j < 4; ++j)
_Pragma("nounroll")
        for (int l = 0; l < 64; ++l) {
            const float x0 = rdlane(v[j][0], l), x1 = rdlane(v[j][1], l), x2 = rdlane(v[j][2], l), x3 = rdlane(v[j][3], l);
            const int k = 256 * j + 4 * l;
            acc += x0 * wr[k * 32 + e]; acc += x1 * wr[(k + 1) * 32 + e]; acc += x2 * wr[(k + 2) * 32 + e]; acc += x3 * wr[(k + 3) * 32 + e];
        }
    float logit = acc + P.b_router[e];
    float tv[4]; int ti[4];
#pragma unroll
    for (int k = 0; k < 4; ++k) { float bv = logit; int bi = e;
#pragma unroll
        for (int o = 1; o < 32; o <<= 1) { const float ov = __shfl_xor(bv, o); const int oi = __shfl_xor(bi, o); if (ov > bv || (ov == bv && oi < bi)) { bv = ov; bi = oi; } }
        tv[k] = bv; ti[k] = bi; if (e == bi) logit = -INFINITY; }
    const float e0 = 1.f, e1 = expf(tv[1] - tv[0]), e2 = expf(tv[2] - tv[0]), e3 = expf(tv[3] - tv[0]), inv = 1.f / (e0 + e1 + e2 + e3);
    const float gt[4] = {e0 * inv, e1 * inv, e2 * inv, e3 * inv};
    if (lane < 4) { float g = gt[0]; int ex = ti[0];
#pragma unroll
        for (int k = 1; k < 4; ++k) { g = (lane == k) ? gt[k] : g; ex = (lane == k) ? ti[k] : ex; }
        const int rank = (int)atomicAdd(cnt + ex, 1u);
        tokslot[(size_t)ex * NTOK + rank] = row; gateslot[(size_t)ex * NTOK + rank] = g;
        route[(size_t)row * 12 + lane] = ex; route[(size_t)row * 12 + 4 + lane] = rank; }
}
__device__ __forceinline__ void combine_row(KPR P, const LAS int* tab, int row, int lane) {
    const int* route = (const int*)(P.ws + WS_ROUTE); const bf16_t* YP = (const bf16_t*)(P.ws + WS_YP); float* X = (float*)(P.ws + WS_X1);
    f32x4 v[4]; const f32x4* xr = (const f32x4*)(X + (size_t)row * DM) + lane;
#pragma unroll
    for (int j = 0; j < 4; ++j) v[j] = xr[64 * j];
#pragma unroll
    for (int k = 0; k < 4; ++k) { const int ex = route[(size_t)row * 12 + k], rank = route[(size_t)row * 12 + 4 + k]; const size_t pos = (size_t)tab[pg8::T_BLKSTART + ex] * 256 + rank;
        const u32x2* yr = (const u32x2*)(YP + pos * DM) + lane;
#pragma unroll
        for (int j = 0; j < 4; ++j) { const u32x2 y = yr[64 * j]; v[j][0] += bflo(y.x); v[j][1] += bfhi(y.x); v[j][2] += bflo(y.y); v[j][3] += bfhi(y.y); } }
    f32x4* xo = (f32x4*)(X + (size_t)row * DM) + lane; float s = 0.f;
#pragma unroll
    for (int j = 0; j < 4; ++j) { xo[64 * j] = v[j]; s += (v[j][0] * v[j][0] + v[j][1] * v[j][1]) + (v[j][2] * v[j][2] + v[j][3] * v[j][3]); }
    const float rstd = rsqrtf(wave_sum(s) * (1.f / DM) + 1e-6f);
#pragma unroll
    for (int j = 0; j < 4; ++j) v[j] = v[j] * rstd * ((const f32x4*)P.ple_norm)[64 * j + lane];
    store_row_bf16((bf16_t*)(P.ws + WS_XN) + (size_t)row * DM, lane, v);
}

constexpr int NPHASE = 13;
__global__ void __launch_bounds__(NTHREADS, 2) mega_fwd(Params Pkarg_unused) {
    extern __shared__ __attribute__((aligned(16))) unsigned char smem[];
    LAS unsigned char* lds = (LAS unsigned char*)smem;
    const int tid = threadIdx.x, lane = tid & 63, wave = __builtin_amdgcn_readfirstlane(tid >> 6);
    const int G = gridDim.x, blk = blockIdx.x;
#define P (*kpp)
#ifndef MK_REP
#define MK_REP -1
#endif
#define PHASE_BEGIN(k) if (IN(k)) for (int rep_ = 0; rep_ < ((k) == MK_REP ? 2 : 1); ++rep_) { const __attribute__((address_space(4))) Params* kpp = kp_fresh();
#define PHASE_END(k) } if (BOTH(k)) xcd_barrier(bar);
#define IN(k) (ph_lo <= (k) && (k) < ph_hi)
#define BOTH(k) (IN(k) && IN((k) + 1))
    const __attribute__((address_space(4))) Params* kpp = kp_fresh();
    unsigned* ctl = (unsigned*)(P.ws + WS_CTL);
    volatile LAS unsigned* MISC = (volatile LAS unsigned*)(lds + MISC_OFF);
    LAS int* tab = (LAS int*)(lds + MISC_OFF + MISC_TAB);
    if (tid < 16) MISC[tid] = 0u;
    __syncthreads();
    XcdBarrier bar = xcd_barrier_post(ctl + CW_BAR, MISC);
    unsigned char* const wsb = P.ws;
    const int ph_lo = P.ph_lo, ph_hi = P.ph_hi;

    PHASE_BEGIN(0)
        phase_prep_weights(P, lds, blk * NWAVES + wave, G * NWAVES, wave, lane);
        phase_cvt_p(P, blk * NTHREADS + tid, G * NTHREADS);
        __syncthreads();
        LAS float* wff = (LAS float*)lds; LAS float* lf = (LAS float*)(lds + 32768);
        load_wff(P, wff, tid, NTHREADS); __syncthreads();
        for (int i = 0; i < 16; ++i) { const int rl = wave * 16 + i; norm1_row(P, blk * 128 + rl, lane, wff, lf + rl * 8); }
        __syncthreads();
        if (tid < 8) { float run = 0.f; float* cloc = (float*)(P.ws + WS_LOGF) + (size_t)blk * 128 * 8 + tid;
            for (int r = 0; r < 128; ++r) { run += lf[r * 8 + tid]; cloc[r * 8] = run; }
            ((float*)(P.ws + WS_CTOT))[blk * 8 + tid] = run; }
        if (blk == 0) { bf16_t* zr = (bf16_t*)(P.ws + WS_XN) + (size_t)NTOK * DM; for (int i = tid; i < DM; i += NTHREADS) zr[i] = 0; }
    PHASE_END(0)

    PHASE_BEGIN(1)
        {
            LAS float* pfx = (LAS float*)(lds + MISC_OFF + MISC_PFX);
            if (tid < 8) { float s = 0.f; const float* ct = (const float*)(wsb + WS_CTOT); for (int j = (blk & ~63); j < blk; ++j) s += ct[j * 8 + tid]; pfx[tid] = s; }
            __syncthreads();
            const float* cloc = (const float*)(wsb + WS_LOGF) + (size_t)blk * 128 * 8; float* c2 = (float*)(P.ws + WS_C2);
            for (int i = tid; i < 1024; i += NTHREADS) { const int r = i >> 3, h = i & 7; const int row = blk * 128 + r, b = row >> 13, t = row & (SEQ - 1);
                c2[((size_t)(b * 8 + h)) * SEQ + t] = (cloc[i] + pfx[h]) * LOG2E; }
            __syncthreads();
        }
        {
            pg8::DenseOrder S{(const bf16_t*)(wsb + WS_XN), (const bf16_t*)(wsb + WS_WIN), 1024, NTOK / 256, ZW / 256, G, blk};
            pg8::EpiIn E{(bf16_t*)(P.ws + WS_Z), P.q_norm, P.k_norm};
            pg8::gemm_phase<pg8::EpiIn, pg8::DenseOrder, true>(lds, 1024, S, E);
        }
        {
            pg8::DenseOrder S{(const bf16_t*)((unsigned char*)P.out + DO_PB), (const bf16_t*)(wsb + WS_WPP), PLE, NTOK / 256, DM / 256, G, blk};
            pg8::EpiBf16 E{(bf16_t*)((unsigned char*)P.out + DO_PJ), DM};
            pg8::gemm_phase<pg8::EpiBf16, pg8::DenseOrder, true>(lds, PLE, S, E);
        }
    PHASE_END(1)

    PHASE_BEGIN(2)
        const int sub = tid >> 8, st = tid & 255; LAS float* xs = (LAS float*)(lds + sub * 8192);
        for (int it = 0; it < NTOK / 8 / (2 * 256); ++it) rwkv_prep_group(P, xs, (it * G + blk) * 2 + sub, st);
    PHASE_END(2)

    PHASE_BEGIN(3)
        for (int task = blk; task < NB * NH * rk::NCHUNK; task += G) rk::pass1_chunk(P, lds, task >> 7, task & 127, tid);
    PHASE_END(3)

    PHASE_BEGIN(4)
        if (blk < NB * NH) rk::pass2_seq(P, lds, blk, tid);
        for (;;) {
            __syncthreads();
            if (tid == 0) MISC[MISC_Q / 4] = __hip_atomic_fetch_add(ctl + CW_QATT + 64 * rep_, 1u, RLX_AGENT);
            __syncthreads();
            const int q = (int)MISC[MISC_Q / 4];
            if (q >= 1024) break;
            attn_unit_v2(P, lds, q & 31, 31 - (q >> 5));
        }
    PHASE_END(4)

    PHASE_BEGIN(5)
        for (int task = blk; task < NB * NH * rk::NCHUNK; task += G) rk::pass3_chunk(P, lds, task >> 7, task & 127, tid);
    PHASE_END(5)

    PHASE_BEGIN(6)
        pg8::DenseOrder S{(const bf16_t*)(wsb + WS_AO), (const bf16_t*)(wsb + WS_WOUT), 1024, NTOK / 256, DM / 256, G, blk};
        pg8::EpiOut E{P.x, (float*)(P.ws + WS_X1)};
        pg8::gemm_phase<pg8::EpiOut, pg8::DenseOrder, true>(lds, 1024, S, E);
    PHASE_END(6)

    PHASE_BEGIN(7)
        LAS float* wr = (LAS float*)lds;
        for (int i = tid; i < 1024 * 32; i += NTHREADS) wr[i] = P.w_router[i];
        __syncthreads();
        for (int row = blk * NWAVES + wave; row < NTOK; row += G * NWAVES) route_row(P, wr, row, lane);
    PHASE_END(7)

    PHASE_BEGIN(8)
        const int nblk = pg8::moe_tables(tab, (const unsigned*)(wsb + WS_CTL) + CW_CNT);
        pg8::MoeOrder S{(const bf16_t*)(wsb + WS_XN), (const bf16_t*)(wsb + WS_WGU), (const int*)(wsb + WS_TOKSLOT), tab, nblk, 8, G, blk, true};
        pg8::EpiGu E{(bf16_t*)(P.ws + WS_ACT), P.b_gu};
        pg8::gemm_phase<pg8::EpiGu, pg8::MoeOrder, true>(lds, 1024, S, E);
    PHASE_END(8)
    PHASE_BEGIN(9)
        const int nblk = pg8::moe_tables(tab, (const unsigned*)(wsb + WS_CTL) + CW_CNT);
        pg8::MoeOrder S{(const bf16_t*)(wsb + WS_ACT), (const bf16_t*)(wsb + WS_WDN), (const int*)(wsb + WS_TOKSLOT), tab, nblk, 4, G, blk, false};
        pg8::EpiDn E{(bf16_t*)(P.ws + WS_YP), P.b_down, (const float*)(wsb + WS_GATESLOT), tab};
        pg8::gemm_phase<pg8::EpiDn, pg8::MoeOrder, true>(lds, 1024, S, E);
    PHASE_END(9)
    PHASE_BEGIN(10)
        (void)pg8::moe_tables(tab, (const unsigned*)(wsb + WS_CTL) + CW_CNT);
        for (int row = blk * NWAVES + wave; row < NTOK; row += G * NWAVES) combine_row(P, tab, row, lane);
    PHASE_END(10)
    PHASE_BEGIN(11)
        pg8::DenseOrder S{(const bf16_t*)(wsb + WS_XN), (const bf16_t*)(wsb + WS_WPG), 1024, NTOK / 256, DM / 256, G, blk};
        pg8::EpiPg E{(float*)(P.ws + WS_X1), (const bf16_t*)((unsigned char*)P.out + DO_PJ)};
        pg8::gemm_phase<pg8::EpiPg, pg8::DenseOrder, true>(lds, 1024, S, E);
    PHASE_END(11)
    PHASE_BEGIN(12)
        const bool dead = __hip_atomic_load(ctl + CW_BAR + XB_TMO, RLX_AGENT) != 0u;
        for (int row = blk * NWAVES + wave; row < NTOK; row += G * NWAVES) final_row(P, row, lane, dead);
    PHASE_END(12)
}
#undef P
extern "C" void kernel_launch(void* const* d_in, const int* in_sizes, int n_in, void* d_out, int out_size, void* d_ws, size_t ws_size, hipStream_t stream) {
    static int ok = 0;
    if (ok == 0) {
        if (n_in != 30 || in_sizes[0] != NTOK * DM || out_size != NTOK * DM || ws_size < WS_END) { fprintf(stderr, "kernel_launch: unexpected shapes (n_in %d, ws %zu)\n", n_in, ws_size); ok = -1; return; }
        if (hipFuncSetAttribute((const void*)mega_fwd, hipFuncAttributeMaxDynamicSharedMemorySize, LDS_BYTES) != hipSuccess) { fprintf(stderr, "kernel_launch: hipFuncSetAttribute failed\n"); ok = -1; return; }
        int dev = 0, cus = 0, per_cu = 0;
        if (hipGetDevice(&dev) != hipSuccess || hipDeviceGetAttribute(&cus, hipDeviceAttributeMultiprocessorCount, dev) != hipSuccess) { ok = -1; return; }
        if (hipOccupancyMaxActiveBlocksPerMultiprocessor(&per_cu, (const void*)mega_fwd, NTHREADS, LDS_BYTES) != hipSuccess || per_cu < 1) { fprintf(stderr, "kernel_launch: occupancy query says %d\n", per_cu); }
        (void)hipGetLastError();
        if (cus != 256) { fprintf(stderr, "kernel_launch: built for 256 CUs, device has %d\n", cus); ok = -1; return; }
        ok = 1;
    }
    if (ok < 0) return;
    Params P{};
    const float** pp = (const float**)&P;
    for (int i = 0; i < 30; ++i) pp[i] = (const float*)d_in[i];
    P.out = (float*)d_out; P.ws = (unsigned char*)d_ws;
    if (hipMemsetAsync((char*)d_ws + WS_CTL, 0, CTL_BYTES, stream) != hipSuccess) return;
#ifndef MK_CUTS
#define MK_CUTS 0
#endif
    if (MK_CUTS == 0) { P.ph_lo = 0; P.ph_hi = NPHASE; hipLaunchKernelGGL(mega_fwd, dim3(256), dim3(NTHREADS), LDS_BYTES, stream, P); }
    else for (int k = 0; k < NPHASE; ++k) { P.ph_lo = k; P.ph_hi = k + 1;
        hipLaunchKernelGGL(mega_fwd, dim3(256), dim3(NTHREADS), LDS_BYTES, stream, P); }
}
```

```cpp
#include <hip/hip_runtime.h>
#include <cstdio>
#include <cstdint>

#define LAS __attribute__((address_space(3)))
#define GAS __attribute__((address_space(1)))
typedef unsigned short bf16_t;
typedef short bf16x8 __attribute__((ext_vector_type(8)));
typedef float f32x2 __attribute__((ext_vector_type(2)));
typedef float f32x4 __attribute__((ext_vector_type(4)));
typedef float f32x16 __attribute__((ext_vector_type(16)));
typedef unsigned u32x2 __attribute__((ext_vector_type(2)));
typedef unsigned u32x4 __attribute__((ext_vector_type(4)));

constexpr int NB = 4, SEQ = 8192, NTOK = NB * SEQ, DM = 1024;
constexpr int NH = 8, HD = 64;
constexpr int INW = 3848;
constexpr int ZW = 3840;
constexpr int ZQ = 0, ZK = 512, ZV = 1024, ZOG = 1536, ZR = 2048;
constexpr int RW_R = 0, RW_K = 512, RW_V = 1024, RW_W = 1536, RW_A = 1600, RW_G = 1664, RWIN = 1792;
constexpr int NE = 32, TOPK = 4, EFF = 1024;
constexpr int MAXBLK = (NTOK * TOPK) / 256 + NE;
constexpr int PLE = 256;
constexpr float LOG2E = 1.4426950408889634f;
constexpr float QSCALE = 0.125f * LOG2E;

constexpr size_t MiB = 1u << 20;
constexpr size_t WS_CTL = 0, CTL_BYTES = 1 * MiB;
constexpr size_t WS_C2 = 1 * MiB;
constexpr size_t WS_LOGF = 2 * MiB;
constexpr size_t WS_ROUTE = 3 * MiB;
constexpr size_t WS_TOKSLOT = 5 * MiB;
constexpr size_t WS_GATESLOT = 9 * MiB;
constexpr size_t WS_CTOT = 13 * MiB;
constexpr size_t WS_WIN = 16 * MiB;
constexpr size_t WS_WOUT = 24 * MiB;
constexpr size_t WS_WPG = 26 * MiB;
constexpr size_t WS_WPP = 28 * MiB;
constexpr size_t WS_WGU = 32 * MiB;
constexpr size_t WS_WDN = 160 * MiB;
constexpr size_t WS_XN = 224 * MiB;
constexpr size_t WS_X1 = 290 * MiB;
constexpr size_t WS_Z = 418 * MiB;
constexpr size_t WS_AO = 658 * MiB;
constexpr size_t WS_ACT = 418 * MiB;
constexpr size_t WS_RW = 722 * MiB;
constexpr size_t WS_RR = WS_RW, WS_RK = WS_RW + 32 * MiB, WS_RV = WS_RW + 64 * MiB, WS_RG = WS_RW + 96 * MiB;
constexpr size_t WS_RLW = WS_RW + 128 * MiB;
constexpr size_t WS_RKK = WS_RW + 160 * MiB, WS_RKA = WS_RW + 192 * MiB;
constexpr size_t WS_YP = 722 * MiB;
constexpr size_t WS_END = 994 * MiB;
static_assert(WS_ACT + (size_t)MAXBLK * 256 * 1024 * 2 <= WS_RW && WS_YP + (size_t)MAXBLK * 256 * 1024 * 2 <= WS_END, "ws map");
constexpr size_t DO_PJ = 0, DO_PB = 64 * MiB;
constexpr int CW_TMO = 0, CW_CNT = 64  , CW_BAR = 4096;

struct Params {
    const float *x, *p, *mix_norm, *w_in, *f_bias, *q_norm, *k_norm, *mu, *w0, *w2, *a0, *a2, *g2, *k_k, *k_a, *r_k, *ln_w, *ln_b, *w_out, *moe_norm, *w_router, *b_router, *w_gu, *b_gu, *w_down,
        *b_down, *ple_norm, *w_pg, *w_pp, *final_norm;
    float* out; unsigned char* ws; int ph_lo, ph_hi;
};

typedef const __attribute__((address_space(4))) Params& KPR;
__device__ __forceinline__ const __attribute__((address_space(4))) Params* kp_fresh() {
    unsigned long long p = (unsigned long long)__builtin_amdgcn_kernarg_segment_ptr(); asm volatile("" : "+s"(p)); return (const __attribute__((address_space(4))) Params*)p; }

__device__ __forceinline__ unsigned f2bf(float f) { unsigned u = __builtin_bit_cast(unsigned, f); return (u + 0x7fffu + ((u >> 16) & 1u)) >> 16; }
__device__ __forceinline__ unsigned pk2(float lo, float hi) { return f2bf(lo) | (f2bf(hi) << 16); }
__device__ __forceinline__ float bf2f(unsigned h) { return __builtin_bit_cast(float, h << 16); }
__device__ __forceinline__ float bflo(unsigned w) { return __builtin_bit_cast(float, w << 16); }
__device__ __forceinline__ float bfhi(unsigned w) { return __builtin_bit_cast(float, w & 0xffff0000u); }
__device__ __forceinline__ unsigned cvt_pk_bf16(float lo, float hi) { unsigned r; asm volatile("v_cvt_pk_bf16_f32 %0, %1, %2" : "=v"(r) : "v"(lo), "v"(hi)); return r; }
__device__ __forceinline__ float wave_sum(float v) {
#pragma unroll
    for (int o = 1; o < 64; o <<= 1) v += __shfl_xor(v, o);
    return v;
}
__device__ __forceinline__ float sigmoidf_(float x) { return 1.0f / (1.0f + __expf(-x)); }
__device__ __forceinline__ float logsigmoidf_(float x) { return fminf(x, 0.f) - log1pf(expf(-fabsf(x))); }
namespace pg8 {
constexpr int BM = 256, BK = 64, HALF = 128, HTB = HALF * BK * 2, STAGE_BYTES = 8 * HTB, NXCD = 8, WGM = 8;
__host__ __device__ __forceinline__ int lds_byte(int r, int c) { const int st = (r >> 4) * 2 + (c >> 5), rr = r & 15, cc = c & 31, ob = rr * 64 + cc * 2; return st * 1024 + (ob ^ (((ob >> 9) & 1) << 5)); }
__host__ __device__ __forceinline__ void stage_rc(int b, int& R, int& C) { const int st = b / 1024, sb = b % 1024, swz = sb ^ (((sb >> 9) & 1) << 5); R = (st >> 1) * 16 + swz / 64; C = (st & 1) * 32 + (swz % 64) / 2; }
__host__ __device__ __forceinline__ int perm32(int rho) { const int n = rho >> 4, i = rho & 15; return 8 * (i >> 2) + 4 * n + (i & 3); }

struct Unit { int pm, pn, e, lb; };

__device__ __forceinline__ bool tile_order(int i, int G, int c, int nM, int nN, int& pm, int& pn) {
    const int nwg = nM * nN; const long L = (long)i * G + c; if (L >= nwg) return false;
    int wgid = (int)L; { const int q = nwg / NXCD, r = nwg % NXCD, xcd = wgid % NXCD, off = wgid / NXCD; wgid = (xcd < r ? xcd * (q + 1) : r * (q + 1) + (xcd - r) * q) + off; }
    const int nig = WGM * nN, gid = wgid / nig, fm = gid * WGM, gsz = (nM - fm) < WGM ? (nM - fm) : WGM;
    pm = fm + ((wgid % nig) % gsz); pn = (wgid % nig) / gsz; return true;
}
struct DenseOrder {
    const bf16_t* A; const bf16_t* Bt; int K, nM, nN, G, c;
    __device__ __forceinline__ bool next(int i, Unit& u) const { u.e = 0; u.lb = 0; return tile_order(i, G, c, nM, nN, u.pm, u.pn); }
    __device__ __forceinline__ const char* a_base(const Unit& u) const { return (const char*)A + (size_t)u.pm * BM * K * 2; }
    __device__ __forceinline__ const char* b_base(const Unit& u) const { return (const char*)Bt + (size_t)u.pn * BM * K * 2; }
    __device__ __forceinline__ void a_off(const Unit&, const int (&R)[2], const int (&C)[2], unsigned (&off)[2][2]) const {
#pragma unroll
        for (int h = 0; h < 2; ++h)
#pragma unroll
            for (int i = 0; i < 2; ++i) off[h][i] = (unsigned)((R[i] + HALF * h) * K + C[i]) * 2u;
    }
};

template <class Epi, class Sched, bool ALIGN_EPI>
__device__ __forceinline__ void gemm_phase(LAS unsigned char* lds, const int K, const Sched& S, const Epi& E) {
    int tid_ = threadIdx.x; asm volatile("" : "+v"(tid_));
    const int tid = tid_, wid = __builtin_amdgcn_readfirstlane(tid >> 6), lane = tid & 63, wr = wid >> 2, wc = wid & 3, fr = lane & 15, fq = lane >> 4;
    const int nt = K / BK;
    int sR[2], sC[2]; unsigned voffB[2];
#pragma unroll
    for (int i = 0; i < 2; ++i) { int R, C; stage_rc(tid * 16 + i * 8192, R, C); const int Rb = Epi::PERM ? ((R & ~31) + perm32(R & 31)) : R; sR[i] = R; sC[i] = C; voffB[i] = (unsigned)(Rb * K + C) * 2u; }
    const size_t kstep = (size_t)(BK * 2);
    const size_t hstep = (size_t)HALF * K * 2;
    const unsigned ldsw = (unsigned)wid * 1024u;
    const int aoff = lds_byte(wr * 64 + fr, fq * 8), boff = lds_byte(wc * 32 + fr, fq * 8);
#define PG8_SA(b, h) (((b) * 2 + (h)) * HTB)
#define PG8_SB(b, h) ((4 + (b) * 2 + (h)) * HTB)
#define PG8_STAGE(bufoff, gbase, voff) do { _Pragma("unroll") for (int _i = 0; _i < 2; ++_i) \
        __builtin_amdgcn_global_load_lds((const unsigned*)((const char*)(gbase) + (voff)[_i]), (LAS unsigned*)(lds + (bufoff) + ldsw + _i * 8192), 16, 0, 0); } while (0)
#define PG8_LDA(dst, b, h) do { _Pragma("unroll") for (int m = 0; m < 4; ++m) _Pragma("unroll") for (int k = 0; k < 2; ++k) dst[m][k] = *(const LAS bf16x8*)(lds + PG8_SA(b, h) + aoff + m * 2048 + k * 1024); } while (0)
#define PG8_LDB(dst, b, h) do { _Pragma("unroll") for (int n = 0; n < 2; ++n) _Pragma("unroll") for (int k = 0; k < 2; ++k) dst[n][k] = *(const LAS bf16x8*)(lds + PG8_SB(b, h) + boff + n * 2048 + k * 1024); } while (0)
#define PG8_MMA(ai, bj, At, Bt) do { __builtin_amdgcn_s_setprio(1); _Pragma("unroll") for (int m = 0; m < 4; ++m) _Pragma("unroll") for (int n = 0; n < 2; ++n) _Pragma("unroll") for (int k = 0; k < 2; ++k) \
        acc[ai][bj][m][n] = __builtin_amdgcn_mfma_f32_16x16x32_bf16(Bt[n][k], At[m][k], acc[ai][bj][m][n], 0, 0, 0); __builtin_amdgcn_s_setprio(0); } while (0)
#define PG8_WAIT_V(n) asm volatile("s_waitcnt vmcnt(" #n ")" ::: "memory")
#define PG8_WAIT_L(n) asm volatile("s_waitcnt lgkmcnt(" #n ")" ::: "memory")
#define PG8_BAR __builtin_amdgcn_s_barrier()
#define PG8_SCHED __builtin_amdgcn_sched_barrier(0)
    Unit cur, nxt; int ui = 0;
    if (!S.next(0, cur)) return;
    f32x4 acc[2][2][4][2];
#pragma unroll
    for (int a = 0; a < 2; ++a)
#pragma unroll
        for (int b = 0; b < 2; ++b)
#pragma unroll
            for (int m = 0; m < 4; ++m)
#pragma unroll
                for (int n = 0; n < 2; ++n) acc[a][b][m][n] = (f32x4){0.f, 0.f, 0.f, 0.f};
    bf16x8 At[4][2], B0[2][2], B1[2][2];
    unsigned offC[2][2], offN[2][2];
    S.a_off(cur, sR, sC, offC);
    const char* cA = S.a_base(cur); const char* cB = S.b_base(cur);
    PG8_STAGE(PG8_SB(0, 0), cB, voffB); PG8_STAGE(PG8_SB(0, 1), cB + hstep, voffB); PG8_STAGE(PG8_SA(0, 0), cA, offC[0]); PG8_STAGE(PG8_SA(0, 1), cA, offC[1]);
    if (wr == 1) PG8_BAR;
    PG8_WAIT_V(2); PG8_BAR;
    PG8_STAGE(PG8_SB(1, 0), cB + kstep, voffB); PG8_STAGE(PG8_SA(1, 0), cA + kstep, offC[0]); PG8_STAGE(PG8_SB(1, 1), cB + hstep + kstep, voffB);
    PG8_WAIT_V(6); PG8_BAR;
    for (;;) {
        const bool has_next = S.next(ui + 1, nxt);
        const char* nA = cA; const char* nB = cB;
        if (has_next) { nA = S.a_base(nxt); nB = S.b_base(nxt); S.a_off(nxt, sR, sC, offN); }
        else {
#pragma unroll
            for (int h = 0; h < 2; ++h)
#pragma unroll
                for (int i = 0; i < 2; ++i) offN[h][i] = offC[h][i];
        }
#pragma nounroll
        for (int t = 0; t < nt; t += 2) {
            const bool last = (t == nt - 2);
            const char* a1 = cA + (size_t)(t + 1) * kstep;
            const char* a2 = last ? nA : cA + (size_t)(t + 2) * kstep; const char* b2 = last ? nB : cB + (size_t)(t + 2) * kstep;
            const char* a3 = a2 + kstep; const char* b3 = b2 + kstep;
            unsigned o2[2][2];
#pragma unroll
            for (int h = 0; h < 2; ++h)
#pragma unroll
                for (int i = 0; i < 2; ++i) o2[h][i] = last ? offN[h][i] : offC[h][i];
            PG8_LDB(B0, 0, 0); PG8_LDB(B1, 0, 1); PG8_SCHED; PG8_LDA(At, 0, 0); PG8_STAGE(PG8_SA(1, 1), a1, offC[1]);
            PG8_WAIT_V(8); PG8_WAIT_L(0); PG8_BAR; PG8_MMA(0, 0, At, B0); PG8_MMA(0, 1, At, B1); PG8_BAR; PG8_SCHED;
            PG8_LDA(At, 0, 1); PG8_STAGE(PG8_SB(0, 0), b2, voffB); PG8_STAGE(PG8_SB(0, 1), b2 + hstep, voffB); PG8_STAGE(PG8_SA(0, 0), a2, o2[0]);
            PG8_WAIT_V(8); PG8_WAIT_L(0); PG8_BAR; PG8_MMA(1, 0, At, B0); PG8_MMA(1, 1, At, B1); PG8_BAR; PG8_SCHED;
            PG8_LDB(B0, 1, 0); PG8_LDB(B1, 1, 1); PG8_SCHED; PG8_LDA(At, 1, 0); PG8_STAGE(PG8_SA(0, 1), a2, o2[1]);
            PG8_WAIT_V(8); PG8_WAIT_L(0); PG8_BAR; PG8_MMA(0, 0, At, B0); PG8_MMA(0, 1, At, B1); PG8_BAR; PG8_SCHED;
            PG8_LDA(At, 1, 1); PG8_STAGE(PG8_SB(1, 0), b3, voffB); PG8_STAGE(PG8_SB(1, 1), b3 + hstep, voffB); PG8_STAGE(PG8_SA(1, 0), a3, o2[0]);
            PG8_WAIT_V(8); PG8_WAIT_L(0); PG8_BAR; PG8_MMA(1, 0, At, B0); PG8_MMA(1, 1, At, B1); PG8_BAR; PG8_SCHED;
        }
        if constexpr (ALIGN_EPI) { if (wr == 0) PG8_BAR; }
        E(acc, cur, wr, wc, fr, fq);
        if (!has_next) break;
#pragma unroll
        for (int a = 0; a < 2; ++a)
#pragma unroll
            for (int b = 0; b < 2; ++b)
#pragma unroll
                for (int m = 0; m < 4; ++m)
#pragma unroll
                    for (int n = 0; n < 2; ++n) acc[a][b][m][n] = (f32x4){0.f, 0.f, 0.f, 0.f};
        cur = nxt; cA = nA; cB = nB; ++ui;
#pragma unroll
        for (int h = 0; h < 2; ++h)
#pragma unroll
            for (int i = 0; i < 2; ++i) offC[h][i] = offN[h][i];
        if constexpr (ALIGN_EPI) { if (wr == 1) PG8_BAR; }
    }
    PG8_WAIT_V(0);
    if constexpr (!ALIGN_EPI) { if (wr == 0) PG8_BAR; }
    PG8_BAR;
#undef PG8_SA
#undef PG8_SB
#undef PG8_STAGE
#undef PG8_LDA
#undef PG8_LDB
#undef PG8_MMA
#undef PG8_WAIT_V
#undef PG8_WAIT_L
#undef PG8_BAR
#undef PG8_SCHED
}
}
namespace pg8 {
constexpr int T_BLKSTART = 0  , T_CNT = 40  , T_BLKE = 80  , T_WORDS = 80 + 560;

struct EpiIn {
    static constexpr bool PERM = true;
    bf16_t* Z; const float* qn; const float* kn;
    __device__ __forceinline__ void operator()(const f32x4 (&acc)[2][2][4][2], const Unit& u, int wr, int wc, int fr, int fq) const {
        const int row0 = u.pm * BM + wr * 64 + fr;
        if (u.pn < 4) {
            const float* g = (u.pn < 2) ? qn : kn; const float sc = (u.pn < 2) ? QSCALE : 1.0f;
            f32x4 gv[2][2];
#pragma unroll
            for (int bj = 0; bj < 2; ++bj)
#pragma unroll
                for (int n = 0; n < 2; ++n) gv[bj][n] = *(const f32x4*)(g + 32 * bj + 8 * fq + 4 * n) * sc;
#pragma unroll
            for (int ai = 0; ai < 2; ++ai)
#pragma unroll
                for (int m = 0; m < 4; ++m) {
                    float ss = 0.f;
#pragma unroll
                    for (int bj = 0; bj < 2; ++bj)
#pragma unroll
                        for (int n = 0; n < 2; ++n) { const f32x4 x = acc[ai][bj][m][n]; ss += (x[0] * x[0] + x[1] * x[1]) + (x[2] * x[2] + x[3] * x[3]); }
                    ss += __shfl_xor(ss, 16); ss += __shfl_xor(ss, 32);
                    const float rstd = rsqrtf(ss * (1.0f / 64.0f) + 1e-6f);
                    bf16_t* rowp = Z + (size_t)(row0 + ai * HALF + m * 16) * ZW + u.pn * BM + 64 * wc + 8 * fq;
#pragma unroll
                    for (int bj = 0; bj < 2; ++bj) { const f32x4 v0 = acc[ai][bj][m][0] * rstd * gv[bj][0], v1 = acc[ai][bj][m][1] * rstd * gv[bj][1];
                        u32x4 w; w.x = cvt_pk_bf16(v0[0], v0[1]); w.y = cvt_pk_bf16(v0[2], v0[3]); w.z = cvt_pk_bf16(v1[0], v1[1]); w.w = cvt_pk_bf16(v1[2], v1[3]);
                        *(u32x4*)(rowp + 32 * bj) = w; }
                }
        } else {
            const int col0 = u.pn * BM + wc * 32 + 8 * fq;
#pragma unroll
            for (int ai = 0; ai < 2; ++ai)
#pragma unroll
                for (int m = 0; m < 4; ++m) { bf16_t* rowp = Z + (size_t)(row0 + ai * HALF + m * 16) * ZW + col0;
#pragma unroll
                    for (int bj = 0; bj < 2; ++bj) { const f32x4 v0 = acc[ai][bj][m][0], v1 = acc[ai][bj][m][1];
                        u32x4 w; w.x = cvt_pk_bf16(v0[0], v0[1]); w.y = cvt_pk_bf16(v0[2], v0[3]); w.z = cvt_pk_bf16(v1[0], v1[1]); w.w = cvt_pk_bf16(v1[2], v1[3]);
                        *(u32x4*)(rowp + bj * HALF) = w; } }
        }
    }
};
struct EpiBf16 {
    static constexpr bool PERM = true;
    bf16_t* O; int ldc;
    __device__ __forceinline__ void operator()(const f32x4 (&acc)[2][2][4][2], const Unit& u, int wr, int wc, int fr, int fq) const {
        const int row0 = u.pm * BM + wr * 64 + fr, col0 = u.pn * BM + wc * 32 + 8 * fq;
#pragma unroll
        for (int ai = 0; ai < 2; ++ai)
#pragma unroll
            for (int m = 0; m < 4; ++m) { bf16_t* rowp = O + (size_t)(row0 + ai * HALF + m * 16) * ldc + col0;
#pragma unroll
                for (int bj = 0; bj < 2; ++bj) { const f32x4 v0 = acc[ai][bj][m][0], v1 = acc[ai][bj][m][1];
                    u32x4 w; w.x = cvt_pk_bf16(v0[0], v0[1]); w.y = cvt_pk_bf16(v0[2], v0[3]); w.z = cvt_pk_bf16(v1[0], v1[1]); w.w = cvt_pk_bf16(v1[2], v1[3]);
                    *(u32x4*)(rowp + bj * HALF) = w; } }
    }
};
struct EpiOut {
    static constexpr bool PERM = false;
    const float* X; float* O;
    __device__ __forceinline__ void operator()(const f32x4 (&acc)[2][2][4][2], const Unit& u, int wr, int wc, int fr, int fq) const {
        const int row0 = u.pm * BM + wr * 64 + fr, col0 = u.pn * BM + wc * 32 + 4 * fq;
#pragma unroll
        for (int ai = 0; ai < 2; ++ai)
#pragma unroll
            for (int m = 0; m < 4; ++m) { const size_t off = (size_t)(row0 + ai * HALF + m * 16) * DM + col0;
#pragma unroll
                for (int bj = 0; bj < 2; ++bj)
#pragma unroll
                    for (int n = 0; n < 2; ++n) *(f32x4*)(O + off + bj * HALF + n * 16) = *(const f32x4*)(X + off + bj * HALF + n * 16) + acc[ai][bj][m][n];
                if (m & 1) asm volatile("" ::: "memory"); }
    }
};
struct EpiPg {
    static constexpr bool PERM = false;
    float* X; const bf16_t* PJ;
    __device__ __forceinline__ void operator()(const f32x4 (&acc)[2][2][4][2], const Unit& u, int wr, int wc, int fr, int fq) const {
        const int row0 = u.pm * BM + wr * 64 + fr, col0 = u.pn * BM + wc * 32 + 4 * fq;
#pragma unroll
        for (int ai = 0; ai < 2; ++ai)
#pragma unroll
            for (int m = 0; m < 4; ++m) { const size_t off = (size_t)(row0 + ai * HALF + m * 16) * DM + col0;
#pragma unroll
                for (int bj = 0; bj < 2; ++bj)
#pragma unroll
                    for (int n = 0; n < 2; ++n) { const size_t o = off + bj * HALF + n * 16; const u32x2 pj = *(const u32x2*)(PJ + o); const f32x4 a = acc[ai][bj][m][n]; const f32x4 xv = *(const f32x4*)(X + o);
                        f32x4 r; r[0] = xv[0] + sigmoidf_(a[0]) * bflo(pj.x); r[1] = xv[1] + sigmoidf_(a[1]) * bfhi(pj.x); r[2] = xv[2] + sigmoidf_(a[2]) * bflo(pj.y); r[3] = xv[3] + sigmoidf_(a[3]) * bfhi(pj.y);
                        *(f32x4*)(X + o) = r; }
                if (m & 1) asm volatile("" ::: "memory"); }
    }
};
struct EpiGu {
    static constexpr bool PERM = true;
    bf16_t* ACT; const float* b_gu;
    __device__ __forceinline__ void operator()(const f32x4 (&acc)[2][2][4][2], const Unit& u, int wr, int wc, int fr, int fq) const {
        const int row0 = u.pm * BM + wr * 64 + fr, cl = u.pn * HALF + wc * 32 + 8 * fq;
        const float* bg = b_gu + (size_t)u.e * 2048 + cl;
        f32x4 bgl[2], bli[2];
#pragma unroll
        for (int n = 0; n < 2; ++n) { bgl[n] = *(const f32x4*)(bg + 4 * n); bli[n] = *(const f32x4*)(bg + 1024 + 4 * n); }
#pragma unroll
        for (int ai = 0; ai < 2; ++ai)
#pragma unroll
            for (int m = 0; m < 4; ++m) { bf16_t* rowp = ACT + (size_t)(row0 + ai * HALF + m * 16) * EFF + cl; float r[8];
#pragma unroll
                for (int n = 0; n < 2; ++n)
#pragma unroll
                    for (int i = 0; i < 4; ++i) { const float gl = fminf(acc[ai][0][m][n][i] + bgl[n][i], 7.0f); const float li = fminf(fmaxf(acc[ai][1][m][n][i] + bli[n][i], -7.0f), 7.0f);
                        r[4 * n + i] = gl * sigmoidf_(1.702f * gl) * (li + 1.0f); }
                u32x4 w; w.x = cvt_pk_bf16(r[0], r[1]); w.y = cvt_pk_bf16(r[2], r[3]); w.z = cvt_pk_bf16(r[4], r[5]); w.w = cvt_pk_bf16(r[6], r[7]);
                *(u32x4*)rowp = w; }
    }
};
struct EpiDn {
    static constexpr bool PERM = true;
    bf16_t* YP; const float* b_dn; const float* gateslot; const LAS int* tab;
    __device__ __forceinline__ void operator()(const f32x4 (&acc)[2][2][4][2], const Unit& u, int wr, int wc, int fr, int fq) const {
        const int row0 = u.pm * BM + wr * 64 + fr, col0 = u.pn * BM + wc * 32 + 8 * fq;
        const float* bd = b_dn + (size_t)u.e * 1024 + col0; const int cnt = tab[T_CNT + u.e];
        f32x4 bv[2][2];
#pragma unroll
        for (int bj = 0; bj < 2; ++bj)
#pragma unroll
            for (int n = 0; n < 2; ++n) bv[bj][n] = *(const f32x4*)(bd + bj * HALF + 4 * n);
#pragma unroll
        for (int ai = 0; ai < 2; ++ai)
#pragma unroll
            for (int m = 0; m < 4; ++m) { const int rr = wr * 64 + fr + ai * HALF + m * 16, slot = u.lb * 256 + rr;
                const float gt = slot < cnt ? gateslot[(size_t)u.e * NTOK + slot] : 0.f;
                bf16_t* rowp = YP + (size_t)(row0 + ai * HALF + m * 16) * DM + col0;
#pragma unroll
                for (int bj = 0; bj < 2; ++bj) { const f32x4 v0 = (acc[ai][bj][m][0] + bv[bj][0]) * gt, v1 = (acc[ai][bj][m][1] + bv[bj][1]) * gt;
                    u32x4 w; w.x = cvt_pk_bf16(v0[0], v0[1]); w.y = cvt_pk_bf16(v0[2], v0[3]); w.z = cvt_pk_bf16(v1[0], v1[1]); w.w = cvt_pk_bf16(v1[2], v1[3]);
                    *(u32x4*)(rowp + bj * HALF) = w; } }
    }
};
struct MoeOrder {
    const bf16_t* A; const bf16_t* Bt; const int* tokslot; const LAS int* tab; int nblk, nN, G, c; bool gather;
    __device__ __forceinline__ bool next(int i, Unit& u) const { if (!tile_order(i, G, c, nblk, nN, u.pm, u.pn)) return false; u.e = tab[T_BLKE + u.pm]; u.lb = u.pm - tab[T_BLKSTART + u.e]; return true; }
    __device__ __forceinline__ const char* a_base(const Unit& u) const { return gather ? (const char*)A : (const char*)A + (size_t)u.pm * BM * 1024 * 2; }
    __device__ __forceinline__ const char* b_base(const Unit& u) const { return (const char*)Bt + ((size_t)u.e * nN + u.pn) * BM * 1024 * 2; }
    __device__ __forceinline__ void a_off(const Unit& u, const int (&R)[2], const int (&C)[2], unsigned (&off)[2][2]) const {
        const int cnt = tab[T_CNT + u.e];
#pragma unroll
        for (int h = 0; h < 2; ++h)
#pragma unroll
            for (int i = 0; i < 2; ++i) {
                if (gather) { const int slot = u.lb * 256 + R[i] + HALF * h; const int tok = slot < cnt ? tokslot[(size_t)u.e * NTOK + slot] : NTOK; off[h][i] = (unsigned)tok * 2048u + (unsigned)C[i] * 2u; }
                else off[h][i] = (unsigned)((R[i] + HALF * h) * 1024 + C[i]) * 2u;
            }
    }
};
__device__ __forceinline__ int moe_tables(LAS int* tab, const unsigned* cntw) {
    if (threadIdx.x == 0) { int s = 0; for (int e = 0; e < NE; ++e) { const int c = (int)cntw[e]; tab[T_CNT + e] = c; tab[T_BLKSTART + e] = s; const int nb = (c + 255) >> 8; for (int j = 0; j < nb; ++j) tab[T_BLKE + s + j] = e; s += nb; } tab[T_BLKSTART + NE] = s; }
    __syncthreads();
    return tab[T_BLKSTART + NE];
}
}
constexpr int NWAVES = 8, NTHREADS = 512;
constexpr int RING_BYTES = 131072, MISC_OFF = RING_BYTES, LDS_BYTES = 147456;

__device__ __forceinline__ void tr_item(const float* W, int ldw, int srccol0, int k0, bf16_t* WT, int Kd, int dstrow0, LAS float* scr, int lane) {
#pragma unroll 8
    for (int i = 0; i < 32; ++i) { const int kk = 2 * i + (lane >> 5); scr[kk * 33 + (lane & 31)] = W[(size_t)(k0 + kk) * ldw + srccol0 + (lane & 31)]; }
    asm volatile("s_waitcnt lgkmcnt(0)" ::: "memory");
    const int c = lane & 7;
#pragma unroll
    for (int j = 0; j < 4; ++j) { const int n = (lane >> 3) + 8 * j; const LAS float* s = scr + (8 * c) * 33 + n;
        u32x4 o; o.x = pk2(s[0 * 33], s[1 * 33]); o.y = pk2(s[2 * 33], s[3 * 33]); o.z = pk2(s[4 * 33], s[5 * 33]); o.w = pk2(s[6 * 33], s[7 * 33]);
        *(u32x4*)(WT + (size_t)(dstrow0 + n) * Kd + k0 + 8 * c) = o; }
    asm volatile("s_waitcnt lgkmcnt(0)" ::: "memory");
}
constexpr int I_IN = 16 * 120, I_OUT = 16 * 32, I_PG = 16 * 32, I_PP = 4 * 32, I_GU1 = 16 * 64, I_DN1 = 16 * 32;
constexpr int I_SMALL = I_IN + I_OUT + I_PG + I_PP, I_GU = NE * I_GU1, I_DN = NE * I_DN1, I_ALL = I_SMALL + I_GU + I_DN;
__device__ __forceinline__ void prep_item(KPR P, int it, LAS float* scr, int lane) {
    unsigned char* ws = P.ws;
    if (it < I_IN) { const int kb = it / 120, nb = it % 120, n0 = nb * 32, pn = n0 >> 8, j0 = n0 & 255;
        const int src = pn < 4 ? (pn * 256 + 64 * ((j0 & 127) >> 5) + 32 * (j0 >> 7)) : (n0 < 2048 ? n0 : n0 + 8);
        tr_item(P.w_in, INW, src, kb * 64, (bf16_t*)(ws + WS_WIN), 1024, n0, scr, lane); return; }
    it -= I_IN;
    if (it < I_OUT) { tr_item(P.w_out, 1024, (it % 32) * 32, (it / 32) * 64, (bf16_t*)(ws + WS_WOUT), 1024, (it % 32) * 32, scr, lane); return; }
    it -= I_OUT;
    if (it < I_PG) { tr_item(P.w_pg, 1024, (it % 32) * 32, (it / 32) * 64, (bf16_t*)(ws + WS_WPG), 1024, (it % 32) * 32, scr, lane); return; }
    it -= I_PG;
    if (it < I_PP) { tr_item(P.w_pp, 1024, (it % 32) * 32, (it / 32) * 64, (bf16_t*)(ws + WS_WPP), 256, (it % 32) * 32, scr, lane); return; }
    it -= I_PP;
    if (it < I_GU) { const int e = it / I_GU1, r = it % I_GU1, kb = r / 64, nb = r % 64, n0 = nb * 32, pn = n0 >> 8, j0 = n0 & 255;
        const int src = (j0 >> 7) * 1024 + pn * 128 + (j0 & 127);
        tr_item(P.w_gu + (size_t)e * 1024 * 2048, 2048, src, kb * 64, (bf16_t*)(ws + WS_WGU) + (size_t)e * 2048 * 1024, 1024, n0, scr, lane); return; }
    it -= I_GU;
    { const int e = it / I_DN1, r = it % I_DN1, kb = r / 32, nb = r % 32;
        tr_item(P.w_down + (size_t)e * 1024 * 1024, 1024, nb * 32, kb * 64, (bf16_t*)(ws + WS_WDN) + (size_t)e * 1024 * 1024, 1024, nb * 32, scr, lane); }
}
__device__ __forceinline__ void phase_prep_weights(KPR P, LAS unsigned char* lds, int gw, int ngw, int wave, int lane) {
    LAS float* scr = (LAS float*)(lds + wave * 16384);
    for (int it = gw; it < I_ALL; it += ngw) prep_item(P, it, scr, lane);
}
__device__ __forceinline__ void phase_cvt_p(KPR P, int gt, int ngt) {
    bf16_t* PB = (bf16_t*)((unsigned char*)P.out + DO_PB);
    for (int i = gt; i < NTOK * PLE / 8; i += ngt) { const f32x4 a = ((const f32x4*)P.p)[2 * i], b = ((const f32x4*)P.p)[2 * i + 1];
        u32x4 w; w.x = pk2(a[0], a[1]); w.y = pk2(a[2], a[3]); w.z = pk2(b[0], b[1]); w.w = pk2(b[2], b[3]); ((u32x4*)PB)[i] = w; }
}
__device__ __forceinline__ void rms_row(const float* xrow, const float* gain, int lane, f32x4 (&v)[4]) {
    const f32x4* xr = (const f32x4*)xrow + lane; float s = 0.f;
#pragma unroll
    for (int j = 0; j < 4; ++j) { v[j] = xr[64 * j]; s += (v[j][0] * v[j][0] + v[j][1] * v[j][1]) + (v[j][2] * v[j][2] + v[j][3] * v[j][3]); }
    const float rstd = rsqrtf(wave_sum(s) * (1.f / DM) + 1e-6f);
#pragma unroll
    for (int j = 0; j < 4; ++j) v[j] = v[j] * rstd * ((const f32x4*)gain)[64 * j + lane];
}
__device__ __forceinline__ void store_row_bf16(bf16_t* orow, int lane, const f32x4 (&v)[4]) {
    u32x2* o8 = (u32x2*)orow + lane;
#pragma unroll
    for (int j = 0; j < 4; ++j) { u32x2 w; w.x = pk2(v[j][0], v[j][1]); w.y = pk2(v[j][2], v[j][3]); o8[64 * j] = w; }
}
__device__ __forceinline__ void norm1_row(KPR P, int row, int lane, const LAS float* wff, LAS float* lf_out  ) {
    f32x4 v[4]; rms_row(P.x + (size_t)row * DM, P.mix_norm, lane, v);
    store_row_bf16((bf16_t*)(P.ws + WS_XN) + (size_t)row * DM, lane, v);
    float ff[8];
#pragma unroll
    for (int q = 0; q < 8; ++q) ff[q] = 0.f;
#pragma unroll
    for (int j = 0; j < 4; ++j)
#pragma unroll
        for (int i = 0; i < 4; ++i) { const LAS f32x4* w = (const LAS f32x4*)(wff + (size_t)(4 * (64 * j + lane) + i) * 8); const f32x4 w0 = w[0], w1 = w[1]; const float h = v[j][i];
            ff[0] += h * w0[0]; ff[1] += h * w0[1]; ff[2] += h * w0[2]; ff[3] += h * w0[3]; ff[4] += h * w1[0]; ff[5] += h * w1[1]; ff[6] += h * w1[2]; ff[7] += h * w1[3]; }
#pragma unroll
    for (int q = 0; q < 8; ++q) ff[q] = wave_sum(ff[q]);
    if (lane < 8) { float f = ff[0];
#pragma unroll
        for (int q = 1; q < 8; ++q) f = (lane == q) ? ff[q] : f;
        lf_out[lane] = logsigmoidf_(f + P.f_bias[lane]); }
}
__device__ __forceinline__ void load_wff(KPR P, LAS float* wff, int tid, int nthr) {
    for (int i = tid; i < 1024 * 8; i += nthr) wff[i] = P.w_in[(size_t)(i >> 3) * INW + 2048 + (i & 7)];
}
__device__ __forceinline__ void final_row(KPR P, int row, int lane, bool dead) {
    f32x4 v[4]; rms_row((const float*)(P.ws + WS_X1) + (size_t)row * DM, P.final_norm, lane, v);
    f32x4* o = (f32x4*)(P.out + (size_t)row * DM) + lane;
#pragma unroll
    for (int j = 0; j < 4; ++j) { if (dead) { const float q = __builtin_nanf(""); v[j] = (f32x4){q, q, q, q}; } o[64 * j] = v[j]; }
}
typedef GAS unsigned gu32;
#define RLX_AGENT __ATOMIC_RELAXED, __HIP_MEMORY_SCOPE_AGENT
#define XB_TMO      128
#define XB_XCNT(j)  (256  + 64 * (j))
#define XB_XSUB(j)  (1280 + 64 * (j))
#define XB_XGEN(j)  (2304 + 64 * (j))
#define XB_TOP      3328
#define XB_TOPGEN   3392
#define XCD_BAR_WORDS 3456
#define XB_SPIN_CAP (1u << 22)

__device__ __forceinline__ unsigned xb_ld(unsigned* p)              { return __hip_atomic_load(p, __ATOMIC_RELAXED, __HIP_MEMORY_SCOPE_AGENT); }
__device__ __forceinline__ unsigned xb_add(unsigned* p, unsigned v) { return __hip_atomic_fetch_add(p, v, __ATOMIC_RELAXED, __HIP_MEMORY_SCOPE_AGENT); }
__device__ __forceinline__ unsigned xb_xcc_id() { return (unsigned)__builtin_amdgcn_s_getreg((3 << 11) | 20) & 0xFu; }
#define XB_SPIN(cond, bar) do { unsigned _sp = 0; while (cond) { __builtin_amdgcn_s_sleep(1); \
    if ((++_sp & 255u) == 0u) { if (xb_ld(&(bar)[XB_TMO])) break; if (_sp > XB_SPIN_CAP) { atomicAdd(&(bar)[XB_TMO], 1u); break; } } } } while (0)

struct XcdBarrier { unsigned* bar; unsigned x; volatile LAS unsigned* st; };

__device__ __forceinline__ XcdBarrier xcd_barrier_post(unsigned* bar, volatile LAS unsigned* st) {
    XcdBarrier b; b.bar = bar; b.x = xb_xcc_id(); b.st = st;
    if (threadIdx.x == 0) (void)xb_add(&bar[XB_XCNT(b.x)], 1u);
    return b;
}
__device__ __forceinline__ void xcd_barrier_complete(unsigned* bar, unsigned x, unsigned& nloc, unsigned& nx) {
    const unsigned G = gridDim.x * gridDim.y * gridDim.z;
    unsigned sum, cnt, mine, sp = 0u;
    for (;;) {
        sum = 0u; cnt = 0u; mine = 0u;
#pragma unroll
        for (unsigned j = 0; j < 16; ++j) { const unsigned c = xb_ld(&bar[XB_XCNT(j)]); sum += c; cnt += (c > 0u) ? 1u : 0u; mine = (j == x) ? c : mine; }
        if (sum == G) break;
        __builtin_amdgcn_s_sleep(1);
        if ((++sp & 255u) == 0u) { if (xb_ld(&bar[XB_TMO])) break; if (sp > XB_SPIN_CAP) { atomicAdd(&bar[XB_TMO], 1u); break; } }
    }
    nloc = mine > 0u ? mine : 1u; nx = cnt > 0u ? cnt : 1u;
}
__device__ __forceinline__ void xcd_barrier(const XcdBarrier& b) {
    asm volatile("s_waitcnt vmcnt(0)" ::: "memory");
    __syncthreads();
    if (threadIdx.x == 0) {
        unsigned* bar = b.bar;
        __builtin_amdgcn_s_waitcnt(0);
        unsigned nloc = b.st[0], nx = b.st[1];
        if (nloc == 0u) { xcd_barrier_complete(bar, b.x, nloc, nx); b.st[0] = nloc; b.st[1] = nx; }
        const unsigned old = xb_add(&bar[XB_XSUB(b.x)], 1u);
        const unsigned gen = old / nloc;
        if (old + 1u == (gen + 1u) * nloc) {
            __builtin_amdgcn_fence(__ATOMIC_RELEASE, "agent");
            asm volatile("s_waitcnt vmcnt(0)" ::: "memory");
            const unsigned og = xb_add(&bar[XB_TOP], 1u);
            const unsigned tg = og / nx;
            if (og + 1u == (tg + 1u) * nx) xb_add(&bar[XB_TOPGEN], 1u);
            else XB_SPIN(xb_ld(&bar[XB_TOPGEN]) == tg, bar);
            __builtin_amdgcn_fence(__ATOMIC_ACQUIRE, "agent");
            xb_add(&bar[XB_XGEN(b.x)], 1u);
            asm volatile("s_waitcnt vmcnt(0)" ::: "memory");
        } else {
            XB_SPIN(xb_ld(&bar[XB_XGEN(b.x)]) == gen, bar);
            __builtin_amdgcn_fence(__ATOMIC_ACQUIRE, "agent");
            asm volatile("s_waitcnt vmcnt(0)" ::: "memory");
        }
    }
    __syncthreads();
}
namespace rk {
constexpr int MB = 8192;
constexpr int S_AT = 0, S_RT = 1, S_KT = 2, S_BT = 3, S_ATT = 4, S_KTT = 5, S_BTT = 6, S_VT = 7, S_N = 8, S_NT = 9, S_MAK = 10, S_MRB = 11, S_MRK = 12, S_TA = 13, S_TB = 14;
constexpr int SCR = 15 * MB;
constexpr int NCHUNK = SEQ / 64;
constexpr size_t WS_HT = WS_X1;
constexpr size_t WS_Y0 = WS_X1 + 64 * MiB;
constexpr size_t WS_QI = WS_X1 + 96 * MiB;
constexpr size_t WS_SC = WS_RW + 224 * MiB;
constexpr size_t DO_GT = 80 * MiB;
static_assert(WS_SC + 32 * MiB <= WS_END, "rwkv blobs");

__device__ __forceinline__ int moff(int row, int col) { return row * 128 + ((((col >> 3) ^ (row >> 1)) & 7) << 4) + (col & 7) * 2; }
__device__ __forceinline__ int crow(int r, int hi) { return (r & 3) + 8 * (r >> 2) + 4 * hi; }
__device__ __forceinline__ f32x16 mm_nt(const LAS unsigned char* A, int ar0, const LAS unsigned char* Bt, int br0, f32x16 acc, int r32, int hi) {
#pragma unroll
    for (int ks = 0; ks < 4; ++ks) { const bf16x8 a = *(const LAS bf16x8*)(A + moff(ar0 + r32, 16 * ks + 8 * hi)), b = *(const LAS bf16x8*)(Bt + moff(br0 + r32, 16 * ks + 8 * hi));
        acc = __builtin_amdgcn_mfma_f32_32x32x16_bf16(a, b, acc, 0, 0, 0); }
    return acc;
}
__device__ __forceinline__ void store_t(LAS unsigned char* dst, const f32x16& acc, int i0, int j0, int r32, int hi) {
#pragma unroll
    for (int g = 0; g < 4; ++g) { u32x2 w; w.x = pk2(acc[4 * g], acc[4 * g + 1]); w.y = pk2(acc[4 * g + 2], acc[4 * g + 3]); *(LAS u32x2*)(dst + moff(j0 + r32, i0 + 8 * g + 4 * hi)) = w; }
}
template <int MODE> __device__ __forceinline__ void mask_tri(f32x16& acc, int i0, int j0, int r32, int hi) {
#pragma unroll
    for (int r = 0; r < 16; ++r) { const int i = i0 + crow(r, hi), j = j0 + r32; const bool keep = MODE == 0 ? (j < i) : (MODE == 1 ? (i < j) : (i <= j)); if (!keep) acc[r] = 0.f; }
}

__device__ __forceinline__ void pass1_chunk(KPR P, LAS unsigned char* lds, int bh, int c, int tid) {
    const int lane = tid & 63, wave = tid >> 6, r32 = lane & 31, hi = lane >> 5, grp = wave >> 2, wq = wave & 3, i0 = 32 * (wq >> 1), j0 = 32 * (wq & 1);
    const int b = bh >> 3, h = bh & 7; const size_t tok0 = (size_t)b * SEQ + (size_t)c * 64; const size_t ci = (size_t)bh * NCHUNK + c;
    LAS float* part = (LAS float*)(lds + SCR); LAS float* WL = (LAS float*)(lds + SCR + 2048);
#define MAT(s) (lds + (s) * MB)
    {
        const bf16_t* RR = (const bf16_t*)(P.ws + WS_RR); const bf16_t* RK = (const bf16_t*)(P.ws + WS_RK); const bf16_t* RV = (const bf16_t*)(P.ws + WS_RV);
        const bf16_t* RLW = (const bf16_t*)(P.ws + WS_RLW); const bf16_t* RKK = (const bf16_t*)(P.ws + WS_RKK); const bf16_t* RKA = (const bf16_t*)(P.ws + WS_RKA);
        const int ch = tid & 63, tq = tid >> 6; const size_t base = (tok0 + 8 * tq) * 512 + h * 64 + ch;
        float cum[8]; float run = 0.f;
#pragma unroll
        for (int i = 0; i < 8; ++i) { run += bf2f(RLW[base + (size_t)i * 512]); cum[i] = run; }
        part[tq * 64 + ch] = run;
        __syncthreads();
        float pre = 0.f;
#pragma unroll
        for (int g = 0; g < 8; ++g) { const float pv = part[g * 64 + ch]; pre += (g < tq) ? pv : 0.f; }
        float eprev = __expf(pre);
        unsigned atT[4], ktT[4], btT[4], vT[4]; unsigned short hold[4] = {0, 0, 0, 0};
#pragma unroll
        for (int i = 0; i < 8; ++i) { const int t = 8 * tq + i; const size_t o = base + (size_t)i * 512;
            const float cm = pre + cum[i], e1 = __expf(cm), einv = __expf(-cm);
            const float r = bf2f(RR[o]), k = bf2f(RK[o]), kk = bf2f(RKK[o]), ka = bf2f(RKA[o]);
            const unsigned short at = (unsigned short)f2bf(-kk * eprev), rt = (unsigned short)f2bf(r * e1), kt = (unsigned short)f2bf(k * einv), bt = (unsigned short)f2bf(ka * einv), vv = RV[o];
            eprev = e1;
            *(LAS unsigned short*)(MAT(S_AT) + moff(t, ch)) = at; *(LAS unsigned short*)(MAT(S_RT) + moff(t, ch)) = rt; *(LAS unsigned short*)(MAT(S_KT) + moff(t, ch)) = kt; *(LAS unsigned short*)(MAT(S_BT) + moff(t, ch)) = bt;
            if (i & 1) { atT[i >> 1] = hold[0] | ((unsigned)at << 16); ktT[i >> 1] = hold[1] | ((unsigned)kt << 16); btT[i >> 1] = hold[2] | ((unsigned)bt << 16); vT[i >> 1] = hold[3] | ((unsigned)vv << 16); }
            else { hold[0] = at; hold[1] = kt; hold[2] = bt; hold[3] = vv; }
            if (i == 7 && tq == 7) WL[ch] = e1; }
        *(LAS u32x4*)(MAT(S_ATT) + moff(ch, 8 * tq)) = (u32x4){atT[0], atT[1], atT[2], atT[3]}; *(LAS u32x4*)(MAT(S_KTT) + moff(ch, 8 * tq)) = (u32x4){ktT[0], ktT[1], ktT[2], ktT[3]};
        *(LAS u32x4*)(MAT(S_BTT) + moff(ch, 8 * tq)) = (u32x4){btT[0], btT[1], btT[2], btT[3]}; *(LAS u32x4*)(MAT(S_VT) + moff(ch, 8 * tq)) = (u32x4){vT[0], vT[1], vT[2], vT[3]};
    }
    __syncthreads();
    const f32x16 zero = f32x16{};
    if (grp == 0) { f32x16 d = mm_nt(MAT(S_AT), i0, MAT(S_BT), j0, zero, r32, hi); mask_tri<0>(d, i0, j0, r32, hi); store_t(MAT(S_NT), d, i0, j0, r32, hi);
        d = mm_nt(MAT(S_KT), i0, MAT(S_AT), j0, zero, r32, hi); mask_tri<1>(d, i0, j0, r32, hi); store_t(MAT(S_MAK), d, i0, j0, r32, hi);
        d = mm_nt(MAT(S_KT), i0, MAT(S_RT), j0, zero, r32, hi); mask_tri<2>(d, i0, j0, r32, hi); store_t(MAT(S_MRK), d, i0, j0, r32, hi); }
    else { f32x16 d = mm_nt(MAT(S_BT), i0, MAT(S_AT), j0, zero, r32, hi); mask_tri<1>(d, i0, j0, r32, hi); store_t(MAT(S_N), d, i0, j0, r32, hi);
#pragma unroll
        for (int r = 0; r < 16; ++r) if (i0 + crow(r, hi) == j0 + r32) d[r] = 1.0f;
        store_t(MAT(S_TA), d, i0, j0, r32, hi);
        d = mm_nt(MAT(S_BT), i0, MAT(S_RT), j0, zero, r32, hi); mask_tri<2>(d, i0, j0, r32, hi); store_t(MAT(S_MRB), d, i0, j0, r32, hi); }
    __syncthreads();
#pragma unroll
    for (int s = 1; s <= 6; ++s) {
        const int mc = (s & 1) ? S_N : S_AT, mcT = (s & 1) ? S_NT : S_KT, mn = (s & 1) ? S_AT : S_N, mnT = (s & 1) ? S_KT : S_NT;
        const int tc = (s & 1) ? S_TB : S_TA, tn = (s & 1) ? S_TA : S_TB;
        if (s <= 5) {
            if (grp == 0) { const f32x16 d = mm_nt(MAT(mc), i0, MAT(mcT), j0, zero, r32, hi); store_t(MAT(mnT), d, i0, j0, r32, hi); }
            else { const f32x16 d = mm_nt(MAT(mcT), i0, MAT(mc), j0, zero, r32, hi); store_t(MAT(mn), d, i0, j0, r32, hi); }
        }
        if (s >= 2 && grp == (s <= 5 ? 0 : 1) ) {
            f32x16 d = mm_nt(MAT(mcT), i0, MAT(tc), j0, zero, r32, hi);
#pragma unroll
            for (int g = 0; g < 4; ++g) { const u32x2 tv = *(const LAS u32x2*)(MAT(tc) + moff(j0 + r32, i0 + 8 * g + 4 * hi)); d[4 * g] += bflo(tv.x); d[4 * g + 1] += bfhi(tv.x); d[4 * g + 2] += bflo(tv.y); d[4 * g + 3] += bfhi(tv.y); }
            store_t(MAT(tn), d, i0, j0, r32, hi);
        }
        __syncthreads();
    }
    if (grp == 0) { const f32x16 d = mm_nt(MAT(S_TB), i0, MAT(S_ATT), j0, zero, r32, hi); store_t(MAT(S_BT), d, i0, j0, r32, hi); }
    else { const f32x16 d = mm_nt(MAT(S_MAK), i0, MAT(S_VT), j0, zero, r32, hi); store_t(MAT(S_N), d, i0, j0, r32, hi); }
    __syncthreads();
    if (grp == 0) { const f32x16 d = mm_nt(MAT(S_TB), i0, MAT(S_N), j0, zero, r32, hi); store_t(MAT(S_NT), d, i0, j0, r32, hi);
        f32x16 q = mm_nt(MAT(S_BT), i0, MAT(S_MRB), j0, zero, r32, hi);
#pragma unroll
        for (int g = 0; g < 4; ++g) { const u32x2 rv = *(const LAS u32x2*)(MAT(S_RT) + moff(j0 + r32, i0 + 8 * g + 4 * hi)); q[4 * g] += bflo(rv.x); q[4 * g + 1] += bfhi(rv.x); q[4 * g + 2] += bflo(rv.y); q[4 * g + 3] += bfhi(rv.y); }
        store_t(MAT(S_KT), q, i0, j0, r32, hi); }
    else { f32x16 g_ = mm_nt(MAT(S_BT), i0, MAT(S_BTT), j0, zero, r32, hi);
        const float wl = WL[j0 + r32];
#pragma unroll
        for (int r = 0; r < 16; ++r) { if (i0 + crow(r, hi) == j0 + r32) g_[r] += 1.0f; g_[r] *= wl; }
        store_t(MAT(S_AT), g_, i0, j0, r32, hi); }
    __syncthreads();
    if (grp == 0) { f32x16 d = mm_nt(MAT(S_BTT), i0, MAT(S_NT), j0, zero, r32, hi); d = mm_nt(MAT(S_KTT), i0, MAT(S_VT), j0, d, r32, hi);
        float* HT = (float*)(P.ws + WS_HT) + ci * 4096 + (size_t)wq * 1024 + lane;
#pragma unroll
        for (int g = 0; g < 4; ++g) { const f32x4 wl4 = *(const LAS f32x4*)(WL + i0 + 8 * g + 4 * hi);
#pragma unroll
            for (int i = 0; i < 4; ++i) HT[(4 * g + i) * 64] = d[4 * g + i] * wl4[i]; } }
    else { f32x16 d = mm_nt(MAT(S_MRB), i0, MAT(S_NT), j0, zero, r32, hi); d = mm_nt(MAT(S_MRK), i0, MAT(S_VT), j0, d, r32, hi);
        unsigned* Y0 = (unsigned*)(P.ws + WS_Y0) + ci * 2048 + (size_t)wq * 512 + lane;
#pragma unroll
        for (int r2 = 0; r2 < 8; ++r2) Y0[r2 * 64] = pk2(d[2 * r2], d[2 * r2 + 1]); }
    { u32x4* GTg = (u32x4*)((unsigned char*)P.out + DO_GT + ci * MB); u32x4* QIg = (u32x4*)(P.ws + WS_QI + ci * MB);
        GTg[tid] = *(const LAS u32x4*)(MAT(S_AT) + tid * 16); QIg[tid] = *(const LAS u32x4*)(MAT(S_KT) + tid * 16); }
    __syncthreads();
#undef MAT
}

__device__ __forceinline__ void pass2_seq(KPR P, LAS unsigned char* lds, int bh, int tid) {
    const int lane = tid & 63, wave = tid >> 6, r32 = lane & 31, hi = lane >> 5, wq = wave & 3, i0 = 32 * (wq >> 1), j0 = 32 * (wq & 1);
    LAS unsigned char* Sm = lds; LAS unsigned char* G0 = lds + MB; LAS unsigned char* G1 = lds + 2 * MB;
    const size_t ci0 = (size_t)bh * NCHUNK;
    const u32x4* GTg = (const u32x4*)((const unsigned char*)P.out + DO_GT + ci0 * MB); u32x4* SCg = (u32x4*)(P.ws + WS_SC + ci0 * MB);
    const float* HT = (const float*)(P.ws + WS_HT) + ci0 * 4096 + (size_t)wq * 1024 + lane;
    *(LAS u32x4*)(Sm + tid * 16) = (u32x4){0u, 0u, 0u, 0u};
    *(LAS u32x4*)(G0 + tid * 16) = GTg[tid];
    u32x4 gnext = GTg[512 + tid];
    f32x16 hcur, hnext;
    if (wave < 4) {
#pragma unroll
        for (int r = 0; r < 16; ++r) { hcur[r] = HT[r * 64]; hnext[r] = HT[4096 + r * 64]; } }
    __syncthreads();
    for (int c = 0; c < NCHUNK; ++c) {
        LAS unsigned char* Gc = (c & 1) ? G1 : G0; LAS unsigned char* Gn = (c & 1) ? G0 : G1;
        SCg[(size_t)c * 512 + tid] = *(const LAS u32x4*)(Sm + tid * 16);
        f32x16 d = hcur;
        if (wave < 4) d = mm_nt(Gc, i0, Sm, j0, d, r32, hi);
        __syncthreads();
        if (wave < 4) store_t(Sm, d, i0, j0, r32, hi);
        *(LAS u32x4*)(Gn + tid * 16) = gnext;
        const int c2 = (c + 2 < NCHUNK) ? c + 2 : NCHUNK - 1;
        gnext = GTg[(size_t)c2 * 512 + tid];
        if (wave < 4) { hcur = hnext;
#pragma unroll
            for (int r = 0; r < 16; ++r) hnext[r] = HT[(size_t)c2 * 4096 + r * 64]; }
        __syncthreads();
    }
}

__device__ __forceinline__ void pass3_chunk(KPR P, LAS unsigned char* lds, int bh, int c, int tid) {
    const int lane = tid & 63, wave = tid >> 6, r32 = lane & 31, hi = lane >> 5, wq = wave & 3, i0 = 32 * (wq >> 1), j0 = 32 * (wq & 1);
    const int b = bh >> 3, h = bh & 7; const size_t tok0 = (size_t)b * SEQ + (size_t)c * 64; const size_t ci = (size_t)bh * NCHUNK + c;
    LAS unsigned char* Qm = lds; LAS unsigned char* Sm = lds + MB; LAS float* Yl = (LAS float*)(lds + 2 * MB);
    *(LAS u32x4*)(Qm + tid * 16) = ((const u32x4*)(P.ws + WS_QI + ci * MB))[tid];
    *(LAS u32x4*)(Sm + tid * 16) = ((const u32x4*)(P.ws + WS_SC + ci * MB))[tid];
    f32x16 d = f32x16{};
    if (wave < 4) { const unsigned* Y0 = (const unsigned*)(P.ws + WS_Y0) + ci * 2048 + (size_t)wq * 512 + lane;
#pragma unroll
        for (int r2 = 0; r2 < 8; ++r2) { const unsigned w = Y0[r2 * 64]; d[2 * r2] = bflo(w); d[2 * r2 + 1] = bfhi(w); } }
    __syncthreads();
    if (wave < 4) { d = mm_nt(Qm, i0, Sm, j0, d, r32, hi);
#pragma unroll
        for (int r = 0; r < 16; ++r) Yl[(i0 + crow(r, hi)) * 65 + j0 + r32] = d[r]; }
    __syncthreads();
    const bf16_t* RR = (const bf16_t*)(P.ws + WS_RR); const bf16_t* RK = (const bf16_t*)(P.ws + WS_RK); const bf16_t* RV = (const bf16_t*)(P.ws + WS_RV); const bf16_t* RG = (const bf16_t*)(P.ws + WS_RG);
    bf16_t* AO = (bf16_t*)(P.ws + WS_AO); const int cc = h * 64 + lane;
    const float lnw = P.ln_w[cc], lnb = P.ln_b[cc], rkc = P.r_k[cc];
#pragma unroll
    for (int i = 0; i < 8; ++i) { const int t = wave * 8 + i; const size_t tok = tok0 + t, o = tok * 512 + cc;
        const float y = Yl[t * 65 + lane], mean = wave_sum(y) * (1.f / 64.f), dv = y - mean, var = wave_sum(dv * dv) * (1.f / 64.f);
        const float yn = dv * rsqrtf(var + 64e-5f) * lnw + lnb;
        const float r = bf2f(RR[o]), k = bf2f(RK[o]), v = bf2f(RV[o]), g = bf2f(RG[o]);
        const float bonus = wave_sum(r * k * rkc) * v;
        AO[tok * DM + 512 + cc] = (bf16_t)f2bf((yn + bonus) * g); }
}
}
namespace rt {
__device__ __forceinline__ int woff(int e, int k) { return e * 2048 + ((((k >> 3) ^ (e & 15))) << 4) + (k & 7) * 2; }
__device__ __forceinline__ void build_w(KPR P, LAS unsigned char* lds, int tid) {
    const int e = tid & 31, kq = tid >> 5;
    for (int i = 0; i < 64; ++i) { const int k = kq * 64 + i; const float w = P.moe_norm[k] * P.w_router[k * 32 + e]; const unsigned h = f2bf(w); const unsigned l = f2bf(w - bf2f(h));
        *(LAS unsigned short*)(lds + woff(e, k)) = (unsigned short)h; *(LAS unsigned short*)(lds + 65536 + woff(e, k)) = (unsigned short)l; }
}
__device__ __forceinline__ void split8(const f32x4& a, const f32x4& b, bf16x8& h, bf16x8& l) {
    unsigned hh[8]; float v[8] = {a[0], a[1], a[2], a[3], b[0], b[1], b[2], b[3]};
#pragma unroll
    for (int j = 0; j < 8; ++j) hh[j] = f2bf(v[j]);
    u32x4 hw, lw;
    hw.x = hh[0] | (hh[1] << 16); hw.y = hh[2] | (hh[3] << 16); hw.z = hh[4] | (hh[5] << 16); hw.w = hh[6] | (hh[7] << 16);
    lw.x = pk2(v[0] - bf2f(hh[0]), v[1] - bf2f(hh[1])); lw.y = pk2(v[2] - bf2f(hh[2]), v[3] - bf2f(hh[3])); lw.z = pk2(v[4] - bf2f(hh[4]), v[5] - bf2f(hh[5])); lw.w = pk2(v[6] - bf2f(hh[6]), v[7] - bf2f(hh[7]));
    h = __builtin_bit_cast(bf16x8, hw); l = __builtin_bit_cast(bf16x8, lw);
}
__device__ __forceinline__ void route_task(KPR P, const LAS unsigned char* wlds, int task, int lane) {
    const int r32 = lane & 31, hi = lane >> 5; const int row = task * 32 + r32;
    const float* xrow = (const float*)(P.ws + WS_X1) + (size_t)row * DM + 8 * hi;
    f32x16 acc = f32x16{}; float ss = 0.f;
    f32x4 xa[4], xb[4];
#pragma unroll
    for (int j = 0; j < 4; ++j) { xa[j] = *(const f32x4*)(xrow + 16 * j); xb[j] = *(const f32x4*)(xrow + 16 * j + 4); }
    for (int ks0 = 0; ks0 < 64; ks0 += 4) {
#pragma unroll
        for (int j = 0; j < 4; ++j) { const int ks = ks0 + j; const f32x4 a = xa[j], b = xb[j];
            const int kn = (ks + 4 < 64) ? ks + 4 : ks; xa[j] = *(const f32x4*)(xrow + 16 * kn); xb[j] = *(const f32x4*)(xrow + 16 * kn + 4);
            ss += (a[0] * a[0] + a[1] * a[1]) + (a[2] * a[2] + a[3] * a[3]) + (b[0] * b[0] + b[1] * b[1]) + (b[2] * b[2] + b[3] * b[3]);
            bf16x8 xh, xl; split8(a, b, xh, xl);
            const bf16x8 wh = *(const LAS bf16x8*)(wlds + woff(r32, 16 * ks + 8 * hi)), wl = *(const LAS bf16x8*)(wlds + 65536 + woff(r32, 16 * ks + 8 * hi));
            acc = __builtin_amdgcn_mfma_f32_32x32x16_bf16(wh, xh, acc, 0, 0, 0); acc = __builtin_amdgcn_mfma_f32_32x32x16_bf16(wh, xl, acc, 0, 0, 0); acc = __builtin_amdgcn_mfma_f32_32x32x16_bf16(wl, xh, acc, 0, 0, 0); }
    }
    ss += __shfl_xor(ss, 32);
    const float rstd = rsqrtf(ss * (1.f / DM) + 1e-6f);
    float lg[16];
#pragma unroll
    for (int g = 0; g < 4; ++g) { const f32x4 bb = *(const f32x4*)(P.b_router + 8 * g + 4 * hi);
#pragma unroll
        for (int i = 0; i < 4; ++i) lg[4 * g + i] = acc[4 * g + i] * rstd + bb[i]; }
    float tv[4]; int ti[4];
#pragma unroll
    for (int k = 0; k < 4; ++k) { float bv = lg[0]; int bi = 4 * hi;
#pragma unroll
        for (int r = 1; r < 16; ++r) { const int e = (r & 3) + 8 * (r >> 2) + 4 * hi; if (lg[r] > bv) { bv = lg[r]; bi = e; } }
        const float pv = __shfl_xor(bv, 32); const int pi = __shfl_xor(bi, 32);
        if (pv > bv || (pv == bv && pi < bi)) { bv = pv; bi = pi; }
        tv[k] = bv; ti[k] = bi;
#pragma unroll
        for (int r = 0; r < 16; ++r) { const int e = (r & 3) + 8 * (r >> 2) + 4 * hi; if (e == bi) lg[r] = -INFINITY; } }
    const float e1 = __expf(tv[1] - tv[0]), e2 = __expf(tv[2] - tv[0]), e3 = __expf(tv[3] - tv[0]), inv = 1.f / (1.f + e1 + e2 + e3);
    const int c0 = hi ? ti[2] : ti[0], c1 = hi ? ti[3] : ti[1]; const float g0 = (hi ? e2 : 1.f) * inv, g1 = (hi ? e3 : e1) * inv;
    const unsigned long long ltm = (1ull << lane) - 1ull; int mycnt = 0, rk0 = 0, rk1 = 0;
    for (int e = 0; e < 32; ++e) { const unsigned long long m0 = __ballot(c0 == e), m1 = __ballot(c1 == e); const int n0 = __popcll(m0);
        if (lane == e) mycnt = n0 + __popcll(m1);
        if (c0 == e) rk0 = __popcll(m0 & ltm);
        if (c1 == e) rk1 = n0 + __popcll(m1 & ltm); }
    unsigned* cnt = (unsigned*)(P.ws + WS_CTL) + CW_CNT; int base = 0;
    if (lane < 32 && mycnt > 0) base = (int)atomicAdd(cnt + lane, (unsigned)mycnt);
    rk0 += __shfl(base, c0); rk1 += __shfl(base, c1);
    int* route = (int*)(P.ws + WS_ROUTE); int* tokslot = (int*)(P.ws + WS_TOKSLOT); float* gateslot = (float*)(P.ws + WS_GATESLOT);
    tokslot[(size_t)c0 * NTOK + rk0] = row; gateslot[(size_t)c0 * NTOK + rk0] = g0; tokslot[(size_t)c1 * NTOK + rk1] = row; gateslot[(size_t)c1 * NTOK + rk1] = g1;
    route[(size_t)row * 12 + 2 * hi] = c0; route[(size_t)row * 12 + 2 * hi + 1] = c1; route[(size_t)row * 12 + 4 + 2 * hi] = rk0; route[(size_t)row * 12 + 4 + 2 * hi + 1] = rk1;
    bf16_t* xn = (bf16_t*)(P.ws + WS_XN) + (size_t)row * DM + 8 * hi; const float* gn = P.moe_norm + 8 * hi;
#pragma unroll 4
    for (int ks = 0; ks < 64; ++ks) { const f32x4 a = *(const f32x4*)(xrow + 16 * ks), b = *(const f32x4*)(xrow + 16 * ks + 4), ga = *(const f32x4*)(gn + 16 * ks), gb = *(const f32x4*)(gn + 16 * ks + 4);
        u32x4 w; w.x = pk2(a[0] * rstd * ga[0], a[1] * rstd * ga[1]); w.y = pk2(a[2] * rstd * ga[2], a[3] * rstd * ga[3]); w.z = pk2(b[0] * rstd * gb[0], b[1] * rstd * gb[1]); w.w = pk2(b[2] * rstd * gb[2], b[3] * rstd * gb[3]);
        *(u32x4*)(xn + 16 * ks) = w; }
}
}
__device__ __forceinline__ int crow(int r, int hi) { return (r & 3) + 8 * (r >> 2) + 4 * hi; }
constexpr int CW_QATT = 128;
constexpr int MISC_TAB = 64, MISC_Q = 4096, MISC_PFX = 4160;

__device__ __forceinline__ void attn_unit_v2(KPR P, LAS unsigned char* lds, int bh, int qb) {
    LAS bf16_t* Ks = (LAS bf16_t*)lds;
    LAS bf16_t* Vt = (LAS bf16_t*)(lds + 9216);
    LAS float* wsf = (LAS float*)(lds + 18432);
    const bf16_t* Z = (const bf16_t*)(P.ws + WS_Z); bf16_t* AO = (bf16_t*)(P.ws + WS_AO);
    const int tid = threadIdx.x, lane = tid & 63, w = tid >> 6, r32 = lane & 31, hi = lane >> 5;
    const int b = bh >> 3, h = bh & 7, q0 = qb * 256;
    const size_t rowbase = (size_t)b * SEQ;
    const float* c2 = (const float*)(P.ws + WS_C2) + (size_t)bh * SEQ;
    const int qloc = q0 + 32 * w + r32;
    const bf16_t* Qp = Z + (rowbase + qloc) * ZW + ZQ + h * 64;
    bf16x8 qr[4];
#pragma unroll
    for (int ks = 0; ks < 4; ++ks) qr[ks] = *(const bf16x8*)(Qp + ks * 16 + hi * 8);
    const float cq = c2[qloc];
    float m = -1e30f, l = 0.f; f32x16 o[2]; o[0] = f32x16{}; o[1] = f32x16{};
    const int ntiles = (q0 + 256) / 64;
    LAS float* wsw = wsf + w * 64;
    int t0 = 0;
    { float gq = fabsf(P.q_norm[lane]), gk = fabsf(P.k_norm[lane]);
#pragma unroll
        for (int o = 1; o < 64; o <<= 1) { gq = fmaxf(gq, __shfl_xor(gq, o)); gk = fmaxf(gk, __shfl_xor(gk, o)); }
        const float thr = c2[q0] + (2.0f * 8.0f * LOG2E * gq * gk + 40.0f);
        const int nfull = q0 / 64;
        for (int tb = 0; tb < nfull; tb += 64) { const int tt = tb + lane; const bool sk = (tt < nfull) && (c2[tt * 64 + 63] > thr); const unsigned long long bm = __ballot(sk); t0 += __popcll(bm); if (bm != ~0ull) break; } }
    for (int t = t0; t < ntiles; ++t) {
        __syncthreads();
        { const int row = tid >> 3, ch = tid & 7; const bf16_t* src = Z + (rowbase + t * 64 + row) * ZW + h * 64 + ch * 8;
            *(LAS u32x4*)&Ks[row * 72 + ch * 8] = *(const u32x4*)(src + ZK);
            const u32x4 v = *(const u32x4*)(src + ZV); const unsigned vv[4] = {v.x, v.y, v.z, v.w};
#pragma unroll
            for (int e = 0; e < 4; ++e) { Vt[(ch * 8 + 2 * e) * 72 + row] = (bf16_t)(vv[e] & 0xffffu); Vt[(ch * 8 + 2 * e + 1) * 72 + row] = (bf16_t)(vv[e] >> 16); } }
        __syncthreads();
        if (t * 64 > q0 + 32 * w + 31) continue;
        f32x16 p[2];
#pragma unroll
        for (int g = 0; g < 2; ++g) { p[g] = f32x16{};
#pragma unroll
            for (int ks = 0; ks < 4; ++ks) { const bf16x8 kf = *(const LAS bf16x8*)&Ks[(32 * g + r32) * 72 + ks * 16 + hi * 8]; p[g] = __builtin_amdgcn_mfma_f32_32x32x16_bf16(kf, qr[ks], p[g], 0, 0, 0); } }
        float mx = -1e30f;
#pragma unroll
        for (int g = 0; g < 2; ++g)
#pragma unroll
            for (int r4 = 0; r4 < 4; ++r4) { const int kv0 = t * 64 + 32 * g + 8 * r4 + 4 * hi; const f32x4 ck = *(const f32x4*)(c2 + kv0);
#pragma unroll
                for (int i = 0; i < 4; ++i) { float s = p[g][4 * r4 + i] + (cq - ck[i]); if (kv0 + i > qloc) s = -INFINITY; p[g][4 * r4 + i] = s; mx = fmaxf(mx, s); } }
        mx = fmaxf(mx, __shfl_xor(mx, 32));
        const float mnew = fmaxf(m, mx), alpha = exp2f(m - mnew); m = mnew;
        float ps = 0.f;
#pragma unroll
        for (int g = 0; g < 2; ++g)
#pragma unroll
            for (int r = 0; r < 16; ++r) { const float e = exp2f(p[g][r] - mnew); p[g][r] = e; ps += e; }
        l = l * alpha + ps;
        if (hi == 0) wsw[r32] = alpha;
        __builtin_amdgcn_wave_barrier(); asm volatile("s_waitcnt lgkmcnt(0)" ::: "memory");
#pragma unroll
        for (int r4 = 0; r4 < 4; ++r4) { const f32x4 al = *(const LAS f32x4*)&wsw[8 * r4 + 4 * hi];
#pragma unroll
            for (int i = 0; i < 4; ++i) { o[0][4 * r4 + i] *= al[i]; o[1][4 * r4 + i] *= al[i]; } }
#pragma unroll
        for (int g = 0; g < 2; ++g)
#pragma unroll
            for (int s = 0; s < 2; ++s) { u32x4 pw; pw.x = pk2(p[g][8 * s + 0], p[g][8 * s + 1]); pw.y = pk2(p[g][8 * s + 2], p[g][8 * s + 3]); pw.z = pk2(p[g][8 * s + 4], p[g][8 * s + 5]); pw.w = pk2(p[g][8 * s + 6], p[g][8 * s + 7]);
                const bf16x8 pa = __builtin_bit_cast(bf16x8, pw);
#pragma unroll
                for (int d0 = 0; d0 < 2; ++d0) { const u32x2 lo = *(const LAS u32x2*)&Vt[(32 * d0 + r32) * 72 + 32 * g + 16 * s + 4 * hi], hh = *(const LAS u32x2*)&Vt[(32 * d0 + r32) * 72 + 32 * g + 16 * s + 8 + 4 * hi];
                    u32x4 vw; vw.x = lo.x; vw.y = lo.y; vw.z = hh.x; vw.w = hh.y;
                    o[d0] = __builtin_amdgcn_mfma_f32_32x32x16_bf16(pa, __builtin_bit_cast(bf16x8, vw), o[d0], 0, 0, 0); } }
        __builtin_amdgcn_wave_barrier();
    }
    l += __shfl_xor(l, 32);
    __builtin_amdgcn_wave_barrier();
    if (hi == 0) wsw[32 + r32] = l;
    __builtin_amdgcn_wave_barrier(); asm volatile("s_waitcnt lgkmcnt(0)" ::: "memory");
#pragma unroll
    for (int r = 0; r < 16; ++r) { const int q = crow(r, hi); const float li = 1.0f / wsw[32 + q]; const size_t row = rowbase + q0 + 32 * w + q;
#pragma unroll
        for (int d0 = 0; d0 < 2; ++d0) { const int d = 32 * d0 + r32; const float og = bf2f(Z[row * ZW + ZOG + h * 64 + d]);
            AO[row * DM + h * 64 + d] = (bf16_t)f2bf(o[d0][r] * li * sigmoidf_(og)); } }
    __builtin_amdgcn_wave_barrier();
}

__device__ __forceinline__ float zlerp(const bf16_t* Z, size_t row, bool first, int col, const float* mu) {
    const float z1 = bf2f(Z[row * ZW + ZR + col]); const float z0 = first ? 0.f : bf2f(Z[(row - 1) * ZW + ZR + col]);
    return z1 + (z0 - z1) * mu[col];
}
__device__ __forceinline__ void rwkv_prep_group(KPR P, LAS float* xs  , int grp, int tid  ) {
    const bf16_t* Z = (const bf16_t*)(P.ws + WS_Z);
    const size_t row0 = (size_t)grp * 8;
    for (int tok = 0; tok < 8; ++tok) { const size_t row = row0 + tok; const bool first = (row % SEQ) == 0;
        const float z = zlerp(Z, row, first, RW_W + tid, P.mu);
        xs[tok * 256 + tid] = tid < 64 ? tanhf(z) : (tid < 128 ? z : sigmoidf_(z)); }
    __syncthreads();
    float lw[8][2], la[8][2], lg[8][2];
#pragma unroll
    for (int t = 0; t < 8; ++t)
#pragma unroll
        for (int c = 0; c < 2; ++c) { lw[t][c] = 0.f; la[t][c] = 0.f; lg[t][c] = 0.f; }
    for (int j = 0; j < 64; ++j) { const float w0 = P.w2[j * 512 + tid], w1 = P.w2[j * 512 + tid + 256], a0 = P.a2[j * 512 + tid], a1 = P.a2[j * 512 + tid + 256];
#pragma unroll
        for (int t = 0; t < 8; ++t) { const float xw = xs[t * 256 + j], xa = xs[t * 256 + 64 + j]; lw[t][0] += xw * w0; lw[t][1] += xw * w1; la[t][0] += xa * a0; la[t][1] += xa * a1; } }
    for (int j = 0; j < 128; ++j) { const float g0 = P.g2[j * 512 + tid], g1 = P.g2[j * 512 + tid + 256];
#pragma unroll
        for (int t = 0; t < 8; ++t) { const float xg = xs[t * 256 + 128 + j]; lg[t][0] += xg * g0; lg[t][1] += xg * g1; } }
    bf16_t* RR = (bf16_t*)(P.ws + WS_RR); bf16_t* RK = (bf16_t*)(P.ws + WS_RK); bf16_t* RV = (bf16_t*)(P.ws + WS_RV); bf16_t* RG = (bf16_t*)(P.ws + WS_RG);
    bf16_t* RLW = (bf16_t*)(P.ws + WS_RLW); bf16_t* RKK = (bf16_t*)(P.ws + WS_RKK); bf16_t* RKA = (bf16_t*)(P.ws + WS_RKA);
#pragma unroll
    for (int t = 0; t < 8; ++t) { const size_t row = row0 + t; const bool first = (row % SEQ) == 0;
#pragma unroll
        for (int c = 0; c < 2; ++c) { const int cc = tid + 256 * c;
            const float zr = zlerp(Z, row, first, RW_R + cc, P.mu), zk = zlerp(Z, row, first, RW_K + cc, P.mu), zv = zlerp(Z, row, first, RW_V + cc, P.mu);
            const float wl = P.w0[cc] + lw[t][c]; const float sp = fmaxf(-wl, 0.f) + log1pf(expf(-fabsf(wl)));
            const float logdecay = -expf(-sp - 0.5f);
            const float a = sigmoidf_(P.a0[cc] + la[t][c]);
            const float kkr = zk * P.k_k[cc]; const float ss = wave_sum(kkr * kkr); const float kk = kkr / fmaxf(sqrtf(ss), 1e-12f);
            const float kp = zk * (1.0f + (a - 1.0f) * P.k_a[cc]);
            const size_t o = row * 512 + cc;
            RR[o] = (bf16_t)f2bf(zr); RK[o] = (bf16_t)f2bf(kp); RV[o] = (bf16_t)f2bf(zv); RG[o] = (bf16_t)f2bf(lg[t][c]); RLW[o] = (bf16_t)f2bf(logdecay); RKK[o] = (bf16_t)f2bf(kk); RKA[o] = (bf16_t)f2bf(kk * a); } }
    __syncthreads();
}
__device__ __forceinline__ void combine_row(KPR P, const LAS int* tab, int row, int lane) {
    const int* route = (const int*)(P.ws + WS_ROUTE); const bf16_t* YP = (const bf16_t*)(P.ws + WS_YP); float* X = (float*)(P.ws + WS_X1);
    f32x4 v[4]; const f32x4* xr = (const f32x4*)(X + (size_t)row * DM) + lane;
#pragma unroll
    for (int j = 0; j < 4; ++j) v[j] = xr[64 * j];
#pragma unroll
    for (int k = 0; k < 4; ++k) { const int ex = route[(size_t)row * 12 + k], rank = route[(size_t)row * 12 + 4 + k]; const size_t pos = (size_t)tab[pg8::T_BLKSTART + ex] * 256 + rank;
        const u32x2* yr = (const u32x2*)(YP + pos * DM) + lane;
#pragma unroll
        for (int j = 0; j < 4; ++j) { const u32x2 y = yr[64 * j]; v[j][0] += bflo(y.x); v[j][1] += bfhi(y.x); v[j][2] += bflo(y.y); v[j][3] += bfhi(y.y); } }
    f32x4* xo = (f32x4*)(X + (size_t)row * DM) + lane; float s = 0.f;
#pragma unroll
    for (int j = 0; j < 4; ++j) { xo[64 * j] = v[j]; s += (v[j][0] * v[j][0] + v[j][1] * v[j][1]) + (v[j][2] * v[j][2] + v[j][3] * v[j][3]); }
    const float rstd = rsqrtf(wave_sum(s) * (1.f / DM) + 1e-6f);
#pragma unroll
    for (int j = 0; j < 4; ++j) v[j] = v[j] * rstd * ((const f32x4*)P.ple_norm)[64 * j + lane];
    store_row_bf16((bf16_t*)(P.ws + WS_XN) + (size_t)row * DM, lane, v);
}

constexpr int NPHASE = 13;
__global__ void __launch_bounds__(NTHREADS, 2) mega_fwd(Params Pkarg_unused) {
    extern __shared__ __attribute__((aligned(16))) unsigned char smem[];
    LAS unsigned char* lds = (LAS unsigned char*)smem;
    const int tid = threadIdx.x, lane = tid & 63, wave = __builtin_amdgcn_readfirstlane(tid >> 6);
    const int G = gridDim.x, blk = blockIdx.x;
#define P (*kpp)
#ifndef MK_REP
#define MK_REP -1
#endif
#define PHASE_BEGIN(k) if (IN(k)) for (int rep_ = 0; rep_ < ((k) == MK_REP ? 2 : 1); ++rep_) { const __attribute__((address_space(4))) Params* kpp = kp_fresh();
#define PHASE_END(k) } if (BOTH(k)) xcd_barrier(bar);
#define IN(k) (ph_lo <= (k) && (k) < ph_hi)
#define BOTH(k) (IN(k) && IN((k) + 1))
    const __attribute__((address_space(4))) Params* kpp = kp_fresh();
    unsigned* ctl = (unsigned*)(P.ws + WS_CTL);
    volatile LAS unsigned* MISC = (volatile LAS unsigned*)(lds + MISC_OFF);
    LAS int* tab = (LAS int*)(lds + MISC_OFF + MISC_TAB);
    if (tid < 16) MISC[tid] = 0u;
    __syncthreads();
    XcdBarrier bar = xcd_barrier_post(ctl + CW_BAR, MISC);
    unsigned char* const wsb = P.ws;
    const int ph_lo = P.ph_lo, ph_hi = P.ph_hi;

    PHASE_BEGIN(0)
        phase_prep_weights(P, lds, blk * NWAVES + wave, G * NWAVES, wave, lane);
        phase_cvt_p(P, blk * NTHREADS + tid, G * NTHREADS);
        __syncthreads();
        LAS float* wff = (LAS float*)lds; LAS float* lf = (LAS float*)(lds + 32768);
        load_wff(P, wff, tid, NTHREADS); __syncthreads();
        for (int i = 0; i < 16; ++i) { const int rl = wave * 16 + i; norm1_row(P, blk * 128 + rl, lane, wff, lf + rl * 8); }
        __syncthreads();
        if (tid < 8) { float run = 0.f; float* cloc = (float*)(P.ws + WS_LOGF) + (size_t)blk * 128 * 8 + tid;
            for (int r = 0; r < 128; ++r) { run += lf[r * 8 + tid]; cloc[r * 8] = run; }
            ((float*)(P.ws + WS_CTOT))[blk * 8 + tid] = run; }
        if (blk == 0) { bf16_t* zr = (bf16_t*)(P.ws + WS_XN) + (size_t)NTOK * DM; for (int i = tid; i < DM; i += NTHREADS) zr[i] = 0; }
    PHASE_END(0)

    PHASE_BEGIN(1)
        {
            LAS float* pfx = (LAS float*)(lds + MISC_OFF + MISC_PFX);
            if (tid < 8) { float s = 0.f; const float* ct = (const float*)(wsb + WS_CTOT); for (int j = (blk & ~63); j < blk; ++j) s += ct[j * 8 + tid]; pfx[tid] = s; }
            __syncthreads();
            const float* cloc = (const float*)(wsb + WS_LOGF) + (size_t)blk * 128 * 8; float* c2 = (float*)(P.ws + WS_C2);
            for (int i = tid; i < 1024; i += NTHREADS) { const int r = i >> 3, h = i & 7; const int row = blk * 128 + r, b = row >> 13, t = row & (SEQ - 1);
                c2[((size_t)(b * 8 + h)) * SEQ + t] = (cloc[i] + pfx[h]) * LOG2E; }
            __syncthreads();
        }
        {
            pg8::DenseOrder S{(const bf16_t*)(wsb + WS_XN), (const bf16_t*)(wsb + WS_WIN), 1024, NTOK / 256, ZW / 256, G, blk};
            pg8::EpiIn E{(bf16_t*)(P.ws + WS_Z), P.q_norm, P.k_norm};
            pg8::gemm_phase<pg8::EpiIn, pg8::DenseOrder, true>(lds, 1024, S, E);
        }
        {
            pg8::DenseOrder S{(const bf16_t*)((unsigned char*)P.out + DO_PB), (const bf16_t*)(wsb + WS_WPP), PLE, NTOK / 256, DM / 256, G, blk};
            pg8::EpiBf16 E{(bf16_t*)((unsigned char*)P.out + DO_PJ), DM};
            pg8::gemm_phase<pg8::EpiBf16, pg8::DenseOrder, true>(lds, PLE, S, E);
        }
    PHASE_END(1)

    PHASE_BEGIN(2)
        const int sub = tid >> 8, st = tid & 255; LAS float* xs = (LAS float*)(lds + sub * 8192);
        for (int it = 0; it < NTOK / 8 / (2 * 256); ++it) rwkv_prep_group(P, xs, (it * G + blk) * 2 + sub, st);
    PHASE_END(2)

    PHASE_BEGIN(3)
        for (int task = blk; task < NB * NH * rk::NCHUNK; task += G) rk::pass1_chunk(P, lds, task >> 7, task & 127, tid);
    PHASE_END(3)

    PHASE_BEGIN(4)
        if (blk < NB * NH) rk::pass2_seq(P, lds, blk, tid);
        for (;;) {
            __syncthreads();
            if (tid == 0) MISC[MISC_Q / 4] = __hip_atomic_fetch_add(ctl + CW_QATT + 64 * rep_, 1u, RLX_AGENT);
            __syncthreads();
            const int q = (int)MISC[MISC_Q / 4];
            if (q >= 1024) break;
            attn_unit_v2(P, lds, q & 31, 31 - (q >> 5));
        }
    PHASE_END(4)

    PHASE_BEGIN(5)
        for (int task = blk; task < NB * NH * rk::NCHUNK; task += G) rk::pass3_chunk(P, lds, task >> 7, task & 127, tid);
    PHASE_END(5)

    PHASE_BEGIN(6)
        pg8::DenseOrder S{(const bf16_t*)(wsb + WS_AO), (const bf16_t*)(wsb + WS_WOUT), 1024, NTOK / 256, DM / 256, G, blk};
        pg8::EpiOut E{P.x, (float*)(P.ws + WS_X1)};
        pg8::gemm_phase<pg8::EpiOut, pg8::DenseOrder, true>(lds, 1024, S, E);
    PHASE_END(6)

    PHASE_BEGIN(7)
        rt::build_w(P, lds, tid);
        __syncthreads();
        for (int task = wave * G + blk; task < NTOK / 32; task += NWAVES * G) rt::route_task(P, lds, task, lane);
    PHASE_END(7)

    PHASE_BEGIN(8)
        const int nblk = pg8::moe_tables(tab, (const unsigned*)(wsb + WS_CTL) + CW_CNT);
        pg8::MoeOrder S{(const bf16_t*)(wsb + WS_XN), (const bf16_t*)(wsb + WS_WGU), (const int*)(wsb + WS_TOKSLOT), tab, nblk, 8, G, blk, true};
        pg8::EpiGu E{(bf16_t*)(P.ws + WS_ACT), P.b_gu};
        pg8::gemm_phase<pg8::EpiGu, pg8::MoeOrder, true>(lds, 1024, S, E);
    PHASE_END(8)
    PHASE_BEGIN(9)
        const int nblk = pg8::moe_tables(tab, (const unsigned*)(wsb + WS_CTL) + CW_CNT);
        pg8::MoeOrder S{(const bf16_t*)(wsb + WS_ACT), (const bf16_t*)(wsb + WS_WDN), (const int*)(wsb + WS_TOKSLOT), tab, nblk, 4, G, blk, false};
        pg8::EpiDn E{(bf16_t*)(P.ws + WS_YP), P.b_down, (const float*)(wsb + WS_GATESLOT), tab};
        pg8::gemm_phase<pg8::EpiDn, pg8::MoeOrder, true>(lds, 1024, S, E);
    PHASE_END(9)
    PHASE_BEGIN(10)
        (void)pg8::moe_tables(tab, (const unsigned*)(wsb + WS_CTL) + CW_CNT);
        for (int row = blk * NWAVES + wave; row < NTOK; row += G * NWAVES) combine_row(P, tab, row, lane);
    PHASE_END(10)
    PHASE_BEGIN(11)
        pg8::DenseOrder S{(const bf16_t*)(wsb + WS_XN), (const bf16_t*)(wsb + WS_WPG), 1024, NTOK / 256, DM / 256, G, blk};
        pg8::EpiPg E{(float*)(P.ws + WS_X1), (const bf16_t*)((unsigned char*)P.out + DO_PJ)};
        pg8::gemm_phase<pg8::EpiPg, pg8::DenseOrder, true>(lds, 1024, S, E);
    PHASE_END(11)
    PHASE_BEGIN(12)
        const bool dead = __hip_atomic_load(ctl + CW_BAR + XB_TMO, RLX_AGENT) != 0u;
        for (int row = blk * NWAVES + wave; row < NTOK; row += G * NWAVES) final_row(P, row, lane, dead);
    PHASE_END(12)
}
#undef P
extern "C" void kernel_launch(void* const* d_in, const int* in_sizes, int n_in, void* d_out, int out_size, void* d_ws, size_t ws_size, hipStream_t stream) {
    static int ok = 0;
    if (ok == 0) {
        if (n_in != 30 || in_sizes[0] != NTOK * DM || out_size != NTOK * DM || ws_size < WS_END) { fprintf(stderr, "kernel_launch: unexpected shapes (n_in %d, ws %zu)\n", n_in, ws_size); ok = -1; return; }
        if (hipFuncSetAttribute((const void*)mega_fwd, hipFuncAttributeMaxDynamicSharedMemorySize, LDS_BYTES) != hipSuccess) { fprintf(stderr, "kernel_launch: hipFuncSetAttribute failed\n"); ok = -1; return; }
        int dev = 0, cus = 0, per_cu = 0;
        if (hipGetDevice(&dev) != hipSuccess || hipDeviceGetAttribute(&cus, hipDeviceAttributeMultiprocessorCount, dev) != hipSuccess) { ok = -1; return; }
        if (hipOccupancyMaxActiveBlocksPerMultiprocessor(&per_cu, (const void*)mega_fwd, NTHREADS, LDS_BYTES) != hipSuccess || per_cu < 1) { fprintf(stderr, "kernel_launch: occupancy query says %d\n", per_cu); }
        (void)hipGetLastError();
        if (cus != 256) { fprintf(stderr, "kernel_launch: built for 256 CUs, device has %d\n", cus); ok = -1; return; }
        ok = 1;
    }
    if (ok < 0) return;
    Params P{};
    const float** pp = (const float**)&P;
    for (int i = 0; i < 30; ++i) pp[i] = (const float*)d_in[i];
    P.out = (float*)d_out; P.ws = (unsigned char*)d_ws;
    if (hipMemsetAsync((char*)d_ws + WS_CTL, 0, CTL_BYTES, stream) != hipSuccess) return;
#ifndef MK_CUTS
#define MK_CUTS 0
#endif
    if (MK_CUTS == 0) { P.ph_lo = 0; P.ph_hi = NPHASE; hipLaunchKernelGGL(mega_fwd, dim3(256), dim3(NTHREADS), LDS_BYTES, stream, P); }
    else for (int k = 0; k < NPHASE; ++k) { P.ph_lo = k; P.ph_hi = k + 1;
        hipLaunchKernelGGL(mega_fwd, dim3(256), dim3(NTHREADS), LDS_BYTES, stream, P); }
}
```

```cpp
#include <hip/hip_runtime.h>
#include <cstdio>
#include <cstdint>

#define LAS __attribute__((address_space(3)))
#define GAS __attribute__((address_space(1)))
typedef unsigned short bf16_t;
typedef short bf16x8 __attribute__((ext_vector_type(8)));
typedef float f32x2 __attribute__((ext_vector_type(2)));
typedef float f32x4 __attribute__((ext_vector_type(4)));
typedef float f32x16 __attribute__((ext_vector_type(16)));
typedef unsigned u32x2 __attribute__((ext_vector_type(2)));
typedef unsigned u32x4 __attribute__((ext_vector_type(4)));

constexpr int NB = 4, SEQ = 8192, NTOK = NB * SEQ, DM = 1024;
constexpr int NH = 8, HD = 64;
constexpr int INW = 3848;
constexpr int ZW = 3840;
constexpr int ZQ = 0, ZK = 512, ZV = 1024, ZOG = 1536, ZR = 2048;
constexpr int RW_R = 0, RW_K = 512, RW_V = 1024, RW_W = 1536, RW_A = 1600, RW_G = 1664, RWIN = 1792;
constexpr int NE = 32, TOPK = 4, EFF = 1024;
constexpr int MAXBLK = (NTOK * TOPK) / 256 + NE;
constexpr int PLE = 256;
constexpr float LOG2E = 1.4426950408889634f;
constexpr float QSCALE = 0.125f * LOG2E;

constexpr size_t MiB = 1u << 20;
constexpr size_t WS_CTL = 0, CTL_BYTES = 1 * MiB;
constexpr size_t WS_C2 = 1 * MiB;
constexpr size_t WS_LOGF = 2 * MiB;
constexpr size_t WS_ROUTE = 3 * MiB;
constexpr size_t WS_TOKSLOT = 5 * MiB;
constexpr size_t WS_GATESLOT = 9 * MiB;
constexpr size_t WS_CTOT = 13 * MiB;
constexpr size_t WS_WIN = 16 * MiB;
constexpr size_t WS_WOUT = 24 * MiB;
constexpr size_t WS_WPG = 26 * MiB;
constexpr size_t WS_WPP = 28 * MiB;
constexpr size_t WS_WGU = 32 * MiB;
constexpr size_t WS_WDN = 160 * MiB;
constexpr size_t WS_XN = 224 * MiB;
constexpr size_t WS_X1 = 290 * MiB;
constexpr size_t WS_Z = 418 * MiB;
constexpr size_t WS_AO = 658 * MiB;
constexpr size_t WS_ACT = 418 * MiB;
constexpr size_t WS_RW = 722 * MiB;
constexpr size_t WS_RR = WS_RW, WS_RK = WS_RW + 32 * MiB, WS_RV = WS_RW + 64 * MiB, WS_RG = WS_RW + 96 * MiB;
constexpr size_t WS_RLW = WS_RW + 128 * MiB;
constexpr size_t WS_RKK = WS_RW + 160 * MiB, WS_RKA = WS_RW + 192 * MiB;
constexpr size_t WS_YP = 722 * MiB;
constexpr size_t WS_END = 994 * MiB;
static_assert(WS_ACT + (size_t)MAXBLK * 256 * 1024 * 2 <= WS_RW && WS_YP + (size_t)MAXBLK * 256 * 1024 * 2 <= WS_END, "ws map");
constexpr size_t DO_PJ = 0, DO_PB = 64 * MiB;
constexpr int CW_TMO = 0, CW_CNT = 64  , CW_BAR = 4096;

struct Params {
    const float *x, *p, *mix_norm, *w_in, *f_bias, *q_norm, *k_norm, *mu, *w0, *w2, *a0, *a2, *g2, *k_k, *k_a, *r_k, *ln_w, *ln_b, *w_out, *moe_norm, *w_router, *b_router, *w_gu, *b_gu, *w_down,
        *b_down, *ple_norm, *w_pg, *w_pp, *final_norm;
    float* out; unsigned char* ws; int ph_lo, ph_hi;
};

typedef const __attribute__((address_space(4))) Params& KPR;
__device__ __forceinline__ const __attribute__((address_space(4))) Params* kp_fresh() {
    unsigned long long p = (unsigned long long)__builtin_amdgcn_kernarg_segment_ptr(); asm volatile("" : "+s"(p)); return (const __attribute__((address_space(4))) Params*)p; }

__device__ __forceinline__ unsigned f2bf(float f) { unsigned u = __builtin_bit_cast(unsigned, f); return (u + 0x7fffu + ((u >> 16) & 1u)) >> 16; }
__device__ __forceinline__ unsigned pk2(float lo, float hi) { return f2bf(lo) | (f2bf(hi) << 16); }
__device__ __forceinline__ float bf2f(unsigned h) { return __builtin_bit_cast(float, h << 16); }
__device__ __forceinline__ float bflo(unsigned w) { return __builtin_bit_cast(float, w << 16); }
__device__ __forceinline__ float bfhi(unsigned w) { return __builtin_bit_cast(float, w & 0xffff0000u); }
__device__ __forceinline__ unsigned cvt_pk_bf16(float lo, float hi) { unsigned r; asm volatile("v_cvt_pk_bf16_f32 %0, %1, %2" : "=v"(r) : "v"(lo), "v"(hi)); return r; }
__device__ __forceinline__ float wave_sum(float v) {
#pragma unroll
    for (int o = 1; o < 64; o <<= 1) v += __shfl_xor(v, o);
    return v;
}
__device__ __forceinline__ float sigmoidf_(float x) { return 1.0f / (1.0f + __expf(-x)); }
__device__ __forceinline__ float logsigmoidf_(float x) { return fminf(x, 0.f) - log1pf(expf(-fabsf(x))); }
namespace pg8 {
constexpr int BM = 256, BK = 64, HALF = 128, HTB = HALF * BK * 2, STAGE_BYTES = 8 * HTB, NXCD = 8, WGM = 8;
__host__ __device__ __forceinline__ int lds_byte(int r, int c) { const int st = (r >> 4) * 2 + (c >> 5), rr = r & 15, cc = c & 31, ob = rr * 64 + cc * 2; return st * 1024 + (ob ^ (((ob >> 9) & 1) << 5)); }
__host__ __device__ __forceinline__ void stage_rc(int b, int& R, int& C) { const int st = b / 1024, sb = b % 1024, swz = sb ^ (((sb >> 9) & 1) << 5); R = (st >> 1) * 16 + swz / 64; C = (st & 1) * 32 + (swz % 64) / 2; }
__host__ __device__ __forceinline__ int perm32(int rho) { const int n = rho >> 4, i = rho & 15; return 8 * (i >> 2) + 4 * n + (i & 3); }

struct Unit { int pm, pn, e, lb; };

__device__ __forceinline__ bool tile_order(int i, int G, int c, int nM, int nN, int& pm, int& pn) {
    const int nwg = nM * nN; const long L = (long)i * G + c; if (L >= nwg) return false;
    int wgid = (int)L; { const int q = nwg / NXCD, r = nwg % NXCD, xcd = wgid % NXCD, off = wgid / NXCD; wgid = (xcd < r ? xcd * (q + 1) : r * (q + 1) + (xcd - r) * q) + off; }
    const int nig = WGM * nN, gid = wgid / nig, fm = gid * WGM, gsz = (nM - fm) < WGM ? (nM - fm) : WGM;
    pm = fm + ((wgid % nig) % gsz); pn = (wgid % nig) / gsz; return true;
}
struct DenseOrder {
    const bf16_t* A; const bf16_t* Bt; int K, nM, nN, G, c;
    __device__ __forceinline__ bool next(int i, Unit& u) const { u.e = 0; u.lb = 0; return tile_order(i, G, c, nM, nN, u.pm, u.pn); }
    __device__ __forceinline__ const char* a_base(const Unit& u) const { return (const char*)A + (size_t)u.pm * BM * K * 2; }
    __device__ __forceinline__ const char* b_base(const Unit& u) const { return (const char*)Bt + (size_t)u.pn * BM * K * 2; }
    __device__ __forceinline__ void a_off(const Unit&, const int (&R)[2], const int (&C)[2], unsigned (&off)[2][2]) const {
#pragma unroll
        for (int h = 0; h < 2; ++h)
#pragma unroll
            for (int i = 0; i < 2; ++i) off[h][i] = (unsigned)((R[i] + HALF * h) * K + C[i]) * 2u;
    }
};

template <class Epi, class Sched, bool ALIGN_EPI>
__device__ __forceinline__ void gemm_phase(LAS unsigned char* lds, const int K, const Sched& S, const Epi& E) {
    int tid_ = threadIdx.x; asm volatile("" : "+v"(tid_));
    const int tid = tid_, wid = __builtin_amdgcn_readfirstlane(tid >> 6), lane = tid & 63, wr = wid >> 2, wc = wid & 3, fr = lane & 15, fq = lane >> 4;
    const int nt = K / BK;
    int sR[2], sC[2]; unsigned voffB[2];
#pragma unroll
    for (int i = 0; i < 2; ++i) { int R, C; stage_rc(tid * 16 + i * 8192, R, C); const int Rb = Epi::PERM ? ((R & ~31) + perm32(R & 31)) : R; sR[i] = R; sC[i] = C; voffB[i] = (unsigned)(Rb * K + C) * 2u; }
    const size_t kstep = (size_t)(BK * 2);
    const size_t hstep = (size_t)HALF * K * 2;
    const unsigned ldsw = (unsigned)wid * 1024u;
    const int aoff = lds_byte(wr * 64 + fr, fq * 8), boff = lds_byte(wc * 32 + fr, fq * 8);
#define PG8_SA(b, h) (((b) * 2 + (h)) * HTB)
#define PG8_SB(b, h) ((4 + (b) * 2 + (h)) * HTB)
#define PG8_STAGE(bufoff, gbase, voff) do { _Pragma("unroll") for (int _i = 0; _i < 2; ++_i) \
        __builtin_amdgcn_global_load_lds((const unsigned*)((const char*)(gbase) + (voff)[_i]), (LAS unsigned*)(lds + (bufoff) + ldsw + _i * 8192), 16, 0, 0); } while (0)
#define PG8_LDA(dst, b, h) do { _Pragma("unroll") for (int m = 0; m < 4; ++m) _Pragma("unroll") for (int k = 0; k < 2; ++k) dst[m][k] = *(const LAS bf16x8*)(lds + PG8_SA(b, h) + aoff + m * 2048 + k * 1024); } while (0)
#define PG8_LDB(dst, b, h) do { _Pragma("unroll") for (int n = 0; n < 2; ++n) _Pragma("unroll") for (int k = 0; k < 2; ++k) dst[n][k] = *(const LAS bf16x8*)(lds + PG8_SB(b, h) + boff + n * 2048 + k * 1024); } while (0)
#define PG8_MMA(ai, bj, At, Bt) do { __builtin_amdgcn_s_setprio(1); _Pragma("unroll") for (int m = 0; m < 4; ++m) _Pragma("unroll") for (int n = 0; n < 2; ++n) _Pragma("unroll") for (int k = 0; k < 2; ++k) \
        acc[ai][bj][m][n] = __builtin_amdgcn_mfma_f32_16x16x32_bf16(Bt[n][k], At[m][k], acc[ai][bj][m][n], 0, 0, 0); __builtin_amdgcn_s_setprio(0); } while (0)
#define PG8_WAIT_V(n) asm volatile("s_waitcnt vmcnt(" #n ")" ::: "memory")
#define PG8_WAIT_L(n) asm volatile("s_waitcnt lgkmcnt(" #n ")" ::: "memory")
#define PG8_BAR __builtin_amdgcn_s_barrier()
#define PG8_SCHED __builtin_amdgcn_sched_barrier(0)
    Unit cur, nxt; int ui = 0;
    if (!S.next(0, cur)) return;
    f32x4 acc[2][2][4][2];
#pragma unroll
    for (int a = 0; a < 2; ++a)
#pragma unroll
        for (int b = 0; b < 2; ++b)
#pragma unroll
            for (int m = 0; m < 4; ++m)
#pragma unroll
                for (int n = 0; n < 2; ++n) acc[a][b][m][n] = (f32x4){0.f, 0.f, 0.f, 0.f};
    bf16x8 At[4][2], B0[2][2], B1[2][2];
    unsigned offC[2][2], offN[2][2];
    S.a_off(cur, sR, sC, offC);
    const char* cA = S.a_base(cur); const char* cB = S.b_base(cur);
    PG8_STAGE(PG8_SB(0, 0), cB, voffB); PG8_STAGE(PG8_SB(0, 1), cB + hstep, voffB); PG8_STAGE(PG8_SA(0, 0), cA, offC[0]); PG8_STAGE(PG8_SA(0, 1), cA, offC[1]);
    if (wr == 1) PG8_BAR;
    PG8_WAIT_V(2); PG8_BAR;
    PG8_STAGE(PG8_SB(1, 0), cB + kstep, voffB); PG8_STAGE(PG8_SA(1, 0), cA + kstep, offC[0]); PG8_STAGE(PG8_SB(1, 1), cB + hstep + kstep, voffB);
    PG8_WAIT_V(6); PG8_BAR;
    for (;;) {
        const bool has_next = S.next(ui + 1, nxt);
        const char* nA = cA; const char* nB = cB;
        if (has_next) { nA = S.a_base(nxt); nB = S.b_base(nxt); S.a_off(nxt, sR, sC, offN); }
        else {
#pragma unroll
            for (int h = 0; h < 2; ++h)
#pragma unroll
                for (int i = 0; i < 2; ++i) offN[h][i] = offC[h][i];
        }
#pragma nounroll
        for (int t = 0; t < nt; t += 2) {
            const bool last = (t == nt - 2);
            const char* a1 = cA + (size_t)(t + 1) * kstep;
            const char* a2 = last ? nA : cA + (size_t)(t + 2) * kstep; const char* b2 = last ? nB : cB + (size_t)(t + 2) * kstep;
            const char* a3 = a2 + kstep; const char* b3 = b2 + kstep;
            unsigned o2[2][2];
#pragma unroll
            for (int h = 0; h < 2; ++h)
#pragma unroll
                for (int i = 0; i < 2; ++i) o2[h][i] = last ? offN[h][i] : offC[h][i];
            PG8_LDB(B0, 0, 0); PG8_LDB(B1, 0, 1); PG8_SCHED; PG8_LDA(At, 0, 0); PG8_STAGE(PG8_SA(1, 1), a1, offC[1]);
            PG8_WAIT_V(8); PG8_WAIT_L(0); PG8_BAR; PG8_MMA(0, 0, At, B0); PG8_MMA(0, 1, At, B1); PG8_BAR; PG8_SCHED;
            PG8_LDA(At, 0, 1); PG8_STAGE(PG8_SB(0, 0), b2, voffB); PG8_STAGE(PG8_SB(0, 1), b2 + hstep, voffB); PG8_STAGE(PG8_SA(0, 0), a2, o2[0]);
            PG8_WAIT_V(8); PG8_WAIT_L(0); PG8_BAR; PG8_MMA(1, 0, At, B0); PG8_MMA(1, 1, At, B1); PG8_BAR; PG8_SCHED;
            PG8_LDB(B0, 1, 0); PG8_LDB(B1, 1, 1); PG8_SCHED; PG8_LDA(At, 1, 0); PG8_STAGE(PG8_SA(0, 1), a2, o2[1]);
            PG8_WAIT_V(8); PG8_WAIT_L(0); PG8_BAR; PG8_MMA(0, 0, At, B0); PG8_MMA(0, 1, At, B1); PG8_BAR; PG8_SCHED;
            PG8_LDA(At, 1, 1); PG8_STAGE(PG8_SB(1, 0), b3, voffB); PG8_STAGE(PG8_SB(1, 1), b3 + hstep, voffB); PG8_STAGE(PG8_SA(1, 0), a3, o2[0]);
            PG8_WAIT_V(8); PG8_WAIT_L(0); PG8_BAR; PG8_MMA(1, 0, At, B0); PG8_MMA(1, 1, At, B1); PG8_BAR; PG8_SCHED;
        }
        if constexpr (ALIGN_EPI) { if (wr == 0) PG8_BAR; }
        E(acc, cur, wr, wc, fr, fq);
        if (!has_next) break;
#pragma unroll
        for (int a = 0; a < 2; ++a)
#pragma unroll
            for (int b = 0; b < 2; ++b)
#pragma unroll
                for (int m = 0; m < 4; ++m)
#pragma unroll
                    for (int n = 0; n < 2; ++n) acc[a][b][m][n] = (f32x4){0.f, 0.f, 0.f, 0.f};
        cur = nxt; cA = nA; cB = nB; ++ui;
#pragma unroll
        for (int h = 0; h < 2; ++h)
#pragma unroll
            for (int i = 0; i < 2; ++i) offC[h][i] = offN[h][i];
        if constexpr (ALIGN_EPI) { if (wr == 1) PG8_BAR; }
    }
    PG8_WAIT_V(0);
    if constexpr (!ALIGN_EPI) { if (wr == 0) PG8_BAR; }
    PG8_BAR;
#undef PG8_SA
#undef PG8_SB
#undef PG8_STAGE
#undef PG8_LDA
#undef PG8_LDB
#undef PG8_MMA
#undef PG8_WAIT_V
#undef PG8_WAIT_L
#undef PG8_BAR
#undef PG8_SCHED
}
}
namespace pg8 {
constexpr int T_BLKSTART = 0  , T_CNT = 40  , T_BLKE = 80  , T_WORDS = 80 + 560;

struct EpiIn {
    static constexpr bool PERM = true;
    bf16_t* Z; const float* qn; const float* kn;
    __device__ __forceinline__ void operator()(const f32x4 (&acc)[2][2][4][2], const Unit& u, int wr, int wc, int fr, int fq) const {
        const int row0 = u.pm * BM + wr * 64 + fr;
        if (u.pn < 4) {
            const float* g = (u.pn < 2) ? qn : kn; const float sc = (u.pn < 2) ? QSCALE : 1.0f;
            f32x4 gv[2][2];
#pragma unroll
            for (int bj = 0; bj < 2; ++bj)
#pragma unroll
                for (int n = 0; n < 2; ++n) gv[bj][n] = *(const f32x4*)(g + 32 * bj + 8 * fq + 4 * n) * sc;
#pragma unroll
            for (int ai = 0; ai < 2; ++ai)
#pragma unroll
                for (int m = 0; m < 4; ++m) {
                    float ss = 0.f;
#pragma unroll
                    for (int bj = 0; bj < 2; ++bj)
#pragma unroll
                        for (int n = 0; n < 2; ++n) { const f32x4 x = acc[ai][bj][m][n]; ss += (x[0] * x[0] + x[1] * x[1]) + (x[2] * x[2] + x[3] * x[3]); }
                    ss += __shfl_xor(ss, 16); ss += __shfl_xor(ss, 32);
                    const float rstd = rsqrtf(ss * (1.0f / 64.0f) + 1e-6f);
                    bf16_t* rowp = Z + (size_t)(row0 + ai * HALF + m * 16) * ZW + u.pn * BM + 64 * wc + 8 * fq;
#pragma unroll
                    for (int bj = 0; bj < 2; ++bj) { const f32x4 v0 = acc[ai][bj][m][0] * rstd * gv[bj][0], v1 = acc[ai][bj][m][1] * rstd * gv[bj][1];
                        u32x4 w; w.x = cvt_pk_bf16(v0[0], v0[1]); w.y = cvt_pk_bf16(v0[2], v0[3]); w.z = cvt_pk_bf16(v1[0], v1[1]); w.w = cvt_pk_bf16(v1[2], v1[3]);
                        *(u32x4*)(rowp + 32 * bj) = w; }
                }
        } else {
            const int col0 = u.pn * BM + wc * 32 + 8 * fq;
#pragma unroll
            for (int ai = 0; ai < 2; ++ai)
#pragma unroll
                for (int m = 0; m < 4; ++m) { bf16_t* rowp = Z + (size_t)(row0 + ai * HALF + m * 16) * ZW + col0;
#pragma unroll
                    for (int bj = 0; bj < 2; ++bj) { const f32x4 v0 = acc[ai][bj][m][0], v1 = acc[ai][bj][m][1];
                        u32x4 w; w.x = cvt_pk_bf16(v0[0], v0[1]); w.y = cvt_pk_bf16(v0[2], v0[3]); w.z = cvt_pk_bf16(v1[0], v1[1]); w.w = cvt_pk_bf16(v1[2], v1[3]);
                        *(u32x4*)(rowp + bj * HALF) = w; } }
        }
    }
};
struct EpiBf16 {
    static constexpr bool PERM = true;
    bf16_t* O; int ldc;
    __device__ __forceinline__ void operator()(const f32x4 (&acc)[2][2][4][2], const Unit& u, int wr, int wc, int fr, int fq) const {
        const int row0 = u.pm * BM + wr * 64 + fr, col0 = u.pn * BM + wc * 32 + 8 * fq;
#pragma unroll
        for (int ai = 0; ai < 2; ++ai)
#pragma unroll
            for (int m = 0; m < 4; ++m) { bf16_t* rowp = O + (size_t)(row0 + ai * HALF + m * 16) * ldc + col0;
#pragma unroll
                for (int bj = 0; bj < 2; ++bj) { const f32x4 v0 = acc[ai][bj][m][0], v1 = acc[ai][bj][m][1];
                    u32x4 w; w.x = cvt_pk_bf16(v0[0], v0[1]); w.y = cvt_pk_bf16(v0[2], v0[3]); w.z = cvt_pk_bf16(v1[0], v1[1]); w.w = cvt_pk_bf16(v1[2], v1[3]);
                    *(u32x4*)(rowp + bj * HALF) = w; } }
    }
};
struct EpiOut {
    static constexpr bool PERM = false;
    const float* X; float* O;
    __device__ __forceinline__ void operator()(const f32x4 (&acc)[2][2][4][2], const Unit& u, int wr, int wc, int fr, int fq) const {
        const int row0 = u.pm * BM + wr * 64 + fr, col0 = u.pn * BM + wc * 32 + 4 * fq;
#pragma unroll
        for (int ai = 0; ai < 2; ++ai)
#pragma unroll
            for (int m = 0; m < 4; ++m) { const size_t off = (size_t)(row0 + ai * HALF + m * 16) * DM + col0;
#pragma unroll
                for (int bj = 0; bj < 2; ++bj)
#pragma unroll
                    for (int n = 0; n < 2; ++n) *(f32x4*)(O + off + bj * HALF + n * 16) = *(const f32x4*)(X + off + bj * HALF + n * 16) + acc[ai][bj][m][n];
                if (m & 1) asm volatile("" ::: "memory"); }
    }
};
struct EpiPg {
    static constexpr bool PERM = false;
    float* X; const bf16_t* PJ;
    __device__ __forceinline__ void operator()(const f32x4 (&acc)[2][2][4][2], const Unit& u, int wr, int wc, int fr, int fq) const {
        const int row0 = u.pm * BM + wr * 64 + fr, col0 = u.pn * BM + wc * 32 + 4 * fq;
#pragma unroll
        for (int ai = 0; ai < 2; ++ai)
#pragma unroll
            for (int m = 0; m < 4; ++m) { const size_t off = (size_t)(row0 + ai * HALF + m * 16) * DM + col0;
#pragma unroll
                for (int bj = 0; bj < 2; ++bj)
#pragma unroll
                    for (int n = 0; n < 2; ++n) { const size_t o = off + bj * HALF + n * 16; const u32x2 pj = *(const u32x2*)(PJ + o); const f32x4 a = acc[ai][bj][m][n]; const f32x4 xv = *(const f32x4*)(X + o);
                        f32x4 r; r[0] = xv[0] + sigmoidf_(a[0]) * bflo(pj.x); r[1] = xv[1] + sigmoidf_(a[1]) * bfhi(pj.x); r[2] = xv[2] + sigmoidf_(a[2]) * bflo(pj.y); r[3] = xv[3] + sigmoidf_(a[3]) * bfhi(pj.y);
                        *(f32x4*)(X + o) = r; }
                if (m & 1) asm volatile("" ::: "memory"); }
    }
};
struct EpiGu {
    static constexpr bool PERM = true;
    bf16_t* ACT; const float* b_gu;
    __device__ __forceinline__ void operator()(const f32x4 (&acc)[2][2][4][2], const Unit& u, int wr, int wc, int fr, int fq) const {
        const int row0 = u.pm * BM + wr * 64 + fr, cl = u.pn * HALF + wc * 32 + 8 * fq;
        const float* bg = b_gu + (size_t)u.e * 2048 + cl;
        f32x4 bgl[2], bli[2];
#pragma unroll
        for (int n = 0; n < 2; ++n) { bgl[n] = *(const f32x4*)(bg + 4 * n); bli[n] = *(const f32x4*)(bg + 1024 + 4 * n); }
#pragma unroll
        for (int ai = 0; ai < 2; ++ai)
#pragma unroll
            for (int m = 0; m < 4; ++m) { bf16_t* rowp = ACT + (size_t)(row0 + ai * HALF + m * 16) * EFF + cl; float r[8];
#pragma unroll
                for (int n = 0; n < 2; ++n)
#pragma unroll
                    for (int i = 0; i < 4; ++i) { const float gl = fminf(acc[ai][0][m][n][i] + bgl[n][i], 7.0f); const float li = fminf(fmaxf(acc[ai][1][m][n][i] + bli[n][i], -7.0f), 7.0f);
                        r[4 * n + i] = gl * sigmoidf_(1.702f * gl) * (li + 1.0f); }
                u32x4 w; w.x = cvt_pk_bf16(r[0], r[1]); w.y = cvt_pk_bf16(r[2], r[3]); w.z = cvt_pk_bf16(r[4], r[5]); w.w = cvt_pk_bf16(r[6], r[7]);
                *(u32x4*)rowp = w; }
    }
};
struct EpiDn {
    static constexpr bool PERM = true;
    bf16_t* YP; const float* b_dn; const float* gateslot; const LAS int* tab;
    __device__ __forceinline__ void operator()(const f32x4 (&acc)[2][2][4][2], const Unit& u, int wr, int wc, int fr, int fq) const {
        const int row0 = u.pm * BM + wr * 64 + fr, col0 = u.pn * BM + wc * 32 + 8 * fq;
        const float* bd = b_dn + (size_t)u.e * 1024 + col0; const int cnt = tab[T_CNT + u.e];
        f32x4 bv[2][2];
#pragma unroll
        for (int bj = 0; bj < 2; ++bj)
#pragma unroll
            for (int n = 0; n < 2; ++n) bv[bj][n] = *(const f32x4*)(bd + bj * HALF + 4 * n);
#pragma unroll
        for (int ai = 0; ai < 2; ++ai)
#pragma unroll
            for (int m = 0; m < 4; ++m) { const int rr = wr * 64 + fr + ai * HALF + m * 16, slot = u.lb * 256 + rr;
                const float gt = slot < cnt ? gateslot[(size_t)u.e * NTOK + slot] : 0.f;
                bf16_t* rowp = YP + (size_t)(row0 + ai * HALF + m * 16) * DM + col0;
#pragma unroll
                for (int bj = 0; bj < 2; ++bj) { const f32x4 v0 = (acc[ai][bj][m][0] + bv[bj][0]) * gt, v1 = (acc[ai][bj][m][1] + bv[bj][1]) * gt;
                    u32x4 w; w.x = cvt_pk_bf16(v0[0], v0[1]); w.y = cvt_pk_bf16(v0[2], v0[3]); w.z = cvt_pk_bf16(v1[0], v1[1]); w.w = cvt_pk_bf16(v1[2], v1[3]);
                    *(u32x4*)(rowp + bj * HALF) = w; } }
    }
};
struct MoeOrder {
    const bf16_t* A; const bf16_t* Bt; const int* tokslot; const LAS int* tab; int nblk, nN, G, c; bool gather;
    __device__ __forceinline__ bool next(int i, Unit& u) const { if (!tile_order(i, G, c, nblk, nN, u.pm, u.pn)) return false; u.e = tab[T_BLKE + u.pm]; u.lb = u.pm - tab[T_BLKSTART + u.e]; return true; }
    __device__ __forceinline__ const char* a_base(const Unit& u) const { return gather ? (const char*)A : (const char*)A + (size_t)u.pm * BM * 1024 * 2; }
    __device__ __forceinline__ const char* b_base(const Unit& u) const { return (const char*)Bt + ((size_t)u.e * nN + u.pn) * BM * 1024 * 2; }
    __device__ __forceinline__ void a_off(const Unit& u, const int (&R)[2], const int (&C)[2], unsigned (&off)[2][2]) const {
        const int cnt = tab[T_CNT + u.e];
#pragma unroll
        for (int h = 0; h < 2; ++h)
#pragma unroll
            for (int i = 0; i < 2; ++i) {
                if (gather) { const int slot = u.lb * 256 + R[i] + HALF * h; const int tok = slot < cnt ? tokslot[(size_t)u.e * NTOK + slot] : NTOK; off[h][i] = (unsigned)tok * 2048u + (unsigned)C[i] * 2u; }
                else off[h][i] = (unsigned)((R[i] + HALF * h) * 1024 + C[i]) * 2u;
            }
    }
};
__device__ __forceinline__ int moe_tables(LAS int* tab, const unsigned* cntw) {
    if (threadIdx.x == 0) { int s = 0; for (int e = 0; e < NE; ++e) { const int c = (int)cntw[e]; tab[T_CNT + e] = c; tab[T_BLKSTART + e] = s; const int nb = (c + 255) >> 8; for (int j = 0; j < nb; ++j) tab[T_BLKE + s + j] = e; s += nb; } tab[T_BLKSTART + NE] = s; }
    __syncthreads();
    return tab[T_BLKSTART + NE];
}
}
constexpr int NWAVES = 8, NTHREADS = 512;
constexpr int RING_BYTES = 131072, MISC_OFF = RING_BYTES, LDS_BYTES = 147456;

__device__ __forceinline__ void tr_item(const float* W, int ldw, int srccol0, int k0, bf16_t* WT, int Kd, int dstrow0, LAS float* scr, int lane) {
#pragma unroll 8
    for (int i = 0; i < 32; ++i) { const int kk = 2 * i + (lane >> 5); scr[kk * 33 + (lane & 31)] = W[(size_t)(k0 + kk) * ldw + srccol0 + (lane & 31)]; }
    asm volatile("s_waitcnt lgkmcnt(0)" ::: "memory");
    const int c = lane & 7;
#pragma unroll
    for (int j = 0; j < 4; ++j) { const int n = (lane >> 3) + 8 * j; const LAS float* s = scr + (8 * c) * 33 + n;
        u32x4 o; o.x = pk2(s[0 * 33], s[1 * 33]); o.y = pk2(s[2 * 33], s[3 * 33]); o.z = pk2(s[4 * 33], s[5 * 33]); o.w = pk2(s[6 * 33], s[7 * 33]);
        *(u32x4*)(WT + (size_t)(dstrow0 + n) * Kd + k0 + 8 * c) = o; }
    asm volatile("s_waitcnt lgkmcnt(0)" ::: "memory");
}
constexpr int I_IN = 16 * 120, I_OUT = 16 * 32, I_PG = 16 * 32, I_PP = 4 * 32, I_GU1 = 16 * 64, I_DN1 = 16 * 32;
constexpr int I_LORA = 16 + 16 + 32;
constexpr int I_SMALL = I_IN + I_OUT + I_PG + I_PP + I_LORA, I_GU = NE * I_GU1, I_DN = NE * I_DN1, I_ALL = I_SMALL + I_GU + I_DN;
__device__ __forceinline__ void prep_item(KPR P, int it, LAS float* scr, int lane) {
    unsigned char* ws = P.ws;
    if (it < I_IN) { const int kb = it / 120, nb = it % 120, n0 = nb * 32, pn = n0 >> 8, j0 = n0 & 255;
        const int src = pn < 4 ? (pn * 256 + 64 * ((j0 & 127) >> 5) + 32 * (j0 >> 7)) : (n0 < 2048 ? n0 : n0 + 8);
        tr_item(P.w_in, INW, src, kb * 64, (bf16_t*)(ws + WS_WIN), 1024, n0, scr, lane); return; }
    it -= I_IN;
    if (it < I_OUT) { tr_item(P.w_out, 1024, (it % 32) * 32, (it / 32) * 64, (bf16_t*)(ws + WS_WOUT), 1024, (it % 32) * 32, scr, lane); return; }
    it -= I_OUT;
    if (it < I_PG) { tr_item(P.w_pg, 1024, (it % 32) * 32, (it / 32) * 64, (bf16_t*)(ws + WS_WPG), 1024, (it % 32) * 32, scr, lane); return; }
    it -= I_PG;
    if (it < I_PP) { tr_item(P.w_pp, 1024, (it % 32) * 32, (it / 32) * 64, (bf16_t*)(ws + WS_WPP), 256, (it % 32) * 32, scr, lane); return; }
    it -= I_PP;
    if (it < 16) { tr_item(P.w2, 512, it * 32, 0, (bf16_t*)(ws + 29 * MiB), 64, it * 32, scr, lane); return; }
    it -= 16;
    if (it < 16) { tr_item(P.a2, 512, it * 32, 0, (bf16_t*)(ws + 29 * MiB + 65536), 64, it * 32, scr, lane); return; }
    it -= 16;
    if (it < 32) { tr_item(P.g2, 512, (it % 16) * 32, (it / 16) * 64, (bf16_t*)(ws + 29 * MiB + 131072), 128, (it % 16) * 32, scr, lane); return; }
    it -= 32;
    if (it < I_GU) { const int e = it / I_GU1, r = it % I_GU1, kb = r / 64, nb = r % 64, n0 = nb * 32, pn = n0 >> 8, j0 = n0 & 255;
        const int src = (j0 >> 7) * 1024 + pn * 128 + (j0 & 127);
        tr_item(P.w_gu + (size_t)e * 1024 * 2048, 2048, src, kb * 64, (bf16_t*)(ws + WS_WGU) + (size_t)e * 2048 * 1024, 1024, n0, scr, lane); return; }
    it -= I_GU;
    { const int e = it / I_DN1, r = it % I_DN1, kb = r / 32, nb = r % 32;
        tr_item(P.w_down + (size_t)e * 1024 * 1024, 1024, nb * 32, kb * 64, (bf16_t*)(ws + WS_WDN) + (size_t)e * 1024 * 1024, 1024, nb * 32, scr, lane); }
}
__device__ __forceinline__ void phase_prep_weights(KPR P, LAS unsigned char* lds, int gw, int ngw, int wave, int lane) {
    LAS float* scr = (LAS float*)(lds + wave * 16384);
    for (int it = gw; it < I_ALL; it += ngw) prep_item(P, it, scr, lane);
}
__device__ __forceinline__ void phase_cvt_p(KPR P, int gt, int ngt) {
    bf16_t* PB = (bf16_t*)((unsigned char*)P.out + DO_PB);
    for (int i = gt; i < NTOK * PLE / 8; i += ngt) { const f32x4 a = ((const f32x4*)P.p)[2 * i], b = ((const f32x4*)P.p)[2 * i + 1];
        u32x4 w; w.x = pk2(a[0], a[1]); w.y = pk2(a[2], a[3]); w.z = pk2(b[0], b[1]); w.w = pk2(b[2], b[3]); ((u32x4*)PB)[i] = w; }
}
__device__ __forceinline__ void rms_row(const float* xrow, const float* gain, int lane, f32x4 (&v)[4]) {
    const f32x4* xr = (const f32x4*)xrow + lane; float s = 0.f;
#pragma unroll
    for (int j = 0; j < 4; ++j) { v[j] = xr[64 * j]; s += (v[j][0] * v[j][0] + v[j][1] * v[j][1]) + (v[j][2] * v[j][2] + v[j][3] * v[j][3]); }
    const float rstd = rsqrtf(wave_sum(s) * (1.f / DM) + 1e-6f);
#pragma unroll
    for (int j = 0; j < 4; ++j) v[j] = v[j] * rstd * ((const f32x4*)gain)[64 * j + lane];
}
__device__ __forceinline__ void store_row_bf16(bf16_t* orow, int lane, const f32x4 (&v)[4]) {
    u32x2* o8 = (u32x2*)orow + lane;
#pragma unroll
    for (int j = 0; j < 4; ++j) { u32x2 w; w.x = pk2(v[j][0], v[j][1]); w.y = pk2(v[j][2], v[j][3]); o8[64 * j] = w; }
}
__device__ __forceinline__ void norm1_row(KPR P, int row, int lane, const LAS float* wff, LAS float* lf_out  ) {
    f32x4 v[4]; rms_row(P.x + (size_t)row * DM, P.mix_norm, lane, v);
    store_row_bf16((bf16_t*)(P.ws + WS_XN) + (size_t)row * DM, lane, v);
    float ff[8];
#pragma unroll
    for (int q = 0; q < 8; ++q) ff[q] = 0.f;
#pragma unroll
    for (int j = 0; j < 4; ++j)
#pragma unroll
        for (int i = 0; i < 4; ++i) { const LAS f32x4* w = (const LAS f32x4*)(wff + (size_t)(4 * (64 * j + lane) + i) * 8); const f32x4 w0 = w[0], w1 = w[1]; const float h = v[j][i];
            ff[0] += h * w0[0]; ff[1] += h * w0[1]; ff[2] += h * w0[2]; ff[3] += h * w0[3]; ff[4] += h * w1[0]; ff[5] += h * w1[1]; ff[6] += h * w1[2]; ff[7] += h * w1[3]; }
#pragma unroll
    for (int q = 0; q < 8; ++q) ff[q] = wave_sum(ff[q]);
    if (lane < 8) { float f = ff[0];
#pragma unroll
        for (int q = 1; q < 8; ++q) f = (lane == q) ? ff[q] : f;
        lf_out[lane] = logsigmoidf_(f + P.f_bias[lane]); }
}
__device__ __forceinline__ void load_wff(KPR P, LAS float* wff, int tid, int nthr) {
    for (int i = tid; i < 1024 * 8; i += nthr) wff[i] = P.w_in[(size_t)(i >> 3) * INW + 2048 + (i & 7)];
}
__device__ __forceinline__ void final_row(KPR P, int row, int lane, bool dead) {
    f32x4 v[4]; rms_row((const float*)(P.ws + WS_X1) + (size_t)row * DM, P.final_norm, lane, v);
    f32x4* o = (f32x4*)(P.out + (size_t)row * DM) + lane;
#pragma unroll
    for (int j = 0; j < 4; ++j) { if (dead) { const float q = __builtin_nanf(""); v[j] = (f32x4){q, q, q, q}; } o[64 * j] = v[j]; }
}
typedef GAS unsigned gu32;
#define RLX_AGENT __ATOMIC_RELAXED, __HIP_MEMORY_SCOPE_AGENT
#define XB_TMO      128
#define XB_XCNT(j)  (256  + 64 * (j))
#define XB_XSUB(j)  (1280 + 64 * (j))
#define XB_XGEN(j)  (2304 + 64 * (j))
#define XB_TOP      3328
#define XB_TOPGEN   3392
#define XCD_BAR_WORDS 3456
#define XB_SPIN_CAP (1u << 22)

__device__ __forceinline__ unsigned xb_ld(unsigned* p)              { return __hip_atomic_load(p, __ATOMIC_RELAXED, __HIP_MEMORY_SCOPE_AGENT); }
__device__ __forceinline__ unsigned xb_add(unsigned* p, unsigned v) { return __hip_atomic_fetch_add(p, v, __ATOMIC_RELAXED, __HIP_MEMORY_SCOPE_AGENT); }
__device__ __forceinline__ unsigned xb_xcc_id() { return (unsigned)__builtin_amdgcn_s_getreg((3 << 11) | 20) & 0xFu; }
#define XB_SPIN(cond, bar) do { unsigned _sp = 0; while (cond) { __builtin_amdgcn_s_sleep(1); \
    if ((++_sp & 255u) == 0u) { if (xb_ld(&(bar)[XB_TMO])) break; if (_sp > XB_SPIN_CAP) { atomicAdd(&(bar)[XB_TMO], 1u); break; } } } } while (0)

struct XcdBarrier { unsigned* bar; unsigned x; volatile LAS unsigned* st; };

__device__ __forceinline__ XcdBarrier xcd_barrier_post(unsigned* bar, volatile LAS unsigned* st) {
    XcdBarrier b; b.bar = bar; b.x = xb_xcc_id(); b.st = st;
    if (threadIdx.x == 0) (void)xb_add(&bar[XB_XCNT(b.x)], 1u);
    return b;
}
__device__ __forceinline__ void xcd_barrier_complete(unsigned* bar, unsigned x, unsigned& nloc, unsigned& nx) {
    const unsigned G = gridDim.x * gridDim.y * gridDim.z;
    unsigned sum, cnt, mine, sp = 0u;
    for (;;) {
        sum = 0u; cnt = 0u; mine = 0u;
#pragma unroll
        for (unsigned j = 0; j < 16; ++j) { const unsigned c = xb_ld(&bar[XB_XCNT(j)]); sum += c; cnt += (c > 0u) ? 1u : 0u; mine = (j == x) ? c : mine; }
        if (sum == G) break;
        __builtin_amdgcn_s_sleep(1);
        if ((++sp & 255u) == 0u) { if (xb_ld(&bar[XB_TMO])) break; if (sp > XB_SPIN_CAP) { atomicAdd(&bar[XB_TMO], 1u); break; } }
    }
    nloc = mine > 0u ? mine : 1u; nx = cnt > 0u ? cnt : 1u;
}
__device__ __forceinline__ void xcd_barrier(const XcdBarrier& b) {
    asm volatile("s_waitcnt vmcnt(0)" ::: "memory");
    __syncthreads();
    if (threadIdx.x == 0) {
        unsigned* bar = b.bar;
        __builtin_amdgcn_s_waitcnt(0);
        unsigned nloc = b.st[0], nx = b.st[1];
        if (nloc == 0u) { xcd_barrier_complete(bar, b.x, nloc, nx); b.st[0] = nloc; b.st[1] = nx; }
        const unsigned old = xb_add(&bar[XB_XSUB(b.x)], 1u);
        const unsigned gen = old / nloc;
        if (old + 1u == (gen + 1u) * nloc) {
            __builtin_amdgcn_fence(__ATOMIC_RELEASE, "agent");
            asm volatile("s_waitcnt vmcnt(0)" ::: "memory");
            const unsigned og = xb_add(&bar[XB_TOP], 1u);
            const unsigned tg = og / nx;
            if (og + 1u == (tg + 1u) * nx) xb_add(&bar[XB_TOPGEN], 1u);
            else XB_SPIN(xb_ld(&bar[XB_TOPGEN]) == tg, bar);
            __builtin_amdgcn_fence(__ATOMIC_ACQUIRE, "agent");
            xb_add(&bar[XB_XGEN(b.x)], 1u);
            asm volatile("s_waitcnt vmcnt(0)" ::: "memory");
        } else {
            XB_SPIN(xb_ld(&bar[XB_XGEN(b.x)]) == gen, bar);
            __builtin_amdgcn_fence(__ATOMIC_ACQUIRE, "agent");
            asm volatile("s_waitcnt vmcnt(0)" ::: "memory");
        }
    }
    __syncthreads();
}
namespace rk {
constexpr int MB = 8192;
constexpr int S_AT = 0, S_RT = 1, S_KT = 2, S_BT = 3, S_ATT = 4, S_KTT = 5, S_BTT = 6, S_VT = 7, S_N = 8, S_NT = 9, S_MAK = 10, S_MRB = 11, S_MRK = 12, S_TA = 13, S_TB = 14;
constexpr int SCR = 15 * MB;
constexpr int NCHUNK = SEQ / 64;
constexpr size_t WS_HT = WS_X1;
constexpr size_t WS_Y0 = WS_X1 + 64 * MiB;
constexpr size_t WS_QI = WS_X1 + 96 * MiB;
constexpr size_t WS_LW = WS_RW, WS_LA = WS_RW + 32 * MiB, WS_LG = WS_RW + 64 * MiB;
constexpr size_t WS_SC = WS_RW + 224 * MiB;
constexpr size_t DO_GT = 80 * MiB;
static_assert(WS_SC + 32 * MiB <= WS_END, "rwkv blobs");

__device__ __forceinline__ int moff(int row, int col) { return row * 128 + ((((col >> 3) ^ (row >> 1)) & 7) << 4) + (col & 7) * 2; }
__device__ __forceinline__ int crow(int r, int hi) { return (r & 3) + 8 * (r >> 2) + 4 * hi; }
__device__ __forceinline__ f32x16 mm_nt(const LAS unsigned char* A, int ar0, const LAS unsigned char* Bt, int br0, f32x16 acc, int r32, int hi) {
#pragma unroll
    for (int ks = 0; ks < 4; ++ks) { const bf16x8 a = *(const LAS bf16x8*)(A + moff(ar0 + r32, 16 * ks + 8 * hi)), b = *(const LAS bf16x8*)(Bt + moff(br0 + r32, 16 * ks + 8 * hi));
        acc = __builtin_amdgcn_mfma_f32_32x32x16_bf16(a, b, acc, 0, 0, 0); }
    return acc;
}
__device__ __forceinline__ void store_t(LAS unsigned char* dst, const f32x16& acc, int i0, int j0, int r32, int hi) {
#pragma unroll
    for (int g = 0; g < 4; ++g) { u32x2 w; w.x = pk2(acc[4 * g], acc[4 * g + 1]); w.y = pk2(acc[4 * g + 2], acc[4 * g + 3]); *(LAS u32x2*)(dst + moff(j0 + r32, i0 + 8 * g + 4 * hi)) = w; }
}
template <int MODE> __device__ __forceinline__ void mask_tri(f32x16& acc, int i0, int j0, int r32, int hi) {
#pragma unroll
    for (int r = 0; r < 16; ++r) { const int i = i0 + crow(r, hi), j = j0 + r32; const bool keep = MODE == 0 ? (j < i) : (MODE == 1 ? (i < j) : (i <= j)); if (!keep) acc[r] = 0.f; }
}

__device__ __forceinline__ void pass1_chunk(KPR P, LAS unsigned char* lds, int bh, int c, int tid) {
    const int lane = tid & 63, wave = tid >> 6, r32 = lane & 31, hi = lane >> 5, grp = wave >> 2, wq = wave & 3, i0 = 32 * (wq >> 1), j0 = 32 * (wq & 1);
    const int b = bh >> 3, h = bh & 7; const size_t tok0 = (size_t)b * SEQ + (size_t)c * 64; const size_t ci = (size_t)bh * NCHUNK + c;
    LAS float* part = (LAS float*)(lds + SCR); LAS float* WL = (LAS float*)(lds + SCR + 2048);
#define MAT(s) (lds + (s) * MB)
    {
        const bf16_t* Z = (const bf16_t*)(P.ws + WS_Z); const bf16_t* LW = (const bf16_t*)(P.ws + WS_LW); const bf16_t* LA = (const bf16_t*)(P.ws + WS_LA);
        const int ch = tid & 63, tq = tid >> 6, cc = h * 64 + ch; const size_t row0 = tok0 + 8 * tq;
        const float mur = P.mu[RW_R + cc], muk = P.mu[RW_K + cc], muv = P.mu[RW_V + cc], w0c = P.w0[cc], a0c = P.a0[cc], kkc = P.k_k[cc], kac = P.k_a[cc];
        const bf16_t* zp = Z + row0 * ZW + ZR + cc;
        const bool first = (c == 0) && (tq == 0);
        float pr = first ? 0.f : bf2f(zp[RW_R - ZW]), pk = first ? 0.f : bf2f(zp[RW_K - ZW]), pv = first ? 0.f : bf2f(zp[RW_V - ZW]);
        float cum[8], vr[8], vk[8], vkk[8], vka[8]; unsigned short vv16[8]; float run = 0.f;
#pragma unroll
        for (int i = 0; i < 8; ++i) { const bf16_t* zi = zp + (size_t)i * ZW; const float zr1 = bf2f(zi[RW_R]), zk1 = bf2f(zi[RW_K]), zv1 = bf2f(zi[RW_V]);
            const float zr = zr1 + (pr - zr1) * mur, zk = zk1 + (pk - zk1) * muk, zv = zv1 + (pv - zv1) * muv; pr = zr1; pk = zk1; pv = zv1;
            const size_t o = (row0 + i) * 512 + cc;
            const float wl = w0c + bf2f(LW[o]); const float sp = fmaxf(-wl, 0.f) + __logf(1.0f + __expf(-fabsf(wl)));
            run += -__expf(-sp - 0.5f); cum[i] = run;
            const float a = 1.0f / (1.0f + __expf(-(a0c + bf2f(LA[o]))));
            const float kkr = zk * kkc; const float ssq = wave_sum(kkr * kkr); const float kk = kkr / fmaxf(sqrtf(ssq), 1e-12f);
            vr[i] = zr; vk[i] = zk * (1.0f + (a - 1.0f) * kac); vkk[i] = kk; vka[i] = kk * a; vv16[i] = (unsigned short)f2bf(zv); }
        part[tq * 64 + ch] = run;
        __syncthreads();
        float pre = 0.f;
#pragma unroll
        for (int g = 0; g < 8; ++g) { const float pvv = part[g * 64 + ch]; pre += (g < tq) ? pvv : 0.f; }
        float eprev = __expf(pre);
        unsigned atT[4], ktT[4], btT[4], vT[4]; unsigned short hold[4] = {0, 0, 0, 0};
#pragma unroll
        for (int i = 0; i < 8; ++i) { const int t = 8 * tq + i;
            const float cm = pre + cum[i], e1 = __expf(cm), einv = __expf(-cm);
            const unsigned short at = (unsigned short)f2bf(-vkk[i] * eprev), rt = (unsigned short)f2bf(vr[i] * e1), kt = (unsigned short)f2bf(vk[i] * einv), bt = (unsigned short)f2bf(vka[i] * einv), vv = vv16[i];
            eprev = e1;
            *(LAS unsigned short*)(MAT(S_AT) + moff(t, ch)) = at; *(LAS unsigned short*)(MAT(S_RT) + moff(t, ch)) = rt; *(LAS unsigned short*)(MAT(S_KT) + moff(t, ch)) = kt; *(LAS unsigned short*)(MAT(S_BT) + moff(t, ch)) = bt;
            if (i & 1) { atT[i >> 1] = hold[0] | ((unsigned)at << 16); ktT[i >> 1] = hold[1] | ((unsigned)kt << 16); btT[i >> 1] = hold[2] | ((unsigned)bt << 16); vT[i >> 1] = hold[3] | ((unsigned)vv << 16); }
            else { hold[0] = at; hold[1] = kt; hold[2] = bt; hold[3] = vv; }
            if (i == 7 && tq == 7) WL[ch] = e1; }
        *(LAS u32x4*)(MAT(S_ATT) + moff(ch, 8 * tq)) = (u32x4){atT[0], atT[1], atT[2], atT[3]}; *(LAS u32x4*)(MAT(S_KTT) + moff(ch, 8 * tq)) = (u32x4){ktT[0], ktT[1], ktT[2], ktT[3]};
        *(LAS u32x4*)(MAT(S_BTT) + moff(ch, 8 * tq)) = (u32x4){btT[0], btT[1], btT[2], btT[3]}; *(LAS u32x4*)(MAT(S_VT) + moff(ch, 8 * tq)) = (u32x4){vT[0], vT[1], vT[2], vT[3]};
    }
    __syncthreads();
    const f32x16 zero = f32x16{};
    if (grp == 0) { f32x16 d = mm_nt(MAT(S_AT), i0, MAT(S_BT), j0, zero, r32, hi); mask_tri<0>(d, i0, j0, r32, hi); store_t(MAT(S_NT), d, i0, j0, r32, hi);
        d = mm_nt(MAT(S_KT), i0, MAT(S_AT), j0, zero, r32, hi); mask_tri<1>(d, i0, j0, r32, hi); store_t(MAT(S_MAK), d, i0, j0, r32, hi);
        d = mm_nt(MAT(S_KT), i0, MAT(S_RT), j0, zero, r32, hi); mask_tri<2>(d, i0, j0, r32, hi); store_t(MAT(S_MRK), d, i0, j0, r32, hi); }
    else { f32x16 d = mm_nt(MAT(S_BT), i0, MAT(S_AT), j0, zero, r32, hi); mask_tri<1>(d, i0, j0, r32, hi); store_t(MAT(S_N), d, i0, j0, r32, hi);
#pragma unroll
        for (int r = 0; r < 16; ++r) if (i0 + crow(r, hi) == j0 + r32) d[r] = 1.0f;
        store_t(MAT(S_TA), d, i0, j0, r32, hi);
        d = mm_nt(MAT(S_BT), i0, MAT(S_RT), j0, zero, r32, hi); mask_tri<2>(d, i0, j0, r32, hi); store_t(MAT(S_MRB), d, i0, j0, r32, hi); }
    __syncthreads();
#pragma unroll
    for (int s = 1; s <= 6; ++s) {
        const int mc = (s & 1) ? S_N : S_AT, mcT = (s & 1) ? S_NT : S_KT, mn = (s & 1) ? S_AT : S_N, mnT = (s & 1) ? S_KT : S_NT;
        const int tc = (s & 1) ? S_TB : S_TA, tn = (s & 1) ? S_TA : S_TB;
        if (s <= 5) {
            if (grp == 0) { const f32x16 d = mm_nt(MAT(mc), i0, MAT(mcT), j0, zero, r32, hi); store_t(MAT(mnT), d, i0, j0, r32, hi); }
            else { const f32x16 d = mm_nt(MAT(mcT), i0, MAT(mc), j0, zero, r32, hi); store_t(MAT(mn), d, i0, j0, r32, hi); }
        }
        if (s >= 2 && grp == (s <= 5 ? 0 : 1) ) {
            f32x16 d = mm_nt(MAT(mcT), i0, MAT(tc), j0, zero, r32, hi);
#pragma unroll
            for (int g = 0; g < 4; ++g) { const u32x2 tv = *(const LAS u32x2*)(MAT(tc) + moff(j0 + r32, i0 + 8 * g + 4 * hi)); d[4 * g] += bflo(tv.x); d[4 * g + 1] += bfhi(tv.x); d[4 * g + 2] += bflo(tv.y); d[4 * g + 3] += bfhi(tv.y); }
            store_t(MAT(tn), d, i0, j0, r32, hi);
        }
        __syncthreads();
    }
    if (grp == 0) { const f32x16 d = mm_nt(MAT(S_TB), i0, MAT(S_ATT), j0, zero, r32, hi); store_t(MAT(S_BT), d, i0, j0, r32, hi); }
    else { const f32x16 d = mm_nt(MAT(S_MAK), i0, MAT(S_VT), j0, zero, r32, hi); store_t(MAT(S_N), d, i0, j0, r32, hi); }
    __syncthreads();
    if (grp == 0) { const f32x16 d = mm_nt(MAT(S_TB), i0, MAT(S_N), j0, zero, r32, hi); store_t(MAT(S_NT), d, i0, j0, r32, hi);
        f32x16 q = mm_nt(MAT(S_BT), i0, MAT(S_MRB), j0, zero, r32, hi);
#pragma unroll
        for (int g = 0; g < 4; ++g) { const u32x2 rv = *(const LAS u32x2*)(MAT(S_RT) + moff(j0 + r32, i0 + 8 * g + 4 * hi)); q[4 * g] += bflo(rv.x); q[4 * g + 1] += bfhi(rv.x); q[4 * g + 2] += bflo(rv.y); q[4 * g + 3] += bfhi(rv.y); }
        store_t(MAT(S_KT), q, i0, j0, r32, hi); }
    else { f32x16 g_ = mm_nt(MAT(S_BT), i0, MAT(S_BTT), j0, zero, r32, hi);
        const float wl = WL[j0 + r32];
#pragma unroll
        for (int r = 0; r < 16; ++r) { if (i0 + crow(r, hi) == j0 + r32) g_[r] += 1.0f; g_[r] *= wl; }
        store_t(MAT(S_AT), g_, i0, j0, r32, hi); }
    __syncthreads();
    if (grp == 0) { f32x16 d = mm_nt(MAT(S_BTT), i0, MAT(S_NT), j0, zero, r32, hi); d = mm_nt(MAT(S_KTT), i0, MAT(S_VT), j0, d, r32, hi);
        float* HT = (float*)(P.ws + WS_HT) + ci * 4096 + (size_t)wq * 1024 + lane;
#pragma unroll
        for (int g = 0; g < 4; ++g) { const f32x4 wl4 = *(const LAS f32x4*)(WL + i0 + 8 * g + 4 * hi);
#pragma unroll
            for (int i = 0; i < 4; ++i) HT[(4 * g + i) * 64] = d[4 * g + i] * wl4[i]; } }
    else { f32x16 d = mm_nt(MAT(S_MRB), i0, MAT(S_NT), j0, zero, r32, hi); d = mm_nt(MAT(S_MRK), i0, MAT(S_VT), j0, d, r32, hi);
        unsigned* Y0 = (unsigned*)(P.ws + WS_Y0) + ci * 2048 + (size_t)wq * 512 + lane;
#pragma unroll
        for (int r2 = 0; r2 < 8; ++r2) Y0[r2 * 64] = pk2(d[2 * r2], d[2 * r2 + 1]); }
    { u32x4* GTg = (u32x4*)((unsigned char*)P.out + DO_GT + ci * MB); u32x4* QIg = (u32x4*)(P.ws + WS_QI + ci * MB);
        GTg[tid] = *(const LAS u32x4*)(MAT(S_AT) + tid * 16); QIg[tid] = *(const LAS u32x4*)(MAT(S_KT) + tid * 16); }
    __syncthreads();
#undef MAT
}

__device__ __forceinline__ void pass2_seq(KPR P, LAS unsigned char* lds, int bh, int tid) {
    const int lane = tid & 63, wave = tid >> 6, r32 = lane & 31, hi = lane >> 5, wq = wave & 3, i0 = 32 * (wq >> 1), j0 = 32 * (wq & 1);
    LAS unsigned char* Sm = lds; LAS unsigned char* G0 = lds + MB; LAS unsigned char* G1 = lds + 2 * MB;
    const size_t ci0 = (size_t)bh * NCHUNK;
    const u32x4* GTg = (const u32x4*)((const unsigned char*)P.out + DO_GT + ci0 * MB); u32x4* SCg = (u32x4*)(P.ws + WS_SC + ci0 * MB);
    const float* HT = (const float*)(P.ws + WS_HT) + ci0 * 4096 + (size_t)wq * 1024 + lane;
    *(LAS u32x4*)(Sm + tid * 16) = (u32x4){0u, 0u, 0u, 0u};
    *(LAS u32x4*)(G0 + tid * 16) = GTg[tid];
    u32x4 gnext = GTg[512 + tid];
    f32x16 hcur, hnext;
    if (wave < 4) {
#pragma unroll
        for (int r = 0; r < 16; ++r) { hcur[r] = HT[r * 64]; hnext[r] = HT[4096 + r * 64]; } }
    __syncthreads();
    for (int c = 0; c < NCHUNK; ++c) {
        LAS unsigned char* Gc = (c & 1) ? G1 : G0; LAS unsigned char* Gn = (c & 1) ? G0 : G1;
        SCg[(size_t)c * 512 + tid] = *(const LAS u32x4*)(Sm + tid * 16);
        f32x16 d = hcur;
        if (wave < 4) d = mm_nt(Gc, i0, Sm, j0, d, r32, hi);
        __syncthreads();
        if (wave < 4) store_t(Sm, d, i0, j0, r32, hi);
        *(LAS u32x4*)(Gn + tid * 16) = gnext;
        const int c2 = (c + 2 < NCHUNK) ? c + 2 : NCHUNK - 1;
        gnext = GTg[(size_t)c2 * 512 + tid];
        if (wave < 4) { hcur = hnext;
#pragma unroll
            for (int r = 0; r < 16; ++r) hnext[r] = HT[(size_t)c2 * 4096 + r * 64]; }
        __syncthreads();
    }
}

__device__ __forceinline__ void pass3_chunk(KPR P, LAS unsigned char* lds, int bh, int c, int tid) {
    const int lane = tid & 63, wave = tid >> 6, r32 = lane & 31, hi = lane >> 5, wq = wave & 3, i0 = 32 * (wq >> 1), j0 = 32 * (wq & 1);
    const int b = bh >> 3, h = bh & 7; const size_t tok0 = (size_t)b * SEQ + (size_t)c * 64; const size_t ci = (size_t)bh * NCHUNK + c;
    LAS unsigned char* Qm = lds; LAS unsigned char* Sm = lds + MB; LAS float* Yl = (LAS float*)(lds + 2 * MB);
    *(LAS u32x4*)(Qm + tid * 16) = ((const u32x4*)(P.ws + WS_QI + ci * MB))[tid];
    *(LAS u32x4*)(Sm + tid * 16) = ((const u32x4*)(P.ws + WS_SC + ci * MB))[tid];
    f32x16 d = f32x16{};
    if (wave < 4) { const unsigned* Y0 = (const unsigned*)(P.ws + WS_Y0) + ci * 2048 + (size_t)wq * 512 + lane;
#pragma unroll
        for (int r2 = 0; r2 < 8; ++r2) { const unsigned w = Y0[r2 * 64]; d[2 * r2] = bflo(w); d[2 * r2 + 1] = bfhi(w); } }
    __syncthreads();
    if (wave < 4) { d = mm_nt(Qm, i0, Sm, j0, d, r32, hi);
#pragma unroll
        for (int r = 0; r < 16; ++r) Yl[(i0 + crow(r, hi)) * 65 + j0 + r32] = d[r]; }
    __syncthreads();
    const bf16_t* Z = (const bf16_t*)(P.ws + WS_Z); const bf16_t* LA = (const bf16_t*)(P.ws + WS_LA); const bf16_t* LG = (const bf16_t*)(P.ws + WS_LG);
    bf16_t* AO = (bf16_t*)(P.ws + WS_AO); const int cc = h * 64 + lane;
    const float lnw = P.ln_w[cc], lnb = P.ln_b[cc], rkc = P.r_k[cc], mur = P.mu[RW_R + cc], muk = P.mu[RW_K + cc], muv = P.mu[RW_V + cc], a0c = P.a0[cc], kac = P.k_a[cc];
    const bf16_t* zp = Z + (tok0 + wave * 8) * ZW + ZR + cc; const bool first = (c == 0) && (wave == 0);
    float pr = first ? 0.f : bf2f(zp[RW_R - ZW]), pk = first ? 0.f : bf2f(zp[RW_K - ZW]), pv = first ? 0.f : bf2f(zp[RW_V - ZW]);
#pragma unroll
    for (int i = 0; i < 8; ++i) { const int t = wave * 8 + i; const size_t tok = tok0 + t, o = tok * 512 + cc; const bf16_t* zi = zp + (size_t)i * ZW;
        const float zr1 = bf2f(zi[RW_R]), zk1 = bf2f(zi[RW_K]), zv1 = bf2f(zi[RW_V]);
        const float r = zr1 + (pr - zr1) * mur, zk = zk1 + (pk - zk1) * muk, v = zv1 + (pv - zv1) * muv; pr = zr1; pk = zk1; pv = zv1;
        const float a = 1.0f / (1.0f + __expf(-(a0c + bf2f(LA[o])))); const float k = zk * (1.0f + (a - 1.0f) * kac), g = bf2f(LG[o]);
        const float y = Yl[t * 65 + lane], mean = wave_sum(y) * (1.f / 64.f), dv = y - mean, var = wave_sum(dv * dv) * (1.f / 64.f);
        const float yn = dv * rsqrtf(var + 64e-5f) * lnw + lnb;
        const float bonus = wave_sum(r * k * rkc) * v;
        AO[tok * DM + 512 + cc] = (bf16_t)f2bf((yn + bonus) * g); }
}

constexpr size_t WS_W2T = 29 * MiB, WS_A2T = 29 * MiB + 65536, WS_G2T = 29 * MiB + 131072;
__device__ __forceinline__ bf16x8 act8(const bf16_t* zc, const bf16_t* zpv, float pmask, const float* mu, int mode) {
    const u32x4 c = *(const u32x4*)zc, p = *(const u32x4*)zpv;
    const f32x4 m0 = *(const f32x4*)mu, m1 = *(const f32x4*)(mu + 4);
    const unsigned cw[4] = {c.x, c.y, c.z, c.w}, pw[4] = {p.x, p.y, p.z, p.w}; const float um[8] = {m0[0], m0[1], m0[2], m0[3], m1[0], m1[1], m1[2], m1[3]}; float v[8];
#pragma unroll
    for (int j = 0; j < 4; ++j) { const float c0 = bflo(cw[j]), c1 = bfhi(cw[j]), p0 = bflo(pw[j]) * pmask, p1 = bfhi(pw[j]) * pmask;
        v[2 * j] = c0 + (p0 - c0) * um[2 * j]; v[2 * j + 1] = c1 + (p1 - c1) * um[2 * j + 1]; }
#pragma unroll
    for (int j = 0; j < 8; ++j) { if (mode == 0) { const float e = __expf(-2.0f * fabsf(v[j])); const float th = (1.0f - e) / (1.0f + e); v[j] = v[j] < 0.f ? -th : th; } else if (mode == 2) v[j] = 1.0f / (1.0f + __expf(-v[j])); }
    u32x4 w; w.x = pk2(v[0], v[1]); w.y = pk2(v[2], v[3]); w.z = pk2(v[4], v[5]); w.w = pk2(v[6], v[7]);
    return __builtin_bit_cast(bf16x8, w);
}
__device__ __forceinline__ void lora_task(KPR P, int task, int lane) {
    const int r32 = lane & 31, hi = lane >> 5; const size_t row = (size_t)task * 32 + r32; const bool first = (row % SEQ) == 0;
    const bf16_t* Z = (const bf16_t*)(P.ws + WS_Z) + row * ZW + ZR + 8 * hi; const bf16_t* Zp = first ? Z : Z - ZW; const float pmask = first ? 0.f : 1.f;
    const float* mub = P.mu + 8 * hi;
    bf16x8 xw[4], xa[4], xg[8];
#pragma unroll
    for (int ks = 0; ks < 4; ++ks) { xw[ks] = act8(Z + RW_W + 16 * ks, Zp + RW_W + 16 * ks, pmask, mub + RW_W + 16 * ks, 0); xa[ks] = act8(Z + RW_A + 16 * ks, Zp + RW_A + 16 * ks, pmask, mub + RW_A + 16 * ks, 1); asm volatile("" ::: "memory"); }
#pragma unroll
    for (int ks = 0; ks < 8; ++ks) { xg[ks] = act8(Z + RW_G + 16 * ks, Zp + RW_G + 16 * ks, pmask, mub + RW_G + 16 * ks, 2); if (ks & 1) asm volatile("" ::: "memory"); }
    const bf16_t* W2T = (const bf16_t*)(P.ws + WS_W2T) + r32 * 64 + 8 * hi; const bf16_t* A2T = (const bf16_t*)(P.ws + WS_A2T) + r32 * 64 + 8 * hi; const bf16_t* G2T = (const bf16_t*)(P.ws + WS_G2T) + r32 * 128 + 8 * hi;
    bf16_t* LW = (bf16_t*)(P.ws + WS_LW) + row * 512 + 4 * hi; bf16_t* LA = (bf16_t*)(P.ws + WS_LA) + row * 512 + 4 * hi; bf16_t* LG = (bf16_t*)(P.ws + WS_LG) + row * 512 + 4 * hi;
#pragma nounroll
    for (int cb = 0; cb < 16; ++cb) {
        f32x16 dw = f32x16{}, da = f32x16{}, dg = f32x16{};
#pragma unroll
        for (int ks = 0; ks < 4; ++ks) { dw = __builtin_amdgcn_mfma_f32_32x32x16_bf16(*(const bf16x8*)(W2T + cb * 32 * 64 + 16 * ks), xw[ks], dw, 0, 0, 0); da = __builtin_amdgcn_mfma_f32_32x32x16_bf16(*(const bf16x8*)(A2T + cb * 32 * 64 + 16 * ks), xa[ks], da, 0, 0, 0); }
#pragma unroll
        for (int ks = 0; ks < 8; ++ks) dg = __builtin_amdgcn_mfma_f32_32x32x16_bf16(*(const bf16x8*)(G2T + cb * 32 * 128 + 16 * ks), xg[ks], dg, 0, 0, 0);
#pragma unroll
        for (int g = 0; g < 4; ++g) { u32x2 w; w.x = pk2(dw[4 * g], dw[4 * g + 1]); w.y = pk2(dw[4 * g + 2], dw[4 * g + 3]); *(u32x2*)(LW + cb * 32 + 8 * g) = w;
            w.x = pk2(da[4 * g], da[4 * g + 1]); w.y = pk2(da[4 * g + 2], da[4 * g + 3]); *(u32x2*)(LA + cb * 32 + 8 * g) = w;
            w.x = pk2(dg[4 * g], dg[4 * g + 1]); w.y = pk2(dg[4 * g + 2], dg[4 * g + 3]); *(u32x2*)(LG + cb * 32 + 8 * g) = w; }
    }
}
}
namespace rt {
__device__ __forceinline__ int woff(int e, int k) { return e * 2048 + ((((k >> 3) ^ (e & 15))) << 4) + (k & 7) * 2; }
__device__ __forceinline__ void build_w(KPR P, LAS unsigned char* lds, int tid) {
    const int e = tid & 31, kq = tid >> 5;
    for (int i = 0; i < 64; ++i) { const int k = kq * 64 + i; const float w = P.moe_norm[k] * P.w_router[k * 32 + e]; const unsigned h = f2bf(w); const unsigned l = f2bf(w - bf2f(h));
        *(LAS unsigned short*)(lds + woff(e, k)) = (unsigned short)h; *(LAS unsigned short*)(lds + 65536 + woff(e, k)) = (unsigned short)l; }
}
__device__ __forceinline__ void split8(const f32x4& a, const f32x4& b, bf16x8& h, bf16x8& l) {
    unsigned hh[8]; float v[8] = {a[0], a[1], a[2], a[3], b[0], b[1], b[2], b[3]};
#pragma unroll
    for (int j = 0; j < 8; ++j) hh[j] = f2bf(v[j]);
    u32x4 hw, lw;
    hw.x = hh[0] | (hh[1] << 16); hw.y = hh[2] | (hh[3] << 16); hw.z = hh[4] | (hh[5] << 16); hw.w = hh[6] | (hh[7] << 16);
    lw.x = pk2(v[0] - bf2f(hh[0]), v[1] - bf2f(hh[1])); lw.y = pk2(v[2] - bf2f(hh[2]), v[3] - bf2f(hh[3])); lw.z = pk2(v[4] - bf2f(hh[4]), v[5] - bf2f(hh[5])); lw.w = pk2(v[6] - bf2f(hh[6]), v[7] - bf2f(hh[7]));
    h = __builtin_bit_cast(bf16x8, hw); l = __builtin_bit_cast(bf16x8, lw);
}
__device__ __forceinline__ void route_task(KPR P, const LAS unsigned char* wlds, int task, int lane) {
    const int r32 = lane & 31, hi = lane >> 5; const int row = task * 32 + r32;
    const float* xrow = (const float*)(P.ws + WS_X1) + (size_t)row * DM + 8 * hi;
    f32x16 acc = f32x16{}; float ss = 0.f;
    f32x4 xa[4], xb[4];
#pragma unroll
    for (int j = 0; j < 4; ++j) { xa[j] = *(const f32x4*)(xrow + 16 * j); xb[j] = *(const f32x4*)(xrow + 16 * j + 4); }
    for (int ks0 = 0; ks0 < 64; ks0 += 4) {
#pragma unroll
        for (int j = 0; j < 4; ++j) { const int ks = ks0 + j; const f32x4 a = xa[j], b = xb[j];
            const int kn = (ks + 4 < 64) ? ks + 4 : ks; xa[j] = *(const f32x4*)(xrow + 16 * kn); xb[j] = *(const f32x4*)(xrow + 16 * kn + 4);
            ss += (a[0] * a[0] + a[1] * a[1]) + (a[2] * a[2] + a[3] * a[3]) + (b[0] * b[0] + b[1] * b[1]) + (b[2] * b[2] + b[3] * b[3]);
            bf16x8 xh, xl; split8(a, b, xh, xl);
            const bf16x8 wh = *(const LAS bf16x8*)(wlds + woff(r32, 16 * ks + 8 * hi)), wl = *(const LAS bf16x8*)(wlds + 65536 + woff(r32, 16 * ks + 8 * hi));
            acc = __builtin_amdgcn_mfma_f32_32x32x16_bf16(wh, xh, acc, 0, 0, 0); acc = __builtin_amdgcn_mfma_f32_32x32x16_bf16(wh, xl, acc, 0, 0, 0); acc = __builtin_amdgcn_mfma_f32_32x32x16_bf16(wl, xh, acc, 0, 0, 0); }
    }
    ss += __shfl_xor(ss, 32);
    const float rstd = rsqrtf(ss * (1.f / DM) + 1e-6f);
    float lg[16];
#pragma unroll
    for (int g = 0; g < 4; ++g) { const f32x4 bb = *(const f32x4*)(P.b_router + 8 * g + 4 * hi);
#pragma unroll
        for (int i = 0; i < 4; ++i) lg[4 * g + i] = acc[4 * g + i] * rstd + bb[i]; }
    float tv[4]; int ti[4];
#pragma unroll
    for (int k = 0; k < 4; ++k) { float bv = lg[0]; int bi = 4 * hi;
#pragma unroll
        for (int r = 1; r < 16; ++r) { const int e = (r & 3) + 8 * (r >> 2) + 4 * hi; if (lg[r] > bv) { bv = lg[r]; bi = e; } }
        const float pv = __shfl_xor(bv, 32); const int pi = __shfl_xor(bi, 32);
        if (pv > bv || (pv == bv && pi < bi)) { bv = pv; bi = pi; }
        tv[k] = bv; ti[k] = bi;
#pragma unroll
        for (int r = 0; r < 16; ++r) { const int e = (r & 3) + 8 * (r >> 2) + 4 * hi; if (e == bi) lg[r] = -INFINITY; } }
    const float e1 = __expf(tv[1] - tv[0]), e2 = __expf(tv[2] - tv[0]), e3 = __expf(tv[3] - tv[0]), inv = 1.f / (1.f + e1 + e2 + e3);
    const int c0 = hi ? ti[2] : ti[0], c1 = hi ? ti[3] : ti[1]; const float g0 = (hi ? e2 : 1.f) * inv, g1 = (hi ? e3 : e1) * inv;
    const unsigned long long ltm = (1ull << lane) - 1ull; int mycnt = 0, rk0 = 0, rk1 = 0;
    for (int e = 0; e < 32; ++e) { const unsigned long long m0 = __ballot(c0 == e), m1 = __ballot(c1 == e); const int n0 = __popcll(m0);
        if (lane == e) mycnt = n0 + __popcll(m1);
        if (c0 == e) rk0 = __popcll(m0 & ltm);
        if (c1 == e) rk1 = n0 + __popcll(m1 & ltm); }
    unsigned* cnt = (unsigned*)(P.ws + WS_CTL) + CW_CNT; int base = 0;
    if (lane < 32 && mycnt > 0) base = (int)atomicAdd(cnt + lane, (unsigned)mycnt);
    rk0 += __shfl(base, c0); rk1 += __shfl(base, c1);
    int* route = (int*)(P.ws + WS_ROUTE); int* tokslot = (int*)(P.ws + WS_TOKSLOT); float* gateslot = (float*)(P.ws + WS_GATESLOT);
    tokslot[(size_t)c0 * NTOK + rk0] = row; gateslot[(size_t)c0 * NTOK + rk0] = g0; tokslot[(size_t)c1 * NTOK + rk1] = row; gateslot[(size_t)c1 * NTOK + rk1] = g1;
    route[(size_t)row * 12 + 2 * hi] = c0; route[(size_t)row * 12 + 2 * hi + 1] = c1; route[(size_t)row * 12 + 4 + 2 * hi] = rk0; route[(size_t)row * 12 + 4 + 2 * hi + 1] = rk1;
    bf16_t* xn = (bf16_t*)(P.ws + WS_XN) + (size_t)row * DM + 8 * hi; const float* gn = P.moe_norm + 8 * hi;
#pragma unroll 4
    for (int ks = 0; ks < 64; ++ks) { const f32x4 a = *(const f32x4*)(xrow + 16 * ks), b = *(const f32x4*)(xrow + 16 * ks + 4), ga = *(const f32x4*)(gn + 16 * ks), gb = *(const f32x4*)(gn + 16 * ks + 4);
        u32x4 w; w.x = pk2(a[0] * rstd * ga[0], a[1] * rstd * ga[1]); w.y = pk2(a[2] * rstd * ga[2], a[3] * rstd * ga[3]); w.z = pk2(b[0] * rstd * gb[0], b[1] * rstd * gb[1]); w.w = pk2(b[2] * rstd * gb[2], b[3] * rstd * gb[3]);
        *(u32x4*)(xn + 16 * ks) = w; }
}
}
__device__ __forceinline__ int crow(int r, int hi) { return (r & 3) + 8 * (r >> 2) + 4 * hi; }
constexpr int CW_QATT = 128;
constexpr int MISC_TAB = 64, MISC_Q = 4096, MISC_PFX = 4160;

__device__ __forceinline__ void attn_unit_v2(KPR P, LAS unsigned char* lds, int bh, int qb) {
    LAS bf16_t* Ks = (LAS bf16_t*)lds;
    LAS bf16_t* Vt = (LAS bf16_t*)(lds + 9216);
    LAS float* wsf = (LAS float*)(lds + 18432);
    const bf16_t* Z = (const bf16_t*)(P.ws + WS_Z); bf16_t* AO = (bf16_t*)(P.ws + WS_AO);
    const int tid = threadIdx.x, lane = tid & 63, w = tid >> 6, r32 = lane & 31, hi = lane >> 5;
    const int b = bh >> 3, h = bh & 7, q0 = qb * 256;
    const size_t rowbase = (size_t)b * SEQ;
    const float* c2 = (const float*)(P.ws + WS_C2) + (size_t)bh * SEQ;
    const int qloc = q0 + 32 * w + r32;
    const bf16_t* Qp = Z + (rowbase + qloc) * ZW + ZQ + h * 64;
    bf16x8 qr[4];
#pragma unroll
    for (int ks = 0; ks < 4; ++ks) qr[ks] = *(const bf16x8*)(Qp + ks * 16 + hi * 8);
    const float cq = c2[qloc];
    float m = -1e30f, l = 0.f; f32x16 o[2]; o[0] = f32x16{}; o[1] = f32x16{};
    const int ntiles = (q0 + 256) / 64;
    LAS float* wsw = wsf + w * 64;
    int t0 = 0;
    { float gq = fabsf(P.q_norm[lane]), gk = fabsf(P.k_norm[lane]);
#pragma unroll
        for (int o = 1; o < 64; o <<= 1) { gq = fmaxf(gq, __shfl_xor(gq, o)); gk = fmaxf(gk, __shfl_xor(gk, o)); }
        const float thr = c2[q0] + (2.0f * 8.0f * LOG2E * gq * gk + 40.0f);
        const int nfull = q0 / 64;
        for (int tb = 0; tb < nfull; tb += 64) { const int tt = tb + lane; const bool sk = (tt < nfull) && (c2[tt * 64 + 63] > thr); const unsigned long long bm = __ballot(sk); t0 += __popcll(bm); if (bm != ~0ull) break; } }
    for (int t = t0; t < ntiles; ++t) {
        __syncthreads();
        { const int row = tid >> 3, ch = tid & 7; const bf16_t* src = Z + (rowbase + t * 64 + row) * ZW + h * 64 + ch * 8;
            *(LAS u32x4*)&Ks[row * 72 + ch * 8] = *(const u32x4*)(src + ZK);
            const u32x4 v = *(const u32x4*)(src + ZV); const unsigned vv[4] = {v.x, v.y, v.z, v.w};
#pragma unroll
            for (int e = 0; e < 4; ++e) { Vt[(ch * 8 + 2 * e) * 72 + row] = (bf16_t)(vv[e] & 0xffffu); Vt[(ch * 8 + 2 * e + 1) * 72 + row] = (bf16_t)(vv[e] >> 16); } }
        __syncthreads();
        if (t * 64 > q0 + 32 * w + 31) continue;
        f32x16 p[2];
#pragma unroll
        for (int g = 0; g < 2; ++g) { p[g] = f32x16{};
#pragma unroll
            for (int ks = 0; ks < 4; ++ks) { const bf16x8 kf = *(const LAS bf16x8*)&Ks[(32 * g + r32) * 72 + ks * 16 + hi * 8]; p[g] = __builtin_amdgcn_mfma_f32_32x32x16_bf16(kf, qr[ks], p[g], 0, 0, 0); } }
        float mx = -1e30f;
#pragma unroll
        for (int g = 0; g < 2; ++g)
#pragma unroll
            for (int r4 = 0; r4 < 4; ++r4) { const int kv0 = t * 64 + 32 * g + 8 * r4 + 4 * hi; const f32x4 ck = *(const f32x4*)(c2 + kv0);
#pragma unroll
                for (int i = 0; i < 4; ++i) { float s = p[g][4 * r4 + i] + (cq - ck[i]); if (kv0 + i > qloc) s = -INFINITY; p[g][4 * r4 + i] = s; mx = fmaxf(mx, s); } }
        mx = fmaxf(mx, __shfl_xor(mx, 32));
        const float mnew = fmaxf(m, mx), alpha = exp2f(m - mnew); m = mnew;
        float ps = 0.f;
#pragma unroll
        for (int g = 0; g < 2; ++g)
#pragma unroll
            for (int r = 0; r < 16; ++r) { const float e = exp2f(p[g][r] - mnew); p[g][r] = e; ps += e; }
        l = l * alpha + ps;
        if (hi == 0) wsw[r32] = alpha;
        __builtin_amdgcn_wave_barrier(); asm volatile("s_waitcnt lgkmcnt(0)" ::: "memory");
#pragma unroll
        for (int r4 = 0; r4 < 4; ++r4) { const f32x4 al = *(const LAS f32x4*)&wsw[8 * r4 + 4 * hi];
#pragma unroll
            for (int i = 0; i < 4; ++i) { o[0][4 * r4 + i] *= al[i]; o[1][4 * r4 + i] *= al[i]; } }
#pragma unroll
        for (int g = 0; g < 2; ++g)
#pragma unroll
            for (int s = 0; s < 2; ++s) { u32x4 pw; pw.x = pk2(p[g][8 * s + 0], p[g][8 * s + 1]); pw.y = pk2(p[g][8 * s + 2], p[g][8 * s + 3]); pw.z = pk2(p[g][8 * s + 4], p[g][8 * s + 5]); pw.w = pk2(p[g][8 * s + 6], p[g][8 * s + 7]);
                const bf16x8 pa = __builtin_bit_cast(bf16x8, pw);
#pragma unroll
                for (int d0 = 0; d0 < 2; ++d0) { const u32x2 lo = *(const LAS u32x2*)&Vt[(32 * d0 + r32) * 72 + 32 * g + 16 * s + 4 * hi], hh = *(const LAS u32x2*)&Vt[(32 * d0 + r32) * 72 + 32 * g + 16 * s + 8 + 4 * hi];
                    u32x4 vw; vw.x = lo.x; vw.y = lo.y; vw.z = hh.x; vw.w = hh.y;
                    o[d0] = __builtin_amdgcn_mfma_f32_32x32x16_bf16(pa, __builtin_bit_cast(bf16x8, vw), o[d0], 0, 0, 0); } }
        __builtin_amdgcn_wave_barrier();
    }
    l += __shfl_xor(l, 32);
    __builtin_amdgcn_wave_barrier();
    if (hi == 0) wsw[32 + r32] = l;
    __builtin_amdgcn_wave_barrier(); asm volatile("s_waitcnt lgkmcnt(0)" ::: "memory");
#pragma unroll
    for (int r = 0; r < 16; ++r) { const int q = crow(r, hi); const float li = 1.0f / wsw[32 + q]; const size_t row = rowbase + q0 + 32 * w + q;
#pragma unroll
        for (int d0 = 0; d0 < 2; ++d0) { const int d = 32 * d0 + r32; const float og = bf2f(Z[row * ZW + ZOG + h * 64 + d]);
            AO[row * DM + h * 64 + d] = (bf16_t)f2bf(o[d0][r] * li * sigmoidf_(og)); } }
    __builtin_amdgcn_wave_barrier();
}

__device__ __forceinline__ void combine_row(KPR P, const LAS int* tab, int row, int lane) {
    const int* route = (const int*)(P.ws + WS_ROUTE); const bf16_t* YP = (const bf16_t*)(P.ws + WS_YP); float* X = (float*)(P.ws + WS_X1);
    f32x4 v[4]; const f32x4* xr = (const f32x4*)(X + (size_t)row * DM) + lane;
#pragma unroll
    for (int j = 0; j < 4; ++j) v[j] = xr[64 * j];
#pragma unroll
    for (int k = 0; k < 4; ++k) { const int ex = route[(size_t)row * 12 + k], rank = route[(size_t)row * 12 + 4 + k]; const size_t pos = (size_t)tab[pg8::T_BLKSTART + ex] * 256 + rank;
        const u32x2* yr = (const u32x2*)(YP + pos * DM) + lane;
#pragma unroll
        for (int j = 0; j < 4; ++j) { const u32x2 y = yr[64 * j]; v[j][0] += bflo(y.x); v[j][1] += bfhi(y.x); v[j][2] += bflo(y.y); v[j][3] += bfhi(y.y); } }
    f32x4* xo = (f32x4*)(X + (size_t)row * DM) + lane; float s = 0.f;
#pragma unroll
    for (int j = 0; j < 4; ++j) { xo[64 * j] = v[j]; s += (v[j][0] * v[j][0] + v[j][1] * v[j][1]) + (v[j][2] * v[j][2] + v[j][3] * v[j][3]); }
    const float rstd = rsqrtf(wave_sum(s) * (1.f / DM) + 1e-6f);
#pragma unroll
    for (int j = 0; j < 4; ++j) v[j] = v[j] * rstd * ((const f32x4*)P.ple_norm)[64 * j + lane];
    store_row_bf16((bf16_t*)(P.ws + WS_XN) + (size_t)row * DM, lane, v);
}

constexpr int NPHASE = 13;
__global__ void __launch_bounds__(NTHREADS, 2) mega_fwd(Params Pkarg_unused) {
    extern __shared__ __attribute__((aligned(16))) unsigned char smem[];
    LAS unsigned char* lds = (LAS unsigned char*)smem;
    const int tid = threadIdx.x, lane = tid & 63, wave = __builtin_amdgcn_readfirstlane(tid >> 6);
    const int G = gridDim.x, blk = blockIdx.x;
#define P (*kpp)
#ifndef MK_REP
#define MK_REP -1
#endif
#define PHASE_BEGIN(k) if (IN(k)) for (int rep_ = 0; rep_ < ((k) == MK_REP ? 2 : 1); ++rep_) { const __attribute__((address_space(4))) Params* kpp = kp_fresh();
#define PHASE_END(k) } if (BOTH(k)) xcd_barrier(bar);
#define IN(k) (ph_lo <= (k) && (k) < ph_hi)
#define BOTH(k) (IN(k) && IN((k) + 1))
    const __attribute__((address_space(4))) Params* kpp = kp_fresh();
    unsigned* ctl = (unsigned*)(P.ws + WS_CTL);
    volatile LAS unsigned* MISC = (volatile LAS unsigned*)(lds + MISC_OFF);
    LAS int* tab = (LAS int*)(lds + MISC_OFF + MISC_TAB);
    if (tid < 16) MISC[tid] = 0u;
    __syncthreads();
    XcdBarrier bar = xcd_barrier_post(ctl + CW_BAR, MISC);
    unsigned char* const wsb = P.ws;
    const int ph_lo = P.ph_lo, ph_hi = P.ph_hi;

    PHASE_BEGIN(0)
        phase_prep_weights(P, lds, blk * NWAVES + wave, G * NWAVES, wave, lane);
        phase_cvt_p(P, blk * NTHREADS + tid, G * NTHREADS);
        __syncthreads();
        LAS float* wff = (LAS float*)lds; LAS float* lf = (LAS float*)(lds + 32768);
        load_wff(P, wff, tid, NTHREADS); __syncthreads();
        for (int i = 0; i < 16; ++i) { const int rl = wave * 16 + i; norm1_row(P, blk * 128 + rl, lane, wff, lf + rl * 8); }
        __syncthreads();
        if (tid < 8) { float run = 0.f; float* cloc = (float*)(P.ws + WS_LOGF) + (size_t)blk * 128 * 8 + tid;
            for (int r = 0; r < 128; ++r) { run += lf[r * 8 + tid]; cloc[r * 8] = run; }
            ((float*)(P.ws + WS_CTOT))[blk * 8 + tid] = run; }
        if (blk == 0) { bf16_t* zr = (bf16_t*)(P.ws + WS_XN) + (size_t)NTOK * DM; for (int i = tid; i < DM; i += NTHREADS) zr[i] = 0; }
    PHASE_END(0)

    PHASE_BEGIN(1)
        {
            LAS float* pfx = (LAS float*)(lds + MISC_OFF + MISC_PFX);
            if (tid < 8) { float s = 0.f; const float* ct = (const float*)(wsb + WS_CTOT); for (int j = (blk & ~63); j < blk; ++j) s += ct[j * 8 + tid]; pfx[tid] = s; }
            __syncthreads();
            const float* cloc = (const float*)(wsb + WS_LOGF) + (size_t)blk * 128 * 8; float* c2 = (float*)(P.ws + WS_C2);
            for (int i = tid; i < 1024; i += NTHREADS) { const int r = i >> 3, h = i & 7; const int row = blk * 128 + r, b = row >> 13, t = row & (SEQ - 1);
                c2[((size_t)(b * 8 + h)) * SEQ + t] = (cloc[i] + pfx[h]) * LOG2E; }
            __syncthreads();
        }
        {
            pg8::DenseOrder S{(const bf16_t*)(wsb + WS_XN), (const bf16_t*)(wsb + WS_WIN), 1024, NTOK / 256, ZW / 256, G, blk};
            pg8::EpiIn E{(bf16_t*)(P.ws + WS_Z), P.q_norm, P.k_norm};
            pg8::gemm_phase<pg8::EpiIn, pg8::DenseOrder, true>(lds, 1024, S, E);
        }
        {
            pg8::DenseOrder S{(const bf16_t*)((unsigned char*)P.out + DO_PB), (const bf16_t*)(wsb + WS_WPP), PLE, NTOK / 256, DM / 256, G, blk};
            pg8::EpiBf16 E{(bf16_t*)((unsigned char*)P.out + DO_PJ), DM};
            pg8::gemm_phase<pg8::EpiBf16, pg8::DenseOrder, true>(lds, PLE, S, E);
        }
    PHASE_END(1)

    PHASE_BEGIN(2)
        for (int task = wave * G + blk; task < NTOK / 32; task += NWAVES * G) rk::lora_task(P, task, lane);
    PHASE_END(2)

    PHASE_BEGIN(3)
        for (int task = blk; task < NB * NH * rk::NCHUNK; task += G) rk::pass1_chunk(P, lds, task >> 7, task & 127, tid);
    PHASE_END(3)

    PHASE_BEGIN(4)
        if (blk < NB * NH) rk::pass2_seq(P, lds, blk, tid);
        for (;;) {
            __syncthreads();
            if (tid == 0) MISC[MISC_Q / 4] = __hip_atomic_fetch_add(ctl + CW_QATT + 64 * rep_, 1u, RLX_AGENT);
            __syncthreads();
            const int q = (int)MISC[MISC_Q / 4];
            if (q >= 1024) break;
            attn_unit_v2(P, lds, q & 31, 31 - (q >> 5));
        }
    PHASE_END(4)

    PHASE_BEGIN(5)
        for (int task = blk; task < NB * NH * rk::NCHUNK; task += G) rk::pass3_chunk(P, lds, task >> 7, task & 127, tid);
    PHASE_END(5)

    PHASE_BEGIN(6)
        pg8::DenseOrder S{(const bf16_t*)(wsb + WS_AO), (const bf16_t*)(wsb + WS_WOUT), 1024, NTOK / 256, DM / 256, G, blk};
        pg8::EpiOut E{P.x, (float*)(P.ws + WS_X1)};
        pg8::gemm_phase<pg8::EpiOut, pg8::DenseOrder, true>(lds, 1024, S, E);
    PHASE_END(6)

    PHASE_BEGIN(7)
        rt::build_w(P, lds, tid);
        __syncthreads();
        for (int task = wave * G + blk; task < NTOK / 32; task += NWAVES * G) rt::route_task(P, lds, task, lane);
    PHASE_END(7)

    PHASE_BEGIN(8)
        const int nblk = pg8::moe_tables(tab, (const unsigned*)(wsb + WS_CTL) + CW_CNT);
        pg8::MoeOrder S{(const bf16_t*)(wsb + WS_XN), (const bf16_t*)(wsb + WS_WGU), (const int*)(wsb + WS_TOKSLOT), tab, nblk, 8, G, blk, true};
        pg8::EpiGu E{(bf16_t*)(P.ws + WS_ACT), P.b_gu};
        pg8::gemm_phase<pg8::EpiGu, pg8::MoeOrder, true>(lds, 1024, S, E);
    PHASE_END(8)
    PHASE_BEGIN(9)
        const int nblk = pg8::moe_tables(tab, (const unsigned*)(wsb + WS_CTL) + CW_CNT);
        pg8::MoeOrder S{(const bf16_t*)(wsb + WS_ACT), (const bf16_t*)(wsb + WS_WDN), (const int*)(wsb + WS_TOKSLOT), tab, nblk, 4, G, blk, false};
        pg8::EpiDn E{(bf16_t*)(P.ws + WS_YP), P.b_down, (const float*)(wsb + WS_GATESLOT), tab};
        pg8::gemm_phase<pg8::EpiDn, pg8::MoeOrder, true>(lds, 1024, S, E);
    PHASE_END(9)
    PHASE_BEGIN(10)
        (void)pg8::moe_tables(tab, (const unsigned*)(wsb + WS_CTL) + CW_CNT);
        for (int row = blk * NWAVES + wave; row < NTOK; row += G * NWAVES) combine_row(P, tab, row, lane);
    PHASE_END(10)
    PHASE_BEGIN(11)
        pg8::DenseOrder S{(const bf16_t*)(wsb + WS_XN), (const bf16_t*)(wsb + WS_WPG), 1024, NTOK / 256, DM / 256, G, blk};
        pg8::EpiPg E{(float*)(P.ws + WS_X1), (const bf16_t*)((unsigned char*)P.out + DO_PJ)};
        pg8::gemm_phase<pg8::EpiPg, pg8::DenseOrder, true>(lds, 1024, S, E);
    PHASE_END(11)
    PHASE_BEGIN(12)
        const bool dead = __hip_atomic_load(ctl + CW_BAR + XB_TMO, RLX_AGENT) != 0u;
        for (int row = blk * NWAVES + wave; row < NTOK; row += G * NWAVES) final_row(P, row, lane, dead);
    PHASE_END(12)
}
#undef P
extern "C" void kernel_launch(void* const* d_in, const int* in_sizes, int n_in, void* d_out, int out_size, void* d_ws, size_t ws_size, hipStream_t stream) {
    static int ok = 0;
    if (ok == 0) {
        if (n_in != 30 || in_sizes[0] != NTOK * DM || out_size != NTOK * DM || ws_size < WS_END) { fprintf(stderr, "kernel_launch: unexpected shapes (n_in %d, ws %zu)\n", n_in, ws_size); ok = -1; return; }
        if (hipFuncSetAttribute((const void*)mega_fwd, hipFuncAttributeMaxDynamicSharedMemorySize, LDS_BYTES) != hipSuccess) { fprintf(stderr, "kernel_launch: hipFuncSetAttribute failed\n"); ok = -1; return; }
        int dev = 0, cus = 0, per_cu = 0;
        if (hipGetDevice(&dev) != hipSuccess || hipDeviceGetAttribute(&cus, hipDeviceAttributeMultiprocessorCount, dev) != hipSuccess) { ok = -1; return; }
        if (hipOccupancyMaxActiveBlocksPerMultiprocessor(&per_cu, (const void*)mega_fwd, NTHREADS, LDS_BYTES) != hipSuccess || per_cu < 1) { fprintf(stderr, "kernel_launch: occupancy query says %d\n", per_cu); }
        (void)hipGetLastError();
        if (cus != 256) { fprintf(stderr, "kernel_launch: built for 256 CUs, device has %d\n", cus); ok = -1; return; }
        ok = 1;
    }
    if (ok < 0) return;
    Params P{};
    const float** pp = (const float**)&P;
    for (int i = 0; i < 30; ++i) pp[i] = (const float*)d_in[i];
    P.out = (float*)d_out; P.ws = (unsigned char*)d_ws;
    if (hipMemsetAsync((char*)d_ws + WS_CTL, 0, CTL_BYTES, stream) != hipSuccess) return;
#ifndef MK_CUTS
#define MK_CUTS 0
#endif
    if (MK_CUTS == 0) { P.ph_lo = 0; P.ph_hi = NPHASE; hipLaunchKernelGGL(mega_fwd, dim3(256), dim3(NTHREADS), LDS_BYTES, stream, P); }
    else for (int k = 0; k < NPHASE; ++k) { P.ph_lo = k; P.ph_hi = k + 1;
        hipLaunchKernelGGL(mega_fwd, dim3(256), dim3(NTHREADS), LDS_BYTES, stream, P); }
}
```

```cpp
#include <hip/hip_runtime.h>
#include <cstdio>
#include <cstdint>

#define LAS __attribute__((address_space(3)))
#define GAS __attribute__((address_space(1)))
typedef unsigned short bf16_t;
typedef short bf16x8 __attribute__((ext_vector_type(8)));
typedef float f32x2 __attribute__((ext_vector_type(2)));
typedef float f32x4 __attribute__((ext_vector_type(4)));
typedef float f32x16 __attribute__((ext_vector_type(16)));
typedef unsigned u32x2 __attribute__((ext_vector_type(2)));
typedef unsigned u32x4 __attribute__((ext_vector_type(4)));

constexpr int NB = 4, SEQ = 8192, NTOK = NB * SEQ, DM = 1024;
constexpr int NH = 8, HD = 64;
constexpr int INW = 3848;
constexpr int ZW = 3840;
constexpr int ZQ = 0, ZK = 512, ZV = 1024, ZOG = 1536, ZR = 2048;
constexpr int RW_R = 0, RW_K = 512, RW_V = 1024, RW_W = 1536, RW_A = 1600, RW_G = 1664, RWIN = 1792;
constexpr int NE = 32, TOPK = 4, EFF = 1024;
constexpr int MAXBLK = (NTOK * TOPK) / 256 + NE;
constexpr int PLE = 256;
constexpr float LOG2E = 1.4426950408889634f;
constexpr float QSCALE = 0.125f * LOG2E;

constexpr size_t MiB = 1u << 20;
constexpr size_t WS_CTL = 0, CTL_BYTES = 1 * MiB;
constexpr size_t WS_C2 = 1 * MiB;
constexpr size_t WS_LOGF = 2 * MiB;
constexpr size_t WS_ROUTE = 3 * MiB;
constexpr size_t WS_TOKSLOT = 5 * MiB;
constexpr size_t WS_GATESLOT = 9 * MiB;
constexpr size_t WS_CTOT = 13 * MiB;
constexpr size_t WS_WIN = 16 * MiB;
constexpr size_t WS_WOUT = 24 * MiB;
constexpr size_t WS_WPG = 26 * MiB;
constexpr size_t WS_WPP = 28 * MiB;
constexpr size_t WS_WGU = 32 * MiB;
constexpr size_t WS_WDN = 160 * MiB;
constexpr size_t WS_XN = 224 * MiB;
constexpr size_t WS_X1 = 290 * MiB;
constexpr size_t WS_Z = 418 * MiB;
constexpr size_t WS_AO = 658 * MiB;
constexpr size_t WS_ACT = 418 * MiB;
constexpr size_t WS_RW = 722 * MiB;
constexpr size_t WS_RR = WS_RW, WS_RK = WS_RW + 32 * MiB, WS_RV = WS_RW + 64 * MiB, WS_RG = WS_RW + 96 * MiB;
constexpr size_t WS_RLW = WS_RW + 128 * MiB;
constexpr size_t WS_RKK = WS_RW + 160 * MiB, WS_RKA = WS_RW + 192 * MiB;
constexpr size_t WS_YP = 722 * MiB;
constexpr size_t WS_END = 994 * MiB;
static_assert(WS_ACT + (size_t)MAXBLK * 256 * 1024 * 2 <= WS_RW && WS_YP + (size_t)MAXBLK * 256 * 1024 * 2 <= WS_END, "ws map");
constexpr size_t DO_PJ = 0, DO_PB = 64 * MiB;
constexpr int CW_TMO = 0, CW_CNT = 64  , CW_BAR = 4096;

struct Params {
    const float *x, *p, *mix_norm, *w_in, *f_bias, *q_norm, *k_norm, *mu, *w0, *w2, *a0, *a2, *g2, *k_k, *k_a, *r_k, *ln_w, *ln_b, *w_out, *moe_norm, *w_router, *b_router, *w_gu, *b_gu, *w_down,
        *b_down, *ple_norm, *w_pg, *w_pp, *final_norm;
    float* out; unsigned char* ws; int ph_lo, ph_hi;
};

typedef const __attribute__((address_space(4))) Params& KPR;
__device__ __forceinline__ const __attribute__((address_space(4))) Params* kp_fresh() {
    unsigned long long p = (unsigned long long)__builtin_amdgcn_kernarg_segment_ptr(); asm volatile("" : "+s"(p)); return (const __attribute__((address_space(4))) Params*)p; }

__device__ __forceinline__ unsigned f2bf(float f) { unsigned u = __builtin_bit_cast(unsigned, f); return (u + 0x7fffu + ((u >> 16) & 1u)) >> 16; }
__device__ __forceinline__ unsigned pk2(float lo, float hi) { return f2bf(lo) | (f2bf(hi) << 16); }
__device__ __forceinline__ float bf2f(unsigned h) { return __builtin_bit_cast(float, h << 16); }
__device__ __forceinline__ float bflo(unsigned w) { return __builtin_bit_cast(float, w << 16); }
__device__ __forceinline__ float bfhi(unsigned w) { return __builtin_bit_cast(float, w & 0xffff0000u); }
__device__ __forceinline__ unsigned cvt_pk_bf16(float lo, float hi) { unsigned r; asm volatile("v_cvt_pk_bf16_f32 %0, %1, %2" : "=v"(r) : "v"(lo), "v"(hi)); return r; }
__device__ __forceinline__ float wave_sum(float v) {
#pragma unroll
    for (int o = 1; o < 64; o <<= 1) v += __shfl_xor(v, o);
    return v;
}
__device__ __forceinline__ float sigmoidf_(float x) { return 1.0f / (1.0f + __expf(-x)); }
__device__ __forceinline__ float logsigmoidf_(float x) { return fminf(x, 0.f) - log1pf(expf(-fabsf(x))); }
namespace pg8 {
constexpr int BM = 256, BK = 64, HALF = 128, HTB = HALF * BK * 2, STAGE_BYTES = 8 * HTB, NXCD = 8, WGM = 8;
__host__ __device__ __forceinline__ int lds_byte(int r, int c) { const int st = (r >> 4) * 2 + (c >> 5), rr = r & 15, cc = c & 31, ob = rr * 64 + cc * 2; return st * 1024 + (ob ^ (((ob >> 9) & 1) << 5)); }
__host__ __device__ __forceinline__ void stage_rc(int b, int& R, int& C) { const int st = b / 1024, sb = b % 1024, swz = sb ^ (((sb >> 9) & 1) << 5); R = (st >> 1) * 16 + swz / 64; C = (st & 1) * 32 + (swz % 64) / 2; }
__host__ __device__ __forceinline__ int perm32(int rho) { const int n = rho >> 4, i = rho & 15; return 8 * (i >> 2) + 4 * n + (i & 3); }

struct Unit { int pm, pn, e, lb; };

__device__ __forceinline__ bool tile_order(int i, int G, int c, int nM, int nN, int& pm, int& pn) {
    const int nwg = nM * nN; const long L = (long)i * G + c; if (L >= nwg) return false;
    int wgid = (int)L; { const int q = nwg / NXCD, r = nwg % NXCD, xcd = wgid % NXCD, off = wgid / NXCD; wgid = (xcd < r ? xcd * (q + 1) : r * (q + 1) + (xcd - r) * q) + off; }
    const int nig = WGM * nN, gid = wgid / nig, fm = gid * WGM, gsz = (nM - fm) < WGM ? (nM - fm) : WGM;
    pm = fm + ((wgid % nig) % gsz); pn = (wgid % nig) / gsz; return true;
}
struct DenseOrder {
    const bf16_t* A; const bf16_t* Bt; int K, nM, nN, G, c;
    __device__ __forceinline__ bool next(int i, Unit& u) const { u.e = 0; u.lb = 0; return tile_order(i, G, c, nM, nN, u.pm, u.pn); }
    __device__ __forceinline__ const char* a_base(const Unit& u) const { return (const char*)A + (size_t)u.pm * BM * K * 2; }
    __device__ __forceinline__ const char* b_base(const Unit& u) const { return (const char*)Bt + (size_t)u.pn * BM * K * 2; }
    __device__ __forceinline__ void a_off(const Unit&, const int (&R)[2], const int (&C)[2], unsigned (&off)[2][2]) const {
#pragma unroll
        for (int h = 0; h < 2; ++h)
#pragma unroll
            for (int i = 0; i < 2; ++i) off[h][i] = (unsigned)((R[i] + HALF * h) * K + C[i]) * 2u;
    }
};

template <class Epi, class Sched, bool ALIGN_EPI>
__device__ __forceinline__ void gemm_phase(LAS unsigned char* lds, const int K, const Sched& S, const Epi& E) {
    int tid_ = threadIdx.x; asm volatile("" : "+v"(tid_));
    const int tid = tid_, wid = __builtin_amdgcn_readfirstlane(tid >> 6), lane = tid & 63, wr = wid >> 2, wc = wid & 3, fr = lane & 15, fq = lane >> 4;
    const int nt = K / BK;
    int sR[2], sC[2]; unsigned voffB[2];
#pragma unroll
    for (int i = 0; i < 2; ++i) { int R, C; stage_rc(tid * 16 + i * 8192, R, C); const int Rb = Epi::PERM ? ((R & ~31) + perm32(R & 31)) : R; sR[i] = R; sC[i] = C; voffB[i] = (unsigned)(Rb * K + C) * 2u; }
    const size_t kstep = (size_t)(BK * 2);
    const size_t hstep = (size_t)HALF * K * 2;
    const unsigned ldsw = (unsigned)wid * 1024u;
    const int aoff = lds_byte(wr * 64 + fr, fq * 8), boff = lds_byte(wc * 32 + fr, fq * 8);
#define PG8_SA(b, h) (((b) * 2 + (h)) * HTB)
#define PG8_SB(b, h) ((4 + (b) * 2 + (h)) * HTB)
#define PG8_STAGE(bufoff, gbase, voff) do { _Pragma("unroll") for (int _i = 0; _i < 2; ++_i) \
        __builtin_amdgcn_global_load_lds((const unsigned*)((const char*)(gbase) + (voff)[_i]), (LAS unsigned*)(lds + (bufoff) + ldsw + _i * 8192), 16, 0, 0); } while (0)
#define PG8_LDA(dst, b, h) do { _Pragma("unroll") for (int m = 0; m < 4; ++m) _Pragma("unroll") for (int k = 0; k < 2; ++k) dst[m][k] = *(const LAS bf16x8*)(lds + PG8_SA(b, h) + aoff + m * 2048 + k * 1024); } while (0)
#define PG8_LDB(dst, b, h) do { _Pragma("unroll") for (int n = 0; n < 2; ++n) _Pragma("unroll") for (int k = 0; k < 2; ++k) dst[n][k] = *(const LAS bf16x8*)(lds + PG8_SB(b, h) + boff + n * 2048 + k * 1024); } while (0)
#define PG8_MMA(ai, bj, At, Bt) do { __builtin_amdgcn_s_setprio(1); _Pragma("unroll") for (int m = 0; m < 4; ++m) _Pragma("unroll") for (int n = 0; n < 2; ++n) _Pragma("unroll") for (int k = 0; k < 2; ++k) \
        acc[ai][bj][m][n] = __builtin_amdgcn_mfma_f32_16x16x32_bf16(Bt[n][k], At[m][k], acc[ai][bj][m][n], 0, 0, 0); __builtin_amdgcn_s_setprio(0); } while (0)
#define PG8_WAIT_V(n) asm volatile("s_waitcnt vmcnt(" #n ")" ::: "memory")
#define PG8_WAIT_L(n) asm volatile("s_waitcnt lgkmcnt(" #n ")" ::: "memory")
#define PG8_BAR __builtin_amdgcn_s_barrier()
#define PG8_SCHED __builtin_amdgcn_sched_barrier(0)
    Unit cur, nxt; int ui = 0;
    if (!S.next(0, cur)) return;
    f32x4 acc[2][2][4][2];
#pragma unroll
    for (int a = 0; a < 2; ++a)
#pragma unroll
        for (int b = 0; b < 2; ++b)
#pragma unroll
            for (int m = 0; m < 4; ++m)
#pragma unroll
                for (int n = 0; n < 2; ++n) acc[a][b][m][n] = (f32x4){0.f, 0.f, 0.f, 0.f};
    bf16x8 At[4][2], B0[2][2], B1[2][2];
    unsigned offC[2][2], offN[2][2];
    S.a_off(cur, sR, sC, offC);
    const char* cA = S.a_base(cur); const char* cB = S.b_base(cur);
    PG8_STAGE(PG8_SB(0, 0), cB, voffB); PG8_STAGE(PG8_SB(0, 1), cB + hstep, voffB); PG8_STAGE(PG8_SA(0, 0), cA, offC[0]); PG8_STAGE(PG8_SA(0, 1), cA, offC[1]);
    if (wr == 1) PG8_BAR;
    PG8_WAIT_V(2); PG8_BAR;
    PG8_STAGE(PG8_SB(1, 0), cB + kstep, voffB); PG8_STAGE(PG8_SA(1, 0), cA + kstep, offC[0]); PG8_STAGE(PG8_SB(1, 1), cB + hstep + kstep, voffB);
    PG8_WAIT_V(6); PG8_BAR;
    for (;;) {
        const bool has_next = S.next(ui + 1, nxt);
        const char* nA = cA; const char* nB = cB;
        if (has_next) { nA = S.a_base(nxt); nB = S.b_base(nxt); S.a_off(nxt, sR, sC, offN); }
        else {
#pragma unroll
            for (int h = 0; h < 2; ++h)
#pragma unroll
                for (int i = 0; i < 2; ++i) offN[h][i] = offC[h][i];
        }
#pragma nounroll
        for (int t = 0; t < nt; t += 2) {
            const bool last = (t == nt - 2);
            const char* a1 = cA + (size_t)(t + 1) * kstep;
            const char* a2 = last ? nA : cA + (size_t)(t + 2) * kstep; const char* b2 = last ? nB : cB + (size_t)(t + 2) * kstep;
            const char* a3 = a2 + kstep; const char* b3 = b2 + kstep;
            unsigned o2[2][2];
#pragma unroll
            for (int h = 0; h < 2; ++h)
#pragma unroll
                for (int i = 0; i < 2; ++i) o2[h][i] = last ? offN[h][i] : offC[h][i];
            PG8_LDB(B0, 0, 0); PG8_LDB(B1, 0, 1); PG8_SCHED; PG8_LDA(At, 0, 0); PG8_STAGE(PG8_SA(1, 1), a1, offC[1]);
            PG8_WAIT_V(8); PG8_WAIT_L(0); PG8_BAR; PG8_MMA(0, 0, At, B0); PG8_MMA(0, 1, At, B1); PG8_BAR; PG8_SCHED;
            PG8_LDA(At, 0, 1); PG8_STAGE(PG8_SB(0, 0), b2, voffB); PG8_STAGE(PG8_SB(0, 1), b2 + hstep, voffB); PG8_STAGE(PG8_SA(0, 0), a2, o2[0]);
            PG8_WAIT_V(8); PG8_WAIT_L(0); PG8_BAR; PG8_MMA(1, 0, At, B0); PG8_MMA(1, 1, At, B1); PG8_BAR; PG8_SCHED;
            PG8_LDB(B0, 1, 0); PG8_LDB(B1, 1, 1); PG8_SCHED; PG8_LDA(At, 1, 0); PG8_STAGE(PG8_SA(0, 1), a2, o2[1]);
            PG8_WAIT_V(8); PG8_WAIT_L(0); PG8_BAR; PG8_MMA(0, 0, At, B0); PG8_MMA(0, 1, At, B1); PG8_BAR; PG8_SCHED;
            PG8_LDA(At, 1, 1); PG8_STAGE(PG8_SB(1, 0), b3, voffB); PG8_STAGE(PG8_SB(1, 1), b3 + hstep, voffB); PG8_STAGE(PG8_SA(1, 0), a3, o2[0]);
            PG8_WAIT_V(8); PG8_WAIT_L(0); PG8_BAR; PG8_MMA(1, 0, At, B0); PG8_MMA(1, 1, At, B1); PG8_BAR; PG8_SCHED;
        }
        if constexpr (ALIGN_EPI) { if (wr == 0) PG8_BAR; }
        E(acc, cur, wr, wc, fr, fq);
        if (!has_next) break;
#pragma unroll
        for (int a = 0; a < 2; ++a)
#pragma unroll
            for (int b = 0; b < 2; ++b)
#pragma unroll
                for (int m = 0; m < 4; ++m)
#pragma unroll
                    for (int n = 0; n < 2; ++n) acc[a][b][m][n] = (f32x4){0.f, 0.f, 0.f, 0.f};
        cur = nxt; cA = nA; cB = nB; ++ui;
#pragma unroll
        for (int h = 0; h < 2; ++h)
#pragma unroll
            for (int i = 0; i < 2; ++i) offC[h][i] = offN[h][i];
        if constexpr (ALIGN_EPI) { if (wr == 1) PG8_BAR; }
    }
    PG8_WAIT_V(0);
    if constexpr (!ALIGN_EPI) { if (wr == 0) PG8_BAR; }
    PG8_BAR;
#undef PG8_SA
#undef PG8_SB
#undef PG8_STAGE
#undef PG8_LDA
#undef PG8_LDB
#undef PG8_MMA
#undef PG8_WAIT_V
#undef PG8_WAIT_L
#undef PG8_BAR
#undef PG8_SCHED
}
}
namespace pg8 {
constexpr int T_BLKSTART = 0  , T_CNT = 40  , T_BLKE = 80  , T_WORDS = 80 + 560;

struct EpiIn {
    static constexpr bool PERM = true;
    bf16_t* Z; const float* qn; const float* kn;
    __device__ __forceinline__ void operator()(const f32x4 (&acc)[2][2][4][2], const Unit& u, int wr, int wc, int fr, int fq) const {
        const int row0 = u.pm * BM + wr * 64 + fr;
        if (u.pn < 4) {
            const float* g = (u.pn < 2) ? qn : kn; const float sc = (u.pn < 2) ? QSCALE : 1.0f;
            f32x4 gv[2][2];
#pragma unroll
            for (int bj = 0; bj < 2; ++bj)
#pragma unroll
                for (int n = 0; n < 2; ++n) gv[bj][n] = *(const f32x4*)(g + 32 * bj + 8 * fq + 4 * n) * sc;
#pragma unroll
            for (int ai = 0; ai < 2; ++ai)
#pragma unroll
                for (int m = 0; m < 4; ++m) {
                    float ss = 0.f;
#pragma unroll
                    for (int bj = 0; bj < 2; ++bj)
#pragma unroll
                        for (int n = 0; n < 2; ++n) { const f32x4 x = acc[ai][bj][m][n]; ss += (x[0] * x[0] + x[1] * x[1]) + (x[2] * x[2] + x[3] * x[3]); }
                    ss += __shfl_xor(ss, 16); ss += __shfl_xor(ss, 32);
                    const float rstd = rsqrtf(ss * (1.0f / 64.0f) + 1e-6f);
                    bf16_t* rowp = Z + (size_t)(row0 + ai * HALF + m * 16) * ZW + u.pn * BM + 64 * wc + 8 * fq;
#pragma unroll
                    for (int bj = 0; bj < 2; ++bj) { const f32x4 v0 = acc[ai][bj][m][0] * rstd * gv[bj][0], v1 = acc[ai][bj][m][1] * rstd * gv[bj][1];
                        u32x4 w; w.x = cvt_pk_bf16(v0[0], v0[1]); w.y = cvt_pk_bf16(v0[2], v0[3]); w.z = cvt_pk_bf16(v1[0], v1[1]); w.w = cvt_pk_bf16(v1[2], v1[3]);
                        *(u32x4*)(rowp + 32 * bj) = w; }
                }
        } else {
            const int col0 = u.pn * BM + wc * 32 + 8 * fq;
#pragma unroll
            for (int ai = 0; ai < 2; ++ai)
#pragma unroll
                for (int m = 0; m < 4; ++m) { bf16_t* rowp = Z + (size_t)(row0 + ai * HALF + m * 16) * ZW + col0;
#pragma unroll
                    for (int bj = 0; bj < 2; ++bj) { const f32x4 v0 = acc[ai][bj][m][0], v1 = acc[ai][bj][m][1];
                        u32x4 w; w.x = cvt_pk_bf16(v0[0], v0[1]); w.y = cvt_pk_bf16(v0[2], v0[3]); w.z = cvt_pk_bf16(v1[0], v1[1]); w.w = cvt_pk_bf16(v1[2], v1[3]);
                        *(u32x4*)(rowp + bj * HALF) = w; } }
        }
    }
};
struct EpiBf16 {
    static constexpr bool PERM = true;
    bf16_t* O; int ldc;
    __device__ __forceinline__ void operator()(const f32x4 (&acc)[2][2][4][2], const Unit& u, int wr, int wc, int fr, int fq) const {
        const int row0 = u.pm * BM + wr * 64 + fr, col0 = u.pn * BM + wc * 32 + 8 * fq;
#pragma unroll
        for (int ai = 0; ai < 2; ++ai)
#pragma unroll
            for (int m = 0; m < 4; ++m) { bf16_t* rowp = O + (size_t)(row0 + ai * HALF + m * 16) * ldc + col0;
#pragma unroll
                for (int bj = 0; bj < 2; ++bj) { const f32x4 v0 = acc[ai][bj][m][0], v1 = acc[ai][bj][m][1];
                    u32x4 w; w.x = cvt_pk_bf16(v0[0], v0[1]); w.y = cvt_pk_bf16(v0[2], v0[3]); w.z = cvt_pk_bf16(v1[0], v1[1]); w.w = cvt_pk_bf16(v1[2], v1[3]);
                    *(u32x4*)(rowp + bj * HALF) = w; } }
    }
};
struct EpiOut {
    static constexpr bool PERM = false;
    const float* X; float* O;
    __device__ __forceinline__ void operator()(const f32x4 (&acc)[2][2][4][2], const Unit& u, int wr, int wc, int fr, int fq) const {
        const int row0 = u.pm * BM + wr * 64 + fr, col0 = u.pn * BM + wc * 32 + 4 * fq;
#pragma unroll
        for (int ai = 0; ai < 2; ++ai)
#pragma unroll
            for (int m = 0; m < 4; ++m) { const size_t off = (size_t)(row0 + ai * HALF + m * 16) * DM + col0;
#pragma unroll
                for (int bj = 0; bj < 2; ++bj)
#pragma unroll
                    for (int n = 0; n < 2; ++n) *(f32x4*)(O + off + bj * HALF + n * 16) = *(const f32x4*)(X + off + bj * HALF + n * 16) + acc[ai][bj][m][n];
                if (m & 1) asm volatile("" ::: "memory"); }
    }
};
struct EpiPg {
    static constexpr bool PERM = false;
    float* X; const bf16_t* PJ;
    __device__ __forceinline__ void operator()(const f32x4 (&acc)[2][2][4][2], const Unit& u, int wr, int wc, int fr, int fq) const {
        const int row0 = u.pm * BM + wr * 64 + fr, col0 = u.pn * BM + wc * 32 + 4 * fq;
#pragma unroll
        for (int ai = 0; ai < 2; ++ai)
#pragma unroll
            for (int m = 0; m < 4; ++m) { const size_t off = (size_t)(row0 + ai * HALF + m * 16) * DM + col0;
#pragma unroll
                for (int bj = 0; bj < 2; ++bj)
#pragma unroll
                    for (int n = 0; n < 2; ++n) { const size_t o = off + bj * HALF + n * 16; const u32x2 pj = *(const u32x2*)(PJ + o); const f32x4 a = acc[ai][bj][m][n]; const f32x4 xv = *(const f32x4*)(X + o);
                        f32x4 r; r[0] = xv[0] + sigmoidf_(a[0]) * bflo(pj.x); r[1] = xv[1] + sigmoidf_(a[1]) * bfhi(pj.x); r[2] = xv[2] + sigmoidf_(a[2]) * bflo(pj.y); r[3] = xv[3] + sigmoidf_(a[3]) * bfhi(pj.y);
                        *(f32x4*)(X + o) = r; }
                if (m & 1) asm volatile("" ::: "memory"); }
    }
};
struct EpiGu {
    static constexpr bool PERM = true;
    bf16_t* ACT; const float* b_gu;
    __device__ __forceinline__ void operator()(const f32x4 (&acc)[2][2][4][2], const Unit& u, int wr, int wc, int fr, int fq) const {
        const int row0 = u.pm * BM + wr * 64 + fr, cl = u.pn * HALF + wc * 32 + 8 * fq;
        const float* bg = b_gu + (size_t)u.e * 2048 + cl;
        f32x4 bgl[2], bli[2];
#pragma unroll
        for (int n = 0; n < 2; ++n) { bgl[n] = *(const f32x4*)(bg + 4 * n); bli[n] = *(const f32x4*)(bg + 1024 + 4 * n); }
#pragma unroll
        for (int ai = 0; ai < 2; ++ai)
#pragma unroll
            for (int m = 0; m < 4; ++m) { bf16_t* rowp = ACT + (size_t)(row0 + ai * HALF + m * 16) * EFF + cl; float r[8];
#pragma unroll
                for (int n = 0; n < 2; ++n)
#pragma unroll
                    for (int i = 0; i < 4; ++i) { const float gl = fminf(acc[ai][0][m][n][i] + bgl[n][i], 7.0f); const float li = fminf(fmaxf(acc[ai][1][m][n][i] + bli[n][i], -7.0f), 7.0f);
                        r[4 * n + i] = gl * sigmoidf_(1.702f * gl) * (li + 1.0f); }
                u32x4 w; w.x = cvt_pk_bf16(r[0], r[1]); w.y = cvt_pk_bf16(r[2], r[3]); w.z = cvt_pk_bf16(r[4], r[5]); w.w = cvt_pk_bf16(r[6], r[7]);
                *(u32x4*)rowp = w; }
    }
};
struct EpiDn {
    static constexpr bool PERM = true;
    bf16_t* YP; const float* b_dn; const float* gateslot; const LAS int* tab;
    __device__ __forceinline__ void operator()(const f32x4 (&acc)[2][2][4][2], const Unit& u, int wr, int wc, int fr, int fq) const {
        const int row0 = u.pm * BM + wr * 64 + fr, col0 = u.pn * BM + wc * 32 + 8 * fq;
        const float* bd = b_dn + (size_t)u.e * 1024 + col0; const int cnt = tab[T_CNT + u.e];
        f32x4 bv[2][2];
#pragma unroll
        for (int bj = 0; bj < 2; ++bj)
#pragma unroll
            for (int n = 0; n < 2; ++n) bv[bj][n] = *(const f32x4*)(bd + bj * HALF + 4 * n);
#pragma unroll
        for (int ai = 0; ai < 2; ++ai)
#pragma unroll
            for (int m = 0; m < 4; ++m) { const int rr = wr * 64 + fr + ai * HALF + m * 16, slot = u.lb * 256 + rr;
                const float gt = slot < cnt ? gateslot[(size_t)u.e * NTOK + slot] : 0.f;
                bf16_t* rowp = YP + (size_t)(row0 + ai * HALF + m * 16) * DM + col0;
#pragma unroll
                for (int bj = 0; bj < 2; ++bj) { const f32x4 v0 = (acc[ai][bj][m][0] + bv[bj][0]) * gt, v1 = (acc[ai][bj][m][1] + bv[bj][1]) * gt;
                    u32x4 w; w.x = cvt_pk_bf16(v0[0], v0[1]); w.y = cvt_pk_bf16(v0[2], v0[3]); w.z = cvt_pk_bf16(v1[0], v1[1]); w.w = cvt_pk_bf16(v1[2], v1[3]);
                    *(u32x4*)(rowp + bj * HALF) = w; } }
    }
};
struct MoeOrder {
    const bf16_t* A; const bf16_t* Bt; const int* tokslot; const LAS int* tab; int nblk, nN, G, c; bool gather;
    __device__ __forceinline__ bool next(int i, Unit& u) const { if (!tile_order(i, G, c, nblk, nN, u.pm, u.pn)) return false; u.e = tab[T_BLKE + u.pm]; u.lb = u.pm - tab[T_BLKSTART + u.e]; return true; }
    __device__ __forceinline__ const char* a_base(const Unit& u) const { return gather ? (const char*)A : (const char*)A + (size_t)u.pm * BM * 1024 * 2; }
    __device__ __forceinline__ const char* b_base(const Unit& u) const { return (const char*)Bt + ((size_t)u.e * nN + u.pn) * BM * 1024 * 2; }
    __device__ __forceinline__ void a_off(const Unit& u, const int (&R)[2], const int (&C)[2], unsigned (&off)[2][2]) const {
        const int cnt = tab[T_CNT + u.e];
#pragma unroll
        for (int h = 0; h < 2; ++h)
#pragma unroll
            for (int i = 0; i < 2; ++i) {
                if (gather) { const int slot = u.lb * 256 + R[i] + HALF * h; const int tok = slot < cnt ? tokslot[(size_t)u.e * NTOK + slot] : NTOK; off[h][i] = (unsigned)tok * 2048u + (unsigned)C[i] * 2u; }
                else off[h][i] = (unsigned)((R[i] + HALF * h) * 1024 + C[i]) * 2u;
            }
    }
};
__device__ __forceinline__ int moe_tables(LAS int* tab, const unsigned* cntw) {
    if (threadIdx.x == 0) { int s = 0; for (int e = 0; e < NE; ++e) { const int c = (int)cntw[e]; tab[T_CNT + e] = c; tab[T_BLKSTART + e] = s; const int nb = (c + 255) >> 8; for (int j = 0; j < nb; ++j) tab[T_BLKE + s + j] = e; s += nb; } tab[T_BLKSTART + NE] = s; }
    __syncthreads();
    return tab[T_BLKSTART + NE];
}
}
constexpr int NWAVES = 8, NTHREADS = 512;
constexpr int RING_BYTES = 131072, MISC_OFF = RING_BYTES, LDS_BYTES = 147456;

__device__ __forceinline__ void tr_item(const float* W, int ldw, int srccol0, int k0, bf16_t* WT, int Kd, int dstrow0, LAS float* scr, int lane) {
#pragma unroll 8
    for (int i = 0; i < 32; ++i) { const int kk = 2 * i + (lane >> 5); scr[kk * 33 + (lane & 31)] = W[(size_t)(k0 + kk) * ldw + srccol0 + (lane & 31)]; }
    asm volatile("s_waitcnt lgkmcnt(0)" ::: "memory");
    const int c = lane & 7;
#pragma unroll
    for (int j = 0; j < 4; ++j) { const int n = (lane >> 3) + 8 * j; const LAS float* s = scr + (8 * c) * 33 + n;
        u32x4 o; o.x = pk2(s[0 * 33], s[1 * 33]); o.y = pk2(s[2 * 33], s[3 * 33]); o.z = pk2(s[4 * 33], s[5 * 33]); o.w = pk2(s[6 * 33], s[7 * 33]);
        *(u32x4*)(WT + (size_t)(dstrow0 + n) * Kd + k0 + 8 * c) = o; }
    asm volatile("s_waitcnt lgkmcnt(0)" ::: "memory");
}
constexpr int I_IN = 16 * 120, I_OUT = 16 * 32, I_PG = 16 * 32, I_PP = 4 * 32, I_GU1 = 16 * 64, I_DN1 = 16 * 32;
constexpr int I_LORA = 16 + 16 + 32;
constexpr int I_SMALL = I_IN + I_OUT + I_PG + I_PP + I_LORA, I_GU = NE * I_GU1, I_DN = NE * I_DN1, I_ALL = I_SMALL + I_GU + I_DN;
__device__ __forceinline__ void prep_item(KPR P, int it, LAS float* scr, int lane) {
    unsigned char* ws = P.ws;
    if (it < I_IN) { const int kb = it / 120, nb = it % 120, n0 = nb * 32, pn = n0 >> 8, j0 = n0 & 255;
        const int src = pn < 4 ? (pn * 256 + 64 * ((j0 & 127) >> 5) + 32 * (j0 >> 7)) : (n0 < 2048 ? n0 : n0 + 8);
        tr_item(P.w_in, INW, src, kb * 64, (bf16_t*)(ws + WS_WIN), 1024, n0, scr, lane); return; }
    it -= I_IN;
    if (it < I_OUT) { tr_item(P.w_out, 1024, (it % 32) * 32, (it / 32) * 64, (bf16_t*)(ws + WS_WOUT), 1024, (it % 32) * 32, scr, lane); return; }
    it -= I_OUT;
    if (it < I_PG) { tr_item(P.w_pg, 1024, (it % 32) * 32, (it / 32) * 64, (bf16_t*)(ws + WS_WPG), 1024, (it % 32) * 32, scr, lane); return; }
    it -= I_PG;
    if (it < I_PP) { tr_item(P.w_pp, 1024, (it % 32) * 32, (it / 32) * 64, (bf16_t*)(ws + WS_WPP), 256, (it % 32) * 32, scr, lane); return; }
    it -= I_PP;
    if (it < 16) { tr_item(P.w2, 512, it * 32, 0, (bf16_t*)(ws + 29 * MiB), 64, it * 32, scr, lane); return; }
    it -= 16;
    if (it < 16) { tr_item(P.a2, 512, it * 32, 0, (bf16_t*)(ws + 29 * MiB + 65536), 64, it * 32, scr, lane); return; }
    it -= 16;
    if (it < 32) { tr_item(P.g2, 512, (it % 16) * 32, (it / 16) * 64, (bf16_t*)(ws + 29 * MiB + 131072), 128, (it % 16) * 32, scr, lane); return; }
    it -= 32;
    if (it < I_GU) { const int e = it / I_GU1, r = it % I_GU1, kb = r / 64, nb = r % 64, n0 = nb * 32, pn = n0 >> 8, j0 = n0 & 255;
        const int src = (j0 >> 7) * 1024 + pn * 128 + (j0 & 127);
        tr_item(P.w_gu + (size_t)e * 1024 * 2048, 2048, src, kb * 64, (bf16_t*)(ws + WS_WGU) + (size_t)e * 2048 * 1024, 1024, n0, scr, lane); return; }
    it -= I_GU;
    { const int e = it / I_DN1, r = it % I_DN1, kb = r / 32, nb = r % 32;
        tr_item(P.w_down + (size_t)e * 1024 * 1024, 1024, nb * 32, kb * 64, (bf16_t*)(ws + WS_WDN) + (size_t)e * 1024 * 1024, 1024, nb * 32, scr, lane); }
}
__device__ __forceinline__ void phase_prep_weights(KPR P, LAS unsigned char* lds, int gw, int ngw, int wave, int lane) {
    LAS float* scr = (LAS float*)(lds + wave * 16384);
    for (int it = gw; it < I_ALL; it += ngw) prep_item(P, it, scr, lane);
}
__device__ __forceinline__ void phase_cvt_p(KPR P, int gt, int ngt) {
    bf16_t* PB = (bf16_t*)((unsigned char*)P.out + DO_PB);
    for (int i = gt; i < NTOK * PLE / 8; i += ngt) { const f32x4 a = ((const f32x4*)P.p)[2 * i], b = ((const f32x4*)P.p)[2 * i + 1];
        u32x4 w; w.x = pk2(a[0], a[1]); w.y = pk2(a[2], a[3]); w.z = pk2(b[0], b[1]); w.w = pk2(b[2], b[3]); ((u32x4*)PB)[i] = w; }
}
__device__ __forceinline__ void rms_row(const float* xrow, const float* gain, int lane, f32x4 (&v)[4]) {
    const f32x4* xr = (const f32x4*)xrow + lane; float s = 0.f;
#pragma unroll
    for (int j = 0; j < 4; ++j) { v[j] = xr[64 * j]; s += (v[j][0] * v[j][0] + v[j][1] * v[j][1]) + (v[j][2] * v[j][2] + v[j][3] * v[j][3]); }
    const float rstd = rsqrtf(wave_sum(s) * (1.f / DM) + 1e-6f);
#pragma unroll
    for (int j = 0; j < 4; ++j) v[j] = v[j] * rstd * ((const f32x4*)gain)[64 * j + lane];
}
__device__ __forceinline__ void store_row_bf16(bf16_t* orow, int lane, const f32x4 (&v)[4]) {
    u32x2* o8 = (u32x2*)orow + lane;
#pragma unroll
    for (int j = 0; j < 4; ++j) { u32x2 w; w.x = pk2(v[j][0], v[j][1]); w.y = pk2(v[j][2], v[j][3]); o8[64 * j] = w; }
}
__device__ __forceinline__ void norm1_row(KPR P, int row, int lane, const LAS float* wff, LAS float* lf_out  ) {
    f32x4 v[4]; rms_row(P.x + (size_t)row * DM, P.mix_norm, lane, v);
    store_row_bf16((bf16_t*)(P.ws + WS_XN) + (size_t)row * DM, lane, v);
    float ff[8];
#pragma unroll
    for (int q = 0; q < 8; ++q) ff[q] = 0.f;
#pragma unroll
    for (int j = 0; j < 4; ++j)
#pragma unroll
        for (int i = 0; i < 4; ++i) { const LAS f32x4* w = (const LAS f32x4*)(wff + (size_t)(4 * (64 * j + lane) + i) * 8); const f32x4 w0 = w[0], w1 = w[1]; const float h = v[j][i];
            ff[0] += h * w0[0]; ff[1] += h * w0[1]; ff[2] += h * w0[2]; ff[3] += h * w0[3]; ff[4] += h * w1[0]; ff[5] += h * w1[1]; ff[6] += h * w1[2]; ff[7] += h * w1[3]; }
#pragma unroll
    for (int q = 0; q < 8; ++q) ff[q] = wave_sum(ff[q]);
    if (lane < 8) { float f = ff[0];
#pragma unroll
        for (int q = 1; q < 8; ++q) f = (lane == q) ? ff[q] : f;
        lf_out[lane] = logsigmoidf_(f + P.f_bias[lane]); }
}
__device__ __forceinline__ void load_wff(KPR P, LAS float* wff, int tid, int nthr) {
    for (int i = tid; i < 1024 * 8; i += nthr) wff[i] = P.w_in[(size_t)(i >> 3) * INW + 2048 + (i & 7)];
}
__device__ __forceinline__ void final_row(KPR P, int row, int lane, bool dead) {
    f32x4 v[4]; rms_row((const float*)(P.ws + WS_X1) + (size_t)row * DM, P.final_norm, lane, v);
    f32x4* o = (f32x4*)(P.out + (size_t)row * DM) + lane;
#pragma unroll
    for (int j = 0; j < 4; ++j) { if (dead) { const float q = __builtin_nanf(""); v[j] = (f32x4){q, q, q, q}; } o[64 * j] = v[j]; }
}
typedef GAS unsigned gu32;
#define RLX_AGENT __ATOMIC_RELAXED, __HIP_MEMORY_SCOPE_AGENT
#define XB_TMO      128
#define XB_XCNT(j)  (256  + 64 * (j))
#define XB_XSUB(j)  (1280 + 64 * (j))
#define XB_XGEN(j)  (2304 + 64 * (j))
#define XB_TOP      3328
#define XB_TOPGEN   3392
#define XCD_BAR_WORDS 3456
#define XB_SPIN_CAP (1u << 22)

__device__ __forceinline__ unsigned xb_ld(unsigned* p)              { return __hip_atomic_load(p, __ATOMIC_RELAXED, __HIP_MEMORY_SCOPE_AGENT); }
__device__ __forceinline__ unsigned xb_add(unsigned* p, unsigned v) { return __hip_atomic_fetch_add(p, v, __ATOMIC_RELAXED, __HIP_MEMORY_SCOPE_AGENT); }
__device__ __forceinline__ unsigned xb_xcc_id() { return (unsigned)__builtin_amdgcn_s_getreg((3 << 11) | 20) & 0xFu; }
#define XB_SPIN(cond, bar) do { unsigned _sp = 0; while (cond) { __builtin_amdgcn_s_sleep(1); \
    if ((++_sp & 255u) == 0u) { if (xb_ld(&(bar)[XB_TMO])) break; if (_sp > XB_SPIN_CAP) { atomicAdd(&(bar)[XB_TMO], 1u); break; } } } } while (0)

struct XcdBarrier { unsigned* bar; unsigned x; volatile LAS unsigned* st; };

__device__ __forceinline__ XcdBarrier xcd_barrier_post(unsigned* bar, volatile LAS unsigned* st) {
    XcdBarrier b; b.bar = bar; b.x = xb_xcc_id(); b.st = st;
    if (threadIdx.x == 0) (void)xb_add(&bar[XB_XCNT(b.x)], 1u);
    return b;
}
__device__ __forceinline__ void xcd_barrier_complete(unsigned* bar, unsigned x, unsigned& nloc, unsigned& nx) {
    const unsigned G = gridDim.x * gridDim.y * gridDim.z;
    unsigned sum, cnt, mine, sp = 0u;
    for (;;) {
        sum = 0u; cnt = 0u; mine = 0u;
#pragma unroll
        for (unsigned j = 0; j < 16; ++j) { const unsigned c = xb_ld(&bar[XB_XCNT(j)]); sum += c; cnt += (c > 0u) ? 1u : 0u; mine = (j == x) ? c : mine; }
        if (sum == G) break;
        __builtin_amdgcn_s_sleep(1);
        if ((++sp & 255u) == 0u) { if (xb_ld(&bar[XB_TMO])) break; if (sp > XB_SPIN_CAP) { atomicAdd(&bar[XB_TMO], 1u); break; } }
    }
    nloc = mine > 0u ? mine : 1u; nx = cnt > 0u ? cnt : 1u;
}
__device__ __forceinline__ void xcd_barrier(const XcdBarrier& b) {
    asm volatile("s_waitcnt vmcnt(0)" ::: "memory");
    __syncthreads();
    if (threadIdx.x == 0) {
        unsigned* bar = b.bar;
        __builtin_amdgcn_s_waitcnt(0);
        unsigned nloc = b.st[0], nx = b.st[1];
        if (nloc == 0u) { xcd_barrier_complete(bar, b.x, nloc, nx); b.st[0] = nloc; b.st[1] = nx; }
        const unsigned old = xb_add(&bar[XB_XSUB(b.x)], 1u);
        const unsigned gen = old / nloc;
        if (old + 1u == (gen + 1u) * nloc) {
            __builtin_amdgcn_fence(__ATOMIC_RELEASE, "agent");
            asm volatile("s_waitcnt vmcnt(0)" ::: "memory");
            const unsigned og = xb_add(&bar[XB_TOP], 1u);
            const unsigned tg = og / nx;
            if (og + 1u == (tg + 1u) * nx) xb_add(&bar[XB_TOPGEN], 1u);
            else XB_SPIN(xb_ld(&bar[XB_TOPGEN]) == tg, bar);
            __builtin_amdgcn_fence(__ATOMIC_ACQUIRE, "agent");
            xb_add(&bar[XB_XGEN(b.x)], 1u);
            asm volatile("s_waitcnt vmcnt(0)" ::: "memory");
        } else {
            XB_SPIN(xb_ld(&bar[XB_XGEN(b.x)]) == gen, bar);
            __builtin_amdgcn_fence(__ATOMIC_ACQUIRE, "agent");
            asm volatile("s_waitcnt vmcnt(0)" ::: "memory");
        }
    }
    __syncthreads();
}
namespace rk {
constexpr int MB = 8192;
constexpr int S_AT = 0, S_RT = 1, S_KT = 2, S_BT = 3, S_ATT = 4, S_KTT = 5, S_BTT = 6, S_VT = 7, S_N = 8, S_NT = 9, S_MAK = 10, S_MRB = 11, S_MRK = 12, S_TA = 13, S_TB = 14;
constexpr int SCR = 15 * MB;
constexpr int NCHUNK = SEQ / 64;
constexpr size_t WS_HT = WS_X1;
constexpr size_t WS_Y0 = WS_X1 + 64 * MiB;
constexpr size_t WS_QI = WS_X1 + 96 * MiB;
constexpr size_t WS_LW = WS_RW, WS_LA = WS_RW + 32 * MiB, WS_LG = WS_RW + 64 * MiB;
constexpr size_t WS_SC = WS_RW + 224 * MiB;
constexpr size_t DO_GT = 80 * MiB;
static_assert(WS_SC + 32 * MiB <= WS_END, "rwkv blobs");

__device__ __forceinline__ int moff(int row, int col) { return row * 128 + ((((col >> 3) ^ (row >> 1)) & 7) << 4) + (col & 7) * 2; }
__device__ __forceinline__ int crow(int r, int hi) { return (r & 3) + 8 * (r >> 2) + 4 * hi; }
__device__ __forceinline__ f32x16 mm_nt(const LAS unsigned char* A, int ar0, const LAS unsigned char* Bt, int br0, f32x16 acc, int r32, int hi) {
#pragma unroll
    for (int ks = 0; ks < 4; ++ks) { const bf16x8 a = *(const LAS bf16x8*)(A + moff(ar0 + r32, 16 * ks + 8 * hi)), b = *(const LAS bf16x8*)(Bt + moff(br0 + r32, 16 * ks + 8 * hi));
        acc = __builtin_amdgcn_mfma_f32_32x32x16_bf16(a, b, acc, 0, 0, 0); }
    return acc;
}
__device__ __forceinline__ void store_t(LAS unsigned char* dst, const f32x16& acc, int i0, int j0, int r32, int hi) {
#pragma unroll
    for (int g = 0; g < 4; ++g) { u32x2 w; w.x = pk2(acc[4 * g], acc[4 * g + 1]); w.y = pk2(acc[4 * g + 2], acc[4 * g + 3]); *(LAS u32x2*)(dst + moff(j0 + r32, i0 + 8 * g + 4 * hi)) = w; }
}
template <int MODE> __device__ __forceinline__ void mask_tri(f32x16& acc, int i0, int j0, int r32, int hi) {
#pragma unroll
    for (int r = 0; r < 16; ++r) { const int i = i0 + crow(r, hi), j = j0 + r32; const bool keep = MODE == 0 ? (j < i) : (MODE == 1 ? (i < j) : (i <= j)); if (!keep) acc[r] = 0.f; }
}

__device__ __forceinline__ void pass1_chunk(KPR P, LAS unsigned char* lds, int bh, int c, int tid) {
    const int lane = tid & 63, wave = tid >> 6, r32 = lane & 31, hi = lane >> 5, grp = wave >> 2, wq = wave & 3, i0 = 32 * (wq >> 1), j0 = 32 * (wq & 1);
    const int b = bh >> 3, h = bh & 7; const size_t tok0 = (size_t)b * SEQ + (size_t)c * 64; const size_t ci = (size_t)bh * NCHUNK + c;
    LAS float* part = (LAS float*)(lds + SCR); LAS float* WL = (LAS float*)(lds + SCR + 2048);
#define MAT(s) (lds + (s) * MB)
    {
        const bf16_t* Z = (const bf16_t*)(P.ws + WS_Z); const bf16_t* LW = (const bf16_t*)(P.ws + WS_LW); const bf16_t* LA = (const bf16_t*)(P.ws + WS_LA);
        const int ch = tid & 63, tq = tid >> 6, cc = h * 64 + ch; const size_t row0 = tok0 + 8 * tq;
        const float mur = P.mu[RW_R + cc], muk = P.mu[RW_K + cc], muv = P.mu[RW_V + cc], w0c = P.w0[cc], a0c = P.a0[cc], kkc = P.k_k[cc], kac = P.k_a[cc];
        const bf16_t* zp = Z + row0 * ZW + ZR + cc;
        const bool first = (c == 0) && (tq == 0); const bf16_t* zq = first ? zp : zp - ZW; const float pm = first ? 0.f : 1.f;
        unsigned short lr[9], lk[9], lv[9], llw[8], lla[8];
        lr[0] = zq[RW_R]; lk[0] = zq[RW_K]; lv[0] = zq[RW_V];
#pragma unroll
        for (int i = 0; i < 8; ++i) { const bf16_t* zi = zp + (size_t)i * ZW; lr[i + 1] = zi[RW_R]; lk[i + 1] = zi[RW_K]; lv[i + 1] = zi[RW_V]; const size_t o = (row0 + i) * 512 + cc; llw[i] = LW[o]; lla[i] = LA[o]; }
        float cum[8], vr[8], vk[8], vkk[8], vka[8], ssq[8]; unsigned short vv16[8]; float run = 0.f;
#pragma unroll
        for (int i = 0; i < 8; ++i) { const float pmi = (i == 0) ? pm : 1.f; const float zr1 = bf2f(lr[i + 1]), zk1 = bf2f(lk[i + 1]), zv1 = bf2f(lv[i + 1]);
            vr[i] = zr1 + (bf2f(lr[i]) * pmi - zr1) * mur; vk[i] = zk1 + (bf2f(lk[i]) * pmi - zk1) * muk; vv16[i] = (unsigned short)f2bf(zv1 + (bf2f(lv[i]) * pmi - zv1) * muv);
            vkk[i] = vk[i] * kkc; ssq[i] = vkk[i] * vkk[i]; }
#pragma unroll
        for (int o = 1; o < 64; o <<= 1) {
#pragma unroll
            for (int i = 0; i < 8; ++i) ssq[i] += __shfl_xor(ssq[i], o); }
#pragma unroll
        for (int i = 0; i < 8; ++i) {
            const float wl = w0c + bf2f(llw[i]); const float sp = fmaxf(-wl, 0.f) + __logf(1.0f + __expf(-fabsf(wl)));
            run += -__expf(-sp - 0.5f); cum[i] = run;
            const float a = __builtin_amdgcn_rcpf(1.0f + __expf(-(a0c + bf2f(lla[i]))));
            const float kk = vkk[i] * __builtin_amdgcn_rcpf(fmaxf(__builtin_amdgcn_sqrtf(ssq[i]), 1e-12f));
            vk[i] = vk[i] * (1.0f + (a - 1.0f) * kac); vkk[i] = kk; vka[i] = kk * a; }
        part[tq * 64 + ch] = run;
        __syncthreads();
        float pre = 0.f;
#pragma unroll
        for (int g = 0; g < 8; ++g) { const float pvv = part[g * 64 + ch]; pre += (g < tq) ? pvv : 0.f; }
        float eprev = __expf(pre);
        unsigned atT[4], ktT[4], btT[4], vT[4]; unsigned short hold[4] = {0, 0, 0, 0};
#pragma unroll
        for (int i = 0; i < 8; ++i) { const int t = 8 * tq + i;
            const float cm = pre + cum[i], e1 = __expf(cm), einv = __expf(-cm);
            const unsigned short at = (unsigned short)f2bf(-vkk[i] * eprev), rt = (unsigned short)f2bf(vr[i] * e1), kt = (unsigned short)f2bf(vk[i] * einv), bt = (unsigned short)f2bf(vka[i] * einv), vv = vv16[i];
            eprev = e1;
            *(LAS unsigned short*)(MAT(S_AT) + moff(t, ch)) = at; *(LAS unsigned short*)(MAT(S_RT) + moff(t, ch)) = rt; *(LAS unsigned short*)(MAT(S_KT) + moff(t, ch)) = kt; *(LAS unsigned short*)(MAT(S_BT) + moff(t, ch)) = bt;
            if (i & 1) { atT[i >> 1] = hold[0] | ((unsigned)at << 16); ktT[i >> 1] = hold[1] | ((unsigned)kt << 16); btT[i >> 1] = hold[2] | ((unsigned)bt << 16); vT[i >> 1] = hold[3] | ((unsigned)vv << 16); }
            else { hold[0] = at; hold[1] = kt; hold[2] = bt; hold[3] = vv; }
            if (i == 7 && tq == 7) WL[ch] = e1; }
        *(LAS u32x4*)(MAT(S_ATT) + moff(ch, 8 * tq)) = (u32x4){atT[0], atT[1], atT[2], atT[3]}; *(LAS u32x4*)(MAT(S_KTT) + moff(ch, 8 * tq)) = (u32x4){ktT[0], ktT[1], ktT[2], ktT[3]};
        *(LAS u32x4*)(MAT(S_BTT) + moff(ch, 8 * tq)) = (u32x4){btT[0], btT[1], btT[2], btT[3]}; *(LAS u32x4*)(MAT(S_VT) + moff(ch, 8 * tq)) = (u32x4){vT[0], vT[1], vT[2], vT[3]};
    }
    __syncthreads();
    const f32x16 zero = f32x16{};
    if (grp == 0) { f32x16 d = mm_nt(MAT(S_AT), i0, MAT(S_BT), j0, zero, r32, hi); mask_tri<0>(d, i0, j0, r32, hi); store_t(MAT(S_NT), d, i0, j0, r32, hi);
        d = mm_nt(MAT(S_KT), i0, MAT(S_AT), j0, zero, r32, hi); mask_tri<1>(d, i0, j0, r32, hi); store_t(MAT(S_MAK), d, i0, j0, r32, hi);
        d = mm_nt(MAT(S_KT), i0, MAT(S_RT), j0, zero, r32, hi); mask_tri<2>(d, i0, j0, r32, hi); store_t(MAT(S_MRK), d, i0, j0, r32, hi); }
    else { f32x16 d = mm_nt(MAT(S_BT), i0, MAT(S_AT), j0, zero, r32, hi); mask_tri<1>(d, i0, j0, r32, hi); store_t(MAT(S_N), d, i0, j0, r32, hi);
#pragma unroll
        for (int r = 0; r < 16; ++r) if (i0 + crow(r, hi) == j0 + r32) d[r] = 1.0f;
        store_t(MAT(S_TA), d, i0, j0, r32, hi);
        d = mm_nt(MAT(S_BT), i0, MAT(S_RT), j0, zero, r32, hi); mask_tri<2>(d, i0, j0, r32, hi); store_t(MAT(S_MRB), d, i0, j0, r32, hi); }
    __syncthreads();
#pragma unroll
    for (int s = 1; s <= 6; ++s) {
        const int mc = (s & 1) ? S_N : S_AT, mcT = (s & 1) ? S_NT : S_KT, mn = (s & 1) ? S_AT : S_N, mnT = (s & 1) ? S_KT : S_NT;
        const int tc = (s & 1) ? S_TB : S_TA, tn = (s & 1) ? S_TA : S_TB;
        if (s <= 5) {
            if (grp == 0) { const f32x16 d = mm_nt(MAT(mc), i0, MAT(mcT), j0, zero, r32, hi); store_t(MAT(mnT), d, i0, j0, r32, hi); }
            else { const f32x16 d = mm_nt(MAT(mcT), i0, MAT(mc), j0, zero, r32, hi); store_t(MAT(mn), d, i0, j0, r32, hi); }
        }
        if (s >= 2 && grp == (s <= 5 ? 0 : 1) ) {
            f32x16 d = mm_nt(MAT(mcT), i0, MAT(tc), j0, zero, r32, hi);
#pragma unroll
            for (int g = 0; g < 4; ++g) { const u32x2 tv = *(const LAS u32x2*)(MAT(tc) + moff(j0 + r32, i0 + 8 * g + 4 * hi)); d[4 * g] += bflo(tv.x); d[4 * g + 1] += bfhi(tv.x); d[4 * g + 2] += bflo(tv.y); d[4 * g + 3] += bfhi(tv.y); }
            store_t(MAT(tn), d, i0, j0, r32, hi);
        }
        __syncthreads();
    }
    if (grp == 0) { const f32x16 d = mm_nt(MAT(S_TB), i0, MAT(S_ATT), j0, zero, r32, hi); store_t(MAT(S_BT), d, i0, j0, r32, hi); }
    else { const f32x16 d = mm_nt(MAT(S_MAK), i0, MAT(S_VT), j0, zero, r32, hi); store_t(MAT(S_N), d, i0, j0, r32, hi); }
    __syncthreads();
    if (grp == 0) { const f32x16 d = mm_nt(MAT(S_TB), i0, MAT(S_N), j0, zero, r32, hi); store_t(MAT(S_NT), d, i0, j0, r32, hi);
        f32x16 q = mm_nt(MAT(S_BT), i0, MAT(S_MRB), j0, zero, r32, hi);
#pragma unroll
        for (int g = 0; g < 4; ++g) { const u32x2 rv = *(const LAS u32x2*)(MAT(S_RT) + moff(j0 + r32, i0 + 8 * g + 4 * hi)); q[4 * g] += bflo(rv.x); q[4 * g + 1] += bfhi(rv.x); q[4 * g + 2] += bflo(rv.y); q[4 * g + 3] += bfhi(rv.y); }
        store_t(MAT(S_KT), q, i0, j0, r32, hi); }
    else { f32x16 g_ = mm_nt(MAT(S_BT), i0, MAT(S_BTT), j0, zero, r32, hi);
        const float wl = WL[j0 + r32];
#pragma unroll
        for (int r = 0; r < 16; ++r) { if (i0 + crow(r, hi) == j0 + r32) g_[r] += 1.0f; g_[r] *= wl; }
        store_t(MAT(S_AT), g_, i0, j0, r32, hi); }
    __syncthreads();
    if (grp == 0) { f32x16 d = mm_nt(MAT(S_BTT), i0, MAT(S_NT), j0, zero, r32, hi); d = mm_nt(MAT(S_KTT), i0, MAT(S_VT), j0, d, r32, hi);
        float* HT = (float*)(P.ws + WS_HT) + ci * 4096 + (size_t)wq * 1024 + lane;
#pragma unroll
        for (int g = 0; g < 4; ++g) { const f32x4 wl4 = *(const LAS f32x4*)(WL + i0 + 8 * g + 4 * hi);
#pragma unroll
            for (int i = 0; i < 4; ++i) HT[(4 * g + i) * 64] = d[4 * g + i] * wl4[i]; } }
    else { f32x16 d = mm_nt(MAT(S_MRB), i0, MAT(S_NT), j0, zero, r32, hi); d = mm_nt(MAT(S_MRK), i0, MAT(S_VT), j0, d, r32, hi);
        unsigned* Y0 = (unsigned*)(P.ws + WS_Y0) + ci * 2048 + (size_t)wq * 512 + lane;
#pragma unroll
        for (int r2 = 0; r2 < 8; ++r2) Y0[r2 * 64] = pk2(d[2 * r2], d[2 * r2 + 1]); }
    { u32x4* GTg = (u32x4*)((unsigned char*)P.out + DO_GT + ci * MB); u32x4* QIg = (u32x4*)(P.ws + WS_QI + ci * MB);
        GTg[tid] = *(const LAS u32x4*)(MAT(S_AT) + tid * 16); QIg[tid] = *(const LAS u32x4*)(MAT(S_KT) + tid * 16); }
    __syncthreads();
#undef MAT
}

__device__ __forceinline__ void pass2_seq(KPR P, LAS unsigned char* lds, int bh, int tid) {
    const int lane = tid & 63, wave = tid >> 6, r32 = lane & 31, hi = lane >> 5, wq = wave & 3, i0 = 32 * (wq >> 1), j0 = 32 * (wq & 1);
    LAS unsigned char* Sm = lds; LAS unsigned char* G0 = lds + MB; LAS unsigned char* G1 = lds + 2 * MB;
    const size_t ci0 = (size_t)bh * NCHUNK;
    const u32x4* GTg = (const u32x4*)((const unsigned char*)P.out + DO_GT + ci0 * MB); u32x4* SCg = (u32x4*)(P.ws + WS_SC + ci0 * MB);
    const float* HT = (const float*)(P.ws + WS_HT) + ci0 * 4096 + (size_t)wq * 1024 + lane;
    *(LAS u32x4*)(Sm + tid * 16) = (u32x4){0u, 0u, 0u, 0u};
    *(LAS u32x4*)(G0 + tid * 16) = GTg[tid];
    u32x4 gnext = GTg[512 + tid];
    f32x16 hcur, hnext;
    if (wave < 4) {
#pragma unroll
        for (int r = 0; r < 16; ++r) { hcur[r] = HT[r * 64]; hnext[r] = HT[4096 + r * 64]; } }
    __syncthreads();
    for (int c = 0; c < NCHUNK; ++c) {
        LAS unsigned char* Gc = (c & 1) ? G1 : G0; LAS unsigned char* Gn = (c & 1) ? G0 : G1;
        SCg[(size_t)c * 512 + tid] = *(const LAS u32x4*)(Sm + tid * 16);
        f32x16 d = hcur;
        if (wave < 4) d = mm_nt(Gc, i0, Sm, j0, d, r32, hi);
        __syncthreads();
        if (wave < 4) store_t(Sm, d, i0, j0, r32, hi);
        *(LAS u32x4*)(Gn + tid * 16) = gnext;
        const int c2 = (c + 2 < NCHUNK) ? c + 2 : NCHUNK - 1;
        gnext = GTg[(size_t)c2 * 512 + tid];
        if (wave < 4) { hcur = hnext;
#pragma unroll
            for (int r = 0; r < 16; ++r) hnext[r] = HT[(size_t)c2 * 4096 + r * 64]; }
        __syncthreads();
    }
}

__device__ __forceinline__ void pass3_chunk(KPR P, LAS unsigned char* lds, int bh, int c, int tid) {
    const int lane = tid & 63, wave = tid >> 6, r32 = lane & 31, hi = lane >> 5, wq = wave & 3, i0 = 32 * (wq >> 1), j0 = 32 * (wq & 1);
    const int b = bh >> 3, h = bh & 7; const size_t tok0 = (size_t)b * SEQ + (size_t)c * 64; const size_t ci = (size_t)bh * NCHUNK + c;
    LAS unsigned char* Qm = lds; LAS unsigned char* Sm = lds + MB; LAS float* Yl = (LAS float*)(lds + 2 * MB);
    *(LAS u32x4*)(Qm + tid * 16) = ((const u32x4*)(P.ws + WS_QI + ci * MB))[tid];
    *(LAS u32x4*)(Sm + tid * 16) = ((const u32x4*)(P.ws + WS_SC + ci * MB))[tid];
    f32x16 d = f32x16{};
    if (wave < 4) { const unsigned* Y0 = (const unsigned*)(P.ws + WS_Y0) + ci * 2048 + (size_t)wq * 512 + lane;
#pragma unroll
        for (int r2 = 0; r2 < 8; ++r2) { const unsigned w = Y0[r2 * 64]; d[2 * r2] = bflo(w); d[2 * r2 + 1] = bfhi(w); } }
    __syncthreads();
    if (wave < 4) { d = mm_nt(Qm, i0, Sm, j0, d, r32, hi);
#pragma unroll
        for (int r = 0; r < 16; ++r) Yl[(i0 + crow(r, hi)) * 65 + j0 + r32] = d[r]; }
    __syncthreads();
    const bf16_t* Z = (const bf16_t*)(P.ws + WS_Z); const bf16_t* LA = (const bf16_t*)(P.ws + WS_LA); const bf16_t* LG = (const bf16_t*)(P.ws + WS_LG);
    bf16_t* AO = (bf16_t*)(P.ws + WS_AO); const int cc = h * 64 + lane;
    const float lnw = P.ln_w[cc], lnb = P.ln_b[cc], rkc = P.r_k[cc], mur = P.mu[RW_R + cc], muk = P.mu[RW_K + cc], muv = P.mu[RW_V + cc], a0c = P.a0[cc], kac = P.k_a[cc];
    const bf16_t* zp = Z + (tok0 + wave * 8) * ZW + ZR + cc; const bool first = (c == 0) && (wave == 0); const bf16_t* zq = first ? zp : zp - ZW; const float pm = first ? 0.f : 1.f;
    unsigned short lr[9], lk[9], lv[9], lla[8], llg[8];
    lr[0] = zq[RW_R]; lk[0] = zq[RW_K]; lv[0] = zq[RW_V];
#pragma unroll
    for (int i = 0; i < 8; ++i) { const bf16_t* zi = zp + (size_t)i * ZW; lr[i + 1] = zi[RW_R]; lk[i + 1] = zi[RW_K]; lv[i + 1] = zi[RW_V]; const size_t o = (tok0 + wave * 8 + i) * 512 + cc; lla[i] = LA[o]; llg[i] = LG[o]; }
    float y[8], s1[8], s2[8], s3[8], vvv[8];
#pragma unroll
    for (int i = 0; i < 8; ++i) { const float pmi = (i == 0) ? pm : 1.f; const float zr1 = bf2f(lr[i + 1]), zk1 = bf2f(lk[i + 1]), zv1 = bf2f(lv[i + 1]);
        const float r = zr1 + (bf2f(lr[i]) * pmi - zr1) * mur, zk = zk1 + (bf2f(lk[i]) * pmi - zk1) * muk; vvv[i] = zv1 + (bf2f(lv[i]) * pmi - zv1) * muv;
        const float a = __builtin_amdgcn_rcpf(1.0f + __expf(-(a0c + bf2f(lla[i])))); const float k = zk * (1.0f + (a - 1.0f) * kac);
        y[i] = Yl[(wave * 8 + i) * 65 + lane]; s1[i] = y[i]; s3[i] = r * k * rkc; }
#pragma unroll
    for (int o = 1; o < 64; o <<= 1) {
#pragma unroll
        for (int i = 0; i < 8; ++i) { s1[i] += __shfl_xor(s1[i], o); s3[i] += __shfl_xor(s3[i], o); } }
#pragma unroll
    for (int i = 0; i < 8; ++i) { y[i] -= s1[i] * (1.f / 64.f); s2[i] = y[i] * y[i]; }
#pragma unroll
    for (int o = 1; o < 64; o <<= 1) {
#pragma unroll
        for (int i = 0; i < 8; ++i) s2[i] += __shfl_xor(s2[i], o); }
#pragma unroll
    for (int i = 0; i < 8; ++i) { const size_t tok = tok0 + wave * 8 + i; const float yn = y[i] * rsqrtf(s2[i] * (1.f / 64.f) + 64e-5f) * lnw + lnb;
        AO[tok * DM + 512 + cc] = (bf16_t)f2bf((yn + s3[i] * vvv[i]) * bf2f(llg[i])); }
}

constexpr size_t WS_W2T = 29 * MiB, WS_A2T = 29 * MiB + 65536, WS_G2T = 29 * MiB + 131072;
__device__ __forceinline__ bf16x8 act8(const bf16_t* zc, const bf16_t* zpv, float pmask, const float* mu, int mode) {
    const u32x4 c = *(const u32x4*)zc, p = *(const u32x4*)zpv;
    const f32x4 m0 = *(const f32x4*)mu, m1 = *(const f32x4*)(mu + 4);
    const unsigned cw[4] = {c.x, c.y, c.z, c.w}, pw[4] = {p.x, p.y, p.z, p.w}; const float um[8] = {m0[0], m0[1], m0[2], m0[3], m1[0], m1[1], m1[2], m1[3]}; float v[8];
#pragma unroll
    for (int j = 0; j < 4; ++j) { const float c0 = bflo(cw[j]), c1 = bfhi(cw[j]), p0 = bflo(pw[j]) * pmask, p1 = bfhi(pw[j]) * pmask;
        v[2 * j] = c0 + (p0 - c0) * um[2 * j]; v[2 * j + 1] = c1 + (p1 - c1) * um[2 * j + 1]; }
#pragma unroll
    for (int j = 0; j < 8; ++j) { if (mode == 0) { const float e = __expf(-2.0f * fabsf(v[j])); const float th = (1.0f - e) / (1.0f + e); v[j] = v[j] < 0.f ? -th : th; } else if (mode == 2) v[j] = 1.0f / (1.0f + __expf(-v[j])); }
    u32x4 w; w.x = pk2(v[0], v[1]); w.y = pk2(v[2], v[3]); w.z = pk2(v[4], v[5]); w.w = pk2(v[6], v[7]);
    return __builtin_bit_cast(bf16x8, w);
}
__device__ __forceinline__ void lora_task(KPR P, int task, int lane) {
    const int r32 = lane & 31, hi = lane >> 5; const size_t row = (size_t)task * 32 + r32; const bool first = (row % SEQ) == 0;
    const bf16_t* Z = (const bf16_t*)(P.ws + WS_Z) + row * ZW + ZR + 8 * hi; const bf16_t* Zp = first ? Z : Z - ZW; const float pmask = first ? 0.f : 1.f;
    const float* mub = P.mu + 8 * hi;
    bf16x8 xw[4], xa[4], xg[8];
#pragma unroll
    for (int ks = 0; ks < 4; ++ks) { xw[ks] = act8(Z + RW_W + 16 * ks, Zp + RW_W + 16 * ks, pmask, mub + RW_W + 16 * ks, 0); xa[ks] = act8(Z + RW_A + 16 * ks, Zp + RW_A + 16 * ks, pmask, mub + RW_A + 16 * ks, 1); asm volatile("" ::: "memory"); }
#pragma unroll
    for (int ks = 0; ks < 8; ++ks) { xg[ks] = act8(Z + RW_G + 16 * ks, Zp + RW_G + 16 * ks, pmask, mub + RW_G + 16 * ks, 2); if (ks & 1) asm volatile("" ::: "memory"); }
    const bf16_t* W2T = (const bf16_t*)(P.ws + WS_W2T) + r32 * 64 + 8 * hi; const bf16_t* A2T = (const bf16_t*)(P.ws + WS_A2T) + r32 * 64 + 8 * hi; const bf16_t* G2T = (const bf16_t*)(P.ws + WS_G2T) + r32 * 128 + 8 * hi;
    bf16_t* LW = (bf16_t*)(P.ws + WS_LW) + row * 512 + 4 * hi; bf16_t* LA = (bf16_t*)(P.ws + WS_LA) + row * 512 + 4 * hi; bf16_t* LG = (bf16_t*)(P.ws + WS_LG) + row * 512 + 4 * hi;
#pragma nounroll
    for (int cb = 0; cb < 16; ++cb) {
        f32x16 dw = f32x16{}, da = f32x16{}, dg = f32x16{};
#pragma unroll
        for (int ks = 0; ks < 4; ++ks) { dw = __builtin_amdgcn_mfma_f32_32x32x16_bf16(*(const bf16x8*)(W2T + cb * 32 * 64 + 16 * ks), xw[ks], dw, 0, 0, 0); da = __builtin_amdgcn_mfma_f32_32x32x16_bf16(*(const bf16x8*)(A2T + cb * 32 * 64 + 16 * ks), xa[ks], da, 0, 0, 0); }
#pragma unroll
        for (int ks = 0; ks < 8; ++ks) dg = __builtin_amdgcn_mfma_f32_32x32x16_bf16(*(const bf16x8*)(G2T + cb * 32 * 128 + 16 * ks), xg[ks], dg, 0, 0, 0);
#pragma unroll
        for (int g = 0; g < 4; ++g) { u32x2 w; w.x = pk2(dw[4 * g], dw[4 * g + 1]); w.y = pk2(dw[4 * g + 2], dw[4 * g + 3]); *(u32x2*)(LW + cb * 32 + 8 * g) = w;
            w.x = pk2(da[4 * g], da[4 * g + 1]); w.y = pk2(da[4 * g + 2], da[4 * g + 3]); *(u32x2*)(LA + cb * 32 + 8 * g) = w;
            w.x = pk2(dg[4 * g], dg[4 * g + 1]); w.y = pk2(dg[4 * g + 2], dg[4 * g + 3]); *(u32x2*)(LG + cb * 32 + 8 * g) = w; }
    }
}
}
namespace rt {
__device__ __forceinline__ int woff(int e, int k) { return e * 2048 + ((((k >> 3) ^ (e & 15))) << 4) + (k & 7) * 2; }
__device__ __forceinline__ void build_w(KPR P, LAS unsigned char* lds, int tid) {
    const int e = tid & 31, kq = tid >> 5;
    for (int i = 0; i < 64; ++i) { const int k = kq * 64 + i; const float w = P.moe_norm[k] * P.w_router[k * 32 + e]; const unsigned h = f2bf(w); const unsigned l = f2bf(w - bf2f(h));
        *(LAS unsigned short*)(lds + woff(e, k)) = (unsigned short)h; *(LAS unsigned short*)(lds + 65536 + woff(e, k)) = (unsigned short)l; }
}
__device__ __forceinline__ void split8(const f32x4& a, const f32x4& b, bf16x8& h, bf16x8& l) {
    unsigned hh[8]; float v[8] = {a[0], a[1], a[2], a[3], b[0], b[1], b[2], b[3]};
#pragma unroll
    for (int j = 0; j < 8; ++j) hh[j] = f2bf(v[j]);
    u32x4 hw, lw;
    hw.x = hh[0] | (hh[1] << 16); hw.y = hh[2] | (hh[3] << 16); hw.z = hh[4] | (hh[5] << 16); hw.w = hh[6] | (hh[7] << 16);
    lw.x = pk2(v[0] - bf2f(hh[0]), v[1] - bf2f(hh[1])); lw.y = pk2(v[2] - bf2f(hh[2]), v[3] - bf2f(hh[3])); lw.z = pk2(v[4] - bf2f(hh[4]), v[5] - bf2f(hh[5])); lw.w = pk2(v[6] - bf2f(hh[6]), v[7] - bf2f(hh[7]));
    h = __builtin_bit_cast(bf16x8, hw); l = __builtin_bit_cast(bf16x8, lw);
}
__device__ __forceinline__ void route_task(KPR P, const LAS unsigned char* wlds, int task, int lane) {
    const int r32 = lane & 31, hi = lane >> 5; const int row = task * 32 + r32;
    const float* xrow = (const float*)(P.ws + WS_X1) + (size_t)row * DM + 8 * hi;
    f32x16 acc = f32x16{}; float ss = 0.f;
    f32x4 xa[4], xb[4];
#pragma unroll
    for (int j = 0; j < 4; ++j) { xa[j] = *(const f32x4*)(xrow + 16 * j); xb[j] = *(const f32x4*)(xrow + 16 * j + 4); }
    for (int ks0 = 0; ks0 < 64; ks0 += 4) {
#pragma unroll
        for (int j = 0; j < 4; ++j) { const int ks = ks0 + j; const f32x4 a = xa[j], b = xb[j];
            const int kn = (ks + 4 < 64) ? ks + 4 : ks; xa[j] = *(const f32x4*)(xrow + 16 * kn); xb[j] = *(const f32x4*)(xrow + 16 * kn + 4);
            ss += (a[0] * a[0] + a[1] * a[1]) + (a[2] * a[2] + a[3] * a[3]) + (b[0] * b[0] + b[1] * b[1]) + (b[2] * b[2] + b[3] * b[3]);
            bf16x8 xh, xl; split8(a, b, xh, xl);
            const bf16x8 wh = *(const LAS bf16x8*)(wlds + woff(r32, 16 * ks + 8 * hi)), wl = *(const LAS bf16x8*)(wlds + 65536 + woff(r32, 16 * ks + 8 * hi));
            acc = __builtin_amdgcn_mfma_f32_32x32x16_bf16(wh, xh, acc, 0, 0, 0); acc = __builtin_amdgcn_mfma_f32_32x32x16_bf16(wh, xl, acc, 0, 0, 0); acc = __builtin_amdgcn_mfma_f32_32x32x16_bf16(wl, xh, acc, 0, 0, 0); }
    }
    ss += __shfl_xor(ss, 32);
    const float rstd = rsqrtf(ss * (1.f / DM) + 1e-6f);
    float lg[16];
#pragma unroll
    for (int g = 0; g < 4; ++g) { const f32x4 bb = *(const f32x4*)(P.b_router + 8 * g + 4 * hi);
#pragma unroll
        for (int i = 0; i < 4; ++i) lg[4 * g + i] = acc[4 * g + i] * rstd + bb[i]; }
    float tv[4]; int ti[4];
#pragma unroll
    for (int k = 0; k < 4; ++k) { float bv = lg[0]; int bi = 4 * hi;
#pragma unroll
        for (int r = 1; r < 16; ++r) { const int e = (r & 3) + 8 * (r >> 2) + 4 * hi; if (lg[r] > bv) { bv = lg[r]; bi = e; } }
        const float pv = __shfl_xor(bv, 32); const int pi = __shfl_xor(bi, 32);
        if (pv > bv || (pv == bv && pi < bi)) { bv = pv; bi = pi; }
        tv[k] = bv; ti[k] = bi;
#pragma unroll
        for (int r = 0; r < 16; ++r) { const int e = (r & 3) + 8 * (r >> 2) + 4 * hi; if (e == bi) lg[r] = -INFINITY; } }
    const float e1 = __expf(tv[1] - tv[0]), e2 = __expf(tv[2] - tv[0]), e3 = __expf(tv[3] - tv[0]), inv = 1.f / (1.f + e1 + e2 + e3);
    const int c0 = hi ? ti[2] : ti[0], c1 = hi ? ti[3] : ti[1]; const float g0 = (hi ? e2 : 1.f) * inv, g1 = (hi ? e3 : e1) * inv;
    const unsigned long long ltm = (1ull << lane) - 1ull; int mycnt = 0, rk0 = 0, rk1 = 0;
    for (int e = 0; e < 32; ++e) { const unsigned long long m0 = __ballot(c0 == e), m1 = __ballot(c1 == e); const int n0 = __popcll(m0);
        if (lane == e) mycnt = n0 + __popcll(m1);
        if (c0 == e) rk0 = __popcll(m0 & ltm);
        if (c1 == e) rk1 = n0 + __popcll(m1 & ltm); }
    unsigned* cnt = (unsigned*)(P.ws + WS_CTL) + CW_CNT; int base = 0;
    if (lane < 32 && mycnt > 0) base = (int)atomicAdd(cnt + lane, (unsigned)mycnt);
    rk0 += __shfl(base, c0); rk1 += __shfl(base, c1);
    int* route = (int*)(P.ws + WS_ROUTE); int* tokslot = (int*)(P.ws + WS_TOKSLOT); float* gateslot = (float*)(P.ws + WS_GATESLOT);
    tokslot[(size_t)c0 * NTOK + rk0] = row; gateslot[(size_t)c0 * NTOK + rk0] = g0; tokslot[(size_t)c1 * NTOK + rk1] = row; gateslot[(size_t)c1 * NTOK + rk1] = g1;
    route[(size_t)row * 12 + 2 * hi] = c0; route[(size_t)row * 12 + 2 * hi + 1] = c1; route[(size_t)row * 12 + 4 + 2 * hi] = rk0; route[(size_t)row * 12 + 4 + 2 * hi + 1] = rk1;
    bf16_t* xn = (bf16_t*)(P.ws + WS_XN) + (size_t)row * DM + 8 * hi; const float* gn = P.moe_norm + 8 * hi;
#pragma unroll 4
    for (int ks = 0; ks < 64; ++ks) { const f32x4 a = *(const f32x4*)(xrow + 16 * ks), b = *(const f32x4*)(xrow + 16 * ks + 4), ga = *(const f32x4*)(gn + 16 * ks), gb = *(const f32x4*)(gn + 16 * ks + 4);
        u32x4 w; w.x = pk2(a[0] * rstd * ga[0], a[1] * rstd * ga[1]); w.y = pk2(a[2] * rstd * ga[2], a[3] * rstd * ga[3]); w.z = pk2(b[0] * rstd * gb[0], b[1] * rstd * gb[1]); w.w = pk2(b[2] * rstd * gb[2], b[3] * rstd * gb[3]);
        *(u32x4*)(xn + 16 * ks) = w; }
}
}
__device__ __forceinline__ int crow(int r, int hi) { return (r & 3) + 8 * (r >> 2) + 4 * hi; }
constexpr int CW_QATT = 128;
constexpr int MISC_TAB = 64, MISC_Q = 4096, MISC_PFX = 4160;

__device__ __forceinline__ void attn_unit_v2(KPR P, LAS unsigned char* lds, int bh, int qb) {
    LAS bf16_t* Ks = (LAS bf16_t*)lds;
    LAS bf16_t* Vt = (LAS bf16_t*)(lds + 9216);
    LAS float* wsf = (LAS float*)(lds + 18432);
    const bf16_t* Z = (const bf16_t*)(P.ws + WS_Z); bf16_t* AO = (bf16_t*)(P.ws + WS_AO);
    const int tid = threadIdx.x, lane = tid & 63, w = tid >> 6, r32 = lane & 31, hi = lane >> 5;
    const int b = bh >> 3, h = bh & 7, q0 = qb * 256;
    const size_t rowbase = (size_t)b * SEQ;
    const float* c2 = (const float*)(P.ws + WS_C2) + (size_t)bh * SEQ;
    const int qloc = q0 + 32 * w + r32;
    const bf16_t* Qp = Z + (rowbase + qloc) * ZW + ZQ + h * 64;
    bf16x8 qr[4];
#pragma unroll
    for (int ks = 0; ks < 4; ++ks) qr[ks] = *(const bf16x8*)(Qp + ks * 16 + hi * 8);
    const float cq = c2[qloc];
    float m = -1e30f, l = 0.f; f32x16 o[2]; o[0] = f32x16{}; o[1] = f32x16{};
    const int ntiles = (q0 + 256) / 64;
    LAS float* wsw = wsf + w * 64;
    int t0 = 0;
    { float gq = fabsf(P.q_norm[lane]), gk = fabsf(P.k_norm[lane]);
#pragma unroll
        for (int o = 1; o < 64; o <<= 1) { gq = fmaxf(gq, __shfl_xor(gq, o)); gk = fmaxf(gk, __shfl_xor(gk, o)); }
        const float thr = c2[q0] + (2.0f * 8.0f * LOG2E * gq * gk + 40.0f);
        const int nfull = q0 / 64;
        for (int tb = 0; tb < nfull; tb += 64) { const int tt = tb + lane; const bool sk = (tt < nfull) && (c2[tt * 64 + 63] > thr); const unsigned long long bm = __ballot(sk); t0 += __popcll(bm); if (bm != ~0ull) break; } }
    for (int t = t0; t < ntiles; ++t) {
        __syncthreads();
        { const int row = tid >> 3, ch = tid & 7; const bf16_t* src = Z + (rowbase + t * 64 + row) * ZW + h * 64 + ch * 8;
            *(LAS u32x4*)&Ks[row * 72 + ch * 8] = *(const u32x4*)(src + ZK);
            const u32x4 v = *(const u32x4*)(src + ZV); const unsigned vv[4] = {v.x, v.y, v.z, v.w};
#pragma unroll
            for (int e = 0; e < 4; ++e) { Vt[(ch * 8 + 2 * e) * 72 + row] = (bf16_t)(vv[e] & 0xffffu); Vt[(ch * 8 + 2 * e + 1) * 72 + row] = (bf16_t)(vv[e] >> 16); } }
        __syncthreads();
        if (t * 64 > q0 + 32 * w + 31) continue;
        f32x16 p[2];
#pragma unroll
        for (int g = 0; g < 2; ++g) { p[g] = f32x16{};
#pragma unroll
            for (int ks = 0; ks < 4; ++ks) { const bf16x8 kf = *(const LAS bf16x8*)&Ks[(32 * g + r32) * 72 + ks * 16 + hi * 8]; p[g] = __builtin_amdgcn_mfma_f32_32x32x16_bf16(kf, qr[ks], p[g], 0, 0, 0); } }
        float mx = -1e30f;
#pragma unroll
        for (int g = 0; g < 2; ++g)
#pragma unroll
            for (int r4 = 0; r4 < 4; ++r4) { const int kv0 = t * 64 + 32 * g + 8 * r4 + 4 * hi; const f32x4 ck = *(const f32x4*)(c2 + kv0);
#pragma unroll
                for (int i = 0; i < 4; ++i) { float s = p[g][4 * r4 + i] + (cq - ck[i]); if (kv0 + i > qloc) s = -INFINITY; p[g][4 * r4 + i] = s; mx = fmaxf(mx, s); } }
        mx = fmaxf(mx, __shfl_xor(mx, 32));
        const float mnew = fmaxf(m, mx), alpha = exp2f(m - mnew); m = mnew;
        float ps = 0.f;
#pragma unroll
        for (int g = 0; g < 2; ++g)
#pragma unroll
            for (int r = 0; r < 16; ++r) { const float e = exp2f(p[g][r] - mnew); p[g][r] = e; ps += e; }
        l = l * alpha + ps;
        if (hi == 0) wsw[r32] = alpha;
        __builtin_amdgcn_wave_barrier(); asm volatile("s_waitcnt lgkmcnt(0)" ::: "memory");
#pragma unroll
        for (int r4 = 0; r4 < 4; ++r4) { const f32x4 al = *(const LAS f32x4*)&wsw[8 * r4 + 4 * hi];
#pragma unroll
            for (int i = 0; i < 4; ++i) { o[0][4 * r4 + i] *= al[i]; o[1][4 * r4 + i] *= al[i]; } }
#pragma unroll
        for (int g = 0; g < 2; ++g)
#pragma unroll
            for (int s = 0; s < 2; ++s) { u32x4 pw; pw.x = pk2(p[g][8 * s + 0], p[g][8 * s + 1]); pw.y = pk2(p[g][8 * s + 2], p[g][8 * s + 3]); pw.z = pk2(p[g][8 * s + 4], p[g][8 * s + 5]); pw.w = pk2(p[g][8 * s + 6], p[g][8 * s + 7]);
                const bf16x8 pa = __builtin_bit_cast(bf16x8, pw);
#pragma unroll
                for (int d0 = 0; d0 < 2; ++d0) { const u32x2 lo = *(const LAS u32x2*)&Vt[(32 * d0 + r32) * 72 + 32 * g + 16 * s + 4 * hi], hh = *(const LAS u32x2*)&Vt[(32 * d0 + r32) * 72 + 32 * g + 16 * s + 8 + 4 * hi];
                    u32x4 vw; vw.x = lo.x; vw.y = lo.y; vw.z = hh.x; vw.w = hh.y;
                    o[d0] = __builtin_amdgcn_mfma_f32_32x32x16_bf16(pa, __builtin_bit_cast(bf16x8, vw), o[d0], 0, 0, 0); } }
        __builtin_amdgcn_wave_barrier();
    }
    l += __shfl_xor(l, 32);
    __builtin_amdgcn_wave_barrier();
    if (hi == 0) wsw[32 + r32] = l;
    __builtin_amdgcn_wave_barrier(); asm volatile("s_waitcnt lgkmcnt(0)" ::: "memory");
#pragma unroll
    for (int r = 0; r < 16; ++r) { const int q = crow(r, hi); const float li = 1.0f / wsw[32 + q]; const size_t row = rowbase + q0 + 32 * w + q;
#pragma unroll
        for (int d0 = 0; d0 < 2; ++d0) { const int d = 32 * d0 + r32; const float og = bf2f(Z[row * ZW + ZOG + h * 64 + d]);
            AO[row * DM + h * 64 + d] = (bf16_t)f2bf(o[d0][r] * li * sigmoidf_(og)); } }
    __builtin_amdgcn_wave_barrier();
}

__device__ __forceinline__ void combine_row(KPR P, const LAS int* tab, int row, int lane) {
    const int* route = (const int*)(P.ws + WS_ROUTE); const bf16_t* YP = (const bf16_t*)(P.ws + WS_YP); float* X = (float*)(P.ws + WS_X1);
    f32x4 v[4]; const f32x4* xr = (const f32x4*)(X + (size_t)row * DM) + lane;
#pragma unroll
    for (int j = 0; j < 4; ++j) v[j] = xr[64 * j];
#pragma unroll
    for (int k = 0; k < 4; ++k) { const int ex = route[(size_t)row * 12 + k], rank = route[(size_t)row * 12 + 4 + k]; const size_t pos = (size_t)tab[pg8::T_BLKSTART + ex] * 256 + rank;
        const u32x2* yr = (const u32x2*)(YP + pos * DM) + lane;
#pragma unroll
        for (int j = 0; j < 4; ++j) { const u32x2 y = yr[64 * j]; v[j][0] += bflo(y.x); v[j][1] += bfhi(y.x); v[j][2] += bflo(y.y); v[j][3] += bfhi(y.y); } }
    f32x4* xo = (f32x4*)(X + (size_t)row * DM) + lane; float s = 0.f;
#pragma unroll
    for (int j = 0; j < 4; ++j) { xo[64 * j] = v[j]; s += (v[j][0] * v[j][0] + v[j][1] * v[j][1]) + (v[j][2] * v[j][2] + v[j][3] * v[j][3]); }
    const float rstd = rsqrtf(wave_sum(s) * (1.f / DM) + 1e-6f);
#pragma unroll
    for (int j = 0; j < 4; ++j) v[j] = v[j] * rstd * ((const f32x4*)P.ple_norm)[64 * j + lane];
    store_row_bf16((bf16_t*)(P.ws + WS_XN) + (size_t)row * DM, lane, v);
}

constexpr int NPHASE = 13;
__global__ void __launch_bounds__(NTHREADS, 2) mega_fwd(Params Pkarg_unused) {
    extern __shared__ __attribute__((aligned(16))) unsigned char smem[];
    LAS unsigned char* lds = (LAS unsigned char*)smem;
    const int tid = threadIdx.x, lane = tid & 63, wave = __builtin_amdgcn_readfirstlane(tid >> 6);
    const int G = gridDim.x, blk = blockIdx.x;
#define P (*kpp)
#ifndef MK_REP
#define MK_REP -1
#endif
#define PHASE_BEGIN(k) if (IN(k)) for (int rep_ = 0; rep_ < ((k) == MK_REP ? 2 : 1); ++rep_) { const __attribute__((address_space(4))) Params* kpp = kp_fresh();
#define PHASE_END(k) } if (BOTH(k)) xcd_barrier(bar);
#define IN(k) (ph_lo <= (k) && (k) < ph_hi)
#define BOTH(k) (IN(k) && IN((k) + 1))
    const __attribute__((address_space(4))) Params* kpp = kp_fresh();
    unsigned* ctl = (unsigned*)(P.ws + WS_CTL);
    volatile LAS unsigned* MISC = (volatile LAS unsigned*)(lds + MISC_OFF);
    LAS int* tab = (LAS int*)(lds + MISC_OFF + MISC_TAB);
    if (tid < 16) MISC[tid] = 0u;
    __syncthreads();
    XcdBarrier bar = xcd_barrier_post(ctl + CW_BAR, MISC);
    unsigned char* const wsb = P.ws;
    const int ph_lo = P.ph_lo, ph_hi = P.ph_hi;

    PHASE_BEGIN(0)
        phase_prep_weights(P, lds, blk * NWAVES + wave, G * NWAVES, wave, lane);
        phase_cvt_p(P, blk * NTHREADS + tid, G * NTHREADS);
        __syncthreads();
        LAS float* wff = (LAS float*)lds; LAS float* lf = (LAS float*)(lds + 32768);
        load_wff(P, wff, tid, NTHREADS); __syncthreads();
        for (int i = 0; i < 16; ++i) { const int rl = wave * 16 + i; norm1_row(P, blk * 128 + rl, lane, wff, lf + rl * 8); }
        __syncthreads();
        if (tid < 8) { float run = 0.f; float* cloc = (float*)(P.ws + WS_LOGF) + (size_t)blk * 128 * 8 + tid;
            for (int r = 0; r < 128; ++r) { run += lf[r * 8 + tid]; cloc[r * 8] = run; }
            ((float*)(P.ws + WS_CTOT))[blk * 8 + tid] = run; }
        if (blk == 0) { bf16_t* zr = (bf16_t*)(P.ws + WS_XN) + (size_t)NTOK * DM; for (int i = tid; i < DM; i += NTHREADS) zr[i] = 0; }
    PHASE_END(0)

    PHASE_BEGIN(1)
        {
            LAS float* pfx = (LAS float*)(lds + MISC_OFF + MISC_PFX);
            if (tid < 8) { float s = 0.f; const float* ct = (const float*)(wsb + WS_CTOT); for (int j = (blk & ~63); j < blk; ++j) s += ct[j * 8 + tid]; pfx[tid] = s; }
            __syncthreads();
            const float* cloc = (const float*)(wsb + WS_LOGF) + (size_t)blk * 128 * 8; float* c2 = (float*)(P.ws + WS_C2);
            for (int i = tid; i < 1024; i += NTHREADS) { const int r = i >> 3, h = i & 7; const int row = blk * 128 + r, b = row >> 13, t = row & (SEQ - 1);
                c2[((size_t)(b * 8 + h)) * SEQ + t] = (cloc[i] + pfx[h]) * LOG2E; }
            __syncthreads();
        }
        {
            pg8::DenseOrder S{(const bf16_t*)(wsb + WS_XN), (const bf16_t*)(wsb + WS_WIN), 1024, NTOK / 256, ZW / 256, G, blk};
            pg8::EpiIn E{(bf16_t*)(P.ws + WS_Z), P.q_norm, P.k_norm};
            pg8::gemm_phase<pg8::EpiIn, pg8::DenseOrder, true>(lds, 1024, S, E);
        }
        {
            pg8::DenseOrder S{(const bf16_t*)((unsigned char*)P.out + DO_PB), (const bf16_t*)(wsb + WS_WPP), PLE, NTOK / 256, DM / 256, G, blk};
            pg8::EpiBf16 E{(bf16_t*)((unsigned char*)P.out + DO_PJ), DM};
            pg8::gemm_phase<pg8::EpiBf16, pg8::DenseOrder, true>(lds, PLE, S, E);
        }
    PHASE_END(1)

    PHASE_BEGIN(2)
        for (int task = wave * G + blk; task < NTOK / 32; task += NWAVES * G) rk::lora_task(P, task, lane);
    PHASE_END(2)

    PHASE_BEGIN(3)
        for (int task = blk; task < NB * NH * rk::NCHUNK; task += G) rk::pass1_chunk(P, lds, task >> 7, task & 127, tid);
    PHASE_END(3)

    PHASE_BEGIN(4)
        if (blk < NB * NH) rk::pass2_seq(P, lds, blk, tid);
        for (;;) {
            __syncthreads();
            if (tid == 0) MISC[MISC_Q / 4] = __hip_atomic_fetch_add(ctl + CW_QATT + 64 * rep_, 1u, RLX_AGENT);
            __syncthreads();
            const int q = (int)MISC[MISC_Q / 4];
            if (q >= 1024) break;
            attn_unit_v2(P, lds, q & 31, 31 - (q >> 5));
        }
    PHASE_END(4)

    PHASE_BEGIN(5)
        for (int task = blk; task < NB * NH * rk::NCHUNK; task += G) rk::pass3_chunk(P, lds, task >> 7, task & 127, tid);
    PHASE_END(5)

    PHASE_BEGIN(6)
        pg8::DenseOrder S{(const bf16_t*)(wsb + WS_AO), (const bf16_t*)(wsb + WS_WOUT), 1024, NTOK / 256, DM / 256, G, blk};
        pg8::EpiOut E{P.x, (float*)(P.ws + WS_X1)};
        pg8::gemm_phase<pg8::EpiOut, pg8::DenseOrder, true>(lds, 1024, S, E);
    PHASE_END(6)

    PHASE_BEGIN(7)
        rt::build_w(P, lds, tid);
        __syncthreads();
        for (int task = wave * G + blk; task < NTOK / 32; task += NWAVES * G) rt::route_task(P, lds, task, lane);
    PHASE_END(7)

    PHASE_BEGIN(8)
        const int nblk = pg8::moe_tables(tab, (const unsigned*)(wsb + WS_CTL) + CW_CNT);
        pg8::MoeOrder S{(const bf16_t*)(wsb + WS_XN), (const bf16_t*)(wsb + WS_WGU), (const int*)(wsb + WS_TOKSLOT), tab, nblk, 8, G, blk, true};
        pg8::EpiGu E{(bf16_t*)(P.ws + WS_ACT), P.b_gu};
        pg8::gemm_phase<pg8::EpiGu, pg8::MoeOrder, true>(lds, 1024, S, E);
    PHASE_END(8)
    PHASE_BEGIN(9)
        const int nblk = pg8::moe_tables(tab, (const unsigned*)(wsb + WS_CTL) + CW_CNT);
        pg8::MoeOrder S{(const bf16_t*)(wsb + WS_ACT), (const bf16_t*)(wsb + WS_WDN), (const int*)(wsb + WS_TOKSLOT), tab, nblk, 4, G, blk, false};
        pg8::EpiDn E{(bf16_t*)(P.ws + WS_YP), P.b_down, (const float*)(wsb + WS_GATESLOT), tab};
        pg8::gemm_phase<pg8::EpiDn, pg8::MoeOrder, true>(lds, 1024, S, E);
    PHASE_END(9)
    PHASE_BEGIN(10)
        (void)pg8::moe_tables(tab, (const unsigned*)(wsb + WS_CTL) + CW_CNT);
        for (int row = blk * NWAVES + wave; row < NTOK; row += G * NWAVES) combine_row(P, tab, row, lane);
    PHASE_END(10)
    PHASE_BEGIN(11)
        pg8::DenseOrder S{(const bf16_t*)(wsb + WS_XN), (const bf16_t*)(wsb + WS_WPG), 1024, NTOK / 256, DM / 256, G, blk};
        pg8::EpiPg E{(float*)(P.ws + WS_X1), (const bf16_t*)((unsigned char*)P.out + DO_PJ)};
        pg8::gemm_phase<pg8::EpiPg, pg8::DenseOrder, true>(lds, 1024, S, E);
    PHASE_END(11)
    PHASE_BEGIN(12)
        const bool dead = __hip_atomic_load(ctl + CW_BAR + XB_TMO, RLX_AGENT) != 0u;
        for (int row = blk * NWAVES + wave; row < NTOK; row += G * NWAVES) final_row(P, row, lane, dead);
    PHASE_END(12)
}
#undef P
extern "C" void kernel_launch(void* const* d_in, const int* in_sizes, int n_in, void* d_out, int out_size, void* d_ws, size_t ws_size, hipStream_t stream) {
    static int ok = 0;
    if (ok == 0) {
        if (n_in != 30 || in_sizes[0] != NTOK * DM || out_size != NTOK * DM || ws_size < WS_END) { fprintf(stderr, "kernel_launch: unexpected shapes (n_in %d, ws %zu)\n", n_in, ws_size); ok = -1; return; }
        if (hipFuncSetAttribute((const void*)mega_fwd, hipFuncAttributeMaxDynamicSharedMemorySize, LDS_BYTES) != hipSuccess) { fprintf(stderr, "kernel_launch: hipFuncSetAttribute failed\n"); ok = -1; return; }
        int dev = 0, cus = 0, per_cu = 0;
        if (hipGetDevice(&dev) != hipSuccess || hipDeviceGetAttribute(&cus, hipDeviceAttributeMultiprocessorCount, dev) != hipSuccess) { ok = -1; return; }
        if (hipOccupancyMaxActiveBlocksPerMultiprocessor(&per_cu, (const void*)mega_fwd, NTHREADS, LDS_BYTES) != hipSuccess || per_cu < 1) { fprintf(stderr, "kernel_launch: occupancy query says %d\n", per_cu); }
        (void)hipGetLastError();
        if (cus != 256) { fprintf(stderr, "kernel_launch: built for 256 CUs, device has %d\n", cus); ok = -1; return; }
        ok = 1;
    }
    if (ok < 0) return;
    Params P{};
    const float** pp = (const float**)&P;
    for (int i = 0; i < 30; ++i) pp[i] = (const float*)d_in[i];
    P.out = (float*)d_out; P.ws = (unsigned char*)d_ws;
    if (hipMemsetAsync((char*)d_ws + WS_CTL, 0, CTL_BYTES, stream) != hipSuccess) return;
#ifndef MK_CUTS
#define MK_CUTS 0
#endif
    if (MK_CUTS == 0) { P.ph_lo = 0; P.ph_hi = NPHASE; hipLaunchKernelGGL(mega_fwd, dim3(256), dim3(NTHREADS), LDS_BYTES, stream, P); }
    else for (int k = 0; k < NPHASE; ++k) { P.ph_lo = k; P.ph_hi = k + 1;
        hipLaunchKernelGGL(mega_fwd, dim3(256), dim3(NTHREADS), LDS_BYTES, stream, P); }
}
```

```cpp
#include <hip/hip_runtime.h>
#include <cstdio>
#include <cstdint>

#define LAS __attribute__((address_space(3)))
#define GAS __attribute__((address_space(1)))
typedef unsigned short bf16_t;
typedef short bf16x8 __attribute__((ext_vector_type(8)));
typedef float f32x2 __attribute__((ext_vector_type(2)));
typedef float f32x4 __attribute__((ext_vector_type(4)));
typedef float f32x16 __attribute__((ext_vector_type(16)));
typedef unsigned u32x2 __attribute__((ext_vector_type(2)));
typedef unsigned u32x4 __attribute__((ext_vector_type(4)));

constexpr int NB = 4, SEQ = 8192, NTOK = NB * SEQ, DM = 1024;
constexpr int NH = 8, HD = 64;
constexpr int INW = 3848;
constexpr int ZW = 3840;
constexpr int ZQ = 0, ZK = 512, ZV = 1024, ZOG = 1536, ZR = 2048;
constexpr int RW_R = 0, RW_K = 512, RW_V = 1024, RW_W = 1536, RW_A = 1600, RW_G = 1664, RWIN = 1792;
constexpr int NE = 32, TOPK = 4, EFF = 1024;
constexpr int MAXBLK = (NTOK * TOPK) / 256 + NE;
constexpr int PLE = 256;
constexpr float LOG2E = 1.4426950408889634f;
constexpr float QSCALE = 0.125f * LOG2E;

constexpr size_t MiB = 1u << 20;
constexpr size_t WS_CTL = 0, CTL_BYTES = 1 * MiB;
constexpr size_t WS_C2 = 1 * MiB;
constexpr size_t WS_LOGF = 2 * MiB;
constexpr size_t WS_ROUTE = 3 * MiB;
constexpr size_t WS_TOKSLOT = 5 * MiB;
constexpr size_t WS_GATESLOT = 9 * MiB;
constexpr size_t WS_CTOT = 13 * MiB;
constexpr size_t WS_WIN = 16 * MiB;
constexpr size_t WS_WOUT = 24 * MiB;
constexpr size_t WS_WPG = 26 * MiB;
constexpr size_t WS_WPP = 28 * MiB;
constexpr size_t WS_WGU = 32 * MiB;
constexpr size_t WS_WDN = 160 * MiB;
constexpr size_t WS_XN = 224 * MiB;
constexpr size_t WS_X1 = 290 * MiB;
constexpr size_t WS_Z = 418 * MiB;
constexpr size_t WS_AO = 658 * MiB;
constexpr size_t WS_ACT = 418 * MiB;
constexpr size_t WS_RW = 722 * MiB;
constexpr size_t WS_RR = WS_RW, WS_RK = WS_RW + 32 * MiB, WS_RV = WS_RW + 64 * MiB, WS_RG = WS_RW + 96 * MiB;
constexpr size_t WS_RLW = WS_RW + 128 * MiB;
constexpr size_t WS_RKK = WS_RW + 160 * MiB, WS_RKA = WS_RW + 192 * MiB;
constexpr size_t WS_YP = 722 * MiB;
constexpr size_t WS_END = 994 * MiB;
static_assert(WS_ACT + (size_t)MAXBLK * 256 * 1024 * 2 <= WS_RW && WS_YP + (size_t)MAXBLK * 256 * 1024 * 2 <= WS_END, "ws map");
constexpr size_t DO_PJ = 0, DO_PB = 64 * MiB;
constexpr int CW_TMO = 0, CW_CNT = 64  , CW_BAR = 4096;

struct Params {
    const float *x, *p, *mix_norm, *w_in, *f_bias, *q_norm, *k_norm, *mu, *w0, *w2, *a0, *a2, *g2, *k_k, *k_a, *r_k, *ln_w, *ln_b, *w_out, *moe_norm, *w_router, *b_router, *w_gu, *b_gu, *w_down,
        *b_down, *ple_norm, *w_pg, *w_pp, *final_norm;
    float* out; unsigned char* ws; int ph_lo, ph_hi;
};

typedef const __attribute__((address_space(4))) Params& KPR;
__device__ __forceinline__ const __attribute__((address_space(4))) Params* kp_fresh() {
    unsigned long long p = (unsigned long long)__builtin_amdgcn_kernarg_segment_ptr(); asm volatile("" : "+s"(p)); return (const __attribute__((address_space(4))) Params*)p; }

__device__ __forceinline__ unsigned f2bf(float f) { unsigned u = __builtin_bit_cast(unsigned, f); return (u + 0x7fffu + ((u >> 16) & 1u)) >> 16; }
__device__ __forceinline__ unsigned pk2(float lo, float hi) { return f2bf(lo) | (f2bf(hi) << 16); }
__device__ __forceinline__ float bf2f(unsigned h) { return __builtin_bit_cast(float, h << 16); }
__device__ __forceinline__ float bflo(unsigned w) { return __builtin_bit_cast(float, w << 16); }
__device__ __forceinline__ float bfhi(unsigned w) { return __builtin_bit_cast(float, w & 0xffff0000u); }
__device__ __forceinline__ unsigned cvt_pk_bf16(float lo, float hi) { unsigned r; asm volatile("v_cvt_pk_bf16_f32 %0, %1, %2" : "=v"(r) : "v"(lo), "v"(hi)); return r; }
__device__ __forceinline__ float wave_sum(float v) {
#pragma unroll
    for (int o = 1; o < 64; o <<= 1) v += __shfl_xor(v, o);
    return v;
}
__device__ __forceinline__ float sigmoidf_(float x) { return 1.0f / (1.0f + __expf(-x)); }
__device__ __forceinline__ float logsigmoidf_(float x) { return fminf(x, 0.f) - log1pf(expf(-fabsf(x))); }
namespace pg8 {
constexpr int BM = 256, BK = 64, HALF = 128, HTB = HALF * BK * 2, STAGE_BYTES = 8 * HTB, NXCD = 8, WGM = 8;
__host__ __device__ __forceinline__ int lds_byte(int r, int c) { const int st = (r >> 4) * 2 + (c >> 5), rr = r & 15, cc = c & 31, ob = rr * 64 + cc * 2; return st * 1024 + (ob ^ (((ob >> 9) & 1) << 5)); }
__host__ __device__ __forceinline__ void stage_rc(int b, int& R, int& C) { const int st = b / 1024, sb = b % 1024, swz = sb ^ (((sb >> 9) & 1) << 5); R = (st >> 1) * 16 + swz / 64; C = (st & 1) * 32 + (swz % 64) / 2; }
__host__ __device__ __forceinline__ int perm32(int rho) { const int n = rho >> 4, i = rho & 15; return 8 * (i >> 2) + 4 * n + (i & 3); }

struct Unit { int pm, pn, e, lb, sl; };

__device__ __forceinline__ bool tile_order(int i, int G, int c, int nM, int nN, int& pm, int& pn) {
    const int nwg = nM * nN; const long L = (long)i * G + c; if (L >= nwg) return false;
    int wgid = (int)L; { const int q = nwg / NXCD, r = nwg % NXCD, xcd = wgid % NXCD, off = wgid / NXCD; wgid = (xcd < r ? xcd * (q + 1) : r * (q + 1) + (xcd - r) * q) + off; }
    const int nig = WGM * nN, gid = wgid / nig, fm = gid * WGM, gsz = (nM - fm) < WGM ? (nM - fm) : WGM;
    pm = fm + ((wgid % nig) % gsz); pn = (wgid % nig) / gsz; return true;
}
struct DenseOrder {
    const bf16_t* A; const bf16_t* Bt; int K, nM, nN, G, c;
    __device__ __forceinline__ bool next(int i, Unit& u) const { u.e = 0; u.lb = 0; return tile_order(i, G, c, nM, nN, u.pm, u.pn); }
    __device__ __forceinline__ const char* a_base(const Unit& u) const { return (const char*)A + (size_t)u.pm * BM * K * 2; }
    __device__ __forceinline__ const char* b_base(const Unit& u) const { return (const char*)Bt + (size_t)u.pn * BM * K * 2; }
    __device__ __forceinline__ void prefetch(const Unit&, int, int, int) const {}
    __device__ __forceinline__ void a_off(const Unit&, const int (&R)[2], const int (&C)[2], unsigned (&off)[2][2]) const {
#pragma unroll
        for (int h = 0; h < 2; ++h)
#pragma unroll
            for (int i = 0; i < 2; ++i) off[h][i] = (unsigned)((R[i] + HALF * h) * K + C[i]) * 2u;
    }
};

template <class Epi, class Sched, bool ALIGN_EPI>
__device__ __forceinline__ void gemm_phase(LAS unsigned char* lds, const int K, const Sched& S, const Epi& E) {
    int tid_ = threadIdx.x; asm volatile("" : "+v"(tid_));
    const int tid = tid_, wid = __builtin_amdgcn_readfirstlane(tid >> 6), lane = tid & 63, wr = wid >> 2, wc = wid & 3, fr = lane & 15, fq = lane >> 4;
    const int nt = K / BK;
    int sR[2], sC[2]; unsigned voffB[2];
#pragma unroll
    for (int i = 0; i < 2; ++i) { int R, C; stage_rc(tid * 16 + i * 8192, R, C); const int Rb = Epi::PERM ? ((R & ~31) + perm32(R & 31)) : R; sR[i] = R; sC[i] = C; voffB[i] = (unsigned)(Rb * K + C) * 2u; }
    const size_t kstep = (size_t)(BK * 2);
    const size_t hstep = (size_t)HALF * K * 2;
    const unsigned ldsw = (unsigned)wid * 1024u;
    const int aoff = lds_byte(wr * 64 + fr, fq * 8), boff = lds_byte(wc * 32 + fr, fq * 8);
#define PG8_SA(b, h) (((b) * 2 + (h)) * HTB)
#define PG8_SB(b, h) ((4 + (b) * 2 + (h)) * HTB)
#define PG8_STAGE(bufoff, gbase, voff) do { _Pragma("unroll") for (int _i = 0; _i < 2; ++_i) \
        __builtin_amdgcn_global_load_lds((const unsigned*)((const char*)(gbase) + (voff)[_i]), (LAS unsigned*)(lds + (bufoff) + ldsw + _i * 8192), 16, 0, 0); } while (0)
#define PG8_LDA(dst, b, h) do { _Pragma("unroll") for (int m = 0; m < 4; ++m) _Pragma("unroll") for (int k = 0; k < 2; ++k) dst[m][k] = *(const LAS bf16x8*)(lds + PG8_SA(b, h) + aoff + m * 2048 + k * 1024); } while (0)
#define PG8_LDB(dst, b, h) do { _Pragma("unroll") for (int n = 0; n < 2; ++n) _Pragma("unroll") for (int k = 0; k < 2; ++k) dst[n][k] = *(const LAS bf16x8*)(lds + PG8_SB(b, h) + boff + n * 2048 + k * 1024); } while (0)
#define PG8_MMA(ai, bj, At, Bt) do { __builtin_amdgcn_s_setprio(1); _Pragma("unroll") for (int m = 0; m < 4; ++m) _Pragma("unroll") for (int n = 0; n < 2; ++n) _Pragma("unroll") for (int k = 0; k < 2; ++k) \
        acc[ai][bj][m][n] = __builtin_amdgcn_mfma_f32_16x16x32_bf16(Bt[n][k], At[m][k], acc[ai][bj][m][n], 0, 0, 0); __builtin_amdgcn_s_setprio(0); } while (0)
#define PG8_WAIT_V(n) asm volatile("s_waitcnt vmcnt(" #n ")" ::: "memory")
#define PG8_WAIT_L(n) asm volatile("s_waitcnt lgkmcnt(" #n ")" ::: "memory")
#define PG8_BAR __builtin_amdgcn_s_barrier()
#define PG8_SCHED __builtin_amdgcn_sched_barrier(0)
    Unit cur, nxt; int ui = 0;
    if (!S.next(0, cur)) return;
    f32x4 acc[2][2][4][2];
#pragma unroll
    for (int a = 0; a < 2; ++a)
#pragma unroll
        for (int b = 0; b < 2; ++b)
#pragma unroll
            for (int m = 0; m < 4; ++m)
#pragma unroll
                for (int n = 0; n < 2; ++n) acc[a][b][m][n] = (f32x4){0.f, 0.f, 0.f, 0.f};
    bf16x8 At[4][2], B0[2][2], B1[2][2];
    unsigned offC[2][2], offN[2][2];
    cur.sl = 0; S.prefetch(cur, 0, wid, lane); PG8_WAIT_V(0); PG8_BAR;
    S.a_off(cur, sR, sC, offC);
    const char* cA = S.a_base(cur); const char* cB = S.b_base(cur);
    PG8_STAGE(PG8_SB(0, 0), cB, voffB); PG8_STAGE(PG8_SB(0, 1), cB + hstep, voffB); PG8_STAGE(PG8_SA(0, 0), cA, offC[0]); PG8_STAGE(PG8_SA(0, 1), cA, offC[1]);
    if (wr == 1) PG8_BAR;
    PG8_WAIT_V(2); PG8_BAR;
    PG8_STAGE(PG8_SB(1, 0), cB + kstep, voffB); PG8_STAGE(PG8_SA(1, 0), cA + kstep, offC[0]); PG8_STAGE(PG8_SB(1, 1), cB + hstep + kstep, voffB);
    PG8_WAIT_V(6); PG8_BAR;
    for (;;) {
        const bool has_next = S.next(ui + 1, nxt);
        const char* nA = cA; const char* nB = cB;
        nxt.sl = cur.sl == 2 ? 0 : cur.sl + 1;
        if (has_next) { nA = S.a_base(nxt); nB = S.b_base(nxt); S.prefetch(nxt, nxt.sl, wid, lane); }
#pragma unroll
        for (int h = 0; h < 2; ++h)
#pragma unroll
            for (int i = 0; i < 2; ++i) offN[h][i] = offC[h][i];
#pragma nounroll
        for (int t = 0; t < nt; t += 2) {
            const bool last = (t == nt - 2);
            if (last && has_next) S.a_off(nxt, sR, sC, offN);
            const char* a1 = cA + (size_t)(t + 1) * kstep;
            const char* a2 = last ? nA : cA + (size_t)(t + 2) * kstep; const char* b2 = last ? nB : cB + (size_t)(t + 2) * kstep;
            const char* a3 = a2 + kstep; const char* b3 = b2 + kstep;
            unsigned o2[2][2];
#pragma unroll
            for (int h = 0; h < 2; ++h)
#pragma unroll
                for (int i = 0; i < 2; ++i) o2[h][i] = last ? offN[h][i] : offC[h][i];
            PG8_LDB(B0, 0, 0); PG8_LDB(B1, 0, 1); PG8_SCHED; PG8_LDA(At, 0, 0); PG8_STAGE(PG8_SA(1, 1), a1, offC[1]);
            PG8_WAIT_V(8); PG8_WAIT_L(0); PG8_BAR; PG8_MMA(0, 0, At, B0); PG8_MMA(0, 1, At, B1); PG8_BAR; PG8_SCHED;
            PG8_LDA(At, 0, 1); PG8_STAGE(PG8_SB(0, 0), b2, voffB); PG8_STAGE(PG8_SB(0, 1), b2 + hstep, voffB); PG8_STAGE(PG8_SA(0, 0), a2, o2[0]);
            PG8_WAIT_V(8); PG8_WAIT_L(0); PG8_BAR; PG8_MMA(1, 0, At, B0); PG8_MMA(1, 1, At, B1); PG8_BAR; PG8_SCHED;
            PG8_LDB(B0, 1, 0); PG8_LDB(B1, 1, 1); PG8_SCHED; PG8_LDA(At, 1, 0); PG8_STAGE(PG8_SA(0, 1), a2, o2[1]);
            PG8_WAIT_V(8); PG8_WAIT_L(0); PG8_BAR; PG8_MMA(0, 0, At, B0); PG8_MMA(0, 1, At, B1); PG8_BAR; PG8_SCHED;
            PG8_LDA(At, 1, 1); PG8_STAGE(PG8_SB(1, 0), b3, voffB); PG8_STAGE(PG8_SB(1, 1), b3 + hstep, voffB); PG8_STAGE(PG8_SA(1, 0), a3, o2[0]);
            PG8_WAIT_V(8); PG8_WAIT_L(0); PG8_BAR; PG8_MMA(1, 0, At, B0); PG8_MMA(1, 1, At, B1); PG8_BAR; PG8_SCHED;
        }
        if constexpr (ALIGN_EPI) { if (wr == 0) PG8_BAR; }
        E(acc, cur, wr, wc, fr, fq);
        if (!has_next) break;
#pragma unroll
        for (int a = 0; a < 2; ++a)
#pragma unroll
            for (int b = 0; b < 2; ++b)
#pragma unroll
                for (int m = 0; m < 4; ++m)
#pragma unroll
                    for (int n = 0; n < 2; ++n) acc[a][b][m][n] = (f32x4){0.f, 0.f, 0.f, 0.f};
        cur = nxt; cA = nA; cB = nB; ++ui;
#pragma unroll
        for (int h = 0; h < 2; ++h)
#pragma unroll
            for (int i = 0; i < 2; ++i) offC[h][i] = offN[h][i];
        if constexpr (ALIGN_EPI) { if (wr == 1) PG8_BAR; }
    }
    PG8_WAIT_V(0);
    if constexpr (!ALIGN_EPI) { if (wr == 0) PG8_BAR; }
    PG8_BAR;
#undef PG8_SA
#undef PG8_SB
#undef PG8_STAGE
#undef PG8_LDA
#undef PG8_LDB
#undef PG8_MMA
#undef PG8_WAIT_V
#undef PG8_WAIT_L
#undef PG8_BAR
#undef PG8_SCHED
}
}
namespace pg8 {
constexpr int T_BLKSTART = 0  , T_CNT = 40  , T_BLKE = 80  , T_WORDS = 80 + 560;
constexpr int TB_OFF = 8192 - 64;

struct EpiIn {
    static constexpr bool PERM = true;
    bf16_t* Z; const float* qn; const float* kn;
    __device__ __forceinline__ void operator()(const f32x4 (&acc)[2][2][4][2], const Unit& u, int wr, int wc, int fr, int fq) const {
        const int row0 = u.pm * BM + wr * 64 + fr;
        if (u.pn < 4) {
            const float* g = (u.pn < 2) ? qn : kn; const float sc = (u.pn < 2) ? QSCALE : 1.0f;
            f32x4 gv[2][2];
#pragma unroll
            for (int bj = 0; bj < 2; ++bj)
#pragma unroll
                for (int n = 0; n < 2; ++n) gv[bj][n] = *(const f32x4*)(g + 32 * bj + 8 * fq + 4 * n) * sc;
#pragma unroll
            for (int ai = 0; ai < 2; ++ai)
#pragma unroll
                for (int m = 0; m < 4; ++m) {
                    float ss = 0.f;
#pragma unroll
                    for (int bj = 0; bj < 2; ++bj)
#pragma unroll
                        for (int n = 0; n < 2; ++n) { const f32x4 x = acc[ai][bj][m][n]; ss += (x[0] * x[0] + x[1] * x[1]) + (x[2] * x[2] + x[3] * x[3]); }
                    ss += __shfl_xor(ss, 16); ss += __shfl_xor(ss, 32);
                    const float rstd = rsqrtf(ss * (1.0f / 64.0f) + 1e-6f);
                    bf16_t* rowp = Z + (size_t)(row0 + ai * HALF + m * 16) * ZW + u.pn * BM + 64 * wc + 8 * fq;
#pragma unroll
                    for (int bj = 0; bj < 2; ++bj) { const f32x4 v0 = acc[ai][bj][m][0] * rstd * gv[bj][0], v1 = acc[ai][bj][m][1] * rstd * gv[bj][1];
                        u32x4 w; w.x = cvt_pk_bf16(v0[0], v0[1]); w.y = cvt_pk_bf16(v0[2], v0[3]); w.z = cvt_pk_bf16(v1[0], v1[1]); w.w = cvt_pk_bf16(v1[2], v1[3]);
                        *(u32x4*)(rowp + 32 * bj) = w; }
                }
        } else {
            const int col0 = u.pn * BM + wc * 32 + 8 * fq;
#pragma unroll
            for (int ai = 0; ai < 2; ++ai)
#pragma unroll
                for (int m = 0; m < 4; ++m) { bf16_t* rowp = Z + (size_t)(row0 + ai * HALF + m * 16) * ZW + col0;
#pragma unroll
                    for (int bj = 0; bj < 2; ++bj) { const f32x4 v0 = acc[ai][bj][m][0], v1 = acc[ai][bj][m][1];
                        u32x4 w; w.x = cvt_pk_bf16(v0[0], v0[1]); w.y = cvt_pk_bf16(v0[2], v0[3]); w.z = cvt_pk_bf16(v1[0], v1[1]); w.w = cvt_pk_bf16(v1[2], v1[3]);
                        *(u32x4*)(rowp + bj * HALF) = w; } }
        }
    }
};
struct EpiBf16 {
    static constexpr bool PERM = true;
    bf16_t* O; int ldc;
    __device__ __forceinline__ void operator()(const f32x4 (&acc)[2][2][4][2], const Unit& u, int wr, int wc, int fr, int fq) const {
        const int row0 = u.pm * BM + wr * 64 + fr, col0 = u.pn * BM + wc * 32 + 8 * fq;
#pragma unroll
        for (int ai = 0; ai < 2; ++ai)
#pragma unroll
            for (int m = 0; m < 4; ++m) { bf16_t* rowp = O + (size_t)(row0 + ai * HALF + m * 16) * ldc + col0;
#pragma unroll
                for (int bj = 0; bj < 2; ++bj) { const f32x4 v0 = acc[ai][bj][m][0], v1 = acc[ai][bj][m][1];
                    u32x4 w; w.x = cvt_pk_bf16(v0[0], v0[1]); w.y = cvt_pk_bf16(v0[2], v0[3]); w.z = cvt_pk_bf16(v1[0], v1[1]); w.w = cvt_pk_bf16(v1[2], v1[3]);
                    *(u32x4*)(rowp + bj * HALF) = w; } }
    }
};
struct EpiOut {
    static constexpr bool PERM = false;
    const float* X; float* O;
    __device__ __forceinline__ void operator()(const f32x4 (&acc)[2][2][4][2], const Unit& u, int wr, int wc, int fr, int fq) const {
        const int row0 = u.pm * BM + wr * 64 + fr, col0 = u.pn * BM + wc * 32 + 4 * fq;
#pragma unroll
        for (int ai = 0; ai < 2; ++ai)
#pragma unroll
            for (int m = 0; m < 4; ++m) { const size_t off = (size_t)(row0 + ai * HALF + m * 16) * DM + col0;
#pragma unroll
                for (int bj = 0; bj < 2; ++bj)
#pragma unroll
                    for (int n = 0; n < 2; ++n) *(f32x4*)(O + off + bj * HALF + n * 16) = *(const f32x4*)(X + off + bj * HALF + n * 16) + acc[ai][bj][m][n];
                if (m & 1) asm volatile("" ::: "memory"); }
    }
};
struct EpiPg {
    static constexpr bool PERM = false;
    float* X; const bf16_t* PJ;
    __device__ __forceinline__ void operator()(const f32x4 (&acc)[2][2][4][2], const Unit& u, int wr, int wc, int fr, int fq) const {
        const int row0 = u.pm * BM + wr * 64 + fr, col0 = u.pn * BM + wc * 32 + 4 * fq;
#pragma unroll
        for (int ai = 0; ai < 2; ++ai)
#pragma unroll
            for (int m = 0; m < 4; ++m) { const size_t off = (size_t)(row0 + ai * HALF + m * 16) * DM + col0;
#pragma unroll
                for (int bj = 0; bj < 2; ++bj)
#pragma unroll
                    for (int n = 0; n < 2; ++n) { const size_t o = off + bj * HALF + n * 16; const u32x2 pj = *(const u32x2*)(PJ + o); const f32x4 a = acc[ai][bj][m][n]; const f32x4 xv = *(const f32x4*)(X + o);
                        f32x4 r; r[0] = xv[0] + sigmoidf_(a[0]) * bflo(pj.x); r[1] = xv[1] + sigmoidf_(a[1]) * bfhi(pj.x); r[2] = xv[2] + sigmoidf_(a[2]) * bflo(pj.y); r[3] = xv[3] + sigmoidf_(a[3]) * bfhi(pj.y);
                        *(f32x4*)(X + o) = r; }
                if (m & 1) asm volatile("" ::: "memory"); }
    }
};
struct EpiGu {
    static constexpr bool PERM = true;
    bf16_t* ACT; const float* b_gu;
    __device__ __forceinline__ void operator()(const f32x4 (&acc)[2][2][4][2], const Unit& u, int wr, int wc, int fr, int fq) const {
        const int row0 = u.pm * BM + wr * 64 + fr, cl = u.pn * HALF + wc * 32 + 8 * fq;
        const float* bg = b_gu + (size_t)u.e * 2048 + cl;
        f32x4 bgl[2], bli[2];
#pragma unroll
        for (int n = 0; n < 2; ++n) { bgl[n] = *(const f32x4*)(bg + 4 * n); bli[n] = *(const f32x4*)(bg + 1024 + 4 * n); }
#pragma unroll
        for (int ai = 0; ai < 2; ++ai)
#pragma unroll
            for (int m = 0; m < 4; ++m) { bf16_t* rowp = ACT + (size_t)(row0 + ai * HALF + m * 16) * EFF + cl; float r[8];
#pragma unroll
                for (int n = 0; n < 2; ++n)
#pragma unroll
                    for (int i = 0; i < 4; ++i) { const float gl = fminf(acc[ai][0][m][n][i] + bgl[n][i], 7.0f); const float li = fminf(fmaxf(acc[ai][1][m][n][i] + bli[n][i], -7.0f), 7.0f);
                        r[4 * n + i] = gl * sigmoidf_(1.702f * gl) * (li + 1.0f); }
                u32x4 w; w.x = cvt_pk_bf16(r[0], r[1]); w.y = cvt_pk_bf16(r[2], r[3]); w.z = cvt_pk_bf16(r[4], r[5]); w.w = cvt_pk_bf16(r[6], r[7]);
                *(u32x4*)rowp = w; }
    }
};
struct EpiDn {
    static constexpr bool PERM = true;
    bf16_t* YP; const float* b_dn; const float* gateslot; const LAS int* tab;
    __device__ __forceinline__ void operator()(const f32x4 (&acc)[2][2][4][2], const Unit& u, int wr, int wc, int fr, int fq) const {
        const int row0 = u.pm * BM + wr * 64 + fr, col0 = u.pn * BM + wc * 32 + 8 * fq;
        const float* bd = b_dn + (size_t)u.e * 1024 + col0; const int cnt = tab[T_CNT + u.e];
        f32x4 bv[2][2];
#pragma unroll
        for (int bj = 0; bj < 2; ++bj)
#pragma unroll
            for (int n = 0; n < 2; ++n) bv[bj][n] = *(const f32x4*)(bd + bj * HALF + 4 * n);
#pragma unroll
        for (int ai = 0; ai < 2; ++ai)
#pragma unroll
            for (int m = 0; m < 4; ++m) { const int rr = wr * 64 + fr + ai * HALF + m * 16, slot = u.lb * 256 + rr;
                const float gt = slot < cnt ? ((const LAS float*)((const LAS unsigned char*)tab + TB_OFF + u.sl * 1024))[rr] : 0.f;
                bf16_t* rowp = YP + (size_t)(row0 + ai * HALF + m * 16) * DM + col0;
#pragma unroll
                for (int bj = 0; bj < 2; ++bj) { const f32x4 v0 = (acc[ai][bj][m][0] + bv[bj][0]) * gt, v1 = (acc[ai][bj][m][1] + bv[bj][1]) * gt;
                    u32x4 w; w.x = cvt_pk_bf16(v0[0], v0[1]); w.y = cvt_pk_bf16(v0[2], v0[3]); w.z = cvt_pk_bf16(v1[0], v1[1]); w.w = cvt_pk_bf16(v1[2], v1[3]);
                    *(u32x4*)(rowp + bj * HALF) = w; } }
    }
};
struct MoeOrder {
    const bf16_t* A; const bf16_t* Bt; const int* tokslot; const float* gateslot; const LAS int* tab; int nblk, nN, G, c; bool gather;
    __device__ __forceinline__ bool next(int i, Unit& u) const { if (!tile_order(i, G, c, nblk, nN, u.pm, u.pn)) return false; u.e = tab[T_BLKE + u.pm]; u.lb = u.pm - tab[T_BLKSTART + u.e]; return true; }
    __device__ __forceinline__ const char* a_base(const Unit& u) const { return gather ? (const char*)A : (const char*)A + (size_t)u.pm * BM * 1024 * 2; }
    __device__ __forceinline__ const char* b_base(const Unit& u) const { return (const char*)Bt + ((size_t)u.e * nN + u.pn) * BM * 1024 * 2; }
    __device__ __forceinline__ void prefetch(const Unit& u, int slot, int wid, int lane) const {
        if (wid < 4) { const unsigned* src = (gather ? (const unsigned*)tokslot : (const unsigned*)gateslot) + (size_t)u.e * NTOK + u.lb * 256 + wid * 64 + lane;
            __builtin_amdgcn_global_load_lds(src, (LAS unsigned*)((LAS unsigned char*)tab + TB_OFF + slot * 1024 + wid * 256), 4, 0, 0); }
    }
    __device__ __forceinline__ void a_off(const Unit& u, const int (&R)[2], const int (&C)[2], unsigned (&off)[2][2]) const {
        const int cnt = tab[T_CNT + u.e]; const LAS int* tb = (const LAS int*)((const LAS unsigned char*)tab + TB_OFF + u.sl * 1024);
#pragma unroll
        for (int h = 0; h < 2; ++h)
#pragma unroll
            for (int i = 0; i < 2; ++i) {
                if (gather) { const int rr = R[i] + HALF * h; const int tk = tb[rr]; const int tok = (u.lb * 256 + rr) < cnt ? tk : NTOK; off[h][i] = (unsigned)tok * 2048u + (unsigned)C[i] * 2u; }
                else off[h][i] = (unsigned)((R[i] + HALF * h) * 1024 + C[i]) * 2u;
            }
    }
};
__device__ __forceinline__ int moe_tables(LAS int* tab, const unsigned* cntw) {
    if (threadIdx.x == 0) { int s = 0; for (int e = 0; e < NE; ++e) { const int c = (int)cntw[e]; tab[T_CNT + e] = c; tab[T_BLKSTART + e] = s; const int nb = (c + 255) >> 8; for (int j = 0; j < nb; ++j) tab[T_BLKE + s + j] = e; s += nb; } tab[T_BLKSTART + NE] = s; }
    __syncthreads();
    return tab[T_BLKSTART + NE];
}
}
constexpr int NWAVES = 8, NTHREADS = 512;
constexpr int RING_BYTES = 131072, MISC_OFF = RING_BYTES, LDS_BYTES = 147456;

__device__ __forceinline__ void tr_item(const float* W, int ldw, int srccol0, int k0, bf16_t* WT, int Kd, int dstrow0, LAS float* scr, int lane) {
#pragma unroll 8
    for (int i = 0; i < 32; ++i) { const int kk = 2 * i + (lane >> 5); scr[kk * 33 + (lane & 31)] = W[(size_t)(k0 + kk) * ldw + srccol0 + (lane & 31)]; }
    asm volatile("s_waitcnt lgkmcnt(0)" ::: "memory");
    const int c = lane & 7;
#pragma unroll
    for (int j = 0; j < 4; ++j) { const int n = (lane >> 3) + 8 * j; const LAS float* s = scr + (8 * c) * 33 + n;
        u32x4 o; o.x = pk2(s[0 * 33], s[1 * 33]); o.y = pk2(s[2 * 33], s[3 * 33]); o.z = pk2(s[4 * 33], s[5 * 33]); o.w = pk2(s[6 * 33], s[7 * 33]);
        *(u32x4*)(WT + (size_t)(dstrow0 + n) * Kd + k0 + 8 * c) = o; }
    asm volatile("s_waitcnt lgkmcnt(0)" ::: "memory");
}
constexpr int I_IN = 16 * 120, I_OUT = 16 * 32, I_PG = 16 * 32, I_PP = 4 * 32, I_GU1 = 16 * 64, I_DN1 = 16 * 32;
constexpr int I_LORA = 16 + 16 + 32;
constexpr int I_SMALL = I_IN + I_OUT + I_PG + I_PP + I_LORA, I_GU = NE * I_GU1, I_DN = NE * I_DN1, I_ALL = I_SMALL + I_GU + I_DN;
__device__ __forceinline__ void prep_item(KPR P, int it, LAS float* scr, int lane) {
    unsigned char* ws = P.ws;
    if (it < I_IN) { const int kb = it / 120, nb = it % 120, n0 = nb * 32, pn = n0 >> 8, j0 = n0 & 255;
        const int src = pn < 4 ? (pn * 256 + 64 * ((j0 & 127) >> 5) + 32 * (j0 >> 7)) : (n0 < 2048 ? n0 : n0 + 8);
        tr_item(P.w_in, INW, src, kb * 64, (bf16_t*)(ws + WS_WIN), 1024, n0, scr, lane); return; }
    it -= I_IN;
    if (it < I_OUT) { tr_item(P.w_out, 1024, (it % 32) * 32, (it / 32) * 64, (bf16_t*)(ws + WS_WOUT), 1024, (it % 32) * 32, scr, lane); return; }
    it -= I_OUT;
    if (it < I_PG) { tr_item(P.w_pg, 1024, (it % 32) * 32, (it / 32) * 64, (bf16_t*)(ws + WS_WPG), 1024, (it % 32) * 32, scr, lane); return; }
    it -= I_PG;
    if (it < I_PP) { tr_item(P.w_pp, 1024, (it % 32) * 32, (it / 32) * 64, (bf16_t*)(ws + WS_WPP), 256, (it % 32) * 32, scr, lane); return; }
    it -= I_PP;
    if (it < 16) { tr_item(P.w2, 512, it * 32, 0, (bf16_t*)(ws + 29 * MiB), 64, it * 32, scr, lane); return; }
    it -= 16;
    if (it < 16) { tr_item(P.a2, 512, it * 32, 0, (bf16_t*)(ws + 29 * MiB + 65536), 64, it * 32, scr, lane); return; }
    it -= 16;
    if (it < 32) { tr_item(P.g2, 512, (it % 16) * 32, (it / 16) * 64, (bf16_t*)(ws + 29 * MiB + 131072), 128, (it % 16) * 32, scr, lane); return; }
    it -= 32;
    if (it < I_GU) { const int e = it / I_GU1, r = it % I_GU1, kb = r / 64, nb = r % 64, n0 = nb * 32, pn = n0 >> 8, j0 = n0 & 255;
        const int src = (j0 >> 7) * 1024 + pn * 128 + (j0 & 127);
        tr_item(P.w_gu + (size_t)e * 1024 * 2048, 2048, src, kb * 64, (bf16_t*)(ws + WS_WGU) + (size_t)e * 2048 * 1024, 1024, n0, scr, lane); return; }
    it -= I_GU;
    { const int e = it / I_DN1, r = it % I_DN1, kb = r / 32, nb = r % 32;
        tr_item(P.w_down + (size_t)e * 1024 * 1024, 1024, nb * 32, kb * 64, (bf16_t*)(ws + WS_WDN) + (size_t)e * 1024 * 1024, 1024, nb * 32, scr, lane); }
}
__device__ __forceinline__ void phase_prep_weights(KPR P, LAS unsigned char* lds, int gw, int ngw, int wave, int lane) {
    LAS float* scr = (LAS float*)(lds + wave * 16384);
    for (int it = gw; it < I_ALL; it += ngw) prep_item(P, it, scr, lane);
}
__device__ __forceinline__ void phase_cvt_p(KPR P, int gt, int ngt) {
    bf16_t* PB = (bf16_t*)((unsigned char*)P.out + DO_PB);
    for (int i = gt; i < NTOK * PLE / 8; i += ngt) { const f32x4 a = ((const f32x4*)P.p)[2 * i], b = ((const f32x4*)P.p)[2 * i + 1];
        u32x4 w; w.x = pk2(a[0], a[1]); w.y = pk2(a[2], a[3]); w.z = pk2(b[0], b[1]); w.w = pk2(b[2], b[3]); ((u32x4*)PB)[i] = w; }
}
__device__ __forceinline__ void rms_row(const float* xrow, const float* gain, int lane, f32x4 (&v)[4]) {
    const f32x4* xr = (const f32x4*)xrow + lane; float s = 0.f;
#pragma unroll
    for (int j = 0; j < 4; ++j) { v[j] = xr[64 * j]; s += (v[j][0] * v[j][0] + v[j][1] * v[j][1]) + (v[j][2] * v[j][2] + v[j][3] * v[j][3]); }
    const float rstd = rsqrtf(wave_sum(s) * (1.f / DM) + 1e-6f);
#pragma unroll
    for (int j = 0; j < 4; ++j) v[j] = v[j] * rstd * ((const f32x4*)gain)[64 * j + lane];
}
__device__ __forceinline__ void store_row_bf16(bf16_t* orow, int lane, const f32x4 (&v)[4]) {
    u32x2* o8 = (u32x2*)orow + lane;
#pragma unroll
    for (int j = 0; j < 4; ++j) { u32x2 w; w.x = pk2(v[j][0], v[j][1]); w.y = pk2(v[j][2], v[j][3]); o8[64 * j] = w; }
}
__device__ __forceinline__ void norm1_row(KPR P, int row, int lane, const LAS float* wff, LAS float* lf_out  ) {
    f32x4 v[4]; rms_row(P.x + (size_t)row * DM, P.mix_norm, lane, v);
    store_row_bf16((bf16_t*)(P.ws + WS_XN) + (size_t)row * DM, lane, v);
    float ff[8];
#pragma unroll
    for (int q = 0; q < 8; ++q) ff[q] = 0.f;
#pragma unroll
    for (int j = 0; j < 4; ++j)
#pragma unroll
        for (int i = 0; i < 4; ++i) { const LAS f32x4* w = (const LAS f32x4*)(wff + (size_t)(4 * (64 * j + lane) + i) * 8); const f32x4 w0 = w[0], w1 = w[1]; const float h = v[j][i];
            ff[0] += h * w0[0]; ff[1] += h * w0[1]; ff[2] += h * w0[2]; ff[3] += h * w0[3]; ff[4] += h * w1[0]; ff[5] += h * w1[1]; ff[6] += h * w1[2]; ff[7] += h * w1[3]; }
#pragma unroll
    for (int q = 0; q < 8; ++q) ff[q] = wave_sum(ff[q]);
    if (lane < 8) { float f = ff[0];
#pragma unroll
        for (int q = 1; q < 8; ++q) f = (lane == q) ? ff[q] : f;
        lf_out[lane] = logsigmoidf_(f + P.f_bias[lane]); }
}
__device__ __forceinline__ void load_wff(KPR P, LAS float* wff, int tid, int nthr) {
    for (int i = tid; i < 1024 * 8; i += nthr) wff[i] = P.w_in[(size_t)(i >> 3) * INW + 2048 + (i & 7)];
}
__device__ __forceinline__ void final_row(KPR P, int row, int lane, bool dead) {
    f32x4 v[4]; rms_row((const float*)(P.ws + WS_X1) + (size_t)row * DM, P.final_norm, lane, v);
    f32x4* o = (f32x4*)(P.out + (size_t)row * DM) + lane;
#pragma unroll
    for (int j = 0; j < 4; ++j) { if (dead) { const float q = __builtin_nanf(""); v[j] = (f32x4){q, q, q, q}; } o[64 * j] = v[j]; }
}
typedef GAS unsigned gu32;
#define RLX_AGENT __ATOMIC_RELAXED, __HIP_MEMORY_SCOPE_AGENT
#define XB_TMO      128
#define XB_XCNT(j)  (256  + 64 * (j))
#define XB_XSUB(j)  (1280 + 64 * (j))
#define XB_XGEN(j)  (2304 + 64 * (j))
#define XB_TOP      3328
#define XB_TOPGEN   3392
#define XCD_BAR_WORDS 3456
#define XB_SPIN_CAP (1u << 22)

__device__ __forceinline__ unsigned xb_ld(unsigned* p)              { return __hip_atomic_load(p, __ATOMIC_RELAXED, __HIP_MEMORY_SCOPE_AGENT); }
__device__ __forceinline__ unsigned xb_add(unsigned* p, unsigned v) { return __hip_atomic_fetch_add(p, v, __ATOMIC_RELAXED, __HIP_MEMORY_SCOPE_AGENT); }
__device__ __forceinline__ unsigned xb_xcc_id() { return (unsigned)__builtin_amdgcn_s_getreg((3 << 11) | 20) & 0xFu; }
#define XB_SPIN(cond, bar) do { unsigned _sp = 0; while (cond) { __builtin_amdgcn_s_sleep(1); \
    if ((++_sp & 255u) == 0u) { if (xb_ld(&(bar)[XB_TMO])) break; if (_sp > XB_SPIN_CAP) { atomicAdd(&(bar)[XB_TMO], 1u); break; } } } } while (0)

struct XcdBarrier { unsigned* bar; unsigned x; volatile LAS unsigned* st; };

__device__ __forceinline__ XcdBarrier xcd_barrier_post(unsigned* bar, volatile LAS unsigned* st) {
    XcdBarrier b; b.bar = bar; b.x = xb_xcc_id(); b.st = st;
    if (threadIdx.x == 0) (void)xb_add(&bar[XB_XCNT(b.x)], 1u);
    return b;
}
__device__ __forceinline__ void xcd_barrier_complete(unsigned* bar, unsigned x, unsigned& nloc, unsigned& nx) {
    const unsigned G = gridDim.x * gridDim.y * gridDim.z;
    unsigned sum, cnt, mine, sp = 0u;
    for (;;) {
        sum = 0u; cnt = 0u; mine = 0u;
#pragma unroll
        for (unsigned j = 0; j < 16; ++j) { const unsigned c = xb_ld(&bar[XB_XCNT(j)]); sum += c; cnt += (c > 0u) ? 1u : 0u; mine = (j == x) ? c : mine; }
        if (sum == G) break;
        __builtin_amdgcn_s_sleep(1);
        if ((++sp & 255u) == 0u) { if (xb_ld(&bar[XB_TMO])) break; if (sp > XB_SPIN_CAP) { atomicAdd(&bar[XB_TMO], 1u); break; } }
    }
    nloc = mine > 0u ? mine : 1u; nx = cnt > 0u ? cnt : 1u;
}
__device__ __forceinline__ void xcd_barrier(const XcdBarrier& b) {
    asm volatile("s_waitcnt vmcnt(0)" ::: "memory");
    __syncthreads();
    if (threadIdx.x == 0) {
        unsigned* bar = b.bar;
        __builtin_amdgcn_s_waitcnt(0);
        unsigned nloc = b.st[0], nx = b.st[1];
        if (nloc == 0u) { xcd_barrier_complete(bar, b.x, nloc, nx); b.st[0] = nloc; b.st[1] = nx; }
        const unsigned old = xb_add(&bar[XB_XSUB(b.x)], 1u);
        const unsigned gen = old / nloc;
        if (old + 1u == (gen + 1u) * nloc) {
            __builtin_amdgcn_fence(__ATOMIC_RELEASE, "agent");
            asm volatile("s_waitcnt vmcnt(0)" ::: "memory");
            const unsigned og = xb_add(&bar[XB_TOP], 1u);
            const unsigned tg = og / nx;
            if (og + 1u == (tg + 1u) * nx) xb_add(&bar[XB_TOPGEN], 1u);
            else XB_SPIN(xb_ld(&bar[XB_TOPGEN]) == tg, bar);
            __builtin_amdgcn_fence(__ATOMIC_ACQUIRE, "agent");
            xb_add(&bar[XB_XGEN(b.x)], 1u);
            asm volatile("s_waitcnt vmcnt(0)" ::: "memory");
        } else {
            XB_SPIN(xb_ld(&bar[XB_XGEN(b.x)]) == gen, bar);
            __builtin_amdgcn_fence(__ATOMIC_ACQUIRE, "agent");
            asm volatile("s_waitcnt vmcnt(0)" ::: "memory");
        }
    }
    __syncthreads();
}
namespace rk {
constexpr int MB = 8192;
constexpr int S_AT = 0, S_RT = 1, S_KT = 2, S_BT = 3, S_ATT = 4, S_KTT = 5, S_BTT = 6, S_VT = 7, S_N = 8, S_NT = 9, S_MAK = 10, S_MRB = 11, S_MRK = 12, S_TA = 13, S_TB = 14;
constexpr int SCR = 15 * MB;
constexpr int NCHUNK = SEQ / 64;
constexpr size_t WS_HT = WS_X1;
constexpr size_t WS_Y0 = WS_X1 + 64 * MiB;
constexpr size_t WS_QI = WS_X1 + 96 * MiB;
constexpr size_t WS_LW = WS_RW, WS_LA = WS_RW + 32 * MiB, WS_LG = WS_RW + 64 * MiB;
constexpr size_t WS_SC = WS_RW + 224 * MiB;
constexpr size_t DO_GT = 80 * MiB;
static_assert(WS_SC + 32 * MiB <= WS_END, "rwkv blobs");

__device__ __forceinline__ int moff(int row, int col) { return row * 128 + ((((col >> 3) ^ (row >> 1)) & 7) << 4) + (col & 7) * 2; }
__device__ __forceinline__ int crow(int r, int hi) { return (r & 3) + 8 * (r >> 2) + 4 * hi; }
__device__ __forceinline__ f32x16 mm_nt(const LAS unsigned char* A, int ar0, const LAS unsigned char* Bt, int br0, f32x16 acc, int r32, int hi) {
#pragma unroll
    for (int ks = 0; ks < 4; ++ks) { const bf16x8 a = *(const LAS bf16x8*)(A + moff(ar0 + r32, 16 * ks + 8 * hi)), b = *(const LAS bf16x8*)(Bt + moff(br0 + r32, 16 * ks + 8 * hi));
        acc = __builtin_amdgcn_mfma_f32_32x32x16_bf16(a, b, acc, 0, 0, 0); }
    return acc;
}
__device__ __forceinline__ void store_t(LAS unsigned char* dst, const f32x16& acc, int i0, int j0, int r32, int hi) {
#pragma unroll
    for (int g = 0; g < 4; ++g) { u32x2 w; w.x = pk2(acc[4 * g], acc[4 * g + 1]); w.y = pk2(acc[4 * g + 2], acc[4 * g + 3]); *(LAS u32x2*)(dst + moff(j0 + r32, i0 + 8 * g + 4 * hi)) = w; }
}
template <int MODE> __device__ __forceinline__ void mask_tri(f32x16& acc, int i0, int j0, int r32, int hi) {
#pragma unroll
    for (int r = 0; r < 16; ++r) { const int i = i0 + crow(r, hi), j = j0 + r32; const bool keep = MODE == 0 ? (j < i) : (MODE == 1 ? (i < j) : (i <= j)); if (!keep) acc[r] = 0.f; }
}

__device__ __forceinline__ void pass1_chunk(KPR P, LAS unsigned char* lds, int bh, int c, int tid) {
    const int lane = tid & 63, wave = tid >> 6, r32 = lane & 31, hi = lane >> 5, grp = wave >> 2, wq = wave & 3, i0 = 32 * (wq >> 1), j0 = 32 * (wq & 1);
    const int b = bh >> 3, h = bh & 7; const size_t tok0 = (size_t)b * SEQ + (size_t)c * 64; const size_t ci = (size_t)bh * NCHUNK + c;
    LAS float* part = (LAS float*)(lds + SCR); LAS float* WL = (LAS float*)(lds + SCR + 2048);
#define MAT(s) (lds + (s) * MB)
    {
        const bf16_t* Z = (const bf16_t*)(P.ws + WS_Z); const bf16_t* LW = (const bf16_t*)(P.ws + WS_LW); const bf16_t* LA = (const bf16_t*)(P.ws + WS_LA);
        const int ch = tid & 63, tq = tid >> 6, cc = h * 64 + ch; const size_t row0 = tok0 + 8 * tq;
        const float mur = P.mu[RW_R + cc], muk = P.mu[RW_K + cc], muv = P.mu[RW_V + cc], w0c = P.w0[cc], a0c = P.a0[cc], kkc = P.k_k[cc], kac = P.k_a[cc];
        const bf16_t* zp = Z + row0 * ZW + ZR + cc;
        const bool first = (c == 0) && (tq == 0); const bf16_t* zq = first ? zp : zp - ZW; const float pm = first ? 0.f : 1.f;
        unsigned short lr[9], lk[9], lv[9], llw[8], lla[8];
        lr[0] = zq[RW_R]; lk[0] = zq[RW_K]; lv[0] = zq[RW_V];
#pragma unroll
        for (int i = 0; i < 8; ++i) { const bf16_t* zi = zp + (size_t)i * ZW; lr[i + 1] = zi[RW_R]; lk[i + 1] = zi[RW_K]; lv[i + 1] = zi[RW_V]; const size_t o = (row0 + i) * 512 + cc; llw[i] = LW[o]; lla[i] = LA[o]; }
        float cum[8], vr[8], vk[8], vkk[8], vka[8], ssq[8]; unsigned short vv16[8]; float run = 0.f;
#pragma unroll
        for (int i = 0; i < 8; ++i) { const float pmi = (i == 0) ? pm : 1.f; const float zr1 = bf2f(lr[i + 1]), zk1 = bf2f(lk[i + 1]), zv1 = bf2f(lv[i + 1]);
            vr[i] = zr1 + (bf2f(lr[i]) * pmi - zr1) * mur; vk[i] = zk1 + (bf2f(lk[i]) * pmi - zk1) * muk; vv16[i] = (unsigned short)f2bf(zv1 + (bf2f(lv[i]) * pmi - zv1) * muv);
            vkk[i] = vk[i] * kkc; ssq[i] = vkk[i] * vkk[i]; }
#pragma unroll
        for (int o = 1; o < 64; o <<= 1) {
#pragma unroll
            for (int i = 0; i < 8; ++i) ssq[i] += __shfl_xor(ssq[i], o); }
#pragma unroll
        for (int i = 0; i < 8; ++i) {
            const float wl = w0c + bf2f(llw[i]); const float sp = fmaxf(-wl, 0.f) + __logf(1.0f + __expf(-fabsf(wl)));
            run += -__expf(-sp - 0.5f); cum[i] = run;
            const float a = __builtin_amdgcn_rcpf(1.0f + __expf(-(a0c + bf2f(lla[i]))));
            const float kk = vkk[i] * __builtin_amdgcn_rcpf(fmaxf(__builtin_amdgcn_sqrtf(ssq[i]), 1e-12f));
            vk[i] = vk[i] * (1.0f + (a - 1.0f) * kac); vkk[i] = kk; vka[i] = kk * a; }
        part[tq * 64 + ch] = run;
        __syncthreads();
        float pre = 0.f;
#pragma unroll
        for (int g = 0; g < 8; ++g) { const float pvv = part[g * 64 + ch]; pre += (g < tq) ? pvv : 0.f; }
        float eprev = __expf(pre);
        unsigned atT[4], ktT[4], btT[4], vT[4]; unsigned short hold[4] = {0, 0, 0, 0};
#pragma unroll
        for (int i = 0; i < 8; ++i) { const int t = 8 * tq + i;
            const float cm = pre + cum[i], e1 = __expf(cm), einv = __expf(-cm);
            const unsigned short at = (unsigned short)f2bf(-vkk[i] * eprev), rt = (unsigned short)f2bf(vr[i] * e1), kt = (unsigned short)f2bf(vk[i] * einv), bt = (unsigned short)f2bf(vka[i] * einv), vv = vv16[i];
            eprev = e1;
            *(LAS unsigned short*)(MAT(S_AT) + moff(t, ch)) = at; *(LAS unsigned short*)(MAT(S_RT) + moff(t, ch)) = rt; *(LAS unsigned short*)(MAT(S_KT) + moff(t, ch)) = kt; *(LAS unsigned short*)(MAT(S_BT) + moff(t, ch)) = bt;
            if (i & 1) { atT[i >> 1] = hold[0] | ((unsigned)at << 16); ktT[i >> 1] = hold[1] | ((unsigned)kt << 16); btT[i >> 1] = hold[2] | ((unsigned)bt << 16); vT[i >> 1] = hold[3] | ((unsigned)vv << 16); }
            else { hold[0] = at; hold[1] = kt; hold[2] = bt; hold[3] = vv; }
            if (i == 7 && tq == 7) WL[ch] = e1; }
        *(LAS u32x4*)(MAT(S_ATT) + moff(ch, 8 * tq)) = (u32x4){atT[0], atT[1], atT[2], atT[3]}; *(LAS u32x4*)(MAT(S_KTT) + moff(ch, 8 * tq)) = (u32x4){ktT[0], ktT[1], ktT[2], ktT[3]};
        *(LAS u32x4*)(MAT(S_BTT) + moff(ch, 8 * tq)) = (u32x4){btT[0], btT[1], btT[2], btT[3]}; *(LAS u32x4*)(MAT(S_VT) + moff(ch, 8 * tq)) = (u32x4){vT[0], vT[1], vT[2], vT[3]};
    }
    __syncthreads();
    const f32x16 zero = f32x16{};
    if (grp == 0) { f32x16 d = mm_nt(MAT(S_AT), i0, MAT(S_BT), j0, zero, r32, hi); mask_tri<0>(d, i0, j0, r32, hi); store_t(MAT(S_NT), d, i0, j0, r32, hi);
        d = mm_nt(MAT(S_KT), i0, MAT(S_AT), j0, zero, r32, hi); mask_tri<1>(d, i0, j0, r32, hi); store_t(MAT(S_MAK), d, i0, j0, r32, hi);
        d = mm_nt(MAT(S_KT), i0, MAT(S_RT), j0, zero, r32, hi); mask_tri<2>(d, i0, j0, r32, hi); store_t(MAT(S_MRK), d, i0, j0, r32, hi); }
    else { f32x16 d = mm_nt(MAT(S_BT), i0, MAT(S_AT), j0, zero, r32, hi); mask_tri<1>(d, i0, j0, r32, hi); store_t(MAT(S_N), d, i0, j0, r32, hi);
#pragma unroll
        for (int r = 0; r < 16; ++r) if (i0 + crow(r, hi) == j0 + r32) d[r] = 1.0f;
        store_t(MAT(S_TA), d, i0, j0, r32, hi);
        d = mm_nt(MAT(S_BT), i0, MAT(S_RT), j0, zero, r32, hi); mask_tri<2>(d, i0, j0, r32, hi); store_t(MAT(S_MRB), d, i0, j0, r32, hi); }
    __syncthreads();
#pragma unroll
    for (int s = 1; s <= 6; ++s) {
        const int mc = (s & 1) ? S_N : S_AT, mcT = (s & 1) ? S_NT : S_KT, mn = (s & 1) ? S_AT : S_N, mnT = (s & 1) ? S_KT : S_NT;
        const int tc = (s & 1) ? S_TB : S_TA, tn = (s & 1) ? S_TA : S_TB;
        if (s <= 5) {
            if (grp == 0) { const f32x16 d = mm_nt(MAT(mc), i0, MAT(mcT), j0, zero, r32, hi); store_t(MAT(mnT), d, i0, j0, r32, hi); }
            else { const f32x16 d = mm_nt(MAT(mcT), i0, MAT(mc), j0, zero, r32, hi); store_t(MAT(mn), d, i0, j0, r32, hi); }
        }
        if (s >= 2 && grp == (s <= 5 ? 0 : 1) ) {
            f32x16 d = mm_nt(MAT(mcT), i0, MAT(tc), j0, zero, r32, hi);
#pragma unroll
            for (int g = 0; g < 4; ++g) { const u32x2 tv = *(const LAS u32x2*)(MAT(tc) + moff(j0 + r32, i0 + 8 * g + 4 * hi)); d[4 * g] += bflo(tv.x); d[4 * g + 1] += bfhi(tv.x); d[4 * g + 2] += bflo(tv.y); d[4 * g + 3] += bfhi(tv.y); }
            store_t(MAT(tn), d, i0, j0, r32, hi);
        }
        __syncthreads();
    }
    if (grp == 0) { const f32x16 d = mm_nt(MAT(S_TB), i0, MAT(S_ATT), j0, zero, r32, hi); store_t(MAT(S_BT), d, i0, j0, r32, hi); }
    else { const f32x16 d = mm_nt(MAT(S_MAK), i0, MAT(S_VT), j0, zero, r32, hi); store_t(MAT(S_N), d, i0, j0, r32, hi); }
    __syncthreads();
    if (grp == 0) { const f32x16 d = mm_nt(MAT(S_TB), i0, MAT(S_N), j0, zero, r32, hi); store_t(MAT(S_NT), d, i0, j0, r32, hi);
        f32x16 q = mm_nt(MAT(S_BT), i0, MAT(S_MRB), j0, zero, r32, hi);
#pragma unroll
        for (int g = 0; g < 4; ++g) { const u32x2 rv = *(const LAS u32x2*)(MAT(S_RT) + moff(j0 + r32, i0 + 8 * g + 4 * hi)); q[4 * g] += bflo(rv.x); q[4 * g + 1] += bfhi(rv.x); q[4 * g + 2] += bflo(rv.y); q[4 * g + 3] += bfhi(rv.y); }
        store_t(MAT(S_KT), q, i0, j0, r32, hi); }
    else { f32x16 g_ = mm_nt(MAT(S_BT), i0, MAT(S_BTT), j0, zero, r32, hi);
        const float wl = WL[j0 + r32];
#pragma unroll
        for (int r = 0; r < 16; ++r) { if (i0 + crow(r, hi) == j0 + r32) g_[r] += 1.0f; g_[r] *= wl; }
        store_t(MAT(S_AT), g_, i0, j0, r32, hi); }
    __syncthreads();
    if (grp == 0) { f32x16 d = mm_nt(MAT(S_BTT), i0, MAT(S_NT), j0, zero, r32, hi); d = mm_nt(MAT(S_KTT), i0, MAT(S_VT), j0, d, r32, hi);
        float* HT = (float*)(P.ws + WS_HT) + ci * 4096 + (size_t)wq * 1024 + lane;
#pragma unroll
        for (int g = 0; g < 4; ++g) { const f32x4 wl4 = *(const LAS f32x4*)(WL + i0 + 8 * g + 4 * hi);
#pragma unroll
            for (int i = 0; i < 4; ++i) HT[(4 * g + i) * 64] = d[4 * g + i] * wl4[i]; } }
    else { f32x16 d = mm_nt(MAT(S_MRB), i0, MAT(S_NT), j0, zero, r32, hi); d = mm_nt(MAT(S_MRK), i0, MAT(S_VT), j0, d, r32, hi);
        unsigned* Y0 = (unsigned*)(P.ws + WS_Y0) + ci * 2048 + (size_t)wq * 512 + lane;
#pragma unroll
        for (int r2 = 0; r2 < 8; ++r2) Y0[r2 * 64] = pk2(d[2 * r2], d[2 * r2 + 1]); }
    { u32x4* GTg = (u32x4*)((unsigned char*)P.out + DO_GT + ci * MB); u32x4* QIg = (u32x4*)(P.ws + WS_QI + ci * MB);
        GTg[tid] = *(const LAS u32x4*)(MAT(S_AT) + tid * 16); QIg[tid] = *(const LAS u32x4*)(MAT(S_KT) + tid * 16); }
    __syncthreads();
#undef MAT
}

__device__ __forceinline__ void pass2_seq(KPR P, LAS unsigned char* lds, int bh, int tid) {
    const int lane = tid & 63, wave = tid >> 6, r32 = lane & 31, hi = lane >> 5, wq = wave & 3, i0 = 32 * (wq >> 1), j0 = 32 * (wq & 1);
    LAS unsigned char* Sm = lds; LAS unsigned char* G0 = lds + MB; LAS unsigned char* G1 = lds + 2 * MB;
    const size_t ci0 = (size_t)bh * NCHUNK;
    const u32x4* GTg = (const u32x4*)((const unsigned char*)P.out + DO_GT + ci0 * MB); u32x4* SCg = (u32x4*)(P.ws + WS_SC + ci0 * MB);
    const float* HT = (const float*)(P.ws + WS_HT) + ci0 * 4096 + (size_t)wq * 1024 + lane;
    *(LAS u32x4*)(Sm + tid * 16) = (u32x4){0u, 0u, 0u, 0u};
    *(LAS u32x4*)(G0 + tid * 16) = GTg[tid];
    u32x4 gnext = GTg[512 + tid];
    f32x16 hcur, hnext;
    if (wave < 4) {
#pragma unroll
        for (int r = 0; r < 16; ++r) { hcur[r] = HT[r * 64]; hnext[r] = HT[4096 + r * 64]; } }
    __syncthreads();
    for (int c = 0; c < NCHUNK; ++c) {
        LAS unsigned char* Gc = (c & 1) ? G1 : G0; LAS unsigned char* Gn = (c & 1) ? G0 : G1;
        SCg[(size_t)c * 512 + tid] = *(const LAS u32x4*)(Sm + tid * 16);
        f32x16 d = hcur;
        if (wave < 4) d = mm_nt(Gc, i0, Sm, j0, d, r32, hi);
        __syncthreads();
        if (wave < 4) store_t(Sm, d, i0, j0, r32, hi);
        *(LAS u32x4*)(Gn + tid * 16) = gnext;
        const int c2 = (c + 2 < NCHUNK) ? c + 2 : NCHUNK - 1;
        gnext = GTg[(size_t)c2 * 512 + tid];
        if (wave < 4) { hcur = hnext;
#pragma unroll
            for (int r = 0; r < 16; ++r) hnext[r] = HT[(size_t)c2 * 4096 + r * 64]; }
        __syncthreads();
    }
}

__device__ __forceinline__ void pass3_chunk(KPR P, LAS unsigned char* lds, int bh, int c, int tid) {
    const int lane = tid & 63, wave = tid >> 6, r32 = lane & 31, hi = lane >> 5, wq = wave & 3, i0 = 32 * (wq >> 1), j0 = 32 * (wq & 1);
    const int b = bh >> 3, h = bh & 7; const size_t tok0 = (size_t)b * SEQ + (size_t)c * 64; const size_t ci = (size_t)bh * NCHUNK + c;
    LAS unsigned char* Qm = lds; LAS unsigned char* Sm = lds + MB; LAS float* Yl = (LAS float*)(lds + 2 * MB);
    *(LAS u32x4*)(Qm + tid * 16) = ((const u32x4*)(P.ws + WS_QI + ci * MB))[tid];
    *(LAS u32x4*)(Sm + tid * 16) = ((const u32x4*)(P.ws + WS_SC + ci * MB))[tid];
    f32x16 d = f32x16{};
    if (wave < 4) { const unsigned* Y0 = (const unsigned*)(P.ws + WS_Y0) + ci * 2048 + (size_t)wq * 512 + lane;
#pragma unroll
        for (int r2 = 0; r2 < 8; ++r2) { const unsigned w = Y0[r2 * 64]; d[2 * r2] = bflo(w); d[2 * r2 + 1] = bfhi(w); } }
    __syncthreads();
    if (wave < 4) { d = mm_nt(Qm, i0, Sm, j0, d, r32, hi);
#pragma unroll
        for (int r = 0; r < 16; ++r) Yl[(i0 + crow(r, hi)) * 65 + j0 + r32] = d[r]; }
    __syncthreads();
    const bf16_t* Z = (const bf16_t*)(P.ws + WS_Z); const bf16_t* LA = (const bf16_t*)(P.ws + WS_LA); const bf16_t* LG = (const bf16_t*)(P.ws + WS_LG);
    bf16_t* AO = (bf16_t*)(P.ws + WS_AO); const int cc = h * 64 + lane;
    const float lnw = P.ln_w[cc], lnb = P.ln_b[cc], rkc = P.r_k[cc], mur = P.mu[RW_R + cc], muk = P.mu[RW_K + cc], muv = P.mu[RW_V + cc], a0c = P.a0[cc], kac = P.k_a[cc];
    const bf16_t* zp = Z + (tok0 + wave * 8) * ZW + ZR + cc; const bool first = (c == 0) && (wave == 0); const bf16_t* zq = first ? zp : zp - ZW; const float pm = first ? 0.f : 1.f;
    unsigned short lr[9], lk[9], lv[9], lla[8], llg[8];
    lr[0] = zq[RW_R]; lk[0] = zq[RW_K]; lv[0] = zq[RW_V];
#pragma unroll
    for (int i = 0; i < 8; ++i) { const bf16_t* zi = zp + (size_t)i * ZW; lr[i + 1] = zi[RW_R]; lk[i + 1] = zi[RW_K]; lv[i + 1] = zi[RW_V]; const size_t o = (tok0 + wave * 8 + i) * 512 + cc; lla[i] = LA[o]; llg[i] = LG[o]; }
    float y[8], s1[8], s2[8], s3[8], vvv[8];
#pragma unroll
    for (int i = 0; i < 8; ++i) { const float pmi = (i == 0) ? pm : 1.f; const float zr1 = bf2f(lr[i + 1]), zk1 = bf2f(lk[i + 1]), zv1 = bf2f(lv[i + 1]);
        const float r = zr1 + (bf2f(lr[i]) * pmi - zr1) * mur, zk = zk1 + (bf2f(lk[i]) * pmi - zk1) * muk; vvv[i] = zv1 + (bf2f(lv[i]) * pmi - zv1) * muv;
        const float a = __builtin_amdgcn_rcpf(1.0f + __expf(-(a0c + bf2f(lla[i])))); const float k = zk * (1.0f + (a - 1.0f) * kac);
        y[i] = Yl[(wave * 8 + i) * 65 + lane]; s1[i] = y[i]; s3[i] = r * k * rkc; }
#pragma unroll
    for (int o = 1; o < 64; o <<= 1) {
#pragma unroll
        for (int i = 0; i < 8; ++i) { s1[i] += __shfl_xor(s1[i], o); s3[i] += __shfl_xor(s3[i], o); } }
#pragma unroll
    for (int i = 0; i < 8; ++i) { y[i] -= s1[i] * (1.f / 64.f); s2[i] = y[i] * y[i]; }
#pragma unroll
    for (int o = 1; o < 64; o <<= 1) {
#pragma unroll
        for (int i = 0; i < 8; ++i) s2[i] += __shfl_xor(s2[i], o); }
#pragma unroll
    for (int i = 0; i < 8; ++i) { const size_t tok = tok0 + wave * 8 + i; const float yn = y[i] * rsqrtf(s2[i] * (1.f / 64.f) + 64e-5f) * lnw + lnb;
        AO[tok * DM + 512 + cc] = (bf16_t)f2bf((yn + s3[i] * vvv[i]) * bf2f(llg[i])); }
}

constexpr size_t WS_W2T = 29 * MiB, WS_A2T = 29 * MiB + 65536, WS_G2T = 29 * MiB + 131072;
__device__ __forceinline__ bf16x8 act8(const bf16_t* zc, const bf16_t* zpv, float pmask, const float* mu, int mode) {
    const u32x4 c = *(const u32x4*)zc, p = *(const u32x4*)zpv;
    const f32x4 m0 = *(const f32x4*)mu, m1 = *(const f32x4*)(mu + 4);
    const unsigned cw[4] = {c.x, c.y, c.z, c.w}, pw[4] = {p.x, p.y, p.z, p.w}; const float um[8] = {m0[0], m0[1], m0[2], m0[3], m1[0], m1[1], m1[2], m1[3]}; float v[8];
#pragma unroll
    for (int j = 0; j < 4; ++j) { const float c0 = bflo(cw[j]), c1 = bfhi(cw[j]), p0 = bflo(pw[j]) * pmask, p1 = bfhi(pw[j]) * pmask;
        v[2 * j] = c0 + (p0 - c0) * um[2 * j]; v[2 * j + 1] = c1 + (p1 - c1) * um[2 * j + 1]; }
#pragma unroll
    for (int j = 0; j < 8; ++j) { if (mode == 0) { const float e = __expf(-2.0f * fabsf(v[j])); const float th = (1.0f - e) / (1.0f + e); v[j] = v[j] < 0.f ? -th : th; } else if (mode == 2) v[j] = 1.0f / (1.0f + __expf(-v[j])); }
    u32x4 w; w.x = pk2(v[0], v[1]); w.y = pk2(v[2], v[3]); w.z = pk2(v[4], v[5]); w.w = pk2(v[6], v[7]);
    return __builtin_bit_cast(bf16x8, w);
}
__device__ __forceinline__ void lora_task(KPR P, int task, int lane) {
    const int r32 = lane & 31, hi = lane >> 5; const size_t row = (size_t)task * 32 + r32; const bool first = (row % SEQ) == 0;
    const bf16_t* Z = (const bf16_t*)(P.ws + WS_Z) + row * ZW + ZR + 8 * hi; const bf16_t* Zp = first ? Z : Z - ZW; const float pmask = first ? 0.f : 1.f;
    const float* mub = P.mu + 8 * hi;
    bf16x8 xw[4], xa[4], xg[8];
#pragma unroll
    for (int ks = 0; ks < 4; ++ks) { xw[ks] = act8(Z + RW_W + 16 * ks, Zp + RW_W + 16 * ks, pmask, mub + RW_W + 16 * ks, 0); xa[ks] = act8(Z + RW_A + 16 * ks, Zp + RW_A + 16 * ks, pmask, mub + RW_A + 16 * ks, 1); asm volatile("" ::: "memory"); }
#pragma unroll
    for (int ks = 0; ks < 8; ++ks) { xg[ks] = act8(Z + RW_G + 16 * ks, Zp + RW_G + 16 * ks, pmask, mub + RW_G + 16 * ks, 2); if (ks & 1) asm volatile("" ::: "memory"); }
    const bf16_t* W2T = (const bf16_t*)(P.ws + WS_W2T) + r32 * 64 + 8 * hi; const bf16_t* A2T = (const bf16_t*)(P.ws + WS_A2T) + r32 * 64 + 8 * hi; const bf16_t* G2T = (const bf16_t*)(P.ws + WS_G2T) + r32 * 128 + 8 * hi;
    bf16_t* LW = (bf16_t*)(P.ws + WS_LW) + row * 512 + 4 * hi; bf16_t* LA = (bf16_t*)(P.ws + WS_LA) + row * 512 + 4 * hi; bf16_t* LG = (bf16_t*)(P.ws + WS_LG) + row * 512 + 4 * hi;
#pragma nounroll
    for (int cb = 0; cb < 16; ++cb) {
        f32x16 dw = f32x16{}, da = f32x16{}, dg = f32x16{};
#pragma unroll
        for (int ks = 0; ks < 4; ++ks) { dw = __builtin_amdgcn_mfma_f32_32x32x16_bf16(*(const bf16x8*)(W2T + cb * 32 * 64 + 16 * ks), xw[ks], dw, 0, 0, 0); da = __builtin_amdgcn_mfma_f32_32x32x16_bf16(*(const bf16x8*)(A2T + cb * 32 * 64 + 16 * ks), xa[ks], da, 0, 0, 0); }
#pragma unroll
        for (int ks = 0; ks < 8; ++ks) dg = __builtin_amdgcn_mfma_f32_32x32x16_bf16(*(const bf16x8*)(G2T + cb * 32 * 128 + 16 * ks), xg[ks], dg, 0, 0, 0);
#pragma unroll
        for (int g = 0; g < 4; ++g) { u32x2 w; w.x = pk2(dw[4 * g], dw[4 * g + 1]); w.y = pk2(dw[4 * g + 2], dw[4 * g + 3]); *(u32x2*)(LW + cb * 32 + 8 * g) = w;
            w.x = pk2(da[4 * g], da[4 * g + 1]); w.y = pk2(da[4 * g + 2], da[4 * g + 3]); *(u32x2*)(LA + cb * 32 + 8 * g) = w;
            w.x = pk2(dg[4 * g], dg[4 * g + 1]); w.y = pk2(dg[4 * g + 2], dg[4 * g + 3]); *(u32x2*)(LG + cb * 32 + 8 * g) = w; }
    }
}
}
namespace rt {
__device__ __forceinline__ int woff(int e, int k) { return e * 2048 + ((((k >> 3) ^ (e & 15))) << 4) + (k & 7) * 2; }
__device__ __forceinline__ void build_w(KPR P, LAS unsigned char* lds, int tid) {
    const int e = tid & 31, kq = tid >> 5;
    for (int i = 0; i < 64; ++i) { const int k = kq * 64 + i; const float w = P.moe_norm[k] * P.w_router[k * 32 + e]; const unsigned h = f2bf(w); const unsigned l = f2bf(w - bf2f(h));
        *(LAS unsigned short*)(lds + woff(e, k)) = (unsigned short)h; *(LAS unsigned short*)(lds + 65536 + woff(e, k)) = (unsigned short)l; }
}
__device__ __forceinline__ void split8(const f32x4& a, const f32x4& b, bf16x8& h, bf16x8& l) {
    unsigned hh[8]; float v[8] = {a[0], a[1], a[2], a[3], b[0], b[1], b[2], b[3]};
#pragma unroll
    for (int j = 0; j < 8; ++j) hh[j] = f2bf(v[j]);
    u32x4 hw, lw;
    hw.x = hh[0] | (hh[1] << 16); hw.y = hh[2] | (hh[3] << 16); hw.z = hh[4] | (hh[5] << 16); hw.w = hh[6] | (hh[7] << 16);
    lw.x = pk2(v[0] - bf2f(hh[0]), v[1] - bf2f(hh[1])); lw.y = pk2(v[2] - bf2f(hh[2]), v[3] - bf2f(hh[3])); lw.z = pk2(v[4] - bf2f(hh[4]), v[5] - bf2f(hh[5])); lw.w = pk2(v[6] - bf2f(hh[6]), v[7] - bf2f(hh[7]));
    h = __builtin_bit_cast(bf16x8, hw); l = __builtin_bit_cast(bf16x8, lw);
}
__device__ __forceinline__ void route_task(KPR P, const LAS unsigned char* wlds, int task, int lane) {
    const int r32 = lane & 31, hi = lane >> 5; const int row = task * 32 + r32;
    const float* xrow = (const float*)(P.ws + WS_X1) + (size_t)row * DM + 8 * hi;
    f32x16 acc = f32x16{}; float ss = 0.f;
    f32x4 xa[4], xb[4];
#pragma unroll
    for (int j = 0; j < 4; ++j) { xa[j] = *(const f32x4*)(xrow + 16 * j); xb[j] = *(const f32x4*)(xrow + 16 * j + 4); }
    for (int ks0 = 0; ks0 < 64; ks0 += 4) {
#pragma unroll
        for (int j = 0; j < 4; ++j) { const int ks = ks0 + j; const f32x4 a = xa[j], b = xb[j];
            const int kn = (ks + 4 < 64) ? ks + 4 : ks; xa[j] = *(const f32x4*)(xrow + 16 * kn); xb[j] = *(const f32x4*)(xrow + 16 * kn + 4);
            ss += (a[0] * a[0] + a[1] * a[1]) + (a[2] * a[2] + a[3] * a[3]) + (b[0] * b[0] + b[1] * b[1]) + (b[2] * b[2] + b[3] * b[3]);
            bf16x8 xh, xl; split8(a, b, xh, xl);
            const bf16x8 wh = *(const LAS bf16x8*)(wlds + woff(r32, 16 * ks + 8 * hi)), wl = *(const LAS bf16x8*)(wlds + 65536 + woff(r32, 16 * ks + 8 * hi));
            acc = __builtin_amdgcn_mfma_f32_32x32x16_bf16(wh, xh, acc, 0, 0, 0); acc = __builtin_amdgcn_mfma_f32_32x32x16_bf16(wh, xl, acc, 0, 0, 0); acc = __builtin_amdgcn_mfma_f32_32x32x16_bf16(wl, xh, acc, 0, 0, 0); }
    }
    ss += __shfl_xor(ss, 32);
    const float rstd = rsqrtf(ss * (1.f / DM) + 1e-6f);
    float lg[16];
#pragma unroll
    for (int g = 0; g < 4; ++g) { const f32x4 bb = *(const f32x4*)(P.b_router + 8 * g + 4 * hi);
#pragma unroll
        for (int i = 0; i < 4; ++i) lg[4 * g + i] = acc[4 * g + i] * rstd + bb[i]; }
    float tv[4]; int ti[4];
#pragma unroll
    for (int k = 0; k < 4; ++k) { float bv = lg[0]; int bi = 4 * hi;
#pragma unroll
        for (int r = 1; r < 16; ++r) { const int e = (r & 3) + 8 * (r >> 2) + 4 * hi; if (lg[r] > bv) { bv = lg[r]; bi = e; } }
        const float pv = __shfl_xor(bv, 32); const int pi = __shfl_xor(bi, 32);
        if (pv > bv || (pv == bv && pi < bi)) { bv = pv; bi = pi; }
        tv[k] = bv; ti[k] = bi;
#pragma unroll
        for (int r = 0; r < 16; ++r) { const int e = (r & 3) + 8 * (r >> 2) + 4 * hi; if (e == bi) lg[r] = -INFINITY; } }
    const float e1 = __expf(tv[1] - tv[0]), e2 = __expf(tv[2] - tv[0]), e3 = __expf(tv[3] - tv[0]), inv = 1.f / (1.f + e1 + e2 + e3);
    const int c0 = hi ? ti[2] : ti[0], c1 = hi ? ti[3] : ti[1]; const float g0 = (hi ? e2 : 1.f) * inv, g1 = (hi ? e3 : e1) * inv;
    const unsigned long long ltm = (1ull << lane) - 1ull; int mycnt = 0, rk0 = 0, rk1 = 0;
    for (int e = 0; e < 32; ++e) { const unsigned long long m0 = __ballot(c0 == e), m1 = __ballot(c1 == e); const int n0 = __popcll(m0);
        if (lane == e) mycnt = n0 + __popcll(m1);
        if (c0 == e) rk0 = __popcll(m0 & ltm);
        if (c1 == e) rk1 = n0 + __popcll(m1 & ltm); }
    unsigned* cnt = (unsigned*)(P.ws + WS_CTL) + CW_CNT; int base = 0;
    if (lane < 32 && mycnt > 0) base = (int)atomicAdd(cnt + lane, (unsigned)mycnt);
    rk0 += __shfl(base, c0); rk1 += __shfl(base, c1);
    int* route = (int*)(P.ws + WS_ROUTE); int* tokslot = (int*)(P.ws + WS_TOKSLOT); float* gateslot = (float*)(P.ws + WS_GATESLOT);
    tokslot[(size_t)c0 * NTOK + rk0] = row; gateslot[(size_t)c0 * NTOK + rk0] = g0; tokslot[(size_t)c1 * NTOK + rk1] = row; gateslot[(size_t)c1 * NTOK + rk1] = g1;
    route[(size_t)row * 12 + 2 * hi] = c0; route[(size_t)row * 12 + 2 * hi + 1] = c1; route[(size_t)row * 12 + 4 + 2 * hi] = rk0; route[(size_t)row * 12 + 4 + 2 * hi + 1] = rk1;
    bf16_t* xn = (bf16_t*)(P.ws + WS_XN) + (size_t)row * DM + 8 * hi; const float* gn = P.moe_norm + 8 * hi;
#pragma unroll 4
    for (int ks = 0; ks < 64; ++ks) { const f32x4 a = *(const f32x4*)(xrow + 16 * ks), b = *(const f32x4*)(xrow + 16 * ks + 4), ga = *(const f32x4*)(gn + 16 * ks), gb = *(const f32x4*)(gn + 16 * ks + 4);
        u32x4 w; w.x = pk2(a[0] * rstd * ga[0], a[1] * rstd * ga[1]); w.y = pk2(a[2] * rstd * ga[2], a[3] * rstd * ga[3]); w.z = pk2(b[0] * rstd * gb[0], b[1] * rstd * gb[1]); w.w = pk2(b[2] * rstd * gb[2], b[3] * rstd * gb[3]);
        *(u32x4*)(xn + 16 * ks) = w; }
}
}
namespace attn_body {
using bf16=unsigned short;
using bf16x8=__attribute__((ext_vector_type(8)))short;
using s16x4=__attribute__((ext_vector_type(4)))short;
using f32x16=__attribute__((ext_vector_type(16)))float;
using u32x4=__attribute__((ext_vector_type(4)))unsigned;
constexpr int BATCH=4,NHEAD=8,SEQ=8192,D=64,DM=3840,OP=1024;
constexpr int NW=8,QBLK=32,QB=QBLK*NW,KVBLK=64,NQB=SEQ/QB;
constexpr int ATTN_PITCH=DM, ATTN_UNIT_ROWS=QB;
__device__ __forceinline__ int crow(int r,int hi){return (r&3)+8*(r>>2)+4*hi;}
#define SBAR() __builtin_amdgcn_sched_barrier(0)
__device__ __forceinline__ void cmask(f32x16&p0,f32x16&p1,int jb,int qrel,int hi){
  const float NEG=-INFINITY; int kb=64*jb+4*hi;
  #pragma unroll
  for(int r=0;r<16;++r){int kv=kb+(r&3)+8*(r>>2); if(kv>qrel)p0[r]=NEG; if(kv+32>qrel)p1[r]=NEG;}
}

constexpr int NSLOT=3, SLOTB=8192;
constexpr int LDS_K=0, LDS_V=NSLOT*SLOTB, LDS_WS=2*NSLOT*SLOTB, LDS_OST=LDS_WS+NW*64*4, LDS_C2=LDS_OST+NW*4096, LDS_BYTES=LDS_C2+SEQ*4;
constexpr float C2=0.125f*1.4426950408889634f;
__device__ __forceinline__ void glds16(const void*gsrc,unsigned lds_dst){unsigned keep;
  asm volatile("s_mov_b32 %0, m0\n\ts_mov_b32 m0, %2\n\ts_nop 0\n\tglobal_load_lds_dwordx4 %1, off\n\ts_mov_b32 m0, %0":"=&s"(keep):"v"(gsrc),"s"(lds_dst):"memory");}
__device__ __forceinline__ float max3f(float a,float b,float c){float r;asm("v_max3_f32 %0, %1, %2, %3":"=v"(r):"v"(a),"v"(b),"v"(c));return r;}
__device__ __forceinline__ float max2f(float a,float b){float r;asm("v_max_f32_e32 %0, %1, %2":"=v"(r):"v"(a),"v"(b));return r;}
__device__ __forceinline__ float fadd_s(float a,float b){float r;asm("v_add_f32_e32 %0, %1, %2":"=v"(r):"v"(a),"v"(b));return r;}
__device__ __forceinline__ float fsub_s(float a,float b){float r;asm("v_sub_f32_e32 %0, %1, %2":"=v"(r):"v"(a),"v"(b));return r;}
typedef float f32x2_t __attribute__((ext_vector_type(2))); typedef float f32x4v __attribute__((ext_vector_type(4))); typedef __bf16 bf16x2_t __attribute__((ext_vector_type(2)));
__device__ __forceinline__ unsigned cvtpk_s(float lo,float hi){f32x2_t v={lo,hi};bf16x2_t b=__builtin_convertvector(v,bf16x2_t);return __builtin_bit_cast(unsigned,b);}
#define WAIT_BAR(N) asm volatile("s_waitcnt vmcnt(" #N ") lgkmcnt(0)\n\ts_barrier":::"memory")

__device__ __forceinline__ void qkt(f32x16&p0,f32x16&p1,const char*Kslot,const bf16x8*qr,int r32,int hi){
  const char*kb=Kslot+hi*1024+r32*16;
  #pragma unroll
  for(int d0=0;d0<4;++d0){
    const bf16x8 b0=*reinterpret_cast<const bf16x8*>(kb+d0*2048);
    const bf16x8 b1=*reinterpret_cast<const bf16x8*>(kb+d0*2048+512);
    p0=__builtin_amdgcn_mfma_f32_32x32x16_bf16(b0,qr[d0],p0,0,0,0);p1=__builtin_amdgcn_mfma_f32_32x32x16_bf16(b1,qr[d0],p1,0,0,0);}
}
typedef __attribute__((address_space(3))) const char* lds_cptr;
typedef short v4i16_t __attribute__((ext_vector_type(4)));
__device__ __forceinline__ void kload8(bf16x8*kf,lds_cptr kp){
  kf[0]=*(const __attribute__((address_space(3))) bf16x8*)(kp);      kf[1]=*(const __attribute__((address_space(3))) bf16x8*)(kp+512);
  kf[2]=*(const __attribute__((address_space(3))) bf16x8*)(kp+2048); kf[3]=*(const __attribute__((address_space(3))) bf16x8*)(kp+2560);
  kf[4]=*(const __attribute__((address_space(3))) bf16x8*)(kp+4096); kf[5]=*(const __attribute__((address_space(3))) bf16x8*)(kp+4608);
  kf[6]=*(const __attribute__((address_space(3))) bf16x8*)(kp+6144); kf[7]=*(const __attribute__((address_space(3))) bf16x8*)(kp+6656);
}
__device__ __forceinline__ void kload2(bf16x8*kf,lds_cptr kp,int j){ kf[2*j]=*(const __attribute__((address_space(3))) bf16x8*)(kp+j*2048); kf[2*j+1]=*(const __attribute__((address_space(3))) bf16x8*)(kp+j*2048+512); }
__device__ __forceinline__ s16x4 vtr(lds_cptr p){ return __builtin_bit_cast(s16x4,__builtin_amdgcn_ds_read_tr16_b64_v4i16((__attribute__((address_space(3))) v4i16_t*)p)); }
__device__ __forceinline__ float rowmax(const f32x16&p0,const f32x16&p1){
  float a=max3f(p0[0],p0[1],p1[0]),b=max3f(p0[2],p0[3],p1[1]);a=max3f(a,p1[2],p1[3]);
  #pragma unroll
  for(int r=4;r<16;r+=4){a=max3f(a,p0[r],p0[r+1]);b=max3f(b,p0[r+2],p0[r+3]);a=max3f(a,p1[r],p1[r+1]);b=max3f(b,p1[r+2],p1[r+3]);}
  const float m=max2f(a,b);
  auto rr=__builtin_amdgcn_permlane32_swap(__float_as_uint(m),__float_as_uint(m),false,false);
  return max2f(__uint_as_float(rr[0]),__uint_as_float(rr[1]));
}
__device__ __forceinline__ void pv(f32x16*o,int vb,bf16x8 pa0,bf16x8 pa1,bf16x8 pa2,bf16x8 pa3){
  #pragma unroll
  for(int d0=0;d0<2;++d0){s16x4 lo[4],hi[4];
    #pragma unroll
    for(int ks=0;ks<4;++ks){
      asm volatile("ds_read_b64_tr_b16 %0,%1 offset:%c2":"=&v"(lo[ks]):"v"(vb),"i"(d0*4096+ks*1024):"memory");
      asm volatile("ds_read_b64_tr_b16 %0,%1 offset:%c2":"=&v"(hi[ks]):"v"(vb),"i"(d0*4096+ks*1024+512):"memory");}
    asm volatile("s_waitcnt lgkmcnt(0)":::"memory");SBAR();
    #define PK(k) (bf16x8){lo[k][0],lo[k][1],lo[k][2],lo[k][3],hi[k][0],hi[k][1],hi[k][2],hi[k][3]}
    o[d0]=__builtin_amdgcn_mfma_f32_32x32x16_bf16(pa0,PK(0),o[d0],0,0,0);
    o[d0]=__builtin_amdgcn_mfma_f32_32x32x16_bf16(pa1,PK(1),o[d0],0,0,0);
    o[d0]=__builtin_amdgcn_mfma_f32_32x32x16_bf16(pa2,PK(2),o[d0],0,0,0);
    o[d0]=__builtin_amdgcn_mfma_f32_32x32x16_bf16(pa3,PK(3),o[d0],0,0,0);
    #undef PK
  }
}

#ifndef ATTN_STORE16
#define ATTN_STORE16(p,v) (*(u32x4*)(p)=(v))
#endif
template<int THRL> __device__ __forceinline__ void attn_unit(int b,int h,int qb,int t0,const bf16*Z,const float*c2g,bf16*O,char*shm){
  const int tid=threadIdx.x,lane=tid&63,r32=lane&31,hi=lane>>5; const int wid=__builtin_amdgcn_readfirstlane(tid>>6);
  const long rowbase=(long)b*SEQ; const int q0=qb*QB;
  const bf16*Qw=Z+(rowbase+q0+wid*QBLK)*DM+h*D;
  const bf16*Kh=Z+(rowbase+(long)t0*KVBLK)*DM+512+h*D,*Vh=Z+(rowbase+(long)t0*KVBLK)*DM+1024+h*D;
  const unsigned lds0=(unsigned)(uintptr_t)shm;
  float*wsf=(float*)(shm+LDS_WS)+wid*64;
  const bf16*ksrc=Kh+(long)lane*DM+wid*8;
  const bf16*vsrc=Vh+(long)(16*(wid&3)+(lane>>2))*DM+(wid>>2)*32+(lane&3)*8;
  const unsigned kdst=lds0+LDS_K+wid*1024, vdst=lds0+LDS_V+wid*1024;
  #define DMA_K(t,slot) glds16(ksrc+(long)(t)*KVBLK*DM,(unsigned)__builtin_amdgcn_readfirstlane(kdst+(slot)))
  #define DMA_V(t,slot) glds16(vsrc+(long)(t)*KVBLK*DM,(unsigned)__builtin_amdgcn_readfirstlane(vdst+(slot)))
  const int vb0=(int)(lds0+LDS_V)+((lane>>4)&1)*32+(lane&3)*8+(4*hi+((lane&15)>>2))*64;
  const char*Kbase=shm+LDS_K; bf16x8 kf[8];
  const lds_cptr shm3=(lds_cptr)shm; const lds_cptr kp0=shm3+LDS_K+hi*1024+r32*16; const lds_cptr vp0=shm3+LDS_V+((lane>>4)&1)*32+(lane&3)*8+(4*hi+((lane&15)>>2))*64;
  const int NT=(q0+QB)/KVBLK-t0;
  { const int np=(q0+QB)/256;
    for(int p=(t0>>2)+wid;p<np;p+=NW) glds16(c2g+p*256+lane*4,(unsigned)__builtin_amdgcn_readfirstlane(lds0+LDS_C2+p*1024)); }
  const __attribute__((address_space(3))) float* c2l=(const __attribute__((address_space(3))) float*)(shm3+LDS_C2)+t0*KVBLK+4*hi;
  DMA_K(0,0);DMA_V(0,0);DMA_K(1,SLOTB);
  bf16x8 qr[4];
  #pragma unroll
  for(int d0=0;d0<4;++d0)qr[d0]=*reinterpret_cast<const bf16x8*>(&Qw[(long)r32*DM+d0*16+hi*8]);
  float l_reg=0.f;f32x16 o[2];o[0]=f32x16{};o[1]=f32x16{};
  float base=c2g[q0+wid*QBLK+r32];
  const int qrel=wid*QBLK+r32;
  #define CMASK(P0,P1,t) do{int jb_=(t)-(NT-4); if(jb_>=0)cmask(P0,P1,jb_,qrel,hi);}while(0)
  bool resc=false;
  #define START(P0,P1) do{ const float rm=rowmax(P0,P1); resc=false; \
    { const float dl=rm; base=fsub_s(base,dl); \
      _Pragma("unroll") for(int r=0;r<16;++r){P0[r]=fsub_s(P0[r],dl);P1[r]=fsub_s(P1[r],dl);} } \
    _Pragma("unroll") for(int r=0;r<16;++r)P0[r]=__builtin_amdgcn_exp2f(P0[r]); }while(0)
  #define RESC() do{ if(resc){ asm volatile("s_waitcnt lgkmcnt(0)":::"memory"); \
      _Pragma("unroll") for(int d_=0;d_<2;++d_) _Pragma("unroll") for(int r=0;r<16;++r)o[d_][r]*=wsf[crow(r,hi)]; } }while(0)
  f32x16 pA0,pA1,pB0,pB1;
  #define BIASLD(P0,P1,tt) do{ _Pragma("unroll") for(int g_=0;g_<4;++g_){ const f32x4v x0_=*(const __attribute__((address_space(3))) f32x4v*)(c2l+(tt)*KVBLK+8*g_), x1_=*(const __attribute__((address_space(3))) f32x4v*)(c2l+(tt)*KVBLK+32+8*g_); \
      P0[4*g_]=x0_[0];P0[4*g_+1]=x0_[1];P0[4*g_+2]=x0_[2];P0[4*g_+3]=x0_[3]; P1[4*g_]=x1_[0];P1[4*g_+1]=x1_[1];P1[4*g_+2]=x1_[2];P1[4*g_+3]=x1_[3]; } }while(0)
  #define BIASFIX(P0,P1) do{ _Pragma("unroll") for(int r=0;r<16;++r){P0[r]=fsub_s(base,P0[r]);P1[r]=fsub_s(base,P1[r]);} }while(0)
  int sl_prev=0,sl_cur=0,sl_next=SLOTB;
  #define ROT() do{sl_prev=sl_cur;sl_cur=sl_next;sl_next=(sl_next==(NSLOT-1)*SLOTB)?0:sl_next+SLOTB;}while(0)
  DMA_K(2,2*SLOTB);
  WAIT_BAR(3);
  BIASLD(pA0,pA1,0); BIASFIX(pA0,pA1);
  qkt(pA0,pA1,Kbase,qr,r32,hi);asm volatile("s_nop 15\n\ts_nop 7":"+v"(pA0),"+v"(pA1));CMASK(pA0,pA1,0);
  START(pA0,pA1);
  _Pragma("unroll") for(int r=0;r<16;++r)pA1[r]=__builtin_amdgcn_exp2f(pA1[r]);
  BIASLD(pB0,pB1,1);
  WAIT_BAR(0);
  DMA_K(3,0);DMA_V(1,SLOTB);
  ROT();
  kload8(kf,kp0+sl_cur);
  WAIT_BAR(2);
  s16x4 vlo[8],vhi[8]; u32x4 pw0,pw1,pw2,pw3;
  #define PKW(P,B) cvtpk_s(P[B],P[B+1])
  #define PAF(k) __builtin_bit_cast(bf16x8,pw##k)
  #define VFR(i) (bf16x8){vlo[i][0],vlo[i][1],vlo[i][2],vlo[i][3],vhi[i][0],vhi[i][1],vhi[i][2],vhi[i][3]}
  #define PIN(x) asm volatile("":"+v"(x))
  #define MX3(a,b,c) __builtin_fmaxf(__builtin_fmaxf((a),(b)),(c))
  #define GAPA(MF,A0,A1,A2,A3,W0,W1,PW) do{ MF; sacc+=A0; sacc+=A1; sacc+=A2; sacc+=A3; PIN(sacc); W0; W1; PIN(PW); SBAR(); }while(0)
  #define EX(v) __builtin_amdgcn_exp2f(v)
  #define GAPB(MF,X,B) do{ MF; X[B]=EX(X[B]); X[B+1]=EX(X[B+1]); X[B+2]=EX(X[B+2]); X[B+3]=EX(X[B+3]); PIN(X); SBAR(); }while(0)
  #define VRD(i) do{ vlo[i]=vtr(vp_+(((i)>>2)*4096+((i)&3)*1024)); vhi[i]=vtr(vp_+(((i)>>2)*4096+((i)&3)*1024+512)); }while(0)
  #define KRD(G,j) do{ if(G){ kload2(kf,kp0+sl_next,j); SBAR(); } }while(0)
  #define STEP(C0,C1,P0,P1,t,GK,GV,GL) do{ SBAR(); \
    BIASFIX(C0,C1); SBAR(); \
    const lds_cptr vp_=vp0+sl_prev; \
    VRD(0); SBAR(); float sacc=(P0[0]+P0[1]); \
    GAPA(C0=__builtin_amdgcn_mfma_f32_32x32x16_bf16(kf[0],qr[0],C0,0,0,0), P0[2],P0[3],P0[4],P0[5],     pw0[0]=PKW(P0,0), pw0[1]=PKW(P0,2), pw0); \
    VRD(4); SBAR(); GAPA(C1=__builtin_amdgcn_mfma_f32_32x32x16_bf16(kf[1],qr[0],C1,0,0,0), P0[6],P0[7],P0[8],P0[9],     pw0[2]=PKW(P0,4), pw0[3]=PKW(P0,6), pw0); \
    VRD(1); SBAR(); GAPA(C0=__builtin_amdgcn_mfma_f32_32x32x16_bf16(kf[2],qr[1],C0,0,0,0),   P0[10],P0[11],P0[12],P0[13], pw1[0]=PKW(P0,8), pw1[1]=PKW(P0,10), pw1); \
    VRD(5); SBAR(); GAPA(C1=__builtin_amdgcn_mfma_f32_32x32x16_bf16(kf[3],qr[1],C1,0,0,0),   P0[14],P0[15],P1[0],P1[1],   pw1[2]=PKW(P0,12),pw1[3]=PKW(P0,14), pw1); \
    VRD(2); SBAR(); GAPA(C0=__builtin_amdgcn_mfma_f32_32x32x16_bf16(kf[4],qr[2],C0,0,0,0),   P1[2],P1[3],P1[4],P1[5],     pw2[0]=PKW(P1,0), pw2[1]=PKW(P1,2), pw2); \
    VRD(6); SBAR(); GAPA(C1=__builtin_amdgcn_mfma_f32_32x32x16_bf16(kf[5],qr[2],C1,0,0,0),   P1[6],P1[7],P1[8],P1[9],     pw2[2]=PKW(P1,4), pw2[3]=PKW(P1,6), pw2); \
    VRD(3); SBAR(); GAPA(C0=__builtin_amdgcn_mfma_f32_32x32x16_bf16(kf[6],qr[3],C0,0,0,0),   P1[10],P1[11],P1[12],P1[13], pw3[0]=PKW(P1,8), pw3[1]=PKW(P1,10), pw3); \
    VRD(7); SBAR(); GAPA(C1=__builtin_amdgcn_mfma_f32_32x32x16_bf16(kf[7],qr[3],C1,0,0,0),   P1[14],P1[15],0.f,0.f,       pw3[2]=PKW(P1,12),pw3[3]=PKW(P1,14), pw3); \
    l_reg+=sacc; \
    if(GL){BIASLD(P0,P1,(t)+1);} \
    if(GK){DMA_K((t)+3,sl_cur);} if(GV){DMA_V((t)+1,sl_next);} \
    CMASK(C0,C1,t); \
    { float a=MX3(C0[0],C0[1],C1[0]),b=MX3(C0[2],C0[3],C1[1]); a=MX3(a,C1[2],C1[3]); \
      _Pragma("unroll") for(int r=4;r<16;r+=4){a=MX3(a,C0[r],C0[r+1]);b=MX3(b,C0[r+2],C0[r+3]);a=MX3(a,C1[r],C1[r+1]);b=MX3(b,C1[r+2],C1[r+3]);} \
      float rm=__builtin_fmaxf(a,b); { auto rr=__builtin_amdgcn_permlane32_swap(__float_as_uint(rm),__float_as_uint(rm),false,false); rm=__builtin_fmaxf(__uint_as_float(rr[0]),__uint_as_float(rr[1])); } \
      resc=false; \
      if(__builtin_expect(__any(rm>(float)THRL),0)){ const float dl=__builtin_fmaxf(rm,0.f); base-=dl; \
        _Pragma("unroll") for(int r=0;r<16;++r){C0[r]-=dl;C1[r]-=dl;} \
        const float f=__builtin_amdgcn_exp2f(-dl); l_reg*=f; if(hi==0)wsf[r32]=f; resc=true; } } \
    SBAR(); \
    GAPB(o[0]=__builtin_amdgcn_mfma_f32_32x32x16_bf16(PAF(0),VFR(0),o[0],0,0,0), C0,0); \
    GAPB(o[1]=__builtin_amdgcn_mfma_f32_32x32x16_bf16(PAF(0),VFR(4),o[1],0,0,0), C0,4); \
    KRD(GL,0); GAPB(o[0]=__builtin_amdgcn_mfma_f32_32x32x16_bf16(PAF(1),VFR(1),o[0],0,0,0), C0,8); \
    KRD(GL,1); GAPB(o[1]=__builtin_amdgcn_mfma_f32_32x32x16_bf16(PAF(1),VFR(5),o[1],0,0,0), C0,12); \
    KRD(GL,2); GAPB(o[0]=__builtin_amdgcn_mfma_f32_32x32x16_bf16(PAF(2),VFR(2),o[0],0,0,0), C1,0); \
    KRD(GL,3); GAPB(o[1]=__builtin_amdgcn_mfma_f32_32x32x16_bf16(PAF(2),VFR(6),o[1],0,0,0), C1,4); \
    GAPB(o[0]=__builtin_amdgcn_mfma_f32_32x32x16_bf16(PAF(3),VFR(3),o[0],0,0,0), C1,8); \
    GAPB(o[1]=__builtin_amdgcn_mfma_f32_32x32x16_bf16(PAF(3),VFR(7),o[1],0,0,0), C1,12); \
    }while(0)
  int t=1;
  #undef CMASK
  #define CMASK(P0,P1,t) do{}while(0)
  for(;t+5<NT;t+=2){
    STEP(pB0,pB1,pA0,pA1,t,true,true,true);     WAIT_BAR(2); RESC(); ROT();
    STEP(pA0,pA1,pB0,pB1,t+1,true,true,true);   WAIT_BAR(2); RESC(); ROT();
  }
  #undef CMASK
  #define CMASK(P0,P1,t) do{int jb_=(t)-(NT-4); if(jb_>=0)cmask(P0,P1,jb_,qrel,hi);}while(0)
  #define ENDW(tt) do{ if((tt)+3<NT){WAIT_BAR(2);} else if((tt)+2<NT){WAIT_BAR(1);} else {WAIT_BAR(0);} }while(0)
  for(;t+1<NT;t+=2){
    STEP(pB0,pB1,pA0,pA1,t,(t+3<NT),(t+1<NT),(t+1<NT));       ENDW(t);   RESC(); ROT();
    STEP(pA0,pA1,pB0,pB1,t+1,(t+4<NT),(t+2<NT),(t+2<NT));     ENDW(t+1); RESC(); ROT();
  }
  STEP(pB0,pB1,pA0,pA1,NT-1,false,false,false); RESC();
  { float sacc=pB0[0]+pB0[1]; _Pragma("unroll") for(int r=2;r<16;++r)sacc+=pB0[r]; _Pragma("unroll") for(int r=0;r<16;++r)sacc+=pB1[r]; l_reg+=sacc;
    pw0=(u32x4){PKW(pB0,0),PKW(pB0,2),PKW(pB0,4),PKW(pB0,6)};pw1=(u32x4){PKW(pB0,8),PKW(pB0,10),PKW(pB0,12),PKW(pB0,14)};pw2=(u32x4){PKW(pB1,0),PKW(pB1,2),PKW(pB1,4),PKW(pB1,6)};pw3=(u32x4){PKW(pB1,8),PKW(pB1,10),PKW(pB1,12),PKW(pB1,14)};
    SBAR(); pv(o,vb0+sl_cur,PAF(0),PAF(1),PAF(2),PAF(3)); }
  #undef PKW
  #undef PAF
  #undef VFR
  #undef PIN
  #undef MX3
  #undef GAPA
  #undef GAPB
  #undef EX
  #undef VRD
  #undef KRD
  #undef STEP
  #undef ENDW
  {auto rr=__builtin_amdgcn_permlane32_swap(__float_as_uint(l_reg),__float_as_uint(l_reg),false,false);l_reg=__uint_as_float(rr[0])+__uint_as_float(rr[1]);}
  if(hi==0)wsf[32+r32]=l_reg;asm volatile("s_waitcnt lgkmcnt(0)":::"memory");
  float rli[16];
  #pragma unroll
  for(int r=0;r<16;++r)rli[r]=__builtin_amdgcn_rcpf(wsf[32+crow(r,hi)]);
  bf16*Ow=O+(rowbase+q0+wid*QBLK)*OP+h*D; const bf16*Gw=Z+(rowbase+q0+wid*QBLK)*DM+1536+h*D;
  { bf16*stg=(bf16*)(shm+LDS_OST)+wid*2048;
    #pragma unroll
    for(int r=0;r<16;++r){const int orow=crow(r,hi);
      #pragma unroll
      for(int d0=0;d0<2;++d0)stg[orow*64+d0*32+r32]=(bf16)f2bf(o[d0][r]*rli[r]);}
    asm volatile("s_waitcnt lgkmcnt(0)":::"memory");
    #pragma unroll
    for(int i=0;i<4;++i){const int row=i*8+(lane>>3),ch=lane&7; const u32x4 v=*(const u32x4*)(stg+row*64+ch*8), g=*(const u32x4*)(Gw+(long)row*DM+ch*8);
      const unsigned vw[4]={v.x,v.y,v.z,v.w},gw[4]={g.x,g.y,g.z,g.w}; unsigned ow[4];
      #pragma unroll
      for(int j=0;j<4;++j){ const float a0=bflo(vw[j])/(1.0f+__expf(-bflo(gw[j]))), a1=bfhi(vw[j])/(1.0f+__expf(-bfhi(gw[j]))); ow[j]=cvtpk_s(a0,a1); }
      ATTN_STORE16(Ow+(long)row*OP+ch*8,((u32x4){ow[0],ow[1],ow[2],ow[3]}));} }
  asm volatile("s_waitcnt lgkmcnt(0)\n\ts_barrier":::"memory");
  #undef DMA_K
  #undef DMA_V
  #undef CMASK
  #undef START
  #undef RESC
  #undef ROT
}
constexpr int ATTN_LDS_BYTES=LDS_BYTES;
#undef SBAR
#undef WAIT_BAR
}
constexpr int CW_QATT = 128;
constexpr int MISC_TAB = 64, MISC_Q = 4096, MISC_PFX = 4160;

__device__ __forceinline__ int attn_t0(KPR P, const float* c2, int q0, int lane) {
    float gq = fabsf(P.q_norm[lane]), gk = fabsf(P.k_norm[lane]);
#pragma unroll
    for (int o = 1; o < 64; o <<= 1) { gq = fmaxf(gq, __shfl_xor(gq, o)); gk = fmaxf(gk, __shfl_xor(gk, o)); }
    const float thr = c2[q0] + (2.0f * 8.0f * LOG2E * gq * gk + 40.0f);
    const int nfull = q0 / 64; int t0 = 0;
    for (int tb = 0; tb < nfull; tb += 64) { const int tt = tb + lane; const bool sk = (tt < nfull) && (c2[tt * 64 + 63] > thr); const unsigned long long bm = __ballot(sk); t0 += __popcll(bm); if (bm != ~0ull) break; }
    return __builtin_amdgcn_readfirstlane(t0) & ~1;
}
__device__ __forceinline__ void combine_row(KPR P, const LAS int* tab, int row, int lane) {
    const int* route = (const int*)(P.ws + WS_ROUTE); const bf16_t* YP = (const bf16_t*)(P.ws + WS_YP); float* X = (float*)(P.ws + WS_X1);
    f32x4 v[4]; const f32x4* xr = (const f32x4*)(X + (size_t)row * DM) + lane;
#pragma unroll
    for (int j = 0; j < 4; ++j) v[j] = xr[64 * j];
#pragma unroll
    for (int k = 0; k < 4; ++k) { const int ex = route[(size_t)row * 12 + k], rank = route[(size_t)row * 12 + 4 + k]; const size_t pos = (size_t)tab[pg8::T_BLKSTART + ex] * 256 + rank;
        const u32x2* yr = (const u32x2*)(YP + pos * DM) + lane;
#pragma unroll
        for (int j = 0; j < 4; ++j) { const u32x2 y = yr[64 * j]; v[j][0] += bflo(y.x); v[j][1] += bfhi(y.x); v[j][2] += bflo(y.y); v[j][3] += bfhi(y.y); } }
    f32x4* xo = (f32x4*)(X + (size_t)row * DM) + lane; float s = 0.f;
#pragma unroll
    for (int j = 0; j < 4; ++j) { xo[64 * j] = v[j]; s += (v[j][0] * v[j][0] + v[j][1] * v[j][1]) + (v[j][2] * v[j][2] + v[j][3] * v[j][3]); }
    const float rstd = rsqrtf(wave_sum(s) * (1.f / DM) + 1e-6f);
#pragma unroll
    for (int j = 0; j < 4; ++j) v[j] = v[j] * rstd * ((const f32x4*)P.ple_norm)[64 * j + lane];
    store_row_bf16((bf16_t*)(P.ws + WS_XN) + (size_t)row * DM, lane, v);
}

constexpr int NPHASE = 13;
__global__ void __launch_bounds__(NTHREADS, 2) mega_fwd(Params Pkarg_unused) {
    extern __shared__ __attribute__((aligned(16))) unsigned char smem[];
    LAS unsigned char* lds = (LAS unsigned char*)smem;
    const int tid = threadIdx.x, lane = tid & 63, wave = __builtin_amdgcn_readfirstlane(tid >> 6);
    const int G = gridDim.x, blk = blockIdx.x;
#define P (*kpp)
#ifndef MK_REP
#define MK_REP -1
#endif
#define PHASE_BEGIN(k) if (IN(k)) for (int rep_ = 0; rep_ < ((k) == MK_REP ? 2 : 1); ++rep_) { const __attribute__((address_space(4))) Params* kpp = kp_fresh();
#define PHASE_END(k) } if (BOTH(k)) xcd_barrier(bar);
#define IN(k) (ph_lo <= (k) && (k) < ph_hi)
#define BOTH(k) (IN(k) && IN((k) + 1))
    const __attribute__((address_space(4))) Params* kpp = kp_fresh();
    unsigned* ctl = (unsigned*)(P.ws + WS_CTL);
    volatile LAS unsigned* MISC = (volatile LAS unsigned*)(lds + MISC_OFF);
    LAS int* tab = (LAS int*)(lds + MISC_OFF + MISC_TAB);
    if (tid < 16) MISC[tid] = 0u;
    __syncthreads();
    XcdBarrier bar = xcd_barrier_post(ctl + CW_BAR, MISC);
    unsigned char* const wsb = P.ws;
    const int ph_lo = P.ph_lo, ph_hi = P.ph_hi;

    PHASE_BEGIN(0)
        phase_prep_weights(P, lds, blk * NWAVES + wave, G * NWAVES, wave, lane);
        phase_cvt_p(P, blk * NTHREADS + tid, G * NTHREADS);
        __syncthreads();
        LAS float* wff = (LAS float*)lds; LAS float* lf = (LAS float*)(lds + 32768);
        load_wff(P, wff, tid, NTHREADS); __syncthreads();
        for (int i = 0; i < 16; ++i) { const int rl = wave * 16 + i; norm1_row(P, blk * 128 + rl, lane, wff, lf + rl * 8); }
        __syncthreads();
        if (tid < 8) { float run = 0.f; float* cloc = (float*)(P.ws + WS_LOGF) + (size_t)blk * 128 * 8 + tid;
            for (int r = 0; r < 128; ++r) { run += lf[r * 8 + tid]; cloc[r * 8] = run; }
            ((float*)(P.ws + WS_CTOT))[blk * 8 + tid] = run; }
        if (blk == 0) { bf16_t* zr = (bf16_t*)(P.ws + WS_XN) + (size_t)NTOK * DM; for (int i = tid; i < DM; i += NTHREADS) zr[i] = 0; }
    PHASE_END(0)

    PHASE_BEGIN(1)
        {
            LAS float* pfx = (LAS float*)(lds + MISC_OFF + MISC_PFX);
            if (tid < 64) { const float* ct = (const float*)(wsb + WS_CTOT); const int j = (blk & ~63) + tid; float v8[8];
#pragma unroll
                for (int h = 0; h < 8; ++h) v8[h] = (j < blk) ? ct[j * 8 + h] : 0.f;
#pragma unroll
                for (int h = 0; h < 8; ++h) { const float s = wave_sum(v8[h]); if (tid == 0) pfx[h] = s; } }
            __syncthreads();
            const float* cloc = (const float*)(wsb + WS_LOGF) + (size_t)blk * 128 * 8; float* c2 = (float*)(P.ws + WS_C2);
            for (int i = tid; i < 1024; i += NTHREADS) { const int r = i >> 3, h = i & 7; const int row = blk * 128 + r, b = row >> 13, t = row & (SEQ - 1);
                c2[((size_t)(b * 8 + h)) * SEQ + t] = (cloc[i] + pfx[h]) * LOG2E; }
            __syncthreads();
        }
        {
            pg8::DenseOrder S{(const bf16_t*)(wsb + WS_XN), (const bf16_t*)(wsb + WS_WIN), 1024, NTOK / 256, ZW / 256, G, blk};
            pg8::EpiIn E{(bf16_t*)(P.ws + WS_Z), P.q_norm, P.k_norm};
            pg8::gemm_phase<pg8::EpiIn, pg8::DenseOrder, true>(lds, 1024, S, E);
        }
        {
            pg8::DenseOrder S{(const bf16_t*)((unsigned char*)P.out + DO_PB), (const bf16_t*)(wsb + WS_WPP), PLE, NTOK / 256, DM / 256, G, blk};
            pg8::EpiBf16 E{(bf16_t*)((unsigned char*)P.out + DO_PJ), DM};
            pg8::gemm_phase<pg8::EpiBf16, pg8::DenseOrder, true>(lds, PLE, S, E);
        }
    PHASE_END(1)

    PHASE_BEGIN(2)
        for (int task = wave * G + blk; task < NTOK / 32; task += NWAVES * G) rk::lora_task(P, task, lane);
    PHASE_END(2)

    PHASE_BEGIN(3)
        for (int task = blk; task < NB * NH * rk::NCHUNK; task += G) rk::pass1_chunk(P, lds, task >> 7, task & 127, tid);
    PHASE_END(3)

    PHASE_BEGIN(4)
        if (blk < NB * NH) rk::pass2_seq(P, lds, blk, tid);
        for (;;) {
            __syncthreads();
            if (tid == 0) MISC[MISC_Q / 4] = __hip_atomic_fetch_add(ctl + CW_QATT + 64 * rep_, 1u, RLX_AGENT);
            __syncthreads();
            const int q = (int)MISC[MISC_Q / 4];
            if (q >= 1024) break;
            { const int bh = q & 31, qb = 31 - (q >> 5); const float* c2 = (const float*)(wsb + WS_C2) + (size_t)bh * SEQ;
              const int t0 = attn_t0(P, c2, qb * 256, lane);
              attn_body::attn_unit<8>(bh >> 3, bh & 7, qb, t0, (const bf16_t*)(wsb + WS_Z), c2, (bf16_t*)(P.ws + WS_AO), (char*)smem); }
        }
    PHASE_END(4)

    PHASE_BEGIN(5)
        for (int task = blk; task < NB * NH * rk::NCHUNK; task += G) rk::pass3_chunk(P, lds, task >> 7, task & 127, tid);
    PHASE_END(5)

    PHASE_BEGIN(6)
        pg8::DenseOrder S{(const bf16_t*)(wsb + WS_AO), (const bf16_t*)(wsb + WS_WOUT), 1024, NTOK / 256, DM / 256, G, blk};
        pg8::EpiOut E{P.x, (float*)(P.ws + WS_X1)};
        pg8::gemm_phase<pg8::EpiOut, pg8::DenseOrder, true>(lds, 1024, S, E);
    PHASE_END(6)

    PHASE_BEGIN(7)
        rt::build_w(P, lds, tid);
        __syncthreads();
        for (int task = wave * G + blk; task < NTOK / 32; task += NWAVES * G) rt::route_task(P, lds, task, lane);
    PHASE_END(7)

    PHASE_BEGIN(8)
        const int nblk = pg8::moe_tables(tab, (const unsigned*)(wsb + WS_CTL) + CW_CNT);
        pg8::MoeOrder S{(const bf16_t*)(wsb + WS_XN), (const bf16_t*)(wsb + WS_WGU), (const int*)(wsb + WS_TOKSLOT), (const float*)(wsb + WS_GATESLOT), tab, nblk, 8, G, blk, true};
        pg8::EpiGu E{(bf16_t*)(P.ws + WS_ACT), P.b_gu};
        pg8::gemm_phase<pg8::EpiGu, pg8::MoeOrder, true>(lds, 1024, S, E);
    PHASE_END(8)
    PHASE_BEGIN(9)
        const int nblk = pg8::moe_tables(tab, (const unsigned*)(wsb + WS_CTL) + CW_CNT);
        pg8::MoeOrder S{(const bf16_t*)(wsb + WS_ACT), (const bf16_t*)(wsb + WS_WDN), (const int*)(wsb + WS_TOKSLOT), (const float*)(wsb + WS_GATESLOT), tab, nblk, 4, G, blk, false};
        pg8::EpiDn E{(bf16_t*)(P.ws + WS_YP), P.b_down, (const float*)(wsb + WS_GATESLOT), tab};
        pg8::gemm_phase<pg8::EpiDn, pg8::MoeOrder, true>(lds, 1024, S, E);
    PHASE_END(9)
    PHASE_BEGIN(10)
        (void)pg8::moe_tables(tab, (const unsigned*)(wsb + WS_CTL) + CW_CNT);
        for (int row = blk * NWAVES + wave; row < NTOK; row += G * NWAVES) combine_row(P, tab, row, lane);
    PHASE_END(10)
    PHASE_BEGIN(11)
        pg8::DenseOrder S{(const bf16_t*)(wsb + WS_XN), (const bf16_t*)(wsb + WS_WPG), 1024, NTOK / 256, DM / 256, G, blk};
        pg8::EpiPg E{(float*)(P.ws + WS_X1), (const bf16_t*)((unsigned char*)P.out + DO_PJ)};
        pg8::gemm_phase<pg8::EpiPg, pg8::DenseOrder, true>(lds, 1024, S, E);
    PHASE_END(11)
    PHASE_BEGIN(12)
        const bool dead = __hip_atomic_load(ctl + CW_BAR + XB_TMO, RLX_AGENT) != 0u;
        for (int row = blk * NWAVES + wave; row < NTOK; row += G * NWAVES) final_row(P, row, lane, dead);
    PHASE_END(12)
}
#undef P
extern "C" void kernel_launch(void* const* d_in, const int* in_sizes, int n_in, void* d_out, int out_size, void* d_ws, size_t ws_size, hipStream_t stream) {
    static int ok = 0;
    if (ok == 0) {
        if (n_in != 30 || in_sizes[0] != NTOK * DM || out_size != NTOK * DM || ws_size < WS_END) { fprintf(stderr, "kernel_launch: unexpected shapes (n_in %d, ws %zu)\n", n_in, ws_size); ok = -1; return; }
        if (hipFuncSetAttribute((const void*)mega_fwd, hipFuncAttributeMaxDynamicSharedMemorySize, LDS_BYTES) != hipSuccess) { fprintf(stderr, "kernel_launch: hipFuncSetAttribute failed\n"); ok = -1; return; }
        int dev = 0, cus = 0, per_cu = 0;
        if (hipGetDevice(&dev) != hipSuccess || hipDeviceGetAttribute(&cus, hipDeviceAttributeMultiprocessorCount, dev) != hipSuccess) { ok = -1; return; }
        if (hipOccupancyMaxActiveBlocksPerMultiprocessor(&per_cu, (const void*)mega_fwd, NTHREADS, LDS_BYTES) != hipSuccess || per_cu < 1) { fprintf(stderr, "kernel_launch: occupancy query says %d\n", per_cu); }
        (void)hipGetLastError();
        if (cus != 256) { fprintf(stderr, "kernel_launch: built for 256 CUs, device has %d\n", cus); ok = -1; return; }
        ok = 1;
    }
    if (ok < 0) return;
    Params P{};
    const float** pp = (const float**)&P;
    for (int i = 0; i < 30; ++i) pp[i] = (const float*)d_in[i];
    P.out = (float*)d_out; P.ws = (unsigned char*)d_ws;
    if (hipMemsetAsync((char*)d_ws + WS_CTL, 0, CTL_BYTES, stream) != hipSuccess) return;
#ifndef MK_CUTS
#define MK_CUTS 0
#endif
    if (MK_CUTS == 0) { P.ph_lo = 0; P.ph_hi = NPHASE; hipLaunchKernelGGL(mega_fwd, dim3(256), dim3(NTHREADS), LDS_BYTES, stream, P); }
    else for (int k = 0; k < NPHASE; ++k) { P.ph_lo = k; P.ph_hi = k + 1;
        hipLaunchKernelGGL(mega_fwd, dim3(256), dim3(NTHREADS), LDS_BYTES, stream, P); }
}
```

```cpp
#include <hip/hip_runtime.h>
#include <cstdio>
#include <cstdint>

#define LAS __attribute__((address_space(3)))
#define GAS __attribute__((address_space(1)))
typedef unsigned short bf16_t;
typedef short bf16x8 __attribute__((ext_vector_type(8)));
typedef float f32x2 __attribute__((ext_vector_type(2)));
typedef float f32x4 __attribute__((ext_vector_type(4)));
typedef float f32x16 __attribute__((ext_vector_type(16)));
typedef unsigned u32x2 __attribute__((ext_vector_type(2)));
typedef unsigned u32x4 __attribute__((ext_vector_type(4)));

constexpr int NB = 4, SEQ = 8192, NTOK = NB * SEQ, DM = 1024;
constexpr int NH = 8, HD = 64;
constexpr int INW = 3848;
constexpr int ZW = 3840;
constexpr int ZQ = 0, ZK = 512, ZV = 1024, ZOG = 1536, ZR = 2048;
constexpr int RW_R = 0, RW_K = 512, RW_V = 1024, RW_W = 1536, RW_A = 1600, RW_G = 1664, RWIN = 1792;
constexpr int NE = 32, TOPK = 4, EFF = 1024;
constexpr int MAXBLK = (NTOK * TOPK) / 256 + NE;
constexpr int PLE = 256;
constexpr float LOG2E = 1.4426950408889634f;
constexpr float QSCALE = 0.125f * LOG2E;

constexpr size_t MiB = 1u << 20;
constexpr size_t WS_CTL = 0, CTL_BYTES = 1 * MiB;
constexpr size_t WS_C2 = 1 * MiB;
constexpr size_t WS_LOGF = 2 * MiB;
constexpr size_t WS_ROUTE = 3 * MiB;
constexpr size_t WS_TOKSLOT = 5 * MiB;
constexpr size_t WS_GATESLOT = 9 * MiB;
constexpr size_t WS_CTOT = 13 * MiB;
constexpr size_t WS_WIN = 16 * MiB;
constexpr size_t WS_WOUT = 24 * MiB;
constexpr size_t WS_WPG = 26 * MiB;
constexpr size_t WS_WPP = 28 * MiB;
constexpr size_t WS_WGU = 32 * MiB;
constexpr size_t WS_WDN = 160 * MiB;
constexpr size_t WS_XN = 224 * MiB;
constexpr size_t WS_X1 = 290 * MiB;
constexpr size_t WS_Z = 418 * MiB;
constexpr size_t WS_AO = 658 * MiB;
constexpr size_t WS_ACT = 418 * MiB;
constexpr size_t WS_RW = 722 * MiB;
constexpr size_t WS_RR = WS_RW, WS_RK = WS_RW + 32 * MiB, WS_RV = WS_RW + 64 * MiB, WS_RG = WS_RW + 96 * MiB;
constexpr size_t WS_RLW = WS_RW + 128 * MiB;
constexpr size_t WS_RKK = WS_RW + 160 * MiB, WS_RKA = WS_RW + 192 * MiB;
constexpr size_t WS_YP = 722 * MiB;
constexpr size_t WS_END = 994 * MiB;
static_assert(WS_ACT + (size_t)MAXBLK * 256 * 1024 * 2 <= WS_RW && WS_YP + (size_t)MAXBLK * 256 * 1024 * 2 <= WS_END, "ws map");
constexpr size_t DO_PJ = 0, DO_PB = 64 * MiB;
constexpr int CW_TMO = 0, CW_CNT = 64  , CW_BAR = 4096;

struct Params {
    const float *x, *p, *mix_norm, *w_in, *f_bias, *q_norm, *k_norm, *mu, *w0, *w2, *a0, *a2, *g2, *k_k, *k_a, *r_k, *ln_w, *ln_b, *w_out, *moe_norm, *w_router, *b_router, *w_gu, *b_gu, *w_down,
        *b_down, *ple_norm, *w_pg, *w_pp, *final_norm;
    float* out; unsigned char* ws; int ph_lo, ph_hi;
};

typedef const __attribute__((address_space(4))) Params& KPR;
__device__ __forceinline__ const __attribute__((address_space(4))) Params* kp_fresh() {
    unsigned long long p = (unsigned long long)__builtin_amdgcn_kernarg_segment_ptr(); asm volatile("" : "+s"(p)); return (const __attribute__((address_space(4))) Params*)p; }

__device__ __forceinline__ unsigned f2bf(float f) { unsigned u = __builtin_bit_cast(unsigned, f); return (u + 0x7fffu + ((u >> 16) & 1u)) >> 16; }
__device__ __forceinline__ unsigned pk2(float lo, float hi) { return f2bf(lo) | (f2bf(hi) << 16); }
__device__ __forceinline__ float bf2f(unsigned h) { return __builtin_bit_cast(float, h << 16); }
__device__ __forceinline__ float bflo(unsigned w) { return __builtin_bit_cast(float, w << 16); }
__device__ __forceinline__ float bfhi(unsigned w) { return __builtin_bit_cast(float, w & 0xffff0000u); }
__device__ __forceinline__ unsigned cvt_pk_bf16(float lo, float hi) { unsigned r; asm volatile("v_cvt_pk_bf16_f32 %0, %1, %2" : "=v"(r) : "v"(lo), "v"(hi)); return r; }
__device__ __forceinline__ unsigned pk4_fp8(float a, float b, float c, float d) { int w = 0; w = __builtin_amdgcn_cvt_pk_fp8_f32(a, b, w, false); w = __builtin_amdgcn_cvt_pk_fp8_f32(c, d, w, true); return (unsigned)w; }
__device__ __forceinline__ float wave_sum(float v) {
#pragma unroll
    for (int o = 1; o < 64; o <<= 1) v += __shfl_xor(v, o);
    return v;
}
__device__ __forceinline__ float sigmoidf_(float x) { return 1.0f / (1.0f + __expf(-x)); }
__device__ __forceinline__ float logsigmoidf_(float x) { return fminf(x, 0.f) - log1pf(expf(-fabsf(x))); }
namespace pg8 {
constexpr int BM = 256, BK = 64, HALF = 128, HTB = HALF * BK * 2, STAGE_BYTES = 8 * HTB, NXCD = 8, WGM = 8;
__host__ __device__ __forceinline__ int lds_byte(int r, int c) { const int st = (r >> 4) * 2 + (c >> 5), rr = r & 15, cc = c & 31, ob = rr * 64 + cc * 2; return st * 1024 + (ob ^ (((ob >> 9) & 1) << 5)); }
__host__ __device__ __forceinline__ void stage_rc(int b, int& R, int& C) { const int st = b / 1024, sb = b % 1024, swz = sb ^ (((sb >> 9) & 1) << 5); R = (st >> 1) * 16 + swz / 64; C = (st & 1) * 32 + (swz % 64) / 2; }
__host__ __device__ __forceinline__ int perm32(int rho) { const int n = rho >> 4, i = rho & 15; return 8 * (i >> 2) + 4 * n + (i & 3); }

struct Unit { int pm, pn, e, lb, sl; };

__device__ __forceinline__ bool tile_order(int i, int G, int c, int nM, int nN, int& pm, int& pn) {
    const int nwg = nM * nN; const long L = (long)i * G + c; if (L >= nwg) return false;
    int wgid = (int)L; { const int q = nwg / NXCD, r = nwg % NXCD, xcd = wgid % NXCD, off = wgid / NXCD; wgid = (xcd < r ? xcd * (q + 1) : r * (q + 1) + (xcd - r) * q) + off; }
    const int nig = WGM * nN, gid = wgid / nig, fm = gid * WGM, gsz = (nM - fm) < WGM ? (nM - fm) : WGM;
    pm = fm + ((wgid % nig) % gsz); pn = (wgid % nig) / gsz; return true;
}
struct DenseOrder {
    const bf16_t* A; const bf16_t* Bt; int K, nM, nN, G, c;
    __device__ __forceinline__ bool next(int i, Unit& u) const { u.e = 0; u.lb = 0; return tile_order(i, G, c, nM, nN, u.pm, u.pn); }
    __device__ __forceinline__ const char* a_base(const Unit& u) const { return (const char*)A + (size_t)u.pm * BM * K * 2; }
    __device__ __forceinline__ const char* b_base(const Unit& u) const { return (const char*)Bt + (size_t)u.pn * BM * K * 2; }
    __device__ __forceinline__ void prefetch(const Unit&, int, int, int) const {}
    __device__ __forceinline__ void a_off(const Unit&, const int (&R)[2], const int (&C)[2], unsigned (&off)[2][2]) const {
#pragma unroll
        for (int h = 0; h < 2; ++h)
#pragma unroll
            for (int i = 0; i < 2; ++i) off[h][i] = (unsigned)((R[i] + HALF * h) * K + C[i]) * 2u;
    }
};

typedef int v8i32 __attribute__((ext_vector_type(8)));
typedef int i32x4 __attribute__((ext_vector_type(4)));
template <class Epi, class Sched, bool ALIGN_EPI, bool FP8 = false>
__device__ __forceinline__ void gemm_phase(LAS unsigned char* lds, const int K, const Sched& S, const Epi& E) {
    int tid_ = threadIdx.x; asm volatile("" : "+v"(tid_));
    const int tid = tid_, wid = __builtin_amdgcn_readfirstlane(tid >> 6), lane = tid & 63, wr = wid >> 2, wc = wid & 3, fr = lane & 15, fq = lane >> 4;
    const int RB = FP8 ? K : 2 * K;
    const int nt = RB / (BK * 2);
    int sR[2], sC[2]; unsigned voffB[2];
#pragma unroll
    for (int i = 0; i < 2; ++i) { int R, C; stage_rc(tid * 16 + i * 8192, R, C); const int Rb = Epi::PERM ? ((R & ~31) + perm32(R & 31)) : R; sR[i] = R; sC[i] = C; voffB[i] = (unsigned)(Rb * RB + C * 2); }
    const size_t kstep = (size_t)(BK * 2);
    const size_t hstep = (size_t)HALF * RB;
    const unsigned ldsw = (unsigned)wid * 1024u;
    const int aoff0 = FP8 ? lds_byte(wr * 64 + fr, fq * 16) : lds_byte(wr * 64 + fr, fq * 8), aoff1 = FP8 ? lds_byte(wr * 64 + fr, fq * 16 + 8) : aoff0 + 1024;
    const int boff0 = FP8 ? lds_byte(wc * 32 + fr, fq * 16) : lds_byte(wc * 32 + fr, fq * 8), boff1 = FP8 ? lds_byte(wc * 32 + fr, fq * 16 + 8) : boff0 + 1024;
#define PG8_SA(b, h) (((b) * 2 + (h)) * HTB)
#define PG8_SB(b, h) ((4 + (b) * 2 + (h)) * HTB)
#define PG8_STAGE(bufoff, gbase, voff) do { _Pragma("unroll") for (int _i = 0; _i < 2; ++_i) \
        __builtin_amdgcn_global_load_lds((const unsigned*)((const char*)(gbase) + (voff)[_i]), (LAS unsigned*)(lds + (bufoff) + ldsw + _i * 8192), 16, 0, 0); } while (0)
#define PG8_CAT(p0, p1) __builtin_shufflevector((p0), (p1), 0, 1, 2, 3, 4, 5, 6, 7)
#define PG8_LDA(dst, b, h) do { _Pragma("unroll") for (int m = 0; m < 4; ++m) dst[m] = PG8_CAT(*(const LAS i32x4*)(lds + PG8_SA(b, h) + aoff0 + m * 2048), *(const LAS i32x4*)(lds + PG8_SA(b, h) + aoff1 + m * 2048)); } while (0)
#define PG8_LDB(dst, b, h) do { _Pragma("unroll") for (int n = 0; n < 2; ++n) dst[n] = PG8_CAT(*(const LAS i32x4*)(lds + PG8_SB(b, h) + boff0 + n * 2048), *(const LAS i32x4*)(lds + PG8_SB(b, h) + boff1 + n * 2048)); } while (0)
#define PG8_LO(x) __builtin_bit_cast(bf16x8, __builtin_shufflevector((x), (x), 0, 1, 2, 3))
#define PG8_HI(x) __builtin_bit_cast(bf16x8, __builtin_shufflevector((x), (x), 4, 5, 6, 7))
#define PG8_MMA(ai, bj, At, Bt) do { __builtin_amdgcn_s_setprio(1); \
        if constexpr (FP8) { _Pragma("unroll") for (int m = 0; m < 4; ++m) _Pragma("unroll") for (int n = 0; n < 2; ++n) \
            asm volatile("v_mfma_scale_f32_16x16x128_f8f6f4 %0, %1, %2, %0, %3, %4 op_sel_hi:[0,0,0]" : "+v"(acc[ai][bj][m][n]) : "v"(Bt[n]), "v"(At[m]), "v"(sc_w), "v"(sc_x)); } \
        else { _Pragma("unroll") for (int m = 0; m < 4; ++m) _Pragma("unroll") for (int n = 0; n < 2; ++n) { \
            acc[ai][bj][m][n] = __builtin_amdgcn_mfma_f32_16x16x32_bf16(PG8_LO(Bt[n]), PG8_LO(At[m]), acc[ai][bj][m][n], 0, 0, 0); } \
            _Pragma("unroll") for (int m = 0; m < 4; ++m) _Pragma("unroll") for (int n = 0; n < 2; ++n) { \
            acc[ai][bj][m][n] = __builtin_amdgcn_mfma_f32_16x16x32_bf16(PG8_HI(Bt[n]), PG8_HI(At[m]), acc[ai][bj][m][n], 0, 0, 0); } } \
        __builtin_amdgcn_s_setprio(0); } while (0)
#define PG8_WAIT_V(n) asm volatile("s_waitcnt vmcnt(" #n ")" ::: "memory")
#define PG8_WAIT_L(n) asm volatile("s_waitcnt lgkmcnt(" #n ")" ::: "memory")
#define PG8_BAR __builtin_amdgcn_s_barrier()
#define PG8_SCHED __builtin_amdgcn_sched_barrier(0)
    Unit cur, nxt; int ui = 0;
    if (!S.next(0, cur)) return;
    f32x4 acc[2][2][4][2];
#pragma unroll
    for (int a = 0; a < 2; ++a)
#pragma unroll
        for (int b = 0; b < 2; ++b)
#pragma unroll
            for (int m = 0; m < 4; ++m)
#pragma unroll
                for (int n = 0; n < 2; ++n) acc[a][b][m][n] = (f32x4){0.f, 0.f, 0.f, 0.f};
    const int sc_w = 121, sc_x = 127;
    v8i32 At[4], B0[2], B1[2];
    unsigned offC[2][2], offN[2][2];
    cur.sl = 0; S.prefetch(cur, 0, wid, lane); PG8_WAIT_V(0); PG8_BAR;
    S.a_off(cur, sR, sC, offC);
    const char* cA = S.a_base(cur); const char* cB = S.b_base(cur);
    PG8_STAGE(PG8_SB(0, 0), cB, voffB); PG8_STAGE(PG8_SB(0, 1), cB + hstep, voffB); PG8_STAGE(PG8_SA(0, 0), cA, offC[0]); PG8_STAGE(PG8_SA(0, 1), cA, offC[1]);
    if (wr == 1) PG8_BAR;
    PG8_WAIT_V(2); PG8_BAR;
    PG8_STAGE(PG8_SB(1, 0), cB + kstep, voffB); PG8_STAGE(PG8_SA(1, 0), cA + kstep, offC[0]); PG8_STAGE(PG8_SB(1, 1), cB + hstep + kstep, voffB);
    PG8_WAIT_V(6); PG8_BAR;
    for (;;) {
        const bool has_next = S.next(ui + 1, nxt);
        const char* nA = cA; const char* nB = cB;
        nxt.sl = cur.sl == 2 ? 0 : cur.sl + 1;
        if (has_next) { nA = S.a_base(nxt); nB = S.b_base(nxt); S.prefetch(nxt, nxt.sl, wid, lane); }
#pragma unroll
        for (int h = 0; h < 2; ++h)
#pragma unroll
            for (int i = 0; i < 2; ++i) offN[h][i] = offC[h][i];
#pragma nounroll
        for (int t = 0; t < nt; t += 2) {
            const bool last = (t == nt - 2);
            if (last && has_next) S.a_off(nxt, sR, sC, offN);
            const char* a1 = cA + (size_t)(t + 1) * kstep;
            const char* a2 = last ? nA : cA + (size_t)(t + 2) * kstep; const char* b2 = last ? nB : cB + (size_t)(t + 2) * kstep;
            const char* a3 = a2 + kstep; const char* b3 = b2 + kstep;
            unsigned o2[2][2];
#pragma unroll
            for (int h = 0; h < 2; ++h)
#pragma unroll
                for (int i = 0; i < 2; ++i) o2[h][i] = last ? offN[h][i] : offC[h][i];
            PG8_LDB(B0, 0, 0); PG8_LDB(B1, 0, 1); PG8_SCHED; PG8_LDA(At, 0, 0); PG8_STAGE(PG8_SA(1, 1), a1, offC[1]);
            PG8_WAIT_V(8); PG8_WAIT_L(0); PG8_BAR; PG8_MMA(0, 0, At, B0); PG8_MMA(0, 1, At, B1); PG8_BAR; PG8_SCHED;
            PG8_LDA(At, 0, 1); PG8_STAGE(PG8_SB(0, 0), b2, voffB); PG8_STAGE(PG8_SB(0, 1), b2 + hstep, voffB); PG8_STAGE(PG8_SA(0, 0), a2, o2[0]);
            PG8_WAIT_V(8); PG8_WAIT_L(0); PG8_BAR; PG8_MMA(1, 0, At, B0); PG8_MMA(1, 1, At, B1); PG8_BAR; PG8_SCHED;
            PG8_LDB(B0, 1, 0); PG8_LDB(B1, 1, 1); PG8_SCHED; PG8_LDA(At, 1, 0); PG8_STAGE(PG8_SA(0, 1), a2, o2[1]);
            PG8_WAIT_V(8); PG8_WAIT_L(0); PG8_BAR; PG8_MMA(0, 0, At, B0); PG8_MMA(0, 1, At, B1); PG8_BAR; PG8_SCHED;
            PG8_LDA(At, 1, 1); PG8_STAGE(PG8_SB(1, 0), b3, voffB); PG8_STAGE(PG8_SB(1, 1), b3 + hstep, voffB); PG8_STAGE(PG8_SA(1, 0), a3, o2[0]);
            PG8_WAIT_V(8); PG8_WAIT_L(0); PG8_BAR; PG8_MMA(1, 0, At, B0); PG8_MMA(1, 1, At, B1); PG8_BAR; PG8_SCHED;
        }
        if constexpr (ALIGN_EPI) { if (wr == 0) PG8_BAR; }
        E(acc, cur, wr, wc, fr, fq);
        if (!has_next) break;
#pragma unroll
        for (int a = 0; a < 2; ++a)
#pragma unroll
            for (int b = 0; b < 2; ++b)
#pragma unroll
                for (int m = 0; m < 4; ++m)
#pragma unroll
                    for (int n = 0; n < 2; ++n) acc[a][b][m][n] = (f32x4){0.f, 0.f, 0.f, 0.f};
        cur = nxt; cA = nA; cB = nB; ++ui;
#pragma unroll
        for (int h = 0; h < 2; ++h)
#pragma unroll
            for (int i = 0; i < 2; ++i) offC[h][i] = offN[h][i];
        if constexpr (ALIGN_EPI) { if (wr == 1) PG8_BAR; }
    }
    PG8_WAIT_V(0);
    if constexpr (!ALIGN_EPI) { if (wr == 0) PG8_BAR; }
    PG8_BAR;
#undef PG8_SA
#undef PG8_SB
#undef PG8_STAGE
#undef PG8_LDA
#undef PG8_LDB
#undef PG8_MMA
#undef PG8_LO
#undef PG8_HI
#undef PG8_CAT
#undef PG8_WAIT_V
#undef PG8_WAIT_L
#undef PG8_BAR
#undef PG8_SCHED
}
}
namespace pg8 {
constexpr int T_BLKSTART = 0  , T_CNT = 40  , T_BLKE = 80  , T_WORDS = 80 + 560;
constexpr int TB_OFF = 8192 - 64;

struct EpiIn {
    static constexpr bool PERM = true;
    bf16_t* Z; const float* qn; const float* kn;
    __device__ __forceinline__ void operator()(const f32x4 (&acc)[2][2][4][2], const Unit& u, int wr, int wc, int fr, int fq) const {
        const int row0 = u.pm * BM + wr * 64 + fr;
        if (u.pn < 4) {
            const float* g = (u.pn < 2) ? qn : kn; const float sc = (u.pn < 2) ? QSCALE : 1.0f;
            f32x4 gv[2][2];
#pragma unroll
            for (int bj = 0; bj < 2; ++bj)
#pragma unroll
                for (int n = 0; n < 2; ++n) gv[bj][n] = *(const f32x4*)(g + 32 * bj + 8 * fq + 4 * n) * sc;
#pragma unroll
            for (int ai = 0; ai < 2; ++ai)
#pragma unroll
                for (int m = 0; m < 4; ++m) {
                    float ss = 0.f;
#pragma unroll
                    for (int bj = 0; bj < 2; ++bj)
#pragma unroll
                        for (int n = 0; n < 2; ++n) { const f32x4 x = acc[ai][bj][m][n]; ss += (x[0] * x[0] + x[1] * x[1]) + (x[2] * x[2] + x[3] * x[3]); }
                    ss += __shfl_xor(ss, 16); ss += __shfl_xor(ss, 32);
                    const float rstd = rsqrtf(ss * (1.0f / 64.0f) + 1e-6f);
                    bf16_t* rowp = Z + (size_t)(row0 + ai * HALF + m * 16) * ZW + u.pn * BM + 64 * wc + 8 * fq;
#pragma unroll
                    for (int bj = 0; bj < 2; ++bj) { const f32x4 v0 = acc[ai][bj][m][0] * rstd * gv[bj][0], v1 = acc[ai][bj][m][1] * rstd * gv[bj][1];
                        u32x4 w; w.x = cvt_pk_bf16(v0[0], v0[1]); w.y = cvt_pk_bf16(v0[2], v0[3]); w.z = cvt_pk_bf16(v1[0], v1[1]); w.w = cvt_pk_bf16(v1[2], v1[3]);
                        *(u32x4*)(rowp + 32 * bj) = w; }
                }
        } else {
            const int col0 = u.pn * BM + wc * 32 + 8 * fq;
#pragma unroll
            for (int ai = 0; ai < 2; ++ai)
#pragma unroll
                for (int m = 0; m < 4; ++m) { bf16_t* rowp = Z + (size_t)(row0 + ai * HALF + m * 16) * ZW + col0;
#pragma unroll
                    for (int bj = 0; bj < 2; ++bj) { const f32x4 v0 = acc[ai][bj][m][0], v1 = acc[ai][bj][m][1];
                        u32x4 w; w.x = cvt_pk_bf16(v0[0], v0[1]); w.y = cvt_pk_bf16(v0[2], v0[3]); w.z = cvt_pk_bf16(v1[0], v1[1]); w.w = cvt_pk_bf16(v1[2], v1[3]);
                        *(u32x4*)(rowp + bj * HALF) = w; } }
        }
    }
};
struct EpiBf16 {
    static constexpr bool PERM = true;
    bf16_t* O; int ldc;
    __device__ __forceinline__ void operator()(const f32x4 (&acc)[2][2][4][2], const Unit& u, int wr, int wc, int fr, int fq) const {
        const int row0 = u.pm * BM + wr * 64 + fr, col0 = u.pn * BM + wc * 32 + 8 * fq;
#pragma unroll
        for (int ai = 0; ai < 2; ++ai)
#pragma unroll
            for (int m = 0; m < 4; ++m) { bf16_t* rowp = O + (size_t)(row0 + ai * HALF + m * 16) * ldc + col0;
#pragma unroll
                for (int bj = 0; bj < 2; ++bj) { const f32x4 v0 = acc[ai][bj][m][0], v1 = acc[ai][bj][m][1];
                    u32x4 w; w.x = cvt_pk_bf16(v0[0], v0[1]); w.y = cvt_pk_bf16(v0[2], v0[3]); w.z = cvt_pk_bf16(v1[0], v1[1]); w.w = cvt_pk_bf16(v1[2], v1[3]);
                    *(u32x4*)(rowp + bj * HALF) = w; } }
    }
};
struct EpiOut {
    static constexpr bool PERM = false;
    const float* X; float* O;
    __device__ __forceinline__ void operator()(const f32x4 (&acc)[2][2][4][2], const Unit& u, int wr, int wc, int fr, int fq) const {
        const int row0 = u.pm * BM + wr * 64 + fr, col0 = u.pn * BM + wc * 32 + 4 * fq;
#pragma unroll
        for (int ai = 0; ai < 2; ++ai)
#pragma unroll
            for (int m = 0; m < 4; ++m) { const size_t off = (size_t)(row0 + ai * HALF + m * 16) * DM + col0;
#pragma unroll
                for (int bj = 0; bj < 2; ++bj)
#pragma unroll
                    for (int n = 0; n < 2; ++n) *(f32x4*)(O + off + bj * HALF + n * 16) = *(const f32x4*)(X + off + bj * HALF + n * 16) + acc[ai][bj][m][n];
                if (m & 1) asm volatile("" ::: "memory"); }
    }
};
struct EpiPg {
    static constexpr bool PERM = false;
    float* X; const bf16_t* PJ;
    __device__ __forceinline__ void operator()(const f32x4 (&acc)[2][2][4][2], const Unit& u, int wr, int wc, int fr, int fq) const {
        const int row0 = u.pm * BM + wr * 64 + fr, col0 = u.pn * BM + wc * 32 + 4 * fq;
#pragma unroll
        for (int ai = 0; ai < 2; ++ai)
#pragma unroll
            for (int m = 0; m < 4; ++m) { const size_t off = (size_t)(row0 + ai * HALF + m * 16) * DM + col0;
#pragma unroll
                for (int bj = 0; bj < 2; ++bj)
#pragma unroll
                    for (int n = 0; n < 2; ++n) { const size_t o = off + bj * HALF + n * 16; const u32x2 pj = *(const u32x2*)(PJ + o); const f32x4 a = acc[ai][bj][m][n]; const f32x4 xv = *(const f32x4*)(X + o);
                        f32x4 r; r[0] = xv[0] + sigmoidf_(a[0]) * bflo(pj.x); r[1] = xv[1] + sigmoidf_(a[1]) * bfhi(pj.x); r[2] = xv[2] + sigmoidf_(a[2]) * bflo(pj.y); r[3] = xv[3] + sigmoidf_(a[3]) * bfhi(pj.y);
                        *(f32x4*)(X + o) = r; }
                if (m & 1) asm volatile("" ::: "memory"); }
    }
};
struct EpiGu {
    static constexpr bool PERM = true;
    unsigned char* ACT; const float* b_gu;
    __device__ __forceinline__ void operator()(const f32x4 (&acc)[2][2][4][2], const Unit& u, int wr, int wc, int fr, int fq) const {
        const int row0 = u.pm * BM + wr * 64 + fr, cl = u.pn * HALF + wc * 32 + 8 * fq;
        const float* bg = b_gu + (size_t)u.e * 2048 + cl;
        f32x4 bgl[2], bli[2];
#pragma unroll
        for (int n = 0; n < 2; ++n) { bgl[n] = *(const f32x4*)(bg + 4 * n); bli[n] = *(const f32x4*)(bg + 1024 + 4 * n); }
#pragma unroll
        for (int ai = 0; ai < 2; ++ai)
#pragma unroll
            for (int m = 0; m < 4; ++m) { unsigned char* rowp = ACT + (size_t)(row0 + ai * HALF + m * 16) * EFF + cl; float r[8];
#pragma unroll
                for (int n = 0; n < 2; ++n)
#pragma unroll
                    for (int i = 0; i < 4; ++i) { const float gl = fminf(acc[ai][0][m][n][i] + bgl[n][i], 7.0f); const float li = fminf(fmaxf(acc[ai][1][m][n][i] + bli[n][i], -7.0f), 7.0f);
                        r[4 * n + i] = gl * sigmoidf_(1.702f * gl) * (li + 1.0f); }
                u32x2 w; w.x = pk4_fp8(r[0], r[1], r[2], r[3]); w.y = pk4_fp8(r[4], r[5], r[6], r[7]);
                *(u32x2*)rowp = w; }
    }
};
struct EpiDn {
    static constexpr bool PERM = true;
    bf16_t* YP; const float* b_dn; const float* gateslot; const LAS int* tab;
    __device__ __forceinline__ void operator()(const f32x4 (&acc)[2][2][4][2], const Unit& u, int wr, int wc, int fr, int fq) const {
        const int row0 = u.pm * BM + wr * 64 + fr, col0 = u.pn * BM + wc * 32 + 8 * fq;
        const float* bd = b_dn + (size_t)u.e * 1024 + col0; const int cnt = tab[T_CNT + u.e];
        f32x4 bv[2][2];
#pragma unroll
        for (int bj = 0; bj < 2; ++bj)
#pragma unroll
            for (int n = 0; n < 2; ++n) bv[bj][n] = *(const f32x4*)(bd + bj * HALF + 4 * n);
#pragma unroll
        for (int ai = 0; ai < 2; ++ai)
#pragma unroll
            for (int m = 0; m < 4; ++m) { const int rr = wr * 64 + fr + ai * HALF + m * 16, slot = u.lb * 256 + rr;
                const float gt = slot < cnt ? ((const LAS float*)((const LAS unsigned char*)tab + TB_OFF + u.sl * 1024))[rr] : 0.f;
                bf16_t* rowp = YP + (size_t)(row0 + ai * HALF + m * 16) * DM + col0;
#pragma unroll
                for (int bj = 0; bj < 2; ++bj) { const f32x4 v0 = (acc[ai][bj][m][0] + bv[bj][0]) * gt, v1 = (acc[ai][bj][m][1] + bv[bj][1]) * gt;
                    u32x4 w; w.x = cvt_pk_bf16(v0[0], v0[1]); w.y = cvt_pk_bf16(v0[2], v0[3]); w.z = cvt_pk_bf16(v1[0], v1[1]); w.w = cvt_pk_bf16(v1[2], v1[3]);
                    *(u32x4*)(rowp + bj * HALF) = w; } }
    }
};
struct MoeOrder {
    const unsigned char* A; const unsigned char* Bt; const int* tokslot; const float* gateslot;   const LAS int* tab; int nblk, nN, G, c; bool gather;
    __device__ __forceinline__ bool next(int i, Unit& u) const { if (!tile_order(i, G, c, nblk, nN, u.pm, u.pn)) return false; u.e = tab[T_BLKE + u.pm]; u.lb = u.pm - tab[T_BLKSTART + u.e]; return true; }
    __device__ __forceinline__ const char* a_base(const Unit& u) const { return gather ? (const char*)A : (const char*)A + (size_t)u.pm * BM * 1024; }
    __device__ __forceinline__ const char* b_base(const Unit& u) const { return (const char*)Bt + ((size_t)u.e * nN + u.pn) * BM * 1024; }
    __device__ __forceinline__ void prefetch(const Unit& u, int slot, int wid, int lane) const {
        if (wid < 4) { const unsigned* src = (gather ? (const unsigned*)tokslot : (const unsigned*)gateslot) + (size_t)u.e * NTOK + u.lb * 256 + wid * 64 + lane;
            __builtin_amdgcn_global_load_lds(src, (LAS unsigned*)((LAS unsigned char*)tab + TB_OFF + slot * 1024 + wid * 256), 4, 0, 0); }
    }
    __device__ __forceinline__ void a_off(const Unit& u, const int (&R)[2], const int (&C)[2], unsigned (&off)[2][2]) const {
        const int cnt = tab[T_CNT + u.e]; const LAS int* tb = (const LAS int*)((const LAS unsigned char*)tab + TB_OFF + u.sl * 1024);
#pragma unroll
        for (int h = 0; h < 2; ++h)
#pragma unroll
            for (int i = 0; i < 2; ++i) {
                if (gather) { const int rr = R[i] + HALF * h; const int tk = tb[rr]; const int tok = (u.lb * 256 + rr) < cnt ? tk : NTOK; off[h][i] = (unsigned)tok * 1024u + (unsigned)C[i] * 2u; }
                else off[h][i] = (unsigned)((R[i] + HALF * h) * 1024 + C[i] * 2);
            }
    }
};
__device__ __forceinline__ int moe_tables(LAS int* tab, const unsigned* cntw) {
    if (threadIdx.x == 0) { int s = 0; for (int e = 0; e < NE; ++e) { const int c = (int)cntw[e]; tab[T_CNT + e] = c; tab[T_BLKSTART + e] = s; const int nb = (c + 255) >> 8; for (int j = 0; j < nb; ++j) tab[T_BLKE + s + j] = e; s += nb; } tab[T_BLKSTART + NE] = s; }
    __syncthreads();
    return tab[T_BLKSTART + NE];
}
}
constexpr int NWAVES = 8, NTHREADS = 512;
constexpr int RING_BYTES = 131072, MISC_OFF = RING_BYTES, LDS_BYTES = 147456;

__device__ __forceinline__ void tr_item(const float* W, int ldw, int srccol0, int k0, bf16_t* WT, int Kd, int dstrow0, LAS float* scr, int lane) {
#pragma unroll 8
    for (int i = 0; i < 32; ++i) { const int kk = 2 * i + (lane >> 5); scr[kk * 33 + (lane & 31)] = W[(size_t)(k0 + kk) * ldw + srccol0 + (lane & 31)]; }
    asm volatile("s_waitcnt lgkmcnt(0)" ::: "memory");
    const int c = lane & 7;
#pragma unroll
    for (int j = 0; j < 4; ++j) { const int n = (lane >> 3) + 8 * j; const LAS float* s = scr + (8 * c) * 33 + n;
        u32x4 o; o.x = pk2(s[0 * 33], s[1 * 33]); o.y = pk2(s[2 * 33], s[3 * 33]); o.z = pk2(s[4 * 33], s[5 * 33]); o.w = pk2(s[6 * 33], s[7 * 33]);
        *(u32x4*)(WT + (size_t)(dstrow0 + n) * Kd + k0 + 8 * c) = o; }
    asm volatile("s_waitcnt lgkmcnt(0)" ::: "memory");
}
__device__ __forceinline__ void tr_item8(const float* W, int ldw, int srccol0, int k0, unsigned char* WT, int Kd, int dstrow0, LAS float* scr, int lane) {
#pragma unroll 8
    for (int i = 0; i < 32; ++i) { const int kk = 2 * i + (lane >> 5); scr[kk * 33 + (lane & 31)] = W[(size_t)(k0 + kk) * ldw + srccol0 + (lane & 31)]; }
    asm volatile("s_waitcnt lgkmcnt(0)" ::: "memory");
    const int c = lane & 7;
#pragma unroll
    for (int j = 0; j < 4; ++j) { const int n = (lane >> 3) + 8 * j; const LAS float* s = scr + (8 * c) * 33 + n;
        u32x2 o; o.x = pk4_fp8(s[0 * 33] * 64.f, s[1 * 33] * 64.f, s[2 * 33] * 64.f, s[3 * 33] * 64.f); o.y = pk4_fp8(s[4 * 33] * 64.f, s[5 * 33] * 64.f, s[6 * 33] * 64.f, s[7 * 33] * 64.f);
        *(u32x2*)(WT + (size_t)(dstrow0 + n) * Kd + k0 + 8 * c) = o; }
    asm volatile("s_waitcnt lgkmcnt(0)" ::: "memory");
}
constexpr int I_IN = 16 * 120, I_OUT = 16 * 32, I_PG = 16 * 32, I_PP = 4 * 32, I_GU1 = 16 * 64, I_DN1 = 16 * 32;
constexpr int I_LORA = 16 + 16 + 32;
constexpr int I_SMALL = I_IN + I_OUT + I_PG + I_PP + I_LORA, I_GU = NE * I_GU1, I_DN = NE * I_DN1, I_ALL = I_SMALL + I_GU + I_DN;
__device__ __forceinline__ void prep_item(KPR P, int it, LAS float* scr, int lane) {
    unsigned char* ws = P.ws;
    if (it < I_IN) { const int kb = it / 120, nb = it % 120, n0 = nb * 32, pn = n0 >> 8, j0 = n0 & 255;
        const int src = pn < 4 ? (pn * 256 + 64 * ((j0 & 127) >> 5) + 32 * (j0 >> 7)) : (n0 < 2048 ? n0 : n0 + 8);
        tr_item(P.w_in, INW, src, kb * 64, (bf16_t*)(ws + WS_WIN), 1024, n0, scr, lane); return; }
    it -= I_IN;
    if (it < I_OUT) { tr_item(P.w_out, 1024, (it % 32) * 32, (it / 32) * 64, (bf16_t*)(ws + WS_WOUT), 1024, (it % 32) * 32, scr, lane); return; }
    it -= I_OUT;
    if (it < I_PG) { tr_item(P.w_pg, 1024, (it % 32) * 32, (it / 32) * 64, (bf16_t*)(ws + WS_WPG), 1024, (it % 32) * 32, scr, lane); return; }
    it -= I_PG;
    if (it < I_PP) { tr_item(P.w_pp, 1024, (it % 32) * 32, (it / 32) * 64, (bf16_t*)(ws + WS_WPP), 256, (it % 32) * 32, scr, lane); return; }
    it -= I_PP;
    if (it < 16) { tr_item(P.w2, 512, it * 32, 0, (bf16_t*)(ws + 29 * MiB), 64, it * 32, scr, lane); return; }
    it -= 16;
    if (it < 16) { tr_item(P.a2, 512, it * 32, 0, (bf16_t*)(ws + 29 * MiB + 65536), 64, it * 32, scr, lane); return; }
    it -= 16;
    if (it < 32) { tr_item(P.g2, 512, (it % 16) * 32, (it / 16) * 64, (bf16_t*)(ws + 29 * MiB + 131072), 128, (it % 16) * 32, scr, lane); return; }
    it -= 32;
    if (it < I_GU) { const int e = it / I_GU1, r = it % I_GU1, kb = r / 64, nb = r % 64, n0 = nb * 32, pn = n0 >> 8, j0 = n0 & 255;
        const int src = (j0 >> 7) * 1024 + pn * 128 + (j0 & 127);
        tr_item8(P.w_gu + (size_t)e * 1024 * 2048, 2048, src, kb * 64, ws + WS_WGU + (size_t)e * 2048 * 1024, 1024, n0, scr, lane); return; }
    it -= I_GU;
    { const int e = it / I_DN1, r = it % I_DN1, kb = r / 32, nb = r % 32;
        tr_item8(P.w_down + (size_t)e * 1024 * 1024, 1024, nb * 32, kb * 64, ws + WS_WDN + (size_t)e * 1024 * 1024, 1024, nb * 32, scr, lane); }
}
__device__ __forceinline__ void phase_prep_weights(KPR P, LAS unsigned char* lds, int gw, int ngw, int wave, int lane) {
    LAS float* scr = (LAS float*)(lds + wave * 16384);
    for (int it = gw; it < I_ALL; it += ngw) prep_item(P, it, scr, lane);
}
__device__ __forceinline__ void phase_cvt_p(KPR P, int gt, int ngt) {
    bf16_t* PB = (bf16_t*)((unsigned char*)P.out + DO_PB);
    for (int i = gt; i < NTOK * PLE / 8; i += ngt) { const f32x4 a = ((const f32x4*)P.p)[2 * i], b = ((const f32x4*)P.p)[2 * i + 1];
        u32x4 w; w.x = pk2(a[0], a[1]); w.y = pk2(a[2], a[3]); w.z = pk2(b[0], b[1]); w.w = pk2(b[2], b[3]); ((u32x4*)PB)[i] = w; }
}
__device__ __forceinline__ void rms_row(const float* xrow, const float* gain, int lane, f32x4 (&v)[4]) {
    const f32x4* xr = (const f32x4*)xrow + lane; float s = 0.f;
#pragma unroll
    for (int j = 0; j < 4; ++j) { v[j] = xr[64 * j]; s += (v[j][0] * v[j][0] + v[j][1] * v[j][1]) + (v[j][2] * v[j][2] + v[j][3] * v[j][3]); }
    const float rstd = rsqrtf(wave_sum(s) * (1.f / DM) + 1e-6f);
#pragma unroll
    for (int j = 0; j < 4; ++j) v[j] = v[j] * rstd * ((const f32x4*)gain)[64 * j + lane];
}
__device__ __forceinline__ void store_row_bf16(bf16_t* orow, int lane, const f32x4 (&v)[4]) {
    u32x2* o8 = (u32x2*)orow + lane;
#pragma unroll
    for (int j = 0; j < 4; ++j) { u32x2 w; w.x = pk2(v[j][0], v[j][1]); w.y = pk2(v[j][2], v[j][3]); o8[64 * j] = w; }
}
__device__ __forceinline__ void norm1_row(KPR P, int row, int lane, const LAS float* wff, LAS float* lf_out  ) {
    f32x4 v[4]; rms_row(P.x + (size_t)row * DM, P.mix_norm, lane, v);
    store_row_bf16((bf16_t*)(P.ws + WS_XN) + (size_t)row * DM, lane, v);
    float ff[8];
#pragma unroll
    for (int q = 0; q < 8; ++q) ff[q] = 0.f;
#pragma unroll
    for (int j = 0; j < 4; ++j)
#pragma unroll
        for (int i = 0; i < 4; ++i) { const LAS f32x4* w = (const LAS f32x4*)(wff + (size_t)(4 * (64 * j + lane) + i) * 8); const f32x4 w0 = w[0], w1 = w[1]; const float h = v[j][i];
            ff[0] += h * w0[0]; ff[1] += h * w0[1]; ff[2] += h * w0[2]; ff[3] += h * w0[3]; ff[4] += h * w1[0]; ff[5] += h * w1[1]; ff[6] += h * w1[2]; ff[7] += h * w1[3]; }
#pragma unroll
    for (int q = 0; q < 8; ++q) ff[q] = wave_sum(ff[q]);
    if (lane < 8) { float f = ff[0];
#pragma unroll
        for (int q = 1; q < 8; ++q) f = (lane == q) ? ff[q] : f;
        lf_out[lane] = logsigmoidf_(f + P.f_bias[lane]); }
}
__device__ __forceinline__ void load_wff(KPR P, LAS float* wff, int tid, int nthr) {
    for (int i = tid; i < 1024 * 8; i += nthr) wff[i] = P.w_in[(size_t)(i >> 3) * INW + 2048 + (i & 7)];
}
__device__ __forceinline__ void final_row(KPR P, int row, int lane, bool dead) {
    f32x4 v[4]; rms_row((const float*)(P.ws + WS_X1) + (size_t)row * DM, P.final_norm, lane, v);
    f32x4* o = (f32x4*)(P.out + (size_t)row * DM) + lane;
#pragma unroll
    for (int j = 0; j < 4; ++j) { if (dead) { const float q = __builtin_nanf(""); v[j] = (f32x4){q, q, q, q}; } o[64 * j] = v[j]; }
}
typedef GAS unsigned gu32;
#define RLX_AGENT __ATOMIC_RELAXED, __HIP_MEMORY_SCOPE_AGENT
#define XB_TMO      128
#define XB_XCNT(j)  (256  + 64 * (j))
#define XB_XSUB(j)  (1280 + 64 * (j))
#define XB_XGEN(j)  (2304 + 64 * (j))
#define XB_TOP      3328
#define XB_TOPGEN   3392
#define XCD_BAR_WORDS 3456
#define XB_SPIN_CAP (1u << 22)

__device__ __forceinline__ unsigned xb_ld(unsigned* p)              { return __hip_atomic_load(p, __ATOMIC_RELAXED, __HIP_MEMORY_SCOPE_AGENT); }
__device__ __forceinline__ unsigned xb_add(unsigned* p, unsigned v) { return __hip_atomic_fetch_add(p, v, __ATOMIC_RELAXED, __HIP_MEMORY_SCOPE_AGENT); }
__device__ __forceinline__ unsigned xb_xcc_id() { return (unsigned)__builtin_amdgcn_s_getreg((3 << 11) | 20) & 0xFu; }
#define XB_SPIN(cond, bar) do { unsigned _sp = 0; while (cond) { __builtin_amdgcn_s_sleep(1); \
    if ((++_sp & 255u) == 0u) { if (xb_ld(&(bar)[XB_TMO])) break; if (_sp > XB_SPIN_CAP) { atomicAdd(&(bar)[XB_TMO], 1u); break; } } } } while (0)

struct XcdBarrier { unsigned* bar; unsigned x; volatile LAS unsigned* st; };

__device__ __forceinline__ XcdBarrier xcd_barrier_post(unsigned* bar, volatile LAS unsigned* st) {
    XcdBarrier b; b.bar = bar; b.x = xb_xcc_id(); b.st = st;
    if (threadIdx.x == 0) (void)xb_add(&bar[XB_XCNT(b.x)], 1u);
    return b;
}
__device__ __forceinline__ void xcd_barrier_complete(unsigned* bar, unsigned x, unsigned& nloc, unsigned& nx) {
    const unsigned G = gridDim.x * gridDim.y * gridDim.z;
    unsigned sum, cnt, mine, sp = 0u;
    for (;;) {
        sum = 0u; cnt = 0u; mine = 0u;
#pragma unroll
        for (unsigned j = 0; j < 16; ++j) { const unsigned c = xb_ld(&bar[XB_XCNT(j)]); sum += c; cnt += (c > 0u) ? 1u : 0u; mine = (j == x) ? c : mine; }
        if (sum == G) break;
        __builtin_amdgcn_s_sleep(1);
        if ((++sp & 255u) == 0u) { if (xb_ld(&bar[XB_TMO])) break; if (sp > XB_SPIN_CAP) { atomicAdd(&bar[XB_TMO], 1u); break; } }
    }
    nloc = mine > 0u ? mine : 1u; nx = cnt > 0u ? cnt : 1u;
}
__device__ __forceinline__ void xcd_barrier(const XcdBarrier& b) {
    asm volatile("s_waitcnt vmcnt(0)" ::: "memory");
    __syncthreads();
    if (threadIdx.x == 0) {
        unsigned* bar = b.bar;
        __builtin_amdgcn_s_waitcnt(0);
        unsigned nloc = b.st[0], nx = b.st[1];
        if (nloc == 0u) { xcd_barrier_complete(bar, b.x, nloc, nx); b.st[0] = nloc; b.st[1] = nx; }
        const unsigned old = xb_add(&bar[XB_XSUB(b.x)], 1u);
        const unsigned gen = old / nloc;
        if (old + 1u == (gen + 1u) * nloc) {
            __builtin_amdgcn_fence(__ATOMIC_RELEASE, "agent");
            asm volatile("s_waitcnt vmcnt(0)" ::: "memory");
            const unsigned og = xb_add(&bar[XB_TOP], 1u);
            const unsigned tg = og / nx;
            if (og + 1u == (tg + 1u) * nx) xb_add(&bar[XB_TOPGEN], 1u);
            else XB_SPIN(xb_ld(&bar[XB_TOPGEN]) == tg, bar);
            __builtin_amdgcn_fence(__ATOMIC_ACQUIRE, "agent");
            xb_add(&bar[XB_XGEN(b.x)], 1u);
            asm volatile("s_waitcnt vmcnt(0)" ::: "memory");
        } else {
            XB_SPIN(xb_ld(&bar[XB_XGEN(b.x)]) == gen, bar);
            __builtin_amdgcn_fence(__ATOMIC_ACQUIRE, "agent");
            asm volatile("s_waitcnt vmcnt(0)" ::: "memory");
        }
    }
    __syncthreads();
}
namespace rk {
constexpr int MB = 8192;
constexpr int S_AT = 0, S_RT = 1, S_KT = 2, S_BT = 3, S_ATT = 4, S_KTT = 5, S_BTT = 6, S_VT = 7, S_N = 8, S_NT = 9, S_MAK = 10, S_MRB = 11, S_MRK = 12, S_TA = 13, S_TB = 14;
constexpr int SCR = 15 * MB;
constexpr int NCHUNK = SEQ / 64;
constexpr size_t WS_HT = WS_X1;
constexpr size_t WS_Y0 = WS_X1 + 64 * MiB;
constexpr size_t WS_QI = WS_X1 + 96 * MiB;
constexpr size_t WS_LW = WS_RW, WS_LA = WS_RW + 32 * MiB, WS_LG = WS_RW + 64 * MiB;
constexpr size_t WS_SC = WS_RW + 224 * MiB;
constexpr size_t DO_GT = 80 * MiB;
static_assert(WS_SC + 32 * MiB <= WS_END, "rwkv blobs");

__device__ __forceinline__ int moff(int row, int col) { return row * 128 + ((((col >> 3) ^ (row >> 1)) & 7) << 4) + (col & 7) * 2; }
__device__ __forceinline__ int crow(int r, int hi) { return (r & 3) + 8 * (r >> 2) + 4 * hi; }
__device__ __forceinline__ f32x16 mm_nt(const LAS unsigned char* A, int ar0, const LAS unsigned char* Bt, int br0, f32x16 acc, int r32, int hi) {
#pragma unroll
    for (int ks = 0; ks < 4; ++ks) { const bf16x8 a = *(const LAS bf16x8*)(A + moff(ar0 + r32, 16 * ks + 8 * hi)), b = *(const LAS bf16x8*)(Bt + moff(br0 + r32, 16 * ks + 8 * hi));
        acc = __builtin_amdgcn_mfma_f32_32x32x16_bf16(a, b, acc, 0, 0, 0); }
    return acc;
}
__device__ __forceinline__ void store_t(LAS unsigned char* dst, const f32x16& acc, int i0, int j0, int r32, int hi) {
#pragma unroll
    for (int g = 0; g < 4; ++g) { u32x2 w; w.x = pk2(acc[4 * g], acc[4 * g + 1]); w.y = pk2(acc[4 * g + 2], acc[4 * g + 3]); *(LAS u32x2*)(dst + moff(j0 + r32, i0 + 8 * g + 4 * hi)) = w; }
}
template <int MODE> __device__ __forceinline__ void mask_tri(f32x16& acc, int i0, int j0, int r32, int hi) {
#pragma unroll
    for (int r = 0; r < 16; ++r) { const int i = i0 + crow(r, hi), j = j0 + r32; const bool keep = MODE == 0 ? (j < i) : (MODE == 1 ? (i < j) : (i <= j)); if (!keep) acc[r] = 0.f; }
}

__device__ __forceinline__ void pass1_chunk(KPR P, LAS unsigned char* lds, int bh, int c, int tid) {
    const int lane = tid & 63, wave = tid >> 6, r32 = lane & 31, hi = lane >> 5, grp = wave >> 2, wq = wave & 3, i0 = 32 * (wq >> 1), j0 = 32 * (wq & 1);
    const int b = bh >> 3, h = bh & 7; const size_t tok0 = (size_t)b * SEQ + (size_t)c * 64; const size_t ci = (size_t)bh * NCHUNK + c;
    LAS float* part = (LAS float*)(lds + SCR); LAS float* WL = (LAS float*)(lds + SCR + 2048);
#define MAT(s) (lds + (s) * MB)
    {
        const bf16_t* Z = (const bf16_t*)(P.ws + WS_Z); const bf16_t* LW = (const bf16_t*)(P.ws + WS_LW); const bf16_t* LA = (const bf16_t*)(P.ws + WS_LA);
        const int ch = tid & 63, tq = tid >> 6, cc = h * 64 + ch; const size_t row0 = tok0 + 8 * tq;
        const float mur = P.mu[RW_R + cc], muk = P.mu[RW_K + cc], muv = P.mu[RW_V + cc], w0c = P.w0[cc], a0c = P.a0[cc], kkc = P.k_k[cc], kac = P.k_a[cc];
        const bf16_t* zp = Z + row0 * ZW + ZR + cc;
        const bool first = (c == 0) && (tq == 0); const bf16_t* zq = first ? zp : zp - ZW; const float pm = first ? 0.f : 1.f;
        unsigned short lr[9], lk[9], lv[9], llw[8], lla[8];
        lr[0] = zq[RW_R]; lk[0] = zq[RW_K]; lv[0] = zq[RW_V];
#pragma unroll
        for (int i = 0; i < 8; ++i) { const bf16_t* zi = zp + (size_t)i * ZW; lr[i + 1] = zi[RW_R]; lk[i + 1] = zi[RW_K]; lv[i + 1] = zi[RW_V]; const size_t o = (row0 + i) * 512 + cc; llw[i] = LW[o]; lla[i] = LA[o]; }
        float cum[8], vr[8], vk[8], vkk[8], vka[8], ssq[8]; unsigned short vv16[8]; float run = 0.f;
#pragma unroll
        for (int i = 0; i < 8; ++i) { const float pmi = (i == 0) ? pm : 1.f; const float zr1 = bf2f(lr[i + 1]), zk1 = bf2f(lk[i + 1]), zv1 = bf2f(lv[i + 1]);
            vr[i] = zr1 + (bf2f(lr[i]) * pmi - zr1) * mur; vk[i] = zk1 + (bf2f(lk[i]) * pmi - zk1) * muk; vv16[i] = (unsigned short)f2bf(zv1 + (bf2f(lv[i]) * pmi - zv1) * muv);
            vkk[i] = vk[i] * kkc; ssq[i] = vkk[i] * vkk[i]; }
#pragma unroll
        for (int o = 1; o < 64; o <<= 1) {
#pragma unroll
            for (int i = 0; i < 8; ++i) ssq[i] += __shfl_xor(ssq[i], o); }
#pragma unroll
        for (int i = 0; i < 8; ++i) {
            const float wl = w0c + bf2f(llw[i]); const float sp = fmaxf(-wl, 0.f) + __logf(1.0f + __expf(-fabsf(wl)));
            run += -__expf(-sp - 0.5f); cum[i] = run;
            const float a = __builtin_amdgcn_rcpf(1.0f + __expf(-(a0c + bf2f(lla[i]))));
            const float kk = vkk[i] * __builtin_amdgcn_rcpf(fmaxf(__builtin_amdgcn_sqrtf(ssq[i]), 1e-12f));
            vk[i] = vk[i] * (1.0f + (a - 1.0f) * kac); vkk[i] = kk; vka[i] = kk * a; }
        part[tq * 64 + ch] = run;
        __syncthreads();
        float pre = 0.f;
#pragma unroll
        for (int g = 0; g < 8; ++g) { const float pvv = part[g * 64 + ch]; pre += (g < tq) ? pvv : 0.f; }
        float eprev = __expf(pre);
        unsigned atT[4], ktT[4], btT[4], vT[4]; unsigned short hold[4] = {0, 0, 0, 0};
#pragma unroll
        for (int i = 0; i < 8; ++i) { const int t = 8 * tq + i;
            const float cm = pre + cum[i], e1 = __expf(cm), einv = __expf(-cm);
            const unsigned short at = (unsigned short)f2bf(-vkk[i] * eprev), rt = (unsigned short)f2bf(vr[i] * e1), kt = (unsigned short)f2bf(vk[i] * einv), bt = (unsigned short)f2bf(vka[i] * einv), vv = vv16[i];
            eprev = e1;
            *(LAS unsigned short*)(MAT(S_AT) + moff(t, ch)) = at; *(LAS unsigned short*)(MAT(S_RT) + moff(t, ch)) = rt; *(LAS unsigned short*)(MAT(S_KT) + moff(t, ch)) = kt; *(LAS unsigned short*)(MAT(S_BT) + moff(t, ch)) = bt;
            if (i & 1) { atT[i >> 1] = hold[0] | ((unsigned)at << 16); ktT[i >> 1] = hold[1] | ((unsigned)kt << 16); btT[i >> 1] = hold[2] | ((unsigned)bt << 16); vT[i >> 1] = hold[3] | ((unsigned)vv << 16); }
            else { hold[0] = at; hold[1] = kt; hold[2] = bt; hold[3] = vv; }
            if (i == 7 && tq == 7) WL[ch] = e1; }
        *(LAS u32x4*)(MAT(S_ATT) + moff(ch, 8 * tq)) = (u32x4){atT[0], atT[1], atT[2], atT[3]}; *(LAS u32x4*)(MAT(S_KTT) + moff(ch, 8 * tq)) = (u32x4){ktT[0], ktT[1], ktT[2], ktT[3]};
        *(LAS u32x4*)(MAT(S_BTT) + moff(ch, 8 * tq)) = (u32x4){btT[0], btT[1], btT[2], btT[3]}; *(LAS u32x4*)(MAT(S_VT) + moff(ch, 8 * tq)) = (u32x4){vT[0], vT[1], vT[2], vT[3]};
    }
    __syncthreads();
    const f32x16 zero = f32x16{};
    if (grp == 0) { f32x16 d = mm_nt(MAT(S_AT), i0, MAT(S_BT), j0, zero, r32, hi); mask_tri<0>(d, i0, j0, r32, hi); store_t(MAT(S_NT), d, i0, j0, r32, hi);
        d = mm_nt(MAT(S_KT), i0, MAT(S_AT), j0, zero, r32, hi); mask_tri<1>(d, i0, j0, r32, hi); store_t(MAT(S_MAK), d, i0, j0, r32, hi);
        d = mm_nt(MAT(S_KT), i0, MAT(S_RT), j0, zero, r32, hi); mask_tri<2>(d, i0, j0, r32, hi); store_t(MAT(S_MRK), d, i0, j0, r32, hi); }
    else { f32x16 d = mm_nt(MAT(S_BT), i0, MAT(S_AT), j0, zero, r32, hi); mask_tri<1>(d, i0, j0, r32, hi); store_t(MAT(S_N), d, i0, j0, r32, hi);
#pragma unroll
        for (int r = 0; r < 16; ++r) if (i0 + crow(r, hi) == j0 + r32) d[r] = 1.0f;
        store_t(MAT(S_TA), d, i0, j0, r32, hi);
        d = mm_nt(MAT(S_BT), i0, MAT(S_RT), j0, zero, r32, hi); mask_tri<2>(d, i0, j0, r32, hi); store_t(MAT(S_MRB), d, i0, j0, r32, hi); }
    __syncthreads();
#pragma unroll
    for (int s = 1; s <= 6; ++s) {
        const int mc = (s & 1) ? S_N : S_AT, mcT = (s & 1) ? S_NT : S_KT, mn = (s & 1) ? S_AT : S_N, mnT = (s & 1) ? S_KT : S_NT;
        const int tc = (s & 1) ? S_TB : S_TA, tn = (s & 1) ? S_TA : S_TB;
        if (s <= 5) {
            if (grp == 0) { const f32x16 d = mm_nt(MAT(mc), i0, MAT(mcT), j0, zero, r32, hi); store_t(MAT(mnT), d, i0, j0, r32, hi); }
            else { const f32x16 d = mm_nt(MAT(mcT), i0, MAT(mc), j0, zero, r32, hi); store_t(MAT(mn), d, i0, j0, r32, hi); }
        }
        if (s >= 2 && grp == (s <= 5 ? 0 : 1) ) {
            f32x16 d = mm_nt(MAT(mcT), i0, MAT(tc), j0, zero, r32, hi);
#pragma unroll
            for (int g = 0; g < 4; ++g) { const u32x2 tv = *(const LAS u32x2*)(MAT(tc) + moff(j0 + r32, i0 + 8 * g + 4 * hi)); d[4 * g] += bflo(tv.x); d[4 * g + 1] += bfhi(tv.x); d[4 * g + 2] += bflo(tv.y); d[4 * g + 3] += bfhi(tv.y); }
            store_t(MAT(tn), d, i0, j0, r32, hi);
        }
        __syncthreads();
    }
    if (grp == 0) { const f32x16 d = mm_nt(MAT(S_TB), i0, MAT(S_ATT), j0, zero, r32, hi); store_t(MAT(S_BT), d, i0, j0, r32, hi); }
    else { const f32x16 d = mm_nt(MAT(S_MAK), i0, MAT(S_VT), j0, zero, r32, hi); store_t(MAT(S_N), d, i0, j0, r32, hi); }
    __syncthreads();
    if (grp == 0) { const f32x16 d = mm_nt(MAT(S_TB), i0, MAT(S_N), j0, zero, r32, hi); store_t(MAT(S_NT), d, i0, j0, r32, hi);
        f32x16 q = mm_nt(MAT(S_BT), i0, MAT(S_MRB), j0, zero, r32, hi);
#pragma unroll
        for (int g = 0; g < 4; ++g) { const u32x2 rv = *(const LAS u32x2*)(MAT(S_RT) + moff(j0 + r32, i0 + 8 * g + 4 * hi)); q[4 * g] += bflo(rv.x); q[4 * g + 1] += bfhi(rv.x); q[4 * g + 2] += bflo(rv.y); q[4 * g + 3] += bfhi(rv.y); }
        store_t(MAT(S_KT), q, i0, j0, r32, hi); }
    else { f32x16 g_ = mm_nt(MAT(S_BT), i0, MAT(S_BTT), j0, zero, r32, hi);
        const float wl = WL[j0 + r32];
#pragma unroll
        for (int r = 0; r < 16; ++r) { if (i0 + crow(r, hi) == j0 + r32) g_[r] += 1.0f; g_[r] *= wl; }
        store_t(MAT(S_AT), g_, i0, j0, r32, hi); }
    __syncthreads();
    if (grp == 0) { f32x16 d = mm_nt(MAT(S_BTT), i0, MAT(S_NT), j0, zero, r32, hi); d = mm_nt(MAT(S_KTT), i0, MAT(S_VT), j0, d, r32, hi);
        float* HT = (float*)(P.ws + WS_HT) + ci * 4096 + (size_t)wq * 1024 + lane;
#pragma unroll
        for (int g = 0; g < 4; ++g) { const f32x4 wl4 = *(const LAS f32x4*)(WL + i0 + 8 * g + 4 * hi);
#pragma unroll
            for (int i = 0; i < 4; ++i) HT[(4 * g + i) * 64] = d[4 * g + i] * wl4[i]; } }
    else { f32x16 d = mm_nt(MAT(S_MRB), i0, MAT(S_NT), j0, zero, r32, hi); d = mm_nt(MAT(S_MRK), i0, MAT(S_VT), j0, d, r32, hi);
        unsigned* Y0 = (unsigned*)(P.ws + WS_Y0) + ci * 2048 + (size_t)wq * 512 + lane;
#pragma unroll
        for (int r2 = 0; r2 < 8; ++r2) Y0[r2 * 64] = pk2(d[2 * r2], d[2 * r2 + 1]); }
    { u32x4* GTg = (u32x4*)((unsigned char*)P.out + DO_GT + ci * MB); u32x4* QIg = (u32x4*)(P.ws + WS_QI + ci * MB);
        GTg[tid] = *(const LAS u32x4*)(MAT(S_AT) + tid * 16); QIg[tid] = *(const LAS u32x4*)(MAT(S_KT) + tid * 16); }
    __syncthreads();
#undef MAT
}

__device__ __forceinline__ void pass2_seq(KPR P, LAS unsigned char* lds, int bh, int tid) {
    const int lane = tid & 63, wave = tid >> 6, r32 = lane & 31, hi = lane >> 5, wq = wave & 3, i0 = 32 * (wq >> 1), j0 = 32 * (wq & 1);
    LAS unsigned char* Sm = lds; LAS unsigned char* G0 = lds + MB; LAS unsigned char* G1 = lds + 2 * MB;
    const size_t ci0 = (size_t)bh * NCHUNK;
    const u32x4* GTg = (const u32x4*)((const unsigned char*)P.out + DO_GT + ci0 * MB); u32x4* SCg = (u32x4*)(P.ws + WS_SC + ci0 * MB);
    const float* HT = (const float*)(P.ws + WS_HT) + ci0 * 4096 + (size_t)wq * 1024 + lane;
    *(LAS u32x4*)(Sm + tid * 16) = (u32x4){0u, 0u, 0u, 0u};
    *(LAS u32x4*)(G0 + tid * 16) = GTg[tid];
    u32x4 gnext = GTg[512 + tid];
    f32x16 hcur, hnext;
    if (wave < 4) {
#pragma unroll
        for (int r = 0; r < 16; ++r) { hcur[r] = HT[r * 64]; hnext[r] = HT[4096 + r * 64]; } }
    __syncthreads();
    for (int c = 0; c < NCHUNK; ++c) {
        LAS unsigned char* Gc = (c & 1) ? G1 : G0; LAS unsigned char* Gn = (c & 1) ? G0 : G1;
        SCg[(size_t)c * 512 + tid] = *(const LAS u32x4*)(Sm + tid * 16);
        f32x16 d = hcur;
        if (wave < 4) d = mm_nt(Gc, i0, Sm, j0, d, r32, hi);
        __syncthreads();
        if (wave < 4) store_t(Sm, d, i0, j0, r32, hi);
        *(LAS u32x4*)(Gn + tid * 16) = gnext;
        const int c2 = (c + 2 < NCHUNK) ? c + 2 : NCHUNK - 1;
        gnext = GTg[(size_t)c2 * 512 + tid];
        if (wave < 4) { hcur = hnext;
#pragma unroll
            for (int r = 0; r < 16; ++r) hnext[r] = HT[(size_t)c2 * 4096 + r * 64]; }
        __syncthreads();
    }
}

__device__ __forceinline__ void pass3_chunk(KPR P, LAS unsigned char* lds, int bh, int c, int tid) {
    const int lane = tid & 63, wave = tid >> 6, r32 = lane & 31, hi = lane >> 5, wq = wave & 3, i0 = 32 * (wq >> 1), j0 = 32 * (wq & 1);
    const int b = bh >> 3, h = bh & 7; const size_t tok0 = (size_t)b * SEQ + (size_t)c * 64; const size_t ci = (size_t)bh * NCHUNK + c;
    LAS unsigned char* Qm = lds; LAS unsigned char* Sm = lds + MB; LAS float* Yl = (LAS float*)(lds + 2 * MB);
    *(LAS u32x4*)(Qm + tid * 16) = ((const u32x4*)(P.ws + WS_QI + ci * MB))[tid];
    *(LAS u32x4*)(Sm + tid * 16) = ((const u32x4*)(P.ws + WS_SC + ci * MB))[tid];
    f32x16 d = f32x16{};
    if (wave < 4) { const unsigned* Y0 = (const unsigned*)(P.ws + WS_Y0) + ci * 2048 + (size_t)wq * 512 + lane;
#pragma unroll
        for (int r2 = 0; r2 < 8; ++r2) { const unsigned w = Y0[r2 * 64]; d[2 * r2] = bflo(w); d[2 * r2 + 1] = bfhi(w); } }
    __syncthreads();
    if (wave < 4) { d = mm_nt(Qm, i0, Sm, j0, d, r32, hi);
#pragma unroll
        for (int r = 0; r < 16; ++r) Yl[(i0 + crow(r, hi)) * 65 + j0 + r32] = d[r]; }
    __syncthreads();
    const bf16_t* Z = (const bf16_t*)(P.ws + WS_Z); const bf16_t* LA = (const bf16_t*)(P.ws + WS_LA); const bf16_t* LG = (const bf16_t*)(P.ws + WS_LG);
    bf16_t* AO = (bf16_t*)(P.ws + WS_AO); const int cc = h * 64 + lane;
    const float lnw = P.ln_w[cc], lnb = P.ln_b[cc], rkc = P.r_k[cc], mur = P.mu[RW_R + cc], muk = P.mu[RW_K + cc], muv = P.mu[RW_V + cc], a0c = P.a0[cc], kac = P.k_a[cc];
    const bf16_t* zp = Z + (tok0 + wave * 8) * ZW + ZR + cc; const bool first = (c == 0) && (wave == 0); const bf16_t* zq = first ? zp : zp - ZW; const float pm = first ? 0.f : 1.f;
    unsigned short lr[9], lk[9], lv[9], lla[8], llg[8];
    lr[0] = zq[RW_R]; lk[0] = zq[RW_K]; lv[0] = zq[RW_V];
#pragma unroll
    for (int i = 0; i < 8; ++i) { const bf16_t* zi = zp + (size_t)i * ZW; lr[i + 1] = zi[RW_R]; lk[i + 1] = zi[RW_K]; lv[i + 1] = zi[RW_V]; const size_t o = (tok0 + wave * 8 + i) * 512 + cc; lla[i] = LA[o]; llg[i] = LG[o]; }
    float y[8], s1[8], s2[8], s3[8], vvv[8];
#pragma unroll
    for (int i = 0; i < 8; ++i) { const float pmi = (i == 0) ? pm : 1.f; const float zr1 = bf2f(lr[i + 1]), zk1 = bf2f(lk[i + 1]), zv1 = bf2f(lv[i + 1]);
        const float r = zr1 + (bf2f(lr[i]) * pmi - zr1) * mur, zk = zk1 + (bf2f(lk[i]) * pmi - zk1) * muk; vvv[i] = zv1 + (bf2f(lv[i]) * pmi - zv1) * muv;
        const float a = __builtin_amdgcn_rcpf(1.0f + __expf(-(a0c + bf2f(lla[i])))); const float k = zk * (1.0f + (a - 1.0f) * kac);
        y[i] = Yl[(wave * 8 + i) * 65 + lane]; s1[i] = y[i]; s3[i] = r * k * rkc; }
#pragma unroll
    for (int o = 1; o < 64; o <<= 1) {
#pragma unroll
        for (int i = 0; i < 8; ++i) { s1[i] += __shfl_xor(s1[i], o); s3[i] += __shfl_xor(s3[i], o); } }
#pragma unroll
    for (int i = 0; i < 8; ++i) { y[i] -= s1[i] * (1.f / 64.f); s2[i] = y[i] * y[i]; }
#pragma unroll
    for (int o = 1; o < 64; o <<= 1) {
#pragma unroll
        for (int i = 0; i < 8; ++i) s2[i] += __shfl_xor(s2[i], o); }
#pragma unroll
    for (int i = 0; i < 8; ++i) { const size_t tok = tok0 + wave * 8 + i; const float yn = y[i] * rsqrtf(s2[i] * (1.f / 64.f) + 64e-5f) * lnw + lnb;
        AO[tok * DM + 512 + cc] = (bf16_t)f2bf((yn + s3[i] * vvv[i]) * bf2f(llg[i])); }
}

constexpr size_t WS_W2T = 29 * MiB, WS_A2T = 29 * MiB + 65536, WS_G2T = 29 * MiB + 131072;
__device__ __forceinline__ bf16x8 act8(const bf16_t* zc, const bf16_t* zpv, float pmask, const float* mu, int mode) {
    const u32x4 c = *(const u32x4*)zc, p = *(const u32x4*)zpv;
    const f32x4 m0 = *(const f32x4*)mu, m1 = *(const f32x4*)(mu + 4);
    const unsigned cw[4] = {c.x, c.y, c.z, c.w}, pw[4] = {p.x, p.y, p.z, p.w}; const float um[8] = {m0[0], m0[1], m0[2], m0[3], m1[0], m1[1], m1[2], m1[3]}; float v[8];
#pragma unroll
    for (int j = 0; j < 4; ++j) { const float c0 = bflo(cw[j]), c1 = bfhi(cw[j]), p0 = bflo(pw[j]) * pmask, p1 = bfhi(pw[j]) * pmask;
        v[2 * j] = c0 + (p0 - c0) * um[2 * j]; v[2 * j + 1] = c1 + (p1 - c1) * um[2 * j + 1]; }
#pragma unroll
    for (int j = 0; j < 8; ++j) { if (mode == 0) { const float e = __expf(-2.0f * fabsf(v[j])); const float th = (1.0f - e) / (1.0f + e); v[j] = v[j] < 0.f ? -th : th; } else if (mode == 2) v[j] = 1.0f / (1.0f + __expf(-v[j])); }
    u32x4 w; w.x = pk2(v[0], v[1]); w.y = pk2(v[2], v[3]); w.z = pk2(v[4], v[5]); w.w = pk2(v[6], v[7]);
    return __builtin_bit_cast(bf16x8, w);
}
__device__ __forceinline__ void lora_task(KPR P, int task, int lane) {
    const int r32 = lane & 31, hi = lane >> 5; const size_t row = (size_t)task * 32 + r32; const bool first = (row % SEQ) == 0;
    const bf16_t* Z = (const bf16_t*)(P.ws + WS_Z) + row * ZW + ZR + 8 * hi; const bf16_t* Zp = first ? Z : Z - ZW; const float pmask = first ? 0.f : 1.f;
    const float* mub = P.mu + 8 * hi;
    bf16x8 xw[4], xa[4], xg[8];
#pragma unroll
    for (int ks = 0; ks < 4; ++ks) { xw[ks] = act8(Z + RW_W + 16 * ks, Zp + RW_W + 16 * ks, pmask, mub + RW_W + 16 * ks, 0); xa[ks] = act8(Z + RW_A + 16 * ks, Zp + RW_A + 16 * ks, pmask, mub + RW_A + 16 * ks, 1); asm volatile("" ::: "memory"); }
#pragma unroll
    for (int ks = 0; ks < 8; ++ks) { xg[ks] = act8(Z + RW_G + 16 * ks, Zp + RW_G + 16 * ks, pmask, mub + RW_G + 16 * ks, 2); if (ks & 1) asm volatile("" ::: "memory"); }
    const bf16_t* W2T = (const bf16_t*)(P.ws + WS_W2T) + r32 * 64 + 8 * hi; const bf16_t* A2T = (const bf16_t*)(P.ws + WS_A2T) + r32 * 64 + 8 * hi; const bf16_t* G2T = (const bf16_t*)(P.ws + WS_G2T) + r32 * 128 + 8 * hi;
    bf16_t* LW = (bf16_t*)(P.ws + WS_LW) + row * 512 + 4 * hi; bf16_t* LA = (bf16_t*)(P.ws + WS_LA) + row * 512 + 4 * hi; bf16_t* LG = (bf16_t*)(P.ws + WS_LG) + row * 512 + 4 * hi;
#pragma nounroll
    for (int cb = 0; cb < 16; ++cb) {
        f32x16 dw = f32x16{}, da = f32x16{}, dg = f32x16{};
#pragma unroll
        for (int ks = 0; ks < 4; ++ks) { dw = __builtin_amdgcn_mfma_f32_32x32x16_bf16(*(const bf16x8*)(W2T + cb * 32 * 64 + 16 * ks), xw[ks], dw, 0, 0, 0); da = __builtin_amdgcn_mfma_f32_32x32x16_bf16(*(const bf16x8*)(A2T + cb * 32 * 64 + 16 * ks), xa[ks], da, 0, 0, 0); }
#pragma unroll
        for (int ks = 0; ks < 8; ++ks) dg = __builtin_amdgcn_mfma_f32_32x32x16_bf16(*(const bf16x8*)(G2T + cb * 32 * 128 + 16 * ks), xg[ks], dg, 0, 0, 0);
#pragma unroll
        for (int g = 0; g < 4; ++g) { u32x2 w; w.x = pk2(dw[4 * g], dw[4 * g + 1]); w.y = pk2(dw[4 * g + 2], dw[4 * g + 3]); *(u32x2*)(LW + cb * 32 + 8 * g) = w;
            w.x = pk2(da[4 * g], da[4 * g + 1]); w.y = pk2(da[4 * g + 2], da[4 * g + 3]); *(u32x2*)(LA + cb * 32 + 8 * g) = w;
            w.x = pk2(dg[4 * g], dg[4 * g + 1]); w.y = pk2(dg[4 * g + 2], dg[4 * g + 3]); *(u32x2*)(LG + cb * 32 + 8 * g) = w; }
    }
}
}
namespace rt {
__device__ __forceinline__ int woff(int e, int k) { return e * 2048 + ((((k >> 3) ^ (e & 15))) << 4) + (k & 7) * 2; }
constexpr size_t WS_WRI = 30 * MiB;
__device__ __forceinline__ void build_w(KPR P, int tid) {
    unsigned char* img = P.ws + WS_WRI; const int e = tid & 31, kq = tid >> 5;
    for (int i0 = 0; i0 < 64; i0 += 8) { float w[8];
#pragma unroll
        for (int i = 0; i < 8; ++i) { const int k = kq * 64 + i0 + i; w[i] = P.moe_norm[k] * P.w_router[k * 32 + e]; }
#pragma unroll
        for (int i = 0; i < 8; ++i) { const int k = kq * 64 + i0 + i; const unsigned h = f2bf(w[i]); const unsigned l = f2bf(w[i] - bf2f(h));
            *(unsigned short*)(img + woff(e, k)) = (unsigned short)h; *(unsigned short*)(img + 65536 + woff(e, k)) = (unsigned short)l; } }
}
__device__ __forceinline__ void copy_w(KPR P, LAS unsigned char* lds, int tid) {
    const u32x4* img = (const u32x4*)(P.ws + WS_WRI);
#pragma unroll 4
    for (int i = 0; i < 16; ++i) *(LAS u32x4*)(lds + (size_t)(i * 512 + tid) * 16) = img[i * 512 + tid];
}
__device__ __forceinline__ void split8(const f32x4& a, const f32x4& b, bf16x8& h, bf16x8& l) {
    unsigned hh[8]; float v[8] = {a[0], a[1], a[2], a[3], b[0], b[1], b[2], b[3]};
#pragma unroll
    for (int j = 0; j < 8; ++j) hh[j] = f2bf(v[j]);
    u32x4 hw, lw;
    hw.x = hh[0] | (hh[1] << 16); hw.y = hh[2] | (hh[3] << 16); hw.z = hh[4] | (hh[5] << 16); hw.w = hh[6] | (hh[7] << 16);
    lw.x = pk2(v[0] - bf2f(hh[0]), v[1] - bf2f(hh[1])); lw.y = pk2(v[2] - bf2f(hh[2]), v[3] - bf2f(hh[3])); lw.z = pk2(v[4] - bf2f(hh[4]), v[5] - bf2f(hh[5])); lw.w = pk2(v[6] - bf2f(hh[6]), v[7] - bf2f(hh[7]));
    h = __builtin_bit_cast(bf16x8, hw); l = __builtin_bit_cast(bf16x8, lw);
}
__device__ __forceinline__ void route_task(KPR P, const LAS unsigned char* wlds, int task, int lane) {
    const int r32 = lane & 31, hi = lane >> 5; const int row = task * 32 + r32;
    const float* xrow = (const float*)(P.ws + WS_X1) + (size_t)row * DM + 8 * hi;
    f32x16 acc = f32x16{}; float ss = 0.f;
    f32x4 xa[4], xb[4];
#pragma unroll
    for (int j = 0; j < 4; ++j) { xa[j] = *(const f32x4*)(xrow + 16 * j); xb[j] = *(const f32x4*)(xrow + 16 * j + 4); }
    for (int ks0 = 0; ks0 < 64; ks0 += 4) {
#pragma unroll
        for (int j = 0; j < 4; ++j) { const int ks = ks0 + j; const f32x4 a = xa[j], b = xb[j];
            const int kn = (ks + 4 < 64) ? ks + 4 : ks; xa[j] = *(const f32x4*)(xrow + 16 * kn); xb[j] = *(const f32x4*)(xrow + 16 * kn + 4);
            ss += (a[0] * a[0] + a[1] * a[1]) + (a[2] * a[2] + a[3] * a[3]) + (b[0] * b[0] + b[1] * b[1]) + (b[2] * b[2] + b[3] * b[3]);
            bf16x8 xh, xl; split8(a, b, xh, xl);
            const bf16x8 wh = *(const LAS bf16x8*)(wlds + woff(r32, 16 * ks + 8 * hi)), wl = *(const LAS bf16x8*)(wlds + 65536 + woff(r32, 16 * ks + 8 * hi));
            acc = __builtin_amdgcn_mfma_f32_32x32x16_bf16(wh, xh, acc, 0, 0, 0); acc = __builtin_amdgcn_mfma_f32_32x32x16_bf16(wh, xl, acc, 0, 0, 0); acc = __builtin_amdgcn_mfma_f32_32x32x16_bf16(wl, xh, acc, 0, 0, 0); }
    }
    ss += __shfl_xor(ss, 32);
    const float rstd = rsqrtf(ss * (1.f / DM) + 1e-6f);
    float lg[16];
#pragma unroll
    for (int g = 0; g < 4; ++g) { const f32x4 bb = *(const f32x4*)(P.b_router + 8 * g + 4 * hi);
#pragma unroll
        for (int i = 0; i < 4; ++i) lg[4 * g + i] = acc[4 * g + i] * rstd + bb[i]; }
    float tv[4]; int ti[4];
#pragma unroll
    for (int k = 0; k < 4; ++k) { float bv = lg[0]; int bi = 4 * hi;
#pragma unroll
        for (int r = 1; r < 16; ++r) { const int e = (r & 3) + 8 * (r >> 2) + 4 * hi; if (lg[r] > bv) { bv = lg[r]; bi = e; } }
        const float pv = __shfl_xor(bv, 32); const int pi = __shfl_xor(bi, 32);
        if (pv > bv || (pv == bv && pi < bi)) { bv = pv; bi = pi; }
        tv[k] = bv; ti[k] = bi;
#pragma unroll
        for (int r = 0; r < 16; ++r) { const int e = (r & 3) + 8 * (r >> 2) + 4 * hi; if (e == bi) lg[r] = -INFINITY; } }
    const float e1 = __expf(tv[1] - tv[0]), e2 = __expf(tv[2] - tv[0]), e3 = __expf(tv[3] - tv[0]), inv = 1.f / (1.f + e1 + e2 + e3);
    const int c0 = hi ? ti[2] : ti[0], c1 = hi ? ti[3] : ti[1]; const float g0 = (hi ? e2 : 1.f) * inv, g1 = (hi ? e3 : e1) * inv;
    const unsigned long long ltm = (1ull << lane) - 1ull; int mycnt = 0, rk0 = 0, rk1 = 0;
    for (int e = 0; e < 32; ++e) { const unsigned long long m0 = __ballot(c0 == e), m1 = __ballot(c1 == e); const int n0 = __popcll(m0);
        if (lane == e) mycnt = n0 + __popcll(m1);
        if (c0 == e) rk0 = __popcll(m0 & ltm);
        if (c1 == e) rk1 = n0 + __popcll(m1 & ltm); }
    unsigned* cnt = (unsigned*)(P.ws + WS_CTL) + CW_CNT; int base = 0;
    if (lane < 32 && mycnt > 0) base = (int)atomicAdd(cnt + lane, (unsigned)mycnt);
    rk0 += __shfl(base, c0); rk1 += __shfl(base, c1);
    int* route = (int*)(P.ws + WS_ROUTE); int* tokslot = (int*)(P.ws + WS_TOKSLOT); float* gateslot = (float*)(P.ws + WS_GATESLOT);
    tokslot[(size_t)c0 * NTOK + rk0] = row; gateslot[(size_t)c0 * NTOK + rk0] = g0; tokslot[(size_t)c1 * NTOK + rk1] = row; gateslot[(size_t)c1 * NTOK + rk1] = g1;
    route[(size_t)row * 12 + 2 * hi] = c0; route[(size_t)row * 12 + 2 * hi + 1] = c1; route[(size_t)row * 12 + 4 + 2 * hi] = rk0; route[(size_t)row * 12 + 4 + 2 * hi + 1] = rk1;
    unsigned char* xn = P.ws + WS_XN + (size_t)row * DM + 8 * hi; const float* gn = P.moe_norm + 8 * hi;
#pragma unroll
    for (int j = 0; j < 4; ++j) { xa[j] = *(const f32x4*)(xrow + 16 * j); xb[j] = *(const f32x4*)(xrow + 16 * j + 4); }
    for (int ks0 = 0; ks0 < 64; ks0 += 4) {
#pragma unroll
        for (int j = 0; j < 4; ++j) { const int ks = ks0 + j; const f32x4 a = xa[j], b = xb[j], ga = *(const f32x4*)(gn + 16 * ks), gb = *(const f32x4*)(gn + 16 * ks + 4);
            const int kn = (ks + 4 < 64) ? ks + 4 : ks; xa[j] = *(const f32x4*)(xrow + 16 * kn); xb[j] = *(const f32x4*)(xrow + 16 * kn + 4);
            u32x2 w; w.x = pk4_fp8(a[0] * rstd * ga[0], a[1] * rstd * ga[1], a[2] * rstd * ga[2], a[3] * rstd * ga[3]); w.y = pk4_fp8(b[0] * rstd * gb[0], b[1] * rstd * gb[1], b[2] * rstd * gb[2], b[3] * rstd * gb[3]);
            *(u32x2*)(xn + 16 * ks) = w; }
    }
}
}
namespace attn_body {
using bf16=unsigned short;
using bf16x8=__attribute__((ext_vector_type(8)))short;
using s16x4=__attribute__((ext_vector_type(4)))short;
using f32x16=__attribute__((ext_vector_type(16)))float;
using u32x4=__attribute__((ext_vector_type(4)))unsigned;
constexpr int BATCH=4,NHEAD=8,SEQ=8192,D=64,DM=3840,OP=1024;
constexpr int NW=8,QBLK=32,QB=QBLK*NW,KVBLK=64,NQB=SEQ/QB;
constexpr int ATTN_PITCH=DM, ATTN_UNIT_ROWS=QB;
__device__ __forceinline__ int crow(int r,int hi){return (r&3)+8*(r>>2)+4*hi;}
#define SBAR() __builtin_amdgcn_sched_barrier(0)
__device__ __forceinline__ void cmask(f32x16&p0,f32x16&p1,int jb,int qrel,int hi){
  const float NEG=-INFINITY; int kb=64*jb+4*hi;
  #pragma unroll
  for(int r=0;r<16;++r){int kv=kb+(r&3)+8*(r>>2); if(kv>qrel)p0[r]=NEG; if(kv+32>qrel)p1[r]=NEG;}
}

constexpr int NSLOT=3, SLOTB=8192;
constexpr int LDS_K=0, LDS_V=NSLOT*SLOTB, LDS_WS=2*NSLOT*SLOTB, LDS_OST=LDS_WS+NW*64*4, LDS_C2=LDS_OST+NW*4096, LDS_BYTES=LDS_C2+SEQ*4;
constexpr float C2=0.125f*1.4426950408889634f;
__device__ __forceinline__ void glds16(const void*gsrc,unsigned lds_dst){unsigned keep;
  asm volatile("s_mov_b32 %0, m0\n\ts_mov_b32 m0, %2\n\ts_nop 0\n\tglobal_load_lds_dwordx4 %1, off\n\ts_mov_b32 m0, %0":"=&s"(keep):"v"(gsrc),"s"(lds_dst):"memory");}
__device__ __forceinline__ float max3f(float a,float b,float c){float r;asm("v_max3_f32 %0, %1, %2, %3":"=v"(r):"v"(a),"v"(b),"v"(c));return r;}
__device__ __forceinline__ float max2f(float a,float b){float r;asm("v_max_f32_e32 %0, %1, %2":"=v"(r):"v"(a),"v"(b));return r;}
__device__ __forceinline__ float fadd_s(float a,float b){float r;asm("v_add_f32_e32 %0, %1, %2":"=v"(r):"v"(a),"v"(b));return r;}
__device__ __forceinline__ float fsub_s(float a,float b){float r;asm("v_sub_f32_e32 %0, %1, %2":"=v"(r):"v"(a),"v"(b));return r;}
typedef float f32x2_t __attribute__((ext_vector_type(2))); typedef float f32x4v __attribute__((ext_vector_type(4))); typedef __bf16 bf16x2_t __attribute__((ext_vector_type(2)));
__device__ __forceinline__ unsigned cvtpk_s(float lo,float hi){f32x2_t v={lo,hi};bf16x2_t b=__builtin_convertvector(v,bf16x2_t);return __builtin_bit_cast(unsigned,b);}
#define WAIT_BAR(N) asm volatile("s_waitcnt vmcnt(" #N ") lgkmcnt(0)\n\ts_barrier":::"memory")

__device__ __forceinline__ void qkt(f32x16&p0,f32x16&p1,const char*Kslot,const bf16x8*qr,int r32,int hi){
  const char*kb=Kslot+hi*1024+r32*16;
  #pragma unroll
  for(int d0=0;d0<4;++d0){
    const bf16x8 b0=*reinterpret_cast<const bf16x8*>(kb+d0*2048);
    const bf16x8 b1=*reinterpret_cast<const bf16x8*>(kb+d0*2048+512);
    p0=__builtin_amdgcn_mfma_f32_32x32x16_bf16(b0,qr[d0],p0,0,0,0);p1=__builtin_amdgcn_mfma_f32_32x32x16_bf16(b1,qr[d0],p1,0,0,0);}
}
typedef __attribute__((address_space(3))) const char* lds_cptr;
typedef short v4i16_t __attribute__((ext_vector_type(4)));
__device__ __forceinline__ void kload8(bf16x8*kf,lds_cptr kp){
  kf[0]=*(const __attribute__((address_space(3))) bf16x8*)(kp);      kf[1]=*(const __attribute__((address_space(3))) bf16x8*)(kp+512);
  kf[2]=*(const __attribute__((address_space(3))) bf16x8*)(kp+2048); kf[3]=*(const __attribute__((address_space(3))) bf16x8*)(kp+2560);
  kf[4]=*(const __attribute__((address_space(3))) bf16x8*)(kp+4096); kf[5]=*(const __attribute__((address_space(3))) bf16x8*)(kp+4608);
  kf[6]=*(const __attribute__((address_space(3))) bf16x8*)(kp+6144); kf[7]=*(const __attribute__((address_space(3))) bf16x8*)(kp+6656);
}
__device__ __forceinline__ void kload2(bf16x8*kf,lds_cptr kp,int j){ kf[2*j]=*(const __attribute__((address_space(3))) bf16x8*)(kp+j*2048); kf[2*j+1]=*(const __attribute__((address_space(3))) bf16x8*)(kp+j*2048+512); }
__device__ __forceinline__ s16x4 vtr(lds_cptr p){ return __builtin_bit_cast(s16x4,__builtin_amdgcn_ds_read_tr16_b64_v4i16((__attribute__((address_space(3))) v4i16_t*)p)); }
__device__ __forceinline__ float rowmax(const f32x16&p0,const f32x16&p1){
  float a=max3f(p0[0],p0[1],p1[0]),b=max3f(p0[2],p0[3],p1[1]);a=max3f(a,p1[2],p1[3]);
  #pragma unroll
  for(int r=4;r<16;r+=4){a=max3f(a,p0[r],p0[r+1]);b=max3f(b,p0[r+2],p0[r+3]);a=max3f(a,p1[r],p1[r+1]);b=max3f(b,p1[r+2],p1[r+3]);}
  const float m=max2f(a,b);
  auto rr=__builtin_amdgcn_permlane32_swap(__float_as_uint(m),__float_as_uint(m),false,false);
  return max2f(__uint_as_float(rr[0]),__uint_as_float(rr[1]));
}
__device__ __forceinline__ void pv(f32x16*o,int vb,bf16x8 pa0,bf16x8 pa1,bf16x8 pa2,bf16x8 pa3){
  #pragma unroll
  for(int d0=0;d0<2;++d0){s16x4 lo[4],hi[4];
    #pragma unroll
    for(int ks=0;ks<4;++ks){
      asm volatile("ds_read_b64_tr_b16 %0,%1 offset:%c2":"=&v"(lo[ks]):"v"(vb),"i"(d0*4096+ks*1024):"memory");
      asm volatile("ds_read_b64_tr_b16 %0,%1 offset:%c2":"=&v"(hi[ks]):"v"(vb),"i"(d0*4096+ks*1024+512):"memory");}
    asm volatile("s_waitcnt lgkmcnt(0)":::"memory");SBAR();
    #define PK(k) (bf16x8){lo[k][0],lo[k][1],lo[k][2],lo[k][3],hi[k][0],hi[k][1],hi[k][2],hi[k][3]}
    o[d0]=__builtin_amdgcn_mfma_f32_32x32x16_bf16(pa0,PK(0),o[d0],0,0,0);
    o[d0]=__builtin_amdgcn_mfma_f32_32x32x16_bf16(pa1,PK(1),o[d0],0,0,0);
    o[d0]=__builtin_amdgcn_mfma_f32_32x32x16_bf16(pa2,PK(2),o[d0],0,0,0);
    o[d0]=__builtin_amdgcn_mfma_f32_32x32x16_bf16(pa3,PK(3),o[d0],0,0,0);
    #undef PK
  }
}

#ifndef ATTN_STORE16
#define ATTN_STORE16(p,v) (*(u32x4*)(p)=(v))
#endif
template<int THRL> __device__ __forceinline__ void attn_unit(int b,int h,int qb,int t0,const bf16*Z,const float*c2g,bf16*O,char*shm){
  const int tid=threadIdx.x,lane=tid&63,r32=lane&31,hi=lane>>5; const int wid=__builtin_amdgcn_readfirstlane(tid>>6);
  const long rowbase=(long)b*SEQ; const int q0=qb*QB;
  const bf16*Qw=Z+(rowbase+q0+wid*QBLK)*DM+h*D;
  const bf16*Kh=Z+(rowbase+(long)t0*KVBLK)*DM+512+h*D,*Vh=Z+(rowbase+(long)t0*KVBLK)*DM+1024+h*D;
  const unsigned lds0=(unsigned)(uintptr_t)shm;
  float*wsf=(float*)(shm+LDS_WS)+wid*64;
  const bf16*ksrc=Kh+(long)lane*DM+wid*8;
  const bf16*vsrc=Vh+(long)(16*(wid&3)+(lane>>2))*DM+(wid>>2)*32+(lane&3)*8;
  const unsigned kdst=lds0+LDS_K+wid*1024, vdst=lds0+LDS_V+wid*1024;
  #define DMA_K(t,slot) glds16(ksrc+(long)(t)*KVBLK*DM,(unsigned)__builtin_amdgcn_readfirstlane(kdst+(slot)))
  #define DMA_V(t,slot) glds16(vsrc+(long)(t)*KVBLK*DM,(unsigned)__builtin_amdgcn_readfirstlane(vdst+(slot)))
  const int vb0=(int)(lds0+LDS_V)+((lane>>4)&1)*32+(lane&3)*8+(4*hi+((lane&15)>>2))*64;
  const char*Kbase=shm+LDS_K; bf16x8 kf[8];
  const lds_cptr shm3=(lds_cptr)shm; const lds_cptr kp0=shm3+LDS_K+hi*1024+r32*16; const lds_cptr vp0=shm3+LDS_V+((lane>>4)&1)*32+(lane&3)*8+(4*hi+((lane&15)>>2))*64;
  const int NT=(q0+QB)/KVBLK-t0;
  { const int np=(q0+QB)/256;
    for(int p=(t0>>2)+wid;p<np;p+=NW) glds16(c2g+p*256+lane*4,(unsigned)__builtin_amdgcn_readfirstlane(lds0+LDS_C2+p*1024)); }
  const __attribute__((address_space(3))) float* c2l=(const __attribute__((address_space(3))) float*)(shm3+LDS_C2)+t0*KVBLK+4*hi;
  DMA_K(0,0);DMA_V(0,0);DMA_K(1,SLOTB);
  bf16x8 qr[4];
  #pragma unroll
  for(int d0=0;d0<4;++d0)qr[d0]=*reinterpret_cast<const bf16x8*>(&Qw[(long)r32*DM+d0*16+hi*8]);
  float l_reg=0.f;f32x16 o[2];o[0]=f32x16{};o[1]=f32x16{};
  float base=c2g[q0+wid*QBLK+r32];
  const int qrel=wid*QBLK+r32;
  #define CMASK(P0,P1,t) do{int jb_=(t)-(NT-4); if(jb_>=0)cmask(P0,P1,jb_,qrel,hi);}while(0)
  bool resc=false;
  #define START(P0,P1) do{ const float rm=rowmax(P0,P1); resc=false; \
    { const float dl=rm; base=fsub_s(base,dl); \
      _Pragma("unroll") for(int r=0;r<16;++r){P0[r]=fsub_s(P0[r],dl);P1[r]=fsub_s(P1[r],dl);} } \
    _Pragma("unroll") for(int r=0;r<16;++r)P0[r]=__builtin_amdgcn_exp2f(P0[r]); }while(0)
  #define RESC() do{ if(resc){ asm volatile("s_waitcnt lgkmcnt(0)":::"memory"); \
      _Pragma("unroll") for(int d_=0;d_<2;++d_) _Pragma("unroll") for(int r=0;r<16;++r)o[d_][r]*=wsf[crow(r,hi)]; } }while(0)
  f32x16 pA0,pA1,pB0,pB1;
  #define BIASLD(P0,P1,tt) do{ _Pragma("unroll") for(int g_=0;g_<4;++g_){ const f32x4v x0_=*(const __attribute__((address_space(3))) f32x4v*)(c2l+(tt)*KVBLK+8*g_), x1_=*(const __attribute__((address_space(3))) f32x4v*)(c2l+(tt)*KVBLK+32+8*g_); \
      P0[4*g_]=x0_[0];P0[4*g_+1]=x0_[1];P0[4*g_+2]=x0_[2];P0[4*g_+3]=x0_[3]; P1[4*g_]=x1_[0];P1[4*g_+1]=x1_[1];P1[4*g_+2]=x1_[2];P1[4*g_+3]=x1_[3]; } }while(0)
  #define BIASFIX(P0,P1) do{ _Pragma("unroll") for(int r=0;r<16;++r){P0[r]=fsub_s(base,P0[r]);P1[r]=fsub_s(base,P1[r]);} }while(0)
  int sl_prev=0,sl_cur=0,sl_next=SLOTB;
  #define ROT() do{sl_prev=sl_cur;sl_cur=sl_next;sl_next=(sl_next==(NSLOT-1)*SLOTB)?0:sl_next+SLOTB;}while(0)
  DMA_K(2,2*SLOTB);
  WAIT_BAR(3);
  BIASLD(pA0,pA1,0); BIASFIX(pA0,pA1);
  qkt(pA0,pA1,Kbase,qr,r32,hi);asm volatile("s_nop 15\n\ts_nop 7":"+v"(pA0),"+v"(pA1));CMASK(pA0,pA1,0);
  START(pA0,pA1);
  _Pragma("unroll") for(int r=0;r<16;++r)pA1[r]=__builtin_amdgcn_exp2f(pA1[r]);
  BIASLD(pB0,pB1,1);
  WAIT_BAR(0);
  DMA_K(3,0);DMA_V(1,SLOTB);
  ROT();
  kload8(kf,kp0+sl_cur);
  WAIT_BAR(2);
  s16x4 vlo[8],vhi[8]; u32x4 pw0,pw1,pw2,pw3;
  #define PKW(P,B) cvtpk_s(P[B],P[B+1])
  #define PAF(k) __builtin_bit_cast(bf16x8,pw##k)
  #define VFR(i) (bf16x8){vlo[i][0],vlo[i][1],vlo[i][2],vlo[i][3],vhi[i][0],vhi[i][1],vhi[i][2],vhi[i][3]}
  #define PIN(x) asm volatile("":"+v"(x))
  #define MX3(a,b,c) __builtin_fmaxf(__builtin_fmaxf((a),(b)),(c))
  #define GAPA(MF,A0,A1,A2,A3,W0,W1,PW) do{ MF; sacc+=A0; sacc+=A1; sacc+=A2; sacc+=A3; PIN(sacc); W0; W1; PIN(PW); SBAR(); }while(0)
  #define EX(v) __builtin_amdgcn_exp2f(v)
  #define GAPB(MF,X,B) do{ MF; X[B]=EX(X[B]); X[B+1]=EX(X[B+1]); X[B+2]=EX(X[B+2]); X[B+3]=EX(X[B+3]); PIN(X); SBAR(); }while(0)
  #define VRD(i) do{ vlo[i]=vtr(vp_+(((i)>>2)*4096+((i)&3)*1024)); vhi[i]=vtr(vp_+(((i)>>2)*4096+((i)&3)*1024+512)); }while(0)
  #define KRD(G,j) do{ if(G){ kload2(kf,kp0+sl_next,j); SBAR(); } }while(0)
  #define STEP(C0,C1,P0,P1,t,GK,GV,GL) do{ SBAR(); \
    BIASFIX(C0,C1); SBAR(); \
    const lds_cptr vp_=vp0+sl_prev; \
    VRD(0); SBAR(); float sacc=(P0[0]+P0[1]); \
    GAPA(C0=__builtin_amdgcn_mfma_f32_32x32x16_bf16(kf[0],qr[0],C0,0,0,0), P0[2],P0[3],P0[4],P0[5],     pw0[0]=PKW(P0,0), pw0[1]=PKW(P0,2), pw0); \
    VRD(4); SBAR(); GAPA(C1=__builtin_amdgcn_mfma_f32_32x32x16_bf16(kf[1],qr[0],C1,0,0,0), P0[6],P0[7],P0[8],P0[9],     pw0[2]=PKW(P0,4), pw0[3]=PKW(P0,6), pw0); \
    VRD(1); SBAR(); GAPA(C0=__builtin_amdgcn_mfma_f32_32x32x16_bf16(kf[2],qr[1],C0,0,0,0),   P0[10],P0[11],P0[12],P0[13], pw1[0]=PKW(P0,8), pw1[1]=PKW(P0,10), pw1); \
    VRD(5); SBAR(); GAPA(C1=__builtin_amdgcn_mfma_f32_32x32x16_bf16(kf[3],qr[1],C1,0,0,0),   P0[14],P0[15],P1[0],P1[1],   pw1[2]=PKW(P0,12),pw1[3]=PKW(P0,14), pw1); \
    VRD(2); SBAR(); GAPA(C0=__builtin_amdgcn_mfma_f32_32x32x16_bf16(kf[4],qr[2],C0,0,0,0),   P1[2],P1[3],P1[4],P1[5],     pw2[0]=PKW(P1,0), pw2[1]=PKW(P1,2), pw2); \
    VRD(6); SBAR(); GAPA(C1=__builtin_amdgcn_mfma_f32_32x32x16_bf16(kf[5],qr[2],C1,0,0,0),   P1[6],P1[7],P1[8],P1[9],     pw2[2]=PKW(P1,4), pw2[3]=PKW(P1,6), pw2); \
    VRD(3); SBAR(); GAPA(C0=__builtin_amdgcn_mfma_f32_32x32x16_bf16(kf[6],qr[3],C0,0,0,0),   P1[10],P1[11],P1[12],P1[13], pw3[0]=PKW(P1,8), pw3[1]=PKW(P1,10), pw3); \
    VRD(7); SBAR(); GAPA(C1=__builtin_amdgcn_mfma_f32_32x32x16_bf16(kf[7],qr[3],C1,0,0,0),   P1[14],P1[15],0.f,0.f,       pw3[2]=PKW(P1,12),pw3[3]=PKW(P1,14), pw3); \
    l_reg+=sacc; \
    if(GL){BIASLD(P0,P1,(t)+1);} \
    if(GK){DMA_K((t)+3,sl_cur);} if(GV){DMA_V((t)+1,sl_next);} \
    CMASK(C0,C1,t); \
    { float a=MX3(C0[0],C0[1],C1[0]),b=MX3(C0[2],C0[3],C1[1]); a=MX3(a,C1[2],C1[3]); \
      _Pragma("unroll") for(int r=4;r<16;r+=4){a=MX3(a,C0[r],C0[r+1]);b=MX3(b,C0[r+2],C0[r+3]);a=MX3(a,C1[r],C1[r+1]);b=MX3(b,C1[r+2],C1[r+3]);} \
      float rm=__builtin_fmaxf(a,b); { auto rr=__builtin_amdgcn_permlane32_swap(__float_as_uint(rm),__float_as_uint(rm),false,false); rm=__builtin_fmaxf(__uint_as_float(rr[0]),__uint_as_float(rr[1])); } \
      resc=false; \
      if(__builtin_expect(__any(rm>(float)THRL),0)){ const float dl=__builtin_fmaxf(rm,0.f); base-=dl; \
        _Pragma("unroll") for(int r=0;r<16;++r){C0[r]-=dl;C1[r]-=dl;} \
        const float f=__builtin_amdgcn_exp2f(-dl); l_reg*=f; if(hi==0)wsf[r32]=f; resc=true; } } \
    SBAR(); \
    GAPB(o[0]=__builtin_amdgcn_mfma_f32_32x32x16_bf16(PAF(0),VFR(0),o[0],0,0,0), C0,0); \
    GAPB(o[1]=__builtin_amdgcn_mfma_f32_32x32x16_bf16(PAF(0),VFR(4),o[1],0,0,0), C0,4); \
    KRD(GL,0); GAPB(o[0]=__builtin_amdgcn_mfma_f32_32x32x16_bf16(PAF(1),VFR(1),o[0],0,0,0), C0,8); \
    KRD(GL,1); GAPB(o[1]=__builtin_amdgcn_mfma_f32_32x32x16_bf16(PAF(1),VFR(5),o[1],0,0,0), C0,12); \
    KRD(GL,2); GAPB(o[0]=__builtin_amdgcn_mfma_f32_32x32x16_bf16(PAF(2),VFR(2),o[0],0,0,0), C1,0); \
    KRD(GL,3); GAPB(o[1]=__builtin_amdgcn_mfma_f32_32x32x16_bf16(PAF(2),VFR(6),o[1],0,0,0), C1,4); \
    GAPB(o[0]=__builtin_amdgcn_mfma_f32_32x32x16_bf16(PAF(3),VFR(3),o[0],0,0,0), C1,8); \
    GAPB(o[1]=__builtin_amdgcn_mfma_f32_32x32x16_bf16(PAF(3),VFR(7),o[1],0,0,0), C1,12); \
    }while(0)
  int t=1;
  #undef CMASK
  #define CMASK(P0,P1,t) do{}while(0)
  for(;t+5<NT;t+=2){
    STEP(pB0,pB1,pA0,pA1,t,true,true,true);     WAIT_BAR(2); RESC(); ROT();
    STEP(pA0,pA1,pB0,pB1,t+1,true,true,true);   WAIT_BAR(2); RESC(); ROT();
  }
  #undef CMASK
  #define CMASK(P0,P1,t) do{int jb_=(t)-(NT-4); if(jb_>=0)cmask(P0,P1,jb_,qrel,hi);}while(0)
  #define ENDW(tt) do{ if((tt)+3<NT){WAIT_BAR(2);} else if((tt)+2<NT){WAIT_BAR(1);} else {WAIT_BAR(0);} }while(0)
  for(;t+1<NT;t+=2){
    STEP(pB0,pB1,pA0,pA1,t,(t+3<NT),(t+1<NT),(t+1<NT));       ENDW(t);   RESC(); ROT();
    STEP(pA0,pA1,pB0,pB1,t+1,(t+4<NT),(t+2<NT),(t+2<NT));     ENDW(t+1); RESC(); ROT();
  }
  STEP(pB0,pB1,pA0,pA1,NT-1,false,false,false); RESC();
  { float sacc=pB0[0]+pB0[1]; _Pragma("unroll") for(int r=2;r<16;++r)sacc+=pB0[r]; _Pragma("unroll") for(int r=0;r<16;++r)sacc+=pB1[r]; l_reg+=sacc;
    pw0=(u32x4){PKW(pB0,0),PKW(pB0,2),PKW(pB0,4),PKW(pB0,6)};pw1=(u32x4){PKW(pB0,8),PKW(pB0,10),PKW(pB0,12),PKW(pB0,14)};pw2=(u32x4){PKW(pB1,0),PKW(pB1,2),PKW(pB1,4),PKW(pB1,6)};pw3=(u32x4){PKW(pB1,8),PKW(pB1,10),PKW(pB1,12),PKW(pB1,14)};
    SBAR(); pv(o,vb0+sl_cur,PAF(0),PAF(1),PAF(2),PAF(3)); }
  #undef PKW
  #undef PAF
  #undef VFR
  #undef PIN
  #undef MX3
  #undef GAPA
  #undef GAPB
  #undef EX
  #undef VRD
  #undef KRD
  #undef STEP
  #undef ENDW
  {auto rr=__builtin_amdgcn_permlane32_swap(__float_as_uint(l_reg),__float_as_uint(l_reg),false,false);l_reg=__uint_as_float(rr[0])+__uint_as_float(rr[1]);}
  if(hi==0)wsf[32+r32]=l_reg;asm volatile("s_waitcnt lgkmcnt(0)":::"memory");
  float rli[16];
  #pragma unroll
  for(int r=0;r<16;++r)rli[r]=__builtin_amdgcn_rcpf(wsf[32+crow(r,hi)]);
  bf16*Ow=O+(rowbase+q0+wid*QBLK)*OP+h*D; const bf16*Gw=Z+(rowbase+q0+wid*QBLK)*DM+1536+h*D;
  { bf16*stg=(bf16*)(shm+LDS_OST)+wid*2048;
    #pragma unroll
    for(int r=0;r<16;++r){const int orow=crow(r,hi);
      #pragma unroll
      for(int d0=0;d0<2;++d0)stg[orow*64+d0*32+r32]=(bf16)f2bf(o[d0][r]*rli[r]);}
    asm volatile("s_waitcnt lgkmcnt(0)":::"memory");
    #pragma unroll
    for(int i=0;i<4;++i){const int row=i*8+(lane>>3),ch=lane&7; const u32x4 v=*(const u32x4*)(stg+row*64+ch*8), g=*(const u32x4*)(Gw+(long)row*DM+ch*8);
      const unsigned vw[4]={v.x,v.y,v.z,v.w},gw[4]={g.x,g.y,g.z,g.w}; unsigned ow[4];
      #pragma unroll
      for(int j=0;j<4;++j){ const float a0=bflo(vw[j])/(1.0f+__expf(-bflo(gw[j]))), a1=bfhi(vw[j])/(1.0f+__expf(-bfhi(gw[j]))); ow[j]=cvtpk_s(a0,a1); }
      ATTN_STORE16(Ow+(long)row*OP+ch*8,((u32x4){ow[0],ow[1],ow[2],ow[3]}));} }
  asm volatile("s_waitcnt lgkmcnt(0)\n\ts_barrier":::"memory");
  #undef DMA_K
  #undef DMA_V
  #undef CMASK
  #undef START
  #undef RESC
  #undef ROT
}
constexpr int ATTN_LDS_BYTES=LDS_BYTES;
#undef SBAR
#undef WAIT_BAR
}
constexpr int CW_QATT = 128;
constexpr int MISC_TAB = 64, MISC_Q = 4096, MISC_PFX = 4160;

__device__ __forceinline__ int attn_t0(KPR P, const float* c2, int q0, int lane) {
    float gq = fabsf(P.q_norm[lane]), gk = fabsf(P.k_norm[lane]);
#pragma unroll
    for (int o = 1; o < 64; o <<= 1) { gq = fmaxf(gq, __shfl_xor(gq, o)); gk = fmaxf(gk, __shfl_xor(gk, o)); }
    const float thr = c2[q0] + (2.0f * 8.0f * LOG2E * gq * gk + 40.0f);
    const int nfull = q0 / 64; int t0 = 0;
    for (int tb = 0; tb < nfull; tb += 64) { const int tt = tb + lane; const bool sk = (tt < nfull) && (c2[tt * 64 + 63] > thr); const unsigned long long bm = __ballot(sk); t0 += __popcll(bm); if (bm != ~0ull) break; }
    return __builtin_amdgcn_readfirstlane(t0) & ~1;
}
__device__ __forceinline__ void combine_row(KPR P, const LAS int* tab, int row, int lane) {
    const int* route = (const int*)(P.ws + WS_ROUTE); const bf16_t* YP = (const bf16_t*)(P.ws + WS_YP); float* X = (float*)(P.ws + WS_X1);
    f32x4 v[4]; const f32x4* xr = (const f32x4*)(X + (size_t)row * DM) + lane;
#pragma unroll
    for (int j = 0; j < 4; ++j) v[j] = xr[64 * j];
#pragma unroll
    for (int k = 0; k < 4; ++k) { const int ex = route[(size_t)row * 12 + k], rank = route[(size_t)row * 12 + 4 + k]; const size_t pos = (size_t)tab[pg8::T_BLKSTART + ex] * 256 + rank;
        const u32x2* yr = (const u32x2*)(YP + pos * DM) + lane;
#pragma unroll
        for (int j = 0; j < 4; ++j) { const u32x2 y = yr[64 * j]; v[j][0] += bflo(y.x); v[j][1] += bfhi(y.x); v[j][2] += bflo(y.y); v[j][3] += bfhi(y.y); } }
    f32x4* xo = (f32x4*)(X + (size_t)row * DM) + lane; float s = 0.f;
#pragma unroll
    for (int j = 0; j < 4; ++j) { xo[64 * j] = v[j]; s += (v[j][0] * v[j][0] + v[j][1] * v[j][1]) + (v[j][2] * v[j][2] + v[j][3] * v[j][3]); }
    const float rstd = rsqrtf(wave_sum(s) * (1.f / DM) + 1e-6f);
#pragma unroll
    for (int j = 0; j < 4; ++j) v[j] = v[j] * rstd * ((const f32x4*)P.ple_norm)[64 * j + lane];
    store_row_bf16((bf16_t*)(P.ws + WS_XN) + (size_t)row * DM, lane, v);
}

constexpr int NPHASE = 13;
__global__ void __launch_bounds__(NTHREADS, 2) mega_fwd(Params Pkarg_unused) {
    extern __shared__ __attribute__((aligned(16))) unsigned char smem[];
    LAS unsigned char* lds = (LAS unsigned char*)smem;
    const int tid = threadIdx.x, lane = tid & 63, wave = __builtin_amdgcn_readfirstlane(tid >> 6);
    const int G = gridDim.x, blk = blockIdx.x;
#define P (*kpp)
#ifndef MK_REP
#define MK_REP -1
#endif
#define PHASE_BEGIN(k) if (IN(k)) for (int rep_ = 0; rep_ < ((k) == MK_REP ? 2 : 1); ++rep_) { const __attribute__((address_space(4))) Params* kpp = kp_fresh();
#define PHASE_END(k) } if (BOTH(k)) xcd_barrier(bar);
#define IN(k) (ph_lo <= (k) && (k) < ph_hi)
#define BOTH(k) (IN(k) && IN((k) + 1))
    const __attribute__((address_space(4))) Params* kpp = kp_fresh();
    unsigned* ctl = (unsigned*)(P.ws + WS_CTL);
    volatile LAS unsigned* MISC = (volatile LAS unsigned*)(lds + MISC_OFF);
    LAS int* tab = (LAS int*)(lds + MISC_OFF + MISC_TAB);
    if (tid < 16) MISC[tid] = 0u;
    __syncthreads();
    XcdBarrier bar = xcd_barrier_post(ctl + CW_BAR, MISC);
    unsigned char* const wsb = P.ws;
    const int ph_lo = P.ph_lo, ph_hi = P.ph_hi;

    PHASE_BEGIN(0)
        phase_prep_weights(P, lds, blk * NWAVES + wave, G * NWAVES, wave, lane);
        phase_cvt_p(P, blk * NTHREADS + tid, G * NTHREADS);
        __syncthreads();
        LAS float* wff = (LAS float*)lds; LAS float* lf = (LAS float*)(lds + 32768);
        load_wff(P, wff, tid, NTHREADS); __syncthreads();
        for (int i = 0; i < 16; ++i) { const int rl = wave * 16 + i; norm1_row(P, blk * 128 + rl, lane, wff, lf + rl * 8); }
        __syncthreads();
        if (tid < 8) { float run = 0.f; float* cloc = (float*)(P.ws + WS_LOGF) + (size_t)blk * 128 * 8 + tid;
            for (int r = 0; r < 128; ++r) { run += lf[r * 8 + tid]; cloc[r * 8] = run; }
            ((float*)(P.ws + WS_CTOT))[blk * 8 + tid] = run; }
        if (blk == G - 1) rt::build_w(P, tid);
    PHASE_END(0)

    PHASE_BEGIN(1)
        {
            LAS float* pfx = (LAS float*)(lds + MISC_OFF + MISC_PFX);
            if (tid < 64) { const float* ct = (const float*)(wsb + WS_CTOT); const int j = (blk & ~63) + tid; float v8[8];
#pragma unroll
                for (int h = 0; h < 8; ++h) v8[h] = (j < blk) ? ct[j * 8 + h] : 0.f;
#pragma unroll
                for (int h = 0; h < 8; ++h) { const float s = wave_sum(v8[h]); if (tid == 0) pfx[h] = s; } }
            __syncthreads();
            const float* cloc = (const float*)(wsb + WS_LOGF) + (size_t)blk * 128 * 8; float* c2 = (float*)(P.ws + WS_C2);
            for (int i = tid; i < 1024; i += NTHREADS) { const int r = i >> 3, h = i & 7; const int row = blk * 128 + r, b = row >> 13, t = row & (SEQ - 1);
                c2[((size_t)(b * 8 + h)) * SEQ + t] = (cloc[i] + pfx[h]) * LOG2E; }
            __syncthreads();
        }
        {
            pg8::DenseOrder S{(const bf16_t*)(wsb + WS_XN), (const bf16_t*)(wsb + WS_WIN), 1024, NTOK / 256, ZW / 256, G, blk};
            pg8::EpiIn E{(bf16_t*)(P.ws + WS_Z), P.q_norm, P.k_norm};
            pg8::gemm_phase<pg8::EpiIn, pg8::DenseOrder, true>(lds, 1024, S, E);
        }
        {
            pg8::DenseOrder S{(const bf16_t*)((unsigned char*)P.out + DO_PB), (const bf16_t*)(wsb + WS_WPP), PLE, NTOK / 256, DM / 256, G / 2, blk >= G / 2 ? blk - G / 2 : (1 << 20)};
            pg8::EpiBf16 E{(bf16_t*)((unsigned char*)P.out + DO_PJ), DM};
            pg8::gemm_phase<pg8::EpiBf16, pg8::DenseOrder, true>(lds, PLE, S, E);
        }
    PHASE_END(1)

    PHASE_BEGIN(2)
        for (int task = wave * G + blk; task < NTOK / 32; task += NWAVES * G) rk::lora_task(P, task, lane);
    PHASE_END(2)

    PHASE_BEGIN(3)
        for (int task = blk; task < NB * NH * rk::NCHUNK; task += G) rk::pass1_chunk(P, lds, task >> 7, task & 127, tid);
    PHASE_END(3)

    PHASE_BEGIN(4)
        if (blk < NB * NH) rk::pass2_seq(P, lds, blk, tid);
        for (;;) {
            __syncthreads();
            if (tid == 0) MISC[MISC_Q / 4] = __hip_atomic_fetch_add(ctl + CW_QATT + 64 * rep_, 1u, RLX_AGENT);
            __syncthreads();
            const int q = (int)MISC[MISC_Q / 4];
            if (q >= 1024) break;
            { const int bh = q & 31, qb = 31 - (q >> 5); const float* c2 = (const float*)(wsb + WS_C2) + (size_t)bh * SEQ;
              const int t0 = attn_t0(P, c2, qb * 256, lane);
              attn_body::attn_unit<8>(bh >> 3, bh & 7, qb, t0, (const bf16_t*)(wsb + WS_Z), c2, (bf16_t*)(P.ws + WS_AO), (char*)smem); }
        }
    PHASE_END(4)

    PHASE_BEGIN(5)
        for (int task = blk; task < NB * NH * rk::NCHUNK; task += G) rk::pass3_chunk(P, lds, task >> 7, task & 127, tid);
    PHASE_END(5)

    PHASE_BEGIN(6)
        pg8::DenseOrder S{(const bf16_t*)(wsb + WS_AO), (const bf16_t*)(wsb + WS_WOUT), 1024, NTOK / 256, DM / 256, G, blk};
        pg8::EpiOut E{P.x, (float*)(P.ws + WS_X1)};
        pg8::gemm_phase<pg8::EpiOut, pg8::DenseOrder, true>(lds, 1024, S, E);
    PHASE_END(6)

    PHASE_BEGIN(7)
        rt::copy_w(P, lds, tid);
        if (blk == 0 && tid < 256) ((unsigned*)(P.ws + WS_XN + (size_t)NTOK * DM))[tid] = 0u;
        __syncthreads();
        for (int task = wave * G + blk; task < NTOK / 32; task += NWAVES * G) rt::route_task(P, lds, task, lane);
    PHASE_END(7)

    PHASE_BEGIN(8)
        const int nblk = pg8::moe_tables(tab, (const unsigned*)(wsb + WS_CTL) + CW_CNT);
        pg8::MoeOrder S{wsb + WS_XN, wsb + WS_WGU, (const int*)(wsb + WS_TOKSLOT), (const float*)(wsb + WS_GATESLOT), tab, nblk, 8, G, blk, true};
        pg8::EpiGu E{P.ws + WS_ACT, P.b_gu};
        pg8::gemm_phase<pg8::EpiGu, pg8::MoeOrder, true, true>(lds, 1024, S, E);
    PHASE_END(8)
    PHASE_BEGIN(9)
        const int nblk = pg8::moe_tables(tab, (const unsigned*)(wsb + WS_CTL) + CW_CNT);
        pg8::MoeOrder S{wsb + WS_ACT, wsb + WS_WDN, (const int*)(wsb + WS_TOKSLOT), (const float*)(wsb + WS_GATESLOT), tab, nblk, 4, G, blk, false};
        pg8::EpiDn E{(bf16_t*)(P.ws + WS_YP), P.b_down, (const float*)(wsb + WS_GATESLOT), tab};
        pg8::gemm_phase<pg8::EpiDn, pg8::MoeOrder, true, true>(lds, 1024, S, E);
    PHASE_END(9)
    PHASE_BEGIN(10)
        (void)pg8::moe_tables(tab, (const unsigned*)(wsb + WS_CTL) + CW_CNT);
        for (int row = blk * NWAVES + wave; row < NTOK; row += G * NWAVES) combine_row(P, tab, row, lane);
    PHASE_END(10)
    PHASE_BEGIN(11)
        pg8::DenseOrder S{(const bf16_t*)(wsb + WS_XN), (const bf16_t*)(wsb + WS_WPG), 1024, NTOK / 256, DM / 256, G, blk};
        pg8::EpiPg E{(float*)(P.ws + WS_X1), (const bf16_t*)((unsigned char*)P.out + DO_PJ)};
        pg8::gemm_phase<pg8::EpiPg, pg8::DenseOrder, true>(lds, 1024, S, E);
    PHASE_END(11)
    PHASE_BEGIN(12)
        const bool dead = __hip_atomic_load(ctl + CW_BAR + XB_TMO, RLX_AGENT) != 0u;
        for (int row = blk * NWAVES + wave; row < NTOK; row += G * NWAVES) final_row(P, row, lane, dead);
    PHASE_END(12)
}
#undef P
extern "C" void kernel_launch(void* const* d_in, const int* in_sizes, int n_in, void* d_out, int out_size, void* d_ws, size_t ws_size, hipStream_t stream) {
    static int ok = 0;
    if (ok == 0) {
        if (n_in != 30 || in_sizes[0] != NTOK * DM || out_size != NTOK * DM || ws_size < WS_END) { fprintf(stderr, "kernel_launch: unexpected shapes (n_in %d, ws %zu)\n", n_in, ws_size); ok = -1; return; }
        if (hipFuncSetAttribute((const void*)mega_fwd, hipFuncAttributeMaxDynamicSharedMemorySize, LDS_BYTES) != hipSuccess) { fprintf(stderr, "kernel_launch: hipFuncSetAttribute failed\n"); ok = -1; return; }
        int dev = 0, cus = 0, per_cu = 0;
        if (hipGetDevice(&dev) != hipSuccess || hipDeviceGetAttribute(&cus, hipDeviceAttributeMultiprocessorCount, dev) != hipSuccess) { ok = -1; return; }
        if (hipOccupancyMaxActiveBlocksPerMultiprocessor(&per_cu, (const void*)mega_fwd, NTHREADS, LDS_BYTES) != hipSuccess || per_cu < 1) { fprintf(stderr, "kernel_launch: occupancy query says %d\n", per_cu); }
        (void)hipGetLastError();
        if (cus != 256) { fprintf(stderr, "kernel_launch: built for 256 CUs, device has %d\n", cus); ok = -1; return; }
        ok = 1;
    }
    if (ok < 0) return;
    Params P{};
    const float** pp = (const float**)&P;
    for (int i = 0; i < 30; ++i) pp[i] = (const float*)d_in[i];
    P.out = (float*)d_out; P.ws = (unsigned char*)d_ws;
    if (hipMemsetAsync((char*)d_ws + WS_CTL, 0, CTL_BYTES, stream) != hipSuccess) return;
#ifndef MK_CUTS
#define MK_CUTS 0
#endif
    if (MK_CUTS == 0) { P.ph_lo = 0; P.ph_hi = NPHASE; hipLaunchKernelGGL(mega_fwd, dim3(256), dim3(NTHREADS), LDS_BYTES, stream, P); }
    else for (int k = 0; k < NPHASE; ++k) { P.ph_lo = k; P.ph_hi = k + 1;
        hipLaunchKernelGGL(mega_fwd, dim3(256), dim3(NTHREADS), LDS_BYTES, stream, P); }
}
```

```cpp
#include <hip/hip_runtime.h>
#include <cstdio>
#include <cstdint>

#define LAS __attribute__((address_space(3)))
#define GAS __attribute__((address_space(1)))
typedef unsigned short bf16_t;
typedef short bf16x8 __attribute__((ext_vector_type(8)));
typedef float f32x2 __attribute__((ext_vector_type(2)));
typedef float f32x4 __attribute__((ext_vector_type(4)));
typedef float f32x16 __attribute__((ext_vector_type(16)));
typedef unsigned u32x2 __attribute__((ext_vector_type(2)));
typedef unsigned u32x4 __attribute__((ext_vector_type(4)));

constexpr int NB = 4, SEQ = 8192, NTOK = NB * SEQ, DM = 1024;
constexpr int NH = 8, HD = 64;
constexpr int INW = 3848;
constexpr int ZW = 3840;
constexpr int ZQ = 0, ZK = 512, ZV = 1024, ZOG = 1536, ZR = 2048;
constexpr int RW_R = 0, RW_K = 512, RW_V = 1024, RW_W = 1536, RW_A = 1600, RW_G = 1664, RWIN = 1792;
constexpr int NE = 32, TOPK = 4, EFF = 1024;
constexpr int MAXBLK = (NTOK * TOPK) / 256 + NE;
constexpr int PLE = 256;
constexpr float LOG2E = 1.4426950408889634f;
constexpr float QSCALE = 0.125f * LOG2E;

constexpr size_t MiB = 1u << 20;
constexpr size_t WS_CTL = 0, CTL_BYTES = 1 * MiB;
constexpr size_t WS_C2 = 1 * MiB;
constexpr size_t WS_LOGF = 2 * MiB;
constexpr size_t WS_ROUTE = 3 * MiB;
constexpr size_t WS_TOKSLOT = 5 * MiB;
constexpr size_t WS_GATESLOT = 9 * MiB;
constexpr size_t WS_CTOT = 13 * MiB;
constexpr size_t WS_WIN = 16 * MiB;
constexpr size_t WS_WOUT = 24 * MiB;
constexpr size_t WS_WPG = 26 * MiB;
constexpr size_t WS_WPP = 28 * MiB;
constexpr size_t WS_WGU = 32 * MiB;
constexpr size_t WS_WDN = 160 * MiB;
constexpr size_t WS_XN = 224 * MiB;
constexpr size_t WS_X1 = 290 * MiB;
constexpr size_t WS_Z = 418 * MiB;
constexpr size_t WS_AO = 658 * MiB;
constexpr size_t WS_ACT = 418 * MiB;
constexpr size_t WS_RW = 722 * MiB;
constexpr size_t WS_RR = WS_RW, WS_RK = WS_RW + 32 * MiB, WS_RV = WS_RW + 64 * MiB, WS_RG = WS_RW + 96 * MiB;
constexpr size_t WS_RLW = WS_RW + 128 * MiB;
constexpr size_t WS_RKK = WS_RW + 160 * MiB, WS_RKA = WS_RW + 192 * MiB;
constexpr size_t WS_YP = 722 * MiB;
constexpr size_t WS_END = 994 * MiB;
static_assert(WS_ACT + (size_t)MAXBLK * 256 * 1024 * 2 <= WS_RW && WS_YP + (size_t)MAXBLK * 256 * 1024 * 2 <= WS_END, "ws map");
constexpr size_t DO_PJ = 0, DO_PB = 64 * MiB;
constexpr int CW_TMO = 0, CW_CNT = 64  , CW_BAR = 4096;

struct Params {
    const float *x, *p, *mix_norm, *w_in, *f_bias, *q_norm, *k_norm, *mu, *w0, *w2, *a0, *a2, *g2, *k_k, *k_a, *r_k, *ln_w, *ln_b, *w_out, *moe_norm, *w_router, *b_router, *w_gu, *b_gu, *w_down,
        *b_down, *ple_norm, *w_pg, *w_pp, *final_norm;
    float* out; unsigned char* ws; int ph_lo, ph_hi;
};

typedef const __attribute__((address_space(4))) Params& KPR;
__device__ __forceinline__ const __attribute__((address_space(4))) Params* kp_fresh() {
    unsigned long long p = (unsigned long long)__builtin_amdgcn_kernarg_segment_ptr(); asm volatile("" : "+s"(p)); return (const __attribute__((address_space(4))) Params*)p; }

typedef __bf16 bf16x2_hw __attribute__((ext_vector_type(2)));
__device__ __forceinline__ unsigned pk2(float lo, float hi) { const f32x2 v = {lo, hi}; return __builtin_bit_cast(unsigned, __builtin_convertvector(v, bf16x2_hw)); }
__device__ __forceinline__ unsigned f2bf(float f) { return pk2(f, f) & 0xffffu; }
__device__ __forceinline__ float bf2f(unsigned h) { return __builtin_bit_cast(float, h << 16); }
__device__ __forceinline__ float bflo(unsigned w) { return __builtin_bit_cast(float, w << 16); }
__device__ __forceinline__ float bfhi(unsigned w) { return __builtin_bit_cast(float, w & 0xffff0000u); }
__device__ __forceinline__ unsigned cvt_pk_bf16(float lo, float hi) { unsigned r; asm volatile("v_cvt_pk_bf16_f32 %0, %1, %2" : "=v"(r) : "v"(lo), "v"(hi)); return r; }
__device__ __forceinline__ unsigned pk4_fp8(float a, float b, float c, float d) { int w = 0; w = __builtin_amdgcn_cvt_pk_fp8_f32(a, b, w, false); w = __builtin_amdgcn_cvt_pk_fp8_f32(c, d, w, true); return (unsigned)w; }
__device__ __forceinline__ float wave_sum(float v) {
#pragma unroll
    for (int o = 1; o < 64; o <<= 1) v += __shfl_xor(v, o);
    return v;
}
__device__ __forceinline__ float sigmoidf_(float x) { return __builtin_amdgcn_rcpf(1.0f + __expf(-x)); }
__device__ __forceinline__ float logsigmoidf_(float x) { return fminf(x, 0.f) - log1pf(expf(-fabsf(x))); }
namespace pg8 {
constexpr int BM = 256, BK = 64, HALF = 128, HTB = HALF * BK * 2, STAGE_BYTES = 8 * HTB, NXCD = 8, WGM = 8;
__host__ __device__ __forceinline__ int lds_byte(int r, int c) { const int st = (r >> 4) * 2 + (c >> 5), rr = r & 15, cc = c & 31, ob = rr * 64 + cc * 2; return st * 1024 + (ob ^ (((ob >> 9) & 1) << 5)); }
__host__ __device__ __forceinline__ void stage_rc(int b, int& R, int& C) { const int st = b / 1024, sb = b % 1024, swz = sb ^ (((sb >> 9) & 1) << 5); R = (st >> 1) * 16 + swz / 64; C = (st & 1) * 32 + (swz % 64) / 2; }
__host__ __device__ __forceinline__ int perm32(int rho) { const int n = rho >> 4, i = rho & 15; return 8 * (i >> 2) + 4 * n + (i & 3); }

struct Unit { int pm, pn, e, lb, sl; };

__device__ __forceinline__ bool tile_order(int i, int G, int c, int nM, int nN, int& pm, int& pn) {
    const int nwg = nM * nN; const long L = (long)i * G + c; if (L >= nwg) return false;
    int wgid = (int)L; { const int q = nwg / NXCD, r = nwg % NXCD, xcd = wgid % NXCD, off = wgid / NXCD; wgid = (xcd < r ? xcd * (q + 1) : r * (q + 1) + (xcd - r) * q) + off; }
    const int nig = WGM * nN, gid = wgid / nig, fm = gid * WGM, gsz = (nM - fm) < WGM ? (nM - fm) : WGM;
    pm = fm + ((wgid % nig) % gsz); pn = (wgid % nig) / gsz; return true;
}
struct DenseOrder {
    const void* A; const void* Bt; int K  , nM, nN, G, c;
    __device__ __forceinline__ bool next(int i, Unit& u) const { u.e = 0; u.lb = 0; return tile_order(i, G, c, nM, nN, u.pm, u.pn); }
    __device__ __forceinline__ const char* a_base(const Unit& u) const { return (const char*)A + (size_t)u.pm * BM * K * 2; }
    __device__ __forceinline__ const char* b_base(const Unit& u) const { return (const char*)Bt + (size_t)u.pn * BM * K * 2; }
    __device__ __forceinline__ void prefetch(const Unit&, int, int, int) const {}
    __device__ __forceinline__ void a_off(const Unit&, const int (&R)[2], const int (&C)[2], unsigned (&off)[2][2]) const {
#pragma unroll
        for (int h = 0; h < 2; ++h)
#pragma unroll
            for (int i = 0; i < 2; ++i) off[h][i] = (unsigned)((R[i] + HALF * h) * K + C[i]) * 2u;
    }
};

typedef int v8i32 __attribute__((ext_vector_type(8)));
typedef int i32x4 __attribute__((ext_vector_type(4)));
template <class Epi, class Sched, bool ALIGN_EPI, bool FP8 = false>
__device__ __forceinline__ void gemm_phase(LAS unsigned char* lds, const int K, const Sched& S, const Epi& E) {
    int tid_ = threadIdx.x; asm volatile("" : "+v"(tid_));
    const int tid = tid_, wid = __builtin_amdgcn_readfirstlane(tid >> 6), lane = tid & 63, wr = wid >> 2, wc = wid & 3, fr = lane & 15, fq = lane >> 4;
    const int RB = FP8 ? K : 2 * K;
    const int nt = RB / (BK * 2);
    int sR[2], sC[2]; unsigned voffB[2];
#pragma unroll
    for (int i = 0; i < 2; ++i) { int R, C; stage_rc(tid * 16 + i * 8192, R, C); const int Rb = Epi::PERM ? ((R & ~31) + perm32(R & 31)) : R; sR[i] = R; sC[i] = C; voffB[i] = (unsigned)(Rb * RB + C * 2); }
    const size_t kstep = (size_t)(BK * 2);
    const size_t hstep = (size_t)HALF * RB;
    const unsigned ldsw = (unsigned)wid * 1024u;
    const int aoff0 = FP8 ? lds_byte(wr * 64 + fr, fq * 16) : lds_byte(wr * 64 + fr, fq * 8), aoff1 = FP8 ? lds_byte(wr * 64 + fr, fq * 16 + 8) : aoff0 + 1024;
    const int boff0 = FP8 ? lds_byte(wc * 32 + fr, fq * 16) : lds_byte(wc * 32 + fr, fq * 8), boff1 = FP8 ? lds_byte(wc * 32 + fr, fq * 16 + 8) : boff0 + 1024;
#define PG8_SA(b, h) (((b) * 2 + (h)) * HTB)
#define PG8_SB(b, h) ((4 + (b) * 2 + (h)) * HTB)
#define PG8_STAGE(bufoff, gbase, voff) do { _Pragma("unroll") for (int _i = 0; _i < 2; ++_i) \
        __builtin_amdgcn_global_load_lds((const unsigned*)((const char*)(gbase) + (voff)[_i]), (LAS unsigned*)(lds + (bufoff) + ldsw + _i * 8192), 16, 0, 0); } while (0)
#define PG8_CAT(p0, p1) __builtin_shufflevector((p0), (p1), 0, 1, 2, 3, 4, 5, 6, 7)
#define PG8_LDA(dst, b, h) do { _Pragma("unroll") for (int m = 0; m < 4; ++m) dst[m] = PG8_CAT(*(const LAS i32x4*)(lds + PG8_SA(b, h) + aoff0 + m * 2048), *(const LAS i32x4*)(lds + PG8_SA(b, h) + aoff1 + m * 2048)); } while (0)
#define PG8_LDB(dst, b, h) do { _Pragma("unroll") for (int n = 0; n < 2; ++n) dst[n] = PG8_CAT(*(const LAS i32x4*)(lds + PG8_SB(b, h) + boff0 + n * 2048), *(const LAS i32x4*)(lds + PG8_SB(b, h) + boff1 + n * 2048)); } while (0)
#define PG8_LO(x) __builtin_bit_cast(bf16x8, __builtin_shufflevector((x), (x), 0, 1, 2, 3))
#define PG8_HI(x) __builtin_bit_cast(bf16x8, __builtin_shufflevector((x), (x), 4, 5, 6, 7))
#define PG8_MMA(ai, bj, At, Bt) do { __builtin_amdgcn_s_setprio(1); \
        if constexpr (FP8) { _Pragma("unroll") for (int m = 0; m < 4; ++m) _Pragma("unroll") for (int n = 0; n < 2; ++n) \
            asm volatile("v_mfma_scale_f32_16x16x128_f8f6f4 %0, %1, %2, %0, %3, %4 op_sel_hi:[0,0,0]" : "+v"(acc[ai][bj][m][n]) : "v"(Bt[n]), "v"(At[m]), "v"(sc_w), "v"(sc_x)); } \
        else { _Pragma("unroll") for (int m = 0; m < 4; ++m) _Pragma("unroll") for (int n = 0; n < 2; ++n) { \
            acc[ai][bj][m][n] = __builtin_amdgcn_mfma_f32_16x16x32_bf16(PG8_LO(Bt[n]), PG8_LO(At[m]), acc[ai][bj][m][n], 0, 0, 0); } \
            _Pragma("unroll") for (int m = 0; m < 4; ++m) _Pragma("unroll") for (int n = 0; n < 2; ++n) { \
            acc[ai][bj][m][n] = __builtin_amdgcn_mfma_f32_16x16x32_bf16(PG8_HI(Bt[n]), PG8_HI(At[m]), acc[ai][bj][m][n], 0, 0, 0); } } \
        __builtin_amdgcn_s_setprio(0); } while (0)
#define PG8_WAIT_V(n) asm volatile("s_waitcnt vmcnt(" #n ")" ::: "memory")
#define PG8_WAIT_L(n) asm volatile("s_waitcnt lgkmcnt(" #n ")" ::: "memory")
#define PG8_BAR __builtin_amdgcn_s_barrier()
#define PG8_SCHED __builtin_amdgcn_sched_barrier(0)
    Unit cur, nxt; int ui = 0;
    if (!S.next(0, cur)) return;
    f32x4 acc[2][2][4][2];
#pragma unroll
    for (int a = 0; a < 2; ++a)
#pragma unroll
        for (int b = 0; b < 2; ++b)
#pragma unroll
            for (int m = 0; m < 4; ++m)
#pragma unroll
                for (int n = 0; n < 2; ++n) acc[a][b][m][n] = (f32x4){0.f, 0.f, 0.f, 0.f};
    const int sc_w = 121, sc_x = 127;
    v8i32 At[4], B0[2], B1[2];
    unsigned offC[2][2], offN[2][2];
    cur.sl = 0; S.prefetch(cur, 0, wid, lane); PG8_WAIT_V(0); PG8_BAR;
    S.a_off(cur, sR, sC, offC);
    const char* cA = S.a_base(cur); const char* cB = S.b_base(cur);
    PG8_STAGE(PG8_SB(0, 0), cB, voffB); PG8_STAGE(PG8_SB(0, 1), cB + hstep, voffB); PG8_STAGE(PG8_SA(0, 0), cA, offC[0]); PG8_STAGE(PG8_SA(0, 1), cA, offC[1]);
    if (wr == 1) PG8_BAR;
    PG8_WAIT_V(2); PG8_BAR;
    PG8_STAGE(PG8_SB(1, 0), cB + kstep, voffB); PG8_STAGE(PG8_SA(1, 0), cA + kstep, offC[0]); PG8_STAGE(PG8_SB(1, 1), cB + hstep + kstep, voffB);
    PG8_WAIT_V(6); PG8_BAR;
    for (;;) {
        const bool has_next = S.next(ui + 1, nxt);
        const char* nA = cA; const char* nB = cB;
        nxt.sl = cur.sl == 2 ? 0 : cur.sl + 1;
        if (has_next) { nA = S.a_base(nxt); nB = S.b_base(nxt); S.prefetch(nxt, nxt.sl, wid, lane); }
#pragma unroll
        for (int h = 0; h < 2; ++h)
#pragma unroll
            for (int i = 0; i < 2; ++i) offN[h][i] = offC[h][i];
#pragma nounroll
        for (int t = 0; t < nt; t += 2) {
            const bool last = (t == nt - 2);
            if (last && has_next) S.a_off(nxt, sR, sC, offN);
            const char* a1 = cA + (size_t)(t + 1) * kstep;
            const char* a2 = last ? nA : cA + (size_t)(t + 2) * kstep; const char* b2 = last ? nB : cB + (size_t)(t + 2) * kstep;
            const char* a3 = a2 + kstep; const char* b3 = b2 + kstep;
            unsigned o2[2][2];
#pragma unroll
            for (int h = 0; h < 2; ++h)
#pragma unroll
                for (int i = 0; i < 2; ++i) o2[h][i] = last ? offN[h][i] : offC[h][i];
            PG8_LDB(B0, 0, 0); PG8_LDB(B1, 0, 1); PG8_SCHED; PG8_LDA(At, 0, 0); PG8_STAGE(PG8_SA(1, 1), a1, offC[1]);
            PG8_WAIT_V(8); PG8_WAIT_L(0); PG8_BAR; PG8_MMA(0, 0, At, B0); PG8_MMA(0, 1, At, B1); PG8_BAR; PG8_SCHED;
            PG8_LDA(At, 0, 1); PG8_STAGE(PG8_SB(0, 0), b2, voffB); PG8_STAGE(PG8_SB(0, 1), b2 + hstep, voffB); PG8_STAGE(PG8_SA(0, 0), a2, o2[0]);
            PG8_WAIT_V(8); PG8_WAIT_L(0); PG8_BAR; PG8_MMA(1, 0, At, B0); PG8_MMA(1, 1, At, B1); PG8_BAR; PG8_SCHED;
            PG8_LDB(B0, 1, 0); PG8_LDB(B1, 1, 1); PG8_SCHED; PG8_LDA(At, 1, 0); PG8_STAGE(PG8_SA(0, 1), a2, o2[1]);
            PG8_WAIT_V(8); PG8_WAIT_L(0); PG8_BAR; PG8_MMA(0, 0, At, B0); PG8_MMA(0, 1, At, B1); PG8_BAR; PG8_SCHED;
            PG8_LDA(At, 1, 1); PG8_STAGE(PG8_SB(1, 0), b3, voffB); PG8_STAGE(PG8_SB(1, 1), b3 + hstep, voffB); PG8_STAGE(PG8_SA(1, 0), a3, o2[0]);
            PG8_WAIT_V(8); PG8_WAIT_L(0); PG8_BAR; PG8_MMA(1, 0, At, B0); PG8_MMA(1, 1, At, B1); PG8_BAR; PG8_SCHED;
        }
        if constexpr (ALIGN_EPI) { if (wr == 0) PG8_BAR; }
        E(acc, cur, wr, wc, fr, fq);
        if (!has_next) break;
#pragma unroll
        for (int a = 0; a < 2; ++a)
#pragma unroll
            for (int b = 0; b < 2; ++b)
#pragma unroll
                for (int m = 0; m < 4; ++m)
#pragma unroll
                    for (int n = 0; n < 2; ++n) acc[a][b][m][n] = (f32x4){0.f, 0.f, 0.f, 0.f};
        cur = nxt; cA = nA; cB = nB; ++ui;
#pragma unroll
        for (int h = 0; h < 2; ++h)
#pragma unroll
            for (int i = 0; i < 2; ++i) offC[h][i] = offN[h][i];
        if constexpr (ALIGN_EPI) { if (wr == 1) PG8_BAR; }
    }
    PG8_WAIT_V(0);
    if constexpr (!ALIGN_EPI) { if (wr == 0) PG8_BAR; }
    PG8_BAR;
#undef PG8_SA
#undef PG8_SB
#undef PG8_STAGE
#undef PG8_LDA
#undef PG8_LDB
#undef PG8_MMA
#undef PG8_LO
#undef PG8_HI
#undef PG8_CAT
#undef PG8_WAIT_V
#undef PG8_WAIT_L
#undef PG8_BAR
#undef PG8_SCHED
}
}
namespace pg8 {
constexpr int T_BLKSTART = 0  , T_CNT = 40  , T_BLKE = 80  , T_WORDS = 80 + 560;
constexpr int TB_OFF = 8192 - 64;

struct EpiIn {
    static constexpr bool PERM = true;
    bf16_t* Z; const float* qn; const float* kn;
    __device__ __forceinline__ void operator()(const f32x4 (&acc)[2][2][4][2], const Unit& u, int wr, int wc, int fr, int fq) const {
        const int row0 = u.pm * BM + wr * 64 + fr;
        if (u.pn < 4) {
            const float* g = (u.pn < 2) ? qn : kn; const float sc = (u.pn < 2) ? QSCALE : 1.0f;
            f32x4 gv[2][2];
#pragma unroll
            for (int bj = 0; bj < 2; ++bj)
#pragma unroll
                for (int n = 0; n < 2; ++n) gv[bj][n] = *(const f32x4*)(g + 32 * bj + 8 * fq + 4 * n) * sc;
#pragma unroll
            for (int ai = 0; ai < 2; ++ai)
#pragma unroll
                for (int m = 0; m < 4; ++m) {
                    float ss = 0.f;
#pragma unroll
                    for (int bj = 0; bj < 2; ++bj)
#pragma unroll
                        for (int n = 0; n < 2; ++n) { const f32x4 x = acc[ai][bj][m][n]; ss += (x[0] * x[0] + x[1] * x[1]) + (x[2] * x[2] + x[3] * x[3]); }
                    ss += __shfl_xor(ss, 16); ss += __shfl_xor(ss, 32);
                    const float rstd = rsqrtf(ss * (1.0f / 64.0f) + 1e-6f);
                    bf16_t* rowp = Z + (size_t)(row0 + ai * HALF + m * 16) * ZW + u.pn * BM + 64 * wc + 8 * fq;
#pragma unroll
                    for (int bj = 0; bj < 2; ++bj) { const f32x4 v0 = acc[ai][bj][m][0] * rstd * gv[bj][0], v1 = acc[ai][bj][m][1] * rstd * gv[bj][1];
                        u32x4 w; w.x = cvt_pk_bf16(v0[0], v0[1]); w.y = cvt_pk_bf16(v0[2], v0[3]); w.z = cvt_pk_bf16(v1[0], v1[1]); w.w = cvt_pk_bf16(v1[2], v1[3]);
                        *(u32x4*)(rowp + 32 * bj) = w; }
                }
        } else {
            const int col0 = u.pn * BM + wc * 32 + 8 * fq;
#pragma unroll
            for (int ai = 0; ai < 2; ++ai)
#pragma unroll
                for (int m = 0; m < 4; ++m) { bf16_t* rowp = Z + (size_t)(row0 + ai * HALF + m * 16) * ZW + col0;
#pragma unroll
                    for (int bj = 0; bj < 2; ++bj) { const f32x4 v0 = acc[ai][bj][m][0], v1 = acc[ai][bj][m][1];
                        u32x4 w; w.x = cvt_pk_bf16(v0[0], v0[1]); w.y = cvt_pk_bf16(v0[2], v0[3]); w.z = cvt_pk_bf16(v1[0], v1[1]); w.w = cvt_pk_bf16(v1[2], v1[3]);
                        *(u32x4*)(rowp + bj * HALF) = w; } }
        }
    }
};
struct EpiBf16 {
    static constexpr bool PERM = true;
    bf16_t* O; int ldc;
    __device__ __forceinline__ void operator()(const f32x4 (&acc)[2][2][4][2], const Unit& u, int wr, int wc, int fr, int fq) const {
        const int row0 = u.pm * BM + wr * 64 + fr, col0 = u.pn * BM + wc * 32 + 8 * fq;
#pragma unroll
        for (int ai = 0; ai < 2; ++ai)
#pragma unroll
            for (int m = 0; m < 4; ++m) { bf16_t* rowp = O + (size_t)(row0 + ai * HALF + m * 16) * ldc + col0;
#pragma unroll
                for (int bj = 0; bj < 2; ++bj) { const f32x4 v0 = acc[ai][bj][m][0], v1 = acc[ai][bj][m][1];
                    u32x4 w; w.x = cvt_pk_bf16(v0[0], v0[1]); w.y = cvt_pk_bf16(v0[2], v0[3]); w.z = cvt_pk_bf16(v1[0], v1[1]); w.w = cvt_pk_bf16(v1[2], v1[3]);
                    *(u32x4*)(rowp + bj * HALF) = w; } }
    }
};
struct EpiOut {
    static constexpr bool PERM = false;
    const float* X; float* O;
    __device__ __forceinline__ void operator()(const f32x4 (&acc)[2][2][4][2], const Unit& u, int wr, int wc, int fr, int fq) const {
        const int row0 = u.pm * BM + wr * 64 + fr, col0 = u.pn * BM + wc * 32 + 4 * fq;
#pragma unroll
        for (int ai = 0; ai < 2; ++ai)
#pragma unroll
            for (int m = 0; m < 4; ++m) { const size_t off = (size_t)(row0 + ai * HALF + m * 16) * DM + col0;
#pragma unroll
                for (int bj = 0; bj < 2; ++bj)
#pragma unroll
                    for (int n = 0; n < 2; ++n) *(f32x4*)(O + off + bj * HALF + n * 16) = *(const f32x4*)(X + off + bj * HALF + n * 16) + acc[ai][bj][m][n];
                if (m & 1) asm volatile("" ::: "memory"); }
    }
};
struct EpiPg {
    static constexpr bool PERM = false;
    float* X; const bf16_t* PJ;
    __device__ __forceinline__ void operator()(const f32x4 (&acc)[2][2][4][2], const Unit& u, int wr, int wc, int fr, int fq) const {
        const int row0 = u.pm * BM + wr * 64 + fr, col0 = u.pn * BM + wc * 32 + 4 * fq;
#pragma unroll
        for (int ai = 0; ai < 2; ++ai)
#pragma unroll
            for (int m = 0; m < 4; ++m) { const size_t off = (size_t)(row0 + ai * HALF + m * 16) * DM + col0;
#pragma unroll
                for (int bj = 0; bj < 2; ++bj)
#pragma unroll
                    for (int n = 0; n < 2; ++n) { const size_t o = off + bj * HALF + n * 16; const u32x2 pj = *(const u32x2*)(PJ + o); const f32x4 a = acc[ai][bj][m][n]; const f32x4 xv = *(const f32x4*)(X + o);
                        f32x4 r; r[0] = xv[0] + sigmoidf_(a[0]) * bflo(pj.x); r[1] = xv[1] + sigmoidf_(a[1]) * bfhi(pj.x); r[2] = xv[2] + sigmoidf_(a[2]) * bflo(pj.y); r[3] = xv[3] + sigmoidf_(a[3]) * bfhi(pj.y);
                        *(f32x4*)(X + o) = r; }
                if (m & 1) asm volatile("" ::: "memory"); }
    }
};
struct EpiGu {
    static constexpr bool PERM = true;
    unsigned char* ACT; const float* b_gu;
    __device__ __forceinline__ void operator()(const f32x4 (&acc)[2][2][4][2], const Unit& u, int wr, int wc, int fr, int fq) const {
        const int row0 = u.pm * BM + wr * 64 + fr, cl = u.pn * HALF + wc * 32 + 8 * fq;
        const float* bg = b_gu + (size_t)u.e * 2048 + cl;
        f32x4 bgl[2], bli[2];
#pragma unroll
        for (int n = 0; n < 2; ++n) { bgl[n] = *(const f32x4*)(bg + 4 * n); bli[n] = *(const f32x4*)(bg + 1024 + 4 * n); }
#pragma unroll
        for (int ai = 0; ai < 2; ++ai)
#pragma unroll
            for (int m = 0; m < 4; ++m) { unsigned char* rowp = ACT + (size_t)(row0 + ai * HALF + m * 16) * EFF + cl; float r[8];
#pragma unroll
                for (int n = 0; n < 2; ++n)
#pragma unroll
                    for (int i = 0; i < 4; ++i) { const float gl = fminf(acc[ai][0][m][n][i] + bgl[n][i], 7.0f); const float li = fminf(fmaxf(acc[ai][1][m][n][i] + bli[n][i], -7.0f), 7.0f);
                        r[4 * n + i] = gl * sigmoidf_(1.702f * gl) * (li + 1.0f); }
                u32x2 w; w.x = pk4_fp8(r[0], r[1], r[2], r[3]); w.y = pk4_fp8(r[4], r[5], r[6], r[7]);
                *(u32x2*)rowp = w; }
    }
};
struct EpiDn {
    static constexpr bool PERM = true;
    bf16_t* YP; const float* b_dn; const float* gateslot; const LAS int* tab;
    __device__ __forceinline__ void operator()(const f32x4 (&acc)[2][2][4][2], const Unit& u, int wr, int wc, int fr, int fq) const {
        const int row0 = u.pm * BM + wr * 64 + fr, col0 = u.pn * BM + wc * 32 + 8 * fq;
        const float* bd = b_dn + (size_t)u.e * 1024 + col0; const int cnt = tab[T_CNT + u.e];
        f32x4 bv[2][2];
#pragma unroll
        for (int bj = 0; bj < 2; ++bj)
#pragma unroll
            for (int n = 0; n < 2; ++n) bv[bj][n] = *(const f32x4*)(bd + bj * HALF + 4 * n);
#pragma unroll
        for (int ai = 0; ai < 2; ++ai)
#pragma unroll
            for (int m = 0; m < 4; ++m) { const int rr = wr * 64 + fr + ai * HALF + m * 16, slot = u.lb * 256 + rr;
                const float gt = slot < cnt ? ((const LAS float*)((const LAS unsigned char*)tab + TB_OFF + u.sl * 1024))[rr] : 0.f;
                bf16_t* rowp = YP + (size_t)(row0 + ai * HALF + m * 16) * DM + col0;
#pragma unroll
                for (int bj = 0; bj < 2; ++bj) { const f32x4 v0 = (acc[ai][bj][m][0] + bv[bj][0]) * gt, v1 = (acc[ai][bj][m][1] + bv[bj][1]) * gt;
                    u32x4 w; w.x = cvt_pk_bf16(v0[0], v0[1]); w.y = cvt_pk_bf16(v0[2], v0[3]); w.z = cvt_pk_bf16(v1[0], v1[1]); w.w = cvt_pk_bf16(v1[2], v1[3]);
                    *(u32x4*)(rowp + bj * HALF) = w; } }
    }
};
struct MoeOrder {
    const unsigned char* A; const unsigned char* Bt; const int* tokslot; const float* gateslot;   const LAS int* tab; int nblk, nN, G, c; bool gather;
    __device__ __forceinline__ bool next(int i, Unit& u) const { if (!tile_order(i, G, c, nblk, nN, u.pm, u.pn)) return false; u.e = tab[T_BLKE + u.pm]; u.lb = u.pm - tab[T_BLKSTART + u.e]; return true; }
    __device__ __forceinline__ const char* a_base(const Unit& u) const { return gather ? (const char*)A : (const char*)A + (size_t)u.pm * BM * 1024; }
    __device__ __forceinline__ const char* b_base(const Unit& u) const { return (const char*)Bt + ((size_t)u.e * nN + u.pn) * BM * 1024; }
    __device__ __forceinline__ void prefetch(const Unit& u, int slot, int wid, int lane) const {
        if (wid < 4) { const unsigned* src = (gather ? (const unsigned*)tokslot : (const unsigned*)gateslot) + (size_t)u.e * NTOK + u.lb * 256 + wid * 64 + lane;
            __builtin_amdgcn_global_load_lds(src, (LAS unsigned*)((LAS unsigned char*)tab + TB_OFF + slot * 1024 + wid * 256), 4, 0, 0); }
    }
    __device__ __forceinline__ void a_off(const Unit& u, const int (&R)[2], const int (&C)[2], unsigned (&off)[2][2]) const {
        const int cnt = tab[T_CNT + u.e]; const LAS int* tb = (const LAS int*)((const LAS unsigned char*)tab + TB_OFF + u.sl * 1024);
#pragma unroll
        for (int h = 0; h < 2; ++h)
#pragma unroll
            for (int i = 0; i < 2; ++i) {
                if (gather) { const int rr = R[i] + HALF * h; const int tk = tb[rr]; const int tok = (u.lb * 256 + rr) < cnt ? tk : NTOK; off[h][i] = (unsigned)tok * 1024u + (unsigned)C[i] * 2u; }
                else off[h][i] = (unsigned)((R[i] + HALF * h) * 1024 + C[i] * 2);
            }
    }
};
__device__ __forceinline__ int moe_tables(LAS int* tab, const unsigned* cntw) {
    if (threadIdx.x == 0) { int s = 0; for (int e = 0; e < NE; ++e) { const int c = (int)cntw[e]; tab[T_CNT + e] = c; tab[T_BLKSTART + e] = s; const int nb = (c + 255) >> 8; for (int j = 0; j < nb; ++j) tab[T_BLKE + s + j] = e; s += nb; } tab[T_BLKSTART + NE] = s; }
    __syncthreads();
    return tab[T_BLKSTART + NE];
}
}
constexpr int NWAVES = 8, NTHREADS = 512;
constexpr int RING_BYTES = 131072, MISC_OFF = RING_BYTES, LDS_BYTES = 147456;

__device__ __forceinline__ void tr_item(const float* W, int ldw, int srccol0, int k0, bf16_t* WT, int Kd, int dstrow0, LAS float* scr, int lane) {
#pragma unroll 8
    for (int i = 0; i < 32; ++i) { const int kk = 2 * i + (lane >> 5); scr[kk * 33 + (lane & 31)] = W[(size_t)(k0 + kk) * ldw + srccol0 + (lane & 31)]; }
    asm volatile("s_waitcnt lgkmcnt(0)" ::: "memory");
    const int c = lane & 7;
#pragma unroll
    for (int j = 0; j < 4; ++j) { const int n = (lane >> 3) + 8 * j; const LAS float* s = scr + (8 * c) * 33 + n;
        u32x4 o; o.x = pk2(s[0 * 33], s[1 * 33]); o.y = pk2(s[2 * 33], s[3 * 33]); o.z = pk2(s[4 * 33], s[5 * 33]); o.w = pk2(s[6 * 33], s[7 * 33]);
        *(u32x4*)(WT + (size_t)(dstrow0 + n) * Kd + k0 + 8 * c) = o; }
    asm volatile("s_waitcnt lgkmcnt(0)" ::: "memory");
}
__device__ __forceinline__ void tr_item8(const float* W, int ldw, int srccol0, int k0, unsigned char* WT, int Kd, int dstrow0, LAS float* scr, int lane) {
#pragma unroll 8
    for (int i = 0; i < 32; ++i) { const int kk = 2 * i + (lane >> 5); scr[kk * 33 + (lane & 31)] = W[(size_t)(k0 + kk) * ldw + srccol0 + (lane & 31)]; }
    asm volatile("s_waitcnt lgkmcnt(0)" ::: "memory");
    const int c = lane & 7;
#pragma unroll
    for (int j = 0; j < 4; ++j) { const int n = (lane >> 3) + 8 * j; const LAS float* s = scr + (8 * c) * 33 + n;
        u32x2 o; o.x = pk4_fp8(s[0 * 33] * 64.f, s[1 * 33] * 64.f, s[2 * 33] * 64.f, s[3 * 33] * 64.f); o.y = pk4_fp8(s[4 * 33] * 64.f, s[5 * 33] * 64.f, s[6 * 33] * 64.f, s[7 * 33] * 64.f);
        *(u32x2*)(WT + (size_t)(dstrow0 + n) * Kd + k0 + 8 * c) = o; }
    asm volatile("s_waitcnt lgkmcnt(0)" ::: "memory");
}
constexpr int I_IN = 16 * 120, I_OUT = 16 * 32, I_PG = 16 * 32, I_PP = 4 * 32, I_GU1 = 16 * 64, I_DN1 = 16 * 32;
constexpr int I_LORA = 16 + 16 + 32;
constexpr int I_SMALL = I_IN + I_OUT + I_PG + I_PP + I_LORA, I_GU = NE * I_GU1, I_DN = NE * I_DN1, I_ALL = I_SMALL + I_GU + I_DN;
__device__ __forceinline__ void prep_item(KPR P, int it, LAS float* scr, int lane) {
    unsigned char* ws = P.ws;
    if (it < I_IN) { const int kb = it / 120, nb = it % 120, n0 = nb * 32, pn = n0 >> 8, j0 = n0 & 255;
        const int src = pn < 4 ? (pn * 256 + 64 * ((j0 & 127) >> 5) + 32 * (j0 >> 7)) : (n0 < 2048 ? n0 : n0 + 8);
        tr_item(P.w_in, INW, src, kb * 64, (bf16_t*)(ws + WS_WIN), 1024, n0, scr, lane); return; }
    it -= I_IN;
    if (it < I_OUT) { tr_item(P.w_out, 1024, (it % 32) * 32, (it / 32) * 64, (bf16_t*)(ws + WS_WOUT), 1024, (it % 32) * 32, scr, lane); return; }
    it -= I_OUT;
    if (it < I_PG) { tr_item8(P.w_pg, 1024, (it % 32) * 32, (it / 32) * 64, ws + WS_WPG, 1024, (it % 32) * 32, scr, lane); return; }
    it -= I_PG;
    if (it < I_PP) { tr_item(P.w_pp, 1024, (it % 32) * 32, (it / 32) * 64, (bf16_t*)(ws + WS_WPP), 256, (it % 32) * 32, scr, lane); return; }
    it -= I_PP;
    if (it < 16) { tr_item(P.w2, 512, it * 32, 0, (bf16_t*)(ws + 29 * MiB), 64, it * 32, scr, lane); return; }
    it -= 16;
    if (it < 16) { tr_item(P.a2, 512, it * 32, 0, (bf16_t*)(ws + 29 * MiB + 65536), 64, it * 32, scr, lane); return; }
    it -= 16;
    if (it < 32) { tr_item(P.g2, 512, (it % 16) * 32, (it / 16) * 64, (bf16_t*)(ws + 29 * MiB + 131072), 128, (it % 16) * 32, scr, lane); return; }
    it -= 32;
    if (it < I_GU) { const int e = it / I_GU1, r = it % I_GU1, kb = r / 64, nb = r % 64, n0 = nb * 32, pn = n0 >> 8, j0 = n0 & 255;
        const int src = (j0 >> 7) * 1024 + pn * 128 + (j0 & 127);
        tr_item8(P.w_gu + (size_t)e * 1024 * 2048, 2048, src, kb * 64, ws + WS_WGU + (size_t)e * 2048 * 1024, 1024, n0, scr, lane); return; }
    it -= I_GU;
    { const int e = it / I_DN1, r = it % I_DN1, kb = r / 32, nb = r % 32;
        tr_item8(P.w_down + (size_t)e * 1024 * 1024, 1024, nb * 32, kb * 64, ws + WS_WDN + (size_t)e * 1024 * 1024, 1024, nb * 32, scr, lane); }
}
__device__ __forceinline__ void phase_prep_weights(KPR P, LAS unsigned char* lds, int gw, int ngw, int wave, int lane) {
    LAS float* scr = (LAS float*)(lds + wave * 16384);
    for (int it = gw; it < I_ALL; it += ngw) prep_item(P, it, scr, lane);
}
__device__ __forceinline__ void phase_cvt_p(KPR P, int gt, int ngt) {
    bf16_t* PB = (bf16_t*)((unsigned char*)P.out + DO_PB);
    for (int i = gt; i < NTOK * PLE / 8; i += ngt) { const f32x4 a = ((const f32x4*)P.p)[2 * i], b = ((const f32x4*)P.p)[2 * i + 1];
        u32x4 w; w.x = pk2(a[0], a[1]); w.y = pk2(a[2], a[3]); w.z = pk2(b[0], b[1]); w.w = pk2(b[2], b[3]); ((u32x4*)PB)[i] = w; }
}
__device__ __forceinline__ void rms_row(const float* xrow, const float* gain, int lane, f32x4 (&v)[4]) {
    const f32x4* xr = (const f32x4*)xrow + lane; float s = 0.f;
#pragma unroll
    for (int j = 0; j < 4; ++j) { v[j] = xr[64 * j]; s += (v[j][0] * v[j][0] + v[j][1] * v[j][1]) + (v[j][2] * v[j][2] + v[j][3] * v[j][3]); }
    const float rstd = rsqrtf(wave_sum(s) * (1.f / DM) + 1e-6f);
#pragma unroll
    for (int j = 0; j < 4; ++j) v[j] = v[j] * rstd * ((const f32x4*)gain)[64 * j + lane];
}
__device__ __forceinline__ void store_row_fp8(unsigned char* orow, int lane, const f32x4 (&v)[4]) {
    unsigned* o4 = (unsigned*)orow + lane;
#pragma unroll
    for (int j = 0; j < 4; ++j) o4[64 * j] = pk4_fp8(v[j][0], v[j][1], v[j][2], v[j][3]);
}
__device__ __forceinline__ void store_row_bf16(bf16_t* orow, int lane, const f32x4 (&v)[4]) {
    u32x2* o8 = (u32x2*)orow + lane;
#pragma unroll
    for (int j = 0; j < 4; ++j) { u32x2 w; w.x = pk2(v[j][0], v[j][1]); w.y = pk2(v[j][2], v[j][3]); o8[64 * j] = w; }
}
__device__ __forceinline__ void norm1_row(KPR P, int row, int lane, const LAS float* wff, LAS float* lf_out  ) {
    f32x4 v[4]; rms_row(P.x + (size_t)row * DM, P.mix_norm, lane, v);
    store_row_bf16((bf16_t*)(P.ws + WS_XN) + (size_t)row * DM, lane, v);
    float ff[8];
#pragma unroll
    for (int q = 0; q < 8; ++q) ff[q] = 0.f;
#pragma unroll
    for (int j = 0; j < 4; ++j)
#pragma unroll
        for (int i = 0; i < 4; ++i) { const LAS f32x4* w = (const LAS f32x4*)(wff + (size_t)(4 * (64 * j + lane) + i) * 8); const f32x4 w0 = w[0], w1 = w[1]; const float h = v[j][i];
            ff[0] += h * w0[0]; ff[1] += h * w0[1]; ff[2] += h * w0[2]; ff[3] += h * w0[3]; ff[4] += h * w1[0]; ff[5] += h * w1[1]; ff[6] += h * w1[2]; ff[7] += h * w1[3]; }
#pragma unroll
    for (int q = 0; q < 8; ++q) ff[q] = wave_sum(ff[q]);
    if (lane < 8) { float f = ff[0];
#pragma unroll
        for (int q = 1; q < 8; ++q) f = (lane == q) ? ff[q] : f;
        lf_out[lane] = logsigmoidf_(f + P.f_bias[lane]); }
}
__device__ __forceinline__ void load_wff(KPR P, LAS float* wff, int tid, int nthr) {
    for (int i = tid; i < 1024 * 8; i += nthr) wff[i] = P.w_in[(size_t)(i >> 3) * INW + 2048 + (i & 7)];
}
__device__ __forceinline__ void final_row(KPR P, int row, int lane, bool dead) {
    f32x4 v[4]; rms_row((const float*)(P.ws + WS_X1) + (size_t)row * DM, P.final_norm, lane, v);
    f32x4* o = (f32x4*)(P.out + (size_t)row * DM) + lane;
#pragma unroll
    for (int j = 0; j < 4; ++j) { if (dead) { const float q = __builtin_nanf(""); v[j] = (f32x4){q, q, q, q}; } o[64 * j] = v[j]; }
}
typedef GAS unsigned gu32;
#define RLX_AGENT __ATOMIC_RELAXED, __HIP_MEMORY_SCOPE_AGENT
#define XB_TMO      128
#define XB_XCNT(j)  (256  + 64 * (j))
#define XB_XSUB(j)  (1280 + 64 * (j))
#define XB_XGEN(j)  (2304 + 64 * (j))
#define XB_TOP      3328
#define XB_TOPGEN   3392
#define XCD_BAR_WORDS 3456
#define XB_SPIN_CAP (1u << 22)

__device__ __forceinline__ unsigned xb_ld(unsigned* p)              { return __hip_atomic_load(p, __ATOMIC_RELAXED, __HIP_MEMORY_SCOPE_AGENT); }
__device__ __forceinline__ unsigned xb_add(unsigned* p, unsigned v) { return __hip_atomic_fetch_add(p, v, __ATOMIC_RELAXED, __HIP_MEMORY_SCOPE_AGENT); }
__device__ __forceinline__ unsigned xb_xcc_id() { return (unsigned)__builtin_amdgcn_s_getreg((3 << 11) | 20) & 0xFu; }
#define XB_SPIN(cond, bar) do { unsigned _sp = 0; while (cond) { __builtin_amdgcn_s_sleep(1); \
    if ((++_sp & 255u) == 0u) { if (xb_ld(&(bar)[XB_TMO])) break; if (_sp > XB_SPIN_CAP) { atomicAdd(&(bar)[XB_TMO], 1u); break; } } } } while (0)

struct XcdBarrier { unsigned* bar; unsigned x; volatile LAS unsigned* st; };

__device__ __forceinline__ XcdBarrier xcd_barrier_post(unsigned* bar, volatile LAS unsigned* st) {
    XcdBarrier b; b.bar = bar; b.x = xb_xcc_id(); b.st = st;
    if (threadIdx.x == 0) (void)xb_add(&bar[XB_XCNT(b.x)], 1u);
    return b;
}
__device__ __forceinline__ void xcd_barrier_complete(unsigned* bar, unsigned x, unsigned& nloc, unsigned& nx) {
    const unsigned G = gridDim.x * gridDim.y * gridDim.z;
    unsigned sum, cnt, mine, sp = 0u;
    for (;;) {
        sum = 0u; cnt = 0u; mine = 0u;
#pragma unroll
        for (unsigned j = 0; j < 16; ++j) { const unsigned c = xb_ld(&bar[XB_XCNT(j)]); sum += c; cnt += (c > 0u) ? 1u : 0u; mine = (j == x) ? c : mine; }
        if (sum == G) break;
        __builtin_amdgcn_s_sleep(1);
        if ((++sp & 255u) == 0u) { if (xb_ld(&bar[XB_TMO])) break; if (sp > XB_SPIN_CAP) { atomicAdd(&bar[XB_TMO], 1u); break; } }
    }
    nloc = mine > 0u ? mine : 1u; nx = cnt > 0u ? cnt : 1u;
}
__device__ __forceinline__ void xcd_barrier(const XcdBarrier& b) {
    asm volatile("s_waitcnt vmcnt(0)" ::: "memory");
    __syncthreads();
    if (threadIdx.x == 0) {
        unsigned* bar = b.bar;
        __builtin_amdgcn_s_waitcnt(0);
        unsigned nloc = b.st[0], nx = b.st[1];
        if (nloc == 0u) { xcd_barrier_complete(bar, b.x, nloc, nx); b.st[0] = nloc; b.st[1] = nx; }
        const unsigned old = xb_add(&bar[XB_XSUB(b.x)], 1u);
        const unsigned gen = old / nloc;
        if (old + 1u == (gen + 1u) * nloc) {
            __builtin_amdgcn_fence(__ATOMIC_RELEASE, "agent");
            asm volatile("s_waitcnt vmcnt(0)" ::: "memory");
            const unsigned og = xb_add(&bar[XB_TOP], 1u);
            const unsigned tg = og / nx;
            if (og + 1u == (tg + 1u) * nx) xb_add(&bar[XB_TOPGEN], 1u);
            else XB_SPIN(xb_ld(&bar[XB_TOPGEN]) == tg, bar);
            __builtin_amdgcn_fence(__ATOMIC_ACQUIRE, "agent");
            xb_add(&bar[XB_XGEN(b.x)], 1u);
            asm volatile("s_waitcnt vmcnt(0)" ::: "memory");
        } else {
            XB_SPIN(xb_ld(&bar[XB_XGEN(b.x)]) == gen, bar);
            __builtin_amdgcn_fence(__ATOMIC_ACQUIRE, "agent");
            asm volatile("s_waitcnt vmcnt(0)" ::: "memory");
        }
    }
    __syncthreads();
}
namespace rk {
constexpr int MB = 8192;
constexpr int S_AT = 0, S_RT = 1, S_KT = 2, S_BT = 3, S_ATT = 4, S_KTT = 5, S_BTT = 6, S_VT = 7, S_N = 8, S_NT = 9, S_MAK = 10, S_MRB = 11, S_MRK = 12, S_TA = 13, S_TB = 14;
constexpr int SCR = 15 * MB;
constexpr int NCHUNK = SEQ / 64;
constexpr size_t WS_HT = WS_X1;
constexpr size_t WS_Y0 = WS_X1 + 64 * MiB;
constexpr size_t WS_QI = WS_X1 + 96 * MiB;
constexpr size_t WS_LW = WS_RW, WS_LA = WS_RW + 32 * MiB, WS_LG = WS_RW + 64 * MiB;
constexpr size_t WS_SC = WS_RW + 224 * MiB;
constexpr size_t DO_GT = 80 * MiB;
static_assert(WS_SC + 32 * MiB <= WS_END, "rwkv blobs");

__device__ __forceinline__ int moff(int row, int col) { return row * 128 + ((((col >> 3) ^ (row >> 1)) & 7) << 4) + (col & 7) * 2; }
__device__ __forceinline__ int crow(int r, int hi) { return (r & 3) + 8 * (r >> 2) + 4 * hi; }
__device__ __forceinline__ f32x16 mm_nt(const LAS unsigned char* A, int ar0, const LAS unsigned char* Bt, int br0, f32x16 acc, int r32, int hi) {
#pragma unroll
    for (int ks = 0; ks < 4; ++ks) { const bf16x8 a = *(const LAS bf16x8*)(A + moff(ar0 + r32, 16 * ks + 8 * hi)), b = *(const LAS bf16x8*)(Bt + moff(br0 + r32, 16 * ks + 8 * hi));
        acc = __builtin_amdgcn_mfma_f32_32x32x16_bf16(a, b, acc, 0, 0, 0); }
    return acc;
}
__device__ __forceinline__ void store_t(LAS unsigned char* dst, const f32x16& acc, int i0, int j0, int r32, int hi) {
#pragma unroll
    for (int g = 0; g < 4; ++g) { u32x2 w; w.x = pk2(acc[4 * g], acc[4 * g + 1]); w.y = pk2(acc[4 * g + 2], acc[4 * g + 3]); *(LAS u32x2*)(dst + moff(j0 + r32, i0 + 8 * g + 4 * hi)) = w; }
}
template <int MODE> __device__ __forceinline__ void mask_tri(f32x16& acc, int i0, int j0, int r32, int hi) {
#pragma unroll
    for (int r = 0; r < 16; ++r) { const int i = i0 + crow(r, hi), j = j0 + r32; const bool keep = MODE == 0 ? (j < i) : (MODE == 1 ? (i < j) : (i <= j)); if (!keep) acc[r] = 0.f; }
}

__device__ __forceinline__ void pass1_chunk(KPR P, LAS unsigned char* lds, int bh, int c, int tid) {
    const int lane = tid & 63, wave = tid >> 6, r32 = lane & 31, hi = lane >> 5, grp = wave >> 2, wq = wave & 3, i0 = 32 * (wq >> 1), j0 = 32 * (wq & 1);
    const int b = bh >> 3, h = bh & 7; const size_t tok0 = (size_t)b * SEQ + (size_t)c * 64; const size_t ci = (size_t)bh * NCHUNK + c;
    LAS float* part = (LAS float*)(lds + SCR); LAS float* WL = (LAS float*)(lds + SCR + 2048);
#define MAT(s) (lds + (s) * MB)
    {
        const bf16_t* Z = (const bf16_t*)(P.ws + WS_Z); const bf16_t* LW = (const bf16_t*)(P.ws + WS_LW); const bf16_t* LA = (const bf16_t*)(P.ws + WS_LA);
        const int ch = tid & 63, tq = tid >> 6, cc = h * 64 + ch; const size_t row0 = tok0 + 8 * tq;
        const float mur = P.mu[RW_R + cc], muk = P.mu[RW_K + cc], muv = P.mu[RW_V + cc], w0c = P.w0[cc], a0c = P.a0[cc], kkc = P.k_k[cc], kac = P.k_a[cc];
        const bf16_t* zp = Z + row0 * ZW + ZR + cc;
        const bool first = (c == 0) && (tq == 0); const bf16_t* zq = first ? zp : zp - ZW; const float pm = first ? 0.f : 1.f;
        unsigned short lr[9], lk[9], lv[9], llw[8], lla[8];
        lr[0] = zq[RW_R]; lk[0] = zq[RW_K]; lv[0] = zq[RW_V];
#pragma unroll
        for (int i = 0; i < 8; ++i) { const bf16_t* zi = zp + (size_t)i * ZW; lr[i + 1] = zi[RW_R]; lk[i + 1] = zi[RW_K]; lv[i + 1] = zi[RW_V]; const size_t o = (row0 + i) * 512 + cc; llw[i] = LW[o]; lla[i] = LA[o]; }
        float cum[8], vr[8], vk[8], vkk[8], vka[8], ssq[8]; unsigned short vv16[8]; float run = 0.f;
#pragma unroll
        for (int i = 0; i < 8; ++i) { const float pmi = (i == 0) ? pm : 1.f; const float zr1 = bf2f(lr[i + 1]), zk1 = bf2f(lk[i + 1]), zv1 = bf2f(lv[i + 1]);
            vr[i] = zr1 + (bf2f(lr[i]) * pmi - zr1) * mur; vk[i] = zk1 + (bf2f(lk[i]) * pmi - zk1) * muk; vv16[i] = (unsigned short)f2bf(zv1 + (bf2f(lv[i]) * pmi - zv1) * muv);
            vkk[i] = vk[i] * kkc; ssq[i] = vkk[i] * vkk[i]; }
#pragma unroll
        for (int o = 1; o < 64; o <<= 1) {
#pragma unroll
            for (int i = 0; i < 8; ++i) ssq[i] += __shfl_xor(ssq[i], o); }
#pragma unroll
        for (int i = 0; i < 8; ++i) {
            const float wl = w0c + bf2f(llw[i]); const float sp = fmaxf(-wl, 0.f) + __logf(1.0f + __expf(-fabsf(wl)));
            run += -__expf(-sp - 0.5f); cum[i] = run;
            const float a = __builtin_amdgcn_rcpf(1.0f + __expf(-(a0c + bf2f(lla[i]))));
            const float kk = vkk[i] * __builtin_amdgcn_rcpf(fmaxf(__builtin_amdgcn_sqrtf(ssq[i]), 1e-12f));
            vk[i] = vk[i] * (1.0f + (a - 1.0f) * kac); vkk[i] = kk; vka[i] = kk * a; }
        part[tq * 64 + ch] = run;
        __syncthreads();
        float pre = 0.f;
#pragma unroll
        for (int g = 0; g < 8; ++g) { const float pvv = part[g * 64 + ch]; pre += (g < tq) ? pvv : 0.f; }
        float eprev = __expf(pre);
        unsigned atT[4], ktT[4], btT[4], vT[4]; unsigned short hold[4] = {0, 0, 0, 0};
#pragma unroll
        for (int i = 0; i < 8; ++i) { const int t = 8 * tq + i;
            const float cm = pre + cum[i], e1 = __expf(cm), einv = __expf(-cm);
            const unsigned short at = (unsigned short)f2bf(-vkk[i] * eprev), rt = (unsigned short)f2bf(vr[i] * e1), kt = (unsigned short)f2bf(vk[i] * einv), bt = (unsigned short)f2bf(vka[i] * einv), vv = vv16[i];
            eprev = e1;
            *(LAS unsigned short*)(MAT(S_AT) + moff(t, ch)) = at; *(LAS unsigned short*)(MAT(S_RT) + moff(t, ch)) = rt; *(LAS unsigned short*)(MAT(S_KT) + moff(t, ch)) = kt; *(LAS unsigned short*)(MAT(S_BT) + moff(t, ch)) = bt;
            if (i & 1) { atT[i >> 1] = hold[0] | ((unsigned)at << 16); ktT[i >> 1] = hold[1] | ((unsigned)kt << 16); btT[i >> 1] = hold[2] | ((unsigned)bt << 16); vT[i >> 1] = hold[3] | ((unsigned)vv << 16); }
            else { hold[0] = at; hold[1] = kt; hold[2] = bt; hold[3] = vv; }
            if (i == 7 && tq == 7) WL[ch] = e1; }
        *(LAS u32x4*)(MAT(S_ATT) + moff(ch, 8 * tq)) = (u32x4){atT[0], atT[1], atT[2], atT[3]}; *(LAS u32x4*)(MAT(S_KTT) + moff(ch, 8 * tq)) = (u32x4){ktT[0], ktT[1], ktT[2], ktT[3]};
        *(LAS u32x4*)(MAT(S_BTT) + moff(ch, 8 * tq)) = (u32x4){btT[0], btT[1], btT[2], btT[3]}; *(LAS u32x4*)(MAT(S_VT) + moff(ch, 8 * tq)) = (u32x4){vT[0], vT[1], vT[2], vT[3]};
    }
    __syncthreads();
    const f32x16 zero = f32x16{};
    if (grp == 0) { f32x16 d = mm_nt(MAT(S_AT), i0, MAT(S_BT), j0, zero, r32, hi); mask_tri<0>(d, i0, j0, r32, hi); store_t(MAT(S_NT), d, i0, j0, r32, hi);
        d = mm_nt(MAT(S_KT), i0, MAT(S_AT), j0, zero, r32, hi); mask_tri<1>(d, i0, j0, r32, hi); store_t(MAT(S_MAK), d, i0, j0, r32, hi);
        d = mm_nt(MAT(S_KT), i0, MAT(S_RT), j0, zero, r32, hi); mask_tri<2>(d, i0, j0, r32, hi); store_t(MAT(S_MRK), d, i0, j0, r32, hi); }
    else { f32x16 d = mm_nt(MAT(S_BT), i0, MAT(S_AT), j0, zero, r32, hi); mask_tri<1>(d, i0, j0, r32, hi); store_t(MAT(S_N), d, i0, j0, r32, hi);
#pragma unroll
        for (int r = 0; r < 16; ++r) if (i0 + crow(r, hi) == j0 + r32) d[r] = 1.0f;
        store_t(MAT(S_TA), d, i0, j0, r32, hi);
        d = mm_nt(MAT(S_BT), i0, MAT(S_RT), j0, zero, r32, hi); mask_tri<2>(d, i0, j0, r32, hi); store_t(MAT(S_MRB), d, i0, j0, r32, hi); }
    __syncthreads();
#pragma unroll
    for (int s = 1; s <= 6; ++s) {
        const int mc = (s & 1) ? S_N : S_AT, mcT = (s & 1) ? S_NT : S_KT, mn = (s & 1) ? S_AT : S_N, mnT = (s & 1) ? S_KT : S_NT;
        const int tc = (s & 1) ? S_TB : S_TA, tn = (s & 1) ? S_TA : S_TB;
        if (s <= 5) {
            if (grp == 0) { const f32x16 d = mm_nt(MAT(mc), i0, MAT(mcT), j0, zero, r32, hi); store_t(MAT(mnT), d, i0, j0, r32, hi); }
            else { const f32x16 d = mm_nt(MAT(mcT), i0, MAT(mc), j0, zero, r32, hi); store_t(MAT(mn), d, i0, j0, r32, hi); }
        }
        if (s >= 2 && grp == (s <= 5 ? 0 : 1) ) {
            f32x16 d = mm_nt(MAT(mcT), i0, MAT(tc), j0, zero, r32, hi);
#pragma unroll
            for (int g = 0; g < 4; ++g) { const u32x2 tv = *(const LAS u32x2*)(MAT(tc) + moff(j0 + r32, i0 + 8 * g + 4 * hi)); d[4 * g] += bflo(tv.x); d[4 * g + 1] += bfhi(tv.x); d[4 * g + 2] += bflo(tv.y); d[4 * g + 3] += bfhi(tv.y); }
            store_t(MAT(tn), d, i0, j0, r32, hi);
        }
        __syncthreads();
    }
    if (grp == 0) { const f32x16 d = mm_nt(MAT(S_TB), i0, MAT(S_ATT), j0, zero, r32, hi); store_t(MAT(S_BT), d, i0, j0, r32, hi); }
    else { const f32x16 d = mm_nt(MAT(S_MAK), i0, MAT(S_VT), j0, zero, r32, hi); store_t(MAT(S_N), d, i0, j0, r32, hi); }
    __syncthreads();
    if (grp == 0) { const f32x16 d = mm_nt(MAT(S_TB), i0, MAT(S_N), j0, zero, r32, hi); store_t(MAT(S_NT), d, i0, j0, r32, hi);
        f32x16 q = mm_nt(MAT(S_BT), i0, MAT(S_MRB), j0, zero, r32, hi);
#pragma unroll
        for (int g = 0; g < 4; ++g) { const u32x2 rv = *(const LAS u32x2*)(MAT(S_RT) + moff(j0 + r32, i0 + 8 * g + 4 * hi)); q[4 * g] += bflo(rv.x); q[4 * g + 1] += bfhi(rv.x); q[4 * g + 2] += bflo(rv.y); q[4 * g + 3] += bfhi(rv.y); }
        store_t(MAT(S_KT), q, i0, j0, r32, hi); }
    else { f32x16 g_ = mm_nt(MAT(S_BT), i0, MAT(S_BTT), j0, zero, r32, hi);
        const float wl = WL[j0 + r32];
#pragma unroll
        for (int r = 0; r < 16; ++r) { if (i0 + crow(r, hi) == j0 + r32) g_[r] += 1.0f; g_[r] *= wl; }
        store_t(MAT(S_AT), g_, i0, j0, r32, hi); }
    __syncthreads();
    if (grp == 0) { f32x16 d = mm_nt(MAT(S_BTT), i0, MAT(S_NT), j0, zero, r32, hi); d = mm_nt(MAT(S_KTT), i0, MAT(S_VT), j0, d, r32, hi);
        float* HT = (float*)(P.ws + WS_HT) + ci * 4096 + (size_t)wq * 1024 + lane;
#pragma unroll
        for (int g = 0; g < 4; ++g) { const f32x4 wl4 = *(const LAS f32x4*)(WL + i0 + 8 * g + 4 * hi);
#pragma unroll
            for (int i = 0; i < 4; ++i) HT[(4 * g + i) * 64] = d[4 * g + i] * wl4[i]; } }
    else { f32x16 d = mm_nt(MAT(S_MRB), i0, MAT(S_NT), j0, zero, r32, hi); d = mm_nt(MAT(S_MRK), i0, MAT(S_VT), j0, d, r32, hi);
        unsigned* Y0 = (unsigned*)(P.ws + WS_Y0) + ci * 2048 + (size_t)wq * 512 + lane;
#pragma unroll
        for (int r2 = 0; r2 < 8; ++r2) Y0[r2 * 64] = pk2(d[2 * r2], d[2 * r2 + 1]); }
    { u32x4* GTg = (u32x4*)((unsigned char*)P.out + DO_GT + ci * MB); u32x4* QIg = (u32x4*)(P.ws + WS_QI + ci * MB);
        GTg[tid] = *(const LAS u32x4*)(MAT(S_AT) + tid * 16); QIg[tid] = *(const LAS u32x4*)(MAT(S_KT) + tid * 16); }
    __syncthreads();
#undef MAT
}

__device__ __forceinline__ void pass2_seq(KPR P, LAS unsigned char* lds, int bh, int tid) {
    const int lane = tid & 63, wave = tid >> 6, r32 = lane & 31, hi = lane >> 5, wq = wave & 3, i0 = 32 * (wq >> 1), j0 = 32 * (wq & 1);
    LAS unsigned char* Sm = lds; LAS unsigned char* G0 = lds + MB; LAS unsigned char* G1 = lds + 2 * MB;
    const size_t ci0 = (size_t)bh * NCHUNK;
    const u32x4* GTg = (const u32x4*)((const unsigned char*)P.out + DO_GT + ci0 * MB); u32x4* SCg = (u32x4*)(P.ws + WS_SC + ci0 * MB);
    const float* HT = (const float*)(P.ws + WS_HT) + ci0 * 4096 + (size_t)wq * 1024 + lane;
    *(LAS u32x4*)(Sm + tid * 16) = (u32x4){0u, 0u, 0u, 0u};
    *(LAS u32x4*)(G0 + tid * 16) = GTg[tid];
    u32x4 gnext = GTg[512 + tid];
    f32x16 hcur, hnext;
    if (wave < 4) {
#pragma unroll
        for (int r = 0; r < 16; ++r) { hcur[r] = HT[r * 64]; hnext[r] = HT[4096 + r * 64]; } }
    __syncthreads();
    for (int c = 0; c < NCHUNK; ++c) {
        LAS unsigned char* Gc = (c & 1) ? G1 : G0; LAS unsigned char* Gn = (c & 1) ? G0 : G1;
        SCg[(size_t)c * 512 + tid] = *(const LAS u32x4*)(Sm + tid * 16);
        f32x16 d = hcur;
        if (wave < 4) d = mm_nt(Gc, i0, Sm, j0, d, r32, hi);
        __syncthreads();
        if (wave < 4) store_t(Sm, d, i0, j0, r32, hi);
        *(LAS u32x4*)(Gn + tid * 16) = gnext;
        const int c2 = (c + 2 < NCHUNK) ? c + 2 : NCHUNK - 1;
        gnext = GTg[(size_t)c2 * 512 + tid];
        if (wave < 4) { hcur = hnext;
#pragma unroll
            for (int r = 0; r < 16; ++r) hnext[r] = HT[(size_t)c2 * 4096 + r * 64]; }
        __syncthreads();
    }
}

__device__ __forceinline__ void pass3_chunk(KPR P, LAS unsigned char* lds, int bh, int c, int tid) {
    const int lane = tid & 63, wave = tid >> 6, r32 = lane & 31, hi = lane >> 5, wq = wave & 3, i0 = 32 * (wq >> 1), j0 = 32 * (wq & 1);
    const int b = bh >> 3, h = bh & 7; const size_t tok0 = (size_t)b * SEQ + (size_t)c * 64; const size_t ci = (size_t)bh * NCHUNK + c;
    LAS unsigned char* Qm = lds; LAS unsigned char* Sm = lds + MB; LAS float* Yl = (LAS float*)(lds + 2 * MB);
    *(LAS u32x4*)(Qm + tid * 16) = ((const u32x4*)(P.ws + WS_QI + ci * MB))[tid];
    *(LAS u32x4*)(Sm + tid * 16) = ((const u32x4*)(P.ws + WS_SC + ci * MB))[tid];
    f32x16 d = f32x16{};
    if (wave < 4) { const unsigned* Y0 = (const unsigned*)(P.ws + WS_Y0) + ci * 2048 + (size_t)wq * 512 + lane;
#pragma unroll
        for (int r2 = 0; r2 < 8; ++r2) { const unsigned w = Y0[r2 * 64]; d[2 * r2] = bflo(w); d[2 * r2 + 1] = bfhi(w); } }
    __syncthreads();
    if (wave < 4) { d = mm_nt(Qm, i0, Sm, j0, d, r32, hi);
#pragma unroll
        for (int r = 0; r < 16; ++r) Yl[(i0 + crow(r, hi)) * 65 + j0 + r32] = d[r]; }
    __syncthreads();
    const bf16_t* Z = (const bf16_t*)(P.ws + WS_Z); const bf16_t* LA = (const bf16_t*)(P.ws + WS_LA); const bf16_t* LG = (const bf16_t*)(P.ws + WS_LG);
    bf16_t* AO = (bf16_t*)(P.ws + WS_AO); const int cc = h * 64 + lane;
    const float lnw = P.ln_w[cc], lnb = P.ln_b[cc], rkc = P.r_k[cc], mur = P.mu[RW_R + cc], muk = P.mu[RW_K + cc], muv = P.mu[RW_V + cc], a0c = P.a0[cc], kac = P.k_a[cc];
    const bf16_t* zp = Z + (tok0 + wave * 8) * ZW + ZR + cc; const bool first = (c == 0) && (wave == 0); const bf16_t* zq = first ? zp : zp - ZW; const float pm = first ? 0.f : 1.f;
    unsigned short lr[9], lk[9], lv[9], lla[8], llg[8];
    lr[0] = zq[RW_R]; lk[0] = zq[RW_K]; lv[0] = zq[RW_V];
#pragma unroll
    for (int i = 0; i < 8; ++i) { const bf16_t* zi = zp + (size_t)i * ZW; lr[i + 1] = zi[RW_R]; lk[i + 1] = zi[RW_K]; lv[i + 1] = zi[RW_V]; const size_t o = (tok0 + wave * 8 + i) * 512 + cc; lla[i] = LA[o]; llg[i] = LG[o]; }
    float y[8], s1[8], s2[8], s3[8], vvv[8];
#pragma unroll
    for (int i = 0; i < 8; ++i) { const float pmi = (i == 0) ? pm : 1.f; const float zr1 = bf2f(lr[i + 1]), zk1 = bf2f(lk[i + 1]), zv1 = bf2f(lv[i + 1]);
        const float r = zr1 + (bf2f(lr[i]) * pmi - zr1) * mur, zk = zk1 + (bf2f(lk[i]) * pmi - zk1) * muk; vvv[i] = zv1 + (bf2f(lv[i]) * pmi - zv1) * muv;
        const float a = __builtin_amdgcn_rcpf(1.0f + __expf(-(a0c + bf2f(lla[i])))); const float k = zk * (1.0f + (a - 1.0f) * kac);
        y[i] = Yl[(wave * 8 + i) * 65 + lane]; s1[i] = y[i]; s3[i] = r * k * rkc; }
#pragma unroll
    for (int o = 1; o < 64; o <<= 1) {
#pragma unroll
        for (int i = 0; i < 8; ++i) { s1[i] += __shfl_xor(s1[i], o); s3[i] += __shfl_xor(s3[i], o); } }
#pragma unroll
    for (int i = 0; i < 8; ++i) { y[i] -= s1[i] * (1.f / 64.f); s2[i] = y[i] * y[i]; }
#pragma unroll
    for (int o = 1; o < 64; o <<= 1) {
#pragma unroll
        for (int i = 0; i < 8; ++i) s2[i] += __shfl_xor(s2[i], o); }
#pragma unroll
    for (int i = 0; i < 8; ++i) { const size_t tok = tok0 + wave * 8 + i; const float yn = y[i] * rsqrtf(s2[i] * (1.f / 64.f) + 64e-5f) * lnw + lnb;
        AO[tok * DM + 512 + cc] = (bf16_t)f2bf((yn + s3[i] * vvv[i]) * bf2f(llg[i])); }
}

constexpr size_t WS_W2T = 29 * MiB, WS_A2T = 29 * MiB + 65536, WS_G2T = 29 * MiB + 131072;
__device__ __forceinline__ bf16x8 act8(const bf16_t* zc, const bf16_t* zpv, float pmask, const float* mu, int mode) {
    const u32x4 c = *(const u32x4*)zc, p = *(const u32x4*)zpv;
    const f32x4 m0 = *(const f32x4*)mu, m1 = *(const f32x4*)(mu + 4);
    const unsigned cw[4] = {c.x, c.y, c.z, c.w}, pw[4] = {p.x, p.y, p.z, p.w}; const float um[8] = {m0[0], m0[1], m0[2], m0[3], m1[0], m1[1], m1[2], m1[3]}; float v[8];
#pragma unroll
    for (int j = 0; j < 4; ++j) { const float c0 = bflo(cw[j]), c1 = bfhi(cw[j]), p0 = bflo(pw[j]) * pmask, p1 = bfhi(pw[j]) * pmask;
        v[2 * j] = c0 + (p0 - c0) * um[2 * j]; v[2 * j + 1] = c1 + (p1 - c1) * um[2 * j + 1]; }
#pragma unroll
    for (int j = 0; j < 8; ++j) { if (mode == 0) { const float e = __expf(-2.0f * fabsf(v[j])); const float th = (1.0f - e) * __builtin_amdgcn_rcpf(1.0f + e); v[j] = v[j] < 0.f ? -th : th; } else if (mode == 2) v[j] = __builtin_amdgcn_rcpf(1.0f + __expf(-v[j])); }
    u32x4 w; w.x = pk2(v[0], v[1]); w.y = pk2(v[2], v[3]); w.z = pk2(v[4], v[5]); w.w = pk2(v[6], v[7]);
    return __builtin_bit_cast(bf16x8, w);
}
__device__ __forceinline__ void lora_task(KPR P, int task, int lane) {
    const int r32 = lane & 31, hi = lane >> 5; const size_t row = (size_t)task * 32 + r32; const bool first = (row % SEQ) == 0;
    const bf16_t* Z = (const bf16_t*)(P.ws + WS_Z) + row * ZW + ZR + 8 * hi; const bf16_t* Zp = first ? Z : Z - ZW; const float pmask = first ? 0.f : 1.f;
    const float* mub = P.mu + 8 * hi;
    bf16x8 xw[4], xa[4], xg[8];
#pragma unroll
    for (int ks = 0; ks < 4; ++ks) { xw[ks] = act8(Z + RW_W + 16 * ks, Zp + RW_W + 16 * ks, pmask, mub + RW_W + 16 * ks, 0); xa[ks] = act8(Z + RW_A + 16 * ks, Zp + RW_A + 16 * ks, pmask, mub + RW_A + 16 * ks, 1); asm volatile("" ::: "memory"); }
#pragma unroll
    for (int ks = 0; ks < 8; ++ks) { xg[ks] = act8(Z + RW_G + 16 * ks, Zp + RW_G + 16 * ks, pmask, mub + RW_G + 16 * ks, 2); if (ks & 1) asm volatile("" ::: "memory"); }
    const bf16_t* W2T = (const bf16_t*)(P.ws + WS_W2T) + r32 * 64 + 8 * hi; const bf16_t* A2T = (const bf16_t*)(P.ws + WS_A2T) + r32 * 64 + 8 * hi; const bf16_t* G2T = (const bf16_t*)(P.ws + WS_G2T) + r32 * 128 + 8 * hi;
    bf16_t* LW = (bf16_t*)(P.ws + WS_LW) + row * 512 + 4 * hi; bf16_t* LA = (bf16_t*)(P.ws + WS_LA) + row * 512 + 4 * hi; bf16_t* LG = (bf16_t*)(P.ws + WS_LG) + row * 512 + 4 * hi;
#pragma nounroll
    for (int cb = 0; cb < 16; ++cb) {
        f32x16 dw = f32x16{}, da = f32x16{}, dg = f32x16{};
#pragma unroll
        for (int ks = 0; ks < 4; ++ks) { dw = __builtin_amdgcn_mfma_f32_32x32x16_bf16(*(const bf16x8*)(W2T + cb * 32 * 64 + 16 * ks), xw[ks], dw, 0, 0, 0); da = __builtin_amdgcn_mfma_f32_32x32x16_bf16(*(const bf16x8*)(A2T + cb * 32 * 64 + 16 * ks), xa[ks], da, 0, 0, 0); }
#pragma unroll
        for (int ks = 0; ks < 8; ++ks) dg = __builtin_amdgcn_mfma_f32_32x32x16_bf16(*(const bf16x8*)(G2T + cb * 32 * 128 + 16 * ks), xg[ks], dg, 0, 0, 0);
#pragma unroll
        for (int g = 0; g < 4; ++g) { u32x2 w; w.x = pk2(dw[4 * g], dw[4 * g + 1]); w.y = pk2(dw[4 * g + 2], dw[4 * g + 3]); *(u32x2*)(LW + cb * 32 + 8 * g) = w;
            w.x = pk2(da[4 * g], da[4 * g + 1]); w.y = pk2(da[4 * g + 2], da[4 * g + 3]); *(u32x2*)(LA + cb * 32 + 8 * g) = w;
            w.x = pk2(dg[4 * g], dg[4 * g + 1]); w.y = pk2(dg[4 * g + 2], dg[4 * g + 3]); *(u32x2*)(LG + cb * 32 + 8 * g) = w; }
    }
}
}
namespace rt {
__device__ __forceinline__ int woff(int e, int k) { return e * 2048 + ((((k >> 3) ^ (e & 15))) << 4) + (k & 7) * 2; }
constexpr size_t WS_WRI = 30 * MiB;
__device__ __forceinline__ void build_w(KPR P, int tid) {
    unsigned char* img = P.ws + WS_WRI; const int e = tid & 31, kq = tid >> 5;
    for (int i0 = 0; i0 < 64; i0 += 8) { float w[8];
#pragma unroll
        for (int i = 0; i < 8; ++i) { const int k = kq * 64 + i0 + i; w[i] = P.moe_norm[k] * P.w_router[k * 32 + e]; }
#pragma unroll
        for (int i = 0; i < 8; ++i) { const int k = kq * 64 + i0 + i; const unsigned h = f2bf(w[i]); const unsigned l = f2bf(w[i] - bf2f(h));
            *(unsigned short*)(img + woff(e, k)) = (unsigned short)h; *(unsigned short*)(img + 65536 + woff(e, k)) = (unsigned short)l; } }
}
__device__ __forceinline__ void copy_w(KPR P, LAS unsigned char* lds, int tid) {
    const u32x4* img = (const u32x4*)(P.ws + WS_WRI);
#pragma unroll 4
    for (int i = 0; i < 16; ++i) *(LAS u32x4*)(lds + (size_t)(i * 512 + tid) * 16) = img[i * 512 + tid];
}
__device__ __forceinline__ void split8(const f32x4& a, const f32x4& b, bf16x8& h, bf16x8& l) {
    unsigned hh[8]; float v[8] = {a[0], a[1], a[2], a[3], b[0], b[1], b[2], b[3]};
#pragma unroll
    for (int j = 0; j < 8; ++j) hh[j] = f2bf(v[j]);
    u32x4 hw, lw;
    hw.x = hh[0] | (hh[1] << 16); hw.y = hh[2] | (hh[3] << 16); hw.z = hh[4] | (hh[5] << 16); hw.w = hh[6] | (hh[7] << 16);
    lw.x = pk2(v[0] - bf2f(hh[0]), v[1] - bf2f(hh[1])); lw.y = pk2(v[2] - bf2f(hh[2]), v[3] - bf2f(hh[3])); lw.z = pk2(v[4] - bf2f(hh[4]), v[5] - bf2f(hh[5])); lw.w = pk2(v[6] - bf2f(hh[6]), v[7] - bf2f(hh[7]));
    h = __builtin_bit_cast(bf16x8, hw); l = __builtin_bit_cast(bf16x8, lw);
}
__device__ __forceinline__ void route_task(KPR P, const LAS unsigned char* wlds, int task, int lane) {
    const int r32 = lane & 31, hi = lane >> 5; const int row = task * 32 + r32;
    const float* xrow = (const float*)(P.ws + WS_X1) + (size_t)row * DM + 8 * hi;
    f32x16 acc = f32x16{}; float ss = 0.f;
    f32x4 xa[4], xb[4];
#pragma unroll
    for (int j = 0; j < 4; ++j) { xa[j] = *(const f32x4*)(xrow + 16 * j); xb[j] = *(const f32x4*)(xrow + 16 * j + 4); }
    for (int ks0 = 0; ks0 < 64; ks0 += 4) {
#pragma unroll
        for (int j = 0; j < 4; ++j) { const int ks = ks0 + j; const f32x4 a = xa[j], b = xb[j];
            const int kn = (ks + 4 < 64) ? ks + 4 : ks; xa[j] = *(const f32x4*)(xrow + 16 * kn); xb[j] = *(const f32x4*)(xrow + 16 * kn + 4);
            ss += (a[0] * a[0] + a[1] * a[1]) + (a[2] * a[2] + a[3] * a[3]) + (b[0] * b[0] + b[1] * b[1]) + (b[2] * b[2] + b[3] * b[3]);
            bf16x8 xh, xl; split8(a, b, xh, xl);
            const bf16x8 wh = *(const LAS bf16x8*)(wlds + woff(r32, 16 * ks + 8 * hi)), wl = *(const LAS bf16x8*)(wlds + 65536 + woff(r32, 16 * ks + 8 * hi));
            acc = __builtin_amdgcn_mfma_f32_32x32x16_bf16(wh, xh, acc, 0, 0, 0); acc = __builtin_amdgcn_mfma_f32_32x32x16_bf16(wh, xl, acc, 0, 0, 0); acc = __builtin_amdgcn_mfma_f32_32x32x16_bf16(wl, xh, acc, 0, 0, 0); }
    }
    ss += __shfl_xor(ss, 32);
    const float rstd = rsqrtf(ss * (1.f / DM) + 1e-6f);
    float lg[16];
#pragma unroll
    for (int g = 0; g < 4; ++g) { const f32x4 bb = *(const f32x4*)(P.b_router + 8 * g + 4 * hi);
#pragma unroll
        for (int i = 0; i < 4; ++i) lg[4 * g + i] = acc[4 * g + i] * rstd + bb[i]; }
    float tv[4]; int ti[4];
#pragma unroll
    for (int k = 0; k < 4; ++k) { float bv = lg[0]; int bi = 4 * hi;
#pragma unroll
        for (int r = 1; r < 16; ++r) { const int e = (r & 3) + 8 * (r >> 2) + 4 * hi; if (lg[r] > bv) { bv = lg[r]; bi = e; } }
        const float pv = __shfl_xor(bv, 32); const int pi = __shfl_xor(bi, 32);
        if (pv > bv || (pv == bv && pi < bi)) { bv = pv; bi = pi; }
        tv[k] = bv; ti[k] = bi;
#pragma unroll
        for (int r = 0; r < 16; ++r) { const int e = (r & 3) + 8 * (r >> 2) + 4 * hi; if (e == bi) lg[r] = -INFINITY; } }
    const float e1 = __expf(tv[1] - tv[0]), e2 = __expf(tv[2] - tv[0]), e3 = __expf(tv[3] - tv[0]), inv = 1.f / (1.f + e1 + e2 + e3);
    const int c0 = hi ? ti[2] : ti[0], c1 = hi ? ti[3] : ti[1]; const float g0 = (hi ? e2 : 1.f) * inv, g1 = (hi ? e3 : e1) * inv;
    const unsigned long long ltm = (1ull << lane) - 1ull; int mycnt = 0, rk0 = 0, rk1 = 0;
    for (int e = 0; e < 32; ++e) { const unsigned long long m0 = __ballot(c0 == e), m1 = __ballot(c1 == e); const int n0 = __popcll(m0);
        if (lane == e) mycnt = n0 + __popcll(m1);
        if (c0 == e) rk0 = __popcll(m0 & ltm);
        if (c1 == e) rk1 = n0 + __popcll(m1 & ltm); }
    unsigned* cnt = (unsigned*)(P.ws + WS_CTL) + CW_CNT; int base = 0;
    if (lane < 32 && mycnt > 0) base = (int)atomicAdd(cnt + lane, (unsigned)mycnt);
    rk0 += __shfl(base, c0); rk1 += __shfl(base, c1);
    int* route = (int*)(P.ws + WS_ROUTE); int* tokslot = (int*)(P.ws + WS_TOKSLOT); float* gateslot = (float*)(P.ws + WS_GATESLOT);
    tokslot[(size_t)c0 * NTOK + rk0] = row; gateslot[(size_t)c0 * NTOK + rk0] = g0; tokslot[(size_t)c1 * NTOK + rk1] = row; gateslot[(size_t)c1 * NTOK + rk1] = g1;
    route[(size_t)row * 12 + 2 * hi] = c0; route[(size_t)row * 12 + 2 * hi + 1] = c1; route[(size_t)row * 12 + 4 + 2 * hi] = rk0; route[(size_t)row * 12 + 4 + 2 * hi + 1] = rk1;
    unsigned char* xn = P.ws + WS_XN + (size_t)row * DM + 8 * hi; const float* gn = P.moe_norm + 8 * hi;
#pragma unroll
    for (int j = 0; j < 4; ++j) { xa[j] = *(const f32x4*)(xrow + 16 * j); xb[j] = *(const f32x4*)(xrow + 16 * j + 4); }
    for (int ks0 = 0; ks0 < 64; ks0 += 4) {
#pragma unroll
        for (int j = 0; j < 4; ++j) { const int ks = ks0 + j; const f32x4 a = xa[j], b = xb[j], ga = *(const f32x4*)(gn + 16 * ks), gb = *(const f32x4*)(gn + 16 * ks + 4);
            const int kn = (ks + 4 < 64) ? ks + 4 : ks; xa[j] = *(const f32x4*)(xrow + 16 * kn); xb[j] = *(const f32x4*)(xrow + 16 * kn + 4);
            u32x2 w; w.x = pk4_fp8(a[0] * rstd * ga[0], a[1] * rstd * ga[1], a[2] * rstd * ga[2], a[3] * rstd * ga[3]); w.y = pk4_fp8(b[0] * rstd * gb[0], b[1] * rstd * gb[1], b[2] * rstd * gb[2], b[3] * rstd * gb[3]);
            *(u32x2*)(xn + 16 * ks) = w; }
    }
}
}
namespace attn_body {
using bf16=unsigned short;
using bf16x8=__attribute__((ext_vector_type(8)))short;
using s16x4=__attribute__((ext_vector_type(4)))short;
using f32x16=__attribute__((ext_vector_type(16)))float;
using u32x4=__attribute__((ext_vector_type(4)))unsigned;
constexpr int BATCH=4,NHEAD=8,SEQ=8192,D=64,DM=3840,OP=1024;
constexpr int NW=8,QBLK=32,QB=QBLK*NW,KVBLK=64,NQB=SEQ/QB;
constexpr int ATTN_PITCH=DM, ATTN_UNIT_ROWS=QB;
__device__ __forceinline__ int crow(int r,int hi){return (r&3)+8*(r>>2)+4*hi;}
#define SBAR() __builtin_amdgcn_sched_barrier(0)
__device__ __forceinline__ void cmask(f32x16&p0,f32x16&p1,int jb,int qrel,int hi){
  const float NEG=-INFINITY; int kb=64*jb+4*hi;
  #pragma unroll
  for(int r=0;r<16;++r){int kv=kb+(r&3)+8*(r>>2); if(kv>qrel)p0[r]=NEG; if(kv+32>qrel)p1[r]=NEG;}
}

constexpr int NSLOT=3, SLOTB=8192;
constexpr int LDS_K=0, LDS_V=NSLOT*SLOTB, LDS_WS=2*NSLOT*SLOTB, LDS_OST=LDS_WS+NW*64*4, LDS_C2=LDS_OST+NW*4096, LDS_BYTES=LDS_C2+SEQ*4;
constexpr float C2=0.125f*1.4426950408889634f;
__device__ __forceinline__ void glds16(const void*gsrc,unsigned lds_dst){unsigned keep;
  asm volatile("s_mov_b32 %0, m0\n\ts_mov_b32 m0, %2\n\ts_nop 0\n\tglobal_load_lds_dwordx4 %1, off\n\ts_mov_b32 m0, %0":"=&s"(keep):"v"(gsrc),"s"(lds_dst):"memory");}
__device__ __forceinline__ float max3f(float a,float b,float c){float r;asm("v_max3_f32 %0, %1, %2, %3":"=v"(r):"v"(a),"v"(b),"v"(c));return r;}
__device__ __forceinline__ float max2f(float a,float b){float r;asm("v_max_f32_e32 %0, %1, %2":"=v"(r):"v"(a),"v"(b));return r;}
__device__ __forceinline__ float fadd_s(float a,float b){float r;asm("v_add_f32_e32 %0, %1, %2":"=v"(r):"v"(a),"v"(b));return r;}
__device__ __forceinline__ float fsub_s(float a,float b){float r;asm("v_sub_f32_e32 %0, %1, %2":"=v"(r):"v"(a),"v"(b));return r;}
typedef float f32x2_t __attribute__((ext_vector_type(2))); typedef float f32x4v __attribute__((ext_vector_type(4))); typedef __bf16 bf16x2_t __attribute__((ext_vector_type(2)));
__device__ __forceinline__ unsigned cvtpk_s(float lo,float hi){f32x2_t v={lo,hi};bf16x2_t b=__builtin_convertvector(v,bf16x2_t);return __builtin_bit_cast(unsigned,b);}
#define WAIT_BAR(N) asm volatile("s_waitcnt vmcnt(" #N ") lgkmcnt(0)\n\ts_barrier":::"memory")

__device__ __forceinline__ void qkt(f32x16&p0,f32x16&p1,const char*Kslot,const bf16x8*qr,int r32,int hi){
  const char*kb=Kslot+hi*1024+r32*16;
  #pragma unroll
  for(int d0=0;d0<4;++d0){
    const bf16x8 b0=*reinterpret_cast<const bf16x8*>(kb+d0*2048);
    const bf16x8 b1=*reinterpret_cast<const bf16x8*>(kb+d0*2048+512);
    p0=__builtin_amdgcn_mfma_f32_32x32x16_bf16(b0,qr[d0],p0,0,0,0);p1=__builtin_amdgcn_mfma_f32_32x32x16_bf16(b1,qr[d0],p1,0,0,0);}
}
typedef __attribute__((address_space(3))) const char* lds_cptr;
typedef short v4i16_t __attribute__((ext_vector_type(4)));
__device__ __forceinline__ void kload8(bf16x8*kf,lds_cptr kp){
  kf[0]=*(const __attribute__((address_space(3))) bf16x8*)(kp);      kf[1]=*(const __attribute__((address_space(3))) bf16x8*)(kp+512);
  kf[2]=*(const __attribute__((address_space(3))) bf16x8*)(kp+2048); kf[3]=*(const __attribute__((address_space(3))) bf16x8*)(kp+2560);
  kf[4]=*(const __attribute__((address_space(3))) bf16x8*)(kp+4096); kf[5]=*(const __attribute__((address_space(3))) bf16x8*)(kp+4608);
  kf[6]=*(const __attribute__((address_space(3))) bf16x8*)(kp+6144); kf[7]=*(const __attribute__((address_space(3))) bf16x8*)(kp+6656);
}
__device__ __forceinline__ void kload2(bf16x8*kf,lds_cptr kp,int j){ kf[2*j]=*(const __attribute__((address_space(3))) bf16x8*)(kp+j*2048); kf[2*j+1]=*(const __attribute__((address_space(3))) bf16x8*)(kp+j*2048+512); }
__device__ __forceinline__ s16x4 vtr(lds_cptr p){ return __builtin_bit_cast(s16x4,__builtin_amdgcn_ds_read_tr16_b64_v4i16((__attribute__((address_space(3))) v4i16_t*)p)); }
__device__ __forceinline__ float rowmax(const f32x16&p0,const f32x16&p1){
  float a=max3f(p0[0],p0[1],p1[0]),b=max3f(p0[2],p0[3],p1[1]);a=max3f(a,p1[2],p1[3]);
  #pragma unroll
  for(int r=4;r<16;r+=4){a=max3f(a,p0[r],p0[r+1]);b=max3f(b,p0[r+2],p0[r+3]);a=max3f(a,p1[r],p1[r+1]);b=max3f(b,p1[r+2],p1[r+3]);}
  const float m=max2f(a,b);
  auto rr=__builtin_amdgcn_permlane32_swap(__float_as_uint(m),__float_as_uint(m),false,false);
  return max2f(__uint_as_float(rr[0]),__uint_as_float(rr[1]));
}
__device__ __forceinline__ void pv(f32x16*o,int vb,bf16x8 pa0,bf16x8 pa1,bf16x8 pa2,bf16x8 pa3){
  #pragma unroll
  for(int d0=0;d0<2;++d0){s16x4 lo[4],hi[4];
    #pragma unroll
    for(int ks=0;ks<4;++ks){
      asm volatile("ds_read_b64_tr_b16 %0,%1 offset:%c2":"=&v"(lo[ks]):"v"(vb),"i"(d0*4096+ks*1024):"memory");
      asm volatile("ds_read_b64_tr_b16 %0,%1 offset:%c2":"=&v"(hi[ks]):"v"(vb),"i"(d0*4096+ks*1024+512):"memory");}
    asm volatile("s_waitcnt lgkmcnt(0)":::"memory");SBAR();
    #define PK(k) (bf16x8){lo[k][0],lo[k][1],lo[k][2],lo[k][3],hi[k][0],hi[k][1],hi[k][2],hi[k][3]}
    o[d0]=__builtin_amdgcn_mfma_f32_32x32x16_bf16(pa0,PK(0),o[d0],0,0,0);
    o[d0]=__builtin_amdgcn_mfma_f32_32x32x16_bf16(pa1,PK(1),o[d0],0,0,0);
    o[d0]=__builtin_amdgcn_mfma_f32_32x32x16_bf16(pa2,PK(2),o[d0],0,0,0);
    o[d0]=__builtin_amdgcn_mfma_f32_32x32x16_bf16(pa3,PK(3),o[d0],0,0,0);
    #undef PK
  }
}

#ifndef ATTN_STORE16
#define ATTN_STORE16(p,v) (*(u32x4*)(p)=(v))
#endif
template<int THRL> __device__ __forceinline__ void attn_unit(int b,int h,int qb,int t0,const bf16*Z,const float*c2g,bf16*O,char*shm){
  const int tid=threadIdx.x,lane=tid&63,r32=lane&31,hi=lane>>5; const int wid=__builtin_amdgcn_readfirstlane(tid>>6);
  const long rowbase=(long)b*SEQ; const int q0=qb*QB;
  const bf16*Qw=Z+(rowbase+q0+wid*QBLK)*DM+h*D;
  const bf16*Kh=Z+(rowbase+(long)t0*KVBLK)*DM+512+h*D,*Vh=Z+(rowbase+(long)t0*KVBLK)*DM+1024+h*D;
  const unsigned lds0=(unsigned)(uintptr_t)shm;
  float*wsf=(float*)(shm+LDS_WS)+wid*64;
  const bf16*ksrc=Kh+(long)lane*DM+wid*8;
  const bf16*vsrc=Vh+(long)(16*(wid&3)+(lane>>2))*DM+(wid>>2)*32+(lane&3)*8;
  const unsigned kdst=lds0+LDS_K+wid*1024, vdst=lds0+LDS_V+wid*1024;
  #define DMA_K(t,slot) glds16(ksrc+(long)(t)*KVBLK*DM,(unsigned)__builtin_amdgcn_readfirstlane(kdst+(slot)))
  #define DMA_V(t,slot) glds16(vsrc+(long)(t)*KVBLK*DM,(unsigned)__builtin_amdgcn_readfirstlane(vdst+(slot)))
  const int vb0=(int)(lds0+LDS_V)+((lane>>4)&1)*32+(lane&3)*8+(4*hi+((lane&15)>>2))*64;
  const char*Kbase=shm+LDS_K; bf16x8 kf[8];
  const lds_cptr shm3=(lds_cptr)shm; const lds_cptr kp0=shm3+LDS_K+hi*1024+r32*16; const lds_cptr vp0=shm3+LDS_V+((lane>>4)&1)*32+(lane&3)*8+(4*hi+((lane&15)>>2))*64;
  const int NT=(q0+QB)/KVBLK-t0;
  { const int np=(q0+QB)/256;
    for(int p=(t0>>2)+wid;p<np;p+=NW) glds16(c2g+p*256+lane*4,(unsigned)__builtin_amdgcn_readfirstlane(lds0+LDS_C2+p*1024)); }
  const __attribute__((address_space(3))) float* c2l=(const __attribute__((address_space(3))) float*)(shm3+LDS_C2)+t0*KVBLK+4*hi;
  DMA_K(0,0);DMA_V(0,0);DMA_K(1,SLOTB);
  bf16x8 qr[4];
  #pragma unroll
  for(int d0=0;d0<4;++d0)qr[d0]=*reinterpret_cast<const bf16x8*>(&Qw[(long)r32*DM+d0*16+hi*8]);
  float l_reg=0.f;f32x16 o[2];o[0]=f32x16{};o[1]=f32x16{};
  float base=c2g[q0+wid*QBLK+r32];
  const int qrel=wid*QBLK+r32;
  #define CMASK(P0,P1,t) do{int jb_=(t)-(NT-4); if(jb_>=0)cmask(P0,P1,jb_,qrel,hi);}while(0)
  bool resc=false;
  #define START(P0,P1) do{ const float rm=rowmax(P0,P1); resc=false; \
    { const float dl=rm; base=fsub_s(base,dl); \
      _Pragma("unroll") for(int r=0;r<16;++r){P0[r]=fsub_s(P0[r],dl);P1[r]=fsub_s(P1[r],dl);} } \
    _Pragma("unroll") for(int r=0;r<16;++r)P0[r]=__builtin_amdgcn_exp2f(P0[r]); }while(0)
  #define RESC() do{ if(resc){ asm volatile("s_waitcnt lgkmcnt(0)":::"memory"); \
      _Pragma("unroll") for(int d_=0;d_<2;++d_) _Pragma("unroll") for(int r=0;r<16;++r)o[d_][r]*=wsf[crow(r,hi)]; } }while(0)
  f32x16 pA0,pA1,pB0,pB1;
  #define BIASLD(P0,P1,tt) do{ _Pragma("unroll") for(int g_=0;g_<4;++g_){ const f32x4v x0_=*(const __attribute__((address_space(3))) f32x4v*)(c2l+(tt)*KVBLK+8*g_), x1_=*(const __attribute__((address_space(3))) f32x4v*)(c2l+(tt)*KVBLK+32+8*g_); \
      P0[4*g_]=x0_[0];P0[4*g_+1]=x0_[1];P0[4*g_+2]=x0_[2];P0[4*g_+3]=x0_[3]; P1[4*g_]=x1_[0];P1[4*g_+1]=x1_[1];P1[4*g_+2]=x1_[2];P1[4*g_+3]=x1_[3]; } }while(0)
  #define BIASFIX(P0,P1) do{ _Pragma("unroll") for(int r=0;r<16;++r){P0[r]=fsub_s(base,P0[r]);P1[r]=fsub_s(base,P1[r]);} }while(0)
  int sl_prev=0,sl_cur=0,sl_next=SLOTB;
  #define ROT() do{sl_prev=sl_cur;sl_cur=sl_next;sl_next=(sl_next==(NSLOT-1)*SLOTB)?0:sl_next+SLOTB;}while(0)
  DMA_K(2,2*SLOTB);
  WAIT_BAR(3);
  BIASLD(pA0,pA1,0); BIASFIX(pA0,pA1);
  qkt(pA0,pA1,Kbase,qr,r32,hi);asm volatile("s_nop 15\n\ts_nop 7":"+v"(pA0),"+v"(pA1));CMASK(pA0,pA1,0);
  START(pA0,pA1);
  _Pragma("unroll") for(int r=0;r<16;++r)pA1[r]=__builtin_amdgcn_exp2f(pA1[r]);
  BIASLD(pB0,pB1,1);
  WAIT_BAR(0);
  DMA_K(3,0);DMA_V(1,SLOTB);
  ROT();
  kload8(kf,kp0+sl_cur);
  WAIT_BAR(2);
  s16x4 vlo[8],vhi[8]; u32x4 pw0,pw1,pw2,pw3;
  #define PKW(P,B) cvtpk_s(P[B],P[B+1])
  #define PAF(k) __builtin_bit_cast(bf16x8,pw##k)
  #define VFR(i) (bf16x8){vlo[i][0],vlo[i][1],vlo[i][2],vlo[i][3],vhi[i][0],vhi[i][1],vhi[i][2],vhi[i][3]}
  #define PIN(x) asm volatile("":"+v"(x))
  #define MX3(a,b,c) __builtin_fmaxf(__builtin_fmaxf((a),(b)),(c))
  #define GAPA(MF,A0,A1,A2,A3,W0,W1,PW) do{ MF; sacc+=A0; sacc+=A1; sacc+=A2; sacc+=A3; PIN(sacc); W0; W1; PIN(PW); SBAR(); }while(0)
  #define EX(v) __builtin_amdgcn_exp2f(v)
  #define GAPB(MF,X,B) do{ MF; X[B]=EX(X[B]); X[B+1]=EX(X[B+1]); X[B+2]=EX(X[B+2]); X[B+3]=EX(X[B+3]); PIN(X); SBAR(); }while(0)
  #define VRD(i) do{ vlo[i]=vtr(vp_+(((i)>>2)*4096+((i)&3)*1024)); vhi[i]=vtr(vp_+(((i)>>2)*4096+((i)&3)*1024+512)); }while(0)
  #define KRD(G,j) do{ if(G){ kload2(kf,kp0+sl_next,j); SBAR(); } }while(0)
  #define STEP(C0,C1,P0,P1,t,GK,GV,GL) do{ SBAR(); \
    BIASFIX(C0,C1); SBAR(); \
    const lds_cptr vp_=vp0+sl_prev; \
    VRD(0); SBAR(); float sacc=(P0[0]+P0[1]); \
    GAPA(C0=__builtin_amdgcn_mfma_f32_32x32x16_bf16(kf[0],qr[0],C0,0,0,0), P0[2],P0[3],P0[4],P0[5],     pw0[0]=PKW(P0,0), pw0[1]=PKW(P0,2), pw0); \
    VRD(4); SBAR(); GAPA(C1=__builtin_amdgcn_mfma_f32_32x32x16_bf16(kf[1],qr[0],C1,0,0,0), P0[6],P0[7],P0[8],P0[9],     pw0[2]=PKW(P0,4), pw0[3]=PKW(P0,6), pw0); \
    VRD(1); SBAR(); GAPA(C0=__builtin_amdgcn_mfma_f32_32x32x16_bf16(kf[2],qr[1],C0,0,0,0),   P0[10],P0[11],P0[12],P0[13], pw1[0]=PKW(P0,8), pw1[1]=PKW(P0,10), pw1); \
    VRD(5); SBAR(); GAPA(C1=__builtin_amdgcn_mfma_f32_32x32x16_bf16(kf[3],qr[1],C1,0,0,0),   P0[14],P0[15],P1[0],P1[1],   pw1[2]=PKW(P0,12),pw1[3]=PKW(P0,14), pw1); \
    VRD(2); SBAR(); GAPA(C0=__builtin_amdgcn_mfma_f32_32x32x16_bf16(kf[4],qr[2],C0,0,0,0),   P1[2],P1[3],P1[4],P1[5],     pw2[0]=PKW(P1,0), pw2[1]=PKW(P1,2), pw2); \
    VRD(6); SBAR(); GAPA(C1=__builtin_amdgcn_mfma_f32_32x32x16_bf16(kf[5],qr[2],C1,0,0,0),   P1[6],P1[7],P1[8],P1[9],     pw2[2]=PKW(P1,4), pw2[3]=PKW(P1,6), pw2); \
    VRD(3); SBAR(); GAPA(C0=__builtin_amdgcn_mfma_f32_32x32x16_bf16(kf[6],qr[3],C0,0,0,0),   P1[10],P1[11],P1[12],P1[13], pw3[0]=PKW(P1,8), pw3[1]=PKW(P1,10), pw3); \
    VRD(7); SBAR(); GAPA(C1=__builtin_amdgcn_mfma_f32_32x32x16_bf16(kf[7],qr[3],C1,0,0,0),   P1[14],P1[15],0.f,0.f,       pw3[2]=PKW(P1,12),pw3[3]=PKW(P1,14), pw3); \
    l_reg+=sacc; \
    if(GL){BIASLD(P0,P1,(t)+1);} \
    if(GK){DMA_K((t)+3,sl_cur);} if(GV){DMA_V((t)+1,sl_next);} \
    CMASK(C0,C1,t); \
    { float a=MX3(C0[0],C0[1],C1[0]),b=MX3(C0[2],C0[3],C1[1]); a=MX3(a,C1[2],C1[3]); \
      _Pragma("unroll") for(int r=4;r<16;r+=4){a=MX3(a,C0[r],C0[r+1]);b=MX3(b,C0[r+2],C0[r+3]);a=MX3(a,C1[r],C1[r+1]);b=MX3(b,C1[r+2],C1[r+3]);} \
      float rm=__builtin_fmaxf(a,b); { auto rr=__builtin_amdgcn_permlane32_swap(__float_as_uint(rm),__float_as_uint(rm),false,false); rm=__builtin_fmaxf(__uint_as_float(rr[0]),__uint_as_float(rr[1])); } \
      resc=false; \
      if(__builtin_expect(__any(rm>(float)THRL),0)){ const float dl=__builtin_fmaxf(rm,0.f); base-=dl; \
        _Pragma("unroll") for(int r=0;r<16;++r){C0[r]-=dl;C1[r]-=dl;} \
        const float f=__builtin_amdgcn_exp2f(-dl); l_reg*=f; if(hi==0)wsf[r32]=f; resc=true; } } \
    SBAR(); \
    GAPB(o[0]=__builtin_amdgcn_mfma_f32_32x32x16_bf16(PAF(0),VFR(0),o[0],0,0,0), C0,0); \
    GAPB(o[1]=__builtin_amdgcn_mfma_f32_32x32x16_bf16(PAF(0),VFR(4),o[1],0,0,0), C0,4); \
    KRD(GL,0); GAPB(o[0]=__builtin_amdgcn_mfma_f32_32x32x16_bf16(PAF(1),VFR(1),o[0],0,0,0), C0,8); \
    KRD(GL,1); GAPB(o[1]=__builtin_amdgcn_mfma_f32_32x32x16_bf16(PAF(1),VFR(5),o[1],0,0,0), C0,12); \
    KRD(GL,2); GAPB(o[0]=__builtin_amdgcn_mfma_f32_32x32x16_bf16(PAF(2),VFR(2),o[0],0,0,0), C1,0); \
    KRD(GL,3); GAPB(o[1]=__builtin_amdgcn_mfma_f32_32x32x16_bf16(PAF(2),VFR(6),o[1],0,0,0), C1,4); \
    GAPB(o[0]=__builtin_amdgcn_mfma_f32_32x32x16_bf16(PAF(3),VFR(3),o[0],0,0,0), C1,8); \
    GAPB(o[1]=__builtin_amdgcn_mfma_f32_32x32x16_bf16(PAF(3),VFR(7),o[1],0,0,0), C1,12); \
    }while(0)
  int t=1;
  #undef CMASK
  #define CMASK(P0,P1,t) do{}while(0)
  for(;t+5<NT;t+=2){
    STEP(pB0,pB1,pA0,pA1,t,true,true,true);     WAIT_BAR(2); RESC(); ROT();
    STEP(pA0,pA1,pB0,pB1,t+1,true,true,true);   WAIT_BAR(2); RESC(); ROT();
  }
  #undef CMASK
  #define CMASK(P0,P1,t) do{int jb_=(t)-(NT-4); if(jb_>=0)cmask(P0,P1,jb_,qrel,hi);}while(0)
  #define ENDW(tt) do{ if((tt)+3<NT){WAIT_BAR(2);} else if((tt)+2<NT){WAIT_BAR(1);} else {WAIT_BAR(0);} }while(0)
  for(;t+1<NT;t+=2){
    STEP(pB0,pB1,pA0,pA1,t,(t+3<NT),(t+1<NT),(t+1<NT));       ENDW(t);   RESC(); ROT();
    STEP(pA0,pA1,pB0,pB1,t+1,(t+4<NT),(t+2<NT),(t+2<NT));     ENDW(t+1); RESC(); ROT();
  }
  STEP(pB0,pB1,pA0,pA1,NT-1,false,false,false); RESC();
  { float sacc=pB0[0]+pB0[1]; _Pragma("unroll") for(int r=2;r<16;++r)sacc+=pB0[r]; _Pragma("unroll") for(int r=0;r<16;++r)sacc+=pB1[r]; l_reg+=sacc;
    pw0=(u32x4){PKW(pB0,0),PKW(pB0,2),PKW(pB0,4),PKW(pB0,6)};pw1=(u32x4){PKW(pB0,8),PKW(pB0,10),PKW(pB0,12),PKW(pB0,14)};pw2=(u32x4){PKW(pB1,0),PKW(pB1,2),PKW(pB1,4),PKW(pB1,6)};pw3=(u32x4){PKW(pB1,8),PKW(pB1,10),PKW(pB1,12),PKW(pB1,14)};
    SBAR(); pv(o,vb0+sl_cur,PAF(0),PAF(1),PAF(2),PAF(3)); }
  #undef PKW
  #undef PAF
  #undef VFR
  #undef PIN
  #undef MX3
  #undef GAPA
  #undef GAPB
  #undef EX
  #undef VRD
  #undef KRD
  #undef STEP
  #undef ENDW
  {auto rr=__builtin_amdgcn_permlane32_swap(__float_as_uint(l_reg),__float_as_uint(l_reg),false,false);l_reg=__uint_as_float(rr[0])+__uint_as_float(rr[1]);}
  if(hi==0)wsf[32+r32]=l_reg;asm volatile("s_waitcnt lgkmcnt(0)":::"memory");
  float rli[16];
  #pragma unroll
  for(int r=0;r<16;++r)rli[r]=__builtin_amdgcn_rcpf(wsf[32+crow(r,hi)]);
  bf16*Ow=O+(rowbase+q0+wid*QBLK)*OP+h*D; const bf16*Gw=Z+(rowbase+q0+wid*QBLK)*DM+1536+h*D;
  { bf16*stg=(bf16*)(shm+LDS_OST)+wid*2048;
    #pragma unroll
    for(int r=0;r<16;++r){const int orow=crow(r,hi);
      #pragma unroll
      for(int d0=0;d0<2;++d0)stg[orow*64+d0*32+r32]=(bf16)f2bf(o[d0][r]*rli[r]);}
    asm volatile("s_waitcnt lgkmcnt(0)":::"memory");
    #pragma unroll
    for(int i=0;i<4;++i){const int row=i*8+(lane>>3),ch=lane&7; const u32x4 v=*(const u32x4*)(stg+row*64+ch*8), g=*(const u32x4*)(Gw+(long)row*DM+ch*8);
      const unsigned vw[4]={v.x,v.y,v.z,v.w},gw[4]={g.x,g.y,g.z,g.w}; unsigned ow[4];
      #pragma unroll
      for(int j=0;j<4;++j){ const float a0=bflo(vw[j])*__builtin_amdgcn_rcpf(1.0f+__expf(-bflo(gw[j]))), a1=bfhi(vw[j])*__builtin_amdgcn_rcpf(1.0f+__expf(-bfhi(gw[j]))); ow[j]=cvtpk_s(a0,a1); }
      ATTN_STORE16(Ow+(long)row*OP+ch*8,((u32x4){ow[0],ow[1],ow[2],ow[3]}));} }
  asm volatile("s_waitcnt lgkmcnt(0)\n\ts_barrier":::"memory");
  #undef DMA_K
  #undef DMA_V
  #undef CMASK
  #undef START
  #undef RESC
  #undef ROT
}
constexpr int ATTN_LDS_BYTES=LDS_BYTES;
#undef SBAR
#undef WAIT_BAR
}
constexpr int CW_QATT = 128;
constexpr int MISC_TAB = 64, MISC_Q = 4096, MISC_PFX = 4160;

__device__ __forceinline__ int attn_t0(KPR P, const float* c2, int q0, int lane) {
    float gq = fabsf(P.q_norm[lane]), gk = fabsf(P.k_norm[lane]);
#pragma unroll
    for (int o = 1; o < 64; o <<= 1) { gq = fmaxf(gq, __shfl_xor(gq, o)); gk = fmaxf(gk, __shfl_xor(gk, o)); }
    const float thr = c2[q0] + (2.0f * 8.0f * LOG2E * gq * gk + 40.0f);
    const int nfull = q0 / 64; int t0 = 0;
    for (int tb = 0; tb < nfull; tb += 64) { const int tt = tb + lane; const bool sk = (tt < nfull) && (c2[tt * 64 + 63] > thr); const unsigned long long bm = __ballot(sk); t0 += __popcll(bm); if (bm != ~0ull) break; }
    return __builtin_amdgcn_readfirstlane(t0) & ~1;
}
__device__ __forceinline__ void combine_row(KPR P, const LAS int* tab, int row, int lane) {
    const int* route = (const int*)(P.ws + WS_ROUTE); const bf16_t* YP = (const bf16_t*)(P.ws + WS_YP); float* X = (float*)(P.ws + WS_X1);
    f32x4 v[4]; const f32x4* xr = (const f32x4*)(X + (size_t)row * DM) + lane;
#pragma unroll
    for (int j = 0; j < 4; ++j) v[j] = xr[64 * j];
#pragma unroll
    for (int k = 0; k < 4; ++k) { const int ex = route[(size_t)row * 12 + k], rank = route[(size_t)row * 12 + 4 + k]; const size_t pos = (size_t)tab[pg8::T_BLKSTART + ex] * 256 + rank;
        const u32x2* yr = (const u32x2*)(YP + pos * DM) + lane;
#pragma unroll
        for (int j = 0; j < 4; ++j) { const u32x2 y = yr[64 * j]; v[j][0] += bflo(y.x); v[j][1] += bfhi(y.x); v[j][2] += bflo(y.y); v[j][3] += bfhi(y.y); } }
    f32x4* xo = (f32x4*)(X + (size_t)row * DM) + lane; float s = 0.f;
#pragma unroll
    for (int j = 0; j < 4; ++j) { xo[64 * j] = v[j]; s += (v[j][0] * v[j][0] + v[j][1] * v[j][1]) + (v[j][2] * v[j][2] + v[j][3] * v[j][3]); }
    const float rstd = rsqrtf(wave_sum(s) * (1.f / DM) + 1e-6f);
#pragma unroll
    for (int j = 0; j < 4; ++j) v[j] = v[j] * rstd * ((const f32x4*)P.ple_norm)[64 * j + lane];
    store_row_fp8(P.ws + WS_XN + (size_t)row * DM, lane, v);
}

constexpr int NPHASE = 13;
__global__ void __launch_bounds__(NTHREADS, 2) mega_fwd(Params Pkarg_unused) {
    extern __shared__ __attribute__((aligned(16))) unsigned char smem[];
    LAS unsigned char* lds = (LAS unsigned char*)smem;
    const int tid = threadIdx.x, lane = tid & 63, wave = __builtin_amdgcn_readfirstlane(tid >> 6);
    const int G = gridDim.x, blk = blockIdx.x;
#define P (*kpp)
#ifndef MK_REP
#define MK_REP -1
#endif
#define PHASE_BEGIN(k) if (IN(k)) for (int rep_ = 0; rep_ < ((k) == MK_REP ? 2 : 1); ++rep_) { const __attribute__((address_space(4))) Params* kpp = kp_fresh();
#define PHASE_END(k) } if (BOTH(k)) xcd_barrier(bar);
#define IN(k) (ph_lo <= (k) && (k) < ph_hi)
#define BOTH(k) (IN(k) && IN((k) + 1))
    const __attribute__((address_space(4))) Params* kpp = kp_fresh();
    unsigned* ctl = (unsigned*)(P.ws + WS_CTL);
    volatile LAS unsigned* MISC = (volatile LAS unsigned*)(lds + MISC_OFF);
    LAS int* tab = (LAS int*)(lds + MISC_OFF + MISC_TAB);
    if (tid < 16) MISC[tid] = 0u;
    __syncthreads();
    XcdBarrier bar = xcd_barrier_post(ctl + CW_BAR, MISC);
    unsigned char* const wsb = P.ws;
    const int ph_lo = P.ph_lo, ph_hi = P.ph_hi;

    PHASE_BEGIN(0)
        phase_prep_weights(P, lds, blk * NWAVES + wave, G * NWAVES, wave, lane);
        phase_cvt_p(P, blk * NTHREADS + tid, G * NTHREADS);
        __syncthreads();
        LAS float* wff = (LAS float*)lds; LAS float* lf = (LAS float*)(lds + 32768);
        load_wff(P, wff, tid, NTHREADS); __syncthreads();
        for (int i = 0; i < 16; ++i) { const int rl = wave * 16 + i; norm1_row(P, blk * 128 + rl, lane, wff, lf + rl * 8); }
        __syncthreads();
        if (tid < 8) { float run = 0.f; float* cloc = (float*)(P.ws + WS_LOGF) + (size_t)blk * 128 * 8 + tid;
            for (int r = 0; r < 128; ++r) { run += lf[r * 8 + tid]; cloc[r * 8] = run; }
            ((float*)(P.ws + WS_CTOT))[blk * 8 + tid] = run; }
        if (blk == G - 1) rt::build_w(P, tid);
    PHASE_END(0)

    PHASE_BEGIN(1)
        {
            LAS float* pfx = (LAS float*)(lds + MISC_OFF + MISC_PFX);
            if (tid < 64) { const float* ct = (const float*)(wsb + WS_CTOT); const int j = (blk & ~63) + tid; float v8[8];
#pragma unroll
                for (int h = 0; h < 8; ++h) v8[h] = (j < blk) ? ct[j * 8 + h] : 0.f;
#pragma unroll
                for (int h = 0; h < 8; ++h) { const float s = wave_sum(v8[h]); if (tid == 0) pfx[h] = s; } }
            __syncthreads();
            const float* cloc = (const float*)(wsb + WS_LOGF) + (size_t)blk * 128 * 8; float* c2 = (float*)(P.ws + WS_C2);
            for (int i = tid; i < 1024; i += NTHREADS) { const int r = i >> 3, h = i & 7; const int row = blk * 128 + r, b = row >> 13, t = row & (SEQ - 1);
                c2[((size_t)(b * 8 + h)) * SEQ + t] = (cloc[i] + pfx[h]) * LOG2E; }
            __syncthreads();
        }
        {
            pg8::DenseOrder S{(const bf16_t*)(wsb + WS_XN), (const bf16_t*)(wsb + WS_WIN), 1024, NTOK / 256, ZW / 256, G, blk};
            pg8::EpiIn E{(bf16_t*)(P.ws + WS_Z), P.q_norm, P.k_norm};
            pg8::gemm_phase<pg8::EpiIn, pg8::DenseOrder, true>(lds, 1024, S, E);
        }
        {
            pg8::DenseOrder S{(const bf16_t*)((unsigned char*)P.out + DO_PB), (const bf16_t*)(wsb + WS_WPP), PLE, NTOK / 256, DM / 256, G / 2, blk >= G / 2 ? blk - G / 2 : (1 << 20)};
            pg8::EpiBf16 E{(bf16_t*)((unsigned char*)P.out + DO_PJ), DM};
            pg8::gemm_phase<pg8::EpiBf16, pg8::DenseOrder, true>(lds, PLE, S, E);
        }
    PHASE_END(1)

    PHASE_BEGIN(2)
        for (int task = wave * G + blk; task < NTOK / 32; task += NWAVES * G) rk::lora_task(P, task, lane);
    PHASE_END(2)

    PHASE_BEGIN(3)
        for (int task = blk; task < NB * NH * rk::NCHUNK; task += G) rk::pass1_chunk(P, lds, task >> 7, task & 127, tid);
    PHASE_END(3)

    PHASE_BEGIN(4)
        if (blk < NB * NH) rk::pass2_seq(P, lds, blk, tid);
        for (;;) {
            __syncthreads();
            if (tid == 0) MISC[MISC_Q / 4] = __hip_atomic_fetch_add(ctl + CW_QATT + 64 * rep_, 1u, RLX_AGENT);
            __syncthreads();
            const int q = (int)MISC[MISC_Q / 4];
            if (q >= 1024) break;
            { const int bh = q & 31, qb = 31 - (q >> 5); const float* c2 = (const float*)(wsb + WS_C2) + (size_t)bh * SEQ;
              const int t0 = attn_t0(P, c2, qb * 256, lane);
              attn_body::attn_unit<8>(bh >> 3, bh & 7, qb, t0, (const bf16_t*)(wsb + WS_Z), c2, (bf16_t*)(P.ws + WS_AO), (char*)smem); }
        }
    PHASE_END(4)

    PHASE_BEGIN(5)
        for (int task = blk; task < NB * NH * rk::NCHUNK; task += G) rk::pass3_chunk(P, lds, task >> 7, task & 127, tid);
    PHASE_END(5)

    PHASE_BEGIN(6)
        pg8::DenseOrder S{(const bf16_t*)(wsb + WS_AO), (const bf16_t*)(wsb + WS_WOUT), 1024, NTOK / 256, DM / 256, G, blk};
        pg8::EpiOut E{P.x, (float*)(P.ws + WS_X1)};
        pg8::gemm_phase<pg8::EpiOut, pg8::DenseOrder, true>(lds, 1024, S, E);
    PHASE_END(6)

    PHASE_BEGIN(7)
        rt::copy_w(P, lds, tid);
        if (blk == 0 && tid < 256) ((unsigned*)(P.ws + WS_XN + (size_t)NTOK * DM))[tid] = 0u;
        __syncthreads();
        for (int task = wave * G + blk; task < NTOK / 32; task += NWAVES * G) rt::route_task(P, lds, task, lane);
    PHASE_END(7)

    PHASE_BEGIN(8)
        const int nblk = pg8::moe_tables(tab, (const unsigned*)(wsb + WS_CTL) + CW_CNT);
        pg8::MoeOrder S{wsb + WS_XN, wsb + WS_WGU, (const int*)(wsb + WS_TOKSLOT), (const float*)(wsb + WS_GATESLOT), tab, nblk, 8, G, blk, true};
        pg8::EpiGu E{P.ws + WS_ACT, P.b_gu};
        pg8::gemm_phase<pg8::EpiGu, pg8::MoeOrder, true, true>(lds, 1024, S, E);
    PHASE_END(8)
    PHASE_BEGIN(9)
        const int nblk = pg8::moe_tables(tab, (const unsigned*)(wsb + WS_CTL) + CW_CNT);
        pg8::MoeOrder S{wsb + WS_ACT, wsb + WS_WDN, (const int*)(wsb + WS_TOKSLOT), (const float*)(wsb + WS_GATESLOT), tab, nblk, 4, G, blk, false};
        pg8::EpiDn E{(bf16_t*)(P.ws + WS_YP), P.b_down, (const float*)(wsb + WS_GATESLOT), tab};
        pg8::gemm_phase<pg8::EpiDn, pg8::MoeOrder, true, true>(lds, 1024, S, E);
    PHASE_END(9)
    PHASE_BEGIN(10)
        (void)pg8::moe_tables(tab, (const unsigned*)(wsb + WS_CTL) + CW_CNT);
        for (int row = blk * NWAVES + wave; row < NTOK; row += G * NWAVES) combine_row(P, tab, row, lane);
    PHASE_END(10)
    PHASE_BEGIN(11)
        pg8::DenseOrder S{wsb + WS_XN, wsb + WS_WPG, 512, NTOK / 256, DM / 256, G, blk};
        pg8::EpiPg E{(float*)(P.ws + WS_X1), (const bf16_t*)((unsigned char*)P.out + DO_PJ)};
        pg8::gemm_phase<pg8::EpiPg, pg8::DenseOrder, true, true>(lds, 1024, S, E);
    PHASE_END(11)
    PHASE_BEGIN(12)
        const bool dead = __hip_atomic_load(ctl + CW_BAR + XB_TMO, RLX_AGENT) != 0u;
        for (int row = blk * NWAVES + wave; row < NTOK; row += G * NWAVES) final_row(P, row, lane, dead);
    PHASE_END(12)
}
#undef P
extern "C" void kernel_launch(void* const* d_in, const int* in_sizes, int n_in, void* d_out, int out_size, void* d_ws, size_t ws_size, hipStream_t stream) {
    static int ok = 0;
    if (ok == 0) {
        if (n_in != 30 || in_sizes[0] != NTOK * DM || out_size != NTOK * DM || ws_size < WS_END) { fprintf(stderr, "kernel_launch: unexpected shapes (n_in %d, ws %zu)\n", n_in, ws_size); ok = -1; return; }
        if (hipFuncSetAttribute((const void*)mega_fwd, hipFuncAttributeMaxDynamicSharedMemorySize, LDS_BYTES) != hipSuccess) { fprintf(stderr, "kernel_launch: hipFuncSetAttribute failed\n"); ok = -1; return; }
        int dev = 0, cus = 0, per_cu = 0;
        if (hipGetDevice(&dev) != hipSuccess || hipDeviceGetAttribute(&cus, hipDeviceAttributeMultiprocessorCount, dev) != hipSuccess) { ok = -1; return; }
        if (hipOccupancyMaxActiveBlocksPerMultiprocessor(&per_cu, (const void*)mega_fwd, NTHREADS, LDS_BYTES) != hipSuccess || per_cu < 1) { fprintf(stderr, "kernel_launch: occupancy query says %d\n", per_cu); }
        (void)hipGetLastError();
        if (cus != 256) { fprintf(stderr, "kernel_launch: built for 256 CUs, device has %d\n", cus); ok = -1; return; }
        ok = 1;
    }
    if (ok < 0) return;
    Params P{};
    const float** pp = (const float**)&P;
    for (int i = 0; i < 30; ++i) pp[i] = (const float*)d_in[i];
    P.out = (float*)d_out; P.ws = (unsigned char*)d_ws;
    if (hipMemsetAsync((char*)d_ws + WS_CTL, 0, CTL_BYTES, stream) != hipSuccess) return;
#ifndef MK_CUTS
#define MK_CUTS 0
#endif
    if (MK_CUTS == 0) { P.ph_lo = 0; P.ph_hi = NPHASE; hipLaunchKernelGGL(mega_fwd, dim3(256), dim3(NTHREADS), LDS_BYTES, stream, P); }
    else for (int k = 0; k < NPHASE; ++k) { P.ph_lo = k; P.ph_hi = k + 1;
        hipLaunchKernelGGL(mega_fwd, dim3(256), dim3(NTHREADS), LDS_BYTES, stream, P); }
}
```

```cpp
#include <hip/hip_runtime.h>
#include <cstdio>
#include <cstdint>

#define LAS __attribute__((address_space(3)))
#define GAS __attribute__((address_space(1)))
typedef unsigned short bf16_t;
typedef short bf16x8 __attribute__((ext_vector_type(8)));
typedef float f32x2 __attribute__((ext_vector_type(2)));
typedef float f32x4 __attribute__((ext_vector_type(4)));
typedef float f32x16 __attribute__((ext_vector_type(16)));
typedef unsigned u32x2 __attribute__((ext_vector_type(2)));
typedef unsigned u32x4 __attribute__((ext_vector_type(4)));

constexpr int NB = 4, SEQ = 8192, NTOK = NB * SEQ, DM = 1024;
constexpr int NH = 8, HD = 64;
constexpr int INW = 3848;
constexpr int ZW = 3840;
constexpr int ZQ = 0, ZK = 512, ZV = 1024, ZOG = 1536, ZR = 2048;
constexpr int RW_R = 0, RW_K = 512, RW_V = 1024, RW_W = 1536, RW_A = 1600, RW_G = 1664, RWIN = 1792;
constexpr int NE = 32, TOPK = 4, EFF = 1024;
constexpr int MAXBLK = (NTOK * TOPK) / 256 + NE;
constexpr int PLE = 256;
constexpr float LOG2E = 1.4426950408889634f;
constexpr float QSCALE = 0.125f * LOG2E;

constexpr size_t MiB = 1u << 20;
constexpr size_t WS_CTL = 0, CTL_BYTES = 1 * MiB;
constexpr size_t WS_C2 = 1 * MiB;
constexpr size_t WS_LOGF = 2 * MiB;
constexpr size_t WS_ROUTE = 3 * MiB;
constexpr size_t WS_TOKSLOT = 5 * MiB;
constexpr size_t WS_GATESLOT = 9 * MiB;
constexpr size_t WS_CTOT = 13 * MiB;
constexpr size_t WS_WIN = 16 * MiB;
constexpr size_t WS_WOUT = 24 * MiB;
constexpr size_t WS_WPG = 26 * MiB;
constexpr size_t WS_WPP = 28 * MiB;
constexpr size_t WS_WGU = 32 * MiB;
constexpr size_t WS_WDN = 160 * MiB;
constexpr size_t WS_XN = 224 * MiB;
constexpr size_t WS_X1 = 290 * MiB;
constexpr size_t WS_Z = 418 * MiB;
constexpr size_t WS_AO = 658 * MiB;
constexpr size_t WS_ACT = 418 * MiB;
constexpr size_t WS_RW = 722 * MiB;
constexpr size_t WS_RR = WS_RW, WS_RK = WS_RW + 32 * MiB, WS_RV = WS_RW + 64 * MiB, WS_RG = WS_RW + 96 * MiB;
constexpr size_t WS_RLW = WS_RW + 128 * MiB;
constexpr size_t WS_RKK = WS_RW + 160 * MiB, WS_RKA = WS_RW + 192 * MiB;
constexpr size_t WS_YP = 722 * MiB;
constexpr size_t WS_END = 994 * MiB;
static_assert(WS_ACT + (size_t)MAXBLK * 256 * 1024 * 2 <= WS_RW && WS_YP + (size_t)MAXBLK * 256 * 1024 * 2 <= WS_END, "ws map");
constexpr size_t DO_PJ = 0, DO_PB = 64 * MiB;
constexpr int CW_TMO = 0, CW_CNT = 64  , CW_BAR = 4096;

struct Params {
    const float *x, *p, *mix_norm, *w_in, *f_bias, *q_norm, *k_norm, *mu, *w0, *w2, *a0, *a2, *g2, *k_k, *k_a, *r_k, *ln_w, *ln_b, *w_out, *moe_norm, *w_router, *b_router, *w_gu, *b_gu, *w_down,
        *b_down, *ple_norm, *w_pg, *w_pp, *final_norm;
    float* out; unsigned char* ws; int ph_lo, ph_hi;
};

typedef const __attribute__((address_space(4))) Params& KPR;
__device__ __forceinline__ const __attribute__((address_space(4))) Params* kp_fresh() {
    unsigned long long p = (unsigned long long)__builtin_amdgcn_kernarg_segment_ptr(); asm volatile("" : "+s"(p)); return (const __attribute__((address_space(4))) Params*)p; }

typedef __bf16 bf16x2_hw __attribute__((ext_vector_type(2)));
__device__ __forceinline__ unsigned pk2(float lo, float hi) { const f32x2 v = {lo, hi}; return __builtin_bit_cast(unsigned, __builtin_convertvector(v, bf16x2_hw)); }
__device__ __forceinline__ unsigned f2bf(float f) { return pk2(f, f) & 0xffffu; }
__device__ __forceinline__ float bf2f(unsigned h) { return __builtin_bit_cast(float, h << 16); }
__device__ __forceinline__ float bflo(unsigned w) { return __builtin_bit_cast(float, w << 16); }
__device__ __forceinline__ float bfhi(unsigned w) { return __builtin_bit_cast(float, w & 0xffff0000u); }
__device__ __forceinline__ unsigned cvt_pk_bf16(float lo, float hi) { unsigned r; asm volatile("v_cvt_pk_bf16_f32 %0, %1, %2" : "=v"(r) : "v"(lo), "v"(hi)); return r; }
__device__ __forceinline__ unsigned pk4_fp8(float a, float b, float c, float d) { int w = 0; w = __builtin_amdgcn_cvt_pk_fp8_f32(a, b, w, false); w = __builtin_amdgcn_cvt_pk_fp8_f32(c, d, w, true); return (unsigned)w; }
__device__ __forceinline__ float wave_sum(float v) {
#pragma unroll
    for (int o = 1; o < 64; o <<= 1) v += __shfl_xor(v, o);
    return v;
}
__device__ __forceinline__ float sigmoidf_(float x) { return __builtin_amdgcn_rcpf(1.0f + __expf(-x)); }
__device__ __forceinline__ float logsigmoidf_(float x) { return fminf(x, 0.f) - log1pf(expf(-fabsf(x))); }
namespace pg8 {
constexpr int BM = 256, BK = 64, HALF = 128, HTB = HALF * BK * 2, STAGE_BYTES = 8 * HTB, NXCD = 8, WGM = 8;
__host__ __device__ __forceinline__ int lds_byte(int r, int c) { const int st = (r >> 4) * 2 + (c >> 5), rr = r & 15, cc = c & 31, ob = rr * 64 + cc * 2; return st * 1024 + (ob ^ (((ob >> 9) & 1) << 5)); }
__host__ __device__ __forceinline__ void stage_rc(int b, int& R, int& C) { const int st = b / 1024, sb = b % 1024, swz = sb ^ (((sb >> 9) & 1) << 5); R = (st >> 1) * 16 + swz / 64; C = (st & 1) * 32 + (swz % 64) / 2; }
__host__ __device__ __forceinline__ int perm32(int rho) { const int n = rho >> 4, i = rho & 15; return 8 * (i >> 2) + 4 * n + (i & 3); }

struct Unit { int pm, pn, e, lb, sl; };

__device__ __forceinline__ bool tile_order(int i, int G, int c, int nM, int nN, int& pm, int& pn) {
    const int nwg = nM * nN; const long L = (long)i * G + c; if (L >= nwg) return false;
    int wgid = (int)L; { const int q = nwg / NXCD, r = nwg % NXCD, xcd = wgid % NXCD, off = wgid / NXCD; wgid = (xcd < r ? xcd * (q + 1) : r * (q + 1) + (xcd - r) * q) + off; }
    const int nig = WGM * nN, gid = wgid / nig, fm = gid * WGM, gsz = (nM - fm) < WGM ? (nM - fm) : WGM;
    pm = fm + ((wgid % nig) % gsz); pn = (wgid % nig) / gsz; return true;
}
struct DenseOrder {
    const void* A; const void* Bt; int K  , nM, nN, G, c;
    __device__ __forceinline__ bool next(int i, Unit& u) const { u.e = 0; u.lb = 0; return tile_order(i, G, c, nM, nN, u.pm, u.pn); }
    __device__ __forceinline__ const char* a_base(const Unit& u) const { return (const char*)A + (size_t)u.pm * BM * K * 2; }
    __device__ __forceinline__ const char* b_base(const Unit& u) const { return (const char*)Bt + (size_t)u.pn * BM * K * 2; }
    __device__ __forceinline__ void prefetch(const Unit&, int, int, int) const {}
    __device__ __forceinline__ void a_off(const Unit&, const int (&R)[2], const int (&C)[2], unsigned (&off)[2][2]) const {
#pragma unroll
        for (int h = 0; h < 2; ++h)
#pragma unroll
            for (int i = 0; i < 2; ++i) off[h][i] = (unsigned)((R[i] + HALF * h) * K + C[i]) * 2u;
    }
};

typedef int v8i32 __attribute__((ext_vector_type(8)));
typedef int i32x4 __attribute__((ext_vector_type(4)));
template <class Epi, class Sched, bool ALIGN_EPI, bool FP8 = false>
__device__ __forceinline__ void gemm_phase(LAS unsigned char* lds, const int K, const Sched& S, const Epi& E) {
    int tid_ = threadIdx.x; asm volatile("" : "+v"(tid_));
    const int tid = tid_, wid = __builtin_amdgcn_readfirstlane(tid >> 6), lane = tid & 63, wr = wid >> 2, wc = wid & 3, fr = lane & 15, fq = lane >> 4;
    const int RB = FP8 ? K : 2 * K;
    const int nt = RB / (BK * 2);
    int sR[2], sC[2]; unsigned voffB[2];
#pragma unroll
    for (int i = 0; i < 2; ++i) { int R, C; stage_rc(tid * 16 + i * 8192, R, C); const int Rb = Epi::PERM ? ((R & ~31) + perm32(R & 31)) : R; sR[i] = R; sC[i] = C; voffB[i] = (unsigned)(Rb * RB + C * 2); }
    const size_t kstep = (size_t)(BK * 2);
    const size_t hstep = (size_t)HALF * RB;
    const unsigned ldsw = (unsigned)wid * 1024u;
    const int aoff0 = FP8 ? lds_byte(wr * 64 + fr, fq * 16) : lds_byte(wr * 64 + fr, fq * 8), aoff1 = FP8 ? lds_byte(wr * 64 + fr, fq * 16 + 8) : aoff0 + 1024;
    const int boff0 = FP8 ? lds_byte(wc * 32 + fr, fq * 16) : lds_byte(wc * 32 + fr, fq * 8), boff1 = FP8 ? lds_byte(wc * 32 + fr, fq * 16 + 8) : boff0 + 1024;
#define PG8_SA(b, h) (((b) * 2 + (h)) * HTB)
#define PG8_SB(b, h) ((4 + (b) * 2 + (h)) * HTB)
#define PG8_STAGE(bufoff, gbase, voff) do { _Pragma("unroll") for (int _i = 0; _i < 2; ++_i) \
        __builtin_amdgcn_global_load_lds((const unsigned*)((const char*)(gbase) + (voff)[_i]), (LAS unsigned*)(lds + (bufoff) + ldsw + _i * 8192), 16, 0, 0); } while (0)
#define PG8_CAT(p0, p1) __builtin_shufflevector((p0), (p1), 0, 1, 2, 3, 4, 5, 6, 7)
#define PG8_LDA(dst, b, h) do { _Pragma("unroll") for (int m = 0; m < 4; ++m) dst[m] = PG8_CAT(*(const LAS i32x4*)(lds + PG8_SA(b, h) + aoff0 + m * 2048), *(const LAS i32x4*)(lds + PG8_SA(b, h) + aoff1 + m * 2048)); } while (0)
#define PG8_LDB(dst, b, h) do { _Pragma("unroll") for (int n = 0; n < 2; ++n) dst[n] = PG8_CAT(*(const LAS i32x4*)(lds + PG8_SB(b, h) + boff0 + n * 2048), *(const LAS i32x4*)(lds + PG8_SB(b, h) + boff1 + n * 2048)); } while (0)
#define PG8_LO(x) __builtin_bit_cast(bf16x8, __builtin_shufflevector((x), (x), 0, 1, 2, 3))
#define PG8_HI(x) __builtin_bit_cast(bf16x8, __builtin_shufflevector((x), (x), 4, 5, 6, 7))
#define PG8_MMA(ai, bj, At, Bt) do { __builtin_amdgcn_s_setprio(1); \
        if constexpr (FP8) { _Pragma("unroll") for (int m = 0; m < 4; ++m) _Pragma("unroll") for (int n = 0; n < 2; ++n) \
            asm volatile("v_mfma_scale_f32_16x16x128_f8f6f4 %0, %1, %2, %0, %3, %4 op_sel_hi:[0,0,0]" : "+v"(acc[ai][bj][m][n]) : "v"(Bt[n]), "v"(At[m]), "v"(sc_w), "v"(sc_x)); } \
        else { _Pragma("unroll") for (int m = 0; m < 4; ++m) _Pragma("unroll") for (int n = 0; n < 2; ++n) { \
            acc[ai][bj][m][n] = __builtin_amdgcn_mfma_f32_16x16x32_bf16(PG8_LO(Bt[n]), PG8_LO(At[m]), acc[ai][bj][m][n], 0, 0, 0); } \
            _Pragma("unroll") for (int m = 0; m < 4; ++m) _Pragma("unroll") for (int n = 0; n < 2; ++n) { \
            acc[ai][bj][m][n] = __builtin_amdgcn_mfma_f32_16x16x32_bf16(PG8_HI(Bt[n]), PG8_HI(At[m]), acc[ai][bj][m][n], 0, 0, 0); } } \
        __builtin_amdgcn_s_setprio(0); } while (0)
#define PG8_WAIT_V(n) asm volatile("s_waitcnt vmcnt(" #n ")" ::: "memory")
#define PG8_WAIT_L(n) asm volatile("s_waitcnt lgkmcnt(" #n ")" ::: "memory")
#define PG8_BAR __builtin_amdgcn_s_barrier()
#define PG8_SCHED __builtin_amdgcn_sched_barrier(0)
    Unit cur, nxt; int ui = 0;
    if (!S.next(0, cur)) return;
    f32x4 acc[2][2][4][2];
#pragma unroll
    for (int a = 0; a < 2; ++a)
#pragma unroll
        for (int b = 0; b < 2; ++b)
#pragma unroll
            for (int m = 0; m < 4; ++m)
#pragma unroll
                for (int n = 0; n < 2; ++n) acc[a][b][m][n] = (f32x4){0.f, 0.f, 0.f, 0.f};
    const int sc_w = 121, sc_x = 127;
    v8i32 At[4], B0[2], B1[2];
    unsigned offC[2][2], offN[2][2];
    cur.sl = 0; S.prefetch(cur, 0, wid, lane); PG8_WAIT_V(0); PG8_BAR;
    S.a_off(cur, sR, sC, offC);
    const char* cA = S.a_base(cur); const char* cB = S.b_base(cur);
    PG8_STAGE(PG8_SB(0, 0), cB, voffB); PG8_STAGE(PG8_SB(0, 1), cB + hstep, voffB); PG8_STAGE(PG8_SA(0, 0), cA, offC[0]); PG8_STAGE(PG8_SA(0, 1), cA, offC[1]);
    if (wr == 1) PG8_BAR;
    PG8_WAIT_V(2); PG8_BAR;
    PG8_STAGE(PG8_SB(1, 0), cB + kstep, voffB); PG8_STAGE(PG8_SA(1, 0), cA + kstep, offC[0]); PG8_STAGE(PG8_SB(1, 1), cB + hstep + kstep, voffB);
    PG8_WAIT_V(6); PG8_BAR;
    for (;;) {
        const bool has_next = S.next(ui + 1, nxt);
        const char* nA = cA; const char* nB = cB;
        nxt.sl = cur.sl == 2 ? 0 : cur.sl + 1;
        if (has_next) { nA = S.a_base(nxt); nB = S.b_base(nxt); S.prefetch(nxt, nxt.sl, wid, lane); }
#pragma unroll
        for (int h = 0; h < 2; ++h)
#pragma unroll
            for (int i = 0; i < 2; ++i) offN[h][i] = offC[h][i];
#pragma nounroll
        for (int t = 0; t < nt; t += 2) {
            const bool last = (t == nt - 2);
            if (last && has_next) S.a_off(nxt, sR, sC, offN);
            const char* a1 = cA + (size_t)(t + 1) * kstep;
            const char* a2 = last ? nA : cA + (size_t)(t + 2) * kstep; const char* b2 = last ? nB : cB + (size_t)(t + 2) * kstep;
            const char* a3 = a2 + kstep; const char* b3 = b2 + kstep;
            unsigned o2[2][2];
#pragma unroll
            for (int h = 0; h < 2; ++h)
#pragma unroll
                for (int i = 0; i < 2; ++i) o2[h][i] = last ? offN[h][i] : offC[h][i];
            PG8_LDB(B0, 0, 0); PG8_LDB(B1, 0, 1); PG8_SCHED; PG8_LDA(At, 0, 0); PG8_STAGE(PG8_SA(1, 1), a1, offC[1]);
            PG8_WAIT_V(8); PG8_WAIT_L(0); PG8_BAR; PG8_MMA(0, 0, At, B0); PG8_MMA(0, 1, At, B1); PG8_BAR; PG8_SCHED;
            PG8_LDA(At, 0, 1); PG8_STAGE(PG8_SB(0, 0), b2, voffB); PG8_STAGE(PG8_SB(0, 1), b2 + hstep, voffB); PG8_STAGE(PG8_SA(0, 0), a2, o2[0]);
            PG8_WAIT_V(8); PG8_WAIT_L(0); PG8_BAR; PG8_MMA(1, 0, At, B0); PG8_MMA(1, 1, At, B1); PG8_BAR; PG8_SCHED;
            PG8_LDB(B0, 1, 0); PG8_LDB(B1, 1, 1); PG8_SCHED; PG8_LDA(At, 1, 0); PG8_STAGE(PG8_SA(0, 1), a2, o2[1]);
            PG8_WAIT_V(8); PG8_WAIT_L(0); PG8_BAR; PG8_MMA(0, 0, At, B0); PG8_MMA(0, 1, At, B1); PG8_BAR; PG8_SCHED;
            PG8_LDA(At, 1, 1); PG8_STAGE(PG8_SB(1, 0), b3, voffB); PG8_STAGE(PG8_SB(1, 1), b3 + hstep, voffB); PG8_STAGE(PG8_SA(1, 0), a3, o2[0]);
            PG8_WAIT_V(8); PG8_WAIT_L(0); PG8_BAR; PG8_MMA(1, 0, At, B0); PG8_MMA(1, 1, At, B1); PG8_BAR; PG8_SCHED;
        }
        if constexpr (ALIGN_EPI) { if (wr == 0) PG8_BAR; }
        E(acc, cur, wr, wc, fr, fq);
        if (!has_next) break;
#pragma unroll
        for (int a = 0; a < 2; ++a)
#pragma unroll
            for (int b = 0; b < 2; ++b)
#pragma unroll
                for (int m = 0; m < 4; ++m)
#pragma unroll
                    for (int n = 0; n < 2; ++n) acc[a][b][m][n] = (f32x4){0.f, 0.f, 0.f, 0.f};
        cur = nxt; cA = nA; cB = nB; ++ui;
#pragma unroll
        for (int h = 0; h < 2; ++h)
#pragma unroll
            for (int i = 0; i < 2; ++i) offC[h][i] = offN[h][i];
        if constexpr (ALIGN_EPI) { if (wr == 1) PG8_BAR; }
    }
    PG8_WAIT_V(0);
    if constexpr (!ALIGN_EPI) { if (wr == 0) PG8_BAR; }
    PG8_BAR;
#undef PG8_SA
#undef PG8_SB
#undef PG8_STAGE
#undef PG8_LDA
#undef PG8_LDB
#undef PG8_MMA
#undef PG8_LO
#undef PG8_HI
#undef PG8_CAT
#undef PG8_WAIT_V
#undef PG8_WAIT_L
#undef PG8_BAR
#undef PG8_SCHED
}
}
namespace pg8 {
constexpr int T_BLKSTART = 0  , T_CNT = 40  , T_BLKE = 80  , T_WORDS = 80 + 560;
constexpr int TB_OFF = 8192 - 64;

struct EpiIn {
    static constexpr bool PERM = true;
    bf16_t* Z; const float* qn; const float* kn;
    __device__ __forceinline__ void operator()(const f32x4 (&acc)[2][2][4][2], const Unit& u, int wr, int wc, int fr, int fq) const {
        const int row0 = u.pm * BM + wr * 64 + fr;
        if (u.pn < 4) {
            const float* g = (u.pn < 2) ? qn : kn; const float sc = (u.pn < 2) ? QSCALE : 1.0f;
            f32x4 gv[2][2];
#pragma unroll
            for (int bj = 0; bj < 2; ++bj)
#pragma unroll
                for (int n = 0; n < 2; ++n) gv[bj][n] = *(const f32x4*)(g + 32 * bj + 8 * fq + 4 * n) * sc;
#pragma unroll
            for (int ai = 0; ai < 2; ++ai)
#pragma unroll
                for (int m = 0; m < 4; ++m) {
                    float ss = 0.f;
#pragma unroll
                    for (int bj = 0; bj < 2; ++bj)
#pragma unroll
                        for (int n = 0; n < 2; ++n) { const f32x4 x = acc[ai][bj][m][n]; ss += (x[0] * x[0] + x[1] * x[1]) + (x[2] * x[2] + x[3] * x[3]); }
                    ss += __shfl_xor(ss, 16); ss += __shfl_xor(ss, 32);
                    const float rstd = rsqrtf(ss * (1.0f / 64.0f) + 1e-6f);
                    bf16_t* rowp = Z + (size_t)(row0 + ai * HALF + m * 16) * ZW + u.pn * BM + 64 * wc + 8 * fq;
#pragma unroll
                    for (int bj = 0; bj < 2; ++bj) { const f32x4 v0 = acc[ai][bj][m][0] * rstd * gv[bj][0], v1 = acc[ai][bj][m][1] * rstd * gv[bj][1];
                        u32x4 w; w.x = cvt_pk_bf16(v0[0], v0[1]); w.y = cvt_pk_bf16(v0[2], v0[3]); w.z = cvt_pk_bf16(v1[0], v1[1]); w.w = cvt_pk_bf16(v1[2], v1[3]);
                        *(u32x4*)(rowp + 32 * bj) = w; }
                }
        } else {
            const int col0 = u.pn * BM + wc * 32 + 8 * fq;
#pragma unroll
            for (int ai = 0; ai < 2; ++ai)
#pragma unroll
                for (int m = 0; m < 4; ++m) { bf16_t* rowp = Z + (size_t)(row0 + ai * HALF + m * 16) * ZW + col0;
#pragma unroll
                    for (int bj = 0; bj < 2; ++bj) { const f32x4 v0 = acc[ai][bj][m][0], v1 = acc[ai][bj][m][1];
                        u32x4 w; w.x = cvt_pk_bf16(v0[0], v0[1]); w.y = cvt_pk_bf16(v0[2], v0[3]); w.z = cvt_pk_bf16(v1[0], v1[1]); w.w = cvt_pk_bf16(v1[2], v1[3]);
                        *(u32x4*)(rowp + bj * HALF) = w; } }
        }
    }
};
struct EpiBf16 {
    static constexpr bool PERM = true;
    bf16_t* O; int ldc;
    __device__ __forceinline__ void operator()(const f32x4 (&acc)[2][2][4][2], const Unit& u, int wr, int wc, int fr, int fq) const {
        const int row0 = u.pm * BM + wr * 64 + fr, col0 = u.pn * BM + wc * 32 + 8 * fq;
#pragma unroll
        for (int ai = 0; ai < 2; ++ai)
#pragma unroll
            for (int m = 0; m < 4; ++m) { bf16_t* rowp = O + (size_t)(row0 + ai * HALF + m * 16) * ldc + col0;
#pragma unroll
                for (int bj = 0; bj < 2; ++bj) { const f32x4 v0 = acc[ai][bj][m][0], v1 = acc[ai][bj][m][1];
                    u32x4 w; w.x = cvt_pk_bf16(v0[0], v0[1]); w.y = cvt_pk_bf16(v0[2], v0[3]); w.z = cvt_pk_bf16(v1[0], v1[1]); w.w = cvt_pk_bf16(v1[2], v1[3]);
                    *(u32x4*)(rowp + bj * HALF) = w; } }
    }
};
struct EpiOut {
    static constexpr bool PERM = false;
    const float* X; float* O;
    __device__ __forceinline__ void operator()(const f32x4 (&acc)[2][2][4][2], const Unit& u, int wr, int wc, int fr, int fq) const {
        const int row0 = u.pm * BM + wr * 64 + fr, col0 = u.pn * BM + wc * 32 + 4 * fq;
#pragma unroll
        for (int ai = 0; ai < 2; ++ai)
#pragma unroll
            for (int m = 0; m < 4; ++m) { const size_t off = (size_t)(row0 + ai * HALF + m * 16) * DM + col0;
#pragma unroll
                for (int bj = 0; bj < 2; ++bj)
#pragma unroll
                    for (int n = 0; n < 2; ++n) *(f32x4*)(O + off + bj * HALF + n * 16) = *(const f32x4*)(X + off + bj * HALF + n * 16) + acc[ai][bj][m][n];
                if (m & 1) asm volatile("" ::: "memory"); }
    }
};
struct EpiPg {
    static constexpr bool PERM = false;
    float* X; const bf16_t* PJ;
    __device__ __forceinline__ void operator()(const f32x4 (&acc)[2][2][4][2], const Unit& u, int wr, int wc, int fr, int fq) const {
        const int row0 = u.pm * BM + wr * 64 + fr, col0 = u.pn * BM + wc * 32 + 4 * fq;
#pragma unroll
        for (int ai = 0; ai < 2; ++ai)
#pragma unroll
            for (int m = 0; m < 4; ++m) { const size_t off = (size_t)(row0 + ai * HALF + m * 16) * DM + col0;
#pragma unroll
                for (int bj = 0; bj < 2; ++bj)
#pragma unroll
                    for (int n = 0; n < 2; ++n) { const size_t o = off + bj * HALF + n * 16; const u32x2 pj = *(const u32x2*)(PJ + o); const f32x4 a = acc[ai][bj][m][n]; const f32x4 xv = *(const f32x4*)(X + o);
                        f32x4 r; r[0] = xv[0] + sigmoidf_(a[0]) * bflo(pj.x); r[1] = xv[1] + sigmoidf_(a[1]) * bfhi(pj.x); r[2] = xv[2] + sigmoidf_(a[2]) * bflo(pj.y); r[3] = xv[3] + sigmoidf_(a[3]) * bfhi(pj.y);
                        *(f32x4*)(X + o) = r; }
                if (m & 1) asm volatile("" ::: "memory"); }
    }
};
struct EpiGu {
    static constexpr bool PERM = true;
    unsigned char* ACT; const float* b_gu;
    __device__ __forceinline__ void operator()(const f32x4 (&acc)[2][2][4][2], const Unit& u, int wr, int wc, int fr, int fq) const {
        const int row0 = u.pm * BM + wr * 64 + fr, cl = u.pn * HALF + wc * 32 + 8 * fq;
        const float* bg = b_gu + (size_t)u.e * 2048 + cl;
        f32x4 bgl[2], bli[2];
#pragma unroll
        for (int n = 0; n < 2; ++n) { bgl[n] = *(const f32x4*)(bg + 4 * n); bli[n] = *(const f32x4*)(bg + 1024 + 4 * n); }
#pragma unroll
        for (int ai = 0; ai < 2; ++ai)
#pragma unroll
            for (int m = 0; m < 4; ++m) { unsigned char* rowp = ACT + (size_t)(row0 + ai * HALF + m * 16) * EFF + cl; float r[8];
#pragma unroll
                for (int n = 0; n < 2; ++n)
#pragma unroll
                    for (int i = 0; i < 4; ++i) { const float gl = fminf(acc[ai][0][m][n][i] + bgl[n][i], 7.0f); const float li = fminf(fmaxf(acc[ai][1][m][n][i] + bli[n][i], -7.0f), 7.0f);
                        r[4 * n + i] = gl * sigmoidf_(1.702f * gl) * (li + 1.0f); }
                u32x2 w; w.x = pk4_fp8(r[0], r[1], r[2], r[3]); w.y = pk4_fp8(r[4], r[5], r[6], r[7]);
                *(u32x2*)rowp = w; }
    }
};
struct EpiDn {
    static constexpr bool PERM = true;
    unsigned char* YP; const float* b_dn; const float* gateslot; const LAS int* tab;
    __device__ __forceinline__ void operator()(const f32x4 (&acc)[2][2][4][2], const Unit& u, int wr, int wc, int fr, int fq) const {
        const int row0 = u.pm * BM + wr * 64 + fr, col0 = u.pn * BM + wc * 32 + 8 * fq;
        const float* bd = b_dn + (size_t)u.e * 1024 + col0; const int cnt = tab[T_CNT + u.e];
        f32x4 bv[2][2];
#pragma unroll
        for (int bj = 0; bj < 2; ++bj)
#pragma unroll
            for (int n = 0; n < 2; ++n) bv[bj][n] = *(const f32x4*)(bd + bj * HALF + 4 * n);
#pragma unroll
        for (int ai = 0; ai < 2; ++ai)
#pragma unroll
            for (int m = 0; m < 4; ++m) { const int rr = wr * 64 + fr + ai * HALF + m * 16, slot = u.lb * 256 + rr;
                const float gt = slot < cnt ? ((const LAS float*)((const LAS unsigned char*)tab + TB_OFF + u.sl * 1024))[rr] * 16.0f : 0.f;
                unsigned char* rowp = YP + (size_t)(row0 + ai * HALF + m * 16) * DM + col0;
#pragma unroll
                for (int bj = 0; bj < 2; ++bj) { const f32x4 v0 = (acc[ai][bj][m][0] + bv[bj][0]) * gt, v1 = (acc[ai][bj][m][1] + bv[bj][1]) * gt;
                    u32x2 w; w.x = pk4_fp8(v0[0], v0[1], v0[2], v0[3]); w.y = pk4_fp8(v1[0], v1[1], v1[2], v1[3]);
                    *(u32x2*)(rowp + bj * HALF) = w; } }
    }
};
struct MoeOrder {
    const unsigned char* A; const unsigned char* Bt; const int* tokslot; const float* gateslot;   const LAS int* tab; int nblk, nN, G, c; bool gather;
    __device__ __forceinline__ bool next(int i, Unit& u) const { if (!tile_order(i, G, c, nblk, nN, u.pm, u.pn)) return false; u.e = tab[T_BLKE + u.pm]; u.lb = u.pm - tab[T_BLKSTART + u.e]; return true; }
    __device__ __forceinline__ const char* a_base(const Unit& u) const { return gather ? (const char*)A : (const char*)A + (size_t)u.pm * BM * 1024; }
    __device__ __forceinline__ const char* b_base(const Unit& u) const { return (const char*)Bt + ((size_t)u.e * nN + u.pn) * BM * 1024; }
    __device__ __forceinline__ void prefetch(const Unit& u, int slot, int wid, int lane) const {
        if (wid < 4) { const unsigned* src = (gather ? (const unsigned*)tokslot : (const unsigned*)gateslot) + (size_t)u.e * NTOK + u.lb * 256 + wid * 64 + lane;
            __builtin_amdgcn_global_load_lds(src, (LAS unsigned*)((LAS unsigned char*)tab + TB_OFF + slot * 1024 + wid * 256), 4, 0, 0); }
    }
    __device__ __forceinline__ void a_off(const Unit& u, const int (&R)[2], const int (&C)[2], unsigned (&off)[2][2]) const {
        const int cnt = tab[T_CNT + u.e]; const LAS int* tb = (const LAS int*)((const LAS unsigned char*)tab + TB_OFF + u.sl * 1024);
#pragma unroll
        for (int h = 0; h < 2; ++h)
#pragma unroll
            for (int i = 0; i < 2; ++i) {
                if (gather) { const int rr = R[i] + HALF * h; const int tk = tb[rr]; const int tok = (u.lb * 256 + rr) < cnt ? tk : NTOK; off[h][i] = (unsigned)tok * 1024u + (unsigned)C[i] * 2u; }
                else off[h][i] = (unsigned)((R[i] + HALF * h) * 1024 + C[i] * 2);
            }
    }
};
__device__ __forceinline__ int moe_tables(LAS int* tab, const unsigned* cntw) {
    if (threadIdx.x == 0) { int s = 0; for (int e = 0; e < NE; ++e) { const int c = (int)cntw[e]; tab[T_CNT + e] = c; tab[T_BLKSTART + e] = s; const int nb = (c + 255) >> 8; for (int j = 0; j < nb; ++j) tab[T_BLKE + s + j] = e; s += nb; } tab[T_BLKSTART + NE] = s; }
    __syncthreads();
    return tab[T_BLKSTART + NE];
}
}
constexpr int NWAVES = 8, NTHREADS = 512;
constexpr int RING_BYTES = 131072, MISC_OFF = RING_BYTES, LDS_BYTES = 147456;

__device__ __forceinline__ void tr_item(const float* W, int ldw, int srccol0, int k0, bf16_t* WT, int Kd, int dstrow0, LAS float* scr, int lane) {
#pragma unroll 8
    for (int i = 0; i < 32; ++i) { const int kk = 2 * i + (lane >> 5); scr[kk * 33 + (lane & 31)] = W[(size_t)(k0 + kk) * ldw + srccol0 + (lane & 31)]; }
    asm volatile("s_waitcnt lgkmcnt(0)" ::: "memory");
    const int c = lane & 7;
#pragma unroll
    for (int j = 0; j < 4; ++j) { const int n = (lane >> 3) + 8 * j; const LAS float* s = scr + (8 * c) * 33 + n;
        u32x4 o; o.x = pk2(s[0 * 33], s[1 * 33]); o.y = pk2(s[2 * 33], s[3 * 33]); o.z = pk2(s[4 * 33], s[5 * 33]); o.w = pk2(s[6 * 33], s[7 * 33]);
        *(u32x4*)(WT + (size_t)(dstrow0 + n) * Kd + k0 + 8 * c) = o; }
    asm volatile("s_waitcnt lgkmcnt(0)" ::: "memory");
}
__device__ __forceinline__ void tr_item8(const float* W, int ldw, int srccol0, int k0, unsigned char* WT, int Kd, int dstrow0, LAS float* scr, int lane) {
#pragma unroll 8
    for (int i = 0; i < 32; ++i) { const int kk = 2 * i + (lane >> 5); scr[kk * 33 + (lane & 31)] = W[(size_t)(k0 + kk) * ldw + srccol0 + (lane & 31)]; }
    asm volatile("s_waitcnt lgkmcnt(0)" ::: "memory");
    const int c = lane & 7;
#pragma unroll
    for (int j = 0; j < 4; ++j) { const int n = (lane >> 3) + 8 * j; const LAS float* s = scr + (8 * c) * 33 + n;
        u32x2 o; o.x = pk4_fp8(s[0 * 33] * 64.f, s[1 * 33] * 64.f, s[2 * 33] * 64.f, s[3 * 33] * 64.f); o.y = pk4_fp8(s[4 * 33] * 64.f, s[5 * 33] * 64.f, s[6 * 33] * 64.f, s[7 * 33] * 64.f);
        *(u32x2*)(WT + (size_t)(dstrow0 + n) * Kd + k0 + 8 * c) = o; }
    asm volatile("s_waitcnt lgkmcnt(0)" ::: "memory");
}
constexpr int I_IN = 16 * 120, I_OUT = 16 * 32, I_PG = 16 * 32, I_PP = 4 * 32, I_GU1 = 16 * 64, I_DN1 = 16 * 32;
constexpr int I_LORA = 16 + 16 + 32;
constexpr int I_SMALL = I_IN + I_OUT + I_PG + I_PP + I_LORA, I_GU = NE * I_GU1, I_DN = NE * I_DN1, I_ALL = I_SMALL + I_GU + I_DN;
__device__ __forceinline__ void prep_item(KPR P, int it, LAS float* scr, int lane) {
    unsigned char* ws = P.ws;
    if (it < I_IN) { const int kb = it / 120, nb = it % 120, n0 = nb * 32, pn = n0 >> 8, j0 = n0 & 255;
        const int src = pn < 4 ? (pn * 256 + 64 * ((j0 & 127) >> 5) + 32 * (j0 >> 7)) : (n0 < 2048 ? n0 : n0 + 8);
        tr_item(P.w_in, INW, src, kb * 64, (bf16_t*)(ws + WS_WIN), 1024, n0, scr, lane); return; }
    it -= I_IN;
    if (it < I_OUT) { tr_item(P.w_out, 1024, (it % 32) * 32, (it / 32) * 64, (bf16_t*)(ws + WS_WOUT), 1024, (it % 32) * 32, scr, lane); return; }
    it -= I_OUT;
    if (it < I_PG) { tr_item8(P.w_pg, 1024, (it % 32) * 32, (it / 32) * 64, ws + WS_WPG, 1024, (it % 32) * 32, scr, lane); return; }
    it -= I_PG;
    if (it < I_PP) { tr_item(P.w_pp, 1024, (it % 32) * 32, (it / 32) * 64, (bf16_t*)(ws + WS_WPP), 256, (it % 32) * 32, scr, lane); return; }
    it -= I_PP;
    if (it < 16) { tr_item(P.w2, 512, it * 32, 0, (bf16_t*)(ws + 29 * MiB), 64, it * 32, scr, lane); return; }
    it -= 16;
    if (it < 16) { tr_item(P.a2, 512, it * 32, 0, (bf16_t*)(ws + 29 * MiB + 65536), 64, it * 32, scr, lane); return; }
    it -= 16;
    if (it < 32) { tr_item(P.g2, 512, (it % 16) * 32, (it / 16) * 64, (bf16_t*)(ws + 29 * MiB + 131072), 128, (it % 16) * 32, scr, lane); return; }
    it -= 32;
    if (it < I_GU) { const int e = it / I_GU1, r = it % I_GU1, kb = r / 64, nb = r % 64, n0 = nb * 32, pn = n0 >> 8, j0 = n0 & 255;
        const int src = (j0 >> 7) * 1024 + pn * 128 + (j0 & 127);
        tr_item8(P.w_gu + (size_t)e * 1024 * 2048, 2048, src, kb * 64, ws + WS_WGU + (size_t)e * 2048 * 1024, 1024, n0, scr, lane); return; }
    it -= I_GU;
    { const int e = it / I_DN1, r = it % I_DN1, kb = r / 32, nb = r % 32;
        tr_item8(P.w_down + (size_t)e * 1024 * 1024, 1024, nb * 32, kb * 64, ws + WS_WDN + (size_t)e * 1024 * 1024, 1024, nb * 32, scr, lane); }
}
__device__ __forceinline__ void phase_prep_weights(KPR P, LAS unsigned char* lds, int gw, int ngw, int wave, int lane) {
    LAS float* scr = (LAS float*)(lds + wave * 16384);
    for (int it = gw; it < I_ALL; it += ngw) prep_item(P, it, scr, lane);
}
__device__ __forceinline__ void phase_cvt_p(KPR P, int gt, int ngt) {
    bf16_t* PB = (bf16_t*)((unsigned char*)P.out + DO_PB);
    for (int i = gt; i < NTOK * PLE / 8; i += ngt) { const f32x4 a = ((const f32x4*)P.p)[2 * i], b = ((const f32x4*)P.p)[2 * i + 1];
        u32x4 w; w.x = pk2(a[0], a[1]); w.y = pk2(a[2], a[3]); w.z = pk2(b[0], b[1]); w.w = pk2(b[2], b[3]); ((u32x4*)PB)[i] = w; }
}
__device__ __forceinline__ void rms_row(const float* xrow, const float* gain, int lane, f32x4 (&v)[4]) {
    const f32x4* xr = (const f32x4*)xrow + lane; float s = 0.f;
#pragma unroll
    for (int j = 0; j < 4; ++j) { v[j] = xr[64 * j]; s += (v[j][0] * v[j][0] + v[j][1] * v[j][1]) + (v[j][2] * v[j][2] + v[j][3] * v[j][3]); }
    const float rstd = rsqrtf(wave_sum(s) * (1.f / DM) + 1e-6f);
#pragma unroll
    for (int j = 0; j < 4; ++j) v[j] = v[j] * rstd * ((const f32x4*)gain)[64 * j + lane];
}
__device__ __forceinline__ void store_row_fp8(unsigned char* orow, int lane, const f32x4 (&v)[4]) {
    unsigned* o4 = (unsigned*)orow + lane;
#pragma unroll
    for (int j = 0; j < 4; ++j) o4[64 * j] = pk4_fp8(v[j][0], v[j][1], v[j][2], v[j][3]);
}
__device__ __forceinline__ void store_row_bf16(bf16_t* orow, int lane, const f32x4 (&v)[4]) {
    u32x2* o8 = (u32x2*)orow + lane;
#pragma unroll
    for (int j = 0; j < 4; ++j) { u32x2 w; w.x = pk2(v[j][0], v[j][1]); w.y = pk2(v[j][2], v[j][3]); o8[64 * j] = w; }
}
__device__ __forceinline__ void norm1_row(KPR P, int row, int lane, const LAS float* wff, LAS float* lf_out  ) {
    f32x4 v[4]; rms_row(P.x + (size_t)row * DM, P.mix_norm, lane, v);
    store_row_bf16((bf16_t*)(P.ws + WS_XN) + (size_t)row * DM, lane, v);
    float ff[8];
#pragma unroll
    for (int q = 0; q < 8; ++q) ff[q] = 0.f;
#pragma unroll
    for (int j = 0; j < 4; ++j)
#pragma unroll
        for (int i = 0; i < 4; ++i) { const LAS f32x4* w = (const LAS f32x4*)(wff + (size_t)(4 * (64 * j + lane) + i) * 8); const f32x4 w0 = w[0], w1 = w[1]; const float h = v[j][i];
            ff[0] += h * w0[0]; ff[1] += h * w0[1]; ff[2] += h * w0[2]; ff[3] += h * w0[3]; ff[4] += h * w1[0]; ff[5] += h * w1[1]; ff[6] += h * w1[2]; ff[7] += h * w1[3]; }
#pragma unroll
    for (int q = 0; q < 8; ++q) ff[q] = wave_sum(ff[q]);
    if (lane < 8) { float f = ff[0];
#pragma unroll
        for (int q = 1; q < 8; ++q) f = (lane == q) ? ff[q] : f;
        lf_out[lane] = logsigmoidf_(f + P.f_bias[lane]); }
}
__device__ __forceinline__ void load_wff(KPR P, LAS float* wff, int tid, int nthr) {
    for (int i = tid; i < 1024 * 8; i += nthr) wff[i] = P.w_in[(size_t)(i >> 3) * INW + 2048 + (i & 7)];
}
__device__ __forceinline__ void final_row(KPR P, int row, int lane, bool dead) {
    f32x4 v[4]; rms_row((const float*)(P.ws + WS_X1) + (size_t)row * DM, P.final_norm, lane, v);
    f32x4* o = (f32x4*)(P.out + (size_t)row * DM) + lane;
#pragma unroll
    for (int j = 0; j < 4; ++j) { if (dead) { const float q = __builtin_nanf(""); v[j] = (f32x4){q, q, q, q}; } o[64 * j] = v[j]; }
}
typedef GAS unsigned gu32;
#define RLX_AGENT __ATOMIC_RELAXED, __HIP_MEMORY_SCOPE_AGENT
#define XB_TMO      128
#define XB_XCNT(j)  (256  + 64 * (j))
#define XB_XSUB(j)  (1280 + 64 * (j))
#define XB_XGEN(j)  (2304 + 64 * (j))
#define XB_TOP      3328
#define XB_TOPGEN   3392
#define XCD_BAR_WORDS 3456
#define XB_SPIN_CAP (1u << 22)

__device__ __forceinline__ unsigned xb_ld(unsigned* p)              { return __hip_atomic_load(p, __ATOMIC_RELAXED, __HIP_MEMORY_SCOPE_AGENT); }
__device__ __forceinline__ unsigned xb_add(unsigned* p, unsigned v) { return __hip_atomic_fetch_add(p, v, __ATOMIC_RELAXED, __HIP_MEMORY_SCOPE_AGENT); }
__device__ __forceinline__ unsigned xb_xcc_id() { return (unsigned)__builtin_amdgcn_s_getreg((3 << 11) | 20) & 0xFu; }
#define XB_SPIN(cond, bar) do { unsigned _sp = 0; while (cond) { __builtin_amdgcn_s_sleep(1); \
    if ((++_sp & 255u) == 0u) { if (xb_ld(&(bar)[XB_TMO])) break; if (_sp > XB_SPIN_CAP) { atomicAdd(&(bar)[XB_TMO], 1u); break; } } } } while (0)

struct XcdBarrier { unsigned* bar; unsigned x; volatile LAS unsigned* st; };

__device__ __forceinline__ XcdBarrier xcd_barrier_post(unsigned* bar, volatile LAS unsigned* st) {
    XcdBarrier b; b.bar = bar; b.x = xb_xcc_id(); b.st = st;
    if (threadIdx.x == 0) (void)xb_add(&bar[XB_XCNT(b.x)], 1u);
    return b;
}
__device__ __forceinline__ void xcd_barrier_complete(unsigned* bar, unsigned x, unsigned& nloc, unsigned& nx) {
    const unsigned G = gridDim.x * gridDim.y * gridDim.z;
    unsigned sum, cnt, mine, sp = 0u;
    for (;;) {
        sum = 0u; cnt = 0u; mine = 0u;
#pragma unroll
        for (unsigned j = 0; j < 16; ++j) { const unsigned c = xb_ld(&bar[XB_XCNT(j)]); sum += c; cnt += (c > 0u) ? 1u : 0u; mine = (j == x) ? c : mine; }
        if (sum == G) break;
        __builtin_amdgcn_s_sleep(1);
        if ((++sp & 255u) == 0u) { if (xb_ld(&bar[XB_TMO])) break; if (sp > XB_SPIN_CAP) { atomicAdd(&bar[XB_TMO], 1u); break; } }
    }
    nloc = mine > 0u ? mine : 1u; nx = cnt > 0u ? cnt : 1u;
}
__device__ __forceinline__ void xcd_barrier(const XcdBarrier& b) {
    asm volatile("s_waitcnt vmcnt(0)" ::: "memory");
    __syncthreads();
    if (threadIdx.x == 0) {
        unsigned* bar = b.bar;
        __builtin_amdgcn_s_waitcnt(0);
        unsigned nloc = b.st[0], nx = b.st[1];
        if (nloc == 0u) { xcd_barrier_complete(bar, b.x, nloc, nx); b.st[0] = nloc; b.st[1] = nx; }
        const unsigned old = xb_add(&bar[XB_XSUB(b.x)], 1u);
        const unsigned gen = old / nloc;
        if (old + 1u == (gen + 1u) * nloc) {
            __builtin_amdgcn_fence(__ATOMIC_RELEASE, "agent");
            asm volatile("s_waitcnt vmcnt(0)" ::: "memory");
            const unsigned og = xb_add(&bar[XB_TOP], 1u);
            const unsigned tg = og / nx;
            if (og + 1u == (tg + 1u) * nx) xb_add(&bar[XB_TOPGEN], 1u);
            else XB_SPIN(xb_ld(&bar[XB_TOPGEN]) == tg, bar);
            __builtin_amdgcn_fence(__ATOMIC_ACQUIRE, "agent");
            xb_add(&bar[XB_XGEN(b.x)], 1u);
            asm volatile("s_waitcnt vmcnt(0)" ::: "memory");
        } else {
            XB_SPIN(xb_ld(&bar[XB_XGEN(b.x)]) == gen, bar);
            __builtin_amdgcn_fence(__ATOMIC_ACQUIRE, "agent");
            asm volatile("s_waitcnt vmcnt(0)" ::: "memory");
        }
    }
    __syncthreads();
}
namespace rk {
constexpr int MB = 8192;
constexpr int S_AT = 0, S_RT = 1, S_KT = 2, S_BT = 3, S_ATT = 4, S_KTT = 5, S_BTT = 6, S_VT = 7, S_N = 8, S_NT = 9, S_MAK = 10, S_MRB = 11, S_MRK = 12, S_TA = 13, S_TB = 14;
constexpr int SCR = 15 * MB;
constexpr int NCHUNK = SEQ / 64;
constexpr size_t WS_HT = WS_X1;
constexpr size_t WS_Y0 = WS_X1 + 64 * MiB;
constexpr size_t WS_QI = WS_X1 + 96 * MiB;
constexpr size_t WS_LW = WS_RW, WS_LA = WS_RW + 32 * MiB, WS_LG = WS_RW + 64 * MiB;
constexpr size_t WS_SC = WS_RW + 224 * MiB;
constexpr size_t DO_GT = 80 * MiB;
static_assert(WS_SC + 32 * MiB <= WS_END, "rwkv blobs");

__device__ __forceinline__ int moff(int row, int col) { return row * 128 + ((((col >> 3) ^ (row >> 1)) & 7) << 4) + (col & 7) * 2; }
__device__ __forceinline__ int crow(int r, int hi) { return (r & 3) + 8 * (r >> 2) + 4 * hi; }
__device__ __forceinline__ f32x16 mm_nt(const LAS unsigned char* A, int ar0, const LAS unsigned char* Bt, int br0, f32x16 acc, int r32, int hi) {
#pragma unroll
    for (int ks = 0; ks < 4; ++ks) { const bf16x8 a = *(const LAS bf16x8*)(A + moff(ar0 + r32, 16 * ks + 8 * hi)), b = *(const LAS bf16x8*)(Bt + moff(br0 + r32, 16 * ks + 8 * hi));
        acc = __builtin_amdgcn_mfma_f32_32x32x16_bf16(a, b, acc, 0, 0, 0); }
    return acc;
}
__device__ __forceinline__ void store_t(LAS unsigned char* dst, const f32x16& acc, int i0, int j0, int r32, int hi) {
#pragma unroll
    for (int g = 0; g < 4; ++g) { u32x2 w; w.x = pk2(acc[4 * g], acc[4 * g + 1]); w.y = pk2(acc[4 * g + 2], acc[4 * g + 3]); *(LAS u32x2*)(dst + moff(j0 + r32, i0 + 8 * g + 4 * hi)) = w; }
}
template <int MODE> __device__ __forceinline__ void mask_tri(f32x16& acc, int i0, int j0, int r32, int hi) {
#pragma unroll
    for (int r = 0; r < 16; ++r) { const int i = i0 + crow(r, hi), j = j0 + r32; const bool keep = MODE == 0 ? (j < i) : (MODE == 1 ? (i < j) : (i <= j)); if (!keep) acc[r] = 0.f; }
}

__device__ __forceinline__ void pass1_chunk(KPR P, LAS unsigned char* lds, int bh, int c, int tid) {
    const int lane = tid & 63, wave = tid >> 6, r32 = lane & 31, hi = lane >> 5, grp = wave >> 2, wq = wave & 3, i0 = 32 * (wq >> 1), j0 = 32 * (wq & 1);
    const int b = bh >> 3, h = bh & 7; const size_t tok0 = (size_t)b * SEQ + (size_t)c * 64; const size_t ci = (size_t)bh * NCHUNK + c;
    LAS float* part = (LAS float*)(lds + SCR); LAS float* WL = (LAS float*)(lds + SCR + 2048);
#define MAT(s) (lds + (s) * MB)
    {
        const bf16_t* Z = (const bf16_t*)(P.ws + WS_Z); const bf16_t* LW = (const bf16_t*)(P.ws + WS_LW); const bf16_t* LA = (const bf16_t*)(P.ws + WS_LA);
        const int ch = tid & 63, tq = tid >> 6, cc = h * 64 + ch; const size_t row0 = tok0 + 8 * tq;
        const float mur = P.mu[RW_R + cc], muk = P.mu[RW_K + cc], muv = P.mu[RW_V + cc], w0c = P.w0[cc], a0c = P.a0[cc], kkc = P.k_k[cc], kac = P.k_a[cc];
        const bf16_t* zp = Z + row0 * ZW + ZR + cc;
        const bool first = (c == 0) && (tq == 0); const bf16_t* zq = first ? zp : zp - ZW; const float pm = first ? 0.f : 1.f;
        unsigned short lr[9], lk[9], lv[9], llw[8], lla[8];
        lr[0] = zq[RW_R]; lk[0] = zq[RW_K]; lv[0] = zq[RW_V];
#pragma unroll
        for (int i = 0; i < 8; ++i) { const bf16_t* zi = zp + (size_t)i * ZW; lr[i + 1] = zi[RW_R]; lk[i + 1] = zi[RW_K]; lv[i + 1] = zi[RW_V]; const size_t o = (row0 + i) * 512 + cc; llw[i] = LW[o]; lla[i] = LA[o]; }
        float cum[8], vr[8], vk[8], vkk[8], vka[8], ssq[8]; unsigned short vv16[8]; float run = 0.f;
#pragma unroll
        for (int i = 0; i < 8; ++i) { const float pmi = (i == 0) ? pm : 1.f; const float zr1 = bf2f(lr[i + 1]), zk1 = bf2f(lk[i + 1]), zv1 = bf2f(lv[i + 1]);
            vr[i] = zr1 + (bf2f(lr[i]) * pmi - zr1) * mur; vk[i] = zk1 + (bf2f(lk[i]) * pmi - zk1) * muk; vv16[i] = (unsigned short)f2bf(zv1 + (bf2f(lv[i]) * pmi - zv1) * muv);
            vkk[i] = vk[i] * kkc; ssq[i] = vkk[i] * vkk[i]; }
#pragma unroll
        for (int o = 1; o < 64; o <<= 1) {
#pragma unroll
            for (int i = 0; i < 8; ++i) ssq[i] += __shfl_xor(ssq[i], o); }
#pragma unroll
        for (int i = 0; i < 8; ++i) {
            const float wl = w0c + bf2f(llw[i]); const float sp = fmaxf(-wl, 0.f) + __logf(1.0f + __expf(-fabsf(wl)));
            run += -__expf(-sp - 0.5f); cum[i] = run;
            const float a = __builtin_amdgcn_rcpf(1.0f + __expf(-(a0c + bf2f(lla[i]))));
            const float kk = vkk[i] * __builtin_amdgcn_rcpf(fmaxf(__builtin_amdgcn_sqrtf(ssq[i]), 1e-12f));
            vk[i] = vk[i] * (1.0f + (a - 1.0f) * kac); vkk[i] = kk; vka[i] = kk * a; }
        part[tq * 64 + ch] = run;
        __syncthreads();
        float pre = 0.f;
#pragma unroll
        for (int g = 0; g < 8; ++g) { const float pvv = part[g * 64 + ch]; pre += (g < tq) ? pvv : 0.f; }
        float eprev = __expf(pre);
        unsigned atT[4], ktT[4], btT[4], vT[4]; unsigned short hold[4] = {0, 0, 0, 0};
#pragma unroll
        for (int i = 0; i < 8; ++i) { const int t = 8 * tq + i;
            const float cm = pre + cum[i], e1 = __expf(cm), einv = __expf(-cm);
            const unsigned short at = (unsigned short)f2bf(-vkk[i] * eprev), rt = (unsigned short)f2bf(vr[i] * e1), kt = (unsigned short)f2bf(vk[i] * einv), bt = (unsigned short)f2bf(vka[i] * einv), vv = vv16[i];
            eprev = e1;
            *(LAS unsigned short*)(MAT(S_AT) + moff(t, ch)) = at; *(LAS unsigned short*)(MAT(S_RT) + moff(t, ch)) = rt; *(LAS unsigned short*)(MAT(S_KT) + moff(t, ch)) = kt; *(LAS unsigned short*)(MAT(S_BT) + moff(t, ch)) = bt;
            if (i & 1) { atT[i >> 1] = hold[0] | ((unsigned)at << 16); ktT[i >> 1] = hold[1] | ((unsigned)kt << 16); btT[i >> 1] = hold[2] | ((unsigned)bt << 16); vT[i >> 1] = hold[3] | ((unsigned)vv << 16); }
            else { hold[0] = at; hold[1] = kt; hold[2] = bt; hold[3] = vv; }
            if (i == 7 && tq == 7) WL[ch] = e1; }
        *(LAS u32x4*)(MAT(S_ATT) + moff(ch, 8 * tq)) = (u32x4){atT[0], atT[1], atT[2], atT[3]}; *(LAS u32x4*)(MAT(S_KTT) + moff(ch, 8 * tq)) = (u32x4){ktT[0], ktT[1], ktT[2], ktT[3]};
        *(LAS u32x4*)(MAT(S_BTT) + moff(ch, 8 * tq)) = (u32x4){btT[0], btT[1], btT[2], btT[3]}; *(LAS u32x4*)(MAT(S_VT) + moff(ch, 8 * tq)) = (u32x4){vT[0], vT[1], vT[2], vT[3]};
    }
    __syncthreads();
    const f32x16 zero = f32x16{};
    if (grp == 0) { f32x16 d = mm_nt(MAT(S_AT), i0, MAT(S_BT), j0, zero, r32, hi); mask_tri<0>(d, i0, j0, r32, hi); store_t(MAT(S_NT), d, i0, j0, r32, hi);
        d = mm_nt(MAT(S_KT), i0, MAT(S_AT), j0, zero, r32, hi); mask_tri<1>(d, i0, j0, r32, hi); store_t(MAT(S_MAK), d, i0, j0, r32, hi);
        d = mm_nt(MAT(S_KT), i0, MAT(S_RT), j0, zero, r32, hi); mask_tri<2>(d, i0, j0, r32, hi); store_t(MAT(S_MRK), d, i0, j0, r32, hi); }
    else { f32x16 d = mm_nt(MAT(S_BT), i0, MAT(S_AT), j0, zero, r32, hi); mask_tri<1>(d, i0, j0, r32, hi); store_t(MAT(S_N), d, i0, j0, r32, hi);
#pragma unroll
        for (int r = 0; r < 16; ++r) if (i0 + crow(r, hi) == j0 + r32) d[r] = 1.0f;
        store_t(MAT(S_TA), d, i0, j0, r32, hi);
        d = mm_nt(MAT(S_BT), i0, MAT(S_RT), j0, zero, r32, hi); mask_tri<2>(d, i0, j0, r32, hi); store_t(MAT(S_MRB), d, i0, j0, r32, hi); }
    __syncthreads();
#pragma unroll
    for (int s = 1; s <= 6; ++s) {
        const int mc = (s & 1) ? S_N : S_AT, mcT = (s & 1) ? S_NT : S_KT, mn = (s & 1) ? S_AT : S_N, mnT = (s & 1) ? S_KT : S_NT;
        const int tc = (s & 1) ? S_TB : S_TA, tn = (s & 1) ? S_TA : S_TB;
        if (s <= 5) {
            if (grp == 0) { const f32x16 d = mm_nt(MAT(mc), i0, MAT(mcT), j0, zero, r32, hi); store_t(MAT(mnT), d, i0, j0, r32, hi); }
            else { const f32x16 d = mm_nt(MAT(mcT), i0, MAT(mc), j0, zero, r32, hi); store_t(MAT(mn), d, i0, j0, r32, hi); }
        }
        if (s >= 2 && grp == (s <= 5 ? 0 : 1) ) {
            f32x16 d = mm_nt(MAT(mcT), i0, MAT(tc), j0, zero, r32, hi);
#pragma unroll
            for (int g = 0; g < 4; ++g) { const u32x2 tv = *(const LAS u32x2*)(MAT(tc) + moff(j0 + r32, i0 + 8 * g + 4 * hi)); d[4 * g] += bflo(tv.x); d[4 * g + 1] += bfhi(tv.x); d[4 * g + 2] += bflo(tv.y); d[4 * g + 3] += bfhi(tv.y); }
            store_t(MAT(tn), d, i0, j0, r32, hi);
        }
        __syncthreads();
    }
    if (grp == 0) { const f32x16 d = mm_nt(MAT(S_TB), i0, MAT(S_ATT), j0, zero, r32, hi); store_t(MAT(S_BT), d, i0, j0, r32, hi); }
    else { const f32x16 d = mm_nt(MAT(S_MAK), i0, MAT(S_VT), j0, zero, r32, hi); store_t(MAT(S_N), d, i0, j0, r32, hi); }
    __syncthreads();
    if (grp == 0) { const f32x16 d = mm_nt(MAT(S_TB), i0, MAT(S_N), j0, zero, r32, hi); store_t(MAT(S_NT), d, i0, j0, r32, hi);
        f32x16 q = mm_nt(MAT(S_BT), i0, MAT(S_MRB), j0, zero, r32, hi);
#pragma unroll
        for (int g = 0; g < 4; ++g) { const u32x2 rv = *(const LAS u32x2*)(MAT(S_RT) + moff(j0 + r32, i0 + 8 * g + 4 * hi)); q[4 * g] += bflo(rv.x); q[4 * g + 1] += bfhi(rv.x); q[4 * g + 2] += bflo(rv.y); q[4 * g + 3] += bfhi(rv.y); }
        store_t(MAT(S_KT), q, i0, j0, r32, hi); }
    else { f32x16 g_ = mm_nt(MAT(S_BT), i0, MAT(S_BTT), j0, zero, r32, hi);
        const float wl = WL[j0 + r32];
#pragma unroll
        for (int r = 0; r < 16; ++r) { if (i0 + crow(r, hi) == j0 + r32) g_[r] += 1.0f; g_[r] *= wl; }
        store_t(MAT(S_AT), g_, i0, j0, r32, hi); }
    __syncthreads();
    if (grp == 0) { f32x16 d = mm_nt(MAT(S_BTT), i0, MAT(S_NT), j0, zero, r32, hi); d = mm_nt(MAT(S_KTT), i0, MAT(S_VT), j0, d, r32, hi);
        float* HT = (float*)(P.ws + WS_HT) + ci * 4096 + (size_t)wq * 1024 + lane;
#pragma unroll
        for (int g = 0; g < 4; ++g) { const f32x4 wl4 = *(const LAS f32x4*)(WL + i0 + 8 * g + 4 * hi);
#pragma unroll
            for (int i = 0; i < 4; ++i) HT[(4 * g + i) * 64] = d[4 * g + i] * wl4[i]; } }
    else { f32x16 d = mm_nt(MAT(S_MRB), i0, MAT(S_NT), j0, zero, r32, hi); d = mm_nt(MAT(S_MRK), i0, MAT(S_VT), j0, d, r32, hi);
        unsigned* Y0 = (unsigned*)(P.ws + WS_Y0) + ci * 2048 + (size_t)wq * 512 + lane;
#pragma unroll
        for (int r2 = 0; r2 < 8; ++r2) Y0[r2 * 64] = pk2(d[2 * r2], d[2 * r2 + 1]); }
    { u32x4* GTg = (u32x4*)((unsigned char*)P.out + DO_GT + ci * MB); u32x4* QIg = (u32x4*)(P.ws + WS_QI + ci * MB);
        GTg[tid] = *(const LAS u32x4*)(MAT(S_AT) + tid * 16); QIg[tid] = *(const LAS u32x4*)(MAT(S_KT) + tid * 16); }
    __syncthreads();
#undef MAT
}

__device__ __forceinline__ void pass2_seq(KPR P, LAS unsigned char* lds, int bh, int tid) {
    const int lane = tid & 63, wave = tid >> 6, r32 = lane & 31, hi = lane >> 5, wq = wave & 3, i0 = 32 * (wq >> 1), j0 = 32 * (wq & 1);
    LAS unsigned char* Sm = lds; LAS unsigned char* G0 = lds + MB; LAS unsigned char* G1 = lds + 2 * MB;
    const size_t ci0 = (size_t)bh * NCHUNK;
    const u32x4* GTg = (const u32x4*)((const unsigned char*)P.out + DO_GT + ci0 * MB); u32x4* SCg = (u32x4*)(P.ws + WS_SC + ci0 * MB);
    const float* HT = (const float*)(P.ws + WS_HT) + ci0 * 4096 + (size_t)wq * 1024 + lane;
    *(LAS u32x4*)(Sm + tid * 16) = (u32x4){0u, 0u, 0u, 0u};
    *(LAS u32x4*)(G0 + tid * 16) = GTg[tid];
    u32x4 gnext = GTg[512 + tid];
    f32x16 hcur, hnext;
    if (wave < 4) {
#pragma unroll
        for (int r = 0; r < 16; ++r) { hcur[r] = HT[r * 64]; hnext[r] = HT[4096 + r * 64]; } }
    __syncthreads();
    for (int c = 0; c < NCHUNK; ++c) {
        LAS unsigned char* Gc = (c & 1) ? G1 : G0; LAS unsigned char* Gn = (c & 1) ? G0 : G1;
        SCg[(size_t)c * 512 + tid] = *(const LAS u32x4*)(Sm + tid * 16);
        f32x16 d = hcur;
        if (wave < 4) d = mm_nt(Gc, i0, Sm, j0, d, r32, hi);
        __syncthreads();
        if (wave < 4) store_t(Sm, d, i0, j0, r32, hi);
        *(LAS u32x4*)(Gn + tid * 16) = gnext;
        const int c2 = (c + 2 < NCHUNK) ? c + 2 : NCHUNK - 1;
        gnext = GTg[(size_t)c2 * 512 + tid];
        if (wave < 4) { hcur = hnext;
#pragma unroll
            for (int r = 0; r < 16; ++r) hnext[r] = HT[(size_t)c2 * 4096 + r * 64]; }
        __syncthreads();
    }
}

__device__ __forceinline__ void pass3_chunk(KPR P, LAS unsigned char* lds, int bh, int c, int tid) {
    const int lane = tid & 63, wave = tid >> 6, r32 = lane & 31, hi = lane >> 5, wq = wave & 3, i0 = 32 * (wq >> 1), j0 = 32 * (wq & 1);
    const int b = bh >> 3, h = bh & 7; const size_t tok0 = (size_t)b * SEQ + (size_t)c * 64; const size_t ci = (size_t)bh * NCHUNK + c;
    LAS unsigned char* Qm = lds; LAS unsigned char* Sm = lds + MB; LAS float* Yl = (LAS float*)(lds + 2 * MB);
    *(LAS u32x4*)(Qm + tid * 16) = ((const u32x4*)(P.ws + WS_QI + ci * MB))[tid];
    *(LAS u32x4*)(Sm + tid * 16) = ((const u32x4*)(P.ws + WS_SC + ci * MB))[tid];
    f32x16 d = f32x16{};
    if (wave < 4) { const unsigned* Y0 = (const unsigned*)(P.ws + WS_Y0) + ci * 2048 + (size_t)wq * 512 + lane;
#pragma unroll
        for (int r2 = 0; r2 < 8; ++r2) { const unsigned w = Y0[r2 * 64]; d[2 * r2] = bflo(w); d[2 * r2 + 1] = bfhi(w); } }
    __syncthreads();
    if (wave < 4) { d = mm_nt(Qm, i0, Sm, j0, d, r32, hi);
#pragma unroll
        for (int r = 0; r < 16; ++r) Yl[(i0 + crow(r, hi)) * 65 + j0 + r32] = d[r]; }
    __syncthreads();
    const bf16_t* Z = (const bf16_t*)(P.ws + WS_Z); const bf16_t* LA = (const bf16_t*)(P.ws + WS_LA); const bf16_t* LG = (const bf16_t*)(P.ws + WS_LG);
    bf16_t* AO = (bf16_t*)(P.ws + WS_AO); const int cc = h * 64 + lane;
    const float lnw = P.ln_w[cc], lnb = P.ln_b[cc], rkc = P.r_k[cc], mur = P.mu[RW_R + cc], muk = P.mu[RW_K + cc], muv = P.mu[RW_V + cc], a0c = P.a0[cc], kac = P.k_a[cc];
    const bf16_t* zp = Z + (tok0 + wave * 8) * ZW + ZR + cc; const bool first = (c == 0) && (wave == 0); const bf16_t* zq = first ? zp : zp - ZW; const float pm = first ? 0.f : 1.f;
    unsigned short lr[9], lk[9], lv[9], lla[8], llg[8];
    lr[0] = zq[RW_R]; lk[0] = zq[RW_K]; lv[0] = zq[RW_V];
#pragma unroll
    for (int i = 0; i < 8; ++i) { const bf16_t* zi = zp + (size_t)i * ZW; lr[i + 1] = zi[RW_R]; lk[i + 1] = zi[RW_K]; lv[i + 1] = zi[RW_V]; const size_t o = (tok0 + wave * 8 + i) * 512 + cc; lla[i] = LA[o]; llg[i] = LG[o]; }
    float y[8], s1[8], s2[8], s3[8], vvv[8];
#pragma unroll
    for (int i = 0; i < 8; ++i) { const float pmi = (i == 0) ? pm : 1.f; const float zr1 = bf2f(lr[i + 1]), zk1 = bf2f(lk[i + 1]), zv1 = bf2f(lv[i + 1]);
        const float r = zr1 + (bf2f(lr[i]) * pmi - zr1) * mur, zk = zk1 + (bf2f(lk[i]) * pmi - zk1) * muk; vvv[i] = zv1 + (bf2f(lv[i]) * pmi - zv1) * muv;
        const float a = __builtin_amdgcn_rcpf(1.0f + __expf(-(a0c + bf2f(lla[i])))); const float k = zk * (1.0f + (a - 1.0f) * kac);
        y[i] = Yl[(wave * 8 + i) * 65 + lane]; s1[i] = y[i]; s3[i] = r * k * rkc; }
#pragma unroll
    for (int o = 1; o < 64; o <<= 1) {
#pragma unroll
        for (int i = 0; i < 8; ++i) { s1[i] += __shfl_xor(s1[i], o); s3[i] += __shfl_xor(s3[i], o); } }
#pragma unroll
    for (int i = 0; i < 8; ++i) { y[i] -= s1[i] * (1.f / 64.f); s2[i] = y[i] * y[i]; }
#pragma unroll
    for (int o = 1; o < 64; o <<= 1) {
#pragma unroll
        for (int i = 0; i < 8; ++i) s2[i] += __shfl_xor(s2[i], o); }
#pragma unroll
    for (int i = 0; i < 8; ++i) { const size_t tok = tok0 + wave * 8 + i; const float yn = y[i] * rsqrtf(s2[i] * (1.f / 64.f) + 64e-5f) * lnw + lnb;
        AO[tok * DM + 512 + cc] = (bf16_t)f2bf((yn + s3[i] * vvv[i]) * bf2f(llg[i])); }
}

constexpr size_t WS_W2T = 29 * MiB, WS_A2T = 29 * MiB + 65536, WS_G2T = 29 * MiB + 131072;
__device__ __forceinline__ bf16x8 act8(const bf16_t* zc, const bf16_t* zpv, float pmask, const float* mu, int mode) {
    const u32x4 c = *(const u32x4*)zc, p = *(const u32x4*)zpv;
    const f32x4 m0 = *(const f32x4*)mu, m1 = *(const f32x4*)(mu + 4);
    const unsigned cw[4] = {c.x, c.y, c.z, c.w}, pw[4] = {p.x, p.y, p.z, p.w}; const float um[8] = {m0[0], m0[1], m0[2], m0[3], m1[0], m1[1], m1[2], m1[3]}; float v[8];
#pragma unroll
    for (int j = 0; j < 4; ++j) { const float c0 = bflo(cw[j]), c1 = bfhi(cw[j]), p0 = bflo(pw[j]) * pmask, p1 = bfhi(pw[j]) * pmask;
        v[2 * j] = c0 + (p0 - c0) * um[2 * j]; v[2 * j + 1] = c1 + (p1 - c1) * um[2 * j + 1]; }
#pragma unroll
    for (int j = 0; j < 8; ++j) { if (mode == 0) { const float e = __expf(-2.0f * fabsf(v[j])); const float th = (1.0f - e) * __builtin_amdgcn_rcpf(1.0f + e); v[j] = v[j] < 0.f ? -th : th; } else if (mode == 2) v[j] = __builtin_amdgcn_rcpf(1.0f + __expf(-v[j])); }
    u32x4 w; w.x = pk2(v[0], v[1]); w.y = pk2(v[2], v[3]); w.z = pk2(v[4], v[5]); w.w = pk2(v[6], v[7]);
    return __builtin_bit_cast(bf16x8, w);
}
__device__ __forceinline__ void lora_task(KPR P, int task, int lane) {
    const int r32 = lane & 31, hi = lane >> 5; const size_t row = (size_t)task * 32 + r32; const bool first = (row % SEQ) == 0;
    const bf16_t* Z = (const bf16_t*)(P.ws + WS_Z) + row * ZW + ZR + 8 * hi; const bf16_t* Zp = first ? Z : Z - ZW; const float pmask = first ? 0.f : 1.f;
    const float* mub = P.mu + 8 * hi;
    bf16x8 xw[4], xa[4], xg[8];
#pragma unroll
    for (int ks = 0; ks < 4; ++ks) { xw[ks] = act8(Z + RW_W + 16 * ks, Zp + RW_W + 16 * ks, pmask, mub + RW_W + 16 * ks, 0); xa[ks] = act8(Z + RW_A + 16 * ks, Zp + RW_A + 16 * ks, pmask, mub + RW_A + 16 * ks, 1); asm volatile("" ::: "memory"); }
#pragma unroll
    for (int ks = 0; ks < 8; ++ks) { xg[ks] = act8(Z + RW_G + 16 * ks, Zp + RW_G + 16 * ks, pmask, mub + RW_G + 16 * ks, 2); if (ks & 1) asm volatile("" ::: "memory"); }
    const bf16_t* W2T = (const bf16_t*)(P.ws + WS_W2T) + r32 * 64 + 8 * hi; const bf16_t* A2T = (const bf16_t*)(P.ws + WS_A2T) + r32 * 64 + 8 * hi; const bf16_t* G2T = (const bf16_t*)(P.ws + WS_G2T) + r32 * 128 + 8 * hi;
    bf16_t* LW = (bf16_t*)(P.ws + WS_LW) + row * 512 + 4 * hi; bf16_t* LA = (bf16_t*)(P.ws + WS_LA) + row * 512 + 4 * hi; bf16_t* LG = (bf16_t*)(P.ws + WS_LG) + row * 512 + 4 * hi;
#pragma nounroll
    for (int cb = 0; cb < 16; ++cb) {
        f32x16 dw = f32x16{}, da = f32x16{}, dg = f32x16{};
#pragma unroll
        for (int ks = 0; ks < 4; ++ks) { dw = __builtin_amdgcn_mfma_f32_32x32x16_bf16(*(const bf16x8*)(W2T + cb * 32 * 64 + 16 * ks), xw[ks], dw, 0, 0, 0); da = __builtin_amdgcn_mfma_f32_32x32x16_bf16(*(const bf16x8*)(A2T + cb * 32 * 64 + 16 * ks), xa[ks], da, 0, 0, 0); }
#pragma unroll
        for (int ks = 0; ks < 8; ++ks) dg = __builtin_amdgcn_mfma_f32_32x32x16_bf16(*(const bf16x8*)(G2T + cb * 32 * 128 + 16 * ks), xg[ks], dg, 0, 0, 0);
#pragma unroll
        for (int g = 0; g < 4; ++g) { u32x2 w; w.x = pk2(dw[4 * g], dw[4 * g + 1]); w.y = pk2(dw[4 * g + 2], dw[4 * g + 3]); *(u32x2*)(LW + cb * 32 + 8 * g) = w;
            w.x = pk2(da[4 * g], da[4 * g + 1]); w.y = pk2(da[4 * g + 2], da[4 * g + 3]); *(u32x2*)(LA + cb * 32 + 8 * g) = w;
            w.x = pk2(dg[4 * g], dg[4 * g + 1]); w.y = pk2(dg[4 * g + 2], dg[4 * g + 3]); *(u32x2*)(LG + cb * 32 + 8 * g) = w; }
    }
}
}
namespace rt {
__device__ __forceinline__ int woff(int e, int k) { return e * 2048 + ((((k >> 3) ^ (e & 15))) << 4) + (k & 7) * 2; }
constexpr size_t WS_WRI = 30 * MiB;
__device__ __forceinline__ void build_w(KPR P, int tid) {
    unsigned char* img = P.ws + WS_WRI; const int e = tid & 31, kq = tid >> 5;
    for (int i0 = 0; i0 < 64; i0 += 8) { float w[8];
#pragma unroll
        for (int i = 0; i < 8; ++i) { const int k = kq * 64 + i0 + i; w[i] = P.moe_norm[k] * P.w_router[k * 32 + e]; }
#pragma unroll
        for (int i = 0; i < 8; ++i) { const int k = kq * 64 + i0 + i; const unsigned h = f2bf(w[i]); const unsigned l = f2bf(w[i] - bf2f(h));
            *(unsigned short*)(img + woff(e, k)) = (unsigned short)h; *(unsigned short*)(img + 65536 + woff(e, k)) = (unsigned short)l; } }
}
__device__ __forceinline__ void copy_w(KPR P, LAS unsigned char* lds, int tid) {
    const u32x4* img = (const u32x4*)(P.ws + WS_WRI);
#pragma unroll 4
    for (int i = 0; i < 16; ++i) *(LAS u32x4*)(lds + (size_t)(i * 512 + tid) * 16) = img[i * 512 + tid];
}
__device__ __forceinline__ void split8(const f32x4& a, const f32x4& b, bf16x8& h, bf16x8& l) {
    unsigned hh[8]; float v[8] = {a[0], a[1], a[2], a[3], b[0], b[1], b[2], b[3]};
#pragma unroll
    for (int j = 0; j < 8; ++j) hh[j] = f2bf(v[j]);
    u32x4 hw, lw;
    hw.x = hh[0] | (hh[1] << 16); hw.y = hh[2] | (hh[3] << 16); hw.z = hh[4] | (hh[5] << 16); hw.w = hh[6] | (hh[7] << 16);
    lw.x = pk2(v[0] - bf2f(hh[0]), v[1] - bf2f(hh[1])); lw.y = pk2(v[2] - bf2f(hh[2]), v[3] - bf2f(hh[3])); lw.z = pk2(v[4] - bf2f(hh[4]), v[5] - bf2f(hh[5])); lw.w = pk2(v[6] - bf2f(hh[6]), v[7] - bf2f(hh[7]));
    h = __builtin_bit_cast(bf16x8, hw); l = __builtin_bit_cast(bf16x8, lw);
}
__device__ __forceinline__ void route_task(KPR P, const LAS unsigned char* wlds, int task, int lane) {
    const int r32 = lane & 31, hi = lane >> 5; const int row = task * 32 + r32;
    const float* xrow = (const float*)(P.ws + WS_X1) + (size_t)row * DM + 8 * hi;
    f32x16 acc = f32x16{}; float ss = 0.f;
    f32x4 xa[4], xb[4];
#pragma unroll
    for (int j = 0; j < 4; ++j) { xa[j] = *(const f32x4*)(xrow + 16 * j); xb[j] = *(const f32x4*)(xrow + 16 * j + 4); }
    for (int ks0 = 0; ks0 < 64; ks0 += 4) {
#pragma unroll
        for (int j = 0; j < 4; ++j) { const int ks = ks0 + j; const f32x4 a = xa[j], b = xb[j];
            const int kn = (ks + 4 < 64) ? ks + 4 : ks; xa[j] = *(const f32x4*)(xrow + 16 * kn); xb[j] = *(const f32x4*)(xrow + 16 * kn + 4);
            ss += (a[0] * a[0] + a[1] * a[1]) + (a[2] * a[2] + a[3] * a[3]) + (b[0] * b[0] + b[1] * b[1]) + (b[2] * b[2] + b[3] * b[3]);
            bf16x8 xh, xl; split8(a, b, xh, xl);
            const bf16x8 wh = *(const LAS bf16x8*)(wlds + woff(r32, 16 * ks + 8 * hi)), wl = *(const LAS bf16x8*)(wlds + 65536 + woff(r32, 16 * ks + 8 * hi));
            acc = __builtin_amdgcn_mfma_f32_32x32x16_bf16(wh, xh, acc, 0, 0, 0); acc = __builtin_amdgcn_mfma_f32_32x32x16_bf16(wh, xl, acc, 0, 0, 0); acc = __builtin_amdgcn_mfma_f32_32x32x16_bf16(wl, xh, acc, 0, 0, 0); }
    }
    ss += __shfl_xor(ss, 32);
    const float rstd = rsqrtf(ss * (1.f / DM) + 1e-6f);
    float lg[16];
#pragma unroll
    for (int g = 0; g < 4; ++g) { const f32x4 bb = *(const f32x4*)(P.b_router + 8 * g + 4 * hi);
#pragma unroll
        for (int i = 0; i < 4; ++i) lg[4 * g + i] = acc[4 * g + i] * rstd + bb[i]; }
    float tv[4]; int ti[4];
#pragma unroll
    for (int k = 0; k < 4; ++k) { float bv = lg[0]; int bi = 4 * hi;
#pragma unroll
        for (int r = 1; r < 16; ++r) { const int e = (r & 3) + 8 * (r >> 2) + 4 * hi; if (lg[r] > bv) { bv = lg[r]; bi = e; } }
        const float pv = __shfl_xor(bv, 32); const int pi = __shfl_xor(bi, 32);
        if (pv > bv || (pv == bv && pi < bi)) { bv = pv; bi = pi; }
        tv[k] = bv; ti[k] = bi;
#pragma unroll
        for (int r = 0; r < 16; ++r) { const int e = (r & 3) + 8 * (r >> 2) + 4 * hi; if (e == bi) lg[r] = -INFINITY; } }
    const float e1 = __expf(tv[1] - tv[0]), e2 = __expf(tv[2] - tv[0]), e3 = __expf(tv[3] - tv[0]), inv = 1.f / (1.f + e1 + e2 + e3);
    const int c0 = hi ? ti[2] : ti[0], c1 = hi ? ti[3] : ti[1]; const float g0 = (hi ? e2 : 1.f) * inv, g1 = (hi ? e3 : e1) * inv;
    const unsigned long long ltm = (1ull << lane) - 1ull; int mycnt = 0, rk0 = 0, rk1 = 0;
    for (int e = 0; e < 32; ++e) { const unsigned long long m0 = __ballot(c0 == e), m1 = __ballot(c1 == e); const int n0 = __popcll(m0);
        if (lane == e) mycnt = n0 + __popcll(m1);
        if (c0 == e) rk0 = __popcll(m0 & ltm);
        if (c1 == e) rk1 = n0 + __popcll(m1 & ltm); }
    unsigned* cnt = (unsigned*)(P.ws + WS_CTL) + CW_CNT; int base = 0;
    if (lane < 32 && mycnt > 0) base = (int)atomicAdd(cnt + lane, (unsigned)mycnt);
    rk0 += __shfl(base, c0); rk1 += __shfl(base, c1);
    int* route = (int*)(P.ws + WS_ROUTE); int* tokslot = (int*)(P.ws + WS_TOKSLOT); float* gateslot = (float*)(P.ws + WS_GATESLOT);
    tokslot[(size_t)c0 * NTOK + rk0] = row; gateslot[(size_t)c0 * NTOK + rk0] = g0; tokslot[(size_t)c1 * NTOK + rk1] = row; gateslot[(size_t)c1 * NTOK + rk1] = g1;
    route[(size_t)row * 12 + 2 * hi] = c0; route[(size_t)row * 12 + 2 * hi + 1] = c1; route[(size_t)row * 12 + 4 + 2 * hi] = rk0; route[(size_t)row * 12 + 4 + 2 * hi + 1] = rk1;
    unsigned char* xn = P.ws + WS_XN + (size_t)row * DM + 8 * hi; const float* gn = P.moe_norm + 8 * hi;
#pragma unroll
    for (int j = 0; j < 4; ++j) { xa[j] = *(const f32x4*)(xrow + 16 * j); xb[j] = *(const f32x4*)(xrow + 16 * j + 4); }
    for (int ks0 = 0; ks0 < 64; ks0 += 4) {
#pragma unroll
        for (int j = 0; j < 4; ++j) { const int ks = ks0 + j; const f32x4 a = xa[j], b = xb[j], ga = *(const f32x4*)(gn + 16 * ks), gb = *(const f32x4*)(gn + 16 * ks + 4);
            const int kn = (ks + 4 < 64) ? ks + 4 : ks; xa[j] = *(const f32x4*)(xrow + 16 * kn); xb[j] = *(const f32x4*)(xrow + 16 * kn + 4);
            u32x2 w; w.x = pk4_fp8(a[0] * rstd * ga[0], a[1] * rstd * ga[1], a[2] * rstd * ga[2], a[3] * rstd * ga[3]); w.y = pk4_fp8(b[0] * rstd * gb[0], b[1] * rstd * gb[1], b[2] * rstd * gb[2], b[3] * rstd * gb[3]);
            *(u32x2*)(xn + 16 * ks) = w; }
    }
}
}
namespace attn_body {
using bf16=unsigned short;
using bf16x8=__attribute__((ext_vector_type(8)))short;
using s16x4=__attribute__((ext_vector_type(4)))short;
using f32x16=__attribute__((ext_vector_type(16)))float;
using u32x4=__attribute__((ext_vector_type(4)))unsigned;
constexpr int BATCH=4,NHEAD=8,SEQ=8192,D=64,DM=3840,OP=1024;
constexpr int NW=8,QBLK=32,QB=QBLK*NW,KVBLK=64,NQB=SEQ/QB;
constexpr int ATTN_PITCH=DM, ATTN_UNIT_ROWS=QB;
__device__ __forceinline__ int crow(int r,int hi){return (r&3)+8*(r>>2)+4*hi;}
#define SBAR() __builtin_amdgcn_sched_barrier(0)
__device__ __forceinline__ void cmask(f32x16&p0,f32x16&p1,int jb,int qrel,int hi){
  const float NEG=-INFINITY; int kb=64*jb+4*hi;
  #pragma unroll
  for(int r=0;r<16;++r){int kv=kb+(r&3)+8*(r>>2); if(kv>qrel)p0[r]=NEG; if(kv+32>qrel)p1[r]=NEG;}
}

constexpr int NSLOT=3, SLOTB=8192;
constexpr int LDS_K=0, LDS_V=NSLOT*SLOTB, LDS_WS=2*NSLOT*SLOTB, LDS_OST=LDS_WS+NW*64*4, LDS_C2=LDS_OST+NW*4096, LDS_BYTES=LDS_C2+SEQ*4;
constexpr float C2=0.125f*1.4426950408889634f;
__device__ __forceinline__ void glds16(const void*gsrc,unsigned lds_dst){unsigned keep;
  asm volatile("s_mov_b32 %0, m0\n\ts_mov_b32 m0, %2\n\ts_nop 0\n\tglobal_load_lds_dwordx4 %1, off\n\ts_mov_b32 m0, %0":"=&s"(keep):"v"(gsrc),"s"(lds_dst):"memory");}
__device__ __forceinline__ float max3f(float a,float b,float c){float r;asm("v_max3_f32 %0, %1, %2, %3":"=v"(r):"v"(a),"v"(b),"v"(c));return r;}
__device__ __forceinline__ float max2f(float a,float b){float r;asm("v_max_f32_e32 %0, %1, %2":"=v"(r):"v"(a),"v"(b));return r;}
__device__ __forceinline__ float fadd_s(float a,float b){float r;asm("v_add_f32_e32 %0, %1, %2":"=v"(r):"v"(a),"v"(b));return r;}
__device__ __forceinline__ float fsub_s(float a,float b){float r;asm("v_sub_f32_e32 %0, %1, %2":"=v"(r):"v"(a),"v"(b));return r;}
typedef float f32x2_t __attribute__((ext_vector_type(2))); typedef float f32x4v __attribute__((ext_vector_type(4))); typedef __bf16 bf16x2_t __attribute__((ext_vector_type(2)));
__device__ __forceinline__ unsigned cvtpk_s(float lo,float hi){f32x2_t v={lo,hi};bf16x2_t b=__builtin_convertvector(v,bf16x2_t);return __builtin_bit_cast(unsigned,b);}
#define WAIT_BAR(N) asm volatile("s_waitcnt vmcnt(" #N ") lgkmcnt(0)\n\ts_barrier":::"memory")

__device__ __forceinline__ void qkt(f32x16&p0,f32x16&p1,const char*Kslot,const bf16x8*qr,int r32,int hi){
  const char*kb=Kslot+hi*1024+r32*16;
  #pragma unroll
  for(int d0=0;d0<4;++d0){
    const bf16x8 b0=*reinterpret_cast<const bf16x8*>(kb+d0*2048);
    const bf16x8 b1=*reinterpret_cast<const bf16x8*>(kb+d0*2048+512);
    p0=__builtin_amdgcn_mfma_f32_32x32x16_bf16(b0,qr[d0],p0,0,0,0);p1=__builtin_amdgcn_mfma_f32_32x32x16_bf16(b1,qr[d0],p1,0,0,0);}
}
typedef __attribute__((address_space(3))) const char* lds_cptr;
typedef short v4i16_t __attribute__((ext_vector_type(4)));
__device__ __forceinline__ void kload8(bf16x8*kf,lds_cptr kp){
  kf[0]=*(const __attribute__((address_space(3))) bf16x8*)(kp);      kf[1]=*(const __attribute__((address_space(3))) bf16x8*)(kp+512);
  kf[2]=*(const __attribute__((address_space(3))) bf16x8*)(kp+2048); kf[3]=*(const __attribute__((address_space(3))) bf16x8*)(kp+2560);
  kf[4]=*(const __attribute__((address_space(3))) bf16x8*)(kp+4096); kf[5]=*(const __attribute__((address_space(3))) bf16x8*)(kp+4608);
  kf[6]=*(const __attribute__((address_space(3))) bf16x8*)(kp+6144); kf[7]=*(const __attribute__((address_space(3))) bf16x8*)(kp+6656);
}
__device__ __forceinline__ void kload2(bf16x8*kf,lds_cptr kp,int j){ kf[2*j]=*(const __attribute__((address_space(3))) bf16x8*)(kp+j*2048); kf[2*j+1]=*(const __attribute__((address_space(3))) bf16x8*)(kp+j*2048+512); }
__device__ __forceinline__ s16x4 vtr(lds_cptr p){ return __builtin_bit_cast(s16x4,__builtin_amdgcn_ds_read_tr16_b64_v4i16((__attribute__((address_space(3))) v4i16_t*)p)); }
__device__ __forceinline__ float rowmax(const f32x16&p0,const f32x16&p1){
  float a=max3f(p0[0],p0[1],p1[0]),b=max3f(p0[2],p0[3],p1[1]);a=max3f(a,p1[2],p1[3]);
  #pragma unroll
  for(int r=4;r<16;r+=4){a=max3f(a,p0[r],p0[r+1]);b=max3f(b,p0[r+2],p0[r+3]);a=max3f(a,p1[r],p1[r+1]);b=max3f(b,p1[r+2],p1[r+3]);}
  const float m=max2f(a,b);
  auto rr=__builtin_amdgcn_permlane32_swap(__float_as_uint(m),__float_as_uint(m),false,false);
  return max2f(__uint_as_float(rr[0]),__uint_as_float(rr[1]));
}
__device__ __forceinline__ void pv(f32x16*o,int vb,bf16x8 pa0,bf16x8 pa1,bf16x8 pa2,bf16x8 pa3){
  #pragma unroll
  for(int d0=0;d0<2;++d0){s16x4 lo[4],hi[4];
    #pragma unroll
    for(int ks=0;ks<4;++ks){
      asm volatile("ds_read_b64_tr_b16 %0,%1 offset:%c2":"=&v"(lo[ks]):"v"(vb),"i"(d0*4096+ks*1024):"memory");
      asm volatile("ds_read_b64_tr_b16 %0,%1 offset:%c2":"=&v"(hi[ks]):"v"(vb),"i"(d0*4096+ks*1024+512):"memory");}
    asm volatile("s_waitcnt lgkmcnt(0)":::"memory");SBAR();
    #define PK(k) (bf16x8){lo[k][0],lo[k][1],lo[k][2],lo[k][3],hi[k][0],hi[k][1],hi[k][2],hi[k][3]}
    o[d0]=__builtin_amdgcn_mfma_f32_32x32x16_bf16(pa0,PK(0),o[d0],0,0,0);
    o[d0]=__builtin_amdgcn_mfma_f32_32x32x16_bf16(pa1,PK(1),o[d0],0,0,0);
    o[d0]=__builtin_amdgcn_mfma_f32_32x32x16_bf16(pa2,PK(2),o[d0],0,0,0);
    o[d0]=__builtin_amdgcn_mfma_f32_32x32x16_bf16(pa3,PK(3),o[d0],0,0,0);
    #undef PK
  }
}

#ifndef ATTN_STORE16
#define ATTN_STORE16(p,v) (*(u32x4*)(p)=(v))
#endif
template<int THRL> __device__ __forceinline__ void attn_unit(int b,int h,int qb,int t0,const bf16*Z,const float*c2g,bf16*O,char*shm){
  const int tid=threadIdx.x,lane=tid&63,r32=lane&31,hi=lane>>5; const int wid=__builtin_amdgcn_readfirstlane(tid>>6);
  const long rowbase=(long)b*SEQ; const int q0=qb*QB;
  const bf16*Qw=Z+(rowbase+q0+wid*QBLK)*DM+h*D;
  const bf16*Kh=Z+(rowbase+(long)t0*KVBLK)*DM+512+h*D,*Vh=Z+(rowbase+(long)t0*KVBLK)*DM+1024+h*D;
  const unsigned lds0=(unsigned)(uintptr_t)shm;
  float*wsf=(float*)(shm+LDS_WS)+wid*64;
  const bf16*ksrc=Kh+(long)lane*DM+wid*8;
  const bf16*vsrc=Vh+(long)(16*(wid&3)+(lane>>2))*DM+(wid>>2)*32+(lane&3)*8;
  const unsigned kdst=lds0+LDS_K+wid*1024, vdst=lds0+LDS_V+wid*1024;
  #define DMA_K(t,slot) glds16(ksrc+(long)(t)*KVBLK*DM,(unsigned)__builtin_amdgcn_readfirstlane(kdst+(slot)))
  #define DMA_V(t,slot) glds16(vsrc+(long)(t)*KVBLK*DM,(unsigned)__builtin_amdgcn_readfirstlane(vdst+(slot)))
  const int vb0=(int)(lds0+LDS_V)+((lane>>4)&1)*32+(lane&3)*8+(4*hi+((lane&15)>>2))*64;
  const char*Kbase=shm+LDS_K; bf16x8 kf[8];
  const lds_cptr shm3=(lds_cptr)shm; const lds_cptr kp0=shm3+LDS_K+hi*1024+r32*16; const lds_cptr vp0=shm3+LDS_V+((lane>>4)&1)*32+(lane&3)*8+(4*hi+((lane&15)>>2))*64;
  const int NT=(q0+QB)/KVBLK-t0;
  { const int np=(q0+QB)/256;
    for(int p=(t0>>2)+wid;p<np;p+=NW) glds16(c2g+p*256+lane*4,(unsigned)__builtin_amdgcn_readfirstlane(lds0+LDS_C2+p*1024)); }
  const __attribute__((address_space(3))) float* c2l=(const __attribute__((address_space(3))) float*)(shm3+LDS_C2)+t0*KVBLK+4*hi;
  DMA_K(0,0);DMA_V(0,0);DMA_K(1,SLOTB);
  bf16x8 qr[4];
  #pragma unroll
  for(int d0=0;d0<4;++d0)qr[d0]=*reinterpret_cast<const bf16x8*>(&Qw[(long)r32*DM+d0*16+hi*8]);
  float l_reg=0.f;f32x16 o[2];o[0]=f32x16{};o[1]=f32x16{};
  float base=c2g[q0+wid*QBLK+r32];
  const int qrel=wid*QBLK+r32;
  #define CMASK(P0,P1,t) do{int jb_=(t)-(NT-4); if(jb_>=0)cmask(P0,P1,jb_,qrel,hi);}while(0)
  bool resc=false;
  #define START(P0,P1) do{ const float rm=rowmax(P0,P1); resc=false; \
    { const float dl=rm; base=fsub_s(base,dl); \
      _Pragma("unroll") for(int r=0;r<16;++r){P0[r]=fsub_s(P0[r],dl);P1[r]=fsub_s(P1[r],dl);} } \
    _Pragma("unroll") for(int r=0;r<16;++r)P0[r]=__builtin_amdgcn_exp2f(P0[r]); }while(0)
  #define RESC() do{ if(resc){ asm volatile("s_waitcnt lgkmcnt(0)":::"memory"); \
      _Pragma("unroll") for(int d_=0;d_<2;++d_) _Pragma("unroll") for(int r=0;r<16;++r)o[d_][r]*=wsf[crow(r,hi)]; } }while(0)
  f32x16 pA0,pA1,pB0,pB1;
  #define BIASLD(P0,P1,tt) do{ _Pragma("unroll") for(int g_=0;g_<4;++g_){ const f32x4v x0_=*(const __attribute__((address_space(3))) f32x4v*)(c2l+(tt)*KVBLK+8*g_), x1_=*(const __attribute__((address_space(3))) f32x4v*)(c2l+(tt)*KVBLK+32+8*g_); \
      P0[4*g_]=x0_[0];P0[4*g_+1]=x0_[1];P0[4*g_+2]=x0_[2];P0[4*g_+3]=x0_[3]; P1[4*g_]=x1_[0];P1[4*g_+1]=x1_[1];P1[4*g_+2]=x1_[2];P1[4*g_+3]=x1_[3]; } }while(0)
  #define BIASFIX(P0,P1) do{ _Pragma("unroll") for(int r=0;r<16;++r){P0[r]=fsub_s(base,P0[r]);P1[r]=fsub_s(base,P1[r]);} }while(0)
  int sl_prev=0,sl_cur=0,sl_next=SLOTB;
  #define ROT() do{sl_prev=sl_cur;sl_cur=sl_next;sl_next=(sl_next==(NSLOT-1)*SLOTB)?0:sl_next+SLOTB;}while(0)
  DMA_K(2,2*SLOTB);
  WAIT_BAR(3);
  BIASLD(pA0,pA1,0); BIASFIX(pA0,pA1);
  qkt(pA0,pA1,Kbase,qr,r32,hi);asm volatile("s_nop 15\n\ts_nop 7":"+v"(pA0),"+v"(pA1));CMASK(pA0,pA1,0);
  START(pA0,pA1);
  _Pragma("unroll") for(int r=0;r<16;++r)pA1[r]=__builtin_amdgcn_exp2f(pA1[r]);
  BIASLD(pB0,pB1,1);
  WAIT_BAR(0);
  DMA_K(3,0);DMA_V(1,SLOTB);
  ROT();
  kload8(kf,kp0+sl_cur);
  WAIT_BAR(2);
  s16x4 vlo[8],vhi[8]; u32x4 pw0,pw1,pw2,pw3;
  #define PKW(P,B) cvtpk_s(P[B],P[B+1])
  #define PAF(k) __builtin_bit_cast(bf16x8,pw##k)
  #define VFR(i) (bf16x8){vlo[i][0],vlo[i][1],vlo[i][2],vlo[i][3],vhi[i][0],vhi[i][1],vhi[i][2],vhi[i][3]}
  #define PIN(x) asm volatile("":"+v"(x))
  #define MX3(a,b,c) __builtin_fmaxf(__builtin_fmaxf((a),(b)),(c))
  #define GAPA(MF,A0,A1,A2,A3,W0,W1,PW) do{ MF; sacc+=A0; sacc+=A1; sacc+=A2; sacc+=A3; PIN(sacc); W0; W1; PIN(PW); SBAR(); }while(0)
  #define EX(v) __builtin_amdgcn_exp2f(v)
  #define GAPB(MF,X,B) do{ MF; X[B]=EX(X[B]); X[B+1]=EX(X[B+1]); X[B+2]=EX(X[B+2]); X[B+3]=EX(X[B+3]); PIN(X); SBAR(); }while(0)
  #define VRD(i) do{ vlo[i]=vtr(vp_+(((i)>>2)*4096+((i)&3)*1024)); vhi[i]=vtr(vp_+(((i)>>2)*4096+((i)&3)*1024+512)); }while(0)
  #define KRD(G,j) do{ if(G){ kload2(kf,kp0+sl_next,j); SBAR(); } }while(0)
  #define STEP(C0,C1,P0,P1,t,GK,GV,GL) do{ SBAR(); \
    BIASFIX(C0,C1); SBAR(); \
    const lds_cptr vp_=vp0+sl_prev; \
    VRD(0); SBAR(); float sacc=(P0[0]+P0[1]); \
    GAPA(C0=__builtin_amdgcn_mfma_f32_32x32x16_bf16(kf[0],qr[0],C0,0,0,0), P0[2],P0[3],P0[4],P0[5],     pw0[0]=PKW(P0,0), pw0[1]=PKW(P0,2), pw0); \
    VRD(4); SBAR(); GAPA(C1=__builtin_amdgcn_mfma_f32_32x32x16_bf16(kf[1],qr[0],C1,0,0,0), P0[6],P0[7],P0[8],P0[9],     pw0[2]=PKW(P0,4), pw0[3]=PKW(P0,6), pw0); \
    VRD(1); SBAR(); GAPA(C0=__builtin_amdgcn_mfma_f32_32x32x16_bf16(kf[2],qr[1],C0,0,0,0),   P0[10],P0[11],P0[12],P0[13], pw1[0]=PKW(P0,8), pw1[1]=PKW(P0,10), pw1); \
    VRD(5); SBAR(); GAPA(C1=__builtin_amdgcn_mfma_f32_32x32x16_bf16(kf[3],qr[1],C1,0,0,0),   P0[14],P0[15],P1[0],P1[1],   pw1[2]=PKW(P0,12),pw1[3]=PKW(P0,14), pw1); \
    VRD(2); SBAR(); GAPA(C0=__builtin_amdgcn_mfma_f32_32x32x16_bf16(kf[4],qr[2],C0,0,0,0),   P1[2],P1[3],P1[4],P1[5],     pw2[0]=PKW(P1,0), pw2[1]=PKW(P1,2), pw2); \
    VRD(6); SBAR(); GAPA(C1=__builtin_amdgcn_mfma_f32_32x32x16_bf16(kf[5],qr[2],C1,0,0,0),   P1[6],P1[7],P1[8],P1[9],     pw2[2]=PKW(P1,4), pw2[3]=PKW(P1,6), pw2); \
    VRD(3); SBAR(); GAPA(C0=__builtin_amdgcn_mfma_f32_32x32x16_bf16(kf[6],qr[3],C0,0,0,0),   P1[10],P1[11],P1[12],P1[13], pw3[0]=PKW(P1,8), pw3[1]=PKW(P1,10), pw3); \
    VRD(7); SBAR(); GAPA(C1=__builtin_amdgcn_mfma_f32_32x32x16_bf16(kf[7],qr[3],C1,0,0,0),   P1[14],P1[15],0.f,0.f,       pw3[2]=PKW(P1,12),pw3[3]=PKW(P1,14), pw3); \
    l_reg+=sacc; \
    if(GL){BIASLD(P0,P1,(t)+1);} \
    if(GK){DMA_K((t)+3,sl_cur);} if(GV){DMA_V((t)+1,sl_next);} \
    CMASK(C0,C1,t); \
    { float a=MX3(C0[0],C0[1],C1[0]),b=MX3(C0[2],C0[3],C1[1]); a=MX3(a,C1[2],C1[3]); \
      _Pragma("unroll") for(int r=4;r<16;r+=4){a=MX3(a,C0[r],C0[r+1]);b=MX3(b,C0[r+2],C0[r+3]);a=MX3(a,C1[r],C1[r+1]);b=MX3(b,C1[r+2],C1[r+3]);} \
      float rm=__builtin_fmaxf(a,b); { auto rr=__builtin_amdgcn_permlane32_swap(__float_as_uint(rm),__float_as_uint(rm),false,false); rm=__builtin_fmaxf(__uint_as_float(rr[0]),__uint_as_float(rr[1])); } \
      resc=false; \
      if(__builtin_expect(__any(rm>(float)THRL),0)){ const float dl=__builtin_fmaxf(rm,0.f); base-=dl; \
        _Pragma("unroll") for(int r=0;r<16;++r){C0[r]-=dl;C1[r]-=dl;} \
        const float f=__builtin_amdgcn_exp2f(-dl); l_reg*=f; if(hi==0)wsf[r32]=f; resc=true; } } \
    SBAR(); \
    GAPB(o[0]=__builtin_amdgcn_mfma_f32_32x32x16_bf16(PAF(0),VFR(0),o[0],0,0,0), C0,0); \
    GAPB(o[1]=__builtin_amdgcn_mfma_f32_32x32x16_bf16(PAF(0),VFR(4),o[1],0,0,0), C0,4); \
    KRD(GL,0); GAPB(o[0]=__builtin_amdgcn_mfma_f32_32x32x16_bf16(PAF(1),VFR(1),o[0],0,0,0), C0,8); \
    KRD(GL,1); GAPB(o[1]=__builtin_amdgcn_mfma_f32_32x32x16_bf16(PAF(1),VFR(5),o[1],0,0,0), C0,12); \
    KRD(GL,2); GAPB(o[0]=__builtin_amdgcn_mfma_f32_32x32x16_bf16(PAF(2),VFR(2),o[0],0,0,0), C1,0); \
    KRD(GL,3); GAPB(o[1]=__builtin_amdgcn_mfma_f32_32x32x16_bf16(PAF(2),VFR(6),o[1],0,0,0), C1,4); \
    GAPB(o[0]=__builtin_amdgcn_mfma_f32_32x32x16_bf16(PAF(3),VFR(3),o[0],0,0,0), C1,8); \
    GAPB(o[1]=__builtin_amdgcn_mfma_f32_32x32x16_bf16(PAF(3),VFR(7),o[1],0,0,0), C1,12); \
    }while(0)
  int t=1;
  #undef CMASK
  #define CMASK(P0,P1,t) do{}while(0)
  for(;t+5<NT;t+=2){
    STEP(pB0,pB1,pA0,pA1,t,true,true,true);     WAIT_BAR(2); RESC(); ROT();
    STEP(pA0,pA1,pB0,pB1,t+1,true,true,true);   WAIT_BAR(2); RESC(); ROT();
  }
  #undef CMASK
  #define CMASK(P0,P1,t) do{int jb_=(t)-(NT-4); if(jb_>=0)cmask(P0,P1,jb_,qrel,hi);}while(0)
  #define ENDW(tt) do{ if((tt)+3<NT){WAIT_BAR(2);} else if((tt)+2<NT){WAIT_BAR(1);} else {WAIT_BAR(0);} }while(0)
  for(;t+1<NT;t+=2){
    STEP(pB0,pB1,pA0,pA1,t,(t+3<NT),(t+1<NT),(t+1<NT));       ENDW(t);   RESC(); ROT();
    STEP(pA0,pA1,pB0,pB1,t+1,(t+4<NT),(t+2<NT),(t+2<NT));     ENDW(t+1); RESC(); ROT();
  }
  STEP(pB0,pB1,pA0,pA1,NT-1,false,false,false); RESC();
  { float sacc=pB0[0]+pB0[1]; _Pragma("unroll") for(int r=2;r<16;++r)sacc+=pB0[r]; _Pragma("unroll") for(int r=0;r<16;++r)sacc+=pB1[r]; l_reg+=sacc;
    pw0=(u32x4){PKW(pB0,0),PKW(pB0,2),PKW(pB0,4),PKW(pB0,6)};pw1=(u32x4){PKW(pB0,8),PKW(pB0,10),PKW(pB0,12),PKW(pB0,14)};pw2=(u32x4){PKW(pB1,0),PKW(pB1,2),PKW(pB1,4),PKW(pB1,6)};pw3=(u32x4){PKW(pB1,8),PKW(pB1,10),PKW(pB1,12),PKW(pB1,14)};
    SBAR(); pv(o,vb0+sl_cur,PAF(0),PAF(1),PAF(2),PAF(3)); }
  #undef PKW
  #undef PAF
  #undef VFR
  #undef PIN
  #undef MX3
  #undef GAPA
  #undef GAPB
  #undef EX
  #undef VRD
  #undef KRD
  #undef STEP
  #undef ENDW
  {auto rr=__builtin_amdgcn_permlane32_swap(__float_as_uint(l_reg),__float_as_uint(l_reg),false,false);l_reg=__uint_as_float(rr[0])+__uint_as_float(rr[1]);}
  if(hi==0)wsf[32+r32]=l_reg;asm volatile("s_waitcnt lgkmcnt(0)":::"memory");
  float rli[16];
  #pragma unroll
  for(int r=0;r<16;++r)rli[r]=__builtin_amdgcn_rcpf(wsf[32+crow(r,hi)]);
  bf16*Ow=O+(rowbase+q0+wid*QBLK)*OP+h*D; const bf16*Gw=Z+(rowbase+q0+wid*QBLK)*DM+1536+h*D;
  { bf16*stg=(bf16*)(shm+LDS_OST)+wid*2048;
    #pragma unroll
    for(int r=0;r<16;++r){const int orow=crow(r,hi);
      #pragma unroll
      for(int d0=0;d0<2;++d0)stg[orow*64+d0*32+r32]=(bf16)f2bf(o[d0][r]*rli[r]);}
    asm volatile("s_waitcnt lgkmcnt(0)":::"memory");
    #pragma unroll
    for(int i=0;i<4;++i){const int row=i*8+(lane>>3),ch=lane&7; const u32x4 v=*(const u32x4*)(stg+row*64+ch*8), g=*(const u32x4*)(Gw+(long)row*DM+ch*8);
      const unsigned vw[4]={v.x,v.y,v.z,v.w},gw[4]={g.x,g.y,g.z,g.w}; unsigned ow[4];
      #pragma unroll
      for(int j=0;j<4;++j){ const float a0=bflo(vw[j])*__builtin_amdgcn_rcpf(1.0f+__expf(-bflo(gw[j]))), a1=bfhi(vw[j])*__builtin_amdgcn_rcpf(1.0f+__expf(-bfhi(gw[j]))); ow[j]=cvtpk_s(a0,a1); }
      ATTN_STORE16(Ow+(long)row*OP+ch*8,((u32x4){ow[0],ow[1],ow[2],ow[3]}));} }
  asm volatile("s_waitcnt lgkmcnt(0)\n\ts_barrier":::"memory");
  #undef DMA_K
  #undef DMA_V
  #undef CMASK
  #undef START
  #undef RESC
  #undef ROT
}
constexpr int ATTN_LDS_BYTES=LDS_BYTES;
#undef SBAR
#undef WAIT_BAR
}
constexpr int CW_QATT = 128;
constexpr int MISC_TAB = 64, MISC_Q = 4096, MISC_PFX = 4160;

__device__ __forceinline__ int attn_t0(KPR P, const float* c2, int q0, int lane) {
    float gq = fabsf(P.q_norm[lane]), gk = fabsf(P.k_norm[lane]);
#pragma unroll
    for (int o = 1; o < 64; o <<= 1) { gq = fmaxf(gq, __shfl_xor(gq, o)); gk = fmaxf(gk, __shfl_xor(gk, o)); }
    const float thr = c2[q0] + (2.0f * 8.0f * LOG2E * gq * gk + 40.0f);
    const int nfull = q0 / 64; int t0 = 0;
    for (int tb = 0; tb < nfull; tb += 64) { const int tt = tb + lane; const bool sk = (tt < nfull) && (c2[tt * 64 + 63] > thr); const unsigned long long bm = __ballot(sk); t0 += __popcll(bm); if (bm != ~0ull) break; }
    return __builtin_amdgcn_readfirstlane(t0) & ~1;
}
__device__ __forceinline__ void combine_row(KPR P, const LAS int* tab, int row, int lane) {
    const int* route = (const int*)(P.ws + WS_ROUTE); const unsigned char* YP = P.ws + WS_YP; float* X = (float*)(P.ws + WS_X1);
    f32x4 v[4]; const f32x4* xr = (const f32x4*)(X + (size_t)row * DM) + lane;
#pragma unroll
    for (int j = 0; j < 4; ++j) v[j] = xr[64 * j];
#pragma unroll
    for (int k = 0; k < 4; ++k) { const int ex = route[(size_t)row * 12 + k], rank = route[(size_t)row * 12 + 4 + k]; const size_t pos = (size_t)tab[pg8::T_BLKSTART + ex] * 256 + rank;
        const unsigned* yr = (const unsigned*)(YP + pos * DM) + lane;
#pragma unroll
        for (int j = 0; j < 4; ++j) { const unsigned y = yr[64 * j]; const f32x2 lo = __builtin_amdgcn_cvt_pk_f32_fp8((int)y, false), hi = __builtin_amdgcn_cvt_pk_f32_fp8((int)y, true);
            v[j][0] += lo[0] * 0.0625f; v[j][1] += lo[1] * 0.0625f; v[j][2] += hi[0] * 0.0625f; v[j][3] += hi[1] * 0.0625f; } }
    f32x4* xo = (f32x4*)(X + (size_t)row * DM) + lane; float s = 0.f;
#pragma unroll
    for (int j = 0; j < 4; ++j) { xo[64 * j] = v[j]; s += (v[j][0] * v[j][0] + v[j][1] * v[j][1]) + (v[j][2] * v[j][2] + v[j][3] * v[j][3]); }
    const float rstd = rsqrtf(wave_sum(s) * (1.f / DM) + 1e-6f);
#pragma unroll
    for (int j = 0; j < 4; ++j) v[j] = v[j] * rstd * ((const f32x4*)P.ple_norm)[64 * j + lane];
    store_row_fp8(P.ws + WS_XN + (size_t)row * DM, lane, v);
}

constexpr int NPHASE = 13;
__global__ void __launch_bounds__(NTHREADS, 2) mega_fwd(Params Pkarg_unused) {
    extern __shared__ __attribute__((aligned(16))) unsigned char smem[];
    LAS unsigned char* lds = (LAS unsigned char*)smem;
    const int tid = threadIdx.x, lane = tid & 63, wave = __builtin_amdgcn_readfirstlane(tid >> 6);
    const int G = gridDim.x, blk = blockIdx.x;
#define P (*kpp)
#ifndef MK_REP
#define MK_REP -1
#endif
#define PHASE_BEGIN(k) if (IN(k)) for (int rep_ = 0; rep_ < ((k) == MK_REP ? 2 : 1); ++rep_) { const __attribute__((address_space(4))) Params* kpp = kp_fresh();
#define PHASE_END(k) } if (BOTH(k)) xcd_barrier(bar);
#define IN(k) (ph_lo <= (k) && (k) < ph_hi)
#define BOTH(k) (IN(k) && IN((k) + 1))
    const __attribute__((address_space(4))) Params* kpp = kp_fresh();
    unsigned* ctl = (unsigned*)(P.ws + WS_CTL);
    volatile LAS unsigned* MISC = (volatile LAS unsigned*)(lds + MISC_OFF);
    LAS int* tab = (LAS int*)(lds + MISC_OFF + MISC_TAB);
    if (tid < 16) MISC[tid] = 0u;
    __syncthreads();
    XcdBarrier bar = xcd_barrier_post(ctl + CW_BAR, MISC);
    unsigned char* const wsb = P.ws;
    const int ph_lo = P.ph_lo, ph_hi = P.ph_hi;

    PHASE_BEGIN(0)
        phase_prep_weights(P, lds, blk * NWAVES + wave, G * NWAVES, wave, lane);
        phase_cvt_p(P, blk * NTHREADS + tid, G * NTHREADS);
        __syncthreads();
        LAS float* wff = (LAS float*)lds; LAS float* lf = (LAS float*)(lds + 32768);
        load_wff(P, wff, tid, NTHREADS); __syncthreads();
        for (int i = 0; i < 16; ++i) { const int rl = wave * 16 + i; norm1_row(P, blk * 128 + rl, lane, wff, lf + rl * 8); }
        __syncthreads();
        if (tid < 8) { float run = 0.f; float* cloc = (float*)(P.ws + WS_LOGF) + (size_t)blk * 128 * 8 + tid;
            for (int r = 0; r < 128; ++r) { run += lf[r * 8 + tid]; cloc[r * 8] = run; }
            ((float*)(P.ws + WS_CTOT))[blk * 8 + tid] = run; }
        if (blk == G - 1) rt::build_w(P, tid);
    PHASE_END(0)

    PHASE_BEGIN(1)
        {
            LAS float* pfx = (LAS float*)(lds + MISC_OFF + MISC_PFX);
            if (tid < 64) { const float* ct = (const float*)(wsb + WS_CTOT); const int j = (blk & ~63) + tid; float v8[8];
#pragma unroll
                for (int h = 0; h < 8; ++h) v8[h] = (j < blk) ? ct[j * 8 + h] : 0.f;
#pragma unroll
                for (int h = 0; h < 8; ++h) { const float s = wave_sum(v8[h]); if (tid == 0) pfx[h] = s; } }
            __syncthreads();
            const float* cloc = (const float*)(wsb + WS_LOGF) + (size_t)blk * 128 * 8; float* c2 = (float*)(P.ws + WS_C2);
            for (int i = tid; i < 1024; i += NTHREADS) { const int r = i >> 3, h = i & 7; const int row = blk * 128 + r, b = row >> 13, t = row & (SEQ - 1);
                c2[((size_t)(b * 8 + h)) * SEQ + t] = (cloc[i] + pfx[h]) * LOG2E; }
            __syncthreads();
        }
        {
            pg8::DenseOrder S{(const bf16_t*)(wsb + WS_XN), (const bf16_t*)(wsb + WS_WIN), 1024, NTOK / 256, ZW / 256, G, blk};
            pg8::EpiIn E{(bf16_t*)(P.ws + WS_Z), P.q_norm, P.k_norm};
            pg8::gemm_phase<pg8::EpiIn, pg8::DenseOrder, true>(lds, 1024, S, E);
        }
        {
            pg8::DenseOrder S{(const bf16_t*)((unsigned char*)P.out + DO_PB), (const bf16_t*)(wsb + WS_WPP), PLE, NTOK / 256, DM / 256, G / 2, blk >= G / 2 ? blk - G / 2 : (1 << 20)};
            pg8::EpiBf16 E{(bf16_t*)((unsigned char*)P.out + DO_PJ), DM};
            pg8::gemm_phase<pg8::EpiBf16, pg8::DenseOrder, true>(lds, PLE, S, E);
        }
    PHASE_END(1)

    PHASE_BEGIN(2)
        for (int task = wave * G + blk; task < NTOK / 32; task += NWAVES * G) rk::lora_task(P, task, lane);
    PHASE_END(2)

    PHASE_BEGIN(3)
        for (int task = blk; task < NB * NH * rk::NCHUNK; task += G) rk::pass1_chunk(P, lds, task >> 7, task & 127, tid);
    PHASE_END(3)

    PHASE_BEGIN(4)
        if (blk < NB * NH) rk::pass2_seq(P, lds, blk, tid);
        for (;;) {
            __syncthreads();
            if (tid == 0) MISC[MISC_Q / 4] = __hip_atomic_fetch_add(ctl + CW_QATT + 64 * rep_, 1u, RLX_AGENT);
            __syncthreads();
            const int q = (int)MISC[MISC_Q / 4];
            if (q >= 1024) break;
            { const int bh = q & 31, qb = 31 - (q >> 5); const float* c2 = (const float*)(wsb + WS_C2) + (size_t)bh * SEQ;
              const int t0 = attn_t0(P, c2, qb * 256, lane);
              attn_body::attn_unit<8>(bh >> 3, bh & 7, qb, t0, (const bf16_t*)(wsb + WS_Z), c2, (bf16_t*)(P.ws + WS_AO), (char*)smem); }
        }
    PHASE_END(4)

    PHASE_BEGIN(5)
        for (int task = blk; task < NB * NH * rk::NCHUNK; task += G) rk::pass3_chunk(P, lds, task >> 7, task & 127, tid);
    PHASE_END(5)

    PHASE_BEGIN(6)
        pg8::DenseOrder S{(const bf16_t*)(wsb + WS_AO), (const bf16_t*)(wsb + WS_WOUT), 1024, NTOK / 256, DM / 256, G, blk};
        pg8::EpiOut E{P.x, (float*)(P.ws + WS_X1)};
        pg8::gemm_phase<pg8::EpiOut, pg8::DenseOrder, true>(lds, 1024, S, E);
    PHASE_END(6)

    PHASE_BEGIN(7)
        rt::copy_w(P, lds, tid);
        if (blk == 0 && tid < 256) ((unsigned*)(P.ws + WS_XN + (size_t)NTOK * DM))[tid] = 0u;
        __syncthreads();
        for (int task = wave * G + blk; task < NTOK / 32; task += NWAVES * G) rt::route_task(P, lds, task, lane);
    PHASE_END(7)

    PHASE_BEGIN(8)
        const int nblk = pg8::moe_tables(tab, (const unsigned*)(wsb + WS_CTL) + CW_CNT);
        pg8::MoeOrder S{wsb + WS_XN, wsb + WS_WGU, (const int*)(wsb + WS_TOKSLOT), (const float*)(wsb + WS_GATESLOT), tab, nblk, 8, G, blk, true};
        pg8::EpiGu E{P.ws + WS_ACT, P.b_gu};
        pg8::gemm_phase<pg8::EpiGu, pg8::MoeOrder, true, true>(lds, 1024, S, E);
    PHASE_END(8)
    PHASE_BEGIN(9)
        const int nblk = pg8::moe_tables(tab, (const unsigned*)(wsb + WS_CTL) + CW_CNT);
        pg8::MoeOrder S{wsb + WS_ACT, wsb + WS_WDN, (const int*)(wsb + WS_TOKSLOT), (const float*)(wsb + WS_GATESLOT), tab, nblk, 4, G, blk, false};
        pg8::EpiDn E{P.ws + WS_YP, P.b_down, (const float*)(wsb + WS_GATESLOT), tab};
        pg8::gemm_phase<pg8::EpiDn, pg8::MoeOrder, true, true>(lds, 1024, S, E);
    PHASE_END(9)
    PHASE_BEGIN(10)
        (void)pg8::moe_tables(tab, (const unsigned*)(wsb + WS_CTL) + CW_CNT);
        for (int row = blk * NWAVES + wave; row < NTOK; row += G * NWAVES) combine_row(P, tab, row, lane);
    PHASE_END(10)
    PHASE_BEGIN(11)
        pg8::DenseOrder S{wsb + WS_XN, wsb + WS_WPG, 512, NTOK / 256, DM / 256, G, blk};
        pg8::EpiPg E{(float*)(P.ws + WS_X1), (const bf16_t*)((unsigned char*)P.out + DO_PJ)};
        pg8::gemm_phase<pg8::EpiPg, pg8::DenseOrder, true, true>(lds, 1024, S, E);
    PHASE_END(11)
    PHASE_BEGIN(12)
        const bool dead = __hip_atomic_load(ctl + CW_BAR + XB_TMO, RLX_AGENT) != 0u;
        for (int row = blk * NWAVES + wave; row < NTOK; row += G * NWAVES) final_row(P, row, lane, dead);
    PHASE_END(12)
}
#undef P
extern "C" void kernel_launch(void* const* d_in, const int* in_sizes, int n_in, void* d_out, int out_size, void* d_ws, size_t ws_size, hipStream_t stream) {
    static int ok = 0;
    if (ok == 0) {
        if (n_in != 30 || in_sizes[0] != NTOK * DM || out_size != NTOK * DM || ws_size < WS_END) { fprintf(stderr, "kernel_launch: unexpected shapes (n_in %d, ws %zu)\n", n_in, ws_size); ok = -1; return; }
        if (hipFuncSetAttribute((const void*)mega_fwd, hipFuncAttributeMaxDynamicSharedMemorySize, LDS_BYTES) != hipSuccess) { fprintf(stderr, "kernel_launch: hipFuncSetAttribute failed\n"); ok = -1; return; }
        int dev = 0, cus = 0, per_cu = 0;
        if (hipGetDevice(&dev) != hipSuccess || hipDeviceGetAttribute(&cus, hipDeviceAttributeMultiprocessorCount, dev) != hipSuccess) { ok = -1; return; }
        if (hipOccupancyMaxActiveBlocksPerMultiprocessor(&per_cu, (const void*)mega_fwd, NTHREADS, LDS_BYTES) != hipSuccess || per_cu < 1) { fprintf(stderr, "kernel_launch: occupancy query says %d\n", per_cu); }
        (void)hipGetLastError();
        if (cus != 256) { fprintf(stderr, "kernel_launch: built for 256 CUs, device has %d\n", cus); ok = -1; return; }
        ok = 1;
    }
    if (ok < 0) return;
    Params P{};
    const float** pp = (const float**)&P;
    for (int i = 0; i < 30; ++i) pp[i] = (const float*)d_in[i];
    P.out = (float*)d_out; P.ws = (unsigned char*)d_ws;
    if (hipMemsetAsync((char*)d_ws + WS_CTL, 0, CTL_BYTES, stream) != hipSuccess) return;
#ifndef MK_CUTS
#define MK_CUTS 0
#endif
    if (MK_CUTS == 0) { P.ph_lo = 0; P.ph_hi = NPHASE; hipLaunchKernelGGL(mega_fwd, dim3(256), dim3(NTHREADS), LDS_BYTES, stream, P); }
    else for (int k = 0; k < NPHASE; ++k) { P.ph_lo = k; P.ph_hi = k + 1;
        hipLaunchKernelGGL(mega_fwd, dim3(256), dim3(NTHREADS), LDS_BYTES, stream, P); }
}
```

```cpp
#include <hip/hip_runtime.h>
#include <cstdio>
#include <cstdint>

#define LAS __attribute__((address_space(3)))
#define GAS __attribute__((address_space(1)))
typedef unsigned short bf16_t;
typedef short bf16x8 __attribute__((ext_vector_type(8)));
typedef float f32x2 __attribute__((ext_vector_type(2)));
typedef float f32x4 __attribute__((ext_vector_type(4)));
typedef float f32x16 __attribute__((ext_vector_type(16)));
typedef unsigned u32x2 __attribute__((ext_vector_type(2)));
typedef unsigned u32x4 __attribute__((ext_vector_type(4)));

constexpr int NB = 4, SEQ = 8192, NTOK = NB * SEQ, DM = 1024;
constexpr int NH = 8, HD = 64;
constexpr int INW = 3848;
constexpr int ZW = 3840;
constexpr int ZQ = 0, ZK = 512, ZV = 1024, ZOG = 1536, ZR = 2048;
constexpr int RW_R = 0, RW_K = 512, RW_V = 1024, RW_W = 1536, RW_A = 1600, RW_G = 1664, RWIN = 1792;
constexpr int NE = 32, TOPK = 4, EFF = 1024;
constexpr int MAXBLK = (NTOK * TOPK) / 256 + NE;
constexpr int PLE = 256;
constexpr float LOG2E = 1.4426950408889634f;
constexpr float QSCALE = 0.125f * LOG2E;

constexpr size_t MiB = 1u << 20;
constexpr size_t WS_CTL = 0, CTL_BYTES = 1 * MiB;
constexpr size_t WS_C2 = 1 * MiB;
constexpr size_t WS_LOGF = 2 * MiB;
constexpr size_t WS_ROUTE = 3 * MiB;
constexpr size_t WS_TOKSLOT = 5 * MiB;
constexpr size_t WS_GATESLOT = 9 * MiB;
constexpr size_t WS_CTOT = 13 * MiB;
constexpr size_t WS_WIN = 16 * MiB;
constexpr size_t WS_WOUT = 24 * MiB;
constexpr size_t WS_WPG = 26 * MiB;
constexpr size_t WS_WPP = 28 * MiB;
constexpr size_t WS_WGU = 32 * MiB;
constexpr size_t WS_WDN = 160 * MiB;
constexpr size_t WS_XN = 224 * MiB;
constexpr size_t WS_X1 = 290 * MiB;
constexpr size_t WS_Z = 418 * MiB;
constexpr size_t WS_AO = 658 * MiB;
constexpr size_t WS_ACT = 418 * MiB;
constexpr size_t WS_RW = 722 * MiB;
constexpr size_t WS_RR = WS_RW, WS_RK = WS_RW + 32 * MiB, WS_RV = WS_RW + 64 * MiB, WS_RG = WS_RW + 96 * MiB;
constexpr size_t WS_RLW = WS_RW + 128 * MiB;
constexpr size_t WS_RKK = WS_RW + 160 * MiB, WS_RKA = WS_RW + 192 * MiB;
constexpr size_t WS_YP = 722 * MiB;
constexpr size_t WS_END = 994 * MiB;
static_assert(WS_ACT + (size_t)MAXBLK * 256 * 1024 * 2 <= WS_RW && WS_YP + (size_t)MAXBLK * 256 * 1024 * 2 <= WS_END, "ws map");
constexpr size_t DO_PJ = 0, DO_PB = 64 * MiB;
constexpr int CW_TMO = 0, CW_CNT = 64  , CW_BAR = 4096;

struct Params {
    const float *x, *p, *mix_norm, *w_in, *f_bias, *q_norm, *k_norm, *mu, *w0, *w2, *a0, *a2, *g2, *k_k, *k_a, *r_k, *ln_w, *ln_b, *w_out, *moe_norm, *w_router, *b_router, *w_gu, *b_gu, *w_down,
        *b_down, *ple_norm, *w_pg, *w_pp, *final_norm;
    float* out; unsigned char* ws; int ph_lo, ph_hi;
};

typedef const __attribute__((address_space(4))) Params& KPR;
__device__ __forceinline__ const __attribute__((address_space(4))) Params* kp_fresh() {
    unsigned long long p = (unsigned long long)__builtin_amdgcn_kernarg_segment_ptr(); asm volatile("" : "+s"(p)); return (const __attribute__((address_space(4))) Params*)p; }

typedef __bf16 bf16x2_hw __attribute__((ext_vector_type(2)));
__device__ __forceinline__ unsigned pk2(float lo, float hi) { const f32x2 v = {lo, hi}; return __builtin_bit_cast(unsigned, __builtin_convertvector(v, bf16x2_hw)); }
__device__ __forceinline__ unsigned f2bf(float f) { return pk2(f, f) & 0xffffu; }
__device__ __forceinline__ float bf2f(unsigned h) { return __builtin_bit_cast(float, h << 16); }
__device__ __forceinline__ float bflo(unsigned w) { return __builtin_bit_cast(float, w << 16); }
__device__ __forceinline__ float bfhi(unsigned w) { return __builtin_bit_cast(float, w & 0xffff0000u); }
__device__ __forceinline__ unsigned cvt_pk_bf16(float lo, float hi) { unsigned r; asm volatile("v_cvt_pk_bf16_f32 %0, %1, %2" : "=v"(r) : "v"(lo), "v"(hi)); return r; }
__device__ __forceinline__ unsigned pk4_fp8(float a, float b, float c, float d) { int w = 0; w = __builtin_amdgcn_cvt_pk_fp8_f32(a, b, w, false); w = __builtin_amdgcn_cvt_pk_fp8_f32(c, d, w, true); return (unsigned)w; }
__device__ __forceinline__ float wave_sum(float v) {
#pragma unroll
    for (int o = 1; o < 64; o <<= 1) v += __shfl_xor(v, o);
    return v;
}
__device__ __forceinline__ float sigmoidf_(float x) { return __builtin_amdgcn_rcpf(1.0f + __expf(-x)); }
__device__ __forceinline__ float logsigmoidf_(float x) { return fminf(x, 0.f) - log1pf(expf(-fabsf(x))); }
namespace pg8 {
constexpr int BM = 256, BK = 64, HALF = 128, HTB = HALF * BK * 2, STAGE_BYTES = 8 * HTB, NXCD = 8, WGM = 8;
__host__ __device__ __forceinline__ int lds_byte(int r, int c) { const int st = (r >> 4) * 2 + (c >> 5), rr = r & 15, cc = c & 31, ob = rr * 64 + cc * 2; return st * 1024 + (ob ^ (((ob >> 9) & 1) << 5)); }
__host__ __device__ __forceinline__ void stage_rc(int b, int& R, int& C) { const int st = b / 1024, sb = b % 1024, swz = sb ^ (((sb >> 9) & 1) << 5); R = (st >> 1) * 16 + swz / 64; C = (st & 1) * 32 + (swz % 64) / 2; }
__host__ __device__ __forceinline__ int perm32(int rho) { const int n = rho >> 4, i = rho & 15; return 8 * (i >> 2) + 4 * n + (i & 3); }

struct Unit { int pm, pn, e, lb, sl; };

__device__ __forceinline__ bool tile_order(int i, int G, int c, int nM, int nN, int& pm, int& pn) {
    const int nwg = nM * nN; const long L = (long)i * G + c; if (L >= nwg) return false;
    int wgid = (int)L; { const int q = nwg / NXCD, r = nwg % NXCD, xcd = wgid % NXCD, off = wgid / NXCD; wgid = (xcd < r ? xcd * (q + 1) : r * (q + 1) + (xcd - r) * q) + off; }
    const int nig = WGM * nN, gid = wgid / nig, fm = gid * WGM, gsz = (nM - fm) < WGM ? (nM - fm) : WGM;
    pm = fm + ((wgid % nig) % gsz); pn = (wgid % nig) / gsz; return true;
}
struct DenseOrder {
    const void* A; const void* Bt; int K  , nM, nN, G, c;
    __device__ __forceinline__ bool next(int i, Unit& u) const { u.e = 0; u.lb = 0; return tile_order(i, G, c, nM, nN, u.pm, u.pn); }
    __device__ __forceinline__ const char* a_base(const Unit& u) const { return (const char*)A + (size_t)u.pm * BM * K * 2; }
    __device__ __forceinline__ const char* b_base(const Unit& u) const { return (const char*)Bt + (size_t)u.pn * BM * K * 2; }
    __device__ __forceinline__ void prefetch(const Unit&, int, int, int) const {}
    __device__ __forceinline__ void a_off(const Unit&, const int (&R)[2], const int (&C)[2], unsigned (&off)[2][2]) const {
#pragma unroll
        for (int h = 0; h < 2; ++h)
#pragma unroll
            for (int i = 0; i < 2; ++i) off[h][i] = (unsigned)((R[i] + HALF * h) * K + C[i]) * 2u;
    }
};

typedef int v8i32 __attribute__((ext_vector_type(8)));
typedef int i32x4 __attribute__((ext_vector_type(4)));
template <class Epi, class Sched, bool ALIGN_EPI, bool FP8 = false>
__device__ __forceinline__ void gemm_phase(LAS unsigned char* lds, const int K, const Sched& S, const Epi& E) {
    int tid_ = threadIdx.x; asm volatile("" : "+v"(tid_));
    const int tid = tid_, wid = __builtin_amdgcn_readfirstlane(tid >> 6), lane = tid & 63, wr = wid >> 2, wc = wid & 3, fr = lane & 15, fq = lane >> 4;
    const int RB = FP8 ? K : 2 * K;
    const int nt = RB / (BK * 2);
    int sR[2], sC[2]; unsigned voffB[2];
#pragma unroll
    for (int i = 0; i < 2; ++i) { int R, C; stage_rc(tid * 16 + i * 8192, R, C); const int Rb = Epi::PERM ? ((R & ~31) + perm32(R & 31)) : R; sR[i] = R; sC[i] = C; voffB[i] = (unsigned)(Rb * RB + C * 2); }
    const size_t kstep = (size_t)(BK * 2);
    const size_t hstep = (size_t)HALF * RB;
    const unsigned ldsw = (unsigned)wid * 1024u;
    const int aoff0 = FP8 ? lds_byte(wr * 64 + fr, fq * 16) : lds_byte(wr * 64 + fr, fq * 8), aoff1 = FP8 ? lds_byte(wr * 64 + fr, fq * 16 + 8) : aoff0 + 1024;
    const int boff0 = FP8 ? lds_byte(wc * 32 + fr, fq * 16) : lds_byte(wc * 32 + fr, fq * 8), boff1 = FP8 ? lds_byte(wc * 32 + fr, fq * 16 + 8) : boff0 + 1024;
#define PG8_SA(b, h) (((b) * 2 + (h)) * HTB)
#define PG8_SB(b, h) ((4 + (b) * 2 + (h)) * HTB)
#define PG8_STAGE(bufoff, gbase, voff) do { _Pragma("unroll") for (int _i = 0; _i < 2; ++_i) \
        __builtin_amdgcn_global_load_lds((const unsigned*)((const char*)(gbase) + (voff)[_i]), (LAS unsigned*)(lds + (bufoff) + ldsw + _i * 8192), 16, 0, 0); } while (0)
#define PG8_CAT(p0, p1) __builtin_shufflevector((p0), (p1), 0, 1, 2, 3, 4, 5, 6, 7)
#define PG8_LDA(dst, b, h) do { _Pragma("unroll") for (int m = 0; m < 4; ++m) dst[m] = PG8_CAT(*(const LAS i32x4*)(lds + PG8_SA(b, h) + aoff0 + m * 2048), *(const LAS i32x4*)(lds + PG8_SA(b, h) + aoff1 + m * 2048)); } while (0)
#define PG8_LDB(dst, b, h) do { _Pragma("unroll") for (int n = 0; n < 2; ++n) dst[n] = PG8_CAT(*(const LAS i32x4*)(lds + PG8_SB(b, h) + boff0 + n * 2048), *(const LAS i32x4*)(lds + PG8_SB(b, h) + boff1 + n * 2048)); } while (0)
#define PG8_LO(x) __builtin_bit_cast(bf16x8, __builtin_shufflevector((x), (x), 0, 1, 2, 3))
#define PG8_HI(x) __builtin_bit_cast(bf16x8, __builtin_shufflevector((x), (x), 4, 5, 6, 7))
#define PG8_MMA(ai, bj, At, Bt) do { __builtin_amdgcn_s_setprio(1); \
        if constexpr (FP8) { _Pragma("unroll") for (int m = 0; m < 4; ++m) _Pragma("unroll") for (int n = 0; n < 2; ++n) \
            asm volatile("v_mfma_scale_f32_16x16x128_f8f6f4 %0, %1, %2, %0, %3, %4 op_sel_hi:[0,0,0]" : "+v"(acc[ai][bj][m][n]) : "v"(Bt[n]), "v"(At[m]), "v"(sc_w), "v"(sc_x)); } \
        else { _Pragma("unroll") for (int m = 0; m < 4; ++m) _Pragma("unroll") for (int n = 0; n < 2; ++n) { \
            acc[ai][bj][m][n] = __builtin_amdgcn_mfma_f32_16x16x32_bf16(PG8_LO(Bt[n]), PG8_LO(At[m]), acc[ai][bj][m][n], 0, 0, 0); } \
            _Pragma("unroll") for (int m = 0; m < 4; ++m) _Pragma("unroll") for (int n = 0; n < 2; ++n) { \
            acc[ai][bj][m][n] = __builtin_amdgcn_mfma_f32_16x16x32_bf16(PG8_HI(Bt[n]), PG8_HI(At[m]), acc[ai][bj][m][n], 0, 0, 0); } } \
        __builtin_amdgcn_s_setprio(0); } while (0)
#define PG8_WAIT_V(n) asm volatile("s_waitcnt vmcnt(" #n ")" ::: "memory")
#define PG8_WAIT_L(n) asm volatile("s_waitcnt lgkmcnt(" #n ")" ::: "memory")
#define PG8_BAR __builtin_amdgcn_s_barrier()
#define PG8_SCHED __builtin_amdgcn_sched_barrier(0)
    Unit cur, nxt; int ui = 0;
    if (!S.next(0, cur)) return;
    f32x4 acc[2][2][4][2];
#pragma unroll
    for (int a = 0; a < 2; ++a)
#pragma unroll
        for (int b = 0; b < 2; ++b)
#pragma unroll
            for (int m = 0; m < 4; ++m)
#pragma unroll
                for (int n = 0; n < 2; ++n) acc[a][b][m][n] = (f32x4){0.f, 0.f, 0.f, 0.f};
    const int sc_w = 121, sc_x = 127;
    v8i32 At[4], B0[2], B1[2];
    unsigned offC[2][2], offN[2][2];
    cur.sl = 0; S.prefetch(cur, 0, wid, lane); PG8_WAIT_V(0); PG8_BAR;
    S.a_off(cur, sR, sC, offC);
    const char* cA = S.a_base(cur); const char* cB = S.b_base(cur);
    PG8_STAGE(PG8_SB(0, 0), cB, voffB); PG8_STAGE(PG8_SB(0, 1), cB + hstep, voffB); PG8_STAGE(PG8_SA(0, 0), cA, offC[0]); PG8_STAGE(PG8_SA(0, 1), cA, offC[1]);
    if (wr == 1) PG8_BAR;
    PG8_WAIT_V(2); PG8_BAR;
    PG8_STAGE(PG8_SB(1, 0), cB + kstep, voffB); PG8_STAGE(PG8_SA(1, 0), cA + kstep, offC[0]); PG8_STAGE(PG8_SB(1, 1), cB + hstep + kstep, voffB);
    PG8_WAIT_V(6); PG8_BAR;
    for (;;) {
        const bool has_next = S.next(ui + 1, nxt);
        const char* nA = cA; const char* nB = cB;
        nxt.sl = cur.sl == 2 ? 0 : cur.sl + 1;
        if (has_next) { nA = S.a_base(nxt); nB = S.b_base(nxt); S.prefetch(nxt, nxt.sl, wid, lane); }
#pragma unroll
        for (int h = 0; h < 2; ++h)
#pragma unroll
            for (int i = 0; i < 2; ++i) offN[h][i] = offC[h][i];
#pragma nounroll
        for (int t = 0; t < nt; t += 2) {
            const bool last = (t == nt - 2);
            if (last && has_next) S.a_off(nxt, sR, sC, offN);
            const char* a1 = cA + (size_t)(t + 1) * kstep;
            const char* a2 = last ? nA : cA + (size_t)(t + 2) * kstep; const char* b2 = last ? nB : cB + (size_t)(t + 2) * kstep;
            const char* a3 = a2 + kstep; const char* b3 = b2 + kstep;
            unsigned o2[2][2];
#pragma unroll
            for (int h = 0; h < 2; ++h)
#pragma unroll
                for (int i = 0; i < 2; ++i) o2[h][i] = last ? offN[h][i] : offC[h][i];
            PG8_LDB(B0, 0, 0); PG8_LDB(B1, 0, 1); PG8_SCHED; PG8_LDA(At, 0, 0); PG8_STAGE(PG8_SA(1, 1), a1, offC[1]);
            PG8_WAIT_V(8); PG8_WAIT_L(0); PG8_BAR; PG8_MMA(0, 0, At, B0); PG8_MMA(0, 1, At, B1); PG8_BAR; PG8_SCHED;
            PG8_LDA(At, 0, 1); PG8_STAGE(PG8_SB(0, 0), b2, voffB); PG8_STAGE(PG8_SB(0, 1), b2 + hstep, voffB); PG8_STAGE(PG8_SA(0, 0), a2, o2[0]);
            PG8_WAIT_V(8); PG8_WAIT_L(0); PG8_BAR; PG8_MMA(1, 0, At, B0); PG8_MMA(1, 1, At, B1); PG8_BAR; PG8_SCHED;
            PG8_LDB(B0, 1, 0); PG8_LDB(B1, 1, 1); PG8_SCHED; PG8_LDA(At, 1, 0); PG8_STAGE(PG8_SA(0, 1), a2, o2[1]);
            PG8_WAIT_V(8); PG8_WAIT_L(0); PG8_BAR; PG8_MMA(0, 0, At, B0); PG8_MMA(0, 1, At, B1); PG8_BAR; PG8_SCHED;
            PG8_LDA(At, 1, 1); PG8_STAGE(PG8_SB(1, 0), b3, voffB); PG8_STAGE(PG8_SB(1, 1), b3 + hstep, voffB); PG8_STAGE(PG8_SA(1, 0), a3, o2[0]);
            PG8_WAIT_V(8); PG8_WAIT_L(0); PG8_BAR; PG8_MMA(1, 0, At, B0); PG8_MMA(1, 1, At, B1); PG8_BAR; PG8_SCHED;
        }
        if constexpr (ALIGN_EPI) { if (wr == 0) PG8_BAR; }
        E(acc, cur, wr, wc, fr, fq);
        if (!has_next) break;
#pragma unroll
        for (int a = 0; a < 2; ++a)
#pragma unroll
            for (int b = 0; b < 2; ++b)
#pragma unroll
                for (int m = 0; m < 4; ++m)
#pragma unroll
                    for (int n = 0; n < 2; ++n) acc[a][b][m][n] = (f32x4){0.f, 0.f, 0.f, 0.f};
        cur = nxt; cA = nA; cB = nB; ++ui;
#pragma unroll
        for (int h = 0; h < 2; ++h)
#pragma unroll
            for (int i = 0; i < 2; ++i) offC[h][i] = offN[h][i];
        if constexpr (ALIGN_EPI) { if (wr == 1) PG8_BAR; }
    }
    PG8_WAIT_V(0);
    if constexpr (!ALIGN_EPI) { if (wr == 0) PG8_BAR; }
    PG8_BAR;
#undef PG8_SA
#undef PG8_SB
#undef PG8_STAGE
#undef PG8_LDA
#undef PG8_LDB
#undef PG8_MMA
#undef PG8_LO
#undef PG8_HI
#undef PG8_CAT
#undef PG8_WAIT_V
#undef PG8_WAIT_L
#undef PG8_BAR
#undef PG8_SCHED
}
}
namespace pg8 {
constexpr int T_BLKSTART = 0  , T_CNT = 40  , T_BLKE = 80  , T_WORDS = 80 + 560;
constexpr int TB_OFF = 8192 - 64;

struct EpiIn {
    static constexpr bool PERM = true;
    bf16_t* Z; const float* qn; const float* kn;
    __device__ __forceinline__ void operator()(const f32x4 (&acc)[2][2][4][2], const Unit& u, int wr, int wc, int fr, int fq) const {
        const int row0 = u.pm * BM + wr * 64 + fr;
        if (u.pn < 4) {
            const float* g = (u.pn < 2) ? qn : kn; const float sc = (u.pn < 2) ? QSCALE : 1.0f;
            f32x4 gv[2][2];
#pragma unroll
            for (int bj = 0; bj < 2; ++bj)
#pragma unroll
                for (int n = 0; n < 2; ++n) gv[bj][n] = *(const f32x4*)(g + 32 * bj + 8 * fq + 4 * n) * sc;
#pragma unroll
            for (int ai = 0; ai < 2; ++ai)
#pragma unroll
                for (int m = 0; m < 4; ++m) {
                    float ss = 0.f;
#pragma unroll
                    for (int bj = 0; bj < 2; ++bj)
#pragma unroll
                        for (int n = 0; n < 2; ++n) { const f32x4 x = acc[ai][bj][m][n]; ss += (x[0] * x[0] + x[1] * x[1]) + (x[2] * x[2] + x[3] * x[3]); }
                    ss += __shfl_xor(ss, 16); ss += __shfl_xor(ss, 32);
                    const float rstd = rsqrtf(ss * (1.0f / 64.0f) + 1e-6f);
                    bf16_t* rowp = Z + (size_t)(row0 + ai * HALF + m * 16) * ZW + u.pn * BM + 64 * wc + 8 * fq;
#pragma unroll
                    for (int bj = 0; bj < 2; ++bj) { const f32x4 v0 = acc[ai][bj][m][0] * rstd * gv[bj][0], v1 = acc[ai][bj][m][1] * rstd * gv[bj][1];
                        u32x4 w; w.x = cvt_pk_bf16(v0[0], v0[1]); w.y = cvt_pk_bf16(v0[2], v0[3]); w.z = cvt_pk_bf16(v1[0], v1[1]); w.w = cvt_pk_bf16(v1[2], v1[3]);
                        *(u32x4*)(rowp + 32 * bj) = w; }
                }
        } else {
            const int col0 = u.pn * BM + wc * 32 + 8 * fq;
#pragma unroll
            for (int ai = 0; ai < 2; ++ai)
#pragma unroll
                for (int m = 0; m < 4; ++m) { bf16_t* rowp = Z + (size_t)(row0 + ai * HALF + m * 16) * ZW + col0;
#pragma unroll
                    for (int bj = 0; bj < 2; ++bj) { const f32x4 v0 = acc[ai][bj][m][0], v1 = acc[ai][bj][m][1];
                        u32x4 w; w.x = cvt_pk_bf16(v0[0], v0[1]); w.y = cvt_pk_bf16(v0[2], v0[3]); w.z = cvt_pk_bf16(v1[0], v1[1]); w.w = cvt_pk_bf16(v1[2], v1[3]);
                        *(u32x4*)(rowp + bj * HALF) = w; } }
        }
    }
};
struct EpiBf16 {
    static constexpr bool PERM = true;
    bf16_t* O; int ldc;
    __device__ __forceinline__ void operator()(const f32x4 (&acc)[2][2][4][2], const Unit& u, int wr, int wc, int fr, int fq) const {
        const int row0 = u.pm * BM + wr * 64 + fr, col0 = u.pn * BM + wc * 32 + 8 * fq;
#pragma unroll
        for (int ai = 0; ai < 2; ++ai)
#pragma unroll
            for (int m = 0; m < 4; ++m) { bf16_t* rowp = O + (size_t)(row0 + ai * HALF + m * 16) * ldc + col0;
#pragma unroll
                for (int bj = 0; bj < 2; ++bj) { const f32x4 v0 = acc[ai][bj][m][0], v1 = acc[ai][bj][m][1];
                    u32x4 w; w.x = cvt_pk_bf16(v0[0], v0[1]); w.y = cvt_pk_bf16(v0[2], v0[3]); w.z = cvt_pk_bf16(v1[0], v1[1]); w.w = cvt_pk_bf16(v1[2], v1[3]);
                    *(u32x4*)(rowp + bj * HALF) = w; } }
    }
};
struct EpiOut {
    static constexpr bool PERM = true;
    const float* X; bf16_t* O;
    __device__ __forceinline__ void operator()(const f32x4 (&acc)[2][2][4][2], const Unit& u, int wr, int wc, int fr, int fq) const {
        const int row0 = u.pm * BM + wr * 64 + fr, col0 = u.pn * BM + wc * 32 + 8 * fq;
#pragma unroll
        for (int ai = 0; ai < 2; ++ai)
#pragma unroll
            for (int m = 0; m < 4; ++m) { const size_t off = (size_t)(row0 + ai * HALF + m * 16) * DM + col0;
#pragma unroll
                for (int bj = 0; bj < 2; ++bj) { const f32x4 v0 = *(const f32x4*)(X + off + bj * HALF) + acc[ai][bj][m][0], v1 = *(const f32x4*)(X + off + bj * HALF + 4) + acc[ai][bj][m][1];
                    u32x4 w; w.x = pk2(v0[0], v0[1]); w.y = pk2(v0[2], v0[3]); w.z = pk2(v1[0], v1[1]); w.w = pk2(v1[2], v1[3]);
                    *(u32x4*)(O + off + bj * HALF) = w; }
                if (m & 1) asm volatile("" ::: "memory"); }
    }
};
struct EpiPg {
    static constexpr bool PERM = true;
    bf16_t* X; const bf16_t* PJ;
    __device__ __forceinline__ void operator()(const f32x4 (&acc)[2][2][4][2], const Unit& u, int wr, int wc, int fr, int fq) const {
        const int row0 = u.pm * BM + wr * 64 + fr, col0 = u.pn * BM + wc * 32 + 8 * fq;
#pragma unroll
        for (int ai = 0; ai < 2; ++ai)
#pragma unroll
            for (int m = 0; m < 4; ++m) { const size_t off = (size_t)(row0 + ai * HALF + m * 16) * DM + col0;
#pragma unroll
                for (int bj = 0; bj < 2; ++bj) { const size_t o = off + bj * HALF; const u32x4 pj = *(const u32x4*)(PJ + o), xv = *(const u32x4*)(X + o);
                    const unsigned pw[4] = {pj.x, pj.y, pj.z, pj.w}, xw[4] = {xv.x, xv.y, xv.z, xv.w}; unsigned ow[4];
#pragma unroll
                    for (int q = 0; q < 4; ++q) { const float a0 = acc[ai][bj][m][q >> 1][2 * (q & 1)], a1 = acc[ai][bj][m][q >> 1][2 * (q & 1) + 1];
                        ow[q] = pk2(bflo(xw[q]) + sigmoidf_(a0) * bflo(pw[q]), bfhi(xw[q]) + sigmoidf_(a1) * bfhi(pw[q])); }
                    *(u32x4*)(X + o) = (u32x4){ow[0], ow[1], ow[2], ow[3]}; }
                if (m & 1) asm volatile("" ::: "memory"); }
    }
};
struct EpiGu {
    static constexpr bool PERM = true;
    unsigned char* ACT; const float* b_gu;
    __device__ __forceinline__ void operator()(const f32x4 (&acc)[2][2][4][2], const Unit& u, int wr, int wc, int fr, int fq) const {
        const int row0 = u.pm * BM + wr * 64 + fr, cl = u.pn * HALF + wc * 32 + 8 * fq;
        const float* bg = b_gu + (size_t)u.e * 2048 + cl;
        f32x4 bgl[2], bli[2];
#pragma unroll
        for (int n = 0; n < 2; ++n) { bgl[n] = *(const f32x4*)(bg + 4 * n); bli[n] = *(const f32x4*)(bg + 1024 + 4 * n); }
#pragma unroll
        for (int ai = 0; ai < 2; ++ai)
#pragma unroll
            for (int m = 0; m < 4; ++m) { unsigned char* rowp = ACT + (size_t)(row0 + ai * HALF + m * 16) * EFF + cl; float r[8];
#pragma unroll
                for (int n = 0; n < 2; ++n)
#pragma unroll
                    for (int i = 0; i < 4; ++i) { const float gl = fminf(acc[ai][0][m][n][i] + bgl[n][i], 7.0f); const float li = fminf(fmaxf(acc[ai][1][m][n][i] + bli[n][i], -7.0f), 7.0f);
                        r[4 * n + i] = gl * sigmoidf_(1.702f * gl) * (li + 1.0f); }
                u32x2 w; w.x = pk4_fp8(r[0], r[1], r[2], r[3]); w.y = pk4_fp8(r[4], r[5], r[6], r[7]);
                *(u32x2*)rowp = w; }
    }
};
struct EpiDn {
    static constexpr bool PERM = true;
    unsigned char* YP; const float* b_dn; const float* gateslot; const LAS int* tab;
    __device__ __forceinline__ void operator()(const f32x4 (&acc)[2][2][4][2], const Unit& u, int wr, int wc, int fr, int fq) const {
        const int row0 = u.pm * BM + wr * 64 + fr, col0 = u.pn * BM + wc * 32 + 8 * fq;
        const float* bd = b_dn + (size_t)u.e * 1024 + col0; const int cnt = tab[T_CNT + u.e];
        f32x4 bv[2][2];
#pragma unroll
        for (int bj = 0; bj < 2; ++bj)
#pragma unroll
            for (int n = 0; n < 2; ++n) bv[bj][n] = *(const f32x4*)(bd + bj * HALF + 4 * n);
#pragma unroll
        for (int ai = 0; ai < 2; ++ai)
#pragma unroll
            for (int m = 0; m < 4; ++m) { const int rr = wr * 64 + fr + ai * HALF + m * 16, slot = u.lb * 256 + rr;
                const float gt = slot < cnt ? ((const LAS float*)((const LAS unsigned char*)tab + TB_OFF + u.sl * 1024))[rr] * 16.0f : 0.f;
                unsigned char* rowp = YP + (size_t)(row0 + ai * HALF + m * 16) * DM + col0;
#pragma unroll
                for (int bj = 0; bj < 2; ++bj) { const f32x4 v0 = (acc[ai][bj][m][0] + bv[bj][0]) * gt, v1 = (acc[ai][bj][m][1] + bv[bj][1]) * gt;
                    u32x2 w; w.x = pk4_fp8(v0[0], v0[1], v0[2], v0[3]); w.y = pk4_fp8(v1[0], v1[1], v1[2], v1[3]);
                    *(u32x2*)(rowp + bj * HALF) = w; } }
    }
};
struct MoeOrder {
    const unsigned char* A; const unsigned char* Bt; const int* tokslot; const float* gateslot;   const LAS int* tab; int nblk, nN, G, c; bool gather;
    __device__ __forceinline__ bool next(int i, Unit& u) const { if (!tile_order(i, G, c, nblk, nN, u.pm, u.pn)) return false; u.e = tab[T_BLKE + u.pm]; u.lb = u.pm - tab[T_BLKSTART + u.e]; return true; }
    __device__ __forceinline__ const char* a_base(const Unit& u) const { return gather ? (const char*)A : (const char*)A + (size_t)u.pm * BM * 1024; }
    __device__ __forceinline__ const char* b_base(const Unit& u) const { return (const char*)Bt + ((size_t)u.e * nN + u.pn) * BM * 1024; }
    __device__ __forceinline__ void prefetch(const Unit& u, int slot, int wid, int lane) const {
        if (wid < 4) { const unsigned* src = (gather ? (const unsigned*)tokslot : (const unsigned*)gateslot) + (size_t)u.e * NTOK + u.lb * 256 + wid * 64 + lane;
            __builtin_amdgcn_global_load_lds(src, (LAS unsigned*)((LAS unsigned char*)tab + TB_OFF + slot * 1024 + wid * 256), 4, 0, 0); }
    }
    __device__ __forceinline__ void a_off(const Unit& u, const int (&R)[2], const int (&C)[2], unsigned (&off)[2][2]) const {
        const int cnt = tab[T_CNT + u.e]; const LAS int* tb = (const LAS int*)((const LAS unsigned char*)tab + TB_OFF + u.sl * 1024);
#pragma unroll
        for (int h = 0; h < 2; ++h)
#pragma unroll
            for (int i = 0; i < 2; ++i) {
                if (gather) { const int rr = R[i] + HALF * h; const int tk = tb[rr]; const int tok = (u.lb * 256 + rr) < cnt ? tk : NTOK; off[h][i] = (unsigned)tok * 1024u + (unsigned)C[i] * 2u; }
                else off[h][i] = (unsigned)((R[i] + HALF * h) * 1024 + C[i] * 2);
            }
    }
};
__device__ __forceinline__ int moe_tables(LAS int* tab, const unsigned* cntw) {
    if (threadIdx.x == 0) { int s = 0; for (int e = 0; e < NE; ++e) { const int c = (int)cntw[e]; tab[T_CNT + e] = c; tab[T_BLKSTART + e] = s; const int nb = (c + 255) >> 8; for (int j = 0; j < nb; ++j) tab[T_BLKE + s + j] = e; s += nb; } tab[T_BLKSTART + NE] = s; }
    __syncthreads();
    return tab[T_BLKSTART + NE];
}
}
constexpr int NWAVES = 8, NTHREADS = 512;
constexpr int RING_BYTES = 131072, MISC_OFF = RING_BYTES, LDS_BYTES = 147456;

__device__ __forceinline__ void tr_item(const float* W, int ldw, int srccol0, int k0, bf16_t* WT, int Kd, int dstrow0, LAS float* scr, int lane) {
#pragma unroll 8
    for (int i = 0; i < 32; ++i) { const int kk = 2 * i + (lane >> 5); scr[kk * 33 + (lane & 31)] = W[(size_t)(k0 + kk) * ldw + srccol0 + (lane & 31)]; }
    asm volatile("s_waitcnt lgkmcnt(0)" ::: "memory");
    const int c = lane & 7;
#pragma unroll
    for (int j = 0; j < 4; ++j) { const int n = (lane >> 3) + 8 * j; const LAS float* s = scr + (8 * c) * 33 + n;
        u32x4 o; o.x = pk2(s[0 * 33], s[1 * 33]); o.y = pk2(s[2 * 33], s[3 * 33]); o.z = pk2(s[4 * 33], s[5 * 33]); o.w = pk2(s[6 * 33], s[7 * 33]);
        *(u32x4*)(WT + (size_t)(dstrow0 + n) * Kd + k0 + 8 * c) = o; }
    asm volatile("s_waitcnt lgkmcnt(0)" ::: "memory");
}
__device__ __forceinline__ void tr_item8(const float* W, int ldw, int srccol0, int k0, unsigned char* WT, int Kd, int dstrow0, LAS float* scr, int lane) {
#pragma unroll 8
    for (int i = 0; i < 32; ++i) { const int kk = 2 * i + (lane >> 5); scr[kk * 33 + (lane & 31)] = W[(size_t)(k0 + kk) * ldw + srccol0 + (lane & 31)]; }
    asm volatile("s_waitcnt lgkmcnt(0)" ::: "memory");
    const int c = lane & 7;
#pragma unroll
    for (int j = 0; j < 4; ++j) { const int n = (lane >> 3) + 8 * j; const LAS float* s = scr + (8 * c) * 33 + n;
        u32x2 o; o.x = pk4_fp8(s[0 * 33] * 64.f, s[1 * 33] * 64.f, s[2 * 33] * 64.f, s[3 * 33] * 64.f); o.y = pk4_fp8(s[4 * 33] * 64.f, s[5 * 33] * 64.f, s[6 * 33] * 64.f, s[7 * 33] * 64.f);
        *(u32x2*)(WT + (size_t)(dstrow0 + n) * Kd + k0 + 8 * c) = o; }
    asm volatile("s_waitcnt lgkmcnt(0)" ::: "memory");
}
constexpr int I_IN = 16 * 120, I_OUT = 16 * 32, I_PG = 16 * 32, I_PP = 4 * 32, I_GU1 = 16 * 64, I_DN1 = 16 * 32;
constexpr int I_LORA = 16 + 16 + 32;
constexpr int I_SMALL = I_IN + I_OUT + I_PG + I_PP + I_LORA, I_GU = NE * I_GU1, I_DN = NE * I_DN1, I_ALL = I_SMALL + I_GU + I_DN;
__device__ __forceinline__ void prep_item(KPR P, int it, LAS float* scr, int lane) {
    unsigned char* ws = P.ws;
    if (it < I_IN) { const int kb = it / 120, nb = it % 120, n0 = nb * 32, pn = n0 >> 8, j0 = n0 & 255;
        const int src = pn < 4 ? (pn * 256 + 64 * ((j0 & 127) >> 5) + 32 * (j0 >> 7)) : (n0 < 2048 ? n0 : n0 + 8);
        tr_item(P.w_in, INW, src, kb * 64, (bf16_t*)(ws + WS_WIN), 1024, n0, scr, lane); return; }
    it -= I_IN;
    if (it < I_OUT) { tr_item(P.w_out, 1024, (it % 32) * 32, (it / 32) * 64, (bf16_t*)(ws + WS_WOUT), 1024, (it % 32) * 32, scr, lane); return; }
    it -= I_OUT;
    if (it < I_PG) { tr_item8(P.w_pg, 1024, (it % 32) * 32, (it / 32) * 64, ws + WS_WPG, 1024, (it % 32) * 32, scr, lane); return; }
    it -= I_PG;
    if (it < I_PP) { tr_item(P.w_pp, 1024, (it % 32) * 32, (it / 32) * 64, (bf16_t*)(ws + WS_WPP), 256, (it % 32) * 32, scr, lane); return; }
    it -= I_PP;
    if (it < 16) { tr_item(P.w2, 512, it * 32, 0, (bf16_t*)(ws + 29 * MiB), 64, it * 32, scr, lane); return; }
    it -= 16;
    if (it < 16) { tr_item(P.a2, 512, it * 32, 0, (bf16_t*)(ws + 29 * MiB + 65536), 64, it * 32, scr, lane); return; }
    it -= 16;
    if (it < 32) { tr_item(P.g2, 512, (it % 16) * 32, (it / 16) * 64, (bf16_t*)(ws + 29 * MiB + 131072), 128, (it % 16) * 32, scr, lane); return; }
    it -= 32;
    if (it < I_GU) { const int e = it / I_GU1, r = it % I_GU1, kb = r / 64, nb = r % 64, n0 = nb * 32, pn = n0 >> 8, j0 = n0 & 255;
        const int src = (j0 >> 7) * 1024 + pn * 128 + (j0 & 127);
        tr_item8(P.w_gu + (size_t)e * 1024 * 2048, 2048, src, kb * 64, ws + WS_WGU + (size_t)e * 2048 * 1024, 1024, n0, scr, lane); return; }
    it -= I_GU;
    { const int e = it / I_DN1, r = it % I_DN1, kb = r / 32, nb = r % 32;
        tr_item8(P.w_down + (size_t)e * 1024 * 1024, 1024, nb * 32, kb * 64, ws + WS_WDN + (size_t)e * 1024 * 1024, 1024, nb * 32, scr, lane); }
}
__device__ __forceinline__ void phase_prep_weights(KPR P, LAS unsigned char* lds, int gw, int ngw, int wave, int lane) {
    LAS float* scr = (LAS float*)(lds + wave * 16384);
    for (int it = gw; it < I_ALL; it += ngw) prep_item(P, it, scr, lane);
}
__device__ __forceinline__ void phase_cvt_p(KPR P, int gt, int ngt) {
    bf16_t* PB = (bf16_t*)((unsigned char*)P.out + DO_PB);
    for (int i = gt; i < NTOK * PLE / 8; i += ngt) { const f32x4 a = ((const f32x4*)P.p)[2 * i], b = ((const f32x4*)P.p)[2 * i + 1];
        u32x4 w; w.x = pk2(a[0], a[1]); w.y = pk2(a[2], a[3]); w.z = pk2(b[0], b[1]); w.w = pk2(b[2], b[3]); ((u32x4*)PB)[i] = w; }
}
__device__ __forceinline__ void rms_row(const float* xrow, const float* gain, int lane, f32x4 (&v)[4]) {
    const f32x4* xr = (const f32x4*)xrow + lane; float s = 0.f;
#pragma unroll
    for (int j = 0; j < 4; ++j) { v[j] = xr[64 * j]; s += (v[j][0] * v[j][0] + v[j][1] * v[j][1]) + (v[j][2] * v[j][2] + v[j][3] * v[j][3]); }
    const float rstd = rsqrtf(wave_sum(s) * (1.f / DM) + 1e-6f);
#pragma unroll
    for (int j = 0; j < 4; ++j) v[j] = v[j] * rstd * ((const f32x4*)gain)[64 * j + lane];
}
__device__ __forceinline__ void store_row_fp8(unsigned char* orow, int lane, const f32x4 (&v)[4]) {
    unsigned* o4 = (unsigned*)orow + lane;
#pragma unroll
    for (int j = 0; j < 4; ++j) o4[64 * j] = pk4_fp8(v[j][0], v[j][1], v[j][2], v[j][3]);
}
__device__ __forceinline__ void store_row_bf16(bf16_t* orow, int lane, const f32x4 (&v)[4]) {
    u32x2* o8 = (u32x2*)orow + lane;
#pragma unroll
    for (int j = 0; j < 4; ++j) { u32x2 w; w.x = pk2(v[j][0], v[j][1]); w.y = pk2(v[j][2], v[j][3]); o8[64 * j] = w; }
}
__device__ __forceinline__ void norm1_row(KPR P, int row, int lane, const LAS float* wff, LAS float* lf_out  ) {
    f32x4 v[4]; rms_row(P.x + (size_t)row * DM, P.mix_norm, lane, v);
    store_row_bf16((bf16_t*)(P.ws + WS_XN) + (size_t)row * DM, lane, v);
    float ff[8];
#pragma unroll
    for (int q = 0; q < 8; ++q) ff[q] = 0.f;
#pragma unroll
    for (int j = 0; j < 4; ++j)
#pragma unroll
        for (int i = 0; i < 4; ++i) { const LAS f32x4* w = (const LAS f32x4*)(wff + (size_t)(4 * (64 * j + lane) + i) * 8); const f32x4 w0 = w[0], w1 = w[1]; const float h = v[j][i];
            ff[0] += h * w0[0]; ff[1] += h * w0[1]; ff[2] += h * w0[2]; ff[3] += h * w0[3]; ff[4] += h * w1[0]; ff[5] += h * w1[1]; ff[6] += h * w1[2]; ff[7] += h * w1[3]; }
#pragma unroll
    for (int q = 0; q < 8; ++q) ff[q] = wave_sum(ff[q]);
    if (lane < 8) { float f = ff[0];
#pragma unroll
        for (int q = 1; q < 8; ++q) f = (lane == q) ? ff[q] : f;
        lf_out[lane] = logsigmoidf_(f + P.f_bias[lane]); }
}
__device__ __forceinline__ void load_wff(KPR P, LAS float* wff, int tid, int nthr) {
    for (int i = tid; i < 1024 * 8; i += nthr) wff[i] = P.w_in[(size_t)(i >> 3) * INW + 2048 + (i & 7)];
}
__device__ __forceinline__ void final_row(KPR P, int row, int lane, bool dead) {
    const u32x2* xr = (const u32x2*)((const bf16_t*)(P.ws + WS_X1) + (size_t)row * DM) + lane; f32x4 v[4]; float s = 0.f;
#pragma unroll
    for (int j = 0; j < 4; ++j) { const u32x2 xv = xr[64 * j]; v[j] = (f32x4){bflo(xv.x), bfhi(xv.x), bflo(xv.y), bfhi(xv.y)}; s += (v[j][0] * v[j][0] + v[j][1] * v[j][1]) + (v[j][2] * v[j][2] + v[j][3] * v[j][3]); }
    const float rstd = rsqrtf(wave_sum(s) * (1.f / DM) + 1e-6f);
    f32x4* o = (f32x4*)(P.out + (size_t)row * DM) + lane;
#pragma unroll
    for (int j = 0; j < 4; ++j) { v[j] = v[j] * rstd * ((const f32x4*)P.final_norm)[64 * j + lane]; if (dead) { const float q = __builtin_nanf(""); v[j] = (f32x4){q, q, q, q}; } o[64 * j] = v[j]; }
}
typedef GAS unsigned gu32;
#define RLX_AGENT __ATOMIC_RELAXED, __HIP_MEMORY_SCOPE_AGENT
#define XB_TMO      128
#define XB_XCNT(j)  (256  + 64 * (j))
#define XB_XSUB(j)  (1280 + 64 * (j))
#define XB_XGEN(j)  (2304 + 64 * (j))
#define XB_TOP      3328
#define XB_TOPGEN   3392
#define XCD_BAR_WORDS 3456
#define XB_SPIN_CAP (1u << 22)

__device__ __forceinline__ unsigned xb_ld(unsigned* p)              { return __hip_atomic_load(p, __ATOMIC_RELAXED, __HIP_MEMORY_SCOPE_AGENT); }
__device__ __forceinline__ unsigned xb_add(unsigned* p, unsigned v) { return __hip_atomic_fetch_add(p, v, __ATOMIC_RELAXED, __HIP_MEMORY_SCOPE_AGENT); }
__device__ __forceinline__ unsigned xb_xcc_id() { return (unsigned)__builtin_amdgcn_s_getreg((3 << 11) | 20) & 0xFu; }
#define XB_SPIN(cond, bar) do { unsigned _sp = 0; while (cond) { __builtin_amdgcn_s_sleep(1); \
    if ((++_sp & 255u) == 0u) { if (xb_ld(&(bar)[XB_TMO])) break; if (_sp > XB_SPIN_CAP) { atomicAdd(&(bar)[XB_TMO], 1u); break; } } } } while (0)

struct XcdBarrier { unsigned* bar; unsigned x; volatile LAS unsigned* st; };

__device__ __forceinline__ XcdBarrier xcd_barrier_post(unsigned* bar, volatile LAS unsigned* st) {
    XcdBarrier b; b.bar = bar; b.x = xb_xcc_id(); b.st = st;
    if (threadIdx.x == 0) (void)xb_add(&bar[XB_XCNT(b.x)], 1u);
    return b;
}
__device__ __forceinline__ void xcd_barrier_complete(unsigned* bar, unsigned x, unsigned& nloc, unsigned& nx) {
    const unsigned G = gridDim.x * gridDim.y * gridDim.z;
    unsigned sum, cnt, mine, sp = 0u;
    for (;;) {
        sum = 0u; cnt = 0u; mine = 0u;
#pragma unroll
        for (unsigned j = 0; j < 16; ++j) { const unsigned c = xb_ld(&bar[XB_XCNT(j)]); sum += c; cnt += (c > 0u) ? 1u : 0u; mine = (j == x) ? c : mine; }
        if (sum == G) break;
        __builtin_amdgcn_s_sleep(1);
        if ((++sp & 255u) == 0u) { if (xb_ld(&bar[XB_TMO])) break; if (sp > XB_SPIN_CAP) { atomicAdd(&bar[XB_TMO], 1u); break; } }
    }
    nloc = mine > 0u ? mine : 1u; nx = cnt > 0u ? cnt : 1u;
}
__device__ __forceinline__ void xcd_barrier(const XcdBarrier& b) {
    asm volatile("s_waitcnt vmcnt(0)" ::: "memory");
    __syncthreads();
    if (threadIdx.x == 0) {
        unsigned* bar = b.bar;
        __builtin_amdgcn_s_waitcnt(0);
        unsigned nloc = b.st[0], nx = b.st[1];
        if (nloc == 0u) { xcd_barrier_complete(bar, b.x, nloc, nx); b.st[0] = nloc; b.st[1] = nx; }
        const unsigned old = xb_add(&bar[XB_XSUB(b.x)], 1u);
        const unsigned gen = old / nloc;
        if (old + 1u == (gen + 1u) * nloc) {
            __builtin_amdgcn_fence(__ATOMIC_RELEASE, "agent");
            asm volatile("s_waitcnt vmcnt(0)" ::: "memory");
            const unsigned og = xb_add(&bar[XB_TOP], 1u);
            const unsigned tg = og / nx;
            if (og + 1u == (tg + 1u) * nx) xb_add(&bar[XB_TOPGEN], 1u);
            else XB_SPIN(xb_ld(&bar[XB_TOPGEN]) == tg, bar);
            __builtin_amdgcn_fence(__ATOMIC_ACQUIRE, "agent");
            xb_add(&bar[XB_XGEN(b.x)], 1u);
            asm volatile("s_waitcnt vmcnt(0)" ::: "memory");
        } else {
            XB_SPIN(xb_ld(&bar[XB_XGEN(b.x)]) == gen, bar);
            __builtin_amdgcn_fence(__ATOMIC_ACQUIRE, "agent");
            asm volatile("s_waitcnt vmcnt(0)" ::: "memory");
        }
    }
    __syncthreads();
}
namespace rk {
constexpr int MB = 8192;
constexpr int S_AT = 0, S_RT = 1, S_KT = 2, S_BT = 3, S_ATT = 4, S_KTT = 5, S_BTT = 6, S_VT = 7, S_N = 8, S_NT = 9, S_MAK = 10, S_MRB = 11, S_MRK = 12, S_TA = 13, S_TB = 14;
constexpr int SCR = 15 * MB;
constexpr int NCHUNK = SEQ / 64;
constexpr size_t WS_HT = WS_X1;
constexpr size_t WS_Y0 = WS_X1 + 64 * MiB;
constexpr size_t WS_QI = WS_X1 + 96 * MiB;
constexpr size_t WS_LW = WS_RW, WS_LA = WS_RW + 32 * MiB, WS_LG = WS_RW + 64 * MiB;
constexpr size_t WS_SC = WS_RW + 224 * MiB;
constexpr size_t DO_GT = 80 * MiB;
static_assert(WS_SC + 32 * MiB <= WS_END, "rwkv blobs");

__device__ __forceinline__ int moff(int row, int col) { return row * 128 + ((((col >> 3) ^ (row >> 1)) & 7) << 4) + (col & 7) * 2; }
__device__ __forceinline__ int crow(int r, int hi) { return (r & 3) + 8 * (r >> 2) + 4 * hi; }
__device__ __forceinline__ f32x16 mm_nt(const LAS unsigned char* A, int ar0, const LAS unsigned char* Bt, int br0, f32x16 acc, int r32, int hi) {
#pragma unroll
    for (int ks = 0; ks < 4; ++ks) { const bf16x8 a = *(const LAS bf16x8*)(A + moff(ar0 + r32, 16 * ks + 8 * hi)), b = *(const LAS bf16x8*)(Bt + moff(br0 + r32, 16 * ks + 8 * hi));
        acc = __builtin_amdgcn_mfma_f32_32x32x16_bf16(a, b, acc, 0, 0, 0); }
    return acc;
}
__device__ __forceinline__ void store_t(LAS unsigned char* dst, const f32x16& acc, int i0, int j0, int r32, int hi) {
#pragma unroll
    for (int g = 0; g < 4; ++g) { u32x2 w; w.x = pk2(acc[4 * g], acc[4 * g + 1]); w.y = pk2(acc[4 * g + 2], acc[4 * g + 3]); *(LAS u32x2*)(dst + moff(j0 + r32, i0 + 8 * g + 4 * hi)) = w; }
}
template <int MODE> __device__ __forceinline__ void mask_tri(f32x16& acc, int i0, int j0, int r32, int hi) {
#pragma unroll
    for (int r = 0; r < 16; ++r) { const int i = i0 + crow(r, hi), j = j0 + r32; const bool keep = MODE == 0 ? (j < i) : (MODE == 1 ? (i < j) : (i <= j)); if (!keep) acc[r] = 0.f; }
}

__device__ __forceinline__ void pass1_chunk(KPR P, LAS unsigned char* lds, int bh, int c, int tid) {
    const int lane = tid & 63, wave = tid >> 6, r32 = lane & 31, hi = lane >> 5, grp = wave >> 2, wq = wave & 3, i0 = 32 * (wq >> 1), j0 = 32 * (wq & 1);
    const int b = bh >> 3, h = bh & 7; const size_t tok0 = (size_t)b * SEQ + (size_t)c * 64; const size_t ci = (size_t)bh * NCHUNK + c;
    LAS float* part = (LAS float*)(lds + SCR); LAS float* WL = (LAS float*)(lds + SCR + 2048);
#define MAT(s) (lds + (s) * MB)
    {
        const bf16_t* Z = (const bf16_t*)(P.ws + WS_Z); const bf16_t* LW = (const bf16_t*)(P.ws + WS_LW); const bf16_t* LA = (const bf16_t*)(P.ws + WS_LA);
        const int ch = tid & 63, tq = tid >> 6, cc = h * 64 + ch; const size_t row0 = tok0 + 8 * tq;
        const float mur = P.mu[RW_R + cc], muk = P.mu[RW_K + cc], muv = P.mu[RW_V + cc], w0c = P.w0[cc], a0c = P.a0[cc], kkc = P.k_k[cc], kac = P.k_a[cc];
        const bf16_t* zp = Z + row0 * ZW + ZR + cc;
        const bool first = (c == 0) && (tq == 0); const bf16_t* zq = first ? zp : zp - ZW; const float pm = first ? 0.f : 1.f;
        unsigned short lr[9], lk[9], lv[9], llw[8], lla[8];
        lr[0] = zq[RW_R]; lk[0] = zq[RW_K]; lv[0] = zq[RW_V];
#pragma unroll
        for (int i = 0; i < 8; ++i) { const bf16_t* zi = zp + (size_t)i * ZW; lr[i + 1] = zi[RW_R]; lk[i + 1] = zi[RW_K]; lv[i + 1] = zi[RW_V]; const size_t o = (row0 + i) * 512 + cc; llw[i] = LW[o]; lla[i] = LA[o]; }
        float cum[8], vr[8], vk[8], vkk[8], vka[8], ssq[8]; unsigned short vv16[8]; float run = 0.f;
#pragma unroll
        for (int i = 0; i < 8; ++i) { const float pmi = (i == 0) ? pm : 1.f; const float zr1 = bf2f(lr[i + 1]), zk1 = bf2f(lk[i + 1]), zv1 = bf2f(lv[i + 1]);
            vr[i] = zr1 + (bf2f(lr[i]) * pmi - zr1) * mur; vk[i] = zk1 + (bf2f(lk[i]) * pmi - zk1) * muk; vv16[i] = (unsigned short)f2bf(zv1 + (bf2f(lv[i]) * pmi - zv1) * muv);
            vkk[i] = vk[i] * kkc; ssq[i] = vkk[i] * vkk[i]; }
#pragma unroll
        for (int o = 1; o < 64; o <<= 1) {
#pragma unroll
            for (int i = 0; i < 8; ++i) ssq[i] += __shfl_xor(ssq[i], o); }
#pragma unroll
        for (int i = 0; i < 8; ++i) {
            const float wl = w0c + bf2f(llw[i]); const float sp = fmaxf(-wl, 0.f) + __logf(1.0f + __expf(-fabsf(wl)));
            run += -__expf(-sp - 0.5f); cum[i] = run;
            const float a = __builtin_amdgcn_rcpf(1.0f + __expf(-(a0c + bf2f(lla[i]))));
            const float kk = vkk[i] * __builtin_amdgcn_rcpf(fmaxf(__builtin_amdgcn_sqrtf(ssq[i]), 1e-12f));
            vk[i] = vk[i] * (1.0f + (a - 1.0f) * kac); vkk[i] = kk; vka[i] = kk * a; }
        part[tq * 64 + ch] = run;
        __syncthreads();
        float pre = 0.f;
#pragma unroll
        for (int g = 0; g < 8; ++g) { const float pvv = part[g * 64 + ch]; pre += (g < tq) ? pvv : 0.f; }
        float eprev = __expf(pre);
        unsigned atT[4], ktT[4], btT[4], vT[4]; unsigned short hold[4] = {0, 0, 0, 0};
#pragma unroll
        for (int i = 0; i < 8; ++i) { const int t = 8 * tq + i;
            const float cm = pre + cum[i], e1 = __expf(cm), einv = __expf(-cm);
            const unsigned short at = (unsigned short)f2bf(-vkk[i] * eprev), rt = (unsigned short)f2bf(vr[i] * e1), kt = (unsigned short)f2bf(vk[i] * einv), bt = (unsigned short)f2bf(vka[i] * einv), vv = vv16[i];
            eprev = e1;
            *(LAS unsigned short*)(MAT(S_AT) + moff(t, ch)) = at; *(LAS unsigned short*)(MAT(S_RT) + moff(t, ch)) = rt; *(LAS unsigned short*)(MAT(S_KT) + moff(t, ch)) = kt; *(LAS unsigned short*)(MAT(S_BT) + moff(t, ch)) = bt;
            if (i & 1) { atT[i >> 1] = hold[0] | ((unsigned)at << 16); ktT[i >> 1] = hold[1] | ((unsigned)kt << 16); btT[i >> 1] = hold[2] | ((unsigned)bt << 16); vT[i >> 1] = hold[3] | ((unsigned)vv << 16); }
            else { hold[0] = at; hold[1] = kt; hold[2] = bt; hold[3] = vv; }
            if (i == 7 && tq == 7) WL[ch] = e1; }
        *(LAS u32x4*)(MAT(S_ATT) + moff(ch, 8 * tq)) = (u32x4){atT[0], atT[1], atT[2], atT[3]}; *(LAS u32x4*)(MAT(S_KTT) + moff(ch, 8 * tq)) = (u32x4){ktT[0], ktT[1], ktT[2], ktT[3]};
        *(LAS u32x4*)(MAT(S_BTT) + moff(ch, 8 * tq)) = (u32x4){btT[0], btT[1], btT[2], btT[3]}; *(LAS u32x4*)(MAT(S_VT) + moff(ch, 8 * tq)) = (u32x4){vT[0], vT[1], vT[2], vT[3]};
    }
    __syncthreads();
    const f32x16 zero = f32x16{};
    if (grp == 0) { f32x16 d = mm_nt(MAT(S_AT), i0, MAT(S_BT), j0, zero, r32, hi); mask_tri<0>(d, i0, j0, r32, hi); store_t(MAT(S_NT), d, i0, j0, r32, hi);
        d = mm_nt(MAT(S_KT), i0, MAT(S_AT), j0, zero, r32, hi); mask_tri<1>(d, i0, j0, r32, hi); store_t(MAT(S_MAK), d, i0, j0, r32, hi);
        d = mm_nt(MAT(S_KT), i0, MAT(S_RT), j0, zero, r32, hi); mask_tri<2>(d, i0, j0, r32, hi); store_t(MAT(S_MRK), d, i0, j0, r32, hi); }
    else { f32x16 d = mm_nt(MAT(S_BT), i0, MAT(S_AT), j0, zero, r32, hi); mask_tri<1>(d, i0, j0, r32, hi); store_t(MAT(S_N), d, i0, j0, r32, hi);
#pragma unroll
        for (int r = 0; r < 16; ++r) if (i0 + crow(r, hi) == j0 + r32) d[r] = 1.0f;
        store_t(MAT(S_TA), d, i0, j0, r32, hi);
        d = mm_nt(MAT(S_BT), i0, MAT(S_RT), j0, zero, r32, hi); mask_tri<2>(d, i0, j0, r32, hi); store_t(MAT(S_MRB), d, i0, j0, r32, hi); }
    __syncthreads();
#pragma unroll
    for (int s = 1; s <= 6; ++s) {
        const int mc = (s & 1) ? S_N : S_AT, mcT = (s & 1) ? S_NT : S_KT, mn = (s & 1) ? S_AT : S_N, mnT = (s & 1) ? S_KT : S_NT;
        const int tc = (s & 1) ? S_TB : S_TA, tn = (s & 1) ? S_TA : S_TB;
        if (s <= 5) {
            if (grp == 0) { const f32x16 d = mm_nt(MAT(mc), i0, MAT(mcT), j0, zero, r32, hi); store_t(MAT(mnT), d, i0, j0, r32, hi); }
            else { const f32x16 d = mm_nt(MAT(mcT), i0, MAT(mc), j0, zero, r32, hi); store_t(MAT(mn), d, i0, j0, r32, hi); }
        }
        if (s >= 2 && grp == (s <= 5 ? 0 : 1) ) {
            f32x16 d = mm_nt(MAT(mcT), i0, MAT(tc), j0, zero, r32, hi);
#pragma unroll
            for (int g = 0; g < 4; ++g) { const u32x2 tv = *(const LAS u32x2*)(MAT(tc) + moff(j0 + r32, i0 + 8 * g + 4 * hi)); d[4 * g] += bflo(tv.x); d[4 * g + 1] += bfhi(tv.x); d[4 * g + 2] += bflo(tv.y); d[4 * g + 3] += bfhi(tv.y); }
            store_t(MAT(tn), d, i0, j0, r32, hi);
        }
        __syncthreads();
    }
    if (grp == 0) { const f32x16 d = mm_nt(MAT(S_TB), i0, MAT(S_ATT), j0, zero, r32, hi); store_t(MAT(S_BT), d, i0, j0, r32, hi); }
    else { const f32x16 d = mm_nt(MAT(S_MAK), i0, MAT(S_VT), j0, zero, r32, hi); store_t(MAT(S_N), d, i0, j0, r32, hi); }
    __syncthreads();
    if (grp == 0) { const f32x16 d = mm_nt(MAT(S_TB), i0, MAT(S_N), j0, zero, r32, hi); store_t(MAT(S_NT), d, i0, j0, r32, hi);
        f32x16 q = mm_nt(MAT(S_BT), i0, MAT(S_MRB), j0, zero, r32, hi);
#pragma unroll
        for (int g = 0; g < 4; ++g) { const u32x2 rv = *(const LAS u32x2*)(MAT(S_RT) + moff(j0 + r32, i0 + 8 * g + 4 * hi)); q[4 * g] += bflo(rv.x); q[4 * g + 1] += bfhi(rv.x); q[4 * g + 2] += bflo(rv.y); q[4 * g + 3] += bfhi(rv.y); }
        store_t(MAT(S_KT), q, i0, j0, r32, hi); }
    else { f32x16 g_ = mm_nt(MAT(S_BT), i0, MAT(S_BTT), j0, zero, r32, hi);
        const float wl = WL[j0 + r32];
#pragma unroll
        for (int r = 0; r < 16; ++r) { if (i0 + crow(r, hi) == j0 + r32) g_[r] += 1.0f; g_[r] *= wl; }
        store_t(MAT(S_AT), g_, i0, j0, r32, hi); }
    __syncthreads();
    if (grp == 0) { f32x16 d = mm_nt(MAT(S_BTT), i0, MAT(S_NT), j0, zero, r32, hi); d = mm_nt(MAT(S_KTT), i0, MAT(S_VT), j0, d, r32, hi);
        float* HT = (float*)(P.ws + WS_HT) + ci * 4096 + (size_t)wq * 1024 + lane;
#pragma unroll
        for (int g = 0; g < 4; ++g) { const f32x4 wl4 = *(const LAS f32x4*)(WL + i0 + 8 * g + 4 * hi);
#pragma unroll
            for (int i = 0; i < 4; ++i) HT[(4 * g + i) * 64] = d[4 * g + i] * wl4[i]; } }
    else { f32x16 d = mm_nt(MAT(S_MRB), i0, MAT(S_NT), j0, zero, r32, hi); d = mm_nt(MAT(S_MRK), i0, MAT(S_VT), j0, d, r32, hi);
        unsigned* Y0 = (unsigned*)(P.ws + WS_Y0) + ci * 2048 + (size_t)wq * 512 + lane;
#pragma unroll
        for (int r2 = 0; r2 < 8; ++r2) Y0[r2 * 64] = pk2(d[2 * r2], d[2 * r2 + 1]); }
    { u32x4* GTg = (u32x4*)((unsigned char*)P.out + DO_GT + ci * MB); u32x4* QIg = (u32x4*)(P.ws + WS_QI + ci * MB);
        GTg[tid] = *(const LAS u32x4*)(MAT(S_AT) + tid * 16); QIg[tid] = *(const LAS u32x4*)(MAT(S_KT) + tid * 16); }
    __syncthreads();
#undef MAT
}

__device__ __forceinline__ void pass2_seq(KPR P, LAS unsigned char* lds, int bh, int tid) {
    const int lane = tid & 63, wave = tid >> 6, r32 = lane & 31, hi = lane >> 5, wq = wave & 3, i0 = 32 * (wq >> 1), j0 = 32 * (wq & 1);
    LAS unsigned char* Sm = lds; LAS unsigned char* G0 = lds + MB; LAS unsigned char* G1 = lds + 2 * MB;
    const size_t ci0 = (size_t)bh * NCHUNK;
    const u32x4* GTg = (const u32x4*)((const unsigned char*)P.out + DO_GT + ci0 * MB); u32x4* SCg = (u32x4*)(P.ws + WS_SC + ci0 * MB);
    const float* HT = (const float*)(P.ws + WS_HT) + ci0 * 4096 + (size_t)wq * 1024 + lane;
    *(LAS u32x4*)(Sm + tid * 16) = (u32x4){0u, 0u, 0u, 0u};
    *(LAS u32x4*)(G0 + tid * 16) = GTg[tid];
    u32x4 gnext = GTg[512 + tid];
    f32x16 hcur, hnext;
    if (wave < 4) {
#pragma unroll
        for (int r = 0; r < 16; ++r) { hcur[r] = HT[r * 64]; hnext[r] = HT[4096 + r * 64]; } }
    __syncthreads();
    for (int c = 0; c < NCHUNK; ++c) {
        LAS unsigned char* Gc = (c & 1) ? G1 : G0; LAS unsigned char* Gn = (c & 1) ? G0 : G1;
        SCg[(size_t)c * 512 + tid] = *(const LAS u32x4*)(Sm + tid * 16);
        f32x16 d = hcur;
        if (wave < 4) d = mm_nt(Gc, i0, Sm, j0, d, r32, hi);
        __syncthreads();
        if (wave < 4) store_t(Sm, d, i0, j0, r32, hi);
        *(LAS u32x4*)(Gn + tid * 16) = gnext;
        const int c2 = (c + 2 < NCHUNK) ? c + 2 : NCHUNK - 1;
        gnext = GTg[(size_t)c2 * 512 + tid];
        if (wave < 4) { hcur = hnext;
#pragma unroll
            for (int r = 0; r < 16; ++r) hnext[r] = HT[(size_t)c2 * 4096 + r * 64]; }
        __syncthreads();
    }
}

__device__ __forceinline__ void pass3_chunk(KPR P, LAS unsigned char* lds, int bh, int c, int tid) {
    const int lane = tid & 63, wave = tid >> 6, r32 = lane & 31, hi = lane >> 5, wq = wave & 3, i0 = 32 * (wq >> 1), j0 = 32 * (wq & 1);
    const int b = bh >> 3, h = bh & 7; const size_t tok0 = (size_t)b * SEQ + (size_t)c * 64; const size_t ci = (size_t)bh * NCHUNK + c;
    LAS unsigned char* Qm = lds; LAS unsigned char* Sm = lds + MB; LAS float* Yl = (LAS float*)(lds + 2 * MB);
    *(LAS u32x4*)(Qm + tid * 16) = ((const u32x4*)(P.ws + WS_QI + ci * MB))[tid];
    *(LAS u32x4*)(Sm + tid * 16) = ((const u32x4*)(P.ws + WS_SC + ci * MB))[tid];
    f32x16 d = f32x16{};
    if (wave < 4) { const unsigned* Y0 = (const unsigned*)(P.ws + WS_Y0) + ci * 2048 + (size_t)wq * 512 + lane;
#pragma unroll
        for (int r2 = 0; r2 < 8; ++r2) { const unsigned w = Y0[r2 * 64]; d[2 * r2] = bflo(w); d[2 * r2 + 1] = bfhi(w); } }
    __syncthreads();
    if (wave < 4) { d = mm_nt(Qm, i0, Sm, j0, d, r32, hi);
#pragma unroll
        for (int r = 0; r < 16; ++r) Yl[(i0 + crow(r, hi)) * 65 + j0 + r32] = d[r]; }
    __syncthreads();
    const bf16_t* Z = (const bf16_t*)(P.ws + WS_Z); const bf16_t* LA = (const bf16_t*)(P.ws + WS_LA); const bf16_t* LG = (const bf16_t*)(P.ws + WS_LG);
    bf16_t* AO = (bf16_t*)(P.ws + WS_AO); const int cc = h * 64 + lane;
    const float lnw = P.ln_w[cc], lnb = P.ln_b[cc], rkc = P.r_k[cc], mur = P.mu[RW_R + cc], muk = P.mu[RW_K + cc], muv = P.mu[RW_V + cc], a0c = P.a0[cc], kac = P.k_a[cc];
    const bf16_t* zp = Z + (tok0 + wave * 8) * ZW + ZR + cc; const bool first = (c == 0) && (wave == 0); const bf16_t* zq = first ? zp : zp - ZW; const float pm = first ? 0.f : 1.f;
    unsigned short lr[9], lk[9], lv[9], lla[8], llg[8];
    lr[0] = zq[RW_R]; lk[0] = zq[RW_K]; lv[0] = zq[RW_V];
#pragma unroll
    for (int i = 0; i < 8; ++i) { const bf16_t* zi = zp + (size_t)i * ZW; lr[i + 1] = zi[RW_R]; lk[i + 1] = zi[RW_K]; lv[i + 1] = zi[RW_V]; const size_t o = (tok0 + wave * 8 + i) * 512 + cc; lla[i] = LA[o]; llg[i] = LG[o]; }
    float y[8], s1[8], s2[8], s3[8], vvv[8];
#pragma unroll
    for (int i = 0; i < 8; ++i) { const float pmi = (i == 0) ? pm : 1.f; const float zr1 = bf2f(lr[i + 1]), zk1 = bf2f(lk[i + 1]), zv1 = bf2f(lv[i + 1]);
        const float r = zr1 + (bf2f(lr[i]) * pmi - zr1) * mur, zk = zk1 + (bf2f(lk[i]) * pmi - zk1) * muk; vvv[i] = zv1 + (bf2f(lv[i]) * pmi - zv1) * muv;
        const float a = __builtin_amdgcn_rcpf(1.0f + __expf(-(a0c + bf2f(lla[i])))); const float k = zk * (1.0f + (a - 1.0f) * kac);
        y[i] = Yl[(wave * 8 + i) * 65 + lane]; s1[i] = y[i]; s3[i] = r * k * rkc; }
#pragma unroll
    for (int o = 1; o < 64; o <<= 1) {
#pragma unroll
        for (int i = 0; i < 8; ++i) { s1[i] += __shfl_xor(s1[i], o); s3[i] += __shfl_xor(s3[i], o); } }
#pragma unroll
    for (int i = 0; i < 8; ++i) { y[i] -= s1[i] * (1.f / 64.f); s2[i] = y[i] * y[i]; }
#pragma unroll
    for (int o = 1; o < 64; o <<= 1) {
#pragma unroll
        for (int i = 0; i < 8; ++i) s2[i] += __shfl_xor(s2[i], o); }
#pragma unroll
    for (int i = 0; i < 8; ++i) { const size_t tok = tok0 + wave * 8 + i; const float yn = y[i] * rsqrtf(s2[i] * (1.f / 64.f) + 64e-5f) * lnw + lnb;
        AO[tok * DM + 512 + cc] = (bf16_t)f2bf((yn + s3[i] * vvv[i]) * bf2f(llg[i])); }
}

constexpr size_t WS_W2T = 29 * MiB, WS_A2T = 29 * MiB + 65536, WS_G2T = 29 * MiB + 131072;
__device__ __forceinline__ bf16x8 act8(const bf16_t* zc, const bf16_t* zpv, float pmask, const float* mu, int mode) {
    const u32x4 c = *(const u32x4*)zc, p = *(const u32x4*)zpv;
    const f32x4 m0 = *(const f32x4*)mu, m1 = *(const f32x4*)(mu + 4);
    const unsigned cw[4] = {c.x, c.y, c.z, c.w}, pw[4] = {p.x, p.y, p.z, p.w}; const float um[8] = {m0[0], m0[1], m0[2], m0[3], m1[0], m1[1], m1[2], m1[3]}; float v[8];
#pragma unroll
    for (int j = 0; j < 4; ++j) { const float c0 = bflo(cw[j]), c1 = bfhi(cw[j]), p0 = bflo(pw[j]) * pmask, p1 = bfhi(pw[j]) * pmask;
        v[2 * j] = c0 + (p0 - c0) * um[2 * j]; v[2 * j + 1] = c1 + (p1 - c1) * um[2 * j + 1]; }
#pragma unroll
    for (int j = 0; j < 8; ++j) { if (mode == 0) { const float e = __expf(-2.0f * fabsf(v[j])); const float th = (1.0f - e) * __builtin_amdgcn_rcpf(1.0f + e); v[j] = v[j] < 0.f ? -th : th; } else if (mode == 2) v[j] = __builtin_amdgcn_rcpf(1.0f + __expf(-v[j])); }
    u32x4 w; w.x = pk2(v[0], v[1]); w.y = pk2(v[2], v[3]); w.z = pk2(v[4], v[5]); w.w = pk2(v[6], v[7]);
    return __builtin_bit_cast(bf16x8, w);
}
__device__ __forceinline__ void lora_task(KPR P, int task, int lane) {
    const int r32 = lane & 31, hi = lane >> 5; const size_t row = (size_t)task * 32 + r32; const bool first = (row % SEQ) == 0;
    const bf16_t* Z = (const bf16_t*)(P.ws + WS_Z) + row * ZW + ZR + 8 * hi; const bf16_t* Zp = first ? Z : Z - ZW; const float pmask = first ? 0.f : 1.f;
    const float* mub = P.mu + 8 * hi;
    bf16x8 xw[4], xa[4], xg[8];
#pragma unroll
    for (int ks = 0; ks < 4; ++ks) { xw[ks] = act8(Z + RW_W + 16 * ks, Zp + RW_W + 16 * ks, pmask, mub + RW_W + 16 * ks, 0); xa[ks] = act8(Z + RW_A + 16 * ks, Zp + RW_A + 16 * ks, pmask, mub + RW_A + 16 * ks, 1); asm volatile("" ::: "memory"); }
#pragma unroll
    for (int ks = 0; ks < 8; ++ks) { xg[ks] = act8(Z + RW_G + 16 * ks, Zp + RW_G + 16 * ks, pmask, mub + RW_G + 16 * ks, 2); if (ks & 1) asm volatile("" ::: "memory"); }
    const bf16_t* W2T = (const bf16_t*)(P.ws + WS_W2T) + r32 * 64 + 8 * hi; const bf16_t* A2T = (const bf16_t*)(P.ws + WS_A2T) + r32 * 64 + 8 * hi; const bf16_t* G2T = (const bf16_t*)(P.ws + WS_G2T) + r32 * 128 + 8 * hi;
    bf16_t* LW = (bf16_t*)(P.ws + WS_LW) + row * 512 + 4 * hi; bf16_t* LA = (bf16_t*)(P.ws + WS_LA) + row * 512 + 4 * hi; bf16_t* LG = (bf16_t*)(P.ws + WS_LG) + row * 512 + 4 * hi;
#pragma nounroll
    for (int cb = 0; cb < 16; ++cb) {
        f32x16 dw = f32x16{}, da = f32x16{}, dg = f32x16{};
#pragma unroll
        for (int ks = 0; ks < 4; ++ks) { dw = __builtin_amdgcn_mfma_f32_32x32x16_bf16(*(const bf16x8*)(W2T + cb * 32 * 64 + 16 * ks), xw[ks], dw, 0, 0, 0); da = __builtin_amdgcn_mfma_f32_32x32x16_bf16(*(const bf16x8*)(A2T + cb * 32 * 64 + 16 * ks), xa[ks], da, 0, 0, 0); }
#pragma unroll
        for (int ks = 0; ks < 8; ++ks) dg = __builtin_amdgcn_mfma_f32_32x32x16_bf16(*(const bf16x8*)(G2T + cb * 32 * 128 + 16 * ks), xg[ks], dg, 0, 0, 0);
#pragma unroll
        for (int g = 0; g < 4; ++g) { u32x2 w; w.x = pk2(dw[4 * g], dw[4 * g + 1]); w.y = pk2(dw[4 * g + 2], dw[4 * g + 3]); *(u32x2*)(LW + cb * 32 + 8 * g) = w;
            w.x = pk2(da[4 * g], da[4 * g + 1]); w.y = pk2(da[4 * g + 2], da[4 * g + 3]); *(u32x2*)(LA + cb * 32 + 8 * g) = w;
            w.x = pk2(dg[4 * g], dg[4 * g + 1]); w.y = pk2(dg[4 * g + 2], dg[4 * g + 3]); *(u32x2*)(LG + cb * 32 + 8 * g) = w; }
    }
}
}
namespace rt {
__device__ __forceinline__ int woff(int e, int k) { return e * 2048 + ((((k >> 3) ^ (e & 15))) << 4) + (k & 7) * 2; }
constexpr size_t WS_WRI = 30 * MiB;
__device__ __forceinline__ void build_w(KPR P, int tid) {
    unsigned char* img = P.ws + WS_WRI; const int e = tid & 31, kq = tid >> 5;
    for (int i0 = 0; i0 < 64; i0 += 8) { float w[8];
#pragma unroll
        for (int i = 0; i < 8; ++i) { const int k = kq * 64 + i0 + i; w[i] = P.moe_norm[k] * P.w_router[k * 32 + e]; }
#pragma unroll
        for (int i = 0; i < 8; ++i) { const int k = kq * 64 + i0 + i; const unsigned h = f2bf(w[i]); const unsigned l = f2bf(w[i] - bf2f(h));
            *(unsigned short*)(img + woff(e, k)) = (unsigned short)h; *(unsigned short*)(img + 65536 + woff(e, k)) = (unsigned short)l; } }
}
__device__ __forceinline__ void copy_w(KPR P, LAS unsigned char* lds, int tid) {
    const u32x4* img = (const u32x4*)(P.ws + WS_WRI);
#pragma unroll 4
    for (int i = 0; i < 16; ++i) *(LAS u32x4*)(lds + (size_t)(i * 512 + tid) * 16) = img[i * 512 + tid];
}
__device__ __forceinline__ void split8(const f32x4& a, const f32x4& b, bf16x8& h, bf16x8& l) {
    unsigned hh[8]; float v[8] = {a[0], a[1], a[2], a[3], b[0], b[1], b[2], b[3]};
#pragma unroll
    for (int j = 0; j < 8; ++j) hh[j] = f2bf(v[j]);
    u32x4 hw, lw;
    hw.x = hh[0] | (hh[1] << 16); hw.y = hh[2] | (hh[3] << 16); hw.z = hh[4] | (hh[5] << 16); hw.w = hh[6] | (hh[7] << 16);
    lw.x = pk2(v[0] - bf2f(hh[0]), v[1] - bf2f(hh[1])); lw.y = pk2(v[2] - bf2f(hh[2]), v[3] - bf2f(hh[3])); lw.z = pk2(v[4] - bf2f(hh[4]), v[5] - bf2f(hh[5])); lw.w = pk2(v[6] - bf2f(hh[6]), v[7] - bf2f(hh[7]));
    h = __builtin_bit_cast(bf16x8, hw); l = __builtin_bit_cast(bf16x8, lw);
}
__device__ __forceinline__ void route_task(KPR P, const LAS unsigned char* wlds, int task, int lane) {
    const int r32 = lane & 31, hi = lane >> 5; const int row = task * 32 + r32;
    const bf16_t* xrow = (const bf16_t*)(P.ws + WS_X1) + (size_t)row * DM + 8 * hi;
    f32x16 acc = f32x16{}; float ss = 0.f;
    u32x4 xq[4];
#pragma unroll
    for (int j = 0; j < 4; ++j) xq[j] = *(const u32x4*)(xrow + 16 * j);
    for (int ks0 = 0; ks0 < 64; ks0 += 4) {
#pragma unroll
        for (int j = 0; j < 4; ++j) { const int ks = ks0 + j; const u32x4 xv = xq[j];
            const int kn = (ks + 4 < 64) ? ks + 4 : ks; xq[j] = *(const u32x4*)(xrow + 16 * kn);
            const unsigned xw[4] = {xv.x, xv.y, xv.z, xv.w};
#pragma unroll
            for (int q = 0; q < 4; ++q) { const float a = bflo(xw[q]), b = bfhi(xw[q]); ss += a * a + b * b; }
            const bf16x8 xh = __builtin_bit_cast(bf16x8, xv);
            const bf16x8 wh = *(const LAS bf16x8*)(wlds + woff(r32, 16 * ks + 8 * hi)), wl = *(const LAS bf16x8*)(wlds + 65536 + woff(r32, 16 * ks + 8 * hi));
            acc = __builtin_amdgcn_mfma_f32_32x32x16_bf16(wh, xh, acc, 0, 0, 0); acc = __builtin_amdgcn_mfma_f32_32x32x16_bf16(wl, xh, acc, 0, 0, 0); }
    }
    ss += __shfl_xor(ss, 32);
    const float rstd = rsqrtf(ss * (1.f / DM) + 1e-6f);
    float lg[16];
#pragma unroll
    for (int g = 0; g < 4; ++g) { const f32x4 bb = *(const f32x4*)(P.b_router + 8 * g + 4 * hi);
#pragma unroll
        for (int i = 0; i < 4; ++i) lg[4 * g + i] = acc[4 * g + i] * rstd + bb[i]; }
    float tv[4]; int ti[4];
#pragma unroll
    for (int k = 0; k < 4; ++k) { float bv = lg[0]; int bi = 4 * hi;
#pragma unroll
        for (int r = 1; r < 16; ++r) { const int e = (r & 3) + 8 * (r >> 2) + 4 * hi; if (lg[r] > bv) { bv = lg[r]; bi = e; } }
        const float pv = __shfl_xor(bv, 32); const int pi = __shfl_xor(bi, 32);
        if (pv > bv || (pv == bv && pi < bi)) { bv = pv; bi = pi; }
        tv[k] = bv; ti[k] = bi;
#pragma unroll
        for (int r = 0; r < 16; ++r) { const int e = (r & 3) + 8 * (r >> 2) + 4 * hi; if (e == bi) lg[r] = -INFINITY; } }
    const float e1 = __expf(tv[1] - tv[0]), e2 = __expf(tv[2] - tv[0]), e3 = __expf(tv[3] - tv[0]), inv = 1.f / (1.f + e1 + e2 + e3);
    const int c0 = hi ? ti[2] : ti[0], c1 = hi ? ti[3] : ti[1]; const float g0 = (hi ? e2 : 1.f) * inv, g1 = (hi ? e3 : e1) * inv;
    const unsigned long long ltm = (1ull << lane) - 1ull; int mycnt = 0, rk0 = 0, rk1 = 0;
    for (int e = 0; e < 32; ++e) { const unsigned long long m0 = __ballot(c0 == e), m1 = __ballot(c1 == e); const int n0 = __popcll(m0);
        if (lane == e) mycnt = n0 + __popcll(m1);
        if (c0 == e) rk0 = __popcll(m0 & ltm);
        if (c1 == e) rk1 = n0 + __popcll(m1 & ltm); }
    unsigned* cnt = (unsigned*)(P.ws + WS_CTL) + CW_CNT; int base = 0;
    if (lane < 32 && mycnt > 0) base = (int)atomicAdd(cnt + lane, (unsigned)mycnt);
    rk0 += __shfl(base, c0); rk1 += __shfl(base, c1);
    int* route = (int*)(P.ws + WS_ROUTE); int* tokslot = (int*)(P.ws + WS_TOKSLOT); float* gateslot = (float*)(P.ws + WS_GATESLOT);
    tokslot[(size_t)c0 * NTOK + rk0] = row; gateslot[(size_t)c0 * NTOK + rk0] = g0; tokslot[(size_t)c1 * NTOK + rk1] = row; gateslot[(size_t)c1 * NTOK + rk1] = g1;
    route[(size_t)row * 12 + 2 * hi] = c0; route[(size_t)row * 12 + 2 * hi + 1] = c1; route[(size_t)row * 12 + 4 + 2 * hi] = rk0; route[(size_t)row * 12 + 4 + 2 * hi + 1] = rk1;
    unsigned char* xn = P.ws + WS_XN + (size_t)row * DM + 8 * hi; const float* gn = P.moe_norm + 8 * hi;
#pragma unroll
    for (int j = 0; j < 4; ++j) xq[j] = *(const u32x4*)(xrow + 16 * j);
    for (int ks0 = 0; ks0 < 64; ks0 += 4) {
#pragma unroll
        for (int j = 0; j < 4; ++j) { const int ks = ks0 + j; const u32x4 xv = xq[j]; const f32x4 ga = *(const f32x4*)(gn + 16 * ks), gb = *(const f32x4*)(gn + 16 * ks + 4);
            const int kn = (ks + 4 < 64) ? ks + 4 : ks; xq[j] = *(const u32x4*)(xrow + 16 * kn);
            u32x2 w; w.x = pk4_fp8(bflo(xv.x) * rstd * ga[0], bfhi(xv.x) * rstd * ga[1], bflo(xv.y) * rstd * ga[2], bfhi(xv.y) * rstd * ga[3]); w.y = pk4_fp8(bflo(xv.z) * rstd * gb[0], bfhi(xv.z) * rstd * gb[1], bflo(xv.w) * rstd * gb[2], bfhi(xv.w) * rstd * gb[3]);
            *(u32x2*)(xn + 16 * ks) = w; }
    }
}
}
namespace attn_body {
using bf16=unsigned short;
using bf16x8=__attribute__((ext_vector_type(8)))short;
using s16x4=__attribute__((ext_vector_type(4)))short;
using f32x16=__attribute__((ext_vector_type(16)))float;
using u32x4=__attribute__((ext_vector_type(4)))unsigned;
constexpr int BATCH=4,NHEAD=8,SEQ=8192,D=64,DM=3840,OP=1024;
constexpr int NW=8,QBLK=32,QB=QBLK*NW,KVBLK=64,NQB=SEQ/QB;
constexpr int ATTN_PITCH=DM, ATTN_UNIT_ROWS=QB;
__device__ __forceinline__ int crow(int r,int hi){return (r&3)+8*(r>>2)+4*hi;}
#define SBAR() __builtin_amdgcn_sched_barrier(0)
__device__ __forceinline__ void cmask(f32x16&p0,f32x16&p1,int jb,int qrel,int hi){
  const float NEG=-INFINITY; int kb=64*jb+4*hi;
  #pragma unroll
  for(int r=0;r<16;++r){int kv=kb+(r&3)+8*(r>>2); if(kv>qrel)p0[r]=NEG; if(kv+32>qrel)p1[r]=NEG;}
}

constexpr int NSLOT=3, SLOTB=8192;
constexpr int LDS_K=0, LDS_V=NSLOT*SLOTB, LDS_WS=2*NSLOT*SLOTB, LDS_OST=LDS_WS+NW*64*4, LDS_C2=LDS_OST+NW*4096, LDS_BYTES=LDS_C2+SEQ*4;
constexpr float C2=0.125f*1.4426950408889634f;
__device__ __forceinline__ void glds16(const void*gsrc,unsigned lds_dst){unsigned keep;
  asm volatile("s_mov_b32 %0, m0\n\ts_mov_b32 m0, %2\n\ts_nop 0\n\tglobal_load_lds_dwordx4 %1, off\n\ts_mov_b32 m0, %0":"=&s"(keep):"v"(gsrc),"s"(lds_dst):"memory");}
__device__ __forceinline__ float max3f(float a,float b,float c){float r;asm("v_max3_f32 %0, %1, %2, %3":"=v"(r):"v"(a),"v"(b),"v"(c));return r;}
__device__ __forceinline__ float max2f(float a,float b){float r;asm("v_max_f32_e32 %0, %1, %2":"=v"(r):"v"(a),"v"(b));return r;}
__device__ __forceinline__ float fadd_s(float a,float b){float r;asm("v_add_f32_e32 %0, %1, %2":"=v"(r):"v"(a),"v"(b));return r;}
__device__ __forceinline__ float fsub_s(float a,float b){float r;asm("v_sub_f32_e32 %0, %1, %2":"=v"(r):"v"(a),"v"(b));return r;}
typedef float f32x2_t __attribute__((ext_vector_type(2))); typedef float f32x4v __attribute__((ext_vector_type(4))); typedef __bf16 bf16x2_t __attribute__((ext_vector_type(2)));
__device__ __forceinline__ unsigned cvtpk_s(float lo,float hi){f32x2_t v={lo,hi};bf16x2_t b=__builtin_convertvector(v,bf16x2_t);return __builtin_bit_cast(unsigned,b);}
#define WAIT_BAR(N) asm volatile("s_waitcnt vmcnt(" #N ") lgkmcnt(0)\n\ts_barrier":::"memory")

__device__ __forceinline__ void qkt(f32x16&p0,f32x16&p1,const char*Kslot,const bf16x8*qr,int r32,int hi){
  const char*kb=Kslot+hi*1024+r32*16;
  #pragma unroll
  for(int d0=0;d0<4;++d0){
    const bf16x8 b0=*reinterpret_cast<const bf16x8*>(kb+d0*2048);
    const bf16x8 b1=*reinterpret_cast<const bf16x8*>(kb+d0*2048+512);
    p0=__builtin_amdgcn_mfma_f32_32x32x16_bf16(b0,qr[d0],p0,0,0,0);p1=__builtin_amdgcn_mfma_f32_32x32x16_bf16(b1,qr[d0],p1,0,0,0);}
}
typedef __attribute__((address_space(3))) const char* lds_cptr;
typedef short v4i16_t __attribute__((ext_vector_type(4)));
__device__ __forceinline__ void kload8(bf16x8*kf,lds_cptr kp){
  kf[0]=*(const __attribute__((address_space(3))) bf16x8*)(kp);      kf[1]=*(const __attribute__((address_space(3))) bf16x8*)(kp+512);
  kf[2]=*(const __attribute__((address_space(3))) bf16x8*)(kp+2048); kf[3]=*(const __attribute__((address_space(3))) bf16x8*)(kp+2560);
  kf[4]=*(const __attribute__((address_space(3))) bf16x8*)(kp+4096); kf[5]=*(const __attribute__((address_space(3))) bf16x8*)(kp+4608);
  kf[6]=*(const __attribute__((address_space(3))) bf16x8*)(kp+6144); kf[7]=*(const __attribute__((address_space(3))) bf16x8*)(kp+6656);
}
__device__ __forceinline__ void kload2(bf16x8*kf,lds_cptr kp,int j){ kf[2*j]=*(const __attribute__((address_space(3))) bf16x8*)(kp+j*2048); kf[2*j+1]=*(const __attribute__((address_space(3))) bf16x8*)(kp+j*2048+512); }
__device__ __forceinline__ s16x4 vtr(lds_cptr p){ return __builtin_bit_cast(s16x4,__builtin_amdgcn_ds_read_tr16_b64_v4i16((__attribute__((address_space(3))) v4i16_t*)p)); }
__device__ __forceinline__ float rowmax(const f32x16&p0,const f32x16&p1){
  float a=max3f(p0[0],p0[1],p1[0]),b=max3f(p0[2],p0[3],p1[1]);a=max3f(a,p1[2],p1[3]);
  #pragma unroll
  for(int r=4;r<16;r+=4){a=max3f(a,p0[r],p0[r+1]);b=max3f(b,p0[r+2],p0[r+3]);a=max3f(a,p1[r],p1[r+1]);b=max3f(b,p1[r+2],p1[r+3]);}
  const float m=max2f(a,b);
  auto rr=__builtin_amdgcn_permlane32_swap(__float_as_uint(m),__float_as_uint(m),false,false);
  return max2f(__uint_as_float(rr[0]),__uint_as_float(rr[1]));
}
__device__ __forceinline__ void pv(f32x16*o,int vb,bf16x8 pa0,bf16x8 pa1,bf16x8 pa2,bf16x8 pa3){
  #pragma unroll
  for(int d0=0;d0<2;++d0){s16x4 lo[4],hi[4];
    #pragma unroll
    for(int ks=0;ks<4;++ks){
      asm volatile("ds_read_b64_tr_b16 %0,%1 offset:%c2":"=&v"(lo[ks]):"v"(vb),"i"(d0*4096+ks*1024):"memory");
      asm volatile("ds_read_b64_tr_b16 %0,%1 offset:%c2":"=&v"(hi[ks]):"v"(vb),"i"(d0*4096+ks*1024+512):"memory");}
    asm volatile("s_waitcnt lgkmcnt(0)":::"memory");SBAR();
    #define PK(k) (bf16x8){lo[k][0],lo[k][1],lo[k][2],lo[k][3],hi[k][0],hi[k][1],hi[k][2],hi[k][3]}
    o[d0]=__builtin_amdgcn_mfma_f32_32x32x16_bf16(pa0,PK(0),o[d0],0,0,0);
    o[d0]=__builtin_amdgcn_mfma_f32_32x32x16_bf16(pa1,PK(1),o[d0],0,0,0);
    o[d0]=__builtin_amdgcn_mfma_f32_32x32x16_bf16(pa2,PK(2),o[d0],0,0,0);
    o[d0]=__builtin_amdgcn_mfma_f32_32x32x16_bf16(pa3,PK(3),o[d0],0,0,0);
    #undef PK
  }
}

#ifndef ATTN_STORE16
#define ATTN_STORE16(p,v) (*(u32x4*)(p)=(v))
#endif
template<int THRL> __device__ __forceinline__ void attn_unit(int b,int h,int qb,int t0,const bf16*Z,const float*c2g,bf16*O,char*shm){
  const int tid=threadIdx.x,lane=tid&63,r32=lane&31,hi=lane>>5; const int wid=__builtin_amdgcn_readfirstlane(tid>>6);
  const long rowbase=(long)b*SEQ; const int q0=qb*QB;
  const bf16*Qw=Z+(rowbase+q0+wid*QBLK)*DM+h*D;
  const bf16*Kh=Z+(rowbase+(long)t0*KVBLK)*DM+512+h*D,*Vh=Z+(rowbase+(long)t0*KVBLK)*DM+1024+h*D;
  const unsigned lds0=(unsigned)(uintptr_t)shm;
  float*wsf=(float*)(shm+LDS_WS)+wid*64;
  const bf16*ksrc=Kh+(long)lane*DM+wid*8;
  const bf16*vsrc=Vh+(long)(16*(wid&3)+(lane>>2))*DM+(wid>>2)*32+(lane&3)*8;
  const unsigned kdst=lds0+LDS_K+wid*1024, vdst=lds0+LDS_V+wid*1024;
  #define DMA_K(t,slot) glds16(ksrc+(long)(t)*KVBLK*DM,(unsigned)__builtin_amdgcn_readfirstlane(kdst+(slot)))
  #define DMA_V(t,slot) glds16(vsrc+(long)(t)*KVBLK*DM,(unsigned)__builtin_amdgcn_readfirstlane(vdst+(slot)))
  const int vb0=(int)(lds0+LDS_V)+((lane>>4)&1)*32+(lane&3)*8+(4*hi+((lane&15)>>2))*64;
  const char*Kbase=shm+LDS_K; bf16x8 kf[8];
  const lds_cptr shm3=(lds_cptr)shm; const lds_cptr kp0=shm3+LDS_K+hi*1024+r32*16; const lds_cptr vp0=shm3+LDS_V+((lane>>4)&1)*32+(lane&3)*8+(4*hi+((lane&15)>>2))*64;
  const int NT=(q0+QB)/KVBLK-t0;
  { const int np=(q0+QB)/256;
    for(int p=(t0>>2)+wid;p<np;p+=NW) glds16(c2g+p*256+lane*4,(unsigned)__builtin_amdgcn_readfirstlane(lds0+LDS_C2+p*1024)); }
  const __attribute__((address_space(3))) float* c2l=(const __attribute__((address_space(3))) float*)(shm3+LDS_C2)+t0*KVBLK+4*hi;
  DMA_K(0,0);DMA_V(0,0);DMA_K(1,SLOTB);
  bf16x8 qr[4];
  #pragma unroll
  for(int d0=0;d0<4;++d0)qr[d0]=*reinterpret_cast<const bf16x8*>(&Qw[(long)r32*DM+d0*16+hi*8]);
  float l_reg=0.f;f32x16 o[2];o[0]=f32x16{};o[1]=f32x16{};
  float base=c2g[q0+wid*QBLK+r32];
  const int qrel=wid*QBLK+r32;
  #define CMASK(P0,P1,t) do{int jb_=(t)-(NT-4); if(jb_>=0)cmask(P0,P1,jb_,qrel,hi);}while(0)
  bool resc=false;
  #define START(P0,P1) do{ const float rm=rowmax(P0,P1); resc=false; \
    { const float dl=rm; base=fsub_s(base,dl); \
      _Pragma("unroll") for(int r=0;r<16;++r){P0[r]=fsub_s(P0[r],dl);P1[r]=fsub_s(P1[r],dl);} } \
    _Pragma("unroll") for(int r=0;r<16;++r)P0[r]=__builtin_amdgcn_exp2f(P0[r]); }while(0)
  #define RESC() do{ if(resc){ asm volatile("s_waitcnt lgkmcnt(0)":::"memory"); \
      _Pragma("unroll") for(int d_=0;d_<2;++d_) _Pragma("unroll") for(int r=0;r<16;++r)o[d_][r]*=wsf[crow(r,hi)]; } }while(0)
  f32x16 pA0,pA1,pB0,pB1;
  #define BIASLD(P0,P1,tt) do{ _Pragma("unroll") for(int g_=0;g_<4;++g_){ const f32x4v x0_=*(const __attribute__((address_space(3))) f32x4v*)(c2l+(tt)*KVBLK+8*g_), x1_=*(const __attribute__((address_space(3))) f32x4v*)(c2l+(tt)*KVBLK+32+8*g_); \
      P0[4*g_]=x0_[0];P0[4*g_+1]=x0_[1];P0[4*g_+2]=x0_[2];P0[4*g_+3]=x0_[3]; P1[4*g_]=x1_[0];P1[4*g_+1]=x1_[1];P1[4*g_+2]=x1_[2];P1[4*g_+3]=x1_[3]; } }while(0)
  #define BIASFIX(P0,P1) do{ _Pragma("unroll") for(int r=0;r<16;++r){P0[r]=fsub_s(base,P0[r]);P1[r]=fsub_s(base,P1[r]);} }while(0)
  int sl_prev=0,sl_cur=0,sl_next=SLOTB;
  #define ROT() do{sl_prev=sl_cur;sl_cur=sl_next;sl_next=(sl_next==(NSLOT-1)*SLOTB)?0:sl_next+SLOTB;}while(0)
  DMA_K(2,2*SLOTB);
  WAIT_BAR(3);
  BIASLD(pA0,pA1,0); BIASFIX(pA0,pA1);
  qkt(pA0,pA1,Kbase,qr,r32,hi);asm volatile("s_nop 15\n\ts_nop 7":"+v"(pA0),"+v"(pA1));CMASK(pA0,pA1,0);
  START(pA0,pA1);
  _Pragma("unroll") for(int r=0;r<16;++r)pA1[r]=__builtin_amdgcn_exp2f(pA1[r]);
  BIASLD(pB0,pB1,1);
  WAIT_BAR(0);
  DMA_K(3,0);DMA_V(1,SLOTB);
  ROT();
  kload8(kf,kp0+sl_cur);
  WAIT_BAR(2);
  s16x4 vlo[8],vhi[8]; u32x4 pw0,pw1,pw2,pw3;
  #define PKW(P,B) cvtpk_s(P[B],P[B+1])
  #define PAF(k) __builtin_bit_cast(bf16x8,pw##k)
  #define VFR(i) (bf16x8){vlo[i][0],vlo[i][1],vlo[i][2],vlo[i][3],vhi[i][0],vhi[i][1],vhi[i][2],vhi[i][3]}
  #define PIN(x) asm volatile("":"+v"(x))
  #define MX3(a,b,c) __builtin_fmaxf(__builtin_fmaxf((a),(b)),(c))
  #define GAPA(MF,A0,A1,A2,A3,W0,W1,PW) do{ MF; sacc+=A0; sacc+=A1; sacc+=A2; sacc+=A3; PIN(sacc); W0; W1; PIN(PW); SBAR(); }while(0)
  #define EX(v) __builtin_amdgcn_exp2f(v)
  #define GAPB(MF,X,B) do{ MF; X[B]=EX(X[B]); X[B+1]=EX(X[B+1]); X[B+2]=EX(X[B+2]); X[B+3]=EX(X[B+3]); PIN(X); SBAR(); }while(0)
  #define VRD(i) do{ vlo[i]=vtr(vp_+(((i)>>2)*4096+((i)&3)*1024)); vhi[i]=vtr(vp_+(((i)>>2)*4096+((i)&3)*1024+512)); }while(0)
  #define KRD(G,j) do{ if(G){ kload2(kf,kp0+sl_next,j); SBAR(); } }while(0)
  #define STEP(C0,C1,P0,P1,t,GK,GV,GL) do{ SBAR(); \
    BIASFIX(C0,C1); SBAR(); \
    const lds_cptr vp_=vp0+sl_prev; \
    VRD(0); SBAR(); float sacc=(P0[0]+P0[1]); \
    GAPA(C0=__builtin_amdgcn_mfma_f32_32x32x16_bf16(kf[0],qr[0],C0,0,0,0), P0[2],P0[3],P0[4],P0[5],     pw0[0]=PKW(P0,0), pw0[1]=PKW(P0,2), pw0); \
    VRD(4); SBAR(); GAPA(C1=__builtin_amdgcn_mfma_f32_32x32x16_bf16(kf[1],qr[0],C1,0,0,0), P0[6],P0[7],P0[8],P0[9],     pw0[2]=PKW(P0,4), pw0[3]=PKW(P0,6), pw0); \
    VRD(1); SBAR(); GAPA(C0=__builtin_amdgcn_mfma_f32_32x32x16_bf16(kf[2],qr[1],C0,0,0,0),   P0[10],P0[11],P0[12],P0[13], pw1[0]=PKW(P0,8), pw1[1]=PKW(P0,10), pw1); \
    VRD(5); SBAR(); GAPA(C1=__builtin_amdgcn_mfma_f32_32x32x16_bf16(kf[3],qr[1],C1,0,0,0),   P0[14],P0[15],P1[0],P1[1],   pw1[2]=PKW(P0,12),pw1[3]=PKW(P0,14), pw1); \
    VRD(2); SBAR(); GAPA(C0=__builtin_amdgcn_mfma_f32_32x32x16_bf16(kf[4],qr[2],C0,0,0,0),   P1[2],P1[3],P1[4],P1[5],     pw2[0]=PKW(P1,0), pw2[1]=PKW(P1,2), pw2); \
    VRD(6); SBAR(); GAPA(C1=__builtin_amdgcn_mfma_f32_32x32x16_bf16(kf[5],qr[2],C1,0,0,0),   P1[6],P1[7],P1[8],P1[9],     pw2[2]=PKW(P1,4), pw2[3]=PKW(P1,6), pw2); \
    VRD(3); SBAR(); GAPA(C0=__builtin_amdgcn_mfma_f32_32x32x16_bf16(kf[6],qr[3],C0,0,0,0),   P1[10],P1[11],P1[12],P1[13], pw3[0]=PKW(P1,8), pw3[1]=PKW(P1,10), pw3); \
    VRD(7); SBAR(); GAPA(C1=__builtin_amdgcn_mfma_f32_32x32x16_bf16(kf[7],qr[3],C1,0,0,0),   P1[14],P1[15],0.f,0.f,       pw3[2]=PKW(P1,12),pw3[3]=PKW(P1,14), pw3); \
    l_reg+=sacc; \
    if(GL){BIASLD(P0,P1,(t)+1);} \
    if(GK){DMA_K((t)+3,sl_cur);} if(GV){DMA_V((t)+1,sl_next);} \
    CMASK(C0,C1,t); \
    { float a=MX3(C0[0],C0[1],C1[0]),b=MX3(C0[2],C0[3],C1[1]); a=MX3(a,C1[2],C1[3]); \
      _Pragma("unroll") for(int r=4;r<16;r+=4){a=MX3(a,C0[r],C0[r+1]);b=MX3(b,C0[r+2],C0[r+3]);a=MX3(a,C1[r],C1[r+1]);b=MX3(b,C1[r+2],C1[r+3]);} \
      float rm=__builtin_fmaxf(a,b); { auto rr=__builtin_amdgcn_permlane32_swap(__float_as_uint(rm),__float_as_uint(rm),false,false); rm=__builtin_fmaxf(__uint_as_float(rr[0]),__uint_as_float(rr[1])); } \
      resc=false; \
      if(__builtin_expect(__any(rm>(float)THRL),0)){ const float dl=__builtin_fmaxf(rm,0.f); base-=dl; \
        _Pragma("unroll") for(int r=0;r<16;++r){C0[r]-=dl;C1[r]-=dl;} \
        const float f=__builtin_amdgcn_exp2f(-dl); l_reg*=f; if(hi==0)wsf[r32]=f; resc=true; } } \
    SBAR(); \
    GAPB(o[0]=__builtin_amdgcn_mfma_f32_32x32x16_bf16(PAF(0),VFR(0),o[0],0,0,0), C0,0); \
    GAPB(o[1]=__builtin_amdgcn_mfma_f32_32x32x16_bf16(PAF(0),VFR(4),o[1],0,0,0), C0,4); \
    KRD(GL,0); GAPB(o[0]=__builtin_amdgcn_mfma_f32_32x32x16_bf16(PAF(1),VFR(1),o[0],0,0,0), C0,8); \
    KRD(GL,1); GAPB(o[1]=__builtin_amdgcn_mfma_f32_32x32x16_bf16(PAF(1),VFR(5),o[1],0,0,0), C0,12); \
    KRD(GL,2); GAPB(o[0]=__builtin_amdgcn_mfma_f32_32x32x16_bf16(PAF(2),VFR(2),o[0],0,0,0), C1,0); \
    KRD(GL,3); GAPB(o[1]=__builtin_amdgcn_mfma_f32_32x32x16_bf16(PAF(2),VFR(6),o[1],0,0,0), C1,4); \
    GAPB(o[0]=__builtin_amdgcn_mfma_f32_32x32x16_bf16(PAF(3),VFR(3),o[0],0,0,0), C1,8); \
    GAPB(o[1]=__builtin_amdgcn_mfma_f32_32x32x16_bf16(PAF(3),VFR(7),o[1],0,0,0), C1,12); \
    }while(0)
  int t=1;
  #undef CMASK
  #define CMASK(P0,P1,t) do{}while(0)
  for(;t+5<NT;t+=2){
    STEP(pB0,pB1,pA0,pA1,t,true,true,true);     WAIT_BAR(2); RESC(); ROT();
    STEP(pA0,pA1,pB0,pB1,t+1,true,true,true);   WAIT_BAR(2); RESC(); ROT();
  }
  #undef CMASK
  #define CMASK(P0,P1,t) do{int jb_=(t)-(NT-4); if(jb_>=0)cmask(P0,P1,jb_,qrel,hi);}while(0)
  #define ENDW(tt) do{ if((tt)+3<NT){WAIT_BAR(2);} else if((tt)+2<NT){WAIT_BAR(1);} else {WAIT_BAR(0);} }while(0)
  for(;t+1<NT;t+=2){
    STEP(pB0,pB1,pA0,pA1,t,(t+3<NT),(t+1<NT),(t+1<NT));       ENDW(t);   RESC(); ROT();
    STEP(pA0,pA1,pB0,pB1,t+1,(t+4<NT),(t+2<NT),(t+2<NT));     ENDW(t+1); RESC(); ROT();
  }
  STEP(pB0,pB1,pA0,pA1,NT-1,false,false,false); RESC();
  { float sacc=pB0[0]+pB0[1]; _Pragma("unroll") for(int r=2;r<16;++r)sacc+=pB0[r]; _Pragma("unroll") for(int r=0;r<16;++r)sacc+=pB1[r]; l_reg+=sacc;
    pw0=(u32x4){PKW(pB0,0),PKW(pB0,2),PKW(pB0,4),PKW(pB0,6)};pw1=(u32x4){PKW(pB0,8),PKW(pB0,10),PKW(pB0,12),PKW(pB0,14)};pw2=(u32x4){PKW(pB1,0),PKW(pB1,2),PKW(pB1,4),PKW(pB1,6)};pw3=(u32x4){PKW(pB1,8),PKW(pB1,10),PKW(pB1,12),PKW(pB1,14)};
    SBAR(); pv(o,vb0+sl_cur,PAF(0),PAF(1),PAF(2),PAF(3)); }
  #undef PKW
  #undef PAF
  #undef VFR
  #undef PIN
  #undef MX3
  #undef GAPA
  #undef GAPB
  #undef EX
  #undef VRD
  #undef KRD
  #undef STEP
  #undef ENDW
  {auto rr=__builtin_amdgcn_permlane32_swap(__float_as_uint(l_reg),__float_as_uint(l_reg),false,false);l_reg=__uint_as_float(rr[0])+__uint_as_float(rr[1]);}
  if(hi==0)wsf[32+r32]=l_reg;asm volatile("s_waitcnt lgkmcnt(0)":::"memory");
  float rli[16];
  #pragma unroll
  for(int r=0;r<16;++r)rli[r]=__builtin_amdgcn_rcpf(wsf[32+crow(r,hi)]);
  bf16*Ow=O+(rowbase+q0+wid*QBLK)*OP+h*D; const bf16*Gw=Z+(rowbase+q0+wid*QBLK)*DM+1536+h*D;
  { bf16*stg=(bf16*)(shm+LDS_OST)+wid*2048;
    #pragma unroll
    for(int r=0;r<16;++r){const int orow=crow(r,hi);
      #pragma unroll
      for(int d0=0;d0<2;++d0)stg[orow*64+d0*32+r32]=(bf16)f2bf(o[d0][r]*rli[r]);}
    asm volatile("s_waitcnt lgkmcnt(0)":::"memory");
    #pragma unroll
    for(int i=0;i<4;++i){const int row=i*8+(lane>>3),ch=lane&7; const u32x4 v=*(const u32x4*)(stg+row*64+ch*8), g=*(const u32x4*)(Gw+(long)row*DM+ch*8);
      const unsigned vw[4]={v.x,v.y,v.z,v.w},gw[4]={g.x,g.y,g.z,g.w}; unsigned ow[4];
      #pragma unroll
      for(int j=0;j<4;++j){ const float a0=bflo(vw[j])*__builtin_amdgcn_rcpf(1.0f+__expf(-bflo(gw[j]))), a1=bfhi(vw[j])*__builtin_amdgcn_rcpf(1.0f+__expf(-bfhi(gw[j]))); ow[j]=cvtpk_s(a0,a1); }
      ATTN_STORE16(Ow+(long)row*OP+ch*8,((u32x4){ow[0],ow[1],ow[2],ow[3]}));} }
  asm volatile("s_waitcnt lgkmcnt(0)\n\ts_barrier":::"memory");
  #undef DMA_K
  #undef DMA_V
  #undef CMASK
  #undef START
  #undef RESC
  #undef ROT
}
constexpr int ATTN_LDS_BYTES=LDS_BYTES;
#undef SBAR
#undef WAIT_BAR
}
constexpr int CW_QATT = 128;
constexpr int MISC_TAB = 64, MISC_Q = 4096, MISC_PFX = 4160;

__device__ __forceinline__ int attn_t0(KPR P, const float* c2, int q0, int lane) {
    float gq = fabsf(P.q_norm[lane]), gk = fabsf(P.k_norm[lane]);
#pragma unroll
    for (int o = 1; o < 64; o <<= 1) { gq = fmaxf(gq, __shfl_xor(gq, o)); gk = fmaxf(gk, __shfl_xor(gk, o)); }
    const float thr = c2[q0] + (2.0f * 8.0f * LOG2E * gq * gk + 40.0f);
    const int nfull = q0 / 64; int t0 = 0;
    for (int tb = 0; tb < nfull; tb += 64) { const int tt = tb + lane; const bool sk = (tt < nfull) && (c2[tt * 64 + 63] > thr); const unsigned long long bm = __ballot(sk); t0 += __popcll(bm); if (bm != ~0ull) break; }
    return __builtin_amdgcn_readfirstlane(t0) & ~1;
}
__device__ __forceinline__ void combine_row(KPR P, const LAS int* tab, int row, int lane) {
    const int* route = (const int*)(P.ws + WS_ROUTE); const unsigned char* YP = P.ws + WS_YP; bf16_t* X = (bf16_t*)(P.ws + WS_X1);
    f32x4 v[4]; const u32x2* xr = (const u32x2*)(X + (size_t)row * DM) + lane;
#pragma unroll
    for (int j = 0; j < 4; ++j) { const u32x2 xv = xr[64 * j]; v[j] = (f32x4){bflo(xv.x), bfhi(xv.x), bflo(xv.y), bfhi(xv.y)}; }
#pragma unroll
    for (int k = 0; k < 4; ++k) { const int ex = route[(size_t)row * 12 + k], rank = route[(size_t)row * 12 + 4 + k]; const size_t pos = (size_t)tab[pg8::T_BLKSTART + ex] * 256 + rank;
        const unsigned* yr = (const unsigned*)(YP + pos * DM) + lane;
#pragma unroll
        for (int j = 0; j < 4; ++j) { const unsigned y = yr[64 * j]; const f32x2 lo = __builtin_amdgcn_cvt_pk_f32_fp8((int)y, false), hi = __builtin_amdgcn_cvt_pk_f32_fp8((int)y, true);
            v[j][0] += lo[0] * 0.0625f; v[j][1] += lo[1] * 0.0625f; v[j][2] += hi[0] * 0.0625f; v[j][3] += hi[1] * 0.0625f; } }
    u32x2* xo = (u32x2*)(X + (size_t)row * DM) + lane; float s = 0.f;
#pragma unroll
    for (int j = 0; j < 4; ++j) { u32x2 w; w.x = pk2(v[j][0], v[j][1]); w.y = pk2(v[j][2], v[j][3]); xo[64 * j] = w; v[j] = (f32x4){bflo(w.x), bfhi(w.x), bflo(w.y), bfhi(w.y)}; s += (v[j][0] * v[j][0] + v[j][1] * v[j][1]) + (v[j][2] * v[j][2] + v[j][3] * v[j][3]); }
    const float rstd = rsqrtf(wave_sum(s) * (1.f / DM) + 1e-6f);
#pragma unroll
    for (int j = 0; j < 4; ++j) v[j] = v[j] * rstd * ((const f32x4*)P.ple_norm)[64 * j + lane];
    store_row_fp8(P.ws + WS_XN + (size_t)row * DM, lane, v);
}

constexpr int NPHASE = 13;
__global__ void __launch_bounds__(NTHREADS, 2) mega_fwd(Params Pkarg_unused) {
    extern __shared__ __attribute__((aligned(16))) unsigned char smem[];
    LAS unsigned char* lds = (LAS unsigned char*)smem;
    const int tid = threadIdx.x, lane = tid & 63, wave = __builtin_amdgcn_readfirstlane(tid >> 6);
    const int G = gridDim.x, blk = blockIdx.x;
#define P (*kpp)
#ifndef MK_REP
#define MK_REP -1
#endif
#define PHASE_BEGIN(k) if (IN(k)) for (int rep_ = 0; rep_ < ((k) == MK_REP ? 2 : 1); ++rep_) { const __attribute__((address_space(4))) Params* kpp = kp_fresh();
#define PHASE_END(k) } if (BOTH(k)) xcd_barrier(bar);
#define IN(k) (ph_lo <= (k) && (k) < ph_hi)
#define BOTH(k) (IN(k) && IN((k) + 1))
    const __attribute__((address_space(4))) Params* kpp = kp_fresh();
    unsigned* ctl = (unsigned*)(P.ws + WS_CTL);
    volatile LAS unsigned* MISC = (volatile LAS unsigned*)(lds + MISC_OFF);
    LAS int* tab = (LAS int*)(lds + MISC_OFF + MISC_TAB);
    if (tid < 16) MISC[tid] = 0u;
    __syncthreads();
    XcdBarrier bar = xcd_barrier_post(ctl + CW_BAR, MISC);
    unsigned char* const wsb = P.ws;
    const int ph_lo = P.ph_lo, ph_hi = P.ph_hi;

    PHASE_BEGIN(0)
        phase_prep_weights(P, lds, blk * NWAVES + wave, G * NWAVES, wave, lane);
        phase_cvt_p(P, blk * NTHREADS + tid, G * NTHREADS);
        __syncthreads();
        LAS float* wff = (LAS float*)lds; LAS float* lf = (LAS float*)(lds + 32768);
        load_wff(P, wff, tid, NTHREADS); __syncthreads();
        for (int i = 0; i < 16; ++i) { const int rl = wave * 16 + i; norm1_row(P, blk * 128 + rl, lane, wff, lf + rl * 8); }
        __syncthreads();
        if (tid < 8) { float run = 0.f; float* cloc = (float*)(P.ws + WS_LOGF) + (size_t)blk * 128 * 8 + tid;
            for (int r = 0; r < 128; ++r) { run += lf[r * 8 + tid]; cloc[r * 8] = run; }
            ((float*)(P.ws + WS_CTOT))[blk * 8 + tid] = run; }
        if (blk == G - 1) rt::build_w(P, tid);
    PHASE_END(0)

    PHASE_BEGIN(1)
        {
            LAS float* pfx = (LAS float*)(lds + MISC_OFF + MISC_PFX);
            if (tid < 64) { const float* ct = (const float*)(wsb + WS_CTOT); const int j = (blk & ~63) + tid; float v8[8];
#pragma unroll
                for (int h = 0; h < 8; ++h) v8[h] = (j < blk) ? ct[j * 8 + h] : 0.f;
#pragma unroll
                for (int h = 0; h < 8; ++h) { const float s = wave_sum(v8[h]); if (tid == 0) pfx[h] = s; } }
            __syncthreads();
            const float* cloc = (const float*)(wsb + WS_LOGF) + (size_t)blk * 128 * 8; float* c2 = (float*)(P.ws + WS_C2);
            for (int i = tid; i < 1024; i += NTHREADS) { const int r = i >> 3, h = i & 7; const int row = blk * 128 + r, b = row >> 13, t = row & (SEQ - 1);
                c2[((size_t)(b * 8 + h)) * SEQ + t] = (cloc[i] + pfx[h]) * LOG2E; }
            __syncthreads();
        }
        {
            pg8::DenseOrder S{(const bf16_t*)(wsb + WS_XN), (const bf16_t*)(wsb + WS_WIN), 1024, NTOK / 256, ZW / 256, G, blk};
            pg8::EpiIn E{(bf16_t*)(P.ws + WS_Z), P.q_norm, P.k_norm};
            pg8::gemm_phase<pg8::EpiIn, pg8::DenseOrder, true>(lds, 1024, S, E);
        }
        {
            pg8::DenseOrder S{(const bf16_t*)((unsigned char*)P.out + DO_PB), (const bf16_t*)(wsb + WS_WPP), PLE, NTOK / 256, DM / 256, G / 2, blk >= G / 2 ? blk - G / 2 : (1 << 20)};
            pg8::EpiBf16 E{(bf16_t*)((unsigned char*)P.out + DO_PJ), DM};
            pg8::gemm_phase<pg8::EpiBf16, pg8::DenseOrder, true>(lds, PLE, S, E);
        }
    PHASE_END(1)

    PHASE_BEGIN(2)
        for (int task = wave * G + blk; task < NTOK / 32; task += NWAVES * G) rk::lora_task(P, task, lane);
    PHASE_END(2)

    PHASE_BEGIN(3)
        for (int task = blk; task < NB * NH * rk::NCHUNK; task += G) rk::pass1_chunk(P, lds, task >> 7, task & 127, tid);
    PHASE_END(3)

    PHASE_BEGIN(4)
        if (blk < NB * NH) rk::pass2_seq(P, lds, blk, tid);
        for (;;) {
            __syncthreads();
            if (tid == 0) MISC[MISC_Q / 4] = __hip_atomic_fetch_add(ctl + CW_QATT + 64 * rep_, 1u, RLX_AGENT);
            __syncthreads();
            const int q = (int)MISC[MISC_Q / 4];
            if (q >= 1024) break;
            { const int bh = q & 31, qb = 31 - (q >> 5); const float* c2 = (const float*)(wsb + WS_C2) + (size_t)bh * SEQ;
              const int t0 = attn_t0(P, c2, qb * 256, lane);
              attn_body::attn_unit<8>(bh >> 3, bh & 7, qb, t0, (const bf16_t*)(wsb + WS_Z), c2, (bf16_t*)(P.ws + WS_AO), (char*)smem); }
        }
    PHASE_END(4)

    PHASE_BEGIN(5)
        for (int task = blk; task < NB * NH * rk::NCHUNK; task += G) rk::pass3_chunk(P, lds, task >> 7, task & 127, tid);
    PHASE_END(5)

    PHASE_BEGIN(6)
        pg8::DenseOrder S{(const bf16_t*)(wsb + WS_AO), (const bf16_t*)(wsb + WS_WOUT), 1024, NTOK / 256, DM / 256, G, blk};
        pg8::EpiOut E{P.x, (bf16_t*)(P.ws + WS_X1)};
        pg8::gemm_phase<pg8::EpiOut, pg8::DenseOrder, true>(lds, 1024, S, E);
    PHASE_END(6)

    PHASE_BEGIN(7)
        rt::copy_w(P, lds, tid);
        if (blk == 0 && tid < 256) ((unsigned*)(P.ws + WS_XN + (size_t)NTOK * DM))[tid] = 0u;
        __syncthreads();
        for (int task = wave * G + blk; task < NTOK / 32; task += NWAVES * G) rt::route_task(P, lds, task, lane);
    PHASE_END(7)

    PHASE_BEGIN(8)
        const int nblk = pg8::moe_tables(tab, (const unsigned*)(wsb + WS_CTL) + CW_CNT);
        pg8::MoeOrder S{wsb + WS_XN, wsb + WS_WGU, (const int*)(wsb + WS_TOKSLOT), (const float*)(wsb + WS_GATESLOT), tab, nblk, 8, G, blk, true};
        pg8::EpiGu E{P.ws + WS_ACT, P.b_gu};
        pg8::gemm_phase<pg8::EpiGu, pg8::MoeOrder, true, true>(lds, 1024, S, E);
    PHASE_END(8)
    PHASE_BEGIN(9)
        const int nblk = pg8::moe_tables(tab, (const unsigned*)(wsb + WS_CTL) + CW_CNT);
        pg8::MoeOrder S{wsb + WS_ACT, wsb + WS_WDN, (const int*)(wsb + WS_TOKSLOT), (const float*)(wsb + WS_GATESLOT), tab, nblk, 4, G, blk, false};
        pg8::EpiDn E{P.ws + WS_YP, P.b_down, (const float*)(wsb + WS_GATESLOT), tab};
        pg8::gemm_phase<pg8::EpiDn, pg8::MoeOrder, true, true>(lds, 1024, S, E);
    PHASE_END(9)
    PHASE_BEGIN(10)
        (void)pg8::moe_tables(tab, (const unsigned*)(wsb + WS_CTL) + CW_CNT);
        for (int row = blk * NWAVES + wave; row < NTOK; row += G * NWAVES) combine_row(P, tab, row, lane);
    PHASE_END(10)
    PHASE_BEGIN(11)
        pg8::DenseOrder S{wsb + WS_XN, wsb + WS_WPG, 512, NTOK / 256, DM / 256, G, blk};
        pg8::EpiPg E{(bf16_t*)(P.ws + WS_X1), (const bf16_t*)((unsigned char*)P.out + DO_PJ)};
        pg8::gemm_phase<pg8::EpiPg, pg8::DenseOrder, true, true>(lds, 1024, S, E);
    PHASE_END(11)
    PHASE_BEGIN(12)
        const bool dead = __hip_atomic_load(ctl + CW_BAR + XB_TMO, RLX_AGENT) != 0u;
        for (int row = blk * NWAVES + wave; row < NTOK; row += G * NWAVES) final_row(P, row, lane, dead);
    PHASE_END(12)
}
#undef P
extern "C" void kernel_launch(void* const* d_in, const int* in_sizes, int n_in, void* d_out, int out_size, void* d_ws, size_t ws_size, hipStream_t stream) {
    static int ok = 0;
    if (ok == 0) {
        if (n_in != 30 || in_sizes[0] != NTOK * DM || out_size != NTOK * DM || ws_size < WS_END) { fprintf(stderr, "kernel_launch: unexpected shapes (n_in %d, ws %zu)\n", n_in, ws_size); ok = -1; return; }
        if (hipFuncSetAttribute((const void*)mega_fwd, hipFuncAttributeMaxDynamicSharedMemorySize, LDS_BYTES) != hipSuccess) { fprintf(stderr, "kernel_launch: hipFuncSetAttribute failed\n"); ok = -1; return; }
        int dev = 0, cus = 0, per_cu = 0;
        if (hipGetDevice(&dev) != hipSuccess || hipDeviceGetAttribute(&cus, hipDeviceAttributeMultiprocessorCount, dev) != hipSuccess) { ok = -1; return; }
        if (hipOccupancyMaxActiveBlocksPerMultiprocessor(&per_cu, (const void*)mega_fwd, NTHREADS, LDS_BYTES) != hipSuccess || per_cu < 1) { fprintf(stderr, "kernel_launch: occupancy query says %d\n", per_cu); }
        (void)hipGetLastError();
        if (cus != 256) { fprintf(stderr, "kernel_launch: built for 256 CUs, device has %d\n", cus); ok = -1; return; }
        ok = 1;
    }
    if (ok < 0) return;
    Params P{};
    const float** pp = (const float**)&P;
    for (int i = 0; i < 30; ++i) pp[i] = (const float*)d_in[i];
    P.out = (float*)d_out; P.ws = (unsigned char*)d_ws;
    if (hipMemsetAsync((char*)d_ws + WS_CTL, 0, CTL_BYTES, stream) != hipSuccess) return;
#ifndef MK_CUTS
#define MK_CUTS 0
#endif
    if (MK_CUTS == 0) { P.ph_lo = 0; P.ph_hi = NPHASE; hipLaunchKernelGGL(mega_fwd, dim3(256), dim3(NTHREADS), LDS_BYTES, stream, P); }
    else for (int k = 0; k < NPHASE; ++k) { P.ph_lo = k; P.ph_hi = k + 1;
        hipLaunchKernelGGL(mega_fwd, dim3(256), dim3(NTHREADS), LDS_BYTES, stream, P); }
}
```

```cpp
#include <hip/hip_runtime.h>
#include <cstdio>
#include <cstdint>

#define LAS __attribute__((address_space(3)))
#define GAS __attribute__((address_space(1)))
typedef unsigned short bf16_t;
typedef short bf16x8 __attribute__((ext_vector_type(8)));
typedef float f32x2 __attribute__((ext_vector_type(2)));
typedef float f32x4 __attribute__((ext_vector_type(4)));
typedef float f32x16 __attribute__((ext_vector_type(16)));
typedef unsigned u32x2 __attribute__((ext_vector_type(2)));
typedef unsigned u32x4 __attribute__((ext_vector_type(4)));

constexpr int NB = 4, SEQ = 8192, NTOK = NB * SEQ, DM = 1024;
constexpr int NH = 8, HD = 64;
constexpr int INW = 3848;
constexpr int ZW = 3840;
constexpr int ZQ = 0, ZK = 512, ZV = 1024, ZOG = 1536, ZR = 2048;
constexpr int RW_R = 0, RW_K = 512, RW_V = 1024, RW_W = 1536, RW_A = 1600, RW_G = 1664, RWIN = 1792;
constexpr int NE = 32, TOPK = 4, EFF = 1024;
constexpr int MAXBLK = (NTOK * TOPK) / 256 + NE;
constexpr int PLE = 256;
constexpr float LOG2E = 1.4426950408889634f;
constexpr float QSCALE = 0.125f * LOG2E;

constexpr size_t MiB = 1u << 20;
constexpr size_t WS_CTL = 0, CTL_BYTES = 1 * MiB;
constexpr size_t WS_C2 = 1 * MiB;
constexpr size_t WS_LOGF = 2 * MiB;
constexpr size_t WS_ROUTE = 3 * MiB;
constexpr size_t WS_TOKSLOT = 5 * MiB;
constexpr size_t WS_GATESLOT = 9 * MiB;
constexpr size_t WS_CTOT = 13 * MiB;
constexpr size_t WS_WIN = 16 * MiB;
constexpr size_t WS_WOUT = 24 * MiB;
constexpr size_t WS_WPG = 26 * MiB;
constexpr size_t WS_WPP = 28 * MiB;
constexpr size_t WS_WGU = 32 * MiB;
constexpr size_t WS_WDN = 160 * MiB;
constexpr size_t WS_XN = 224 * MiB;
constexpr size_t WS_X1 = 290 * MiB;
constexpr size_t WS_Z = 418 * MiB;
constexpr size_t WS_AO = 658 * MiB;
constexpr size_t WS_ACT = 418 * MiB;
constexpr size_t WS_RW = 722 * MiB;
constexpr size_t WS_RR = WS_RW, WS_RK = WS_RW + 32 * MiB, WS_RV = WS_RW + 64 * MiB, WS_RG = WS_RW + 96 * MiB;
constexpr size_t WS_RLW = WS_RW + 128 * MiB;
constexpr size_t WS_RKK = WS_RW + 160 * MiB, WS_RKA = WS_RW + 192 * MiB;
constexpr size_t WS_YP = 722 * MiB;
constexpr size_t WS_END = 994 * MiB;
static_assert(WS_ACT + (size_t)MAXBLK * 256 * 1024 * 2 <= WS_RW && WS_YP + (size_t)MAXBLK * 256 * 1024 * 2 <= WS_END, "ws map");
constexpr size_t DO_PJ = 0, DO_PB = 64 * MiB;
constexpr int CW_TMO = 0, CW_CNT = 64  , CW_BAR = 4096;

struct Params {
    const float *x, *p, *mix_norm, *w_in, *f_bias, *q_norm, *k_norm, *mu, *w0, *w2, *a0, *a2, *g2, *k_k, *k_a, *r_k, *ln_w, *ln_b, *w_out, *moe_norm, *w_router, *b_router, *w_gu, *b_gu, *w_down,
        *b_down, *ple_norm, *w_pg, *w_pp, *final_norm;
    float* out; unsigned char* ws; int ph_lo, ph_hi;
};

typedef const __attribute__((address_space(4))) Params& KPR;
__device__ __forceinline__ const __attribute__((address_space(4))) Params* kp_fresh() {
    unsigned long long p = (unsigned long long)__builtin_amdgcn_kernarg_segment_ptr(); asm volatile("" : "+s"(p)); return (const __attribute__((address_space(4))) Params*)p; }

typedef __bf16 bf16x2_hw __attribute__((ext_vector_type(2)));
__device__ __forceinline__ unsigned pk2(float lo, float hi) { const f32x2 v = {lo, hi}; return __builtin_bit_cast(unsigned, __builtin_convertvector(v, bf16x2_hw)); }
__device__ __forceinline__ unsigned f2bf(float f) { return pk2(f, f) & 0xffffu; }
__device__ __forceinline__ float bf2f(unsigned h) { return __builtin_bit_cast(float, h << 16); }
__device__ __forceinline__ float bflo(unsigned w) { return __builtin_bit_cast(float, w << 16); }
__device__ __forceinline__ float bfhi(unsigned w) { return __builtin_bit_cast(float, w & 0xffff0000u); }
__device__ __forceinline__ unsigned cvt_pk_bf16(float lo, float hi) { unsigned r; asm volatile("v_cvt_pk_bf16_f32 %0, %1, %2" : "=v"(r) : "v"(lo), "v"(hi)); return r; }
__device__ __forceinline__ unsigned pk4_fp8(float a, float b, float c, float d) { int w = 0; w = __builtin_amdgcn_cvt_pk_fp8_f32(a, b, w, false); w = __builtin_amdgcn_cvt_pk_fp8_f32(c, d, w, true); return (unsigned)w; }
#define DPP_ADD(v, ctrl) ((v) + __builtin_bit_cast(float, __builtin_amdgcn_mov_dpp(__builtin_bit_cast(int, (v)), (ctrl), 0xF, 0xF, true)))
__device__ __forceinline__ float wave_sum(float v) {
    v = DPP_ADD(v, 0xB1);
    v = DPP_ADD(v, 0x4E);
    v = DPP_ADD(v, 0x124);
    v = DPP_ADD(v, 0x128);
    { float a = v, b = v; asm volatile("s_nop 1\n\tv_permlane16_swap_b32 %0, %1" : "+v"(a), "+v"(b)); v = a + b; }
    { float a = v, b = v; asm volatile("s_nop 1\n\tv_permlane32_swap_b32 %0, %1" : "+v"(a), "+v"(b)); v = a + b; }
    return v;
}
__device__ __forceinline__ float sigmoidf_(float x) { return __builtin_amdgcn_rcpf(1.0f + __expf(-x)); }
__device__ __forceinline__ float logsigmoidf_(float x) { return fminf(x, 0.f) - log1pf(expf(-fabsf(x))); }
namespace pg8 {
constexpr int BM = 256, BK = 64, HALF = 128, HTB = HALF * BK * 2, STAGE_BYTES = 8 * HTB, NXCD = 8, WGM = 8;
__host__ __device__ __forceinline__ int lds_byte(int r, int c) { const int st = (r >> 4) * 2 + (c >> 5), rr = r & 15, cc = c & 31, ob = rr * 64 + cc * 2; return st * 1024 + (ob ^ (((ob >> 9) & 1) << 5)); }
__host__ __device__ __forceinline__ void stage_rc(int b, int& R, int& C) { const int st = b / 1024, sb = b % 1024, swz = sb ^ (((sb >> 9) & 1) << 5); R = (st >> 1) * 16 + swz / 64; C = (st & 1) * 32 + (swz % 64) / 2; }
__host__ __device__ __forceinline__ int perm32(int rho) { const int n = rho >> 4, i = rho & 15; return 8 * (i >> 2) + 4 * n + (i & 3); }

struct Unit { int pm, pn, e, lb, sl; };

__device__ __forceinline__ bool tile_order(int i, int G, int c, int nM, int nN, int& pm, int& pn) {
    const int nwg = nM * nN; const long L = (long)i * G + c; if (L >= nwg) return false;
    int wgid = (int)L; { const int q = nwg / NXCD, r = nwg % NXCD, xcd = wgid % NXCD, off = wgid / NXCD; wgid = (xcd < r ? xcd * (q + 1) : r * (q + 1) + (xcd - r) * q) + off; }
    const int nig = WGM * nN, gid = wgid / nig, fm = gid * WGM, gsz = (nM - fm) < WGM ? (nM - fm) : WGM;
    pm = fm + ((wgid % nig) % gsz); pn = (wgid % nig) / gsz; return true;
}
struct DenseOrder {
    const void* A; const void* Bt; int K  , nM, nN, G, c;
    __device__ __forceinline__ bool next(int i, Unit& u) const { u.e = 0; u.lb = 0; return tile_order(i, G, c, nM, nN, u.pm, u.pn); }
    __device__ __forceinline__ const char* a_base(const Unit& u) const { return (const char*)A + (size_t)u.pm * BM * K * 2; }
    __device__ __forceinline__ const char* b_base(const Unit& u) const { return (const char*)Bt + (size_t)u.pn * BM * K * 2; }
    __device__ __forceinline__ void prefetch(const Unit&, int, int, int) const {}
    __device__ __forceinline__ void a_off(const Unit&, const int (&R)[2], const int (&C)[2], unsigned (&off)[2][2]) const {
#pragma unroll
        for (int h = 0; h < 2; ++h)
#pragma unroll
            for (int i = 0; i < 2; ++i) off[h][i] = (unsigned)((R[i] + HALF * h) * K + C[i]) * 2u;
    }
};

typedef int v8i32 __attribute__((ext_vector_type(8)));
typedef int i32x4 __attribute__((ext_vector_type(4)));
template <class Epi, class Sched, bool ALIGN_EPI, bool FP8 = false>
__device__ __forceinline__ void gemm_phase(LAS unsigned char* lds, const int K, const Sched& S, const Epi& E) {
    int tid_ = threadIdx.x; asm volatile("" : "+v"(tid_));
    const int tid = tid_, wid = __builtin_amdgcn_readfirstlane(tid >> 6), lane = tid & 63, wr = wid >> 2, wc = wid & 3, fr = lane & 15, fq = lane >> 4;
    const int RB = FP8 ? K : 2 * K;
    const int nt = RB / (BK * 2);
    int sR[2], sC[2]; unsigned voffB[2];
#pragma unroll
    for (int i = 0; i < 2; ++i) { int R, C; stage_rc(tid * 16 + i * 8192, R, C); const int Rb = Epi::PERM ? ((R & ~31) + perm32(R & 31)) : R; sR[i] = R; sC[i] = C; voffB[i] = (unsigned)(Rb * RB + C * 2); }
    const size_t kstep = (size_t)(BK * 2);
    const size_t hstep = (size_t)HALF * RB;
    const unsigned ldsw = (unsigned)wid * 1024u;
    const int aoff0 = FP8 ? lds_byte(wr * 64 + fr, fq * 16) : lds_byte(wr * 64 + fr, fq * 8), aoff1 = FP8 ? lds_byte(wr * 64 + fr, fq * 16 + 8) : aoff0 + 1024;
    const int boff0 = FP8 ? lds_byte(wc * 32 + fr, fq * 16) : lds_byte(wc * 32 + fr, fq * 8), boff1 = FP8 ? lds_byte(wc * 32 + fr, fq * 16 + 8) : boff0 + 1024;
#define PG8_SA(b, h) (((b) * 2 + (h)) * HTB)
#define PG8_SB(b, h) ((4 + (b) * 2 + (h)) * HTB)
#define PG8_STAGE(bufoff, gbase, voff) do { _Pragma("unroll") for (int _i = 0; _i < 2; ++_i) \
        __builtin_amdgcn_global_load_lds((const unsigned*)((const char*)(gbase) + (voff)[_i]), (LAS unsigned*)(lds + (bufoff) + ldsw + _i * 8192), 16, 0, 0); } while (0)
#define PG8_CAT(p0, p1) __builtin_shufflevector((p0), (p1), 0, 1, 2, 3, 4, 5, 6, 7)
#define PG8_LDA(dst, b, h) do { _Pragma("unroll") for (int m = 0; m < 4; ++m) dst[m] = PG8_CAT(*(const LAS i32x4*)(lds + PG8_SA(b, h) + aoff0 + m * 2048), *(const LAS i32x4*)(lds + PG8_SA(b, h) + aoff1 + m * 2048)); } while (0)
#define PG8_LDB(dst, b, h) do { _Pragma("unroll") for (int n = 0; n < 2; ++n) dst[n] = PG8_CAT(*(const LAS i32x4*)(lds + PG8_SB(b, h) + boff0 + n * 2048), *(const LAS i32x4*)(lds + PG8_SB(b, h) + boff1 + n * 2048)); } while (0)
#define PG8_LO(x) __builtin_bit_cast(bf16x8, __builtin_shufflevector((x), (x), 0, 1, 2, 3))
#define PG8_HI(x) __builtin_bit_cast(bf16x8, __builtin_shufflevector((x), (x), 4, 5, 6, 7))
#define PG8_MMA(ai, bj, At, Bt) do { __builtin_amdgcn_s_setprio(1); \
        if constexpr (FP8) { _Pragma("unroll") for (int m = 0; m < 4; ++m) _Pragma("unroll") for (int n = 0; n < 2; ++n) \
            asm volatile("v_mfma_scale_f32_16x16x128_f8f6f4 %0, %1, %2, %0, %3, %4 op_sel_hi:[0,0,0]" : "+v"(acc[ai][bj][m][n]) : "v"(Bt[n]), "v"(At[m]), "v"(sc_w), "v"(sc_x)); } \
        else { _Pragma("unroll") for (int m = 0; m < 4; ++m) _Pragma("unroll") for (int n = 0; n < 2; ++n) { \
            acc[ai][bj][m][n] = __builtin_amdgcn_mfma_f32_16x16x32_bf16(PG8_LO(Bt[n]), PG8_LO(At[m]), acc[ai][bj][m][n], 0, 0, 0); } \
            _Pragma("unroll") for (int m = 0; m < 4; ++m) _Pragma("unroll") for (int n = 0; n < 2; ++n) { \
            acc[ai][bj][m][n] = __builtin_amdgcn_mfma_f32_16x16x32_bf16(PG8_HI(Bt[n]), PG8_HI(At[m]), acc[ai][bj][m][n], 0, 0, 0); } } \
        __builtin_amdgcn_s_setprio(0); } while (0)
#define PG8_WAIT_V(n) asm volatile("s_waitcnt vmcnt(" #n ")" ::: "memory")
#define PG8_WAIT_L(n) asm volatile("s_waitcnt lgkmcnt(" #n ")" ::: "memory")
#define PG8_BAR __builtin_amdgcn_s_barrier()
#define PG8_SCHED __builtin_amdgcn_sched_barrier(0)
    Unit cur, nxt; int ui = 0;
    if (!S.next(0, cur)) return;
    f32x4 acc[2][2][4][2];
#pragma unroll
    for (int a = 0; a < 2; ++a)
#pragma unroll
        for (int b = 0; b < 2; ++b)
#pragma unroll
            for (int m = 0; m < 4; ++m)
#pragma unroll
                for (int n = 0; n < 2; ++n) acc[a][b][m][n] = (f32x4){0.f, 0.f, 0.f, 0.f};
    const int sc_w = 121, sc_x = 127;
    v8i32 At[4], B0[2], B1[2];
    unsigned offC[2][2], offN[2][2];
    cur.sl = 0; S.prefetch(cur, 0, wid, lane); PG8_WAIT_V(0); PG8_BAR;
    S.a_off(cur, sR, sC, offC);
    const char* cA = S.a_base(cur); const char* cB = S.b_base(cur);
    PG8_STAGE(PG8_SB(0, 0), cB, voffB); PG8_STAGE(PG8_SB(0, 1), cB + hstep, voffB); PG8_STAGE(PG8_SA(0, 0), cA, offC[0]); PG8_STAGE(PG8_SA(0, 1), cA, offC[1]);
    if (wr == 1) PG8_BAR;
    PG8_WAIT_V(2); PG8_BAR;
    PG8_STAGE(PG8_SB(1, 0), cB + kstep, voffB); PG8_STAGE(PG8_SA(1, 0), cA + kstep, offC[0]); PG8_STAGE(PG8_SB(1, 1), cB + hstep + kstep, voffB);
    PG8_WAIT_V(6); PG8_BAR;
    for (;;) {
        const bool has_next = S.next(ui + 1, nxt);
        const char* nA = cA; const char* nB = cB;
        nxt.sl = cur.sl == 2 ? 0 : cur.sl + 1;
        if (has_next) { nA = S.a_base(nxt); nB = S.b_base(nxt); S.prefetch(nxt, nxt.sl, wid, lane); }
#pragma unroll
        for (int h = 0; h < 2; ++h)
#pragma unroll
            for (int i = 0; i < 2; ++i) offN[h][i] = offC[h][i];
#pragma nounroll
        for (int t = 0; t < nt; t += 2) {
            const bool last = (t == nt - 2);
            if (last && has_next) S.a_off(nxt, sR, sC, offN);
            const char* a1 = cA + (size_t)(t + 1) * kstep;
            const char* a2 = last ? nA : cA + (size_t)(t + 2) * kstep; const char* b2 = last ? nB : cB + (size_t)(t + 2) * kstep;
            const char* a3 = a2 + kstep; const char* b3 = b2 + kstep;
            unsigned o2[2][2];
#pragma unroll
            for (int h = 0; h < 2; ++h)
#pragma unroll
                for (int i = 0; i < 2; ++i) o2[h][i] = last ? offN[h][i] : offC[h][i];
            PG8_LDB(B0, 0, 0); PG8_LDB(B1, 0, 1); PG8_SCHED; PG8_LDA(At, 0, 0); PG8_STAGE(PG8_SA(1, 1), a1, offC[1]);
            PG8_WAIT_V(8); PG8_WAIT_L(0); PG8_BAR; PG8_MMA(0, 0, At, B0); PG8_MMA(0, 1, At, B1); PG8_BAR; PG8_SCHED;
            PG8_LDA(At, 0, 1); PG8_STAGE(PG8_SB(0, 0), b2, voffB); PG8_STAGE(PG8_SB(0, 1), b2 + hstep, voffB); PG8_STAGE(PG8_SA(0, 0), a2, o2[0]);
            PG8_WAIT_V(8); PG8_WAIT_L(0); PG8_BAR; PG8_MMA(1, 0, At, B0); PG8_MMA(1, 1, At, B1); PG8_BAR; PG8_SCHED;
            PG8_LDB(B0, 1, 0); PG8_LDB(B1, 1, 1); PG8_SCHED; PG8_LDA(At, 1, 0); PG8_STAGE(PG8_SA(0, 1), a2, o2[1]);
            PG8_WAIT_V(8); PG8_WAIT_L(0); PG8_BAR; PG8_MMA(0, 0, At, B0); PG8_MMA(0, 1, At, B1); PG8_BAR; PG8_SCHED;
            PG8_LDA(At, 1, 1); PG8_STAGE(PG8_SB(1, 0), b3, voffB); PG8_STAGE(PG8_SB(1, 1), b3 + hstep, voffB); PG8_STAGE(PG8_SA(1, 0), a3, o2[0]);
            PG8_WAIT_V(8); PG8_WAIT_L(0); PG8_BAR; PG8_MMA(1, 0, At, B0); PG8_MMA(1, 1, At, B1); PG8_BAR; PG8_SCHED;
        }
        if constexpr (ALIGN_EPI) { if (wr == 0) PG8_BAR; }
        E(acc, cur, wr, wc, fr, fq);
        if (!has_next) break;
#pragma unroll
        for (int a = 0; a < 2; ++a)
#pragma unroll
            for (int b = 0; b < 2; ++b)
#pragma unroll
                for (int m = 0; m < 4; ++m)
#pragma unroll
                    for (int n = 0; n < 2; ++n) acc[a][b][m][n] = (f32x4){0.f, 0.f, 0.f, 0.f};
        cur = nxt; cA = nA; cB = nB; ++ui;
#pragma unroll
        for (int h = 0; h < 2; ++h)
#pragma unroll
            for (int i = 0; i < 2; ++i) offC[h][i] = offN[h][i];
        if constexpr (ALIGN_EPI) { if (wr == 1) PG8_BAR; }
    }
    PG8_WAIT_V(0);
    if constexpr (!ALIGN_EPI) { if (wr == 0) PG8_BAR; }
    PG8_BAR;
#undef PG8_SA
#undef PG8_SB
#undef PG8_STAGE
#undef PG8_LDA
#undef PG8_LDB
#undef PG8_MMA
#undef PG8_LO
#undef PG8_HI
#undef PG8_CAT
#undef PG8_WAIT_V
#undef PG8_WAIT_L
#undef PG8_BAR
#undef PG8_SCHED
}
}
namespace pg8 {
constexpr int T_BLKSTART = 0  , T_CNT = 40  , T_BLKE = 80  , T_WORDS = 80 + 560;
constexpr int TB_OFF = 8192 - 64;

struct EpiIn {
    static constexpr bool PERM = true;
    bf16_t* Z; const float* qn; const float* kn;
    __device__ __forceinline__ void operator()(const f32x4 (&acc)[2][2][4][2], const Unit& u, int wr, int wc, int fr, int fq) const {
        const int row0 = u.pm * BM + wr * 64 + fr;
        if (u.pn < 4) {
            const float* g = (u.pn < 2) ? qn : kn; const float sc = (u.pn < 2) ? QSCALE : 1.0f;
            f32x4 gv[2][2];
#pragma unroll
            for (int bj = 0; bj < 2; ++bj)
#pragma unroll
                for (int n = 0; n < 2; ++n) gv[bj][n] = *(const f32x4*)(g + 32 * bj + 8 * fq + 4 * n) * sc;
#pragma unroll
            for (int ai = 0; ai < 2; ++ai)
#pragma unroll
                for (int m = 0; m < 4; ++m) {
                    float ss = 0.f;
#pragma unroll
                    for (int bj = 0; bj < 2; ++bj)
#pragma unroll
                        for (int n = 0; n < 2; ++n) { const f32x4 x = acc[ai][bj][m][n]; ss += (x[0] * x[0] + x[1] * x[1]) + (x[2] * x[2] + x[3] * x[3]); }
                    ss += __shfl_xor(ss, 16); ss += __shfl_xor(ss, 32);
                    const float rstd = rsqrtf(ss * (1.0f / 64.0f) + 1e-6f);
                    bf16_t* rowp = Z + (size_t)(row0 + ai * HALF + m * 16) * ZW + u.pn * BM + 64 * wc + 8 * fq;
#pragma unroll
                    for (int bj = 0; bj < 2; ++bj) { const f32x4 v0 = acc[ai][bj][m][0] * rstd * gv[bj][0], v1 = acc[ai][bj][m][1] * rstd * gv[bj][1];
                        u32x4 w; w.x = cvt_pk_bf16(v0[0], v0[1]); w.y = cvt_pk_bf16(v0[2], v0[3]); w.z = cvt_pk_bf16(v1[0], v1[1]); w.w = cvt_pk_bf16(v1[2], v1[3]);
                        *(u32x4*)(rowp + 32 * bj) = w; }
                }
        } else {
            const int col0 = u.pn * BM + wc * 32 + 8 * fq;
#pragma unroll
            for (int ai = 0; ai < 2; ++ai)
#pragma unroll
                for (int m = 0; m < 4; ++m) { bf16_t* rowp = Z + (size_t)(row0 + ai * HALF + m * 16) * ZW + col0;
#pragma unroll
                    for (int bj = 0; bj < 2; ++bj) { const f32x4 v0 = acc[ai][bj][m][0], v1 = acc[ai][bj][m][1];
                        u32x4 w; w.x = cvt_pk_bf16(v0[0], v0[1]); w.y = cvt_pk_bf16(v0[2], v0[3]); w.z = cvt_pk_bf16(v1[0], v1[1]); w.w = cvt_pk_bf16(v1[2], v1[3]);
                        *(u32x4*)(rowp + bj * HALF) = w; } }
        }
    }
};
struct EpiBf16 {
    static constexpr bool PERM = true;
    bf16_t* O; int ldc;
    __device__ __forceinline__ void operator()(const f32x4 (&acc)[2][2][4][2], const Unit& u, int wr, int wc, int fr, int fq) const {
        const int row0 = u.pm * BM + wr * 64 + fr, col0 = u.pn * BM + wc * 32 + 8 * fq;
#pragma unroll
        for (int ai = 0; ai < 2; ++ai)
#pragma unroll
            for (int m = 0; m < 4; ++m) { bf16_t* rowp = O + (size_t)(row0 + ai * HALF + m * 16) * ldc + col0;
#pragma unroll
                for (int bj = 0; bj < 2; ++bj) { const f32x4 v0 = acc[ai][bj][m][0], v1 = acc[ai][bj][m][1];
                    u32x4 w; w.x = cvt_pk_bf16(v0[0], v0[1]); w.y = cvt_pk_bf16(v0[2], v0[3]); w.z = cvt_pk_bf16(v1[0], v1[1]); w.w = cvt_pk_bf16(v1[2], v1[3]);
                    *(u32x4*)(rowp + bj * HALF) = w; } }
    }
};
struct EpiOut {
    static constexpr bool PERM = true;
    const float* X; bf16_t* O;
    __device__ __forceinline__ void operator()(const f32x4 (&acc)[2][2][4][2], const Unit& u, int wr, int wc, int fr, int fq) const {
        const int row0 = u.pm * BM + wr * 64 + fr, col0 = u.pn * BM + wc * 32 + 8 * fq;
#pragma unroll
        for (int ai = 0; ai < 2; ++ai)
#pragma unroll
            for (int m = 0; m < 4; ++m) { const size_t off = (size_t)(row0 + ai * HALF + m * 16) * DM + col0;
#pragma unroll
                for (int bj = 0; bj < 2; ++bj) { const f32x4 v0 = *(const f32x4*)(X + off + bj * HALF) + acc[ai][bj][m][0], v1 = *(const f32x4*)(X + off + bj * HALF + 4) + acc[ai][bj][m][1];
                    u32x4 w; w.x = pk2(v0[0], v0[1]); w.y = pk2(v0[2], v0[3]); w.z = pk2(v1[0], v1[1]); w.w = pk2(v1[2], v1[3]);
                    *(u32x4*)(O + off + bj * HALF) = w; }
                if (m & 1) asm volatile("" ::: "memory"); }
    }
};
struct EpiPg {
    static constexpr bool PERM = true;
    bf16_t* X; const bf16_t* PJ;
    __device__ __forceinline__ void operator()(const f32x4 (&acc)[2][2][4][2], const Unit& u, int wr, int wc, int fr, int fq) const {
        const int row0 = u.pm * BM + wr * 64 + fr, col0 = u.pn * BM + wc * 32 + 8 * fq;
#pragma unroll
        for (int ai = 0; ai < 2; ++ai)
#pragma unroll
            for (int m = 0; m < 4; ++m) { const size_t off = (size_t)(row0 + ai * HALF + m * 16) * DM + col0;
#pragma unroll
                for (int bj = 0; bj < 2; ++bj) { const size_t o = off + bj * HALF; const u32x4 pj = *(const u32x4*)(PJ + o), xv = *(const u32x4*)(X + o);
                    const unsigned pw[4] = {pj.x, pj.y, pj.z, pj.w}, xw[4] = {xv.x, xv.y, xv.z, xv.w}; unsigned ow[4];
#pragma unroll
                    for (int q = 0; q < 4; ++q) { const float a0 = acc[ai][bj][m][q >> 1][2 * (q & 1)], a1 = acc[ai][bj][m][q >> 1][2 * (q & 1) + 1];
                        ow[q] = pk2(bflo(xw[q]) + sigmoidf_(a0) * bflo(pw[q]), bfhi(xw[q]) + sigmoidf_(a1) * bfhi(pw[q])); }
                    *(u32x4*)(X + o) = (u32x4){ow[0], ow[1], ow[2], ow[3]}; }
                if (m & 1) asm volatile("" ::: "memory"); }
    }
};
struct EpiGu {
    static constexpr bool PERM = true;
    unsigned char* ACT; const float* b_gu;
    __device__ __forceinline__ void operator()(const f32x4 (&acc)[2][2][4][2], const Unit& u, int wr, int wc, int fr, int fq) const {
        const int row0 = u.pm * BM + wr * 64 + fr, cl = u.pn * HALF + wc * 32 + 8 * fq;
        const float* bg = b_gu + (size_t)u.e * 2048 + cl;
        f32x4 bgl[2], bli[2];
#pragma unroll
        for (int n = 0; n < 2; ++n) { bgl[n] = *(const f32x4*)(bg + 4 * n); bli[n] = *(const f32x4*)(bg + 1024 + 4 * n); }
#pragma unroll
        for (int ai = 0; ai < 2; ++ai)
#pragma unroll
            for (int m = 0; m < 4; ++m) { unsigned char* rowp = ACT + (size_t)(row0 + ai * HALF + m * 16) * EFF + cl; float r[8];
#pragma unroll
                for (int n = 0; n < 2; ++n)
#pragma unroll
                    for (int i = 0; i < 4; ++i) { const float gl = fminf(acc[ai][0][m][n][i] + bgl[n][i], 7.0f); const float li = fminf(fmaxf(acc[ai][1][m][n][i] + bli[n][i], -7.0f), 7.0f);
                        r[4 * n + i] = gl * sigmoidf_(1.702f * gl) * (li + 1.0f); }
                u32x2 w; w.x = pk4_fp8(r[0], r[1], r[2], r[3]); w.y = pk4_fp8(r[4], r[5], r[6], r[7]);
                *(u32x2*)rowp = w; }
    }
};
struct EpiDn {
    static constexpr bool PERM = true;
    unsigned char* YP; const float* b_dn; const float* gateslot; const LAS int* tab;
    __device__ __forceinline__ void operator()(const f32x4 (&acc)[2][2][4][2], const Unit& u, int wr, int wc, int fr, int fq) const {
        const int row0 = u.pm * BM + wr * 64 + fr, col0 = u.pn * BM + wc * 32 + 8 * fq;
        const float* bd = b_dn + (size_t)u.e * 1024 + col0; const int cnt = tab[T_CNT + u.e];
        f32x4 bv[2][2];
#pragma unroll
        for (int bj = 0; bj < 2; ++bj)
#pragma unroll
            for (int n = 0; n < 2; ++n) bv[bj][n] = *(const f32x4*)(bd + bj * HALF + 4 * n);
#pragma unroll
        for (int ai = 0; ai < 2; ++ai)
#pragma unroll
            for (int m = 0; m < 4; ++m) { const int rr = wr * 64 + fr + ai * HALF + m * 16, slot = u.lb * 256 + rr;
                const float gt = slot < cnt ? ((const LAS float*)((const LAS unsigned char*)tab + TB_OFF + u.sl * 1024))[rr] * 16.0f : 0.f;
                unsigned char* rowp = YP + (size_t)(row0 + ai * HALF + m * 16) * DM + col0;
#pragma unroll
                for (int bj = 0; bj < 2; ++bj) { const f32x4 v0 = (acc[ai][bj][m][0] + bv[bj][0]) * gt, v1 = (acc[ai][bj][m][1] + bv[bj][1]) * gt;
                    u32x2 w; w.x = pk4_fp8(v0[0], v0[1], v0[2], v0[3]); w.y = pk4_fp8(v1[0], v1[1], v1[2], v1[3]);
                    *(u32x2*)(rowp + bj * HALF) = w; } }
    }
};
struct MoeOrder {
    const unsigned char* A; const unsigned char* Bt; const int* tokslot; const float* gateslot;   const LAS int* tab; int nblk, nN, G, c; bool gather;
    __device__ __forceinline__ bool next(int i, Unit& u) const { if (!tile_order(i, G, c, nblk, nN, u.pm, u.pn)) return false; u.e = tab[T_BLKE + u.pm]; u.lb = u.pm - tab[T_BLKSTART + u.e]; return true; }
    __device__ __forceinline__ const char* a_base(const Unit& u) const { return gather ? (const char*)A : (const char*)A + (size_t)u.pm * BM * 1024; }
    __device__ __forceinline__ const char* b_base(const Unit& u) const { return (const char*)Bt + ((size_t)u.e * nN + u.pn) * BM * 1024; }
    __device__ __forceinline__ void prefetch(const Unit& u, int slot, int wid, int lane) const {
        if (wid < 4) { const unsigned* src = (gather ? (const unsigned*)tokslot : (const unsigned*)gateslot) + (size_t)u.e * NTOK + u.lb * 256 + wid * 64 + lane;
            __builtin_amdgcn_global_load_lds(src, (LAS unsigned*)((LAS unsigned char*)tab + TB_OFF + slot * 1024 + wid * 256), 4, 0, 0); }
    }
    __device__ __forceinline__ void a_off(const Unit& u, const int (&R)[2], const int (&C)[2], unsigned (&off)[2][2]) const {
        const int cnt = tab[T_CNT + u.e]; const LAS int* tb = (const LAS int*)((const LAS unsigned char*)tab + TB_OFF + u.sl * 1024);
#pragma unroll
        for (int h = 0; h < 2; ++h)
#pragma unroll
            for (int i = 0; i < 2; ++i) {
                if (gather) { const int rr = R[i] + HALF * h; const int tk = tb[rr]; const int tok = (u.lb * 256 + rr) < cnt ? tk : NTOK; off[h][i] = (unsigned)tok * 1024u + (unsigned)C[i] * 2u; }
                else off[h][i] = (unsigned)((R[i] + HALF * h) * 1024 + C[i] * 2);
            }
    }
};
__device__ __forceinline__ int moe_tables(LAS int* tab, const unsigned* cntw) {
    if (threadIdx.x == 0) { int s = 0; for (int e = 0; e < NE; ++e) { const int c = (int)cntw[e]; tab[T_CNT + e] = c; tab[T_BLKSTART + e] = s; const int nb = (c + 255) >> 8; for (int j = 0; j < nb; ++j) tab[T_BLKE + s + j] = e; s += nb; } tab[T_BLKSTART + NE] = s; }
    __syncthreads();
    return tab[T_BLKSTART + NE];
}
}
constexpr int NWAVES = 8, NTHREADS = 512;
constexpr int RING_BYTES = 131072, MISC_OFF = RING_BYTES, LDS_BYTES = 147456;

__device__ __forceinline__ void tr_item(const float* W, int ldw, int srccol0, int k0, bf16_t* WT, int Kd, int dstrow0, LAS float* scr, int lane) {
#pragma unroll 8
    for (int i = 0; i < 32; ++i) { const int kk = 2 * i + (lane >> 5); scr[kk * 33 + (lane & 31)] = W[(size_t)(k0 + kk) * ldw + srccol0 + (lane & 31)]; }
    asm volatile("s_waitcnt lgkmcnt(0)" ::: "memory");
    const int c = lane & 7;
#pragma unroll
    for (int j = 0; j < 4; ++j) { const int n = (lane >> 3) + 8 * j; const LAS float* s = scr + (8 * c) * 33 + n;
        u32x4 o; o.x = pk2(s[0 * 33], s[1 * 33]); o.y = pk2(s[2 * 33], s[3 * 33]); o.z = pk2(s[4 * 33], s[5 * 33]); o.w = pk2(s[6 * 33], s[7 * 33]);
        *(u32x4*)(WT + (size_t)(dstrow0 + n) * Kd + k0 + 8 * c) = o; }
    asm volatile("s_waitcnt lgkmcnt(0)" ::: "memory");
}
__device__ __forceinline__ void tr_item8(const float* W, int ldw, int srccol0, int k0, unsigned char* WT, int Kd, int dstrow0, LAS float* scr, int lane) {
#pragma unroll 8
    for (int i = 0; i < 32; ++i) { const int kk = 2 * i + (lane >> 5); scr[kk * 33 + (lane & 31)] = W[(size_t)(k0 + kk) * ldw + srccol0 + (lane & 31)]; }
    asm volatile("s_waitcnt lgkmcnt(0)" ::: "memory");
    const int c = lane & 7;
#pragma unroll
    for (int j = 0; j < 4; ++j) { const int n = (lane >> 3) + 8 * j; const LAS float* s = scr + (8 * c) * 33 + n;
        u32x2 o; o.x = pk4_fp8(s[0 * 33] * 64.f, s[1 * 33] * 64.f, s[2 * 33] * 64.f, s[3 * 33] * 64.f); o.y = pk4_fp8(s[4 * 33] * 64.f, s[5 * 33] * 64.f, s[6 * 33] * 64.f, s[7 * 33] * 64.f);
        *(u32x2*)(WT + (size_t)(dstrow0 + n) * Kd + k0 + 8 * c) = o; }
    asm volatile("s_waitcnt lgkmcnt(0)" ::: "memory");
}
constexpr int I_IN = 16 * 120, I_OUT = 16 * 32, I_PG = 16 * 32, I_PP = 4 * 32, I_GU1 = 16 * 64, I_DN1 = 16 * 32;
constexpr int I_LORA = 16 + 16 + 32;
constexpr int I_SMALL = I_IN + I_OUT + I_PG + I_PP + I_LORA, I_GU = NE * I_GU1, I_DN = NE * I_DN1, I_ALL = I_SMALL + I_GU + I_DN;
__device__ __forceinline__ void prep_item(KPR P, int it, LAS float* scr, int lane) {
    unsigned char* ws = P.ws;
    if (it < I_IN) { const int kb = it / 120, nb = it % 120, n0 = nb * 32, pn = n0 >> 8, j0 = n0 & 255;
        const int src = pn < 4 ? (pn * 256 + 64 * ((j0 & 127) >> 5) + 32 * (j0 >> 7)) : (n0 < 2048 ? n0 : n0 + 8);
        tr_item(P.w_in, INW, src, kb * 64, (bf16_t*)(ws + WS_WIN), 1024, n0, scr, lane); return; }
    it -= I_IN;
    if (it < I_OUT) { tr_item(P.w_out, 1024, (it % 32) * 32, (it / 32) * 64, (bf16_t*)(ws + WS_WOUT), 1024, (it % 32) * 32, scr, lane); return; }
    it -= I_OUT;
    if (it < I_PG) { tr_item8(P.w_pg, 1024, (it % 32) * 32, (it / 32) * 64, ws + WS_WPG, 1024, (it % 32) * 32, scr, lane); return; }
    it -= I_PG;
    if (it < I_PP) { tr_item(P.w_pp, 1024, (it % 32) * 32, (it / 32) * 64, (bf16_t*)(ws + WS_WPP), 256, (it % 32) * 32, scr, lane); return; }
    it -= I_PP;
    if (it < 16) { tr_item(P.w2, 512, it * 32, 0, (bf16_t*)(ws + 29 * MiB), 64, it * 32, scr, lane); return; }
    it -= 16;
    if (it < 16) { tr_item(P.a2, 512, it * 32, 0, (bf16_t*)(ws + 29 * MiB + 65536), 64, it * 32, scr, lane); return; }
    it -= 16;
    if (it < 32) { tr_item(P.g2, 512, (it % 16) * 32, (it / 16) * 64, (bf16_t*)(ws + 29 * MiB + 131072), 128, (it % 16) * 32, scr, lane); return; }
    it -= 32;
    if (it < I_GU) { const int e = it / I_GU1, r = it % I_GU1, kb = r / 64, nb = r % 64, n0 = nb * 32, pn = n0 >> 8, j0 = n0 & 255;
        const int src = (j0 >> 7) * 1024 + pn * 128 + (j0 & 127);
        tr_item8(P.w_gu + (size_t)e * 1024 * 2048, 2048, src, kb * 64, ws + WS_WGU + (size_t)e * 2048 * 1024, 1024, n0, scr, lane); return; }
    it -= I_GU;
    { const int e = it / I_DN1, r = it % I_DN1, kb = r / 32, nb = r % 32;
        tr_item8(P.w_down + (size_t)e * 1024 * 1024, 1024, nb * 32, kb * 64, ws + WS_WDN + (size_t)e * 1024 * 1024, 1024, nb * 32, scr, lane); }
}
__device__ __forceinline__ void phase_prep_weights(KPR P, LAS unsigned char* lds, int gw, int ngw, int wave, int lane) {
    LAS float* scr = (LAS float*)(lds + wave * 16384);
    for (int it = gw; it < I_ALL; it += ngw) prep_item(P, it, scr, lane);
}
__device__ __forceinline__ void phase_cvt_p(KPR P, int gt, int ngt) {
    bf16_t* PB = (bf16_t*)((unsigned char*)P.out + DO_PB);
    for (int i = gt; i < NTOK * PLE / 8; i += ngt) { const f32x4 a = ((const f32x4*)P.p)[2 * i], b = ((const f32x4*)P.p)[2 * i + 1];
        u32x4 w; w.x = pk2(a[0], a[1]); w.y = pk2(a[2], a[3]); w.z = pk2(b[0], b[1]); w.w = pk2(b[2], b[3]); ((u32x4*)PB)[i] = w; }
}
__device__ __forceinline__ void rms_row(const float* xrow, const float* gain, int lane, f32x4 (&v)[4]) {
    const f32x4* xr = (const f32x4*)xrow + lane; float s = 0.f;
#pragma unroll
    for (int j = 0; j < 4; ++j) { v[j] = xr[64 * j]; s += (v[j][0] * v[j][0] + v[j][1] * v[j][1]) + (v[j][2] * v[j][2] + v[j][3] * v[j][3]); }
    const float rstd = rsqrtf(wave_sum(s) * (1.f / DM) + 1e-6f);
#pragma unroll
    for (int j = 0; j < 4; ++j) v[j] = v[j] * rstd * ((const f32x4*)gain)[64 * j + lane];
}
__device__ __forceinline__ void store_row_fp8(unsigned char* orow, int lane, const f32x4 (&v)[4]) {
    unsigned* o4 = (unsigned*)orow + lane;
#pragma unroll
    for (int j = 0; j < 4; ++j) o4[64 * j] = pk4_fp8(v[j][0], v[j][1], v[j][2], v[j][3]);
}
__device__ __forceinline__ void store_row_bf16(bf16_t* orow, int lane, const f32x4 (&v)[4]) {
    u32x2* o8 = (u32x2*)orow + lane;
#pragma unroll
    for (int j = 0; j < 4; ++j) { u32x2 w; w.x = pk2(v[j][0], v[j][1]); w.y = pk2(v[j][2], v[j][3]); o8[64 * j] = w; }
}
__device__ __forceinline__ void norm1_row(KPR P, int row, int lane, const LAS float* wff, LAS float* lf_out  ) {
    f32x4 v[4]; rms_row(P.x + (size_t)row * DM, P.mix_norm, lane, v);
    store_row_bf16((bf16_t*)(P.ws + WS_XN) + (size_t)row * DM, lane, v);
    float ff[8];
#pragma unroll
    for (int q = 0; q < 8; ++q) { float s = 0.f;
#pragma unroll
        for (int j = 0; j < 4; ++j) { const f32x4 w = *(const LAS f32x4*)(wff + q * 1024 + 4 * (64 * j + lane)); s += (v[j][0] * w[0] + v[j][1] * w[1]) + (v[j][2] * w[2] + v[j][3] * w[3]); }
        ff[q] = s; }
    float g4[4], g2[2], g1;
    { const bool up = lane & 32;
#pragma unroll
        for (int q = 0; q < 4; ++q) { const float keep = up ? ff[4 + q] : ff[q], give = up ? ff[q] : ff[4 + q]; g4[q] = keep + __shfl_xor(give, 32); } }
    { const bool up = lane & 16;
#pragma unroll
        for (int q = 0; q < 2; ++q) { const float keep = up ? g4[2 + q] : g4[q], give = up ? g4[q] : g4[2 + q]; g2[q] = keep + __shfl_xor(give, 16); } }
    { const bool up = lane & 8; const float keep = up ? g2[1] : g2[0], give = up ? g2[0] : g2[1]; g1 = keep + __shfl_xor(give, 8); }
    g1 += __shfl_xor(g1, 4); g1 += __shfl_xor(g1, 2); g1 += __shfl_xor(g1, 1);
    if ((lane & 7) == 0) { const int q = lane >> 3; lf_out[q] = logsigmoidf_(g1 + P.f_bias[q]); }
}
__device__ __forceinline__ void load_wff(KPR P, LAS float* wff, int tid, int nthr) {
    for (int i = tid; i < 1024 * 8; i += nthr) wff[(i & 7) * 1024 + (i >> 3)] = P.w_in[(size_t)(i >> 3) * INW + 2048 + (i & 7)];
}
__device__ __forceinline__ void final_row(KPR P, int row, int lane, bool dead) {
    const u32x2* xr = (const u32x2*)((const bf16_t*)(P.ws + WS_X1) + (size_t)row * DM) + lane; f32x4 v[4]; float s = 0.f;
#pragma unroll
    for (int j = 0; j < 4; ++j) { const u32x2 xv = xr[64 * j]; v[j] = (f32x4){bflo(xv.x), bfhi(xv.x), bflo(xv.y), bfhi(xv.y)}; s += (v[j][0] * v[j][0] + v[j][1] * v[j][1]) + (v[j][2] * v[j][2] + v[j][3] * v[j][3]); }
    const float rstd = rsqrtf(wave_sum(s) * (1.f / DM) + 1e-6f);
    f32x4* o = (f32x4*)(P.out + (size_t)row * DM) + lane;
#pragma unroll
    for (int j = 0; j < 4; ++j) { v[j] = v[j] * rstd * ((const f32x4*)P.final_norm)[64 * j + lane]; if (dead) { const float q = __builtin_nanf(""); v[j] = (f32x4){q, q, q, q}; } o[64 * j] = v[j]; }
}
typedef GAS unsigned gu32;
#define RLX_AGENT __ATOMIC_RELAXED, __HIP_MEMORY_SCOPE_AGENT
#define XB_TMO      128
#define XB_XCNT(j)  (256  + 64 * (j))
#define XB_XSUB(j)  (1280 + 64 * (j))
#define XB_XGEN(j)  (2304 + 64 * (j))
#define XB_TOP      3328
#define XB_TOPGEN   3392
#define XCD_BAR_WORDS 3456
#define XB_SPIN_CAP (1u << 22)

__device__ __forceinline__ unsigned xb_ld(unsigned* p)              { return __hip_atomic_load(p, __ATOMIC_RELAXED, __HIP_MEMORY_SCOPE_AGENT); }
__device__ __forceinline__ unsigned xb_add(unsigned* p, unsigned v) { return __hip_atomic_fetch_add(p, v, __ATOMIC_RELAXED, __HIP_MEMORY_SCOPE_AGENT); }
__device__ __forceinline__ unsigned xb_xcc_id() { return (unsigned)__builtin_amdgcn_s_getreg((3 << 11) | 20) & 0xFu; }
#define XB_SPIN(cond, bar) do { unsigned _sp = 0; while (cond) { __builtin_amdgcn_s_sleep(1); \
    if ((++_sp & 255u) == 0u) { if (xb_ld(&(bar)[XB_TMO])) break; if (_sp > XB_SPIN_CAP) { atomicAdd(&(bar)[XB_TMO], 1u); break; } } } } while (0)

struct XcdBarrier { unsigned* bar; unsigned x; volatile LAS unsigned* st; };

__device__ __forceinline__ XcdBarrier xcd_barrier_post(unsigned* bar, volatile LAS unsigned* st) {
    XcdBarrier b; b.bar = bar; b.x = xb_xcc_id(); b.st = st;
    if (threadIdx.x == 0) (void)xb_add(&bar[XB_XCNT(b.x)], 1u);
    return b;
}
__device__ __forceinline__ void xcd_barrier_complete(unsigned* bar, unsigned x, unsigned& nloc, unsigned& nx) {
    const unsigned G = gridDim.x * gridDim.y * gridDim.z;
    unsigned sum, cnt, mine, sp = 0u;
    for (;;) {
        sum = 0u; cnt = 0u; mine = 0u;
#pragma unroll
        for (unsigned j = 0; j < 16; ++j) { const unsigned c = xb_ld(&bar[XB_XCNT(j)]); sum += c; cnt += (c > 0u) ? 1u : 0u; mine = (j == x) ? c : mine; }
        if (sum == G) break;
        __builtin_amdgcn_s_sleep(1);
        if ((++sp & 255u) == 0u) { if (xb_ld(&bar[XB_TMO])) break; if (sp > XB_SPIN_CAP) { atomicAdd(&bar[XB_TMO], 1u); break; } }
    }
    nloc = mine > 0u ? mine : 1u; nx = cnt > 0u ? cnt : 1u;
}
__device__ __forceinline__ void xcd_barrier(const XcdBarrier& b) {
    asm volatile("s_waitcnt vmcnt(0)" ::: "memory");
    __syncthreads();
    if (threadIdx.x == 0) {
        unsigned* bar = b.bar;
        __builtin_amdgcn_s_waitcnt(0);
        unsigned nloc = b.st[0], nx = b.st[1];
        if (nloc == 0u) { xcd_barrier_complete(bar, b.x, nloc, nx); b.st[0] = nloc; b.st[1] = nx; }
        const unsigned old = xb_add(&bar[XB_XSUB(b.x)], 1u);
        const unsigned gen = old / nloc;
        if (old + 1u == (gen + 1u) * nloc) {
            __builtin_amdgcn_fence(__ATOMIC_RELEASE, "agent");
            asm volatile("s_waitcnt vmcnt(0)" ::: "memory");
            const unsigned og = xb_add(&bar[XB_TOP], 1u);
            const unsigned tg = og / nx;
            if (og + 1u == (tg + 1u) * nx) xb_add(&bar[XB_TOPGEN], 1u);
            else XB_SPIN(xb_ld(&bar[XB_TOPGEN]) == tg, bar);
            __builtin_amdgcn_fence(__ATOMIC_ACQUIRE, "agent");
            xb_add(&bar[XB_XGEN(b.x)], 1u);
            asm volatile("s_waitcnt vmcnt(0)" ::: "memory");
        } else {
            XB_SPIN(xb_ld(&bar[XB_XGEN(b.x)]) == gen, bar);
            __builtin_amdgcn_fence(__ATOMIC_ACQUIRE, "agent");
            asm volatile("s_waitcnt vmcnt(0)" ::: "memory");
        }
    }
    __syncthreads();
}
namespace rk {
constexpr int MB = 8192;
constexpr int S_AT = 0, S_RT = 1, S_KT = 2, S_BT = 3, S_ATT = 4, S_KTT = 5, S_BTT = 6, S_VT = 7, S_N = 8, S_NT = 9, S_MAK = 10, S_MRB = 11, S_MRK = 12, S_TA = 13, S_TB = 14;
constexpr int SCR = 15 * MB;
constexpr int NCHUNK = SEQ / 64;
constexpr size_t WS_HT = WS_X1;
constexpr size_t WS_Y0 = WS_X1 + 64 * MiB;
constexpr size_t WS_QI = WS_X1 + 96 * MiB;
constexpr size_t WS_LW = WS_RW, WS_LA = WS_RW + 32 * MiB, WS_LG = WS_RW + 64 * MiB;
constexpr size_t WS_SC = WS_RW + 224 * MiB;
constexpr size_t DO_GT = 80 * MiB;
static_assert(WS_SC + 32 * MiB <= WS_END, "rwkv blobs");

__device__ __forceinline__ int moff(int row, int col) { return row * 128 + ((((col >> 3) ^ (row >> 1)) & 7) << 4) + (col & 7) * 2; }
__device__ __forceinline__ int crow(int r, int hi) { return (r & 3) + 8 * (r >> 2) + 4 * hi; }
__device__ __forceinline__ f32x16 mm_nt(const LAS unsigned char* A, int ar0, const LAS unsigned char* Bt, int br0, f32x16 acc, int r32, int hi) {
#pragma unroll
    for (int ks = 0; ks < 4; ++ks) { const bf16x8 a = *(const LAS bf16x8*)(A + moff(ar0 + r32, 16 * ks + 8 * hi)), b = *(const LAS bf16x8*)(Bt + moff(br0 + r32, 16 * ks + 8 * hi));
        acc = __builtin_amdgcn_mfma_f32_32x32x16_bf16(a, b, acc, 0, 0, 0); }
    return acc;
}
__device__ __forceinline__ void store_t(LAS unsigned char* dst, const f32x16& acc, int i0, int j0, int r32, int hi) {
#pragma unroll
    for (int g = 0; g < 4; ++g) { u32x2 w; w.x = pk2(acc[4 * g], acc[4 * g + 1]); w.y = pk2(acc[4 * g + 2], acc[4 * g + 3]); *(LAS u32x2*)(dst + moff(j0 + r32, i0 + 8 * g + 4 * hi)) = w; }
}
template <int MODE> __device__ __forceinline__ void mask_tri(f32x16& acc, int i0, int j0, int r32, int hi) {
#pragma unroll
    for (int r = 0; r < 16; ++r) { const int i = i0 + crow(r, hi), j = j0 + r32; const bool keep = MODE == 0 ? (j < i) : (MODE == 1 ? (i < j) : (i <= j)); if (!keep) acc[r] = 0.f; }
}

__device__ __forceinline__ void pass1_chunk(KPR P, LAS unsigned char* lds, int bh, int c, int tid) {
    const int lane = tid & 63, wave = tid >> 6, r32 = lane & 31, hi = lane >> 5, grp = wave >> 2, wq = wave & 3, i0 = 32 * (wq >> 1), j0 = 32 * (wq & 1);
    const int b = bh >> 3, h = bh & 7; const size_t tok0 = (size_t)b * SEQ + (size_t)c * 64; const size_t ci = (size_t)bh * NCHUNK + c;
    LAS float* part = (LAS float*)(lds + SCR); LAS float* WL = (LAS float*)(lds + SCR + 2048);
#define MAT(s) (lds + (s) * MB)
    {
        const bf16_t* Z = (const bf16_t*)(P.ws + WS_Z); const bf16_t* LW = (const bf16_t*)(P.ws + WS_LW); const bf16_t* LA = (const bf16_t*)(P.ws + WS_LA);
        const int ch = tid & 63, tq = tid >> 6, cc = h * 64 + ch; const size_t row0 = tok0 + 8 * tq;
        const float mur = P.mu[RW_R + cc], muk = P.mu[RW_K + cc], muv = P.mu[RW_V + cc], w0c = P.w0[cc], a0c = P.a0[cc], kkc = P.k_k[cc], kac = P.k_a[cc];
        const bf16_t* zp = Z + row0 * ZW + ZR + cc;
        const bool first = (c == 0) && (tq == 0); const bf16_t* zq = first ? zp : zp - ZW; const float pm = first ? 0.f : 1.f;
        unsigned short lr[9], lk[9], lv[9], llw[8], lla[8];
        lr[0] = zq[RW_R]; lk[0] = zq[RW_K]; lv[0] = zq[RW_V];
#pragma unroll
        for (int i = 0; i < 8; ++i) { const bf16_t* zi = zp + (size_t)i * ZW; lr[i + 1] = zi[RW_R]; lk[i + 1] = zi[RW_K]; lv[i + 1] = zi[RW_V]; const size_t o = (row0 + i) * 512 + cc; llw[i] = LW[o]; lla[i] = LA[o]; }
        float cum[8], vr[8], vk[8], vkk[8], vka[8], ssq[8]; unsigned short vv16[8]; float run = 0.f;
#pragma unroll
        for (int i = 0; i < 8; ++i) { const float pmi = (i == 0) ? pm : 1.f; const float zr1 = bf2f(lr[i + 1]), zk1 = bf2f(lk[i + 1]), zv1 = bf2f(lv[i + 1]);
            vr[i] = zr1 + (bf2f(lr[i]) * pmi - zr1) * mur; vk[i] = zk1 + (bf2f(lk[i]) * pmi - zk1) * muk; vv16[i] = (unsigned short)f2bf(zv1 + (bf2f(lv[i]) * pmi - zv1) * muv);
            vkk[i] = vk[i] * kkc; ssq[i] = vkk[i] * vkk[i]; }
#pragma unroll
        for (int i = 0; i < 8; ++i) ssq[i] = wave_sum(ssq[i]);
#pragma unroll
        for (int i = 0; i < 8; ++i) {
            const float wl = w0c + bf2f(llw[i]); const float sp = fmaxf(-wl, 0.f) + __logf(1.0f + __expf(-fabsf(wl)));
            run += -__expf(-sp - 0.5f); cum[i] = run;
            const float a = __builtin_amdgcn_rcpf(1.0f + __expf(-(a0c + bf2f(lla[i]))));
            const float kk = vkk[i] * __builtin_amdgcn_rcpf(fmaxf(__builtin_amdgcn_sqrtf(ssq[i]), 1e-12f));
            vk[i] = vk[i] * (1.0f + (a - 1.0f) * kac); vkk[i] = kk; vka[i] = kk * a; }
        part[tq * 64 + ch] = run;
        __syncthreads();
        float pre = 0.f;
#pragma unroll
        for (int g = 0; g < 8; ++g) { const float pvv = part[g * 64 + ch]; pre += (g < tq) ? pvv : 0.f; }
        float eprev = __expf(pre);
        unsigned atT[4], ktT[4], btT[4], vT[4]; unsigned short hold[4] = {0, 0, 0, 0};
#pragma unroll
        for (int i = 0; i < 8; ++i) { const int t = 8 * tq + i;
            const float cm = pre + cum[i], e1 = __expf(cm), einv = __expf(-cm);
            const unsigned short at = (unsigned short)f2bf(-vkk[i] * eprev), rt = (unsigned short)f2bf(vr[i] * e1), kt = (unsigned short)f2bf(vk[i] * einv), bt = (unsigned short)f2bf(vka[i] * einv), vv = vv16[i];
            eprev = e1;
            *(LAS unsigned short*)(MAT(S_AT) + moff(t, ch)) = at; *(LAS unsigned short*)(MAT(S_RT) + moff(t, ch)) = rt; *(LAS unsigned short*)(MAT(S_KT) + moff(t, ch)) = kt; *(LAS unsigned short*)(MAT(S_BT) + moff(t, ch)) = bt;
            if (i & 1) { atT[i >> 1] = hold[0] | ((unsigned)at << 16); ktT[i >> 1] = hold[1] | ((unsigned)kt << 16); btT[i >> 1] = hold[2] | ((unsigned)bt << 16); vT[i >> 1] = hold[3] | ((unsigned)vv << 16); }
            else { hold[0] = at; hold[1] = kt; hold[2] = bt; hold[3] = vv; }
            if (i == 7 && tq == 7) WL[ch] = e1; }
        *(LAS u32x4*)(MAT(S_ATT) + moff(ch, 8 * tq)) = (u32x4){atT[0], atT[1], atT[2], atT[3]}; *(LAS u32x4*)(MAT(S_KTT) + moff(ch, 8 * tq)) = (u32x4){ktT[0], ktT[1], ktT[2], ktT[3]};
        *(LAS u32x4*)(MAT(S_BTT) + moff(ch, 8 * tq)) = (u32x4){btT[0], btT[1], btT[2], btT[3]}; *(LAS u32x4*)(MAT(S_VT) + moff(ch, 8 * tq)) = (u32x4){vT[0], vT[1], vT[2], vT[3]};
    }
    __syncthreads();
    const f32x16 zero = f32x16{};
    if (grp == 0) { f32x16 d = mm_nt(MAT(S_AT), i0, MAT(S_BT), j0, zero, r32, hi); mask_tri<0>(d, i0, j0, r32, hi); store_t(MAT(S_NT), d, i0, j0, r32, hi);
        d = mm_nt(MAT(S_KT), i0, MAT(S_AT), j0, zero, r32, hi); mask_tri<1>(d, i0, j0, r32, hi); store_t(MAT(S_MAK), d, i0, j0, r32, hi);
        d = mm_nt(MAT(S_KT), i0, MAT(S_RT), j0, zero, r32, hi); mask_tri<2>(d, i0, j0, r32, hi); store_t(MAT(S_MRK), d, i0, j0, r32, hi); }
    else { f32x16 d = mm_nt(MAT(S_BT), i0, MAT(S_AT), j0, zero, r32, hi); mask_tri<1>(d, i0, j0, r32, hi); store_t(MAT(S_N), d, i0, j0, r32, hi);
#pragma unroll
        for (int r = 0; r < 16; ++r) if (i0 + crow(r, hi) == j0 + r32) d[r] = 1.0f;
        store_t(MAT(S_TA), d, i0, j0, r32, hi);
        d = mm_nt(MAT(S_BT), i0, MAT(S_RT), j0, zero, r32, hi); mask_tri<2>(d, i0, j0, r32, hi); store_t(MAT(S_MRB), d, i0, j0, r32, hi); }
    __syncthreads();
#pragma unroll
    for (int s = 1; s <= 6; ++s) {
        const int mc = (s & 1) ? S_N : S_AT, mcT = (s & 1) ? S_NT : S_KT, mn = (s & 1) ? S_AT : S_N, mnT = (s & 1) ? S_KT : S_NT;
        const int tc = (s & 1) ? S_TB : S_TA, tn = (s & 1) ? S_TA : S_TB;
        if (s <= 5) {
            if (grp == 0) { const f32x16 d = mm_nt(MAT(mc), i0, MAT(mcT), j0, zero, r32, hi); store_t(MAT(mnT), d, i0, j0, r32, hi); }
            else { const f32x16 d = mm_nt(MAT(mcT), i0, MAT(mc), j0, zero, r32, hi); store_t(MAT(mn), d, i0, j0, r32, hi); }
        }
        if (s >= 2 && grp == (s <= 5 ? 0 : 1) ) {
            f32x16 d = mm_nt(MAT(mcT), i0, MAT(tc), j0, zero, r32, hi);
#pragma unroll
            for (int g = 0; g < 4; ++g) { const u32x2 tv = *(const LAS u32x2*)(MAT(tc) + moff(j0 + r32, i0 + 8 * g + 4 * hi)); d[4 * g] += bflo(tv.x); d[4 * g + 1] += bfhi(tv.x); d[4 * g + 2] += bflo(tv.y); d[4 * g + 3] += bfhi(tv.y); }
            store_t(MAT(tn), d, i0, j0, r32, hi);
        }
        __syncthreads();
    }
    if (grp == 0) { const f32x16 d = mm_nt(MAT(S_TB), i0, MAT(S_ATT), j0, zero, r32, hi); store_t(MAT(S_BT), d, i0, j0, r32, hi); }
    else { const f32x16 d = mm_nt(MAT(S_MAK), i0, MAT(S_VT), j0, zero, r32, hi); store_t(MAT(S_N), d, i0, j0, r32, hi); }
    __syncthreads();
    if (grp == 0) { const f32x16 d = mm_nt(MAT(S_TB), i0, MAT(S_N), j0, zero, r32, hi); store_t(MAT(S_NT), d, i0, j0, r32, hi);
        f32x16 q = mm_nt(MAT(S_BT), i0, MAT(S_MRB), j0, zero, r32, hi);
#pragma unroll
        for (int g = 0; g < 4; ++g) { const u32x2 rv = *(const LAS u32x2*)(MAT(S_RT) + moff(j0 + r32, i0 + 8 * g + 4 * hi)); q[4 * g] += bflo(rv.x); q[4 * g + 1] += bfhi(rv.x); q[4 * g + 2] += bflo(rv.y); q[4 * g + 3] += bfhi(rv.y); }
        store_t(MAT(S_KT), q, i0, j0, r32, hi); }
    else { f32x16 g_ = mm_nt(MAT(S_BT), i0, MAT(S_BTT), j0, zero, r32, hi);
        const float wl = WL[j0 + r32];
#pragma unroll
        for (int r = 0; r < 16; ++r) { if (i0 + crow(r, hi) == j0 + r32) g_[r] += 1.0f; g_[r] *= wl; }
        store_t(MAT(S_AT), g_, i0, j0, r32, hi); }
    __syncthreads();
    if (grp == 0) { f32x16 d = mm_nt(MAT(S_BTT), i0, MAT(S_NT), j0, zero, r32, hi); d = mm_nt(MAT(S_KTT), i0, MAT(S_VT), j0, d, r32, hi);
        float* HT = (float*)(P.ws + WS_HT) + ci * 4096 + (size_t)wq * 1024 + lane;
#pragma unroll
        for (int g = 0; g < 4; ++g) { const f32x4 wl4 = *(const LAS f32x4*)(WL + i0 + 8 * g + 4 * hi);
#pragma unroll
            for (int i = 0; i < 4; ++i) HT[(4 * g + i) * 64] = d[4 * g + i] * wl4[i]; } }
    else { f32x16 d = mm_nt(MAT(S_MRB), i0, MAT(S_NT), j0, zero, r32, hi); d = mm_nt(MAT(S_MRK), i0, MAT(S_VT), j0, d, r32, hi);
        unsigned* Y0 = (unsigned*)(P.ws + WS_Y0) + ci * 2048 + (size_t)wq * 512 + lane;
#pragma unroll
        for (int r2 = 0; r2 < 8; ++r2) Y0[r2 * 64] = pk2(d[2 * r2], d[2 * r2 + 1]); }
    { u32x4* GTg = (u32x4*)((unsigned char*)P.out + DO_GT + ci * MB); u32x4* QIg = (u32x4*)(P.ws + WS_QI + ci * MB);
        GTg[tid] = *(const LAS u32x4*)(MAT(S_AT) + tid * 16); QIg[tid] = *(const LAS u32x4*)(MAT(S_KT) + tid * 16); }
    __syncthreads();
#undef MAT
}

__device__ __forceinline__ void pass2_seq(KPR P, LAS unsigned char* lds, int bh, int tid) {
    const int lane = tid & 63, wave = tid >> 6, r32 = lane & 31, hi = lane >> 5, wq = wave & 3, i0 = 32 * (wq >> 1), j0 = 32 * (wq & 1);
    LAS unsigned char* Sm = lds; LAS unsigned char* G0 = lds + MB; LAS unsigned char* G1 = lds + 2 * MB;
    const size_t ci0 = (size_t)bh * NCHUNK;
    const u32x4* GTg = (const u32x4*)((const unsigned char*)P.out + DO_GT + ci0 * MB); u32x4* SCg = (u32x4*)(P.ws + WS_SC + ci0 * MB);
    const float* HT = (const float*)(P.ws + WS_HT) + ci0 * 4096 + (size_t)wq * 1024 + lane;
    *(LAS u32x4*)(Sm + tid * 16) = (u32x4){0u, 0u, 0u, 0u};
    *(LAS u32x4*)(G0 + tid * 16) = GTg[tid];
    u32x4 gnext = GTg[512 + tid];
    f32x16 hcur, hnext;
    if (wave < 4) {
#pragma unroll
        for (int r = 0; r < 16; ++r) { hcur[r] = HT[r * 64]; hnext[r] = HT[4096 + r * 64]; } }
    __syncthreads();
    for (int c = 0; c < NCHUNK; ++c) {
        LAS unsigned char* Gc = (c & 1) ? G1 : G0; LAS unsigned char* Gn = (c & 1) ? G0 : G1;
        SCg[(size_t)c * 512 + tid] = *(const LAS u32x4*)(Sm + tid * 16);
        f32x16 d = hcur;
        if (wave < 4) d = mm_nt(Gc, i0, Sm, j0, d, r32, hi);
        __syncthreads();
        if (wave < 4) store_t(Sm, d, i0, j0, r32, hi);
        *(LAS u32x4*)(Gn + tid * 16) = gnext;
        const int c2 = (c + 2 < NCHUNK) ? c + 2 : NCHUNK - 1;
        gnext = GTg[(size_t)c2 * 512 + tid];
        if (wave < 4) { hcur = hnext;
#pragma unroll
            for (int r = 0; r < 16; ++r) hnext[r] = HT[(size_t)c2 * 4096 + r * 64]; }
        __syncthreads();
    }
}

__device__ __forceinline__ void pass3_chunk(KPR P, LAS unsigned char* lds, int bh, int c, int tid) {
    const int lane = tid & 63, wave = tid >> 6, r32 = lane & 31, hi = lane >> 5, wq = wave & 3, i0 = 32 * (wq >> 1), j0 = 32 * (wq & 1);
    const int b = bh >> 3, h = bh & 7; const size_t tok0 = (size_t)b * SEQ + (size_t)c * 64; const size_t ci = (size_t)bh * NCHUNK + c;
    LAS unsigned char* Qm = lds; LAS unsigned char* Sm = lds + MB; LAS float* Yl = (LAS float*)(lds + 2 * MB);
    *(LAS u32x4*)(Qm + tid * 16) = ((const u32x4*)(P.ws + WS_QI + ci * MB))[tid];
    *(LAS u32x4*)(Sm + tid * 16) = ((const u32x4*)(P.ws + WS_SC + ci * MB))[tid];
    f32x16 d = f32x16{};
    if (wave < 4) { const unsigned* Y0 = (const unsigned*)(P.ws + WS_Y0) + ci * 2048 + (size_t)wq * 512 + lane;
#pragma unroll
        for (int r2 = 0; r2 < 8; ++r2) { const unsigned w = Y0[r2 * 64]; d[2 * r2] = bflo(w); d[2 * r2 + 1] = bfhi(w); } }
    __syncthreads();
    if (wave < 4) { d = mm_nt(Qm, i0, Sm, j0, d, r32, hi);
#pragma unroll
        for (int r = 0; r < 16; ++r) Yl[(i0 + crow(r, hi)) * 65 + j0 + r32] = d[r]; }
    __syncthreads();
    const bf16_t* Z = (const bf16_t*)(P.ws + WS_Z); const bf16_t* LA = (const bf16_t*)(P.ws + WS_LA); const bf16_t* LG = (const bf16_t*)(P.ws + WS_LG);
    bf16_t* AO = (bf16_t*)(P.ws + WS_AO); const int cc = h * 64 + lane;
    const float lnw = P.ln_w[cc], lnb = P.ln_b[cc], rkc = P.r_k[cc], mur = P.mu[RW_R + cc], muk = P.mu[RW_K + cc], muv = P.mu[RW_V + cc], a0c = P.a0[cc], kac = P.k_a[cc];
    const bf16_t* zp = Z + (tok0 + wave * 8) * ZW + ZR + cc; const bool first = (c == 0) && (wave == 0); const bf16_t* zq = first ? zp : zp - ZW; const float pm = first ? 0.f : 1.f;
    unsigned short lr[9], lk[9], lv[9], lla[8], llg[8];
    lr[0] = zq[RW_R]; lk[0] = zq[RW_K]; lv[0] = zq[RW_V];
#pragma unroll
    for (int i = 0; i < 8; ++i) { const bf16_t* zi = zp + (size_t)i * ZW; lr[i + 1] = zi[RW_R]; lk[i + 1] = zi[RW_K]; lv[i + 1] = zi[RW_V]; const size_t o = (tok0 + wave * 8 + i) * 512 + cc; lla[i] = LA[o]; llg[i] = LG[o]; }
    float y[8], s1[8], s2[8], s3[8], vvv[8];
#pragma unroll
    for (int i = 0; i < 8; ++i) { const float pmi = (i == 0) ? pm : 1.f; const float zr1 = bf2f(lr[i + 1]), zk1 = bf2f(lk[i + 1]), zv1 = bf2f(lv[i + 1]);
        const float r = zr1 + (bf2f(lr[i]) * pmi - zr1) * mur, zk = zk1 + (bf2f(lk[i]) * pmi - zk1) * muk; vvv[i] = zv1 + (bf2f(lv[i]) * pmi - zv1) * muv;
        const float a = __builtin_amdgcn_rcpf(1.0f + __expf(-(a0c + bf2f(lla[i])))); const float k = zk * (1.0f + (a - 1.0f) * kac);
        y[i] = Yl[(wave * 8 + i) * 65 + lane]; s1[i] = y[i]; s3[i] = r * k * rkc; }
#pragma unroll
    for (int i = 0; i < 8; ++i) { s1[i] = wave_sum(s1[i]); s3[i] = wave_sum(s3[i]); }
#pragma unroll
    for (int i = 0; i < 8; ++i) { y[i] -= s1[i] * (1.f / 64.f); s2[i] = y[i] * y[i]; }
#pragma unroll
    for (int i = 0; i < 8; ++i) s2[i] = wave_sum(s2[i]);
#pragma unroll
    for (int i = 0; i < 8; ++i) { const size_t tok = tok0 + wave * 8 + i; const float yn = y[i] * rsqrtf(s2[i] * (1.f / 64.f) + 64e-5f) * lnw + lnb;
        AO[tok * DM + 512 + cc] = (bf16_t)f2bf((yn + s3[i] * vvv[i]) * bf2f(llg[i])); }
}

constexpr size_t WS_W2T = 29 * MiB, WS_A2T = 29 * MiB + 65536, WS_G2T = 29 * MiB + 131072;
__device__ __forceinline__ bf16x8 act8(const bf16_t* zc, const bf16_t* zpv, float pmask, const float* mu, int mode) {
    const u32x4 c = *(const u32x4*)zc, p = *(const u32x4*)zpv;
    const f32x4 m0 = *(const f32x4*)mu, m1 = *(const f32x4*)(mu + 4);
    const unsigned cw[4] = {c.x, c.y, c.z, c.w}, pw[4] = {p.x, p.y, p.z, p.w}; const float um[8] = {m0[0], m0[1], m0[2], m0[3], m1[0], m1[1], m1[2], m1[3]}; float v[8];
#pragma unroll
    for (int j = 0; j < 4; ++j) { const float c0 = bflo(cw[j]), c1 = bfhi(cw[j]), p0 = bflo(pw[j]) * pmask, p1 = bfhi(pw[j]) * pmask;
        v[2 * j] = c0 + (p0 - c0) * um[2 * j]; v[2 * j + 1] = c1 + (p1 - c1) * um[2 * j + 1]; }
#pragma unroll
    for (int j = 0; j < 8; ++j) { if (mode == 0) { const float e = __expf(-2.0f * fabsf(v[j])); const float th = (1.0f - e) * __builtin_amdgcn_rcpf(1.0f + e); v[j] = v[j] < 0.f ? -th : th; } else if (mode == 2) v[j] = __builtin_amdgcn_rcpf(1.0f + __expf(-v[j])); }
    u32x4 w; w.x = pk2(v[0], v[1]); w.y = pk2(v[2], v[3]); w.z = pk2(v[4], v[5]); w.w = pk2(v[6], v[7]);
    return __builtin_bit_cast(bf16x8, w);
}
__device__ __forceinline__ void lora_task(KPR P, int task, int lane) {
    const int r32 = lane & 31, hi = lane >> 5; const size_t row = (size_t)task * 32 + r32; const bool first = (row % SEQ) == 0;
    const bf16_t* Z = (const bf16_t*)(P.ws + WS_Z) + row * ZW + ZR + 8 * hi; const bf16_t* Zp = first ? Z : Z - ZW; const float pmask = first ? 0.f : 1.f;
    const float* mub = P.mu + 8 * hi;
    bf16x8 xw[4], xa[4], xg[8];
#pragma unroll
    for (int ks = 0; ks < 4; ++ks) { xw[ks] = act8(Z + RW_W + 16 * ks, Zp + RW_W + 16 * ks, pmask, mub + RW_W + 16 * ks, 0); xa[ks] = act8(Z + RW_A + 16 * ks, Zp + RW_A + 16 * ks, pmask, mub + RW_A + 16 * ks, 1); asm volatile("" ::: "memory"); }
#pragma unroll
    for (int ks = 0; ks < 8; ++ks) { xg[ks] = act8(Z + RW_G + 16 * ks, Zp + RW_G + 16 * ks, pmask, mub + RW_G + 16 * ks, 2); if (ks & 1) asm volatile("" ::: "memory"); }
    const bf16_t* W2T = (const bf16_t*)(P.ws + WS_W2T) + r32 * 64 + 8 * hi; const bf16_t* A2T = (const bf16_t*)(P.ws + WS_A2T) + r32 * 64 + 8 * hi; const bf16_t* G2T = (const bf16_t*)(P.ws + WS_G2T) + r32 * 128 + 8 * hi;
    bf16_t* LW = (bf16_t*)(P.ws + WS_LW) + row * 512 + 4 * hi; bf16_t* LA = (bf16_t*)(P.ws + WS_LA) + row * 512 + 4 * hi; bf16_t* LG = (bf16_t*)(P.ws + WS_LG) + row * 512 + 4 * hi;
#pragma nounroll
    for (int cb = 0; cb < 16; ++cb) {
        f32x16 dw = f32x16{}, da = f32x16{}, dg = f32x16{};
#pragma unroll
        for (int ks = 0; ks < 4; ++ks) { dw = __builtin_amdgcn_mfma_f32_32x32x16_bf16(*(const bf16x8*)(W2T + cb * 32 * 64 + 16 * ks), xw[ks], dw, 0, 0, 0); da = __builtin_amdgcn_mfma_f32_32x32x16_bf16(*(const bf16x8*)(A2T + cb * 32 * 64 + 16 * ks), xa[ks], da, 0, 0, 0); }
#pragma unroll
        for (int ks = 0; ks < 8; ++ks) dg = __builtin_amdgcn_mfma_f32_32x32x16_bf16(*(const bf16x8*)(G2T + cb * 32 * 128 + 16 * ks), xg[ks], dg, 0, 0, 0);
#pragma unroll
        for (int g = 0; g < 4; ++g) { u32x2 w; w.x = pk2(dw[4 * g], dw[4 * g + 1]); w.y = pk2(dw[4 * g + 2], dw[4 * g + 3]); *(u32x2*)(LW + cb * 32 + 8 * g) = w;
            w.x = pk2(da[4 * g], da[4 * g + 1]); w.y = pk2(da[4 * g + 2], da[4 * g + 3]); *(u32x2*)(LA + cb * 32 + 8 * g) = w;
            w.x = pk2(dg[4 * g], dg[4 * g + 1]); w.y = pk2(dg[4 * g + 2], dg[4 * g + 3]); *(u32x2*)(LG + cb * 32 + 8 * g) = w; }
    }
}
}
namespace rt {
__device__ __forceinline__ int woff(int e, int k) { return e * 2048 + ((((k >> 3) ^ (e & 15))) << 4) + (k & 7) * 2; }
constexpr size_t WS_WRI = 30 * MiB;
__device__ __forceinline__ void build_w(KPR P, int part, int tid) {
    unsigned char* img = P.ws + WS_WRI; const int e = tid & 31, k0 = part * 64 + 4 * (tid >> 5); float w[4];
#pragma unroll
    for (int i = 0; i < 4; ++i) w[i] = P.moe_norm[k0 + i] * P.w_router[(k0 + i) * 32 + e];
#pragma unroll
    for (int i = 0; i < 4; ++i) { const int k = k0 + i; const unsigned h = f2bf(w[i]); const unsigned l = f2bf(w[i] - bf2f(h));
        *(unsigned short*)(img + woff(e, k)) = (unsigned short)h; *(unsigned short*)(img + 65536 + woff(e, k)) = (unsigned short)l; }
}
__device__ __forceinline__ void copy_w(KPR P, LAS unsigned char* lds, int tid) {
    const u32x4* img = (const u32x4*)(P.ws + WS_WRI);
#pragma unroll 4
    for (int i = 0; i < 16; ++i) *(LAS u32x4*)(lds + (size_t)(i * 512 + tid) * 16) = img[i * 512 + tid];
}
__device__ __forceinline__ void split8(const f32x4& a, const f32x4& b, bf16x8& h, bf16x8& l) {
    unsigned hh[8]; float v[8] = {a[0], a[1], a[2], a[3], b[0], b[1], b[2], b[3]};
#pragma unroll
    for (int j = 0; j < 8; ++j) hh[j] = f2bf(v[j]);
    u32x4 hw, lw;
    hw.x = hh[0] | (hh[1] << 16); hw.y = hh[2] | (hh[3] << 16); hw.z = hh[4] | (hh[5] << 16); hw.w = hh[6] | (hh[7] << 16);
    lw.x = pk2(v[0] - bf2f(hh[0]), v[1] - bf2f(hh[1])); lw.y = pk2(v[2] - bf2f(hh[2]), v[3] - bf2f(hh[3])); lw.z = pk2(v[4] - bf2f(hh[4]), v[5] - bf2f(hh[5])); lw.w = pk2(v[6] - bf2f(hh[6]), v[7] - bf2f(hh[7]));
    h = __builtin_bit_cast(bf16x8, hw); l = __builtin_bit_cast(bf16x8, lw);
}
__device__ __forceinline__ void route_task(KPR P, const LAS unsigned char* wlds, int task, int lane) {
    const int r32 = lane & 31, hi = lane >> 5; const int row = task * 32 + r32;
    const bf16_t* xrow = (const bf16_t*)(P.ws + WS_X1) + (size_t)row * DM + 8 * hi;
    f32x16 acc = f32x16{}; float ss = 0.f;
    u32x4 xq[4];
#pragma unroll
    for (int j = 0; j < 4; ++j) xq[j] = *(const u32x4*)(xrow + 16 * j);
    for (int ks0 = 0; ks0 < 64; ks0 += 4) {
#pragma unroll
        for (int j = 0; j < 4; ++j) { const int ks = ks0 + j; const u32x4 xv = xq[j];
            const int kn = (ks + 4 < 64) ? ks + 4 : ks; xq[j] = *(const u32x4*)(xrow + 16 * kn);
            const unsigned xw[4] = {xv.x, xv.y, xv.z, xv.w};
#pragma unroll
            for (int q = 0; q < 4; ++q) { const float a = bflo(xw[q]), b = bfhi(xw[q]); ss += a * a + b * b; }
            const bf16x8 xh = __builtin_bit_cast(bf16x8, xv);
            const bf16x8 wh = *(const LAS bf16x8*)(wlds + woff(r32, 16 * ks + 8 * hi)), wl = *(const LAS bf16x8*)(wlds + 65536 + woff(r32, 16 * ks + 8 * hi));
            acc = __builtin_amdgcn_mfma_f32_32x32x16_bf16(wh, xh, acc, 0, 0, 0); acc = __builtin_amdgcn_mfma_f32_32x32x16_bf16(wl, xh, acc, 0, 0, 0); }
    }
    ss += __shfl_xor(ss, 32);
    const float rstd = rsqrtf(ss * (1.f / DM) + 1e-6f);
    float lg[16];
#pragma unroll
    for (int g = 0; g < 4; ++g) { const f32x4 bb = *(const f32x4*)(P.b_router + 8 * g + 4 * hi);
#pragma unroll
        for (int i = 0; i < 4; ++i) lg[4 * g + i] = acc[4 * g + i] * rstd + bb[i]; }
    float tv[4]; int ti[4];
#pragma unroll
    for (int k = 0; k < 4; ++k) { float bv = lg[0]; int bi = 4 * hi;
#pragma unroll
        for (int r = 1; r < 16; ++r) { const int e = (r & 3) + 8 * (r >> 2) + 4 * hi; if (lg[r] > bv) { bv = lg[r]; bi = e; } }
        const float pv = __shfl_xor(bv, 32); const int pi = __shfl_xor(bi, 32);
        if (pv > bv || (pv == bv && pi < bi)) { bv = pv; bi = pi; }
        tv[k] = bv; ti[k] = bi;
#pragma unroll
        for (int r = 0; r < 16; ++r) { const int e = (r & 3) + 8 * (r >> 2) + 4 * hi; if (e == bi) lg[r] = -INFINITY; } }
    const float e1 = __expf(tv[1] - tv[0]), e2 = __expf(tv[2] - tv[0]), e3 = __expf(tv[3] - tv[0]), inv = 1.f / (1.f + e1 + e2 + e3);
    const int c0 = hi ? ti[2] : ti[0], c1 = hi ? ti[3] : ti[1]; const float g0 = (hi ? e2 : 1.f) * inv, g1 = (hi ? e3 : e1) * inv;
    const unsigned long long ltm = (1ull << lane) - 1ull; int mycnt = 0, rk0 = 0, rk1 = 0;
    for (int e = 0; e < 32; ++e) { const unsigned long long m0 = __ballot(c0 == e), m1 = __ballot(c1 == e); const int n0 = __popcll(m0);
        if (lane == e) mycnt = n0 + __popcll(m1);
        if (c0 == e) rk0 = __popcll(m0 & ltm);
        if (c1 == e) rk1 = n0 + __popcll(m1 & ltm); }
    unsigned* cnt = (unsigned*)(P.ws + WS_CTL) + CW_CNT; int base = 0;
    if (lane < 32 && mycnt > 0) base = (int)atomicAdd(cnt + lane, (unsigned)mycnt);
    rk0 += __shfl(base, c0); rk1 += __shfl(base, c1);
    int* route = (int*)(P.ws + WS_ROUTE); int* tokslot = (int*)(P.ws + WS_TOKSLOT); float* gateslot = (float*)(P.ws + WS_GATESLOT);
    tokslot[(size_t)c0 * NTOK + rk0] = row; gateslot[(size_t)c0 * NTOK + rk0] = g0; tokslot[(size_t)c1 * NTOK + rk1] = row; gateslot[(size_t)c1 * NTOK + rk1] = g1;
    route[(size_t)row * 12 + 2 * hi] = c0; route[(size_t)row * 12 + 2 * hi + 1] = c1; route[(size_t)row * 12 + 4 + 2 * hi] = rk0; route[(size_t)row * 12 + 4 + 2 * hi + 1] = rk1;
    unsigned char* xn = P.ws + WS_XN + (size_t)row * DM + 8 * hi; const float* gn = P.moe_norm + 8 * hi;
#pragma unroll
    for (int j = 0; j < 4; ++j) xq[j] = *(const u32x4*)(xrow + 16 * j);
    for (int ks0 = 0; ks0 < 64; ks0 += 4) {
#pragma unroll
        for (int j = 0; j < 4; ++j) { const int ks = ks0 + j; const u32x4 xv = xq[j]; const f32x4 ga = *(const f32x4*)(gn + 16 * ks), gb = *(const f32x4*)(gn + 16 * ks + 4);
            const int kn = (ks + 4 < 64) ? ks + 4 : ks; xq[j] = *(const u32x4*)(xrow + 16 * kn);
            u32x2 w; w.x = pk4_fp8(bflo(xv.x) * rstd * ga[0], bfhi(xv.x) * rstd * ga[1], bflo(xv.y) * rstd * ga[2], bfhi(xv.y) * rstd * ga[3]); w.y = pk4_fp8(bflo(xv.z) * rstd * gb[0], bfhi(xv.z) * rstd * gb[1], bflo(xv.w) * rstd * gb[2], bfhi(xv.w) * rstd * gb[3]);
            *(u32x2*)(xn + 16 * ks) = w; }
    }
}
}
namespace attn_body {
using bf16=unsigned short;
using bf16x8=__attribute__((ext_vector_type(8)))short;
using s16x4=__attribute__((ext_vector_type(4)))short;
using f32x16=__attribute__((ext_vector_type(16)))float;
using u32x4=__attribute__((ext_vector_type(4)))unsigned;
constexpr int BATCH=4,NHEAD=8,SEQ=8192,D=64,DM=3840,OP=1024;
constexpr int NW=8,QBLK=32,QB=QBLK*NW,KVBLK=64,NQB=SEQ/QB;
constexpr int ATTN_PITCH=DM, ATTN_UNIT_ROWS=QB;
__device__ __forceinline__ int crow(int r,int hi){return (r&3)+8*(r>>2)+4*hi;}
#define SBAR() __builtin_amdgcn_sched_barrier(0)
__device__ __forceinline__ void cmask(f32x16&p0,f32x16&p1,int jb,int qrel,int hi){
  const float NEG=-INFINITY; int kb=64*jb+4*hi;
  #pragma unroll
  for(int r=0;r<16;++r){int kv=kb+(r&3)+8*(r>>2); if(kv>qrel)p0[r]=NEG; if(kv+32>qrel)p1[r]=NEG;}
}

constexpr int NSLOT=3, SLOTB=8192;
constexpr int LDS_K=0, LDS_V=NSLOT*SLOTB, LDS_WS=2*NSLOT*SLOTB, LDS_OST=LDS_WS+NW*64*4, LDS_C2=LDS_OST+NW*4096, LDS_BYTES=LDS_C2+SEQ*4;
constexpr float C2=0.125f*1.4426950408889634f;
__device__ __forceinline__ void glds16(const void*gsrc,unsigned lds_dst){unsigned keep;
  asm volatile("s_mov_b32 %0, m0\n\ts_mov_b32 m0, %2\n\ts_nop 0\n\tglobal_load_lds_dwordx4 %1, off\n\ts_mov_b32 m0, %0":"=&s"(keep):"v"(gsrc),"s"(lds_dst):"memory");}
__device__ __forceinline__ float max3f(float a,float b,float c){float r;asm("v_max3_f32 %0, %1, %2, %3":"=v"(r):"v"(a),"v"(b),"v"(c));return r;}
__device__ __forceinline__ float max2f(float a,float b){float r;asm("v_max_f32_e32 %0, %1, %2":"=v"(r):"v"(a),"v"(b));return r;}
__device__ __forceinline__ float fadd_s(float a,float b){float r;asm("v_add_f32_e32 %0, %1, %2":"=v"(r):"v"(a),"v"(b));return r;}
__device__ __forceinline__ float fsub_s(float a,float b){float r;asm("v_sub_f32_e32 %0, %1, %2":"=v"(r):"v"(a),"v"(b));return r;}
typedef float f32x2_t __attribute__((ext_vector_type(2))); typedef float f32x4v __attribute__((ext_vector_type(4))); typedef __bf16 bf16x2_t __attribute__((ext_vector_type(2)));
__device__ __forceinline__ unsigned cvtpk_s(float lo,float hi){f32x2_t v={lo,hi};bf16x2_t b=__builtin_convertvector(v,bf16x2_t);return __builtin_bit_cast(unsigned,b);}
#define WAIT_BAR(N) asm volatile("s_waitcnt vmcnt(" #N ") lgkmcnt(0)\n\ts_barrier":::"memory")

__device__ __forceinline__ void qkt(f32x16&p0,f32x16&p1,const char*Kslot,const bf16x8*qr,int r32,int hi){
  const char*kb=Kslot+hi*1024+r32*16;
  #pragma unroll
  for(int d0=0;d0<4;++d0){
    const bf16x8 b0=*reinterpret_cast<const bf16x8*>(kb+d0*2048);
    const bf16x8 b1=*reinterpret_cast<const bf16x8*>(kb+d0*2048+512);
    p0=__builtin_amdgcn_mfma_f32_32x32x16_bf16(b0,qr[d0],p0,0,0,0);p1=__builtin_amdgcn_mfma_f32_32x32x16_bf16(b1,qr[d0],p1,0,0,0);}
}
typedef __attribute__((address_space(3))) const char* lds_cptr;
typedef short v4i16_t __attribute__((ext_vector_type(4)));
__device__ __forceinline__ void kload8(bf16x8*kf,lds_cptr kp){
  kf[0]=*(const __attribute__((address_space(3))) bf16x8*)(kp);      kf[1]=*(const __attribute__((address_space(3))) bf16x8*)(kp+512);
  kf[2]=*(const __attribute__((address_space(3))) bf16x8*)(kp+2048); kf[3]=*(const __attribute__((address_space(3))) bf16x8*)(kp+2560);
  kf[4]=*(const __attribute__((address_space(3))) bf16x8*)(kp+4096); kf[5]=*(const __attribute__((address_space(3))) bf16x8*)(kp+4608);
  kf[6]=*(const __attribute__((address_space(3))) bf16x8*)(kp+6144); kf[7]=*(const __attribute__((address_space(3))) bf16x8*)(kp+6656);
}
__device__ __forceinline__ void kload2(bf16x8*kf,lds_cptr kp,int j){ kf[2*j]=*(const __attribute__((address_space(3))) bf16x8*)(kp+j*2048); kf[2*j+1]=*(const __attribute__((address_space(3))) bf16x8*)(kp+j*2048+512); }
__device__ __forceinline__ s16x4 vtr(lds_cptr p){ return __builtin_bit_cast(s16x4,__builtin_amdgcn_ds_read_tr16_b64_v4i16((__attribute__((address_space(3))) v4i16_t*)p)); }
__device__ __forceinline__ float rowmax(const f32x16&p0,const f32x16&p1){
  float a=max3f(p0[0],p0[1],p1[0]),b=max3f(p0[2],p0[3],p1[1]);a=max3f(a,p1[2],p1[3]);
  #pragma unroll
  for(int r=4;r<16;r+=4){a=max3f(a,p0[r],p0[r+1]);b=max3f(b,p0[r+2],p0[r+3]);a=max3f(a,p1[r],p1[r+1]);b=max3f(b,p1[r+2],p1[r+3]);}
  const float m=max2f(a,b);
  auto rr=__builtin_amdgcn_permlane32_swap(__float_as_uint(m),__float_as_uint(m),false,false);
  return max2f(__uint_as_float(rr[0]),__uint_as_float(rr[1]));
}
__device__ __forceinline__ void pv(f32x16*o,int vb,bf16x8 pa0,bf16x8 pa1,bf16x8 pa2,bf16x8 pa3){
  #pragma unroll
  for(int d0=0;d0<2;++d0){s16x4 lo[4],hi[4];
    #pragma unroll
    for(int ks=0;ks<4;++ks){
      asm volatile("ds_read_b64_tr_b16 %0,%1 offset:%c2":"=&v"(lo[ks]):"v"(vb),"i"(d0*4096+ks*1024):"memory");
      asm volatile("ds_read_b64_tr_b16 %0,%1 offset:%c2":"=&v"(hi[ks]):"v"(vb),"i"(d0*4096+ks*1024+512):"memory");}
    asm volatile("s_waitcnt lgkmcnt(0)":::"memory");SBAR();
    #define PK(k) (bf16x8){lo[k][0],lo[k][1],lo[k][2],lo[k][3],hi[k][0],hi[k][1],hi[k][2],hi[k][3]}
    o[d0]=__builtin_amdgcn_mfma_f32_32x32x16_bf16(pa0,PK(0),o[d0],0,0,0);
    o[d0]=__builtin_amdgcn_mfma_f32_32x32x16_bf16(pa1,PK(1),o[d0],0,0,0);
    o[d0]=__builtin_amdgcn_mfma_f32_32x32x16_bf16(pa2,PK(2),o[d0],0,0,0);
    o[d0]=__builtin_amdgcn_mfma_f32_32x32x16_bf16(pa3,PK(3),o[d0],0,0,0);
    #undef PK
  }
}

#ifndef ATTN_STORE16
#define ATTN_STORE16(p,v) (*(u32x4*)(p)=(v))
#endif
template<int THRL> __device__ __forceinline__ void attn_unit(int b,int h,int qb,int t0,const bf16*Z,const float*c2g,bf16*O,char*shm){
  const int tid=threadIdx.x,lane=tid&63,r32=lane&31,hi=lane>>5; const int wid=__builtin_amdgcn_readfirstlane(tid>>6);
  const long rowbase=(long)b*SEQ; const int q0=qb*QB;
  const bf16*Qw=Z+(rowbase+q0+wid*QBLK)*DM+h*D;
  const bf16*Kh=Z+(rowbase+(long)t0*KVBLK)*DM+512+h*D,*Vh=Z+(rowbase+(long)t0*KVBLK)*DM+1024+h*D;
  const unsigned lds0=(unsigned)(uintptr_t)shm;
  float*wsf=(float*)(shm+LDS_WS)+wid*64;
  const bf16*ksrc=Kh+(long)lane*DM+wid*8;
  const bf16*vsrc=Vh+(long)(16*(wid&3)+(lane>>2))*DM+(wid>>2)*32+(lane&3)*8;
  const unsigned kdst=lds0+LDS_K+wid*1024, vdst=lds0+LDS_V+wid*1024;
  #define DMA_K(t,slot) glds16(ksrc+(long)(t)*KVBLK*DM,(unsigned)__builtin_amdgcn_readfirstlane(kdst+(slot)))
  #define DMA_V(t,slot) glds16(vsrc+(long)(t)*KVBLK*DM,(unsigned)__builtin_amdgcn_readfirstlane(vdst+(slot)))
  const int vb0=(int)(lds0+LDS_V)+((lane>>4)&1)*32+(lane&3)*8+(4*hi+((lane&15)>>2))*64;
  const char*Kbase=shm+LDS_K; bf16x8 kf[8];
  const lds_cptr shm3=(lds_cptr)shm; const lds_cptr kp0=shm3+LDS_K+hi*1024+r32*16; const lds_cptr vp0=shm3+LDS_V+((lane>>4)&1)*32+(lane&3)*8+(4*hi+((lane&15)>>2))*64;
  const int NT=(q0+QB)/KVBLK-t0;
  { const int np=(q0+QB)/256;
    for(int p=(t0>>2)+wid;p<np;p+=NW) glds16(c2g+p*256+lane*4,(unsigned)__builtin_amdgcn_readfirstlane(lds0+LDS_C2+p*1024)); }
  const __attribute__((address_space(3))) float* c2l=(const __attribute__((address_space(3))) float*)(shm3+LDS_C2)+t0*KVBLK+4*hi;
  DMA_K(0,0);DMA_V(0,0);DMA_K(1,SLOTB);
  bf16x8 qr[4];
  #pragma unroll
  for(int d0=0;d0<4;++d0)qr[d0]=*reinterpret_cast<const bf16x8*>(&Qw[(long)r32*DM+d0*16+hi*8]);
  float l_reg=0.f;f32x16 o[2];o[0]=f32x16{};o[1]=f32x16{};
  float base=c2g[q0+wid*QBLK+r32];
  const int qrel=wid*QBLK+r32;
  #define CMASK(P0,P1,t) do{int jb_=(t)-(NT-4); if(jb_>=0)cmask(P0,P1,jb_,qrel,hi);}while(0)
  bool resc=false;
  #define START(P0,P1) do{ const float rm=rowmax(P0,P1); resc=false; \
    { const float dl=rm; base=fsub_s(base,dl); \
      _Pragma("unroll") for(int r=0;r<16;++r){P0[r]=fsub_s(P0[r],dl);P1[r]=fsub_s(P1[r],dl);} } \
    _Pragma("unroll") for(int r=0;r<16;++r)P0[r]=__builtin_amdgcn_exp2f(P0[r]); }while(0)
  #define RESC() do{ if(resc){ asm volatile("s_waitcnt lgkmcnt(0)":::"memory"); \
      _Pragma("unroll") for(int d_=0;d_<2;++d_) _Pragma("unroll") for(int r=0;r<16;++r)o[d_][r]*=wsf[crow(r,hi)]; } }while(0)
  f32x16 pA0,pA1,pB0,pB1;
  #define BIASLD(P0,P1,tt) do{ _Pragma("unroll") for(int g_=0;g_<4;++g_){ const f32x4v x0_=*(const __attribute__((address_space(3))) f32x4v*)(c2l+(tt)*KVBLK+8*g_), x1_=*(const __attribute__((address_space(3))) f32x4v*)(c2l+(tt)*KVBLK+32+8*g_); \
      P0[4*g_]=x0_[0];P0[4*g_+1]=x0_[1];P0[4*g_+2]=x0_[2];P0[4*g_+3]=x0_[3]; P1[4*g_]=x1_[0];P1[4*g_+1]=x1_[1];P1[4*g_+2]=x1_[2];P1[4*g_+3]=x1_[3]; } }while(0)
  #define BIASFIX(P0,P1) do{ _Pragma("unroll") for(int r=0;r<16;++r){P0[r]=fsub_s(base,P0[r]);P1[r]=fsub_s(base,P1[r]);} }while(0)
  int sl_prev=0,sl_cur=0,sl_next=SLOTB;
  #define ROT() do{sl_prev=sl_cur;sl_cur=sl_next;sl_next=(sl_next==(NSLOT-1)*SLOTB)?0:sl_next+SLOTB;}while(0)
  DMA_K(2,2*SLOTB);
  WAIT_BAR(3);
  BIASLD(pA0,pA1,0); BIASFIX(pA0,pA1);
  qkt(pA0,pA1,Kbase,qr,r32,hi);asm volatile("s_nop 15\n\ts_nop 7":"+v"(pA0),"+v"(pA1));CMASK(pA0,pA1,0);
  START(pA0,pA1);
  _Pragma("unroll") for(int r=0;r<16;++r)pA1[r]=__builtin_amdgcn_exp2f(pA1[r]);
  BIASLD(pB0,pB1,1);
  WAIT_BAR(0);
  DMA_K(3,0);DMA_V(1,SLOTB);
  ROT();
  kload8(kf,kp0+sl_cur);
  WAIT_BAR(2);
  s16x4 vlo[8],vhi[8]; u32x4 pw0,pw1,pw2,pw3;
  #define PKW(P,B) cvtpk_s(P[B],P[B+1])
  #define PAF(k) __builtin_bit_cast(bf16x8,pw##k)
  #define VFR(i) (bf16x8){vlo[i][0],vlo[i][1],vlo[i][2],vlo[i][3],vhi[i][0],vhi[i][1],vhi[i][2],vhi[i][3]}
  #define PIN(x) asm volatile("":"+v"(x))
  #define MX3(a,b,c) __builtin_fmaxf(__builtin_fmaxf((a),(b)),(c))
  #define GAPA(MF,A0,A1,A2,A3,W0,W1,PW) do{ MF; sacc+=A0; sacc+=A1; sacc+=A2; sacc+=A3; PIN(sacc); W0; W1; PIN(PW); SBAR(); }while(0)
  #define EX(v) __builtin_amdgcn_exp2f(v)
  #define GAPB(MF,X,B) do{ MF; X[B]=EX(X[B]); X[B+1]=EX(X[B+1]); X[B+2]=EX(X[B+2]); X[B+3]=EX(X[B+3]); PIN(X); SBAR(); }while(0)
  #define VRD(i) do{ vlo[i]=vtr(vp_+(((i)>>2)*4096+((i)&3)*1024)); vhi[i]=vtr(vp_+(((i)>>2)*4096+((i)&3)*1024+512)); }while(0)
  #define KRD(G,j) do{ if(G){ kload2(kf,kp0+sl_next,j); SBAR(); } }while(0)
  #define STEP(C0,C1,P0,P1,t,GK,GV,GL) do{ SBAR(); \
    BIASFIX(C0,C1); SBAR(); \
    const lds_cptr vp_=vp0+sl_prev; \
    VRD(0); SBAR(); float sacc=(P0[0]+P0[1]); \
    GAPA(C0=__builtin_amdgcn_mfma_f32_32x32x16_bf16(kf[0],qr[0],C0,0,0,0), P0[2],P0[3],P0[4],P0[5],     pw0[0]=PKW(P0,0), pw0[1]=PKW(P0,2), pw0); \
    VRD(4); SBAR(); GAPA(C1=__builtin_amdgcn_mfma_f32_32x32x16_bf16(kf[1],qr[0],C1,0,0,0), P0[6],P0[7],P0[8],P0[9],     pw0[2]=PKW(P0,4), pw0[3]=PKW(P0,6), pw0); \
    VRD(1); SBAR(); GAPA(C0=__builtin_amdgcn_mfma_f32_32x32x16_bf16(kf[2],qr[1],C0,0,0,0),   P0[10],P0[11],P0[12],P0[13], pw1[0]=PKW(P0,8), pw1[1]=PKW(P0,10), pw1); \
    VRD(5); SBAR(); GAPA(C1=__builtin_amdgcn_mfma_f32_32x32x16_bf16(kf[3],qr[1],C1,0,0,0),   P0[14],P0[15],P1[0],P1[1],   pw1[2]=PKW(P0,12),pw1[3]=PKW(P0,14), pw1); \
    VRD(2); SBAR(); GAPA(C0=__builtin_amdgcn_mfma_f32_32x32x16_bf16(kf[4],qr[2],C0,0,0,0),   P1[2],P1[3],P1[4],P1[5],     pw2[0]=PKW(P1,0), pw2[1]=PKW(P1,2), pw2); \
    VRD(6); SBAR(); GAPA(C1=__builtin_amdgcn_mfma_f32_32x32x16_bf16(kf[5],qr[2],C1,0,0,0),   P1[6],P1[7],P1[8],P1[9],     pw2[2]=PKW(P1,4), pw2[3]=PKW(P1,6), pw2); \
    VRD(3); SBAR(); GAPA(C0=__builtin_amdgcn_mfma_f32_32x32x16_bf16(kf[6],qr[3],C0,0,0,0),   P1[10],P1[11],P1[12],P1[13], pw3[0]=PKW(P1,8), pw3[1]=PKW(P1,10), pw3); \
    VRD(7); SBAR(); GAPA(C1=__builtin_amdgcn_mfma_f32_32x32x16_bf16(kf[7],qr[3],C1,0,0,0),   P1[14],P1[15],0.f,0.f,       pw3[2]=PKW(P1,12),pw3[3]=PKW(P1,14), pw3); \
    l_reg+=sacc; \
    if(GL){BIASLD(P0,P1,(t)+1);} \
    if(GK){DMA_K((t)+3,sl_cur);} if(GV){DMA_V((t)+1,sl_next);} \
    CMASK(C0,C1,t); \
    { float a=MX3(C0[0],C0[1],C1[0]),b=MX3(C0[2],C0[3],C1[1]); a=MX3(a,C1[2],C1[3]); \
      _Pragma("unroll") for(int r=4;r<16;r+=4){a=MX3(a,C0[r],C0[r+1]);b=MX3(b,C0[r+2],C0[r+3]);a=MX3(a,C1[r],C1[r+1]);b=MX3(b,C1[r+2],C1[r+3]);} \
      float rm=__builtin_fmaxf(a,b); { auto rr=__builtin_amdgcn_permlane32_swap(__float_as_uint(rm),__float_as_uint(rm),false,false); rm=__builtin_fmaxf(__uint_as_float(rr[0]),__uint_as_float(rr[1])); } \
      resc=false; \
      if(__builtin_expect(__any(rm>(float)THRL),0)){ const float dl=__builtin_fmaxf(rm,0.f); base-=dl; \
        _Pragma("unroll") for(int r=0;r<16;++r){C0[r]-=dl;C1[r]-=dl;} \
        const float f=__builtin_amdgcn_exp2f(-dl); l_reg*=f; if(hi==0)wsf[r32]=f; resc=true; } } \
    SBAR(); \
    GAPB(o[0]=__builtin_amdgcn_mfma_f32_32x32x16_bf16(PAF(0),VFR(0),o[0],0,0,0), C0,0); \
    GAPB(o[1]=__builtin_amdgcn_mfma_f32_32x32x16_bf16(PAF(0),VFR(4),o[1],0,0,0), C0,4); \
    KRD(GL,0); GAPB(o[0]=__builtin_amdgcn_mfma_f32_32x32x16_bf16(PAF(1),VFR(1),o[0],0,0,0), C0,8); \
    KRD(GL,1); GAPB(o[1]=__builtin_amdgcn_mfma_f32_32x32x16_bf16(PAF(1),VFR(5),o[1],0,0,0), C0,12); \
    KRD(GL,2); GAPB(o[0]=__builtin_amdgcn_mfma_f32_32x32x16_bf16(PAF(2),VFR(2),o[0],0,0,0), C1,0); \
    KRD(GL,3); GAPB(o[1]=__builtin_amdgcn_mfma_f32_32x32x16_bf16(PAF(2),VFR(6),o[1],0,0,0), C1,4); \
    GAPB(o[0]=__builtin_amdgcn_mfma_f32_32x32x16_bf16(PAF(3),VFR(3),o[0],0,0,0), C1,8); \
    GAPB(o[1]=__builtin_amdgcn_mfma_f32_32x32x16_bf16(PAF(3),VFR(7),o[1],0,0,0), C1,12); \
    }while(0)
  int t=1;
  #undef CMASK
  #define CMASK(P0,P1,t) do{}while(0)
  for(;t+5<NT;t+=2){
    STEP(pB0,pB1,pA0,pA1,t,true,true,true);     WAIT_BAR(2); RESC(); ROT();
    STEP(pA0,pA1,pB0,pB1,t+1,true,true,true);   WAIT_BAR(2); RESC(); ROT();
  }
  #undef CMASK
  #define CMASK(P0,P1,t) do{int jb_=(t)-(NT-4); if(jb_>=0)cmask(P0,P1,jb_,qrel,hi);}while(0)
  #define ENDW(tt) do{ if((tt)+3<NT){WAIT_BAR(2);} else if((tt)+2<NT){WAIT_BAR(1);} else {WAIT_BAR(0);} }while(0)
  for(;t+1<NT;t+=2){
    STEP(pB0,pB1,pA0,pA1,t,(t+3<NT),(t+1<NT),(t+1<NT));       ENDW(t);   RESC(); ROT();
    STEP(pA0,pA1,pB0,pB1,t+1,(t+4<NT),(t+2<NT),(t+2<NT));     ENDW(t+1); RESC(); ROT();
  }
  STEP(pB0,pB1,pA0,pA1,NT-1,false,false,false); RESC();
  { float sacc=pB0[0]+pB0[1]; _Pragma("unroll") for(int r=2;r<16;++r)sacc+=pB0[r]; _Pragma("unroll") for(int r=0;r<16;++r)sacc+=pB1[r]; l_reg+=sacc;
    pw0=(u32x4){PKW(pB0,0),PKW(pB0,2),PKW(pB0,4),PKW(pB0,6)};pw1=(u32x4){PKW(pB0,8),PKW(pB0,10),PKW(pB0,12),PKW(pB0,14)};pw2=(u32x4){PKW(pB1,0),PKW(pB1,2),PKW(pB1,4),PKW(pB1,6)};pw3=(u32x4){PKW(pB1,8),PKW(pB1,10),PKW(pB1,12),PKW(pB1,14)};
    SBAR(); pv(o,vb0+sl_cur,PAF(0),PAF(1),PAF(2),PAF(3)); }
  #undef PKW
  #undef PAF
  #undef VFR
  #undef PIN
  #undef MX3
  #undef GAPA
  #undef GAPB
  #undef EX
  #undef VRD
  #undef KRD
  #undef STEP
  #undef ENDW
  {auto rr=__builtin_amdgcn_permlane32_swap(__float_as_uint(l_reg),__float_as_uint(l_reg),false,false);l_reg=__uint_as_float(rr[0])+__uint_as_float(rr[1]);}
  if(hi==0)wsf[32+r32]=l_reg;asm volatile("s_waitcnt lgkmcnt(0)":::"memory");
  float rli[16];
  #pragma unroll
  for(int r=0;r<16;++r)rli[r]=__builtin_amdgcn_rcpf(wsf[32+crow(r,hi)]);
  bf16*Ow=O+(rowbase+q0+wid*QBLK)*OP+h*D; const bf16*Gw=Z+(rowbase+q0+wid*QBLK)*DM+1536+h*D;
  { bf16*stg=(bf16*)(shm+LDS_OST)+wid*2048;
    #pragma unroll
    for(int r=0;r<16;++r){const int orow=crow(r,hi);
      #pragma unroll
      for(int d0=0;d0<2;++d0)stg[orow*64+d0*32+r32]=(bf16)f2bf(o[d0][r]*rli[r]);}
    asm volatile("s_waitcnt lgkmcnt(0)":::"memory");
    #pragma unroll
    for(int i=0;i<4;++i){const int row=i*8+(lane>>3),ch=lane&7; const u32x4 v=*(const u32x4*)(stg+row*64+ch*8), g=*(const u32x4*)(Gw+(long)row*DM+ch*8);
      const unsigned vw[4]={v.x,v.y,v.z,v.w},gw[4]={g.x,g.y,g.z,g.w}; unsigned ow[4];
      #pragma unroll
      for(int j=0;j<4;++j){ const float a0=bflo(vw[j])*__builtin_amdgcn_rcpf(1.0f+__expf(-bflo(gw[j]))), a1=bfhi(vw[j])*__builtin_amdgcn_rcpf(1.0f+__expf(-bfhi(gw[j]))); ow[j]=cvtpk_s(a0,a1); }
      ATTN_STORE16(Ow+(long)row*OP+ch*8,((u32x4){ow[0],ow[1],ow[2],ow[3]}));} }
  asm volatile("s_waitcnt lgkmcnt(0)\n\ts_barrier":::"memory");
  #undef DMA_K
  #undef DMA_V
  #undef CMASK
  #undef START
  #undef RESC
  #undef ROT
}
constexpr int ATTN_LDS_BYTES=LDS_BYTES;
#undef SBAR
#undef WAIT_BAR
}
constexpr int CW_QATT = 128;
constexpr int MISC_TAB = 64, MISC_Q = 4096, MISC_PFX = 4160;

__device__ __forceinline__ int attn_t0(KPR P, const float* c2, int q0, int lane) {
    float gq = fabsf(P.q_norm[lane]), gk = fabsf(P.k_norm[lane]);
#pragma unroll
    for (int o = 1; o < 64; o <<= 1) { gq = fmaxf(gq, __shfl_xor(gq, o)); gk = fmaxf(gk, __shfl_xor(gk, o)); }
    const float thr = c2[q0] + (2.0f * 8.0f * LOG2E * gq * gk + 40.0f);
    const int nfull = q0 / 64; int t0 = 0;
    for (int tb = 0; tb < nfull; tb += 64) { const int tt = tb + lane; const bool sk = (tt < nfull) && (c2[tt * 64 + 63] > thr); const unsigned long long bm = __ballot(sk); t0 += __popcll(bm); if (bm != ~0ull) break; }
    return __builtin_amdgcn_readfirstlane(t0) & ~1;
}
__device__ __forceinline__ void combine_row(KPR P, const LAS int* tab, int row, int lane) {
    const int* route = (const int*)(P.ws + WS_ROUTE); const unsigned char* YP = P.ws + WS_YP; bf16_t* X = (bf16_t*)(P.ws + WS_X1);
    f32x4 v[4]; const u32x2* xr = (const u32x2*)(X + (size_t)row * DM) + lane;
#pragma unroll
    for (int j = 0; j < 4; ++j) { const u32x2 xv = xr[64 * j]; v[j] = (f32x4){bflo(xv.x), bfhi(xv.x), bflo(xv.y), bfhi(xv.y)}; }
#pragma unroll
    for (int k = 0; k < 4; ++k) { const int ex = route[(size_t)row * 12 + k], rank = route[(size_t)row * 12 + 4 + k]; const size_t pos = (size_t)tab[pg8::T_BLKSTART + ex] * 256 + rank;
        const unsigned* yr = (const unsigned*)(YP + pos * DM) + lane;
#pragma unroll
        for (int j = 0; j < 4; ++j) { const unsigned y = yr[64 * j]; const f32x2 lo = __builtin_amdgcn_cvt_pk_f32_fp8((int)y, false), hi = __builtin_amdgcn_cvt_pk_f32_fp8((int)y, true);
            v[j][0] += lo[0] * 0.0625f; v[j][1] += lo[1] * 0.0625f; v[j][2] += hi[0] * 0.0625f; v[j][3] += hi[1] * 0.0625f; } }
    u32x2* xo = (u32x2*)(X + (size_t)row * DM) + lane; float s = 0.f;
#pragma unroll
    for (int j = 0; j < 4; ++j) { u32x2 w; w.x = pk2(v[j][0], v[j][1]); w.y = pk2(v[j][2], v[j][3]); xo[64 * j] = w; v[j] = (f32x4){bflo(w.x), bfhi(w.x), bflo(w.y), bfhi(w.y)}; s += (v[j][0] * v[j][0] + v[j][1] * v[j][1]) + (v[j][2] * v[j][2] + v[j][3] * v[j][3]); }
    const float rstd = rsqrtf(wave_sum(s) * (1.f / DM) + 1e-6f);
#pragma unroll
    for (int j = 0; j < 4; ++j) v[j] = v[j] * rstd * ((const f32x4*)P.ple_norm)[64 * j + lane];
    store_row_fp8(P.ws + WS_XN + (size_t)row * DM, lane, v);
}

constexpr int NPHASE = 13;
__global__ void __launch_bounds__(NTHREADS, 2) mega_fwd(Params Pkarg_unused) {
    extern __shared__ __attribute__((aligned(16))) unsigned char smem[];
    LAS unsigned char* lds = (LAS unsigned char*)smem;
    const int tid = threadIdx.x, lane = tid & 63, wave = __builtin_amdgcn_readfirstlane(tid >> 6);
    const int G = gridDim.x, blk = blockIdx.x;
#define P (*kpp)
#ifndef MK_REP
#define MK_REP -1
#endif
#define PHASE_BEGIN(k) if (IN(k)) for (int rep_ = 0; rep_ < ((k) == MK_REP ? 2 : 1); ++rep_) { const __attribute__((address_space(4))) Params* kpp = kp_fresh();
#define PHASE_END(k) } if (BOTH(k)) xcd_barrier(bar);
#define IN(k) (ph_lo <= (k) && (k) < ph_hi)
#define BOTH(k) (IN(k) && IN((k) + 1))
    const __attribute__((address_space(4))) Params* kpp = kp_fresh();
    unsigned* ctl = (unsigned*)(P.ws + WS_CTL);
    volatile LAS unsigned* MISC = (volatile LAS unsigned*)(lds + MISC_OFF);
    LAS int* tab = (LAS int*)(lds + MISC_OFF + MISC_TAB);
    if (tid < 16) MISC[tid] = 0u;
    __syncthreads();
    XcdBarrier bar = xcd_barrier_post(ctl + CW_BAR, MISC);
    unsigned char* const wsb = P.ws;
    const int ph_lo = P.ph_lo, ph_hi = P.ph_hi;

    PHASE_BEGIN(0)
        phase_prep_weights(P, lds, blk * NWAVES + wave, G * NWAVES, wave, lane);
        phase_cvt_p(P, blk * NTHREADS + tid, G * NTHREADS);
        __syncthreads();
        LAS float* wff = (LAS float*)lds; LAS float* lf = (LAS float*)(lds + 32768);
        load_wff(P, wff, tid, NTHREADS); __syncthreads();
        for (int i = 0; i < 16; ++i) { const int rl = wave * 16 + i; norm1_row(P, blk * 128 + rl, lane, wff, lf + rl * 8); }
        __syncthreads();
        if (tid < 8) { float run = 0.f; float* cloc = (float*)(P.ws + WS_LOGF) + (size_t)blk * 128 * 8 + tid;
            for (int r = 0; r < 128; ++r) { run += lf[r * 8 + tid]; cloc[r * 8] = run; }
            ((float*)(P.ws + WS_CTOT))[blk * 8 + tid] = run; }
        if (blk >= G - 16) rt::build_w(P, blk - (G - 16), tid);
    PHASE_END(0)

    PHASE_BEGIN(1)
        {
            LAS float* pfx = (LAS float*)(lds + MISC_OFF + MISC_PFX);
            if (tid < 64) { const float* ct = (const float*)(wsb + WS_CTOT); const int j = (blk & ~63) + tid; float v8[8];
#pragma unroll
                for (int h = 0; h < 8; ++h) v8[h] = (j < blk) ? ct[j * 8 + h] : 0.f;
#pragma unroll
                for (int h = 0; h < 8; ++h) { const float s = wave_sum(v8[h]); if (tid == 0) pfx[h] = s; } }
            __syncthreads();
            const float* cloc = (const float*)(wsb + WS_LOGF) + (size_t)blk * 128 * 8; float* c2 = (float*)(P.ws + WS_C2);
            for (int i = tid; i < 1024; i += NTHREADS) { const int r = i >> 3, h = i & 7; const int row = blk * 128 + r, b = row >> 13, t = row & (SEQ - 1);
                c2[((size_t)(b * 8 + h)) * SEQ + t] = (cloc[i] + pfx[h]) * LOG2E; }
            __syncthreads();
        }
        {
            pg8::DenseOrder S{(const bf16_t*)(wsb + WS_XN), (const bf16_t*)(wsb + WS_WIN), 1024, NTOK / 256, ZW / 256, G, blk};
            pg8::EpiIn E{(bf16_t*)(P.ws + WS_Z), P.q_norm, P.k_norm};
            pg8::gemm_phase<pg8::EpiIn, pg8::DenseOrder, true>(lds, 1024, S, E);
        }
        {
            pg8::DenseOrder S{(const bf16_t*)((unsigned char*)P.out + DO_PB), (const bf16_t*)(wsb + WS_WPP), PLE, NTOK / 256, DM / 256, G / 2, blk >= G / 2 ? blk - G / 2 : (1 << 20)};
            pg8::EpiBf16 E{(bf16_t*)((unsigned char*)P.out + DO_PJ), DM};
            pg8::gemm_phase<pg8::EpiBf16, pg8::DenseOrder, true>(lds, PLE, S, E);
        }
    PHASE_END(1)

    PHASE_BEGIN(2)
        for (int task = wave * G + blk; task < NTOK / 32; task += NWAVES * G) rk::lora_task(P, task, lane);
    PHASE_END(2)

    PHASE_BEGIN(3)
        for (int task = blk; task < NB * NH * rk::NCHUNK; task += G) rk::pass1_chunk(P, lds, task >> 7, task & 127, tid);
    PHASE_END(3)

    PHASE_BEGIN(4)
        if (blk < NB * NH) rk::pass2_seq(P, lds, blk, tid);
        for (;;) {
            __syncthreads();
            if (tid == 0) MISC[MISC_Q / 4] = __hip_atomic_fetch_add(ctl + CW_QATT + 64 * rep_, 1u, RLX_AGENT);
            __syncthreads();
            const int q = (int)MISC[MISC_Q / 4];
            if (q >= 1024) break;
            { const int bh = q & 31, qb = 31 - (q >> 5); const float* c2 = (const float*)(wsb + WS_C2) + (size_t)bh * SEQ;
              const int t0 = attn_t0(P, c2, qb * 256, lane);
              attn_body::attn_unit<8>(bh >> 3, bh & 7, qb, t0, (const bf16_t*)(wsb + WS_Z), c2, (bf16_t*)(P.ws + WS_AO), (char*)smem); }
        }
    PHASE_END(4)

    PHASE_BEGIN(5)
        for (int task = blk; task < NB * NH * rk::NCHUNK; task += G) rk::pass3_chunk(P, lds, task >> 7, task & 127, tid);
    PHASE_END(5)

    PHASE_BEGIN(6)
        pg8::DenseOrder S{(const bf16_t*)(wsb + WS_AO), (const bf16_t*)(wsb + WS_WOUT), 1024, NTOK / 256, DM / 256, G, blk};
        pg8::EpiOut E{P.x, (bf16_t*)(P.ws + WS_X1)};
        pg8::gemm_phase<pg8::EpiOut, pg8::DenseOrder, true>(lds, 1024, S, E);
    PHASE_END(6)

    PHASE_BEGIN(7)
        rt::copy_w(P, lds, tid);
        if (blk == 0 && tid < 256) ((unsigned*)(P.ws + WS_XN + (size_t)NTOK * DM))[tid] = 0u;
        __syncthreads();
        for (int task = wave * G + blk; task < NTOK / 32; task += NWAVES * G) rt::route_task(P, lds, task, lane);
    PHASE_END(7)

    PHASE_BEGIN(8)
        const int nblk = pg8::moe_tables(tab, (const unsigned*)(wsb + WS_CTL) + CW_CNT);
        pg8::MoeOrder S{wsb + WS_XN, wsb + WS_WGU, (const int*)(wsb + WS_TOKSLOT), (const float*)(wsb + WS_GATESLOT), tab, nblk, 8, G, blk, true};
        pg8::EpiGu E{P.ws + WS_ACT, P.b_gu};
        pg8::gemm_phase<pg8::EpiGu, pg8::MoeOrder, true, true>(lds, 1024, S, E);
    PHASE_END(8)
    PHASE_BEGIN(9)
        const int nblk = pg8::moe_tables(tab, (const unsigned*)(wsb + WS_CTL) + CW_CNT);
        pg8::MoeOrder S{wsb + WS_ACT, wsb + WS_WDN, (const int*)(wsb + WS_TOKSLOT), (const float*)(wsb + WS_GATESLOT), tab, nblk, 4, G, blk, false};
        pg8::EpiDn E{P.ws + WS_YP, P.b_down, (const float*)(wsb + WS_GATESLOT), tab};
        pg8::gemm_phase<pg8::EpiDn, pg8::MoeOrder, true, true>(lds, 1024, S, E);
    PHASE_END(9)
    PHASE_BEGIN(10)
        (void)pg8::moe_tables(tab, (const unsigned*)(wsb + WS_CTL) + CW_CNT);
        for (int row = blk * NWAVES + wave; row < NTOK; row += G * NWAVES) combine_row(P, tab, row, lane);
    PHASE_END(10)
    PHASE_BEGIN(11)
        pg8::DenseOrder S{wsb + WS_XN, wsb + WS_WPG, 512, NTOK / 256, DM / 256, G, blk};
        pg8::EpiPg E{(bf16_t*)(P.ws + WS_X1), (const bf16_t*)((unsigned char*)P.out + DO_PJ)};
        pg8::gemm_phase<pg8::EpiPg, pg8::DenseOrder, true, true>(lds, 1024, S, E);
    PHASE_END(11)
    PHASE_BEGIN(12)
        const bool dead = __hip_atomic_load(ctl + CW_BAR + XB_TMO, RLX_AGENT) != 0u;
        for (int row = blk * NWAVES + wave; row < NTOK; row += G * NWAVES) final_row(P, row, lane, dead);
    PHASE_END(12)
}
#undef P
extern "C" void kernel_launch(void* const* d_in, const int* in_sizes, int n_in, void* d_out, int out_size, void* d_ws, size_t ws_size, hipStream_t stream) {
    static int ok = 0;
    if (ok == 0) {
        if (n_in != 30 || in_sizes[0] != NTOK * DM || out_size != NTOK * DM || ws_size < WS_END) { fprintf(stderr, "kernel_launch: unexpected shapes (n_in %d, ws %zu)\n", n_in, ws_size); ok = -1; return; }
        if (hipFuncSetAttribute((const void*)mega_fwd, hipFuncAttributeMaxDynamicSharedMemorySize, LDS_BYTES) != hipSuccess) { fprintf(stderr, "kernel_launch: hipFuncSetAttribute failed\n"); ok = -1; return; }
        int dev = 0, cus = 0, per_cu = 0;
        if (hipGetDevice(&dev) != hipSuccess || hipDeviceGetAttribute(&cus, hipDeviceAttributeMultiprocessorCount, dev) != hipSuccess) { ok = -1; return; }
        if (hipOccupancyMaxActiveBlocksPerMultiprocessor(&per_cu, (const void*)mega_fwd, NTHREADS, LDS_BYTES) != hipSuccess || per_cu < 1) { fprintf(stderr, "kernel_launch: occupancy query says %d\n", per_cu); }
        (void)hipGetLastError();
        if (cus != 256) { fprintf(stderr, "kernel_launch: built for 256 CUs, device has %d\n", cus); ok = -1; return; }
        ok = 1;
    }
    if (ok < 0) return;
    Params P{};
    const float** pp = (const float**)&P;
    for (int i = 0; i < 30; ++i) pp[i] = (const float*)d_in[i];
    P.out = (float*)d_out; P.ws = (unsigned char*)d_ws;
    if (hipMemsetAsync((char*)d_ws + WS_CTL, 0, CTL_BYTES, stream) != hipSuccess) return;
#ifndef MK_CUTS
#define MK_CUTS 0
#endif
    if (MK_CUTS == 0) { P.ph_lo = 0; P.ph_hi = NPHASE; hipLaunchKernelGGL(mega_fwd, dim3(256), dim3(NTHREADS), LDS_BYTES, stream, P); }
    else for (int k = 0; k < NPHASE; ++k) { P.ph_lo = k; P.ph_hi = k + 1;
        hipLaunchKernelGGL(mega_fwd, dim3(256), dim3(NTHREADS), LDS_BYTES, stream, P); }
}
```

```cpp
#include <hip/hip_runtime.h>
#include <cstdio>
#include <cstdint>

#define LAS __attribute__((address_space(3)))
#define GAS __attribute__((address_space(1)))
typedef unsigned short bf16_t;
typedef short bf16x8 __attribute__((ext_vector_type(8)));
typedef float f32x2 __attribute__((ext_vector_type(2)));
typedef float f32x4 __attribute__((ext_vector_type(4)));
typedef float f32x16 __attribute__((ext_vector_type(16)));
typedef unsigned u32x2 __attribute__((ext_vector_type(2)));
typedef unsigned u32x4 __attribute__((ext_vector_type(4)));

constexpr int NB = 4, SEQ = 8192, NTOK = NB * SEQ, DM = 1024;
constexpr int NH = 8, HD = 64;
constexpr int INW = 3848;
constexpr int ZW = 3840;
constexpr int ZQ = 0, ZK = 512, ZV = 1024, ZOG = 1536, ZR = 2048;
constexpr int RW_R = 0, RW_K = 512, RW_V = 1024, RW_W = 1536, RW_A = 1600, RW_G = 1664, RWIN = 1792;
constexpr int NE = 32, TOPK = 4, EFF = 1024;
constexpr int MAXBLK = (NTOK * TOPK) / 256 + NE;
constexpr int PLE = 256;
constexpr float LOG2E = 1.4426950408889634f;
constexpr float QSCALE = 0.125f * LOG2E;

constexpr size_t MiB = 1u << 20;
constexpr size_t WS_CTL = 0, CTL_BYTES = 1 * MiB;
constexpr size_t WS_C2 = 1 * MiB;
constexpr size_t WS_LOGF = 2 * MiB;
constexpr size_t WS_ROUTE = 3 * MiB;
constexpr size_t WS_TOKSLOT = 5 * MiB;
constexpr size_t WS_GATESLOT = 9 * MiB;
constexpr size_t WS_CTOT = 13 * MiB;
constexpr size_t WS_WIN = 16 * MiB;
constexpr size_t WS_WOUT = 24 * MiB;
constexpr size_t WS_WPG = 26 * MiB;
constexpr size_t WS_WPP = 28 * MiB;
constexpr size_t WS_WGU = 32 * MiB;
constexpr size_t WS_WDN = 160 * MiB;
constexpr size_t WS_XN = 224 * MiB;
constexpr size_t WS_X1 = 290 * MiB;
constexpr size_t WS_Z = 418 * MiB;
constexpr size_t WS_AO = 658 * MiB;
constexpr size_t WS_ACT = 418 * MiB;
constexpr size_t WS_RW = 722 * MiB;
constexpr size_t WS_RR = WS_RW, WS_RK = WS_RW + 32 * MiB, WS_RV = WS_RW + 64 * MiB, WS_RG = WS_RW + 96 * MiB;
constexpr size_t WS_RLW = WS_RW + 128 * MiB;
constexpr size_t WS_RKK = WS_RW + 160 * MiB, WS_RKA = WS_RW + 192 * MiB;
constexpr size_t WS_YP = 722 * MiB;
constexpr size_t WS_END = 994 * MiB;
static_assert(WS_ACT + (size_t)MAXBLK * 256 * 1024 * 2 <= WS_RW && WS_YP + (size_t)MAXBLK * 256 * 1024 * 2 <= WS_END, "ws map");
constexpr size_t DO_PJ = 0, DO_PB = 64 * MiB;
constexpr int CW_TMO = 0, CW_CNT = 64  , CW_BAR = 4096;

struct Params {
    const float *x, *p, *mix_norm, *w_in, *f_bias, *q_norm, *k_norm, *mu, *w0, *w2, *a0, *a2, *g2, *k_k, *k_a, *r_k, *ln_w, *ln_b, *w_out, *moe_norm, *w_router, *b_router, *w_gu, *b_gu, *w_down,
        *b_down, *ple_norm, *w_pg, *w_pp, *final_norm;
    float* out; unsigned char* ws; int ph_lo, ph_hi;
};

typedef const __attribute__((address_space(4))) Params& KPR;
__device__ __forceinline__ const __attribute__((address_space(4))) Params* kp_fresh() {
    unsigned long long p = (unsigned long long)__builtin_amdgcn_kernarg_segment_ptr(); asm volatile("" : "+s"(p)); return (const __attribute__((address_space(4))) Params*)p; }

typedef __bf16 bf16x2_hw __attribute__((ext_vector_type(2)));
__device__ __forceinline__ unsigned pk2(float lo, float hi) { const f32x2 v = {lo, hi}; return __builtin_bit_cast(unsigned, __builtin_convertvector(v, bf16x2_hw)); }
__device__ __forceinline__ unsigned f2bf(float f) { return pk2(f, f) & 0xffffu; }
__device__ __forceinline__ float bf2f(unsigned h) { return __builtin_bit_cast(float, h << 16); }
__device__ __forceinline__ float bflo(unsigned w) { return __builtin_bit_cast(float, w << 16); }
__device__ __forceinline__ float bfhi(unsigned w) { return __builtin_bit_cast(float, w & 0xffff0000u); }
__device__ __forceinline__ unsigned cvt_pk_bf16(float lo, float hi) { unsigned r; asm volatile("v_cvt_pk_bf16_f32 %0, %1, %2" : "=v"(r) : "v"(lo), "v"(hi)); return r; }
__device__ __forceinline__ unsigned pk4_fp8(float a, float b, float c, float d) { int w = 0; w = __builtin_amdgcn_cvt_pk_fp8_f32(a, b, w, false); w = __builtin_amdgcn_cvt_pk_fp8_f32(c, d, w, true); return (unsigned)w; }
#define DPP_ADD(v, ctrl) ((v) + __builtin_bit_cast(float, __builtin_amdgcn_mov_dpp(__builtin_bit_cast(int, (v)), (ctrl), 0xF, 0xF, true)))
__device__ __forceinline__ float wave_sum(float v) {
    v = DPP_ADD(v, 0xB1);
    v = DPP_ADD(v, 0x4E);
    v = DPP_ADD(v, 0x124);
    v = DPP_ADD(v, 0x128);
    { float a = v, b = v; asm volatile("s_nop 1\n\tv_permlane16_swap_b32 %0, %1" : "+v"(a), "+v"(b)); v = a + b; }
    { float a = v, b = v; asm volatile("s_nop 1\n\tv_permlane32_swap_b32 %0, %1" : "+v"(a), "+v"(b)); v = a + b; }
    return v;
}
__device__ __forceinline__ float sigmoidf_(float x) { return __builtin_amdgcn_rcpf(1.0f + __expf(-x)); }
__device__ __forceinline__ float logsigmoidf_(float x) { return fminf(x, 0.f) - log1pf(expf(-fabsf(x))); }
namespace pg8 {
constexpr int BM = 256, BK = 64, HALF = 128, HTB = HALF * BK * 2, STAGE_BYTES = 8 * HTB, NXCD = 8, WGM = 8;
__host__ __device__ __forceinline__ int lds_byte(int r, int c) { const int st = (r >> 4) * 2 + (c >> 5), rr = r & 15, cc = c & 31, ob = rr * 64 + cc * 2; return st * 1024 + (ob ^ (((ob >> 9) & 1) << 5)); }
__host__ __device__ __forceinline__ void stage_rc(int b, int& R, int& C) { const int st = b / 1024, sb = b % 1024, swz = sb ^ (((sb >> 9) & 1) << 5); R = (st >> 1) * 16 + swz / 64; C = (st & 1) * 32 + (swz % 64) / 2; }
__host__ __device__ __forceinline__ int perm32(int rho) { const int n = rho >> 4, i = rho & 15; return 8 * (i >> 2) + 4 * n + (i & 3); }

struct Unit { int pm, pn, e, lb, sl; };

__device__ __forceinline__ bool tile_order(int i, int G, int c, int nM, int nN, int& pm, int& pn) {
    const int nwg = nM * nN; const long L = (long)i * G + c; if (L >= nwg) return false;
    int wgid = (int)L; { const int q = nwg / NXCD, r = nwg % NXCD, xcd = wgid % NXCD, off = wgid / NXCD; wgid = (xcd < r ? xcd * (q + 1) : r * (q + 1) + (xcd - r) * q) + off; }
    const int nig = WGM * nN, gid = wgid / nig, fm = gid * WGM, gsz = (nM - fm) < WGM ? (nM - fm) : WGM;
    pm = fm + ((wgid % nig) % gsz); pn = (wgid % nig) / gsz; return true;
}
struct DenseOrder {
    const void* A; const void* Bt; int K  , nM, nN, G, c;
    __device__ __forceinline__ bool next(int i, Unit& u) const { u.e = 0; u.lb = 0; return tile_order(i, G, c, nM, nN, u.pm, u.pn); }
    __device__ __forceinline__ const char* a_base(const Unit& u) const { return (const char*)A + (size_t)u.pm * BM * K * 2; }
    __device__ __forceinline__ const char* b_base(const Unit& u) const { return (const char*)Bt + (size_t)u.pn * BM * K * 2; }
    __device__ __forceinline__ void prefetch(const Unit&, int, int, int) const {}
    __device__ __forceinline__ void a_off(const Unit&, const int (&R)[2], const int (&C)[2], unsigned (&off)[2][2]) const {
#pragma unroll
        for (int h = 0; h < 2; ++h)
#pragma unroll
            for (int i = 0; i < 2; ++i) off[h][i] = (unsigned)((R[i] + HALF * h) * K + C[i]) * 2u;
    }
};

typedef int v8i32 __attribute__((ext_vector_type(8)));
typedef int i32x4 __attribute__((ext_vector_type(4)));
template <class Epi, class Sched, bool ALIGN_EPI, bool FP8 = false>
__device__ __forceinline__ void gemm_phase(LAS unsigned char* lds, const int K, const Sched& S, const Epi& E) {
    int tid_ = threadIdx.x; asm volatile("" : "+v"(tid_));
    const int tid = tid_, wid = __builtin_amdgcn_readfirstlane(tid >> 6), lane = tid & 63, wr = wid >> 2, wc = wid & 3, fr = lane & 15, fq = lane >> 4;
    const int RB = FP8 ? K : 2 * K;
    const int nt = RB / (BK * 2);
    int sR[2], sC[2]; unsigned voffB[2];
#pragma unroll
    for (int i = 0; i < 2; ++i) { int R, C; stage_rc(tid * 16 + i * 8192, R, C); const int Rb = Epi::PERM ? ((R & ~31) + perm32(R & 31)) : R; sR[i] = R; sC[i] = C; voffB[i] = (unsigned)(Rb * RB + C * 2); }
    const size_t kstep = (size_t)(BK * 2);
    const size_t hstep = (size_t)HALF * RB;
    const unsigned ldsw = (unsigned)wid * 1024u;
    const int aoff0 = FP8 ? lds_byte(wr * 64 + fr, fq * 16) : lds_byte(wr * 64 + fr, fq * 8), aoff1 = FP8 ? lds_byte(wr * 64 + fr, fq * 16 + 8) : aoff0 + 1024;
    const int boff0 = FP8 ? lds_byte(wc * 32 + fr, fq * 16) : lds_byte(wc * 32 + fr, fq * 8), boff1 = FP8 ? lds_byte(wc * 32 + fr, fq * 16 + 8) : boff0 + 1024;
#define PG8_SA(b, h) (((b) * 2 + (h)) * HTB)
#define PG8_SB(b, h) ((4 + (b) * 2 + (h)) * HTB)
#define PG8_STAGE(bufoff, gbase, voff) do { _Pragma("unroll") for (int _i = 0; _i < 2; ++_i) \
        __builtin_amdgcn_global_load_lds((const unsigned*)((const char*)(gbase) + (voff)[_i]), (LAS unsigned*)(lds + (bufoff) + ldsw + _i * 8192), 16, 0, 0); } while (0)
#define PG8_CAT(p0, p1) __builtin_shufflevector((p0), (p1), 0, 1, 2, 3, 4, 5, 6, 7)
#define PG8_LDA(dst, b, h) do { _Pragma("unroll") for (int m = 0; m < 4; ++m) dst[m] = PG8_CAT(*(const LAS i32x4*)(lds + PG8_SA(b, h) + aoff0 + m * 2048), *(const LAS i32x4*)(lds + PG8_SA(b, h) + aoff1 + m * 2048)); } while (0)
#define PG8_LDB(dst, b, h) do { _Pragma("unroll") for (int n = 0; n < 2; ++n) dst[n] = PG8_CAT(*(const LAS i32x4*)(lds + PG8_SB(b, h) + boff0 + n * 2048), *(const LAS i32x4*)(lds + PG8_SB(b, h) + boff1 + n * 2048)); } while (0)
#define PG8_LO(x) __builtin_bit_cast(bf16x8, __builtin_shufflevector((x), (x), 0, 1, 2, 3))
#define PG8_HI(x) __builtin_bit_cast(bf16x8, __builtin_shufflevector((x), (x), 4, 5, 6, 7))
#define PG8_MMA(ai, bj, At, Bt) do { __builtin_amdgcn_s_setprio(1); \
        if constexpr (FP8) { _Pragma("unroll") for (int m = 0; m < 4; ++m) _Pragma("unroll") for (int n = 0; n < 2; ++n) \
            asm volatile("v_mfma_scale_f32_16x16x128_f8f6f4 %0, %1, %2, %0, %3, %4 op_sel_hi:[0,0,0]" : "+v"(acc[ai][bj][m][n]) : "v"(Bt[n]), "v"(At[m]), "v"(sc_w), "v"(sc_x)); } \
        else { _Pragma("unroll") for (int m = 0; m < 4; ++m) _Pragma("unroll") for (int n = 0; n < 2; ++n) { \
            acc[ai][bj][m][n] = __builtin_amdgcn_mfma_f32_16x16x32_bf16(PG8_LO(Bt[n]), PG8_LO(At[m]), acc[ai][bj][m][n], 0, 0, 0); } \
            _Pragma("unroll") for (int m = 0; m < 4; ++m) _Pragma("unroll") for (int n = 0; n < 2; ++n) { \
            acc[ai][bj][m][n] = __builtin_amdgcn_mfma_f32_16x16x32_bf16(PG8_HI(Bt[n]), PG8_HI(At[m]), acc[ai][bj][m][n], 0, 0, 0); } } \
        __builtin_amdgcn_s_setprio(0); } while (0)
#define PG8_WAIT_V(n) asm volatile("s_waitcnt vmcnt(" #n ")" ::: "memory")
#define PG8_WAIT_L(n) asm volatile("s_waitcnt lgkmcnt(" #n ")" ::: "memory")
#define PG8_BAR __builtin_amdgcn_s_barrier()
#define PG8_SCHED __builtin_amdgcn_sched_barrier(0)
    Unit cur, nxt; int ui = 0;
    if (!S.next(0, cur)) return;
    f32x4 acc[2][2][4][2];
#pragma unroll
    for (int a = 0; a < 2; ++a)
#pragma unroll
        for (int b = 0; b < 2; ++b)
#pragma unroll
            for (int m = 0; m < 4; ++m)
#pragma unroll
                for (int n = 0; n < 2; ++n) acc[a][b][m][n] = (f32x4){0.f, 0.f, 0.f, 0.f};
    const int sc_w = 121, sc_x = 127;
    v8i32 At[4], B0[2], B1[2];
    unsigned offC[2][2], offN[2][2];
    cur.sl = 0; S.prefetch(cur, 0, wid, lane); PG8_WAIT_V(0); PG8_BAR;
    S.a_off(cur, sR, sC, offC);
    const char* cA = S.a_base(cur); const char* cB = S.b_base(cur);
    PG8_STAGE(PG8_SB(0, 0), cB, voffB); PG8_STAGE(PG8_SB(0, 1), cB + hstep, voffB); PG8_STAGE(PG8_SA(0, 0), cA, offC[0]); PG8_STAGE(PG8_SA(0, 1), cA, offC[1]);
    if (wr == 1) PG8_BAR;
    PG8_WAIT_V(2); PG8_BAR;
    PG8_STAGE(PG8_SB(1, 0), cB + kstep, voffB); PG8_STAGE(PG8_SA(1, 0), cA + kstep, offC[0]); PG8_STAGE(PG8_SB(1, 1), cB + hstep + kstep, voffB);
    PG8_WAIT_V(6); PG8_BAR;
    for (;;) {
        const bool has_next = S.next(ui + 1, nxt);
        const char* nA = cA; const char* nB = cB;
        nxt.sl = cur.sl == 2 ? 0 : cur.sl + 1;
        if (has_next) { nA = S.a_base(nxt); nB = S.b_base(nxt); S.prefetch(nxt, nxt.sl, wid, lane); }
#pragma unroll
        for (int h = 0; h < 2; ++h)
#pragma unroll
            for (int i = 0; i < 2; ++i) offN[h][i] = offC[h][i];
#pragma nounroll
        for (int t = 0; t < nt; t += 2) {
            const bool last = (t == nt - 2);
            if (last && has_next) S.a_off(nxt, sR, sC, offN);
            const char* a1 = cA + (size_t)(t + 1) * kstep;
            const char* a2 = last ? nA : cA + (size_t)(t + 2) * kstep; const char* b2 = last ? nB : cB + (size_t)(t + 2) * kstep;
            const char* a3 = a2 + kstep; const char* b3 = b2 + kstep;
            unsigned o2[2][2];
#pragma unroll
            for (int h = 0; h < 2; ++h)
#pragma unroll
                for (int i = 0; i < 2; ++i) o2[h][i] = last ? offN[h][i] : offC[h][i];
            PG8_LDB(B0, 0, 0); PG8_LDB(B1, 0, 1); PG8_SCHED; PG8_LDA(At, 0, 0); PG8_STAGE(PG8_SA(1, 1), a1, offC[1]);
            PG8_WAIT_V(8); PG8_WAIT_L(0); PG8_BAR; PG8_MMA(0, 0, At, B0); PG8_MMA(0, 1, At, B1); PG8_BAR; PG8_SCHED;
            PG8_LDA(At, 0, 1); PG8_STAGE(PG8_SB(0, 0), b2, voffB); PG8_STAGE(PG8_SB(0, 1), b2 + hstep, voffB); PG8_STAGE(PG8_SA(0, 0), a2, o2[0]);
            PG8_WAIT_V(8); PG8_WAIT_L(0); PG8_BAR; PG8_MMA(1, 0, At, B0); PG8_MMA(1, 1, At, B1); PG8_BAR; PG8_SCHED;
            PG8_LDB(B0, 1, 0); PG8_LDB(B1, 1, 1); PG8_SCHED; PG8_LDA(At, 1, 0); PG8_STAGE(PG8_SA(0, 1), a2, o2[1]);
            PG8_WAIT_V(8); PG8_WAIT_L(0); PG8_BAR; PG8_MMA(0, 0, At, B0); PG8_MMA(0, 1, At, B1); PG8_BAR; PG8_SCHED;
            PG8_LDA(At, 1, 1); PG8_STAGE(PG8_SB(1, 0), b3, voffB); PG8_STAGE(PG8_SB(1, 1), b3 + hstep, voffB); PG8_STAGE(PG8_SA(1, 0), a3, o2[0]);
            PG8_WAIT_V(8); PG8_WAIT_L(0); PG8_BAR; PG8_MMA(1, 0, At, B0); PG8_MMA(1, 1, At, B1); PG8_BAR; PG8_SCHED;
        }
        if constexpr (ALIGN_EPI) { if (wr == 0) PG8_BAR; }
        E(acc, cur, wr, wc, fr, fq);
        if (!has_next) break;
#pragma unroll
        for (int a = 0; a < 2; ++a)
#pragma unroll
            for (int b = 0; b < 2; ++b)
#pragma unroll
                for (int m = 0; m < 4; ++m)
#pragma unroll
                    for (int n = 0; n < 2; ++n) acc[a][b][m][n] = (f32x4){0.f, 0.f, 0.f, 0.f};
        cur = nxt; cA = nA; cB = nB; ++ui;
#pragma unroll
        for (int h = 0; h < 2; ++h)
#pragma unroll
            for (int i = 0; i < 2; ++i) offC[h][i] = offN[h][i];
        if constexpr (ALIGN_EPI) { if (wr == 1) PG8_BAR; }
    }
    PG8_WAIT_V(0);
    if constexpr (!ALIGN_EPI) { if (wr == 0) PG8_BAR; }
    PG8_BAR;
#undef PG8_SA
#undef PG8_SB
#undef PG8_STAGE
#undef PG8_LDA
#undef PG8_LDB
#undef PG8_MMA
#undef PG8_LO
#undef PG8_HI
#undef PG8_CAT
#undef PG8_WAIT_V
#undef PG8_WAIT_L
#undef PG8_BAR
#undef PG8_SCHED
}
}
namespace pg8 {
constexpr int T_BLKSTART = 0  , T_CNT = 40  , T_BLKE = 80  , T_WORDS = 80 + 560;
constexpr int TB_OFF = 8192 - 64;

struct EpiIn {
    static constexpr bool PERM = true;
    bf16_t* Z; const float* qn; const float* kn;
    __device__ __forceinline__ void operator()(const f32x4 (&acc)[2][2][4][2], const Unit& u, int wr, int wc, int fr, int fq) const {
        const int row0 = u.pm * BM + wr * 64 + fr;
        if (u.pn < 4) {
            const float* g = (u.pn < 2) ? qn : kn; const float sc = (u.pn < 2) ? QSCALE : 1.0f;
            f32x4 gv[2][2];
#pragma unroll
            for (int bj = 0; bj < 2; ++bj)
#pragma unroll
                for (int n = 0; n < 2; ++n) gv[bj][n] = *(const f32x4*)(g + 32 * bj + 8 * fq + 4 * n) * sc;
#pragma unroll
            for (int ai = 0; ai < 2; ++ai)
#pragma unroll
                for (int m = 0; m < 4; ++m) {
                    float ss = 0.f;
#pragma unroll
                    for (int bj = 0; bj < 2; ++bj)
#pragma unroll
                        for (int n = 0; n < 2; ++n) { const f32x4 x = acc[ai][bj][m][n]; ss += (x[0] * x[0] + x[1] * x[1]) + (x[2] * x[2] + x[3] * x[3]); }
                    ss += __shfl_xor(ss, 16); ss += __shfl_xor(ss, 32);
                    const float rstd = rsqrtf(ss * (1.0f / 64.0f) + 1e-6f);
                    bf16_t* rowp = Z + (size_t)(row0 + ai * HALF + m * 16) * ZW + u.pn * BM + 64 * wc + 8 * fq;
#pragma unroll
                    for (int bj = 0; bj < 2; ++bj) { const f32x4 v0 = acc[ai][bj][m][0] * rstd * gv[bj][0], v1 = acc[ai][bj][m][1] * rstd * gv[bj][1];
                        u32x4 w; w.x = cvt_pk_bf16(v0[0], v0[1]); w.y = cvt_pk_bf16(v0[2], v0[3]); w.z = cvt_pk_bf16(v1[0], v1[1]); w.w = cvt_pk_bf16(v1[2], v1[3]);
                        *(u32x4*)(rowp + 32 * bj) = w; }
                }
        } else {
            const int col0 = u.pn * BM + wc * 32 + 8 * fq;
#pragma unroll
            for (int ai = 0; ai < 2; ++ai)
#pragma unroll
                for (int m = 0; m < 4; ++m) { bf16_t* rowp = Z + (size_t)(row0 + ai * HALF + m * 16) * ZW + col0;
#pragma unroll
                    for (int bj = 0; bj < 2; ++bj) { const f32x4 v0 = acc[ai][bj][m][0], v1 = acc[ai][bj][m][1];
                        u32x4 w; w.x = cvt_pk_bf16(v0[0], v0[1]); w.y = cvt_pk_bf16(v0[2], v0[3]); w.z = cvt_pk_bf16(v1[0], v1[1]); w.w = cvt_pk_bf16(v1[2], v1[3]);
                        *(u32x4*)(rowp + bj * HALF) = w; } }
        }
    }
};
struct EpiBf16 {
    static constexpr bool PERM = true;
    bf16_t* O; int ldc;
    __device__ __forceinline__ void operator()(const f32x4 (&acc)[2][2][4][2], const Unit& u, int wr, int wc, int fr, int fq) const {
        const int row0 = u.pm * BM + wr * 64 + fr, col0 = u.pn * BM + wc * 32 + 8 * fq;
#pragma unroll
        for (int ai = 0; ai < 2; ++ai)
#pragma unroll
            for (int m = 0; m < 4; ++m) { bf16_t* rowp = O + (size_t)(row0 + ai * HALF + m * 16) * ldc + col0;
#pragma unroll
                for (int bj = 0; bj < 2; ++bj) { const f32x4 v0 = acc[ai][bj][m][0], v1 = acc[ai][bj][m][1];
                    u32x4 w; w.x = cvt_pk_bf16(v0[0], v0[1]); w.y = cvt_pk_bf16(v0[2], v0[3]); w.z = cvt_pk_bf16(v1[0], v1[1]); w.w = cvt_pk_bf16(v1[2], v1[3]);
                    *(u32x4*)(rowp + bj * HALF) = w; } }
    }
};
struct EpiOut {
    static constexpr bool PERM = true;
    const float* X; bf16_t* O;
    __device__ __forceinline__ void operator()(const f32x4 (&acc)[2][2][4][2], const Unit& u, int wr, int wc, int fr, int fq) const {
        const int row0 = u.pm * BM + wr * 64 + fr, col0 = u.pn * BM + wc * 32 + 8 * fq;
#pragma unroll
        for (int ai = 0; ai < 2; ++ai)
#pragma unroll
            for (int m = 0; m < 4; ++m) { const size_t off = (size_t)(row0 + ai * HALF + m * 16) * DM + col0;
#pragma unroll
                for (int bj = 0; bj < 2; ++bj) { const f32x4 v0 = *(const f32x4*)(X + off + bj * HALF) + acc[ai][bj][m][0], v1 = *(const f32x4*)(X + off + bj * HALF + 4) + acc[ai][bj][m][1];
                    u32x4 w; w.x = pk2(v0[0], v0[1]); w.y = pk2(v0[2], v0[3]); w.z = pk2(v1[0], v1[1]); w.w = pk2(v1[2], v1[3]);
                    *(u32x4*)(O + off + bj * HALF) = w; }
                if (m & 1) asm volatile("" ::: "memory"); }
    }
};
struct EpiPg {
    static constexpr bool PERM = true;
    bf16_t* X; const bf16_t* PJ;
    __device__ __forceinline__ void operator()(const f32x4 (&acc)[2][2][4][2], const Unit& u, int wr, int wc, int fr, int fq) const {
        const int row0 = u.pm * BM + wr * 64 + fr, col0 = u.pn * BM + wc * 32 + 8 * fq;
#pragma unroll
        for (int ai = 0; ai < 2; ++ai)
#pragma unroll
            for (int m = 0; m < 4; ++m) { const size_t off = (size_t)(row0 + ai * HALF + m * 16) * DM + col0;
#pragma unroll
                for (int bj = 0; bj < 2; ++bj) { const size_t o = off + bj * HALF; const u32x4 pj = *(const u32x4*)(PJ + o), xv = *(const u32x4*)(X + o);
                    const unsigned pw[4] = {pj.x, pj.y, pj.z, pj.w}, xw[4] = {xv.x, xv.y, xv.z, xv.w}; unsigned ow[4];
#pragma unroll
                    for (int q = 0; q < 4; ++q) { const float a0 = acc[ai][bj][m][q >> 1][2 * (q & 1)], a1 = acc[ai][bj][m][q >> 1][2 * (q & 1) + 1];
                        ow[q] = pk2(bflo(xw[q]) + sigmoidf_(a0) * bflo(pw[q]), bfhi(xw[q]) + sigmoidf_(a1) * bfhi(pw[q])); }
                    *(u32x4*)(X + o) = (u32x4){ow[0], ow[1], ow[2], ow[3]}; }
                if (m & 1) asm volatile("" ::: "memory"); }
    }
};
struct EpiGu {
    static constexpr bool PERM = true;
    unsigned char* ACT; const float* b_gu;
    __device__ __forceinline__ void operator()(const f32x4 (&acc)[2][2][4][2], const Unit& u, int wr, int wc, int fr, int fq) const {
        const int row0 = u.pm * BM + wr * 64 + fr, cl = u.pn * HALF + wc * 32 + 8 * fq;
        const float* bg = b_gu + (size_t)u.e * 2048 + cl;
        f32x4 bgl[2], bli[2];
#pragma unroll
        for (int n = 0; n < 2; ++n) { bgl[n] = *(const f32x4*)(bg + 4 * n); bli[n] = *(const f32x4*)(bg + 1024 + 4 * n); }
#pragma unroll
        for (int ai = 0; ai < 2; ++ai)
#pragma unroll
            for (int m = 0; m < 4; ++m) { unsigned char* rowp = ACT + (size_t)(row0 + ai * HALF + m * 16) * EFF + cl; float r[8];
#pragma unroll
                for (int n = 0; n < 2; ++n)
#pragma unroll
                    for (int i = 0; i < 4; ++i) { const float gl = fminf(acc[ai][0][m][n][i] + bgl[n][i], 7.0f); const float li = fminf(fmaxf(acc[ai][1][m][n][i] + bli[n][i], -7.0f), 7.0f);
                        r[4 * n + i] = gl * sigmoidf_(1.702f * gl) * (li + 1.0f); }
                u32x2 w; w.x = pk4_fp8(r[0], r[1], r[2], r[3]); w.y = pk4_fp8(r[4], r[5], r[6], r[7]);
                *(u32x2*)rowp = w; }
    }
};
struct EpiDn {
    static constexpr bool PERM = true;
    unsigned char* YP; const float* b_dn; const float* gateslot; const LAS int* tab;
    __device__ __forceinline__ void operator()(const f32x4 (&acc)[2][2][4][2], const Unit& u, int wr, int wc, int fr, int fq) const {
        const int row0 = u.pm * BM + wr * 64 + fr, col0 = u.pn * BM + wc * 32 + 8 * fq;
        const float* bd = b_dn + (size_t)u.e * 1024 + col0; const int cnt = tab[T_CNT + u.e];
        f32x4 bv[2][2];
#pragma unroll
        for (int bj = 0; bj < 2; ++bj)
#pragma unroll
            for (int n = 0; n < 2; ++n) bv[bj][n] = *(const f32x4*)(bd + bj * HALF + 4 * n);
#pragma unroll
        for (int ai = 0; ai < 2; ++ai)
#pragma unroll
            for (int m = 0; m < 4; ++m) { const int rr = wr * 64 + fr + ai * HALF + m * 16, slot = u.lb * 256 + rr;
                const float gt = slot < cnt ? ((const LAS float*)((const LAS unsigned char*)tab + TB_OFF + u.sl * 1024))[rr] * 16.0f : 0.f;
                unsigned char* rowp = YP + (size_t)(row0 + ai * HALF + m * 16) * DM + col0;
#pragma unroll
                for (int bj = 0; bj < 2; ++bj) { const f32x4 v0 = (acc[ai][bj][m][0] + bv[bj][0]) * gt, v1 = (acc[ai][bj][m][1] + bv[bj][1]) * gt;
                    u32x2 w; w.x = pk4_fp8(v0[0], v0[1], v0[2], v0[3]); w.y = pk4_fp8(v1[0], v1[1], v1[2], v1[3]);
                    *(u32x2*)(rowp + bj * HALF) = w; } }
    }
};
struct MoeOrder {
    const unsigned char* A; const unsigned char* Bt; const int* tokslot; const float* gateslot;   const LAS int* tab; int nblk, nN, G, c; bool gather;
    __device__ __forceinline__ bool next(int i, Unit& u) const { if (!tile_order(i, G, c, nblk, nN, u.pm, u.pn)) return false; u.e = tab[T_BLKE + u.pm]; u.lb = u.pm - tab[T_BLKSTART + u.e]; return true; }
    __device__ __forceinline__ const char* a_base(const Unit& u) const { return gather ? (const char*)A : (const char*)A + (size_t)u.pm * BM * 1024; }
    __device__ __forceinline__ const char* b_base(const Unit& u) const { return (const char*)Bt + ((size_t)u.e * nN + u.pn) * BM * 1024; }
    __device__ __forceinline__ void prefetch(const Unit& u, int slot, int wid, int lane) const {
        if (wid < 4) { const unsigned* src = (gather ? (const unsigned*)tokslot : (const unsigned*)gateslot) + (size_t)u.e * NTOK + u.lb * 256 + wid * 64 + lane;
            __builtin_amdgcn_global_load_lds(src, (LAS unsigned*)((LAS unsigned char*)tab + TB_OFF + slot * 1024 + wid * 256), 4, 0, 0); }
    }
    __device__ __forceinline__ void a_off(const Unit& u, const int (&R)[2], const int (&C)[2], unsigned (&off)[2][2]) const {
        const int cnt = tab[T_CNT + u.e]; const LAS int* tb = (const LAS int*)((const LAS unsigned char*)tab + TB_OFF + u.sl * 1024);
#pragma unroll
        for (int h = 0; h < 2; ++h)
#pragma unroll
            for (int i = 0; i < 2; ++i) {
                if (gather) { const int rr = R[i] + HALF * h; const int tk = tb[rr]; const int tok = (u.lb * 256 + rr) < cnt ? tk : NTOK; off[h][i] = (unsigned)tok * 1024u + (unsigned)C[i] * 2u; }
                else off[h][i] = (unsigned)((R[i] + HALF * h) * 1024 + C[i] * 2);
            }
    }
};
__device__ __forceinline__ int moe_tables(LAS int* tab, const unsigned* cntw) {
    if (threadIdx.x == 0) { int s = 0; for (int e = 0; e < NE; ++e) { const int c = (int)cntw[e]; tab[T_CNT + e] = c; tab[T_BLKSTART + e] = s; const int nb = (c + 255) >> 8; for (int j = 0; j < nb; ++j) tab[T_BLKE + s + j] = e; s += nb; } tab[T_BLKSTART + NE] = s; }
    __syncthreads();
    return tab[T_BLKSTART + NE];
}
}
constexpr int NWAVES = 8, NTHREADS = 512;
constexpr int RING_BYTES = 131072, MISC_OFF = RING_BYTES, LDS_BYTES = 147456;

__device__ __forceinline__ void tr_item(const float* W, int ldw, int srccol0, int k0, bf16_t* WT, int Kd, int dstrow0, LAS float* scr, int lane) {
#pragma unroll 8
    for (int i = 0; i < 32; ++i) { const int kk = 2 * i + (lane >> 5); scr[kk * 33 + (lane & 31)] = W[(size_t)(k0 + kk) * ldw + srccol0 + (lane & 31)]; }
    asm volatile("s_waitcnt lgkmcnt(0)" ::: "memory");
    const int c = lane & 7;
#pragma unroll
    for (int j = 0; j < 4; ++j) { const int n = (lane >> 3) + 8 * j; const LAS float* s = scr + (8 * c) * 33 + n;
        u32x4 o; o.x = pk2(s[0 * 33], s[1 * 33]); o.y = pk2(s[2 * 33], s[3 * 33]); o.z = pk2(s[4 * 33], s[5 * 33]); o.w = pk2(s[6 * 33], s[7 * 33]);
        *(u32x4*)(WT + (size_t)(dstrow0 + n) * Kd + k0 + 8 * c) = o; }
    asm volatile("s_waitcnt lgkmcnt(0)" ::: "memory");
}
__device__ __forceinline__ void tr_item8(const float* W, int ldw, int srccol0, int k0, unsigned char* WT, int Kd, int dstrow0, LAS float* scr, int lane) {
#pragma unroll 8
    for (int i = 0; i < 32; ++i) { const int kk = 2 * i + (lane >> 5); scr[kk * 33 + (lane & 31)] = W[(size_t)(k0 + kk) * ldw + srccol0 + (lane & 31)]; }
    asm volatile("s_waitcnt lgkmcnt(0)" ::: "memory");
    const int c = lane & 7;
#pragma unroll
    for (int j = 0; j < 4; ++j) { const int n = (lane >> 3) + 8 * j; const LAS float* s = scr + (8 * c) * 33 + n;
        u32x2 o; o.x = pk4_fp8(s[0 * 33] * 64.f, s[1 * 33] * 64.f, s[2 * 33] * 64.f, s[3 * 33] * 64.f); o.y = pk4_fp8(s[4 * 33] * 64.f, s[5 * 33] * 64.f, s[6 * 33] * 64.f, s[7 * 33] * 64.f);
        *(u32x2*)(WT + (size_t)(dstrow0 + n) * Kd + k0 + 8 * c) = o; }
    asm volatile("s_waitcnt lgkmcnt(0)" ::: "memory");
}
constexpr int I_IN = 16 * 120, I_OUT = 16 * 32, I_PG = 16 * 32, I_PP = 4 * 32, I_GU1 = 16 * 64, I_DN1 = 16 * 32;
constexpr int I_LORA = 16 + 16 + 32;
constexpr int I_SMALL = I_IN + I_OUT + I_PG + I_PP + I_LORA, I_GU = NE * I_GU1, I_DN = NE * I_DN1, I_ALL = I_SMALL + I_GU + I_DN;
__device__ __forceinline__ void prep_item(KPR P, int it, LAS float* scr, int lane) {
    unsigned char* ws = P.ws;
    if (it < I_IN) { const int kb = it / 120, nb = it % 120, n0 = nb * 32, pn = n0 >> 8, j0 = n0 & 255;
        const int src = pn < 4 ? (pn * 256 + 64 * ((j0 & 127) >> 5) + 32 * (j0 >> 7)) : (n0 < 2048 ? n0 : n0 + 8);
        tr_item(P.w_in, INW, src, kb * 64, (bf16_t*)(ws + WS_WIN), 1024, n0, scr, lane); return; }
    it -= I_IN;
    if (it < I_OUT) { tr_item(P.w_out, 1024, (it % 32) * 32, (it / 32) * 64, (bf16_t*)(ws + WS_WOUT), 1024, (it % 32) * 32, scr, lane); return; }
    it -= I_OUT;
    if (it < I_PG) { tr_item8(P.w_pg, 1024, (it % 32) * 32, (it / 32) * 64, ws + WS_WPG, 1024, (it % 32) * 32, scr, lane); return; }
    it -= I_PG;
    if (it < I_PP) { tr_item(P.w_pp, 1024, (it % 32) * 32, (it / 32) * 64, (bf16_t*)(ws + WS_WPP), 256, (it % 32) * 32, scr, lane); return; }
    it -= I_PP;
    if (it < 16) { tr_item(P.w2, 512, it * 32, 0, (bf16_t*)(ws + 29 * MiB), 64, it * 32, scr, lane); return; }
    it -= 16;
    if (it < 16) { tr_item(P.a2, 512, it * 32, 0, (bf16_t*)(ws + 29 * MiB + 65536), 64, it * 32, scr, lane); return; }
    it -= 16;
    if (it < 32) { tr_item(P.g2, 512, (it % 16) * 32, (it / 16) * 64, (bf16_t*)(ws + 29 * MiB + 131072), 128, (it % 16) * 32, scr, lane); return; }
    it -= 32;
    if (it < I_GU) { const int e = it / I_GU1, r = it % I_GU1, kb = r / 64, nb = r % 64, n0 = nb * 32, pn = n0 >> 8, j0 = n0 & 255;
        const int src = (j0 >> 7) * 1024 + pn * 128 + (j0 & 127);
        tr_item8(P.w_gu + (size_t)e * 1024 * 2048, 2048, src, kb * 64, ws + WS_WGU + (size_t)e * 2048 * 1024, 1024, n0, scr, lane); return; }
    it -= I_GU;
    { const int e = it / I_DN1, r = it % I_DN1, kb = r / 32, nb = r % 32;
        tr_item8(P.w_down + (size_t)e * 1024 * 1024, 1024, nb * 32, kb * 64, ws + WS_WDN + (size_t)e * 1024 * 1024, 1024, nb * 32, scr, lane); }
}
__device__ __forceinline__ void phase_prep_weights(KPR P, LAS unsigned char* lds, int gw, int ngw, int wave, int lane) {
    LAS float* scr = (LAS float*)(lds + wave * 16384);
    for (int it = gw; it < I_ALL; it += ngw) prep_item(P, it, scr, lane);
}
__device__ __forceinline__ void phase_cvt_p(KPR P, int gt, int ngt) {
    bf16_t* PB = (bf16_t*)((unsigned char*)P.out + DO_PB);
    for (int i = gt; i < NTOK * PLE / 8; i += ngt) { const f32x4 a = ((const f32x4*)P.p)[2 * i], b = ((const f32x4*)P.p)[2 * i + 1];
        u32x4 w; w.x = pk2(a[0], a[1]); w.y = pk2(a[2], a[3]); w.z = pk2(b[0], b[1]); w.w = pk2(b[2], b[3]); ((u32x4*)PB)[i] = w; }
}
__device__ __forceinline__ void rms_row(const float* xrow, const float* gain, int lane, f32x4 (&v)[4]) {
    const f32x4* xr = (const f32x4*)xrow + lane; float s = 0.f;
#pragma unroll
    for (int j = 0; j < 4; ++j) { v[j] = xr[64 * j]; s += (v[j][0] * v[j][0] + v[j][1] * v[j][1]) + (v[j][2] * v[j][2] + v[j][3] * v[j][3]); }
    const float rstd = rsqrtf(wave_sum(s) * (1.f / DM) + 1e-6f);
#pragma unroll
    for (int j = 0; j < 4; ++j) v[j] = v[j] * rstd * ((const f32x4*)gain)[64 * j + lane];
}
__device__ __forceinline__ void store_row_fp8(unsigned char* orow, int lane, const f32x4 (&v)[4]) {
    unsigned* o4 = (unsigned*)orow + lane;
#pragma unroll
    for (int j = 0; j < 4; ++j) o4[64 * j] = pk4_fp8(v[j][0], v[j][1], v[j][2], v[j][3]);
}
__device__ __forceinline__ void store_row_bf16(bf16_t* orow, int lane, const f32x4 (&v)[4]) {
    u32x2* o8 = (u32x2*)orow + lane;
#pragma unroll
    for (int j = 0; j < 4; ++j) { u32x2 w; w.x = pk2(v[j][0], v[j][1]); w.y = pk2(v[j][2], v[j][3]); o8[64 * j] = w; }
}
__device__ __forceinline__ void norm1_row(KPR P, int row, int lane, const LAS float* wff, LAS float* lf_out  ) {
    f32x4 v[4]; rms_row(P.x + (size_t)row * DM, P.mix_norm, lane, v);
    store_row_bf16((bf16_t*)(P.ws + WS_XN) + (size_t)row * DM, lane, v);
    float ff[8];
#pragma unroll
    for (int q = 0; q < 8; ++q) { float s = 0.f;
#pragma unroll
        for (int j = 0; j < 4; ++j) { const f32x4 w = *(const LAS f32x4*)(wff + q * 1024 + 4 * (64 * j + lane)); s += (v[j][0] * w[0] + v[j][1] * w[1]) + (v[j][2] * w[2] + v[j][3] * w[3]); }
        ff[q] = s; }
    float g4[4], g2[2], g1;
    { const bool up = lane & 32;
#pragma unroll
        for (int q = 0; q < 4; ++q) { const float keep = up ? ff[4 + q] : ff[q], give = up ? ff[q] : ff[4 + q]; g4[q] = keep + __shfl_xor(give, 32); } }
    { const bool up = lane & 16;
#pragma unroll
        for (int q = 0; q < 2; ++q) { const float keep = up ? g4[2 + q] : g4[q], give = up ? g4[q] : g4[2 + q]; g2[q] = keep + __shfl_xor(give, 16); } }
    { const bool up = lane & 8; const float keep = up ? g2[1] : g2[0], give = up ? g2[0] : g2[1]; g1 = keep + __shfl_xor(give, 8); }
    g1 += __shfl_xor(g1, 4); g1 += __shfl_xor(g1, 2); g1 += __shfl_xor(g1, 1);
    if ((lane & 7) == 0) { const int q = lane >> 3; lf_out[q] = logsigmoidf_(g1 + P.f_bias[q]); }
}
__device__ __forceinline__ void load_wff(KPR P, LAS float* wff, int tid, int nthr) {
    for (int i = tid; i < 1024 * 8; i += nthr) wff[(i & 7) * 1024 + (i >> 3)] = P.w_in[(size_t)(i >> 3) * INW + 2048 + (i & 7)];
}
__device__ __forceinline__ void final_row(KPR P, int row, int lane, bool dead) {
    const u32x2* xr = (const u32x2*)((const bf16_t*)(P.ws + WS_X1) + (size_t)row * DM) + lane; f32x4 v[4]; float s = 0.f;
#pragma unroll
    for (int j = 0; j < 4; ++j) { const u32x2 xv = xr[64 * j]; v[j] = (f32x4){bflo(xv.x), bfhi(xv.x), bflo(xv.y), bfhi(xv.y)}; s += (v[j][0] * v[j][0] + v[j][1] * v[j][1]) + (v[j][2] * v[j][2] + v[j][3] * v[j][3]); }
    const float rstd = rsqrtf(wave_sum(s) * (1.f / DM) + 1e-6f);
    f32x4* o = (f32x4*)(P.out + (size_t)row * DM) + lane;
#pragma unroll
    for (int j = 0; j < 4; ++j) { v[j] = v[j] * rstd * ((const f32x4*)P.final_norm)[64 * j + lane]; if (dead) { const float q = __builtin_nanf(""); v[j] = (f32x4){q, q, q, q}; } o[64 * j] = v[j]; }
}
typedef GAS unsigned gu32;
#define RLX_AGENT __ATOMIC_RELAXED, __HIP_MEMORY_SCOPE_AGENT
#define XB_TMO      128
#define XB_XCNT(j)  (256  + 64 * (j))
#define XB_XSUB(j)  (1280 + 64 * (j))
#define XB_XGEN(j)  (2304 + 64 * (j))
#define XB_TOP      3328
#define XB_TOPGEN   3392
#define XCD_BAR_WORDS 3456
#define XB_SPIN_CAP (1u << 22)

__device__ __forceinline__ unsigned xb_ld(unsigned* p)              { return __hip_atomic_load(p, __ATOMIC_RELAXED, __HIP_MEMORY_SCOPE_AGENT); }
__device__ __forceinline__ unsigned xb_add(unsigned* p, unsigned v) { return __hip_atomic_fetch_add(p, v, __ATOMIC_RELAXED, __HIP_MEMORY_SCOPE_AGENT); }
__device__ __forceinline__ unsigned xb_xcc_id() { return (unsigned)__builtin_amdgcn_s_getreg((3 << 11) | 20) & 0xFu; }
#define XB_SPIN(cond, bar) do { unsigned _sp = 0; while (cond) { __builtin_amdgcn_s_sleep(1); \
    if ((++_sp & 255u) == 0u) { if (xb_ld(&(bar)[XB_TMO])) break; if (_sp > XB_SPIN_CAP) { atomicAdd(&(bar)[XB_TMO], 1u); break; } } } } while (0)

struct XcdBarrier { unsigned* bar; unsigned x; volatile LAS unsigned* st; };

__device__ __forceinline__ XcdBarrier xcd_barrier_post(unsigned* bar, volatile LAS unsigned* st) {
    XcdBarrier b; b.bar = bar; b.x = xb_xcc_id(); b.st = st;
    if (threadIdx.x == 0) (void)xb_add(&bar[XB_XCNT(b.x)], 1u);
    return b;
}
__device__ __forceinline__ void xcd_barrier_complete(unsigned* bar, unsigned x, unsigned& nloc, unsigned& nx) {
    const unsigned G = gridDim.x * gridDim.y * gridDim.z;
    unsigned sum, cnt, mine, sp = 0u;
    for (;;) {
        sum = 0u; cnt = 0u; mine = 0u;
#pragma unroll
        for (unsigned j = 0; j < 16; ++j) { const unsigned c = xb_ld(&bar[XB_XCNT(j)]); sum += c; cnt += (c > 0u) ? 1u : 0u; mine = (j == x) ? c : mine; }
        if (sum == G) break;
        __builtin_amdgcn_s_sleep(1);
        if ((++sp & 255u) == 0u) { if (xb_ld(&bar[XB_TMO])) break; if (sp > XB_SPIN_CAP) { atomicAdd(&bar[XB_TMO], 1u); break; } }
    }
    nloc = mine > 0u ? mine : 1u; nx = cnt > 0u ? cnt : 1u;
}
__device__ __forceinline__ void xcd_barrier(const XcdBarrier& b) {
    asm volatile("s_waitcnt vmcnt(0)" ::: "memory");
    __syncthreads();
    if (threadIdx.x == 0) {
        unsigned* bar = b.bar;
        __builtin_amdgcn_s_waitcnt(0);
        unsigned nloc = b.st[0], nx = b.st[1];
        if (nloc == 0u) { xcd_barrier_complete(bar, b.x, nloc, nx); b.st[0] = nloc; b.st[1] = nx; }
        const unsigned old = xb_add(&bar[XB_XSUB(b.x)], 1u);
        const unsigned gen = old / nloc;
        if (old + 1u == (gen + 1u) * nloc) {
            __builtin_amdgcn_fence(__ATOMIC_RELEASE, "agent");
            asm volatile("s_waitcnt vmcnt(0)" ::: "memory");
            const unsigned og = xb_add(&bar[XB_TOP], 1u);
            const unsigned tg = og / nx;
            if (og + 1u == (tg + 1u) * nx) xb_add(&bar[XB_TOPGEN], 1u);
            else XB_SPIN(xb_ld(&bar[XB_TOPGEN]) == tg, bar);
            __builtin_amdgcn_fence(__ATOMIC_ACQUIRE, "agent");
            xb_add(&bar[XB_XGEN(b.x)], 1u);
            asm volatile("s_waitcnt vmcnt(0)" ::: "memory");
        } else {
            XB_SPIN(xb_ld(&bar[XB_XGEN(b.x)]) == gen, bar);
            __builtin_amdgcn_fence(__ATOMIC_ACQUIRE, "agent");
            asm volatile("s_waitcnt vmcnt(0)" ::: "memory");
        }
    }
    __syncthreads();
}
namespace rk {
constexpr int MB = 8192;
constexpr int S_AT = 0, S_RT = 1, S_KT = 2, S_BT = 3, S_ATT = 4, S_KTT = 5, S_BTT = 6, S_VT = 7, S_N = 8, S_NT = 9, S_MAK = 10, S_MRB = 11, S_MRK = 12, S_TA = 13, S_TB = 14;
constexpr int SCR = 15 * MB;
constexpr int NCHUNK = SEQ / 64;
constexpr size_t WS_HT = WS_X1;
constexpr size_t WS_Y0 = WS_X1 + 64 * MiB;
constexpr size_t WS_QI = WS_X1 + 96 * MiB;
constexpr size_t WS_LW = WS_RW, WS_LA = WS_RW + 32 * MiB, WS_LG = WS_RW + 64 * MiB;
constexpr size_t WS_SC = WS_RW + 224 * MiB;
constexpr size_t DO_GT = 80 * MiB;
static_assert(WS_SC + 32 * MiB <= WS_END, "rwkv blobs");

__device__ __forceinline__ int moff(int row, int col) { return row * 128 + ((((col >> 3) ^ (row >> 1)) & 7) << 4) + (col & 7) * 2; }
__device__ __forceinline__ int crow(int r, int hi) { return (r & 3) + 8 * (r >> 2) + 4 * hi; }
__device__ __forceinline__ f32x16 mm_nt(const LAS unsigned char* A, int ar0, const LAS unsigned char* Bt, int br0, f32x16 acc, int r32, int hi) {
#pragma unroll
    for (int ks = 0; ks < 4; ++ks) { const bf16x8 a = *(const LAS bf16x8*)(A + moff(ar0 + r32, 16 * ks + 8 * hi)), b = *(const LAS bf16x8*)(Bt + moff(br0 + r32, 16 * ks + 8 * hi));
        acc = __builtin_amdgcn_mfma_f32_32x32x16_bf16(a, b, acc, 0, 0, 0); }
    return acc;
}
__device__ __forceinline__ void store_t(LAS unsigned char* dst, const f32x16& acc, int i0, int j0, int r32, int hi) {
#pragma unroll
    for (int g = 0; g < 4; ++g) { u32x2 w; w.x = pk2(acc[4 * g], acc[4 * g + 1]); w.y = pk2(acc[4 * g + 2], acc[4 * g + 3]); *(LAS u32x2*)(dst + moff(j0 + r32, i0 + 8 * g + 4 * hi)) = w; }
}
template <int MODE> __device__ __forceinline__ void mask_tri(f32x16& acc, int i0, int j0, int r32, int hi) {
#pragma unroll
    for (int r = 0; r < 16; ++r) { const int i = i0 + crow(r, hi), j = j0 + r32; const bool keep = MODE == 0 ? (j < i) : (MODE == 1 ? (i < j) : (i <= j)); if (!keep) acc[r] = 0.f; }
}

__device__ __forceinline__ void pass1_chunk(KPR P, LAS unsigned char* lds, int bh, int c, int tid) {
    const int lane = tid & 63, wave = tid >> 6, r32 = lane & 31, hi = lane >> 5, grp = wave >> 2, wq = wave & 3, i0 = 32 * (wq >> 1), j0 = 32 * (wq & 1);
    const int b = bh >> 3, h = bh & 7; const size_t tok0 = (size_t)b * SEQ + (size_t)c * 64; const size_t ci = (size_t)bh * NCHUNK + c;
    LAS float* part = (LAS float*)(lds + SCR); LAS float* WL = (LAS float*)(lds + SCR + 2048);
#define MAT(s) (lds + (s) * MB)
    {
        const bf16_t* Z = (const bf16_t*)(P.ws + WS_Z); const bf16_t* LW = (const bf16_t*)(P.ws + WS_LW); const bf16_t* LA = (const bf16_t*)(P.ws + WS_LA);
        const int ch = tid & 63, tq = tid >> 6, cc = h * 64 + ch; const size_t row0 = tok0 + 8 * tq;
        const float mur = P.mu[RW_R + cc], muk = P.mu[RW_K + cc], muv = P.mu[RW_V + cc], w0c = P.w0[cc], a0c = P.a0[cc], kkc = P.k_k[cc], kac = P.k_a[cc];
        const bf16_t* zp = Z + row0 * ZW + ZR + cc;
        const bool first = (c == 0) && (tq == 0); const bf16_t* zq = first ? zp : zp - ZW; const float pm = first ? 0.f : 1.f;
        unsigned short lr[9], lk[9], lv[9], llw[8], lla[8];
        lr[0] = zq[RW_R]; lk[0] = zq[RW_K]; lv[0] = zq[RW_V];
#pragma unroll
        for (int i = 0; i < 8; ++i) { const bf16_t* zi = zp + (size_t)i * ZW; lr[i + 1] = zi[RW_R]; lk[i + 1] = zi[RW_K]; lv[i + 1] = zi[RW_V]; const size_t o = (row0 + i) * 512 + cc; llw[i] = LW[o]; lla[i] = LA[o]; }
        float cum[8], vr[8], vk[8], vkk[8], vka[8], ssq[8]; unsigned short vv16[8]; float run = 0.f;
#pragma unroll
        for (int i = 0; i < 8; ++i) { const float pmi = (i == 0) ? pm : 1.f; const float zr1 = bf2f(lr[i + 1]), zk1 = bf2f(lk[i + 1]), zv1 = bf2f(lv[i + 1]);
            vr[i] = zr1 + (bf2f(lr[i]) * pmi - zr1) * mur; vk[i] = zk1 + (bf2f(lk[i]) * pmi - zk1) * muk; vv16[i] = (unsigned short)f2bf(zv1 + (bf2f(lv[i]) * pmi - zv1) * muv);
            vkk[i] = vk[i] * kkc; ssq[i] = vkk[i] * vkk[i]; }
#pragma unroll
        for (int i = 0; i < 8; ++i) ssq[i] = wave_sum(ssq[i]);
#pragma unroll
        for (int i = 0; i < 8; ++i) {
            const float wl = w0c + bf2f(llw[i]); const float sp = fmaxf(-wl, 0.f) + __logf(1.0f + __expf(-fabsf(wl)));
            run += -__expf(-sp - 0.5f); cum[i] = run;
            const float a = __builtin_amdgcn_rcpf(1.0f + __expf(-(a0c + bf2f(lla[i]))));
            const float kk = vkk[i] * __builtin_amdgcn_rcpf(fmaxf(__builtin_amdgcn_sqrtf(ssq[i]), 1e-12f));
            vk[i] = vk[i] * (1.0f + (a - 1.0f) * kac); vkk[i] = kk; vka[i] = kk * a; }
        part[tq * 64 + ch] = run;
        __syncthreads();
        float pre = 0.f;
#pragma unroll
        for (int g = 0; g < 8; ++g) { const float pvv = part[g * 64 + ch]; pre += (g < tq) ? pvv : 0.f; }
        float eprev = __expf(pre);
        unsigned atT[4], ktT[4], btT[4], vT[4]; unsigned short hold[4] = {0, 0, 0, 0};
#pragma unroll
        for (int i = 0; i < 8; ++i) { const int t = 8 * tq + i;
            const float cm = pre + cum[i], e1 = __expf(cm), einv = __expf(-cm);
            const unsigned short at = (unsigned short)f2bf(-vkk[i] * eprev), rt = (unsigned short)f2bf(vr[i] * e1), kt = (unsigned short)f2bf(vk[i] * einv), bt = (unsigned short)f2bf(vka[i] * einv), vv = vv16[i];
            eprev = e1;
            *(LAS unsigned short*)(MAT(S_AT) + moff(t, ch)) = at; *(LAS unsigned short*)(MAT(S_RT) + moff(t, ch)) = rt; *(LAS unsigned short*)(MAT(S_KT) + moff(t, ch)) = kt; *(LAS unsigned short*)(MAT(S_BT) + moff(t, ch)) = bt;
            if (i & 1) { atT[i >> 1] = hold[0] | ((unsigned)at << 16); ktT[i >> 1] = hold[1] | ((unsigned)kt << 16); btT[i >> 1] = hold[2] | ((unsigned)bt << 16); vT[i >> 1] = hold[3] | ((unsigned)vv << 16); }
            else { hold[0] = at; hold[1] = kt; hold[2] = bt; hold[3] = vv; }
            if (i == 7 && tq == 7) WL[ch] = e1; }
        *(LAS u32x4*)(MAT(S_ATT) + moff(ch, 8 * tq)) = (u32x4){atT[0], atT[1], atT[2], atT[3]}; *(LAS u32x4*)(MAT(S_KTT) + moff(ch, 8 * tq)) = (u32x4){ktT[0], ktT[1], ktT[2], ktT[3]};
        *(LAS u32x4*)(MAT(S_BTT) + moff(ch, 8 * tq)) = (u32x4){btT[0], btT[1], btT[2], btT[3]}; *(LAS u32x4*)(MAT(S_VT) + moff(ch, 8 * tq)) = (u32x4){vT[0], vT[1], vT[2], vT[3]};
    }
    __syncthreads();
    const f32x16 zero = f32x16{};
    if (grp == 0) { f32x16 d = mm_nt(MAT(S_AT), i0, MAT(S_BT), j0, zero, r32, hi); mask_tri<0>(d, i0, j0, r32, hi); store_t(MAT(S_NT), d, i0, j0, r32, hi);
        d = mm_nt(MAT(S_KT), i0, MAT(S_AT), j0, zero, r32, hi); mask_tri<1>(d, i0, j0, r32, hi); store_t(MAT(S_MAK), d, i0, j0, r32, hi);
        d = mm_nt(MAT(S_KT), i0, MAT(S_RT), j0, zero, r32, hi); mask_tri<2>(d, i0, j0, r32, hi); store_t(MAT(S_MRK), d, i0, j0, r32, hi); }
    else { f32x16 d = mm_nt(MAT(S_BT), i0, MAT(S_AT), j0, zero, r32, hi); mask_tri<1>(d, i0, j0, r32, hi); store_t(MAT(S_N), d, i0, j0, r32, hi);
#pragma unroll
        for (int r = 0; r < 16; ++r) if (i0 + crow(r, hi) == j0 + r32) d[r] = 1.0f;
        store_t(MAT(S_TA), d, i0, j0, r32, hi);
        d = mm_nt(MAT(S_BT), i0, MAT(S_RT), j0, zero, r32, hi); mask_tri<2>(d, i0, j0, r32, hi); store_t(MAT(S_MRB), d, i0, j0, r32, hi); }
    __syncthreads();
#pragma unroll
    for (int s = 1; s <= 6; ++s) {
        const int mc = (s & 1) ? S_N : S_AT, mcT = (s & 1) ? S_NT : S_KT, mn = (s & 1) ? S_AT : S_N, mnT = (s & 1) ? S_KT : S_NT;
        const int tc = (s & 1) ? S_TB : S_TA, tn = (s & 1) ? S_TA : S_TB;
        if (s <= 5) {
            if (grp == 0) { const f32x16 d = mm_nt(MAT(mc), i0, MAT(mcT), j0, zero, r32, hi); store_t(MAT(mnT), d, i0, j0, r32, hi); }
            else { const f32x16 d = mm_nt(MAT(mcT), i0, MAT(mc), j0, zero, r32, hi); store_t(MAT(mn), d, i0, j0, r32, hi); }
        }
        if (s >= 2 && grp == (s <= 5 ? 0 : 1) ) {
            f32x16 d = mm_nt(MAT(mcT), i0, MAT(tc), j0, zero, r32, hi);
#pragma unroll
            for (int g = 0; g < 4; ++g) { const u32x2 tv = *(const LAS u32x2*)(MAT(tc) + moff(j0 + r32, i0 + 8 * g + 4 * hi)); d[4 * g] += bflo(tv.x); d[4 * g + 1] += bfhi(tv.x); d[4 * g + 2] += bflo(tv.y); d[4 * g + 3] += bfhi(tv.y); }
            store_t(MAT(tn), d, i0, j0, r32, hi);
        }
        __syncthreads();
    }
    if (grp == 0) { const f32x16 d = mm_nt(MAT(S_TB), i0, MAT(S_ATT), j0, zero, r32, hi); store_t(MAT(S_BT), d, i0, j0, r32, hi); }
    else { const f32x16 d = mm_nt(MAT(S_MAK), i0, MAT(S_VT), j0, zero, r32, hi); store_t(MAT(S_N), d, i0, j0, r32, hi); }
    __syncthreads();
    if (grp == 0) { const f32x16 d = mm_nt(MAT(S_TB), i0, MAT(S_N), j0, zero, r32, hi); store_t(MAT(S_NT), d, i0, j0, r32, hi);
        f32x16 q = mm_nt(MAT(S_BT), i0, MAT(S_MRB), j0, zero, r32, hi);
#pragma unroll
        for (int g = 0; g < 4; ++g) { const u32x2 rv = *(const LAS u32x2*)(MAT(S_RT) + moff(j0 + r32, i0 + 8 * g + 4 * hi)); q[4 * g] += bflo(rv.x); q[4 * g + 1] += bfhi(rv.x); q[4 * g + 2] += bflo(rv.y); q[4 * g + 3] += bfhi(rv.y); }
        store_t(MAT(S_KT), q, i0, j0, r32, hi); }
    else { f32x16 g_ = mm_nt(MAT(S_BT), i0, MAT(S_BTT), j0, zero, r32, hi);
        const float wl = WL[j0 + r32];
#pragma unroll
        for (int r = 0; r < 16; ++r) { if (i0 + crow(r, hi) == j0 + r32) g_[r] += 1.0f; g_[r] *= wl; }
        store_t(MAT(S_AT), g_, i0, j0, r32, hi); }
    __syncthreads();
    if (grp == 0) { f32x16 d = mm_nt(MAT(S_BTT), i0, MAT(S_NT), j0, zero, r32, hi); d = mm_nt(MAT(S_KTT), i0, MAT(S_VT), j0, d, r32, hi);
        float* HT = (float*)(P.ws + WS_HT) + ci * 4096 + (size_t)wq * 1024 + lane;
#pragma unroll
        for (int g = 0; g < 4; ++g) { const f32x4 wl4 = *(const LAS f32x4*)(WL + i0 + 8 * g + 4 * hi);
#pragma unroll
            for (int i = 0; i < 4; ++i) HT[(4 * g + i) * 64] = d[4 * g + i] * wl4[i]; } }
    else { f32x16 d = mm_nt(MAT(S_MRB), i0, MAT(S_NT), j0, zero, r32, hi); d = mm_nt(MAT(S_MRK), i0, MAT(S_VT), j0, d, r32, hi);
        unsigned* Y0 = (unsigned*)(P.ws + WS_Y0) + ci * 2048 + (size_t)wq * 512 + lane;
#pragma unroll
        for (int r2 = 0; r2 < 8; ++r2) Y0[r2 * 64] = pk2(d[2 * r2], d[2 * r2 + 1]); }
    { u32x4* GTg = (u32x4*)((unsigned char*)P.out + DO_GT + ci * MB); u32x4* QIg = (u32x4*)(P.ws + WS_QI + ci * MB);
        GTg[tid] = *(const LAS u32x4*)(MAT(S_AT) + tid * 16); QIg[tid] = *(const LAS u32x4*)(MAT(S_KT) + tid * 16); }
    __syncthreads();
#undef MAT
}

__device__ __forceinline__ void pass2_seq(KPR P, LAS unsigned char* lds, int bh, int tid) {
    const int lane = tid & 63, wave = tid >> 6, r32 = lane & 31, hi = lane >> 5, wq = wave & 3, i0 = 32 * (wq >> 1), j0 = 32 * (wq & 1);
    LAS unsigned char* Sm = lds; LAS unsigned char* G0 = lds + MB; LAS unsigned char* G1 = lds + 2 * MB;
    const size_t ci0 = (size_t)bh * NCHUNK;
    const u32x4* GTg = (const u32x4*)((const unsigned char*)P.out + DO_GT + ci0 * MB); u32x4* SCg = (u32x4*)(P.ws + WS_SC + ci0 * MB);
    const float* HT = (const float*)(P.ws + WS_HT) + ci0 * 4096 + (size_t)wq * 1024 + lane;
    *(LAS u32x4*)(Sm + tid * 16) = (u32x4){0u, 0u, 0u, 0u};
    *(LAS u32x4*)(G0 + tid * 16) = GTg[tid];
    u32x4 gnext = GTg[512 + tid];
    f32x16 hcur, hnext;
    if (wave < 4) {
#pragma unroll
        for (int r = 0; r < 16; ++r) { hcur[r] = HT[r * 64]; hnext[r] = HT[4096 + r * 64]; } }
    __syncthreads();
    for (int c = 0; c < NCHUNK; ++c) {
        LAS unsigned char* Gc = (c & 1) ? G1 : G0; LAS unsigned char* Gn = (c & 1) ? G0 : G1;
        SCg[(size_t)c * 512 + tid] = *(const LAS u32x4*)(Sm + tid * 16);
        f32x16 d = hcur;
        if (wave < 4) d = mm_nt(Gc, i0, Sm, j0, d, r32, hi);
        __syncthreads();
        if (wave < 4) store_t(Sm, d, i0, j0, r32, hi);
        *(LAS u32x4*)(Gn + tid * 16) = gnext;
        const int c2 = (c + 2 < NCHUNK) ? c + 2 : NCHUNK - 1;
        gnext = GTg[(size_t)c2 * 512 + tid];
        if (wave < 4) { hcur = hnext;
#pragma unroll
            for (int r = 0; r < 16; ++r) hnext[r] = HT[(size_t)c2 * 4096 + r * 64]; }
        __syncthreads();
    }
}

__device__ __forceinline__ void pass3_chunk(KPR P, LAS unsigned char* lds, int bh, int c, int tid) {
    const int lane = tid & 63, wave = tid >> 6, r32 = lane & 31, hi = lane >> 5, wq = wave & 3, i0 = 32 * (wq >> 1), j0 = 32 * (wq & 1);
    const int b = bh >> 3, h = bh & 7; const size_t tok0 = (size_t)b * SEQ + (size_t)c * 64; const size_t ci = (size_t)bh * NCHUNK + c;
    LAS unsigned char* Qm = lds; LAS unsigned char* Sm = lds + MB; LAS float* Yl = (LAS float*)(lds + 2 * MB);
    *(LAS u32x4*)(Qm + tid * 16) = ((const u32x4*)(P.ws + WS_QI + ci * MB))[tid];
    *(LAS u32x4*)(Sm + tid * 16) = ((const u32x4*)(P.ws + WS_SC + ci * MB))[tid];
    f32x16 d = f32x16{};
    if (wave < 4) { const unsigned* Y0 = (const unsigned*)(P.ws + WS_Y0) + ci * 2048 + (size_t)wq * 512 + lane;
#pragma unroll
        for (int r2 = 0; r2 < 8; ++r2) { const unsigned w = Y0[r2 * 64]; d[2 * r2] = bflo(w); d[2 * r2 + 1] = bfhi(w); } }
    const bf16_t* Z = (const bf16_t*)(P.ws + WS_Z); const bf16_t* LA = (const bf16_t*)(P.ws + WS_LA); const bf16_t* LG = (const bf16_t*)(P.ws + WS_LG);
    bf16_t* AO = (bf16_t*)(P.ws + WS_AO); const int cc = h * 64 + lane;
    const float lnw = P.ln_w[cc], lnb = P.ln_b[cc], rkc = P.r_k[cc], mur = P.mu[RW_R + cc], muk = P.mu[RW_K + cc], muv = P.mu[RW_V + cc], a0c = P.a0[cc], kac = P.k_a[cc];
    const bf16_t* zp = Z + (tok0 + wave * 8) * ZW + ZR + cc; const bool first = (c == 0) && (wave == 0); const bf16_t* zq = first ? zp : zp - ZW; const float pm = first ? 0.f : 1.f;
    unsigned short lr[9], lk[9], lv[9], lla[8], llg[8];
    lr[0] = zq[RW_R]; lk[0] = zq[RW_K]; lv[0] = zq[RW_V];
#pragma unroll
    for (int i = 0; i < 8; ++i) { const bf16_t* zi = zp + (size_t)i * ZW; lr[i + 1] = zi[RW_R]; lk[i + 1] = zi[RW_K]; lv[i + 1] = zi[RW_V]; const size_t o = (tok0 + wave * 8 + i) * 512 + cc; lla[i] = LA[o]; llg[i] = LG[o]; }
    __syncthreads();
    if (wave < 4) { d = mm_nt(Qm, i0, Sm, j0, d, r32, hi);
#pragma unroll
        for (int r = 0; r < 16; ++r) Yl[(i0 + crow(r, hi)) * 65 + j0 + r32] = d[r]; }
    __syncthreads();
    float y[8], s1[8], s2[8], s3[8], vvv[8];
#pragma unroll
    for (int i = 0; i < 8; ++i) { const float pmi = (i == 0) ? pm : 1.f; const float zr1 = bf2f(lr[i + 1]), zk1 = bf2f(lk[i + 1]), zv1 = bf2f(lv[i + 1]);
        const float r = zr1 + (bf2f(lr[i]) * pmi - zr1) * mur, zk = zk1 + (bf2f(lk[i]) * pmi - zk1) * muk; vvv[i] = zv1 + (bf2f(lv[i]) * pmi - zv1) * muv;
        const float a = __builtin_amdgcn_rcpf(1.0f + __expf(-(a0c + bf2f(lla[i])))); const float k = zk * (1.0f + (a - 1.0f) * kac);
        y[i] = Yl[(wave * 8 + i) * 65 + lane]; s1[i] = y[i]; s3[i] = r * k * rkc; }
#pragma unroll
    for (int i = 0; i < 8; ++i) { s1[i] = wave_sum(s1[i]); s3[i] = wave_sum(s3[i]); }
#pragma unroll
    for (int i = 0; i < 8; ++i) { y[i] -= s1[i] * (1.f / 64.f); s2[i] = y[i] * y[i]; }
#pragma unroll
    for (int i = 0; i < 8; ++i) s2[i] = wave_sum(s2[i]);
#pragma unroll
    for (int i = 0; i < 8; ++i) { const size_t tok = tok0 + wave * 8 + i; const float yn = y[i] * rsqrtf(s2[i] * (1.f / 64.f) + 64e-5f) * lnw + lnb;
        AO[tok * DM + 512 + cc] = (bf16_t)f2bf((yn + s3[i] * vvv[i]) * bf2f(llg[i])); }
}

constexpr size_t WS_W2T = 29 * MiB, WS_A2T = 29 * MiB + 65536, WS_G2T = 29 * MiB + 131072;
__device__ __forceinline__ bf16x8 act8(const bf16_t* zc, const bf16_t* zpv, float pmask, const float* mu, int mode) {
    const u32x4 c = *(const u32x4*)zc, p = *(const u32x4*)zpv;
    const f32x4 m0 = *(const f32x4*)mu, m1 = *(const f32x4*)(mu + 4);
    const unsigned cw[4] = {c.x, c.y, c.z, c.w}, pw[4] = {p.x, p.y, p.z, p.w}; const float um[8] = {m0[0], m0[1], m0[2], m0[3], m1[0], m1[1], m1[2], m1[3]}; float v[8];
#pragma unroll
    for (int j = 0; j < 4; ++j) { const float c0 = bflo(cw[j]), c1 = bfhi(cw[j]), p0 = bflo(pw[j]) * pmask, p1 = bfhi(pw[j]) * pmask;
        v[2 * j] = c0 + (p0 - c0) * um[2 * j]; v[2 * j + 1] = c1 + (p1 - c1) * um[2 * j + 1]; }
#pragma unroll
    for (int j = 0; j < 8; ++j) { if (mode == 0) { const float e = __expf(-2.0f * fabsf(v[j])); const float th = (1.0f - e) * __builtin_amdgcn_rcpf(1.0f + e); v[j] = v[j] < 0.f ? -th : th; } else if (mode == 2) v[j] = __builtin_amdgcn_rcpf(1.0f + __expf(-v[j])); }
    u32x4 w; w.x = pk2(v[0], v[1]); w.y = pk2(v[2], v[3]); w.z = pk2(v[4], v[5]); w.w = pk2(v[6], v[7]);
    return __builtin_bit_cast(bf16x8, w);
}
__device__ __forceinline__ int goff(int row, int col) { return row * 256 + ((((col >> 3) ^ row) & 15) << 4) + (col & 7) * 2; }
__device__ __forceinline__ void lora_block(KPR P, LAS unsigned char* lds, int blk, int G, int tid) {
    const int lane = tid & 63, wave = tid >> 6, r32 = lane & 31, hi = lane >> 5;
    const int task = wave * G + blk; const bool work = (wave < 4) && (task < NTOK / 32);
    const size_t row = (size_t)(work ? task : 0) * 32 + r32; const bool first = (row % SEQ) == 0;
    const bf16_t* Z = (const bf16_t*)(P.ws + WS_Z) + row * ZW + ZR + 8 * hi; const bf16_t* Zp = first ? Z : Z - ZW; const float pmask = first ? 0.f : 1.f;
    const float* mub = P.mu + 8 * hi;
    { const u32x4* w2 = (const u32x4*)(P.ws + WS_W2T); const u32x4* a2 = (const u32x4*)(P.ws + WS_A2T);
#pragma unroll
        for (int i = 0; i < 8; ++i) { const int idx = i * 512 + tid, rw = idx >> 3, ch = idx & 7; const int o = rw * 128 + (((ch ^ (rw >> 1)) & 7) << 4);
            *(LAS u32x4*)(lds + o) = w2[idx]; *(LAS u32x4*)(lds + 65536 + o) = a2[idx]; } }
    bf16x8 xw[4], xa[4], xg[8];
    if (work) {
#pragma unroll
        for (int ks = 0; ks < 4; ++ks) { xw[ks] = act8(Z + RW_W + 16 * ks, Zp + RW_W + 16 * ks, pmask, mub + RW_W + 16 * ks, 0); xa[ks] = act8(Z + RW_A + 16 * ks, Zp + RW_A + 16 * ks, pmask, mub + RW_A + 16 * ks, 1); asm volatile("" ::: "memory"); }
#pragma unroll
        for (int ks = 0; ks < 8; ++ks) { xg[ks] = act8(Z + RW_G + 16 * ks, Zp + RW_G + 16 * ks, pmask, mub + RW_G + 16 * ks, 2); if (ks & 1) asm volatile("" ::: "memory"); }
    }
    bf16_t* LW = (bf16_t*)(P.ws + WS_LW) + row * 512 + 4 * hi; bf16_t* LA = (bf16_t*)(P.ws + WS_LA) + row * 512 + 4 * hi; bf16_t* LG = (bf16_t*)(P.ws + WS_LG) + row * 512 + 4 * hi;
    __syncthreads();
    if (work) {
#pragma nounroll
        for (int cb = 0; cb < 16; ++cb) { f32x16 dw = f32x16{}, da = f32x16{};
#pragma unroll
            for (int ks = 0; ks < 4; ++ks) { const int o = moff(cb * 32 + r32, 16 * ks + 8 * hi);
                dw = __builtin_amdgcn_mfma_f32_32x32x16_bf16(*(const LAS bf16x8*)(lds + o), xw[ks], dw, 0, 0, 0); da = __builtin_amdgcn_mfma_f32_32x32x16_bf16(*(const LAS bf16x8*)(lds + 65536 + o), xa[ks], da, 0, 0, 0); }
#pragma unroll
            for (int g = 0; g < 4; ++g) { u32x2 w; w.x = pk2(dw[4 * g], dw[4 * g + 1]); w.y = pk2(dw[4 * g + 2], dw[4 * g + 3]); *(u32x2*)(LW + cb * 32 + 8 * g) = w;
                w.x = pk2(da[4 * g], da[4 * g + 1]); w.y = pk2(da[4 * g + 2], da[4 * g + 3]); *(u32x2*)(LA + cb * 32 + 8 * g) = w; } }
    }
    __syncthreads();
    { const u32x4* g2 = (const u32x4*)(P.ws + WS_G2T);
#pragma unroll
        for (int i = 0; i < 16; ++i) { const int idx = i * 512 + tid, rw = idx >> 4, ch = idx & 15; *(LAS u32x4*)(lds + rw * 256 + (((ch ^ rw) & 15) << 4)) = g2[idx]; } }
    __syncthreads();
    if (work) {
#pragma nounroll
        for (int cb = 0; cb < 16; ++cb) { f32x16 dg = f32x16{};
#pragma unroll
            for (int ks = 0; ks < 8; ++ks) dg = __builtin_amdgcn_mfma_f32_32x32x16_bf16(*(const LAS bf16x8*)(lds + goff(cb * 32 + r32, 16 * ks + 8 * hi)), xg[ks], dg, 0, 0, 0);
#pragma unroll
            for (int g = 0; g < 4; ++g) { u32x2 w; w.x = pk2(dg[4 * g], dg[4 * g + 1]); w.y = pk2(dg[4 * g + 2], dg[4 * g + 3]); *(u32x2*)(LG + cb * 32 + 8 * g) = w; } }
    }
    __syncthreads();
}
}
namespace rt {
__device__ __forceinline__ int woff(int e, int k) { return e * 2048 + ((((k >> 3) ^ (e & 15))) << 4) + (k & 7) * 2; }
constexpr size_t WS_WRI = 30 * MiB;
__device__ __forceinline__ void build_w(KPR P, int part, int tid) {
    unsigned char* img = P.ws + WS_WRI; const int e = tid & 31, k0 = part * 64 + 4 * (tid >> 5); float w[4];
#pragma unroll
    for (int i = 0; i < 4; ++i) w[i] = P.moe_norm[k0 + i] * P.w_router[(k0 + i) * 32 + e];
#pragma unroll
    for (int i = 0; i < 4; ++i) { const int k = k0 + i; const unsigned h = f2bf(w[i]); const unsigned l = f2bf(w[i] - bf2f(h));
        *(unsigned short*)(img + woff(e, k)) = (unsigned short)h; *(unsigned short*)(img + 65536 + woff(e, k)) = (unsigned short)l; }
}
__device__ __forceinline__ void copy_w(KPR P, LAS unsigned char* lds, int tid) {
    const u32x4* img = (const u32x4*)(P.ws + WS_WRI);
#pragma unroll 4
    for (int i = 0; i < 16; ++i) *(LAS u32x4*)(lds + (size_t)(i * 512 + tid) * 16) = img[i * 512 + tid];
}
__device__ __forceinline__ void split8(const f32x4& a, const f32x4& b, bf16x8& h, bf16x8& l) {
    unsigned hh[8]; float v[8] = {a[0], a[1], a[2], a[3], b[0], b[1], b[2], b[3]};
#pragma unroll
    for (int j = 0; j < 8; ++j) hh[j] = f2bf(v[j]);
    u32x4 hw, lw;
    hw.x = hh[0] | (hh[1] << 16); hw.y = hh[2] | (hh[3] << 16); hw.z = hh[4] | (hh[5] << 16); hw.w = hh[6] | (hh[7] << 16);
    lw.x = pk2(v[0] - bf2f(hh[0]), v[1] - bf2f(hh[1])); lw.y = pk2(v[2] - bf2f(hh[2]), v[3] - bf2f(hh[3])); lw.z = pk2(v[4] - bf2f(hh[4]), v[5] - bf2f(hh[5])); lw.w = pk2(v[6] - bf2f(hh[6]), v[7] - bf2f(hh[7]));
    h = __builtin_bit_cast(bf16x8, hw); l = __builtin_bit_cast(bf16x8, lw);
}
__device__ __forceinline__ void route_task(KPR P, const LAS unsigned char* wlds, int task, int lane) {
    const int r32 = lane & 31, hi = lane >> 5; const int row = task * 32 + r32;
    const bf16_t* xrow = (const bf16_t*)(P.ws + WS_X1) + (size_t)row * DM + 8 * hi;
    f32x16 acc = f32x16{}; float ss = 0.f;
    u32x4 xq[4];
#pragma unroll
    for (int j = 0; j < 4; ++j) xq[j] = *(const u32x4*)(xrow + 16 * j);
    for (int ks0 = 0; ks0 < 64; ks0 += 4) {
#pragma unroll
        for (int j = 0; j < 4; ++j) { const int ks = ks0 + j; const u32x4 xv = xq[j];
            const int kn = (ks + 4 < 64) ? ks + 4 : ks; xq[j] = *(const u32x4*)(xrow + 16 * kn);
            const unsigned xw[4] = {xv.x, xv.y, xv.z, xv.w};
#pragma unroll
            for (int q = 0; q < 4; ++q) { const float a = bflo(xw[q]), b = bfhi(xw[q]); ss += a * a + b * b; }
            const bf16x8 xh = __builtin_bit_cast(bf16x8, xv);
            const bf16x8 wh = *(const LAS bf16x8*)(wlds + woff(r32, 16 * ks + 8 * hi)), wl = *(const LAS bf16x8*)(wlds + 65536 + woff(r32, 16 * ks + 8 * hi));
            acc = __builtin_amdgcn_mfma_f32_32x32x16_bf16(wh, xh, acc, 0, 0, 0); acc = __builtin_amdgcn_mfma_f32_32x32x16_bf16(wl, xh, acc, 0, 0, 0); }
    }
    ss += __shfl_xor(ss, 32);
    const float rstd = rsqrtf(ss * (1.f / DM) + 1e-6f);
    float lg[16];
#pragma unroll
    for (int g = 0; g < 4; ++g) { const f32x4 bb = *(const f32x4*)(P.b_router + 8 * g + 4 * hi);
#pragma unroll
        for (int i = 0; i < 4; ++i) lg[4 * g + i] = acc[4 * g + i] * rstd + bb[i]; }
    float tv[4]; int ti[4];
#pragma unroll
    for (int k = 0; k < 4; ++k) { float bv = lg[0]; int bi = 4 * hi;
#pragma unroll
        for (int r = 1; r < 16; ++r) { const int e = (r & 3) + 8 * (r >> 2) + 4 * hi; if (lg[r] > bv) { bv = lg[r]; bi = e; } }
        const float pv = __shfl_xor(bv, 32); const int pi = __shfl_xor(bi, 32);
        if (pv > bv || (pv == bv && pi < bi)) { bv = pv; bi = pi; }
        tv[k] = bv; ti[k] = bi;
#pragma unroll
        for (int r = 0; r < 16; ++r) { const int e = (r & 3) + 8 * (r >> 2) + 4 * hi; if (e == bi) lg[r] = -INFINITY; } }
    const float e1 = __expf(tv[1] - tv[0]), e2 = __expf(tv[2] - tv[0]), e3 = __expf(tv[3] - tv[0]), inv = 1.f / (1.f + e1 + e2 + e3);
    const int c0 = hi ? ti[2] : ti[0], c1 = hi ? ti[3] : ti[1]; const float g0 = (hi ? e2 : 1.f) * inv, g1 = (hi ? e3 : e1) * inv;
    const unsigned long long ltm = (1ull << lane) - 1ull; int mycnt = 0, rk0 = 0, rk1 = 0;
    for (int e = 0; e < 32; ++e) { const unsigned long long m0 = __ballot(c0 == e), m1 = __ballot(c1 == e); const int n0 = __popcll(m0);
        if (lane == e) mycnt = n0 + __popcll(m1);
        if (c0 == e) rk0 = __popcll(m0 & ltm);
        if (c1 == e) rk1 = n0 + __popcll(m1 & ltm); }
    unsigned* cnt = (unsigned*)(P.ws + WS_CTL) + CW_CNT; int base = 0;
    if (lane < 32 && mycnt > 0) base = (int)atomicAdd(cnt + lane, (unsigned)mycnt);
    rk0 += __shfl(base, c0); rk1 += __shfl(base, c1);
    int* route = (int*)(P.ws + WS_ROUTE); int* tokslot = (int*)(P.ws + WS_TOKSLOT); float* gateslot = (float*)(P.ws + WS_GATESLOT);
    tokslot[(size_t)c0 * NTOK + rk0] = row; gateslot[(size_t)c0 * NTOK + rk0] = g0; tokslot[(size_t)c1 * NTOK + rk1] = row; gateslot[(size_t)c1 * NTOK + rk1] = g1;
    route[(size_t)row * 12 + 2 * hi] = c0; route[(size_t)row * 12 + 2 * hi + 1] = c1; route[(size_t)row * 12 + 4 + 2 * hi] = rk0; route[(size_t)row * 12 + 4 + 2 * hi + 1] = rk1;
    unsigned char* xn = P.ws + WS_XN + (size_t)row * DM + 8 * hi; const float* gn = P.moe_norm + 8 * hi;
#pragma unroll
    for (int j = 0; j < 4; ++j) xq[j] = *(const u32x4*)(xrow + 16 * j);
    for (int ks0 = 0; ks0 < 64; ks0 += 4) {
#pragma unroll
        for (int j = 0; j < 4; ++j) { const int ks = ks0 + j; const u32x4 xv = xq[j]; const f32x4 ga = *(const f32x4*)(gn + 16 * ks), gb = *(const f32x4*)(gn + 16 * ks + 4);
            const int kn = (ks + 4 < 64) ? ks + 4 : ks; xq[j] = *(const u32x4*)(xrow + 16 * kn);
            u32x2 w; w.x = pk4_fp8(bflo(xv.x) * rstd * ga[0], bfhi(xv.x) * rstd * ga[1], bflo(xv.y) * rstd * ga[2], bfhi(xv.y) * rstd * ga[3]); w.y = pk4_fp8(bflo(xv.z) * rstd * gb[0], bfhi(xv.z) * rstd * gb[1], bflo(xv.w) * rstd * gb[2], bfhi(xv.w) * rstd * gb[3]);
            *(u32x2*)(xn + 16 * ks) = w; }
    }
}
}
namespace attn_body {
using bf16=unsigned short;
using bf16x8=__attribute__((ext_vector_type(8)))short;
using s16x4=__attribute__((ext_vector_type(4)))short;
using f32x16=__attribute__((ext_vector_type(16)))float;
using u32x4=__attribute__((ext_vector_type(4)))unsigned;
constexpr int BATCH=4,NHEAD=8,SEQ=8192,D=64,DM=3840,OP=1024;
constexpr int NW=8,QBLK=32,QB=QBLK*NW,KVBLK=64,NQB=SEQ/QB;
constexpr int ATTN_PITCH=DM, ATTN_UNIT_ROWS=QB;
__device__ __forceinline__ int crow(int r,int hi){return (r&3)+8*(r>>2)+4*hi;}
#define SBAR() __builtin_amdgcn_sched_barrier(0)
__device__ __forceinline__ void cmask(f32x16&p0,f32x16&p1,int jb,int qrel,int hi){
  const float NEG=-INFINITY; int kb=64*jb+4*hi;
  #pragma unroll
  for(int r=0;r<16;++r){int kv=kb+(r&3)+8*(r>>2); if(kv>qrel)p0[r]=NEG; if(kv+32>qrel)p1[r]=NEG;}
}

constexpr int NSLOT=3, SLOTB=8192;
constexpr int LDS_K=0, LDS_V=NSLOT*SLOTB, LDS_WS=2*NSLOT*SLOTB, LDS_OST=LDS_WS+NW*64*4, LDS_C2=LDS_OST+NW*4096, LDS_BYTES=LDS_C2+SEQ*4;
constexpr float C2=0.125f*1.4426950408889634f;
__device__ __forceinline__ void glds16(const void*gsrc,unsigned lds_dst){unsigned keep;
  asm volatile("s_mov_b32 %0, m0\n\ts_mov_b32 m0, %2\n\ts_nop 0\n\tglobal_load_lds_dwordx4 %1, off\n\ts_mov_b32 m0, %0":"=&s"(keep):"v"(gsrc),"s"(lds_dst):"memory");}
__device__ __forceinline__ float max3f(float a,float b,float c){float r;asm("v_max3_f32 %0, %1, %2, %3":"=v"(r):"v"(a),"v"(b),"v"(c));return r;}
__device__ __forceinline__ float max2f(float a,float b){float r;asm("v_max_f32_e32 %0, %1, %2":"=v"(r):"v"(a),"v"(b));return r;}
__device__ __forceinline__ float fadd_s(float a,float b){float r;asm("v_add_f32_e32 %0, %1, %2":"=v"(r):"v"(a),"v"(b));return r;}
__device__ __forceinline__ float fsub_s(float a,float b){float r;asm("v_sub_f32_e32 %0, %1, %2":"=v"(r):"v"(a),"v"(b));return r;}
typedef float f32x2_t __attribute__((ext_vector_type(2))); typedef float f32x4v __attribute__((ext_vector_type(4))); typedef __bf16 bf16x2_t __attribute__((ext_vector_type(2)));
__device__ __forceinline__ unsigned cvtpk_s(float lo,float hi){f32x2_t v={lo,hi};bf16x2_t b=__builtin_convertvector(v,bf16x2_t);return __builtin_bit_cast(unsigned,b);}
#define WAIT_BAR(N) asm volatile("s_waitcnt vmcnt(" #N ") lgkmcnt(0)\n\ts_barrier":::"memory")

__device__ __forceinline__ void qkt(f32x16&p0,f32x16&p1,const char*Kslot,const bf16x8*qr,int r32,int hi){
  const char*kb=Kslot+hi*1024+r32*16;
  #pragma unroll
  for(int d0=0;d0<4;++d0){
    const bf16x8 b0=*reinterpret_cast<const bf16x8*>(kb+d0*2048);
    const bf16x8 b1=*reinterpret_cast<const bf16x8*>(kb+d0*2048+512);
    p0=__builtin_amdgcn_mfma_f32_32x32x16_bf16(b0,qr[d0],p0,0,0,0);p1=__builtin_amdgcn_mfma_f32_32x32x16_bf16(b1,qr[d0],p1,0,0,0);}
}
typedef __attribute__((address_space(3))) const char* lds_cptr;
typedef short v4i16_t __attribute__((ext_vector_type(4)));
__device__ __forceinline__ void kload8(bf16x8*kf,lds_cptr kp){
  kf[0]=*(const __attribute__((address_space(3))) bf16x8*)(kp);      kf[1]=*(const __attribute__((address_space(3))) bf16x8*)(kp+512);
  kf[2]=*(const __attribute__((address_space(3))) bf16x8*)(kp+2048); kf[3]=*(const __attribute__((address_space(3))) bf16x8*)(kp+2560);
  kf[4]=*(const __attribute__((address_space(3))) bf16x8*)(kp+4096); kf[5]=*(const __attribute__((address_space(3))) bf16x8*)(kp+4608);
  kf[6]=*(const __attribute__((address_space(3))) bf16x8*)(kp+6144); kf[7]=*(const __attribute__((address_space(3))) bf16x8*)(kp+6656);
}
__device__ __forceinline__ void kload2(bf16x8*kf,lds_cptr kp,int j){ kf[2*j]=*(const __attribute__((address_space(3))) bf16x8*)(kp+j*2048); kf[2*j+1]=*(const __attribute__((address_space(3))) bf16x8*)(kp+j*2048+512); }
__device__ __forceinline__ s16x4 vtr(lds_cptr p){ return __builtin_bit_cast(s16x4,__builtin_amdgcn_ds_read_tr16_b64_v4i16((__attribute__((address_space(3))) v4i16_t*)p)); }
__device__ __forceinline__ float rowmax(const f32x16&p0,const f32x16&p1){
  float a=max3f(p0[0],p0[1],p1[0]),b=max3f(p0[2],p0[3],p1[1]);a=max3f(a,p1[2],p1[3]);
  #pragma unroll
  for(int r=4;r<16;r+=4){a=max3f(a,p0[r],p0[r+1]);b=max3f(b,p0[r+2],p0[r+3]);a=max3f(a,p1[r],p1[r+1]);b=max3f(b,p1[r+2],p1[r+3]);}
  const float m=max2f(a,b);
  auto rr=__builtin_amdgcn_permlane32_swap(__float_as_uint(m),__float_as_uint(m),false,false);
  return max2f(__uint_as_float(rr[0]),__uint_as_float(rr[1]));
}
__device__ __forceinline__ void pv(f32x16*o,int vb,bf16x8 pa0,bf16x8 pa1,bf16x8 pa2,bf16x8 pa3){
  #pragma unroll
  for(int d0=0;d0<2;++d0){s16x4 lo[4],hi[4];
    #pragma unroll
    for(int ks=0;ks<4;++ks){
      asm volatile("ds_read_b64_tr_b16 %0,%1 offset:%c2":"=&v"(lo[ks]):"v"(vb),"i"(d0*4096+ks*1024):"memory");
      asm volatile("ds_read_b64_tr_b16 %0,%1 offset:%c2":"=&v"(hi[ks]):"v"(vb),"i"(d0*4096+ks*1024+512):"memory");}
    asm volatile("s_waitcnt lgkmcnt(0)":::"memory");SBAR();
    #define PK(k) (bf16x8){lo[k][0],lo[k][1],lo[k][2],lo[k][3],hi[k][0],hi[k][1],hi[k][2],hi[k][3]}
    o[d0]=__builtin_amdgcn_mfma_f32_32x32x16_bf16(pa0,PK(0),o[d0],0,0,0);
    o[d0]=__builtin_amdgcn_mfma_f32_32x32x16_bf16(pa1,PK(1),o[d0],0,0,0);
    o[d0]=__builtin_amdgcn_mfma_f32_32x32x16_bf16(pa2,PK(2),o[d0],0,0,0);
    o[d0]=__builtin_amdgcn_mfma_f32_32x32x16_bf16(pa3,PK(3),o[d0],0,0,0);
    #undef PK
  }
}

#ifndef ATTN_STORE16
#define ATTN_STORE16(p,v) (*(u32x4*)(p)=(v))
#endif
template<int THRL> __device__ __forceinline__ void attn_unit(int b,int h,int qb,int t0,const bf16*Z,const float*c2g,bf16*O,char*shm){
  const int tid=threadIdx.x,lane=tid&63,r32=lane&31,hi=lane>>5; const int wid=__builtin_amdgcn_readfirstlane(tid>>6);
  const long rowbase=(long)b*SEQ; const int q0=qb*QB;
  const bf16*Qw=Z+(rowbase+q0+wid*QBLK)*DM+h*D;
  const bf16*Kh=Z+(rowbase+(long)t0*KVBLK)*DM+512+h*D,*Vh=Z+(rowbase+(long)t0*KVBLK)*DM+1024+h*D;
  const unsigned lds0=(unsigned)(uintptr_t)shm;
  float*wsf=(float*)(shm+LDS_WS)+wid*64;
  const bf16*ksrc=Kh+(long)lane*DM+wid*8;
  const bf16*vsrc=Vh+(long)(16*(wid&3)+(lane>>2))*DM+(wid>>2)*32+(lane&3)*8;
  const unsigned kdst=lds0+LDS_K+wid*1024, vdst=lds0+LDS_V+wid*1024;
  #define DMA_K(t,slot) glds16(ksrc+(long)(t)*KVBLK*DM,(unsigned)__builtin_amdgcn_readfirstlane(kdst+(slot)))
  #define DMA_V(t,slot) glds16(vsrc+(long)(t)*KVBLK*DM,(unsigned)__builtin_amdgcn_readfirstlane(vdst+(slot)))
  const int vb0=(int)(lds0+LDS_V)+((lane>>4)&1)*32+(lane&3)*8+(4*hi+((lane&15)>>2))*64;
  const char*Kbase=shm+LDS_K; bf16x8 kf[8];
  const lds_cptr shm3=(lds_cptr)shm; const lds_cptr kp0=shm3+LDS_K+hi*1024+r32*16; const lds_cptr vp0=shm3+LDS_V+((lane>>4)&1)*32+(lane&3)*8+(4*hi+((lane&15)>>2))*64;
  const int NT=(q0+QB)/KVBLK-t0;
  { const int np=(q0+QB)/256;
    for(int p=(t0>>2)+wid;p<np;p+=NW) glds16(c2g+p*256+lane*4,(unsigned)__builtin_amdgcn_readfirstlane(lds0+LDS_C2+p*1024)); }
  const __attribute__((address_space(3))) float* c2l=(const __attribute__((address_space(3))) float*)(shm3+LDS_C2)+t0*KVBLK+4*hi;
  DMA_K(0,0);DMA_V(0,0);DMA_K(1,SLOTB);
  bf16x8 qr[4];
  #pragma unroll
  for(int d0=0;d0<4;++d0)qr[d0]=*reinterpret_cast<const bf16x8*>(&Qw[(long)r32*DM+d0*16+hi*8]);
  float l_reg=0.f;f32x16 o[2];o[0]=f32x16{};o[1]=f32x16{};
  float base=c2g[q0+wid*QBLK+r32];
  const int qrel=wid*QBLK+r32;
  #define CMASK(P0,P1,t) do{int jb_=(t)-(NT-4); if(jb_>=0)cmask(P0,P1,jb_,qrel,hi);}while(0)
  bool resc=false;
  #define START(P0,P1) do{ const float rm=rowmax(P0,P1); resc=false; \
    { const float dl=rm; base=fsub_s(base,dl); \
      _Pragma("unroll") for(int r=0;r<16;++r){P0[r]=fsub_s(P0[r],dl);P1[r]=fsub_s(P1[r],dl);} } \
    _Pragma("unroll") for(int r=0;r<16;++r)P0[r]=__builtin_amdgcn_exp2f(P0[r]); }while(0)
  #define RESC() do{ if(resc){ asm volatile("s_waitcnt lgkmcnt(0)":::"memory"); \
      _Pragma("unroll") for(int d_=0;d_<2;++d_) _Pragma("unroll") for(int r=0;r<16;++r)o[d_][r]*=wsf[crow(r,hi)]; } }while(0)
  f32x16 pA0,pA1,pB0,pB1;
  #define BIASLD(P0,P1,tt) do{ _Pragma("unroll") for(int g_=0;g_<4;++g_){ const f32x4v x0_=*(const __attribute__((address_space(3))) f32x4v*)(c2l+(tt)*KVBLK+8*g_), x1_=*(const __attribute__((address_space(3))) f32x4v*)(c2l+(tt)*KVBLK+32+8*g_); \
      P0[4*g_]=x0_[0];P0[4*g_+1]=x0_[1];P0[4*g_+2]=x0_[2];P0[4*g_+3]=x0_[3]; P1[4*g_]=x1_[0];P1[4*g_+1]=x1_[1];P1[4*g_+2]=x1_[2];P1[4*g_+3]=x1_[3]; } }while(0)
  #define BIASFIX(P0,P1) do{ _Pragma("unroll") for(int r=0;r<16;++r){P0[r]=fsub_s(base,P0[r]);P1[r]=fsub_s(base,P1[r]);} }while(0)
  int sl_prev=0,sl_cur=0,sl_next=SLOTB;
  #define ROT() do{sl_prev=sl_cur;sl_cur=sl_next;sl_next=(sl_next==(NSLOT-1)*SLOTB)?0:sl_next+SLOTB;}while(0)
  DMA_K(2,2*SLOTB);
  WAIT_BAR(3);
  BIASLD(pA0,pA1,0); BIASFIX(pA0,pA1);
  qkt(pA0,pA1,Kbase,qr,r32,hi);asm volatile("s_nop 15\n\ts_nop 7":"+v"(pA0),"+v"(pA1));CMASK(pA0,pA1,0);
  START(pA0,pA1);
  _Pragma("unroll") for(int r=0;r<16;++r)pA1[r]=__builtin_amdgcn_exp2f(pA1[r]);
  BIASLD(pB0,pB1,1);
  WAIT_BAR(0);
  DMA_K(3,0);DMA_V(1,SLOTB);
  ROT();
  kload8(kf,kp0+sl_cur);
  WAIT_BAR(2);
  s16x4 vlo[8],vhi[8]; u32x4 pw0,pw1,pw2,pw3;
  #define PKW(P,B) cvtpk_s(P[B],P[B+1])
  #define PAF(k) __builtin_bit_cast(bf16x8,pw##k)
  #define VFR(i) (bf16x8){vlo[i][0],vlo[i][1],vlo[i][2],vlo[i][3],vhi[i][0],vhi[i][1],vhi[i][2],vhi[i][3]}
  #define PIN(x) asm volatile("":"+v"(x))
  #define MX3(a,b,c) __builtin_fmaxf(__builtin_fmaxf((a),(b)),(c))
  #define GAPA(MF,A0,A1,A2,A3,W0,W1,PW) do{ MF; sacc+=A0; sacc+=A1; sacc+=A2; sacc+=A3; PIN(sacc); W0; W1; PIN(PW); SBAR(); }while(0)
  #define EX(v) __builtin_amdgcn_exp2f(v)
  #define GAPB(MF,X,B) do{ MF; X[B]=EX(X[B]); X[B+1]=EX(X[B+1]); X[B+2]=EX(X[B+2]); X[B+3]=EX(X[B+3]); PIN(X); SBAR(); }while(0)
  #define VRD(i) do{ vlo[i]=vtr(vp_+(((i)>>2)*4096+((i)&3)*1024)); vhi[i]=vtr(vp_+(((i)>>2)*4096+((i)&3)*1024+512)); }while(0)
  #define KRD(G,j) do{ if(G){ kload2(kf,kp0+sl_next,j); SBAR(); } }while(0)
  #define STEP(C0,C1,P0,P1,t,GK,GV,GL) do{ SBAR(); \
    BIASFIX(C0,C1); SBAR(); \
    const lds_cptr vp_=vp0+sl_prev; \
    VRD(0); SBAR(); float sacc=(P0[0]+P0[1]); \
    GAPA(C0=__builtin_amdgcn_mfma_f32_32x32x16_bf16(kf[0],qr[0],C0,0,0,0), P0[2],P0[3],P0[4],P0[5],     pw0[0]=PKW(P0,0), pw0[1]=PKW(P0,2), pw0); \
    VRD(4); SBAR(); GAPA(C1=__builtin_amdgcn_mfma_f32_32x32x16_bf16(kf[1],qr[0],C1,0,0,0), P0[6],P0[7],P0[8],P0[9],     pw0[2]=PKW(P0,4), pw0[3]=PKW(P0,6), pw0); \
    VRD(1); SBAR(); GAPA(C0=__builtin_amdgcn_mfma_f32_32x32x16_bf16(kf[2],qr[1],C0,0,0,0),   P0[10],P0[11],P0[12],P0[13], pw1[0]=PKW(P0,8), pw1[1]=PKW(P0,10), pw1); \
    VRD(5); SBAR(); GAPA(C1=__builtin_amdgcn_mfma_f32_32x32x16_bf16(kf[3],qr[1],C1,0,0,0),   P0[14],P0[15],P1[0],P1[1],   pw1[2]=PKW(P0,12),pw1[3]=PKW(P0,14), pw1); \
    VRD(2); SBAR(); GAPA(C0=__builtin_amdgcn_mfma_f32_32x32x16_bf16(kf[4],qr[2],C0,0,0,0),   P1[2],P1[3],P1[4],P1[5],     pw2[0]=PKW(P1,0), pw2[1]=PKW(P1,2), pw2); \
    VRD(6); SBAR(); GAPA(C1=__builtin_amdgcn_mfma_f32_32x32x16_bf16(kf[5],qr[2],C1,0,0,0),   P1[6],P1[7],P1[8],P1[9],     pw2[2]=PKW(P1,4), pw2[3]=PKW(P1,6), pw2); \
    VRD(3); SBAR(); GAPA(C0=__builtin_amdgcn_mfma_f32_32x32x16_bf16(kf[6],qr[3],C0,0,0,0),   P1[10],P1[11],P1[12],P1[13], pw3[0]=PKW(P1,8), pw3[1]=PKW(P1,10), pw3); \
    VRD(7); SBAR(); GAPA(C1=__builtin_amdgcn_mfma_f32_32x32x16_bf16(kf[7],qr[3],C1,0,0,0),   P1[14],P1[15],0.f,0.f,       pw3[2]=PKW(P1,12),pw3[3]=PKW(P1,14), pw3); \
    l_reg+=sacc; \
    if(GL){BIASLD(P0,P1,(t)+1);} \
    if(GK){DMA_K((t)+3,sl_cur);} if(GV){DMA_V((t)+1,sl_next);} \
    CMASK(C0,C1,t); \
    { float a=MX3(C0[0],C0[1],C1[0]),b=MX3(C0[2],C0[3],C1[1]); a=MX3(a,C1[2],C1[3]); \
      _Pragma("unroll") for(int r=4;r<16;r+=4){a=MX3(a,C0[r],C0[r+1]);b=MX3(b,C0[r+2],C0[r+3]);a=MX3(a,C1[r],C1[r+1]);b=MX3(b,C1[r+2],C1[r+3]);} \
      float rm=__builtin_fmaxf(a,b); { auto rr=__builtin_amdgcn_permlane32_swap(__float_as_uint(rm),__float_as_uint(rm),false,false); rm=__builtin_fmaxf(__uint_as_float(rr[0]),__uint_as_float(rr[1])); } \
      resc=false; \
      if(__builtin_expect(__any(rm>(float)THRL),0)){ const float dl=__builtin_fmaxf(rm,0.f); base-=dl; \
        _Pragma("unroll") for(int r=0;r<16;++r){C0[r]-=dl;C1[r]-=dl;} \
        const float f=__builtin_amdgcn_exp2f(-dl); l_reg*=f; if(hi==0)wsf[r32]=f; resc=true; } } \
    SBAR(); \
    GAPB(o[0]=__builtin_amdgcn_mfma_f32_32x32x16_bf16(PAF(0),VFR(0),o[0],0,0,0), C0,0); \
    GAPB(o[1]=__builtin_amdgcn_mfma_f32_32x32x16_bf16(PAF(0),VFR(4),o[1],0,0,0), C0,4); \
    KRD(GL,0); GAPB(o[0]=__builtin_amdgcn_mfma_f32_32x32x16_bf16(PAF(1),VFR(1),o[0],0,0,0), C0,8); \
    KRD(GL,1); GAPB(o[1]=__builtin_amdgcn_mfma_f32_32x32x16_bf16(PAF(1),VFR(5),o[1],0,0,0), C0,12); \
    KRD(GL,2); GAPB(o[0]=__builtin_amdgcn_mfma_f32_32x32x16_bf16(PAF(2),VFR(2),o[0],0,0,0), C1,0); \
    KRD(GL,3); GAPB(o[1]=__builtin_amdgcn_mfma_f32_32x32x16_bf16(PAF(2),VFR(6),o[1],0,0,0), C1,4); \
    GAPB(o[0]=__builtin_amdgcn_mfma_f32_32x32x16_bf16(PAF(3),VFR(3),o[0],0,0,0), C1,8); \
    GAPB(o[1]=__builtin_amdgcn_mfma_f32_32x32x16_bf16(PAF(3),VFR(7),o[1],0,0,0), C1,12); \
    }while(0)
  int t=1;
  #undef CMASK
  #define CMASK(P0,P1,t) do{}while(0)
  for(;t+5<NT;t+=2){
    STEP(pB0,pB1,pA0,pA1,t,true,true,true);     WAIT_BAR(2); RESC(); ROT();
    STEP(pA0,pA1,pB0,pB1,t+1,true,true,true);   WAIT_BAR(2); RESC(); ROT();
  }
  #undef CMASK
  #define CMASK(P0,P1,t) do{int jb_=(t)-(NT-4); if(jb_>=0)cmask(P0,P1,jb_,qrel,hi);}while(0)
  #define ENDW(tt) do{ if((tt)+3<NT){WAIT_BAR(2);} else if((tt)+2<NT){WAIT_BAR(1);} else {WAIT_BAR(0);} }while(0)
  for(;t+1<NT;t+=2){
    STEP(pB0,pB1,pA0,pA1,t,(t+3<NT),(t+1<NT),(t+1<NT));       ENDW(t);   RESC(); ROT();
    STEP(pA0,pA1,pB0,pB1,t+1,(t+4<NT),(t+2<NT),(t+2<NT));     ENDW(t+1); RESC(); ROT();
  }
  STEP(pB0,pB1,pA0,pA1,NT-1,false,false,false); RESC();
  { float sacc=pB0[0]+pB0[1]; _Pragma("unroll") for(int r=2;r<16;++r)sacc+=pB0[r]; _Pragma("unroll") for(int r=0;r<16;++r)sacc+=pB1[r]; l_reg+=sacc;
    pw0=(u32x4){PKW(pB0,0),PKW(pB0,2),PKW(pB0,4),PKW(pB0,6)};pw1=(u32x4){PKW(pB0,8),PKW(pB0,10),PKW(pB0,12),PKW(pB0,14)};pw2=(u32x4){PKW(pB1,0),PKW(pB1,2),PKW(pB1,4),PKW(pB1,6)};pw3=(u32x4){PKW(pB1,8),PKW(pB1,10),PKW(pB1,12),PKW(pB1,14)};
    SBAR(); pv(o,vb0+sl_cur,PAF(0),PAF(1),PAF(2),PAF(3)); }
  #undef PKW
  #undef PAF
  #undef VFR
  #undef PIN
  #undef MX3
  #undef GAPA
  #undef GAPB
  #undef EX
  #undef VRD
  #undef KRD
  #undef STEP
  #undef ENDW
  {auto rr=__builtin_amdgcn_permlane32_swap(__float_as_uint(l_reg),__float_as_uint(l_reg),false,false);l_reg=__uint_as_float(rr[0])+__uint_as_float(rr[1]);}
  if(hi==0)wsf[32+r32]=l_reg;asm volatile("s_waitcnt lgkmcnt(0)":::"memory");
  float rli[16];
  #pragma unroll
  for(int r=0;r<16;++r)rli[r]=__builtin_amdgcn_rcpf(wsf[32+crow(r,hi)]);
  bf16*Ow=O+(rowbase+q0+wid*QBLK)*OP+h*D; const bf16*Gw=Z+(rowbase+q0+wid*QBLK)*DM+1536+h*D;
  { bf16*stg=(bf16*)(shm+LDS_OST)+wid*2048;
    #pragma unroll
    for(int r=0;r<16;++r){const int orow=crow(r,hi);
      #pragma unroll
      for(int d0=0;d0<2;++d0)stg[orow*64+d0*32+r32]=(bf16)f2bf(o[d0][r]*rli[r]);}
    asm volatile("s_waitcnt lgkmcnt(0)":::"memory");
    #pragma unroll
    for(int i=0;i<4;++i){const int row=i*8+(lane>>3),ch=lane&7; const u32x4 v=*(const u32x4*)(stg+row*64+ch*8), g=*(const u32x4*)(Gw+(long)row*DM+ch*8);
      const unsigned vw[4]={v.x,v.y,v.z,v.w},gw[4]={g.x,g.y,g.z,g.w}; unsigned ow[4];
      #pragma unroll
      for(int j=0;j<4;++j){ const float a0=bflo(vw[j])*__builtin_amdgcn_rcpf(1.0f+__expf(-bflo(gw[j]))), a1=bfhi(vw[j])*__builtin_amdgcn_rcpf(1.0f+__expf(-bfhi(gw[j]))); ow[j]=cvtpk_s(a0,a1); }
      ATTN_STORE16(Ow+(long)row*OP+ch*8,((u32x4){ow[0],ow[1],ow[2],ow[3]}));} }
  asm volatile("s_waitcnt lgkmcnt(0)\n\ts_barrier":::"memory");
  #undef DMA_K
  #undef DMA_V
  #undef CMASK
  #undef START
  #undef RESC
  #undef ROT
}
constexpr int ATTN_LDS_BYTES=LDS_BYTES;
#undef SBAR
#undef WAIT_BAR
}
constexpr int CW_QATT = 128;
constexpr int MISC_TAB = 64, MISC_Q = 4096, MISC_PFX = 4160;

__device__ __forceinline__ int attn_t0(KPR P, const float* c2, int q0, int lane) {
    float gq = fabsf(P.q_norm[lane]), gk = fabsf(P.k_norm[lane]);
#pragma unroll
    for (int o = 1; o < 64; o <<= 1) { gq = fmaxf(gq, __shfl_xor(gq, o)); gk = fmaxf(gk, __shfl_xor(gk, o)); }
    const float thr = c2[q0] + (2.0f * 8.0f * LOG2E * gq * gk + 40.0f);
    const int nfull = q0 / 64; int t0 = 0;
    for (int tb = 0; tb < nfull; tb += 64) { const int tt = tb + lane; const bool sk = (tt < nfull) && (c2[tt * 64 + 63] > thr); const unsigned long long bm = __ballot(sk); t0 += __popcll(bm); if (bm != ~0ull) break; }
    return __builtin_amdgcn_readfirstlane(t0) & ~1;
}
__device__ __forceinline__ void combine_row(KPR P, const LAS int* tab, int row, int lane) {
    const int* route = (const int*)(P.ws + WS_ROUTE); const unsigned char* YP = P.ws + WS_YP; bf16_t* X = (bf16_t*)(P.ws + WS_X1);
    f32x4 v[4]; const u32x2* xr = (const u32x2*)(X + (size_t)row * DM) + lane;
#pragma unroll
    for (int j = 0; j < 4; ++j) { const u32x2 xv = xr[64 * j]; v[j] = (f32x4){bflo(xv.x), bfhi(xv.x), bflo(xv.y), bfhi(xv.y)}; }
#pragma unroll
    for (int k = 0; k < 4; ++k) { const int ex = route[(size_t)row * 12 + k], rank = route[(size_t)row * 12 + 4 + k]; const size_t pos = (size_t)tab[pg8::T_BLKSTART + ex] * 256 + rank;
        const unsigned* yr = (const unsigned*)(YP + pos * DM) + lane;
#pragma unroll
        for (int j = 0; j < 4; ++j) { const unsigned y = yr[64 * j]; const f32x2 lo = __builtin_amdgcn_cvt_pk_f32_fp8((int)y, false), hi = __builtin_amdgcn_cvt_pk_f32_fp8((int)y, true);
            v[j][0] += lo[0] * 0.0625f; v[j][1] += lo[1] * 0.0625f; v[j][2] += hi[0] * 0.0625f; v[j][3] += hi[1] * 0.0625f; } }
    u32x2* xo = (u32x2*)(X + (size_t)row * DM) + lane; float s = 0.f;
#pragma unroll
    for (int j = 0; j < 4; ++j) { u32x2 w; w.x = pk2(v[j][0], v[j][1]); w.y = pk2(v[j][2], v[j][3]); xo[64 * j] = w; v[j] = (f32x4){bflo(w.x), bfhi(w.x), bflo(w.y), bfhi(w.y)}; s += (v[j][0] * v[j][0] + v[j][1] * v[j][1]) + (v[j][2] * v[j][2] + v[j][3] * v[j][3]); }
    const float rstd = rsqrtf(wave_sum(s) * (1.f / DM) + 1e-6f);
#pragma unroll
    for (int j = 0; j < 4; ++j) v[j] = v[j] * rstd * ((const f32x4*)P.ple_norm)[64 * j + lane];
    store_row_fp8(P.ws + WS_XN + (size_t)row * DM, lane, v);
}

constexpr int NPHASE = 13;
__global__ void __launch_bounds__(NTHREADS, 2) mega_fwd(Params Pkarg_unused) {
    extern __shared__ __attribute__((aligned(16))) unsigned char smem[];
    LAS unsigned char* lds = (LAS unsigned char*)smem;
    const int tid = threadIdx.x, lane = tid & 63, wave = __builtin_amdgcn_readfirstlane(tid >> 6);
    const int G = gridDim.x, blk = blockIdx.x;
#define P (*kpp)
#ifndef MK_REP
#define MK_REP -1
#endif
#define PHASE_BEGIN(k) if (IN(k)) for (int rep_ = 0; rep_ < ((k) == MK_REP ? 2 : 1); ++rep_) { const __attribute__((address_space(4))) Params* kpp = kp_fresh();
#define PHASE_END(k) } if (BOTH(k)) xcd_barrier(bar);
#define IN(k) (ph_lo <= (k) && (k) < ph_hi)
#define BOTH(k) (IN(k) && IN((k) + 1))
    const __attribute__((address_space(4))) Params* kpp = kp_fresh();
    unsigned* ctl = (unsigned*)(P.ws + WS_CTL);
    volatile LAS unsigned* MISC = (volatile LAS unsigned*)(lds + MISC_OFF);
    LAS int* tab = (LAS int*)(lds + MISC_OFF + MISC_TAB);
    if (tid < 16) MISC[tid] = 0u;
    __syncthreads();
    XcdBarrier bar = xcd_barrier_post(ctl + CW_BAR, MISC);
    unsigned char* const wsb = P.ws;
    const int ph_lo = P.ph_lo, ph_hi = P.ph_hi;

    PHASE_BEGIN(0)
        phase_prep_weights(P, lds, blk * NWAVES + wave, G * NWAVES, wave, lane);
        phase_cvt_p(P, blk * NTHREADS + tid, G * NTHREADS);
        __syncthreads();
        LAS float* wff = (LAS float*)lds; LAS float* lf = (LAS float*)(lds + 32768);
        load_wff(P, wff, tid, NTHREADS); __syncthreads();
        for (int i = 0; i < 16; ++i) { const int rl = wave * 16 + i; norm1_row(P, blk * 128 + rl, lane, wff, lf + rl * 8); }
        __syncthreads();
        if (tid < 8) { float run = 0.f; float* cloc = (float*)(P.ws + WS_LOGF) + (size_t)blk * 128 * 8 + tid;
            for (int r = 0; r < 128; ++r) { run += lf[r * 8 + tid]; cloc[r * 8] = run; }
            ((float*)(P.ws + WS_CTOT))[blk * 8 + tid] = run; }
        if (blk >= G - 16) rt::build_w(P, blk - (G - 16), tid);
    PHASE_END(0)

    PHASE_BEGIN(1)
        {
            LAS float* pfx = (LAS float*)(lds + MISC_OFF + MISC_PFX);
            if (tid < 64) { const float* ct = (const float*)(wsb + WS_CTOT); const int j = (blk & ~63) + tid; float v8[8];
#pragma unroll
                for (int h = 0; h < 8; ++h) v8[h] = (j < blk) ? ct[j * 8 + h] : 0.f;
#pragma unroll
                for (int h = 0; h < 8; ++h) { const float s = wave_sum(v8[h]); if (tid == 0) pfx[h] = s; } }
            __syncthreads();
            const float* cloc = (const float*)(wsb + WS_LOGF) + (size_t)blk * 128 * 8; float* c2 = (float*)(P.ws + WS_C2);
            for (int i = tid; i < 1024; i += NTHREADS) { const int r = i >> 3, h = i & 7; const int row = blk * 128 + r, b = row >> 13, t = row & (SEQ - 1);
                c2[((size_t)(b * 8 + h)) * SEQ + t] = (cloc[i] + pfx[h]) * LOG2E; }
            __syncthreads();
        }
        {
            pg8::DenseOrder S{(const bf16_t*)(wsb + WS_XN), (const bf16_t*)(wsb + WS_WIN), 1024, NTOK / 256, ZW / 256, G, blk};
            pg8::EpiIn E{(bf16_t*)(P.ws + WS_Z), P.q_norm, P.k_norm};
            pg8::gemm_phase<pg8::EpiIn, pg8::DenseOrder, true>(lds, 1024, S, E);
        }
        {
            pg8::DenseOrder S{(const bf16_t*)((unsigned char*)P.out + DO_PB), (const bf16_t*)(wsb + WS_WPP), PLE, NTOK / 256, DM / 256, G / 2, blk >= G / 2 ? blk - G / 2 : (1 << 20)};
            pg8::EpiBf16 E{(bf16_t*)((unsigned char*)P.out + DO_PJ), DM};
            pg8::gemm_phase<pg8::EpiBf16, pg8::DenseOrder, true>(lds, PLE, S, E);
        }
    PHASE_END(1)

    PHASE_BEGIN(2)
        rk::lora_block(P, lds, blk, G, tid);
    PHASE_END(2)

    PHASE_BEGIN(3)
        for (int task = blk; task < NB * NH * rk::NCHUNK; task += G) rk::pass1_chunk(P, lds, task >> 7, task & 127, tid);
    PHASE_END(3)

    PHASE_BEGIN(4)
        if (blk < NB * NH) rk::pass2_seq(P, lds, blk, tid);
        for (;;) {
            __syncthreads();
            if (tid == 0) MISC[MISC_Q / 4] = __hip_atomic_fetch_add(ctl + CW_QATT + 64 * rep_, 1u, RLX_AGENT);
            __syncthreads();
            const int q = (int)MISC[MISC_Q / 4];
            if (q >= 1024) break;
            { const int bh = q & 31, qb = 31 - (q >> 5); const float* c2 = (const float*)(wsb + WS_C2) + (size_t)bh * SEQ;
              const int t0 = attn_t0(P, c2, qb * 256, lane);
              attn_body::attn_unit<8>(bh >> 3, bh & 7, qb, t0, (const bf16_t*)(wsb + WS_Z), c2, (bf16_t*)(P.ws + WS_AO), (char*)smem); }
        }
    PHASE_END(4)

    PHASE_BEGIN(5)
        for (int task = blk; task < NB * NH * rk::NCHUNK; task += G) rk::pass3_chunk(P, lds, task >> 7, task & 127, tid);
    PHASE_END(5)

    PHASE_BEGIN(6)
        pg8::DenseOrder S{(const bf16_t*)(wsb + WS_AO), (const bf16_t*)(wsb + WS_WOUT), 1024, NTOK / 256, DM / 256, G, blk};
        pg8::EpiOut E{P.x, (bf16_t*)(P.ws + WS_X1)};
        pg8::gemm_phase<pg8::EpiOut, pg8::DenseOrder, true>(lds, 1024, S, E);
    PHASE_END(6)

    PHASE_BEGIN(7)
        rt::copy_w(P, lds, tid);
        if (blk == 0 && tid < 256) ((unsigned*)(P.ws + WS_XN + (size_t)NTOK * DM))[tid] = 0u;
        __syncthreads();
        for (int task = wave * G + blk; task < NTOK / 32; task += NWAVES * G) rt::route_task(P, lds, task, lane);
    PHASE_END(7)

    PHASE_BEGIN(8)
        const int nblk = pg8::moe_tables(tab, (const unsigned*)(wsb + WS_CTL) + CW_CNT);
        pg8::MoeOrder S{wsb + WS_XN, wsb + WS_WGU, (const int*)(wsb + WS_TOKSLOT), (const float*)(wsb + WS_GATESLOT), tab, nblk, 8, G, blk, true};
        pg8::EpiGu E{P.ws + WS_ACT, P.b_gu};
        pg8::gemm_phase<pg8::EpiGu, pg8::MoeOrder, true, true>(lds, 1024, S, E);
    PHASE_END(8)
    PHASE_BEGIN(9)
        const int nblk = pg8::moe_tables(tab, (const unsigned*)(wsb + WS_CTL) + CW_CNT);
        pg8::MoeOrder S{wsb + WS_ACT, wsb + WS_WDN, (const int*)(wsb + WS_TOKSLOT), (const float*)(wsb + WS_GATESLOT), tab, nblk, 4, G, blk, false};
        pg8::EpiDn E{P.ws + WS_YP, P.b_down, (const float*)(wsb + WS_GATESLOT), tab};
        pg8::gemm_phase<pg8::EpiDn, pg8::MoeOrder, true, true>(lds, 1024, S, E);
    PHASE_END(9)
    PHASE_BEGIN(10)
        (void)pg8::moe_tables(tab, (const unsigned*)(wsb + WS_CTL) + CW_CNT);
        for (int row = blk * NWAVES + wave; row < NTOK; row += G * NWAVES) combine_row(P, tab, row, lane);
    PHASE_END(10)
    PHASE_BEGIN(11)
        pg8::DenseOrder S{wsb + WS_XN, wsb + WS_WPG, 512, NTOK / 256, DM / 256, G, blk};
        pg8::EpiPg E{(bf16_t*)(P.ws + WS_X1), (const bf16_t*)((unsigned char*)P.out + DO_PJ)};
        pg8::gemm_phase<pg8::EpiPg, pg8::DenseOrder, true, true>(lds, 1024, S, E);
    PHASE_END(11)
    PHASE_BEGIN(12)
        const bool dead = __hip_atomic_load(ctl + CW_BAR + XB_TMO, RLX_AGENT) != 0u;
        for (int row = blk * NWAVES + wave; row < NTOK; row += G * NWAVES) final_row(P, row, lane, dead);
    PHASE_END(12)
}
#undef P
extern "C" void kernel_launch(void* const* d_in, const int* in_sizes, int n_in, void* d_out, int out_size, void* d_ws, size_t ws_size, hipStream_t stream) {
    static int ok = 0;
    if (ok == 0) {
        if (n_in != 30 || in_sizes[0] != NTOK * DM || out_size != NTOK * DM || ws_size < WS_END) { fprintf(stderr, "kernel_launch: unexpected shapes (n_in %d, ws %zu)\n", n_in, ws_size); ok = -1; return; }
        if (hipFuncSetAttribute((const void*)mega_fwd, hipFuncAttributeMaxDynamicSharedMemorySize, LDS_BYTES) != hipSuccess) { fprintf(stderr, "kernel_launch: hipFuncSetAttribute failed\n"); ok = -1; return; }
        int dev = 0, cus = 0, per_cu = 0;
        if (hipGetDevice(&dev) != hipSuccess || hipDeviceGetAttribute(&cus, hipDeviceAttributeMultiprocessorCount, dev) != hipSuccess) { ok = -1; return; }
        if (hipOccupancyMaxActiveBlocksPerMultiprocessor(&per_cu, (const void*)mega_fwd, NTHREADS, LDS_BYTES) != hipSuccess || per_cu < 1) { fprintf(stderr, "kernel_launch: occupancy query says %d\n", per_cu); }
        (void)hipGetLastError();
        if (cus != 256) { fprintf(stderr, "kernel_launch: built for 256 CUs, device has %d\n", cus); ok = -1; return; }
        ok = 1;
    }
    if (ok < 0) return;
    Params P{};
    const float** pp = (const float**)&P;
    for (int i = 0; i < 30; ++i) pp[i] = (const float*)d_in[i];
    P.out = (float*)d_out; P.ws = (unsigned char*)d_ws;
    if (hipMemsetAsync((char*)d_ws + WS_CTL, 0, CTL_BYTES, stream) != hipSuccess) return;
#ifndef MK_CUTS
#define MK_CUTS 0
#endif
    if (MK_CUTS == 0) { P.ph_lo = 0; P.ph_hi = NPHASE; hipLaunchKernelGGL(mega_fwd, dim3(256), dim3(NTHREADS), LDS_BYTES, stream, P); }
    else for (int k = 0; k < NPHASE; ++k) { P.ph_lo = k; P.ph_hi = k + 1;
        hipLaunchKernelGGL(mega_fwd, dim3(256), dim3(NTHREADS), LDS_BYTES, stream, P); }
}
```

```cpp
#include <hip/hip_runtime.h>
#include <cstdio>
#include <cstdint>

#define LAS __attribute__((address_space(3)))
#define GAS __attribute__((address_space(1)))
typedef unsigned short bf16_t;
typedef short bf16x8 __attribute__((ext_vector_type(8)));
typedef float f32x2 __attribute__((ext_vector_type(2)));
typedef float f32x4 __attribute__((ext_vector_type(4)));
typedef float f32x16 __attribute__((ext_vector_type(16)));
typedef unsigned u32x2 __attribute__((ext_vector_type(2)));
typedef unsigned u32x4 __attribute__((ext_vector_type(4)));

constexpr int NB = 4, SEQ = 8192, NTOK = NB * SEQ, DM = 1024;
constexpr int NH = 8, HD = 64;
constexpr int INW = 3848;
constexpr int ZW = 3840;
constexpr int ZQ = 0, ZK = 512, ZV = 1024, ZOG = 1536, ZR = 2048;
constexpr int RW_R = 0, RW_K = 512, RW_V = 1024, RW_W = 1536, RW_A = 1600, RW_G = 1664, RWIN = 1792;
constexpr int NE = 32, TOPK = 4, EFF = 1024;
constexpr int MAXBLK = (NTOK * TOPK) / 256 + NE;
constexpr int PLE = 256;
constexpr float LOG2E = 1.4426950408889634f;
constexpr float QSCALE = 0.125f * LOG2E;

constexpr size_t MiB = 1u << 20;
constexpr size_t WS_CTL = 0, CTL_BYTES = 1 * MiB;
constexpr size_t WS_C2 = 1 * MiB;
constexpr size_t WS_LOGF = 2 * MiB;
constexpr size_t WS_ROUTE = 3 * MiB;
constexpr size_t WS_TOKSLOT = 5 * MiB;
constexpr size_t WS_GATESLOT = 9 * MiB;
constexpr size_t WS_CTOT = 13 * MiB;
constexpr size_t WS_WIN = 16 * MiB;
constexpr size_t WS_WOUT = 24 * MiB;
constexpr size_t WS_WPG = 26 * MiB;
constexpr size_t WS_WPP = 28 * MiB;
constexpr size_t WS_WGU = 32 * MiB;
constexpr size_t WS_WDN = 160 * MiB;
constexpr size_t WS_XN = 224 * MiB;
constexpr size_t WS_X1 = 290 * MiB;
constexpr size_t WS_Z = 418 * MiB;
constexpr size_t WS_AO = 658 * MiB;
constexpr size_t WS_ACT = 418 * MiB;
constexpr size_t WS_RW = 722 * MiB;
constexpr size_t WS_RR = WS_RW, WS_RK = WS_RW + 32 * MiB, WS_RV = WS_RW + 64 * MiB, WS_RG = WS_RW + 96 * MiB;
constexpr size_t WS_RLW = WS_RW + 128 * MiB;
constexpr size_t WS_RKK = WS_RW + 160 * MiB, WS_RKA = WS_RW + 192 * MiB;
constexpr size_t WS_YP = 722 * MiB;
constexpr size_t WS_END = 994 * MiB;
static_assert(WS_ACT + (size_t)MAXBLK * 256 * 1024 * 2 <= WS_RW && WS_YP + (size_t)MAXBLK * 256 * 1024 * 2 <= WS_END, "ws map");
constexpr size_t DO_PJ = 0, DO_PB = 64 * MiB;
constexpr int CW_TMO = 0, CW_CNT = 64  , CW_BAR = 4096;

struct Params {
    const float *x, *p, *mix_norm, *w_in, *f_bias, *q_norm, *k_norm, *mu, *w0, *w2, *a0, *a2, *g2, *k_k, *k_a, *r_k, *ln_w, *ln_b, *w_out, *moe_norm, *w_router, *b_router, *w_gu, *b_gu, *w_down,
        *b_down, *ple_norm, *w_pg, *w_pp, *final_norm;
    float* out; unsigned char* ws; int ph_lo, ph_hi;
};

typedef const __attribute__((address_space(4))) Params& KPR;
__device__ __forceinline__ const __attribute__((address_space(4))) Params* kp_fresh() {
    unsigned long long p = (unsigned long long)__builtin_amdgcn_kernarg_segment_ptr(); asm volatile("" : "+s"(p)); return (const __attribute__((address_space(4))) Params*)p; }

typedef __bf16 bf16x2_hw __attribute__((ext_vector_type(2)));
__device__ __forceinline__ unsigned pk2(float lo, float hi) { const f32x2 v = {lo, hi}; return __builtin_bit_cast(unsigned, __builtin_convertvector(v, bf16x2_hw)); }
__device__ __forceinline__ unsigned f2bf(float f) { return pk2(f, f) & 0xffffu; }
__device__ __forceinline__ float bf2f(unsigned h) { return __builtin_bit_cast(float, h << 16); }
__device__ __forceinline__ float bflo(unsigned w) { return __builtin_bit_cast(float, w << 16); }
__device__ __forceinline__ float bfhi(unsigned w) { return __builtin_bit_cast(float, w & 0xffff0000u); }
__device__ __forceinline__ unsigned cvt_pk_bf16(float lo, float hi) { unsigned r; asm volatile("v_cvt_pk_bf16_f32 %0, %1, %2" : "=v"(r) : "v"(lo), "v"(hi)); return r; }
__device__ __forceinline__ unsigned pk4_fp8(float a, float b, float c, float d) { int w = 0; w = __builtin_amdgcn_cvt_pk_fp8_f32(a, b, w, false); w = __builtin_amdgcn_cvt_pk_fp8_f32(c, d, w, true); return (unsigned)w; }
#define DPP_ADD(v, ctrl) ((v) + __builtin_bit_cast(float, __builtin_amdgcn_mov_dpp(__builtin_bit_cast(int, (v)), (ctrl), 0xF, 0xF, true)))
__device__ __forceinline__ float wave_sum(float v) {
    v = DPP_ADD(v, 0xB1);
    v = DPP_ADD(v, 0x4E);
    v = DPP_ADD(v, 0x124);
    v = DPP_ADD(v, 0x128);
    { float a = v, b = v; asm volatile("s_nop 1\n\tv_permlane16_swap_b32 %0, %1" : "+v"(a), "+v"(b)); v = a + b; }
    { float a = v, b = v; asm volatile("s_nop 1\n\tv_permlane32_swap_b32 %0, %1" : "+v"(a), "+v"(b)); v = a + b; }
    return v;
}
__device__ __forceinline__ float sigmoidf_(float x) { return __builtin_amdgcn_rcpf(1.0f + __expf(-x)); }
__device__ __forceinline__ float logsigmoidf_(float x) { return fminf(x, 0.f) - log1pf(expf(-fabsf(x))); }
namespace pg8 {
constexpr int BM = 256, BK = 64, HALF = 128, HTB = HALF * BK * 2, STAGE_BYTES = 8 * HTB, NXCD = 8, WGM = 8;
__host__ __device__ __forceinline__ int lds_byte(int r, int c) { const int st = (r >> 4) * 2 + (c >> 5), rr = r & 15, cc = c & 31, ob = rr * 64 + cc * 2; return st * 1024 + (ob ^ (((ob >> 9) & 1) << 5)); }
__host__ __device__ __forceinline__ void stage_rc(int b, int& R, int& C) { const int st = b / 1024, sb = b % 1024, swz = sb ^ (((sb >> 9) & 1) << 5); R = (st >> 1) * 16 + swz / 64; C = (st & 1) * 32 + (swz % 64) / 2; }
__host__ __device__ __forceinline__ int perm32(int rho) { const int n = rho >> 4, i = rho & 15; return 8 * (i >> 2) + 4 * n + (i & 3); }

struct Unit { int pm, pn, e, lb, sl; };

__device__ __forceinline__ bool tile_order(int i, int G, int c, int nM, int nN, int& pm, int& pn) {
    const int nwg = nM * nN; const long L = (long)i * G + c; if (L >= nwg) return false;
    int wgid = (int)L; { const int q = nwg / NXCD, r = nwg % NXCD, xcd = wgid % NXCD, off = wgid / NXCD; wgid = (xcd < r ? xcd * (q + 1) : r * (q + 1) + (xcd - r) * q) + off; }
    const int nig = WGM * nN, gid = wgid / nig, fm = gid * WGM, gsz = (nM - fm) < WGM ? (nM - fm) : WGM;
    pm = fm + ((wgid % nig) % gsz); pn = (wgid % nig) / gsz; return true;
}
struct DenseOrder {
    const void* A; const void* Bt; int K  , nM, nN, G, c;
    __device__ __forceinline__ bool next(int i, Unit& u) const { u.e = 0; u.lb = 0; return tile_order(i, G, c, nM, nN, u.pm, u.pn); }
    __device__ __forceinline__ const char* a_base(const Unit& u) const { return (const char*)A + (size_t)u.pm * BM * K * 2; }
    __device__ __forceinline__ const char* b_base(const Unit& u) const { return (const char*)Bt + (size_t)u.pn * BM * K * 2; }
    __device__ __forceinline__ void prefetch(const Unit&, int, int, int) const {}
    __device__ __forceinline__ void a_off(const Unit&, const int (&R)[2], const int (&C)[2], unsigned (&off)[2][2]) const {
#pragma unroll
        for (int h = 0; h < 2; ++h)
#pragma unroll
            for (int i = 0; i < 2; ++i) off[h][i] = (unsigned)((R[i] + HALF * h) * K + C[i]) * 2u;
    }
};

typedef int v8i32 __attribute__((ext_vector_type(8)));
typedef int i32x4 __attribute__((ext_vector_type(4)));
template <class Epi, class Sched, bool ALIGN_EPI, bool FP8 = false>
__device__ __forceinline__ void gemm_phase(LAS unsigned char* lds, const int K, const Sched& S, const Epi& E) {
    int tid_ = threadIdx.x; asm volatile("" : "+v"(tid_));
    const int tid = tid_, wid = __builtin_amdgcn_readfirstlane(tid >> 6), lane = tid & 63, wr = wid >> 2, wc = wid & 3, fr = lane & 15, fq = lane >> 4;
    const int RB = FP8 ? K : 2 * K;
    const int nt = RB / (BK * 2);
    int sR[2], sC[2]; unsigned voffB[2];
#pragma unroll
    for (int i = 0; i < 2; ++i) { int R, C; stage_rc(tid * 16 + i * 8192, R, C); const int Rb = Epi::PERM ? ((R & ~31) + perm32(R & 31)) : R; sR[i] = R; sC[i] = C; voffB[i] = (unsigned)(Rb * RB + C * 2); }
    const size_t kstep = (size_t)(BK * 2);
    const size_t hstep = (size_t)HALF * RB;
    const unsigned ldsw = (unsigned)wid * 1024u;
    const int aoff0 = FP8 ? lds_byte(wr * 64 + fr, fq * 16) : lds_byte(wr * 64 + fr, fq * 8), aoff1 = FP8 ? lds_byte(wr * 64 + fr, fq * 16 + 8) : aoff0 + 1024;
    const int boff0 = FP8 ? lds_byte(wc * 32 + fr, fq * 16) : lds_byte(wc * 32 + fr, fq * 8), boff1 = FP8 ? lds_byte(wc * 32 + fr, fq * 16 + 8) : boff0 + 1024;
#define PG8_SA(b, h) (((b) * 2 + (h)) * HTB)
#define PG8_SB(b, h) ((4 + (b) * 2 + (h)) * HTB)
#define PG8_STAGE(bufoff, gbase, voff) do { _Pragma("unroll") for (int _i = 0; _i < 2; ++_i) \
        __builtin_amdgcn_global_load_lds((const unsigned*)((const char*)(gbase) + (voff)[_i]), (LAS unsigned*)(lds + (bufoff) + ldsw + _i * 8192), 16, 0, 0); } while (0)
#define PG8_CAT(p0, p1) __builtin_shufflevector((p0), (p1), 0, 1, 2, 3, 4, 5, 6, 7)
#define PG8_LDA(dst, b, h) do { _Pragma("unroll") for (int m = 0; m < 4; ++m) dst[m] = PG8_CAT(*(const LAS i32x4*)(lds + PG8_SA(b, h) + aoff0 + m * 2048), *(const LAS i32x4*)(lds + PG8_SA(b, h) + aoff1 + m * 2048)); } while (0)
#define PG8_LDB(dst, b, h) do { _Pragma("unroll") for (int n = 0; n < 2; ++n) dst[n] = PG8_CAT(*(const LAS i32x4*)(lds + PG8_SB(b, h) + boff0 + n * 2048), *(const LAS i32x4*)(lds + PG8_SB(b, h) + boff1 + n * 2048)); } while (0)
#define PG8_LO(x) __builtin_bit_cast(bf16x8, __builtin_shufflevector((x), (x), 0, 1, 2, 3))
#define PG8_HI(x) __builtin_bit_cast(bf16x8, __builtin_shufflevector((x), (x), 4, 5, 6, 7))
#define PG8_MMA(ai, bj, At, Bt) do { __builtin_amdgcn_s_setprio(1); \
        if constexpr (FP8) { _Pragma("unroll") for (int m = 0; m < 4; ++m) _Pragma("unroll") for (int n = 0; n < 2; ++n) \
            asm volatile("v_mfma_scale_f32_16x16x128_f8f6f4 %0, %1, %2, %0, %3, %4 op_sel_hi:[0,0,0]" : "+v"(acc[ai][bj][m][n]) : "v"(Bt[n]), "v"(At[m]), "v"(sc_w), "v"(sc_x)); } \
        else { _Pragma("unroll") for (int m = 0; m < 4; ++m) _Pragma("unroll") for (int n = 0; n < 2; ++n) { \
            acc[ai][bj][m][n] = __builtin_amdgcn_mfma_f32_16x16x32_bf16(PG8_LO(Bt[n]), PG8_LO(At[m]), acc[ai][bj][m][n], 0, 0, 0); } \
            _Pragma("unroll") for (int m = 0; m < 4; ++m) _Pragma("unroll") for (int n = 0; n < 2; ++n) { \
            acc[ai][bj][m][n] = __builtin_amdgcn_mfma_f32_16x16x32_bf16(PG8_HI(Bt[n]), PG8_HI(At[m]), acc[ai][bj][m][n], 0, 0, 0); } } \
        __builtin_amdgcn_s_setprio(0); } while (0)
#define PG8_WAIT_V(n) asm volatile("s_waitcnt vmcnt(" #n ")" ::: "memory")
#define PG8_WAIT_L(n) asm volatile("s_waitcnt lgkmcnt(" #n ")" ::: "memory")
#define PG8_BAR __builtin_amdgcn_s_barrier()
#define PG8_SCHED __builtin_amdgcn_sched_barrier(0)
    Unit cur, nxt; int ui = 0;
    if (!S.next(0, cur)) return;
    f32x4 acc[2][2][4][2];
#pragma unroll
    for (int a = 0; a < 2; ++a)
#pragma unroll
        for (int b = 0; b < 2; ++b)
#pragma unroll
            for (int m = 0; m < 4; ++m)
#pragma unroll
                for (int n = 0; n < 2; ++n) acc[a][b][m][n] = (f32x4){0.f, 0.f, 0.f, 0.f};
    const int sc_w = 121, sc_x = 127;
    v8i32 At[4], B0[2], B1[2];
    unsigned offC[2][2], offN[2][2];
    cur.sl = 0; S.prefetch(cur, 0, wid, lane); PG8_WAIT_V(0); PG8_BAR;
    S.a_off(cur, sR, sC, offC);
    const char* cA = S.a_base(cur); const char* cB = S.b_base(cur);
    PG8_STAGE(PG8_SB(0, 0), cB, voffB); PG8_STAGE(PG8_SB(0, 1), cB + hstep, voffB); PG8_STAGE(PG8_SA(0, 0), cA, offC[0]); PG8_STAGE(PG8_SA(0, 1), cA, offC[1]);
    if (wr == 1) PG8_BAR;
    PG8_WAIT_V(2); PG8_BAR;
    PG8_STAGE(PG8_SB(1, 0), cB + kstep, voffB); PG8_STAGE(PG8_SA(1, 0), cA + kstep, offC[0]); PG8_STAGE(PG8_SB(1, 1), cB + hstep + kstep, voffB);
    PG8_WAIT_V(6); PG8_BAR;
    for (;;) {
        const bool has_next = S.next(ui + 1, nxt);
        const char* nA = cA; const char* nB = cB;
        nxt.sl = cur.sl == 2 ? 0 : cur.sl + 1;
        if (has_next) { nA = S.a_base(nxt); nB = S.b_base(nxt); S.prefetch(nxt, nxt.sl, wid, lane); }
#pragma unroll
        for (int h = 0; h < 2; ++h)
#pragma unroll
            for (int i = 0; i < 2; ++i) offN[h][i] = offC[h][i];
#pragma nounroll
        for (int t = 0; t < nt; t += 2) {
            const bool last = (t == nt - 2);
            if (last && has_next) S.a_off(nxt, sR, sC, offN);
            const char* a1 = cA + (size_t)(t + 1) * kstep;
            const char* a2 = last ? nA : cA + (size_t)(t + 2) * kstep; const char* b2 = last ? nB : cB + (size_t)(t + 2) * kstep;
            const char* a3 = a2 + kstep; const char* b3 = b2 + kstep;
            unsigned o2[2][2];
#pragma unroll
            for (int h = 0; h < 2; ++h)
#pragma unroll
                for (int i = 0; i < 2; ++i) o2[h][i] = last ? offN[h][i] : offC[h][i];
            PG8_LDB(B0, 0, 0); PG8_LDB(B1, 0, 1); PG8_SCHED; PG8_LDA(At, 0, 0); PG8_STAGE(PG8_SA(1, 1), a1, offC[1]);
            PG8_WAIT_V(8); PG8_WAIT_L(0); PG8_BAR; PG8_MMA(0, 0, At, B0); PG8_MMA(0, 1, At, B1); PG8_BAR; PG8_SCHED;
            PG8_LDA(At, 0, 1); PG8_STAGE(PG8_SB(0, 0), b2, voffB); PG8_STAGE(PG8_SB(0, 1), b2 + hstep, voffB); PG8_STAGE(PG8_SA(0, 0), a2, o2[0]);
            PG8_WAIT_V(8); PG8_WAIT_L(0); PG8_BAR; PG8_MMA(1, 0, At, B0); PG8_MMA(1, 1, At, B1); PG8_BAR; PG8_SCHED;
            PG8_LDB(B0, 1, 0); PG8_LDB(B1, 1, 1); PG8_SCHED; PG8_LDA(At, 1, 0); PG8_STAGE(PG8_SA(0, 1), a2, o2[1]);
            PG8_WAIT_V(8); PG8_WAIT_L(0); PG8_BAR; PG8_MMA(0, 0, At, B0); PG8_MMA(0, 1, At, B1); PG8_BAR; PG8_SCHED;
            PG8_LDA(At, 1, 1); PG8_STAGE(PG8_SB(1, 0), b3, voffB); PG8_STAGE(PG8_SB(1, 1), b3 + hstep, voffB); PG8_STAGE(PG8_SA(1, 0), a3, o2[0]);
            PG8_WAIT_V(8); PG8_WAIT_L(0); PG8_BAR; PG8_MMA(1, 0, At, B0); PG8_MMA(1, 1, At, B1); PG8_BAR; PG8_SCHED;
        }
        if constexpr (ALIGN_EPI) { if (wr == 0) PG8_BAR; }
        E(acc, cur, wr, wc, fr, fq);
        if (!has_next) break;
#pragma unroll
        for (int a = 0; a < 2; ++a)
#pragma unroll
            for (int b = 0; b < 2; ++b)
#pragma unroll
                for (int m = 0; m < 4; ++m)
#pragma unroll
                    for (int n = 0; n < 2; ++n) acc[a][b][m][n] = (f32x4){0.f, 0.f, 0.f, 0.f};
        cur = nxt; cA = nA; cB = nB; ++ui;
#pragma unroll
        for (int h = 0; h < 2; ++h)
#pragma unroll
            for (int i = 0; i < 2; ++i) offC[h][i] = offN[h][i];
        if constexpr (ALIGN_EPI) { if (wr == 1) PG8_BAR; }
    }
    PG8_WAIT_V(0);
    if constexpr (!ALIGN_EPI) { if (wr == 0) PG8_BAR; }
    PG8_BAR;
#undef PG8_SA
#undef PG8_SB
#undef PG8_STAGE
#undef PG8_LDA
#undef PG8_LDB
#undef PG8_MMA
#undef PG8_LO
#undef PG8_HI
#undef PG8_CAT
#undef PG8_WAIT_V
#undef PG8_WAIT_L
#undef PG8_BAR
#undef PG8_SCHED
}
}
namespace pg8 {
constexpr int T_BLKSTART = 0  , T_CNT = 40  , T_BLKE = 80  , T_WORDS = 80 + 560;
constexpr int TB_OFF = 8192 - 64;

struct EpiIn {
    static constexpr bool PERM = true;
    bf16_t* Z; const float* qn; const float* kn;
    __device__ __forceinline__ void operator()(const f32x4 (&acc)[2][2][4][2], const Unit& u, int wr, int wc, int fr, int fq) const {
        const int row0 = u.pm * BM + wr * 64 + fr;
        if (u.pn < 4) {
            const float* g = (u.pn < 2) ? qn : kn; const float sc = (u.pn < 2) ? QSCALE : 1.0f;
            f32x4 gv[2][2];
#pragma unroll
            for (int bj = 0; bj < 2; ++bj)
#pragma unroll
                for (int n = 0; n < 2; ++n) gv[bj][n] = *(const f32x4*)(g + 32 * bj + 8 * fq + 4 * n) * sc;
#pragma unroll
            for (int ai = 0; ai < 2; ++ai)
#pragma unroll
                for (int m = 0; m < 4; ++m) {
                    float ss = 0.f;
#pragma unroll
                    for (int bj = 0; bj < 2; ++bj)
#pragma unroll
                        for (int n = 0; n < 2; ++n) { const f32x4 x = acc[ai][bj][m][n]; ss += (x[0] * x[0] + x[1] * x[1]) + (x[2] * x[2] + x[3] * x[3]); }
                    ss += __shfl_xor(ss, 16); ss += __shfl_xor(ss, 32);
                    const float rstd = rsqrtf(ss * (1.0f / 64.0f) + 1e-6f);
                    bf16_t* rowp = Z + (size_t)(row0 + ai * HALF + m * 16) * ZW + u.pn * BM + 64 * wc + 8 * fq;
#pragma unroll
                    for (int bj = 0; bj < 2; ++bj) { const f32x4 v0 = acc[ai][bj][m][0] * rstd * gv[bj][0], v1 = acc[ai][bj][m][1] * rstd * gv[bj][1];
                        u32x4 w; w.x = cvt_pk_bf16(v0[0], v0[1]); w.y = cvt_pk_bf16(v0[2], v0[3]); w.z = cvt_pk_bf16(v1[0], v1[1]); w.w = cvt_pk_bf16(v1[2], v1[3]);
                        *(u32x4*)(rowp + 32 * bj) = w; }
                }
        } else {
            const int col0 = u.pn * BM + wc * 32 + 8 * fq;
#pragma unroll
            for (int ai = 0; ai < 2; ++ai)
#pragma unroll
                for (int m = 0; m < 4; ++m) { bf16_t* rowp = Z + (size_t)(row0 + ai * HALF + m * 16) * ZW + col0;
#pragma unroll
                    for (int bj = 0; bj < 2; ++bj) { const f32x4 v0 = acc[ai][bj][m][0], v1 = acc[ai][bj][m][1];
                        u32x4 w; w.x = cvt_pk_bf16(v0[0], v0[1]); w.y = cvt_pk_bf16(v0[2], v0[3]); w.z = cvt_pk_bf16(v1[0], v1[1]); w.w = cvt_pk_bf16(v1[2], v1[3]);
                        *(u32x4*)(rowp + bj * HALF) = w; } }
        }
    }
};
struct EpiBf16 {
    static constexpr bool PERM = true;
    bf16_t* O; int ldc;
    __device__ __forceinline__ void operator()(const f32x4 (&acc)[2][2][4][2], const Unit& u, int wr, int wc, int fr, int fq) const {
        const int row0 = u.pm * BM + wr * 64 + fr, col0 = u.pn * BM + wc * 32 + 8 * fq;
#pragma unroll
        for (int ai = 0; ai < 2; ++ai)
#pragma unroll
            for (int m = 0; m < 4; ++m) { bf16_t* rowp = O + (size_t)(row0 + ai * HALF + m * 16) * ldc + col0;
#pragma unroll
                for (int bj = 0; bj < 2; ++bj) { const f32x4 v0 = acc[ai][bj][m][0], v1 = acc[ai][bj][m][1];
                    u32x4 w; w.x = cvt_pk_bf16(v0[0], v0[1]); w.y = cvt_pk_bf16(v0[2], v0[3]); w.z = cvt_pk_bf16(v1[0], v1[1]); w.w = cvt_pk_bf16(v1[2], v1[3]);
                    *(u32x4*)(rowp + bj * HALF) = w; } }
    }
};
struct EpiOut {
    static constexpr bool PERM = true;
    const float* X; bf16_t* O;
    __device__ __forceinline__ void operator()(const f32x4 (&acc)[2][2][4][2], const Unit& u, int wr, int wc, int fr, int fq) const {
        const int row0 = u.pm * BM + wr * 64 + fr, col0 = u.pn * BM + wc * 32 + 8 * fq;
#pragma unroll
        for (int ai = 0; ai < 2; ++ai)
#pragma unroll
            for (int m = 0; m < 4; ++m) { const size_t off = (size_t)(row0 + ai * HALF + m * 16) * DM + col0;
#pragma unroll
                for (int bj = 0; bj < 2; ++bj) { const f32x4 v0 = *(const f32x4*)(X + off + bj * HALF) + acc[ai][bj][m][0], v1 = *(const f32x4*)(X + off + bj * HALF + 4) + acc[ai][bj][m][1];
                    u32x4 w; w.x = pk2(v0[0], v0[1]); w.y = pk2(v0[2], v0[3]); w.z = pk2(v1[0], v1[1]); w.w = pk2(v1[2], v1[3]);
                    *(u32x4*)(O + off + bj * HALF) = w; }
                if (m & 1) asm volatile("" ::: "memory"); }
    }
};
struct EpiPg {
    static constexpr bool PERM = true;
    bf16_t* X; const bf16_t* PJ;
    __device__ __forceinline__ void operator()(const f32x4 (&acc)[2][2][4][2], const Unit& u, int wr, int wc, int fr, int fq) const {
        const int row0 = u.pm * BM + wr * 64 + fr, col0 = u.pn * BM + wc * 32 + 8 * fq;
#pragma unroll
        for (int ai = 0; ai < 2; ++ai)
#pragma unroll
            for (int m = 0; m < 4; ++m) { const size_t off = (size_t)(row0 + ai * HALF + m * 16) * DM + col0;
#pragma unroll
                for (int bj = 0; bj < 2; ++bj) { const size_t o = off + bj * HALF; const u32x4 pj = *(const u32x4*)(PJ + o), xv = *(const u32x4*)(X + o);
                    const unsigned pw[4] = {pj.x, pj.y, pj.z, pj.w}, xw[4] = {xv.x, xv.y, xv.z, xv.w}; unsigned ow[4];
#pragma unroll
                    for (int q = 0; q < 4; ++q) { const float a0 = acc[ai][bj][m][q >> 1][2 * (q & 1)], a1 = acc[ai][bj][m][q >> 1][2 * (q & 1) + 1];
                        ow[q] = pk2(bflo(xw[q]) + sigmoidf_(a0) * bflo(pw[q]), bfhi(xw[q]) + sigmoidf_(a1) * bfhi(pw[q])); }
                    *(u32x4*)(X + o) = (u32x4){ow[0], ow[1], ow[2], ow[3]}; }
                if (m & 1) asm volatile("" ::: "memory"); }
    }
};
struct EpiGu {
    static constexpr bool PERM = true;
    unsigned char* ACT; const float* b_gu;
    __device__ __forceinline__ void operator()(const f32x4 (&acc)[2][2][4][2], const Unit& u, int wr, int wc, int fr, int fq) const {
        const int row0 = u.pm * BM + wr * 64 + fr, cl = u.pn * HALF + wc * 32 + 8 * fq;
        const float* bg = b_gu + (size_t)u.e * 2048 + cl;
        f32x4 bgl[2], bli[2];
#pragma unroll
        for (int n = 0; n < 2; ++n) { bgl[n] = *(const f32x4*)(bg + 4 * n); bli[n] = *(const f32x4*)(bg + 1024 + 4 * n); }
#pragma unroll
        for (int ai = 0; ai < 2; ++ai)
#pragma unroll
            for (int m = 0; m < 4; ++m) { unsigned char* rowp = ACT + (size_t)(row0 + ai * HALF + m * 16) * EFF + cl; float r[8];
#pragma unroll
                for (int n = 0; n < 2; ++n)
#pragma unroll
                    for (int i = 0; i < 4; ++i) { const float gl = fminf(acc[ai][0][m][n][i] + bgl[n][i], 7.0f); const float li = fminf(fmaxf(acc[ai][1][m][n][i] + bli[n][i], -7.0f), 7.0f);
                        r[4 * n + i] = gl * sigmoidf_(1.702f * gl) * (li + 1.0f); }
                u32x2 w; w.x = pk4_fp8(r[0], r[1], r[2], r[3]); w.y = pk4_fp8(r[4], r[5], r[6], r[7]);
                *(u32x2*)rowp = w; }
    }
};
struct EpiDn {
    static constexpr bool PERM = true;
    unsigned char* YP; const float* b_dn; const float* gateslot; const LAS int* tab;
    __device__ __forceinline__ void operator()(const f32x4 (&acc)[2][2][4][2], const Unit& u, int wr, int wc, int fr, int fq) const {
        const int row0 = u.pm * BM + wr * 64 + fr, col0 = u.pn * BM + wc * 32 + 8 * fq;
        const float* bd = b_dn + (size_t)u.e * 1024 + col0; const int cnt = tab[T_CNT + u.e];
        f32x4 bv[2][2];
#pragma unroll
        for (int bj = 0; bj < 2; ++bj)
#pragma unroll
            for (int n = 0; n < 2; ++n) bv[bj][n] = *(const f32x4*)(bd + bj * HALF + 4 * n);
#pragma unroll
        for (int ai = 0; ai < 2; ++ai)
#pragma unroll
            for (int m = 0; m < 4; ++m) { const int rr = wr * 64 + fr + ai * HALF + m * 16, slot = u.lb * 256 + rr;
                const float gt = slot < cnt ? ((const LAS float*)((const LAS unsigned char*)tab + TB_OFF + u.sl * 1024))[rr] * 16.0f : 0.f;
                unsigned char* rowp = YP + (size_t)(row0 + ai * HALF + m * 16) * DM + col0;
#pragma unroll
                for (int bj = 0; bj < 2; ++bj) { const f32x4 v0 = (acc[ai][bj][m][0] + bv[bj][0]) * gt, v1 = (acc[ai][bj][m][1] + bv[bj][1]) * gt;
                    u32x2 w; w.x = pk4_fp8(v0[0], v0[1], v0[2], v0[3]); w.y = pk4_fp8(v1[0], v1[1], v1[2], v1[3]);
                    *(u32x2*)(rowp + bj * HALF) = w; } }
    }
};
struct MoeOrder {
    const unsigned char* A; const unsigned char* Bt; const int* tokslot; const float* gateslot;   const LAS int* tab; int nblk, nN, G, c; bool gather;
    __device__ __forceinline__ bool next(int i, Unit& u) const { if (!tile_order(i, G, c, nblk, nN, u.pm, u.pn)) return false; u.e = tab[T_BLKE + u.pm]; u.lb = u.pm - tab[T_BLKSTART + u.e]; return true; }
    __device__ __forceinline__ const char* a_base(const Unit& u) const { return gather ? (const char*)A : (const char*)A + (size_t)u.pm * BM * 1024; }
    __device__ __forceinline__ const char* b_base(const Unit& u) const { return (const char*)Bt + ((size_t)u.e * nN + u.pn) * BM * 1024; }
    __device__ __forceinline__ void prefetch(const Unit& u, int slot, int wid, int lane) const {
        if (wid < 4) { const unsigned* src = (gather ? (const unsigned*)tokslot : (const unsigned*)gateslot) + (size_t)u.e * NTOK + u.lb * 256 + wid * 64 + lane;
            __builtin_amdgcn_global_load_lds(src, (LAS unsigned*)((LAS unsigned char*)tab + TB_OFF + slot * 1024 + wid * 256), 4, 0, 0); }
    }
    __device__ __forceinline__ void a_off(const Unit& u, const int (&R)[2], const int (&C)[2], unsigned (&off)[2][2]) const {
        const int cnt = tab[T_CNT + u.e]; const LAS int* tb = (const LAS int*)((const LAS unsigned char*)tab + TB_OFF + u.sl * 1024);
#pragma unroll
        for (int h = 0; h < 2; ++h)
#pragma unroll
            for (int i = 0; i < 2; ++i) {
                if (gather) { const int rr = R[i] + HALF * h; const int tk = tb[rr]; const int tok = (u.lb * 256 + rr) < cnt ? tk : NTOK; off[h][i] = (unsigned)tok * 1024u + (unsigned)C[i] * 2u; }
                else off[h][i] = (unsigned)((R[i] + HALF * h) * 1024 + C[i] * 2);
            }
    }
};
__device__ __forceinline__ int moe_tables(LAS int* tab, const unsigned* cntw) {
    if (threadIdx.x == 0) { int s = 0; for (int e = 0; e < NE; ++e) { const int c = (int)cntw[e]; tab[T_CNT + e] = c; tab[T_BLKSTART + e] = s; const int nb = (c + 255) >> 8; for (int j = 0; j < nb; ++j) tab[T_BLKE + s + j] = e; s += nb; } tab[T_BLKSTART + NE] = s; }
    __syncthreads();
    return tab[T_BLKSTART + NE];
}
}
constexpr int NWAVES = 8, NTHREADS = 512;
constexpr int RING_BYTES = 131072, MISC_OFF = RING_BYTES, LDS_BYTES = 147456;

__device__ __forceinline__ void tr_item(const float* W, int ldw, int srccol0, int k0, bf16_t* WT, int Kd, int dstrow0, LAS float* scr, int lane) {
#pragma unroll 8
    for (int i = 0; i < 32; ++i) { const int kk = 2 * i + (lane >> 5); scr[kk * 33 + (lane & 31)] = W[(size_t)(k0 + kk) * ldw + srccol0 + (lane & 31)]; }
    asm volatile("s_waitcnt lgkmcnt(0)" ::: "memory");
    const int c = lane & 7;
#pragma unroll
    for (int j = 0; j < 4; ++j) { const int n = (lane >> 3) + 8 * j; const LAS float* s = scr + (8 * c) * 33 + n;
        u32x4 o; o.x = pk2(s[0 * 33], s[1 * 33]); o.y = pk2(s[2 * 33], s[3 * 33]); o.z = pk2(s[4 * 33], s[5 * 33]); o.w = pk2(s[6 * 33], s[7 * 33]);
        *(u32x4*)(WT + (size_t)(dstrow0 + n) * Kd + k0 + 8 * c) = o; }
    asm volatile("s_waitcnt lgkmcnt(0)" ::: "memory");
}
__device__ __forceinline__ void tr_item8(const float* W, int ldw, int srccol0, int k0, unsigned char* WT, int Kd, int dstrow0, LAS float* scr, int lane) {
#pragma unroll 8
    for (int i = 0; i < 32; ++i) { const int kk = 2 * i + (lane >> 5); scr[kk * 33 + (lane & 31)] = W[(size_t)(k0 + kk) * ldw + srccol0 + (lane & 31)]; }
    asm volatile("s_waitcnt lgkmcnt(0)" ::: "memory");
    const int c = lane & 7;
#pragma unroll
    for (int j = 0; j < 4; ++j) { const int n = (lane >> 3) + 8 * j; const LAS float* s = scr + (8 * c) * 33 + n;
        u32x2 o; o.x = pk4_fp8(s[0 * 33] * 64.f, s[1 * 33] * 64.f, s[2 * 33] * 64.f, s[3 * 33] * 64.f); o.y = pk4_fp8(s[4 * 33] * 64.f, s[5 * 33] * 64.f, s[6 * 33] * 64.f, s[7 * 33] * 64.f);
        *(u32x2*)(WT + (size_t)(dstrow0 + n) * Kd + k0 + 8 * c) = o; }
    asm volatile("s_waitcnt lgkmcnt(0)" ::: "memory");
}
constexpr int I_IN = 16 * 120, I_OUT = 16 * 32, I_PG = 16 * 32, I_PP = 4 * 32, I_GU1 = 16 * 64, I_DN1 = 16 * 32;
constexpr int I_LORA = 16 + 16 + 32;
constexpr int I_SMALL = I_IN + I_OUT + I_PG + I_PP + I_LORA, I_GU = NE * I_GU1, I_DN = NE * I_DN1, I_ALL = I_SMALL + I_GU + I_DN;
__device__ __forceinline__ void prep_item(KPR P, int it, LAS float* scr, int lane) {
    unsigned char* ws = P.ws;
    if (it < I_IN) { const int kb = it / 120, nb = it % 120, n0 = nb * 32, pn = n0 >> 8, j0 = n0 & 255;
        const int src = pn < 4 ? (pn * 256 + 64 * ((j0 & 127) >> 5) + 32 * (j0 >> 7)) : (n0 < 2048 ? n0 : n0 + 8);
        tr_item(P.w_in, INW, src, kb * 64, (bf16_t*)(ws + WS_WIN), 1024, n0, scr, lane); return; }
    it -= I_IN;
    if (it < I_OUT) { tr_item(P.w_out, 1024, (it % 32) * 32, (it / 32) * 64, (bf16_t*)(ws + WS_WOUT), 1024, (it % 32) * 32, scr, lane); return; }
    it -= I_OUT;
    if (it < I_PG) { tr_item8(P.w_pg, 1024, (it % 32) * 32, (it / 32) * 64, ws + WS_WPG, 1024, (it % 32) * 32, scr, lane); return; }
    it -= I_PG;
    if (it < I_PP) { tr_item(P.w_pp, 1024, (it % 32) * 32, (it / 32) * 64, (bf16_t*)(ws + WS_WPP), 256, (it % 32) * 32, scr, lane); return; }
    it -= I_PP;
    if (it < 16) { tr_item(P.w2, 512, it * 32, 0, (bf16_t*)(ws + 29 * MiB), 64, it * 32, scr, lane); return; }
    it -= 16;
    if (it < 16) { tr_item(P.a2, 512, it * 32, 0, (bf16_t*)(ws + 29 * MiB + 65536), 64, it * 32, scr, lane); return; }
    it -= 16;
    if (it < 32) { tr_item(P.g2, 512, (it % 16) * 32, (it / 16) * 64, (bf16_t*)(ws + 29 * MiB + 131072), 128, (it % 16) * 32, scr, lane); return; }
    it -= 32;
    if (it < I_GU) { const int e = it / I_GU1, r = it % I_GU1, kb = r / 64, nb = r % 64, n0 = nb * 32, pn = n0 >> 8, j0 = n0 & 255;
        const int src = (j0 >> 7) * 1024 + pn * 128 + (j0 & 127);
        tr_item8(P.w_gu + (size_t)e * 1024 * 2048, 2048, src, kb * 64, ws + WS_WGU + (size_t)e * 2048 * 1024, 1024, n0, scr, lane); return; }
    it -= I_GU;
    { const int e = it / I_DN1, r = it % I_DN1, kb = r / 32, nb = r % 32;
        tr_item8(P.w_down + (size_t)e * 1024 * 1024, 1024, nb * 32, kb * 64, ws + WS_WDN + (size_t)e * 1024 * 1024, 1024, nb * 32, scr, lane); }
}
__device__ __forceinline__ void phase_prep_weights(KPR P, LAS unsigned char* lds, int gw, int ngw, int wave, int lane) {
    LAS float* scr = (LAS float*)(lds + wave * 16384);
    for (int it = gw; it < I_SMALL; it += ngw) prep_item(P, it, scr, lane);
}
constexpr int NCVT = (I_GU + I_DN) / 64;
__device__ __forceinline__ void cvt_task(KPR P, LAS unsigned char* lds, int task, int wave, int lane) {
    LAS float* scr = (LAS float*)(lds + wave * 16384);
    for (int i = 0; i < 8; ++i) prep_item(P, I_SMALL + task * 64 + i * 8 + wave, scr, lane);
}
__device__ __forceinline__ void phase_cvt_p(KPR P, int gt, int ngt) {
    bf16_t* PB = (bf16_t*)((unsigned char*)P.out + DO_PB);
    for (int i = gt; i < NTOK * PLE / 8; i += ngt) { const f32x4 a = ((const f32x4*)P.p)[2 * i], b = ((const f32x4*)P.p)[2 * i + 1];
        u32x4 w; w.x = pk2(a[0], a[1]); w.y = pk2(a[2], a[3]); w.z = pk2(b[0], b[1]); w.w = pk2(b[2], b[3]); ((u32x4*)PB)[i] = w; }
}
__device__ __forceinline__ void rms_row(const float* xrow, const float* gain, int lane, f32x4 (&v)[4]) {
    const f32x4* xr = (const f32x4*)xrow + lane; float s = 0.f;
#pragma unroll
    for (int j = 0; j < 4; ++j) { v[j] = xr[64 * j]; s += (v[j][0] * v[j][0] + v[j][1] * v[j][1]) + (v[j][2] * v[j][2] + v[j][3] * v[j][3]); }
    const float rstd = rsqrtf(wave_sum(s) * (1.f / DM) + 1e-6f);
#pragma unroll
    for (int j = 0; j < 4; ++j) v[j] = v[j] * rstd * ((const f32x4*)gain)[64 * j + lane];
}
__device__ __forceinline__ void store_row_fp8(unsigned char* orow, int lane, const f32x4 (&v)[4]) {
    unsigned* o4 = (unsigned*)orow + lane;
#pragma unroll
    for (int j = 0; j < 4; ++j) o4[64 * j] = pk4_fp8(v[j][0], v[j][1], v[j][2], v[j][3]);
}
__device__ __forceinline__ void store_row_bf16(bf16_t* orow, int lane, const f32x4 (&v)[4]) {
    u32x2* o8 = (u32x2*)orow + lane;
#pragma unroll
    for (int j = 0; j < 4; ++j) { u32x2 w; w.x = pk2(v[j][0], v[j][1]); w.y = pk2(v[j][2], v[j][3]); o8[64 * j] = w; }
}
__device__ __forceinline__ void norm1_row(KPR P, int row, int lane, const LAS float* wff, LAS float* lf_out  ) {
    f32x4 v[4]; rms_row(P.x + (size_t)row * DM, P.mix_norm, lane, v);
    store_row_bf16((bf16_t*)(P.ws + WS_XN) + (size_t)row * DM, lane, v);
    float ff[8];
#pragma unroll
    for (int q = 0; q < 8; ++q) { float s = 0.f;
#pragma unroll
        for (int j = 0; j < 4; ++j) { const f32x4 w = *(const LAS f32x4*)(wff + q * 1024 + 4 * (64 * j + lane)); s += (v[j][0] * w[0] + v[j][1] * w[1]) + (v[j][2] * w[2] + v[j][3] * w[3]); }
        ff[q] = s; }
    float g4[4], g2[2], g1;
    { const bool up = lane & 32;
#pragma unroll
        for (int q = 0; q < 4; ++q) { const float keep = up ? ff[4 + q] : ff[q], give = up ? ff[q] : ff[4 + q]; g4[q] = keep + __shfl_xor(give, 32); } }
    { const bool up = lane & 16;
#pragma unroll
        for (int q = 0; q < 2; ++q) { const float keep = up ? g4[2 + q] : g4[q], give = up ? g4[q] : g4[2 + q]; g2[q] = keep + __shfl_xor(give, 16); } }
    { const bool up = lane & 8; const float keep = up ? g2[1] : g2[0], give = up ? g2[0] : g2[1]; g1 = keep + __shfl_xor(give, 8); }
    g1 += __shfl_xor(g1, 4); g1 += __shfl_xor(g1, 2); g1 += __shfl_xor(g1, 1);
    if ((lane & 7) == 0) { const int q = lane >> 3; lf_out[q] = logsigmoidf_(g1 + P.f_bias[q]); }
}
__device__ __forceinline__ void load_wff(KPR P, LAS float* wff, int tid, int nthr) {
    for (int i = tid; i < 1024 * 8; i += nthr) wff[(i & 7) * 1024 + (i >> 3)] = P.w_in[(size_t)(i >> 3) * INW + 2048 + (i & 7)];
}
__device__ __forceinline__ void final_row(KPR P, int row, int lane, bool dead) {
    const u32x2* xr = (const u32x2*)((const bf16_t*)(P.ws + WS_X1) + (size_t)row * DM) + lane; f32x4 v[4]; float s = 0.f;
#pragma unroll
    for (int j = 0; j < 4; ++j) { const u32x2 xv = xr[64 * j]; v[j] = (f32x4){bflo(xv.x), bfhi(xv.x), bflo(xv.y), bfhi(xv.y)}; s += (v[j][0] * v[j][0] + v[j][1] * v[j][1]) + (v[j][2] * v[j][2] + v[j][3] * v[j][3]); }
    const float rstd = rsqrtf(wave_sum(s) * (1.f / DM) + 1e-6f);
    f32x4* o = (f32x4*)(P.out + (size_t)row * DM) + lane;
#pragma unroll
    for (int j = 0; j < 4; ++j) { v[j] = v[j] * rstd * ((const f32x4*)P.final_norm)[64 * j + lane]; if (dead) { const float q = __builtin_nanf(""); v[j] = (f32x4){q, q, q, q}; } o[64 * j] = v[j]; }
}
typedef GAS unsigned gu32;
#define RLX_AGENT __ATOMIC_RELAXED, __HIP_MEMORY_SCOPE_AGENT
#define XB_TMO      128
#define XB_XCNT(j)  (256  + 64 * (j))
#define XB_XSUB(j)  (1280 + 64 * (j))
#define XB_XGEN(j)  (2304 + 64 * (j))
#define XB_TOP      3328
#define XB_TOPGEN   3392
#define XCD_BAR_WORDS 3456
#define XB_SPIN_CAP (1u << 22)

__device__ __forceinline__ unsigned xb_ld(unsigned* p)              { return __hip_atomic_load(p, __ATOMIC_RELAXED, __HIP_MEMORY_SCOPE_AGENT); }
__device__ __forceinline__ unsigned xb_add(unsigned* p, unsigned v) { return __hip_atomic_fetch_add(p, v, __ATOMIC_RELAXED, __HIP_MEMORY_SCOPE_AGENT); }
__device__ __forceinline__ unsigned xb_xcc_id() { return (unsigned)__builtin_amdgcn_s_getreg((3 << 11) | 20) & 0xFu; }
#define XB_SPIN(cond, bar) do { unsigned _sp = 0; while (cond) { __builtin_amdgcn_s_sleep(1); \
    if ((++_sp & 255u) == 0u) { if (xb_ld(&(bar)[XB_TMO])) break; if (_sp > XB_SPIN_CAP) { atomicAdd(&(bar)[XB_TMO], 1u); break; } } } } while (0)

struct XcdBarrier { unsigned* bar; unsigned x; volatile LAS unsigned* st; };

__device__ __forceinline__ XcdBarrier xcd_barrier_post(unsigned* bar, volatile LAS unsigned* st) {
    XcdBarrier b; b.bar = bar; b.x = xb_xcc_id(); b.st = st;
    if (threadIdx.x == 0) (void)xb_add(&bar[XB_XCNT(b.x)], 1u);
    return b;
}
__device__ __forceinline__ void xcd_barrier_complete(unsigned* bar, unsigned x, unsigned& nloc, unsigned& nx) {
    const unsigned G = gridDim.x * gridDim.y * gridDim.z;
    unsigned sum, cnt, mine, sp = 0u;
    for (;;) {
        sum = 0u; cnt = 0u; mine = 0u;
#pragma unroll
        for (unsigned j = 0; j < 16; ++j) { const unsigned c = xb_ld(&bar[XB_XCNT(j)]); sum += c; cnt += (c > 0u) ? 1u : 0u; mine = (j == x) ? c : mine; }
        if (sum == G) break;
        __builtin_amdgcn_s_sleep(1);
        if ((++sp & 255u) == 0u) { if (xb_ld(&bar[XB_TMO])) break; if (sp > XB_SPIN_CAP) { atomicAdd(&bar[XB_TMO], 1u); break; } }
    }
    nloc = mine > 0u ? mine : 1u; nx = cnt > 0u ? cnt : 1u;
}
__device__ __forceinline__ void xcd_barrier(const XcdBarrier& b) {
    asm volatile("s_waitcnt vmcnt(0)" ::: "memory");
    __syncthreads();
    if (threadIdx.x == 0) {
        unsigned* bar = b.bar;
        __builtin_amdgcn_s_waitcnt(0);
        unsigned nloc = b.st[0], nx = b.st[1];
        if (nloc == 0u) { xcd_barrier_complete(bar, b.x, nloc, nx); b.st[0] = nloc; b.st[1] = nx; }
        const unsigned old = xb_add(&bar[XB_XSUB(b.x)], 1u);
        const unsigned gen = old / nloc;
        if (old + 1u == (gen + 1u) * nloc) {
            __builtin_amdgcn_fence(__ATOMIC_RELEASE, "agent");
            asm volatile("s_waitcnt vmcnt(0)" ::: "memory");
            const unsigned og = xb_add(&bar[XB_TOP], 1u);
            const unsigned tg = og / nx;
            if (og + 1u == (tg + 1u) * nx) xb_add(&bar[XB_TOPGEN], 1u);
            else XB_SPIN(xb_ld(&bar[XB_TOPGEN]) == tg, bar);
            __builtin_amdgcn_fence(__ATOMIC_ACQUIRE, "agent");
            xb_add(&bar[XB_XGEN(b.x)], 1u);
            asm volatile("s_waitcnt vmcnt(0)" ::: "memory");
        } else {
            XB_SPIN(xb_ld(&bar[XB_XGEN(b.x)]) == gen, bar);
            __builtin_amdgcn_fence(__ATOMIC_ACQUIRE, "agent");
            asm volatile("s_waitcnt vmcnt(0)" ::: "memory");
        }
    }
    __syncthreads();
}
namespace rk {
constexpr int MB = 8192;
constexpr int S_AT = 0, S_RT = 1, S_KT = 2, S_BT = 3, S_ATT = 4, S_KTT = 5, S_BTT = 6, S_VT = 7, S_N = 8, S_NT = 9, S_MAK = 10, S_MRB = 11, S_MRK = 12, S_TA = 13, S_TB = 14;
constexpr int SCR = 15 * MB;
constexpr int NCHUNK = SEQ / 64;
constexpr size_t WS_HT = WS_X1;
constexpr size_t WS_Y0 = WS_X1 + 64 * MiB;
constexpr size_t WS_QI = WS_X1 + 96 * MiB;
constexpr size_t WS_LW = WS_RW, WS_LA = WS_RW + 32 * MiB, WS_LG = WS_RW + 64 * MiB;
constexpr size_t WS_SC = WS_RW + 224 * MiB;
constexpr size_t DO_GT = 80 * MiB;
static_assert(WS_SC + 32 * MiB <= WS_END, "rwkv blobs");

__device__ __forceinline__ int moff(int row, int col) { return row * 128 + ((((col >> 3) ^ (row >> 1)) & 7) << 4) + (col & 7) * 2; }
__device__ __forceinline__ int crow(int r, int hi) { return (r & 3) + 8 * (r >> 2) + 4 * hi; }
__device__ __forceinline__ f32x16 mm_nt(const LAS unsigned char* A, int ar0, const LAS unsigned char* Bt, int br0, f32x16 acc, int r32, int hi) {
#pragma unroll
    for (int ks = 0; ks < 4; ++ks) { const bf16x8 a = *(const LAS bf16x8*)(A + moff(ar0 + r32, 16 * ks + 8 * hi)), b = *(const LAS bf16x8*)(Bt + moff(br0 + r32, 16 * ks + 8 * hi));
        acc = __builtin_amdgcn_mfma_f32_32x32x16_bf16(a, b, acc, 0, 0, 0); }
    return acc;
}
__device__ __forceinline__ void store_t(LAS unsigned char* dst, const f32x16& acc, int i0, int j0, int r32, int hi) {
#pragma unroll
    for (int g = 0; g < 4; ++g) { u32x2 w; w.x = pk2(acc[4 * g], acc[4 * g + 1]); w.y = pk2(acc[4 * g + 2], acc[4 * g + 3]); *(LAS u32x2*)(dst + moff(j0 + r32, i0 + 8 * g + 4 * hi)) = w; }
}
template <int MODE> __device__ __forceinline__ void mask_tri(f32x16& acc, int i0, int j0, int r32, int hi) {
#pragma unroll
    for (int r = 0; r < 16; ++r) { const int i = i0 + crow(r, hi), j = j0 + r32; const bool keep = MODE == 0 ? (j < i) : (MODE == 1 ? (i < j) : (i <= j)); if (!keep) acc[r] = 0.f; }
}

__device__ __forceinline__ void pass1_chunk(KPR P, LAS unsigned char* lds, int bh, int c, int tid) {
    const int lane = tid & 63, wave = tid >> 6, r32 = lane & 31, hi = lane >> 5, grp = wave >> 2, wq = wave & 3, i0 = 32 * (wq >> 1), j0 = 32 * (wq & 1);
    const int b = bh >> 3, h = bh & 7; const size_t tok0 = (size_t)b * SEQ + (size_t)c * 64; const size_t ci = (size_t)bh * NCHUNK + c;
    LAS float* part = (LAS float*)(lds + SCR); LAS float* WL = (LAS float*)(lds + SCR + 2048);
#define MAT(s) (lds + (s) * MB)
    {
        const bf16_t* Z = (const bf16_t*)(P.ws + WS_Z); const bf16_t* LW = (const bf16_t*)(P.ws + WS_LW); const bf16_t* LA = (const bf16_t*)(P.ws + WS_LA);
        const int ch = tid & 63, tq = tid >> 6, cc = h * 64 + ch; const size_t row0 = tok0 + 8 * tq;
        const float mur = P.mu[RW_R + cc], muk = P.mu[RW_K + cc], muv = P.mu[RW_V + cc], w0c = P.w0[cc], a0c = P.a0[cc], kkc = P.k_k[cc], kac = P.k_a[cc];
        const bf16_t* zp = Z + row0 * ZW + ZR + cc;
        const bool first = (c == 0) && (tq == 0); const bf16_t* zq = first ? zp : zp - ZW; const float pm = first ? 0.f : 1.f;
        unsigned short lr[9], lk[9], lv[9], llw[8], lla[8];
        lr[0] = zq[RW_R]; lk[0] = zq[RW_K]; lv[0] = zq[RW_V];
#pragma unroll
        for (int i = 0; i < 8; ++i) { const bf16_t* zi = zp + (size_t)i * ZW; lr[i + 1] = zi[RW_R]; lk[i + 1] = zi[RW_K]; lv[i + 1] = zi[RW_V]; const size_t o = (row0 + i) * 512 + cc; llw[i] = LW[o]; lla[i] = LA[o]; }
        float cum[8], vr[8], vk[8], vkk[8], vka[8], ssq[8]; unsigned short vv16[8]; float run = 0.f;
#pragma unroll
        for (int i = 0; i < 8; ++i) { const float pmi = (i == 0) ? pm : 1.f; const float zr1 = bf2f(lr[i + 1]), zk1 = bf2f(lk[i + 1]), zv1 = bf2f(lv[i + 1]);
            vr[i] = zr1 + (bf2f(lr[i]) * pmi - zr1) * mur; vk[i] = zk1 + (bf2f(lk[i]) * pmi - zk1) * muk; vv16[i] = (unsigned short)f2bf(zv1 + (bf2f(lv[i]) * pmi - zv1) * muv);
            vkk[i] = vk[i] * kkc; ssq[i] = vkk[i] * vkk[i]; }
#pragma unroll
        for (int i = 0; i < 8; ++i) ssq[i] = wave_sum(ssq[i]);
#pragma unroll
        for (int i = 0; i < 8; ++i) {
            const float wl = w0c + bf2f(llw[i]); const float sp = fmaxf(-wl, 0.f) + __logf(1.0f + __expf(-fabsf(wl)));
            run += -__expf(-sp - 0.5f); cum[i] = run;
            const float a = __builtin_amdgcn_rcpf(1.0f + __expf(-(a0c + bf2f(lla[i]))));
            const float kk = vkk[i] * __builtin_amdgcn_rcpf(fmaxf(__builtin_amdgcn_sqrtf(ssq[i]), 1e-12f));
            vk[i] = vk[i] * (1.0f + (a - 1.0f) * kac); vkk[i] = kk; vka[i] = kk * a; }
        part[tq * 64 + ch] = run;
        __syncthreads();
        float pre = 0.f;
#pragma unroll
        for (int g = 0; g < 8; ++g) { const float pvv = part[g * 64 + ch]; pre += (g < tq) ? pvv : 0.f; }
        float eprev = __expf(pre);
        unsigned atT[4], ktT[4], btT[4], vT[4]; unsigned short hold[4] = {0, 0, 0, 0};
#pragma unroll
        for (int i = 0; i < 8; ++i) { const int t = 8 * tq + i;
            const float cm = pre + cum[i], e1 = __expf(cm), einv = __expf(-cm);
            const unsigned short at = (unsigned short)f2bf(-vkk[i] * eprev), rt = (unsigned short)f2bf(vr[i] * e1), kt = (unsigned short)f2bf(vk[i] * einv), bt = (unsigned short)f2bf(vka[i] * einv), vv = vv16[i];
            eprev = e1;
            *(LAS unsigned short*)(MAT(S_AT) + moff(t, ch)) = at; *(LAS unsigned short*)(MAT(S_RT) + moff(t, ch)) = rt; *(LAS unsigned short*)(MAT(S_KT) + moff(t, ch)) = kt; *(LAS unsigned short*)(MAT(S_BT) + moff(t, ch)) = bt;
            if (i & 1) { atT[i >> 1] = hold[0] | ((unsigned)at << 16); ktT[i >> 1] = hold[1] | ((unsigned)kt << 16); btT[i >> 1] = hold[2] | ((unsigned)bt << 16); vT[i >> 1] = hold[3] | ((unsigned)vv << 16); }
            else { hold[0] = at; hold[1] = kt; hold[2] = bt; hold[3] = vv; }
            if (i == 7 && tq == 7) WL[ch] = e1; }
        *(LAS u32x4*)(MAT(S_ATT) + moff(ch, 8 * tq)) = (u32x4){atT[0], atT[1], atT[2], atT[3]}; *(LAS u32x4*)(MAT(S_KTT) + moff(ch, 8 * tq)) = (u32x4){ktT[0], ktT[1], ktT[2], ktT[3]};
        *(LAS u32x4*)(MAT(S_BTT) + moff(ch, 8 * tq)) = (u32x4){btT[0], btT[1], btT[2], btT[3]}; *(LAS u32x4*)(MAT(S_VT) + moff(ch, 8 * tq)) = (u32x4){vT[0], vT[1], vT[2], vT[3]};
    }
    __syncthreads();
    const f32x16 zero = f32x16{};
    if (grp == 0) { f32x16 d = mm_nt(MAT(S_AT), i0, MAT(S_BT), j0, zero, r32, hi); mask_tri<0>(d, i0, j0, r32, hi); store_t(MAT(S_NT), d, i0, j0, r32, hi);
        d = mm_nt(MAT(S_KT), i0, MAT(S_AT), j0, zero, r32, hi); mask_tri<1>(d, i0, j0, r32, hi); store_t(MAT(S_MAK), d, i0, j0, r32, hi);
        d = mm_nt(MAT(S_KT), i0, MAT(S_RT), j0, zero, r32, hi); mask_tri<2>(d, i0, j0, r32, hi); store_t(MAT(S_MRK), d, i0, j0, r32, hi); }
    else { f32x16 d = mm_nt(MAT(S_BT), i0, MAT(S_AT), j0, zero, r32, hi); mask_tri<1>(d, i0, j0, r32, hi); store_t(MAT(S_N), d, i0, j0, r32, hi);
#pragma unroll
        for (int r = 0; r < 16; ++r) if (i0 + crow(r, hi) == j0 + r32) d[r] = 1.0f;
        store_t(MAT(S_TA), d, i0, j0, r32, hi);
        d = mm_nt(MAT(S_BT), i0, MAT(S_RT), j0, zero, r32, hi); mask_tri<2>(d, i0, j0, r32, hi); store_t(MAT(S_MRB), d, i0, j0, r32, hi); }
    __syncthreads();
#pragma unroll
    for (int s = 1; s <= 6; ++s) {
        const int mc = (s & 1) ? S_N : S_AT, mcT = (s & 1) ? S_NT : S_KT, mn = (s & 1) ? S_AT : S_N, mnT = (s & 1) ? S_KT : S_NT;
        const int tc = (s & 1) ? S_TB : S_TA, tn = (s & 1) ? S_TA : S_TB;
        if (s <= 5) {
            if (grp == 0) { const f32x16 d = mm_nt(MAT(mc), i0, MAT(mcT), j0, zero, r32, hi); store_t(MAT(mnT), d, i0, j0, r32, hi); }
            else { const f32x16 d = mm_nt(MAT(mcT), i0, MAT(mc), j0, zero, r32, hi); store_t(MAT(mn), d, i0, j0, r32, hi); }
        }
        if (s >= 2 && grp == (s <= 5 ? 0 : 1) ) {
            f32x16 d = mm_nt(MAT(mcT), i0, MAT(tc), j0, zero, r32, hi);
#pragma unroll
            for (int g = 0; g < 4; ++g) { const u32x2 tv = *(const LAS u32x2*)(MAT(tc) + moff(j0 + r32, i0 + 8 * g + 4 * hi)); d[4 * g] += bflo(tv.x); d[4 * g + 1] += bfhi(tv.x); d[4 * g + 2] += bflo(tv.y); d[4 * g + 3] += bfhi(tv.y); }
            store_t(MAT(tn), d, i0, j0, r32, hi);
        }
        __syncthreads();
    }
    if (grp == 0) { const f32x16 d = mm_nt(MAT(S_TB), i0, MAT(S_ATT), j0, zero, r32, hi); store_t(MAT(S_BT), d, i0, j0, r32, hi); }
    else { const f32x16 d = mm_nt(MAT(S_MAK), i0, MAT(S_VT), j0, zero, r32, hi); store_t(MAT(S_N), d, i0, j0, r32, hi); }
    __syncthreads();
    if (grp == 0) { const f32x16 d = mm_nt(MAT(S_TB), i0, MAT(S_N), j0, zero, r32, hi); store_t(MAT(S_NT), d, i0, j0, r32, hi);
        f32x16 q = mm_nt(MAT(S_BT), i0, MAT(S_MRB), j0, zero, r32, hi);
#pragma unroll
        for (int g = 0; g < 4; ++g) { const u32x2 rv = *(const LAS u32x2*)(MAT(S_RT) + moff(j0 + r32, i0 + 8 * g + 4 * hi)); q[4 * g] += bflo(rv.x); q[4 * g + 1] += bfhi(rv.x); q[4 * g + 2] += bflo(rv.y); q[4 * g + 3] += bfhi(rv.y); }
        store_t(MAT(S_KT), q, i0, j0, r32, hi); }
    else { f32x16 g_ = mm_nt(MAT(S_BT), i0, MAT(S_BTT), j0, zero, r32, hi);
        const float wl = WL[j0 + r32];
#pragma unroll
        for (int r = 0; r < 16; ++r) { if (i0 + crow(r, hi) == j0 + r32) g_[r] += 1.0f; g_[r] *= wl; }
        store_t(MAT(S_AT), g_, i0, j0, r32, hi); }
    __syncthreads();
    if (grp == 0) { f32x16 d = mm_nt(MAT(S_BTT), i0, MAT(S_NT), j0, zero, r32, hi); d = mm_nt(MAT(S_KTT), i0, MAT(S_VT), j0, d, r32, hi);
        float* HT = (float*)(P.ws + WS_HT) + ci * 4096 + (size_t)wq * 1024 + lane;
#pragma unroll
        for (int g = 0; g < 4; ++g) { const f32x4 wl4 = *(const LAS f32x4*)(WL + i0 + 8 * g + 4 * hi);
#pragma unroll
            for (int i = 0; i < 4; ++i) HT[(4 * g + i) * 64] = d[4 * g + i] * wl4[i]; } }
    else { f32x16 d = mm_nt(MAT(S_MRB), i0, MAT(S_NT), j0, zero, r32, hi); d = mm_nt(MAT(S_MRK), i0, MAT(S_VT), j0, d, r32, hi);
        unsigned* Y0 = (unsigned*)(P.ws + WS_Y0) + ci * 2048 + (size_t)wq * 512 + lane;
#pragma unroll
        for (int r2 = 0; r2 < 8; ++r2) Y0[r2 * 64] = pk2(d[2 * r2], d[2 * r2 + 1]); }
    { u32x4* GTg = (u32x4*)((unsigned char*)P.out + DO_GT + ci * MB); u32x4* QIg = (u32x4*)(P.ws + WS_QI + ci * MB);
        GTg[tid] = *(const LAS u32x4*)(MAT(S_AT) + tid * 16); QIg[tid] = *(const LAS u32x4*)(MAT(S_KT) + tid * 16); }
    __syncthreads();
#undef MAT
}

__device__ __forceinline__ void pass2_seq(KPR P, LAS unsigned char* lds, int bh, int tid) {
    const int lane = tid & 63, wave = tid >> 6, r32 = lane & 31, hi = lane >> 5, wq = wave & 3, i0 = 32 * (wq >> 1), j0 = 32 * (wq & 1);
    LAS unsigned char* Sm = lds; LAS unsigned char* G0 = lds + MB; LAS unsigned char* G1 = lds + 2 * MB;
    const size_t ci0 = (size_t)bh * NCHUNK;
    const u32x4* GTg = (const u32x4*)((const unsigned char*)P.out + DO_GT + ci0 * MB); u32x4* SCg = (u32x4*)(P.ws + WS_SC + ci0 * MB);
    const float* HT = (const float*)(P.ws + WS_HT) + ci0 * 4096 + (size_t)wq * 1024 + lane;
    *(LAS u32x4*)(Sm + tid * 16) = (u32x4){0u, 0u, 0u, 0u};
    *(LAS u32x4*)(G0 + tid * 16) = GTg[tid];
    u32x4 gnext = GTg[512 + tid];
    f32x16 hcur, hnext;
    if (wave < 4) {
#pragma unroll
        for (int r = 0; r < 16; ++r) { hcur[r] = HT[r * 64]; hnext[r] = HT[4096 + r * 64]; } }
    __syncthreads();
    for (int c = 0; c < NCHUNK; ++c) {
        LAS unsigned char* Gc = (c & 1) ? G1 : G0; LAS unsigned char* Gn = (c & 1) ? G0 : G1;
        SCg[(size_t)c * 512 + tid] = *(const LAS u32x4*)(Sm + tid * 16);
        f32x16 d = hcur;
        if (wave < 4) d = mm_nt(Gc, i0, Sm, j0, d, r32, hi);
        __syncthreads();
        if (wave < 4) store_t(Sm, d, i0, j0, r32, hi);
        *(LAS u32x4*)(Gn + tid * 16) = gnext;
        const int c2 = (c + 2 < NCHUNK) ? c + 2 : NCHUNK - 1;
        gnext = GTg[(size_t)c2 * 512 + tid];
        if (wave < 4) { hcur = hnext;
#pragma unroll
            for (int r = 0; r < 16; ++r) hnext[r] = HT[(size_t)c2 * 4096 + r * 64]; }
        __syncthreads();
    }
}

__device__ __forceinline__ void pass3_chunk(KPR P, LAS unsigned char* lds, int bh, int c, int tid) {
    const int lane = tid & 63, wave = tid >> 6, r32 = lane & 31, hi = lane >> 5, wq = wave & 3, i0 = 32 * (wq >> 1), j0 = 32 * (wq & 1);
    const int b = bh >> 3, h = bh & 7; const size_t tok0 = (size_t)b * SEQ + (size_t)c * 64; const size_t ci = (size_t)bh * NCHUNK + c;
    LAS unsigned char* Qm = lds; LAS unsigned char* Sm = lds + MB; LAS float* Yl = (LAS float*)(lds + 2 * MB);
    *(LAS u32x4*)(Qm + tid * 16) = ((const u32x4*)(P.ws + WS_QI + ci * MB))[tid];
    *(LAS u32x4*)(Sm + tid * 16) = ((const u32x4*)(P.ws + WS_SC + ci * MB))[tid];
    f32x16 d = f32x16{};
    if (wave < 4) { const unsigned* Y0 = (const unsigned*)(P.ws + WS_Y0) + ci * 2048 + (size_t)wq * 512 + lane;
#pragma unroll
        for (int r2 = 0; r2 < 8; ++r2) { const unsigned w = Y0[r2 * 64]; d[2 * r2] = bflo(w); d[2 * r2 + 1] = bfhi(w); } }
    const bf16_t* Z = (const bf16_t*)(P.ws + WS_Z); const bf16_t* LA = (const bf16_t*)(P.ws + WS_LA); const bf16_t* LG = (const bf16_t*)(P.ws + WS_LG);
    bf16_t* AO = (bf16_t*)(P.ws + WS_AO); const int cc = h * 64 + lane;
    const float lnw = P.ln_w[cc], lnb = P.ln_b[cc], rkc = P.r_k[cc], mur = P.mu[RW_R + cc], muk = P.mu[RW_K + cc], muv = P.mu[RW_V + cc], a0c = P.a0[cc], kac = P.k_a[cc];
    const bf16_t* zp = Z + (tok0 + wave * 8) * ZW + ZR + cc; const bool first = (c == 0) && (wave == 0); const bf16_t* zq = first ? zp : zp - ZW; const float pm = first ? 0.f : 1.f;
    unsigned short lr[9], lk[9], lv[9], lla[8], llg[8];
    lr[0] = zq[RW_R]; lk[0] = zq[RW_K]; lv[0] = zq[RW_V];
#pragma unroll
    for (int i = 0; i < 8; ++i) { const bf16_t* zi = zp + (size_t)i * ZW; lr[i + 1] = zi[RW_R]; lk[i + 1] = zi[RW_K]; lv[i + 1] = zi[RW_V]; const size_t o = (tok0 + wave * 8 + i) * 512 + cc; lla[i] = LA[o]; llg[i] = LG[o]; }
    __syncthreads();
    if (wave < 4) { d = mm_nt(Qm, i0, Sm, j0, d, r32, hi);
#pragma unroll
        for (int r = 0; r < 16; ++r) Yl[(i0 + crow(r, hi)) * 65 + j0 + r32] = d[r]; }
    __syncthreads();
    float y[8], s1[8], s2[8], s3[8], vvv[8];
#pragma unroll
    for (int i = 0; i < 8; ++i) { const float pmi = (i == 0) ? pm : 1.f; const float zr1 = bf2f(lr[i + 1]), zk1 = bf2f(lk[i + 1]), zv1 = bf2f(lv[i + 1]);
        const float r = zr1 + (bf2f(lr[i]) * pmi - zr1) * mur, zk = zk1 + (bf2f(lk[i]) * pmi - zk1) * muk; vvv[i] = zv1 + (bf2f(lv[i]) * pmi - zv1) * muv;
        const float a = __builtin_amdgcn_rcpf(1.0f + __expf(-(a0c + bf2f(lla[i])))); const float k = zk * (1.0f + (a - 1.0f) * kac);
        y[i] = Yl[(wave * 8 + i) * 65 + lane]; s1[i] = y[i]; s3[i] = r * k * rkc; }
#pragma unroll
    for (int i = 0; i < 8; ++i) { s1[i] = wave_sum(s1[i]); s3[i] = wave_sum(s3[i]); }
#pragma unroll
    for (int i = 0; i < 8; ++i) { y[i] -= s1[i] * (1.f / 64.f); s2[i] = y[i] * y[i]; }
#pragma unroll
    for (int i = 0; i < 8; ++i) s2[i] = wave_sum(s2[i]);
#pragma unroll
    for (int i = 0; i < 8; ++i) { const size_t tok = tok0 + wave * 8 + i; const float yn = y[i] * rsqrtf(s2[i] * (1.f / 64.f) + 64e-5f) * lnw + lnb;
        AO[tok * DM + 512 + cc] = (bf16_t)f2bf((yn + s3[i] * vvv[i]) * bf2f(llg[i])); }
}

constexpr size_t WS_W2T = 29 * MiB, WS_A2T = 29 * MiB + 65536, WS_G2T = 29 * MiB + 131072;
__device__ __forceinline__ bf16x8 act8(const bf16_t* zc, const bf16_t* zpv, float pmask, const float* mu, int mode) {
    const u32x4 c = *(const u32x4*)zc, p = *(const u32x4*)zpv;
    const f32x4 m0 = *(const f32x4*)mu, m1 = *(const f32x4*)(mu + 4);
    const unsigned cw[4] = {c.x, c.y, c.z, c.w}, pw[4] = {p.x, p.y, p.z, p.w}; const float um[8] = {m0[0], m0[1], m0[2], m0[3], m1[0], m1[1], m1[2], m1[3]}; float v[8];
#pragma unroll
    for (int j = 0; j < 4; ++j) { const float c0 = bflo(cw[j]), c1 = bfhi(cw[j]), p0 = bflo(pw[j]) * pmask, p1 = bfhi(pw[j]) * pmask;
        v[2 * j] = c0 + (p0 - c0) * um[2 * j]; v[2 * j + 1] = c1 + (p1 - c1) * um[2 * j + 1]; }
#pragma unroll
    for (int j = 0; j < 8; ++j) { if (mode == 0) { const float e = __expf(-2.0f * fabsf(v[j])); const float th = (1.0f - e) * __builtin_amdgcn_rcpf(1.0f + e); v[j] = v[j] < 0.f ? -th : th; } else if (mode == 2) v[j] = __builtin_amdgcn_rcpf(1.0f + __expf(-v[j])); }
    u32x4 w; w.x = pk2(v[0], v[1]); w.y = pk2(v[2], v[3]); w.z = pk2(v[4], v[5]); w.w = pk2(v[6], v[7]);
    return __builtin_bit_cast(bf16x8, w);
}
__device__ __forceinline__ int goff(int row, int col) { return row * 256 + ((((col >> 3) ^ row) & 15) << 4) + (col & 7) * 2; }
__device__ __forceinline__ void lora_block(KPR P, LAS unsigned char* lds, int blk, int G, int tid) {
    const int lane = tid & 63, wave = tid >> 6, r32 = lane & 31, hi = lane >> 5;
    const int task = wave * G + blk; const bool work = (wave < 4) && (task < NTOK / 32);
    const size_t row = (size_t)(work ? task : 0) * 32 + r32; const bool first = (row % SEQ) == 0;
    const bf16_t* Z = (const bf16_t*)(P.ws + WS_Z) + row * ZW + ZR + 8 * hi; const bf16_t* Zp = first ? Z : Z - ZW; const float pmask = first ? 0.f : 1.f;
    const float* mub = P.mu + 8 * hi;
    { const u32x4* w2 = (const u32x4*)(P.ws + WS_W2T); const u32x4* a2 = (const u32x4*)(P.ws + WS_A2T);
#pragma unroll
        for (int i = 0; i < 8; ++i) { const int idx = i * 512 + tid, rw = idx >> 3, ch = idx & 7; const int o = rw * 128 + (((ch ^ (rw >> 1)) & 7) << 4);
            *(LAS u32x4*)(lds + o) = w2[idx]; *(LAS u32x4*)(lds + 65536 + o) = a2[idx]; } }
    bf16x8 xw[4], xa[4], xg[8];
    if (work) {
#pragma unroll
        for (int ks = 0; ks < 4; ++ks) { xw[ks] = act8(Z + RW_W + 16 * ks, Zp + RW_W + 16 * ks, pmask, mub + RW_W + 16 * ks, 0); xa[ks] = act8(Z + RW_A + 16 * ks, Zp + RW_A + 16 * ks, pmask, mub + RW_A + 16 * ks, 1); asm volatile("" ::: "memory"); }
#pragma unroll
        for (int ks = 0; ks < 8; ++ks) { xg[ks] = act8(Z + RW_G + 16 * ks, Zp + RW_G + 16 * ks, pmask, mub + RW_G + 16 * ks, 2); if (ks & 1) asm volatile("" ::: "memory"); }
    }
    bf16_t* LW = (bf16_t*)(P.ws + WS_LW) + row * 512 + 4 * hi; bf16_t* LA = (bf16_t*)(P.ws + WS_LA) + row * 512 + 4 * hi; bf16_t* LG = (bf16_t*)(P.ws + WS_LG) + row * 512 + 4 * hi;
    __syncthreads();
    if (work) {
#pragma nounroll
        for (int cb = 0; cb < 16; ++cb) { f32x16 dw = f32x16{}, da = f32x16{};
#pragma unroll
            for (int ks = 0; ks < 4; ++ks) { const int o = moff(cb * 32 + r32, 16 * ks + 8 * hi);
                dw = __builtin_amdgcn_mfma_f32_32x32x16_bf16(*(const LAS bf16x8*)(lds + o), xw[ks], dw, 0, 0, 0); da = __builtin_amdgcn_mfma_f32_32x32x16_bf16(*(const LAS bf16x8*)(lds + 65536 + o), xa[ks], da, 0, 0, 0); }
#pragma unroll
            for (int g = 0; g < 4; ++g) { u32x2 w; w.x = pk2(dw[4 * g], dw[4 * g + 1]); w.y = pk2(dw[4 * g + 2], dw[4 * g + 3]); *(u32x2*)(LW + cb * 32 + 8 * g) = w;
                w.x = pk2(da[4 * g], da[4 * g + 1]); w.y = pk2(da[4 * g + 2], da[4 * g + 3]); *(u32x2*)(LA + cb * 32 + 8 * g) = w; } }
    }
    __syncthreads();
    { const u32x4* g2 = (const u32x4*)(P.ws + WS_G2T);
#pragma unroll
        for (int i = 0; i < 16; ++i) { const int idx = i * 512 + tid, rw = idx >> 4, ch = idx & 15; *(LAS u32x4*)(lds + rw * 256 + (((ch ^ rw) & 15) << 4)) = g2[idx]; } }
    __syncthreads();
    if (work) {
#pragma nounroll
        for (int cb = 0; cb < 16; ++cb) { f32x16 dg = f32x16{};
#pragma unroll
            for (int ks = 0; ks < 8; ++ks) dg = __builtin_amdgcn_mfma_f32_32x32x16_bf16(*(const LAS bf16x8*)(lds + goff(cb * 32 + r32, 16 * ks + 8 * hi)), xg[ks], dg, 0, 0, 0);
#pragma unroll
            for (int g = 0; g < 4; ++g) { u32x2 w; w.x = pk2(dg[4 * g], dg[4 * g + 1]); w.y = pk2(dg[4 * g + 2], dg[4 * g + 3]); *(u32x2*)(LG + cb * 32 + 8 * g) = w; } }
    }
    __syncthreads();
}
}
namespace rt {
__device__ __forceinline__ int woff(int e, int k) { return e * 2048 + ((((k >> 3) ^ (e & 15))) << 4) + (k & 7) * 2; }
constexpr size_t WS_WRI = 30 * MiB;
__device__ __forceinline__ void build_w(KPR P, int part, int tid) {
    unsigned char* img = P.ws + WS_WRI; const int e = tid & 31, k0 = part * 64 + 4 * (tid >> 5); float w[4];
#pragma unroll
    for (int i = 0; i < 4; ++i) w[i] = P.moe_norm[k0 + i] * P.w_router[(k0 + i) * 32 + e];
#pragma unroll
    for (int i = 0; i < 4; ++i) { const int k = k0 + i; const unsigned h = f2bf(w[i]); const unsigned l = f2bf(w[i] - bf2f(h));
        *(unsigned short*)(img + woff(e, k)) = (unsigned short)h; *(unsigned short*)(img + 65536 + woff(e, k)) = (unsigned short)l; }
}
__device__ __forceinline__ void copy_w(KPR P, LAS unsigned char* lds, int tid) {
    const u32x4* img = (const u32x4*)(P.ws + WS_WRI);
#pragma unroll 4
    for (int i = 0; i < 16; ++i) *(LAS u32x4*)(lds + (size_t)(i * 512 + tid) * 16) = img[i * 512 + tid];
}
__device__ __forceinline__ void split8(const f32x4& a, const f32x4& b, bf16x8& h, bf16x8& l) {
    unsigned hh[8]; float v[8] = {a[0], a[1], a[2], a[3], b[0], b[1], b[2], b[3]};
#pragma unroll
    for (int j = 0; j < 8; ++j) hh[j] = f2bf(v[j]);
    u32x4 hw, lw;
    hw.x = hh[0] | (hh[1] << 16); hw.y = hh[2] | (hh[3] << 16); hw.z = hh[4] | (hh[5] << 16); hw.w = hh[6] | (hh[7] << 16);
    lw.x = pk2(v[0] - bf2f(hh[0]), v[1] - bf2f(hh[1])); lw.y = pk2(v[2] - bf2f(hh[2]), v[3] - bf2f(hh[3])); lw.z = pk2(v[4] - bf2f(hh[4]), v[5] - bf2f(hh[5])); lw.w = pk2(v[6] - bf2f(hh[6]), v[7] - bf2f(hh[7]));
    h = __builtin_bit_cast(bf16x8, hw); l = __builtin_bit_cast(bf16x8, lw);
}
__device__ __forceinline__ void route_task(KPR P, const LAS unsigned char* wlds, int task, int lane) {
    const int r32 = lane & 31, hi = lane >> 5; const int row = task * 32 + r32;
    const bf16_t* xrow = (const bf16_t*)(P.ws + WS_X1) + (size_t)row * DM + 8 * hi;
    f32x16 acc = f32x16{}; float ss = 0.f;
    u32x4 xq[4];
#pragma unroll
    for (int j = 0; j < 4; ++j) xq[j] = *(const u32x4*)(xrow + 16 * j);
    for (int ks0 = 0; ks0 < 64; ks0 += 4) {
#pragma unroll
        for (int j = 0; j < 4; ++j) { const int ks = ks0 + j; const u32x4 xv = xq[j];
            const int kn = (ks + 4 < 64) ? ks + 4 : ks; xq[j] = *(const u32x4*)(xrow + 16 * kn);
            const unsigned xw[4] = {xv.x, xv.y, xv.z, xv.w};
#pragma unroll
            for (int q = 0; q < 4; ++q) { const float a = bflo(xw[q]), b = bfhi(xw[q]); ss += a * a + b * b; }
            const bf16x8 xh = __builtin_bit_cast(bf16x8, xv);
            const bf16x8 wh = *(const LAS bf16x8*)(wlds + woff(r32, 16 * ks + 8 * hi)), wl = *(const LAS bf16x8*)(wlds + 65536 + woff(r32, 16 * ks + 8 * hi));
            acc = __builtin_amdgcn_mfma_f32_32x32x16_bf16(wh, xh, acc, 0, 0, 0); acc = __builtin_amdgcn_mfma_f32_32x32x16_bf16(wl, xh, acc, 0, 0, 0); }
    }
    ss += __shfl_xor(ss, 32);
    const float rstd = rsqrtf(ss * (1.f / DM) + 1e-6f);
    float lg[16];
#pragma unroll
    for (int g = 0; g < 4; ++g) { const f32x4 bb = *(const f32x4*)(P.b_router + 8 * g + 4 * hi);
#pragma unroll
        for (int i = 0; i < 4; ++i) lg[4 * g + i] = acc[4 * g + i] * rstd + bb[i]; }
    float tv[4]; int ti[4];
#pragma unroll
    for (int k = 0; k < 4; ++k) { float bv = lg[0]; int bi = 4 * hi;
#pragma unroll
        for (int r = 1; r < 16; ++r) { const int e = (r & 3) + 8 * (r >> 2) + 4 * hi; if (lg[r] > bv) { bv = lg[r]; bi = e; } }
        const float pv = __shfl_xor(bv, 32); const int pi = __shfl_xor(bi, 32);
        if (pv > bv || (pv == bv && pi < bi)) { bv = pv; bi = pi; }
        tv[k] = bv; ti[k] = bi;
#pragma unroll
        for (int r = 0; r < 16; ++r) { const int e = (r & 3) + 8 * (r >> 2) + 4 * hi; if (e == bi) lg[r] = -INFINITY; } }
    const float e1 = __expf(tv[1] - tv[0]), e2 = __expf(tv[2] - tv[0]), e3 = __expf(tv[3] - tv[0]), inv = 1.f / (1.f + e1 + e2 + e3);
    const int c0 = hi ? ti[2] : ti[0], c1 = hi ? ti[3] : ti[1]; const float g0 = (hi ? e2 : 1.f) * inv, g1 = (hi ? e3 : e1) * inv;
    const unsigned long long ltm = (1ull << lane) - 1ull; int mycnt = 0, rk0 = 0, rk1 = 0;
    for (int e = 0; e < 32; ++e) { const unsigned long long m0 = __ballot(c0 == e), m1 = __ballot(c1 == e); const int n0 = __popcll(m0);
        if (lane == e) mycnt = n0 + __popcll(m1);
        if (c0 == e) rk0 = __popcll(m0 & ltm);
        if (c1 == e) rk1 = n0 + __popcll(m1 & ltm); }
    unsigned* cnt = (unsigned*)(P.ws + WS_CTL) + CW_CNT; int base = 0;
    if (lane < 32 && mycnt > 0) base = (int)atomicAdd(cnt + lane, (unsigned)mycnt);
    rk0 += __shfl(base, c0); rk1 += __shfl(base, c1);
    int* route = (int*)(P.ws + WS_ROUTE); int* tokslot = (int*)(P.ws + WS_TOKSLOT); float* gateslot = (float*)(P.ws + WS_GATESLOT);
    tokslot[(size_t)c0 * NTOK + rk0] = row; gateslot[(size_t)c0 * NTOK + rk0] = g0; tokslot[(size_t)c1 * NTOK + rk1] = row; gateslot[(size_t)c1 * NTOK + rk1] = g1;
    route[(size_t)row * 12 + 2 * hi] = c0; route[(size_t)row * 12 + 2 * hi + 1] = c1; route[(size_t)row * 12 + 4 + 2 * hi] = rk0; route[(size_t)row * 12 + 4 + 2 * hi + 1] = rk1;
    unsigned char* xn = P.ws + WS_XN + (size_t)row * DM + 8 * hi; const float* gn = P.moe_norm + 8 * hi;
#pragma unroll
    for (int j = 0; j < 4; ++j) xq[j] = *(const u32x4*)(xrow + 16 * j);
    for (int ks0 = 0; ks0 < 64; ks0 += 4) {
#pragma unroll
        for (int j = 0; j < 4; ++j) { const int ks = ks0 + j; const u32x4 xv = xq[j]; const f32x4 ga = *(const f32x4*)(gn + 16 * ks), gb = *(const f32x4*)(gn + 16 * ks + 4);
            const int kn = (ks + 4 < 64) ? ks + 4 : ks; xq[j] = *(const u32x4*)(xrow + 16 * kn);
            u32x2 w; w.x = pk4_fp8(bflo(xv.x) * rstd * ga[0], bfhi(xv.x) * rstd * ga[1], bflo(xv.y) * rstd * ga[2], bfhi(xv.y) * rstd * ga[3]); w.y = pk4_fp8(bflo(xv.z) * rstd * gb[0], bfhi(xv.z) * rstd * gb[1], bflo(xv.w) * rstd * gb[2], bfhi(xv.w) * rstd * gb[3]);
            *(u32x2*)(xn + 16 * ks) = w; }
    }
}
}
namespace attn_body {
using bf16=unsigned short;
using bf16x8=__attribute__((ext_vector_type(8)))short;
using s16x4=__attribute__((ext_vector_type(4)))short;
using f32x16=__attribute__((ext_vector_type(16)))float;
using u32x4=__attribute__((ext_vector_type(4)))unsigned;
constexpr int BATCH=4,NHEAD=8,SEQ=8192,D=64,DM=3840,OP=1024;
constexpr int NW=8,QBLK=32,QB=QBLK*NW,KVBLK=64,NQB=SEQ/QB;
constexpr int ATTN_PITCH=DM, ATTN_UNIT_ROWS=QB;
__device__ __forceinline__ int crow(int r,int hi){return (r&3)+8*(r>>2)+4*hi;}
#define SBAR() __builtin_amdgcn_sched_barrier(0)
__device__ __forceinline__ void cmask(f32x16&p0,f32x16&p1,int jb,int qrel,int hi){
  const float NEG=-INFINITY; int kb=64*jb+4*hi;
  #pragma unroll
  for(int r=0;r<16;++r){int kv=kb+(r&3)+8*(r>>2); if(kv>qrel)p0[r]=NEG; if(kv+32>qrel)p1[r]=NEG;}
}

constexpr int NSLOT=3, SLOTB=8192;
constexpr int LDS_K=0, LDS_V=NSLOT*SLOTB, LDS_WS=2*NSLOT*SLOTB, LDS_OST=LDS_WS+NW*64*4, LDS_C2=LDS_OST+NW*4096, LDS_BYTES=LDS_C2+SEQ*4;
constexpr float C2=0.125f*1.4426950408889634f;
__device__ __forceinline__ void glds16(const void*gsrc,unsigned lds_dst){unsigned keep;
  asm volatile("s_mov_b32 %0, m0\n\ts_mov_b32 m0, %2\n\ts_nop 0\n\tglobal_load_lds_dwordx4 %1, off\n\ts_mov_b32 m0, %0":"=&s"(keep):"v"(gsrc),"s"(lds_dst):"memory");}
__device__ __forceinline__ float max3f(float a,float b,float c){float r;asm("v_max3_f32 %0, %1, %2, %3":"=v"(r):"v"(a),"v"(b),"v"(c));return r;}
__device__ __forceinline__ float max2f(float a,float b){float r;asm("v_max_f32_e32 %0, %1, %2":"=v"(r):"v"(a),"v"(b));return r;}
__device__ __forceinline__ float fadd_s(float a,float b){float r;asm("v_add_f32_e32 %0, %1, %2":"=v"(r):"v"(a),"v"(b));return r;}
__device__ __forceinline__ float fsub_s(float a,float b){float r;asm("v_sub_f32_e32 %0, %1, %2":"=v"(r):"v"(a),"v"(b));return r;}
typedef float f32x2_t __attribute__((ext_vector_type(2))); typedef float f32x4v __attribute__((ext_vector_type(4))); typedef __bf16 bf16x2_t __attribute__((ext_vector_type(2)));
__device__ __forceinline__ unsigned cvtpk_s(float lo,float hi){f32x2_t v={lo,hi};bf16x2_t b=__builtin_convertvector(v,bf16x2_t);return __builtin_bit_cast(unsigned,b);}
#define WAIT_BAR(N) asm volatile("s_waitcnt vmcnt(" #N ") lgkmcnt(0)\n\ts_barrier":::"memory")

__device__ __forceinline__ void qkt(f32x16&p0,f32x16&p1,const char*Kslot,const bf16x8*qr,int r32,int hi){
  const char*kb=Kslot+hi*1024+r32*16;
  #pragma unroll
  for(int d0=0;d0<4;++d0){
    const bf16x8 b0=*reinterpret_cast<const bf16x8*>(kb+d0*2048);
    const bf16x8 b1=*reinterpret_cast<const bf16x8*>(kb+d0*2048+512);
    p0=__builtin_amdgcn_mfma_f32_32x32x16_bf16(b0,qr[d0],p0,0,0,0);p1=__builtin_amdgcn_mfma_f32_32x32x16_bf16(b1,qr[d0],p1,0,0,0);}
}
typedef __attribute__((address_space(3))) const char* lds_cptr;
typedef short v4i16_t __attribute__((ext_vector_type(4)));
__device__ __forceinline__ void kload8(bf16x8*kf,lds_cptr kp){
  kf[0]=*(const __attribute__((address_space(3))) bf16x8*)(kp);      kf[1]=*(const __attribute__((address_space(3))) bf16x8*)(kp+512);
  kf[2]=*(const __attribute__((address_space(3))) bf16x8*)(kp+2048); kf[3]=*(const __attribute__((address_space(3))) bf16x8*)(kp+2560);
  kf[4]=*(const __attribute__((address_space(3))) bf16x8*)(kp+4096); kf[5]=*(const __attribute__((address_space(3))) bf16x8*)(kp+4608);
  kf[6]=*(const __attribute__((address_space(3))) bf16x8*)(kp+6144); kf[7]=*(const __attribute__((address_space(3))) bf16x8*)(kp+6656);
}
__device__ __forceinline__ void kload2(bf16x8*kf,lds_cptr kp,int j){ kf[2*j]=*(const __attribute__((address_space(3))) bf16x8*)(kp+j*2048); kf[2*j+1]=*(const __attribute__((address_space(3))) bf16x8*)(kp+j*2048+512); }
__device__ __forceinline__ s16x4 vtr(lds_cptr p){ return __builtin_bit_cast(s16x4,__builtin_amdgcn_ds_read_tr16_b64_v4i16((__attribute__((address_space(3))) v4i16_t*)p)); }
__device__ __forceinline__ float rowmax(const f32x16&p0,const f32x16&p1){
  float a=max3f(p0[0],p0[1],p1[0]),b=max3f(p0[2],p0[3],p1[1]);a=max3f(a,p1[2],p1[3]);
  #pragma unroll
  for(int r=4;r<16;r+=4){a=max3f(a,p0[r],p0[r+1]);b=max3f(b,p0[r+2],p0[r+3]);a=max3f(a,p1[r],p1[r+1]);b=max3f(b,p1[r+2],p1[r+3]);}
  const float m=max2f(a,b);
  auto rr=__builtin_amdgcn_permlane32_swap(__float_as_uint(m),__float_as_uint(m),false,false);
  return max2f(__uint_as_float(rr[0]),__uint_as_float(rr[1]));
}
__device__ __forceinline__ void pv(f32x16*o,int vb,bf16x8 pa0,bf16x8 pa1,bf16x8 pa2,bf16x8 pa3){
  #pragma unroll
  for(int d0=0;d0<2;++d0){s16x4 lo[4],hi[4];
    #pragma unroll
    for(int ks=0;ks<4;++ks){
      asm volatile("ds_read_b64_tr_b16 %0,%1 offset:%c2":"=&v"(lo[ks]):"v"(vb),"i"(d0*4096+ks*1024):"memory");
      asm volatile("ds_read_b64_tr_b16 %0,%1 offset:%c2":"=&v"(hi[ks]):"v"(vb),"i"(d0*4096+ks*1024+512):"memory");}
    asm volatile("s_waitcnt lgkmcnt(0)":::"memory");SBAR();
    #define PK(k) (bf16x8){lo[k][0],lo[k][1],lo[k][2],lo[k][3],hi[k][0],hi[k][1],hi[k][2],hi[k][3]}
    o[d0]=__builtin_amdgcn_mfma_f32_32x32x16_bf16(pa0,PK(0),o[d0],0,0,0);
    o[d0]=__builtin_amdgcn_mfma_f32_32x32x16_bf16(pa1,PK(1),o[d0],0,0,0);
    o[d0]=__builtin_amdgcn_mfma_f32_32x32x16_bf16(pa2,PK(2),o[d0],0,0,0);
    o[d0]=__builtin_amdgcn_mfma_f32_32x32x16_bf16(pa3,PK(3),o[d0],0,0,0);
    #undef PK
  }
}

#ifndef ATTN_STORE16
#define ATTN_STORE16(p,v) (*(u32x4*)(p)=(v))
#endif
template<int THRL> __device__ __forceinline__ void attn_unit(int b,int h,int qb,int t0,const bf16*Z,const float*c2g,bf16*O,char*shm){
  int tid_=threadIdx.x; asm volatile("":"+v"(tid_));
  const int tid=tid_,lane=tid&63,r32=lane&31,hi=lane>>5; const int wid=__builtin_amdgcn_readfirstlane(tid>>6);
  const long rowbase=(long)b*SEQ; const int q0=qb*QB;
  const bf16*Qw=Z+(rowbase+q0+wid*QBLK)*DM+h*D;
  const bf16*Kh=Z+(rowbase+(long)t0*KVBLK)*DM+512+h*D,*Vh=Z+(rowbase+(long)t0*KVBLK)*DM+1024+h*D;
  const unsigned lds0=(unsigned)(uintptr_t)shm;
  float*wsf=(float*)(shm+LDS_WS)+wid*64;
  const bf16*ksrc=Kh+(long)lane*DM+wid*8;
  const bf16*vsrc=Vh+(long)(16*(wid&3)+(lane>>2))*DM+(wid>>2)*32+(lane&3)*8;
  const unsigned kdst=lds0+LDS_K+wid*1024, vdst=lds0+LDS_V+wid*1024;
  #define DMA_K(t,slot) glds16(ksrc+(long)(t)*KVBLK*DM,(unsigned)__builtin_amdgcn_readfirstlane(kdst+(slot)))
  #define DMA_V(t,slot) glds16(vsrc+(long)(t)*KVBLK*DM,(unsigned)__builtin_amdgcn_readfirstlane(vdst+(slot)))
  const int vb0=(int)(lds0+LDS_V)+((lane>>4)&1)*32+(lane&3)*8+(4*hi+((lane&15)>>2))*64;
  const char*Kbase=shm+LDS_K; bf16x8 kf[8];
  const lds_cptr shm3=(lds_cptr)shm; const lds_cptr kp0=shm3+LDS_K+hi*1024+r32*16; const lds_cptr vp0=shm3+LDS_V+((lane>>4)&1)*32+(lane&3)*8+(4*hi+((lane&15)>>2))*64;
  const int NT=(q0+QB)/KVBLK-t0;
  { const int np=(q0+QB)/256;
    for(int p=(t0>>2)+wid;p<np;p+=NW) glds16(c2g+p*256+lane*4,(unsigned)__builtin_amdgcn_readfirstlane(lds0+LDS_C2+p*1024)); }
  const __attribute__((address_space(3))) float* c2l=(const __attribute__((address_space(3))) float*)(shm3+LDS_C2)+t0*KVBLK+4*hi;
  DMA_K(0,0);DMA_V(0,0);DMA_K(1,SLOTB);
  bf16x8 qr[4];
  #pragma unroll
  for(int d0=0;d0<4;++d0)qr[d0]=*reinterpret_cast<const bf16x8*>(&Qw[(long)r32*DM+d0*16+hi*8]);
  float l_reg=0.f;f32x16 o[2];o[0]=f32x16{};o[1]=f32x16{};
  float base=c2g[q0+wid*QBLK+r32];
  const int qrel=wid*QBLK+r32;
  #define CMASK(P0,P1,t) do{int jb_=(t)-(NT-4); if(jb_>=0)cmask(P0,P1,jb_,qrel,hi);}while(0)
  bool resc=false;
  #define START(P0,P1) do{ const float rm=rowmax(P0,P1); resc=false; \
    { const float dl=rm; base=fsub_s(base,dl); \
      _Pragma("unroll") for(int r=0;r<16;++r){P0[r]=fsub_s(P0[r],dl);P1[r]=fsub_s(P1[r],dl);} } \
    _Pragma("unroll") for(int r=0;r<16;++r)P0[r]=__builtin_amdgcn_exp2f(P0[r]); }while(0)
  #define RESC() do{ if(resc){ asm volatile("s_waitcnt lgkmcnt(0)":::"memory"); \
      _Pragma("unroll") for(int d_=0;d_<2;++d_) _Pragma("unroll") for(int r=0;r<16;++r)o[d_][r]*=wsf[crow(r,hi)]; } }while(0)
  f32x16 pA0,pA1,pB0,pB1;
  #define BIASLD(P0,P1,tt) do{ _Pragma("unroll") for(int g_=0;g_<4;++g_){ const f32x4v x0_=*(const __attribute__((address_space(3))) f32x4v*)(c2l+(tt)*KVBLK+8*g_), x1_=*(const __attribute__((address_space(3))) f32x4v*)(c2l+(tt)*KVBLK+32+8*g_); \
      P0[4*g_]=x0_[0];P0[4*g_+1]=x0_[1];P0[4*g_+2]=x0_[2];P0[4*g_+3]=x0_[3]; P1[4*g_]=x1_[0];P1[4*g_+1]=x1_[1];P1[4*g_+2]=x1_[2];P1[4*g_+3]=x1_[3]; } }while(0)
  #define BIASFIX(P0,P1) do{ _Pragma("unroll") for(int r=0;r<16;++r){P0[r]=fsub_s(base,P0[r]);P1[r]=fsub_s(base,P1[r]);} }while(0)
  int sl_prev=0,sl_cur=0,sl_next=SLOTB;
  #define ROT() do{sl_prev=sl_cur;sl_cur=sl_next;sl_next=(sl_next==(NSLOT-1)*SLOTB)?0:sl_next+SLOTB;}while(0)
  DMA_K(2,2*SLOTB);
  WAIT_BAR(3);
  BIASLD(pA0,pA1,0); BIASFIX(pA0,pA1);
  qkt(pA0,pA1,Kbase,qr,r32,hi);asm volatile("s_nop 15\n\ts_nop 7":"+v"(pA0),"+v"(pA1));CMASK(pA0,pA1,0);
  START(pA0,pA1);
  _Pragma("unroll") for(int r=0;r<16;++r)pA1[r]=__builtin_amdgcn_exp2f(pA1[r]);
  BIASLD(pB0,pB1,1);
  WAIT_BAR(0);
  DMA_K(3,0);DMA_V(1,SLOTB);
  ROT();
  kload8(kf,kp0+sl_cur);
  WAIT_BAR(2);
  s16x4 vlo[8],vhi[8]; u32x4 pw0,pw1,pw2,pw3;
  #define PKW(P,B) cvtpk_s(P[B],P[B+1])
  #define PAF(k) __builtin_bit_cast(bf16x8,pw##k)
  #define VFR(i) (bf16x8){vlo[i][0],vlo[i][1],vlo[i][2],vlo[i][3],vhi[i][0],vhi[i][1],vhi[i][2],vhi[i][3]}
  #define PIN(x) asm volatile("":"+v"(x))
  #define MX3(a,b,c) __builtin_fmaxf(__builtin_fmaxf((a),(b)),(c))
  #define GAPA(MF,A0,A1,A2,A3,W0,W1,PW) do{ MF; sacc+=A0; sacc+=A1; sacc+=A2; sacc+=A3; PIN(sacc); W0; W1; PIN(PW); SBAR(); }while(0)
  #define EX(v) __builtin_amdgcn_exp2f(v)
  #define GAPB(MF,X,B) do{ MF; X[B]=EX(X[B]); X[B+1]=EX(X[B+1]); X[B+2]=EX(X[B+2]); X[B+3]=EX(X[B+3]); PIN(X); SBAR(); }while(0)
  #define VRD(i) do{ vlo[i]=vtr(vp_+(((i)>>2)*4096+((i)&3)*1024)); vhi[i]=vtr(vp_+(((i)>>2)*4096+((i)&3)*1024+512)); }while(0)
  #define KRD(G,j) do{ if(G){ kload2(kf,kp0+sl_next,j); SBAR(); } }while(0)
  #define STEP(C0,C1,P0,P1,t,GK,GV,GL) do{ SBAR(); \
    BIASFIX(C0,C1); SBAR(); \
    const lds_cptr vp_=vp0+sl_prev; \
    VRD(0); SBAR(); float sacc=(P0[0]+P0[1]); \
    GAPA(C0=__builtin_amdgcn_mfma_f32_32x32x16_bf16(kf[0],qr[0],C0,0,0,0), P0[2],P0[3],P0[4],P0[5],     pw0[0]=PKW(P0,0), pw0[1]=PKW(P0,2), pw0); \
    VRD(4); SBAR(); GAPA(C1=__builtin_amdgcn_mfma_f32_32x32x16_bf16(kf[1],qr[0],C1,0,0,0), P0[6],P0[7],P0[8],P0[9],     pw0[2]=PKW(P0,4), pw0[3]=PKW(P0,6), pw0); \
    VRD(1); SBAR(); GAPA(C0=__builtin_amdgcn_mfma_f32_32x32x16_bf16(kf[2],qr[1],C0,0,0,0),   P0[10],P0[11],P0[12],P0[13], pw1[0]=PKW(P0,8), pw1[1]=PKW(P0,10), pw1); \
    VRD(5); SBAR(); GAPA(C1=__builtin_amdgcn_mfma_f32_32x32x16_bf16(kf[3],qr[1],C1,0,0,0),   P0[14],P0[15],P1[0],P1[1],   pw1[2]=PKW(P0,12),pw1[3]=PKW(P0,14), pw1); \
    VRD(2); SBAR(); GAPA(C0=__builtin_amdgcn_mfma_f32_32x32x16_bf16(kf[4],qr[2],C0,0,0,0),   P1[2],P1[3],P1[4],P1[5],     pw2[0]=PKW(P1,0), pw2[1]=PKW(P1,2), pw2); \
    VRD(6); SBAR(); GAPA(C1=__builtin_amdgcn_mfma_f32_32x32x16_bf16(kf[5],qr[2],C1,0,0,0),   P1[6],P1[7],P1[8],P1[9],     pw2[2]=PKW(P1,4), pw2[3]=PKW(P1,6), pw2); \
    VRD(3); SBAR(); GAPA(C0=__builtin_amdgcn_mfma_f32_32x32x16_bf16(kf[6],qr[3],C0,0,0,0),   P1[10],P1[11],P1[12],P1[13], pw3[0]=PKW(P1,8), pw3[1]=PKW(P1,10), pw3); \
    VRD(7); SBAR(); GAPA(C1=__builtin_amdgcn_mfma_f32_32x32x16_bf16(kf[7],qr[3],C1,0,0,0),   P1[14],P1[15],0.f,0.f,       pw3[2]=PKW(P1,12),pw3[3]=PKW(P1,14), pw3); \
    l_reg+=sacc; \
    if(GL){BIASLD(P0,P1,(t)+1);} \
    if(GK){DMA_K((t)+3,sl_cur);} if(GV){DMA_V((t)+1,sl_next);} \
    CMASK(C0,C1,t); \
    { float a=MX3(C0[0],C0[1],C1[0]),b=MX3(C0[2],C0[3],C1[1]); a=MX3(a,C1[2],C1[3]); \
      _Pragma("unroll") for(int r=4;r<16;r+=4){a=MX3(a,C0[r],C0[r+1]);b=MX3(b,C0[r+2],C0[r+3]);a=MX3(a,C1[r],C1[r+1]);b=MX3(b,C1[r+2],C1[r+3]);} \
      float rm=__builtin_fmaxf(a,b); { auto rr=__builtin_amdgcn_permlane32_swap(__float_as_uint(rm),__float_as_uint(rm),false,false); rm=__builtin_fmaxf(__uint_as_float(rr[0]),__uint_as_float(rr[1])); } \
      resc=false; \
      if(__builtin_expect(__any(rm>(float)THRL),0)){ const float dl=__builtin_fmaxf(rm,0.f); base-=dl; \
        _Pragma("unroll") for(int r=0;r<16;++r){C0[r]-=dl;C1[r]-=dl;} \
        const float f=__builtin_amdgcn_exp2f(-dl); l_reg*=f; if(hi==0)wsf[r32]=f; resc=true; } } \
    SBAR(); \
    GAPB(o[0]=__builtin_amdgcn_mfma_f32_32x32x16_bf16(PAF(0),VFR(0),o[0],0,0,0), C0,0); \
    GAPB(o[1]=__builtin_amdgcn_mfma_f32_32x32x16_bf16(PAF(0),VFR(4),o[1],0,0,0), C0,4); \
    KRD(GL,0); GAPB(o[0]=__builtin_amdgcn_mfma_f32_32x32x16_bf16(PAF(1),VFR(1),o[0],0,0,0), C0,8); \
    KRD(GL,1); GAPB(o[1]=__builtin_amdgcn_mfma_f32_32x32x16_bf16(PAF(1),VFR(5),o[1],0,0,0), C0,12); \
    KRD(GL,2); GAPB(o[0]=__builtin_amdgcn_mfma_f32_32x32x16_bf16(PAF(2),VFR(2),o[0],0,0,0), C1,0); \
    KRD(GL,3); GAPB(o[1]=__builtin_amdgcn_mfma_f32_32x32x16_bf16(PAF(2),VFR(6),o[1],0,0,0), C1,4); \
    GAPB(o[0]=__builtin_amdgcn_mfma_f32_32x32x16_bf16(PAF(3),VFR(3),o[0],0,0,0), C1,8); \
    GAPB(o[1]=__builtin_amdgcn_mfma_f32_32x32x16_bf16(PAF(3),VFR(7),o[1],0,0,0), C1,12); \
    }while(0)
  int t=1;
  #undef CMASK
  #define CMASK(P0,P1,t) do{}while(0)
  for(;t+5<NT;t+=2){
    STEP(pB0,pB1,pA0,pA1,t,true,true,true);     WAIT_BAR(2); RESC(); ROT();
    STEP(pA0,pA1,pB0,pB1,t+1,true,true,true);   WAIT_BAR(2); RESC(); ROT();
  }
  #undef CMASK
  #define CMASK(P0,P1,t) do{int jb_=(t)-(NT-4); if(jb_>=0)cmask(P0,P1,jb_,qrel,hi);}while(0)
  #define ENDW(tt) do{ if((tt)+3<NT){WAIT_BAR(2);} else if((tt)+2<NT){WAIT_BAR(1);} else {WAIT_BAR(0);} }while(0)
  for(;t+1<NT;t+=2){
    STEP(pB0,pB1,pA0,pA1,t,(t+3<NT),(t+1<NT),(t+1<NT));       ENDW(t);   RESC(); ROT();
    STEP(pA0,pA1,pB0,pB1,t+1,(t+4<NT),(t+2<NT),(t+2<NT));     ENDW(t+1); RESC(); ROT();
  }
  STEP(pB0,pB1,pA0,pA1,NT-1,false,false,false); RESC();
  { float sacc=pB0[0]+pB0[1]; _Pragma("unroll") for(int r=2;r<16;++r)sacc+=pB0[r]; _Pragma("unroll") for(int r=0;r<16;++r)sacc+=pB1[r]; l_reg+=sacc;
    pw0=(u32x4){PKW(pB0,0),PKW(pB0,2),PKW(pB0,4),PKW(pB0,6)};pw1=(u32x4){PKW(pB0,8),PKW(pB0,10),PKW(pB0,12),PKW(pB0,14)};pw2=(u32x4){PKW(pB1,0),PKW(pB1,2),PKW(pB1,4),PKW(pB1,6)};pw3=(u32x4){PKW(pB1,8),PKW(pB1,10),PKW(pB1,12),PKW(pB1,14)};
    SBAR(); pv(o,vb0+sl_cur,PAF(0),PAF(1),PAF(2),PAF(3)); }
  #undef PKW
  #undef PAF
  #undef VFR
  #undef PIN
  #undef MX3
  #undef GAPA
  #undef GAPB
  #undef EX
  #undef VRD
  #undef KRD
  #undef STEP
  #undef ENDW
  {auto rr=__builtin_amdgcn_permlane32_swap(__float_as_uint(l_reg),__float_as_uint(l_reg),false,false);l_reg=__uint_as_float(rr[0])+__uint_as_float(rr[1]);}
  if(hi==0)wsf[32+r32]=l_reg;asm volatile("s_waitcnt lgkmcnt(0)":::"memory");
  float rli[16];
  #pragma unroll
  for(int r=0;r<16;++r)rli[r]=__builtin_amdgcn_rcpf(wsf[32+crow(r,hi)]);
  bf16*Ow=O+(rowbase+q0+wid*QBLK)*OP+h*D; const bf16*Gw=Z+(rowbase+q0+wid*QBLK)*DM+1536+h*D;
  { bf16*stg=(bf16*)(shm+LDS_OST)+wid*2048;
    #pragma unroll
    for(int r=0;r<16;++r){const int orow=crow(r,hi);
      #pragma unroll
      for(int d0=0;d0<2;++d0)stg[orow*64+d0*32+r32]=(bf16)f2bf(o[d0][r]*rli[r]);}
    asm volatile("s_waitcnt lgkmcnt(0)":::"memory");
    #pragma unroll
    for(int i=0;i<4;++i){const int row=i*8+(lane>>3),ch=lane&7; const u32x4 v=*(const u32x4*)(stg+row*64+ch*8), g=*(const u32x4*)(Gw+(long)row*DM+ch*8);
      const unsigned vw[4]={v.x,v.y,v.z,v.w},gw[4]={g.x,g.y,g.z,g.w}; unsigned ow[4];
      #pragma unroll
      for(int j=0;j<4;++j){ const float a0=bflo(vw[j])*__builtin_amdgcn_rcpf(1.0f+__expf(-bflo(gw[j]))), a1=bfhi(vw[j])*__builtin_amdgcn_rcpf(1.0f+__expf(-bfhi(gw[j]))); ow[j]=cvtpk_s(a0,a1); }
      ATTN_STORE16(Ow+(long)row*OP+ch*8,((u32x4){ow[0],ow[1],ow[2],ow[3]}));} }
  asm volatile("s_waitcnt lgkmcnt(0)\n\ts_barrier":::"memory");
  #undef DMA_K
  #undef DMA_V
  #undef CMASK
  #undef START
  #undef RESC
  #undef ROT
}
constexpr int ATTN_LDS_BYTES=LDS_BYTES;
#undef SBAR
#undef WAIT_BAR
}
constexpr int CW_QATT = 128, CW_QCVT = 384;
constexpr int MISC_TAB = 64, MISC_Q = 4096, MISC_PFX = 4160;

__device__ __forceinline__ int attn_t0(KPR P, const float* c2, int q0, int lane) {
    float gq = fabsf(P.q_norm[lane]), gk = fabsf(P.k_norm[lane]);
#pragma unroll
    for (int o = 1; o < 64; o <<= 1) { gq = fmaxf(gq, __shfl_xor(gq, o)); gk = fmaxf(gk, __shfl_xor(gk, o)); }
    const float thr = c2[q0] + (2.0f * 8.0f * LOG2E * gq * gk + 40.0f);
    const int nfull = q0 / 64; int t0 = 0;
    for (int tb = 0; tb < nfull; tb += 64) { const int tt = tb + lane; const bool sk = (tt < nfull) && (c2[tt * 64 + 63] > thr); const unsigned long long bm = __ballot(sk); t0 += __popcll(bm); if (bm != ~0ull) break; }
    return __builtin_amdgcn_readfirstlane(t0) & ~1;
}
__device__ __forceinline__ void combine_row(KPR P, const LAS int* tab, int row, int lane) {
    const int* route = (const int*)(P.ws + WS_ROUTE); const unsigned char* YP = P.ws + WS_YP; bf16_t* X = (bf16_t*)(P.ws + WS_X1);
    f32x4 v[4]; const u32x2* xr = (const u32x2*)(X + (size_t)row * DM) + lane;
#pragma unroll
    for (int j = 0; j < 4; ++j) { const u32x2 xv = xr[64 * j]; v[j] = (f32x4){bflo(xv.x), bfhi(xv.x), bflo(xv.y), bfhi(xv.y)}; }
#pragma unroll
    for (int k = 0; k < 4; ++k) { const int ex = route[(size_t)row * 12 + k], rank = route[(size_t)row * 12 + 4 + k]; const size_t pos = (size_t)tab[pg8::T_BLKSTART + ex] * 256 + rank;
        const unsigned* yr = (const unsigned*)(YP + pos * DM) + lane;
#pragma unroll
        for (int j = 0; j < 4; ++j) { const unsigned y = yr[64 * j]; const f32x2 lo = __builtin_amdgcn_cvt_pk_f32_fp8((int)y, false), hi = __builtin_amdgcn_cvt_pk_f32_fp8((int)y, true);
            v[j][0] += lo[0] * 0.0625f; v[j][1] += lo[1] * 0.0625f; v[j][2] += hi[0] * 0.0625f; v[j][3] += hi[1] * 0.0625f; } }
    u32x2* xo = (u32x2*)(X + (size_t)row * DM) + lane; float s = 0.f;
#pragma unroll
    for (int j = 0; j < 4; ++j) { u32x2 w; w.x = pk2(v[j][0], v[j][1]); w.y = pk2(v[j][2], v[j][3]); xo[64 * j] = w; v[j] = (f32x4){bflo(w.x), bfhi(w.x), bflo(w.y), bfhi(w.y)}; s += (v[j][0] * v[j][0] + v[j][1] * v[j][1]) + (v[j][2] * v[j][2] + v[j][3] * v[j][3]); }
    const float rstd = rsqrtf(wave_sum(s) * (1.f / DM) + 1e-6f);
#pragma unroll
    for (int j = 0; j < 4; ++j) v[j] = v[j] * rstd * ((const f32x4*)P.ple_norm)[64 * j + lane];
    store_row_fp8(P.ws + WS_XN + (size_t)row * DM, lane, v);
}

constexpr int NPHASE = 13;
__global__ void __launch_bounds__(NTHREADS, 2) mega_fwd(Params Pkarg_unused) {
    extern __shared__ __attribute__((aligned(16))) unsigned char smem[];
    LAS unsigned char* lds = (LAS unsigned char*)smem;
    const int tid = threadIdx.x, lane = tid & 63, wave = __builtin_amdgcn_readfirstlane(tid >> 6);
    const int G = gridDim.x, blk = blockIdx.x;
#define P (*kpp)
#ifndef MK_REP
#define MK_REP -1
#endif
#define PHASE_BEGIN(k) if (IN(k)) for (int rep_ = 0; rep_ < ((k) == MK_REP ? 2 : 1); ++rep_) { const __attribute__((address_space(4))) Params* kpp = kp_fresh();
#define PHASE_END(k) } if (BOTH(k)) { XcdBarrier bar_; bar_.bar = (unsigned*)((*kp_fresh()).ws + WS_CTL) + CW_BAR; bar_.x = xb_xcc_id(); bar_.st = (volatile LAS unsigned*)(lds + MISC_OFF); xcd_barrier(bar_); }
#define IN(k) (ph_lo <= (k) && (k) < ph_hi)
#define BOTH(k) (IN(k) && IN((k) + 1))
    const __attribute__((address_space(4))) Params* kpp = kp_fresh();
    if (tid < 16) ((volatile LAS unsigned*)(lds + MISC_OFF))[tid] = 0u;
    __syncthreads();
    (void)xcd_barrier_post((unsigned*)(P.ws + WS_CTL) + CW_BAR, (volatile LAS unsigned*)(lds + MISC_OFF));
    const int ph_lo = P.ph_lo, ph_hi = P.ph_hi;
#define wsb (P.ws)
#define ctl ((unsigned*)(P.ws + WS_CTL))
#define MISC ((volatile LAS unsigned*)(lds + MISC_OFF))
#define tab ((LAS int*)(lds + MISC_OFF + MISC_TAB))

    PHASE_BEGIN(0)
        phase_prep_weights(P, lds, blk * NWAVES + wave, G * NWAVES, wave, lane);
        phase_cvt_p(P, blk * NTHREADS + tid, G * NTHREADS);
        __syncthreads();
        LAS float* wff = (LAS float*)lds; LAS float* lf = (LAS float*)(lds + 32768);
        load_wff(P, wff, tid, NTHREADS); __syncthreads();
        for (int i = 0; i < 16; ++i) { const int rl = wave * 16 + i; norm1_row(P, blk * 128 + rl, lane, wff, lf + rl * 8); }
        __syncthreads();
        if (tid < 8) { float run = 0.f; float* cloc = (float*)(P.ws + WS_LOGF) + (size_t)blk * 128 * 8 + tid;
            for (int r = 0; r < 128; ++r) { run += lf[r * 8 + tid]; cloc[r * 8] = run; }
            ((float*)(P.ws + WS_CTOT))[blk * 8 + tid] = run; }
        if (blk >= G - 16) rt::build_w(P, blk - (G - 16), tid);
    PHASE_END(0)

    PHASE_BEGIN(1)
        {
            LAS float* pfx = (LAS float*)(lds + MISC_OFF + MISC_PFX);
            if (tid < 64) { const float* ct = (const float*)(wsb + WS_CTOT); const int j = (blk & ~63) + tid; float v8[8];
#pragma unroll
                for (int h = 0; h < 8; ++h) v8[h] = (j < blk) ? ct[j * 8 + h] : 0.f;
#pragma unroll
                for (int h = 0; h < 8; ++h) { const float s = wave_sum(v8[h]); if (tid == 0) pfx[h] = s; } }
            __syncthreads();
            const float* cloc = (const float*)(wsb + WS_LOGF) + (size_t)blk * 128 * 8; float* c2 = (float*)(P.ws + WS_C2);
            for (int i = tid; i < 1024; i += NTHREADS) { const int r = i >> 3, h = i & 7; const int row = blk * 128 + r, b = row >> 13, t = row & (SEQ - 1);
                c2[((size_t)(b * 8 + h)) * SEQ + t] = (cloc[i] + pfx[h]) * LOG2E; }
            __syncthreads();
        }
        {
            pg8::DenseOrder S{(const bf16_t*)(wsb + WS_XN), (const bf16_t*)(wsb + WS_WIN), 1024, NTOK / 256, ZW / 256, G, blk};
            pg8::EpiIn E{(bf16_t*)(P.ws + WS_Z), P.q_norm, P.k_norm};
            pg8::gemm_phase<pg8::EpiIn, pg8::DenseOrder, true>(lds, 1024, S, E);
        }
        {
            pg8::DenseOrder S{(const bf16_t*)((unsigned char*)P.out + DO_PB), (const bf16_t*)(wsb + WS_WPP), PLE, NTOK / 256, DM / 256, G / 2, blk >= G / 2 ? blk - G / 2 : (1 << 20)};
            pg8::EpiBf16 E{(bf16_t*)((unsigned char*)P.out + DO_PJ), DM};
            pg8::gemm_phase<pg8::EpiBf16, pg8::DenseOrder, true>(lds, PLE, S, E);
        }
    PHASE_END(1)

    PHASE_BEGIN(2)
        rk::lora_block(P, lds, blk, G, tid);
    PHASE_END(2)

    PHASE_BEGIN(3)
        for (int task = blk; task < NB * NH * rk::NCHUNK; task += G) rk::pass1_chunk(P, lds, task >> 7, task & 127, tid);
    PHASE_END(3)

    PHASE_BEGIN(4)
        if (blk < NB * NH) rk::pass2_seq(P, lds, blk, tid);
#define CVT_LOOP() for (;;) { __syncthreads(); if (tid == 0) MISC[MISC_Q / 4] = __hip_atomic_fetch_add(ctl + CW_QCVT + 64 * rep_, 1u, RLX_AGENT); __syncthreads(); \
            const int q = (int)MISC[MISC_Q / 4]; if (q >= NCVT) break; cvt_task(P, lds, q, wave, lane); }
        if (blk & 1) { CVT_LOOP() }
        for (;;) {
            __syncthreads();
            if (tid == 0) MISC[MISC_Q / 4] = __hip_atomic_fetch_add(ctl + CW_QATT + 64 * rep_, 1u, RLX_AGENT);
            __syncthreads();
            const int q = (int)MISC[MISC_Q / 4];
            if (q >= 1024) break;
            { const int bh = q & 31, qb = 31 - (q >> 5); const float* c2 = (const float*)(wsb + WS_C2) + (size_t)bh * SEQ;
              const int t0 = attn_t0(P, c2, qb * 256, lane);
              attn_body::attn_unit<8>(bh >> 3, bh & 7, qb, t0, (const bf16_t*)(wsb + WS_Z), c2, (bf16_t*)(P.ws + WS_AO), (char*)smem); }
        }
        if (!(blk & 1)) { CVT_LOOP() }
#undef CVT_LOOP
    PHASE_END(4)

    PHASE_BEGIN(5)
        for (int task = blk; task < NB * NH * rk::NCHUNK; task += G) rk::pass3_chunk(P, lds, task >> 7, task & 127, tid);
    PHASE_END(5)

    PHASE_BEGIN(6)
        pg8::DenseOrder S{(const bf16_t*)(wsb + WS_AO), (const bf16_t*)(wsb + WS_WOUT), 1024, NTOK / 256, DM / 256, G, blk};
        pg8::EpiOut E{P.x, (bf16_t*)(P.ws + WS_X1)};
        pg8::gemm_phase<pg8::EpiOut, pg8::DenseOrder, true>(lds, 1024, S, E);
    PHASE_END(6)

    PHASE_BEGIN(7)
        rt::copy_w(P, lds, tid);
        if (blk == 0 && tid < 256) ((unsigned*)(P.ws + WS_XN + (size_t)NTOK * DM))[tid] = 0u;
        __syncthreads();
        for (int task = wave * G + blk; task < NTOK / 32; task += NWAVES * G) rt::route_task(P, lds, task, lane);
    PHASE_END(7)

    PHASE_BEGIN(8)
        const int nblk = pg8::moe_tables(tab, (const unsigned*)(wsb + WS_CTL) + CW_CNT);
        pg8::MoeOrder S{wsb + WS_XN, wsb + WS_WGU, (const int*)(wsb + WS_TOKSLOT), (const float*)(wsb + WS_GATESLOT), tab, nblk, 8, G, blk, true};
        pg8::EpiGu E{P.ws + WS_ACT, P.b_gu};
        pg8::gemm_phase<pg8::EpiGu, pg8::MoeOrder, true, true>(lds, 1024, S, E);
    PHASE_END(8)
    PHASE_BEGIN(9)
        const int nblk = pg8::moe_tables(tab, (const unsigned*)(wsb + WS_CTL) + CW_CNT);
        pg8::MoeOrder S{wsb + WS_ACT, wsb + WS_WDN, (const int*)(wsb + WS_TOKSLOT), (const float*)(wsb + WS_GATESLOT), tab, nblk, 4, G, blk, false};
        pg8::EpiDn E{P.ws + WS_YP, P.b_down, (const float*)(wsb + WS_GATESLOT), tab};
        pg8::gemm_phase<pg8::EpiDn, pg8::MoeOrder, true, true>(lds, 1024, S, E);
    PHASE_END(9)
    PHASE_BEGIN(10)
        (void)pg8::moe_tables(tab, (const unsigned*)(wsb + WS_CTL) + CW_CNT);
        for (int row = blk * NWAVES + wave; row < NTOK; row += G * NWAVES) combine_row(P, tab, row, lane);
    PHASE_END(10)
    PHASE_BEGIN(11)
        pg8::DenseOrder S{wsb + WS_XN, wsb + WS_WPG, 512, NTOK / 256, DM / 256, G, blk};
        pg8::EpiPg E{(bf16_t*)(P.ws + WS_X1), (const bf16_t*)((unsigned char*)P.out + DO_PJ)};
        pg8::gemm_phase<pg8::EpiPg, pg8::DenseOrder, true, true>(lds, 1024, S, E);
    PHASE_END(11)
    PHASE_BEGIN(12)
        const bool dead = __hip_atomic_load(ctl + CW_BAR + XB_TMO, RLX_AGENT) != 0u;
        for (int row = blk * NWAVES + wave; row < NTOK; row += G * NWAVES) final_row(P, row, lane, dead);
    PHASE_END(12)
}
#undef P
#undef wsb
#undef ctl
#undef MISC
#undef tab
extern "C" void kernel_launch(void* const* d_in, const int* in_sizes, int n_in, void* d_out, int out_size, void* d_ws, size_t ws_size, hipStream_t stream) {
    static int ok = 0;
    if (ok == 0) {
        if (n_in != 30 || in_sizes[0] != NTOK * DM || out_size != NTOK * DM || ws_size < WS_END) { fprintf(stderr, "kernel_launch: unexpected shapes (n_in %d, ws %zu)\n", n_in, ws_size); ok = -1; return; }
        if (hipFuncSetAttribute((const void*)mega_fwd, hipFuncAttributeMaxDynamicSharedMemorySize, LDS_BYTES) != hipSuccess) { fprintf(stderr, "kernel_launch: hipFuncSetAttribute failed\n"); ok = -1; return; }
        int dev = 0, cus = 0, per_cu = 0;
        if (hipGetDevice(&dev) != hipSuccess || hipDeviceGetAttribute(&cus, hipDeviceAttributeMultiprocessorCount, dev) != hipSuccess) { ok = -1; return; }
        if (hipOccupancyMaxActiveBlocksPerMultiprocessor(&per_cu, (const void*)mega_fwd, NTHREADS, LDS_BYTES) != hipSuccess || per_cu < 1) { fprintf(stderr, "kernel_launch: occupancy query says %d\n", per_cu); }
        (void)hipGetLastError();
        if (cus != 256) { fprintf(stderr, "kernel_launch: built for 256 CUs, device has %d\n", cus); ok = -1; return; }
        ok = 1;
    }
    if (ok < 0) return;
    Params P{};
    const float** pp = (const float**)&P;
    for (int i = 0; i < 30; ++i) pp[i] = (const float*)d_in[i];
    P.out = (float*)d_out; P.ws = (unsigned char*)d_ws;
    if (hipMemsetAsync((char*)d_ws + WS_CTL, 0, CTL_BYTES, stream) != hipSuccess) return;
#ifndef MK_CUTS
#define MK_CUTS 0
#endif
    if (MK_CUTS == 0) { P.ph_lo = 0; P.ph_hi = NPHASE; hipLaunchKernelGGL(mega_fwd, dim3(256), dim3(NTHREADS), LDS_BYTES, stream, P); }
    else for (int k = 0; k < NPHASE; ++k) { P.ph_lo = k; P.ph_hi = k + 1;
        hipLaunchKernelGGL(mega_fwd, dim3(256), dim3(NTHREADS), LDS_BYTES, stream, P); }
}
```

```cpp
#include <hip/hip_runtime.h>
#include <cstdio>
#include <cstdint>

#define LAS __attribute__((address_space(3)))
#define GAS __attribute__((address_space(1)))
typedef unsigned short bf16_t;
typedef short bf16x8 __attribute__((ext_vector_type(8)));
typedef float f32x2 __attribute__((ext_vector_type(2)));
typedef float f32x4 __attribute__((ext_vector_type(4)));
typedef float f32x16 __attribute__((ext_vector_type(16)));
typedef unsigned u32x2 __attribute__((ext_vector_type(2)));
typedef unsigned u32x4 __attribute__((ext_vector_type(4)));

constexpr int NB = 4, SEQ = 8192, NTOK = NB * SEQ, DM = 1024;
constexpr int NH = 8, HD = 64;
constexpr int INW = 3848;
constexpr int ZW = 3840;
constexpr int ZQ = 0, ZK = 512, ZV = 1024, ZOG = 1536, ZR = 2048;
constexpr int RW_R = 0, RW_K = 512, RW_V = 1024, RW_W = 1536, RW_A = 1600, RW_G = 1664, RWIN = 1792;
constexpr int NE = 32, TOPK = 4, EFF = 1024;
constexpr int MAXBLK = (NTOK * TOPK) / 256 + NE;
constexpr int PLE = 256;
constexpr float LOG2E = 1.4426950408889634f;
constexpr float QSCALE = 0.125f * LOG2E;

constexpr size_t MiB = 1u << 20;
constexpr size_t WS_CTL = 0, CTL_BYTES = 1 * MiB;
constexpr size_t WS_C2 = 1 * MiB;
constexpr size_t WS_LOGF = 2 * MiB;
constexpr size_t WS_ROUTE = 3 * MiB;
constexpr size_t WS_TOKSLOT = 5 * MiB;
constexpr size_t WS_GATESLOT = 9 * MiB;
constexpr size_t WS_CTOT = 13 * MiB;
constexpr size_t WS_WIN = 16 * MiB;
constexpr size_t WS_WOUT = 24 * MiB;
constexpr size_t WS_WPG = 26 * MiB;
constexpr size_t WS_WPP = 28 * MiB;
constexpr size_t WS_WGU = 32 * MiB;
constexpr size_t WS_WDN = 160 * MiB;
constexpr size_t WS_XN = 224 * MiB;
constexpr size_t WS_X1 = 290 * MiB;
constexpr size_t WS_Z = 418 * MiB;
constexpr size_t WS_AO = 658 * MiB;
constexpr size_t WS_ACT = 418 * MiB;
constexpr size_t WS_RW = 722 * MiB;
constexpr size_t WS_RR = WS_RW, WS_RK = WS_RW + 32 * MiB, WS_RV = WS_RW + 64 * MiB, WS_RG = WS_RW + 96 * MiB;
constexpr size_t WS_RLW = WS_RW + 128 * MiB;
constexpr size_t WS_RKK = WS_RW + 160 * MiB, WS_RKA = WS_RW + 192 * MiB;
constexpr size_t WS_YP = 722 * MiB;
constexpr size_t WS_END = 994 * MiB;
static_assert(WS_ACT + (size_t)MAXBLK * 256 * 1024 * 2 <= WS_RW && WS_YP + (size_t)MAXBLK * 256 * 1024 * 2 <= WS_END, "ws map");
constexpr size_t DO_PJ = 0, DO_PB = 64 * MiB;
constexpr int CW_TMO = 0, CW_CNT = 64  , CW_BAR = 4096;

struct Params {
    const float *x, *p, *mix_norm, *w_in, *f_bias, *q_norm, *k_norm, *mu, *w0, *w2, *a0, *a2, *g2, *k_k, *k_a, *r_k, *ln_w, *ln_b, *w_out, *moe_norm, *w_router, *b_router, *w_gu, *b_gu, *w_down,
        *b_down, *ple_norm, *w_pg, *w_pp, *final_norm;
    float* out; unsigned char* ws; int ph_lo, ph_hi;
};

typedef const __attribute__((address_space(4))) Params& KPR;
__device__ __forceinline__ const __attribute__((address_space(4))) Params* kp_fresh() {
    unsigned long long p = (unsigned long long)__builtin_amdgcn_kernarg_segment_ptr(); asm volatile("" : "+s"(p)); return (const __attribute__((address_space(4))) Params*)p; }

typedef __bf16 bf16x2_hw __attribute__((ext_vector_type(2)));
__device__ __forceinline__ unsigned pk2(float lo, float hi) { const f32x2 v = {lo, hi}; return __builtin_bit_cast(unsigned, __builtin_convertvector(v, bf16x2_hw)); }
__device__ __forceinline__ unsigned f2bf(float f) { return pk2(f, f) & 0xffffu; }
__device__ __forceinline__ float bf2f(unsigned h) { return __builtin_bit_cast(float, h << 16); }
__device__ __forceinline__ float bflo(unsigned w) { return __builtin_bit_cast(float, w << 16); }
__device__ __forceinline__ float bfhi(unsigned w) { return __builtin_bit_cast(float, w & 0xffff0000u); }
__device__ __forceinline__ unsigned cvt_pk_bf16(float lo, float hi) { unsigned r; asm volatile("v_cvt_pk_bf16_f32 %0, %1, %2" : "=v"(r) : "v"(lo), "v"(hi)); return r; }
__device__ __forceinline__ unsigned pk4_fp8(float a, float b, float c, float d) { int w = 0; w = __builtin_amdgcn_cvt_pk_fp8_f32(a, b, w, false); w = __builtin_amdgcn_cvt_pk_fp8_f32(c, d, w, true); return (unsigned)w; }
#define DPP_ADD(v, ctrl) ((v) + __builtin_bit_cast(float, __builtin_amdgcn_mov_dpp(__builtin_bit_cast(int, (v)), (ctrl), 0xF, 0xF, true)))
__device__ __forceinline__ float wave_sum(float v) {
    v = DPP_ADD(v, 0xB1);
    v = DPP_ADD(v, 0x4E);
    v = DPP_ADD(v, 0x124);
    v = DPP_ADD(v, 0x128);
    { float a = v, b = v; asm volatile("s_nop 1\n\tv_permlane16_swap_b32 %0, %1" : "+v"(a), "+v"(b)); v = a + b; }
    { float a = v, b = v; asm volatile("s_nop 1\n\tv_permlane32_swap_b32 %0, %1" : "+v"(a), "+v"(b)); v = a + b; }
    return v;
}
__device__ __forceinline__ float sigmoidf_(float x) { return __builtin_amdgcn_rcpf(1.0f + __expf(-x)); }
__device__ __forceinline__ float logsigmoidf_(float x) { return fminf(x, 0.f) - log1pf(expf(-fabsf(x))); }
namespace pg8 {
constexpr int BM = 256, BK = 64, HALF = 128, HTB = HALF * BK * 2, STAGE_BYTES = 8 * HTB, NXCD = 8, WGM = 8;
__host__ __device__ __forceinline__ int lds_byte(int r, int c) { const int st = (r >> 4) * 2 + (c >> 5), rr = r & 15, cc = c & 31, ob = rr * 64 + cc * 2; return st * 1024 + (ob ^ (((ob >> 9) & 1) << 5)); }
__host__ __device__ __forceinline__ void stage_rc(int b, int& R, int& C) { const int st = b / 1024, sb = b % 1024, swz = sb ^ (((sb >> 9) & 1) << 5); R = (st >> 1) * 16 + swz / 64; C = (st & 1) * 32 + (swz % 64) / 2; }
__host__ __device__ __forceinline__ int perm32(int rho) { const int n = rho >> 4, i = rho & 15; return 8 * (i >> 2) + 4 * n + (i & 3); }

struct Unit { int pm, pn, e, lb, sl; };

__device__ __forceinline__ bool tile_order(int i, int G, int c, int nM, int nN, int& pm, int& pn) {
    const int nwg = nM * nN; const long L = (long)i * G + c; if (L >= nwg) return false;
    int wgid = (int)L; { const int q = nwg / NXCD, r = nwg % NXCD, xcd = wgid % NXCD, off = wgid / NXCD; wgid = (xcd < r ? xcd * (q + 1) : r * (q + 1) + (xcd - r) * q) + off; }
    const int nig = WGM * nN, gid = wgid / nig, fm = gid * WGM, gsz = (nM - fm) < WGM ? (nM - fm) : WGM;
    pm = fm + ((wgid % nig) % gsz); pn = (wgid % nig) / gsz; return true;
}
struct DenseOrder {
    const void* A; const void* Bt; int K  , nM, nN, G, c;
    __device__ __forceinline__ bool next(int i, Unit& u) const { u.e = 0; u.lb = 0; return tile_order(i, G, c, nM, nN, u.pm, u.pn); }
    __device__ __forceinline__ const char* a_base(const Unit& u) const { return (const char*)A + (size_t)u.pm * BM * K * 2; }
    __device__ __forceinline__ const char* b_base(const Unit& u) const { return (const char*)Bt + (size_t)u.pn * BM * K * 2; }
    __device__ __forceinline__ void prefetch(const Unit&, int, int, int) const {}
    __device__ __forceinline__ void a_off(const Unit&, const int (&R)[2], const int (&C)[2], unsigned (&off)[2][2]) const {
#pragma unroll
        for (int h = 0; h < 2; ++h)
#pragma unroll
            for (int i = 0; i < 2; ++i) off[h][i] = (unsigned)((R[i] + HALF * h) * K + C[i]) * 2u;
    }
};

typedef int v8i32 __attribute__((ext_vector_type(8)));
typedef int i32x4 __attribute__((ext_vector_type(4)));
template <class Epi, class Sched, bool ALIGN_EPI, bool FP8 = false>
__device__ __forceinline__ void gemm_phase(LAS unsigned char* lds, const int K, const Sched& S, const Epi& E) {
    int tid_ = threadIdx.x; asm volatile("" : "+v"(tid_));
    const int tid = tid_, wid = __builtin_amdgcn_readfirstlane(tid >> 6), lane = tid & 63, wr = wid >> 2, wc = wid & 3, fr = lane & 15, fq = lane >> 4;
    const int RB = FP8 ? K : 2 * K;
    const int nt = RB / (BK * 2);
    int sR[2], sC[2]; unsigned voffB[2];
#pragma unroll
    for (int i = 0; i < 2; ++i) { int R, C; stage_rc(tid * 16 + i * 8192, R, C); const int Rb = Epi::PERM ? ((R & ~31) + perm32(R & 31)) : R; sR[i] = R; sC[i] = C; voffB[i] = (unsigned)(Rb * RB + C * 2); }
    const size_t kstep = (size_t)(BK * 2);
    const size_t hstep = (size_t)HALF * RB;
    const unsigned ldsw = (unsigned)wid * 1024u;
    const int aoff0 = lds_byte(wr * 64 + fr, fq * 8), aoff1 = aoff0 + 1024;
    const int boff0 = lds_byte(wc * 32 + fr, fq * 8), boff1 = boff0 + 1024;
#define PG8_SA(b, h) (((b) * 2 + (h)) * HTB)
#define PG8_SB(b, h) ((4 + (b) * 2 + (h)) * HTB)
#define PG8_STAGE(bufoff, gbase, voff) do { _Pragma("unroll") for (int _i = 0; _i < 2; ++_i) \
        __builtin_amdgcn_global_load_lds((const unsigned*)((const char*)(gbase) + (voff)[_i]), (LAS unsigned*)(lds + (bufoff) + ldsw + _i * 8192), 16, 0, 0); } while (0)
#define PG8_CAT(p0, p1) __builtin_shufflevector((p0), (p1), 0, 1, 2, 3, 4, 5, 6, 7)
#define PG8_LDA(dst, b, h) do { _Pragma("unroll") for (int m = 0; m < 4; ++m) dst[m] = PG8_CAT(*(const LAS i32x4*)(lds + PG8_SA(b, h) + aoff0 + m * 2048), *(const LAS i32x4*)(lds + PG8_SA(b, h) + aoff1 + m * 2048)); } while (0)
#define PG8_LDB(dst, b, h) do { _Pragma("unroll") for (int n = 0; n < 2; ++n) dst[n] = PG8_CAT(*(const LAS i32x4*)(lds + PG8_SB(b, h) + boff0 + n * 2048), *(const LAS i32x4*)(lds + PG8_SB(b, h) + boff1 + n * 2048)); } while (0)
#define PG8_LO(x) __builtin_bit_cast(bf16x8, __builtin_shufflevector((x), (x), 0, 1, 2, 3))
#define PG8_HI(x) __builtin_bit_cast(bf16x8, __builtin_shufflevector((x), (x), 4, 5, 6, 7))
#define PG8_MMA(ai, bj, At, Bt) do { __builtin_amdgcn_s_setprio(1); \
        if constexpr (FP8) { _Pragma("unroll") for (int m = 0; m < 4; ++m) _Pragma("unroll") for (int n = 0; n < 2; ++n) \
            asm volatile("v_mfma_scale_f32_16x16x128_f8f6f4 %0, %1, %2, %0, %3, %4 op_sel_hi:[0,0,0]" : "+v"(acc[ai][bj][m][n]) : "v"(Bt[n]), "v"(At[m]), "v"(sc_w), "v"(sc_x)); } \
        else { _Pragma("unroll") for (int m = 0; m < 4; ++m) _Pragma("unroll") for (int n = 0; n < 2; ++n) { \
            acc[ai][bj][m][n] = __builtin_amdgcn_mfma_f32_16x16x32_bf16(PG8_LO(Bt[n]), PG8_LO(At[m]), acc[ai][bj][m][n], 0, 0, 0); } \
            _Pragma("unroll") for (int m = 0; m < 4; ++m) _Pragma("unroll") for (int n = 0; n < 2; ++n) { \
            acc[ai][bj][m][n] = __builtin_amdgcn_mfma_f32_16x16x32_bf16(PG8_HI(Bt[n]), PG8_HI(At[m]), acc[ai][bj][m][n], 0, 0, 0); } } \
        __builtin_amdgcn_s_setprio(0); } while (0)
#define PG8_WAIT_V(n) asm volatile("s_waitcnt vmcnt(" #n ")" ::: "memory")
#define PG8_WAIT_L(n) asm volatile("s_waitcnt lgkmcnt(" #n ")" ::: "memory")
#define PG8_BAR __builtin_amdgcn_s_barrier()
#define PG8_SCHED __builtin_amdgcn_sched_barrier(0)
    Unit cur, nxt; int ui = 0;
    if (!S.next(0, cur)) return;
    f32x4 acc[2][2][4][2];
#pragma unroll
    for (int a = 0; a < 2; ++a)
#pragma unroll
        for (int b = 0; b < 2; ++b)
#pragma unroll
            for (int m = 0; m < 4; ++m)
#pragma unroll
                for (int n = 0; n < 2; ++n) acc[a][b][m][n] = (f32x4){0.f, 0.f, 0.f, 0.f};
    const int sc_w = 121, sc_x = 127;
    v8i32 At[4], B0[2], B1[2];
    unsigned offC[2][2], offN[2][2];
    cur.sl = 0; S.prefetch(cur, 0, wid, lane); PG8_WAIT_V(0); PG8_BAR;
    S.a_off(cur, sR, sC, offC);
    const char* cA = S.a_base(cur); const char* cB = S.b_base(cur);
    PG8_STAGE(PG8_SB(0, 0), cB, voffB); PG8_STAGE(PG8_SB(0, 1), cB + hstep, voffB); PG8_STAGE(PG8_SA(0, 0), cA, offC[0]); PG8_STAGE(PG8_SA(0, 1), cA, offC[1]);
    if (wr == 1) PG8_BAR;
    PG8_WAIT_V(2); PG8_BAR;
    PG8_STAGE(PG8_SB(1, 0), cB + kstep, voffB); PG8_STAGE(PG8_SA(1, 0), cA + kstep, offC[0]); PG8_STAGE(PG8_SB(1, 1), cB + hstep + kstep, voffB);
    PG8_WAIT_V(6); PG8_BAR;
    for (;;) {
        const bool has_next = S.next(ui + 1, nxt);
        const char* nA = cA; const char* nB = cB;
        nxt.sl = cur.sl == 2 ? 0 : cur.sl + 1;
        if (has_next) { nA = S.a_base(nxt); nB = S.b_base(nxt); S.prefetch(nxt, nxt.sl, wid, lane); }
#pragma unroll
        for (int h = 0; h < 2; ++h)
#pragma unroll
            for (int i = 0; i < 2; ++i) offN[h][i] = offC[h][i];
#pragma nounroll
        for (int t = 0; t < nt; t += 2) {
            const bool last = (t == nt - 2);
            if (last && has_next) S.a_off(nxt, sR, sC, offN);
            const char* a1 = cA + (size_t)(t + 1) * kstep;
            const char* a2 = last ? nA : cA + (size_t)(t + 2) * kstep; const char* b2 = last ? nB : cB + (size_t)(t + 2) * kstep;
            const char* a3 = a2 + kstep; const char* b3 = b2 + kstep;
            unsigned o2[2][2];
#pragma unroll
            for (int h = 0; h < 2; ++h)
#pragma unroll
                for (int i = 0; i < 2; ++i) o2[h][i] = last ? offN[h][i] : offC[h][i];
            PG8_LDB(B0, 0, 0); PG8_LDB(B1, 0, 1); PG8_SCHED; PG8_LDA(At, 0, 0); PG8_STAGE(PG8_SA(1, 1), a1, offC[1]);
            PG8_WAIT_V(8); PG8_WAIT_L(0); PG8_BAR; PG8_MMA(0, 0, At, B0); PG8_MMA(0, 1, At, B1); PG8_BAR; PG8_SCHED;
            PG8_LDA(At, 0, 1); PG8_STAGE(PG8_SB(0, 0), b2, voffB); PG8_STAGE(PG8_SB(0, 1), b2 + hstep, voffB); PG8_STAGE(PG8_SA(0, 0), a2, o2[0]);
            PG8_WAIT_V(8); PG8_WAIT_L(0); PG8_BAR; PG8_MMA(1, 0, At, B0); PG8_MMA(1, 1, At, B1); PG8_BAR; PG8_SCHED;
            PG8_LDB(B0, 1, 0); PG8_LDB(B1, 1, 1); PG8_SCHED; PG8_LDA(At, 1, 0); PG8_STAGE(PG8_SA(0, 1), a2, o2[1]);
            PG8_WAIT_V(8); PG8_WAIT_L(0); PG8_BAR; PG8_MMA(0, 0, At, B0); PG8_MMA(0, 1, At, B1); PG8_BAR; PG8_SCHED;
            PG8_LDA(At, 1, 1); PG8_STAGE(PG8_SB(1, 0), b3, voffB); PG8_STAGE(PG8_SB(1, 1), b3 + hstep, voffB); PG8_STAGE(PG8_SA(1, 0), a3, o2[0]);
            PG8_WAIT_V(8); PG8_WAIT_L(0); PG8_BAR; PG8_MMA(1, 0, At, B0); PG8_MMA(1, 1, At, B1); PG8_BAR; PG8_SCHED;
        }
        if constexpr (ALIGN_EPI) { if (wr == 0) PG8_BAR; }
        E(acc, cur, wr, wc, fr, fq);
        if (!has_next) break;
#pragma unroll
        for (int a = 0; a < 2; ++a)
#pragma unroll
            for (int b = 0; b < 2; ++b)
#pragma unroll
                for (int m = 0; m < 4; ++m)
#pragma unroll
                    for (int n = 0; n < 2; ++n) acc[a][b][m][n] = (f32x4){0.f, 0.f, 0.f, 0.f};
        cur = nxt; cA = nA; cB = nB; ++ui;
#pragma unroll
        for (int h = 0; h < 2; ++h)
#pragma unroll
            for (int i = 0; i < 2; ++i) offC[h][i] = offN[h][i];
        if constexpr (ALIGN_EPI) { if (wr == 1) PG8_BAR; }
    }
    PG8_WAIT_V(0);
    if constexpr (!ALIGN_EPI) { if (wr == 0) PG8_BAR; }
    PG8_BAR;
#undef PG8_SA
#undef PG8_SB
#undef PG8_STAGE
#undef PG8_LDA
#undef PG8_LDB
#undef PG8_MMA
#undef PG8_LO
#undef PG8_HI
#undef PG8_CAT
#undef PG8_WAIT_V
#undef PG8_WAIT_L
#undef PG8_BAR
#undef PG8_SCHED
}
}
namespace pg8 {
constexpr int T_BLKSTART = 0  , T_CNT = 40  , T_BLKE = 80  , T_WORDS = 80 + 560;
constexpr int TB_OFF = 8192 - 64;

struct EpiIn {
    static constexpr bool PERM = true;
    bf16_t* Z; const float* qn; const float* kn;
    __device__ __forceinline__ void operator()(const f32x4 (&acc)[2][2][4][2], const Unit& u, int wr, int wc, int fr, int fq) const {
        const int row0 = u.pm * BM + wr * 64 + fr;
        if (u.pn < 4) {
            const float* g = (u.pn < 2) ? qn : kn; const float sc = (u.pn < 2) ? QSCALE : 1.0f;
            f32x4 gv[2][2];
#pragma unroll
            for (int bj = 0; bj < 2; ++bj)
#pragma unroll
                for (int n = 0; n < 2; ++n) gv[bj][n] = *(const f32x4*)(g + 32 * bj + 8 * fq + 4 * n) * sc;
#pragma unroll
            for (int ai = 0; ai < 2; ++ai)
#pragma unroll
                for (int m = 0; m < 4; ++m) {
                    float ss = 0.f;
#pragma unroll
                    for (int bj = 0; bj < 2; ++bj)
#pragma unroll
                        for (int n = 0; n < 2; ++n) { const f32x4 x = acc[ai][bj][m][n]; ss += (x[0] * x[0] + x[1] * x[1]) + (x[2] * x[2] + x[3] * x[3]); }
                    ss += __shfl_xor(ss, 16); ss += __shfl_xor(ss, 32);
                    const float rstd = rsqrtf(ss * (1.0f / 64.0f) + 1e-6f);
                    bf16_t* rowp = Z + (size_t)(row0 + ai * HALF + m * 16) * ZW + u.pn * BM + 64 * wc + 8 * fq;
#pragma unroll
                    for (int bj = 0; bj < 2; ++bj) { const f32x4 v0 = acc[ai][bj][m][0] * rstd * gv[bj][0], v1 = acc[ai][bj][m][1] * rstd * gv[bj][1];
                        u32x4 w; w.x = cvt_pk_bf16(v0[0], v0[1]); w.y = cvt_pk_bf16(v0[2], v0[3]); w.z = cvt_pk_bf16(v1[0], v1[1]); w.w = cvt_pk_bf16(v1[2], v1[3]);
                        *(u32x4*)(rowp + 32 * bj) = w; }
                }
        } else {
            const int col0 = u.pn * BM + wc * 32 + 8 * fq;
#pragma unroll
            for (int ai = 0; ai < 2; ++ai)
#pragma unroll
                for (int m = 0; m < 4; ++m) { bf16_t* rowp = Z + (size_t)(row0 + ai * HALF + m * 16) * ZW + col0;
#pragma unroll
                    for (int bj = 0; bj < 2; ++bj) { const f32x4 v0 = acc[ai][bj][m][0], v1 = acc[ai][bj][m][1];
                        u32x4 w; w.x = cvt_pk_bf16(v0[0], v0[1]); w.y = cvt_pk_bf16(v0[2], v0[3]); w.z = cvt_pk_bf16(v1[0], v1[1]); w.w = cvt_pk_bf16(v1[2], v1[3]);
                        *(u32x4*)(rowp + bj * HALF) = w; } }
        }
    }
};
struct EpiBf16 {
    static constexpr bool PERM = true;
    bf16_t* O; int ldc;
    __device__ __forceinline__ void operator()(const f32x4 (&acc)[2][2][4][2], const Unit& u, int wr, int wc, int fr, int fq) const {
        const int row0 = u.pm * BM + wr * 64 + fr, col0 = u.pn * BM + wc * 32 + 8 * fq;
#pragma unroll
        for (int ai = 0; ai < 2; ++ai)
#pragma unroll
            for (int m = 0; m < 4; ++m) { bf16_t* rowp = O + (size_t)(row0 + ai * HALF + m * 16) * ldc + col0;
#pragma unroll
                for (int bj = 0; bj < 2; ++bj) { const f32x4 v0 = acc[ai][bj][m][0], v1 = acc[ai][bj][m][1];
                    u32x4 w; w.x = cvt_pk_bf16(v0[0], v0[1]); w.y = cvt_pk_bf16(v0[2], v0[3]); w.z = cvt_pk_bf16(v1[0], v1[1]); w.w = cvt_pk_bf16(v1[2], v1[3]);
                    *(u32x4*)(rowp + bj * HALF) = w; } }
    }
};
struct EpiOut {
    static constexpr bool PERM = true;
    const float* X; bf16_t* O;
    __device__ __forceinline__ void operator()(const f32x4 (&acc)[2][2][4][2], const Unit& u, int wr, int wc, int fr, int fq) const {
        const int row0 = u.pm * BM + wr * 64 + fr, col0 = u.pn * BM + wc * 32 + 8 * fq;
#pragma unroll
        for (int ai = 0; ai < 2; ++ai)
#pragma unroll
            for (int m = 0; m < 4; ++m) { const size_t off = (size_t)(row0 + ai * HALF + m * 16) * DM + col0;
#pragma unroll
                for (int bj = 0; bj < 2; ++bj) { const f32x4 v0 = *(const f32x4*)(X + off + bj * HALF) + acc[ai][bj][m][0], v1 = *(const f32x4*)(X + off + bj * HALF + 4) + acc[ai][bj][m][1];
                    u32x4 w; w.x = pk2(v0[0], v0[1]); w.y = pk2(v0[2], v0[3]); w.z = pk2(v1[0], v1[1]); w.w = pk2(v1[2], v1[3]);
                    *(u32x4*)(O + off + bj * HALF) = w; }
                if (m & 1) asm volatile("" ::: "memory"); }
    }
};
struct EpiPg {
    static constexpr bool PERM = true;
    bf16_t* X; const bf16_t* PJ;
    __device__ __forceinline__ void operator()(const f32x4 (&acc)[2][2][4][2], const Unit& u, int wr, int wc, int fr, int fq) const {
        const int row0 = u.pm * BM + wr * 64 + fr, col0 = u.pn * BM + wc * 32 + 8 * fq;
#pragma unroll
        for (int ai = 0; ai < 2; ++ai)
#pragma unroll
            for (int m = 0; m < 4; ++m) { const size_t off = (size_t)(row0 + ai * HALF + m * 16) * DM + col0;
#pragma unroll
                for (int bj = 0; bj < 2; ++bj) { const size_t o = off + bj * HALF; const u32x4 pj = *(const u32x4*)(PJ + o), xv = *(const u32x4*)(X + o);
                    const unsigned pw[4] = {pj.x, pj.y, pj.z, pj.w}, xw[4] = {xv.x, xv.y, xv.z, xv.w}; unsigned ow[4];
#pragma unroll
                    for (int q = 0; q < 4; ++q) { const float a0 = acc[ai][bj][m][q >> 1][2 * (q & 1)], a1 = acc[ai][bj][m][q >> 1][2 * (q & 1) + 1];
                        ow[q] = pk2(bflo(xw[q]) + sigmoidf_(a0) * bflo(pw[q]), bfhi(xw[q]) + sigmoidf_(a1) * bfhi(pw[q])); }
                    *(u32x4*)(X + o) = (u32x4){ow[0], ow[1], ow[2], ow[3]}; }
                if (m & 1) asm volatile("" ::: "memory"); }
    }
};
struct EpiGu {
    static constexpr bool PERM = true;
    unsigned char* ACT; const float* b_gu;
    __device__ __forceinline__ void operator()(const f32x4 (&acc)[2][2][4][2], const Unit& u, int wr, int wc, int fr, int fq) const {
        const int row0 = u.pm * BM + wr * 64 + fr, cl = u.pn * HALF + wc * 32 + 8 * fq;
        const float* bg = b_gu + (size_t)u.e * 2048 + cl;
        f32x4 bgl[2], bli[2];
#pragma unroll
        for (int n = 0; n < 2; ++n) { bgl[n] = *(const f32x4*)(bg + 4 * n); bli[n] = *(const f32x4*)(bg + 1024 + 4 * n) + 1.0f; }
#pragma unroll
        for (int ai = 0; ai < 2; ++ai)
#pragma unroll
            for (int m = 0; m < 4; ++m) { unsigned char* rowp = ACT + (size_t)(row0 + ai * HALF + m * 16) * EFF + cl; f32x4 r[2];
#pragma unroll
                for (int n = 0; n < 2; ++n) {
                    f32x4 g = acc[ai][0][m][n] + bgl[n], u = acc[ai][1][m][n] + bli[n];
#pragma unroll
                    for (int i = 0; i < 4; ++i) { g[i] = fminf(g[i], 7.0f); u[i] = __builtin_amdgcn_fmed3f(u[i], -6.0f, 8.0f); }
                    f32x4 d = g * (-1.702f * LOG2E);
#pragma unroll
                    for (int i = 0; i < 4; ++i) d[i] = __builtin_amdgcn_exp2f(d[i]);
                    d = d + 1.0f;
#pragma unroll
                    for (int i = 0; i < 4; ++i) d[i] = __builtin_amdgcn_rcpf(d[i]);
                    r[n] = (g * d) * u; }
                u32x2 w; w.x = pk4_fp8(r[0][0], r[0][1], r[0][2], r[0][3]); w.y = pk4_fp8(r[1][0], r[1][1], r[1][2], r[1][3]);
                *(u32x2*)rowp = w; }
    }
};
struct EpiDn {
    static constexpr bool PERM = true;
    unsigned char* YP; const float* b_dn; const float* gateslot; const LAS int* tab;
    __device__ __forceinline__ void operator()(const f32x4 (&acc)[2][2][4][2], const Unit& u, int wr, int wc, int fr, int fq) const {
        const int row0 = u.pm * BM + wr * 64 + fr, col0 = u.pn * BM + wc * 32 + 8 * fq;
        const float* bd = b_dn + (size_t)u.e * 1024 + col0; const int cnt = tab[T_CNT + u.e];
        f32x4 bv[2][2];
#pragma unroll
        for (int bj = 0; bj < 2; ++bj)
#pragma unroll
            for (int n = 0; n < 2; ++n) bv[bj][n] = *(const f32x4*)(bd + bj * HALF + 4 * n);
#pragma unroll
        for (int ai = 0; ai < 2; ++ai)
#pragma unroll
            for (int m = 0; m < 4; ++m) { const int rr = wr * 64 + fr + ai * HALF + m * 16, slot = u.lb * 256 + rr;
                const float gt = slot < cnt ? ((const LAS float*)((const LAS unsigned char*)tab + TB_OFF + u.sl * 1024))[rr] * 4.0f : 0.f;
                unsigned char* rowp = YP + (size_t)(row0 + ai * HALF + m * 16) * DM + col0;
#pragma unroll
                for (int bj = 0; bj < 2; ++bj) { const f32x4 v0 = (acc[ai][bj][m][0] + bv[bj][0]) * gt, v1 = (acc[ai][bj][m][1] + bv[bj][1]) * gt;
                    u32x2 w; w.x = pk4_fp8(v0[0], v0[1], v0[2], v0[3]); w.y = pk4_fp8(v1[0], v1[1], v1[2], v1[3]);
                    *(u32x2*)(rowp + bj * HALF) = w; } }
    }
};
struct MoeOrder {
    const unsigned char* A; const unsigned char* Bt; const int* tokslot; const float* gateslot;   const LAS int* tab; int nblk, nN, G, c; bool gather;
    __device__ __forceinline__ bool next(int i, Unit& u) const { if (!tile_order(i, G, c, nblk, nN, u.pm, u.pn)) return false; u.e = tab[T_BLKE + u.pm]; u.lb = u.pm - tab[T_BLKSTART + u.e]; return true; }
    __device__ __forceinline__ const char* a_base(const Unit& u) const { return gather ? (const char*)A : (const char*)A + (size_t)u.pm * BM * 1024; }
    __device__ __forceinline__ const char* b_base(const Unit& u) const { return (const char*)Bt + ((size_t)u.e * nN + u.pn) * BM * 1024; }
    __device__ __forceinline__ void prefetch(const Unit& u, int slot, int wid, int lane) const {
        if (wid < 4) { const unsigned* src = (gather ? (const unsigned*)tokslot : (const unsigned*)gateslot) + (size_t)u.e * NTOK + u.lb * 256 + wid * 64 + lane;
            __builtin_amdgcn_global_load_lds(src, (LAS unsigned*)((LAS unsigned char*)tab + TB_OFF + slot * 1024 + wid * 256), 4, 0, 0); }
    }
    __device__ __forceinline__ void a_off(const Unit& u, const int (&R)[2], const int (&C)[2], unsigned (&off)[2][2]) const {
        const int cnt = tab[T_CNT + u.e]; const LAS int* tb = (const LAS int*)((const LAS unsigned char*)tab + TB_OFF + u.sl * 1024);
#pragma unroll
        for (int h = 0; h < 2; ++h)
#pragma unroll
            for (int i = 0; i < 2; ++i) {
                if (gather) { const int rr = R[i] + HALF * h; const int tk = tb[rr]; const int tok = (u.lb * 256 + rr) < cnt ? tk : NTOK; off[h][i] = (unsigned)tok * 1024u + (unsigned)C[i] * 2u; }
                else off[h][i] = (unsigned)((R[i] + HALF * h) * 1024 + C[i] * 2);
            }
    }
};
__device__ __forceinline__ int moe_tables(LAS int* tab, const unsigned* cntw) {
    if (threadIdx.x < 64) { const int e = threadIdx.x & 31; const int c = (int)cntw[e]; const int nb = (c + 255) >> 8; int incl = nb;
#pragma unroll
        for (int o = 1; o < 32; o <<= 1) { const int t = __shfl_up(incl, o, 32); if (e >= o) incl += t; }
        const int start = incl - nb;
        if (threadIdx.x < 32) { tab[T_CNT + e] = c; tab[T_BLKSTART + e] = start; if (e == NE - 1) tab[T_BLKSTART + NE] = incl;
            for (int j = 0; j < nb; ++j) tab[T_BLKE + start + j] = e; } }
    __syncthreads();
    return tab[T_BLKSTART + NE];
}
}
constexpr int NWAVES = 8, NTHREADS = 512;
constexpr int RING_BYTES = 131072, MISC_OFF = RING_BYTES, LDS_BYTES = 147456;

__device__ __forceinline__ void tr_item(const float* W, int ldw, int srccol0, int k0, bf16_t* WT, int Kd, int dstrow0, LAS float* scr, int lane) {
#pragma unroll 8
    for (int i = 0; i < 32; ++i) { const int kk = 2 * i + (lane >> 5); scr[kk * 33 + (lane & 31)] = W[(size_t)(k0 + kk) * ldw + srccol0 + (lane & 31)]; }
    asm volatile("s_waitcnt lgkmcnt(0)" ::: "memory");
    const int c = lane & 7;
#pragma unroll
    for (int j = 0; j < 4; ++j) { const int n = (lane >> 3) + 8 * j; const LAS float* s = scr + (8 * c) * 33 + n;
        u32x4 o; o.x = pk2(s[0 * 33], s[1 * 33]); o.y = pk2(s[2 * 33], s[3 * 33]); o.z = pk2(s[4 * 33], s[5 * 33]); o.w = pk2(s[6 * 33], s[7 * 33]);
        *(u32x4*)(WT + (size_t)(dstrow0 + n) * Kd + k0 + 8 * c) = o; }
    asm volatile("s_waitcnt lgkmcnt(0)" ::: "memory");
}
__device__ __forceinline__ void tr_item8(const float* W, int ldw, int srccol0, int k0, unsigned char* WT, int Kd, int dstrow0, LAS float* scr, int lane) {
    f32x4 v[8]; const int r8 = lane >> 3, c4 = lane & 7;
#pragma unroll
    for (int i = 0; i < 8; ++i) v[i] = *(const f32x4*)(W + (size_t)(k0 + 8 * i + r8) * ldw + srccol0 + 4 * c4);
#pragma unroll
    for (int i = 0; i < 8; ++i) { LAS float* d = scr + (8 * i + r8) * 33 + 4 * c4; d[0] = v[i][0]; d[1] = v[i][1]; d[2] = v[i][2]; d[3] = v[i][3]; }
    asm volatile("s_waitcnt lgkmcnt(0)" ::: "memory");
    const int c = lane & 7;
#pragma unroll
    for (int j = 0; j < 4; ++j) { const int n = (lane >> 3) + 8 * j; const LAS float* s = scr + (8 * c) * 33 + n;
        u32x2 o; o.x = pk4_fp8(s[0 * 33] * 64.f, s[1 * 33] * 64.f, s[2 * 33] * 64.f, s[3 * 33] * 64.f); o.y = pk4_fp8(s[4 * 33] * 64.f, s[5 * 33] * 64.f, s[6 * 33] * 64.f, s[7 * 33] * 64.f);
        *(u32x2*)(WT + (size_t)(dstrow0 + n) * Kd + k0 + 8 * c) = o; }
    asm volatile("s_waitcnt lgkmcnt(0)" ::: "memory");
}
constexpr int I_IN = 16 * 120, I_OUT = 16 * 32, I_PG = 16 * 32, I_PP = 4 * 32, I_GU1 = 16 * 64, I_DN1 = 16 * 32;
constexpr int I_LORA = 16 + 16 + 32;
constexpr int I_SMALL = I_IN + I_OUT + I_PG + I_PP + I_LORA, I_GU = NE * I_GU1, I_DN = NE * I_DN1, I_ALL = I_SMALL + I_GU + I_DN;
__device__ __forceinline__ void prep_item(KPR P, int it, LAS float* scr, int lane) {
    unsigned char* ws = P.ws;
    if (it < I_IN) { const int kb = it / 120, nb = it % 120, n0 = nb * 32, pn = n0 >> 8, j0 = n0 & 255;
        const int src = pn < 4 ? (pn * 256 + 64 * ((j0 & 127) >> 5) + 32 * (j0 >> 7)) : (n0 < 2048 ? n0 : n0 + 8);
        tr_item(P.w_in, INW, src, kb * 64, (bf16_t*)(ws + WS_WIN), 1024, n0, scr, lane); return; }
    it -= I_IN;
    if (it < I_OUT) { tr_item(P.w_out, 1024, (it % 32) * 32, (it / 32) * 64, (bf16_t*)(ws + WS_WOUT), 1024, (it % 32) * 32, scr, lane); return; }
    it -= I_OUT;
    if (it < I_PG) { tr_item8(P.w_pg, 1024, (it % 32) * 32, (it / 32) * 64, ws + WS_WPG, 1024, (it % 32) * 32, scr, lane); return; }
    it -= I_PG;
    if (it < I_PP) { tr_item(P.w_pp, 1024, (it % 32) * 32, (it / 32) * 64, (bf16_t*)(ws + WS_WPP), 256, (it % 32) * 32, scr, lane); return; }
    it -= I_PP;
    if (it < 16) { tr_item(P.w2, 512, it * 32, 0, (bf16_t*)(ws + 29 * MiB), 64, it * 32, scr, lane); return; }
    it -= 16;
    if (it < 16) { tr_item(P.a2, 512, it * 32, 0, (bf16_t*)(ws + 29 * MiB + 65536), 64, it * 32, scr, lane); return; }
    it -= 16;
    if (it < 32) { tr_item(P.g2, 512, (it % 16) * 32, (it / 16) * 64, (bf16_t*)(ws + 29 * MiB + 131072), 128, (it % 16) * 32, scr, lane); return; }
    it -= 32;
    if (it < I_GU) { const int e = it / I_GU1, r = it % I_GU1, kb = r / 64, nb = r % 64, n0 = nb * 32, pn = n0 >> 8, j0 = n0 & 255;
        const int src = (j0 >> 7) * 1024 + pn * 128 + (j0 & 127);
        tr_item8(P.w_gu + (size_t)e * 1024 * 2048, 2048, src, kb * 64, ws + WS_WGU + (size_t)e * 2048 * 1024, 1024, n0, scr, lane); return; }
    it -= I_GU;
    { const int e = it / I_DN1, r = it % I_DN1, kb = r / 32, nb = r % 32;
        tr_item8(P.w_down + (size_t)e * 1024 * 1024, 1024, nb * 32, kb * 64, ws + WS_WDN + (size_t)e * 1024 * 1024, 1024, nb * 32, scr, lane); }
}
__device__ __forceinline__ void phase_prep_weights(KPR P, LAS unsigned char* lds, int gw, int ngw, int wave, int lane) {
    LAS float* scr = (LAS float*)(lds + wave * 16384);
    for (int it = gw; it < I_SMALL; it += ngw) prep_item(P, it, scr, lane);
}
constexpr int NCVT = I_DN / 64, CVT_TASK0 = I_GU / 64;
__device__ __forceinline__ void cvt_task(KPR P, LAS unsigned char* lds, int task, int wave, int lane) {
    LAS float* scr = (LAS float*)(lds + wave * 16384);
    for (int i = 0; i < 8; ++i) prep_item(P, I_SMALL + task * 64 + i * 8 + wave, scr, lane);
}
__device__ __forceinline__ const float* gu_item_src(KPR P, int it) {
    const int e = it / I_GU1, r = it % I_GU1, kb = r / 64, nb = r % 64, n0 = nb * 32, pn = n0 >> 8, j0 = n0 & 255;
    return P.w_gu + (size_t)e * 1024 * 2048 + (size_t)(kb * 64) * 2048 + (j0 >> 7) * 1024 + pn * 128 + (j0 & 127);
}
__device__ __forceinline__ void gu_half(KPR P, int it, int h, int lane, LAS float* scr, const f32x4& v0, const f32x4& v1, const f32x4& v2, const f32x4& v3) {
    const int e = it / I_GU1, r = it % I_GU1, kb = r / 64, nb = r % 64;
    unsigned char* dst = P.ws + WS_WGU + (size_t)e * 2048 * 1024 + (size_t)(nb * 32) * 1024 + kb * 64 + 32 * h;
    const int r8 = lane >> 3, c4 = lane & 7, n = lane & 31, kg = lane >> 5;
    { LAS f32x4* d = (LAS f32x4*)(scr + r8 * 36 + 4 * c4); d[0] = v0; d[8 * 9] = v1; d[16 * 9] = v2; d[24 * 9] = v3; }
    asm volatile("s_waitcnt lgkmcnt(0)" ::: "memory");
#pragma unroll
    for (int q = 0; q < 2; ++q) { const LAS float* s = scr + (16 * q + 8 * kg) * 36 + n;
        u32x2 o; o.x = pk4_fp8(s[0 * 36] * 64.f, s[1 * 36] * 64.f, s[2 * 36] * 64.f, s[3 * 36] * 64.f); o.y = pk4_fp8(s[4 * 36] * 64.f, s[5 * 36] * 64.f, s[6 * 36] * 64.f, s[7 * 36] * 64.f);
        *(u32x2*)(dst + (size_t)n * 1024 + 16 * q + 8 * kg) = o; }
    asm volatile("s_waitcnt lgkmcnt(0)" ::: "memory");
}
__device__ __forceinline__ void phase_cvt_p(KPR P, int gt, int ngt) {
    bf16_t* PB = (bf16_t*)((unsigned char*)P.out + DO_PB);
    for (int i = gt; i < NTOK * PLE / 8; i += ngt) { const f32x4 a = ((const f32x4*)P.p)[2 * i], b = ((const f32x4*)P.p)[2 * i + 1];
        u32x4 w; w.x = pk2(a[0], a[1]); w.y = pk2(a[2], a[3]); w.z = pk2(b[0], b[1]); w.w = pk2(b[2], b[3]); ((u32x4*)PB)[i] = w; }
}
__device__ __forceinline__ void rms_row(const float* xrow, const float* gain, int lane, f32x4 (&v)[4]) {
    const f32x4* xr = (const f32x4*)xrow + lane; float s = 0.f;
#pragma unroll
    for (int j = 0; j < 4; ++j) { v[j] = xr[64 * j]; s += (v[j][0] * v[j][0] + v[j][1] * v[j][1]) + (v[j][2] * v[j][2] + v[j][3] * v[j][3]); }
    const float rstd = rsqrtf(wave_sum(s) * (1.f / DM) + 1e-6f);
#pragma unroll
    for (int j = 0; j < 4; ++j) v[j] = v[j] * rstd * ((const f32x4*)gain)[64 * j + lane];
}
__device__ __forceinline__ void store_row_fp8(unsigned char* orow, int lane, const f32x4 (&v)[4]) {
    unsigned* o4 = (unsigned*)orow + lane;
#pragma unroll
    for (int j = 0; j < 4; ++j) o4[64 * j] = pk4_fp8(v[j][0], v[j][1], v[j][2], v[j][3]);
}
__device__ __forceinline__ void store_row_bf16(bf16_t* orow, int lane, const f32x4 (&v)[4]) {
    u32x2* o8 = (u32x2*)orow + lane;
#pragma unroll
    for (int j = 0; j < 4; ++j) { u32x2 w; w.x = pk2(v[j][0], v[j][1]); w.y = pk2(v[j][2], v[j][3]); o8[64 * j] = w; }
}
__device__ __forceinline__ void norm1_row(KPR P, int row, int lane, const LAS float* wff, LAS float* lf_out  ) {
    f32x4 v[4]; rms_row(P.x + (size_t)row * DM, P.mix_norm, lane, v);
    store_row_bf16((bf16_t*)(P.ws + WS_XN) + (size_t)row * DM, lane, v);
    float ff[8];
#pragma unroll
    for (int q = 0; q < 8; ++q) { float s = 0.f;
#pragma unroll
        for (int j = 0; j < 4; ++j) { const f32x4 w = *(const LAS f32x4*)(wff + q * 1024 + 4 * (64 * j + lane)); s += (v[j][0] * w[0] + v[j][1] * w[1]) + (v[j][2] * w[2] + v[j][3] * w[3]); }
        ff[q] = s; }
    float g4[4], g2[2], g1;
    { const bool up = lane & 32;
#pragma unroll
        for (int q = 0; q < 4; ++q) { const float keep = up ? ff[4 + q] : ff[q], give = up ? ff[q] : ff[4 + q]; g4[q] = keep + __shfl_xor(give, 32); } }
    { const bool up = lane & 16;
#pragma unroll
        for (int q = 0; q < 2; ++q) { const float keep = up ? g4[2 + q] : g4[q], give = up ? g4[q] : g4[2 + q]; g2[q] = keep + __shfl_xor(give, 16); } }
    { const bool up = lane & 8; const float keep = up ? g2[1] : g2[0], give = up ? g2[0] : g2[1]; g1 = keep + __shfl_xor(give, 8); }
    g1 += __shfl_xor(g1, 4); g1 += __shfl_xor(g1, 2); g1 += __shfl_xor(g1, 1);
    if ((lane & 7) == 0) { const int q = lane >> 3; lf_out[q] = logsigmoidf_(g1 + P.f_bias[q]); }
}
__device__ __forceinline__ void load_wff(KPR P, LAS float* wff, int tid, int nthr) {
    float t[16];
#pragma unroll
    for (int u = 0; u < 16; ++u) { const int i = tid + u * NTHREADS; t[u] = P.w_in[(size_t)(i >> 3) * INW + 2048 + (i & 7)]; }
#pragma unroll
    for (int u = 0; u < 16; ++u) { const int i = tid + u * NTHREADS; wff[(i & 7) * 1024 + (i >> 3)] = t[u]; }
    (void)nthr;
}
__device__ __forceinline__ void final_row(KPR P, int row, int lane, bool dead) {
    const u32x2* xr = (const u32x2*)((const bf16_t*)(P.ws + WS_X1) + (size_t)row * DM) + lane; f32x4 v[4]; float s = 0.f;
#pragma unroll
    for (int j = 0; j < 4; ++j) { const u32x2 xv = xr[64 * j]; v[j] = (f32x4){bflo(xv.x), bfhi(xv.x), bflo(xv.y), bfhi(xv.y)}; s += (v[j][0] * v[j][0] + v[j][1] * v[j][1]) + (v[j][2] * v[j][2] + v[j][3] * v[j][3]); }
    const float rstd = rsqrtf(wave_sum(s) * (1.f / DM) + 1e-6f);
    f32x4* o = (f32x4*)(P.out + (size_t)row * DM) + lane;
#pragma unroll
    for (int j = 0; j < 4; ++j) { v[j] = v[j] * rstd * ((const f32x4*)P.final_norm)[64 * j + lane]; if (dead) { const float q = __builtin_nanf(""); v[j] = (f32x4){q, q, q, q}; } o[64 * j] = v[j]; }
}
typedef GAS unsigned gu32;
#define RLX_AGENT __ATOMIC_RELAXED, __HIP_MEMORY_SCOPE_AGENT
#define XB_TMO      128
#define XB_XCNT(j)  (256  + 64 * (j))
#define XB_XSUB(j)  (1280 + 64 * (j))
#define XB_XGEN(j)  (2304 + 64 * (j))
#define XB_TOP      3328
#define XB_TOPGEN   3392
#define XCD_BAR_WORDS 3456
#define XB_SPIN_CAP (1u << 22)

__device__ __forceinline__ unsigned xb_ld(unsigned* p)              { return __hip_atomic_load(p, __ATOMIC_RELAXED, __HIP_MEMORY_SCOPE_AGENT); }
__device__ __forceinline__ unsigned xb_add(unsigned* p, unsigned v) { return __hip_atomic_fetch_add(p, v, __ATOMIC_RELAXED, __HIP_MEMORY_SCOPE_AGENT); }
__device__ __forceinline__ unsigned xb_xcc_id() { return (unsigned)__builtin_amdgcn_s_getreg((3 << 11) | 20) & 0xFu; }
#define XB_SPIN(cond, bar) do { unsigned _sp = 0; while (cond) { __builtin_amdgcn_s_sleep(1); \
    if ((++_sp & 255u) == 0u) { if (xb_ld(&(bar)[XB_TMO])) break; if (_sp > XB_SPIN_CAP) { atomicAdd(&(bar)[XB_TMO], 1u); break; } } } } while (0)

struct XcdBarrier { unsigned* bar; unsigned x; volatile LAS unsigned* st; };

__device__ __forceinline__ XcdBarrier xcd_barrier_post(unsigned* bar, volatile LAS unsigned* st) {
    XcdBarrier b; b.bar = bar; b.x = xb_xcc_id(); b.st = st;
    if (threadIdx.x == 0) (void)xb_add(&bar[XB_XCNT(b.x)], 1u);
    return b;
}
__device__ __forceinline__ void xcd_barrier_complete(unsigned* bar, unsigned x, unsigned& nloc, unsigned& nx) {
    const unsigned G = gridDim.x * gridDim.y * gridDim.z;
    unsigned sum, cnt, mine, sp = 0u;
    for (;;) {
        sum = 0u; cnt = 0u; mine = 0u;
#pragma unroll
        for (unsigned j = 0; j < 16; ++j) { const unsigned c = xb_ld(&bar[XB_XCNT(j)]); sum += c; cnt += (c > 0u) ? 1u : 0u; mine = (j == x) ? c : mine; }
        if (sum == G) break;
        __builtin_amdgcn_s_sleep(1);
        if ((++sp & 255u) == 0u) { if (xb_ld(&bar[XB_TMO])) break; if (sp > XB_SPIN_CAP) { atomicAdd(&bar[XB_TMO], 1u); break; } }
    }
    nloc = mine > 0u ? mine : 1u; nx = cnt > 0u ? cnt : 1u;
}
__device__ __forceinline__ void xcd_barrier(const XcdBarrier& b) {
    asm volatile("s_waitcnt vmcnt(0)" ::: "memory");
    __syncthreads();
    if (threadIdx.x == 0) {
        unsigned* bar = b.bar;
        __builtin_amdgcn_s_waitcnt(0);
        unsigned nloc = b.st[0], nx = b.st[1];
        if (nloc == 0u) { xcd_barrier_complete(bar, b.x, nloc, nx); b.st[0] = nloc; b.st[1] = nx; }
        const unsigned old = xb_add(&bar[XB_XSUB(b.x)], 1u);
        const unsigned gen = old / nloc;
        if (old + 1u == (gen + 1u) * nloc) {
            __builtin_amdgcn_fence(__ATOMIC_RELEASE, "agent");
            asm volatile("s_waitcnt vmcnt(0)" ::: "memory");
            const unsigned og = xb_add(&bar[XB_TOP], 1u);
            const unsigned tg = og / nx;
            if (og + 1u == (tg + 1u) * nx) xb_add(&bar[XB_TOPGEN], 1u);
            else XB_SPIN(xb_ld(&bar[XB_TOPGEN]) == tg, bar);
            __builtin_amdgcn_fence(__ATOMIC_ACQUIRE, "agent");
            xb_add(&bar[XB_XGEN(b.x)], 1u);
            asm volatile("s_waitcnt vmcnt(0)" ::: "memory");
        } else {
            XB_SPIN(xb_ld(&bar[XB_XGEN(b.x)]) == gen, bar);
            __builtin_amdgcn_fence(__ATOMIC_ACQUIRE, "agent");
            asm volatile("s_waitcnt vmcnt(0)" ::: "memory");
        }
    }
    __syncthreads();
}
namespace rk {
constexpr int MB = 8192;
constexpr int S_AT = 0, S_RT = 1, S_KT = 2, S_BT = 3, S_ATT = 4, S_KTT = 5, S_BTT = 6, S_VT = 7, S_N = 8, S_NT = 9, S_MAK = 10, S_MRB = 11, S_MRK = 12, S_TA = 13, S_TB = 14;
constexpr int SCR = 15 * MB;
constexpr int NCHUNK = SEQ / 64;
constexpr size_t WS_HT = WS_X1;
constexpr size_t WS_Y0 = WS_X1 + 64 * MiB;
constexpr size_t WS_QI = WS_X1 + 96 * MiB;
constexpr size_t WS_LW = WS_RW, WS_LA = WS_RW + 32 * MiB, WS_LG = WS_RW + 64 * MiB;
constexpr size_t WS_S3 = WS_LOGF;
constexpr size_t WS_SC = WS_RW + 224 * MiB;
constexpr size_t DO_GT = 80 * MiB;
static_assert(WS_SC + 32 * MiB <= WS_END, "rwkv blobs");

__device__ __forceinline__ int moff(int row, int col) { return row * 128 + ((((col >> 3) ^ (row >> 1)) & 7) << 4) + (col & 7) * 2; }
__device__ __forceinline__ int crow(int r, int hi) { return (r & 3) + 8 * (r >> 2) + 4 * hi; }
__device__ __forceinline__ f32x16 mm_nt(const LAS unsigned char* A, int ar0, const LAS unsigned char* Bt, int br0, f32x16 acc, int r32, int hi) {
#pragma unroll
    for (int ks = 0; ks < 4; ++ks) { const bf16x8 a = *(const LAS bf16x8*)(A + moff(ar0 + r32, 16 * ks + 8 * hi)), b = *(const LAS bf16x8*)(Bt + moff(br0 + r32, 16 * ks + 8 * hi));
        acc = __builtin_amdgcn_mfma_f32_32x32x16_bf16(a, b, acc, 0, 0, 0); }
    return acc;
}
__device__ __forceinline__ void store_t(LAS unsigned char* dst, const f32x16& acc, int i0, int j0, int r32, int hi) {
#pragma unroll
    for (int g = 0; g < 4; ++g) { u32x2 w; w.x = pk2(acc[4 * g], acc[4 * g + 1]); w.y = pk2(acc[4 * g + 2], acc[4 * g + 3]); *(LAS u32x2*)(dst + moff(j0 + r32, i0 + 8 * g + 4 * hi)) = w; }
}
template <int MODE> __device__ __forceinline__ void mask_tri(f32x16& acc, int i0, int j0, int r32, int hi) {
#pragma unroll
    for (int r = 0; r < 16; ++r) { const int i = i0 + crow(r, hi), j = j0 + r32; const bool keep = MODE == 0 ? (j < i) : (MODE == 1 ? (i < j) : (i <= j)); if (!keep) acc[r] = 0.f; }
}

__device__ __forceinline__ void pass1_chunk(KPR P, LAS unsigned char* lds, int bh, int c, int tid, int itbase, LAS float* cscr) {
    const int lane = tid & 63, wave = tid >> 6, r32 = lane & 31, hi = lane >> 5, grp = wave >> 2, wq = wave & 3, i0 = 32 * (wq >> 1), j0 = 32 * (wq & 1);
    const int b = bh >> 3, h = bh & 7; const size_t tok0 = (size_t)b * SEQ + (size_t)c * 64; const size_t ci = (size_t)bh * NCHUNK + c;
    LAS float* part = (LAS float*)(lds + SCR); LAS float* WL = (LAS float*)(lds + SCR + 2048);
#define MAT(s) (lds + (s) * MB)
    {
        const bf16_t* Z = (const bf16_t*)(P.ws + WS_Z); const bf16_t* LW = (const bf16_t*)(P.ws + WS_LW); const bf16_t* LA = (const bf16_t*)(P.ws + WS_LA);
        const int ch = tid & 63, tq = tid >> 6, cc = h * 64 + ch; const size_t row0 = tok0 + 8 * tq;
        const float mur = P.mu[RW_R + cc], muk = P.mu[RW_K + cc], muv = P.mu[RW_V + cc], w0c = P.w0[cc], a0c = P.a0[cc], kkc = P.k_k[cc], kac = P.k_a[cc];
        const bf16_t* zp = Z + row0 * ZW + ZR + cc;
        const bool first = (c == 0) && (tq == 0); const bf16_t* zq = first ? zp : zp - ZW; const float pm = first ? 0.f : 1.f;
        unsigned short lr[9], lk[9], lv[9], llw[8], lla[8];
        lr[0] = zq[RW_R]; lk[0] = zq[RW_K]; lv[0] = zq[RW_V];
#pragma unroll
        for (int i = 0; i < 8; ++i) { const bf16_t* zi = zp + (size_t)i * ZW; lr[i + 1] = zi[RW_R]; lk[i + 1] = zi[RW_K]; lv[i + 1] = zi[RW_V]; const size_t o = (row0 + i) * 512 + cc; llw[i] = LW[o]; lla[i] = LA[o]; }
        float cum[8], vr[8], vk[8], vkk[8], vka[8], ssq[8]; unsigned short vv16[8]; float run = 0.f;
#pragma unroll
        for (int i = 0; i < 8; ++i) { const float pmi = (i == 0) ? pm : 1.f; const float zr1 = bf2f(lr[i + 1]), zk1 = bf2f(lk[i + 1]), zv1 = bf2f(lv[i + 1]);
            vr[i] = zr1 + (bf2f(lr[i]) * pmi - zr1) * mur; vk[i] = zk1 + (bf2f(lk[i]) * pmi - zk1) * muk; vv16[i] = (unsigned short)f2bf(zv1 + (bf2f(lv[i]) * pmi - zv1) * muv);
            vkk[i] = vk[i] * kkc; ssq[i] = vkk[i] * vkk[i]; }
#pragma unroll
        for (int i = 0; i < 8; ++i) ssq[i] = wave_sum(ssq[i]);
#pragma unroll
        for (int i = 0; i < 8; ++i) {
            const float wl = w0c + bf2f(llw[i]); const float sp = fmaxf(-wl, 0.f) + __logf(1.0f + __expf(-fabsf(wl)));
            run += -__expf(-sp - 0.5f); cum[i] = run;
            const float a = __builtin_amdgcn_rcpf(1.0f + __expf(-(a0c + bf2f(lla[i]))));
            const float kk = vkk[i] * __builtin_amdgcn_rcpf(fmaxf(__builtin_amdgcn_sqrtf(ssq[i]), 1e-12f));
            vk[i] = vk[i] * (1.0f + (a - 1.0f) * kac); vkk[i] = kk; vka[i] = kk * a; }
        { float s3[8];
#pragma unroll
            for (int i = 0; i < 8; ++i) s3[i] = wave_sum(vr[i] * vk[i] * P.r_k[cc]);
            if (ch == 0) { float* S3 = (float*)(P.ws + WS_S3) + (row0 * 8 + h);
#pragma unroll
                for (int i = 0; i < 8; ++i) S3[i * 8] = s3[i]; } }
        part[tq * 64 + ch] = run;
        __syncthreads();
        float pre = 0.f;
#pragma unroll
        for (int g = 0; g < 8; ++g) { const float pvv = part[g * 64 + ch]; pre += (g < tq) ? pvv : 0.f; }
        float eprev = __expf(pre);
        unsigned atT[4], ktT[4], btT[4], vT[4]; unsigned short hold[4] = {0, 0, 0, 0};
#pragma unroll
        for (int i = 0; i < 8; ++i) { const int t = 8 * tq + i;
            const float cm = pre + cum[i], e1 = __expf(cm), einv = __expf(-cm);
            const unsigned short at = (unsigned short)f2bf(-vkk[i] * eprev), rt = (unsigned short)f2bf(vr[i] * e1), kt = (unsigned short)f2bf(vk[i] * einv), bt = (unsigned short)f2bf(vka[i] * einv), vv = vv16[i];
            eprev = e1;
            *(LAS unsigned short*)(MAT(S_AT) + moff(t, ch)) = at; *(LAS unsigned short*)(MAT(S_RT) + moff(t, ch)) = rt; *(LAS unsigned short*)(MAT(S_KT) + moff(t, ch)) = kt; *(LAS unsigned short*)(MAT(S_BT) + moff(t, ch)) = bt;
            if (i & 1) { atT[i >> 1] = hold[0] | ((unsigned)at << 16); ktT[i >> 1] = hold[1] | ((unsigned)kt << 16); btT[i >> 1] = hold[2] | ((unsigned)bt << 16); vT[i >> 1] = hold[3] | ((unsigned)vv << 16); }
            else { hold[0] = at; hold[1] = kt; hold[2] = bt; hold[3] = vv; }
            if (i == 7 && tq == 7) WL[ch] = e1; }
        *(LAS u32x4*)(MAT(S_ATT) + moff(ch, 8 * tq)) = (u32x4){atT[0], atT[1], atT[2], atT[3]}; *(LAS u32x4*)(MAT(S_KTT) + moff(ch, 8 * tq)) = (u32x4){ktT[0], ktT[1], ktT[2], ktT[3]};
        *(LAS u32x4*)(MAT(S_BTT) + moff(ch, 8 * tq)) = (u32x4){btT[0], btT[1], btT[2], btT[3]}; *(LAS u32x4*)(MAT(S_VT) + moff(ch, 8 * tq)) = (u32x4){vT[0], vT[1], vT[2], vT[3]};
    }
    __syncthreads();
    const f32x16 zero = f32x16{};
    f32x4 cv[2][8];
    if (grp == 1) {
#pragma unroll
        for (int u = 0; u < 2; ++u) { const float* cs = gu_item_src(P, itbase + 4 * u + wq) + (size_t)(lane >> 3) * 2048 + 4 * (lane & 7);
#pragma unroll
            for (int i = 0; i < 8; ++i) cv[u][i] = *(const f32x4*)(cs + (size_t)(8 * i) * 2048); } }
    if (grp == 0) { f32x16 d = mm_nt(MAT(S_AT), i0, MAT(S_BT), j0, zero, r32, hi); mask_tri<0>(d, i0, j0, r32, hi); store_t(MAT(S_NT), d, i0, j0, r32, hi);
        d = mm_nt(MAT(S_KT), i0, MAT(S_AT), j0, zero, r32, hi); mask_tri<1>(d, i0, j0, r32, hi); store_t(MAT(S_MAK), d, i0, j0, r32, hi);
        d = mm_nt(MAT(S_KT), i0, MAT(S_RT), j0, zero, r32, hi); mask_tri<2>(d, i0, j0, r32, hi); store_t(MAT(S_MRK), d, i0, j0, r32, hi); }
    else { f32x16 d = mm_nt(MAT(S_BT), i0, MAT(S_AT), j0, zero, r32, hi); mask_tri<1>(d, i0, j0, r32, hi); store_t(MAT(S_N), d, i0, j0, r32, hi);
#pragma unroll
        for (int r = 0; r < 16; ++r) if (i0 + crow(r, hi) == j0 + r32) d[r] = 1.0f;
        store_t(MAT(S_TA), d, i0, j0, r32, hi);
        d = mm_nt(MAT(S_BT), i0, MAT(S_RT), j0, zero, r32, hi); mask_tri<2>(d, i0, j0, r32, hi); store_t(MAT(S_MRB), d, i0, j0, r32, hi); }
    __syncthreads();
#pragma unroll
    for (int s = 1; s <= 6; ++s) {
        const int mc = (s & 1) ? S_N : S_AT, mcT = (s & 1) ? S_NT : S_KT, mn = (s & 1) ? S_AT : S_N, mnT = (s & 1) ? S_KT : S_NT;
        const int tc = (s & 1) ? S_TB : S_TA, tn = (s & 1) ? S_TA : S_TB;
        if (s <= 5) {
            if (grp == 0) { const f32x16 d = mm_nt(MAT(mc), i0, MAT(mcT), j0, zero, r32, hi); store_t(MAT(mnT), d, i0, j0, r32, hi); }
            else { const f32x16 d = mm_nt(MAT(mcT), i0, MAT(mc), j0, zero, r32, hi); store_t(MAT(mn), d, i0, j0, r32, hi); }
        }
        if (s >= 2 && grp == (s <= 5 ? 0 : 1) ) {
            f32x16 d = mm_nt(MAT(mcT), i0, MAT(tc), j0, zero, r32, hi);
#pragma unroll
            for (int g = 0; g < 4; ++g) { const u32x2 tv = *(const LAS u32x2*)(MAT(tc) + moff(j0 + r32, i0 + 8 * g + 4 * hi)); d[4 * g] += bflo(tv.x); d[4 * g + 1] += bfhi(tv.x); d[4 * g + 2] += bflo(tv.y); d[4 * g + 3] += bfhi(tv.y); }
            store_t(MAT(tn), d, i0, j0, r32, hi);
        }
        if (s >= 2 && s <= 5 && grp == 1) { const int u = (s - 2) >> 1, h = (s - 2) & 1;
            gu_half(P, itbase + 4 * u + wq, h, lane, cscr, cv[u][4 * h], cv[u][4 * h + 1], cv[u][4 * h + 2], cv[u][4 * h + 3]); }
        __syncthreads();
    }
    if (grp == 0) { const f32x16 d = mm_nt(MAT(S_TB), i0, MAT(S_ATT), j0, zero, r32, hi); store_t(MAT(S_BT), d, i0, j0, r32, hi); }
    else { const f32x16 d = mm_nt(MAT(S_MAK), i0, MAT(S_VT), j0, zero, r32, hi); store_t(MAT(S_N), d, i0, j0, r32, hi); }
    __syncthreads();
    if (grp == 0) { const f32x16 d = mm_nt(MAT(S_TB), i0, MAT(S_N), j0, zero, r32, hi); store_t(MAT(S_NT), d, i0, j0, r32, hi);
        f32x16 q = mm_nt(MAT(S_BT), i0, MAT(S_MRB), j0, zero, r32, hi);
#pragma unroll
        for (int g = 0; g < 4; ++g) { const u32x2 rv = *(const LAS u32x2*)(MAT(S_RT) + moff(j0 + r32, i0 + 8 * g + 4 * hi)); q[4 * g] += bflo(rv.x); q[4 * g + 1] += bfhi(rv.x); q[4 * g + 2] += bflo(rv.y); q[4 * g + 3] += bfhi(rv.y); }
        store_t(MAT(S_KT), q, i0, j0, r32, hi); }
    else { f32x16 g_ = mm_nt(MAT(S_BT), i0, MAT(S_BTT), j0, zero, r32, hi);
        const float wl = WL[j0 + r32];
#pragma unroll
        for (int r = 0; r < 16; ++r) { if (i0 + crow(r, hi) == j0 + r32) g_[r] += 1.0f; g_[r] *= wl; }
        store_t(MAT(S_AT), g_, i0, j0, r32, hi); }
    __syncthreads();
    if (grp == 0) { f32x16 d = mm_nt(MAT(S_BTT), i0, MAT(S_NT), j0, zero, r32, hi); d = mm_nt(MAT(S_KTT), i0, MAT(S_VT), j0, d, r32, hi);
        float* HT = (float*)(P.ws + WS_HT) + ci * 4096 + (size_t)wq * 1024 + lane;
#pragma unroll
        for (int g = 0; g < 4; ++g) { const f32x4 wl4 = *(const LAS f32x4*)(WL + i0 + 8 * g + 4 * hi);
#pragma unroll
            for (int i = 0; i < 4; ++i) HT[(4 * g + i) * 64] = d[4 * g + i] * wl4[i]; } }
    else { f32x16 d = mm_nt(MAT(S_MRB), i0, MAT(S_NT), j0, zero, r32, hi); d = mm_nt(MAT(S_MRK), i0, MAT(S_VT), j0, d, r32, hi);
        unsigned* Y0 = (unsigned*)(P.ws + WS_Y0) + ci * 2048 + (size_t)wq * 512 + lane;
#pragma unroll
        for (int r2 = 0; r2 < 8; ++r2) Y0[r2 * 64] = pk2(d[2 * r2], d[2 * r2 + 1]); }
    { u32x4* GTg = (u32x4*)((unsigned char*)P.out + DO_GT + ci * MB); u32x4* QIg = (u32x4*)(P.ws + WS_QI + ci * MB);
        GTg[tid] = *(const LAS u32x4*)(MAT(S_AT) + tid * 16); QIg[tid] = *(const LAS u32x4*)(MAT(S_KT) + tid * 16); }
    __syncthreads();
#undef MAT
}

__device__ __forceinline__ void pass2_seq(KPR P, LAS unsigned char* lds, int bh, int tid) {
    const int lane = tid & 63, wave = tid >> 6, r32 = lane & 31, hi = lane >> 5, wq = wave & 3, i0 = 32 * (wq >> 1), j0 = 32 * (wq & 1);
    LAS unsigned char* Sm = lds; LAS unsigned char* G0 = lds + MB; LAS unsigned char* G1 = lds + 2 * MB;
    const size_t ci0 = (size_t)bh * NCHUNK;
    const u32x4* GTg = (const u32x4*)((const unsigned char*)P.out + DO_GT + ci0 * MB); u32x4* SCg = (u32x4*)(P.ws + WS_SC + ci0 * MB);
    const float* HT = (const float*)(P.ws + WS_HT) + ci0 * 4096 + (size_t)wq * 1024 + lane;
    *(LAS u32x4*)(Sm + tid * 16) = (u32x4){0u, 0u, 0u, 0u};
    *(LAS u32x4*)(G0 + tid * 16) = GTg[tid];
    u32x4 gnext = GTg[512 + tid];
    f32x16 hcur, hnext;
    if (wave < 4) {
#pragma unroll
        for (int r = 0; r < 16; ++r) { hcur[r] = HT[r * 64]; hnext[r] = HT[4096 + r * 64]; } }
    __syncthreads();
    for (int c = 0; c < NCHUNK; ++c) {
        LAS unsigned char* Gc = (c & 1) ? G1 : G0; LAS unsigned char* Gn = (c & 1) ? G0 : G1;
        SCg[(size_t)c * 512 + tid] = *(const LAS u32x4*)(Sm + tid * 16);
        f32x16 d = hcur;
        if (wave < 4) d = mm_nt(Gc, i0, Sm, j0, d, r32, hi);
        __syncthreads();
        if (wave < 4) store_t(Sm, d, i0, j0, r32, hi);
        *(LAS u32x4*)(Gn + tid * 16) = gnext;
        const int c2 = (c + 2 < NCHUNK) ? c + 2 : NCHUNK - 1;
        gnext = GTg[(size_t)c2 * 512 + tid];
        if (wave < 4) { hcur = hnext;
#pragma unroll
            for (int r = 0; r < 16; ++r) hnext[r] = HT[(size_t)c2 * 4096 + r * 64]; }
        __syncthreads();
    }
}

__device__ __forceinline__ void pass3_chunk(KPR P, LAS unsigned char* lds, int bh, int c, int tid) {
    const int lane = tid & 63, wave = tid >> 6, r32 = lane & 31, hi = lane >> 5, wq = wave & 3, i0 = 32 * (wq >> 1), j0 = 32 * (wq & 1);
    const int b = bh >> 3, h = bh & 7; const size_t tok0 = (size_t)b * SEQ + (size_t)c * 64; const size_t ci = (size_t)bh * NCHUNK + c;
    LAS unsigned char* Qm = lds; LAS unsigned char* Sm = lds + MB; LAS float* Yl = (LAS float*)(lds + 2 * MB);
    *(LAS u32x4*)(Qm + tid * 16) = ((const u32x4*)(P.ws + WS_QI + ci * MB))[tid];
    *(LAS u32x4*)(Sm + tid * 16) = ((const u32x4*)(P.ws + WS_SC + ci * MB))[tid];
    f32x16 d = f32x16{};
    if (wave < 4) { const unsigned* Y0 = (const unsigned*)(P.ws + WS_Y0) + ci * 2048 + (size_t)wq * 512 + lane;
#pragma unroll
        for (int r2 = 0; r2 < 8; ++r2) { const unsigned w = Y0[r2 * 64]; d[2 * r2] = bflo(w); d[2 * r2 + 1] = bfhi(w); } }
    const bf16_t* Z = (const bf16_t*)(P.ws + WS_Z); const bf16_t* LG = (const bf16_t*)(P.ws + WS_LG);
    bf16_t* AO = (bf16_t*)(P.ws + WS_AO); const int cc = h * 64 + lane;
    const float lnw = P.ln_w[cc], lnb = P.ln_b[cc], muv = P.mu[RW_V + cc];
    const bf16_t* zp = Z + (tok0 + wave * 8) * ZW + ZR + cc; const bool first = (c == 0) && (wave == 0); const bf16_t* zq = first ? zp : zp - ZW; const float pm = first ? 0.f : 1.f;
    unsigned short lv[9], llg[8]; float s3[8];
    lv[0] = zq[RW_V];
#pragma unroll
    for (int i = 0; i < 8; ++i) { const bf16_t* zi = zp + (size_t)i * ZW; lv[i + 1] = zi[RW_V]; const size_t o = (tok0 + wave * 8 + i) * 512 + cc; llg[i] = LG[o]; s3[i] = ((const float*)(P.ws + WS_S3))[(tok0 + wave * 8 + i) * 8 + h]; }
    __syncthreads();
    if (wave < 4) { d = mm_nt(Qm, i0, Sm, j0, d, r32, hi);
#pragma unroll
        for (int r = 0; r < 16; ++r) Yl[(i0 + crow(r, hi)) * 65 + j0 + r32] = d[r]; }
    __syncthreads();
    float y[8], s1[8], s2[8], vvv[8];
#pragma unroll
    for (int i = 0; i < 8; ++i) { const float pmi = (i == 0) ? pm : 1.f; const float zv1 = bf2f(lv[i + 1]);
        vvv[i] = zv1 + (bf2f(lv[i]) * pmi - zv1) * muv;
        y[i] = Yl[(wave * 8 + i) * 65 + lane]; s1[i] = y[i]; }
#pragma unroll
    for (int i = 0; i < 8; ++i) s1[i] = wave_sum(s1[i]);
#pragma unroll
    for (int i = 0; i < 8; ++i) { y[i] -= s1[i] * (1.f / 64.f); s2[i] = y[i] * y[i]; }
#pragma unroll
    for (int i = 0; i < 8; ++i) s2[i] = wave_sum(s2[i]);
#pragma unroll
    for (int i = 0; i < 8; ++i) { const size_t tok = tok0 + wave * 8 + i; const float yn = y[i] * rsqrtf(s2[i] * (1.f / 64.f) + 64e-5f) * lnw + lnb;
        AO[tok * DM + 512 + cc] = (bf16_t)f2bf((yn + s3[i] * vvv[i]) * bf2f(llg[i])); }
}

constexpr size_t WS_W2T = 29 * MiB, WS_A2T = 29 * MiB + 65536, WS_G2T = 29 * MiB + 131072;
__device__ __forceinline__ bf16x8 act8(const bf16_t* zc, const bf16_t* zpv, float pmask, const float* mu, int mode) {
    const u32x4 c = *(const u32x4*)zc, p = *(const u32x4*)zpv;
    const f32x4 m0 = *(const f32x4*)mu, m1 = *(const f32x4*)(mu + 4);
    const unsigned cw[4] = {c.x, c.y, c.z, c.w}, pw[4] = {p.x, p.y, p.z, p.w}; const float um[8] = {m0[0], m0[1], m0[2], m0[3], m1[0], m1[1], m1[2], m1[3]}; float v[8];
#pragma unroll
    for (int j = 0; j < 4; ++j) { const float c0 = bflo(cw[j]), c1 = bfhi(cw[j]), p0 = bflo(pw[j]) * pmask, p1 = bfhi(pw[j]) * pmask;
        v[2 * j] = c0 + (p0 - c0) * um[2 * j]; v[2 * j + 1] = c1 + (p1 - c1) * um[2 * j + 1]; }
#pragma unroll
    for (int j = 0; j < 8; ++j) { if (mode == 0) { const float e = __expf(-2.0f * fabsf(v[j])); const float th = (1.0f - e) * __builtin_amdgcn_rcpf(1.0f + e); v[j] = v[j] < 0.f ? -th : th; } else if (mode == 2) v[j] = __builtin_amdgcn_rcpf(1.0f + __expf(-v[j])); }
    u32x4 w; w.x = pk2(v[0], v[1]); w.y = pk2(v[2], v[3]); w.z = pk2(v[4], v[5]); w.w = pk2(v[6], v[7]);
    return __builtin_bit_cast(bf16x8, w);
}
__device__ __forceinline__ int goff(int row, int col) { return row * 256 + ((((col >> 3) ^ row) & 15) << 4) + (col & 7) * 2; }
__device__ __forceinline__ void lora_block(KPR P, LAS unsigned char* lds, int blk, int G, int tid) {
    const int lane = tid & 63, wave = tid >> 6, r32 = lane & 31, hi = lane >> 5;
    const int task = blk * 4 + (wave & 3), cb0 = 8 * (wave >> 2); const bool work = task < NTOK / 32;
    const size_t row = (size_t)(work ? task : 0) * 32 + r32; const bool first = (row % SEQ) == 0;
    const bf16_t* Z = (const bf16_t*)(P.ws + WS_Z) + row * ZW + ZR + 8 * hi; const bf16_t* Zp = first ? Z : Z - ZW; const float pmask = first ? 0.f : 1.f;
    const float* mub = P.mu + 8 * hi;
    { const u32x4* w2 = (const u32x4*)(P.ws + WS_W2T); const u32x4* a2 = (const u32x4*)(P.ws + WS_A2T);
#pragma unroll
        for (int i = 0; i < 8; ++i) { const int idx = i * 512 + tid, rw = idx >> 3, ch = idx & 7; const int o = rw * 128 + (((ch ^ (rw >> 1)) & 7) << 4);
            *(LAS u32x4*)(lds + o) = w2[idx]; *(LAS u32x4*)(lds + 65536 + o) = a2[idx]; } }
    bf16x8 xw[4], xa[4], xg[8];
    if (work) {
#pragma unroll
        for (int ks = 0; ks < 4; ++ks) { xw[ks] = act8(Z + RW_W + 16 * ks, Zp + RW_W + 16 * ks, pmask, mub + RW_W + 16 * ks, 0); xa[ks] = act8(Z + RW_A + 16 * ks, Zp + RW_A + 16 * ks, pmask, mub + RW_A + 16 * ks, 1); asm volatile("" ::: "memory"); }
#pragma unroll
        for (int ks = 0; ks < 8; ++ks) { xg[ks] = act8(Z + RW_G + 16 * ks, Zp + RW_G + 16 * ks, pmask, mub + RW_G + 16 * ks, 2); if (ks & 1) asm volatile("" ::: "memory"); }
    }
    bf16_t* LW = (bf16_t*)(P.ws + WS_LW) + row * 512 + 4 * hi; bf16_t* LA = (bf16_t*)(P.ws + WS_LA) + row * 512 + 4 * hi; bf16_t* LG = (bf16_t*)(P.ws + WS_LG) + row * 512 + 4 * hi;
    __syncthreads();
    if (work) {
#pragma nounroll
        for (int cb = cb0; cb < cb0 + 8; ++cb) { f32x16 dw = f32x16{}, da = f32x16{};
#pragma unroll
            for (int ks = 0; ks < 4; ++ks) { const int o = moff(cb * 32 + r32, 16 * ks + 8 * hi);
                dw = __builtin_amdgcn_mfma_f32_32x32x16_bf16(*(const LAS bf16x8*)(lds + o), xw[ks], dw, 0, 0, 0); da = __builtin_amdgcn_mfma_f32_32x32x16_bf16(*(const LAS bf16x8*)(lds + 65536 + o), xa[ks], da, 0, 0, 0); }
#pragma unroll
            for (int g = 0; g < 4; ++g) { u32x2 w; w.x = pk2(dw[4 * g], dw[4 * g + 1]); w.y = pk2(dw[4 * g + 2], dw[4 * g + 3]); *(u32x2*)(LW + cb * 32 + 8 * g) = w;
                w.x = pk2(da[4 * g], da[4 * g + 1]); w.y = pk2(da[4 * g + 2], da[4 * g + 3]); *(u32x2*)(LA + cb * 32 + 8 * g) = w; } }
    }
    __syncthreads();
    { const u32x4* g2 = (const u32x4*)(P.ws + WS_G2T);
#pragma unroll
        for (int i = 0; i < 16; ++i) { const int idx = i * 512 + tid, rw = idx >> 4, ch = idx & 15; *(LAS u32x4*)(lds + rw * 256 + (((ch ^ rw) & 15) << 4)) = g2[idx]; } }
    __syncthreads();
    if (work) {
#pragma nounroll
        for (int cb = cb0; cb < cb0 + 8; ++cb) { f32x16 dg = f32x16{};
#pragma unroll
            for (int ks = 0; ks < 8; ++ks) dg = __builtin_amdgcn_mfma_f32_32x32x16_bf16(*(const LAS bf16x8*)(lds + goff(cb * 32 + r32, 16 * ks + 8 * hi)), xg[ks], dg, 0, 0, 0);
#pragma unroll
            for (int g = 0; g < 4; ++g) { u32x2 w; w.x = pk2(dg[4 * g], dg[4 * g + 1]); w.y = pk2(dg[4 * g + 2], dg[4 * g + 3]); *(u32x2*)(LG + cb * 32 + 8 * g) = w; } }
    }
    __syncthreads();
}
}
namespace rt {
__device__ __forceinline__ int woff(int e, int k) { return e * 2048 + ((((k >> 3) ^ (e & 15))) << 4) + (k & 7) * 2; }
constexpr size_t WS_WRI = 30 * MiB;
__device__ __forceinline__ void build_w(KPR P, int part, int tid) {
    unsigned char* img = P.ws + WS_WRI; const int e = tid & 31, k0 = part * 64 + 4 * (tid >> 5); float w[4];
#pragma unroll
    for (int i = 0; i < 4; ++i) w[i] = P.moe_norm[k0 + i] * P.w_router[(k0 + i) * 32 + e];
#pragma unroll
    for (int i = 0; i < 4; ++i) { const int k = k0 + i; const unsigned h = f2bf(w[i]); const unsigned l = f2bf(w[i] - bf2f(h));
        *(unsigned short*)(img + woff(e, k)) = (unsigned short)h; *(unsigned short*)(img + 65536 + woff(e, k)) = (unsigned short)l; }
}
__device__ __forceinline__ void copy_w(KPR P, LAS unsigned char* lds, int tid) {
    const u32x4* img = (const u32x4*)(P.ws + WS_WRI);
    u32x4 t[16];
#pragma unroll
    for (int i = 0; i < 16; ++i) t[i] = img[i * 512 + tid];
#pragma unroll
    for (int i = 0; i < 16; ++i) *(LAS u32x4*)(lds + (size_t)(i * 512 + tid) * 16) = t[i];
}
__device__ __forceinline__ void split8(const f32x4& a, const f32x4& b, bf16x8& h, bf16x8& l) {
    unsigned hh[8]; float v[8] = {a[0], a[1], a[2], a[3], b[0], b[1], b[2], b[3]};
#pragma unroll
    for (int j = 0; j < 8; ++j) hh[j] = f2bf(v[j]);
    u32x4 hw, lw;
    hw.x = hh[0] | (hh[1] << 16); hw.y = hh[2] | (hh[3] << 16); hw.z = hh[4] | (hh[5] << 16); hw.w = hh[6] | (hh[7] << 16);
    lw.x = pk2(v[0] - bf2f(hh[0]), v[1] - bf2f(hh[1])); lw.y = pk2(v[2] - bf2f(hh[2]), v[3] - bf2f(hh[3])); lw.z = pk2(v[4] - bf2f(hh[4]), v[5] - bf2f(hh[5])); lw.w = pk2(v[6] - bf2f(hh[6]), v[7] - bf2f(hh[7]));
    h = __builtin_bit_cast(bf16x8, hw); l = __builtin_bit_cast(bf16x8, lw);
}
__device__ __forceinline__ void route_task(KPR P, const LAS unsigned char* wlds, int task, int lane) {
    const int r32 = lane & 31, hi = lane >> 5; const int row = task * 32 + r32;
    const bf16_t* xrow = (const bf16_t*)(P.ws + WS_X1) + (size_t)row * DM + 8 * hi;
    f32x16 acc = f32x16{}; float ss = 0.f;
    u32x4 xq[16];
#pragma unroll
    for (int j = 0; j < 16; ++j) xq[j] = *(const u32x4*)(xrow + 16 * j);
    for (int ks0 = 0; ks0 < 64; ks0 += 16) {
#pragma unroll
        for (int j = 0; j < 16; ++j) { const int ks = ks0 + j; const u32x4 xv = xq[j];
            const int kn = (ks + 16 < 64) ? ks + 16 : ks; xq[j] = *(const u32x4*)(xrow + 16 * kn);
            const unsigned xw[4] = {xv.x, xv.y, xv.z, xv.w};
#pragma unroll
            for (int q = 0; q < 4; ++q) { const float a = bflo(xw[q]), b = bfhi(xw[q]); ss += a * a + b * b; }
            const bf16x8 xh = __builtin_bit_cast(bf16x8, xv);
            const bf16x8 wh = *(const LAS bf16x8*)(wlds + woff(r32, 16 * ks + 8 * hi)), wl = *(const LAS bf16x8*)(wlds + 65536 + woff(r32, 16 * ks + 8 * hi));
            acc = __builtin_amdgcn_mfma_f32_32x32x16_bf16(wh, xh, acc, 0, 0, 0); acc = __builtin_amdgcn_mfma_f32_32x32x16_bf16(wl, xh, acc, 0, 0, 0); }
    }
    ss += __shfl_xor(ss, 32);
    const float rstd = rsqrtf(ss * (1.f / DM) + 1e-6f);
    float lg[16];
#pragma unroll
    for (int g = 0; g < 4; ++g) { const f32x4 bb = *(const f32x4*)(P.b_router + 8 * g + 4 * hi);
#pragma unroll
        for (int i = 0; i < 4; ++i) lg[4 * g + i] = acc[4 * g + i] * rstd + bb[i]; }
    float tv[4]; int ti[4];
#pragma unroll
    for (int k = 0; k < 4; ++k) { float bv = lg[0]; int bi = 4 * hi;
#pragma unroll
        for (int r = 1; r < 16; ++r) { const int e = (r & 3) + 8 * (r >> 2) + 4 * hi; if (lg[r] > bv) { bv = lg[r]; bi = e; } }
        const float pv = __shfl_xor(bv, 32); const int pi = __shfl_xor(bi, 32);
        if (pv > bv || (pv == bv && pi < bi)) { bv = pv; bi = pi; }
        tv[k] = bv; ti[k] = bi;
#pragma unroll
        for (int r = 0; r < 16; ++r) { const int e = (r & 3) + 8 * (r >> 2) + 4 * hi; if (e == bi) lg[r] = -INFINITY; } }
    const float e1 = __expf(tv[1] - tv[0]), e2 = __expf(tv[2] - tv[0]), e3 = __expf(tv[3] - tv[0]), inv = 1.f / (1.f + e1 + e2 + e3);
    const int c0 = hi ? ti[2] : ti[0], c1 = hi ? ti[3] : ti[1]; const float g0 = (hi ? e2 : 1.f) * inv, g1 = (hi ? e3 : e1) * inv;
    const unsigned long long ltm = (1ull << lane) - 1ull; int mycnt = 0, rk0 = 0, rk1 = 0;
    for (int e = 0; e < 32; ++e) { const unsigned long long m0 = __ballot(c0 == e), m1 = __ballot(c1 == e); const int n0 = __popcll(m0);
        if (lane == e) mycnt = n0 + __popcll(m1);
        if (c0 == e) rk0 = __popcll(m0 & ltm);
        if (c1 == e) rk1 = n0 + __popcll(m1 & ltm); }
    unsigned* cnt = (unsigned*)(P.ws + WS_CTL) + CW_CNT; int base = 0;
    if (lane < 32 && mycnt > 0) base = (int)atomicAdd(cnt + lane, (unsigned)mycnt);
    rk0 += __shfl(base, c0); rk1 += __shfl(base, c1);
    int* route = (int*)(P.ws + WS_ROUTE); int* tokslot = (int*)(P.ws + WS_TOKSLOT); float* gateslot = (float*)(P.ws + WS_GATESLOT);
    tokslot[(size_t)c0 * NTOK + rk0] = row; gateslot[(size_t)c0 * NTOK + rk0] = g0; tokslot[(size_t)c1 * NTOK + rk1] = row; gateslot[(size_t)c1 * NTOK + rk1] = g1;
    route[(size_t)row * 12 + 2 * hi] = c0; route[(size_t)row * 12 + 2 * hi + 1] = c1; route[(size_t)row * 12 + 4 + 2 * hi] = rk0; route[(size_t)row * 12 + 4 + 2 * hi + 1] = rk1;
}
__device__ __forceinline__ void xn8_task(KPR P, int task, int lane) {
    const bf16_t* x1 = (const bf16_t*)(P.ws + WS_X1) + (size_t)task * 32 * DM + 16 * lane; unsigned char* xn = P.ws + WS_XN + (size_t)task * 32 * DM + 16 * lane;
    f32x4 g[4];
#pragma unroll
    for (int q = 0; q < 4; ++q) g[q] = *(const f32x4*)(P.moe_norm + 16 * lane + 4 * q);
    u32x4 xa[4][2];
#pragma unroll
    for (int i = 0; i < 4; ++i) { xa[i][0] = *(const u32x4*)(x1 + (size_t)i * DM); xa[i][1] = *(const u32x4*)(x1 + (size_t)i * DM + 8); }
    for (int r0 = 0; r0 < 32; r0 += 4) {
        f32x4 v[4][4]; float ss[4];
#pragma unroll
        for (int i = 0; i < 4; ++i) { const unsigned w[8] = {xa[i][0].x, xa[i][0].y, xa[i][0].z, xa[i][0].w, xa[i][1].x, xa[i][1].y, xa[i][1].z, xa[i][1].w}; float s = 0.f;
#pragma unroll
            for (int q = 0; q < 4; ++q) { v[i][q] = (f32x4){bflo(w[2 * q]), bfhi(w[2 * q]), bflo(w[2 * q + 1]), bfhi(w[2 * q + 1])}; s += (v[i][q][0] * v[i][q][0] + v[i][q][1] * v[i][q][1]) + (v[i][q][2] * v[i][q][2] + v[i][q][3] * v[i][q][3]); }
            ss[i] = s;
            const int rn = (r0 + 4 + i < 32) ? r0 + 4 + i : r0 + i; xa[i][0] = *(const u32x4*)(x1 + (size_t)rn * DM); xa[i][1] = *(const u32x4*)(x1 + (size_t)rn * DM + 8); }
#pragma unroll
        for (int i = 0; i < 4; ++i) ss[i] = wave_sum(ss[i]);
#pragma unroll
        for (int i = 0; i < 4; ++i) { const float rstd = rsqrtf(ss[i] * (1.f / DM) + 1e-6f); u32x4 o; unsigned ow[4];
#pragma unroll
            for (int q = 0; q < 4; ++q) { const f32x4 t = v[i][q] * rstd * g[q]; ow[q] = pk4_fp8(t[0], t[1], t[2], t[3]); }
            o.x = ow[0]; o.y = ow[1]; o.z = ow[2]; o.w = ow[3];
            *(u32x4*)(xn + (size_t)(r0 + i) * DM) = o; }
    }
}
}
namespace attn_body {
using bf16=unsigned short;
using bf16x8=__attribute__((ext_vector_type(8)))short;
using s16x4=__attribute__((ext_vector_type(4)))short;
using f32x16=__attribute__((ext_vector_type(16)))float;
using u32x4=__attribute__((ext_vector_type(4)))unsigned;
constexpr int BATCH=4,NHEAD=8,SEQ=8192,D=64,DM=3840,OP=1024;
constexpr int NW=8,QBLK=32,QB=QBLK*NW,KVBLK=64,NQB=SEQ/QB;
constexpr int ATTN_PITCH=DM, ATTN_UNIT_ROWS=QB;
__device__ __forceinline__ int crow(int r,int hi){return (r&3)+8*(r>>2)+4*hi;}
#define SBAR() __builtin_amdgcn_sched_barrier(0)
__device__ __forceinline__ void cmask(f32x16&p0,f32x16&p1,int jb,int qrel,int hi){
  const float NEG=-INFINITY; int kb=64*jb+4*hi;
  #pragma unroll
  for(int r=0;r<16;++r){int kv=kb+(r&3)+8*(r>>2); if(kv>qrel)p0[r]=NEG; if(kv+32>qrel)p1[r]=NEG;}
}

constexpr int NSLOT=3, SLOTB=8192;
constexpr int LDS_K=0, LDS_V=NSLOT*SLOTB, LDS_WS=2*NSLOT*SLOTB, LDS_OST=LDS_WS+NW*64*4, LDS_C2=LDS_OST+NW*4096, LDS_BYTES=LDS_C2+SEQ*4;
constexpr float C2=0.125f*1.4426950408889634f;
__device__ __forceinline__ void glds16(const void*gsrc,unsigned lds_dst){unsigned keep;
  asm volatile("s_mov_b32 %0, m0\n\ts_mov_b32 m0, %2\n\ts_nop 0\n\tglobal_load_lds_dwordx4 %1, off\n\ts_mov_b32 m0, %0":"=&s"(keep):"v"(gsrc),"s"(lds_dst):"memory");}
__device__ __forceinline__ float max3f(float a,float b,float c){float r;asm("v_max3_f32 %0, %1, %2, %3":"=v"(r):"v"(a),"v"(b),"v"(c));return r;}
__device__ __forceinline__ float max2f(float a,float b){float r;asm("v_max_f32_e32 %0, %1, %2":"=v"(r):"v"(a),"v"(b));return r;}
__device__ __forceinline__ float fadd_s(float a,float b){float r;asm("v_add_f32_e32 %0, %1, %2":"=v"(r):"v"(a),"v"(b));return r;}
__device__ __forceinline__ float fsub_s(float a,float b){float r;asm("v_sub_f32_e32 %0, %1, %2":"=v"(r):"v"(a),"v"(b));return r;}
typedef float f32x2_t __attribute__((ext_vector_type(2))); typedef float f32x4v __attribute__((ext_vector_type(4))); typedef __bf16 bf16x2_t __attribute__((ext_vector_type(2)));
__device__ __forceinline__ unsigned cvtpk_s(float lo,float hi){f32x2_t v={lo,hi};bf16x2_t b=__builtin_convertvector(v,bf16x2_t);return __builtin_bit_cast(unsigned,b);}
#define WAIT_BAR(N) asm volatile("s_waitcnt vmcnt(" #N ") lgkmcnt(0)\n\ts_barrier":::"memory")

__device__ __forceinline__ void qkt(f32x16&p0,f32x16&p1,const char*Kslot,const bf16x8*qr,int r32,int hi){
  const char*kb=Kslot+hi*1024+r32*16;
  #pragma unroll
  for(int d0=0;d0<4;++d0){
    const bf16x8 b0=*reinterpret_cast<const bf16x8*>(kb+d0*2048);
    const bf16x8 b1=*reinterpret_cast<const bf16x8*>(kb+d0*2048+512);
    p0=__builtin_amdgcn_mfma_f32_32x32x16_bf16(b0,qr[d0],p0,0,0,0);p1=__builtin_amdgcn_mfma_f32_32x32x16_bf16(b1,qr[d0],p1,0,0,0);}
}
typedef __attribute__((address_space(3))) const char* lds_cptr;
typedef short v4i16_t __attribute__((ext_vector_type(4)));
__device__ __forceinline__ void kload8(bf16x8*kf,lds_cptr kp){
  kf[0]=*(const __attribute__((address_space(3))) bf16x8*)(kp);      kf[1]=*(const __attribute__((address_space(3))) bf16x8*)(kp+512);
  kf[2]=*(const __attribute__((address_space(3))) bf16x8*)(kp+2048); kf[3]=*(const __attribute__((address_space(3))) bf16x8*)(kp+2560);
  kf[4]=*(const __attribute__((address_space(3))) bf16x8*)(kp+4096); kf[5]=*(const __attribute__((address_space(3))) bf16x8*)(kp+4608);
  kf[6]=*(const __attribute__((address_space(3))) bf16x8*)(kp+6144); kf[7]=*(const __attribute__((address_space(3))) bf16x8*)(kp+6656);
}
__device__ __forceinline__ void kload2(bf16x8*kf,lds_cptr kp,int j){ kf[2*j]=*(const __attribute__((address_space(3))) bf16x8*)(kp+j*2048); kf[2*j+1]=*(const __attribute__((address_space(3))) bf16x8*)(kp+j*2048+512); }
__device__ __forceinline__ s16x4 vtr(lds_cptr p){ return __builtin_bit_cast(s16x4,__builtin_amdgcn_ds_read_tr16_b64_v4i16((__attribute__((address_space(3))) v4i16_t*)p)); }
__device__ __forceinline__ float rowmax(const f32x16&p0,const f32x16&p1){
  float a=max3f(p0[0],p0[1],p1[0]),b=max3f(p0[2],p0[3],p1[1]);a=max3f(a,p1[2],p1[3]);
  #pragma unroll
  for(int r=4;r<16;r+=4){a=max3f(a,p0[r],p0[r+1]);b=max3f(b,p0[r+2],p0[r+3]);a=max3f(a,p1[r],p1[r+1]);b=max3f(b,p1[r+2],p1[r+3]);}
  const float m=max2f(a,b);
  auto rr=__builtin_amdgcn_permlane32_swap(__float_as_uint(m),__float_as_uint(m),false,false);
  return max2f(__uint_as_float(rr[0]),__uint_as_float(rr[1]));
}
__device__ __forceinline__ void pv(f32x16*o,int vb,bf16x8 pa0,bf16x8 pa1,bf16x8 pa2,bf16x8 pa3){
  #pragma unroll
  for(int d0=0;d0<2;++d0){s16x4 lo[4],hi[4];
    #pragma unroll
    for(int ks=0;ks<4;++ks){
      asm volatile("ds_read_b64_tr_b16 %0,%1 offset:%c2":"=&v"(lo[ks]):"v"(vb),"i"(d0*4096+ks*1024):"memory");
      asm volatile("ds_read_b64_tr_b16 %0,%1 offset:%c2":"=&v"(hi[ks]):"v"(vb),"i"(d0*4096+ks*1024+512):"memory");}
    asm volatile("s_waitcnt lgkmcnt(0)":::"memory");SBAR();
    #define PK(k) (bf16x8){lo[k][0],lo[k][1],lo[k][2],lo[k][3],hi[k][0],hi[k][1],hi[k][2],hi[k][3]}
    o[d0]=__builtin_amdgcn_mfma_f32_32x32x16_bf16(pa0,PK(0),o[d0],0,0,0);
    o[d0]=__builtin_amdgcn_mfma_f32_32x32x16_bf16(pa1,PK(1),o[d0],0,0,0);
    o[d0]=__builtin_amdgcn_mfma_f32_32x32x16_bf16(pa2,PK(2),o[d0],0,0,0);
    o[d0]=__builtin_amdgcn_mfma_f32_32x32x16_bf16(pa3,PK(3),o[d0],0,0,0);
    #undef PK
  }
}

#ifndef ATTN_STORE16
#define ATTN_STORE16(p,v) (*(u32x4*)(p)=(v))
#endif
template<int THRL> __device__ __forceinline__ void attn_unit(int b,int h,int qb,int t0,const bf16*Z,const float*c2g,bf16*O,char*shm){
  int tid_=threadIdx.x; asm volatile("":"+v"(tid_));
  const int tid=tid_,lane=tid&63,r32=lane&31,hi=lane>>5; const int wid=__builtin_amdgcn_readfirstlane(tid>>6);
  const long rowbase=(long)b*SEQ; const int q0=qb*QB;
  const bf16*Qw=Z+(rowbase+q0+wid*QBLK)*DM+h*D;
  const bf16*Kh=Z+(rowbase+(long)t0*KVBLK)*DM+512+h*D,*Vh=Z+(rowbase+(long)t0*KVBLK)*DM+1024+h*D;
  const unsigned lds0=(unsigned)(uintptr_t)shm;
  float*wsf=(float*)(shm+LDS_WS)+wid*64;
  const bf16*ksrc=Kh+(long)lane*DM+wid*8;
  const bf16*vsrc=Vh+(long)(16*(wid&3)+(lane>>2))*DM+(wid>>2)*32+(lane&3)*8;
  const unsigned kdst=lds0+LDS_K+wid*1024, vdst=lds0+LDS_V+wid*1024;
  #define DMA_K(t,slot) glds16(ksrc+(long)(t)*KVBLK*DM,(unsigned)__builtin_amdgcn_readfirstlane(kdst+(slot)))
  #define DMA_V(t,slot) glds16(vsrc+(long)(t)*KVBLK*DM,(unsigned)__builtin_amdgcn_readfirstlane(vdst+(slot)))
  const int vb0=(int)(lds0+LDS_V)+((lane>>4)&1)*32+(lane&3)*8+(4*hi+((lane&15)>>2))*64;
  const char*Kbase=shm+LDS_K; bf16x8 kf[8];
  const lds_cptr shm3=(lds_cptr)shm; const lds_cptr kp0=shm3+LDS_K+hi*1024+r32*16; const lds_cptr vp0=shm3+LDS_V+((lane>>4)&1)*32+(lane&3)*8+(4*hi+((lane&15)>>2))*64;
  const int NT=(q0+QB)/KVBLK-t0;
  { const int np=(q0+QB)/256;
    for(int p=(t0>>2)+wid;p<np;p+=NW) glds16(c2g+p*256+lane*4,(unsigned)__builtin_amdgcn_readfirstlane(lds0+LDS_C2+p*1024)); }
  const __attribute__((address_space(3))) float* c2l=(const __attribute__((address_space(3))) float*)(shm3+LDS_C2)+t0*KVBLK+4*hi;
  DMA_K(0,0);DMA_V(0,0);DMA_K(1,SLOTB);
  bf16x8 qr[4];
  #pragma unroll
  for(int d0=0;d0<4;++d0)qr[d0]=*reinterpret_cast<const bf16x8*>(&Qw[(long)r32*DM+d0*16+hi*8]);
  float l_reg=0.f;f32x16 o[2];o[0]=f32x16{};o[1]=f32x16{};
  float base=c2g[q0+wid*QBLK+r32];
  const int qrel=wid*QBLK+r32;
  #define CMASK(P0,P1,t) do{int jb_=(t)-(NT-4); if(jb_>=0)cmask(P0,P1,jb_,qrel,hi);}while(0)
  bool resc=false;
  #define START(P0,P1) do{ const float rm=rowmax(P0,P1); resc=false; \
    { const float dl=rm; base=fsub_s(base,dl); \
      _Pragma("unroll") for(int r=0;r<16;++r){P0[r]=fsub_s(P0[r],dl);P1[r]=fsub_s(P1[r],dl);} } \
    _Pragma("unroll") for(int r=0;r<16;++r)P0[r]=__builtin_amdgcn_exp2f(P0[r]); }while(0)
  #define RESC() do{ if(resc){ asm volatile("s_waitcnt lgkmcnt(0)":::"memory"); \
      _Pragma("unroll") for(int d_=0;d_<2;++d_) _Pragma("unroll") for(int r=0;r<16;++r)o[d_][r]*=wsf[crow(r,hi)]; } }while(0)
  f32x16 pA0,pA1,pB0,pB1;
  #define BIASLD(P0,P1,tt) do{ _Pragma("unroll") for(int g_=0;g_<4;++g_){ const f32x4v x0_=*(const __attribute__((address_space(3))) f32x4v*)(c2l+(tt)*KVBLK+8*g_), x1_=*(const __attribute__((address_space(3))) f32x4v*)(c2l+(tt)*KVBLK+32+8*g_); \
      P0[4*g_]=x0_[0];P0[4*g_+1]=x0_[1];P0[4*g_+2]=x0_[2];P0[4*g_+3]=x0_[3]; P1[4*g_]=x1_[0];P1[4*g_+1]=x1_[1];P1[4*g_+2]=x1_[2];P1[4*g_+3]=x1_[3]; } }while(0)
  #define BIASFIX(P0,P1) do{ _Pragma("unroll") for(int r=0;r<16;++r){P0[r]=fsub_s(base,P0[r]);P1[r]=fsub_s(base,P1[r]);} }while(0)
  int sl_prev=0,sl_cur=0,sl_next=SLOTB;
  #define ROT() do{sl_prev=sl_cur;sl_cur=sl_next;sl_next=(sl_next==(NSLOT-1)*SLOTB)?0:sl_next+SLOTB;}while(0)
  DMA_K(2,2*SLOTB);
  WAIT_BAR(3);
  BIASLD(pA0,pA1,0); BIASFIX(pA0,pA1);
  qkt(pA0,pA1,Kbase,qr,r32,hi);asm volatile("s_nop 15\n\ts_nop 7":"+v"(pA0),"+v"(pA1));CMASK(pA0,pA1,0);
  START(pA0,pA1);
  _Pragma("unroll") for(int r=0;r<16;++r)pA1[r]=__builtin_amdgcn_exp2f(pA1[r]);
  BIASLD(pB0,pB1,1);
  WAIT_BAR(0);
  DMA_K(3,0);DMA_V(1,SLOTB);
  ROT();
  kload8(kf,kp0+sl_cur);
  WAIT_BAR(2);
  s16x4 vlo[8],vhi[8]; u32x4 pw0,pw1,pw2,pw3;
  #define PKW(P,B) cvtpk_s(P[B],P[B+1])
  #define PAF(k) __builtin_bit_cast(bf16x8,pw##k)
  #define VFR(i) (bf16x8){vlo[i][0],vlo[i][1],vlo[i][2],vlo[i][3],vhi[i][0],vhi[i][1],vhi[i][2],vhi[i][3]}
  #define PIN(x) asm volatile("":"+v"(x))
  #define MX3(a,b,c) __builtin_fmaxf(__builtin_fmaxf((a),(b)),(c))
  #define GAPA(MF,A0,A1,A2,A3,W0,W1,PW) do{ MF; sacc+=A0; sacc+=A1; sacc+=A2; sacc+=A3; PIN(sacc); W0; W1; PIN(PW); SBAR(); }while(0)
  #define EX(v) __builtin_amdgcn_exp2f(v)
  #define GAPB(MF,X,B) do{ MF; X[B]=EX(X[B]); X[B+1]=EX(X[B+1]); X[B+2]=EX(X[B+2]); X[B+3]=EX(X[B+3]); PIN(X); SBAR(); }while(0)
  #define VRD(i) do{ vlo[i]=vtr(vp_+(((i)>>2)*4096+((i)&3)*1024)); vhi[i]=vtr(vp_+(((i)>>2)*4096+((i)&3)*1024+512)); }while(0)
  #define KRD(G,j) do{ if(G){ kload2(kf,kp0+sl_next,j); SBAR(); } }while(0)
  #define STEP(C0,C1,P0,P1,t,GK,GV,GL) do{ SBAR(); \
    BIASFIX(C0,C1); SBAR(); \
    const lds_cptr vp_=vp0+sl_prev; \
    VRD(0); SBAR(); float sacc=(P0[0]+P0[1]); \
    GAPA(C0=__builtin_amdgcn_mfma_f32_32x32x16_bf16(kf[0],qr[0],C0,0,0,0), P0[2],P0[3],P0[4],P0[5],     pw0[0]=PKW(P0,0), pw0[1]=PKW(P0,2), pw0); \
    VRD(4); SBAR(); GAPA(C1=__builtin_amdgcn_mfma_f32_32x32x16_bf16(kf[1],qr[0],C1,0,0,0), P0[6],P0[7],P0[8],P0[9],     pw0[2]=PKW(P0,4), pw0[3]=PKW(P0,6), pw0); \
    VRD(1); SBAR(); GAPA(C0=__builtin_amdgcn_mfma_f32_32x32x16_bf16(kf[2],qr[1],C0,0,0,0),   P0[10],P0[11],P0[12],P0[13], pw1[0]=PKW(P0,8), pw1[1]=PKW(P0,10), pw1); \
    VRD(5); SBAR(); GAPA(C1=__builtin_amdgcn_mfma_f32_32x32x16_bf16(kf[3],qr[1],C1,0,0,0),   P0[14],P0[15],P1[0],P1[1],   pw1[2]=PKW(P0,12),pw1[3]=PKW(P0,14), pw1); \
    VRD(2); SBAR(); GAPA(C0=__builtin_amdgcn_mfma_f32_32x32x16_bf16(kf[4],qr[2],C0,0,0,0),   P1[2],P1[3],P1[4],P1[5],     pw2[0]=PKW(P1,0), pw2[1]=PKW(P1,2), pw2); \
    VRD(6); SBAR(); GAPA(C1=__builtin_amdgcn_mfma_f32_32x32x16_bf16(kf[5],qr[2],C1,0,0,0),   P1[6],P1[7],P1[8],P1[9],     pw2[2]=PKW(P1,4), pw2[3]=PKW(P1,6), pw2); \
    VRD(3); SBAR(); GAPA(C0=__builtin_amdgcn_mfma_f32_32x32x16_bf16(kf[6],qr[3],C0,0,0,0),   P1[10],P1[11],P1[12],P1[13], pw3[0]=PKW(P1,8), pw3[1]=PKW(P1,10), pw3); \
    VRD(7); SBAR(); GAPA(C1=__builtin_amdgcn_mfma_f32_32x32x16_bf16(kf[7],qr[3],C1,0,0,0),   P1[14],P1[15],0.f,0.f,       pw3[2]=PKW(P1,12),pw3[3]=PKW(P1,14), pw3); \
    l_reg+=sacc; \
    if(GL){BIASLD(P0,P1,(t)+1);} \
    if(GK){DMA_K((t)+3,sl_cur);} if(GV){DMA_V((t)+1,sl_next);} \
    CMASK(C0,C1,t); \
    { float a=MX3(C0[0],C0[1],C1[0]),b=MX3(C0[2],C0[3],C1[1]); a=MX3(a,C1[2],C1[3]); \
      _Pragma("unroll") for(int r=4;r<16;r+=4){a=MX3(a,C0[r],C0[r+1]);b=MX3(b,C0[r+2],C0[r+3]);a=MX3(a,C1[r],C1[r+1]);b=MX3(b,C1[r+2],C1[r+3]);} \
      float rm=__builtin_fmaxf(a,b); { auto rr=__builtin_amdgcn_permlane32_swap(__float_as_uint(rm),__float_as_uint(rm),false,false); rm=__builtin_fmaxf(__uint_as_float(rr[0]),__uint_as_float(rr[1])); } \
      resc=false; \
      if(__builtin_expect(__any(rm>(float)THRL),0)){ const float dl=__builtin_fmaxf(rm,0.f); base-=dl; \
        _Pragma("unroll") for(int r=0;r<16;++r){C0[r]-=dl;C1[r]-=dl;} \
        const float f=__builtin_amdgcn_exp2f(-dl); l_reg*=f; if(hi==0)wsf[r32]=f; resc=true; } } \
    SBAR(); \
    GAPB(o[0]=__builtin_amdgcn_mfma_f32_32x32x16_bf16(PAF(0),VFR(0),o[0],0,0,0), C0,0); \
    GAPB(o[1]=__builtin_amdgcn_mfma_f32_32x32x16_bf16(PAF(0),VFR(4),o[1],0,0,0), C0,4); \
    KRD(GL,0); GAPB(o[0]=__builtin_amdgcn_mfma_f32_32x32x16_bf16(PAF(1),VFR(1),o[0],0,0,0), C0,8); \
    KRD(GL,1); GAPB(o[1]=__builtin_amdgcn_mfma_f32_32x32x16_bf16(PAF(1),VFR(5),o[1],0,0,0), C0,12); \
    KRD(GL,2); GAPB(o[0]=__builtin_amdgcn_mfma_f32_32x32x16_bf16(PAF(2),VFR(2),o[0],0,0,0), C1,0); \
    KRD(GL,3); GAPB(o[1]=__builtin_amdgcn_mfma_f32_32x32x16_bf16(PAF(2),VFR(6),o[1],0,0,0), C1,4); \
    GAPB(o[0]=__builtin_amdgcn_mfma_f32_32x32x16_bf16(PAF(3),VFR(3),o[0],0,0,0), C1,8); \
    GAPB(o[1]=__builtin_amdgcn_mfma_f32_32x32x16_bf16(PAF(3),VFR(7),o[1],0,0,0), C1,12); \
    }while(0)
  int t=1;
  #undef CMASK
  #define CMASK(P0,P1,t) do{}while(0)
  for(;t+5<NT;t+=2){
    STEP(pB0,pB1,pA0,pA1,t,true,true,true);     WAIT_BAR(2); RESC(); ROT();
    STEP(pA0,pA1,pB0,pB1,t+1,true,true,true);   WAIT_BAR(2); RESC(); ROT();
  }
  #undef CMASK
  #define CMASK(P0,P1,t) do{int jb_=(t)-(NT-4); if(jb_>=0)cmask(P0,P1,jb_,qrel,hi);}while(0)
  #define ENDW(tt) do{ if((tt)+3<NT){WAIT_BAR(2);} else if((tt)+2<NT){WAIT_BAR(1);} else {WAIT_BAR(0);} }while(0)
  for(;t+1<NT;t+=2){
    STEP(pB0,pB1,pA0,pA1,t,(t+3<NT),(t+1<NT),(t+1<NT));       ENDW(t);   RESC(); ROT();
    STEP(pA0,pA1,pB0,pB1,t+1,(t+4<NT),(t+2<NT),(t+2<NT));     ENDW(t+1); RESC(); ROT();
  }
  STEP(pB0,pB1,pA0,pA1,NT-1,false,false,false); RESC();
  { float sacc=pB0[0]+pB0[1]; _Pragma("unroll") for(int r=2;r<16;++r)sacc+=pB0[r]; _Pragma("unroll") for(int r=0;r<16;++r)sacc+=pB1[r]; l_reg+=sacc;
    pw0=(u32x4){PKW(pB0,0),PKW(pB0,2),PKW(pB0,4),PKW(pB0,6)};pw1=(u32x4){PKW(pB0,8),PKW(pB0,10),PKW(pB0,12),PKW(pB0,14)};pw2=(u32x4){PKW(pB1,0),PKW(pB1,2),PKW(pB1,4),PKW(pB1,6)};pw3=(u32x4){PKW(pB1,8),PKW(pB1,10),PKW(pB1,12),PKW(pB1,14)};
    SBAR(); pv(o,vb0+sl_cur,PAF(0),PAF(1),PAF(2),PAF(3)); }
  #undef PKW
  #undef PAF
  #undef VFR
  #undef PIN
  #undef MX3
  #undef GAPA
  #undef GAPB
  #undef EX
  #undef VRD
  #undef KRD
  #undef STEP
  #undef ENDW
  {auto rr=__builtin_amdgcn_permlane32_swap(__float_as_uint(l_reg),__float_as_uint(l_reg),false,false);l_reg=__uint_as_float(rr[0])+__uint_as_float(rr[1]);}
  if(hi==0)wsf[32+r32]=l_reg;asm volatile("s_waitcnt lgkmcnt(0)":::"memory");
  float rli[16];
  #pragma unroll
  for(int r=0;r<16;++r)rli[r]=__builtin_amdgcn_rcpf(wsf[32+crow(r,hi)]);
  bf16*Ow=O+(rowbase+q0+wid*QBLK)*OP+h*D; const bf16*Gw=Z+(rowbase+q0+wid*QBLK)*DM+1536+h*D;
  { bf16*stg=(bf16*)(shm+LDS_OST)+wid*2048;
    #pragma unroll
    for(int r=0;r<16;++r){const int orow=crow(r,hi);
      #pragma unroll
      for(int d0=0;d0<2;++d0)stg[orow*64+d0*32+r32]=(bf16)f2bf(o[d0][r]*rli[r]);}
    asm volatile("s_waitcnt lgkmcnt(0)":::"memory");
    #pragma unroll
    for(int i=0;i<4;++i){const int row=i*8+(lane>>3),ch=lane&7; const u32x4 v=*(const u32x4*)(stg+row*64+ch*8), g=*(const u32x4*)(Gw+(long)row*DM+ch*8);
      const unsigned vw[4]={v.x,v.y,v.z,v.w},gw[4]={g.x,g.y,g.z,g.w}; unsigned ow[4];
      #pragma unroll
      for(int j=0;j<4;++j){ const float a0=bflo(vw[j])*__builtin_amdgcn_rcpf(1.0f+__expf(-bflo(gw[j]))), a1=bfhi(vw[j])*__builtin_amdgcn_rcpf(1.0f+__expf(-bfhi(gw[j]))); ow[j]=cvtpk_s(a0,a1); }
      ATTN_STORE16(Ow+(long)row*OP+ch*8,((u32x4){ow[0],ow[1],ow[2],ow[3]}));} }
  asm volatile("s_waitcnt lgkmcnt(0)\n\ts_barrier":::"memory");
  #undef DMA_K
  #undef DMA_V
  #undef CMASK
  #undef START
  #undef RESC
  #undef ROT
}
constexpr int ATTN_LDS_BYTES=LDS_BYTES;
#undef SBAR
#undef WAIT_BAR
}
constexpr int CW_QATT = 128, CW_QCVT = 384;
constexpr int MISC_TAB = 64, MISC_Q = 4096, MISC_PFX = 4160;

__device__ __forceinline__ int attn_t0(KPR P, const float* c2, int q0, int lane) {
    float gq = fabsf(P.q_norm[lane]), gk = fabsf(P.k_norm[lane]);
#pragma unroll
    for (int o = 1; o < 64; o <<= 1) { gq = fmaxf(gq, __shfl_xor(gq, o)); gk = fmaxf(gk, __shfl_xor(gk, o)); }
    const float thr = c2[q0] + (2.0f * 8.0f * LOG2E * gq * gk + 40.0f);
    const int nfull = q0 / 64; int t0 = 0;
    for (int tb = 0; tb < nfull; tb += 64) { const int tt = tb + lane; const bool sk = (tt < nfull) && (c2[tt * 64 + 63] > thr); const unsigned long long bm = __ballot(sk); t0 += __popcll(bm); if (bm != ~0ull) break; }
    return __builtin_amdgcn_readfirstlane(t0) & ~1;
}
template <int NR>
__device__ __forceinline__ void combine_rows(KPR P, const LAS int* tab, const int (&rows)[NR], int lane) {
    const int* route = (const int*)(P.ws + WS_ROUTE); const unsigned char* YP = P.ws + WS_YP; bf16_t* X = (bf16_t*)(P.ws + WS_X1);
    u32x2 xv[NR][4]; unsigned yv[NR][4][4];
#pragma unroll
    for (int r = 0; r < NR; ++r) { const u32x2* xr = (const u32x2*)(X + (size_t)rows[r] * DM) + lane;
#pragma unroll
        for (int j = 0; j < 4; ++j) xv[r][j] = xr[64 * j]; }
#pragma unroll
    for (int r = 0; r < NR; ++r)
#pragma unroll
        for (int k = 0; k < 4; ++k) { const int ex = route[(size_t)rows[r] * 12 + k], rank = route[(size_t)rows[r] * 12 + 4 + k]; const size_t pos = (size_t)tab[pg8::T_BLKSTART + ex] * 256 + rank;
            const unsigned* yr = (const unsigned*)(YP + pos * DM) + lane;
#pragma unroll
            for (int j = 0; j < 4; ++j) yv[r][k][j] = yr[64 * j]; }
#pragma unroll
    for (int r = 0; r < NR; ++r) { f32x4 v[4];
#pragma unroll
        for (int j = 0; j < 4; ++j) v[j] = (f32x4){bflo(xv[r][j].x), bfhi(xv[r][j].x), bflo(xv[r][j].y), bfhi(xv[r][j].y)};
#pragma unroll
        for (int k = 0; k < 4; ++k)
#pragma unroll
            for (int j = 0; j < 4; ++j) { const unsigned y = yv[r][k][j]; const f32x2 lo = __builtin_amdgcn_cvt_pk_f32_fp8((int)y, false), hi = __builtin_amdgcn_cvt_pk_f32_fp8((int)y, true);
                v[j][0] += lo[0] * 0.25f; v[j][1] += lo[1] * 0.25f; v[j][2] += hi[0] * 0.25f; v[j][3] += hi[1] * 0.25f; }
        u32x2* xo = (u32x2*)(X + (size_t)rows[r] * DM) + lane; float s = 0.f;
#pragma unroll
        for (int j = 0; j < 4; ++j) { u32x2 w; w.x = pk2(v[j][0], v[j][1]); w.y = pk2(v[j][2], v[j][3]); xo[64 * j] = w; v[j] = (f32x4){bflo(w.x), bfhi(w.x), bflo(w.y), bfhi(w.y)}; s += (v[j][0] * v[j][0] + v[j][1] * v[j][1]) + (v[j][2] * v[j][2] + v[j][3] * v[j][3]); }
        const float rstd = rsqrtf(wave_sum(s) * (1.f / DM) + 1e-6f);
#pragma unroll
        for (int j = 0; j < 4; ++j) v[j] = v[j] * rstd * ((const f32x4*)P.ple_norm)[64 * j + lane];
        store_row_fp8(P.ws + WS_XN + (size_t)rows[r] * DM, lane, v); }
}

constexpr int NPHASE = 13;
__global__ void __launch_bounds__(NTHREADS, 2) mega_fwd(Params Pkarg_unused) {
    extern __shared__ __attribute__((aligned(16))) unsigned char smem[];
    LAS unsigned char* lds = (LAS unsigned char*)smem;
    const int tid = threadIdx.x, lane = tid & 63, wave = __builtin_amdgcn_readfirstlane(tid >> 6);
    const int G = gridDim.x, blk = blockIdx.x;
#define P (*kpp)
#ifndef MK_REP
#define MK_REP -1
#endif
#define PHASE_BEGIN(k) if (IN(k)) for (int rep_ = 0; rep_ < ((k) == MK_REP ? 2 : 1); ++rep_) { const __attribute__((address_space(4))) Params* kpp = kp_fresh();
#define PHASE_END(k) } if (BOTH(k)) { XcdBarrier bar_; bar_.bar = (unsigned*)((*kp_fresh()).ws + WS_CTL) + CW_BAR; bar_.x = xb_xcc_id(); bar_.st = (volatile LAS unsigned*)(lds + MISC_OFF); xcd_barrier(bar_); }
#define IN(k) (ph_lo <= (k) && (k) < ph_hi)
#define BOTH(k) (IN(k) && IN((k) + 1))
    const __attribute__((address_space(4))) Params* kpp = kp_fresh();
    if (tid < 16) ((volatile LAS unsigned*)(lds + MISC_OFF))[tid] = 0u;
    __syncthreads();
    (void)xcd_barrier_post((unsigned*)(P.ws + WS_CTL) + CW_BAR, (volatile LAS unsigned*)(lds + MISC_OFF));
    const int ph_lo = P.ph_lo, ph_hi = P.ph_hi;
#define wsb (P.ws)
#define ctl ((unsigned*)(P.ws + WS_CTL))
#define MISC ((volatile LAS unsigned*)(lds + MISC_OFF))
#define tab ((LAS int*)(lds + MISC_OFF + MISC_TAB))

    PHASE_BEGIN(0)
        phase_prep_weights(P, lds, blk * NWAVES + wave, G * NWAVES, wave, lane);
        phase_cvt_p(P, blk * NTHREADS + tid, G * NTHREADS);
        __syncthreads();
        LAS float* wff = (LAS float*)lds; LAS float* lf = (LAS float*)(lds + 32768);
        load_wff(P, wff, tid, NTHREADS); __syncthreads();
        for (int i = 0; i < 16; ++i) { const int rl = wave * 16 + i; norm1_row(P, blk * 128 + rl, lane, wff, lf + rl * 8); }
        __syncthreads();
        if (tid < 64) { const int h = tid & 7, seg = tid >> 3; float c16[16]; float run = 0.f;
#pragma unroll
            for (int r = 0; r < 16; ++r) { run += lf[(seg * 16 + r) * 8 + h]; c16[r] = run; }
            float incl = run;
#pragma unroll
            for (int o = 8; o < 64; o <<= 1) { const float t = __shfl_up(incl, o); if (tid >= o) incl += t; }
            const float pre = incl - run; float* cloc = (float*)(P.ws + WS_LOGF) + ((size_t)blk * 128 + seg * 16) * 8 + h;
#pragma unroll
            for (int r = 0; r < 16; ++r) cloc[r * 8] = pre + c16[r];
            if (seg == 7) ((float*)(P.ws + WS_CTOT))[blk * 8 + h] = incl; }
        if (blk >= G - 16) rt::build_w(P, blk - (G - 16), tid);
    PHASE_END(0)

    PHASE_BEGIN(1)
        {
            LAS float* pfx = (LAS float*)(lds + MISC_OFF + MISC_PFX);
            if (tid < 64) { const float* ct = (const float*)(wsb + WS_CTOT); const int j = (blk & ~63) + tid; float v8[8];
#pragma unroll
                for (int h = 0; h < 8; ++h) v8[h] = (j < blk) ? ct[j * 8 + h] : 0.f;
#pragma unroll
                for (int h = 0; h < 8; ++h) { const float s = wave_sum(v8[h]); if (tid == 0) pfx[h] = s; } }
            __syncthreads();
            const float* cloc = (const float*)(wsb + WS_LOGF) + (size_t)blk * 128 * 8; float* c2 = (float*)(P.ws + WS_C2);
            for (int i = tid; i < 1024; i += NTHREADS) { const int r = i >> 3, h = i & 7; const int row = blk * 128 + r, b = row >> 13, t = row & (SEQ - 1);
                c2[((size_t)(b * 8 + h)) * SEQ + t] = (cloc[i] + pfx[h]) * LOG2E; }
            __syncthreads();
        }
        {
            pg8::DenseOrder S{(const bf16_t*)(wsb + WS_XN), (const bf16_t*)(wsb + WS_WIN), 1024, NTOK / 256, ZW / 256, G, blk};
            pg8::EpiIn E{(bf16_t*)(P.ws + WS_Z), P.q_norm, P.k_norm};
            pg8::gemm_phase<pg8::EpiIn, pg8::DenseOrder, true>(lds, 1024, S, E);
        }
        {
            pg8::DenseOrder S{(const bf16_t*)((unsigned char*)P.out + DO_PB), (const bf16_t*)(wsb + WS_WPP), PLE, NTOK / 256, DM / 256, G / 2, blk >= G / 2 ? blk - G / 2 : (1 << 20)};
            pg8::EpiBf16 E{(bf16_t*)((unsigned char*)P.out + DO_PJ), DM};
            pg8::gemm_phase<pg8::EpiBf16, pg8::DenseOrder, true>(lds, PLE, S, E);
        }
    PHASE_END(1)

    PHASE_BEGIN(2)
        rk::lora_block(P, lds, blk, G, tid);
        __syncthreads();
        { LAS float* cscr = (LAS float*)(lds + ((wave & 3) == 0 ? 125184 : MISC_OFF + 64 + ((wave & 3) - 1) * 4608));
          for (int i = 0; i < 16; ++i) rk::pass1_chunk(P, lds, (blk >> 6) * 8 + (i & 7), 2 * (blk & 63) + (i >> 3), tid, (blk * 16 + i) * 8, cscr); }
    PHASE_END(2)

    PHASE_BEGIN(4)
        if (blk < NB * NH) rk::pass2_seq(P, lds, blk, tid);
#define CVT_LOOP() for (;;) { __syncthreads(); if (tid == 0) MISC[MISC_Q / 4] = __hip_atomic_fetch_add(ctl + CW_QCVT + 64 * rep_, 1u, RLX_AGENT); __syncthreads(); \
            const int q = (int)MISC[MISC_Q / 4]; if (q >= NCVT) break; cvt_task(P, lds, CVT_TASK0 + q, wave, lane); }
        if (((blk >> 3) & 3) == 1) { CVT_LOOP() }
        for (;;) {
            __syncthreads();
            if (tid == 0) MISC[MISC_Q / 4] = __hip_atomic_fetch_add(ctl + CW_QATT + 64 * rep_, 1u, RLX_AGENT);
            __syncthreads();
            const int q = (int)MISC[MISC_Q / 4];
            if (q >= 1024) break;
            { const int bh = q & 31, qb = 31 - (q >> 5); const float* c2 = (const float*)(wsb + WS_C2) + (size_t)bh * SEQ;
              const int t0 = attn_t0(P, c2, qb * 256, lane);
              attn_body::attn_unit<8>(bh >> 3, bh & 7, qb, t0, (const bf16_t*)(wsb + WS_Z), c2, (bf16_t*)(P.ws + WS_AO), (char*)smem); }
        }
        if (((blk >> 3) & 3) != 1) { CVT_LOOP() }
#undef CVT_LOOP
    PHASE_END(4)

    PHASE_BEGIN(5)
        for (int task = blk; task < NB * NH * rk::NCHUNK; task += G) rk::pass3_chunk(P, lds, task >> 7, task & 127, tid);
    PHASE_END(5)

    PHASE_BEGIN(6)
        pg8::DenseOrder S{(const bf16_t*)(wsb + WS_AO), (const bf16_t*)(wsb + WS_WOUT), 1024, NTOK / 256, DM / 256, G, blk};
        pg8::EpiOut E{P.x, (bf16_t*)(P.ws + WS_X1)};
        pg8::gemm_phase<pg8::EpiOut, pg8::DenseOrder, true>(lds, 1024, S, E);
    PHASE_END(6)

    PHASE_BEGIN(7)
        rt::copy_w(P, lds, tid);
        if (blk == 0 && tid < 256) ((unsigned*)(P.ws + WS_XN + (size_t)NTOK * DM))[tid] = 0u;
        __syncthreads();
        if (wave < 4) { for (int task = wave * G + blk; task < NTOK / 32; task += 4 * G) rt::route_task(P, lds, task, lane); }
        else { for (int task = (wave - 4) * G + blk; task < NTOK / 32; task += 4 * G) rt::xn8_task(P, task, lane); }
    PHASE_END(7)

    PHASE_BEGIN(8)
        const int nblk = pg8::moe_tables(tab, (const unsigned*)(wsb + WS_CTL) + CW_CNT);
        pg8::MoeOrder S{wsb + WS_XN, wsb + WS_WGU, (const int*)(wsb + WS_TOKSLOT), (const float*)(wsb + WS_GATESLOT), tab, nblk, 8, G, blk, true};
        pg8::EpiGu E{P.ws + WS_ACT, P.b_gu};
        pg8::gemm_phase<pg8::EpiGu, pg8::MoeOrder, true, true>(lds, 1024, S, E);
    PHASE_END(8)
    PHASE_BEGIN(9)
        const int nblk = pg8::moe_tables(tab, (const unsigned*)(wsb + WS_CTL) + CW_CNT);
        pg8::MoeOrder S{wsb + WS_ACT, wsb + WS_WDN, (const int*)(wsb + WS_TOKSLOT), (const float*)(wsb + WS_GATESLOT), tab, nblk, 4, G, blk, false};
        pg8::EpiDn E{P.ws + WS_YP, P.b_down, (const float*)(wsb + WS_GATESLOT), tab};
        pg8::gemm_phase<pg8::EpiDn, pg8::MoeOrder, true, true>(lds, 1024, S, E);
    PHASE_END(9)
    PHASE_BEGIN(10)
        (void)pg8::moe_tables(tab, (const unsigned*)(wsb + WS_CTL) + CW_CNT);
        for (int row = blk * NWAVES + wave; row < NTOK; row += 2 * G * NWAVES) { const int rows[2] = {row, row + G * NWAVES}; combine_rows<2>(P, tab, rows, lane); }
    PHASE_END(10)
    PHASE_BEGIN(11)
        pg8::DenseOrder S{wsb + WS_XN, wsb + WS_WPG, 512, NTOK / 256, DM / 256, G, blk};
        pg8::EpiPg E{(bf16_t*)(P.ws + WS_X1), (const bf16_t*)((unsigned char*)P.out + DO_PJ)};
        pg8::gemm_phase<pg8::EpiPg, pg8::DenseOrder, true, true>(lds, 1024, S, E);
    PHASE_END(11)
    PHASE_BEGIN(12)
        const bool dead = __hip_atomic_load(ctl + CW_BAR + XB_TMO, RLX_AGENT) != 0u;
        for (int row = blk * NWAVES + wave; row < NTOK; row += G * NWAVES) final_row(P, row, lane, dead);
    PHASE_END(12)
}
#undef P
#undef wsb
#undef ctl
#undef MISC
#undef tab
extern "C" void kernel_launch(void* const* d_in, const int* in_sizes, int n_in, void* d_out, int out_size, void* d_ws, size_t ws_size, hipStream_t stream) {
    static int ok = 0;
    if (ok == 0) {
        if (n_in != 30 || in_sizes[0] != NTOK * DM || out_size != NTOK * DM || ws_size < WS_END) { fprintf(stderr, "kernel_launch: unexpected shapes (n_in %d, ws %zu)\n", n_in, ws_size); ok = -1; return; }
        if (hipFuncSetAttribute((const void*)mega_fwd, hipFuncAttributeMaxDynamicSharedMemorySize, LDS_BYTES) != hipSuccess) { fprintf(stderr, "kernel_launch: hipFuncSetAttribute failed\n"); ok = -1; return; }
        int dev = 0, cus = 0, per_cu = 0;
        if (hipGetDevice(&dev) != hipSuccess || hipDeviceGetAttribute(&cus, hipDeviceAttributeMultiprocessorCount, dev) != hipSuccess) { ok = -1; return; }
        if (hipOccupancyMaxActiveBlocksPerMultiprocessor(&per_cu, (const void*)mega_fwd, NTHREADS, LDS_BYTES) != hipSuccess || per_cu < 1) { fprintf(stderr, "kernel_launch: occupancy query says %d\n", per_cu); }
        (void)hipGetLastError();
        if (cus != 256) { fprintf(stderr, "kernel_launch: built for 256 CUs, device has %d\n", cus); ok = -1; return; }
        ok = 1;
    }
    if (ok < 0) return;
    Params P{};
    const float** pp = (const float**)&P;
    for (int i = 0; i < 30; ++i) pp[i] = (const float*)d_in[i];
    P.out = (float*)d_out; P.ws = (unsigned char*)d_ws;
    if (hipMemsetAsync((char*)d_ws + WS_CTL, 0, CTL_BYTES, stream) != hipSuccess) return;
#ifndef MK_CUTS
#define MK_CUTS 0
#endif
    if (MK_CUTS == 0) { P.ph_lo = 0; P.ph_hi = NPHASE; hipLaunchKernelGGL(mega_fwd, dim3(256), dim3(NTHREADS), LDS_BYTES, stream, P); }
    else for (int k = 0; k < NPHASE; ++k) { P.ph_lo = k; P.ph_hi = k + 1;
        hipLaunchKernelGGL(mega_fwd, dim3(256), dim3(NTHREADS), LDS_BYTES, stream, P); }
}
```

```cpp
#include <hip/hip_runtime.h>
#include <cstdio>
#include <cstdint>

#define LAS __attribute__((address_space(3)))
#define GAS __attribute__((address_space(1)))
typedef unsigned short bf16_t;
typedef short bf16x8 __attribute__((ext_vector_type(8)));
typedef float f32x2 __attribute__((ext_vector_type(2)));
typedef float f32x4 __attribute__((ext_vector_type(4)));
typedef float f32x16 __attribute__((ext_vector_type(16)));
typedef unsigned u32x2 __attribute__((ext_vector_type(2)));
typedef unsigned u32x4 __attribute__((ext_vector_type(4)));

constexpr int NB = 4, SEQ = 8192, NTOK = NB * SEQ, DM = 1024;
constexpr int NH = 8, HD = 64;
constexpr int INW = 3848;
constexpr int ZW = 3840;
constexpr int ZQ = 0, ZK = 512, ZV = 1024, ZOG = 1536, ZR = 2048;
constexpr int RW_R = 0, RW_K = 512, RW_V = 1024, RW_W = 1536, RW_A = 1600, RW_G = 1664, RWIN = 1792;
constexpr int NE = 32, TOPK = 4, EFF = 1024;
constexpr int MAXBLK = (NTOK * TOPK) / 256 + NE;
constexpr int PLE = 256;
constexpr float LOG2E = 1.4426950408889634f;
constexpr float QSCALE = 0.125f * LOG2E;

constexpr size_t MiB = 1u << 20;
constexpr size_t WS_CTL = 0, CTL_BYTES = 1 * MiB;
constexpr size_t WS_C2 = 1 * MiB;
constexpr size_t WS_LOGF = 2 * MiB;
constexpr size_t WS_ROUTE = 3 * MiB;
constexpr size_t WS_TOKSLOT = 5 * MiB;
constexpr size_t WS_GATESLOT = 9 * MiB;
constexpr size_t WS_CTOT = 13 * MiB;
constexpr size_t WS_WIN = 16 * MiB;
constexpr size_t WS_WOUT = 24 * MiB;
constexpr size_t WS_WPG = 26 * MiB;
constexpr size_t WS_WPP = 28 * MiB;
constexpr size_t WS_WGU = 32 * MiB;
constexpr size_t WS_WDN = 160 * MiB;
constexpr size_t WS_XN = 224 * MiB;
constexpr size_t WS_X1 = 290 * MiB;
constexpr size_t WS_Z = 418 * MiB;
constexpr size_t WS_AO = 658 * MiB;
constexpr size_t WS_ACT = 418 * MiB;
constexpr size_t WS_RW = 722 * MiB;
constexpr size_t WS_RR = WS_RW, WS_RK = WS_RW + 32 * MiB, WS_RV = WS_RW + 64 * MiB, WS_RG = WS_RW + 96 * MiB;
constexpr size_t WS_RLW = WS_RW + 128 * MiB;
constexpr size_t WS_RKK = WS_RW + 160 * MiB, WS_RKA = WS_RW + 192 * MiB;
constexpr size_t WS_YP = 722 * MiB;
constexpr size_t WS_END = 994 * MiB;
static_assert(WS_ACT + (size_t)MAXBLK * 256 * 1024 * 2 <= WS_RW && WS_YP + (size_t)MAXBLK * 256 * 1024 * 2 <= WS_END, "ws map");
constexpr size_t DO_PJ = 0, DO_PB = 64 * MiB;
constexpr int CW_TMO = 0, CW_CNT = 64  , CW_BAR = 4096;

struct Params {
    const float *x, *p, *mix_norm, *w_in, *f_bias, *q_norm, *k_norm, *mu, *w0, *w2, *a0, *a2, *g2, *k_k, *k_a, *r_k, *ln_w, *ln_b, *w_out, *moe_norm, *w_router, *b_router, *w_gu, *b_gu, *w_down,
        *b_down, *ple_norm, *w_pg, *w_pp, *final_norm;
    float* out; unsigned char* ws; int ph_lo, ph_hi;
};

typedef const __attribute__((address_space(4))) Params& KPR;
__device__ __forceinline__ const __attribute__((address_space(4))) Params* kp_fresh() {
    unsigned long long p = (unsigned long long)__builtin_amdgcn_kernarg_segment_ptr(); asm volatile("" : "+s"(p)); return (const __attribute__((address_space(4))) Params*)p; }

typedef __bf16 bf16x2_hw __attribute__((ext_vector_type(2)));
__device__ __forceinline__ unsigned pk2(float lo, float hi) { const f32x2 v = {lo, hi}; return __builtin_bit_cast(unsigned, __builtin_convertvector(v, bf16x2_hw)); }
__device__ __forceinline__ unsigned f2bf(float f) { return pk2(f, f) & 0xffffu; }
__device__ __forceinline__ float bf2f(unsigned h) { return __builtin_bit_cast(float, h << 16); }
__device__ __forceinline__ float bflo(unsigned w) { return __builtin_bit_cast(float, w << 16); }
__device__ __forceinline__ float bfhi(unsigned w) { return __builtin_bit_cast(float, w & 0xffff0000u); }
__device__ __forceinline__ unsigned cvt_pk_bf16(float lo, float hi) { unsigned r; asm volatile("v_cvt_pk_bf16_f32 %0, %1, %2" : "=v"(r) : "v"(lo), "v"(hi)); return r; }
__device__ __forceinline__ unsigned pk4_fp8(float a, float b, float c, float d) { int w = 0; w = __builtin_amdgcn_cvt_pk_fp8_f32(a, b, w, false); w = __builtin_amdgcn_cvt_pk_fp8_f32(c, d, w, true); return (unsigned)w; }
#define DPP_ADD(v, ctrl) ((v) + __builtin_bit_cast(float, __builtin_amdgcn_mov_dpp(__builtin_bit_cast(int, (v)), (ctrl), 0xF, 0xF, true)))
__device__ __forceinline__ float wave_sum(float v) {
    v = DPP_ADD(v, 0xB1);
    v = DPP_ADD(v, 0x4E);
    v = DPP_ADD(v, 0x124);
    v = DPP_ADD(v, 0x128);
    { float a = v, b = v; asm volatile("s_nop 1\n\tv_permlane16_swap_b32 %0, %1" : "+v"(a), "+v"(b)); v = a + b; }
    { float a = v, b = v; asm volatile("s_nop 1\n\tv_permlane32_swap_b32 %0, %1" : "+v"(a), "+v"(b)); v = a + b; }
    return v;
}
__device__ __forceinline__ float sigmoidf_(float x) { return __builtin_amdgcn_rcpf(1.0f + __expf(-x)); }
__device__ __forceinline__ float logsigmoidf_(float x) { return fminf(x, 0.f) - log1pf(expf(-fabsf(x))); }
namespace pg8 {
constexpr int BM = 256, BK = 64, HALF = 128, HTB = HALF * BK * 2, STAGE_BYTES = 8 * HTB, NXCD = 8, WGM = 8;
__host__ __device__ __forceinline__ int lds_byte(int r, int c) { const int st = (r >> 4) * 2 + (c >> 5), rr = r & 15, cc = c & 31, ob = rr * 64 + cc * 2; return st * 1024 + (ob ^ (((ob >> 9) & 1) << 5)); }
__host__ __device__ __forceinline__ void stage_rc(int b, int& R, int& C) { const int st = b / 1024, sb = b % 1024, swz = sb ^ (((sb >> 9) & 1) << 5); R = (st >> 1) * 16 + swz / 64; C = (st & 1) * 32 + (swz % 64) / 2; }
__host__ __device__ __forceinline__ int perm32(int rho) { const int n = rho >> 4, i = rho & 15; return 8 * (i >> 2) + 4 * n + (i & 3); }

struct Unit { int pm, pn, e, lb, sl; };

__device__ __forceinline__ bool tile_order(int i, int G, int c, int nM, int nN, int& pm, int& pn) {
    const int nwg = nM * nN; const long L = (long)i * G + c; if (L >= nwg) return false;
    int wgid = (int)L; { const int q = nwg / NXCD, r = nwg % NXCD, xcd = wgid % NXCD, off = wgid / NXCD; wgid = (xcd < r ? xcd * (q + 1) : r * (q + 1) + (xcd - r) * q) + off; }
    const int nig = WGM * nN, gid = wgid / nig, fm = gid * WGM, gsz = (nM - fm) < WGM ? (nM - fm) : WGM;
    pm = fm + ((wgid % nig) % gsz); pn = (wgid % nig) / gsz; return true;
}
struct DenseOrder {
    const void* A; const void* Bt; int K  , nM, nN, G, c;
    __device__ __forceinline__ bool next(int i, Unit& u) const { u.e = 0; u.lb = 0; return tile_order(i, G, c, nM, nN, u.pm, u.pn); }
    __device__ __forceinline__ const char* a_base(const Unit& u) const { return (const char*)A + (size_t)u.pm * BM * K * 2; }
    __device__ __forceinline__ const char* b_base(const Unit& u) const { return (const char*)Bt + (size_t)u.pn * BM * K * 2; }
    __device__ __forceinline__ void prefetch(const Unit&, int, int, int) const {}
    __device__ __forceinline__ void touch(const Unit&, int, LAS unsigned*) const {}
    __device__ __forceinline__ void a_off(const Unit&, const int (&R)[2], const int (&C)[2], unsigned (&off)[2][2]) const {
#pragma unroll
        for (int h = 0; h < 2; ++h)
#pragma unroll
            for (int i = 0; i < 2; ++i) off[h][i] = (unsigned)((R[i] + HALF * h) * K + C[i]) * 2u;
    }
};

typedef int v8i32 __attribute__((ext_vector_type(8)));
typedef int i32x4 __attribute__((ext_vector_type(4)));
template <class Epi, class Sched, bool ALIGN_EPI, bool FP8 = false>
__device__ __forceinline__ void gemm_phase(LAS unsigned char* lds, const int K, const Sched& S, const Epi& E) {
    int tid_ = threadIdx.x; asm volatile("" : "+v"(tid_));
    const int tid = tid_, wid = __builtin_amdgcn_readfirstlane(tid >> 6), lane = tid & 63, wr = wid >> 2, wc = wid & 3, fr = lane & 15, fq = lane >> 4;
    const int RB = FP8 ? K : 2 * K;
    const int nt = RB / (BK * 2);
    int sR[2], sC[2]; unsigned voffB[2];
#pragma unroll
    for (int i = 0; i < 2; ++i) { int R, C; stage_rc(tid * 16 + i * 8192, R, C); const int Rb = Epi::PERM ? ((R & ~31) + perm32(R & 31)) : R; sR[i] = R; sC[i] = C; voffB[i] = (unsigned)(Rb * RB + C * 2); }
    const size_t kstep = (size_t)(BK * 2);
    const size_t hstep = (size_t)HALF * RB;
    const unsigned ldsw = (unsigned)wid * 1024u;
    const int aoff0 = lds_byte(wr * 64 + fr, fq * 8), aoff1 = aoff0 + 1024;
    const int boff0 = lds_byte(wc * 32 + fr, fq * 8), boff1 = boff0 + 1024;
#define PG8_SA(b, h) (((b) * 2 + (h)) * HTB)
#define PG8_SB(b, h) ((4 + (b) * 2 + (h)) * HTB)
#define PG8_STAGE(bufoff, gbase, voff) do { _Pragma("unroll") for (int _i = 0; _i < 2; ++_i) \
        __builtin_amdgcn_global_load_lds((const unsigned*)((const char*)(gbase) + (voff)[_i]), (LAS unsigned*)(lds + (bufoff) + ldsw + _i * 8192), 16, 0, 0); } while (0)
#define PG8_CAT(p0, p1) __builtin_shufflevector((p0), (p1), 0, 1, 2, 3, 4, 5, 6, 7)
#define PG8_LDA(dst, b, h) do { _Pragma("unroll") for (int m = 0; m < 4; ++m) dst[m] = PG8_CAT(*(const LAS i32x4*)(lds + PG8_SA(b, h) + aoff0 + m * 2048), *(const LAS i32x4*)(lds + PG8_SA(b, h) + aoff1 + m * 2048)); } while (0)
#define PG8_LDB(dst, b, h) do { _Pragma("unroll") for (int n = 0; n < 2; ++n) dst[n] = PG8_CAT(*(const LAS i32x4*)(lds + PG8_SB(b, h) + boff0 + n * 2048), *(const LAS i32x4*)(lds + PG8_SB(b, h) + boff1 + n * 2048)); } while (0)
#define PG8_LO(x) __builtin_bit_cast(bf16x8, __builtin_shufflevector((x), (x), 0, 1, 2, 3))
#define PG8_HI(x) __builtin_bit_cast(bf16x8, __builtin_shufflevector((x), (x), 4, 5, 6, 7))
#define PG8_MMA(ai, bj, At, Bt) do { __builtin_amdgcn_s_setprio(1); \
        if constexpr (FP8) { _Pragma("unroll") for (int m = 0; m < 4; ++m) _Pragma("unroll") for (int n = 0; n < 2; ++n) \
            asm volatile("v_mfma_scale_f32_16x16x128_f8f6f4 %0, %1, %2, %0, %3, %4 op_sel_hi:[0,0,0]" : "+v"(acc[ai][bj][m][n]) : "v"(Bt[n]), "v"(At[m]), "v"(sc_w), "v"(sc_x)); } \
        else { _Pragma("unroll") for (int m = 0; m < 4; ++m) _Pragma("unroll") for (int n = 0; n < 2; ++n) { \
            acc[ai][bj][m][n] = __builtin_amdgcn_mfma_f32_16x16x32_bf16(PG8_LO(Bt[n]), PG8_LO(At[m]), acc[ai][bj][m][n], 0, 0, 0); } \
            _Pragma("unroll") for (int m = 0; m < 4; ++m) _Pragma("unroll") for (int n = 0; n < 2; ++n) { \
            acc[ai][bj][m][n] = __builtin_amdgcn_mfma_f32_16x16x32_bf16(PG8_HI(Bt[n]), PG8_HI(At[m]), acc[ai][bj][m][n], 0, 0, 0); } } \
        __builtin_amdgcn_s_setprio(0); } while (0)
#define PG8_WAIT_V(n) asm volatile("s_waitcnt vmcnt(" #n ")" ::: "memory")
#define PG8_WAIT_L(n) asm volatile("s_waitcnt lgkmcnt(" #n ")" ::: "memory")
#define PG8_BAR __builtin_amdgcn_s_barrier()
#define PG8_SCHED __builtin_amdgcn_sched_barrier(0)
    Unit cur, nxt; int ui = 0;
    if (!S.next(0, cur)) return;
    f32x4 acc[2][2][4][2];
#pragma unroll
    for (int a = 0; a < 2; ++a)
#pragma unroll
        for (int b = 0; b < 2; ++b)
#pragma unroll
            for (int m = 0; m < 4; ++m)
#pragma unroll
                for (int n = 0; n < 2; ++n) acc[a][b][m][n] = (f32x4){0.f, 0.f, 0.f, 0.f};
    const int sc_w = 121, sc_x = 127;
    v8i32 At[4], B0[2], B1[2];
    unsigned offC[2][2], offN[2][2];
    cur.sl = 0; S.prefetch(cur, 0, wid, lane); PG8_WAIT_V(0); PG8_BAR;
    S.a_off(cur, sR, sC, offC);
    const char* cA = S.a_base(cur); const char* cB = S.b_base(cur);
    PG8_STAGE(PG8_SB(0, 0), cB, voffB); PG8_STAGE(PG8_SB(0, 1), cB + hstep, voffB); PG8_STAGE(PG8_SA(0, 0), cA, offC[0]); PG8_STAGE(PG8_SA(0, 1), cA, offC[1]);
    if (wr == 1) PG8_BAR;
    PG8_WAIT_V(2); PG8_BAR;
    PG8_STAGE(PG8_SB(1, 0), cB + kstep, voffB); PG8_STAGE(PG8_SA(1, 0), cA + kstep, offC[0]); PG8_STAGE(PG8_SB(1, 1), cB + hstep + kstep, voffB);
    PG8_WAIT_V(6); PG8_BAR;
    for (;;) {
        const bool has_next = S.next(ui + 1, nxt);
        const char* nA = cA; const char* nB = cB;
        nxt.sl = cur.sl == 2 ? 0 : cur.sl + 1;
        if (has_next) { nA = S.a_base(nxt); nB = S.b_base(nxt); S.prefetch(nxt, nxt.sl, wid, lane); }
#pragma unroll
        for (int h = 0; h < 2; ++h)
#pragma unroll
            for (int i = 0; i < 2; ++i) offN[h][i] = offC[h][i];
#pragma nounroll
        for (int t = 0; t < nt; t += 2) {
            const bool last = (t == nt - 2);
            if (last && has_next) S.a_off(nxt, sR, sC, offN);
            const char* a1 = cA + (size_t)(t + 1) * kstep;
            const char* a2 = last ? nA : cA + (size_t)(t + 2) * kstep; const char* b2 = last ? nB : cB + (size_t)(t + 2) * kstep;
            const char* a3 = a2 + kstep; const char* b3 = b2 + kstep;
            unsigned o2[2][2];
#pragma unroll
            for (int h = 0; h < 2; ++h)
#pragma unroll
                for (int i = 0; i < 2; ++i) o2[h][i] = last ? offN[h][i] : offC[h][i];
            PG8_LDB(B0, 0, 0); PG8_LDB(B1, 0, 1); PG8_SCHED; PG8_LDA(At, 0, 0); PG8_STAGE(PG8_SA(1, 1), a1, offC[1]);
            PG8_WAIT_V(8); PG8_WAIT_L(0); PG8_BAR; PG8_MMA(0, 0, At, B0); PG8_MMA(0, 1, At, B1); PG8_BAR; PG8_SCHED;
            PG8_LDA(At, 0, 1); PG8_STAGE(PG8_SB(0, 0), b2, voffB); PG8_STAGE(PG8_SB(0, 1), b2 + hstep, voffB); PG8_STAGE(PG8_SA(0, 0), a2, o2[0]);
            PG8_WAIT_V(8); PG8_WAIT_L(0); PG8_BAR; PG8_MMA(1, 0, At, B0); PG8_MMA(1, 1, At, B1); PG8_BAR; PG8_SCHED;
            PG8_LDB(B0, 1, 0); PG8_LDB(B1, 1, 1); PG8_SCHED; PG8_LDA(At, 1, 0); PG8_STAGE(PG8_SA(0, 1), a2, o2[1]);
            PG8_WAIT_V(8); PG8_WAIT_L(0); PG8_BAR; PG8_MMA(0, 0, At, B0); PG8_MMA(0, 1, At, B1); PG8_BAR; PG8_SCHED;
            PG8_LDA(At, 1, 1); PG8_STAGE(PG8_SB(1, 0), b3, voffB); PG8_STAGE(PG8_SB(1, 1), b3 + hstep, voffB); PG8_STAGE(PG8_SA(1, 0), a3, o2[0]);
            PG8_WAIT_V(8); PG8_WAIT_L(0); PG8_BAR; PG8_MMA(1, 0, At, B0); PG8_MMA(1, 1, At, B1); PG8_BAR; PG8_SCHED;
        }
        if (has_next) S.touch(nxt, tid, (LAS unsigned*)(lds + STAGE_BYTES + 12288 + wid * 256));
        if constexpr (ALIGN_EPI) { if (wr == 0) PG8_BAR; }
        E(acc, cur, wr, wc, fr, fq);
        if (!has_next) break;
#pragma unroll
        for (int a = 0; a < 2; ++a)
#pragma unroll
            for (int b = 0; b < 2; ++b)
#pragma unroll
                for (int m = 0; m < 4; ++m)
#pragma unroll
                    for (int n = 0; n < 2; ++n) acc[a][b][m][n] = (f32x4){0.f, 0.f, 0.f, 0.f};
        cur = nxt; cA = nA; cB = nB; ++ui;
#pragma unroll
        for (int h = 0; h < 2; ++h)
#pragma unroll
            for (int i = 0; i < 2; ++i) offC[h][i] = offN[h][i];
        if constexpr (ALIGN_EPI) { if (wr == 1) PG8_BAR; }
    }
    PG8_WAIT_V(0);
    if constexpr (!ALIGN_EPI) { if (wr == 0) PG8_BAR; }
    PG8_BAR;
#undef PG8_SA
#undef PG8_SB
#undef PG8_STAGE
#undef PG8_LDA
#undef PG8_LDB
#undef PG8_MMA
#undef PG8_LO
#undef PG8_HI
#undef PG8_CAT
#undef PG8_WAIT_V
#undef PG8_WAIT_L
#undef PG8_BAR
#undef PG8_SCHED
}
}
namespace pg8 {
constexpr int T_BLKSTART = 0  , T_CNT = 40  , T_BLKE = 80  , T_WORDS = 80 + 560;
constexpr int TB_OFF = 8192 - 64;

struct EpiIn {
    static constexpr bool PERM = true;
    bf16_t* Z; const float* qn; const float* kn;
    __device__ __forceinline__ void operator()(const f32x4 (&acc)[2][2][4][2], const Unit& u, int wr, int wc, int fr, int fq) const {
        const int row0 = u.pm * BM + wr * 64 + fr;
        if (u.pn < 4) {
            const float* g = (u.pn < 2) ? qn : kn; const float sc = (u.pn < 2) ? QSCALE : 1.0f;
            f32x4 gv[2][2];
#pragma unroll
            for (int bj = 0; bj < 2; ++bj)
#pragma unroll
                for (int n = 0; n < 2; ++n) gv[bj][n] = *(const f32x4*)(g + 32 * bj + 8 * fq + 4 * n) * sc;
#pragma unroll
            for (int ai = 0; ai < 2; ++ai)
#pragma unroll
                for (int m = 0; m < 4; ++m) {
                    float ss = 0.f;
#pragma unroll
                    for (int bj = 0; bj < 2; ++bj)
#pragma unroll
                        for (int n = 0; n < 2; ++n) { const f32x4 x = acc[ai][bj][m][n]; ss += (x[0] * x[0] + x[1] * x[1]) + (x[2] * x[2] + x[3] * x[3]); }
                    ss += __shfl_xor(ss, 16); ss += __shfl_xor(ss, 32);
                    const float rstd = rsqrtf(ss * (1.0f / 64.0f) + 1e-6f);
                    bf16_t* rowp = Z + (size_t)(row0 + ai * HALF + m * 16) * ZW + u.pn * BM + 64 * wc + 8 * fq;
#pragma unroll
                    for (int bj = 0; bj < 2; ++bj) { const f32x4 v0 = acc[ai][bj][m][0] * rstd * gv[bj][0], v1 = acc[ai][bj][m][1] * rstd * gv[bj][1];
                        u32x4 w; w.x = cvt_pk_bf16(v0[0], v0[1]); w.y = cvt_pk_bf16(v0[2], v0[3]); w.z = cvt_pk_bf16(v1[0], v1[1]); w.w = cvt_pk_bf16(v1[2], v1[3]);
                        *(u32x4*)(rowp + 32 * bj) = w; }
                }
        } else {
            const int col0 = u.pn * BM + wc * 32 + 8 * fq;
#pragma unroll
            for (int ai = 0; ai < 2; ++ai)
#pragma unroll
                for (int m = 0; m < 4; ++m) { bf16_t* rowp = Z + (size_t)(row0 + ai * HALF + m * 16) * ZW + col0;
#pragma unroll
                    for (int bj = 0; bj < 2; ++bj) { const f32x4 v0 = acc[ai][bj][m][0], v1 = acc[ai][bj][m][1];
                        u32x4 w; w.x = cvt_pk_bf16(v0[0], v0[1]); w.y = cvt_pk_bf16(v0[2], v0[3]); w.z = cvt_pk_bf16(v1[0], v1[1]); w.w = cvt_pk_bf16(v1[2], v1[3]);
                        *(u32x4*)(rowp + bj * HALF) = w; } }
        }
    }
};
struct EpiBf16 {
    static constexpr bool PERM = true;
    bf16_t* O; int ldc;
    __device__ __forceinline__ void operator()(const f32x4 (&acc)[2][2][4][2], const Unit& u, int wr, int wc, int fr, int fq) const {
        const int row0 = u.pm * BM + wr * 64 + fr, col0 = u.pn * BM + wc * 32 + 8 * fq;
#pragma unroll
        for (int ai = 0; ai < 2; ++ai)
#pragma unroll
            for (int m = 0; m < 4; ++m) { bf16_t* rowp = O + (size_t)(row0 + ai * HALF + m * 16) * ldc + col0;
#pragma unroll
                for (int bj = 0; bj < 2; ++bj) { const f32x4 v0 = acc[ai][bj][m][0], v1 = acc[ai][bj][m][1];
                    u32x4 w; w.x = cvt_pk_bf16(v0[0], v0[1]); w.y = cvt_pk_bf16(v0[2], v0[3]); w.z = cvt_pk_bf16(v1[0], v1[1]); w.w = cvt_pk_bf16(v1[2], v1[3]);
                    *(u32x4*)(rowp + bj * HALF) = w; } }
    }
};
struct EpiOut {
    static constexpr bool PERM = true;
    const float* X; bf16_t* O;
    __device__ __forceinline__ void operator()(const f32x4 (&acc)[2][2][4][2], const Unit& u, int wr, int wc, int fr, int fq) const {
        const int row0 = u.pm * BM + wr * 64 + fr, col0 = u.pn * BM + wc * 32 + 8 * fq;
#pragma unroll
        for (int ai = 0; ai < 2; ++ai)
#pragma unroll
            for (int m = 0; m < 4; ++m) { const size_t off = (size_t)(row0 + ai * HALF + m * 16) * DM + col0;
#pragma unroll
                for (int bj = 0; bj < 2; ++bj) { const f32x4 v0 = *(const f32x4*)(X + off + bj * HALF) + acc[ai][bj][m][0], v1 = *(const f32x4*)(X + off + bj * HALF + 4) + acc[ai][bj][m][1];
                    u32x4 w; w.x = pk2(v0[0], v0[1]); w.y = pk2(v0[2], v0[3]); w.z = pk2(v1[0], v1[1]); w.w = pk2(v1[2], v1[3]);
                    *(u32x4*)(O + off + bj * HALF) = w; }
                if (m & 1) asm volatile("" ::: "memory"); }
    }
};
struct EpiPg {
    static constexpr bool PERM = true;
    bf16_t* X; const bf16_t* PJ;
    __device__ __forceinline__ void operator()(const f32x4 (&acc)[2][2][4][2], const Unit& u, int wr, int wc, int fr, int fq) const {
        const int row0 = u.pm * BM + wr * 64 + fr, col0 = u.pn * BM + wc * 32 + 8 * fq;
#pragma unroll
        for (int ai = 0; ai < 2; ++ai)
#pragma unroll
            for (int m = 0; m < 4; ++m) { const size_t off = (size_t)(row0 + ai * HALF + m * 16) * DM + col0;
#pragma unroll
                for (int bj = 0; bj < 2; ++bj) { const size_t o = off + bj * HALF; const u32x4 pj = *(const u32x4*)(PJ + o), xv = *(const u32x4*)(X + o);
                    const unsigned pw[4] = {pj.x, pj.y, pj.z, pj.w}, xw[4] = {xv.x, xv.y, xv.z, xv.w}; unsigned ow[4];
#pragma unroll
                    for (int q = 0; q < 4; ++q) { const float a0 = acc[ai][bj][m][q >> 1][2 * (q & 1)], a1 = acc[ai][bj][m][q >> 1][2 * (q & 1) + 1];
                        ow[q] = pk2(bflo(xw[q]) + sigmoidf_(a0) * bflo(pw[q]), bfhi(xw[q]) + sigmoidf_(a1) * bfhi(pw[q])); }
                    *(u32x4*)(X + o) = (u32x4){ow[0], ow[1], ow[2], ow[3]}; }
                if (m & 1) asm volatile("" ::: "memory"); }
    }
};
struct EpiGu {
    static constexpr bool PERM = true;
    unsigned char* ACT; const float* b_gu;
    __device__ __forceinline__ void operator()(const f32x4 (&acc)[2][2][4][2], const Unit& u, int wr, int wc, int fr, int fq) const {
        const int row0 = u.pm * BM + wr * 64 + fr, cl = u.pn * HALF + wc * 32 + 8 * fq;
        const float* bg = b_gu + (size_t)u.e * 2048 + cl;
        f32x4 bgl[2], bli[2];
#pragma unroll
        for (int n = 0; n < 2; ++n) { bgl[n] = *(const f32x4*)(bg + 4 * n); bli[n] = *(const f32x4*)(bg + 1024 + 4 * n) + 1.0f; }
#pragma unroll
        for (int ai = 0; ai < 2; ++ai)
#pragma unroll
            for (int m = 0; m < 4; ++m) { unsigned char* rowp = ACT + (size_t)(row0 + ai * HALF + m * 16) * EFF + cl; f32x4 r[2];
#pragma unroll
                for (int n = 0; n < 2; ++n) {
                    f32x4 g = acc[ai][0][m][n] + bgl[n], u = acc[ai][1][m][n] + bli[n];
#pragma unroll
                    for (int i = 0; i < 4; ++i) { g[i] = fminf(g[i], 7.0f); u[i] = __builtin_amdgcn_fmed3f(u[i], -6.0f, 8.0f); }
                    f32x4 d = g * (-1.702f * LOG2E);
#pragma unroll
                    for (int i = 0; i < 4; ++i) d[i] = __builtin_amdgcn_exp2f(d[i]);
                    d = d + 1.0f;
#pragma unroll
                    for (int i = 0; i < 4; ++i) d[i] = __builtin_amdgcn_rcpf(d[i]);
                    r[n] = (g * d) * u; }
                u32x2 w; w.x = pk4_fp8(r[0][0], r[0][1], r[0][2], r[0][3]); w.y = pk4_fp8(r[1][0], r[1][1], r[1][2], r[1][3]);
                *(u32x2*)rowp = w; }
    }
};
struct EpiDn {
    static constexpr bool PERM = true;
    unsigned char* YP; const float* b_dn; const float* gateslot; const LAS int* tab;
    __device__ __forceinline__ void operator()(const f32x4 (&acc)[2][2][4][2], const Unit& u, int wr, int wc, int fr, int fq) const {
        const int row0 = u.pm * BM + wr * 64 + fr, col0 = u.pn * BM + wc * 32 + 8 * fq;
        const float* bd = b_dn + (size_t)u.e * 1024 + col0; const int cnt = tab[T_CNT + u.e];
        f32x4 bv[2][2];
#pragma unroll
        for (int bj = 0; bj < 2; ++bj)
#pragma unroll
            for (int n = 0; n < 2; ++n) bv[bj][n] = *(const f32x4*)(bd + bj * HALF + 4 * n);
#pragma unroll
        for (int ai = 0; ai < 2; ++ai)
#pragma unroll
            for (int m = 0; m < 4; ++m) { const int rr = wr * 64 + fr + ai * HALF + m * 16, slot = u.lb * 256 + rr;
                const float gt = slot < cnt ? ((const LAS float*)((const LAS unsigned char*)tab + TB_OFF + u.sl * 1024))[rr] * 4.0f : 0.f;
                unsigned char* rowp = YP + (size_t)(row0 + ai * HALF + m * 16) * DM + col0;
#pragma unroll
                for (int bj = 0; bj < 2; ++bj) { const f32x4 v0 = (acc[ai][bj][m][0] + bv[bj][0]) * gt, v1 = (acc[ai][bj][m][1] + bv[bj][1]) * gt;
                    u32x2 w; w.x = pk4_fp8(v0[0], v0[1], v0[2], v0[3]); w.y = pk4_fp8(v1[0], v1[1], v1[2], v1[3]);
                    *(u32x2*)(rowp + bj * HALF) = w; } }
    }
};
struct MoeOrder {
    const unsigned char* A; const unsigned char* Bt; const int* tokslot; const float* gateslot;   const LAS int* tab; int nblk, nN, G, c; bool gather;
    __device__ __forceinline__ bool next(int i, Unit& u) const { if (!tile_order(i, G, c, nblk, nN, u.pm, u.pn)) return false; u.e = tab[T_BLKE + u.pm]; u.lb = u.pm - tab[T_BLKSTART + u.e]; return true; }
    __device__ __forceinline__ const char* a_base(const Unit& u) const { return gather ? (const char*)A : (const char*)A + (size_t)u.pm * BM * 1024; }
    __device__ __forceinline__ const char* b_base(const Unit& u) const { return (const char*)Bt + ((size_t)u.e * nN + u.pn) * BM * 1024; }
    __device__ __forceinline__ void prefetch(const Unit& u, int slot, int wid, int lane) const {
        if (wid < 4) { const unsigned* src = (gather ? (const unsigned*)tokslot : (const unsigned*)gateslot) + (size_t)u.e * NTOK + u.lb * 256 + wid * 64 + lane;
            __builtin_amdgcn_global_load_lds(src, (LAS unsigned*)((LAS unsigned char*)tab + TB_OFF + slot * 1024 + wid * 256), 4, 0, 0); }
    }
    __device__ __forceinline__ void touch(const Unit& u, int tid, LAS unsigned* dummy) const {
        const int row = tid >> 1, l0 = 2 + 3 * (tid & 1); size_t base;
        if (gather) { const int cnt = tab[T_CNT + u.e]; const LAS int* tb = (const LAS int*)((const LAS unsigned char*)tab + TB_OFF + u.sl * 1024); const int tk = tb[row];
            base = (size_t)((u.lb * 256 + row) < cnt ? tk : NTOK) * 1024; }
        else base = ((size_t)u.pm * BM + row) * 1024;
        const unsigned char* p = A + base + l0 * 128;
#pragma unroll
        for (int j = 0; j < 3; ++j) __builtin_amdgcn_global_load_lds((const unsigned*)(p + 128 * j), dummy, 4, 0, 0);
    }
    __device__ __forceinline__ void a_off(const Unit& u, const int (&R)[2], const int (&C)[2], unsigned (&off)[2][2]) const {
        const int cnt = tab[T_CNT + u.e]; const LAS int* tb = (const LAS int*)((const LAS unsigned char*)tab + TB_OFF + u.sl * 1024);
#pragma unroll
        for (int h = 0; h < 2; ++h)
#pragma unroll
            for (int i = 0; i < 2; ++i) {
                if (gather) { const int rr = R[i] + HALF * h; const int tk = tb[rr]; const int tok = (u.lb * 256 + rr) < cnt ? tk : NTOK; off[h][i] = (unsigned)tok * 1024u + (unsigned)C[i] * 2u; }
                else off[h][i] = (unsigned)((R[i] + HALF * h) * 1024 + C[i] * 2);
            }
    }
};
__device__ __forceinline__ int moe_tables(LAS int* tab, const unsigned* cntw) {
    if (threadIdx.x < 64) { const int e = threadIdx.x & 31; const int c = (int)cntw[e]; const int nb = (c + 255) >> 8; int incl = nb;
#pragma unroll
        for (int o = 1; o < 32; o <<= 1) { const int t = __shfl_up(incl, o, 32); if (e >= o) incl += t; }
        const int start = incl - nb;
        if (threadIdx.x < 32) { tab[T_CNT + e] = c; tab[T_BLKSTART + e] = start; if (e == NE - 1) tab[T_BLKSTART + NE] = incl;
            for (int j = 0; j < nb; ++j) tab[T_BLKE + start + j] = e; } }
    __syncthreads();
    return tab[T_BLKSTART + NE];
}
}
constexpr int NWAVES = 8, NTHREADS = 512;
constexpr int RING_BYTES = 131072, MISC_OFF = RING_BYTES, LDS_BYTES = 147456;

__device__ __forceinline__ void tr_item(const float* W, int ldw, int srccol0, int k0, bf16_t* WT, int Kd, int dstrow0, LAS float* scr, int lane) {
#pragma unroll 8
    for (int i = 0; i < 32; ++i) { const int kk = 2 * i + (lane >> 5); scr[kk * 33 + (lane & 31)] = W[(size_t)(k0 + kk) * ldw + srccol0 + (lane & 31)]; }
    asm volatile("s_waitcnt lgkmcnt(0)" ::: "memory");
    const int c = lane & 7;
#pragma unroll
    for (int j = 0; j < 4; ++j) { const int n = (lane >> 3) + 8 * j; const LAS float* s = scr + (8 * c) * 33 + n;
        u32x4 o; o.x = pk2(s[0 * 33], s[1 * 33]); o.y = pk2(s[2 * 33], s[3 * 33]); o.z = pk2(s[4 * 33], s[5 * 33]); o.w = pk2(s[6 * 33], s[7 * 33]);
        *(u32x4*)(WT + (size_t)(dstrow0 + n) * Kd + k0 + 8 * c) = o; }
    asm volatile("s_waitcnt lgkmcnt(0)" ::: "memory");
}
__device__ __forceinline__ void tr_item8(const float* W, int ldw, int srccol0, int k0, unsigned char* WT, int Kd, int dstrow0, LAS float* scr, int lane) {
    f32x4 v[8]; const int r8 = lane >> 3, c4 = lane & 7;
#pragma unroll
    for (int i = 0; i < 8; ++i) v[i] = *(const f32x4*)(W + (size_t)(k0 + 8 * i + r8) * ldw + srccol0 + 4 * c4);
#pragma unroll
    for (int i = 0; i < 8; ++i) { LAS float* d = scr + (8 * i + r8) * 33 + 4 * c4; d[0] = v[i][0]; d[1] = v[i][1]; d[2] = v[i][2]; d[3] = v[i][3]; }
    asm volatile("s_waitcnt lgkmcnt(0)" ::: "memory");
    const int c = lane & 7;
#pragma unroll
    for (int j = 0; j < 4; ++j) { const int n = (lane >> 3) + 8 * j; const LAS float* s = scr + (8 * c) * 33 + n;
        u32x2 o; o.x = pk4_fp8(s[0 * 33] * 64.f, s[1 * 33] * 64.f, s[2 * 33] * 64.f, s[3 * 33] * 64.f); o.y = pk4_fp8(s[4 * 33] * 64.f, s[5 * 33] * 64.f, s[6 * 33] * 64.f, s[7 * 33] * 64.f);
        *(u32x2*)(WT + (size_t)(dstrow0 + n) * Kd + k0 + 8 * c) = o; }
    asm volatile("s_waitcnt lgkmcnt(0)" ::: "memory");
}
constexpr int I_IN = 16 * 120, I_OUT = 16 * 32, I_PG = 16 * 32, I_PP = 4 * 32, I_GU1 = 16 * 64, I_DN1 = 16 * 32;
constexpr int I_LORA = 16 + 16 + 32;
constexpr int I_SMALL = I_IN + I_OUT + I_PG + I_PP + I_LORA, I_GU = NE * I_GU1, I_DN = NE * I_DN1, I_ALL = I_SMALL + I_GU + I_DN;
__device__ __forceinline__ void prep_item(KPR P, int it, LAS float* scr, int lane) {
    unsigned char* ws = P.ws;
    if (it < I_IN) { const int kb = it / 120, nb = it % 120, n0 = nb * 32, pn = n0 >> 8, j0 = n0 & 255;
        const int src = pn < 4 ? (pn * 256 + 64 * ((j0 & 127) >> 5) + 32 * (j0 >> 7)) : (n0 < 2048 ? n0 : n0 + 8);
        tr_item(P.w_in, INW, src, kb * 64, (bf16_t*)(ws + WS_WIN), 1024, n0, scr, lane); return; }
    it -= I_IN;
    if (it < I_OUT) { tr_item(P.w_out, 1024, (it % 32) * 32, (it / 32) * 64, (bf16_t*)(ws + WS_WOUT), 1024, (it % 32) * 32, scr, lane); return; }
    it -= I_OUT;
    if (it < I_PG) { tr_item8(P.w_pg, 1024, (it % 32) * 32, (it / 32) * 64, ws + WS_WPG, 1024, (it % 32) * 32, scr, lane); return; }
    it -= I_PG;
    if (it < I_PP) { tr_item(P.w_pp, 1024, (it % 32) * 32, (it / 32) * 64, (bf16_t*)(ws + WS_WPP), 256, (it % 32) * 32, scr, lane); return; }
    it -= I_PP;
    if (it < 16) { tr_item(P.w2, 512, it * 32, 0, (bf16_t*)(ws + 29 * MiB), 64, it * 32, scr, lane); return; }
    it -= 16;
    if (it < 16) { tr_item(P.a2, 512, it * 32, 0, (bf16_t*)(ws + 29 * MiB + 65536), 64, it * 32, scr, lane); return; }
    it -= 16;
    if (it < 32) { tr_item(P.g2, 512, (it % 16) * 32, (it / 16) * 64, (bf16_t*)(ws + 29 * MiB + 131072), 128, (it % 16) * 32, scr, lane); return; }
    it -= 32;
    if (it < I_GU) { const int e = it / I_GU1, r = it % I_GU1, kb = r / 64, nb = r % 64, n0 = nb * 32, pn = n0 >> 8, j0 = n0 & 255;
        const int src = (j0 >> 7) * 1024 + pn * 128 + (j0 & 127);
        tr_item8(P.w_gu + (size_t)e * 1024 * 2048, 2048, src, kb * 64, ws + WS_WGU + (size_t)e * 2048 * 1024, 1024, n0, scr, lane); return; }
    it -= I_GU;
    { const int e = it / I_DN1, r = it % I_DN1, kb = r / 32, nb = r % 32;
        tr_item8(P.w_down + (size_t)e * 1024 * 1024, 1024, nb * 32, kb * 64, ws + WS_WDN + (size_t)e * 1024 * 1024, 1024, nb * 32, scr, lane); }
}
__device__ __forceinline__ void phase_prep_weights(KPR P, LAS unsigned char* lds, int gw, int ngw, int wave, int lane) {
    LAS float* scr = (LAS float*)(lds + wave * 16384);
    for (int it = gw; it < I_SMALL; it += ngw) prep_item(P, it, scr, lane);
}
constexpr int NCVT = I_DN / 64, CVT_TASK0 = I_GU / 64;
__device__ __forceinline__ void cvt_task(KPR P, LAS unsigned char* lds, int task, int wave, int lane) {
    LAS float* scr = (LAS float*)(lds + wave * 16384);
    for (int i = 0; i < 8; ++i) prep_item(P, I_SMALL + task * 64 + i * 8 + wave, scr, lane);
}
__device__ __forceinline__ const float* gu_item_src(KPR P, int it) {
    const int e = it / I_GU1, r = it % I_GU1, kb = r / 64, nb = r % 64, n0 = nb * 32, pn = n0 >> 8, j0 = n0 & 255;
    return P.w_gu + (size_t)e * 1024 * 2048 + (size_t)(kb * 64) * 2048 + (j0 >> 7) * 1024 + pn * 128 + (j0 & 127);
}
__device__ __forceinline__ void gu_half(KPR P, int it, int h, int lane, LAS float* scr, const f32x4& v0, const f32x4& v1, const f32x4& v2, const f32x4& v3) {
    const int e = it / I_GU1, r = it % I_GU1, kb = r / 64, nb = r % 64;
    unsigned char* dst = P.ws + WS_WGU + (size_t)e * 2048 * 1024 + (size_t)(nb * 32) * 1024 + kb * 64 + 32 * h;
    const int r8 = lane >> 3, c4 = lane & 7, n = lane & 31, kg = lane >> 5;
    { LAS f32x4* d = (LAS f32x4*)(scr + r8 * 36 + 4 * c4); d[0] = v0; d[8 * 9] = v1; d[16 * 9] = v2; d[24 * 9] = v3; }
    asm volatile("s_waitcnt lgkmcnt(0)" ::: "memory");
#pragma unroll
    for (int q = 0; q < 2; ++q) { const LAS float* s = scr + (16 * q + 8 * kg) * 36 + n;
        u32x2 o; o.x = pk4_fp8(s[0 * 36] * 64.f, s[1 * 36] * 64.f, s[2 * 36] * 64.f, s[3 * 36] * 64.f); o.y = pk4_fp8(s[4 * 36] * 64.f, s[5 * 36] * 64.f, s[6 * 36] * 64.f, s[7 * 36] * 64.f);
        *(u32x2*)(dst + (size_t)n * 1024 + 16 * q + 8 * kg) = o; }
    asm volatile("s_waitcnt lgkmcnt(0)" ::: "memory");
}
__device__ __forceinline__ void phase_cvt_p(KPR P, int gt, int ngt) {
    bf16_t* PB = (bf16_t*)((unsigned char*)P.out + DO_PB);
    for (int i = gt; i < NTOK * PLE / 8; i += ngt) { const f32x4 a = ((const f32x4*)P.p)[2 * i], b = ((const f32x4*)P.p)[2 * i + 1];
        u32x4 w; w.x = pk2(a[0], a[1]); w.y = pk2(a[2], a[3]); w.z = pk2(b[0], b[1]); w.w = pk2(b[2], b[3]); ((u32x4*)PB)[i] = w; }
}
__device__ __forceinline__ void rms_row(const float* xrow, const float* gain, int lane, f32x4 (&v)[4]) {
    const f32x4* xr = (const f32x4*)xrow + lane; float s = 0.f;
#pragma unroll
    for (int j = 0; j < 4; ++j) { v[j] = xr[64 * j]; s += (v[j][0] * v[j][0] + v[j][1] * v[j][1]) + (v[j][2] * v[j][2] + v[j][3] * v[j][3]); }
    const float rstd = rsqrtf(wave_sum(s) * (1.f / DM) + 1e-6f);
#pragma unroll
    for (int j = 0; j < 4; ++j) v[j] = v[j] * rstd * ((const f32x4*)gain)[64 * j + lane];
}
__device__ __forceinline__ void store_row_fp8(unsigned char* orow, int lane, const f32x4 (&v)[4]) {
    unsigned* o4 = (unsigned*)orow + lane;
#pragma unroll
    for (int j = 0; j < 4; ++j) o4[64 * j] = pk4_fp8(v[j][0], v[j][1], v[j][2], v[j][3]);
}
__device__ __forceinline__ void store_row_bf16(bf16_t* orow, int lane, const f32x4 (&v)[4]) {
    u32x2* o8 = (u32x2*)orow + lane;
#pragma unroll
    for (int j = 0; j < 4; ++j) { u32x2 w; w.x = pk2(v[j][0], v[j][1]); w.y = pk2(v[j][2], v[j][3]); o8[64 * j] = w; }
}
__device__ __forceinline__ void norm1_row(KPR P, int row, int lane, const LAS float* wff, LAS float* lf_out  ) {
    f32x4 v[4]; rms_row(P.x + (size_t)row * DM, P.mix_norm, lane, v);
    store_row_bf16((bf16_t*)(P.ws + WS_XN) + (size_t)row * DM, lane, v);
    float ff[8];
#pragma unroll
    for (int q = 0; q < 8; ++q) { float s = 0.f;
#pragma unroll
        for (int j = 0; j < 4; ++j) { const f32x4 w = *(const LAS f32x4*)(wff + q * 1024 + 4 * (64 * j + lane)); s += (v[j][0] * w[0] + v[j][1] * w[1]) + (v[j][2] * w[2] + v[j][3] * w[3]); }
        ff[q] = s; }
    float g4[4], g2[2], g1;
    { const bool up = lane & 32;
#pragma unroll
        for (int q = 0; q < 4; ++q) { const float keep = up ? ff[4 + q] : ff[q], give = up ? ff[q] : ff[4 + q]; g4[q] = keep + __shfl_xor(give, 32); } }
    { const bool up = lane & 16;
#pragma unroll
        for (int q = 0; q < 2; ++q) { const float keep = up ? g4[2 + q] : g4[q], give = up ? g4[q] : g4[2 + q]; g2[q] = keep + __shfl_xor(give, 16); } }
    { const bool up = lane & 8; const float keep = up ? g2[1] : g2[0], give = up ? g2[0] : g2[1]; g1 = keep + __shfl_xor(give, 8); }
    g1 += __shfl_xor(g1, 4); g1 += __shfl_xor(g1, 2); g1 += __shfl_xor(g1, 1);
    if ((lane & 7) == 0) { const int q = lane >> 3; lf_out[q] = logsigmoidf_(g1 + P.f_bias[q]); }
}
__device__ __forceinline__ void load_wff(KPR P, LAS float* wff, int tid, int nthr) {
    float t[16];
#pragma unroll
    for (int u = 0; u < 16; ++u) { const int i = tid + u * NTHREADS; t[u] = P.w_in[(size_t)(i >> 3) * INW + 2048 + (i & 7)]; }
#pragma unroll
    for (int u = 0; u < 16; ++u) { const int i = tid + u * NTHREADS; wff[(i & 7) * 1024 + (i >> 3)] = t[u]; }
    (void)nthr;
}
__device__ __forceinline__ void final_row(KPR P, int row, int lane, bool dead) {
    const u32x2* xr = (const u32x2*)((const bf16_t*)(P.ws + WS_X1) + (size_t)row * DM) + lane; f32x4 v[4]; float s = 0.f;
#pragma unroll
    for (int j = 0; j < 4; ++j) { const u32x2 xv = xr[64 * j]; v[j] = (f32x4){bflo(xv.x), bfhi(xv.x), bflo(xv.y), bfhi(xv.y)}; s += (v[j][0] * v[j][0] + v[j][1] * v[j][1]) + (v[j][2] * v[j][2] + v[j][3] * v[j][3]); }
    const float rstd = rsqrtf(wave_sum(s) * (1.f / DM) + 1e-6f);
    f32x4* o = (f32x4*)(P.out + (size_t)row * DM) + lane;
#pragma unroll
    for (int j = 0; j < 4; ++j) { v[j] = v[j] * rstd * ((const f32x4*)P.final_norm)[64 * j + lane]; if (dead) { const float q = __builtin_nanf(""); v[j] = (f32x4){q, q, q, q}; } o[64 * j] = v[j]; }
}
typedef GAS unsigned gu32;
#define RLX_AGENT __ATOMIC_RELAXED, __HIP_MEMORY_SCOPE_AGENT
#define XB_TMO      128
#define XB_XCNT(j)  (256  + 64 * (j))
#define XB_XSUB(j)  (1280 + 64 * (j))
#define XB_XGEN(j)  (2304 + 64 * (j))
#define XB_TOP      3328
#define XB_TOPGEN   3392
#define XCD_BAR_WORDS 3456
#define XB_SPIN_CAP (1u << 22)

__device__ __forceinline__ unsigned xb_ld(unsigned* p)              { return __hip_atomic_load(p, __ATOMIC_RELAXED, __HIP_MEMORY_SCOPE_AGENT); }
__device__ __forceinline__ unsigned xb_add(unsigned* p, unsigned v) { return __hip_atomic_fetch_add(p, v, __ATOMIC_RELAXED, __HIP_MEMORY_SCOPE_AGENT); }
__device__ __forceinline__ unsigned xb_xcc_id() { return (unsigned)__builtin_amdgcn_s_getreg((3 << 11) | 20) & 0xFu; }
#define XB_SPIN(cond, bar) do { unsigned _sp = 0; while (cond) { __builtin_amdgcn_s_sleep(1); \
    if ((++_sp & 255u) == 0u) { if (xb_ld(&(bar)[XB_TMO])) break; if (_sp > XB_SPIN_CAP) { atomicAdd(&(bar)[XB_TMO], 1u); break; } } } } while (0)

struct XcdBarrier { unsigned* bar; unsigned x; volatile LAS unsigned* st; };

__device__ __forceinline__ XcdBarrier xcd_barrier_post(unsigned* bar, volatile LAS unsigned* st) {
    XcdBarrier b; b.bar = bar; b.x = xb_xcc_id(); b.st = st;
    if (threadIdx.x == 0) (void)xb_add(&bar[XB_XCNT(b.x)], 1u);
    return b;
}
__device__ __forceinline__ void xcd_barrier_complete(unsigned* bar, unsigned x, unsigned& nloc, unsigned& nx) {
    const unsigned G = gridDim.x * gridDim.y * gridDim.z;
    unsigned sum, cnt, mine, sp = 0u;
    for (;;) {
        sum = 0u; cnt = 0u; mine = 0u;
#pragma unroll
        for (unsigned j = 0; j < 16; ++j) { const unsigned c = xb_ld(&bar[XB_XCNT(j)]); sum += c; cnt += (c > 0u) ? 1u : 0u; mine = (j == x) ? c : mine; }
        if (sum == G) break;
        __builtin_amdgcn_s_sleep(1);
        if ((++sp & 255u) == 0u) { if (xb_ld(&bar[XB_TMO])) break; if (sp > XB_SPIN_CAP) { atomicAdd(&bar[XB_TMO], 1u); break; } }
    }
    nloc = mine > 0u ? mine : 1u; nx = cnt > 0u ? cnt : 1u;
}
__device__ __forceinline__ void xcd_barrier(const XcdBarrier& b) {
    asm volatile("s_waitcnt vmcnt(0)" ::: "memory");
    __syncthreads();
    if (threadIdx.x == 0) {
        unsigned* bar = b.bar;
        __builtin_amdgcn_s_waitcnt(0);
        unsigned nloc = b.st[0], nx = b.st[1];
        if (nloc == 0u) { xcd_barrier_complete(bar, b.x, nloc, nx); b.st[0] = nloc; b.st[1] = nx; }
        const unsigned old = xb_add(&bar[XB_XSUB(b.x)], 1u);
        const unsigned gen = old / nloc;
        if (old + 1u == (gen + 1u) * nloc) {
            __builtin_amdgcn_fence(__ATOMIC_RELEASE, "agent");
            asm volatile("s_waitcnt vmcnt(0)" ::: "memory");
            const unsigned og = xb_add(&bar[XB_TOP], 1u);
            const unsigned tg = og / nx;
            if (og + 1u == (tg + 1u) * nx) xb_add(&bar[XB_TOPGEN], 1u);
            else XB_SPIN(xb_ld(&bar[XB_TOPGEN]) == tg, bar);
            __builtin_amdgcn_fence(__ATOMIC_ACQUIRE, "agent");
            xb_add(&bar[XB_XGEN(b.x)], 1u);
            asm volatile("s_waitcnt vmcnt(0)" ::: "memory");
        } else {
            XB_SPIN(xb_ld(&bar[XB_XGEN(b.x)]) == gen, bar);
            __builtin_amdgcn_fence(__ATOMIC_ACQUIRE, "agent");
            asm volatile("s_waitcnt vmcnt(0)" ::: "memory");
        }
    }
    __syncthreads();
}
namespace rk {
constexpr int MB = 8192;
constexpr int S_AT = 0, S_RT = 1, S_KT = 2, S_BT = 3, S_ATT = 4, S_KTT = 5, S_BTT = 6, S_VT = 7, S_N = 8, S_NT = 9, S_MAK = 10, S_MRB = 11, S_MRK = 12, S_TA = 13, S_TB = 14;
constexpr int SCR = 15 * MB;
constexpr int NCHUNK = SEQ / 64;
constexpr size_t WS_HT = WS_X1;
constexpr size_t WS_Y0 = WS_X1 + 64 * MiB;
constexpr size_t WS_QI = WS_X1 + 96 * MiB;
constexpr size_t WS_LW = WS_RW, WS_LA = WS_RW + 32 * MiB, WS_LG = WS_RW + 64 * MiB;
constexpr size_t WS_SC = WS_RW + 224 * MiB;
constexpr size_t DO_GT = 80 * MiB;
static_assert(WS_SC + 32 * MiB <= WS_END, "rwkv blobs");

__device__ __forceinline__ int moff(int row, int col) { return row * 128 + ((((col >> 3) ^ (row >> 1)) & 7) << 4) + (col & 7) * 2; }
__device__ __forceinline__ int crow(int r, int hi) { return (r & 3) + 8 * (r >> 2) + 4 * hi; }
__device__ __forceinline__ f32x16 mm_nt(const LAS unsigned char* A, int ar0, const LAS unsigned char* Bt, int br0, f32x16 acc, int r32, int hi) {
#pragma unroll
    for (int ks = 0; ks < 4; ++ks) { const bf16x8 a = *(const LAS bf16x8*)(A + moff(ar0 + r32, 16 * ks + 8 * hi)), b = *(const LAS bf16x8*)(Bt + moff(br0 + r32, 16 * ks + 8 * hi));
        acc = __builtin_amdgcn_mfma_f32_32x32x16_bf16(a, b, acc, 0, 0, 0); }
    return acc;
}
__device__ __forceinline__ void store_t(LAS unsigned char* dst, const f32x16& acc, int i0, int j0, int r32, int hi) {
#pragma unroll
    for (int g = 0; g < 4; ++g) { u32x2 w; w.x = pk2(acc[4 * g], acc[4 * g + 1]); w.y = pk2(acc[4 * g + 2], acc[4 * g + 3]); *(LAS u32x2*)(dst + moff(j0 + r32, i0 + 8 * g + 4 * hi)) = w; }
}
template <int MODE> __device__ __forceinline__ void mask_tri(f32x16& acc, int i0, int j0, int r32, int hi) {
#pragma unroll
    for (int r = 0; r < 16; ++r) { const int i = i0 + crow(r, hi), j = j0 + r32; const bool keep = MODE == 0 ? (j < i) : (MODE == 1 ? (i < j) : (i <= j)); if (!keep) acc[r] = 0.f; }
}

__device__ __forceinline__ void pass1_chunk(KPR P, LAS unsigned char* lds, int bh, int c, int tid, int itbase, LAS float* cscr) {
    const int lane = tid & 63, wave = tid >> 6, r32 = lane & 31, hi = lane >> 5, grp = wave >> 2, wq = wave & 3, i0 = 32 * (wq >> 1), j0 = 32 * (wq & 1);
    const int b = bh >> 3, h = bh & 7; const size_t tok0 = (size_t)b * SEQ + (size_t)c * 64; const size_t ci = (size_t)bh * NCHUNK + c;
    LAS float* part = (LAS float*)(lds + SCR); LAS float* WL = (LAS float*)(lds + SCR + 2048);
#define MAT(s) (lds + (s) * MB)
    {
        const bf16_t* Z = (const bf16_t*)(P.ws + WS_Z); const bf16_t* LW = (const bf16_t*)(P.ws + WS_LW); const bf16_t* LA = (const bf16_t*)(P.ws + WS_LA);
        const int ch = tid & 63, tq = tid >> 6, cc = h * 64 + ch; const size_t row0 = tok0 + 8 * tq;
        const float mur = P.mu[RW_R + cc], muk = P.mu[RW_K + cc], muv = P.mu[RW_V + cc], w0c = P.w0[cc], a0c = P.a0[cc], kkc = P.k_k[cc], kac = P.k_a[cc];
        const bf16_t* zp = Z + row0 * ZW + ZR + cc;
        const bool first = (c == 0) && (tq == 0); const bf16_t* zq = first ? zp : zp - ZW; const float pm = first ? 0.f : 1.f;
        unsigned short lr[9], lk[9], lv[9], llw[8], lla[8];
        lr[0] = zq[RW_R]; lk[0] = zq[RW_K]; lv[0] = zq[RW_V];
#pragma unroll
        for (int i = 0; i < 8; ++i) { const bf16_t* zi = zp + (size_t)i * ZW; lr[i + 1] = zi[RW_R]; lk[i + 1] = zi[RW_K]; lv[i + 1] = zi[RW_V]; const size_t o = (row0 + i) * 512 + cc; llw[i] = LW[o]; lla[i] = LA[o]; }
        float cum[8], vr[8], vk[8], vkk[8], vka[8], ssq[8]; unsigned short vv16[8]; float run = 0.f;
#pragma unroll
        for (int i = 0; i < 8; ++i) { const float pmi = (i == 0) ? pm : 1.f; const float zr1 = bf2f(lr[i + 1]), zk1 = bf2f(lk[i + 1]), zv1 = bf2f(lv[i + 1]);
            vr[i] = zr1 + (bf2f(lr[i]) * pmi - zr1) * mur; vk[i] = zk1 + (bf2f(lk[i]) * pmi - zk1) * muk; vv16[i] = (unsigned short)f2bf(zv1 + (bf2f(lv[i]) * pmi - zv1) * muv);
            vkk[i] = vk[i] * kkc; ssq[i] = vkk[i] * vkk[i]; }
#pragma unroll
        for (int i = 0; i < 8; ++i) ssq[i] = wave_sum(ssq[i]);
#pragma unroll
        for (int i = 0; i < 8; ++i) {
            const float wl = w0c + bf2f(llw[i]); const float sp = fmaxf(-wl, 0.f) + __logf(1.0f + __expf(-fabsf(wl)));
            run += -__expf(-sp - 0.5f); cum[i] = run;
            const float a = __builtin_amdgcn_rcpf(1.0f + __expf(-(a0c + bf2f(lla[i]))));
            const float kk = vkk[i] * __builtin_amdgcn_rcpf(fmaxf(__builtin_amdgcn_sqrtf(ssq[i]), 1e-12f));
            vk[i] = vk[i] * (1.0f + (a - 1.0f) * kac); vkk[i] = kk; vka[i] = kk * a; }
        part[tq * 64 + ch] = run;
        __syncthreads();
        float pre = 0.f;
#pragma unroll
        for (int g = 0; g < 8; ++g) { const float pvv = part[g * 64 + ch]; pre += (g < tq) ? pvv : 0.f; }
        float eprev = __expf(pre);
        unsigned atT[4], ktT[4], btT[4], vT[4]; unsigned short hold[4] = {0, 0, 0, 0};
#pragma unroll
        for (int i = 0; i < 8; ++i) { const int t = 8 * tq + i;
            const float cm = pre + cum[i], e1 = __expf(cm), einv = __expf(-cm);
            const unsigned short at = (unsigned short)f2bf(-vkk[i] * eprev), rt = (unsigned short)f2bf(vr[i] * e1), kt = (unsigned short)f2bf(vk[i] * einv), bt = (unsigned short)f2bf(vka[i] * einv), vv = vv16[i];
            eprev = e1;
            *(LAS unsigned short*)(MAT(S_AT) + moff(t, ch)) = at; *(LAS unsigned short*)(MAT(S_RT) + moff(t, ch)) = rt; *(LAS unsigned short*)(MAT(S_KT) + moff(t, ch)) = kt; *(LAS unsigned short*)(MAT(S_BT) + moff(t, ch)) = bt;
            if (i & 1) { atT[i >> 1] = hold[0] | ((unsigned)at << 16); ktT[i >> 1] = hold[1] | ((unsigned)kt << 16); btT[i >> 1] = hold[2] | ((unsigned)bt << 16); vT[i >> 1] = hold[3] | ((unsigned)vv << 16); }
            else { hold[0] = at; hold[1] = kt; hold[2] = bt; hold[3] = vv; }
            if (i == 7 && tq == 7) WL[ch] = e1; }
        *(LAS u32x4*)(MAT(S_ATT) + moff(ch, 8 * tq)) = (u32x4){atT[0], atT[1], atT[2], atT[3]}; *(LAS u32x4*)(MAT(S_KTT) + moff(ch, 8 * tq)) = (u32x4){ktT[0], ktT[1], ktT[2], ktT[3]};
        *(LAS u32x4*)(MAT(S_BTT) + moff(ch, 8 * tq)) = (u32x4){btT[0], btT[1], btT[2], btT[3]}; *(LAS u32x4*)(MAT(S_VT) + moff(ch, 8 * tq)) = (u32x4){vT[0], vT[1], vT[2], vT[3]};
    }
    __syncthreads();
    const f32x16 zero = f32x16{};
    f32x4 cv[2][8];
    if (grp == 1) {
#pragma unroll
        for (int u = 0; u < 2; ++u) { const float* cs = gu_item_src(P, itbase + 4 * u + wq) + (size_t)(lane >> 3) * 2048 + 4 * (lane & 7);
#pragma unroll
            for (int i = 0; i < 8; ++i) cv[u][i] = *(const f32x4*)(cs + (size_t)(8 * i) * 2048); } }
    if (grp == 0) { f32x16 d = mm_nt(MAT(S_AT), i0, MAT(S_BT), j0, zero, r32, hi); mask_tri<0>(d, i0, j0, r32, hi); store_t(MAT(S_NT), d, i0, j0, r32, hi);
        d = mm_nt(MAT(S_KT), i0, MAT(S_AT), j0, zero, r32, hi); mask_tri<1>(d, i0, j0, r32, hi); store_t(MAT(S_MAK), d, i0, j0, r32, hi);
        d = mm_nt(MAT(S_KT), i0, MAT(S_RT), j0, zero, r32, hi); mask_tri<2>(d, i0, j0, r32, hi); store_t(MAT(S_MRK), d, i0, j0, r32, hi); }
    else { f32x16 d = mm_nt(MAT(S_BT), i0, MAT(S_AT), j0, zero, r32, hi); mask_tri<1>(d, i0, j0, r32, hi); store_t(MAT(S_N), d, i0, j0, r32, hi);
#pragma unroll
        for (int r = 0; r < 16; ++r) if (i0 + crow(r, hi) == j0 + r32) d[r] = 1.0f;
        store_t(MAT(S_TA), d, i0, j0, r32, hi);
        d = mm_nt(MAT(S_BT), i0, MAT(S_RT), j0, zero, r32, hi); mask_tri<2>(d, i0, j0, r32, hi); store_t(MAT(S_MRB), d, i0, j0, r32, hi); }
    __syncthreads();
#pragma unroll
    for (int s = 1; s <= 6; ++s) {
        const int mc = (s & 1) ? S_N : S_AT, mcT = (s & 1) ? S_NT : S_KT, mn = (s & 1) ? S_AT : S_N, mnT = (s & 1) ? S_KT : S_NT;
        const int tc = (s & 1) ? S_TB : S_TA, tn = (s & 1) ? S_TA : S_TB;
        if (s <= 5) {
            if (grp == 0) { const f32x16 d = mm_nt(MAT(mc), i0, MAT(mcT), j0, zero, r32, hi); store_t(MAT(mnT), d, i0, j0, r32, hi); }
            else { const f32x16 d = mm_nt(MAT(mcT), i0, MAT(mc), j0, zero, r32, hi); store_t(MAT(mn), d, i0, j0, r32, hi); }
        }
        if (s >= 2 && grp == (s <= 5 ? 0 : 1) ) {
            f32x16 d = mm_nt(MAT(mcT), i0, MAT(tc), j0, zero, r32, hi);
#pragma unroll
            for (int g = 0; g < 4; ++g) { const u32x2 tv = *(const LAS u32x2*)(MAT(tc) + moff(j0 + r32, i0 + 8 * g + 4 * hi)); d[4 * g] += bflo(tv.x); d[4 * g + 1] += bfhi(tv.x); d[4 * g + 2] += bflo(tv.y); d[4 * g + 3] += bfhi(tv.y); }
            store_t(MAT(tn), d, i0, j0, r32, hi);
        }
        if (s >= 2 && s <= 5 && grp == 1) { const int u = (s - 2) >> 1, h = (s - 2) & 1;
            gu_half(P, itbase + 4 * u + wq, h, lane, cscr, cv[u][4 * h], cv[u][4 * h + 1], cv[u][4 * h + 2], cv[u][4 * h + 3]); }
        __syncthreads();
    }
    if (grp == 0) { const f32x16 d = mm_nt(MAT(S_TB), i0, MAT(S_ATT), j0, zero, r32, hi); store_t(MAT(S_BT), d, i0, j0, r32, hi); }
    else { const f32x16 d = mm_nt(MAT(S_MAK), i0, MAT(S_VT), j0, zero, r32, hi); store_t(MAT(S_N), d, i0, j0, r32, hi); }
    __syncthreads();
    if (grp == 0) { const f32x16 d = mm_nt(MAT(S_TB), i0, MAT(S_N), j0, zero, r32, hi); store_t(MAT(S_NT), d, i0, j0, r32, hi);
        f32x16 q = mm_nt(MAT(S_BT), i0, MAT(S_MRB), j0, zero, r32, hi);
#pragma unroll
        for (int g = 0; g < 4; ++g) { const u32x2 rv = *(const LAS u32x2*)(MAT(S_RT) + moff(j0 + r32, i0 + 8 * g + 4 * hi)); q[4 * g] += bflo(rv.x); q[4 * g + 1] += bfhi(rv.x); q[4 * g + 2] += bflo(rv.y); q[4 * g + 3] += bfhi(rv.y); }
        store_t(MAT(S_KT), q, i0, j0, r32, hi); }
    else { f32x16 g_ = mm_nt(MAT(S_BT), i0, MAT(S_BTT), j0, zero, r32, hi);
        const float wl = WL[j0 + r32];
#pragma unroll
        for (int r = 0; r < 16; ++r) { if (i0 + crow(r, hi) == j0 + r32) g_[r] += 1.0f; g_[r] *= wl; }
        store_t(MAT(S_AT), g_, i0, j0, r32, hi); }
    __syncthreads();
    if (grp == 0) { f32x16 d = mm_nt(MAT(S_BTT), i0, MAT(S_NT), j0, zero, r32, hi); d = mm_nt(MAT(S_KTT), i0, MAT(S_VT), j0, d, r32, hi);
        float* HT = (float*)(P.ws + WS_HT) + ci * 4096 + (size_t)wq * 1024 + lane;
#pragma unroll
        for (int g = 0; g < 4; ++g) { const f32x4 wl4 = *(const LAS f32x4*)(WL + i0 + 8 * g + 4 * hi);
#pragma unroll
            for (int i = 0; i < 4; ++i) HT[(4 * g + i) * 64] = d[4 * g + i] * wl4[i]; } }
    else { f32x16 d = mm_nt(MAT(S_MRB), i0, MAT(S_NT), j0, zero, r32, hi); d = mm_nt(MAT(S_MRK), i0, MAT(S_VT), j0, d, r32, hi);
        unsigned* Y0 = (unsigned*)(P.ws + WS_Y0) + ci * 2048 + (size_t)wq * 512 + lane;
#pragma unroll
        for (int r2 = 0; r2 < 8; ++r2) Y0[r2 * 64] = pk2(d[2 * r2], d[2 * r2 + 1]); }
    { u32x4* GTg = (u32x4*)((unsigned char*)P.out + DO_GT + ci * MB); u32x4* QIg = (u32x4*)(P.ws + WS_QI + ci * MB);
        GTg[tid] = *(const LAS u32x4*)(MAT(S_AT) + tid * 16); QIg[tid] = *(const LAS u32x4*)(MAT(S_KT) + tid * 16); }
    __syncthreads();
#undef MAT
}

__device__ __forceinline__ void pass2_seq(KPR P, LAS unsigned char* lds, int bh, int tid) {
    const int lane = tid & 63, wave = tid >> 6, r32 = lane & 31, hi = lane >> 5, wq = wave & 3, i0 = 32 * (wq >> 1), j0 = 32 * (wq & 1);
    LAS unsigned char* Sm = lds; LAS unsigned char* G0 = lds + MB; LAS unsigned char* G1 = lds + 2 * MB;
    const size_t ci0 = (size_t)bh * NCHUNK;
    const u32x4* GTg = (const u32x4*)((const unsigned char*)P.out + DO_GT + ci0 * MB); u32x4* SCg = (u32x4*)(P.ws + WS_SC + ci0 * MB);
    const float* HT = (const float*)(P.ws + WS_HT) + ci0 * 4096 + (size_t)wq * 1024 + lane;
    *(LAS u32x4*)(Sm + tid * 16) = (u32x4){0u, 0u, 0u, 0u};
    *(LAS u32x4*)(G0 + tid * 16) = GTg[tid];
    u32x4 gnext = GTg[512 + tid];
    f32x16 hcur, hnext;
    if (wave < 4) {
#pragma unroll
        for (int r = 0; r < 16; ++r) { hcur[r] = HT[r * 64]; hnext[r] = HT[4096 + r * 64]; } }
    __syncthreads();
    for (int c = 0; c < NCHUNK; ++c) {
        LAS unsigned char* Gc = (c & 1) ? G1 : G0; LAS unsigned char* Gn = (c & 1) ? G0 : G1;
        SCg[(size_t)c * 512 + tid] = *(const LAS u32x4*)(Sm + tid * 16);
        f32x16 d = hcur;
        if (wave < 4) d = mm_nt(Gc, i0, Sm, j0, d, r32, hi);
        __syncthreads();
        if (wave < 4) store_t(Sm, d, i0, j0, r32, hi);
        *(LAS u32x4*)(Gn + tid * 16) = gnext;
        const int c2 = (c + 2 < NCHUNK) ? c + 2 : NCHUNK - 1;
        gnext = GTg[(size_t)c2 * 512 + tid];
        if (wave < 4) { hcur = hnext;
#pragma unroll
            for (int r = 0; r < 16; ++r) hnext[r] = HT[(size_t)c2 * 4096 + r * 64]; }
        __syncthreads();
    }
}

__device__ __forceinline__ void pass3_chunk(KPR P, LAS unsigned char* lds, int bh, int c, int tid) {
    const int lane = tid & 63, wave = tid >> 6, r32 = lane & 31, hi = lane >> 5, wq = wave & 3, i0 = 32 * (wq >> 1), j0 = 32 * (wq & 1);
    const int b = bh >> 3, h = bh & 7; const size_t tok0 = (size_t)b * SEQ + (size_t)c * 64; const size_t ci = (size_t)bh * NCHUNK + c;
    LAS unsigned char* Qm = lds; LAS unsigned char* Sm = lds + MB; LAS float* Yl = (LAS float*)(lds + 2 * MB);
    *(LAS u32x4*)(Qm + tid * 16) = ((const u32x4*)(P.ws + WS_QI + ci * MB))[tid];
    *(LAS u32x4*)(Sm + tid * 16) = ((const u32x4*)(P.ws + WS_SC + ci * MB))[tid];
    f32x16 d = f32x16{};
    if (wave < 4) { const unsigned* Y0 = (const unsigned*)(P.ws + WS_Y0) + ci * 2048 + (size_t)wq * 512 + lane;
#pragma unroll
        for (int r2 = 0; r2 < 8; ++r2) { const unsigned w = Y0[r2 * 64]; d[2 * r2] = bflo(w); d[2 * r2 + 1] = bfhi(w); } }
    const bf16_t* Z = (const bf16_t*)(P.ws + WS_Z); const bf16_t* LA = (const bf16_t*)(P.ws + WS_LA); const bf16_t* LG = (const bf16_t*)(P.ws + WS_LG);
    bf16_t* AO = (bf16_t*)(P.ws + WS_AO); const int cc = h * 64 + lane;
    const float lnw = P.ln_w[cc], lnb = P.ln_b[cc], rkc = P.r_k[cc], mur = P.mu[RW_R + cc], muk = P.mu[RW_K + cc], muv = P.mu[RW_V + cc], a0c = P.a0[cc], kac = P.k_a[cc];
    const bf16_t* zp = Z + (tok0 + wave * 8) * ZW + ZR + cc; const bool first = (c == 0) && (wave == 0); const bf16_t* zq = first ? zp : zp - ZW; const float pm = first ? 0.f : 1.f;
    unsigned short lr[9], lk[9], lv[9], lla[8], llg[8];
    lr[0] = zq[RW_R]; lk[0] = zq[RW_K]; lv[0] = zq[RW_V];
#pragma unroll
    for (int i = 0; i < 8; ++i) { const bf16_t* zi = zp + (size_t)i * ZW; lr[i + 1] = zi[RW_R]; lk[i + 1] = zi[RW_K]; lv[i + 1] = zi[RW_V]; const size_t o = (tok0 + wave * 8 + i) * 512 + cc; lla[i] = LA[o]; llg[i] = LG[o]; }
    __syncthreads();
    if (wave < 4) { d = mm_nt(Qm, i0, Sm, j0, d, r32, hi);
#pragma unroll
        for (int r = 0; r < 16; ++r) Yl[(i0 + crow(r, hi)) * 65 + j0 + r32] = d[r]; }
    __syncthreads();
    float y[8], s1[8], s2[8], s3[8], vvv[8];
#pragma unroll
    for (int i = 0; i < 8; ++i) { const float pmi = (i == 0) ? pm : 1.f; const float zr1 = bf2f(lr[i + 1]), zk1 = bf2f(lk[i + 1]), zv1 = bf2f(lv[i + 1]);
        const float r = zr1 + (bf2f(lr[i]) * pmi - zr1) * mur, zk = zk1 + (bf2f(lk[i]) * pmi - zk1) * muk; vvv[i] = zv1 + (bf2f(lv[i]) * pmi - zv1) * muv;
        const float a = __builtin_amdgcn_rcpf(1.0f + __expf(-(a0c + bf2f(lla[i])))); const float k = zk * (1.0f + (a - 1.0f) * kac);
        y[i] = Yl[(wave * 8 + i) * 65 + lane]; s1[i] = y[i]; s3[i] = r * k * rkc; }
#pragma unroll
    for (int i = 0; i < 8; ++i) { s1[i] = wave_sum(s1[i]); s3[i] = wave_sum(s3[i]); }
#pragma unroll
    for (int i = 0; i < 8; ++i) { y[i] -= s1[i] * (1.f / 64.f); s2[i] = y[i] * y[i]; }
#pragma unroll
    for (int i = 0; i < 8; ++i) s2[i] = wave_sum(s2[i]);
#pragma unroll
    for (int i = 0; i < 8; ++i) { const size_t tok = tok0 + wave * 8 + i; const float yn = y[i] * rsqrtf(s2[i] * (1.f / 64.f) + 64e-5f) * lnw + lnb;
        AO[tok * DM + 512 + cc] = (bf16_t)f2bf((yn + s3[i] * vvv[i]) * bf2f(llg[i])); }
}

constexpr size_t WS_W2T = 29 * MiB, WS_A2T = 29 * MiB + 65536, WS_G2T = 29 * MiB + 131072;
__device__ __forceinline__ bf16x8 act8(const bf16_t* zc, const bf16_t* zpv, float pmask, const float* mu, int mode) {
    const u32x4 c = *(const u32x4*)zc, p = *(const u32x4*)zpv;
    const f32x4 m0 = *(const f32x4*)mu, m1 = *(const f32x4*)(mu + 4);
    const unsigned cw[4] = {c.x, c.y, c.z, c.w}, pw[4] = {p.x, p.y, p.z, p.w}; const float um[8] = {m0[0], m0[1], m0[2], m0[3], m1[0], m1[1], m1[2], m1[3]}; float v[8];
#pragma unroll
    for (int j = 0; j < 4; ++j) { const float c0 = bflo(cw[j]), c1 = bfhi(cw[j]), p0 = bflo(pw[j]) * pmask, p1 = bfhi(pw[j]) * pmask;
        v[2 * j] = c0 + (p0 - c0) * um[2 * j]; v[2 * j + 1] = c1 + (p1 - c1) * um[2 * j + 1]; }
#pragma unroll
    for (int j = 0; j < 8; ++j) { if (mode == 0) { const float e = __expf(-2.0f * fabsf(v[j])); const float th = (1.0f - e) * __builtin_amdgcn_rcpf(1.0f + e); v[j] = v[j] < 0.f ? -th : th; } else if (mode == 2) v[j] = __builtin_amdgcn_rcpf(1.0f + __expf(-v[j])); }
    u32x4 w; w.x = pk2(v[0], v[1]); w.y = pk2(v[2], v[3]); w.z = pk2(v[4], v[5]); w.w = pk2(v[6], v[7]);
    return __builtin_bit_cast(bf16x8, w);
}
__device__ __forceinline__ int goff(int row, int col) { return row * 256 + ((((col >> 3) ^ row) & 15) << 4) + (col & 7) * 2; }
__device__ __forceinline__ void lora_block(KPR P, LAS unsigned char* lds, int blk, int G, int tid) {
    const int lane = tid & 63, wave = tid >> 6, r32 = lane & 31, hi = lane >> 5;
    const int task = blk * 4 + (wave & 3), cb0 = 8 * (wave >> 2); const bool work = task < NTOK / 32;
    const size_t row = (size_t)(work ? task : 0) * 32 + r32; const bool first = (row % SEQ) == 0;
    const bf16_t* Z = (const bf16_t*)(P.ws + WS_Z) + row * ZW + ZR + 8 * hi; const bf16_t* Zp = first ? Z : Z - ZW; const float pmask = first ? 0.f : 1.f;
    const float* mub = P.mu + 8 * hi;
    { const u32x4* w2 = (const u32x4*)(P.ws + WS_W2T); const u32x4* a2 = (const u32x4*)(P.ws + WS_A2T);
#pragma unroll
        for (int i = 0; i < 8; ++i) { const int idx = i * 512 + tid, rw = idx >> 3, ch = idx & 7; const int o = rw * 128 + (((ch ^ (rw >> 1)) & 7) << 4);
            *(LAS u32x4*)(lds + o) = w2[idx]; *(LAS u32x4*)(lds + 65536 + o) = a2[idx]; } }
    bf16x8 xw[4], xa[4], xg[8];
    if (work) {
#pragma unroll
        for (int ks = 0; ks < 4; ++ks) { xw[ks] = act8(Z + RW_W + 16 * ks, Zp + RW_W + 16 * ks, pmask, mub + RW_W + 16 * ks, 0); xa[ks] = act8(Z + RW_A + 16 * ks, Zp + RW_A + 16 * ks, pmask, mub + RW_A + 16 * ks, 1); asm volatile("" ::: "memory"); }
#pragma unroll
        for (int ks = 0; ks < 8; ++ks) { xg[ks] = act8(Z + RW_G + 16 * ks, Zp + RW_G + 16 * ks, pmask, mub + RW_G + 16 * ks, 2); if (ks & 1) asm volatile("" ::: "memory"); }
    }
    bf16_t* LW = (bf16_t*)(P.ws + WS_LW) + row * 512 + 4 * hi; bf16_t* LA = (bf16_t*)(P.ws + WS_LA) + row * 512 + 4 * hi; bf16_t* LG = (bf16_t*)(P.ws + WS_LG) + row * 512 + 4 * hi;
    __syncthreads();
    if (work) {
#pragma nounroll
        for (int cb = cb0; cb < cb0 + 8; ++cb) { f32x16 dw = f32x16{}, da = f32x16{};
#pragma unroll
            for (int ks = 0; ks < 4; ++ks) { const int o = moff(cb * 32 + r32, 16 * ks + 8 * hi);
                dw = __builtin_amdgcn_mfma_f32_32x32x16_bf16(*(const LAS bf16x8*)(lds + o), xw[ks], dw, 0, 0, 0); da = __builtin_amdgcn_mfma_f32_32x32x16_bf16(*(const LAS bf16x8*)(lds + 65536 + o), xa[ks], da, 0, 0, 0); }
#pragma unroll
            for (int g = 0; g < 4; ++g) { u32x2 w; w.x = pk2(dw[4 * g], dw[4 * g + 1]); w.y = pk2(dw[4 * g + 2], dw[4 * g + 3]); *(u32x2*)(LW + cb * 32 + 8 * g) = w;
                w.x = pk2(da[4 * g], da[4 * g + 1]); w.y = pk2(da[4 * g + 2], da[4 * g + 3]); *(u32x2*)(LA + cb * 32 + 8 * g) = w; } }
    }
    __syncthreads();
    { const u32x4* g2 = (const u32x4*)(P.ws + WS_G2T);
#pragma unroll
        for (int i = 0; i < 16; ++i) { const int idx = i * 512 + tid, rw = idx >> 4, ch = idx & 15; *(LAS u32x4*)(lds + rw * 256 + (((ch ^ rw) & 15) << 4)) = g2[idx]; } }
    __syncthreads();
    if (work) {
#pragma nounroll
        for (int cb = cb0; cb < cb0 + 8; ++cb) { f32x16 dg = f32x16{};
#pragma unroll
            for (int ks = 0; ks < 8; ++ks) dg = __builtin_amdgcn_mfma_f32_32x32x16_bf16(*(const LAS bf16x8*)(lds + goff(cb * 32 + r32, 16 * ks + 8 * hi)), xg[ks], dg, 0, 0, 0);
#pragma unroll
            for (int g = 0; g < 4; ++g) { u32x2 w; w.x = pk2(dg[4 * g], dg[4 * g + 1]); w.y = pk2(dg[4 * g + 2], dg[4 * g + 3]); *(u32x2*)(LG + cb * 32 + 8 * g) = w; } }
    }
    __syncthreads();
}
}
namespace rt {
__device__ __forceinline__ int woff(int e, int k) { return e * 2048 + ((((k >> 3) ^ (e & 15))) << 4) + (k & 7) * 2; }
constexpr size_t WS_WRI = 30 * MiB;
__device__ __forceinline__ void build_w(KPR P, int part, int tid) {
    unsigned char* img = P.ws + WS_WRI; const int e = tid & 31, k0 = part * 64 + 4 * (tid >> 5); float w[4];
#pragma unroll
    for (int i = 0; i < 4; ++i) w[i] = P.moe_norm[k0 + i] * P.w_router[(k0 + i) * 32 + e];
#pragma unroll
    for (int i = 0; i < 4; ++i) { const int k = k0 + i; const unsigned h = f2bf(w[i]); const unsigned l = f2bf(w[i] - bf2f(h));
        *(unsigned short*)(img + woff(e, k)) = (unsigned short)h; *(unsigned short*)(img + 65536 + woff(e, k)) = (unsigned short)l; }
}
__device__ __forceinline__ void copy_w(KPR P, LAS unsigned char* lds, int tid) {
    const u32x4* img = (const u32x4*)(P.ws + WS_WRI);
    u32x4 t[16];
#pragma unroll
    for (int i = 0; i < 16; ++i) t[i] = img[i * 512 + tid];
#pragma unroll
    for (int i = 0; i < 16; ++i) *(LAS u32x4*)(lds + (size_t)(i * 512 + tid) * 16) = t[i];
}
__device__ __forceinline__ void split8(const f32x4& a, const f32x4& b, bf16x8& h, bf16x8& l) {
    unsigned hh[8]; float v[8] = {a[0], a[1], a[2], a[3], b[0], b[1], b[2], b[3]};
#pragma unroll
    for (int j = 0; j < 8; ++j) hh[j] = f2bf(v[j]);
    u32x4 hw, lw;
    hw.x = hh[0] | (hh[1] << 16); hw.y = hh[2] | (hh[3] << 16); hw.z = hh[4] | (hh[5] << 16); hw.w = hh[6] | (hh[7] << 16);
    lw.x = pk2(v[0] - bf2f(hh[0]), v[1] - bf2f(hh[1])); lw.y = pk2(v[2] - bf2f(hh[2]), v[3] - bf2f(hh[3])); lw.z = pk2(v[4] - bf2f(hh[4]), v[5] - bf2f(hh[5])); lw.w = pk2(v[6] - bf2f(hh[6]), v[7] - bf2f(hh[7]));
    h = __builtin_bit_cast(bf16x8, hw); l = __builtin_bit_cast(bf16x8, lw);
}
__device__ __forceinline__ void route_task(KPR P, const LAS unsigned char* wlds, int task, int lane) {
    const int r32 = lane & 31, hi = lane >> 5; const int row = task * 32 + r32;
    const bf16_t* xrow = (const bf16_t*)(P.ws + WS_X1) + (size_t)row * DM + 8 * hi;
    f32x16 acc = f32x16{}; float ss = 0.f;
    u32x4 xq[16];
#pragma unroll
    for (int j = 0; j < 16; ++j) xq[j] = *(const u32x4*)(xrow + 16 * j);
    for (int ks0 = 0; ks0 < 64; ks0 += 16) {
#pragma unroll
        for (int j = 0; j < 16; ++j) { const int ks = ks0 + j; const u32x4 xv = xq[j];
            const int kn = (ks + 16 < 64) ? ks + 16 : ks; xq[j] = *(const u32x4*)(xrow + 16 * kn);
            const unsigned xw[4] = {xv.x, xv.y, xv.z, xv.w};
#pragma unroll
            for (int q = 0; q < 4; ++q) { const float a = bflo(xw[q]), b = bfhi(xw[q]); ss += a * a + b * b; }
            const bf16x8 xh = __builtin_bit_cast(bf16x8, xv);
            const bf16x8 wh = *(const LAS bf16x8*)(wlds + woff(r32, 16 * ks + 8 * hi)), wl = *(const LAS bf16x8*)(wlds + 65536 + woff(r32, 16 * ks + 8 * hi));
            acc = __builtin_amdgcn_mfma_f32_32x32x16_bf16(wh, xh, acc, 0, 0, 0); acc = __builtin_amdgcn_mfma_f32_32x32x16_bf16(wl, xh, acc, 0, 0, 0); }
    }
    ss += __shfl_xor(ss, 32);
    const float rstd = rsqrtf(ss * (1.f / DM) + 1e-6f);
    float lg[16];
#pragma unroll
    for (int g = 0; g < 4; ++g) { const f32x4 bb = *(const f32x4*)(P.b_router + 8 * g + 4 * hi);
#pragma unroll
        for (int i = 0; i < 4; ++i) lg[4 * g + i] = acc[4 * g + i] * rstd + bb[i]; }
    float tv[4]; int ti[4];
#pragma unroll
    for (int k = 0; k < 4; ++k) { float bv = lg[0]; int bi = 4 * hi;
#pragma unroll
        for (int r = 1; r < 16; ++r) { const int e = (r & 3) + 8 * (r >> 2) + 4 * hi; if (lg[r] > bv) { bv = lg[r]; bi = e; } }
        const float pv = __shfl_xor(bv, 32); const int pi = __shfl_xor(bi, 32);
        if (pv > bv || (pv == bv && pi < bi)) { bv = pv; bi = pi; }
        tv[k] = bv; ti[k] = bi;
#pragma unroll
        for (int r = 0; r < 16; ++r) { const int e = (r & 3) + 8 * (r >> 2) + 4 * hi; if (e == bi) lg[r] = -INFINITY; } }
    const float e1 = __expf(tv[1] - tv[0]), e2 = __expf(tv[2] - tv[0]), e3 = __expf(tv[3] - tv[0]), inv = 1.f / (1.f + e1 + e2 + e3);
    const int c0 = hi ? ti[2] : ti[0], c1 = hi ? ti[3] : ti[1]; const float g0 = (hi ? e2 : 1.f) * inv, g1 = (hi ? e3 : e1) * inv;
    const unsigned long long ltm = (1ull << lane) - 1ull; int mycnt = 0, rk0 = 0, rk1 = 0;
    for (int e = 0; e < 32; ++e) { const unsigned long long m0 = __ballot(c0 == e), m1 = __ballot(c1 == e); const int n0 = __popcll(m0);
        if (lane == e) mycnt = n0 + __popcll(m1);
        if (c0 == e) rk0 = __popcll(m0 & ltm);
        if (c1 == e) rk1 = n0 + __popcll(m1 & ltm); }
    unsigned* cnt = (unsigned*)(P.ws + WS_CTL) + CW_CNT; int base = 0;
    if (lane < 32 && mycnt > 0) base = (int)atomicAdd(cnt + lane, (unsigned)mycnt);
    rk0 += __shfl(base, c0); rk1 += __shfl(base, c1);
    int* route = (int*)(P.ws + WS_ROUTE); int* tokslot = (int*)(P.ws + WS_TOKSLOT); float* gateslot = (float*)(P.ws + WS_GATESLOT);
    tokslot[(size_t)c0 * NTOK + rk0] = row; gateslot[(size_t)c0 * NTOK + rk0] = g0; tokslot[(size_t)c1 * NTOK + rk1] = row; gateslot[(size_t)c1 * NTOK + rk1] = g1;
    route[(size_t)row * 12 + 2 * hi] = c0; route[(size_t)row * 12 + 2 * hi + 1] = c1; route[(size_t)row * 12 + 4 + 2 * hi] = rk0; route[(size_t)row * 12 + 4 + 2 * hi + 1] = rk1;
}
__device__ __forceinline__ void xn8_task(KPR P, int task, int lane) {
    const bf16_t* x1 = (const bf16_t*)(P.ws + WS_X1) + (size_t)task * 32 * DM + 16 * lane; unsigned char* xn = P.ws + WS_XN + (size_t)task * 32 * DM + 16 * lane;
    f32x4 g[4];
#pragma unroll
    for (int q = 0; q < 4; ++q) g[q] = *(const f32x4*)(P.moe_norm + 16 * lane + 4 * q);
    u32x4 xa[4][2];
#pragma unroll
    for (int i = 0; i < 4; ++i) { xa[i][0] = *(const u32x4*)(x1 + (size_t)i * DM); xa[i][1] = *(const u32x4*)(x1 + (size_t)i * DM + 8); }
    for (int r0 = 0; r0 < 32; r0 += 4) {
        f32x4 v[4][4]; float ss[4];
#pragma unroll
        for (int i = 0; i < 4; ++i) { const unsigned w[8] = {xa[i][0].x, xa[i][0].y, xa[i][0].z, xa[i][0].w, xa[i][1].x, xa[i][1].y, xa[i][1].z, xa[i][1].w}; float s = 0.f;
#pragma unroll
            for (int q = 0; q < 4; ++q) { v[i][q] = (f32x4){bflo(w[2 * q]), bfhi(w[2 * q]), bflo(w[2 * q + 1]), bfhi(w[2 * q + 1])}; s += (v[i][q][0] * v[i][q][0] + v[i][q][1] * v[i][q][1]) + (v[i][q][2] * v[i][q][2] + v[i][q][3] * v[i][q][3]); }
            ss[i] = s;
            const int rn = (r0 + 4 + i < 32) ? r0 + 4 + i : r0 + i; xa[i][0] = *(const u32x4*)(x1 + (size_t)rn * DM); xa[i][1] = *(const u32x4*)(x1 + (size_t)rn * DM + 8); }
#pragma unroll
        for (int i = 0; i < 4; ++i) ss[i] = wave_sum(ss[i]);
#pragma unroll
        for (int i = 0; i < 4; ++i) { const float rstd = rsqrtf(ss[i] * (1.f / DM) + 1e-6f); u32x4 o; unsigned ow[4];
#pragma unroll
            for (int q = 0; q < 4; ++q) { const f32x4 t = v[i][q] * rstd * g[q]; ow[q] = pk4_fp8(t[0], t[1], t[2], t[3]); }
            o.x = ow[0]; o.y = ow[1]; o.z = ow[2]; o.w = ow[3];
            *(u32x4*)(xn + (size_t)(r0 + i) * DM) = o; }
    }
}
}
namespace attn_body {
using bf16=unsigned short;
using bf16x8=__attribute__((ext_vector_type(8)))short;
using s16x4=__attribute__((ext_vector_type(4)))short;
using f32x16=__attribute__((ext_vector_type(16)))float;
using u32x4=__attribute__((ext_vector_type(4)))unsigned;
constexpr int BATCH=4,NHEAD=8,SEQ=8192,D=64,DM=3840,OP=1024;
constexpr int NW=8,QBLK=32,QB=QBLK*NW,KVBLK=64,NQB=SEQ/QB;
constexpr int ATTN_PITCH=DM, ATTN_UNIT_ROWS=QB;
__device__ __forceinline__ int crow(int r,int hi){return (r&3)+8*(r>>2)+4*hi;}
#define SBAR() __builtin_amdgcn_sched_barrier(0)
__device__ __forceinline__ void cmask(f32x16&p0,f32x16&p1,int jb,int qrel,int hi){
  const float NEG=-INFINITY; int kb=64*jb+4*hi;
  #pragma unroll
  for(int r=0;r<16;++r){int kv=kb+(r&3)+8*(r>>2); if(kv>qrel)p0[r]=NEG; if(kv+32>qrel)p1[r]=NEG;}
}

constexpr int NSLOT=3, SLOTB=8192;
constexpr int LDS_K=0, LDS_V=NSLOT*SLOTB, LDS_WS=2*NSLOT*SLOTB, LDS_OST=LDS_WS+NW*64*4, LDS_C2=LDS_OST+NW*4096, LDS_BYTES=LDS_C2+SEQ*4;
constexpr float C2=0.125f*1.4426950408889634f;
__device__ __forceinline__ void glds16(const void*gsrc,unsigned lds_dst){unsigned keep;
  asm volatile("s_mov_b32 %0, m0\n\ts_mov_b32 m0, %2\n\ts_nop 0\n\tglobal_load_lds_dwordx4 %1, off\n\ts_mov_b32 m0, %0":"=&s"(keep):"v"(gsrc),"s"(lds_dst):"memory");}
__device__ __forceinline__ float max3f(float a,float b,float c){float r;asm("v_max3_f32 %0, %1, %2, %3":"=v"(r):"v"(a),"v"(b),"v"(c));return r;}
__device__ __forceinline__ float max2f(float a,float b){float r;asm("v_max_f32_e32 %0, %1, %2":"=v"(r):"v"(a),"v"(b));return r;}
__device__ __forceinline__ float fadd_s(float a,float b){float r;asm("v_add_f32_e32 %0, %1, %2":"=v"(r):"v"(a),"v"(b));return r;}
__device__ __forceinline__ float fsub_s(float a,float b){float r;asm("v_sub_f32_e32 %0, %1, %2":"=v"(r):"v"(a),"v"(b));return r;}
typedef float f32x2_t __attribute__((ext_vector_type(2))); typedef float f32x4v __attribute__((ext_vector_type(4))); typedef __bf16 bf16x2_t __attribute__((ext_vector_type(2)));
__device__ __forceinline__ unsigned cvtpk_s(float lo,float hi){f32x2_t v={lo,hi};bf16x2_t b=__builtin_convertvector(v,bf16x2_t);return __builtin_bit_cast(unsigned,b);}
#define WAIT_BAR(N) asm volatile("s_waitcnt vmcnt(" #N ") lgkmcnt(0)\n\ts_barrier":::"memory")

__device__ __forceinline__ void qkt(f32x16&p0,f32x16&p1,const char*Kslot,const bf16x8*qr,int r32,int hi){
  const char*kb=Kslot+hi*1024+r32*16;
  #pragma unroll
  for(int d0=0;d0<4;++d0){
    const bf16x8 b0=*reinterpret_cast<const bf16x8*>(kb+d0*2048);
    const bf16x8 b1=*reinterpret_cast<const bf16x8*>(kb+d0*2048+512);
    p0=__builtin_amdgcn_mfma_f32_32x32x16_bf16(b0,qr[d0],p0,0,0,0);p1=__builtin_amdgcn_mfma_f32_32x32x16_bf16(b1,qr[d0],p1,0,0,0);}
}
typedef __attribute__((address_space(3))) const char* lds_cptr;
typedef short v4i16_t __attribute__((ext_vector_type(4)));
__device__ __forceinline__ void kload8(bf16x8*kf,lds_cptr kp){
  kf[0]=*(const __attribute__((address_space(3))) bf16x8*)(kp);      kf[1]=*(const __attribute__((address_space(3))) bf16x8*)(kp+512);
  kf[2]=*(const __attribute__((address_space(3))) bf16x8*)(kp+2048); kf[3]=*(const __attribute__((address_space(3))) bf16x8*)(kp+2560);
  kf[4]=*(const __attribute__((address_space(3))) bf16x8*)(kp+4096); kf[5]=*(const __attribute__((address_space(3))) bf16x8*)(kp+4608);
  kf[6]=*(const __attribute__((address_space(3))) bf16x8*)(kp+6144); kf[7]=*(const __attribute__((address_space(3))) bf16x8*)(kp+6656);
}
__device__ __forceinline__ void kload2(bf16x8*kf,lds_cptr kp,int j){ kf[2*j]=*(const __attribute__((address_space(3))) bf16x8*)(kp+j*2048); kf[2*j+1]=*(const __attribute__((address_space(3))) bf16x8*)(kp+j*2048+512); }
__device__ __forceinline__ s16x4 vtr(lds_cptr p){ return __builtin_bit_cast(s16x4,__builtin_amdgcn_ds_read_tr16_b64_v4i16((__attribute__((address_space(3))) v4i16_t*)p)); }
__device__ __forceinline__ float rowmax(const f32x16&p0,const f32x16&p1){
  float a=max3f(p0[0],p0[1],p1[0]),b=max3f(p0[2],p0[3],p1[1]);a=max3f(a,p1[2],p1[3]);
  #pragma unroll
  for(int r=4;r<16;r+=4){a=max3f(a,p0[r],p0[r+1]);b=max3f(b,p0[r+2],p0[r+3]);a=max3f(a,p1[r],p1[r+1]);b=max3f(b,p1[r+2],p1[r+3]);}
  const float m=max2f(a,b);
  auto rr=__builtin_amdgcn_permlane32_swap(__float_as_uint(m),__float_as_uint(m),false,false);
  return max2f(__uint_as_float(rr[0]),__uint_as_float(rr[1]));
}
__device__ __forceinline__ void pv(f32x16*o,int vb,bf16x8 pa0,bf16x8 pa1,bf16x8 pa2,bf16x8 pa3){
  #pragma unroll
  for(int d0=0;d0<2;++d0){s16x4 lo[4],hi[4];
    #pragma unroll
    for(int ks=0;ks<4;++ks){
      asm volatile("ds_read_b64_tr_b16 %0,%1 offset:%c2":"=&v"(lo[ks]):"v"(vb),"i"(d0*4096+ks*1024):"memory");
      asm volatile("ds_read_b64_tr_b16 %0,%1 offset:%c2":"=&v"(hi[ks]):"v"(vb),"i"(d0*4096+ks*1024+512):"memory");}
    asm volatile("s_waitcnt lgkmcnt(0)":::"memory");SBAR();
    #define PK(k) (bf16x8){lo[k][0],lo[k][1],lo[k][2],lo[k][3],hi[k][0],hi[k][1],hi[k][2],hi[k][3]}
    o[d0]=__builtin_amdgcn_mfma_f32_32x32x16_bf16(pa0,PK(0),o[d0],0,0,0);
    o[d0]=__builtin_amdgcn_mfma_f32_32x32x16_bf16(pa1,PK(1),o[d0],0,0,0);
    o[d0]=__builtin_amdgcn_mfma_f32_32x32x16_bf16(pa2,PK(2),o[d0],0,0,0);
    o[d0]=__builtin_amdgcn_mfma_f32_32x32x16_bf16(pa3,PK(3),o[d0],0,0,0);
    #undef PK
  }
}

#ifndef ATTN_STORE16
#define ATTN_STORE16(p,v) (*(u32x4*)(p)=(v))
#endif
template<int THRL> __device__ __forceinline__ void attn_unit(int b,int h,int qb,int t0,const bf16*Z,const float*c2g,bf16*O,char*shm){
  int tid_=threadIdx.x; asm volatile("":"+v"(tid_));
  const int tid=tid_,lane=tid&63,r32=lane&31,hi=lane>>5; const int wid=__builtin_amdgcn_readfirstlane(tid>>6);
  const long rowbase=(long)b*SEQ; const int q0=qb*QB;
  const bf16*Qw=Z+(rowbase+q0+wid*QBLK)*DM+h*D;
  const bf16*Kh=Z+(rowbase+(long)t0*KVBLK)*DM+512+h*D,*Vh=Z+(rowbase+(long)t0*KVBLK)*DM+1024+h*D;
  const unsigned lds0=(unsigned)(uintptr_t)shm;
  float*wsf=(float*)(shm+LDS_WS)+wid*64;
  const bf16*ksrc=Kh+(long)lane*DM+wid*8;
  const bf16*vsrc=Vh+(long)(16*(wid&3)+(lane>>2))*DM+(wid>>2)*32+(lane&3)*8;
  const unsigned kdst=lds0+LDS_K+wid*1024, vdst=lds0+LDS_V+wid*1024;
  #define DMA_K(t,slot) glds16(ksrc+(long)(t)*KVBLK*DM,(unsigned)__builtin_amdgcn_readfirstlane(kdst+(slot)))
  #define DMA_V(t,slot) glds16(vsrc+(long)(t)*KVBLK*DM,(unsigned)__builtin_amdgcn_readfirstlane(vdst+(slot)))
  const int vb0=(int)(lds0+LDS_V)+((lane>>4)&1)*32+(lane&3)*8+(4*hi+((lane&15)>>2))*64;
  const char*Kbase=shm+LDS_K; bf16x8 kf[8];
  const lds_cptr shm3=(lds_cptr)shm; const lds_cptr kp0=shm3+LDS_K+hi*1024+r32*16; const lds_cptr vp0=shm3+LDS_V+((lane>>4)&1)*32+(lane&3)*8+(4*hi+((lane&15)>>2))*64;
  const int NT=(q0+QB)/KVBLK-t0;
  { const int np=(q0+QB)/256;
    for(int p=(t0>>2)+wid;p<np;p+=NW) glds16(c2g+p*256+lane*4,(unsigned)__builtin_amdgcn_readfirstlane(lds0+LDS_C2+p*1024)); }
  const __attribute__((address_space(3))) float* c2l=(const __attribute__((address_space(3))) float*)(shm3+LDS_C2)+t0*KVBLK+4*hi;
  DMA_K(0,0);DMA_V(0,0);DMA_K(1,SLOTB);
  bf16x8 qr[4];
  #pragma unroll
  for(int d0=0;d0<4;++d0)qr[d0]=*reinterpret_cast<const bf16x8*>(&Qw[(long)r32*DM+d0*16+hi*8]);
  float l_reg=0.f;f32x16 o[2];o[0]=f32x16{};o[1]=f32x16{};
  float base=c2g[q0+wid*QBLK+r32];
  const int qrel=wid*QBLK+r32;
  #define CMASK(P0,P1,t) do{int jb_=(t)-(NT-4); if(jb_>=0)cmask(P0,P1,jb_,qrel,hi);}while(0)
  bool resc=false;
  #define START(P0,P1) do{ const float rm=rowmax(P0,P1); resc=false; \
    { const float dl=rm; base=fsub_s(base,dl); \
      _Pragma("unroll") for(int r=0;r<16;++r){P0[r]=fsub_s(P0[r],dl);P1[r]=fsub_s(P1[r],dl);} } \
    _Pragma("unroll") for(int r=0;r<16;++r)P0[r]=__builtin_amdgcn_exp2f(P0[r]); }while(0)
  #define RESC() do{ if(resc){ asm volatile("s_waitcnt lgkmcnt(0)":::"memory"); \
      _Pragma("unroll") for(int d_=0;d_<2;++d_) _Pragma("unroll") for(int r=0;r<16;++r)o[d_][r]*=wsf[crow(r,hi)]; } }while(0)
  f32x16 pA0,pA1,pB0,pB1;
  #define BIASLD(P0,P1,tt) do{ _Pragma("unroll") for(int g_=0;g_<4;++g_){ const f32x4v x0_=*(const __attribute__((address_space(3))) f32x4v*)(c2l+(tt)*KVBLK+8*g_), x1_=*(const __attribute__((address_space(3))) f32x4v*)(c2l+(tt)*KVBLK+32+8*g_); \
      P0[4*g_]=x0_[0];P0[4*g_+1]=x0_[1];P0[4*g_+2]=x0_[2];P0[4*g_+3]=x0_[3]; P1[4*g_]=x1_[0];P1[4*g_+1]=x1_[1];P1[4*g_+2]=x1_[2];P1[4*g_+3]=x1_[3]; } }while(0)
  #define BIASFIX(P0,P1) do{ _Pragma("unroll") for(int r=0;r<16;++r){P0[r]=fsub_s(base,P0[r]);P1[r]=fsub_s(base,P1[r]);} }while(0)
  int sl_prev=0,sl_cur=0,sl_next=SLOTB;
  #define ROT() do{sl_prev=sl_cur;sl_cur=sl_next;sl_next=(sl_next==(NSLOT-1)*SLOTB)?0:sl_next+SLOTB;}while(0)
  DMA_K(2,2*SLOTB);
  WAIT_BAR(3);
  BIASLD(pA0,pA1,0); BIASFIX(pA0,pA1);
  qkt(pA0,pA1,Kbase,qr,r32,hi);asm volatile("s_nop 15\n\ts_nop 7":"+v"(pA0),"+v"(pA1));CMASK(pA0,pA1,0);
  START(pA0,pA1);
  _Pragma("unroll") for(int r=0;r<16;++r)pA1[r]=__builtin_amdgcn_exp2f(pA1[r]);
  BIASLD(pB0,pB1,1);
  WAIT_BAR(0);
  DMA_K(3,0);DMA_V(1,SLOTB);
  ROT();
  kload8(kf,kp0+sl_cur);
  WAIT_BAR(2);
  s16x4 vlo[8],vhi[8]; u32x4 pw0,pw1,pw2,pw3;
  #define PKW(P,B) cvtpk_s(P[B],P[B+1])
  #define PAF(k) __builtin_bit_cast(bf16x8,pw##k)
  #define VFR(i) (bf16x8){vlo[i][0],vlo[i][1],vlo[i][2],vlo[i][3],vhi[i][0],vhi[i][1],vhi[i][2],vhi[i][3]}
  #define PIN(x) asm volatile("":"+v"(x))
  #define MX3(a,b,c) __builtin_fmaxf(__builtin_fmaxf((a),(b)),(c))
  #define GAPA(MF,A0,A1,A2,A3,W0,W1,PW) do{ MF; sacc+=A0; sacc+=A1; sacc+=A2; sacc+=A3; PIN(sacc); W0; W1; PIN(PW); SBAR(); }while(0)
  #define EX(v) __builtin_amdgcn_exp2f(v)
  #define GAPB(MF,X,B) do{ MF; X[B]=EX(X[B]); X[B+1]=EX(X[B+1]); X[B+2]=EX(X[B+2]); X[B+3]=EX(X[B+3]); PIN(X); SBAR(); }while(0)
  #define VRD(i) do{ vlo[i]=vtr(vp_+(((i)>>2)*4096+((i)&3)*1024)); vhi[i]=vtr(vp_+(((i)>>2)*4096+((i)&3)*1024+512)); }while(0)
  #define KRD(G,j) do{ if(G){ kload2(kf,kp0+sl_next,j); SBAR(); } }while(0)
  #define STEP(C0,C1,P0,P1,t,GK,GV,GL) do{ SBAR(); \
    BIASFIX(C0,C1); SBAR(); \
    const lds_cptr vp_=vp0+sl_prev; \
    VRD(0); SBAR(); float sacc=(P0[0]+P0[1]); \
    GAPA(C0=__builtin_amdgcn_mfma_f32_32x32x16_bf16(kf[0],qr[0],C0,0,0,0), P0[2],P0[3],P0[4],P0[5],     pw0[0]=PKW(P0,0), pw0[1]=PKW(P0,2), pw0); \
    VRD(4); SBAR(); GAPA(C1=__builtin_amdgcn_mfma_f32_32x32x16_bf16(kf[1],qr[0],C1,0,0,0), P0[6],P0[7],P0[8],P0[9],     pw0[2]=PKW(P0,4), pw0[3]=PKW(P0,6), pw0); \
    VRD(1); SBAR(); GAPA(C0=__builtin_amdgcn_mfma_f32_32x32x16_bf16(kf[2],qr[1],C0,0,0,0),   P0[10],P0[11],P0[12],P0[13], pw1[0]=PKW(P0,8), pw1[1]=PKW(P0,10), pw1); \
    VRD(5); SBAR(); GAPA(C1=__builtin_amdgcn_mfma_f32_32x32x16_bf16(kf[3],qr[1],C1,0,0,0),   P0[14],P0[15],P1[0],P1[1],   pw1[2]=PKW(P0,12),pw1[3]=PKW(P0,14), pw1); \
    VRD(2); SBAR(); GAPA(C0=__builtin_amdgcn_mfma_f32_32x32x16_bf16(kf[4],qr[2],C0,0,0,0),   P1[2],P1[3],P1[4],P1[5],     pw2[0]=PKW(P1,0), pw2[1]=PKW(P1,2), pw2); \
    VRD(6); SBAR(); GAPA(C1=__builtin_amdgcn_mfma_f32_32x32x16_bf16(kf[5],qr[2],C1,0,0,0),   P1[6],P1[7],P1[8],P1[9],     pw2[2]=PKW(P1,4), pw2[3]=PKW(P1,6), pw2); \
    VRD(3); SBAR(); GAPA(C0=__builtin_amdgcn_mfma_f32_32x32x16_bf16(kf[6],qr[3],C0,0,0,0),   P1[10],P1[11],P1[12],P1[13], pw3[0]=PKW(P1,8), pw3[1]=PKW(P1,10), pw3); \
    VRD(7); SBAR(); GAPA(C1=__builtin_amdgcn_mfma_f32_32x32x16_bf16(kf[7],qr[3],C1,0,0,0),   P1[14],P1[15],0.f,0.f,       pw3[2]=PKW(P1,12),pw3[3]=PKW(P1,14), pw3); \
    l_reg+=sacc; \
    if(GL){BIASLD(P0,P1,(t)+1);} \
    if(GK){DMA_K((t)+3,sl_cur);} if(GV){DMA_V((t)+1,sl_next);} \
    CMASK(C0,C1,t); \
    { float a=MX3(C0[0],C0[1],C1[0]),b=MX3(C0[2],C0[3],C1[1]); a=MX3(a,C1[2],C1[3]); \
      _Pragma("unroll") for(int r=4;r<16;r+=4){a=MX3(a,C0[r],C0[r+1]);b=MX3(b,C0[r+2],C0[r+3]);a=MX3(a,C1[r],C1[r+1]);b=MX3(b,C1[r+2],C1[r+3]);} \
      float rm=__builtin_fmaxf(a,b); { auto rr=__builtin_amdgcn_permlane32_swap(__float_as_uint(rm),__float_as_uint(rm),false,false); rm=__builtin_fmaxf(__uint_as_float(rr[0]),__uint_as_float(rr[1])); } \
      resc=false; \
      if(__builtin_expect(__any(rm>(float)THRL),0)){ const float dl=__builtin_fmaxf(rm,0.f); base-=dl; \
        _Pragma("unroll") for(int r=0;r<16;++r){C0[r]-=dl;C1[r]-=dl;} \
        const float f=__builtin_amdgcn_exp2f(-dl); l_reg*=f; if(hi==0)wsf[r32]=f; resc=true; } } \
    SBAR(); \
    GAPB(o[0]=__builtin_amdgcn_mfma_f32_32x32x16_bf16(PAF(0),VFR(0),o[0],0,0,0), C0,0); \
    GAPB(o[1]=__builtin_amdgcn_mfma_f32_32x32x16_bf16(PAF(0),VFR(4),o[1],0,0,0), C0,4); \
    KRD(GL,0); GAPB(o[0]=__builtin_amdgcn_mfma_f32_32x32x16_bf16(PAF(1),VFR(1),o[0],0,0,0), C0,8); \
    KRD(GL,1); GAPB(o[1]=__builtin_amdgcn_mfma_f32_32x32x16_bf16(PAF(1),VFR(5),o[1],0,0,0), C0,12); \
    KRD(GL,2); GAPB(o[0]=__builtin_amdgcn_mfma_f32_32x32x16_bf16(PAF(2),VFR(2),o[0],0,0,0), C1,0); \
    KRD(GL,3); GAPB(o[1]=__builtin_amdgcn_mfma_f32_32x32x16_bf16(PAF(2),VFR(6),o[1],0,0,0), C1,4); \
    GAPB(o[0]=__builtin_amdgcn_mfma_f32_32x32x16_bf16(PAF(3),VFR(3),o[0],0,0,0), C1,8); \
    GAPB(o[1]=__builtin_amdgcn_mfma_f32_32x32x16_bf16(PAF(3),VFR(7),o[1],0,0,0), C1,12); \
    }while(0)
  int t=1;
  #undef CMASK
  #define CMASK(P0,P1,t) do{}while(0)
  for(;t+5<NT;t+=2){
    STEP(pB0,pB1,pA0,pA1,t,true,true,true);     WAIT_BAR(2); RESC(); ROT();
    STEP(pA0,pA1,pB0,pB1,t+1,true,true,true);   WAIT_BAR(2); RESC(); ROT();
  }
  #undef CMASK
  #define CMASK(P0,P1,t) do{int jb_=(t)-(NT-4); if(jb_>=0)cmask(P0,P1,jb_,qrel,hi);}while(0)
  #define ENDW(tt) do{ if((tt)+3<NT){WAIT_BAR(2);} else if((tt)+2<NT){WAIT_BAR(1);} else {WAIT_BAR(0);} }while(0)
  for(;t+1<NT;t+=2){
    STEP(pB0,pB1,pA0,pA1,t,(t+3<NT),(t+1<NT),(t+1<NT));       ENDW(t);   RESC(); ROT();
    STEP(pA0,pA1,pB0,pB1,t+1,(t+4<NT),(t+2<NT),(t+2<NT));     ENDW(t+1); RESC(); ROT();
  }
  STEP(pB0,pB1,pA0,pA1,NT-1,false,false,false); RESC();
  { float sacc=pB0[0]+pB0[1]; _Pragma("unroll") for(int r=2;r<16;++r)sacc+=pB0[r]; _Pragma("unroll") for(int r=0;r<16;++r)sacc+=pB1[r]; l_reg+=sacc;
    pw0=(u32x4){PKW(pB0,0),PKW(pB0,2),PKW(pB0,4),PKW(pB0,6)};pw1=(u32x4){PKW(pB0,8),PKW(pB0,10),PKW(pB0,12),PKW(pB0,14)};pw2=(u32x4){PKW(pB1,0),PKW(pB1,2),PKW(pB1,4),PKW(pB1,6)};pw3=(u32x4){PKW(pB1,8),PKW(pB1,10),PKW(pB1,12),PKW(pB1,14)};
    SBAR(); pv(o,vb0+sl_cur,PAF(0),PAF(1),PAF(2),PAF(3)); }
  #undef PKW
  #undef PAF
  #undef VFR
  #undef PIN
  #undef MX3
  #undef GAPA
  #undef GAPB
  #undef EX
  #undef VRD
  #undef KRD
  #undef STEP
  #undef ENDW
  {auto rr=__builtin_amdgcn_permlane32_swap(__float_as_uint(l_reg),__float_as_uint(l_reg),false,false);l_reg=__uint_as_float(rr[0])+__uint_as_float(rr[1]);}
  if(hi==0)wsf[32+r32]=l_reg;asm volatile("s_waitcnt lgkmcnt(0)":::"memory");
  float rli[16];
  #pragma unroll
  for(int r=0;r<16;++r)rli[r]=__builtin_amdgcn_rcpf(wsf[32+crow(r,hi)]);
  bf16*Ow=O+(rowbase+q0+wid*QBLK)*OP+h*D; const bf16*Gw=Z+(rowbase+q0+wid*QBLK)*DM+1536+h*D;
  { bf16*stg=(bf16*)(shm+LDS_OST)+wid*2048;
    #pragma unroll
    for(int r=0;r<16;++r){const int orow=crow(r,hi);
      #pragma unroll
      for(int d0=0;d0<2;++d0)stg[orow*64+d0*32+r32]=(bf16)f2bf(o[d0][r]*rli[r]);}
    asm volatile("s_waitcnt lgkmcnt(0)":::"memory");
    #pragma unroll
    for(int i=0;i<4;++i){const int row=i*8+(lane>>3),ch=lane&7; const u32x4 v=*(const u32x4*)(stg+row*64+ch*8), g=*(const u32x4*)(Gw+(long)row*DM+ch*8);
      const unsigned vw[4]={v.x,v.y,v.z,v.w},gw[4]={g.x,g.y,g.z,g.w}; unsigned ow[4];
      #pragma unroll
      for(int j=0;j<4;++j){ const float a0=bflo(vw[j])*__builtin_amdgcn_rcpf(1.0f+__expf(-bflo(gw[j]))), a1=bfhi(vw[j])*__builtin_amdgcn_rcpf(1.0f+__expf(-bfhi(gw[j]))); ow[j]=cvtpk_s(a0,a1); }
      ATTN_STORE16(Ow+(long)row*OP+ch*8,((u32x4){ow[0],ow[1],ow[2],ow[3]}));} }
  asm volatile("s_waitcnt lgkmcnt(0)\n\ts_barrier":::"memory");
  #undef DMA_K
  #undef DMA_V
  #undef CMASK
  #undef START
  #undef RESC
  #undef ROT
}
constexpr int ATTN_LDS_BYTES=LDS_BYTES;
#undef SBAR
#undef WAIT_BAR
}
constexpr int CW_QATT = 128, CW_QCVT = 384;
constexpr int MISC_TAB = 64, MISC_Q = 4096, MISC_PFX = 4160;

__device__ __forceinline__ int attn_t0(KPR P, const float* c2, int q0, int lane) {
    float gq = fabsf(P.q_norm[lane]), gk = fabsf(P.k_norm[lane]);
#pragma unroll
    for (int o = 1; o < 64; o <<= 1) { gq = fmaxf(gq, __shfl_xor(gq, o)); gk = fmaxf(gk, __shfl_xor(gk, o)); }
    const float thr = c2[q0] + (2.0f * 8.0f * LOG2E * gq * gk + 40.0f);
    const int nfull = q0 / 64; int t0 = 0;
    for (int tb = 0; tb < nfull; tb += 64) { const int tt = tb + lane; const bool sk = (tt < nfull) && (c2[tt * 64 + 63] > thr); const unsigned long long bm = __ballot(sk); t0 += __popcll(bm); if (bm != ~0ull) break; }
    return __builtin_amdgcn_readfirstlane(t0) & ~1;
}
template <int NR>
__device__ __forceinline__ void combine_rows(KPR P, const LAS int* tab, const int (&rows)[NR], int lane) {
    const int* route = (const int*)(P.ws + WS_ROUTE); const unsigned char* YP = P.ws + WS_YP; bf16_t* X = (bf16_t*)(P.ws + WS_X1);
    u32x2 xv[NR][4]; unsigned yv[NR][4][4];
#pragma unroll
    for (int r = 0; r < NR; ++r) { const u32x2* xr = (const u32x2*)(X + (size_t)rows[r] * DM) + lane;
#pragma unroll
        for (int j = 0; j < 4; ++j) xv[r][j] = xr[64 * j]; }
#pragma unroll
    for (int r = 0; r < NR; ++r)
#pragma unroll
        for (int k = 0; k < 4; ++k) { const int ex = route[(size_t)rows[r] * 12 + k], rank = route[(size_t)rows[r] * 12 + 4 + k]; const size_t pos = (size_t)tab[pg8::T_BLKSTART + ex] * 256 + rank;
            const unsigned* yr = (const unsigned*)(YP + pos * DM) + lane;
#pragma unroll
            for (int j = 0; j < 4; ++j) yv[r][k][j] = yr[64 * j]; }
#pragma unroll
    for (int r = 0; r < NR; ++r) { f32x4 v[4];
#pragma unroll
        for (int j = 0; j < 4; ++j) v[j] = (f32x4){bflo(xv[r][j].x), bfhi(xv[r][j].x), bflo(xv[r][j].y), bfhi(xv[r][j].y)};
#pragma unroll
        for (int k = 0; k < 4; ++k)
#pragma unroll
            for (int j = 0; j < 4; ++j) { const unsigned y = yv[r][k][j]; const f32x2 lo = __builtin_amdgcn_cvt_pk_f32_fp8((int)y, false), hi = __builtin_amdgcn_cvt_pk_f32_fp8((int)y, true);
                v[j][0] += lo[0] * 0.25f; v[j][1] += lo[1] * 0.25f; v[j][2] += hi[0] * 0.25f; v[j][3] += hi[1] * 0.25f; }
        u32x2* xo = (u32x2*)(X + (size_t)rows[r] * DM) + lane; float s = 0.f;
#pragma unroll
        for (int j = 0; j < 4; ++j) { u32x2 w; w.x = pk2(v[j][0], v[j][1]); w.y = pk2(v[j][2], v[j][3]); xo[64 * j] = w; v[j] = (f32x4){bflo(w.x), bfhi(w.x), bflo(w.y), bfhi(w.y)}; s += (v[j][0] * v[j][0] + v[j][1] * v[j][1]) + (v[j][2] * v[j][2] + v[j][3] * v[j][3]); }
        const float rstd = rsqrtf(wave_sum(s) * (1.f / DM) + 1e-6f);
#pragma unroll
        for (int j = 0; j < 4; ++j) v[j] = v[j] * rstd * ((const f32x4*)P.ple_norm)[64 * j + lane];
        store_row_fp8(P.ws + WS_XN + (size_t)rows[r] * DM, lane, v); }
}

constexpr int NPHASE = 13;
__global__ void __launch_bounds__(NTHREADS, 2) mega_fwd(Params Pkarg_unused) {
    extern __shared__ __attribute__((aligned(16))) unsigned char smem[];
    LAS unsigned char* lds = (LAS unsigned char*)smem;
    const int tid = threadIdx.x, lane = tid & 63, wave = __builtin_amdgcn_readfirstlane(tid >> 6);
    const int G = gridDim.x, blk = blockIdx.x;
#define P (*kpp)
#ifndef MK_REP
#define MK_REP -1
#endif
#define PHASE_BEGIN(k) if (IN(k)) for (int rep_ = 0; rep_ < ((k) == MK_REP ? 2 : 1); ++rep_) { const __attribute__((address_space(4))) Params* kpp = kp_fresh();
#define PHASE_END(k) } if (BOTH(k)) { XcdBarrier bar_; bar_.bar = (unsigned*)((*kp_fresh()).ws + WS_CTL) + CW_BAR; bar_.x = xb_xcc_id(); bar_.st = (volatile LAS unsigned*)(lds + MISC_OFF); xcd_barrier(bar_); }
#define IN(k) (ph_lo <= (k) && (k) < ph_hi)
#define BOTH(k) (IN(k) && IN((k) + 1))
    const __attribute__((address_space(4))) Params* kpp = kp_fresh();
    if (tid < 16) ((volatile LAS unsigned*)(lds + MISC_OFF))[tid] = 0u;
    __syncthreads();
    (void)xcd_barrier_post((unsigned*)(P.ws + WS_CTL) + CW_BAR, (volatile LAS unsigned*)(lds + MISC_OFF));
    const int ph_lo = P.ph_lo, ph_hi = P.ph_hi;
#define wsb (P.ws)
#define ctl ((unsigned*)(P.ws + WS_CTL))
#define MISC ((volatile LAS unsigned*)(lds + MISC_OFF))
#define tab ((LAS int*)(lds + MISC_OFF + MISC_TAB))

    PHASE_BEGIN(0)
        phase_prep_weights(P, lds, blk * NWAVES + wave, G * NWAVES, wave, lane);
        phase_cvt_p(P, blk * NTHREADS + tid, G * NTHREADS);
        __syncthreads();
        LAS float* wff = (LAS float*)lds; LAS float* lf = (LAS float*)(lds + 32768);
        load_wff(P, wff, tid, NTHREADS); __syncthreads();
        for (int i = 0; i < 16; ++i) { const int rl = wave * 16 + i; norm1_row(P, blk * 128 + rl, lane, wff, lf + rl * 8); }
        __syncthreads();
        if (tid < 64) { const int h = tid & 7, seg = tid >> 3; float c16[16]; float run = 0.f;
#pragma unroll
            for (int r = 0; r < 16; ++r) { run += lf[(seg * 16 + r) * 8 + h]; c16[r] = run; }
            float incl = run;
#pragma unroll
            for (int o = 8; o < 64; o <<= 1) { const float t = __shfl_up(incl, o); if (tid >= o) incl += t; }
            const float pre = incl - run; float* cloc = (float*)(P.ws + WS_LOGF) + ((size_t)blk * 128 + seg * 16) * 8 + h;
#pragma unroll
            for (int r = 0; r < 16; ++r) cloc[r * 8] = pre + c16[r];
            if (seg == 7) ((float*)(P.ws + WS_CTOT))[blk * 8 + h] = incl; }
        if (blk >= G - 16) rt::build_w(P, blk - (G - 16), tid);
    PHASE_END(0)

    PHASE_BEGIN(1)
        {
            LAS float* pfx = (LAS float*)(lds + MISC_OFF + MISC_PFX);
            if (tid < 64) { const float* ct = (const float*)(wsb + WS_CTOT); const int j = (blk & ~63) + tid; float v8[8];
#pragma unroll
                for (int h = 0; h < 8; ++h) v8[h] = (j < blk) ? ct[j * 8 + h] : 0.f;
#pragma unroll
                for (int h = 0; h < 8; ++h) { const float s = wave_sum(v8[h]); if (tid == 0) pfx[h] = s; } }
            __syncthreads();
            const float* cloc = (const float*)(wsb + WS_LOGF) + (size_t)blk * 128 * 8; float* c2 = (float*)(P.ws + WS_C2);
            for (int i = tid; i < 1024; i += NTHREADS) { const int r = i >> 3, h = i & 7; const int row = blk * 128 + r, b = row >> 13, t = row & (SEQ - 1);
                c2[((size_t)(b * 8 + h)) * SEQ + t] = (cloc[i] + pfx[h]) * LOG2E; }
            __syncthreads();
        }
        {
            pg8::DenseOrder S{(const bf16_t*)(wsb + WS_XN), (const bf16_t*)(wsb + WS_WIN), 1024, NTOK / 256, ZW / 256, G, blk};
            pg8::EpiIn E{(bf16_t*)(P.ws + WS_Z), P.q_norm, P.k_norm};
            pg8::gemm_phase<pg8::EpiIn, pg8::DenseOrder, true>(lds, 1024, S, E);
        }
        {
            pg8::DenseOrder S{(const bf16_t*)((unsigned char*)P.out + DO_PB), (const bf16_t*)(wsb + WS_WPP), PLE, NTOK / 256, DM / 256, G / 2, blk >= G / 2 ? blk - G / 2 : (1 << 20)};
            pg8::EpiBf16 E{(bf16_t*)((unsigned char*)P.out + DO_PJ), DM};
            pg8::gemm_phase<pg8::EpiBf16, pg8::DenseOrder, true>(lds, PLE, S, E);
        }
    PHASE_END(1)

    PHASE_BEGIN(2)
        rk::lora_block(P, lds, blk, G, tid);
        __syncthreads();
        { LAS float* cscr = (LAS float*)(lds + ((wave & 3) == 0 ? 125184 : MISC_OFF + 64 + ((wave & 3) - 1) * 4608));
          for (int i = 0; i < 16; ++i) rk::pass1_chunk(P, lds, (blk >> 6) * 8 + (i & 7), 2 * (blk & 63) + (i >> 3), tid, (blk * 16 + i) * 8, cscr); }
    PHASE_END(2)

    PHASE_BEGIN(4)
        if (blk < NB * NH) rk::pass2_seq(P, lds, blk, tid);
#define CVT_LOOP() for (;;) { __syncthreads(); if (tid == 0) MISC[MISC_Q / 4] = __hip_atomic_fetch_add(ctl + CW_QCVT + 64 * rep_, 1u, RLX_AGENT); __syncthreads(); \
            const int q = (int)MISC[MISC_Q / 4]; if (q >= NCVT) break; cvt_task(P, lds, CVT_TASK0 + q, wave, lane); }
        if (((blk >> 3) & 3) == 1) { CVT_LOOP() }
        for (;;) {
            __syncthreads();
            if (tid == 0) MISC[MISC_Q / 4] = __hip_atomic_fetch_add(ctl + CW_QATT + 64 * rep_, 1u, RLX_AGENT);
            __syncthreads();
            const int q = (int)MISC[MISC_Q / 4];
            if (q >= 1024) break;
            { const int bh = q & 31, qb = 31 - (q >> 5); const float* c2 = (const float*)(wsb + WS_C2) + (size_t)bh * SEQ;
              const int t0 = attn_t0(P, c2, qb * 256, lane);
              attn_body::attn_unit<8>(bh >> 3, bh & 7, qb, t0, (const bf16_t*)(wsb + WS_Z), c2, (bf16_t*)(P.ws + WS_AO), (char*)smem); }
        }
        if (((blk >> 3) & 3) != 1) { CVT_LOOP() }
#undef CVT_LOOP
    PHASE_END(4)

    PHASE_BEGIN(5)
        for (int task = blk; task < NB * NH * rk::NCHUNK; task += G) rk::pass3_chunk(P, lds, task >> 7, task & 127, tid);
    PHASE_END(5)

    PHASE_BEGIN(6)
        pg8::DenseOrder S{(const bf16_t*)(wsb + WS_AO), (const bf16_t*)(wsb + WS_WOUT), 1024, NTOK / 256, DM / 256, G, blk};
        pg8::EpiOut E{P.x, (bf16_t*)(P.ws + WS_X1)};
        pg8::gemm_phase<pg8::EpiOut, pg8::DenseOrder, true>(lds, 1024, S, E);
    PHASE_END(6)

    PHASE_BEGIN(7)
        rt::copy_w(P, lds, tid);
        if (blk == 0 && tid < 256) ((unsigned*)(P.ws + WS_XN + (size_t)NTOK * DM))[tid] = 0u;
        __syncthreads();
        if (wave < 4) { for (int task = wave * G + blk; task < NTOK / 32; task += 4 * G) rt::route_task(P, lds, task, lane); }
        else { for (int task = (wave - 4) * G + blk; task < NTOK / 32; task += 4 * G) rt::xn8_task(P, task, lane); }
    PHASE_END(7)

    PHASE_BEGIN(8)
        const int nblk = pg8::moe_tables(tab, (const unsigned*)(wsb + WS_CTL) + CW_CNT);
        pg8::MoeOrder S{wsb + WS_XN, wsb + WS_WGU, (const int*)(wsb + WS_TOKSLOT), (const float*)(wsb + WS_GATESLOT), tab, nblk, 8, G, blk, true};
        pg8::EpiGu E{P.ws + WS_ACT, P.b_gu};
        pg8::gemm_phase<pg8::EpiGu, pg8::MoeOrder, true, true>(lds, 1024, S, E);
    PHASE_END(8)
    PHASE_BEGIN(9)
        const int nblk = pg8::moe_tables(tab, (const unsigned*)(wsb + WS_CTL) + CW_CNT);
        pg8::MoeOrder S{wsb + WS_ACT, wsb + WS_WDN, (const int*)(wsb + WS_TOKSLOT), (const float*)(wsb + WS_GATESLOT), tab, nblk, 4, G, blk, false};
        pg8::EpiDn E{P.ws + WS_YP, P.b_down, (const float*)(wsb + WS_GATESLOT), tab};
        pg8::gemm_phase<pg8::EpiDn, pg8::MoeOrder, true, true>(lds, 1024, S, E);
    PHASE_END(9)
    PHASE_BEGIN(10)
        (void)pg8::moe_tables(tab, (const unsigned*)(wsb + WS_CTL) + CW_CNT);
        for (int row = blk * NWAVES + wave; row < NTOK; row += 2 * G * NWAVES) { const int rows[2] = {row, row + G * NWAVES}; combine_rows<2>(P, tab, rows, lane); }
    PHASE_END(10)
    PHASE_BEGIN(11)
        pg8::DenseOrder S{wsb + WS_XN, wsb + WS_WPG, 512, NTOK / 256, DM / 256, G, blk};
        pg8::EpiPg E{(bf16_t*)(P.ws + WS_X1), (const bf16_t*)((unsigned char*)P.out + DO_PJ)};
        pg8::gemm_phase<pg8::EpiPg, pg8::DenseOrder, true, true>(lds, 1024, S, E);
    PHASE_END(11)
    PHASE_BEGIN(12)
        const bool dead = __hip_atomic_load(ctl + CW_BAR + XB_TMO, RLX_AGENT) != 0u;
        for (int row = blk * NWAVES + wave; row < NTOK; row += G * NWAVES) final_row(P, row, lane, dead);
    PHASE_END(12)
}
#undef P
#undef wsb
#undef ctl
#undef MISC
#undef tab
extern "C" void kernel_launch(void* const* d_in, const int* in_sizes, int n_in, void* d_out, int out_size, void* d_ws, size_t ws_size, hipStream_t stream) {
    static int ok = 0;
    if (ok == 0) {
        if (n_in != 30 || in_sizes[0] != NTOK * DM || out_size != NTOK * DM || ws_size < WS_END) { fprintf(stderr, "kernel_launch: unexpected shapes (n_in %d, ws %zu)\n", n_in, ws_size); ok = -1; return; }
        if (hipFuncSetAttribute((const void*)mega_fwd, hipFuncAttributeMaxDynamicSharedMemorySize, LDS_BYTES) != hipSuccess) { fprintf(stderr, "kernel_launch: hipFuncSetAttribute failed\n"); ok = -1; return; }
        int dev = 0, cus = 0, per_cu = 0;
        if (hipGetDevice(&dev) != hipSuccess || hipDeviceGetAttribute(&cus, hipDeviceAttributeMultiprocessorCount, dev) != hipSuccess) { ok = -1; return; }
        if (hipOccupancyMaxActiveBlocksPerMultiprocessor(&per_cu, (const void*)mega_fwd, NTHREADS, LDS_BYTES) != hipSuccess || per_cu < 1) { fprintf(stderr, "kernel_launch: occupancy query says %d\n", per_cu); }
        (void)hipGetLastError();
        if (cus != 256) { fprintf(stderr, "kernel_launch: built for 256 CUs, device has %d\n", cus); ok = -1; return; }
        ok = 1;
    }
    if (ok < 0) return;
    Params P{};
    const float** pp = (const float**)&P;
    for (int i = 0; i < 30; ++i) pp[i] = (const float*)d_in[i];
    P.out = (float*)d_out; P.ws = (unsigned char*)d_ws;
    if (hipMemsetAsync((char*)d_ws + WS_CTL, 0, CTL_BYTES, stream) != hipSuccess) return;
#ifndef MK_CUTS
#define MK_CUTS 0
#endif
    if (MK_CUTS == 0) { P.ph_lo = 0; P.ph_hi = NPHASE; hipLaunchKernelGGL(mega_fwd, dim3(256), dim3(NTHREADS), LDS_BYTES, stream, P); }
    else for (int k = 0; k < NPHASE; ++k) { P.ph_lo = k; P.ph_hi = k + 1;
        hipLaunchKernelGGL(mega_fwd, dim3(256), dim3(NTHREADS), LDS_BYTES, stream, P); }
}
```

```cpp
#include <hip/hip_runtime.h>
#include <cstdio>
#include <cstdint>

#define LAS __attribute__((address_space(3)))
#define GAS __attribute__((address_space(1)))
typedef unsigned short bf16_t;
typedef short bf16x8 __attribute__((ext_vector_type(8)));
typedef float f32x2 __attribute__((ext_vector_type(2)));
typedef float f32x4 __attribute__((ext_vector_type(4)));
typedef float f32x16 __attribute__((ext_vector_type(16)));
typedef unsigned u32x2 __attribute__((ext_vector_type(2)));
typedef unsigned u32x4 __attribute__((ext_vector_type(4)));

constexpr int NB = 4, SEQ = 8192, NTOK = NB * SEQ, DM = 1024;
constexpr int NH = 8, HD = 64;
constexpr int INW = 3848;
constexpr int ZW = 3840;
constexpr int ZQ = 0, ZK = 512, ZV = 1024, ZOG = 1536, ZR = 2048;
constexpr int RW_R = 0, RW_K = 512, RW_V = 1024, RW_W = 1536, RW_A = 1600, RW_G = 1664, RWIN = 1792;
constexpr int NE = 32, TOPK = 4, EFF = 1024;
constexpr int MAXBLK = (NTOK * TOPK) / 256 + NE;
constexpr int PLE = 256;
constexpr float LOG2E = 1.4426950408889634f;
constexpr float QSCALE = 0.125f * LOG2E;

constexpr size_t MiB = 1u << 20;
constexpr size_t WS_CTL = 0, CTL_BYTES = 1 * MiB;
constexpr size_t WS_C2 = 1 * MiB;
constexpr size_t WS_LOGF = 2 * MiB;
constexpr size_t WS_ROUTE = 3 * MiB;
constexpr size_t WS_TOKSLOT = 5 * MiB;
constexpr size_t WS_GATESLOT = 9 * MiB;
constexpr size_t WS_CTOT = 13 * MiB;
constexpr size_t WS_WIN = 16 * MiB;
constexpr size_t WS_WOUT = 24 * MiB;
constexpr size_t WS_WPG = 26 * MiB;
constexpr size_t WS_WPP = 28 * MiB;
constexpr size_t WS_WGU = 32 * MiB;
constexpr size_t WS_WDN = 160 * MiB;
constexpr size_t WS_XN = 224 * MiB;
constexpr size_t WS_X1 = 290 * MiB;
constexpr size_t WS_Z = 418 * MiB;
constexpr size_t WS_AO = 658 * MiB;
constexpr size_t WS_ACT = 418 * MiB;
constexpr size_t WS_RW = 722 * MiB;
constexpr size_t WS_RR = WS_RW, WS_RK = WS_RW + 32 * MiB, WS_RV = WS_RW + 64 * MiB, WS_RG = WS_RW + 96 * MiB;
constexpr size_t WS_RLW = WS_RW + 128 * MiB;
constexpr size_t WS_RKK = WS_RW + 160 * MiB, WS_RKA = WS_RW + 192 * MiB;
constexpr size_t WS_YP = 722 * MiB;
constexpr size_t WS_END = 994 * MiB;
static_assert(WS_ACT + (size_t)MAXBLK * 256 * 1024 * 2 <= WS_RW && WS_YP + (size_t)MAXBLK * 256 * 1024 * 2 <= WS_END, "ws map");
constexpr size_t DO_PJ = 0, DO_PB = 64 * MiB;
constexpr int CW_TMO = 0, CW_CNT = 64  , CW_BAR = 4096;

struct Params {
    const float *x, *p, *mix_norm, *w_in, *f_bias, *q_norm, *k_norm, *mu, *w0, *w2, *a0, *a2, *g2, *k_k, *k_a, *r_k, *ln_w, *ln_b, *w_out, *moe_norm, *w_router, *b_router, *w_gu, *b_gu, *w_down,
        *b_down, *ple_norm, *w_pg, *w_pp, *final_norm;
    float* out; unsigned char* ws; int ph_lo, ph_hi;
};

typedef const __attribute__((address_space(4))) Params& KPR;
__device__ __forceinline__ const __attribute__((address_space(4))) Params* kp_fresh() {
    unsigned long long p = (unsigned long long)__builtin_amdgcn_kernarg_segment_ptr(); asm volatile("" : "+s"(p)); return (const __attribute__((address_space(4))) Params*)p; }

typedef __bf16 bf16x2_hw __attribute__((ext_vector_type(2)));
__device__ __forceinline__ unsigned pk2(float lo, float hi) { const f32x2 v = {lo, hi}; return __builtin_bit_cast(unsigned, __builtin_convertvector(v, bf16x2_hw)); }
__device__ __forceinline__ unsigned f2bf(float f) { return pk2(f, f) & 0xffffu; }
__device__ __forceinline__ float bf2f(unsigned h) { return __builtin_bit_cast(float, h << 16); }
__device__ __forceinline__ float bflo(unsigned w) { return __builtin_bit_cast(float, w << 16); }
__device__ __forceinline__ float bfhi(unsigned w) { return __builtin_bit_cast(float, w & 0xffff0000u); }
__device__ __forceinline__ unsigned cvt_pk_bf16(float lo, float hi) { unsigned r; asm volatile("v_cvt_pk_bf16_f32 %0, %1, %2" : "=v"(r) : "v"(lo), "v"(hi)); return r; }
__device__ __forceinline__ unsigned pk4_fp8(float a, float b, float c, float d) { int w = 0; w = __builtin_amdgcn_cvt_pk_fp8_f32(a, b, w, false); w = __builtin_amdgcn_cvt_pk_fp8_f32(c, d, w, true); return (unsigned)w; }
#define DPP_ADD(v, ctrl) ((v) + __builtin_bit_cast(float, __builtin_amdgcn_mov_dpp(__builtin_bit_cast(int, (v)), (ctrl), 0xF, 0xF, true)))
__device__ __forceinline__ float wave_sum(float v) {
    v = DPP_ADD(v, 0xB1);
    v = DPP_ADD(v, 0x4E);
    v = DPP_ADD(v, 0x124);
    v = DPP_ADD(v, 0x128);
    { float a = v, b = v; asm volatile("s_nop 1\n\tv_permlane16_swap_b32 %0, %1" : "+v"(a), "+v"(b)); v = a + b; }
    { float a = v, b = v; asm volatile("s_nop 1\n\tv_permlane32_swap_b32 %0, %1" : "+v"(a), "+v"(b)); v = a + b; }
    return v;
}
__device__ __forceinline__ float sigmoidf_(float x) { return __builtin_amdgcn_rcpf(1.0f + __expf(-x)); }
__device__ __forceinline__ float logsigmoidf_(float x) { return fminf(x, 0.f) - log1pf(expf(-fabsf(x))); }
namespace pg8 {
constexpr int BM = 256, BK = 64, HALF = 128, HTB = HALF * BK * 2, STAGE_BYTES = 8 * HTB, NXCD = 8, WGM = 8;
__host__ __device__ __forceinline__ int lds_byte(int r, int c) { const int st = (r >> 4) * 2 + (c >> 5), rr = r & 15, cc = c & 31, ob = rr * 64 + cc * 2; return st * 1024 + (ob ^ (((ob >> 9) & 1) << 5)); }
__host__ __device__ __forceinline__ void stage_rc(int b, int& R, int& C) { const int st = b / 1024, sb = b % 1024, swz = sb ^ (((sb >> 9) & 1) << 5); R = (st >> 1) * 16 + swz / 64; C = (st & 1) * 32 + (swz % 64) / 2; }
__host__ __device__ __forceinline__ int perm32(int rho) { const int n = rho >> 4, i = rho & 15; return 8 * (i >> 2) + 4 * n + (i & 3); }

struct Unit { int pm, pn, e, lb, sl; };

__device__ __forceinline__ bool tile_order(int i, int G, int c, int nM, int nN, int& pm, int& pn) {
    const int nwg = nM * nN; const long L = (long)i * G + c; if (L >= nwg) return false;
    int wgid = (int)L; { const int q = nwg / NXCD, r = nwg % NXCD, xcd = wgid % NXCD, off = wgid / NXCD; wgid = (xcd < r ? xcd * (q + 1) : r * (q + 1) + (xcd - r) * q) + off; }
    const int nig = WGM * nN, gid = wgid / nig, fm = gid * WGM, gsz = (nM - fm) < WGM ? (nM - fm) : WGM;
    pm = fm + ((wgid % nig) % gsz); pn = (wgid % nig) / gsz; return true;
}
struct DenseOrder {
    const void* A; const void* Bt; int K  , nM, nN, G, c;
    __device__ __forceinline__ bool next(int i, Unit& u) const { u.e = 0; u.lb = 0; return tile_order(i, G, c, nM, nN, u.pm, u.pn); }
    __device__ __forceinline__ const char* a_base(const Unit& u) const { return (const char*)A + (size_t)u.pm * BM * K * 2; }
    __device__ __forceinline__ const char* b_base(const Unit& u) const { return (const char*)Bt + (size_t)u.pn * BM * K * 2; }
    __device__ __forceinline__ void prefetch(const Unit&, int, int, int) const {}
    __device__ __forceinline__ void a_off(const Unit&, const int (&R)[2], const int (&C)[2], unsigned (&off)[2][2]) const {
#pragma unroll
        for (int h = 0; h < 2; ++h)
#pragma unroll
            for (int i = 0; i < 2; ++i) off[h][i] = (unsigned)((R[i] + HALF * h) * K + C[i]) * 2u;
    }
};

typedef int v8i32 __attribute__((ext_vector_type(8)));
typedef int i32x4 __attribute__((ext_vector_type(4)));
template <class Epi, class Sched, bool ALIGN_EPI, bool FP8 = false>
__device__ __forceinline__ void gemm_phase(LAS unsigned char* lds, const int K, const Sched& S, const Epi& E) {
    int tid_ = threadIdx.x; asm volatile("" : "+v"(tid_));
    const int tid = tid_, wid = __builtin_amdgcn_readfirstlane(tid >> 6), lane = tid & 63, wr = wid >> 2, wc = wid & 3, fr = lane & 15, fq = lane >> 4;
    const int RB = FP8 ? K : 2 * K;
    const int nt = RB / (BK * 2);
    int sR[2], sC[2]; unsigned voffB[2];
#pragma unroll
    for (int i = 0; i < 2; ++i) { int R, C; stage_rc(tid * 16 + i * 8192, R, C); const int Rb = Epi::PERM ? ((R & ~31) + perm32(R & 31)) : R; sR[i] = R; sC[i] = C; voffB[i] = (unsigned)(Rb * RB + C * 2); }
    const size_t kstep = (size_t)(BK * 2);
    const size_t hstep = (size_t)HALF * RB;
    const unsigned ldsw = (unsigned)wid * 1024u;
    const int aoff0 = lds_byte(wr * 64 + fr, fq * 8), aoff1 = aoff0 + 1024;
    const int boff0 = lds_byte(wc * 32 + fr, fq * 8), boff1 = boff0 + 1024;
#define PG8_SA(b, h) (((b) * 2 + (h)) * HTB)
#define PG8_SB(b, h) ((4 + (b) * 2 + (h)) * HTB)
#define PG8_STAGE(bufoff, gbase, voff) do { _Pragma("unroll") for (int _i = 0; _i < 2; ++_i) \
        __builtin_amdgcn_global_load_lds((const unsigned*)((const char*)(gbase) + (voff)[_i]), (LAS unsigned*)(lds + (bufoff) + ldsw + _i * 8192), 16, 0, 0); } while (0)
#define PG8_CAT(p0, p1) __builtin_shufflevector((p0), (p1), 0, 1, 2, 3, 4, 5, 6, 7)
#define PG8_LDA(dst, b, h) do { _Pragma("unroll") for (int m = 0; m < 4; ++m) dst[m] = PG8_CAT(*(const LAS i32x4*)(lds + PG8_SA(b, h) + aoff0 + m * 2048), *(const LAS i32x4*)(lds + PG8_SA(b, h) + aoff1 + m * 2048)); } while (0)
#define PG8_LDB(dst, b, h) do { _Pragma("unroll") for (int n = 0; n < 2; ++n) dst[n] = PG8_CAT(*(const LAS i32x4*)(lds + PG8_SB(b, h) + boff0 + n * 2048), *(const LAS i32x4*)(lds + PG8_SB(b, h) + boff1 + n * 2048)); } while (0)
#define PG8_LO(x) __builtin_bit_cast(bf16x8, __builtin_shufflevector((x), (x), 0, 1, 2, 3))
#define PG8_HI(x) __builtin_bit_cast(bf16x8, __builtin_shufflevector((x), (x), 4, 5, 6, 7))
#define PG8_MMA(ai, bj, At, Bt) do { __builtin_amdgcn_s_setprio(1); \
        if constexpr (FP8) { _Pragma("unroll") for (int m = 0; m < 4; ++m) _Pragma("unroll") for (int n = 0; n < 2; ++n) \
            asm volatile("v_mfma_scale_f32_16x16x128_f8f6f4 %0, %1, %2, %0, %3, %4 op_sel_hi:[0,0,0]" : "+v"(acc[ai][bj][m][n]) : "v"(Bt[n]), "v"(At[m]), "v"(sc_w), "v"(sc_x)); } \
        else { _Pragma("unroll") for (int m = 0; m < 4; ++m) _Pragma("unroll") for (int n = 0; n < 2; ++n) { \
            acc[ai][bj][m][n] = __builtin_amdgcn_mfma_f32_16x16x32_bf16(PG8_LO(Bt[n]), PG8_LO(At[m]), acc[ai][bj][m][n], 0, 0, 0); } \
            _Pragma("unroll") for (int m = 0; m < 4; ++m) _Pragma("unroll") for (int n = 0; n < 2; ++n) { \
            acc[ai][bj][m][n] = __builtin_amdgcn_mfma_f32_16x16x32_bf16(PG8_HI(Bt[n]), PG8_HI(At[m]), acc[ai][bj][m][n], 0, 0, 0); } } \
        __builtin_amdgcn_s_setprio(0); } while (0)
#define PG8_WAIT_V(n) asm volatile("s_waitcnt vmcnt(" #n ")" ::: "memory")
#define PG8_WAIT_L(n) asm volatile("s_waitcnt lgkmcnt(" #n ")" ::: "memory")
#define PG8_BAR __builtin_amdgcn_s_barrier()
#define PG8_SCHED __builtin_amdgcn_sched_barrier(0)
    Unit cur, nxt; int ui = 0;
    if (!S.next(0, cur)) return;
    f32x4 acc[2][2][4][2];
#pragma unroll
    for (int a = 0; a < 2; ++a)
#pragma unroll
        for (int b = 0; b < 2; ++b)
#pragma unroll
            for (int m = 0; m < 4; ++m)
#pragma unroll
                for (int n = 0; n < 2; ++n) acc[a][b][m][n] = (f32x4){0.f, 0.f, 0.f, 0.f};
    const int sc_w = 121, sc_x = 127;
    v8i32 At[4], B0[2], B1[2];
    unsigned offC[2][2], offN[2][2];
    cur.sl = 0; S.prefetch(cur, 0, wid, lane); PG8_WAIT_V(0); PG8_BAR;
    S.a_off(cur, sR, sC, offC);
    const char* cA = S.a_base(cur); const char* cB = S.b_base(cur);
    PG8_STAGE(PG8_SB(0, 0), cB, voffB); PG8_STAGE(PG8_SB(0, 1), cB + hstep, voffB); PG8_STAGE(PG8_SA(0, 0), cA, offC[0]); PG8_STAGE(PG8_SA(0, 1), cA, offC[1]);
    if (wr == 1) PG8_BAR;
    PG8_WAIT_V(2); PG8_BAR;
    PG8_STAGE(PG8_SB(1, 0), cB + kstep, voffB); PG8_STAGE(PG8_SA(1, 0), cA + kstep, offC[0]); PG8_STAGE(PG8_SB(1, 1), cB + hstep + kstep, voffB);
    PG8_WAIT_V(6); PG8_BAR;
    for (;;) {
        const bool has_next = S.next(ui + 1, nxt);
        const char* nA = cA; const char* nB = cB;
        nxt.sl = cur.sl == 2 ? 0 : cur.sl + 1;
        if (has_next) { nA = S.a_base(nxt); nB = S.b_base(nxt); S.prefetch(nxt, nxt.sl, wid, lane); }
#pragma unroll
        for (int h = 0; h < 2; ++h)
#pragma unroll
            for (int i = 0; i < 2; ++i) offN[h][i] = offC[h][i];
#pragma nounroll
        for (int t = 0; t < nt; t += 2) {
            const bool last = (t == nt - 2);
            if (last && has_next) S.a_off(nxt, sR, sC, offN);
            const char* a1 = cA + (size_t)(t + 1) * kstep;
            const char* a2 = last ? nA : cA + (size_t)(t + 2) * kstep; const char* b2 = last ? nB : cB + (size_t)(t + 2) * kstep;
            const char* a3 = a2 + kstep; const char* b3 = b2 + kstep;
            unsigned o2[2][2];
#pragma unroll
            for (int h = 0; h < 2; ++h)
#pragma unroll
                for (int i = 0; i < 2; ++i) o2[h][i] = last ? offN[h][i] : offC[h][i];
            PG8_LDB(B0, 0, 0); PG8_LDB(B1, 0, 1); PG8_SCHED; PG8_LDA(At, 0, 0); PG8_STAGE(PG8_SA(1, 1), a1, offC[1]);
            PG8_WAIT_V(8); PG8_WAIT_L(0); PG8_BAR; PG8_MMA(0, 0, At, B0); PG8_MMA(0, 1, At, B1); PG8_BAR; PG8_SCHED;
            PG8_LDA(At, 0, 1); PG8_STAGE(PG8_SB(0, 0), b2, voffB); PG8_STAGE(PG8_SB(0, 1), b2 + hstep, voffB); PG8_STAGE(PG8_SA(0, 0), a2, o2[0]);
            PG8_WAIT_V(8); PG8_WAIT_L(0); PG8_BAR; PG8_MMA(1, 0, At, B0); PG8_MMA(1, 1, At, B1); PG8_BAR; PG8_SCHED;
            PG8_LDB(B0, 1, 0); PG8_LDB(B1, 1, 1); PG8_SCHED; PG8_LDA(At, 1, 0); PG8_STAGE(PG8_SA(0, 1), a2, o2[1]);
            PG8_WAIT_V(8); PG8_WAIT_L(0); PG8_BAR; PG8_MMA(0, 0, At, B0); PG8_MMA(0, 1, At, B1); PG8_BAR; PG8_SCHED;
            PG8_LDA(At, 1, 1); PG8_STAGE(PG8_SB(1, 0), b3, voffB); PG8_STAGE(PG8_SB(1, 1), b3 + hstep, voffB); PG8_STAGE(PG8_SA(1, 0), a3, o2[0]);
            PG8_WAIT_V(8); PG8_WAIT_L(0); PG8_BAR; PG8_MMA(1, 0, At, B0); PG8_MMA(1, 1, At, B1); PG8_BAR; PG8_SCHED;
        }
        if constexpr (ALIGN_EPI) { if (wr == 0) PG8_BAR; }
        E(acc, cur, wr, wc, fr, fq);
        if (!has_next) break;
#pragma unroll
        for (int a = 0; a < 2; ++a)
#pragma unroll
            for (int b = 0; b < 2; ++b)
#pragma unroll
                for (int m = 0; m < 4; ++m)
#pragma unroll
                    for (int n = 0; n < 2; ++n) acc[a][b][m][n] = (f32x4){0.f, 0.f, 0.f, 0.f};
        cur = nxt; cA = nA; cB = nB; ++ui;
#pragma unroll
        for (int h = 0; h < 2; ++h)
#pragma unroll
            for (int i = 0; i < 2; ++i) offC[h][i] = offN[h][i];
        if constexpr (ALIGN_EPI) { if (wr == 1) PG8_BAR; }
    }
    PG8_WAIT_V(0);
    if constexpr (!ALIGN_EPI) { if (wr == 0) PG8_BAR; }
    PG8_BAR;
#undef PG8_SA
#undef PG8_SB
#undef PG8_STAGE
#undef PG8_LDA
#undef PG8_LDB
#undef PG8_MMA
#undef PG8_LO
#undef PG8_HI
#undef PG8_CAT
#undef PG8_WAIT_V
#undef PG8_WAIT_L
#undef PG8_BAR
#undef PG8_SCHED
}
}
namespace pg8 {
constexpr int T_BLKSTART = 0  , T_CNT = 40  , T_BLKE = 80  , T_WORDS = 80 + 560;
constexpr int TB_OFF = 8192 - 64;

struct EpiIn {
    static constexpr bool PERM = true;
    bf16_t* Z; const float* qn; const float* kn;
    __device__ __forceinline__ void operator()(const f32x4 (&acc)[2][2][4][2], const Unit& u, int wr, int wc, int fr, int fq) const {
        const int row0 = u.pm * BM + wr * 64 + fr;
        if (u.pn < 4) {
            const float* g = (u.pn < 2) ? qn : kn; const float sc = (u.pn < 2) ? QSCALE : 1.0f;
            f32x4 gv[2][2];
#pragma unroll
            for (int bj = 0; bj < 2; ++bj)
#pragma unroll
                for (int n = 0; n < 2; ++n) gv[bj][n] = *(const f32x4*)(g + 32 * bj + 8 * fq + 4 * n) * sc;
#pragma unroll
            for (int ai = 0; ai < 2; ++ai)
#pragma unroll
                for (int m = 0; m < 4; ++m) {
                    float ss = 0.f;
#pragma unroll
                    for (int bj = 0; bj < 2; ++bj)
#pragma unroll
                        for (int n = 0; n < 2; ++n) { const f32x4 x = acc[ai][bj][m][n]; ss += (x[0] * x[0] + x[1] * x[1]) + (x[2] * x[2] + x[3] * x[3]); }
                    ss += __shfl_xor(ss, 16); ss += __shfl_xor(ss, 32);
                    const float rstd = rsqrtf(ss * (1.0f / 64.0f) + 1e-6f);
                    bf16_t* rowp = Z + (size_t)(row0 + ai * HALF + m * 16) * ZW + u.pn * BM + 64 * wc + 8 * fq;
#pragma unroll
                    for (int bj = 0; bj < 2; ++bj) { const f32x4 v0 = acc[ai][bj][m][0] * rstd * gv[bj][0], v1 = acc[ai][bj][m][1] * rstd * gv[bj][1];
                        u32x4 w; w.x = cvt_pk_bf16(v0[0], v0[1]); w.y = cvt_pk_bf16(v0[2], v0[3]); w.z = cvt_pk_bf16(v1[0], v1[1]); w.w = cvt_pk_bf16(v1[2], v1[3]);
                        *(u32x4*)(rowp + 32 * bj) = w; }
                }
        } else {
            const int col0 = u.pn * BM + wc * 32 + 8 * fq;
#pragma unroll
            for (int ai = 0; ai < 2; ++ai)
#pragma unroll
                for (int m = 0; m < 4; ++m) { bf16_t* rowp = Z + (size_t)(row0 + ai * HALF + m * 16) * ZW + col0;
#pragma unroll
                    for (int bj = 0; bj < 2; ++bj) { const f32x4 v0 = acc[ai][bj][m][0], v1 = acc[ai][bj][m][1];
                        u32x4 w; w.x = cvt_pk_bf16(v0[0], v0[1]); w.y = cvt_pk_bf16(v0[2], v0[3]); w.z = cvt_pk_bf16(v1[0], v1[1]); w.w = cvt_pk_bf16(v1[2], v1[3]);
                        *(u32x4*)(rowp + bj * HALF) = w; } }
        }
    }
};
struct EpiBf16 {
    static constexpr bool PERM = true;
    bf16_t* O; int ldc;
    __device__ __forceinline__ void operator()(const f32x4 (&acc)[2][2][4][2], const Unit& u, int wr, int wc, int fr, int fq) const {
        const int row0 = u.pm * BM + wr * 64 + fr, col0 = u.pn * BM + wc * 32 + 8 * fq;
#pragma unroll
        for (int ai = 0; ai < 2; ++ai)
#pragma unroll
            for (int m = 0; m < 4; ++m) { bf16_t* rowp = O + (size_t)(row0 + ai * HALF + m * 16) * ldc + col0;
#pragma unroll
                for (int bj = 0; bj < 2; ++bj) { const f32x4 v0 = acc[ai][bj][m][0], v1 = acc[ai][bj][m][1];
                    u32x4 w; w.x = cvt_pk_bf16(v0[0], v0[1]); w.y = cvt_pk_bf16(v0[2], v0[3]); w.z = cvt_pk_bf16(v1[0], v1[1]); w.w = cvt_pk_bf16(v1[2], v1[3]);
                    *(u32x4*)(rowp + bj * HALF) = w; } }
    }
};
struct EpiOut {
    static constexpr bool PERM = true;
    const float* X; bf16_t* O;
    __device__ __forceinline__ void operator()(const f32x4 (&acc)[2][2][4][2], const Unit& u, int wr, int wc, int fr, int fq) const {
        const int row0 = u.pm * BM + wr * 64 + fr, col0 = u.pn * BM + wc * 32 + 8 * fq;
#pragma unroll
        for (int ai = 0; ai < 2; ++ai)
#pragma unroll
            for (int m = 0; m < 4; ++m) { const size_t off = (size_t)(row0 + ai * HALF + m * 16) * DM + col0;
#pragma unroll
                for (int bj = 0; bj < 2; ++bj) { const f32x4 v0 = *(const f32x4*)(X + off + bj * HALF) + acc[ai][bj][m][0], v1 = *(const f32x4*)(X + off + bj * HALF + 4) + acc[ai][bj][m][1];
                    u32x4 w; w.x = pk2(v0[0], v0[1]); w.y = pk2(v0[2], v0[3]); w.z = pk2(v1[0], v1[1]); w.w = pk2(v1[2], v1[3]);
                    *(u32x4*)(O + off + bj * HALF) = w; }
                if (m & 1) asm volatile("" ::: "memory"); }
    }
};
struct EpiPg {
    static constexpr bool PERM = true;
    bf16_t* X; const bf16_t* PJ;
    __device__ __forceinline__ void operator()(const f32x4 (&acc)[2][2][4][2], const Unit& u, int wr, int wc, int fr, int fq) const {
        const int row0 = u.pm * BM + wr * 64 + fr, col0 = u.pn * BM + wc * 32 + 8 * fq;
#pragma unroll
        for (int ai = 0; ai < 2; ++ai)
#pragma unroll
            for (int m = 0; m < 4; ++m) { const size_t off = (size_t)(row0 + ai * HALF + m * 16) * DM + col0;
#pragma unroll
                for (int bj = 0; bj < 2; ++bj) { const size_t o = off + bj * HALF; const u32x4 pj = *(const u32x4*)(PJ + o), xv = *(const u32x4*)(X + o);
                    const unsigned pw[4] = {pj.x, pj.y, pj.z, pj.w}, xw[4] = {xv.x, xv.y, xv.z, xv.w}; unsigned ow[4];
#pragma unroll
                    for (int q = 0; q < 4; ++q) { const float a0 = acc[ai][bj][m][q >> 1][2 * (q & 1)], a1 = acc[ai][bj][m][q >> 1][2 * (q & 1) + 1];
                        ow[q] = pk2(bflo(xw[q]) + sigmoidf_(a0) * bflo(pw[q]), bfhi(xw[q]) + sigmoidf_(a1) * bfhi(pw[q])); }
                    *(u32x4*)(X + o) = (u32x4){ow[0], ow[1], ow[2], ow[3]}; }
                if (m & 1) asm volatile("" ::: "memory"); }
    }
};
struct EpiGu {
    static constexpr bool PERM = true;
    unsigned char* ACT; const float* b_gu;
    __device__ __forceinline__ void operator()(const f32x4 (&acc)[2][2][4][2], const Unit& u, int wr, int wc, int fr, int fq) const {
        const int row0 = u.pm * BM + wr * 64 + fr, cl = u.pn * HALF + wc * 32 + 8 * fq;
        const float* bg = b_gu + (size_t)u.e * 2048 + cl;
        f32x4 bgl[2], bli[2];
#pragma unroll
        for (int n = 0; n < 2; ++n) { bgl[n] = *(const f32x4*)(bg + 4 * n); bli[n] = *(const f32x4*)(bg + 1024 + 4 * n) + 1.0f; }
#pragma unroll
        for (int ai = 0; ai < 2; ++ai)
#pragma unroll
            for (int m = 0; m < 4; ++m) { unsigned char* rowp = ACT + (size_t)(row0 + ai * HALF + m * 16) * EFF + cl; f32x4 r[2];
#pragma unroll
                for (int n = 0; n < 2; ++n) {
                    f32x4 g = acc[ai][0][m][n] + bgl[n], u = acc[ai][1][m][n] + bli[n];
#pragma unroll
                    for (int i = 0; i < 4; ++i) { g[i] = fminf(g[i], 7.0f); u[i] = __builtin_amdgcn_fmed3f(u[i], -6.0f, 8.0f); }
                    f32x4 d = g * (-1.702f * LOG2E);
#pragma unroll
                    for (int i = 0; i < 4; ++i) d[i] = __builtin_amdgcn_exp2f(d[i]);
                    d = d + 1.0f;
#pragma unroll
                    for (int i = 0; i < 4; ++i) d[i] = __builtin_amdgcn_rcpf(d[i]);
                    r[n] = (g * d) * u; }
                u32x2 w; w.x = pk4_fp8(r[0][0], r[0][1], r[0][2], r[0][3]); w.y = pk4_fp8(r[1][0], r[1][1], r[1][2], r[1][3]);
                *(u32x2*)rowp = w; }
    }
};
struct EpiDn {
    static constexpr bool PERM = true;
    unsigned char* YP; const float* b_dn; const float* gateslot; const LAS int* tab;
    __device__ __forceinline__ void operator()(const f32x4 (&acc)[2][2][4][2], const Unit& u, int wr, int wc, int fr, int fq) const {
        const int row0 = u.pm * BM + wr * 64 + fr, col0 = u.pn * BM + wc * 32 + 8 * fq;
        const float* bd = b_dn + (size_t)u.e * 1024 + col0; const int cnt = tab[T_CNT + u.e];
        f32x4 bv[2][2];
#pragma unroll
        for (int bj = 0; bj < 2; ++bj)
#pragma unroll
            for (int n = 0; n < 2; ++n) bv[bj][n] = *(const f32x4*)(bd + bj * HALF + 4 * n);
#pragma unroll
        for (int ai = 0; ai < 2; ++ai)
#pragma unroll
            for (int m = 0; m < 4; ++m) { const int rr = wr * 64 + fr + ai * HALF + m * 16, slot = u.lb * 256 + rr;
                const float gt = slot < cnt ? ((const LAS float*)((const LAS unsigned char*)tab + TB_OFF + u.sl * 1024))[rr] * 4.0f : 0.f;
                unsigned char* rowp = YP + (size_t)(row0 + ai * HALF + m * 16) * DM + col0;
#pragma unroll
                for (int bj = 0; bj < 2; ++bj) { const f32x4 v0 = (acc[ai][bj][m][0] + bv[bj][0]) * gt, v1 = (acc[ai][bj][m][1] + bv[bj][1]) * gt;
                    u32x2 w; w.x = pk4_fp8(v0[0], v0[1], v0[2], v0[3]); w.y = pk4_fp8(v1[0], v1[1], v1[2], v1[3]);
                    *(u32x2*)(rowp + bj * HALF) = w; } }
    }
};
struct MoeOrder {
    const unsigned char* A; const unsigned char* Bt; const int* tokslot; const float* gateslot;   const LAS int* tab; int nblk, nN, G, c; bool gather;
    __device__ __forceinline__ bool next(int i, Unit& u) const { if (!tile_order(i, G, c, nblk, nN, u.pm, u.pn)) return false; u.e = tab[T_BLKE + u.pm]; u.lb = u.pm - tab[T_BLKSTART + u.e]; return true; }
    __device__ __forceinline__ const char* a_base(const Unit& u) const { return gather ? (const char*)A : (const char*)A + (size_t)u.pm * BM * 1024; }
    __device__ __forceinline__ const char* b_base(const Unit& u) const { return (const char*)Bt + ((size_t)u.e * nN + u.pn) * BM * 1024; }
    __device__ __forceinline__ void prefetch(const Unit& u, int slot, int wid, int lane) const {
        if (wid < 4) { const unsigned* src = (gather ? (const unsigned*)tokslot : (const unsigned*)gateslot) + (size_t)u.e * NTOK + u.lb * 256 + wid * 64 + lane;
            __builtin_amdgcn_global_load_lds(src, (LAS unsigned*)((LAS unsigned char*)tab + TB_OFF + slot * 1024 + wid * 256), 4, 0, 0); }
    }
    __device__ __forceinline__ void a_off(const Unit& u, const int (&R)[2], const int (&C)[2], unsigned (&off)[2][2]) const {
        const int cnt = tab[T_CNT + u.e]; const LAS int* tb = (const LAS int*)((const LAS unsigned char*)tab + TB_OFF + u.sl * 1024);
#pragma unroll
        for (int h = 0; h < 2; ++h)
#pragma unroll
            for (int i = 0; i < 2; ++i) {
                if (gather) { const int rr = R[i] + HALF * h; const int tk = tb[rr]; const int tok = (u.lb * 256 + rr) < cnt ? tk : NTOK; off[h][i] = (unsigned)tok * 1024u + (unsigned)C[i] * 2u; }
                else off[h][i] = (unsigned)((R[i] + HALF * h) * 1024 + C[i] * 2);
            }
    }
};
__device__ __forceinline__ int moe_tables(LAS int* tab, const unsigned* cntw) {
    if (threadIdx.x < 64) { const int e = threadIdx.x & 31; const int c = (int)cntw[e]; const int nb = (c + 255) >> 8; int incl = nb;
#pragma unroll
        for (int o = 1; o < 32; o <<= 1) { const int t = __shfl_up(incl, o, 32); if (e >= o) incl += t; }
        const int start = incl - nb;
        if (threadIdx.x < 32) { tab[T_CNT + e] = c; tab[T_BLKSTART + e] = start; if (e == NE - 1) tab[T_BLKSTART + NE] = incl;
            for (int j = 0; j < nb; ++j) tab[T_BLKE + start + j] = e; } }
    __syncthreads();
    return tab[T_BLKSTART + NE];
}
}
constexpr int NWAVES = 8, NTHREADS = 512;
constexpr int RING_BYTES = 131072, MISC_OFF = RING_BYTES, LDS_BYTES = 147456;

__device__ __forceinline__ void tr_item(const float* W, int ldw, int srccol0, int k0, bf16_t* WT, int Kd, int dstrow0, LAS float* scr, int lane) {
#pragma unroll 8
    for (int i = 0; i < 32; ++i) { const int kk = 2 * i + (lane >> 5); scr[kk * 33 + (lane & 31)] = W[(size_t)(k0 + kk) * ldw + srccol0 + (lane & 31)]; }
    asm volatile("s_waitcnt lgkmcnt(0)" ::: "memory");
    const int c = lane & 7;
#pragma unroll
    for (int j = 0; j < 4; ++j) { const int n = (lane >> 3) + 8 * j; const LAS float* s = scr + (8 * c) * 33 + n;
        u32x4 o; o.x = pk2(s[0 * 33], s[1 * 33]); o.y = pk2(s[2 * 33], s[3 * 33]); o.z = pk2(s[4 * 33], s[5 * 33]); o.w = pk2(s[6 * 33], s[7 * 33]);
        *(u32x4*)(WT + (size_t)(dstrow0 + n) * Kd + k0 + 8 * c) = o; }
    asm volatile("s_waitcnt lgkmcnt(0)" ::: "memory");
}
__device__ __forceinline__ void tr_item8(const float* W, int ldw, int srccol0, int k0, unsigned char* WT, int Kd, int dstrow0, LAS float* scr, int lane) {
    f32x4 v[8]; const int r8 = lane >> 3, c4 = lane & 7;
#pragma unroll
    for (int i = 0; i < 8; ++i) v[i] = __builtin_nontemporal_load((const f32x4*)(W + (size_t)(k0 + 8 * i + r8) * ldw + srccol0 + 4 * c4));
#pragma unroll
    for (int i = 0; i < 8; ++i) { LAS float* d = scr + (8 * i + r8) * 33 + 4 * c4; d[0] = v[i][0]; d[1] = v[i][1]; d[2] = v[i][2]; d[3] = v[i][3]; }
    asm volatile("s_waitcnt lgkmcnt(0)" ::: "memory");
    const int c = lane & 7;
#pragma unroll
    for (int j = 0; j < 4; ++j) { const int n = (lane >> 3) + 8 * j; const LAS float* s = scr + (8 * c) * 33 + n;
        u32x2 o; o.x = pk4_fp8(s[0 * 33] * 64.f, s[1 * 33] * 64.f, s[2 * 33] * 64.f, s[3 * 33] * 64.f); o.y = pk4_fp8(s[4 * 33] * 64.f, s[5 * 33] * 64.f, s[6 * 33] * 64.f, s[7 * 33] * 64.f);
        *(u32x2*)(WT + (size_t)(dstrow0 + n) * Kd + k0 + 8 * c) = o; }
    asm volatile("s_waitcnt lgkmcnt(0)" ::: "memory");
}
constexpr int I_IN = 16 * 120, I_OUT = 16 * 32, I_PG = 16 * 32, I_PP = 4 * 32, I_GU1 = 16 * 64, I_DN1 = 16 * 32;
constexpr int I_LORA = 16 + 16 + 32;
constexpr int I_SMALL = I_IN + I_OUT + I_PG + I_PP + I_LORA, I_GU = NE * I_GU1, I_DN = NE * I_DN1, I_ALL = I_SMALL + I_GU + I_DN;
__device__ __forceinline__ void prep_item(KPR P, int it, LAS float* scr, int lane) {
    unsigned char* ws = P.ws;
    if (it < I_IN) { const int kb = it / 120, nb = it % 120, n0 = nb * 32, pn = n0 >> 8, j0 = n0 & 255;
        const int src = pn < 4 ? (pn * 256 + 64 * ((j0 & 127) >> 5) + 32 * (j0 >> 7)) : (n0 < 2048 ? n0 : n0 + 8);
        tr_item(P.w_in, INW, src, kb * 64, (bf16_t*)(ws + WS_WIN), 1024, n0, scr, lane); return; }
    it -= I_IN;
    if (it < I_OUT) { tr_item(P.w_out, 1024, (it % 32) * 32, (it / 32) * 64, (bf16_t*)(ws + WS_WOUT), 1024, (it % 32) * 32, scr, lane); return; }
    it -= I_OUT;
    if (it < I_PG) { tr_item8(P.w_pg, 1024, (it % 32) * 32, (it / 32) * 64, ws + WS_WPG, 1024, (it % 32) * 32, scr, lane); return; }
    it -= I_PG;
    if (it < I_PP) { tr_item(P.w_pp, 1024, (it % 32) * 32, (it / 32) * 64, (bf16_t*)(ws + WS_WPP), 256, (it % 32) * 32, scr, lane); return; }
    it -= I_PP;
    if (it < 16) { tr_item(P.w2, 512, it * 32, 0, (bf16_t*)(ws + 29 * MiB), 64, it * 32, scr, lane); return; }
    it -= 16;
    if (it < 16) { tr_item(P.a2, 512, it * 32, 0, (bf16_t*)(ws + 29 * MiB + 65536), 64, it * 32, scr, lane); return; }
    it -= 16;
    if (it < 32) { tr_item(P.g2, 512, (it % 16) * 32, (it / 16) * 64, (bf16_t*)(ws + 29 * MiB + 131072), 128, (it % 16) * 32, scr, lane); return; }
    it -= 32;
    if (it < I_GU) { const int e = it / I_GU1, r = it % I_GU1, kb = r / 64, nb = r % 64, n0 = nb * 32, pn = n0 >> 8, j0 = n0 & 255;
        const int src = (j0 >> 7) * 1024 + pn * 128 + (j0 & 127);
        tr_item8(P.w_gu + (size_t)e * 1024 * 2048, 2048, src, kb * 64, ws + WS_WGU + (size_t)e * 2048 * 1024, 1024, n0, scr, lane); return; }
    it -= I_GU;
    { const int e = it / I_DN1, r = it % I_DN1, kb = r / 32, nb = r % 32;
        tr_item8(P.w_down + (size_t)e * 1024 * 1024, 1024, nb * 32, kb * 64, ws + WS_WDN + (size_t)e * 1024 * 1024, 1024, nb * 32, scr, lane); }
}
__device__ __forceinline__ void phase_prep_weights(KPR P, LAS unsigned char* lds, int gw, int ngw, int wave, int lane) {
    LAS float* scr = (LAS float*)(lds + wave * 16384);
    for (int it = gw; it < I_SMALL; it += ngw) prep_item(P, it, scr, lane);
}
constexpr int NCVT = I_DN / 64, CVT_TASK0 = I_GU / 64;
__device__ __forceinline__ void cvt_task(KPR P, LAS unsigned char* lds, int task, int wave, int lane) {
    LAS float* scr = (LAS float*)(lds + wave * 16384);
    for (int i = 0; i < 8; ++i) prep_item(P, I_SMALL + task * 64 + i * 8 + wave, scr, lane);
}
__device__ __forceinline__ const float* gu_item_src(KPR P, int it) {
    const int e = it / I_GU1, r = it % I_GU1, kb = r / 64, nb = r % 64, n0 = nb * 32, pn = n0 >> 8, j0 = n0 & 255;
    return P.w_gu + (size_t)e * 1024 * 2048 + (size_t)(kb * 64) * 2048 + (j0 >> 7) * 1024 + pn * 128 + (j0 & 127);
}
__device__ __forceinline__ void gu_half(KPR P, int it, int h, int lane, LAS float* scr, const f32x4& v0, const f32x4& v1, const f32x4& v2, const f32x4& v3) {
    const int e = it / I_GU1, r = it % I_GU1, kb = r / 64, nb = r % 64;
    unsigned char* dst = P.ws + WS_WGU + (size_t)e * 2048 * 1024 + (size_t)(nb * 32) * 1024 + kb * 64 + 32 * h;
    const int r8 = lane >> 3, c4 = lane & 7, n = lane & 31, kg = lane >> 5;
    { LAS f32x4* d = (LAS f32x4*)(scr + r8 * 36 + 4 * c4); d[0] = v0; d[8 * 9] = v1; d[16 * 9] = v2; d[24 * 9] = v3; }
    asm volatile("s_waitcnt lgkmcnt(0)" ::: "memory");
#pragma unroll
    for (int q = 0; q < 2; ++q) { const LAS float* s = scr + (16 * q + 8 * kg) * 36 + n;
        u32x2 o; o.x = pk4_fp8(s[0 * 36] * 64.f, s[1 * 36] * 64.f, s[2 * 36] * 64.f, s[3 * 36] * 64.f); o.y = pk4_fp8(s[4 * 36] * 64.f, s[5 * 36] * 64.f, s[6 * 36] * 64.f, s[7 * 36] * 64.f);
        *(u32x2*)(dst + (size_t)n * 1024 + 16 * q + 8 * kg) = o; }
    asm volatile("s_waitcnt lgkmcnt(0)" ::: "memory");
}
__device__ __forceinline__ void phase_cvt_p(KPR P, int gt, int ngt) {
    bf16_t* PB = (bf16_t*)((unsigned char*)P.out + DO_PB);
    for (int i = gt; i < NTOK * PLE / 8; i += ngt) { const f32x4 a = __builtin_nontemporal_load(&((const f32x4*)P.p)[2 * i]), b = __builtin_nontemporal_load(&((const f32x4*)P.p)[2 * i + 1]);
        u32x4 w; w.x = pk2(a[0], a[1]); w.y = pk2(a[2], a[3]); w.z = pk2(b[0], b[1]); w.w = pk2(b[2], b[3]); ((u32x4*)PB)[i] = w; }
}
__device__ __forceinline__ void rms_row(const float* xrow, const float* gain, int lane, f32x4 (&v)[4]) {
    const f32x4* xr = (const f32x4*)xrow + lane; float s = 0.f;
#pragma unroll
    for (int j = 0; j < 4; ++j) { v[j] = __builtin_nontemporal_load(&xr[64 * j]); s += (v[j][0] * v[j][0] + v[j][1] * v[j][1]) + (v[j][2] * v[j][2] + v[j][3] * v[j][3]); }
    const float rstd = rsqrtf(wave_sum(s) * (1.f / DM) + 1e-6f);
#pragma unroll
    for (int j = 0; j < 4; ++j) v[j] = v[j] * rstd * ((const f32x4*)gain)[64 * j + lane];
}
__device__ __forceinline__ void store_row_fp8(unsigned char* orow, int lane, const f32x4 (&v)[4]) {
    unsigned* o4 = (unsigned*)orow + lane;
#pragma unroll
    for (int j = 0; j < 4; ++j) o4[64 * j] = pk4_fp8(v[j][0], v[j][1], v[j][2], v[j][3]);
}
__device__ __forceinline__ void store_row_bf16(bf16_t* orow, int lane, const f32x4 (&v)[4]) {
    u32x2* o8 = (u32x2*)orow + lane;
#pragma unroll
    for (int j = 0; j < 4; ++j) { u32x2 w; w.x = pk2(v[j][0], v[j][1]); w.y = pk2(v[j][2], v[j][3]); o8[64 * j] = w; }
}
__device__ __forceinline__ void norm1_row(KPR P, int row, int lane, const LAS float* wff, LAS float* lf_out  ) {
    f32x4 v[4]; rms_row(P.x + (size_t)row * DM, P.mix_norm, lane, v);
    store_row_bf16((bf16_t*)(P.ws + WS_XN) + (size_t)row * DM, lane, v);
    float ff[8];
#pragma unroll
    for (int q = 0; q < 8; ++q) { float s = 0.f;
#pragma unroll
        for (int j = 0; j < 4; ++j) { const f32x4 w = *(const LAS f32x4*)(wff + q * 1024 + 4 * (64 * j + lane)); s += (v[j][0] * w[0] + v[j][1] * w[1]) + (v[j][2] * w[2] + v[j][3] * w[3]); }
        ff[q] = s; }
    float g4[4], g2[2], g1;
    { const bool up = lane & 32;
#pragma unroll
        for (int q = 0; q < 4; ++q) { const float keep = up ? ff[4 + q] : ff[q], give = up ? ff[q] : ff[4 + q]; g4[q] = keep + __shfl_xor(give, 32); } }
    { const bool up = lane & 16;
#pragma unroll
        for (int q = 0; q < 2; ++q) { const float keep = up ? g4[2 + q] : g4[q], give = up ? g4[q] : g4[2 + q]; g2[q] = keep + __shfl_xor(give, 16); } }
    { const bool up = lane & 8; const float keep = up ? g2[1] : g2[0], give = up ? g2[0] : g2[1]; g1 = keep + __shfl_xor(give, 8); }
    g1 += __shfl_xor(g1, 4); g1 += __shfl_xor(g1, 2); g1 += __shfl_xor(g1, 1);
    if ((lane & 7) == 0) { const int q = lane >> 3; lf_out[q] = logsigmoidf_(g1 + P.f_bias[q]); }
}
__device__ __forceinline__ void load_wff(KPR P, LAS float* wff, int tid, int nthr) {
    float t[16];
#pragma unroll
    for (int u = 0; u < 16; ++u) { const int i = tid + u * NTHREADS; t[u] = P.w_in[(size_t)(i >> 3) * INW + 2048 + (i & 7)]; }
#pragma unroll
    for (int u = 0; u < 16; ++u) { const int i = tid + u * NTHREADS; wff[(i & 7) * 1024 + (i >> 3)] = t[u]; }
    (void)nthr;
}
__device__ __forceinline__ void final_row(KPR P, int row, int lane, bool dead) {
    const u32x2* xr = (const u32x2*)((const bf16_t*)(P.ws + WS_X1) + (size_t)row * DM) + lane; f32x4 v[4]; float s = 0.f;
#pragma unroll
    for (int j = 0; j < 4; ++j) { const u32x2 xv = xr[64 * j]; v[j] = (f32x4){bflo(xv.x), bfhi(xv.x), bflo(xv.y), bfhi(xv.y)}; s += (v[j][0] * v[j][0] + v[j][1] * v[j][1]) + (v[j][2] * v[j][2] + v[j][3] * v[j][3]); }
    const float rstd = rsqrtf(wave_sum(s) * (1.f / DM) + 1e-6f);
    f32x4* o = (f32x4*)(P.out + (size_t)row * DM) + lane;
#pragma unroll
    for (int j = 0; j < 4; ++j) { v[j] = v[j] * rstd * ((const f32x4*)P.final_norm)[64 * j + lane]; if (dead) { const float q = __builtin_nanf(""); v[j] = (f32x4){q, q, q, q}; } __builtin_nontemporal_store(v[j], &o[64 * j]); }
}
typedef GAS unsigned gu32;
#define RLX_AGENT __ATOMIC_RELAXED, __HIP_MEMORY_SCOPE_AGENT
#define XB_TMO      128
#define XB_XCNT(j)  (256  + 64 * (j))
#define XB_XSUB(j)  (1280 + 64 * (j))
#define XB_XGEN(j)  (2304 + 64 * (j))
#define XB_TOP      3328
#define XB_TOPGEN   3392
#define XCD_BAR_WORDS 3456
#define XB_SPIN_CAP (1u << 22)

__device__ __forceinline__ unsigned xb_ld(unsigned* p)              { return __hip_atomic_load(p, __ATOMIC_RELAXED, __HIP_MEMORY_SCOPE_AGENT); }
__device__ __forceinline__ unsigned xb_add(unsigned* p, unsigned v) { return __hip_atomic_fetch_add(p, v, __ATOMIC_RELAXED, __HIP_MEMORY_SCOPE_AGENT); }
__device__ __forceinline__ unsigned xb_xcc_id() { return (unsigned)__builtin_amdgcn_s_getreg((3 << 11) | 20) & 0xFu; }
#define XB_SPIN(cond, bar) do { unsigned _sp = 0; while (cond) { __builtin_amdgcn_s_sleep(1); \
    if ((++_sp & 255u) == 0u) { if (xb_ld(&(bar)[XB_TMO])) break; if (_sp > XB_SPIN_CAP) { atomicAdd(&(bar)[XB_TMO], 1u); break; } } } } while (0)

struct XcdBarrier { unsigned* bar; unsigned x; volatile LAS unsigned* st; };

__device__ __forceinline__ XcdBarrier xcd_barrier_post(unsigned* bar, volatile LAS unsigned* st) {
    XcdBarrier b; b.bar = bar; b.x = xb_xcc_id(); b.st = st;
    if (threadIdx.x == 0) (void)xb_add(&bar[XB_XCNT(b.x)], 1u);
    return b;
}
__device__ __forceinline__ void xcd_barrier_complete(unsigned* bar, unsigned x, unsigned& nloc, unsigned& nx) {
    const unsigned G = gridDim.x * gridDim.y * gridDim.z;
    unsigned sum, cnt, mine, sp = 0u;
    for (;;) {
        sum = 0u; cnt = 0u; mine = 0u;
#pragma unroll
        for (unsigned j = 0; j < 16; ++j) { const unsigned c = xb_ld(&bar[XB_XCNT(j)]); sum += c; cnt += (c > 0u) ? 1u : 0u; mine = (j == x) ? c : mine; }
        if (sum == G) break;
        __builtin_amdgcn_s_sleep(1);
        if ((++sp & 255u) == 0u) { if (xb_ld(&bar[XB_TMO])) break; if (sp > XB_SPIN_CAP) { atomicAdd(&bar[XB_TMO], 1u); break; } }
    }
    nloc = mine > 0u ? mine : 1u; nx = cnt > 0u ? cnt : 1u;
}
__device__ __forceinline__ void xcd_barrier(const XcdBarrier& b) {
    asm volatile("s_waitcnt vmcnt(0)" ::: "memory");
    __syncthreads();
    if (threadIdx.x == 0) {
        unsigned* bar = b.bar;
        __builtin_amdgcn_s_waitcnt(0);
        unsigned nloc = b.st[0], nx = b.st[1];
        if (nloc == 0u) { xcd_barrier_complete(bar, b.x, nloc, nx); b.st[0] = nloc; b.st[1] = nx; }
        const unsigned old = xb_add(&bar[XB_XSUB(b.x)], 1u);
        const unsigned gen = old / nloc;
        if (old + 1u == (gen + 1u) * nloc) {
            __builtin_amdgcn_fence(__ATOMIC_RELEASE, "agent");
            asm volatile("s_waitcnt vmcnt(0)" ::: "memory");
            const unsigned og = xb_add(&bar[XB_TOP], 1u);
            const unsigned tg = og / nx;
            if (og + 1u == (tg + 1u) * nx) xb_add(&bar[XB_TOPGEN], 1u);
            else XB_SPIN(xb_ld(&bar[XB_TOPGEN]) == tg, bar);
            __builtin_amdgcn_fence(__ATOMIC_ACQUIRE, "agent");
            xb_add(&bar[XB_XGEN(b.x)], 1u);
            asm volatile("s_waitcnt vmcnt(0)" ::: "memory");
        } else {
            XB_SPIN(xb_ld(&bar[XB_XGEN(b.x)]) == gen, bar);
            __builtin_amdgcn_fence(__ATOMIC_ACQUIRE, "agent");
            asm volatile("s_waitcnt vmcnt(0)" ::: "memory");
        }
    }
    __syncthreads();
}
namespace rk {
constexpr int MB = 8192;
constexpr int S_AT = 0, S_RT = 1, S_KT = 2, S_BT = 3, S_ATT = 4, S_KTT = 5, S_BTT = 6, S_VT = 7, S_N = 8, S_NT = 9, S_MAK = 10, S_MRB = 11, S_MRK = 12, S_TA = 13, S_TB = 14;
constexpr int SCR = 15 * MB;
constexpr int NCHUNK = SEQ / 64;
constexpr size_t WS_HT = WS_X1;
constexpr size_t WS_Y0 = WS_X1 + 64 * MiB;
constexpr size_t WS_QI = WS_X1 + 96 * MiB;
constexpr size_t WS_LW = WS_RW, WS_LA = WS_RW + 32 * MiB, WS_LG = WS_RW + 64 * MiB;
constexpr size_t WS_SC = WS_RW + 224 * MiB;
constexpr size_t DO_GT = 80 * MiB;
static_assert(WS_SC + 32 * MiB <= WS_END, "rwkv blobs");

__device__ __forceinline__ int moff(int row, int col) { return row * 128 + ((((col >> 3) ^ (row >> 1)) & 7) << 4) + (col & 7) * 2; }
__device__ __forceinline__ int crow(int r, int hi) { return (r & 3) + 8 * (r >> 2) + 4 * hi; }
__device__ __forceinline__ f32x16 mm_nt(const LAS unsigned char* A, int ar0, const LAS unsigned char* Bt, int br0, f32x16 acc, int r32, int hi) {
#pragma unroll
    for (int ks = 0; ks < 4; ++ks) { const bf16x8 a = *(const LAS bf16x8*)(A + moff(ar0 + r32, 16 * ks + 8 * hi)), b = *(const LAS bf16x8*)(Bt + moff(br0 + r32, 16 * ks + 8 * hi));
        acc = __builtin_amdgcn_mfma_f32_32x32x16_bf16(a, b, acc, 0, 0, 0); }
    return acc;
}
__device__ __forceinline__ void store_t(LAS unsigned char* dst, const f32x16& acc, int i0, int j0, int r32, int hi) {
#pragma unroll
    for (int g = 0; g < 4; ++g) { u32x2 w; w.x = pk2(acc[4 * g], acc[4 * g + 1]); w.y = pk2(acc[4 * g + 2], acc[4 * g + 3]); *(LAS u32x2*)(dst + moff(j0 + r32, i0 + 8 * g + 4 * hi)) = w; }
}
template <int MODE> __device__ __forceinline__ void mask_tri(f32x16& acc, int i0, int j0, int r32, int hi) {
#pragma unroll
    for (int r = 0; r < 16; ++r) { const int i = i0 + crow(r, hi), j = j0 + r32; const bool keep = MODE == 0 ? (j < i) : (MODE == 1 ? (i < j) : (i <= j)); if (!keep) acc[r] = 0.f; }
}

__device__ __forceinline__ void pass1_chunk(KPR P, LAS unsigned char* lds, int bh, int c, int tid, int itbase, LAS float* cscr) {
    const int lane = tid & 63, wave = tid >> 6, r32 = lane & 31, hi = lane >> 5, grp = wave >> 2, wq = wave & 3, i0 = 32 * (wq >> 1), j0 = 32 * (wq & 1);
    const int b = bh >> 3, h = bh & 7; const size_t tok0 = (size_t)b * SEQ + (size_t)c * 64; const size_t ci = (size_t)bh * NCHUNK + c;
    LAS float* part = (LAS float*)(lds + SCR); LAS float* WL = (LAS float*)(lds + SCR + 2048);
#define MAT(s) (lds + (s) * MB)
    {
        const bf16_t* Z = (const bf16_t*)(P.ws + WS_Z); const bf16_t* LW = (const bf16_t*)(P.ws + WS_LW); const bf16_t* LA = (const bf16_t*)(P.ws + WS_LA);
        const int ch = tid & 63, tq = tid >> 6, cc = h * 64 + ch; const size_t row0 = tok0 + 8 * tq;
        const float mur = P.mu[RW_R + cc], muk = P.mu[RW_K + cc], muv = P.mu[RW_V + cc], w0c = P.w0[cc], a0c = P.a0[cc], kkc = P.k_k[cc], kac = P.k_a[cc];
        const bf16_t* zp = Z + row0 * ZW + ZR + cc;
        const bool first = (c == 0) && (tq == 0); const bf16_t* zq = first ? zp : zp - ZW; const float pm = first ? 0.f : 1.f;
        unsigned short lr[9], lk[9], lv[9], llw[8], lla[8];
        lr[0] = zq[RW_R]; lk[0] = zq[RW_K]; lv[0] = zq[RW_V];
#pragma unroll
        for (int i = 0; i < 8; ++i) { const bf16_t* zi = zp + (size_t)i * ZW; lr[i + 1] = zi[RW_R]; lk[i + 1] = zi[RW_K]; lv[i + 1] = zi[RW_V]; const size_t o = (row0 + i) * 512 + cc; llw[i] = LW[o]; lla[i] = LA[o]; }
        float cum[8], vr[8], vk[8], vkk[8], vka[8], ssq[8]; unsigned short vv16[8]; float run = 0.f;
#pragma unroll
        for (int i = 0; i < 8; ++i) { const float pmi = (i == 0) ? pm : 1.f; const float zr1 = bf2f(lr[i + 1]), zk1 = bf2f(lk[i + 1]), zv1 = bf2f(lv[i + 1]);
            vr[i] = zr1 + (bf2f(lr[i]) * pmi - zr1) * mur; vk[i] = zk1 + (bf2f(lk[i]) * pmi - zk1) * muk; vv16[i] = (unsigned short)f2bf(zv1 + (bf2f(lv[i]) * pmi - zv1) * muv);
            vkk[i] = vk[i] * kkc; ssq[i] = vkk[i] * vkk[i]; }
#pragma unroll
        for (int i = 0; i < 8; ++i) ssq[i] = wave_sum(ssq[i]);
#pragma unroll
        for (int i = 0; i < 8; ++i) {
            const float wl = w0c + bf2f(llw[i]); const float sp = fmaxf(-wl, 0.f) + __logf(1.0f + __expf(-fabsf(wl)));
            run += -__expf(-sp - 0.5f); cum[i] = run;
            const float a = __builtin_amdgcn_rcpf(1.0f + __expf(-(a0c + bf2f(lla[i]))));
            const float kk = vkk[i] * __builtin_amdgcn_rcpf(fmaxf(__builtin_amdgcn_sqrtf(ssq[i]), 1e-12f));
            vk[i] = vk[i] * (1.0f + (a - 1.0f) * kac); vkk[i] = kk; vka[i] = kk * a; }
        part[tq * 64 + ch] = run;
        __syncthreads();
        float pre = 0.f;
#pragma unroll
        for (int g = 0; g < 8; ++g) { const float pvv = part[g * 64 + ch]; pre += (g < tq) ? pvv : 0.f; }
        float eprev = __expf(pre);
        unsigned atT[4], ktT[4], btT[4], vT[4]; unsigned short hold[4] = {0, 0, 0, 0};
#pragma unroll
        for (int i = 0; i < 8; ++i) { const int t = 8 * tq + i;
            const float cm = pre + cum[i], e1 = __expf(cm), einv = __expf(-cm);
            const unsigned short at = (unsigned short)f2bf(-vkk[i] * eprev), rt = (unsigned short)f2bf(vr[i] * e1), kt = (unsigned short)f2bf(vk[i] * einv), bt = (unsigned short)f2bf(vka[i] * einv), vv = vv16[i];
            eprev = e1;
            *(LAS unsigned short*)(MAT(S_AT) + moff(t, ch)) = at; *(LAS unsigned short*)(MAT(S_RT) + moff(t, ch)) = rt; *(LAS unsigned short*)(MAT(S_KT) + moff(t, ch)) = kt; *(LAS unsigned short*)(MAT(S_BT) + moff(t, ch)) = bt;
            if (i & 1) { atT[i >> 1] = hold[0] | ((unsigned)at << 16); ktT[i >> 1] = hold[1] | ((unsigned)kt << 16); btT[i >> 1] = hold[2] | ((unsigned)bt << 16); vT[i >> 1] = hold[3] | ((unsigned)vv << 16); }
            else { hold[0] = at; hold[1] = kt; hold[2] = bt; hold[3] = vv; }
            if (i == 7 && tq == 7) WL[ch] = e1; }
        *(LAS u32x4*)(MAT(S_ATT) + moff(ch, 8 * tq)) = (u32x4){atT[0], atT[1], atT[2], atT[3]}; *(LAS u32x4*)(MAT(S_KTT) + moff(ch, 8 * tq)) = (u32x4){ktT[0], ktT[1], ktT[2], ktT[3]};
        *(LAS u32x4*)(MAT(S_BTT) + moff(ch, 8 * tq)) = (u32x4){btT[0], btT[1], btT[2], btT[3]}; *(LAS u32x4*)(MAT(S_VT) + moff(ch, 8 * tq)) = (u32x4){vT[0], vT[1], vT[2], vT[3]};
    }
    __syncthreads();
    const f32x16 zero = f32x16{};
    f32x4 cv[2][8];
    if (grp == 1) {
#pragma unroll
        for (int u = 0; u < 2; ++u) { const float* cs = gu_item_src(P, itbase + 4 * u + wq) + (size_t)(lane >> 3) * 2048 + 4 * (lane & 7);
#pragma unroll
            for (int i = 0; i < 8; ++i) cv[u][i] = __builtin_nontemporal_load((const f32x4*)(cs + (size_t)(8 * i) * 2048)); } }
    if (grp == 0) { f32x16 d = mm_nt(MAT(S_AT), i0, MAT(S_BT), j0, zero, r32, hi); mask_tri<0>(d, i0, j0, r32, hi); store_t(MAT(S_NT), d, i0, j0, r32, hi);
        d = mm_nt(MAT(S_KT), i0, MAT(S_AT), j0, zero, r32, hi); mask_tri<1>(d, i0, j0, r32, hi); store_t(MAT(S_MAK), d, i0, j0, r32, hi);
        d = mm_nt(MAT(S_KT), i0, MAT(S_RT), j0, zero, r32, hi); mask_tri<2>(d, i0, j0, r32, hi); store_t(MAT(S_MRK), d, i0, j0, r32, hi); }
    else { f32x16 d = mm_nt(MAT(S_BT), i0, MAT(S_AT), j0, zero, r32, hi); mask_tri<1>(d, i0, j0, r32, hi); store_t(MAT(S_N), d, i0, j0, r32, hi);
#pragma unroll
        for (int r = 0; r < 16; ++r) if (i0 + crow(r, hi) == j0 + r32) d[r] = 1.0f;
        store_t(MAT(S_TA), d, i0, j0, r32, hi);
        d = mm_nt(MAT(S_BT), i0, MAT(S_RT), j0, zero, r32, hi); mask_tri<2>(d, i0, j0, r32, hi); store_t(MAT(S_MRB), d, i0, j0, r32, hi); }
    __syncthreads();
#pragma unroll
    for (int s = 1; s <= 6; ++s) {
        const int mc = (s & 1) ? S_N : S_AT, mcT = (s & 1) ? S_NT : S_KT, mn = (s & 1) ? S_AT : S_N, mnT = (s & 1) ? S_KT : S_NT;
        const int tc = (s & 1) ? S_TB : S_TA, tn = (s & 1) ? S_TA : S_TB;
        if (s <= 5) {
            if (grp == 0) { const f32x16 d = mm_nt(MAT(mc), i0, MAT(mcT), j0, zero, r32, hi); store_t(MAT(mnT), d, i0, j0, r32, hi); }
            else { const f32x16 d = mm_nt(MAT(mcT), i0, MAT(mc), j0, zero, r32, hi); store_t(MAT(mn), d, i0, j0, r32, hi); }
        }
        if (s >= 2 && grp == (s <= 5 ? 0 : 1) ) {
            f32x16 d = mm_nt(MAT(mcT), i0, MAT(tc), j0, zero, r32, hi);
#pragma unroll
            for (int g = 0; g < 4; ++g) { const u32x2 tv = *(const LAS u32x2*)(MAT(tc) + moff(j0 + r32, i0 + 8 * g + 4 * hi)); d[4 * g] += bflo(tv.x); d[4 * g + 1] += bfhi(tv.x); d[4 * g + 2] += bflo(tv.y); d[4 * g + 3] += bfhi(tv.y); }
            store_t(MAT(tn), d, i0, j0, r32, hi);
        }
        if (s >= 2 && s <= 5 && grp == 1) { const int u = (s - 2) >> 1, h = (s - 2) & 1;
            gu_half(P, itbase + 4 * u + wq, h, lane, cscr, cv[u][4 * h], cv[u][4 * h + 1], cv[u][4 * h + 2], cv[u][4 * h + 3]); }
        __syncthreads();
    }
    if (grp == 0) { const f32x16 d = mm_nt(MAT(S_TB), i0, MAT(S_ATT), j0, zero, r32, hi); store_t(MAT(S_BT), d, i0, j0, r32, hi); }
    else { const f32x16 d = mm_nt(MAT(S_MAK), i0, MAT(S_VT), j0, zero, r32, hi); store_t(MAT(S_N), d, i0, j0, r32, hi); }
    __syncthreads();
    if (grp == 0) { const f32x16 d = mm_nt(MAT(S_TB), i0, MAT(S_N), j0, zero, r32, hi); store_t(MAT(S_NT), d, i0, j0, r32, hi);
        f32x16 q = mm_nt(MAT(S_BT), i0, MAT(S_MRB), j0, zero, r32, hi);
#pragma unroll
        for (int g = 0; g < 4; ++g) { const u32x2 rv = *(const LAS u32x2*)(MAT(S_RT) + moff(j0 + r32, i0 + 8 * g + 4 * hi)); q[4 * g] += bflo(rv.x); q[4 * g + 1] += bfhi(rv.x); q[4 * g + 2] += bflo(rv.y); q[4 * g + 3] += bfhi(rv.y); }
        store_t(MAT(S_KT), q, i0, j0, r32, hi); }
    else { f32x16 g_ = mm_nt(MAT(S_BT), i0, MAT(S_BTT), j0, zero, r32, hi);
        const float wl = WL[j0 + r32];
#pragma unroll
        for (int r = 0; r < 16; ++r) { if (i0 + crow(r, hi) == j0 + r32) g_[r] += 1.0f; g_[r] *= wl; }
        store_t(MAT(S_AT), g_, i0, j0, r32, hi); }
    __syncthreads();
    if (grp == 0) { f32x16 d = mm_nt(MAT(S_BTT), i0, MAT(S_NT), j0, zero, r32, hi); d = mm_nt(MAT(S_KTT), i0, MAT(S_VT), j0, d, r32, hi);
        float* HT = (float*)(P.ws + WS_HT) + ci * 4096 + (size_t)wq * 1024 + lane;
#pragma unroll
        for (int g = 0; g < 4; ++g) { const f32x4 wl4 = *(const LAS f32x4*)(WL + i0 + 8 * g + 4 * hi);
#pragma unroll
            for (int i = 0; i < 4; ++i) HT[(4 * g + i) * 64] = d[4 * g + i] * wl4[i]; } }
    else { f32x16 d = mm_nt(MAT(S_MRB), i0, MAT(S_NT), j0, zero, r32, hi); d = mm_nt(MAT(S_MRK), i0, MAT(S_VT), j0, d, r32, hi);
        unsigned* Y0 = (unsigned*)(P.ws + WS_Y0) + ci * 2048 + (size_t)wq * 512 + lane;
#pragma unroll
        for (int r2 = 0; r2 < 8; ++r2) Y0[r2 * 64] = pk2(d[2 * r2], d[2 * r2 + 1]); }
    { u32x4* GTg = (u32x4*)((unsigned char*)P.out + DO_GT + ci * MB); u32x4* QIg = (u32x4*)(P.ws + WS_QI + ci * MB);
        GTg[tid] = *(const LAS u32x4*)(MAT(S_AT) + tid * 16); QIg[tid] = *(const LAS u32x4*)(MAT(S_KT) + tid * 16); }
    __syncthreads();
#undef MAT
}

__device__ __forceinline__ void pass2_seq(KPR P, LAS unsigned char* lds, int bh, int tid) {
    const int lane = tid & 63, wave = tid >> 6, r32 = lane & 31, hi = lane >> 5, wq = wave & 3, i0 = 32 * (wq >> 1), j0 = 32 * (wq & 1);
    LAS unsigned char* Sm = lds; LAS unsigned char* G0 = lds + MB; LAS unsigned char* G1 = lds + 2 * MB;
    const size_t ci0 = (size_t)bh * NCHUNK;
    const u32x4* GTg = (const u32x4*)((const unsigned char*)P.out + DO_GT + ci0 * MB); u32x4* SCg = (u32x4*)(P.ws + WS_SC + ci0 * MB);
    const float* HT = (const float*)(P.ws + WS_HT) + ci0 * 4096 + (size_t)wq * 1024 + lane;
    *(LAS u32x4*)(Sm + tid * 16) = (u32x4){0u, 0u, 0u, 0u};
    *(LAS u32x4*)(G0 + tid * 16) = GTg[tid];
    u32x4 gnext = GTg[512 + tid];
    f32x16 hcur, hnext;
    if (wave < 4) {
#pragma unroll
        for (int r = 0; r < 16; ++r) { hcur[r] = HT[r * 64]; hnext[r] = HT[4096 + r * 64]; } }
    __syncthreads();
    for (int c = 0; c < NCHUNK; ++c) {
        LAS unsigned char* Gc = (c & 1) ? G1 : G0; LAS unsigned char* Gn = (c & 1) ? G0 : G1;
        SCg[(size_t)c * 512 + tid] = *(const LAS u32x4*)(Sm + tid * 16);
        f32x16 d = hcur;
        if (wave < 4) d = mm_nt(Gc, i0, Sm, j0, d, r32, hi);
        __syncthreads();
        if (wave < 4) store_t(Sm, d, i0, j0, r32, hi);
        *(LAS u32x4*)(Gn + tid * 16) = gnext;
        const int c2 = (c + 2 < NCHUNK) ? c + 2 : NCHUNK - 1;
        gnext = GTg[(size_t)c2 * 512 + tid];
        if (wave < 4) { hcur = hnext;
#pragma unroll
            for (int r = 0; r < 16; ++r) hnext[r] = HT[(size_t)c2 * 4096 + r * 64]; }
        __syncthreads();
    }
}

__device__ __forceinline__ void pass3_chunk(KPR P, LAS unsigned char* lds, int bh, int c, int tid) {
    const int lane = tid & 63, wave = tid >> 6, r32 = lane & 31, hi = lane >> 5, wq = wave & 3, i0 = 32 * (wq >> 1), j0 = 32 * (wq & 1);
    const int b = bh >> 3, h = bh & 7; const size_t tok0 = (size_t)b * SEQ + (size_t)c * 64; const size_t ci = (size_t)bh * NCHUNK + c;
    LAS unsigned char* Qm = lds; LAS unsigned char* Sm = lds + MB; LAS float* Yl = (LAS float*)(lds + 2 * MB);
    *(LAS u32x4*)(Qm + tid * 16) = ((const u32x4*)(P.ws + WS_QI + ci * MB))[tid];
    *(LAS u32x4*)(Sm + tid * 16) = ((const u32x4*)(P.ws + WS_SC + ci * MB))[tid];
    f32x16 d = f32x16{};
    if (wave < 4) { const unsigned* Y0 = (const unsigned*)(P.ws + WS_Y0) + ci * 2048 + (size_t)wq * 512 + lane;
#pragma unroll
        for (int r2 = 0; r2 < 8; ++r2) { const unsigned w = Y0[r2 * 64]; d[2 * r2] = bflo(w); d[2 * r2 + 1] = bfhi(w); } }
    const bf16_t* Z = (const bf16_t*)(P.ws + WS_Z); const bf16_t* LA = (const bf16_t*)(P.ws + WS_LA); const bf16_t* LG = (const bf16_t*)(P.ws + WS_LG);
    bf16_t* AO = (bf16_t*)(P.ws + WS_AO); const int cc = h * 64 + lane;
    const float lnw = P.ln_w[cc], lnb = P.ln_b[cc], rkc = P.r_k[cc], mur = P.mu[RW_R + cc], muk = P.mu[RW_K + cc], muv = P.mu[RW_V + cc], a0c = P.a0[cc], kac = P.k_a[cc];
    const bf16_t* zp = Z + (tok0 + wave * 8) * ZW + ZR + cc; const bool first = (c == 0) && (wave == 0); const bf16_t* zq = first ? zp : zp - ZW; const float pm = first ? 0.f : 1.f;
    unsigned short lr[9], lk[9], lv[9], lla[8], llg[8];
    lr[0] = zq[RW_R]; lk[0] = zq[RW_K]; lv[0] = zq[RW_V];
#pragma unroll
    for (int i = 0; i < 8; ++i) { const bf16_t* zi = zp + (size_t)i * ZW; lr[i + 1] = zi[RW_R]; lk[i + 1] = zi[RW_K]; lv[i + 1] = zi[RW_V]; const size_t o = (tok0 + wave * 8 + i) * 512 + cc; lla[i] = LA[o]; llg[i] = LG[o]; }
    __syncthreads();
    if (wave < 4) { d = mm_nt(Qm, i0, Sm, j0, d, r32, hi);
#pragma unroll
        for (int r = 0; r < 16; ++r) Yl[(i0 + crow(r, hi)) * 65 + j0 + r32] = d[r]; }
    __syncthreads();
    float y[8], s1[8], s2[8], s3[8], vvv[8];
#pragma unroll
    for (int i = 0; i < 8; ++i) { const float pmi = (i == 0) ? pm : 1.f; const float zr1 = bf2f(lr[i + 1]), zk1 = bf2f(lk[i + 1]), zv1 = bf2f(lv[i + 1]);
        const float r = zr1 + (bf2f(lr[i]) * pmi - zr1) * mur, zk = zk1 + (bf2f(lk[i]) * pmi - zk1) * muk; vvv[i] = zv1 + (bf2f(lv[i]) * pmi - zv1) * muv;
        const float a = __builtin_amdgcn_rcpf(1.0f + __expf(-(a0c + bf2f(lla[i])))); const float k = zk * (1.0f + (a - 1.0f) * kac);
        y[i] = Yl[(wave * 8 + i) * 65 + lane]; s1[i] = y[i]; s3[i] = r * k * rkc; }
#pragma unroll
    for (int i = 0; i < 8; ++i) { s1[i] = wave_sum(s1[i]); s3[i] = wave_sum(s3[i]); }
#pragma unroll
    for (int i = 0; i < 8; ++i) { y[i] -= s1[i] * (1.f / 64.f); s2[i] = y[i] * y[i]; }
#pragma unroll
    for (int i = 0; i < 8; ++i) s2[i] = wave_sum(s2[i]);
#pragma unroll
    for (int i = 0; i < 8; ++i) { const size_t tok = tok0 + wave * 8 + i; const float yn = y[i] * rsqrtf(s2[i] * (1.f / 64.f) + 64e-5f) * lnw + lnb;
        AO[tok * DM + 512 + cc] = (bf16_t)f2bf((yn + s3[i] * vvv[i]) * bf2f(llg[i])); }
}

constexpr size_t WS_W2T = 29 * MiB, WS_A2T = 29 * MiB + 65536, WS_G2T = 29 * MiB + 131072;
__device__ __forceinline__ bf16x8 act8(const bf16_t* zc, const bf16_t* zpv, float pmask, const float* mu, int mode) {
    const u32x4 c = *(const u32x4*)zc, p = *(const u32x4*)zpv;
    const f32x4 m0 = *(const f32x4*)mu, m1 = *(const f32x4*)(mu + 4);
    const unsigned cw[4] = {c.x, c.y, c.z, c.w}, pw[4] = {p.x, p.y, p.z, p.w}; const float um[8] = {m0[0], m0[1], m0[2], m0[3], m1[0], m1[1], m1[2], m1[3]}; float v[8];
#pragma unroll
    for (int j = 0; j < 4; ++j) { const float c0 = bflo(cw[j]), c1 = bfhi(cw[j]), p0 = bflo(pw[j]) * pmask, p1 = bfhi(pw[j]) * pmask;
        v[2 * j] = c0 + (p0 - c0) * um[2 * j]; v[2 * j + 1] = c1 + (p1 - c1) * um[2 * j + 1]; }
#pragma unroll
    for (int j = 0; j < 8; ++j) { if (mode == 0) { const float e = __expf(-2.0f * fabsf(v[j])); const float th = (1.0f - e) * __builtin_amdgcn_rcpf(1.0f + e); v[j] = v[j] < 0.f ? -th : th; } else if (mode == 2) v[j] = __builtin_amdgcn_rcpf(1.0f + __expf(-v[j])); }
    u32x4 w; w.x = pk2(v[0], v[1]); w.y = pk2(v[2], v[3]); w.z = pk2(v[4], v[5]); w.w = pk2(v[6], v[7]);
    return __builtin_bit_cast(bf16x8, w);
}
__device__ __forceinline__ int goff(int row, int col) { return row * 256 + ((((col >> 3) ^ row) & 15) << 4) + (col & 7) * 2; }
__device__ __forceinline__ void lora_block(KPR P, LAS unsigned char* lds, int blk, int G, int tid) {
    const int lane = tid & 63, wave = tid >> 6, r32 = lane & 31, hi = lane >> 5;
    const int task = blk * 4 + (wave & 3), cb0 = 8 * (wave >> 2); const bool work = task < NTOK / 32;
    const size_t row = (size_t)(work ? task : 0) * 32 + r32; const bool first = (row % SEQ) == 0;
    const bf16_t* Z = (const bf16_t*)(P.ws + WS_Z) + row * ZW + ZR + 8 * hi; const bf16_t* Zp = first ? Z : Z - ZW; const float pmask = first ? 0.f : 1.f;
    const float* mub = P.mu + 8 * hi;
    { const u32x4* w2 = (const u32x4*)(P.ws + WS_W2T); const u32x4* a2 = (const u32x4*)(P.ws + WS_A2T);
#pragma unroll
        for (int i = 0; i < 8; ++i) { const int idx = i * 512 + tid, rw = idx >> 3, ch = idx & 7; const int o = rw * 128 + (((ch ^ (rw >> 1)) & 7) << 4);
            *(LAS u32x4*)(lds + o) = w2[idx]; *(LAS u32x4*)(lds + 65536 + o) = a2[idx]; } }
    bf16x8 xw[4], xa[4], xg[8];
    if (work) {
#pragma unroll
        for (int ks = 0; ks < 4; ++ks) { xw[ks] = act8(Z + RW_W + 16 * ks, Zp + RW_W + 16 * ks, pmask, mub + RW_W + 16 * ks, 0); xa[ks] = act8(Z + RW_A + 16 * ks, Zp + RW_A + 16 * ks, pmask, mub + RW_A + 16 * ks, 1); asm volatile("" ::: "memory"); }
#pragma unroll
        for (int ks = 0; ks < 8; ++ks) { xg[ks] = act8(Z + RW_G + 16 * ks, Zp + RW_G + 16 * ks, pmask, mub + RW_G + 16 * ks, 2); if (ks & 1) asm volatile("" ::: "memory"); }
    }
    bf16_t* LW = (bf16_t*)(P.ws + WS_LW) + row * 512 + 4 * hi; bf16_t* LA = (bf16_t*)(P.ws + WS_LA) + row * 512 + 4 * hi; bf16_t* LG = (bf16_t*)(P.ws + WS_LG) + row * 512 + 4 * hi;
    __syncthreads();
    if (work) {
#pragma nounroll
        for (int cb = cb0; cb < cb0 + 8; ++cb) { f32x16 dw = f32x16{}, da = f32x16{};
#pragma unroll
            for (int ks = 0; ks < 4; ++ks) { const int o = moff(cb * 32 + r32, 16 * ks + 8 * hi);
                dw = __builtin_amdgcn_mfma_f32_32x32x16_bf16(*(const LAS bf16x8*)(lds + o), xw[ks], dw, 0, 0, 0); da = __builtin_amdgcn_mfma_f32_32x32x16_bf16(*(const LAS bf16x8*)(lds + 65536 + o), xa[ks], da, 0, 0, 0); }
#pragma unroll
            for (int g = 0; g < 4; ++g) { u32x2 w; w.x = pk2(dw[4 * g], dw[4 * g + 1]); w.y = pk2(dw[4 * g + 2], dw[4 * g + 3]); *(u32x2*)(LW + cb * 32 + 8 * g) = w;
                w.x = pk2(da[4 * g], da[4 * g + 1]); w.y = pk2(da[4 * g + 2], da[4 * g + 3]); *(u32x2*)(LA + cb * 32 + 8 * g) = w; } }
    }
    __syncthreads();
    { const u32x4* g2 = (const u32x4*)(P.ws + WS_G2T);
#pragma unroll
        for (int i = 0; i < 16; ++i) { const int idx = i * 512 + tid, rw = idx >> 4, ch = idx & 15; *(LAS u32x4*)(lds + rw * 256 + (((ch ^ rw) & 15) << 4)) = g2[idx]; } }
    __syncthreads();
    if (work) {
#pragma nounroll
        for (int cb = cb0; cb < cb0 + 8; ++cb) { f32x16 dg = f32x16{};
#pragma unroll
            for (int ks = 0; ks < 8; ++ks) dg = __builtin_amdgcn_mfma_f32_32x32x16_bf16(*(const LAS bf16x8*)(lds + goff(cb * 32 + r32, 16 * ks + 8 * hi)), xg[ks], dg, 0, 0, 0);
#pragma unroll
            for (int g = 0; g < 4; ++g) { u32x2 w; w.x = pk2(dg[4 * g], dg[4 * g + 1]); w.y = pk2(dg[4 * g + 2], dg[4 * g + 3]); *(u32x2*)(LG + cb * 32 + 8 * g) = w; } }
    }
    __syncthreads();
}
}
namespace rt {
__device__ __forceinline__ int woff(int e, int k) { return e * 2048 + ((((k >> 3) ^ (e & 15))) << 4) + (k & 7) * 2; }
constexpr size_t WS_WRI = 30 * MiB;
__device__ __forceinline__ void build_w(KPR P, int part, int tid) {
    unsigned char* img = P.ws + WS_WRI; const int e = tid & 31, k0 = part * 64 + 4 * (tid >> 5); float w[4];
#pragma unroll
    for (int i = 0; i < 4; ++i) w[i] = P.moe_norm[k0 + i] * P.w_router[(k0 + i) * 32 + e];
#pragma unroll
    for (int i = 0; i < 4; ++i) { const int k = k0 + i; const unsigned h = f2bf(w[i]); const unsigned l = f2bf(w[i] - bf2f(h));
        *(unsigned short*)(img + woff(e, k)) = (unsigned short)h; *(unsigned short*)(img + 65536 + woff(e, k)) = (unsigned short)l; }
}
__device__ __forceinline__ void copy_w(KPR P, LAS unsigned char* lds, int tid) {
    const u32x4* img = (const u32x4*)(P.ws + WS_WRI);
    u32x4 t[16];
#pragma unroll
    for (int i = 0; i < 16; ++i) t[i] = img[i * 512 + tid];
#pragma unroll
    for (int i = 0; i < 16; ++i) *(LAS u32x4*)(lds + (size_t)(i * 512 + tid) * 16) = t[i];
}
__device__ __forceinline__ void split8(const f32x4& a, const f32x4& b, bf16x8& h, bf16x8& l) {
    unsigned hh[8]; float v[8] = {a[0], a[1], a[2], a[3], b[0], b[1], b[2], b[3]};
#pragma unroll
    for (int j = 0; j < 8; ++j) hh[j] = f2bf(v[j]);
    u32x4 hw, lw;
    hw.x = hh[0] | (hh[1] << 16); hw.y = hh[2] | (hh[3] << 16); hw.z = hh[4] | (hh[5] << 16); hw.w = hh[6] | (hh[7] << 16);
    lw.x = pk2(v[0] - bf2f(hh[0]), v[1] - bf2f(hh[1])); lw.y = pk2(v[2] - bf2f(hh[2]), v[3] - bf2f(hh[3])); lw.z = pk2(v[4] - bf2f(hh[4]), v[5] - bf2f(hh[5])); lw.w = pk2(v[6] - bf2f(hh[6]), v[7] - bf2f(hh[7]));
    h = __builtin_bit_cast(bf16x8, hw); l = __builtin_bit_cast(bf16x8, lw);
}
__device__ __forceinline__ void route_task(KPR P, const LAS unsigned char* wlds, int task, int lane) {
    const int r32 = lane & 31, hi = lane >> 5; const int row = task * 32 + r32;
    const bf16_t* xrow = (const bf16_t*)(P.ws + WS_X1) + (size_t)row * DM + 8 * hi;
    f32x16 acc = f32x16{}; float ss = 0.f;
    u32x4 xq[16];
#pragma unroll
    for (int j = 0; j < 16; ++j) xq[j] = *(const u32x4*)(xrow + 16 * j);
    for (int ks0 = 0; ks0 < 64; ks0 += 16) {
#pragma unroll
        for (int j = 0; j < 16; ++j) { const int ks = ks0 + j; const u32x4 xv = xq[j];
            const int kn = (ks + 16 < 64) ? ks + 16 : ks; xq[j] = *(const u32x4*)(xrow + 16 * kn);
            const unsigned xw[4] = {xv.x, xv.y, xv.z, xv.w};
#pragma unroll
            for (int q = 0; q < 4; ++q) { const float a = bflo(xw[q]), b = bfhi(xw[q]); ss += a * a + b * b; }
            const bf16x8 xh = __builtin_bit_cast(bf16x8, xv);
            const bf16x8 wh = *(const LAS bf16x8*)(wlds + woff(r32, 16 * ks + 8 * hi)), wl = *(const LAS bf16x8*)(wlds + 65536 + woff(r32, 16 * ks + 8 * hi));
            acc = __builtin_amdgcn_mfma_f32_32x32x16_bf16(wh, xh, acc, 0, 0, 0); acc = __builtin_amdgcn_mfma_f32_32x32x16_bf16(wl, xh, acc, 0, 0, 0); }
    }
    ss += __shfl_xor(ss, 32);
    const float rstd = rsqrtf(ss * (1.f / DM) + 1e-6f);
    float lg[16];
#pragma unroll
    for (int g = 0; g < 4; ++g) { const f32x4 bb = *(const f32x4*)(P.b_router + 8 * g + 4 * hi);
#pragma unroll
        for (int i = 0; i < 4; ++i) lg[4 * g + i] = acc[4 * g + i] * rstd + bb[i]; }
    float tv[4]; int ti[4];
#pragma unroll
    for (int k = 0; k < 4; ++k) { float bv = lg[0]; int bi = 4 * hi;
#pragma unroll
        for (int r = 1; r < 16; ++r) { const int e = (r & 3) + 8 * (r >> 2) + 4 * hi; if (lg[r] > bv) { bv = lg[r]; bi = e; } }
        const float pv = __shfl_xor(bv, 32); const int pi = __shfl_xor(bi, 32);
        if (pv > bv || (pv == bv && pi < bi)) { bv = pv; bi = pi; }
        tv[k] = bv; ti[k] = bi;
#pragma unroll
        for (int r = 0; r < 16; ++r) { const int e = (r & 3) + 8 * (r >> 2) + 4 * hi; if (e == bi) lg[r] = -INFINITY; } }
    const float e1 = __expf(tv[1] - tv[0]), e2 = __expf(tv[2] - tv[0]), e3 = __expf(tv[3] - tv[0]), inv = 1.f / (1.f + e1 + e2 + e3);
    const int c0 = hi ? ti[2] : ti[0], c1 = hi ? ti[3] : ti[1]; const float g0 = (hi ? e2 : 1.f) * inv, g1 = (hi ? e3 : e1) * inv;
    const unsigned long long ltm = (1ull << lane) - 1ull; int mycnt = 0, rk0 = 0, rk1 = 0;
    for (int e = 0; e < 32; ++e) { const unsigned long long m0 = __ballot(c0 == e), m1 = __ballot(c1 == e); const int n0 = __popcll(m0);
        if (lane == e) mycnt = n0 + __popcll(m1);
        if (c0 == e) rk0 = __popcll(m0 & ltm);
        if (c1 == e) rk1 = n0 + __popcll(m1 & ltm); }
    unsigned* cnt = (unsigned*)(P.ws + WS_CTL) + CW_CNT; int base = 0;
    if (lane < 32 && mycnt > 0) base = (int)atomicAdd(cnt + lane, (unsigned)mycnt);
    rk0 += __shfl(base, c0); rk1 += __shfl(base, c1);
    int* route = (int*)(P.ws + WS_ROUTE); int* tokslot = (int*)(P.ws + WS_TOKSLOT); float* gateslot = (float*)(P.ws + WS_GATESLOT);
    tokslot[(size_t)c0 * NTOK + rk0] = row; gateslot[(size_t)c0 * NTOK + rk0] = g0; tokslot[(size_t)c1 * NTOK + rk1] = row; gateslot[(size_t)c1 * NTOK + rk1] = g1;
    route[(size_t)row * 12 + 2 * hi] = c0; route[(size_t)row * 12 + 2 * hi + 1] = c1; route[(size_t)row * 12 + 4 + 2 * hi] = rk0; route[(size_t)row * 12 + 4 + 2 * hi + 1] = rk1;
}
__device__ __forceinline__ void xn8_task(KPR P, int task, int lane) {
    const bf16_t* x1 = (const bf16_t*)(P.ws + WS_X1) + (size_t)task * 32 * DM + 16 * lane; unsigned char* xn = P.ws + WS_XN + (size_t)task * 32 * DM + 16 * lane;
    f32x4 g[4];
#pragma unroll
    for (int q = 0; q < 4; ++q) g[q] = *(const f32x4*)(P.moe_norm + 16 * lane + 4 * q);
    u32x4 xa[4][2];
#pragma unroll
    for (int i = 0; i < 4; ++i) { xa[i][0] = *(const u32x4*)(x1 + (size_t)i * DM); xa[i][1] = *(const u32x4*)(x1 + (size_t)i * DM + 8); }
    for (int r0 = 0; r0 < 32; r0 += 4) {
        f32x4 v[4][4]; float ss[4];
#pragma unroll
        for (int i = 0; i < 4; ++i) { const unsigned w[8] = {xa[i][0].x, xa[i][0].y, xa[i][0].z, xa[i][0].w, xa[i][1].x, xa[i][1].y, xa[i][1].z, xa[i][1].w}; float s = 0.f;
#pragma unroll
            for (int q = 0; q < 4; ++q) { v[i][q] = (f32x4){bflo(w[2 * q]), bfhi(w[2 * q]), bflo(w[2 * q + 1]), bfhi(w[2 * q + 1])}; s += (v[i][q][0] * v[i][q][0] + v[i][q][1] * v[i][q][1]) + (v[i][q][2] * v[i][q][2] + v[i][q][3] * v[i][q][3]); }
            ss[i] = s;
            const int rn = (r0 + 4 + i < 32) ? r0 + 4 + i : r0 + i; xa[i][0] = *(const u32x4*)(x1 + (size_t)rn * DM); xa[i][1] = *(const u32x4*)(x1 + (size_t)rn * DM + 8); }
#pragma unroll
        for (int i = 0; i < 4; ++i) ss[i] = wave_sum(ss[i]);
#pragma unroll
        for (int i = 0; i < 4; ++i) { const float rstd = rsqrtf(ss[i] * (1.f / DM) + 1e-6f); u32x4 o; unsigned ow[4];
#pragma unroll
            for (int q = 0; q < 4; ++q) { const f32x4 t = v[i][q] * rstd * g[q]; ow[q] = pk4_fp8(t[0], t[1], t[2], t[3]); }
            o.x = ow[0]; o.y = ow[1]; o.z = ow[2]; o.w = ow[3];
            *(u32x4*)(xn + (size_t)(r0 + i) * DM) = o; }
    }
}
}
namespace attn_body {
using bf16=unsigned short;
using bf16x8=__attribute__((ext_vector_type(8)))short;
using s16x4=__attribute__((ext_vector_type(4)))short;
using f32x16=__attribute__((ext_vector_type(16)))float;
using u32x4=__attribute__((ext_vector_type(4)))unsigned;
constexpr int BATCH=4,NHEAD=8,SEQ=8192,D=64,DM=3840,OP=1024;
constexpr int NW=8,QBLK=32,QB=QBLK*NW,KVBLK=64,NQB=SEQ/QB;
constexpr int ATTN_PITCH=DM, ATTN_UNIT_ROWS=QB;
__device__ __forceinline__ int crow(int r,int hi){return (r&3)+8*(r>>2)+4*hi;}
#define SBAR() __builtin_amdgcn_sched_barrier(0)
__device__ __forceinline__ void cmask(f32x16&p0,f32x16&p1,int jb,int qrel,int hi){
  const float NEG=-INFINITY; int kb=64*jb+4*hi;
  #pragma unroll
  for(int r=0;r<16;++r){int kv=kb+(r&3)+8*(r>>2); if(kv>qrel)p0[r]=NEG; if(kv+32>qrel)p1[r]=NEG;}
}

constexpr int NSLOT=3, SLOTB=8192;
constexpr int LDS_K=0, LDS_V=NSLOT*SLOTB, LDS_WS=2*NSLOT*SLOTB, LDS_OST=LDS_WS+NW*64*4, LDS_C2=LDS_OST+NW*4096, LDS_BYTES=LDS_C2+SEQ*4;
constexpr float C2=0.125f*1.4426950408889634f;
__device__ __forceinline__ void glds16(const void*gsrc,unsigned lds_dst){unsigned keep;
  asm volatile("s_mov_b32 %0, m0\n\ts_mov_b32 m0, %2\n\ts_nop 0\n\tglobal_load_lds_dwordx4 %1, off\n\ts_mov_b32 m0, %0":"=&s"(keep):"v"(gsrc),"s"(lds_dst):"memory");}
__device__ __forceinline__ float max3f(float a,float b,float c){float r;asm("v_max3_f32 %0, %1, %2, %3":"=v"(r):"v"(a),"v"(b),"v"(c));return r;}
__device__ __forceinline__ float max2f(float a,float b){float r;asm("v_max_f32_e32 %0, %1, %2":"=v"(r):"v"(a),"v"(b));return r;}
__device__ __forceinline__ float fadd_s(float a,float b){float r;asm("v_add_f32_e32 %0, %1, %2":"=v"(r):"v"(a),"v"(b));return r;}
__device__ __forceinline__ float fsub_s(float a,float b){float r;asm("v_sub_f32_e32 %0, %1, %2":"=v"(r):"v"(a),"v"(b));return r;}
typedef float f32x2_t __attribute__((ext_vector_type(2))); typedef float f32x4v __attribute__((ext_vector_type(4))); typedef __bf16 bf16x2_t __attribute__((ext_vector_type(2)));
__device__ __forceinline__ unsigned cvtpk_s(float lo,float hi){f32x2_t v={lo,hi};bf16x2_t b=__builtin_convertvector(v,bf16x2_t);return __builtin_bit_cast(unsigned,b);}
#define WAIT_BAR(N) asm volatile("s_waitcnt vmcnt(" #N ") lgkmcnt(0)\n\ts_barrier":::"memory")

__device__ __forceinline__ void qkt(f32x16&p0,f32x16&p1,const char*Kslot,const bf16x8*qr,int r32,int hi){
  const char*kb=Kslot+hi*1024+r32*16;
  #pragma unroll
  for(int d0=0;d0<4;++d0){
    const bf16x8 b0=*reinterpret_cast<const bf16x8*>(kb+d0*2048);
    const bf16x8 b1=*reinterpret_cast<const bf16x8*>(kb+d0*2048+512);
    p0=__builtin_amdgcn_mfma_f32_32x32x16_bf16(b0,qr[d0],p0,0,0,0);p1=__builtin_amdgcn_mfma_f32_32x32x16_bf16(b1,qr[d0],p1,0,0,0);}
}
typedef __attribute__((address_space(3))) const char* lds_cptr;
typedef short v4i16_t __attribute__((ext_vector_type(4)));
__device__ __forceinline__ void kload8(bf16x8*kf,lds_cptr kp){
  kf[0]=*(const __attribute__((address_space(3))) bf16x8*)(kp);      kf[1]=*(const __attribute__((address_space(3))) bf16x8*)(kp+512);
  kf[2]=*(const __attribute__((address_space(3))) bf16x8*)(kp+2048); kf[3]=*(const __attribute__((address_space(3))) bf16x8*)(kp+2560);
  kf[4]=*(const __attribute__((address_space(3))) bf16x8*)(kp+4096); kf[5]=*(const __attribute__((address_space(3))) bf16x8*)(kp+4608);
  kf[6]=*(const __attribute__((address_space(3))) bf16x8*)(kp+6144); kf[7]=*(const __attribute__((address_space(3))) bf16x8*)(kp+6656);
}
__device__ __forceinline__ void kload2(bf16x8*kf,lds_cptr kp,int j){ kf[2*j]=*(const __attribute__((address_space(3))) bf16x8*)(kp+j*2048); kf[2*j+1]=*(const __attribute__((address_space(3))) bf16x8*)(kp+j*2048+512); }
__device__ __forceinline__ s16x4 vtr(lds_cptr p){ return __builtin_bit_cast(s16x4,__builtin_amdgcn_ds_read_tr16_b64_v4i16((__attribute__((address_space(3))) v4i16_t*)p)); }
__device__ __forceinline__ float rowmax(const f32x16&p0,const f32x16&p1){
  float a=max3f(p0[0],p0[1],p1[0]),b=max3f(p0[2],p0[3],p1[1]);a=max3f(a,p1[2],p1[3]);
  #pragma unroll
  for(int r=4;r<16;r+=4){a=max3f(a,p0[r],p0[r+1]);b=max3f(b,p0[r+2],p0[r+3]);a=max3f(a,p1[r],p1[r+1]);b=max3f(b,p1[r+2],p1[r+3]);}
  const float m=max2f(a,b);
  auto rr=__builtin_amdgcn_permlane32_swap(__float_as_uint(m),__float_as_uint(m),false,false);
  return max2f(__uint_as_float(rr[0]),__uint_as_float(rr[1]));
}
__device__ __forceinline__ void pv(f32x16*o,int vb,bf16x8 pa0,bf16x8 pa1,bf16x8 pa2,bf16x8 pa3){
  #pragma unroll
  for(int d0=0;d0<2;++d0){s16x4 lo[4],hi[4];
    #pragma unroll
    for(int ks=0;ks<4;++ks){
      asm volatile("ds_read_b64_tr_b16 %0,%1 offset:%c2":"=&v"(lo[ks]):"v"(vb),"i"(d0*4096+ks*1024):"memory");
      asm volatile("ds_read_b64_tr_b16 %0,%1 offset:%c2":"=&v"(hi[ks]):"v"(vb),"i"(d0*4096+ks*1024+512):"memory");}
    asm volatile("s_waitcnt lgkmcnt(0)":::"memory");SBAR();
    #define PK(k) (bf16x8){lo[k][0],lo[k][1],lo[k][2],lo[k][3],hi[k][0],hi[k][1],hi[k][2],hi[k][3]}
    o[d0]=__builtin_amdgcn_mfma_f32_32x32x16_bf16(pa0,PK(0),o[d0],0,0,0);
    o[d0]=__builtin_amdgcn_mfma_f32_32x32x16_bf16(pa1,PK(1),o[d0],0,0,0);
    o[d0]=__builtin_amdgcn_mfma_f32_32x32x16_bf16(pa2,PK(2),o[d0],0,0,0);
    o[d0]=__builtin_amdgcn_mfma_f32_32x32x16_bf16(pa3,PK(3),o[d0],0,0,0);
    #undef PK
  }
}

#ifndef ATTN_STORE16
#define ATTN_STORE16(p,v) (*(u32x4*)(p)=(v))
#endif
template<int THRL> __device__ __forceinline__ void attn_unit(int b,int h,int qb,int t0,const bf16*Z,const float*c2g,bf16*O,char*shm){
  int tid_=threadIdx.x; asm volatile("":"+v"(tid_));
  const int tid=tid_,lane=tid&63,r32=lane&31,hi=lane>>5; const int wid=__builtin_amdgcn_readfirstlane(tid>>6);
  const long rowbase=(long)b*SEQ; const int q0=qb*QB;
  const bf16*Qw=Z+(rowbase+q0+wid*QBLK)*DM+h*D;
  const bf16*Kh=Z+(rowbase+(long)t0*KVBLK)*DM+512+h*D,*Vh=Z+(rowbase+(long)t0*KVBLK)*DM+1024+h*D;
  const unsigned lds0=(unsigned)(uintptr_t)shm;
  float*wsf=(float*)(shm+LDS_WS)+wid*64;
  const bf16*ksrc=Kh+(long)lane*DM+wid*8;
  const bf16*vsrc=Vh+(long)(16*(wid&3)+(lane>>2))*DM+(wid>>2)*32+(lane&3)*8;
  const unsigned kdst=lds0+LDS_K+wid*1024, vdst=lds0+LDS_V+wid*1024;
  #define DMA_K(t,slot) glds16(ksrc+(long)(t)*KVBLK*DM,(unsigned)__builtin_amdgcn_readfirstlane(kdst+(slot)))
  #define DMA_V(t,slot) glds16(vsrc+(long)(t)*KVBLK*DM,(unsigned)__builtin_amdgcn_readfirstlane(vdst+(slot)))
  const int vb0=(int)(lds0+LDS_V)+((lane>>4)&1)*32+(lane&3)*8+(4*hi+((lane&15)>>2))*64;
  const char*Kbase=shm+LDS_K; bf16x8 kf[8];
  const lds_cptr shm3=(lds_cptr)shm; const lds_cptr kp0=shm3+LDS_K+hi*1024+r32*16; const lds_cptr vp0=shm3+LDS_V+((lane>>4)&1)*32+(lane&3)*8+(4*hi+((lane&15)>>2))*64;
  const int NT=(q0+QB)/KVBLK-t0;
  { const int np=(q0+QB)/256;
    for(int p=(t0>>2)+wid;p<np;p+=NW) glds16(c2g+p*256+lane*4,(unsigned)__builtin_amdgcn_readfirstlane(lds0+LDS_C2+p*1024)); }
  const __attribute__((address_space(3))) float* c2l=(const __attribute__((address_space(3))) float*)(shm3+LDS_C2)+t0*KVBLK+4*hi;
  DMA_K(0,0);DMA_V(0,0);DMA_K(1,SLOTB);
  bf16x8 qr[4];
  #pragma unroll
  for(int d0=0;d0<4;++d0)qr[d0]=*reinterpret_cast<const bf16x8*>(&Qw[(long)r32*DM+d0*16+hi*8]);
  float l_reg=0.f;f32x16 o[2];o[0]=f32x16{};o[1]=f32x16{};
  float base=c2g[q0+wid*QBLK+r32];
  const int qrel=wid*QBLK+r32;
  #define CMASK(P0,P1,t) do{int jb_=(t)-(NT-4); if(jb_>=0)cmask(P0,P1,jb_,qrel,hi);}while(0)
  bool resc=false;
  #define START(P0,P1) do{ const float rm=rowmax(P0,P1); resc=false; \
    { const float dl=rm; base=fsub_s(base,dl); \
      _Pragma("unroll") for(int r=0;r<16;++r){P0[r]=fsub_s(P0[r],dl);P1[r]=fsub_s(P1[r],dl);} } \
    _Pragma("unroll") for(int r=0;r<16;++r)P0[r]=__builtin_amdgcn_exp2f(P0[r]); }while(0)
  #define RESC() do{ if(resc){ asm volatile("s_waitcnt lgkmcnt(0)":::"memory"); \
      _Pragma("unroll") for(int d_=0;d_<2;++d_) _Pragma("unroll") for(int r=0;r<16;++r)o[d_][r]*=wsf[crow(r,hi)]; } }while(0)
  f32x16 pA0,pA1,pB0,pB1;
  #define BIASLD(P0,P1,tt) do{ _Pragma("unroll") for(int g_=0;g_<4;++g_){ const f32x4v x0_=*(const __attribute__((address_space(3))) f32x4v*)(c2l+(tt)*KVBLK+8*g_), x1_=*(const __attribute__((address_space(3))) f32x4v*)(c2l+(tt)*KVBLK+32+8*g_); \
      P0[4*g_]=x0_[0];P0[4*g_+1]=x0_[1];P0[4*g_+2]=x0_[2];P0[4*g_+3]=x0_[3]; P1[4*g_]=x1_[0];P1[4*g_+1]=x1_[1];P1[4*g_+2]=x1_[2];P1[4*g_+3]=x1_[3]; } }while(0)
  #define BIASFIX(P0,P1) do{ _Pragma("unroll") for(int r=0;r<16;++r){P0[r]=fsub_s(base,P0[r]);P1[r]=fsub_s(base,P1[r]);} }while(0)
  int sl_prev=0,sl_cur=0,sl_next=SLOTB;
  #define ROT() do{sl_prev=sl_cur;sl_cur=sl_next;sl_next=(sl_next==(NSLOT-1)*SLOTB)?0:sl_next+SLOTB;}while(0)
  DMA_K(2,2*SLOTB);
  WAIT_BAR(3);
  BIASLD(pA0,pA1,0); BIASFIX(pA0,pA1);
  qkt(pA0,pA1,Kbase,qr,r32,hi);asm volatile("s_nop 15\n\ts_nop 7":"+v"(pA0),"+v"(pA1));CMASK(pA0,pA1,0);
  START(pA0,pA1);
  _Pragma("unroll") for(int r=0;r<16;++r)pA1[r]=__builtin_amdgcn_exp2f(pA1[r]);
  BIASLD(pB0,pB1,1);
  WAIT_BAR(0);
  DMA_K(3,0);DMA_V(1,SLOTB);
  ROT();
  kload8(kf,kp0+sl_cur);
  WAIT_BAR(2);
  s16x4 vlo[8],vhi[8]; u32x4 pw0,pw1,pw2,pw3;
  #define PKW(P,B) cvtpk_s(P[B],P[B+1])
  #define PAF(k) __builtin_bit_cast(bf16x8,pw##k)
  #define VFR(i) (bf16x8){vlo[i][0],vlo[i][1],vlo[i][2],vlo[i][3],vhi[i][0],vhi[i][1],vhi[i][2],vhi[i][3]}
  #define PIN(x) asm volatile("":"+v"(x))
  #define MX3(a,b,c) __builtin_fmaxf(__builtin_fmaxf((a),(b)),(c))
  #define GAPA(MF,A0,A1,A2,A3,W0,W1,PW) do{ MF; sacc+=A0; sacc+=A1; sacc+=A2; sacc+=A3; PIN(sacc); W0; W1; PIN(PW); SBAR(); }while(0)
  #define EX(v) __builtin_amdgcn_exp2f(v)
  #define GAPB(MF,X,B) do{ MF; X[B]=EX(X[B]); X[B+1]=EX(X[B+1]); X[B+2]=EX(X[B+2]); X[B+3]=EX(X[B+3]); PIN(X); SBAR(); }while(0)
  #define VRD(i) do{ vlo[i]=vtr(vp_+(((i)>>2)*4096+((i)&3)*1024)); vhi[i]=vtr(vp_+(((i)>>2)*4096+((i)&3)*1024+512)); }while(0)
  #define KRD(G,j) do{ if(G){ kload2(kf,kp0+sl_next,j); SBAR(); } }while(0)
  #define STEP(C0,C1,P0,P1,t,GK,GV,GL) do{ SBAR(); \
    BIASFIX(C0,C1); SBAR(); \
    const lds_cptr vp_=vp0+sl_prev; \
    VRD(0); SBAR(); float sacc=(P0[0]+P0[1]); \
    GAPA(C0=__builtin_amdgcn_mfma_f32_32x32x16_bf16(kf[0],qr[0],C0,0,0,0), P0[2],P0[3],P0[4],P0[5],     pw0[0]=PKW(P0,0), pw0[1]=PKW(P0,2), pw0); \
    VRD(4); SBAR(); GAPA(C1=__builtin_amdgcn_mfma_f32_32x32x16_bf16(kf[1],qr[0],C1,0,0,0), P0[6],P0[7],P0[8],P0[9],     pw0[2]=PKW(P0,4), pw0[3]=PKW(P0,6), pw0); \
    VRD(1); SBAR(); GAPA(C0=__builtin_amdgcn_mfma_f32_32x32x16_bf16(kf[2],qr[1],C0,0,0,0),   P0[10],P0[11],P0[12],P0[13], pw1[0]=PKW(P0,8), pw1[1]=PKW(P0,10), pw1); \
    VRD(5); SBAR(); GAPA(C1=__builtin_amdgcn_mfma_f32_32x32x16_bf16(kf[3],qr[1],C1,0,0,0),   P0[14],P0[15],P1[0],P1[1],   pw1[2]=PKW(P0,12),pw1[3]=PKW(P0,14), pw1); \
    VRD(2); SBAR(); GAPA(C0=__builtin_amdgcn_mfma_f32_32x32x16_bf16(kf[4],qr[2],C0,0,0,0),   P1[2],P1[3],P1[4],P1[5],     pw2[0]=PKW(P1,0), pw2[1]=PKW(P1,2), pw2); \
    VRD(6); SBAR(); GAPA(C1=__builtin_amdgcn_mfma_f32_32x32x16_bf16(kf[5],qr[2],C1,0,0,0),   P1[6],P1[7],P1[8],P1[9],     pw2[2]=PKW(P1,4), pw2[3]=PKW(P1,6), pw2); \
    VRD(3); SBAR(); GAPA(C0=__builtin_amdgcn_mfma_f32_32x32x16_bf16(kf[6],qr[3],C0,0,0,0),   P1[10],P1[11],P1[12],P1[13], pw3[0]=PKW(P1,8), pw3[1]=PKW(P1,10), pw3); \
    VRD(7); SBAR(); GAPA(C1=__builtin_amdgcn_mfma_f32_32x32x16_bf16(kf[7],qr[3],C1,0,0,0),   P1[14],P1[15],0.f,0.f,       pw3[2]=PKW(P1,12),pw3[3]=PKW(P1,14), pw3); \
    l_reg+=sacc; \
    if(GL){BIASLD(P0,P1,(t)+1);} \
    if(GK){DMA_K((t)+3,sl_cur);} if(GV){DMA_V((t)+1,sl_next);} \
    CMASK(C0,C1,t); \
    { float a=MX3(C0[0],C0[1],C1[0]),b=MX3(C0[2],C0[3],C1[1]); a=MX3(a,C1[2],C1[3]); \
      _Pragma("unroll") for(int r=4;r<16;r+=4){a=MX3(a,C0[r],C0[r+1]);b=MX3(b,C0[r+2],C0[r+3]);a=MX3(a,C1[r],C1[r+1]);b=MX3(b,C1[r+2],C1[r+3]);} \
      float rm=__builtin_fmaxf(a,b); { auto rr=__builtin_amdgcn_permlane32_swap(__float_as_uint(rm),__float_as_uint(rm),false,false); rm=__builtin_fmaxf(__uint_as_float(rr[0]),__uint_as_float(rr[1])); } \
      resc=false; \
      if(__builtin_expect(__any(rm>(float)THRL),0)){ const float dl=__builtin_fmaxf(rm,0.f); base-=dl; \
        _Pragma("unroll") for(int r=0;r<16;++r){C0[r]-=dl;C1[r]-=dl;} \
        const float f=__builtin_amdgcn_exp2f(-dl); l_reg*=f; if(hi==0)wsf[r32]=f; resc=true; } } \
    SBAR(); \
    GAPB(o[0]=__builtin_amdgcn_mfma_f32_32x32x16_bf16(PAF(0),VFR(0),o[0],0,0,0), C0,0); \
    GAPB(o[1]=__builtin_amdgcn_mfma_f32_32x32x16_bf16(PAF(0),VFR(4),o[1],0,0,0), C0,4); \
    KRD(GL,0); GAPB(o[0]=__builtin_amdgcn_mfma_f32_32x32x16_bf16(PAF(1),VFR(1),o[0],0,0,0), C0,8); \
    KRD(GL,1); GAPB(o[1]=__builtin_amdgcn_mfma_f32_32x32x16_bf16(PAF(1),VFR(5),o[1],0,0,0), C0,12); \
    KRD(GL,2); GAPB(o[0]=__builtin_amdgcn_mfma_f32_32x32x16_bf16(PAF(2),VFR(2),o[0],0,0,0), C1,0); \
    KRD(GL,3); GAPB(o[1]=__builtin_amdgcn_mfma_f32_32x32x16_bf16(PAF(2),VFR(6),o[1],0,0,0), C1,4); \
    GAPB(o[0]=__builtin_amdgcn_mfma_f32_32x32x16_bf16(PAF(3),VFR(3),o[0],0,0,0), C1,8); \
    GAPB(o[1]=__builtin_amdgcn_mfma_f32_32x32x16_bf16(PAF(3),VFR(7),o[1],0,0,0), C1,12); \
    }while(0)
  int t=1;
  #undef CMASK
  #define CMASK(P0,P1,t) do{}while(0)
  for(;t+5<NT;t+=2){
    STEP(pB0,pB1,pA0,pA1,t,true,true,true);     WAIT_BAR(2); RESC(); ROT();
    STEP(pA0,pA1,pB0,pB1,t+1,true,true,true);   WAIT_BAR(2); RESC(); ROT();
  }
  #undef CMASK
  #define CMASK(P0,P1,t) do{int jb_=(t)-(NT-4); if(jb_>=0)cmask(P0,P1,jb_,qrel,hi);}while(0)
  #define ENDW(tt) do{ if((tt)+3<NT){WAIT_BAR(2);} else if((tt)+2<NT){WAIT_BAR(1);} else {WAIT_BAR(0);} }while(0)
  for(;t+1<NT;t+=2){
    STEP(pB0,pB1,pA0,pA1,t,(t+3<NT),(t+1<NT),(t+1<NT));       ENDW(t);   RESC(); ROT();
    STEP(pA0,pA1,pB0,pB1,t+1,(t+4<NT),(t+2<NT),(t+2<NT));     ENDW(t+1); RESC(); ROT();
  }
  STEP(pB0,pB1,pA0,pA1,NT-1,false,false,false); RESC();
  { float sacc=pB0[0]+pB0[1]; _Pragma("unroll") for(int r=2;r<16;++r)sacc+=pB0[r]; _Pragma("unroll") for(int r=0;r<16;++r)sacc+=pB1[r]; l_reg+=sacc;
    pw0=(u32x4){PKW(pB0,0),PKW(pB0,2),PKW(pB0,4),PKW(pB0,6)};pw1=(u32x4){PKW(pB0,8),PKW(pB0,10),PKW(pB0,12),PKW(pB0,14)};pw2=(u32x4){PKW(pB1,0),PKW(pB1,2),PKW(pB1,4),PKW(pB1,6)};pw3=(u32x4){PKW(pB1,8),PKW(pB1,10),PKW(pB1,12),PKW(pB1,14)};
    SBAR(); pv(o,vb0+sl_cur,PAF(0),PAF(1),PAF(2),PAF(3)); }
  #undef PKW
  #undef PAF
  #undef VFR
  #undef PIN
  #undef MX3
  #undef GAPA
  #undef GAPB
  #undef EX
  #undef VRD
  #undef KRD
  #undef STEP
  #undef ENDW
  {auto rr=__builtin_amdgcn_permlane32_swap(__float_as_uint(l_reg),__float_as_uint(l_reg),false,false);l_reg=__uint_as_float(rr[0])+__uint_as_float(rr[1]);}
  if(hi==0)wsf[32+r32]=l_reg;asm volatile("s_waitcnt lgkmcnt(0)":::"memory");
  float rli[16];
  #pragma unroll
  for(int r=0;r<16;++r)rli[r]=__builtin_amdgcn_rcpf(wsf[32+crow(r,hi)]);
  bf16*Ow=O+(rowbase+q0+wid*QBLK)*OP+h*D; const bf16*Gw=Z+(rowbase+q0+wid*QBLK)*DM+1536+h*D;
  { bf16*stg=(bf16*)(shm+LDS_OST)+wid*2048;
    #pragma unroll
    for(int r=0;r<16;++r){const int orow=crow(r,hi);
      #pragma unroll
      for(int d0=0;d0<2;++d0)stg[orow*64+d0*32+r32]=(bf16)f2bf(o[d0][r]*rli[r]);}
    asm volatile("s_waitcnt lgkmcnt(0)":::"memory");
    #pragma unroll
    for(int i=0;i<4;++i){const int row=i*8+(lane>>3),ch=lane&7; const u32x4 v=*(const u32x4*)(stg+row*64+ch*8), g=*(const u32x4*)(Gw+(long)row*DM+ch*8);
      const unsigned vw[4]={v.x,v.y,v.z,v.w},gw[4]={g.x,g.y,g.z,g.w}; unsigned ow[4];
      #pragma unroll
      for(int j=0;j<4;++j){ const float a0=bflo(vw[j])*__builtin_amdgcn_rcpf(1.0f+__expf(-bflo(gw[j]))), a1=bfhi(vw[j])*__builtin_amdgcn_rcpf(1.0f+__expf(-bfhi(gw[j]))); ow[j]=cvtpk_s(a0,a1); }
      ATTN_STORE16(Ow+(long)row*OP+ch*8,((u32x4){ow[0],ow[1],ow[2],ow[3]}));} }
  asm volatile("s_waitcnt lgkmcnt(0)\n\ts_barrier":::"memory");
  #undef DMA_K
  #undef DMA_V
  #undef CMASK
  #undef START
  #undef RESC
  #undef ROT
}
constexpr int ATTN_LDS_BYTES=LDS_BYTES;
#undef SBAR
#undef WAIT_BAR
}
constexpr int CW_QATT = 128, CW_QCVT = 384;
constexpr int MISC_TAB = 64, MISC_Q = 4096, MISC_PFX = 4160;

__device__ __forceinline__ int attn_t0(KPR P, const float* c2, int q0, int lane) {
    float gq = fabsf(P.q_norm[lane]), gk = fabsf(P.k_norm[lane]);
#pragma unroll
    for (int o = 1; o < 64; o <<= 1) { gq = fmaxf(gq, __shfl_xor(gq, o)); gk = fmaxf(gk, __shfl_xor(gk, o)); }
    const float thr = c2[q0] + (2.0f * 8.0f * LOG2E * gq * gk + 40.0f);
    const int nfull = q0 / 64; int t0 = 0;
    for (int tb = 0; tb < nfull; tb += 64) { const int tt = tb + lane; const bool sk = (tt < nfull) && (c2[tt * 64 + 63] > thr); const unsigned long long bm = __ballot(sk); t0 += __popcll(bm); if (bm != ~0ull) break; }
    return __builtin_amdgcn_readfirstlane(t0) & ~1;
}
template <int NR>
__device__ __forceinline__ void combine_rows(KPR P, const LAS int* tab, const int (&rows)[NR], int lane) {
    const int* route = (const int*)(P.ws + WS_ROUTE); const unsigned char* YP = P.ws + WS_YP; bf16_t* X = (bf16_t*)(P.ws + WS_X1);
    u32x2 xv[NR][4]; unsigned yv[NR][4][4];
#pragma unroll
    for (int r = 0; r < NR; ++r) { const u32x2* xr = (const u32x2*)(X + (size_t)rows[r] * DM) + lane;
#pragma unroll
        for (int j = 0; j < 4; ++j) xv[r][j] = xr[64 * j]; }
#pragma unroll
    for (int r = 0; r < NR; ++r)
#pragma unroll
        for (int k = 0; k < 4; ++k) { const int ex = route[(size_t)rows[r] * 12 + k], rank = route[(size_t)rows[r] * 12 + 4 + k]; const size_t pos = (size_t)tab[pg8::T_BLKSTART + ex] * 256 + rank;
            const unsigned* yr = (const unsigned*)(YP + pos * DM) + lane;
#pragma unroll
            for (int j = 0; j < 4; ++j) yv[r][k][j] = yr[64 * j]; }
#pragma unroll
    for (int r = 0; r < NR; ++r) { f32x4 v[4];
#pragma unroll
        for (int j = 0; j < 4; ++j) v[j] = (f32x4){bflo(xv[r][j].x), bfhi(xv[r][j].x), bflo(xv[r][j].y), bfhi(xv[r][j].y)};
#pragma unroll
        for (int k = 0; k < 4; ++k)
#pragma unroll
            for (int j = 0; j < 4; ++j) { const unsigned y = yv[r][k][j]; const f32x2 lo = __builtin_amdgcn_cvt_pk_f32_fp8((int)y, false), hi = __builtin_amdgcn_cvt_pk_f32_fp8((int)y, true);
                v[j][0] += lo[0] * 0.25f; v[j][1] += lo[1] * 0.25f; v[j][2] += hi[0] * 0.25f; v[j][3] += hi[1] * 0.25f; }
        u32x2* xo = (u32x2*)(X + (size_t)rows[r] * DM) + lane; float s = 0.f;
#pragma unroll
        for (int j = 0; j < 4; ++j) { u32x2 w; w.x = pk2(v[j][0], v[j][1]); w.y = pk2(v[j][2], v[j][3]); xo[64 * j] = w; v[j] = (f32x4){bflo(w.x), bfhi(w.x), bflo(w.y), bfhi(w.y)}; s += (v[j][0] * v[j][0] + v[j][1] * v[j][1]) + (v[j][2] * v[j][2] + v[j][3] * v[j][3]); }
        const float rstd = rsqrtf(wave_sum(s) * (1.f / DM) + 1e-6f);
#pragma unroll
        for (int j = 0; j < 4; ++j) v[j] = v[j] * rstd * ((const f32x4*)P.ple_norm)[64 * j + lane];
        store_row_fp8(P.ws + WS_XN + (size_t)rows[r] * DM, lane, v); }
}

constexpr int NPHASE = 13;
__global__ void __launch_bounds__(NTHREADS, 2) mega_fwd(Params Pkarg_unused) {
    extern __shared__ __attribute__((aligned(16))) unsigned char smem[];
    LAS unsigned char* lds = (LAS unsigned char*)smem;
    const int tid = threadIdx.x, lane = tid & 63, wave = __builtin_amdgcn_readfirstlane(tid >> 6);
    const int G = gridDim.x, blk = blockIdx.x;
#define P (*kpp)
#ifndef MK_REP
#define MK_REP -1
#endif
#define PHASE_BEGIN(k) if (IN(k)) for (int rep_ = 0; rep_ < ((k) == MK_REP ? 2 : 1); ++rep_) { const __attribute__((address_space(4))) Params* kpp = kp_fresh();
#define PHASE_END(k) } if (BOTH(k)) { XcdBarrier bar_; bar_.bar = (unsigned*)((*kp_fresh()).ws + WS_CTL) + CW_BAR; bar_.x = xb_xcc_id(); bar_.st = (volatile LAS unsigned*)(lds + MISC_OFF); xcd_barrier(bar_); }
#define IN(k) (ph_lo <= (k) && (k) < ph_hi)
#define BOTH(k) (IN(k) && IN((k) + 1))
    const __attribute__((address_space(4))) Params* kpp = kp_fresh();
    if (tid < 16) ((volatile LAS unsigned*)(lds + MISC_OFF))[tid] = 0u;
    __syncthreads();
    (void)xcd_barrier_post((unsigned*)(P.ws + WS_CTL) + CW_BAR, (volatile LAS unsigned*)(lds + MISC_OFF));
    const int ph_lo = P.ph_lo, ph_hi = P.ph_hi;
#define wsb (P.ws)
#define ctl ((unsigned*)(P.ws + WS_CTL))
#define MISC ((volatile LAS unsigned*)(lds + MISC_OFF))
#define tab ((LAS int*)(lds + MISC_OFF + MISC_TAB))

    PHASE_BEGIN(0)
        phase_prep_weights(P, lds, blk * NWAVES + wave, G * NWAVES, wave, lane);
        phase_cvt_p(P, blk * NTHREADS + tid, G * NTHREADS);
        __syncthreads();
        LAS float* wff = (LAS float*)lds; LAS float* lf = (LAS float*)(lds + 32768);
        load_wff(P, wff, tid, NTHREADS); __syncthreads();
        for (int i = 0; i < 16; ++i) { const int rl = wave * 16 + i; norm1_row(P, blk * 128 + rl, lane, wff, lf + rl * 8); }
        __syncthreads();
        if (tid < 64) { const int h = tid & 7, seg = tid >> 3; float c16[16]; float run = 0.f;
#pragma unroll
            for (int r = 0; r < 16; ++r) { run += lf[(seg * 16 + r) * 8 + h]; c16[r] = run; }
            float incl = run;
#pragma unroll
            for (int o = 8; o < 64; o <<= 1) { const float t = __shfl_up(incl, o); if (tid >= o) incl += t; }
            const float pre = incl - run; float* cloc = (float*)(P.ws + WS_LOGF) + ((size_t)blk * 128 + seg * 16) * 8 + h;
#pragma unroll
            for (int r = 0; r < 16; ++r) cloc[r * 8] = pre + c16[r];
            if (seg == 7) ((float*)(P.ws + WS_CTOT))[blk * 8 + h] = incl; }
        if (blk >= G - 16) rt::build_w(P, blk - (G - 16), tid);
    PHASE_END(0)

    PHASE_BEGIN(1)
        {
            LAS float* pfx = (LAS float*)(lds + MISC_OFF + MISC_PFX);
            if (tid < 64) { const float* ct = (const float*)(wsb + WS_CTOT); const int j = (blk & ~63) + tid; float v8[8];
#pragma unroll
                for (int h = 0; h < 8; ++h) v8[h] = (j < blk) ? ct[j * 8 + h] : 0.f;
#pragma unroll
                for (int h = 0; h < 8; ++h) { const float s = wave_sum(v8[h]); if (tid == 0) pfx[h] = s; } }
            __syncthreads();
            const float* cloc = (const float*)(wsb + WS_LOGF) + (size_t)blk * 128 * 8; float* c2 = (float*)(P.ws + WS_C2);
            for (int i = tid; i < 1024; i += NTHREADS) { const int r = i >> 3, h = i & 7; const int row = blk * 128 + r, b = row >> 13, t = row & (SEQ - 1);
                c2[((size_t)(b * 8 + h)) * SEQ + t] = (cloc[i] + pfx[h]) * LOG2E; }
            __syncthreads();
        }
        {
            pg8::DenseOrder S{(const bf16_t*)(wsb + WS_XN), (const bf16_t*)(wsb + WS_WIN), 1024, NTOK / 256, ZW / 256, G, blk};
            pg8::EpiIn E{(bf16_t*)(P.ws + WS_Z), P.q_norm, P.k_norm};
            pg8::gemm_phase<pg8::EpiIn, pg8::DenseOrder, true>(lds, 1024, S, E);
        }
        {
            pg8::DenseOrder S{(const bf16_t*)((unsigned char*)P.out + DO_PB), (const bf16_t*)(wsb + WS_WPP), PLE, NTOK / 256, DM / 256, G / 2, blk >= G / 2 ? blk - G / 2 : (1 << 20)};
            pg8::EpiBf16 E{(bf16_t*)((unsigned char*)P.out + DO_PJ), DM};
            pg8::gemm_phase<pg8::EpiBf16, pg8::DenseOrder, true>(lds, PLE, S, E);
        }
    PHASE_END(1)

    PHASE_BEGIN(2)
        rk::lora_block(P, lds, blk, G, tid);
        __syncthreads();
        { LAS float* cscr = (LAS float*)(lds + ((wave & 3) == 0 ? 125184 : MISC_OFF + 64 + ((wave & 3) - 1) * 4608));
          for (int i = 0; i < 16; ++i) rk::pass1_chunk(P, lds, (blk >> 6) * 8 + (i & 7), 2 * (blk & 63) + (i >> 3), tid, (blk * 16 + i) * 8, cscr); }
    PHASE_END(2)

    PHASE_BEGIN(4)
        if (blk < NB * NH) rk::pass2_seq(P, lds, blk, tid);
#define CVT_LOOP() for (;;) { __syncthreads(); if (tid == 0) MISC[MISC_Q / 4] = __hip_atomic_fetch_add(ctl + CW_QCVT + 64 * rep_, 1u, RLX_AGENT); __syncthreads(); \
            const int q = (int)MISC[MISC_Q / 4]; if (q >= NCVT) break; cvt_task(P, lds, CVT_TASK0 + q, wave, lane); }
        if (((blk >> 3) & 3) == 1) { CVT_LOOP() }
        for (;;) {
            __syncthreads();
            if (tid == 0) MISC[MISC_Q / 4] = __hip_atomic_fetch_add(ctl + CW_QATT + 64 * rep_, 1u, RLX_AGENT);
            __syncthreads();
            const int q = (int)MISC[MISC_Q / 4];
            if (q >= 1024) break;
            { const int bh = q & 31, qb = 31 - (q >> 5); const float* c2 = (const float*)(wsb + WS_C2) + (size_t)bh * SEQ;
              const int t0 = attn_t0(P, c2, qb * 256, lane);
              attn_body::attn_unit<8>(bh >> 3, bh & 7, qb, t0, (const bf16_t*)(wsb + WS_Z), c2, (bf16_t*)(P.ws + WS_AO), (char*)smem); }
        }
        if (((blk >> 3) & 3) != 1) { CVT_LOOP() }
#undef CVT_LOOP
    PHASE_END(4)

    PHASE_BEGIN(5)
        for (int task = blk; task < NB * NH * rk::NCHUNK; task += G) rk::pass3_chunk(P, lds, task >> 7, task & 127, tid);
    PHASE_END(5)

    PHASE_BEGIN(6)
        pg8::DenseOrder S{(const bf16_t*)(wsb + WS_AO), (const bf16_t*)(wsb + WS_WOUT), 1024, NTOK / 256, DM / 256, G, blk};
        pg8::EpiOut E{P.x, (bf16_t*)(P.ws + WS_X1)};
        pg8::gemm_phase<pg8::EpiOut, pg8::DenseOrder, true>(lds, 1024, S, E);
    PHASE_END(6)

    PHASE_BEGIN(7)
        rt::copy_w(P, lds, tid);
        if (blk == 0 && tid < 256) ((unsigned*)(P.ws + WS_XN + (size_t)NTOK * DM))[tid] = 0u;
        __syncthreads();
        if (wave < 4) { for (int task = wave * G + blk; task < NTOK / 32; task += 4 * G) rt::route_task(P, lds, task, lane); }
        else { for (int task = (wave - 4) * G + blk; task < NTOK / 32; task += 4 * G) rt::xn8_task(P, task, lane); }
    PHASE_END(7)

    PHASE_BEGIN(8)
        const int nblk = pg8::moe_tables(tab, (const unsigned*)(wsb + WS_CTL) + CW_CNT);
        pg8::MoeOrder S{wsb + WS_XN, wsb + WS_WGU, (const int*)(wsb + WS_TOKSLOT), (const float*)(wsb + WS_GATESLOT), tab, nblk, 8, G, blk, true};
        pg8::EpiGu E{P.ws + WS_ACT, P.b_gu};
        pg8::gemm_phase<pg8::EpiGu, pg8::MoeOrder, true, true>(lds, 1024, S, E);
    PHASE_END(8)
    PHASE_BEGIN(9)
        const int nblk = pg8::moe_tables(tab, (const unsigned*)(wsb + WS_CTL) + CW_CNT);
        pg8::MoeOrder S{wsb + WS_ACT, wsb + WS_WDN, (const int*)(wsb + WS_TOKSLOT), (const float*)(wsb + WS_GATESLOT), tab, nblk, 4, G, blk, false};
        pg8::EpiDn E{P.ws + WS_YP, P.b_down, (const float*)(wsb + WS_GATESLOT), tab};
        pg8::gemm_phase<pg8::EpiDn, pg8::MoeOrder, true, true>(lds, 1024, S, E);
    PHASE_END(9)
    PHASE_BEGIN(10)
        (void)pg8::moe_tables(tab, (const unsigned*)(wsb + WS_CTL) + CW_CNT);
        for (int row = blk * NWAVES + wave; row < NTOK; row += 2 * G * NWAVES) { const int rows[2] = {row, row + G * NWAVES}; combine_rows<2>(P, tab, rows, lane); }
    PHASE_END(10)
    PHASE_BEGIN(11)
        pg8::DenseOrder S{wsb + WS_XN, wsb + WS_WPG, 512, NTOK / 256, DM / 256, G, blk};
        pg8::EpiPg E{(bf16_t*)(P.ws + WS_X1), (const bf16_t*)((unsigned char*)P.out + DO_PJ)};
        pg8::gemm_phase<pg8::EpiPg, pg8::DenseOrder, true, true>(lds, 1024, S, E);
    PHASE_END(11)
    PHASE_BEGIN(12)
        const bool dead = __hip_atomic_load(ctl + CW_BAR + XB_TMO, RLX_AGENT) != 0u;
        for (int row = blk * NWAVES + wave; row < NTOK; row += G * NWAVES) final_row(P, row, lane, dead);
    PHASE_END(12)
}
#undef P
#undef wsb
#undef ctl
#undef MISC
#undef tab
extern "C" void kernel_launch(void* const* d_in, const int* in_sizes, int n_in, void* d_out, int out_size, void* d_ws, size_t ws_size, hipStream_t stream) {
    static int ok = 0;
    if (ok == 0) {
        if (n_in != 30 || in_sizes[0] != NTOK * DM || out_size != NTOK * DM || ws_size < WS_END) { fprintf(stderr, "kernel_launch: unexpected shapes (n_in %d, ws %zu)\n", n_in, ws_size); ok = -1; return; }
        if (hipFuncSetAttribute((const void*)mega_fwd, hipFuncAttributeMaxDynamicSharedMemorySize, LDS_BYTES) != hipSuccess) { fprintf(stderr, "kernel_launch: hipFuncSetAttribute failed\n"); ok = -1; return; }
        int dev = 0, cus = 0, per_cu = 0;
        if (hipGetDevice(&dev) != hipSuccess || hipDeviceGetAttribute(&cus, hipDeviceAttributeMultiprocessorCount, dev) != hipSuccess) { ok = -1; return; }
        if (hipOccupancyMaxActiveBlocksPerMultiprocessor(&per_cu, (const void*)mega_fwd, NTHREADS, LDS_BYTES) != hipSuccess || per_cu < 1) { fprintf(stderr, "kernel_launch: occupancy query says %d\n", per_cu); }
        (void)hipGetLastError();
        if (cus != 256) { fprintf(stderr, "kernel_launch: built for 256 CUs, device has %d\n", cus); ok = -1; return; }
        ok = 1;
    }
    if (ok < 0) return;
    Params P{};
    const float** pp = (const float**)&P;
    for (int i = 0; i < 30; ++i) pp[i] = (const float*)d_in[i];
    P.out = (float*)d_out; P.ws = (unsigned char*)d_ws;
    if (hipMemsetAsync((char*)d_ws + WS_CTL, 0, CTL_BYTES, stream) != hipSuccess) return;
#ifndef MK_CUTS
#define MK_CUTS 0
#endif
    if (MK_CUTS == 0) { P.ph_lo = 0; P.ph_hi = NPHASE; hipLaunchKernelGGL(mega_fwd, dim3(256), dim3(NTHREADS), LDS_BYTES, stream, P); }
    else for (int k = 0; k < NPHASE; ++k) { P.ph_lo = k; P.ph_hi = k + 1;
        hipLaunchKernelGGL(mega_fwd, dim3(256), dim3(NTHREADS), LDS_BYTES, stream, P); }
}
```

```cpp
#include <hip/hip_runtime.h>
#include <cstdio>
#include <cstdint>

#define LAS __attribute__((address_space(3)))
#define GAS __attribute__((address_space(1)))
typedef unsigned short bf16_t;
typedef short bf16x8 __attribute__((ext_vector_type(8)));
typedef float f32x2 __attribute__((ext_vector_type(2)));
typedef float f32x4 __attribute__((ext_vector_type(4)));
typedef float f32x16 __attribute__((ext_vector_type(16)));
typedef unsigned u32x2 __attribute__((ext_vector_type(2)));
typedef unsigned u32x4 __attribute__((ext_vector_type(4)));

constexpr int NB = 4, SEQ = 8192, NTOK = NB * SEQ, DM = 1024;
constexpr int NH = 8, HD = 64;
constexpr int INW = 3848;
constexpr int ZW = 3840;
constexpr int ZQ = 0, ZK = 512, ZV = 1024, ZOG = 1536, ZR = 2048;
constexpr int RW_R = 0, RW_K = 512, RW_V = 1024, RW_W = 1536, RW_A = 1600, RW_G = 1664, RWIN = 1792;
constexpr int NE = 32, TOPK = 4, EFF = 1024;
constexpr int MAXBLK = (NTOK * TOPK) / 256 + NE;
constexpr int PLE = 256;
constexpr float LOG2E = 1.4426950408889634f;
constexpr float QSCALE = 0.125f * LOG2E;

constexpr size_t MiB = 1u << 20;
constexpr size_t WS_CTL = 0, CTL_BYTES = 1 * MiB;
constexpr size_t WS_C2 = 1 * MiB;
constexpr size_t WS_LOGF = 2 * MiB;
constexpr size_t WS_ROUTE = 3 * MiB;
constexpr size_t WS_TOKSLOT = 5 * MiB;
constexpr size_t WS_GATESLOT = 9 * MiB;
constexpr size_t WS_CTOT = 13 * MiB;
constexpr size_t WS_WIN = 16 * MiB;
constexpr size_t WS_WOUT = 24 * MiB;
constexpr size_t WS_WPG = 26 * MiB;
constexpr size_t WS_WPP = 28 * MiB;
constexpr size_t WS_WGU = 32 * MiB;
constexpr size_t WS_WDN = 160 * MiB;
constexpr size_t WS_XN = 224 * MiB;
constexpr size_t WS_X1 = 290 * MiB;
constexpr size_t WS_Z = 418 * MiB;
constexpr size_t WS_AO = 658 * MiB;
constexpr size_t WS_ACT = 418 * MiB;
constexpr size_t WS_RW = 722 * MiB;
constexpr size_t WS_RR = WS_RW, WS_RK = WS_RW + 32 * MiB, WS_RV = WS_RW + 64 * MiB, WS_RG = WS_RW + 96 * MiB;
constexpr size_t WS_RLW = WS_RW + 128 * MiB;
constexpr size_t WS_RKK = WS_RW + 160 * MiB, WS_RKA = WS_RW + 192 * MiB;
constexpr size_t WS_YP = 722 * MiB;
constexpr size_t WS_END = 994 * MiB;
static_assert(WS_ACT + (size_t)MAXBLK * 256 * 1024 * 2 <= WS_RW && WS_YP + (size_t)MAXBLK * 256 * 1024 * 2 <= WS_END, "ws map");
constexpr size_t DO_PJ = 0, DO_PB = 64 * MiB;
constexpr int CW_TMO = 0, CW_CNT = 64  , CW_BAR = 4096;

struct Params {
    const float *x, *p, *mix_norm, *w_in, *f_bias, *q_norm, *k_norm, *mu, *w0, *w2, *a0, *a2, *g2, *k_k, *k_a, *r_k, *ln_w, *ln_b, *w_out, *moe_norm, *w_router, *b_router, *w_gu, *b_gu, *w_down,
        *b_down, *ple_norm, *w_pg, *w_pp, *final_norm;
    float* out; unsigned char* ws; int ph_lo, ph_hi;
};

typedef const __attribute__((address_space(4))) Params& KPR;
__device__ __forceinline__ const __attribute__((address_space(4))) Params* kp_fresh() {
    unsigned long long p = (unsigned long long)__builtin_amdgcn_kernarg_segment_ptr(); asm volatile("" : "+s"(p)); return (const __attribute__((address_space(4))) Params*)p; }

typedef __bf16 bf16x2_hw __attribute__((ext_vector_type(2)));
__device__ __forceinline__ unsigned pk2(float lo, float hi) { const f32x2 v = {lo, hi}; return __builtin_bit_cast(unsigned, __builtin_convertvector(v, bf16x2_hw)); }
__device__ __forceinline__ unsigned f2bf(float f) { return pk2(f, f) & 0xffffu; }
__device__ __forceinline__ float bf2f(unsigned h) { return __builtin_bit_cast(float, h << 16); }
__device__ __forceinline__ float bflo(unsigned w) { return __builtin_bit_cast(float, w << 16); }
__device__ __forceinline__ float bfhi(unsigned w) { return __builtin_bit_cast(float, w & 0xffff0000u); }
__device__ __forceinline__ unsigned cvt_pk_bf16(float lo, float hi) { unsigned r; asm volatile("v_cvt_pk_bf16_f32 %0, %1, %2" : "=v"(r) : "v"(lo), "v"(hi)); return r; }
__device__ __forceinline__ unsigned pk4_fp8(float a, float b, float c, float d) { int w = 0; w = __builtin_amdgcn_cvt_pk_fp8_f32(a, b, w, false); w = __builtin_amdgcn_cvt_pk_fp8_f32(c, d, w, true); return (unsigned)w; }
#define DPP_ADD(v, ctrl) ((v) + __builtin_bit_cast(float, __builtin_amdgcn_mov_dpp(__builtin_bit_cast(int, (v)), (ctrl), 0xF, 0xF, true)))
__device__ __forceinline__ float wave_sum(float v) {
    v = DPP_ADD(v, 0xB1);
    v = DPP_ADD(v, 0x4E);
    v = DPP_ADD(v, 0x124);
    v = DPP_ADD(v, 0x128);
    { float a = v, b = v; asm volatile("s_nop 1\n\tv_permlane16_swap_b32 %0, %1" : "+v"(a), "+v"(b)); v = a + b; }
    { float a = v, b = v; asm volatile("s_nop 1\n\tv_permlane32_swap_b32 %0, %1" : "+v"(a), "+v"(b)); v = a + b; }
    return v;
}
__device__ __forceinline__ float sigmoidf_(float x) { return __builtin_amdgcn_rcpf(1.0f + __expf(-x)); }
__device__ __forceinline__ float logsigmoidf_(float x) { return fminf(x, 0.f) - log1pf(expf(-fabsf(x))); }
namespace pg8 {
constexpr int BM = 256, BK = 64, HALF = 128, HTB = HALF * BK * 2, STAGE_BYTES = 8 * HTB, NXCD = 8, WGM = 8;
__host__ __device__ __forceinline__ int lds_byte(int r, int c) { const int st = (r >> 4) * 2 + (c >> 5), rr = r & 15, cc = c & 31, ob = rr * 64 + cc * 2; return st * 1024 + (ob ^ (((ob >> 9) & 1) << 5)); }
__host__ __device__ __forceinline__ void stage_rc(int b, int& R, int& C) { const int st = b / 1024, sb = b % 1024, swz = sb ^ (((sb >> 9) & 1) << 5); R = (st >> 1) * 16 + swz / 64; C = (st & 1) * 32 + (swz % 64) / 2; }
__host__ __device__ __forceinline__ int perm32(int rho) { const int n = rho >> 4, i = rho & 15; return 8 * (i >> 2) + 4 * n + (i & 3); }

struct Unit { int pm, pn, e, lb, sl; };

__device__ __forceinline__ bool tile_order(int i, int G, int c, int nM, int nN, int& pm, int& pn) {
    const int nwg = nM * nN; const long L = (long)i * G + c; if (L >= nwg) return false;
    int wgid = (int)L; { const int q = nwg / NXCD, r = nwg % NXCD, xcd = wgid % NXCD, off = wgid / NXCD; wgid = (xcd < r ? xcd * (q + 1) : r * (q + 1) + (xcd - r) * q) + off; }
    const int nig = WGM * nN, gid = wgid / nig, fm = gid * WGM, gsz = (nM - fm) < WGM ? (nM - fm) : WGM;
    pm = fm + ((wgid % nig) % gsz); pn = (wgid % nig) / gsz; return true;
}
struct DenseOrder {
    const void* A; const void* Bt; int K  , nM, nN, G, c;
    __device__ __forceinline__ bool next(int i, Unit& u) const { u.e = 0; u.lb = 0; return tile_order(i, G, c, nM, nN, u.pm, u.pn); }
    __device__ __forceinline__ const char* a_base(const Unit& u) const { return (const char*)A + (size_t)u.pm * BM * K * 2; }
    __device__ __forceinline__ const char* b_base(const Unit& u) const { return (const char*)Bt + (size_t)u.pn * BM * K * 2; }
    __device__ __forceinline__ void prefetch(const Unit&, int, int, int) const {}
    __device__ __forceinline__ void a_off(const Unit&, const int (&R)[2], const int (&C)[2], unsigned (&off)[2][2]) const {
#pragma unroll
        for (int h = 0; h < 2; ++h)
#pragma unroll
            for (int i = 0; i < 2; ++i) off[h][i] = (unsigned)((R[i] + HALF * h) * K + C[i]) * 2u;
    }
};

typedef int v8i32 __attribute__((ext_vector_type(8)));
typedef int i32x4 __attribute__((ext_vector_type(4)));
template <class Epi, class Sched, bool ALIGN_EPI, bool FP8 = false>
__device__ __forceinline__ void gemm_phase(LAS unsigned char* lds, const int K, const Sched& S, const Epi& E) {
    int tid_ = threadIdx.x; asm volatile("" : "+v"(tid_));
    const int tid = tid_, wid = __builtin_amdgcn_readfirstlane(tid >> 6), lane = tid & 63, wr = wid >> 2, wc = wid & 3, fr = lane & 15, fq = lane >> 4;
    const int RB = FP8 ? K : 2 * K;
    const int nt = RB / (BK * 2);
    int sR[2], sC[2]; unsigned voffB[2];
#pragma unroll
    for (int i = 0; i < 2; ++i) { int R, C; stage_rc(tid * 16 + i * 8192, R, C); const int Rb = Epi::PERM ? ((R & ~31) + perm32(R & 31)) : R; sR[i] = R; sC[i] = C; voffB[i] = (unsigned)(Rb * RB + C * 2); }
    const size_t kstep = (size_t)(BK * 2);
    const size_t hstep = (size_t)HALF * RB;
    const unsigned ldsw = (unsigned)wid * 1024u;
    const int aoff0 = lds_byte(wr * 64 + fr, fq * 8), aoff1 = aoff0 + 1024;
    const int boff0 = lds_byte(wc * 32 + fr, fq * 8), boff1 = boff0 + 1024;
#define PG8_SA(b, h) (((b) * 2 + (h)) * HTB)
#define PG8_SB(b, h) ((4 + (b) * 2 + (h)) * HTB)
#define PG8_STAGE(bufoff, gbase, voff) do { _Pragma("unroll") for (int _i = 0; _i < 2; ++_i) \
        __builtin_amdgcn_global_load_lds((const unsigned*)((const char*)(gbase) + (voff)[_i]), (LAS unsigned*)(lds + (bufoff) + ldsw + _i * 8192), 16, 0, 0); } while (0)
#define PG8_CAT(p0, p1) __builtin_shufflevector((p0), (p1), 0, 1, 2, 3, 4, 5, 6, 7)
#define PG8_LDA(dst, b, h) do { _Pragma("unroll") for (int m = 0; m < 4; ++m) dst[m] = PG8_CAT(*(const LAS i32x4*)(lds + PG8_SA(b, h) + aoff0 + m * 2048), *(const LAS i32x4*)(lds + PG8_SA(b, h) + aoff1 + m * 2048)); } while (0)
#define PG8_LDB(dst, b, h) do { _Pragma("unroll") for (int n = 0; n < 2; ++n) dst[n] = PG8_CAT(*(const LAS i32x4*)(lds + PG8_SB(b, h) + boff0 + n * 2048), *(const LAS i32x4*)(lds + PG8_SB(b, h) + boff1 + n * 2048)); } while (0)
#define PG8_LO(x) __builtin_bit_cast(bf16x8, __builtin_shufflevector((x), (x), 0, 1, 2, 3))
#define PG8_HI(x) __builtin_bit_cast(bf16x8, __builtin_shufflevector((x), (x), 4, 5, 6, 7))
#define PG8_MMA(ai, bj, At, Bt) do { __builtin_amdgcn_s_setprio(1); \
        if constexpr (FP8) { _Pragma("unroll") for (int m = 0; m < 4; ++m) _Pragma("unroll") for (int n = 0; n < 2; ++n) \
            asm volatile("v_mfma_scale_f32_16x16x128_f8f6f4 %0, %1, %2, %0, %3, %4 op_sel_hi:[0,0,0]" : "+v"(acc[ai][bj][m][n]) : "v"(Bt[n]), "v"(At[m]), "v"(sc_w), "v"(sc_x)); } \
        else { _Pragma("unroll") for (int m = 0; m < 4; ++m) _Pragma("unroll") for (int n = 0; n < 2; ++n) { \
            acc[ai][bj][m][n] = __builtin_amdgcn_mfma_f32_16x16x32_bf16(PG8_LO(Bt[n]), PG8_LO(At[m]), acc[ai][bj][m][n], 0, 0, 0); } \
            _Pragma("unroll") for (int m = 0; m < 4; ++m) _Pragma("unroll") for (int n = 0; n < 2; ++n) { \
            acc[ai][bj][m][n] = __builtin_amdgcn_mfma_f32_16x16x32_bf16(PG8_HI(Bt[n]), PG8_HI(At[m]), acc[ai][bj][m][n], 0, 0, 0); } } \
        __builtin_amdgcn_s_setprio(0); } while (0)
#define PG8_WAIT_V(n) asm volatile("s_waitcnt vmcnt(" #n ")" ::: "memory")
#define PG8_WAIT_L(n) asm volatile("s_waitcnt lgkmcnt(" #n ")" ::: "memory")
#define PG8_BAR __builtin_amdgcn_s_barrier()
#define PG8_SCHED __builtin_amdgcn_sched_barrier(0)
    Unit cur, nxt; int ui = 0;
    if (!S.next(0, cur)) return;
    f32x4 acc[2][2][4][2];
    const int sc_w = 121, sc_x = 127;
    v8i32 At[4], B0[2], B1[2];
    unsigned offC[2][2], offN[2][2];
    cur.sl = 0; S.prefetch(cur, 0, wid, lane); PG8_WAIT_V(0); PG8_BAR;
    E.acc_init(acc, cur, wc, fq);
    S.a_off(cur, sR, sC, offC);
    const char* cA = S.a_base(cur); const char* cB = S.b_base(cur);
    PG8_STAGE(PG8_SB(0, 0), cB, voffB); PG8_STAGE(PG8_SB(0, 1), cB + hstep, voffB); PG8_STAGE(PG8_SA(0, 0), cA, offC[0]); PG8_STAGE(PG8_SA(0, 1), cA, offC[1]);
    if (wr == 1) PG8_BAR;
    PG8_WAIT_V(2); PG8_BAR;
    PG8_STAGE(PG8_SB(1, 0), cB + kstep, voffB); PG8_STAGE(PG8_SA(1, 0), cA + kstep, offC[0]); PG8_STAGE(PG8_SB(1, 1), cB + hstep + kstep, voffB);
    PG8_WAIT_V(6); PG8_BAR;
    for (;;) {
        const bool has_next = S.next(ui + 1, nxt);
        const char* nA = cA; const char* nB = cB;
        nxt.sl = cur.sl == 2 ? 0 : cur.sl + 1;
        if (has_next) { nA = S.a_base(nxt); nB = S.b_base(nxt); S.prefetch(nxt, nxt.sl, wid, lane); }
#pragma unroll
        for (int h = 0; h < 2; ++h)
#pragma unroll
            for (int i = 0; i < 2; ++i) offN[h][i] = offC[h][i];
#pragma nounroll
        for (int t = 0; t < nt; t += 2) {
            const bool last = (t == nt - 2);
            if (last && has_next) S.a_off(nxt, sR, sC, offN);
            const char* a1 = cA + (size_t)(t + 1) * kstep;
            const char* a2 = last ? nA : cA + (size_t)(t + 2) * kstep; const char* b2 = last ? nB : cB + (size_t)(t + 2) * kstep;
            const char* a3 = a2 + kstep; const char* b3 = b2 + kstep;
            unsigned o2[2][2];
#pragma unroll
            for (int h = 0; h < 2; ++h)
#pragma unroll
                for (int i = 0; i < 2; ++i) o2[h][i] = last ? offN[h][i] : offC[h][i];
            PG8_LDB(B0, 0, 0); PG8_LDB(B1, 0, 1); PG8_SCHED; PG8_LDA(At, 0, 0); PG8_STAGE(PG8_SA(1, 1), a1, offC[1]);
            PG8_WAIT_V(8); PG8_WAIT_L(0); PG8_BAR; PG8_MMA(0, 0, At, B0); PG8_MMA(0, 1, At, B1); PG8_BAR; PG8_SCHED;
            PG8_LDA(At, 0, 1); PG8_STAGE(PG8_SB(0, 0), b2, voffB); PG8_STAGE(PG8_SB(0, 1), b2 + hstep, voffB); PG8_STAGE(PG8_SA(0, 0), a2, o2[0]);
            PG8_WAIT_V(8); PG8_WAIT_L(0); PG8_BAR; PG8_MMA(1, 0, At, B0); PG8_MMA(1, 1, At, B1); PG8_BAR; PG8_SCHED;
            PG8_LDB(B0, 1, 0); PG8_LDB(B1, 1, 1); PG8_SCHED; PG8_LDA(At, 1, 0); PG8_STAGE(PG8_SA(0, 1), a2, o2[1]);
            PG8_WAIT_V(8); PG8_WAIT_L(0); PG8_BAR; PG8_MMA(0, 0, At, B0); PG8_MMA(0, 1, At, B1); PG8_BAR; PG8_SCHED;
            PG8_LDA(At, 1, 1); PG8_STAGE(PG8_SB(1, 0), b3, voffB); PG8_STAGE(PG8_SB(1, 1), b3 + hstep, voffB); PG8_STAGE(PG8_SA(1, 0), a3, o2[0]);
            PG8_WAIT_V(8); PG8_WAIT_L(0); PG8_BAR; PG8_MMA(1, 0, At, B0); PG8_MMA(1, 1, At, B1); PG8_BAR; PG8_SCHED;
        }
        if constexpr (ALIGN_EPI) { if (wr == 0) PG8_BAR; }
        E(acc, cur, wr, wc, fr, fq);
        if (!has_next) break;
        E.acc_init(acc, nxt, wc, fq);
        cur = nxt; cA = nA; cB = nB; ++ui;
#pragma unroll
        for (int h = 0; h < 2; ++h)
#pragma unroll
            for (int i = 0; i < 2; ++i) offC[h][i] = offN[h][i];
        if constexpr (ALIGN_EPI) { if (wr == 1) PG8_BAR; }
    }
    PG8_WAIT_V(0);
    if constexpr (!ALIGN_EPI) { if (wr == 0) PG8_BAR; }
    PG8_BAR;
#undef PG8_SA
#undef PG8_SB
#undef PG8_STAGE
#undef PG8_LDA
#undef PG8_LDB
#undef PG8_MMA
#undef PG8_LO
#undef PG8_HI
#undef PG8_CAT
#undef PG8_WAIT_V
#undef PG8_WAIT_L
#undef PG8_BAR
#undef PG8_SCHED
}
}
namespace pg8 {
constexpr int T_BLKSTART = 0  , T_CNT = 40  , T_BLKE = 80  , T_WORDS = 80 + 560;
constexpr int TB_OFF = 8192 - 64;

#define PG8_ZERO_ACC(acc) _Pragma("unroll") for (int a_ = 0; a_ < 2; ++a_) _Pragma("unroll") for (int b_ = 0; b_ < 2; ++b_) _Pragma("unroll") for (int m_ = 0; m_ < 4; ++m_) _Pragma("unroll") for (int n_ = 0; n_ < 2; ++n_) acc[a_][b_][m_][n_] = (f32x4){0.f, 0.f, 0.f, 0.f}
constexpr int TB_BIAS = 8192 - 64 + 4096;
struct EpiIn {
    static constexpr bool PERM = true;
    __device__ __forceinline__ void acc_init(f32x4 (&acc)[2][2][4][2], const Unit&, int, int) const { PG8_ZERO_ACC(acc); }
    bf16_t* Z; const float* qn; const float* kn;
    __device__ __forceinline__ void operator()(const f32x4 (&acc)[2][2][4][2], const Unit& u, int wr, int wc, int fr, int fq) const {
        const int row0 = u.pm * BM + wr * 64 + fr;
        if (u.pn < 4) {
            const float* g = (u.pn < 2) ? qn : kn; const float sc = (u.pn < 2) ? QSCALE : 1.0f;
            f32x4 gv[2][2];
#pragma unroll
            for (int bj = 0; bj < 2; ++bj)
#pragma unroll
                for (int n = 0; n < 2; ++n) gv[bj][n] = *(const f32x4*)(g + 32 * bj + 8 * fq + 4 * n) * sc;
#pragma unroll
            for (int ai = 0; ai < 2; ++ai)
#pragma unroll
                for (int m = 0; m < 4; ++m) {
                    float ss = 0.f;
#pragma unroll
                    for (int bj = 0; bj < 2; ++bj)
#pragma unroll
                        for (int n = 0; n < 2; ++n) { const f32x4 x = acc[ai][bj][m][n]; ss += (x[0] * x[0] + x[1] * x[1]) + (x[2] * x[2] + x[3] * x[3]); }
                    ss += __shfl_xor(ss, 16); ss += __shfl_xor(ss, 32);
                    const float rstd = rsqrtf(ss * (1.0f / 64.0f) + 1e-6f);
                    bf16_t* rowp = Z + (size_t)(row0 + ai * HALF + m * 16) * ZW + u.pn * BM + 64 * wc + 8 * fq;
#pragma unroll
                    for (int bj = 0; bj < 2; ++bj) { const f32x4 v0 = acc[ai][bj][m][0] * rstd * gv[bj][0], v1 = acc[ai][bj][m][1] * rstd * gv[bj][1];
                        u32x4 w; w.x = cvt_pk_bf16(v0[0], v0[1]); w.y = cvt_pk_bf16(v0[2], v0[3]); w.z = cvt_pk_bf16(v1[0], v1[1]); w.w = cvt_pk_bf16(v1[2], v1[3]);
                        *(u32x4*)(rowp + 32 * bj) = w; }
                }
        } else {
            const int col0 = u.pn * BM + wc * 32 + 8 * fq;
#pragma unroll
            for (int ai = 0; ai < 2; ++ai)
#pragma unroll
                for (int m = 0; m < 4; ++m) { bf16_t* rowp = Z + (size_t)(row0 + ai * HALF + m * 16) * ZW + col0;
#pragma unroll
                    for (int bj = 0; bj < 2; ++bj) { const f32x4 v0 = acc[ai][bj][m][0], v1 = acc[ai][bj][m][1];
                        u32x4 w; w.x = cvt_pk_bf16(v0[0], v0[1]); w.y = cvt_pk_bf16(v0[2], v0[3]); w.z = cvt_pk_bf16(v1[0], v1[1]); w.w = cvt_pk_bf16(v1[2], v1[3]);
                        *(u32x4*)(rowp + bj * HALF) = w; } }
        }
    }
};
struct EpiBf16 {
    static constexpr bool PERM = true;
    __device__ __forceinline__ void acc_init(f32x4 (&acc)[2][2][4][2], const Unit&, int, int) const { PG8_ZERO_ACC(acc); }
    bf16_t* O; int ldc;
    __device__ __forceinline__ void operator()(const f32x4 (&acc)[2][2][4][2], const Unit& u, int wr, int wc, int fr, int fq) const {
        const int row0 = u.pm * BM + wr * 64 + fr, col0 = u.pn * BM + wc * 32 + 8 * fq;
#pragma unroll
        for (int ai = 0; ai < 2; ++ai)
#pragma unroll
            for (int m = 0; m < 4; ++m) { bf16_t* rowp = O + (size_t)(row0 + ai * HALF + m * 16) * ldc + col0;
#pragma unroll
                for (int bj = 0; bj < 2; ++bj) { const f32x4 v0 = acc[ai][bj][m][0], v1 = acc[ai][bj][m][1];
                    u32x4 w; w.x = cvt_pk_bf16(v0[0], v0[1]); w.y = cvt_pk_bf16(v0[2], v0[3]); w.z = cvt_pk_bf16(v1[0], v1[1]); w.w = cvt_pk_bf16(v1[2], v1[3]);
                    *(u32x4*)(rowp + bj * HALF) = w; } }
    }
};
struct EpiOut {
    static constexpr bool PERM = true;
    __device__ __forceinline__ void acc_init(f32x4 (&acc)[2][2][4][2], const Unit&, int, int) const { PG8_ZERO_ACC(acc); }
    const float* X; bf16_t* O;
    __device__ __forceinline__ void operator()(const f32x4 (&acc)[2][2][4][2], const Unit& u, int wr, int wc, int fr, int fq) const {
        const int row0 = u.pm * BM + wr * 64 + fr, col0 = u.pn * BM + wc * 32 + 8 * fq;
#pragma unroll
        for (int ai = 0; ai < 2; ++ai)
#pragma unroll
            for (int m = 0; m < 4; ++m) { const size_t off = (size_t)(row0 + ai * HALF + m * 16) * DM + col0;
#pragma unroll
                for (int bj = 0; bj < 2; ++bj) { const f32x4 v0 = *(const f32x4*)(X + off + bj * HALF) + acc[ai][bj][m][0], v1 = *(const f32x4*)(X + off + bj * HALF + 4) + acc[ai][bj][m][1];
                    u32x4 w; w.x = pk2(v0[0], v0[1]); w.y = pk2(v0[2], v0[3]); w.z = pk2(v1[0], v1[1]); w.w = pk2(v1[2], v1[3]);
                    *(u32x4*)(O + off + bj * HALF) = w; }
                if (m & 1) asm volatile("" ::: "memory"); }
    }
};
struct EpiPg {
    static constexpr bool PERM = true;
    __device__ __forceinline__ void acc_init(f32x4 (&acc)[2][2][4][2], const Unit&, int, int) const { PG8_ZERO_ACC(acc); }
    bf16_t* X; const bf16_t* PJ;
    __device__ __forceinline__ void operator()(const f32x4 (&acc)[2][2][4][2], const Unit& u, int wr, int wc, int fr, int fq) const {
        const int row0 = u.pm * BM + wr * 64 + fr, col0 = u.pn * BM + wc * 32 + 8 * fq;
#pragma unroll
        for (int ai = 0; ai < 2; ++ai)
#pragma unroll
            for (int m = 0; m < 4; ++m) { const size_t off = (size_t)(row0 + ai * HALF + m * 16) * DM + col0;
#pragma unroll
                for (int bj = 0; bj < 2; ++bj) { const size_t o = off + bj * HALF; const u32x4 pj = *(const u32x4*)(PJ + o), xv = *(const u32x4*)(X + o);
                    const unsigned pw[4] = {pj.x, pj.y, pj.z, pj.w}, xw[4] = {xv.x, xv.y, xv.z, xv.w}; unsigned ow[4];
#pragma unroll
                    for (int q = 0; q < 4; ++q) { const float a0 = acc[ai][bj][m][q >> 1][2 * (q & 1)], a1 = acc[ai][bj][m][q >> 1][2 * (q & 1) + 1];
                        ow[q] = pk2(bflo(xw[q]) + sigmoidf_(a0) * bflo(pw[q]), bfhi(xw[q]) + sigmoidf_(a1) * bfhi(pw[q])); }
                    *(u32x4*)(X + o) = (u32x4){ow[0], ow[1], ow[2], ow[3]}; }
                if (m & 1) asm volatile("" ::: "memory"); }
    }
};
struct EpiGu {
    static constexpr bool PERM = true;
    unsigned char* ACT; const LAS int* tab;
    __device__ __forceinline__ void acc_init(f32x4 (&acc)[2][2][4][2], const Unit& u, int wc, int fq) const {
        const LAS float* bl = (const LAS float*)((const LAS unsigned char*)tab + TB_BIAS + u.sl * 1024) + wc * 32 + 8 * fq;
#pragma unroll
        for (int n = 0; n < 2; ++n) { const f32x4 bg = *(const LAS f32x4*)(bl + 4 * n), bu = *(const LAS f32x4*)(bl + 128 + 4 * n) + 1.0f;
#pragma unroll
            for (int ai = 0; ai < 2; ++ai)
#pragma unroll
                for (int m = 0; m < 4; ++m) { acc[ai][0][m][n] = bg; acc[ai][1][m][n] = bu; } }
    }
    __device__ __forceinline__ void operator()(const f32x4 (&acc)[2][2][4][2], const Unit& u, int wr, int wc, int fr, int fq) const {
        const int row0 = u.pm * BM + wr * 64 + fr, cl = u.pn * HALF + wc * 32 + 8 * fq;
#pragma unroll
        for (int ai = 0; ai < 2; ++ai)
#pragma unroll
            for (int m = 0; m < 4; ++m) { unsigned char* rowp = ACT + (size_t)(row0 + ai * HALF + m * 16) * EFF + cl; f32x4 r[2];
#pragma unroll
                for (int n = 0; n < 2; ++n) {
                    f32x4 g = acc[ai][0][m][n], u = acc[ai][1][m][n];
#pragma unroll
                    for (int i = 0; i < 4; ++i) { g[i] = fminf(g[i], 7.0f); u[i] = __builtin_amdgcn_fmed3f(u[i], -6.0f, 8.0f); }
                    f32x4 d = g * (-1.702f * LOG2E);
#pragma unroll
                    for (int i = 0; i < 4; ++i) d[i] = __builtin_amdgcn_exp2f(d[i]);
                    d = d + 1.0f;
#pragma unroll
                    for (int i = 0; i < 4; ++i) d[i] = __builtin_amdgcn_rcpf(d[i]);
                    r[n] = (g * d) * u; }
                u32x2 w; w.x = pk4_fp8(r[0][0], r[0][1], r[0][2], r[0][3]); w.y = pk4_fp8(r[1][0], r[1][1], r[1][2], r[1][3]);
                *(u32x2*)rowp = w; }
    }
};
struct EpiDn {
    static constexpr bool PERM = true;
    unsigned char* YP; const float* gateslot; const LAS int* tab;
    __device__ __forceinline__ void acc_init(f32x4 (&acc)[2][2][4][2], const Unit& u, int wc, int fq) const {
        const LAS float* bl = (const LAS float*)((const LAS unsigned char*)tab + TB_BIAS + u.sl * 1024) + wc * 32 + 8 * fq;
#pragma unroll
        for (int bj = 0; bj < 2; ++bj)
#pragma unroll
            for (int n = 0; n < 2; ++n) { const f32x4 b = *(const LAS f32x4*)(bl + bj * HALF + 4 * n);
#pragma unroll
                for (int ai = 0; ai < 2; ++ai)
#pragma unroll
                    for (int m = 0; m < 4; ++m) acc[ai][bj][m][n] = b; }
    }
    __device__ __forceinline__ void operator()(const f32x4 (&acc)[2][2][4][2], const Unit& u, int wr, int wc, int fr, int fq) const {
        const int row0 = u.pm * BM + wr * 64 + fr, col0 = u.pn * BM + wc * 32 + 8 * fq;
#pragma unroll
        for (int ai = 0; ai < 2; ++ai)
#pragma unroll
            for (int m = 0; m < 4; ++m) {
                unsigned char* rowp = YP + (size_t)(row0 + ai * HALF + m * 16) * DM + col0;
#pragma unroll
                for (int bj = 0; bj < 2; ++bj) { const f32x4 v0 = acc[ai][bj][m][0], v1 = acc[ai][bj][m][1];
                    u32x2 w; w.x = pk4_fp8(v0[0], v0[1], v0[2], v0[3]); w.y = pk4_fp8(v1[0], v1[1], v1[2], v1[3]);
                    *(u32x2*)(rowp + bj * HALF) = w; } }
    }
};
struct MoeOrder {
    const unsigned char* A; const unsigned char* Bt; const int* tokslot; const float* gateslot;   const LAS int* tab; int nblk, nN, G, c; bool gather; const float* bias  ;
    __device__ __forceinline__ bool next(int i, Unit& u) const { if (!tile_order(i, G, c, nblk, nN, u.pm, u.pn)) return false; u.e = tab[T_BLKE + u.pm]; u.lb = u.pm - tab[T_BLKSTART + u.e]; return true; }
    __device__ __forceinline__ const char* a_base(const Unit& u) const { return gather ? (const char*)A : (const char*)A + (size_t)u.pm * BM * 1024; }
    __device__ __forceinline__ const char* b_base(const Unit& u) const { return (const char*)Bt + ((size_t)u.e * nN + u.pn) * BM * 1024; }
    __device__ __forceinline__ void prefetch(const Unit& u, int slot, int wid, int lane) const {
        if (wid < 4) { if (gather) { const unsigned* src = (const unsigned*)tokslot + (size_t)u.e * NTOK + u.lb * 256 + wid * 64 + lane;
            __builtin_amdgcn_global_load_lds(src, (LAS unsigned*)((LAS unsigned char*)tab + TB_OFF + slot * 1024 + wid * 256), 4, 0, 0); } }
        else { const int k = wid - 4;
            const float* src = gather ? bias + (size_t)u.e * 2048 + (k >> 1) * 1024 + u.pn * 128 + (k & 1) * 64 + lane : bias + (size_t)u.e * 1024 + u.pn * 256 + k * 64 + lane;
            __builtin_amdgcn_global_load_lds((const unsigned*)src, (LAS unsigned*)((LAS unsigned char*)tab + TB_BIAS + slot * 1024 + k * 256), 4, 0, 0); }
    }
    __device__ __forceinline__ void a_off(const Unit& u, const int (&R)[2], const int (&C)[2], unsigned (&off)[2][2]) const {
        const int cnt = tab[T_CNT + u.e]; const LAS int* tb = (const LAS int*)((const LAS unsigned char*)tab + TB_OFF + u.sl * 1024);
#pragma unroll
        for (int h = 0; h < 2; ++h)
#pragma unroll
            for (int i = 0; i < 2; ++i) {
                if (gather) { const int rr = R[i] + HALF * h; const int tk = tb[rr]; const int tok = (u.lb * 256 + rr) < cnt ? tk : NTOK; off[h][i] = (unsigned)tok * 1024u + (unsigned)C[i] * 2u; }
                else off[h][i] = (unsigned)((R[i] + HALF * h) * 1024 + C[i] * 2);
            }
    }
};
__device__ __forceinline__ int moe_tables(LAS int* tab, const unsigned* cntw) {
    if (threadIdx.x < 64) { const int e = threadIdx.x & 31; const int c = (int)cntw[e]; const int nb = (c + 255) >> 8; int incl = nb;
#pragma unroll
        for (int o = 1; o < 32; o <<= 1) { const int t = __shfl_up(incl, o, 32); if (e >= o) incl += t; }
        const int start = incl - nb;
        if (threadIdx.x < 32) { tab[T_CNT + e] = c; tab[T_BLKSTART + e] = start; if (e == NE - 1) tab[T_BLKSTART + NE] = incl;
            for (int j = 0; j < nb; ++j) tab[T_BLKE + start + j] = e; } }
    __syncthreads();
    return tab[T_BLKSTART + NE];
}
}
constexpr int NWAVES = 8, NTHREADS = 512;
constexpr int RING_BYTES = 131072, MISC_OFF = RING_BYTES, LDS_BYTES = 147456;

__device__ __forceinline__ void tr_item(const float* W, int ldw, int srccol0, int k0, bf16_t* WT, int Kd, int dstrow0, LAS float* scr, int lane) {
#pragma unroll 8
    for (int i = 0; i < 32; ++i) { const int kk = 2 * i + (lane >> 5); scr[kk * 33 + (lane & 31)] = W[(size_t)(k0 + kk) * ldw + srccol0 + (lane & 31)]; }
    asm volatile("s_waitcnt lgkmcnt(0)" ::: "memory");
    const int c = lane & 7;
#pragma unroll
    for (int j = 0; j < 4; ++j) { const int n = (lane >> 3) + 8 * j; const LAS float* s = scr + (8 * c) * 33 + n;
        u32x4 o; o.x = pk2(s[0 * 33], s[1 * 33]); o.y = pk2(s[2 * 33], s[3 * 33]); o.z = pk2(s[4 * 33], s[5 * 33]); o.w = pk2(s[6 * 33], s[7 * 33]);
        *(u32x4*)(WT + (size_t)(dstrow0 + n) * Kd + k0 + 8 * c) = o; }
    asm volatile("s_waitcnt lgkmcnt(0)" ::: "memory");
}
__device__ __forceinline__ void tr_item8(const float* W, int ldw, int srccol0, int k0, unsigned char* WT, int Kd, int dstrow0, LAS float* scr, int lane) {
    f32x4 v[8]; const int r8 = lane >> 3, c4 = lane & 7;
#pragma unroll
    for (int i = 0; i < 8; ++i) v[i] = __builtin_nontemporal_load((const f32x4*)(W + (size_t)(k0 + 8 * i + r8) * ldw + srccol0 + 4 * c4));
#pragma unroll
    for (int i = 0; i < 8; ++i) { LAS float* d = scr + (8 * i + r8) * 33 + 4 * c4; d[0] = v[i][0]; d[1] = v[i][1]; d[2] = v[i][2]; d[3] = v[i][3]; }
    asm volatile("s_waitcnt lgkmcnt(0)" ::: "memory");
    const int c = lane & 7;
#pragma unroll
    for (int j = 0; j < 4; ++j) { const int n = (lane >> 3) + 8 * j; const LAS float* s = scr + (8 * c) * 33 + n;
        u32x2 o; o.x = pk4_fp8(s[0 * 33] * 64.f, s[1 * 33] * 64.f, s[2 * 33] * 64.f, s[3 * 33] * 64.f); o.y = pk4_fp8(s[4 * 33] * 64.f, s[5 * 33] * 64.f, s[6 * 33] * 64.f, s[7 * 33] * 64.f);
        __builtin_nontemporal_store(o, (u32x2*)(WT + (size_t)(dstrow0 + n) * Kd + k0 + 8 * c)); }
    asm volatile("s_waitcnt lgkmcnt(0)" ::: "memory");
}
constexpr int I_IN = 16 * 120, I_OUT = 16 * 32, I_PG = 16 * 32, I_PP = 4 * 32, I_GU1 = 16 * 64, I_DN1 = 16 * 32;
constexpr int I_LORA = 16 + 16 + 32;
constexpr int I_SMALL = I_IN + I_OUT + I_PG + I_PP + I_LORA, I_GU = NE * I_GU1, I_DN = NE * I_DN1, I_ALL = I_SMALL + I_GU + I_DN;
__device__ __forceinline__ void prep_item(KPR P, int it, LAS float* scr, int lane) {
    unsigned char* ws = P.ws;
    if (it < I_IN) { const int kb = it / 120, nb = it % 120, n0 = nb * 32, pn = n0 >> 8, j0 = n0 & 255;
        const int src = pn < 4 ? (pn * 256 + 64 * ((j0 & 127) >> 5) + 32 * (j0 >> 7)) : (n0 < 2048 ? n0 : n0 + 8);
        tr_item(P.w_in, INW, src, kb * 64, (bf16_t*)(ws + WS_WIN), 1024, n0, scr, lane); return; }
    it -= I_IN;
    if (it < I_OUT) { tr_item(P.w_out, 1024, (it % 32) * 32, (it / 32) * 64, (bf16_t*)(ws + WS_WOUT), 1024, (it % 32) * 32, scr, lane); return; }
    it -= I_OUT;
    if (it < I_PG) { tr_item8(P.w_pg, 1024, (it % 32) * 32, (it / 32) * 64, ws + WS_WPG, 1024, (it % 32) * 32, scr, lane); return; }
    it -= I_PG;
    if (it < I_PP) { tr_item(P.w_pp, 1024, (it % 32) * 32, (it / 32) * 64, (bf16_t*)(ws + WS_WPP), 256, (it % 32) * 32, scr, lane); return; }
    it -= I_PP;
    if (it < 16) { tr_item(P.w2, 512, it * 32, 0, (bf16_t*)(ws + 29 * MiB), 64, it * 32, scr, lane); return; }
    it -= 16;
    if (it < 16) { tr_item(P.a2, 512, it * 32, 0, (bf16_t*)(ws + 29 * MiB + 65536), 64, it * 32, scr, lane); return; }
    it -= 16;
    if (it < 32) { tr_item(P.g2, 512, (it % 16) * 32, (it / 16) * 64, (bf16_t*)(ws + 29 * MiB + 131072), 128, (it % 16) * 32, scr, lane); return; }
    it -= 32;
    if (it < I_GU) { const int e = it / I_GU1, r = it % I_GU1, kb = r / 64, nb = r % 64, n0 = nb * 32, pn = n0 >> 8, j0 = n0 & 255;
        const int src = (j0 >> 7) * 1024 + pn * 128 + (j0 & 127);
        tr_item8(P.w_gu + (size_t)e * 1024 * 2048, 2048, src, kb * 64, ws + WS_WGU + (size_t)e * 2048 * 1024, 1024, n0, scr, lane); return; }
    it -= I_GU;
    { const int e = it / I_DN1, r = it % I_DN1, kb = r / 32, nb = r % 32;
        tr_item8(P.w_down + (size_t)e * 1024 * 1024, 1024, nb * 32, kb * 64, ws + WS_WDN + (size_t)e * 1024 * 1024, 1024, nb * 32, scr, lane); }
}
__device__ __forceinline__ void phase_prep_weights(KPR P, LAS unsigned char* lds, int gw, int ngw, int wave, int lane) {
    LAS float* scr = (LAS float*)(lds + wave * 16384);
    for (int it = gw; it < I_SMALL; it += ngw) prep_item(P, it, scr, lane);
}
constexpr int NCVT = I_DN / 64, CVT_TASK0 = I_GU / 64;
__device__ __forceinline__ void cvt_task(KPR P, LAS unsigned char* lds, int task, int wave, int lane) {
    LAS float* scr = (LAS float*)(lds + wave * 16384);
    for (int i = 0; i < 8; ++i) prep_item(P, I_SMALL + task * 64 + i * 8 + wave, scr, lane);
}
__device__ __forceinline__ const float* gu_item_src(KPR P, int it) {
    const int e = it / I_GU1, r = it % I_GU1, kb = r / 64, nb = r % 64, n0 = nb * 32, pn = n0 >> 8, j0 = n0 & 255;
    return P.w_gu + (size_t)e * 1024 * 2048 + (size_t)(kb * 64) * 2048 + (j0 >> 7) * 1024 + pn * 128 + (j0 & 127);
}
__device__ __forceinline__ void gu_half(KPR P, int it, int h, int lane, LAS float* scr, const f32x4& v0, const f32x4& v1, const f32x4& v2, const f32x4& v3) {
    const int e = it / I_GU1, r = it % I_GU1, kb = r / 64, nb = r % 64;
    unsigned char* dst = P.ws + WS_WGU + (size_t)e * 2048 * 1024 + (size_t)(nb * 32) * 1024 + kb * 64 + 32 * h;
    const int r8 = lane >> 3, c4 = lane & 7, n = lane & 31, kg = lane >> 5;
    { LAS f32x4* d = (LAS f32x4*)(scr + r8 * 36 + 4 * c4); d[0] = v0; d[8 * 9] = v1; d[16 * 9] = v2; d[24 * 9] = v3; }
    asm volatile("s_waitcnt lgkmcnt(0)" ::: "memory");
#pragma unroll
    for (int q = 0; q < 2; ++q) { const LAS float* s = scr + (16 * q + 8 * kg) * 36 + n;
        u32x2 o; o.x = pk4_fp8(s[0 * 36] * 64.f, s[1 * 36] * 64.f, s[2 * 36] * 64.f, s[3 * 36] * 64.f); o.y = pk4_fp8(s[4 * 36] * 64.f, s[5 * 36] * 64.f, s[6 * 36] * 64.f, s[7 * 36] * 64.f);
        __builtin_nontemporal_store(o, (u32x2*)(dst + (size_t)n * 1024 + 16 * q + 8 * kg)); }
    asm volatile("s_waitcnt lgkmcnt(0)" ::: "memory");
}
__device__ __forceinline__ void phase_cvt_p(KPR P, int gt, int ngt) {
    bf16_t* PB = (bf16_t*)((unsigned char*)P.out + DO_PB);
    for (int i = gt; i < NTOK * PLE / 8; i += ngt) { const f32x4 a = __builtin_nontemporal_load(&((const f32x4*)P.p)[2 * i]), b = __builtin_nontemporal_load(&((const f32x4*)P.p)[2 * i + 1]);
        u32x4 w; w.x = pk2(a[0], a[1]); w.y = pk2(a[2], a[3]); w.z = pk2(b[0], b[1]); w.w = pk2(b[2], b[3]); ((u32x4*)PB)[i] = w; }
}
__device__ __forceinline__ void rms_row(const float* xrow, const float* gain, int lane, f32x4 (&v)[4]) {
    const f32x4* xr = (const f32x4*)xrow + lane; float s = 0.f;
#pragma unroll
    for (int j = 0; j < 4; ++j) { v[j] = __builtin_nontemporal_load(&xr[64 * j]); s += (v[j][0] * v[j][0] + v[j][1] * v[j][1]) + (v[j][2] * v[j][2] + v[j][3] * v[j][3]); }
    const float rstd = rsqrtf(wave_sum(s) * (1.f / DM) + 1e-6f);
#pragma unroll
    for (int j = 0; j < 4; ++j) v[j] = v[j] * rstd * ((const f32x4*)gain)[64 * j + lane];
}
__device__ __forceinline__ void store_row_fp8(unsigned char* orow, int lane, const f32x4 (&v)[4]) {
    unsigned* o4 = (unsigned*)orow + lane;
#pragma unroll
    for (int j = 0; j < 4; ++j) o4[64 * j] = pk4_fp8(v[j][0], v[j][1], v[j][2], v[j][3]);
}
__device__ __forceinline__ void store_row_bf16(bf16_t* orow, int lane, const f32x4 (&v)[4]) {
    u32x2* o8 = (u32x2*)orow + lane;
#pragma unroll
    for (int j = 0; j < 4; ++j) { u32x2 w; w.x = pk2(v[j][0], v[j][1]); w.y = pk2(v[j][2], v[j][3]); o8[64 * j] = w; }
}
__device__ __forceinline__ void norm1_row(KPR P, int row, int lane, const LAS float* wff, LAS float* lf_out  ) {
    f32x4 v[4]; rms_row(P.x + (size_t)row * DM, P.mix_norm, lane, v);
    store_row_bf16((bf16_t*)(P.ws + WS_XN) + (size_t)row * DM, lane, v);
    float ff[8];
#pragma unroll
    for (int q = 0; q < 8; ++q) { float s = 0.f;
#pragma unroll
        for (int j = 0; j < 4; ++j) { const f32x4 w = *(const LAS f32x4*)(wff + q * 1024 + 4 * (64 * j + lane)); s += (v[j][0] * w[0] + v[j][1] * w[1]) + (v[j][2] * w[2] + v[j][3] * w[3]); }
        ff[q] = s; }
    float g4[4], g2[2], g1;
    { const bool up = lane & 32;
#pragma unroll
        for (int q = 0; q < 4; ++q) { const float keep = up ? ff[4 + q] : ff[q], give = up ? ff[q] : ff[4 + q]; g4[q] = keep + __shfl_xor(give, 32); } }
    { const bool up = lane & 16;
#pragma unroll
        for (int q = 0; q < 2; ++q) { const float keep = up ? g4[2 + q] : g4[q], give = up ? g4[q] : g4[2 + q]; g2[q] = keep + __shfl_xor(give, 16); } }
    { const bool up = lane & 8; const float keep = up ? g2[1] : g2[0], give = up ? g2[0] : g2[1]; g1 = keep + __shfl_xor(give, 8); }
    g1 += __shfl_xor(g1, 4); g1 += __shfl_xor(g1, 2); g1 += __shfl_xor(g1, 1);
    if ((lane & 7) == 0) { const int q = lane >> 3; lf_out[q] = logsigmoidf_(g1 + P.f_bias[q]); }
}
__device__ __forceinline__ void load_wff(KPR P, LAS float* wff, int tid, int nthr) {
    float t[16];
#pragma unroll
    for (int u = 0; u < 16; ++u) { const int i = tid + u * NTHREADS; t[u] = P.w_in[(size_t)(i >> 3) * INW + 2048 + (i & 7)]; }
#pragma unroll
    for (int u = 0; u < 16; ++u) { const int i = tid + u * NTHREADS; wff[(i & 7) * 1024 + (i >> 3)] = t[u]; }
    (void)nthr;
}
__device__ __forceinline__ void final_row(KPR P, int row, int lane, bool dead) {
    const u32x2* xr = (const u32x2*)((const bf16_t*)(P.ws + WS_X1) + (size_t)row * DM) + lane; f32x4 v[4]; float s = 0.f;
#pragma unroll
    for (int j = 0; j < 4; ++j) { const u32x2 xv = xr[64 * j]; v[j] = (f32x4){bflo(xv.x), bfhi(xv.x), bflo(xv.y), bfhi(xv.y)}; s += (v[j][0] * v[j][0] + v[j][1] * v[j][1]) + (v[j][2] * v[j][2] + v[j][3] * v[j][3]); }
    const float rstd = rsqrtf(wave_sum(s) * (1.f / DM) + 1e-6f);
    f32x4* o = (f32x4*)(P.out + (size_t)row * DM) + lane;
#pragma unroll
    for (int j = 0; j < 4; ++j) { v[j] = v[j] * rstd * ((const f32x4*)P.final_norm)[64 * j + lane]; if (dead) { const float q = __builtin_nanf(""); v[j] = (f32x4){q, q, q, q}; } __builtin_nontemporal_store(v[j], &o[64 * j]); }
}
typedef GAS unsigned gu32;
#define RLX_AGENT __ATOMIC_RELAXED, __HIP_MEMORY_SCOPE_AGENT
#define XB_TMO      128
#define XB_XCNT(j)  (256  + 64 * (j))
#define XB_XSUB(j)  (1280 + 64 * (j))
#define XB_XGEN(j)  (2304 + 64 * (j))
#define XB_TOP      3328
#define XB_TOPGEN   3392
#define XCD_BAR_WORDS 3456
#define XB_SPIN_CAP (1u << 22)

__device__ __forceinline__ unsigned xb_ld(unsigned* p)              { return __hip_atomic_load(p, __ATOMIC_RELAXED, __HIP_MEMORY_SCOPE_AGENT); }
__device__ __forceinline__ unsigned xb_add(unsigned* p, unsigned v) { return __hip_atomic_fetch_add(p, v, __ATOMIC_RELAXED, __HIP_MEMORY_SCOPE_AGENT); }
__device__ __forceinline__ unsigned xb_xcc_id() { return (unsigned)__builtin_amdgcn_s_getreg((3 << 11) | 20) & 0xFu; }
#define XB_SPIN(cond, bar) do { unsigned _sp = 0; while (cond) { __builtin_amdgcn_s_sleep(1); \
    if ((++_sp & 255u) == 0u) { if (xb_ld(&(bar)[XB_TMO])) break; if (_sp > XB_SPIN_CAP) { atomicAdd(&(bar)[XB_TMO], 1u); break; } } } } while (0)

struct XcdBarrier { unsigned* bar; unsigned x; volatile LAS unsigned* st; };

__device__ __forceinline__ XcdBarrier xcd_barrier_post(unsigned* bar, volatile LAS unsigned* st) {
    XcdBarrier b; b.bar = bar; b.x = xb_xcc_id(); b.st = st;
    if (threadIdx.x == 0) (void)xb_add(&bar[XB_XCNT(b.x)], 1u);
    return b;
}
__device__ __forceinline__ void xcd_barrier_complete(unsigned* bar, unsigned x, unsigned& nloc, unsigned& nx) {
    const unsigned G = gridDim.x * gridDim.y * gridDim.z;
    unsigned sum, cnt, mine, sp = 0u;
    for (;;) {
        sum = 0u; cnt = 0u; mine = 0u;
#pragma unroll
        for (unsigned j = 0; j < 16; ++j) { const unsigned c = xb_ld(&bar[XB_XCNT(j)]); sum += c; cnt += (c > 0u) ? 1u : 0u; mine = (j == x) ? c : mine; }
        if (sum == G) break;
        __builtin_amdgcn_s_sleep(1);
        if ((++sp & 255u) == 0u) { if (xb_ld(&bar[XB_TMO])) break; if (sp > XB_SPIN_CAP) { atomicAdd(&bar[XB_TMO], 1u); break; } }
    }
    nloc = mine > 0u ? mine : 1u; nx = cnt > 0u ? cnt : 1u;
}
__device__ __forceinline__ void xcd_barrier(const XcdBarrier& b) {
    asm volatile("s_waitcnt vmcnt(0)" ::: "memory");
    __syncthreads();
    if (threadIdx.x == 0) {
        unsigned* bar = b.bar;
        __builtin_amdgcn_s_waitcnt(0);
        unsigned nloc = b.st[0], nx = b.st[1];
        if (nloc == 0u) { xcd_barrier_complete(bar, b.x, nloc, nx); b.st[0] = nloc; b.st[1] = nx; }
        const unsigned old = xb_add(&bar[XB_XSUB(b.x)], 1u);
        const unsigned gen = old / nloc;
        if (old + 1u == (gen + 1u) * nloc) {
            __builtin_amdgcn_fence(__ATOMIC_RELEASE, "agent");
            asm volatile("s_waitcnt vmcnt(0)" ::: "memory");
            const unsigned og = xb_add(&bar[XB_TOP], 1u);
            const unsigned tg = og / nx;
            if (og + 1u == (tg + 1u) * nx) xb_add(&bar[XB_TOPGEN], 1u);
            else XB_SPIN(xb_ld(&bar[XB_TOPGEN]) == tg, bar);
            __builtin_amdgcn_fence(__ATOMIC_ACQUIRE, "agent");
            xb_add(&bar[XB_XGEN(b.x)], 1u);
            asm volatile("s_waitcnt vmcnt(0)" ::: "memory");
        } else {
            XB_SPIN(xb_ld(&bar[XB_XGEN(b.x)]) == gen, bar);
            __builtin_amdgcn_fence(__ATOMIC_ACQUIRE, "agent");
            asm volatile("s_waitcnt vmcnt(0)" ::: "memory");
        }
    }
    __syncthreads();
}
namespace rk {
constexpr int MB = 8192;
constexpr int S_AT = 0, S_RT = 1, S_KT = 2, S_BT = 3, S_ATT = 4, S_KTT = 5, S_BTT = 6, S_VT = 7, S_N = 8, S_NT = 9, S_MAK = 10, S_MRB = 11, S_MRK = 12, S_TA = 13, S_TB = 14;
constexpr int SCR = 15 * MB;
constexpr int NCHUNK = SEQ / 64;
constexpr size_t WS_HT = WS_X1;
constexpr size_t WS_Y0 = WS_X1 + 64 * MiB;
constexpr size_t WS_QI = WS_X1 + 96 * MiB;
constexpr size_t WS_LW = WS_RW, WS_LA = WS_RW + 32 * MiB, WS_LG = WS_RW + 64 * MiB;
constexpr size_t WS_SC = WS_RW + 224 * MiB;
constexpr size_t DO_GT = 80 * MiB;
static_assert(WS_SC + 32 * MiB <= WS_END, "rwkv blobs");

__device__ __forceinline__ int moff(int row, int col) { return row * 128 + ((((col >> 3) ^ (row >> 1)) & 7) << 4) + (col & 7) * 2; }
__device__ __forceinline__ int crow(int r, int hi) { return (r & 3) + 8 * (r >> 2) + 4 * hi; }
__device__ __forceinline__ f32x16 mm_nt(const LAS unsigned char* A, int ar0, const LAS unsigned char* Bt, int br0, f32x16 acc, int r32, int hi) {
#pragma unroll
    for (int ks = 0; ks < 4; ++ks) { const bf16x8 a = *(const LAS bf16x8*)(A + moff(ar0 + r32, 16 * ks + 8 * hi)), b = *(const LAS bf16x8*)(Bt + moff(br0 + r32, 16 * ks + 8 * hi));
        acc = __builtin_amdgcn_mfma_f32_32x32x16_bf16(a, b, acc, 0, 0, 0); }
    return acc;
}
__device__ __forceinline__ void store_t(LAS unsigned char* dst, const f32x16& acc, int i0, int j0, int r32, int hi) {
#pragma unroll
    for (int g = 0; g < 4; ++g) { u32x2 w; w.x = pk2(acc[4 * g], acc[4 * g + 1]); w.y = pk2(acc[4 * g + 2], acc[4 * g + 3]); *(LAS u32x2*)(dst + moff(j0 + r32, i0 + 8 * g + 4 * hi)) = w; }
}
template <int MODE> __device__ __forceinline__ void mask_tri(f32x16& acc, int i0, int j0, int r32, int hi) {
#pragma unroll
    for (int r = 0; r < 16; ++r) { const int i = i0 + crow(r, hi), j = j0 + r32; const bool keep = MODE == 0 ? (j < i) : (MODE == 1 ? (i < j) : (i <= j)); if (!keep) acc[r] = 0.f; }
}

__device__ __forceinline__ void pass1_chunk(KPR P, LAS unsigned char* lds, int bh, int c, int tid, int itbase, LAS float* cscr) {
    const int lane = tid & 63, wave = tid >> 6, r32 = lane & 31, hi = lane >> 5, grp = wave >> 2, wq = wave & 3, i0 = 32 * (wq >> 1), j0 = 32 * (wq & 1);
    const int b = bh >> 3, h = bh & 7; const size_t tok0 = (size_t)b * SEQ + (size_t)c * 64; const size_t ci = (size_t)bh * NCHUNK + c;
    LAS float* part = (LAS float*)(lds + SCR); LAS float* WL = (LAS float*)(lds + SCR + 2048);
#define MAT(s) (lds + (s) * MB)
    {
        const bf16_t* Z = (const bf16_t*)(P.ws + WS_Z); const bf16_t* LW = (const bf16_t*)(P.ws + WS_LW); const bf16_t* LA = (const bf16_t*)(P.ws + WS_LA);
        const int ch = tid & 63, tq = tid >> 6, cc = h * 64 + ch; const size_t row0 = tok0 + 8 * tq;
        const float mur = P.mu[RW_R + cc], muk = P.mu[RW_K + cc], muv = P.mu[RW_V + cc], w0c = P.w0[cc], a0c = P.a0[cc], kkc = P.k_k[cc], kac = P.k_a[cc];
        const bf16_t* zp = Z + row0 * ZW + ZR + cc;
        const bool first = (c == 0) && (tq == 0); const bf16_t* zq = first ? zp : zp - ZW; const float pm = first ? 0.f : 1.f;
        unsigned short lr[9], lk[9], lv[9], llw[8], lla[8];
        lr[0] = zq[RW_R]; lk[0] = zq[RW_K]; lv[0] = zq[RW_V];
#pragma unroll
        for (int i = 0; i < 8; ++i) { const bf16_t* zi = zp + (size_t)i * ZW; lr[i + 1] = zi[RW_R]; lk[i + 1] = zi[RW_K]; lv[i + 1] = zi[RW_V]; const size_t o = (row0 + i) * 512 + cc; llw[i] = LW[o]; lla[i] = LA[o]; }
        float cum[8], vr[8], vk[8], vkk[8], vka[8], ssq[8]; unsigned short vv16[8]; float run = 0.f;
#pragma unroll
        for (int i = 0; i < 8; ++i) { const float pmi = (i == 0) ? pm : 1.f; const float zr1 = bf2f(lr[i + 1]), zk1 = bf2f(lk[i + 1]), zv1 = bf2f(lv[i + 1]);
            vr[i] = zr1 + (bf2f(lr[i]) * pmi - zr1) * mur; vk[i] = zk1 + (bf2f(lk[i]) * pmi - zk1) * muk; vv16[i] = (unsigned short)f2bf(zv1 + (bf2f(lv[i]) * pmi - zv1) * muv);
            vkk[i] = vk[i] * kkc; ssq[i] = vkk[i] * vkk[i]; }
#pragma unroll
        for (int i = 0; i < 8; ++i) ssq[i] = wave_sum(ssq[i]);
#pragma unroll
        for (int i = 0; i < 8; ++i) {
            const float wl = w0c + bf2f(llw[i]);
            run += (-0.60653066f * LOG2E) * __builtin_amdgcn_rcpf(1.0f + __expf(-wl)); cum[i] = run;
            const float a = __builtin_amdgcn_rcpf(1.0f + __expf(-(a0c + bf2f(lla[i]))));
            const float kk = vkk[i] * __builtin_amdgcn_rsqf(fmaxf(ssq[i], 1e-24f));
            vk[i] = vk[i] * (1.0f + (a - 1.0f) * kac); vkk[i] = kk; vka[i] = kk * a; }
        part[tq * 64 + ch] = run;
        __syncthreads();
        float pre = 0.f;
#pragma unroll
        for (int g = 0; g < 8; ++g) { const float pvv = part[g * 64 + ch]; pre += (g < tq) ? pvv : 0.f; }
        float eprev = __builtin_amdgcn_exp2f(pre);
        unsigned atT[4], ktT[4], btT[4], vT[4];
#pragma unroll
        for (int p = 0; p < 4; ++p) { const int i0 = 2 * p, i1 = 2 * p + 1, t0 = 8 * tq + i0;
            const float cm0 = pre + cum[i0], ea = __builtin_amdgcn_exp2f(cm0), ia = __builtin_amdgcn_rcpf(ea);
            const float cm1 = pre + cum[i1], eb = __builtin_amdgcn_exp2f(cm1), ib = __builtin_amdgcn_rcpf(eb);
            const unsigned wa = pk2(-vkk[i0] * eprev, -vkk[i1] * ea), wr_ = pk2(vr[i0] * ea, vr[i1] * eb), wk = pk2(vk[i0] * ia, vk[i1] * ib), wb = pk2(vka[i0] * ia, vka[i1] * ib);
            eprev = eb;
            *(LAS unsigned short*)(MAT(S_AT) + moff(t0, ch)) = (unsigned short)wa; *(LAS unsigned short*)(MAT(S_AT) + moff(t0 + 1, ch)) = (unsigned short)(wa >> 16);
            *(LAS unsigned short*)(MAT(S_RT) + moff(t0, ch)) = (unsigned short)wr_; *(LAS unsigned short*)(MAT(S_RT) + moff(t0 + 1, ch)) = (unsigned short)(wr_ >> 16);
            *(LAS unsigned short*)(MAT(S_KT) + moff(t0, ch)) = (unsigned short)wk; *(LAS unsigned short*)(MAT(S_KT) + moff(t0 + 1, ch)) = (unsigned short)(wk >> 16);
            *(LAS unsigned short*)(MAT(S_BT) + moff(t0, ch)) = (unsigned short)wb; *(LAS unsigned short*)(MAT(S_BT) + moff(t0 + 1, ch)) = (unsigned short)(wb >> 16);
            atT[p] = wa; ktT[p] = wk; btT[p] = wb; vT[p] = (unsigned)vv16[i0] | ((unsigned)vv16[i1] << 16);
            if (p == 3 && tq == 7) WL[ch] = eb; }
        *(LAS u32x4*)(MAT(S_ATT) + moff(ch, 8 * tq)) = (u32x4){atT[0], atT[1], atT[2], atT[3]}; *(LAS u32x4*)(MAT(S_KTT) + moff(ch, 8 * tq)) = (u32x4){ktT[0], ktT[1], ktT[2], ktT[3]};
        *(LAS u32x4*)(MAT(S_BTT) + moff(ch, 8 * tq)) = (u32x4){btT[0], btT[1], btT[2], btT[3]}; *(LAS u32x4*)(MAT(S_VT) + moff(ch, 8 * tq)) = (u32x4){vT[0], vT[1], vT[2], vT[3]};
    }
    __syncthreads();
    const f32x16 zero = f32x16{};
    f32x4 cv[2][8];
    if (grp == 1) {
#pragma unroll
        for (int u = 0; u < 2; ++u) { const float* cs = gu_item_src(P, itbase + 4 * u + wq) + (size_t)(lane >> 3) * 2048 + 4 * (lane & 7);
#pragma unroll
            for (int i = 0; i < 8; ++i) cv[u][i] = __builtin_nontemporal_load((const f32x4*)(cs + (size_t)(8 * i) * 2048)); } }
    if (grp == 0) { f32x16 d = mm_nt(MAT(S_AT), i0, MAT(S_BT), j0, zero, r32, hi); mask_tri<0>(d, i0, j0, r32, hi); store_t(MAT(S_NT), d, i0, j0, r32, hi);
        d = mm_nt(MAT(S_KT), i0, MAT(S_AT), j0, zero, r32, hi); mask_tri<1>(d, i0, j0, r32, hi); store_t(MAT(S_MAK), d, i0, j0, r32, hi);
        d = mm_nt(MAT(S_KT), i0, MAT(S_RT), j0, zero, r32, hi); mask_tri<2>(d, i0, j0, r32, hi); store_t(MAT(S_MRK), d, i0, j0, r32, hi); }
    else { f32x16 d = mm_nt(MAT(S_BT), i0, MAT(S_AT), j0, zero, r32, hi); mask_tri<1>(d, i0, j0, r32, hi); store_t(MAT(S_N), d, i0, j0, r32, hi);
#pragma unroll
        for (int r = 0; r < 16; ++r) if (i0 + crow(r, hi) == j0 + r32) d[r] = 1.0f;
        store_t(MAT(S_TA), d, i0, j0, r32, hi);
        d = mm_nt(MAT(S_BT), i0, MAT(S_RT), j0, zero, r32, hi); mask_tri<2>(d, i0, j0, r32, hi); store_t(MAT(S_MRB), d, i0, j0, r32, hi); }
    __syncthreads();
#pragma unroll
    for (int s = 1; s <= 6; ++s) {
        const int mc = (s & 1) ? S_N : S_AT, mcT = (s & 1) ? S_NT : S_KT, mn = (s & 1) ? S_AT : S_N, mnT = (s & 1) ? S_KT : S_NT;
        const int tc = (s & 1) ? S_TB : S_TA, tn = (s & 1) ? S_TA : S_TB;
        if (s <= 5) {
            if (grp == 0) { const f32x16 d = mm_nt(MAT(mc), i0, MAT(mcT), j0, zero, r32, hi); store_t(MAT(mnT), d, i0, j0, r32, hi); }
            else { const f32x16 d = mm_nt(MAT(mcT), i0, MAT(mc), j0, zero, r32, hi); store_t(MAT(mn), d, i0, j0, r32, hi); }
        }
        if (s >= 2 && grp == (s <= 5 ? 0 : 1) ) {
            f32x16 d = mm_nt(MAT(mcT), i0, MAT(tc), j0, zero, r32, hi);
#pragma unroll
            for (int g = 0; g < 4; ++g) { const u32x2 tv = *(const LAS u32x2*)(MAT(tc) + moff(j0 + r32, i0 + 8 * g + 4 * hi)); d[4 * g] += bflo(tv.x); d[4 * g + 1] += bfhi(tv.x); d[4 * g + 2] += bflo(tv.y); d[4 * g + 3] += bfhi(tv.y); }
            store_t(MAT(tn), d, i0, j0, r32, hi);
        }
        if (s >= 2 && s <= 5 && grp == 1) { const int u = (s - 2) >> 1, h = (s - 2) & 1;
            gu_half(P, itbase + 4 * u + wq, h, lane, cscr, cv[u][4 * h], cv[u][4 * h + 1], cv[u][4 * h + 2], cv[u][4 * h + 3]); }
        __syncthreads();
    }
    if (grp == 0) { const f32x16 d = mm_nt(MAT(S_TB), i0, MAT(S_ATT), j0, zero, r32, hi); store_t(MAT(S_BT), d, i0, j0, r32, hi); }
    else { const f32x16 d = mm_nt(MAT(S_MAK), i0, MAT(S_VT), j0, zero, r32, hi); store_t(MAT(S_N), d, i0, j0, r32, hi); }
    __syncthreads();
    if (grp == 0) { const f32x16 d = mm_nt(MAT(S_TB), i0, MAT(S_N), j0, zero, r32, hi); store_t(MAT(S_NT), d, i0, j0, r32, hi);
        f32x16 q = mm_nt(MAT(S_BT), i0, MAT(S_MRB), j0, zero, r32, hi);
#pragma unroll
        for (int g = 0; g < 4; ++g) { const u32x2 rv = *(const LAS u32x2*)(MAT(S_RT) + moff(j0 + r32, i0 + 8 * g + 4 * hi)); q[4 * g] += bflo(rv.x); q[4 * g + 1] += bfhi(rv.x); q[4 * g + 2] += bflo(rv.y); q[4 * g + 3] += bfhi(rv.y); }
        store_t(MAT(S_KT), q, i0, j0, r32, hi); }
    else { f32x16 g_ = mm_nt(MAT(S_BT), i0, MAT(S_BTT), j0, zero, r32, hi);
        const float wl = WL[j0 + r32];
#pragma unroll
        for (int r = 0; r < 16; ++r) { if (i0 + crow(r, hi) == j0 + r32) g_[r] += 1.0f; g_[r] *= wl; }
        store_t(MAT(S_AT), g_, i0, j0, r32, hi); }
    __syncthreads();
    if (grp == 0) { f32x16 d = mm_nt(MAT(S_BTT), i0, MAT(S_NT), j0, zero, r32, hi); d = mm_nt(MAT(S_KTT), i0, MAT(S_VT), j0, d, r32, hi);
        float* HT = (float*)(P.ws + WS_HT) + ci * 4096 + (size_t)wq * 1024 + lane;
#pragma unroll
        for (int g = 0; g < 4; ++g) { const f32x4 wl4 = *(const LAS f32x4*)(WL + i0 + 8 * g + 4 * hi);
#pragma unroll
            for (int i = 0; i < 4; ++i) HT[(4 * g + i) * 64] = d[4 * g + i] * wl4[i]; } }
    else { f32x16 d = mm_nt(MAT(S_MRB), i0, MAT(S_NT), j0, zero, r32, hi); d = mm_nt(MAT(S_MRK), i0, MAT(S_VT), j0, d, r32, hi);
        unsigned* Y0 = (unsigned*)(P.ws + WS_Y0) + ci * 2048 + (size_t)wq * 512 + lane;
#pragma unroll
        for (int r2 = 0; r2 < 8; ++r2) Y0[r2 * 64] = pk2(d[2 * r2], d[2 * r2 + 1]); }
    { u32x4* GTg = (u32x4*)((unsigned char*)P.out + DO_GT + ci * MB); u32x4* QIg = (u32x4*)(P.ws + WS_QI + ci * MB);
        GTg[tid] = *(const LAS u32x4*)(MAT(S_AT) + tid * 16); QIg[tid] = *(const LAS u32x4*)(MAT(S_KT) + tid * 16); }
    __syncthreads();
#undef MAT
}

__device__ __forceinline__ void pass2_seq(KPR P, LAS unsigned char* lds, int bh, int tid) {
    const int lane = tid & 63, wave = tid >> 6, r32 = lane & 31, hi = lane >> 5, wq = wave & 3, i0 = 32 * (wq >> 1), j0 = 32 * (wq & 1);
    LAS unsigned char* Sm = lds; LAS unsigned char* G0 = lds + MB; LAS unsigned char* G1 = lds + 2 * MB;
    const size_t ci0 = (size_t)bh * NCHUNK;
    const u32x4* GTg = (const u32x4*)((const unsigned char*)P.out + DO_GT + ci0 * MB); u32x4* SCg = (u32x4*)(P.ws + WS_SC + ci0 * MB);
    const float* HT = (const float*)(P.ws + WS_HT) + ci0 * 4096 + (size_t)wq * 1024 + lane;
    *(LAS u32x4*)(Sm + tid * 16) = (u32x4){0u, 0u, 0u, 0u};
    *(LAS u32x4*)(G0 + tid * 16) = GTg[tid];
    u32x4 gnext = GTg[512 + tid];
    f32x16 hcur, hnext;
    if (wave < 4) {
#pragma unroll
        for (int r = 0; r < 16; ++r) { hcur[r] = HT[r * 64]; hnext[r] = HT[4096 + r * 64]; } }
    __syncthreads();
    for (int c = 0; c < NCHUNK; ++c) {
        LAS unsigned char* Gc = (c & 1) ? G1 : G0; LAS unsigned char* Gn = (c & 1) ? G0 : G1;
        SCg[(size_t)c * 512 + tid] = *(const LAS u32x4*)(Sm + tid * 16);
        f32x16 d = hcur;
        if (wave < 4) d = mm_nt(Gc, i0, Sm, j0, d, r32, hi);
        __syncthreads();
        if (wave < 4) store_t(Sm, d, i0, j0, r32, hi);
        *(LAS u32x4*)(Gn + tid * 16) = gnext;
        const int c2 = (c + 2 < NCHUNK) ? c + 2 : NCHUNK - 1;
        gnext = GTg[(size_t)c2 * 512 + tid];
        if (wave < 4) { hcur = hnext;
#pragma unroll
            for (int r = 0; r < 16; ++r) hnext[r] = HT[(size_t)c2 * 4096 + r * 64]; }
        __syncthreads();
    }
}

__device__ __forceinline__ void pass3_chunk(KPR P, LAS unsigned char* lds, int bh, int c, int tid) {
    const int lane = tid & 63, wave = tid >> 6, r32 = lane & 31, hi = lane >> 5, wq = wave & 3, i0 = 32 * (wq >> 1), j0 = 32 * (wq & 1);
    const int b = bh >> 3, h = bh & 7; const size_t tok0 = (size_t)b * SEQ + (size_t)c * 64; const size_t ci = (size_t)bh * NCHUNK + c;
    LAS unsigned char* Qm = lds; LAS unsigned char* Sm = lds + MB; LAS float* Yl = (LAS float*)(lds + 2 * MB);
    *(LAS u32x4*)(Qm + tid * 16) = ((const u32x4*)(P.ws + WS_QI + ci * MB))[tid];
    *(LAS u32x4*)(Sm + tid * 16) = ((const u32x4*)(P.ws + WS_SC + ci * MB))[tid];
    f32x16 d = f32x16{};
    if (wave < 4) { const unsigned* Y0 = (const unsigned*)(P.ws + WS_Y0) + ci * 2048 + (size_t)wq * 512 + lane;
#pragma unroll
        for (int r2 = 0; r2 < 8; ++r2) { const unsigned w = Y0[r2 * 64]; d[2 * r2] = bflo(w); d[2 * r2 + 1] = bfhi(w); } }
    const bf16_t* Z = (const bf16_t*)(P.ws + WS_Z); const bf16_t* LA = (const bf16_t*)(P.ws + WS_LA); const bf16_t* LG = (const bf16_t*)(P.ws + WS_LG);
    bf16_t* AO = (bf16_t*)(P.ws + WS_AO); const int cc = h * 64 + lane;
    const float lnw = P.ln_w[cc], lnb = P.ln_b[cc], rkc = P.r_k[cc], mur = P.mu[RW_R + cc], muk = P.mu[RW_K + cc], muv = P.mu[RW_V + cc], a0c = P.a0[cc], kac = P.k_a[cc];
    const bf16_t* zp = Z + (tok0 + wave * 8) * ZW + ZR + cc; const bool first = (c == 0) && (wave == 0); const bf16_t* zq = first ? zp : zp - ZW; const float pm = first ? 0.f : 1.f;
    unsigned short lr[9], lk[9], lv[9], lla[8], llg[8];
    lr[0] = zq[RW_R]; lk[0] = zq[RW_K]; lv[0] = zq[RW_V];
#pragma unroll
    for (int i = 0; i < 8; ++i) { const bf16_t* zi = zp + (size_t)i * ZW; lr[i + 1] = zi[RW_R]; lk[i + 1] = zi[RW_K]; lv[i + 1] = zi[RW_V]; const size_t o = (tok0 + wave * 8 + i) * 512 + cc; lla[i] = LA[o]; llg[i] = LG[o]; }
    __syncthreads();
    if (wave < 4) { d = mm_nt(Qm, i0, Sm, j0, d, r32, hi);
#pragma unroll
        for (int r = 0; r < 16; ++r) Yl[(i0 + crow(r, hi)) * 65 + j0 + r32] = d[r]; }
    __syncthreads();
    float y[8], s1[8], s2[8], s3[8], vvv[8];
#pragma unroll
    for (int i = 0; i < 8; ++i) { const float pmi = (i == 0) ? pm : 1.f; const float zr1 = bf2f(lr[i + 1]), zk1 = bf2f(lk[i + 1]), zv1 = bf2f(lv[i + 1]);
        const float r = zr1 + (bf2f(lr[i]) * pmi - zr1) * mur, zk = zk1 + (bf2f(lk[i]) * pmi - zk1) * muk; vvv[i] = zv1 + (bf2f(lv[i]) * pmi - zv1) * muv;
        const float a = __builtin_amdgcn_rcpf(1.0f + __expf(-(a0c + bf2f(lla[i])))); const float k = zk * (1.0f + (a - 1.0f) * kac);
        y[i] = Yl[(wave * 8 + i) * 65 + lane]; s1[i] = y[i]; s3[i] = r * k * rkc; }
#pragma unroll
    for (int i = 0; i < 8; ++i) { s1[i] = wave_sum(s1[i]); s3[i] = wave_sum(s3[i]); }
#pragma unroll
    for (int i = 0; i < 8; ++i) { y[i] -= s1[i] * (1.f / 64.f); s2[i] = y[i] * y[i]; }
#pragma unroll
    for (int i = 0; i < 8; ++i) s2[i] = wave_sum(s2[i]);
#pragma unroll
    for (int i = 0; i < 8; ++i) { const size_t tok = tok0 + wave * 8 + i; const float yn = y[i] * rsqrtf(s2[i] * (1.f / 64.f) + 64e-5f) * lnw + lnb;
        AO[tok * DM + 512 + cc] = (bf16_t)f2bf((yn + s3[i] * vvv[i]) * bf2f(llg[i])); }
}

constexpr size_t WS_W2T = 29 * MiB, WS_A2T = 29 * MiB + 65536, WS_G2T = 29 * MiB + 131072;
__device__ __forceinline__ bf16x8 act8(const bf16_t* zc, const bf16_t* zpv, float pmask, const float* mu, int mode) {
    const u32x4 c = *(const u32x4*)zc, p = *(const u32x4*)zpv;
    const f32x4 m0 = *(const f32x4*)mu, m1 = *(const f32x4*)(mu + 4);
    const unsigned cw[4] = {c.x, c.y, c.z, c.w}, pw[4] = {p.x, p.y, p.z, p.w}; const float um[8] = {m0[0], m0[1], m0[2], m0[3], m1[0], m1[1], m1[2], m1[3]}; float v[8];
#pragma unroll
    for (int j = 0; j < 4; ++j) { const float c0 = bflo(cw[j]), c1 = bfhi(cw[j]), p0 = bflo(pw[j]) * pmask, p1 = bfhi(pw[j]) * pmask;
        v[2 * j] = c0 + (p0 - c0) * um[2 * j]; v[2 * j + 1] = c1 + (p1 - c1) * um[2 * j + 1]; }
#pragma unroll
    for (int j = 0; j < 8; ++j) { if (mode == 0) { v[j] = 2.0f * __builtin_amdgcn_rcpf(1.0f + __builtin_amdgcn_exp2f(v[j] * (-2.0f * LOG2E))) - 1.0f; }        else if (mode == 2) v[j] = __builtin_amdgcn_rcpf(1.0f + __expf(-v[j])); }
    u32x4 w; w.x = pk2(v[0], v[1]); w.y = pk2(v[2], v[3]); w.z = pk2(v[4], v[5]); w.w = pk2(v[6], v[7]);
    return __builtin_bit_cast(bf16x8, w);
}
__device__ __forceinline__ int goff(int row, int col) { return row * 256 + ((((col >> 3) ^ row) & 15) << 4) + (col & 7) * 2; }
__device__ __forceinline__ void lora_block(KPR P, LAS unsigned char* lds, int blk, int G, int tid) {
    const int lane = tid & 63, wave = tid >> 6, r32 = lane & 31, hi = lane >> 5;
    const int task = blk * 4 + (wave & 3), cb0 = 8 * (wave >> 2); const bool work = task < NTOK / 32;
    const size_t row = (size_t)(work ? task : 0) * 32 + r32; const bool first = (row % SEQ) == 0;
    const bf16_t* Z = (const bf16_t*)(P.ws + WS_Z) + row * ZW + ZR + 8 * hi; const bf16_t* Zp = first ? Z : Z - ZW; const float pmask = first ? 0.f : 1.f;
    const float* mub = P.mu + 8 * hi;
    { const u32x4* w2 = (const u32x4*)(P.ws + WS_W2T); const u32x4* a2 = (const u32x4*)(P.ws + WS_A2T);
#pragma unroll
        for (int i = 0; i < 8; ++i) { const int idx = i * 512 + tid, rw = idx >> 3, ch = idx & 7; const int o = rw * 128 + (((ch ^ (rw >> 1)) & 7) << 4);
            *(LAS u32x4*)(lds + o) = w2[idx]; *(LAS u32x4*)(lds + 65536 + o) = a2[idx]; } }
    bf16x8 xw[4], xa[4], xg[8];
    if (work) {
#pragma unroll
        for (int ks = 0; ks < 4; ++ks) { xw[ks] = act8(Z + RW_W + 16 * ks, Zp + RW_W + 16 * ks, pmask, mub + RW_W + 16 * ks, 0); xa[ks] = act8(Z + RW_A + 16 * ks, Zp + RW_A + 16 * ks, pmask, mub + RW_A + 16 * ks, 1); asm volatile("" ::: "memory"); }
#pragma unroll
        for (int ks = 0; ks < 8; ++ks) { xg[ks] = act8(Z + RW_G + 16 * ks, Zp + RW_G + 16 * ks, pmask, mub + RW_G + 16 * ks, 2); if (ks & 1) asm volatile("" ::: "memory"); }
    }
    bf16_t* LW = (bf16_t*)(P.ws + WS_LW) + row * 512 + 4 * hi; bf16_t* LA = (bf16_t*)(P.ws + WS_LA) + row * 512 + 4 * hi; bf16_t* LG = (bf16_t*)(P.ws + WS_LG) + row * 512 + 4 * hi;
    __syncthreads();
    if (work) {
#pragma nounroll
        for (int cb = cb0; cb < cb0 + 8; ++cb) { f32x16 dw = f32x16{}, da = f32x16{};
#pragma unroll
            for (int ks = 0; ks < 4; ++ks) { const int o = moff(cb * 32 + r32, 16 * ks + 8 * hi);
                dw = __builtin_amdgcn_mfma_f32_32x32x16_bf16(*(const LAS bf16x8*)(lds + o), xw[ks], dw, 0, 0, 0); da = __builtin_amdgcn_mfma_f32_32x32x16_bf16(*(const LAS bf16x8*)(lds + 65536 + o), xa[ks], da, 0, 0, 0); }
#pragma unroll
            for (int g = 0; g < 4; ++g) { u32x2 w; w.x = pk2(dw[4 * g], dw[4 * g + 1]); w.y = pk2(dw[4 * g + 2], dw[4 * g + 3]); *(u32x2*)(LW + cb * 32 + 8 * g) = w;
                w.x = pk2(da[4 * g], da[4 * g + 1]); w.y = pk2(da[4 * g + 2], da[4 * g + 3]); *(u32x2*)(LA + cb * 32 + 8 * g) = w; } }
    }
    __syncthreads();
    { const u32x4* g2 = (const u32x4*)(P.ws + WS_G2T);
#pragma unroll
        for (int i = 0; i < 16; ++i) { const int idx = i * 512 + tid, rw = idx >> 4, ch = idx & 15; *(LAS u32x4*)(lds + rw * 256 + (((ch ^ rw) & 15) << 4)) = g2[idx]; } }
    __syncthreads();
    if (work) {
#pragma nounroll
        for (int cb = cb0; cb < cb0 + 8; ++cb) { f32x16 dg = f32x16{};
#pragma unroll
            for (int ks = 0; ks < 8; ++ks) dg = __builtin_amdgcn_mfma_f32_32x32x16_bf16(*(const LAS bf16x8*)(lds + goff(cb * 32 + r32, 16 * ks + 8 * hi)), xg[ks], dg, 0, 0, 0);
#pragma unroll
            for (int g = 0; g < 4; ++g) { u32x2 w; w.x = pk2(dg[4 * g], dg[4 * g + 1]); w.y = pk2(dg[4 * g + 2], dg[4 * g + 3]); *(u32x2*)(LG + cb * 32 + 8 * g) = w; } }
    }
    __syncthreads();
}
}
namespace rt {
__device__ __forceinline__ int woff(int e, int k) { return e * 2048 + ((((k >> 3) ^ (e & 15))) << 4) + (k & 7) * 2; }
constexpr size_t WS_WRI = 30 * MiB;
__device__ __forceinline__ void build_w(KPR P, int part, int tid) {
    unsigned char* img = P.ws + WS_WRI; const int e = tid & 31, k0 = part * 64 + 4 * (tid >> 5); float w[4];
#pragma unroll
    for (int i = 0; i < 4; ++i) w[i] = P.moe_norm[k0 + i] * P.w_router[(k0 + i) * 32 + e];
#pragma unroll
    for (int i = 0; i < 4; ++i) { const int k = k0 + i; const unsigned h = f2bf(w[i]); const unsigned l = f2bf(w[i] - bf2f(h));
        *(unsigned short*)(img + woff(e, k)) = (unsigned short)h; *(unsigned short*)(img + 65536 + woff(e, k)) = (unsigned short)l; }
}
__device__ __forceinline__ void copy_w(KPR P, LAS unsigned char* lds, int tid) {
    const u32x4* img = (const u32x4*)(P.ws + WS_WRI);
    u32x4 t[16];
#pragma unroll
    for (int i = 0; i < 16; ++i) t[i] = img[i * 512 + tid];
#pragma unroll
    for (int i = 0; i < 16; ++i) *(LAS u32x4*)(lds + (size_t)(i * 512 + tid) * 16) = t[i];
}
__device__ __forceinline__ void split8(const f32x4& a, const f32x4& b, bf16x8& h, bf16x8& l) {
    unsigned hh[8]; float v[8] = {a[0], a[1], a[2], a[3], b[0], b[1], b[2], b[3]};
#pragma unroll
    for (int j = 0; j < 8; ++j) hh[j] = f2bf(v[j]);
    u32x4 hw, lw;
    hw.x = hh[0] | (hh[1] << 16); hw.y = hh[2] | (hh[3] << 16); hw.z = hh[4] | (hh[5] << 16); hw.w = hh[6] | (hh[7] << 16);
    lw.x = pk2(v[0] - bf2f(hh[0]), v[1] - bf2f(hh[1])); lw.y = pk2(v[2] - bf2f(hh[2]), v[3] - bf2f(hh[3])); lw.z = pk2(v[4] - bf2f(hh[4]), v[5] - bf2f(hh[5])); lw.w = pk2(v[6] - bf2f(hh[6]), v[7] - bf2f(hh[7]));
    h = __builtin_bit_cast(bf16x8, hw); l = __builtin_bit_cast(bf16x8, lw);
}
__device__ __forceinline__ void route_task(KPR P, const LAS unsigned char* wlds, int task, int lane) {
    const int r32 = lane & 31, hi = lane >> 5; const int row = task * 32 + r32;
    const bf16_t* xrow = (const bf16_t*)(P.ws + WS_X1) + (size_t)row * DM + 8 * hi;
    f32x16 acc = f32x16{}; float ss = 0.f;
    u32x4 xq[16];
#pragma unroll
    for (int j = 0; j < 16; ++j) xq[j] = *(const u32x4*)(xrow + 16 * j);
    for (int ks0 = 0; ks0 < 64; ks0 += 16) {
#pragma unroll
        for (int j = 0; j < 16; ++j) { const int ks = ks0 + j; const u32x4 xv = xq[j];
            const int kn = (ks + 16 < 64) ? ks + 16 : ks; xq[j] = *(const u32x4*)(xrow + 16 * kn);
            const unsigned xw[4] = {xv.x, xv.y, xv.z, xv.w};
#pragma unroll
            for (int q = 0; q < 4; ++q) { const float a = bflo(xw[q]), b = bfhi(xw[q]); ss += a * a + b * b; }
            const bf16x8 xh = __builtin_bit_cast(bf16x8, xv);
            const bf16x8 wh = *(const LAS bf16x8*)(wlds + woff(r32, 16 * ks + 8 * hi)), wl = *(const LAS bf16x8*)(wlds + 65536 + woff(r32, 16 * ks + 8 * hi));
            acc = __builtin_amdgcn_mfma_f32_32x32x16_bf16(wh, xh, acc, 0, 0, 0); acc = __builtin_amdgcn_mfma_f32_32x32x16_bf16(wl, xh, acc, 0, 0, 0); }
    }
    ss += __shfl_xor(ss, 32);
    const float rstd = rsqrtf(ss * (1.f / DM) + 1e-6f);
    float lg[16];
#pragma unroll
    for (int g = 0; g < 4; ++g) { const f32x4 bb = *(const f32x4*)(P.b_router + 8 * g + 4 * hi);
#pragma unroll
        for (int i = 0; i < 4; ++i) lg[4 * g + i] = acc[4 * g + i] * rstd + bb[i]; }
    float tv[4]; int ti[4];
#pragma unroll
    for (int k = 0; k < 4; ++k) { float bv = lg[0]; int bi = 4 * hi;
#pragma unroll
        for (int r = 1; r < 16; ++r) { const int e = (r & 3) + 8 * (r >> 2) + 4 * hi; if (lg[r] > bv) { bv = lg[r]; bi = e; } }
        const float pv = __shfl_xor(bv, 32); const int pi = __shfl_xor(bi, 32);
        if (pv > bv || (pv == bv && pi < bi)) { bv = pv; bi = pi; }
        tv[k] = bv; ti[k] = bi;
#pragma unroll
        for (int r = 0; r < 16; ++r) { const int e = (r & 3) + 8 * (r >> 2) + 4 * hi; if (e == bi) lg[r] = -INFINITY; } }
    const float e1 = __expf(tv[1] - tv[0]), e2 = __expf(tv[2] - tv[0]), e3 = __expf(tv[3] - tv[0]), inv = 1.f / (1.f + e1 + e2 + e3);
    const int c0 = hi ? ti[2] : ti[0], c1 = hi ? ti[3] : ti[1]; const float g0 = (hi ? e2 : 1.f) * inv, g1 = (hi ? e3 : e1) * inv;
    const unsigned long long ltm = (1ull << lane) - 1ull; int mycnt = 0, rk0 = 0, rk1 = 0;
    for (int e = 0; e < 32; ++e) { const unsigned long long m0 = __ballot(c0 == e), m1 = __ballot(c1 == e); const int n0 = __popcll(m0);
        if (lane == e) mycnt = n0 + __popcll(m1);
        if (c0 == e) rk0 = __popcll(m0 & ltm);
        if (c1 == e) rk1 = n0 + __popcll(m1 & ltm); }
    unsigned* cnt = (unsigned*)(P.ws + WS_CTL) + CW_CNT; int base = 0;
    if (lane < 32 && mycnt > 0) base = (int)atomicAdd(cnt + lane, (unsigned)mycnt);
    rk0 += __shfl(base, c0); rk1 += __shfl(base, c1);
    int* route = (int*)(P.ws + WS_ROUTE); int* tokslot = (int*)(P.ws + WS_TOKSLOT); float* gateslot = (float*)(P.ws + WS_GATESLOT);
    tokslot[(size_t)c0 * NTOK + rk0] = row; gateslot[(size_t)c0 * NTOK + rk0] = g0; tokslot[(size_t)c1 * NTOK + rk1] = row; gateslot[(size_t)c1 * NTOK + rk1] = g1;
    route[(size_t)row * 12 + 2 * hi] = c0; route[(size_t)row * 12 + 2 * hi + 1] = c1; route[(size_t)row * 12 + 4 + 2 * hi] = rk0; route[(size_t)row * 12 + 4 + 2 * hi + 1] = rk1;
    ((float*)route)[(size_t)row * 12 + 8 + 2 * hi] = g0; ((float*)route)[(size_t)row * 12 + 8 + 2 * hi + 1] = g1;
}
__device__ __forceinline__ void xn8_task(KPR P, int task, int lane) {
    const bf16_t* x1 = (const bf16_t*)(P.ws + WS_X1) + (size_t)task * 32 * DM + 16 * lane; unsigned char* xn = P.ws + WS_XN + (size_t)task * 32 * DM + 16 * lane;
    f32x4 g[4];
#pragma unroll
    for (int q = 0; q < 4; ++q) g[q] = *(const f32x4*)(P.moe_norm + 16 * lane + 4 * q);
    u32x4 xa[4][2];
#pragma unroll
    for (int i = 0; i < 4; ++i) { xa[i][0] = *(const u32x4*)(x1 + (size_t)i * DM); xa[i][1] = *(const u32x4*)(x1 + (size_t)i * DM + 8); }
    for (int r0 = 0; r0 < 32; r0 += 4) {
        f32x4 v[4][4]; float ss[4];
#pragma unroll
        for (int i = 0; i < 4; ++i) { const unsigned w[8] = {xa[i][0].x, xa[i][0].y, xa[i][0].z, xa[i][0].w, xa[i][1].x, xa[i][1].y, xa[i][1].z, xa[i][1].w}; float s = 0.f;
#pragma unroll
            for (int q = 0; q < 4; ++q) { v[i][q] = (f32x4){bflo(w[2 * q]), bfhi(w[2 * q]), bflo(w[2 * q + 1]), bfhi(w[2 * q + 1])}; s += (v[i][q][0] * v[i][q][0] + v[i][q][1] * v[i][q][1]) + (v[i][q][2] * v[i][q][2] + v[i][q][3] * v[i][q][3]); }
            ss[i] = s;
            const int rn = (r0 + 4 + i < 32) ? r0 + 4 + i : r0 + i; xa[i][0] = *(const u32x4*)(x1 + (size_t)rn * DM); xa[i][1] = *(const u32x4*)(x1 + (size_t)rn * DM + 8); }
#pragma unroll
        for (int i = 0; i < 4; ++i) ss[i] = wave_sum(ss[i]);
#pragma unroll
        for (int i = 0; i < 4; ++i) { const float rstd = rsqrtf(ss[i] * (1.f / DM) + 1e-6f); u32x4 o; unsigned ow[4];
#pragma unroll
            for (int q = 0; q < 4; ++q) { const f32x4 t = v[i][q] * rstd * g[q]; ow[q] = pk4_fp8(t[0], t[1], t[2], t[3]); }
            o.x = ow[0]; o.y = ow[1]; o.z = ow[2]; o.w = ow[3];
            *(u32x4*)(xn + (size_t)(r0 + i) * DM) = o; }
    }
}
}
namespace attn_body {
using bf16=unsigned short;
using bf16x8=__attribute__((ext_vector_type(8)))short;
using s16x4=__attribute__((ext_vector_type(4)))short;
using f32x16=__attribute__((ext_vector_type(16)))float;
using u32x4=__attribute__((ext_vector_type(4)))unsigned;
constexpr int BATCH=4,NHEAD=8,SEQ=8192,D=64,DM=3840,OP=1024;
constexpr int NW=8,QBLK=32,QB=QBLK*NW,KVBLK=64,NQB=SEQ/QB;
constexpr int ATTN_PITCH=DM, ATTN_UNIT_ROWS=QB;
__device__ __forceinline__ int crow(int r,int hi){return (r&3)+8*(r>>2)+4*hi;}
#define SBAR() __builtin_amdgcn_sched_barrier(0)
__device__ __forceinline__ void cmask(f32x16&p0,f32x16&p1,int jb,int qrel,int hi){
  const float NEG=-INFINITY; int kb=64*jb+4*hi;
  #pragma unroll
  for(int r=0;r<16;++r){int kv=kb+(r&3)+8*(r>>2); if(kv>qrel)p0[r]=NEG; if(kv+32>qrel)p1[r]=NEG;}
}

constexpr int NSLOT=3, SLOTB=8192;
constexpr int LDS_K=0, LDS_V=NSLOT*SLOTB, LDS_WS=2*NSLOT*SLOTB, LDS_OST=LDS_WS+NW*64*4, LDS_C2=LDS_OST+NW*4096, LDS_BYTES=LDS_C2+SEQ*4;
constexpr float C2=0.125f*1.4426950408889634f;
__device__ __forceinline__ void glds16(const void*gsrc,unsigned lds_dst){unsigned keep;
  asm volatile("s_mov_b32 %0, m0\n\ts_mov_b32 m0, %2\n\ts_nop 0\n\tglobal_load_lds_dwordx4 %1, off\n\ts_mov_b32 m0, %0":"=&s"(keep):"v"(gsrc),"s"(lds_dst):"memory");}
__device__ __forceinline__ float max3f(float a,float b,float c){float r;asm("v_max3_f32 %0, %1, %2, %3":"=v"(r):"v"(a),"v"(b),"v"(c));return r;}
__device__ __forceinline__ float max2f(float a,float b){float r;asm("v_max_f32_e32 %0, %1, %2":"=v"(r):"v"(a),"v"(b));return r;}
__device__ __forceinline__ float fadd_s(float a,float b){float r;asm("v_add_f32_e32 %0, %1, %2":"=v"(r):"v"(a),"v"(b));return r;}
__device__ __forceinline__ float fsub_s(float a,float b){float r;asm("v_sub_f32_e32 %0, %1, %2":"=v"(r):"v"(a),"v"(b));return r;}
typedef float f32x2_t __attribute__((ext_vector_type(2))); typedef float f32x4v __attribute__((ext_vector_type(4))); typedef __bf16 bf16x2_t __attribute__((ext_vector_type(2)));
__device__ __forceinline__ unsigned cvtpk_s(float lo,float hi){f32x2_t v={lo,hi};bf16x2_t b=__builtin_convertvector(v,bf16x2_t);return __builtin_bit_cast(unsigned,b);}
#define WAIT_BAR(N) asm volatile("s_waitcnt vmcnt(" #N ") lgkmcnt(0)\n\ts_barrier":::"memory")

__device__ __forceinline__ void qkt(f32x16&p0,f32x16&p1,const char*Kslot,const bf16x8*qr,int r32,int hi){
  const char*kb=Kslot+hi*1024+r32*16;
  #pragma unroll
  for(int d0=0;d0<4;++d0){
    const bf16x8 b0=*reinterpret_cast<const bf16x8*>(kb+d0*2048);
    const bf16x8 b1=*reinterpret_cast<const bf16x8*>(kb+d0*2048+512);
    p0=__builtin_amdgcn_mfma_f32_32x32x16_bf16(b0,qr[d0],p0,0,0,0);p1=__builtin_amdgcn_mfma_f32_32x32x16_bf16(b1,qr[d0],p1,0,0,0);}
}
typedef __attribute__((address_space(3))) const char* lds_cptr;
typedef short v4i16_t __attribute__((ext_vector_type(4)));
__device__ __forceinline__ void kload8(bf16x8*kf,lds_cptr kp){
  kf[0]=*(const __attribute__((address_space(3))) bf16x8*)(kp);      kf[1]=*(const __attribute__((address_space(3))) bf16x8*)(kp+512);
  kf[2]=*(const __attribute__((address_space(3))) bf16x8*)(kp+2048); kf[3]=*(const __attribute__((address_space(3))) bf16x8*)(kp+2560);
  kf[4]=*(const __attribute__((address_space(3))) bf16x8*)(kp+4096); kf[5]=*(const __attribute__((address_space(3))) bf16x8*)(kp+4608);
  kf[6]=*(const __attribute__((address_space(3))) bf16x8*)(kp+6144); kf[7]=*(const __attribute__((address_space(3))) bf16x8*)(kp+6656);
}
__device__ __forceinline__ void kload2(bf16x8*kf,lds_cptr kp,int j){ kf[2*j]=*(const __attribute__((address_space(3))) bf16x8*)(kp+j*2048); kf[2*j+1]=*(const __attribute__((address_space(3))) bf16x8*)(kp+j*2048+512); }
__device__ __forceinline__ s16x4 vtr(lds_cptr p){ return __builtin_bit_cast(s16x4,__builtin_amdgcn_ds_read_tr16_b64_v4i16((__attribute__((address_space(3))) v4i16_t*)p)); }
__device__ __forceinline__ float rowmax(const f32x16&p0,const f32x16&p1){
  float a=max3f(p0[0],p0[1],p1[0]),b=max3f(p0[2],p0[3],p1[1]);a=max3f(a,p1[2],p1[3]);
  #pragma unroll
  for(int r=4;r<16;r+=4){a=max3f(a,p0[r],p0[r+1]);b=max3f(b,p0[r+2],p0[r+3]);a=max3f(a,p1[r],p1[r+1]);b=max3f(b,p1[r+2],p1[r+3]);}
  const float m=max2f(a,b);
  auto rr=__builtin_amdgcn_permlane32_swap(__float_as_uint(m),__float_as_uint(m),false,false);
  return max2f(__uint_as_float(rr[0]),__uint_as_float(rr[1]));
}
__device__ __forceinline__ void pv(f32x16*o,int vb,bf16x8 pa0,bf16x8 pa1,bf16x8 pa2,bf16x8 pa3){
  #pragma unroll
  for(int d0=0;d0<2;++d0){s16x4 lo[4],hi[4];
    #pragma unroll
    for(int ks=0;ks<4;++ks){
      asm volatile("ds_read_b64_tr_b16 %0,%1 offset:%c2":"=&v"(lo[ks]):"v"(vb),"i"(d0*4096+ks*1024):"memory");
      asm volatile("ds_read_b64_tr_b16 %0,%1 offset:%c2":"=&v"(hi[ks]):"v"(vb),"i"(d0*4096+ks*1024+512):"memory");}
    asm volatile("s_waitcnt lgkmcnt(0)":::"memory");SBAR();
    #define PK(k) (bf16x8){lo[k][0],lo[k][1],lo[k][2],lo[k][3],hi[k][0],hi[k][1],hi[k][2],hi[k][3]}
    o[d0]=__builtin_amdgcn_mfma_f32_32x32x16_bf16(pa0,PK(0),o[d0],0,0,0);
    o[d0]=__builtin_amdgcn_mfma_f32_32x32x16_bf16(pa1,PK(1),o[d0],0,0,0);
    o[d0]=__builtin_amdgcn_mfma_f32_32x32x16_bf16(pa2,PK(2),o[d0],0,0,0);
    o[d0]=__builtin_amdgcn_mfma_f32_32x32x16_bf16(pa3,PK(3),o[d0],0,0,0);
    #undef PK
  }
}

#ifndef ATTN_STORE16
#define ATTN_STORE16(p,v) (*(u32x4*)(p)=(v))
#endif
template<int THRL> __device__ __forceinline__ void attn_unit(int b,int h,int qb,int t0,const bf16*Z,const float*c2g,bf16*O,char*shm){
  int tid_=threadIdx.x; asm volatile("":"+v"(tid_));
  const int tid=tid_,lane=tid&63,r32=lane&31,hi=lane>>5; const int wid=__builtin_amdgcn_readfirstlane(tid>>6);
  const long rowbase=(long)b*SEQ; const int q0=qb*QB;
  const bf16*Qw=Z+(rowbase+q0+wid*QBLK)*DM+h*D;
  const bf16*Kh=Z+(rowbase+(long)t0*KVBLK)*DM+512+h*D,*Vh=Z+(rowbase+(long)t0*KVBLK)*DM+1024+h*D;
  const unsigned lds0=(unsigned)(uintptr_t)shm;
  float*wsf=(float*)(shm+LDS_WS)+wid*64;
  const bf16*ksrc=Kh+(long)lane*DM+wid*8;
  const bf16*vsrc=Vh+(long)(16*(wid&3)+(lane>>2))*DM+(wid>>2)*32+(lane&3)*8;
  const unsigned kdst=lds0+LDS_K+wid*1024, vdst=lds0+LDS_V+wid*1024;
  #define DMA_K(t,slot) glds16(ksrc+(long)(t)*KVBLK*DM,(unsigned)__builtin_amdgcn_readfirstlane(kdst+(slot)))
  #define DMA_V(t,slot) glds16(vsrc+(long)(t)*KVBLK*DM,(unsigned)__builtin_amdgcn_readfirstlane(vdst+(slot)))
  const int vb0=(int)(lds0+LDS_V)+((lane>>4)&1)*32+(lane&3)*8+(4*hi+((lane&15)>>2))*64;
  const char*Kbase=shm+LDS_K; bf16x8 kf[8];
  const lds_cptr shm3=(lds_cptr)shm; const lds_cptr kp0=shm3+LDS_K+hi*1024+r32*16; const lds_cptr vp0=shm3+LDS_V+((lane>>4)&1)*32+(lane&3)*8+(4*hi+((lane&15)>>2))*64;
  const int NT=(q0+QB)/KVBLK-t0;
  { const int np=(q0+QB)/256;
    for(int p=(t0>>2)+wid;p<np;p+=NW) glds16(c2g+p*256+lane*4,(unsigned)__builtin_amdgcn_readfirstlane(lds0+LDS_C2+p*1024)); }
  const __attribute__((address_space(3))) float* c2l=(const __attribute__((address_space(3))) float*)(shm3+LDS_C2)+t0*KVBLK+4*hi;
  DMA_K(0,0);DMA_V(0,0);DMA_K(1,SLOTB);
  bf16x8 qr[4];
  #pragma unroll
  for(int d0=0;d0<4;++d0)qr[d0]=*reinterpret_cast<const bf16x8*>(&Qw[(long)r32*DM+d0*16+hi*8]);
  float l_reg=0.f;f32x16 o[2];o[0]=f32x16{};o[1]=f32x16{};
  float base=c2g[q0+wid*QBLK+r32];
  const int qrel=wid*QBLK+r32;
  #define CMASK(P0,P1,t) do{int jb_=(t)-(NT-4); if(jb_>=0)cmask(P0,P1,jb_,qrel,hi);}while(0)
  bool resc=false;
  #define START(P0,P1) do{ const float rm=rowmax(P0,P1); resc=false; \
    { const float dl=rm; base=fsub_s(base,dl); \
      _Pragma("unroll") for(int r=0;r<16;++r){P0[r]=fsub_s(P0[r],dl);P1[r]=fsub_s(P1[r],dl);} } \
    _Pragma("unroll") for(int r=0;r<16;++r)P0[r]=__builtin_amdgcn_exp2f(P0[r]); }while(0)
  #define RESC() do{ if(resc){ asm volatile("s_waitcnt lgkmcnt(0)":::"memory"); \
      _Pragma("unroll") for(int d_=0;d_<2;++d_) _Pragma("unroll") for(int r=0;r<16;++r)o[d_][r]*=wsf[crow(r,hi)]; } }while(0)
  f32x16 pA0,pA1,pB0,pB1;
  #define BIASLD(P0,P1,tt) do{ _Pragma("unroll") for(int g_=0;g_<4;++g_){ const f32x4v x0_=*(const __attribute__((address_space(3))) f32x4v*)(c2l+(tt)*KVBLK+8*g_), x1_=*(const __attribute__((address_space(3))) f32x4v*)(c2l+(tt)*KVBLK+32+8*g_); \
      P0[4*g_]=x0_[0];P0[4*g_+1]=x0_[1];P0[4*g_+2]=x0_[2];P0[4*g_+3]=x0_[3]; P1[4*g_]=x1_[0];P1[4*g_+1]=x1_[1];P1[4*g_+2]=x1_[2];P1[4*g_+3]=x1_[3]; } }while(0)
  #define BIASFIX(P0,P1) do{ _Pragma("unroll") for(int r=0;r<16;++r){P0[r]=fsub_s(base,P0[r]);P1[r]=fsub_s(base,P1[r]);} }while(0)
  int sl_prev=0,sl_cur=0,sl_next=SLOTB;
  #define ROT() do{sl_prev=sl_cur;sl_cur=sl_next;sl_next=(sl_next==(NSLOT-1)*SLOTB)?0:sl_next+SLOTB;}while(0)
  DMA_K(2,2*SLOTB);
  WAIT_BAR(3);
  BIASLD(pA0,pA1,0); BIASFIX(pA0,pA1);
  qkt(pA0,pA1,Kbase,qr,r32,hi);asm volatile("s_nop 15\n\ts_nop 7":"+v"(pA0),"+v"(pA1));CMASK(pA0,pA1,0);
  START(pA0,pA1);
  _Pragma("unroll") for(int r=0;r<16;++r)pA1[r]=__builtin_amdgcn_exp2f(pA1[r]);
  BIASLD(pB0,pB1,1);
  WAIT_BAR(0);
  DMA_K(3,0);DMA_V(1,SLOTB);
  ROT();
  kload8(kf,kp0+sl_cur);
  WAIT_BAR(2);
  s16x4 vlo[8],vhi[8]; u32x4 pw0,pw1,pw2,pw3;
  #define PKW(P,B) cvtpk_s(P[B],P[B+1])
  #define PAF(k) __builtin_bit_cast(bf16x8,pw##k)
  #define VFR(i) (bf16x8){vlo[i][0],vlo[i][1],vlo[i][2],vlo[i][3],vhi[i][0],vhi[i][1],vhi[i][2],vhi[i][3]}
  #define PIN(x) asm volatile("":"+v"(x))
  #define MX3(a,b,c) __builtin_fmaxf(__builtin_fmaxf((a),(b)),(c))
  #define GAPA(MF,A0,A1,A2,A3,W0,W1,PW) do{ MF; sacc+=A0; sacc+=A1; sacc+=A2; sacc+=A3; PIN(sacc); W0; W1; PIN(PW); SBAR(); }while(0)
  #define EX(v) __builtin_amdgcn_exp2f(v)
  #define GAPB(MF,X,B) do{ MF; X[B]=EX(X[B]); X[B+1]=EX(X[B+1]); X[B+2]=EX(X[B+2]); X[B+3]=EX(X[B+3]); PIN(X); SBAR(); }while(0)
  #define VRD(i) do{ vlo[i]=vtr(vp_+(((i)>>2)*4096+((i)&3)*1024)); vhi[i]=vtr(vp_+(((i)>>2)*4096+((i)&3)*1024+512)); }while(0)
  #define KRD(G,j) do{ if(G){ kload2(kf,kp0+sl_next,j); SBAR(); } }while(0)
  #define STEP(C0,C1,P0,P1,t,GK,GV,GL) do{ SBAR(); \
    BIASFIX(C0,C1); SBAR(); \
    const lds_cptr vp_=vp0+sl_prev; \
    VRD(0); SBAR(); float sacc=(P0[0]+P0[1]); \
    GAPA(C0=__builtin_amdgcn_mfma_f32_32x32x16_bf16(kf[0],qr[0],C0,0,0,0), P0[2],P0[3],P0[4],P0[5],     pw0[0]=PKW(P0,0), pw0[1]=PKW(P0,2), pw0); \
    VRD(4); SBAR(); GAPA(C1=__builtin_amdgcn_mfma_f32_32x32x16_bf16(kf[1],qr[0],C1,0,0,0), P0[6],P0[7],P0[8],P0[9],     pw0[2]=PKW(P0,4), pw0[3]=PKW(P0,6), pw0); \
    VRD(1); SBAR(); GAPA(C0=__builtin_amdgcn_mfma_f32_32x32x16_bf16(kf[2],qr[1],C0,0,0,0),   P0[10],P0[11],P0[12],P0[13], pw1[0]=PKW(P0,8), pw1[1]=PKW(P0,10), pw1); \
    VRD(5); SBAR(); GAPA(C1=__builtin_amdgcn_mfma_f32_32x32x16_bf16(kf[3],qr[1],C1,0,0,0),   P0[14],P0[15],P1[0],P1[1],   pw1[2]=PKW(P0,12),pw1[3]=PKW(P0,14), pw1); \
    VRD(2); SBAR(); GAPA(C0=__builtin_amdgcn_mfma_f32_32x32x16_bf16(kf[4],qr[2],C0,0,0,0),   P1[2],P1[3],P1[4],P1[5],     pw2[0]=PKW(P1,0), pw2[1]=PKW(P1,2), pw2); \
    VRD(6); SBAR(); GAPA(C1=__builtin_amdgcn_mfma_f32_32x32x16_bf16(kf[5],qr[2],C1,0,0,0),   P1[6],P1[7],P1[8],P1[9],     pw2[2]=PKW(P1,4), pw2[3]=PKW(P1,6), pw2); \
    VRD(3); SBAR(); GAPA(C0=__builtin_amdgcn_mfma_f32_32x32x16_bf16(kf[6],qr[3],C0,0,0,0),   P1[10],P1[11],P1[12],P1[13], pw3[0]=PKW(P1,8), pw3[1]=PKW(P1,10), pw3); \
    VRD(7); SBAR(); GAPA(C1=__builtin_amdgcn_mfma_f32_32x32x16_bf16(kf[7],qr[3],C1,0,0,0),   P1[14],P1[15],0.f,0.f,       pw3[2]=PKW(P1,12),pw3[3]=PKW(P1,14), pw3); \
    l_reg+=sacc; \
    if(GL){BIASLD(P0,P1,(t)+1);} \
    if(GK){DMA_K((t)+3,sl_cur);} if(GV){DMA_V((t)+1,sl_next);} \
    CMASK(C0,C1,t); \
    { float a=MX3(C0[0],C0[1],C1[0]),b=MX3(C0[2],C0[3],C1[1]); a=MX3(a,C1[2],C1[3]); \
      _Pragma("unroll") for(int r=4;r<16;r+=4){a=MX3(a,C0[r],C0[r+1]);b=MX3(b,C0[r+2],C0[r+3]);a=MX3(a,C1[r],C1[r+1]);b=MX3(b,C1[r+2],C1[r+3]);} \
      float rm=__builtin_fmaxf(a,b); { auto rr=__builtin_amdgcn_permlane32_swap(__float_as_uint(rm),__float_as_uint(rm),false,false); rm=__builtin_fmaxf(__uint_as_float(rr[0]),__uint_as_float(rr[1])); } \
      resc=false; \
      if(__builtin_expect(__any(rm>(float)THRL),0)){ const float dl=__builtin_fmaxf(rm,0.f); base-=dl; \
        _Pragma("unroll") for(int r=0;r<16;++r){C0[r]-=dl;C1[r]-=dl;} \
        const float f=__builtin_amdgcn_exp2f(-dl); l_reg*=f; if(hi==0)wsf[r32]=f; resc=true; } } \
    SBAR(); \
    GAPB(o[0]=__builtin_amdgcn_mfma_f32_32x32x16_bf16(PAF(0),VFR(0),o[0],0,0,0), C0,0); \
    GAPB(o[1]=__builtin_amdgcn_mfma_f32_32x32x16_bf16(PAF(0),VFR(4),o[1],0,0,0), C0,4); \
    KRD(GL,0); GAPB(o[0]=__builtin_amdgcn_mfma_f32_32x32x16_bf16(PAF(1),VFR(1),o[0],0,0,0), C0,8); \
    KRD(GL,1); GAPB(o[1]=__builtin_amdgcn_mfma_f32_32x32x16_bf16(PAF(1),VFR(5),o[1],0,0,0), C0,12); \
    KRD(GL,2); GAPB(o[0]=__builtin_amdgcn_mfma_f32_32x32x16_bf16(PAF(2),VFR(2),o[0],0,0,0), C1,0); \
    KRD(GL,3); GAPB(o[1]=__builtin_amdgcn_mfma_f32_32x32x16_bf16(PAF(2),VFR(6),o[1],0,0,0), C1,4); \
    GAPB(o[0]=__builtin_amdgcn_mfma_f32_32x32x16_bf16(PAF(3),VFR(3),o[0],0,0,0), C1,8); \
    GAPB(o[1]=__builtin_amdgcn_mfma_f32_32x32x16_bf16(PAF(3),VFR(7),o[1],0,0,0), C1,12); \
    }while(0)
  int t=1;
  #undef CMASK
  #define CMASK(P0,P1,t) do{}while(0)
  for(;t+5<NT;t+=2){
    STEP(pB0,pB1,pA0,pA1,t,true,true,true);     WAIT_BAR(2); RESC(); ROT();
    STEP(pA0,pA1,pB0,pB1,t+1,true,true,true);   WAIT_BAR(2); RESC(); ROT();
  }
  #undef CMASK
  #define CMASK(P0,P1,t) do{int jb_=(t)-(NT-4); if(jb_>=0)cmask(P0,P1,jb_,qrel,hi);}while(0)
  #define ENDW(tt) do{ if((tt)+3<NT){WAIT_BAR(2);} else if((tt)+2<NT){WAIT_BAR(1);} else {WAIT_BAR(0);} }while(0)
  for(;t+1<NT;t+=2){
    STEP(pB0,pB1,pA0,pA1,t,(t+3<NT),(t+1<NT),(t+1<NT));       ENDW(t);   RESC(); ROT();
    STEP(pA0,pA1,pB0,pB1,t+1,(t+4<NT),(t+2<NT),(t+2<NT));     ENDW(t+1); RESC(); ROT();
  }
  STEP(pB0,pB1,pA0,pA1,NT-1,false,false,false); RESC();
  { float sacc=pB0[0]+pB0[1]; _Pragma("unroll") for(int r=2;r<16;++r)sacc+=pB0[r]; _Pragma("unroll") for(int r=0;r<16;++r)sacc+=pB1[r]; l_reg+=sacc;
    pw0=(u32x4){PKW(pB0,0),PKW(pB0,2),PKW(pB0,4),PKW(pB0,6)};pw1=(u32x4){PKW(pB0,8),PKW(pB0,10),PKW(pB0,12),PKW(pB0,14)};pw2=(u32x4){PKW(pB1,0),PKW(pB1,2),PKW(pB1,4),PKW(pB1,6)};pw3=(u32x4){PKW(pB1,8),PKW(pB1,10),PKW(pB1,12),PKW(pB1,14)};
    SBAR(); pv(o,vb0+sl_cur,PAF(0),PAF(1),PAF(2),PAF(3)); }
  #undef PKW
  #undef PAF
  #undef VFR
  #undef PIN
  #undef MX3
  #undef GAPA
  #undef GAPB
  #undef EX
  #undef VRD
  #undef KRD
  #undef STEP
  #undef ENDW
  {auto rr=__builtin_amdgcn_permlane32_swap(__float_as_uint(l_reg),__float_as_uint(l_reg),false,false);l_reg=__uint_as_float(rr[0])+__uint_as_float(rr[1]);}
  if(hi==0)wsf[32+r32]=l_reg;asm volatile("s_waitcnt lgkmcnt(0)":::"memory");
  float rli[16];
  #pragma unroll
  for(int r=0;r<16;++r)rli[r]=__builtin_amdgcn_rcpf(wsf[32+crow(r,hi)]);
  bf16*Ow=O+(rowbase+q0+wid*QBLK)*OP+h*D; const bf16*Gw=Z+(rowbase+q0+wid*QBLK)*DM+1536+h*D;
  { bf16*stg=(bf16*)(shm+LDS_OST)+wid*2048;
    #pragma unroll
    for(int r=0;r<16;++r){const int orow=crow(r,hi);
      #pragma unroll
      for(int d0=0;d0<2;++d0)stg[orow*64+d0*32+r32]=(bf16)f2bf(o[d0][r]*rli[r]);}
    asm volatile("s_waitcnt lgkmcnt(0)":::"memory");
    #pragma unroll
    for(int i=0;i<4;++i){const int row=i*8+(lane>>3),ch=lane&7; const u32x4 v=*(const u32x4*)(stg+row*64+ch*8), g=*(const u32x4*)(Gw+(long)row*DM+ch*8);
      const unsigned vw[4]={v.x,v.y,v.z,v.w},gw[4]={g.x,g.y,g.z,g.w}; unsigned ow[4];
      #pragma unroll
      for(int j=0;j<4;++j){ const float a0=bflo(vw[j])*__builtin_amdgcn_rcpf(1.0f+__expf(-bflo(gw[j]))), a1=bfhi(vw[j])*__builtin_amdgcn_rcpf(1.0f+__expf(-bfhi(gw[j]))); ow[j]=cvtpk_s(a0,a1); }
      ATTN_STORE16(Ow+(long)row*OP+ch*8,((u32x4){ow[0],ow[1],ow[2],ow[3]}));} }
  asm volatile("s_waitcnt lgkmcnt(0)\n\ts_barrier":::"memory");
  #undef DMA_K
  #undef DMA_V
  #undef CMASK
  #undef START
  #undef RESC
  #undef ROT
}
constexpr int ATTN_LDS_BYTES=LDS_BYTES;
#undef SBAR
#undef WAIT_BAR
}
constexpr int CW_QATT = 128, CW_QCVT = 384;
constexpr int MISC_TAB = 64, MISC_Q = 4096, MISC_PFX = 4160;

__device__ __forceinline__ int attn_t0(KPR P, const float* c2, int q0, int lane) {
    float gq = fabsf(P.q_norm[lane]), gk = fabsf(P.k_norm[lane]);
#pragma unroll
    for (int o = 1; o < 64; o <<= 1) { gq = fmaxf(gq, __shfl_xor(gq, o)); gk = fmaxf(gk, __shfl_xor(gk, o)); }
    const float thr = c2[q0] + (2.0f * 8.0f * LOG2E * gq * gk + 40.0f);
    const int nfull = q0 / 64; int t0 = 0;
    for (int tb = 0; tb < nfull; tb += 64) { const int tt = tb + lane; const bool sk = (tt < nfull) && (c2[tt * 64 + 63] > thr); const unsigned long long bm = __ballot(sk); t0 += __popcll(bm); if (bm != ~0ull) break; }
    return __builtin_amdgcn_readfirstlane(t0) & ~1;
}
template <int NR>
__device__ __forceinline__ void combine_rows(KPR P, const LAS int* tab, const int (&rows)[NR], int lane) {
    const int* route = (const int*)(P.ws + WS_ROUTE); const unsigned char* YP = P.ws + WS_YP; bf16_t* X = (bf16_t*)(P.ws + WS_X1);
    u32x2 xv[NR][4]; unsigned yv[NR][4][4];
#pragma unroll
    for (int r = 0; r < NR; ++r) { const u32x2* xr = (const u32x2*)(X + (size_t)rows[r] * DM) + lane;
#pragma unroll
        for (int j = 0; j < 4; ++j) xv[r][j] = xr[64 * j]; }
#pragma unroll
    for (int r = 0; r < NR; ++r)
#pragma unroll
        for (int k = 0; k < 4; ++k) { const int ex = route[(size_t)rows[r] * 12 + k], rank = route[(size_t)rows[r] * 12 + 4 + k]; const size_t pos = (size_t)tab[pg8::T_BLKSTART + ex] * 256 + rank;
            const unsigned* yr = (const unsigned*)(YP + pos * DM) + lane;
#pragma unroll
            for (int j = 0; j < 4; ++j) yv[r][k][j] = yr[64 * j]; }
#pragma unroll
    for (int r = 0; r < NR; ++r) { f32x4 v[4];
#pragma unroll
        for (int j = 0; j < 4; ++j) v[j] = (f32x4){bflo(xv[r][j].x), bfhi(xv[r][j].x), bflo(xv[r][j].y), bfhi(xv[r][j].y)};
#pragma unroll
        for (int k = 0; k < 4; ++k) { const float gk = ((const float*)route)[(size_t)rows[r] * 12 + 8 + k];
#pragma unroll
            for (int j = 0; j < 4; ++j) { const unsigned y = yv[r][k][j]; const f32x2 lo = __builtin_amdgcn_cvt_pk_f32_fp8((int)y, false), hi = __builtin_amdgcn_cvt_pk_f32_fp8((int)y, true);
                v[j][0] += lo[0] * gk; v[j][1] += lo[1] * gk; v[j][2] += hi[0] * gk; v[j][3] += hi[1] * gk; } }
        u32x2* xo = (u32x2*)(X + (size_t)rows[r] * DM) + lane; float s = 0.f;
#pragma unroll
        for (int j = 0; j < 4; ++j) { u32x2 w; w.x = pk2(v[j][0], v[j][1]); w.y = pk2(v[j][2], v[j][3]); xo[64 * j] = w; v[j] = (f32x4){bflo(w.x), bfhi(w.x), bflo(w.y), bfhi(w.y)}; s += (v[j][0] * v[j][0] + v[j][1] * v[j][1]) + (v[j][2] * v[j][2] + v[j][3] * v[j][3]); }
        const float rstd = rsqrtf(wave_sum(s) * (1.f / DM) + 1e-6f);
#pragma unroll
        for (int j = 0; j < 4; ++j) v[j] = v[j] * rstd * ((const f32x4*)P.ple_norm)[64 * j + lane];
        store_row_fp8(P.ws + WS_XN + (size_t)rows[r] * DM, lane, v); }
}

constexpr int NPHASE = 13;
__global__ void __launch_bounds__(NTHREADS, 2) mega_fwd(Params Pkarg_unused) {
    extern __shared__ __attribute__((aligned(16))) unsigned char smem[];
    LAS unsigned char* lds = (LAS unsigned char*)smem;
    const int tid = threadIdx.x, lane = tid & 63, wave = __builtin_amdgcn_readfirstlane(tid >> 6);
    const int G = gridDim.x, blk = blockIdx.x;
#define P (*kpp)
#ifndef MK_REP
#define MK_REP -1
#endif
#define PHASE_BEGIN(k) if (IN(k)) for (int rep_ = 0; rep_ < ((k) == MK_REP ? 2 : 1); ++rep_) { const __attribute__((address_space(4))) Params* kpp = kp_fresh();
#define PHASE_END(k) } if (BOTH(k)) { XcdBarrier bar_; bar_.bar = (unsigned*)((*kp_fresh()).ws + WS_CTL) + CW_BAR; bar_.x = xb_xcc_id(); bar_.st = (volatile LAS unsigned*)(lds + MISC_OFF); xcd_barrier(bar_); }
#define IN(k) (ph_lo <= (k) && (k) < ph_hi)
#define BOTH(k) (IN(k) && IN((k) + 1))
    const __attribute__((address_space(4))) Params* kpp = kp_fresh();
    if (tid < 16) ((volatile LAS unsigned*)(lds + MISC_OFF))[tid] = 0u;
    __syncthreads();
    (void)xcd_barrier_post((unsigned*)(P.ws + WS_CTL) + CW_BAR, (volatile LAS unsigned*)(lds + MISC_OFF));
    const int ph_lo = P.ph_lo, ph_hi = P.ph_hi;
#define wsb (P.ws)
#define ctl ((unsigned*)(P.ws + WS_CTL))
#define MISC ((volatile LAS unsigned*)(lds + MISC_OFF))
#define tab ((LAS int*)(lds + MISC_OFF + MISC_TAB))

    PHASE_BEGIN(0)
        phase_prep_weights(P, lds, blk * NWAVES + wave, G * NWAVES, wave, lane);
        phase_cvt_p(P, blk * NTHREADS + tid, G * NTHREADS);
        __syncthreads();
        LAS float* wff = (LAS float*)lds; LAS float* lf = (LAS float*)(lds + 32768);
        load_wff(P, wff, tid, NTHREADS); __syncthreads();
        for (int i = 0; i < 16; ++i) { const int rl = wave * 16 + i; norm1_row(P, blk * 128 + rl, lane, wff, lf + rl * 8); }
        __syncthreads();
        if (tid < 64) { const int h = tid & 7, seg = tid >> 3; float c16[16]; float run = 0.f;
#pragma unroll
            for (int r = 0; r < 16; ++r) { run += lf[(seg * 16 + r) * 8 + h]; c16[r] = run; }
            float incl = run;
#pragma unroll
            for (int o = 8; o < 64; o <<= 1) { const float t = __shfl_up(incl, o); if (tid >= o) incl += t; }
            const float pre = incl - run; float* cloc = (float*)(P.ws + WS_LOGF) + ((size_t)blk * 128 + seg * 16) * 8 + h;
#pragma unroll
            for (int r = 0; r < 16; ++r) cloc[r * 8] = pre + c16[r];
            if (seg == 7) ((float*)(P.ws + WS_CTOT))[blk * 8 + h] = incl; }
        if (blk >= G - 16) rt::build_w(P, blk - (G - 16), tid);
    PHASE_END(0)

    PHASE_BEGIN(1)
        {
            LAS float* pfx = (LAS float*)(lds + MISC_OFF + MISC_PFX);
            if (tid < 64) { const float* ct = (const float*)(wsb + WS_CTOT); const int j = (blk & ~63) + tid; float v8[8];
#pragma unroll
                for (int h = 0; h < 8; ++h) v8[h] = (j < blk) ? ct[j * 8 + h] : 0.f;
#pragma unroll
                for (int h = 0; h < 8; ++h) { const float s = wave_sum(v8[h]); if (tid == 0) pfx[h] = s; } }
            __syncthreads();
            const float* cloc = (const float*)(wsb + WS_LOGF) + (size_t)blk * 128 * 8; float* c2 = (float*)(P.ws + WS_C2);
            for (int i = tid; i < 1024; i += NTHREADS) { const int r = i >> 3, h = i & 7; const int row = blk * 128 + r, b = row >> 13, t = row & (SEQ - 1);
                c2[((size_t)(b * 8 + h)) * SEQ + t] = (cloc[i] + pfx[h]) * LOG2E; }
            __syncthreads();
        }
        {
            pg8::DenseOrder S{(const bf16_t*)(wsb + WS_XN), (const bf16_t*)(wsb + WS_WIN), 1024, NTOK / 256, ZW / 256, G, blk};
            pg8::EpiIn E{(bf16_t*)(P.ws + WS_Z), P.q_norm, P.k_norm};
            pg8::gemm_phase<pg8::EpiIn, pg8::DenseOrder, true>(lds, 1024, S, E);
        }
        {
            pg8::DenseOrder S{(const bf16_t*)((unsigned char*)P.out + DO_PB), (const bf16_t*)(wsb + WS_WPP), PLE, NTOK / 256, DM / 256, G / 2, blk >= G / 2 ? blk - G / 2 : (1 << 20)};
            pg8::EpiBf16 E{(bf16_t*)((unsigned char*)P.out + DO_PJ), DM};
            pg8::gemm_phase<pg8::EpiBf16, pg8::DenseOrder, true>(lds, PLE, S, E);
        }
    PHASE_END(1)

    PHASE_BEGIN(2)
        rk::lora_block(P, lds, blk, G, tid);
        __syncthreads();
        { LAS float* cscr = (LAS float*)(lds + ((wave & 3) == 0 ? 125184 : MISC_OFF + 64 + ((wave & 3) - 1) * 4608));
          for (int i = 0; i < 16; ++i) rk::pass1_chunk(P, lds, (blk >> 6) * 8 + (i & 7), 2 * (blk & 63) + (i >> 3), tid, (blk * 16 + i) * 8, cscr); }
    PHASE_END(2)

    PHASE_BEGIN(4)
        if (blk < NB * NH) rk::pass2_seq(P, lds, blk, tid);
#define CVT_LOOP() for (;;) { __syncthreads(); if (tid == 0) MISC[MISC_Q / 4] = __hip_atomic_fetch_add(ctl + CW_QCVT + 64 * rep_, 1u, RLX_AGENT); __syncthreads(); \
            const int q = (int)MISC[MISC_Q / 4]; if (q >= NCVT) break; cvt_task(P, lds, CVT_TASK0 + q, wave, lane); }
        if (((blk >> 3) & 7) == 5) { CVT_LOOP() }
        for (;;) {
            __syncthreads();
            if (tid == 0) MISC[MISC_Q / 4] = __hip_atomic_fetch_add(ctl + CW_QATT + 64 * rep_, 1u, RLX_AGENT);
            __syncthreads();
            const int q = (int)MISC[MISC_Q / 4];
            if (q >= 1024) break;
            { const int bh = q & 31, qb = 31 - (q >> 5); const float* c2 = (const float*)(wsb + WS_C2) + (size_t)bh * SEQ;
              const int t0 = attn_t0(P, c2, qb * 256, lane);
              attn_body::attn_unit<8>(bh >> 3, bh & 7, qb, t0, (const bf16_t*)(wsb + WS_Z), c2, (bf16_t*)(P.ws + WS_AO), (char*)smem); }
        }
        if (((blk >> 3) & 7) != 5) { CVT_LOOP() }
#undef CVT_LOOP
    PHASE_END(4)

    PHASE_BEGIN(5)
        for (int task = blk; task < NB * NH * rk::NCHUNK; task += G) rk::pass3_chunk(P, lds, task >> 7, task & 127, tid);
    PHASE_END(5)

    PHASE_BEGIN(6)
        pg8::DenseOrder S{(const bf16_t*)(wsb + WS_AO), (const bf16_t*)(wsb + WS_WOUT), 1024, NTOK / 256, DM / 256, G, blk};
        pg8::EpiOut E{P.x, (bf16_t*)(P.ws + WS_X1)};
        pg8::gemm_phase<pg8::EpiOut, pg8::DenseOrder, true>(lds, 1024, S, E);
    PHASE_END(6)

    PHASE_BEGIN(7)
        rt::copy_w(P, lds, tid);
        if (blk == 0 && tid < 256) ((unsigned*)(P.ws + WS_XN + (size_t)NTOK * DM))[tid] = 0u;
        __syncthreads();
        if (wave < 4) { for (int task = wave * G + blk; task < NTOK / 32; task += 4 * G) rt::route_task(P, lds, task, lane); }
        else { for (int task = (wave - 4) * G + blk; task < NTOK / 32; task += 4 * G) rt::xn8_task(P, task, lane); }
    PHASE_END(7)

    PHASE_BEGIN(8)
        const int nblk = pg8::moe_tables(tab, (const unsigned*)(wsb + WS_CTL) + CW_CNT);
        pg8::MoeOrder S{wsb + WS_XN, wsb + WS_WGU, (const int*)(wsb + WS_TOKSLOT), (const float*)(wsb + WS_GATESLOT), tab, nblk, 8, G, blk, true, P.b_gu};
        pg8::EpiGu E{P.ws + WS_ACT, tab};
        pg8::gemm_phase<pg8::EpiGu, pg8::MoeOrder, true, true>(lds, 1024, S, E);
    PHASE_END(8)
    PHASE_BEGIN(9)
        const int nblk = pg8::moe_tables(tab, (const unsigned*)(wsb + WS_CTL) + CW_CNT);
        pg8::MoeOrder S{wsb + WS_ACT, wsb + WS_WDN, (const int*)(wsb + WS_TOKSLOT), (const float*)(wsb + WS_GATESLOT), tab, nblk, 4, G, blk, false, P.b_down};
        pg8::EpiDn E{P.ws + WS_YP, (const float*)(wsb + WS_GATESLOT), tab};
        pg8::gemm_phase<pg8::EpiDn, pg8::MoeOrder, true, true>(lds, 1024, S, E);
    PHASE_END(9)
    PHASE_BEGIN(10)
        (void)pg8::moe_tables(tab, (const unsigned*)(wsb + WS_CTL) + CW_CNT);
        for (int row = blk * NWAVES + wave; row < NTOK; row += 2 * G * NWAVES) { const int rows[2] = {row, row + G * NWAVES}; combine_rows<2>(P, tab, rows, lane); }
    PHASE_END(10)
    PHASE_BEGIN(11)
        pg8::DenseOrder S{wsb + WS_XN, wsb + WS_WPG, 512, NTOK / 256, DM / 256, G, blk};
        pg8::EpiPg E{(bf16_t*)(P.ws + WS_X1), (const bf16_t*)((unsigned char*)P.out + DO_PJ)};
        pg8::gemm_phase<pg8::EpiPg, pg8::DenseOrder, true, true>(lds, 1024, S, E);
    PHASE_END(11)
    PHASE_BEGIN(12)
        const bool dead = __hip_atomic_load(ctl + CW_BAR + XB_TMO, RLX_AGENT) != 0u;
        for (int row = blk * NWAVES + wave; row < NTOK; row += G * NWAVES) final_row(P, row, lane, dead);
    PHASE_END(12)
}
#undef P
#undef wsb
#undef ctl
#undef MISC
#undef tab
extern "C" void kernel_launch(void* const* d_in, const int* in_sizes, int n_in, void* d_out, int out_size, void* d_ws, size_t ws_size, hipStream_t stream) {
    static int ok = 0;
    if (ok == 0) {
        if (n_in != 30 || in_sizes[0] != NTOK * DM || out_size != NTOK * DM || ws_size < WS_END) { fprintf(stderr, "kernel_launch: unexpected shapes (n_in %d, ws %zu)\n", n_in, ws_size); ok = -1; return; }
        if (hipFuncSetAttribute((const void*)mega_fwd, hipFuncAttributeMaxDynamicSharedMemorySize, LDS_BYTES) != hipSuccess) { fprintf(stderr, "kernel_launch: hipFuncSetAttribute failed\n"); ok = -1; return; }
        int dev = 0, cus = 0, per_cu = 0;
        if (hipGetDevice(&dev) != hipSuccess || hipDeviceGetAttribute(&cus, hipDeviceAttributeMultiprocessorCount, dev) != hipSuccess) { ok = -1; return; }
        if (hipOccupancyMaxActiveBlocksPerMultiprocessor(&per_cu, (const void*)mega_fwd, NTHREADS, LDS_BYTES) != hipSuccess || per_cu < 1) { fprintf(stderr, "kernel_launch: occupancy query says %d\n", per_cu); }
        (void)hipGetLastError();
        if (cus != 256) { fprintf(stderr, "kernel_launch: built for 256 CUs, device has %d\n", cus); ok = -1; return; }
        ok = 1;
    }
    if (ok < 0) return;
    Params P{};
    const float** pp = (const float**)&P;
    for (int i = 0; i < 30; ++i) pp[i] = (const float*)d_in[i];
    P.out = (float*)d_out; P.ws = (unsigned char*)d_ws;
    if (hipMemsetAsync((char*)d_ws + WS_CTL, 0, CTL_BYTES, stream) != hipSuccess) return;
#ifndef MK_CUTS
#define MK_CUTS 0
#endif
    if (MK_CUTS == 0) { P.ph_lo = 0; P.ph_hi = NPHASE; hipLaunchKernelGGL(mega_fwd, dim3(256), dim3(NTHREADS), LDS_BYTES, stream, P); }
    else for (int k = 0; k < NPHASE; ++k) { P.ph_lo = k; P.ph_hi = k + 1;
        hipLaunchKernelGGL(mega_fwd, dim3(256), dim3(NTHREADS), LDS_BYTES, stream, P); }
}
```
